# Optimizing an MI355X kernel written in HIP

```python
import math
import jax, jax.numpy as jnp
from jax import lax
import numpy as np

D_MODEL = 1024
BATCH = 16
SEQ = 2048
DEPTH = 1

DIFF_HEADS = 4
DIFF_QK_DIM = 64
DIFF_V_DIM = 2 * DIFF_QK_DIM
DIFF_WIDTH = DIFF_HEADS * DIFF_V_DIM
HGRN_HEADS = 4
HGRN_K_DIM = 128
HGRN_V_DIM = 128
HGRN_WIDTH = HGRN_HEADS * HGRN_V_DIM
HGRN_CHUNK = 32
MIX_WIDTH = DIFF_WIDTH + HGRN_WIDTH
DIFF_Q_COLS = DIFF_HEADS * 2 * DIFF_QK_DIM
HGRN_K_COLS = HGRN_HEADS * HGRN_K_DIM
IN_SPLIT_SIZES = (DIFF_Q_COLS, DIFF_Q_COLS, DIFF_WIDTH, HGRN_K_COLS, HGRN_K_COLS, HGRN_WIDTH, HGRN_WIDTH)
IN_WIDTH = 2 * DIFF_Q_COLS + DIFF_WIDTH + 2 * HGRN_K_COLS + 2 * HGRN_WIDTH
REL_BUCKETS = 32
REL_MAX_DIST = 128
Q_BLOCK = 128
PEER_HEADS = 8
PEER_N_KEYS = 128
PEER_N_EXPERTS = PEER_N_KEYS * PEER_N_KEYS
PEER_QUERY_DIM = 256
PEER_TOPK = 16
PEER_TOKEN_BLOCK = 128
NORM_EPS = 1e-6

kernel_name = 'hymba_diffattn_hgrn2_peer_block'


def rmsnorm(x, g):
    xf = x.astype(jnp.float32)
    y = xf * lax.rsqrt(jnp.mean(xf * xf, axis=-1, keepdims=True) + NORM_EPS)
    return (y * g.astype(jnp.float32)).astype(x.dtype)


def t5_causal_bucket(q_pos, k_pos):
    n = jnp.maximum(q_pos[:, None] - k_pos[None, :], 0)
    max_exact = REL_BUCKETS // 2
    nf = jnp.maximum(n, max_exact).astype(jnp.float32)
    large = max_exact + (jnp.log(nf / max_exact) / math.log(REL_MAX_DIST / max_exact)
                         * (REL_BUCKETS - max_exact)).astype(jnp.int32)
    large = jnp.minimum(large, REL_BUCKETS - 1)
    return jnp.where(n < max_exact, n, large)


def diff_attention(q, k, v, lam, rel_bias_table):
    B, H, _, S, dq = q.shape
    dv = v.shape[-1]
    nb = S // Q_BLOCK
    qb = q.reshape(B, H, 2, nb, Q_BLOCK, dq).transpose(3, 0, 1, 2, 4, 5)
    k_pos = jnp.arange(S)
    scale = DIFF_QK_DIM ** -0.5

    def block(args):
        qblk, bi = args
        q_pos = bi * Q_BLOCK + jnp.arange(Q_BLOCK)
        bucket = t5_causal_bucket(q_pos, k_pos)
        bias = jnp.take(rel_bias_table, bucket, axis=0).transpose(2, 0, 1).astype(jnp.float32)
        logits = jnp.einsum('bhmqd,bhmkd->bhmqk', qblk, k).astype(jnp.float32) * scale + bias[None, :, None]
        causal = k_pos[None, :] <= q_pos[:, None]
        logits = jnp.where(causal, logits, -jnp.inf)
        p = jax.nn.softmax(logits, axis=-1)
        attn = p[:, :, 0] - lam * p[:, :, 1]
        return jnp.einsum('bhqk,bhkd->bhqd', attn.astype(v.dtype), v)

    out = lax.map(block, (qb, jnp.arange(nb)))
    return out.transpose(1, 0, 3, 2, 4).reshape(B, S, H, dv)


def hgrn2_chunked(q, k, v, log_f):
    B, H, S, dk = q.shape
    dv = v.shape[-1]
    C = HGRN_CHUNK
    nc = S // C
    q, k, v, log_f = (t.reshape(B, H, nc, C, t.shape[-1]) for t in (q, k, v, log_f))
    b = jnp.cumsum(log_f, axis=3)
    b_last = b[:, :, :, -1:, :]
    q_dec = q * jnp.exp(b)
    k_inv = k * jnp.exp(-b)
    k_dec = k * jnp.exp(b_last - b)
    causal = jnp.tril(jnp.ones((C, C), dtype=bool))
    scores = jnp.where(causal, jnp.einsum('bhncd,bhnsd->bhncs', q_dec, k_inv), 0.0)
    o_intra = jnp.einsum('bhncs,bhnsv->bhncv', scores, v)
    chunk_decay = jnp.exp(b_last[:, :, :, 0, :])

    def step(state, inp):
        qd, kd, vv, cd = inp
        o = jnp.einsum('bhcd,bhdv->bhcv', qd, state)
        state = cd[..., None] * state + jnp.einsum('bhcd,bhcv->bhdv', kd, vv)
        return state, o

    xs = (jnp.moveaxis(q_dec, 2, 0), jnp.moveaxis(k_dec, 2, 0), jnp.moveaxis(v, 2, 0), jnp.moveaxis(chunk_decay, 2, 0))
    s0 = jnp.zeros((B, H, dk, dv), jnp.float32)
    _, o_inter = lax.scan(step, s0, xs)
    o = o_intra + jnp.moveaxis(o_inter, 0, 2)
    return o.reshape(B, H, S, dv)


def peer(xn, w_q, sub_keys, u, v):
    B, S, D = xn.shape
    T = B * S
    xt = xn.reshape(T, D)
    q = (xt @ w_q).reshape(T, PEER_HEADS, 2, PEER_QUERY_DIM // 2)
    s = jnp.einsum('thcd,hcnd->thcn', q, sub_keys).astype(jnp.float32)
    s1, i1 = lax.top_k(s[:, :, 0], PEER_TOPK)
    s2, i2 = lax.top_k(s[:, :, 1], PEER_TOPK)
    cand = (s1[..., :, None] + s2[..., None, :]).reshape(T, PEER_HEADS, PEER_TOPK * PEER_TOPK)
    cand_idx = (i1[..., :, None] * PEER_N_KEYS + i2[..., None, :]).reshape(T, PEER_HEADS, PEER_TOPK * PEER_TOPK)
    top_s, top_pos = lax.top_k(cand, PEER_TOPK)
    expert_idx = jnp.take_along_axis(cand_idx, top_pos, axis=-1)
    gate = jax.nn.softmax(top_s, axis=-1)
    nblk = T // PEER_TOKEN_BLOCK
    n_sel = PEER_HEADS * PEER_TOPK

    def block(args):
        xb, idx, g = args
        hidden = jnp.einsum('td,tkd->tk', xb, u[idx]).astype(jnp.float32)
        act = jax.nn.gelu(hidden, approximate=False) * g
        return jnp.einsum('tk,tkd->td', act.astype(xb.dtype), v[idx])

    out = lax.map(block, (xt.reshape(nblk, PEER_TOKEN_BLOCK, D),
                          expert_idx.reshape(nblk, PEER_TOKEN_BLOCK, n_sel),
                          gate.reshape(nblk, PEER_TOKEN_BLOCK, n_sel)))
    return out.reshape(B, S, D)


def setup_inputs(seed: int = 0) -> dict:
    key = jax.random.key(seed)
    ks = jax.random.split(key, 18)
    f32 = jnp.float32
    nrm = lambda k, shape, s: jax.random.normal(k, shape, f32) * s
    gain = lambda k, shape: 1.0 + 0.02 * jax.random.normal(k, shape, f32)
    return {
        'x': nrm(ks[0], (BATCH, SEQ, D_MODEL), 1.0),
        'norm1_g': gain(ks[1], (DEPTH, D_MODEL)),
        'w_in': nrm(ks[2], (DEPTH, D_MODEL, IN_WIDTH), D_MODEL ** -0.5),
        'diff_lambda_q1': nrm(ks[3], (DEPTH, DIFF_QK_DIM), 0.1),
        'diff_lambda_k1': nrm(ks[4], (DEPTH, DIFF_QK_DIM), 0.1),
        'diff_lambda_q2': nrm(ks[5], (DEPTH, DIFF_QK_DIM), 0.1),
        'diff_lambda_k2': nrm(ks[6], (DEPTH, DIFF_QK_DIM), 0.1),
        'diff_subln_g': gain(ks[7], (DEPTH, DIFF_V_DIM)),
        'rel_bias_table': nrm(ks[8], (REL_BUCKETS, DIFF_HEADS), 0.5),
        'hgrn_lb_logits': nrm(ks[9], (DEPTH + 1, HGRN_K_COLS), 0.1),
        'hgrn_gnorm_g': gain(ks[10], (DEPTH, HGRN_V_DIM)),
        'w_out': nrm(ks[11], (DEPTH, MIX_WIDTH, D_MODEL), MIX_WIDTH ** -0.5),
        'norm2_g': gain(ks[12], (DEPTH, D_MODEL)),
        'peer_w_q': nrm(ks[13], (DEPTH, D_MODEL, PEER_HEADS * PEER_QUERY_DIM), D_MODEL ** -0.5),
        'peer_sub_keys': nrm(ks[14], (DEPTH, PEER_HEADS, 2, PEER_N_KEYS, PEER_QUERY_DIM // 2), (PEER_QUERY_DIM // 2) ** -0.5),
        'peer_u': nrm(ks[15], (DEPTH, PEER_N_EXPERTS, D_MODEL), D_MODEL ** -0.5),
        'peer_v': nrm(ks[16], (DEPTH, PEER_N_EXPERTS, D_MODEL), PEER_HEADS ** -0.5),
        'final_norm_g': gain(ks[17], (D_MODEL,)),
    }


def reference(x, norm1_g, w_in, diff_lambda_q1, diff_lambda_k1, diff_lambda_q2, diff_lambda_k2,
              diff_subln_g, rel_bias_table, hgrn_lb_logits, hgrn_gnorm_g, w_out, norm2_g,
              peer_w_q, peer_sub_keys, peer_u, peer_v, final_norm_g):
    B, S, _ = x.shape
    split_points = [int(p) for p in np.cumsum(IN_SPLIT_SIZES)[:-1]]
    lb_all = jnp.cumsum(jax.nn.softmax(hgrn_lb_logits.astype(jnp.float32), axis=0), axis=0)
    h = x
    for l in range(DEPTH):
        hn = rmsnorm(h, norm1_g[l])
        proj = hn @ w_in[l]
        dq, dk, dvv, hq, hf, hi, hg = jnp.split(proj, split_points, axis=-1)

        q = dq.reshape(B, S, DIFF_HEADS, 2, DIFF_QK_DIM).transpose(0, 2, 3, 1, 4)
        k = dk.reshape(B, S, DIFF_HEADS, 2, DIFF_QK_DIM).transpose(0, 2, 3, 1, 4)
        v = dvv.reshape(B, S, DIFF_HEADS, DIFF_V_DIM).transpose(0, 2, 1, 3)
        lam_init = 0.8 - 0.6 * math.exp(-0.3 * l)
        lam = (jnp.exp(jnp.sum(diff_lambda_q1[l].astype(jnp.float32) * diff_lambda_k1[l].astype(jnp.float32)))
               - jnp.exp(jnp.sum(diff_lambda_q2[l].astype(jnp.float32) * diff_lambda_k2[l].astype(jnp.float32)))
               + lam_init)
        a = diff_attention(q, k, v, lam, rel_bias_table)
        a = rmsnorm(a, diff_subln_g[l]) * (1.0 - lam_init)

        heads = lambda t: t.reshape(B, S, HGRN_HEADS, -1).transpose(0, 2, 1, 3).astype(jnp.float32)
        lb = lb_all[l].reshape(HGRN_HEADS, 1, HGRN_K_DIM)
        f = lb + (1.0 - lb) * jax.nn.sigmoid(heads(hf))
        o = hgrn2_chunked(jax.nn.silu(heads(hq)), 1.0 - f, heads(hi), jnp.log(f))
        o = o.transpose(0, 2, 1, 3)
        o = rmsnorm(o, hgrn_gnorm_g[l]) * jax.nn.silu(hg.reshape(B, S, HGRN_HEADS, HGRN_V_DIM).astype(jnp.float32))

        mixed = jnp.concatenate([a.reshape(B, S, DIFF_WIDTH).astype(x.dtype),
                                 o.reshape(B, S, HGRN_WIDTH).astype(x.dtype)], axis=-1)
        h = h + mixed @ w_out[l]

        hn2 = rmsnorm(h, norm2_g[l])
        h = h + peer(hn2, peer_w_q[l], peer_sub_keys[l], peer_u[l], peer_v[l])
    return rmsnorm(h, final_norm_g)
```

```cpp
#include <hip/hip_runtime.h>
#include <cstdio>
#include <cstdint>
#include <cmath>
namespace pg8 {
#define PG8_LAS __attribute__((address_space(3)))
typedef unsigned short bf16_t;
typedef short bf16x8 __attribute__((ext_vector_type(8)));
typedef float f32x4 __attribute__((ext_vector_type(4)));
typedef unsigned u32x4 __attribute__((ext_vector_type(4)));
constexpr int BM = 256, BK = 64, HALF = 128, HTB = HALF * BK * 2  , STAGE_BYTES = 8 * HTB, NXCD = 8, WGM = 8;

__host__ __device__ __forceinline__ int lds_byte(int r, int c) { const int st = (r >> 4) * 2 + (c >> 5), rr = r & 15, cc = c & 31, ob = rr * 64 + cc * 2; return st * 1024 + (ob ^ (((ob >> 9) & 1) << 5)); }
__host__ __device__ __forceinline__ void stage_rc(int b, int& R, int& C) { const int st = b / 1024, sb = b % 1024, swz = sb ^ (((sb >> 9) & 1) << 5); R = (st >> 1) * 16 + swz / 64; C = (st & 1) * 32 + (swz % 64) / 2; }
__host__ __device__ __forceinline__ int perm32(int rho) { const int n = rho >> 4, i = rho & 15; return 8 * (i >> 2) + 4 * n + (i & 3); }

struct Unit { int pm, pn; };
struct Gemm { const bf16_t* A; const bf16_t* Bt; int M, N, K; };

struct StaticOrder {
    int nM, nN, nwg, G, c;
    __host__ __device__ void init(int M, int N, int G_, int c_) { nM = M / BM; nN = N / BM; nwg = nM * nN; G = G_; c = c_; }
    __host__ __device__ bool next(int i, Unit& u) const {
        const long L = (long)i * G + c; if (L >= nwg) return false;
        int wgid = (int)L; { const int q = nwg / NXCD, r = nwg % NXCD, xcd = wgid % NXCD, off = wgid / NXCD; wgid = (xcd < r ? xcd * (q + 1) : r * (q + 1) + (xcd - r) * q) + off; }
        const int nig = WGM * nN, gid = wgid / nig, fm = gid * WGM, gsz = (nM - fm) < WGM ? (nM - fm) : WGM;
        u.pm = fm + ((wgid % nig) % gsz); u.pn = (wgid % nig) / gsz; return true;
    }
    __device__ __forceinline__ void a_ready(const Unit&) const {}
    __device__ __forceinline__ void done(const Unit&) const {}
};
__device__ __forceinline__ unsigned cvt_pk_bf16(float lo, float hi) { unsigned r; asm volatile("v_cvt_pk_bf16_f32 %0, %1, %2" : "=v"(r) : "v"(lo), "v"(hi)); return r; }
typedef float f32x2 __attribute__((ext_vector_type(2)));
__device__ __forceinline__ f32x2 gelu_pk(f32x2 v) {
    const f32x2 av = __builtin_elementwise_abs(v), d = av * 0.2316418882f + 1.0f;
    f32x2 t; t.x = __builtin_amdgcn_rcpf(d.x); t.y = __builtin_amdgcn_rcpf(d.y);
    f32x2 q = t * 0.5307027145f + (-0.7265760135f); q = q * t + 0.7107068705f; q = q * t + (-0.142248368f); q = q * t + 0.127414796f; q = q * t;
    const f32x2 s = (v * v) * (-0.72134752044f);
    f32x2 e; e.x = __builtin_amdgcn_exp2f(s.x); e.y = __builtin_amdgcn_exp2f(s.y);
    const f32x2 m = v * (q * e), r = v - m;
    f32x2 o; o.x = v.x < 0.f ? m.x : r.x; o.y = v.y < 0.f ? m.y : r.y; return o;
}
struct EpiProj {
    static constexpr bool PERM = true, AFTER_DRAIN = false;
    bf16_t* O; int ldc; int qtiles; float qscale;
    __device__ __forceinline__ void operator()(const f32x4 (&acc)[2][2][4][2], const Unit& u, int wr, int wc, int fr, int fq) const {
        const int row0 = u.pm * BM + wr * 64 + fr, col0 = u.pn * BM + wc * 32 + 8 * fq;
        const float sc = (u.pn < qtiles) ? qscale : 1.f;
#pragma unroll
        for (int ai = 0; ai < 2; ++ai)
#pragma unroll
            for (int m = 0; m < 4; ++m) { bf16_t* rowp = O + (size_t)(row0 + ai * HALF + m * 16) * ldc + col0;
#pragma unroll
                for (int bj = 0; bj < 2; ++bj) { const f32x4 v0 = acc[ai][bj][m][0] * sc, v1 = acc[ai][bj][m][1] * sc;
                    u32x4 w; w.x = cvt_pk_bf16(v0[0], v0[1]); w.y = cvt_pk_bf16(v0[2], v0[3]); w.z = cvt_pk_bf16(v1[0], v1[1]); w.w = cvt_pk_bf16(v1[2], v1[3]);
                    *(u32x4*)(rowp + bj * HALF) = w; } }
    }
};
struct EpiF32Res {
    static constexpr bool PERM = false, AFTER_DRAIN = false;
    float* C; int ldc; const float* res;
    __device__ __forceinline__ void operator()(const f32x4 (&acc)[2][2][4][2], const Unit& u, int wr, int wc, int fr, int fq) const {
        const int row0 = u.pm * BM + wr * 64 + fr, col0 = u.pn * BM + wc * 32 + 4 * fq;
#pragma unroll
        for (int ai = 0; ai < 2; ++ai)
#pragma unroll
            for (int m = 0; m < 4; ++m) { const size_t off = (size_t)(row0 + ai * HALF + m * 16) * ldc + col0;
#pragma unroll
                for (int bj = 0; bj < 2; ++bj)
#pragma unroll
                    for (int n = 0; n < 2; ++n) { f32x4 o = acc[ai][bj][m][n]; if (res) o = o + *(const f32x4*)(res + off + bj * HALF + n * 16);
                        *(f32x4*)(C + off + bj * HALF + n * 16) = o; } }
    }
};

struct EpiMix {
    static constexpr bool PERM = true, AFTER_DRAIN = false;
    int ldc; const float* res; const float* g2; bf16_t* HB; unsigned char* XB; float* ssq;
    __device__ __forceinline__ void operator()(const f32x4 (&acc)[2][2][4][2], const Unit& u, int wr, int wc, int fr, int fq) const {
        const int row0 = u.pm * BM + wr * 64 + fr, col0 = u.pn * BM + wc * 32 + 8 * fq;
        f32x4 gv[2][2];
#pragma unroll
        for (int bj = 0; bj < 2; ++bj)
#pragma unroll
            for (int n = 0; n < 2; ++n) gv[bj][n] = *(const f32x4*)(g2 + col0 + bj * HALF + 4 * n);
#pragma unroll
        for (int ai = 0; ai < 2; ++ai)
#pragma unroll
            for (int m = 0; m < 4; ++m) { const int row = row0 + ai * HALF + m * 16; const size_t off = (size_t)row * ldc + col0; float sq = 0.f;
#pragma unroll
                for (int bj = 0; bj < 2; ++bj) {
                    const f32x4 h0 = acc[ai][bj][m][0] + *(const f32x4*)(res + off + bj * HALF), h1 = acc[ai][bj][m][1] + *(const f32x4*)(res + off + bj * HALF + 4);
                    sq += (h0[0] * h0[0] + h0[1] * h0[1]) + (h0[2] * h0[2] + h0[3] * h0[3]) + (h1[0] * h1[0] + h1[1] * h1[1]) + (h1[2] * h1[2] + h1[3] * h1[3]);
                    u32x4 w; w.x = cvt_pk_bf16(h0[0], h0[1]); w.y = cvt_pk_bf16(h0[2], h0[3]); w.z = cvt_pk_bf16(h1[0], h1[1]); w.w = cvt_pk_bf16(h1[2], h1[3]);
                    *(u32x4*)(HB + off + bj * HALF) = w;
                    const f32x4 g0 = h0 * gv[bj][0], g1 = h1 * gv[bj][1];
                    int p0 = __builtin_amdgcn_cvt_pk_bf8_f32(g0[0], g0[1], 0, false); p0 = __builtin_amdgcn_cvt_pk_bf8_f32(g0[2], g0[3], p0, true);
                    int p1 = __builtin_amdgcn_cvt_pk_bf8_f32(g1[0], g1[1], 0, false); p1 = __builtin_amdgcn_cvt_pk_bf8_f32(g1[2], g1[3], p1, true);
                    typedef unsigned u32x2 __attribute__((ext_vector_type(2)));
                    *(u32x2*)(XB + off + bj * HALF) = (u32x2){(unsigned)p0, (unsigned)p1}; }
                sq += __shfl_xor(sq, 16); sq += __shfl_xor(sq, 32);
                if (fq == 0) atomicAdd(ssq + row, sq); }
    }
};
struct EpiScaleRow {
    static constexpr bool PERM = true, AFTER_DRAIN = false;
    _Float16* C; int ldc; const float* ssq; float invk, eps;
    __device__ __forceinline__ void operator()(const f32x4 (&acc)[2][2][4][2], const Unit& u, int wr, int wc, int fr, int fq) const {
        typedef _Float16 h2 __attribute__((ext_vector_type(2)));
        const int row0 = u.pm * BM + wr * 64 + fr, col0 = u.pn * BM + wc * 32 + 8 * fq;
#pragma unroll
        for (int ai = 0; ai < 2; ++ai)
#pragma unroll
            for (int m = 0; m < 4; ++m) { const int row = row0 + ai * HALF + m * 16; const size_t off = (size_t)row * ldc + col0; const float rs = 1.f / sqrtf(ssq[row] * invk + eps);
#pragma unroll
                for (int bj = 0; bj < 2; ++bj) { const f32x4 v0 = acc[ai][bj][m][0] * rs, v1 = acc[ai][bj][m][1] * rs;
                    const h2 p0 = {(_Float16)v0[0], (_Float16)v0[1]}, p1 = {(_Float16)v0[2], (_Float16)v0[3]}, p2 = {(_Float16)v1[0], (_Float16)v1[1]}, p3 = {(_Float16)v1[2], (_Float16)v1[3]};
                    u32x4 w; w.x = __builtin_bit_cast(unsigned, p0); w.y = __builtin_bit_cast(unsigned, p1); w.z = __builtin_bit_cast(unsigned, p2); w.w = __builtin_bit_cast(unsigned, p3);
                    *(u32x4*)(C + off + bj * HALF) = w; } }
    }
};
template <class Epi, class Sched, bool ALIGN_EPI = false, bool SP2 = false>
__device__ __forceinline__ void gemm_phase(PG8_LAS unsigned char* lds, const Gemm g, const Sched& S, const Epi& E) {
    const int tid = threadIdx.x, wid = __builtin_amdgcn_readfirstlane(tid >> 6), lane = tid & 63, wr = wid >> 2, wc = wid & 3, fr = lane & 15, fq = lane >> 4;
    const int K = g.K, nt = K / BK;
    unsigned voffA[2], voffB[2];
#pragma unroll
    for (int i = 0; i < 2; ++i) { int R, C; stage_rc(tid * 16 + i * 8192, R, C); const int Rb = Epi::PERM ? ((R & ~31) + perm32(R & 31)) : R;
        voffA[i] = (unsigned)(R * K + C) * 2u; voffB[i] = (unsigned)(Rb * K + C) * 2u; }
    const size_t kstep = (size_t)(BK * 2);
    const size_t hstep = (size_t)HALF * K * 2;
    const size_t tstep = 2 * hstep;
    const unsigned ldsw = (unsigned)wid * 1024u;
    const int aoff = lds_byte(wr * 64 + fr, fq * 8), boff = lds_byte(wc * 32 + fr, fq * 8);
#define PG8_SA(b, h) (((b) * 2 + (h)) * HTB)
#define PG8_SB(b, h) ((4 + (b) * 2 + (h)) * HTB)
#define PG8_STAGE(bufoff, gbase, voff) do { _Pragma("unroll") for (int _i = 0; _i < 2; ++_i) \
        __builtin_amdgcn_global_load_lds((const unsigned*)((const char*)(gbase) + (voff)[_i]), (PG8_LAS unsigned*)(lds + (bufoff) + ldsw + _i * 8192), 16, 0, 0); } while (0)
#define PG8_LDA(dst, b, h) do { _Pragma("unroll") for (int m = 0; m < 4; ++m) _Pragma("unroll") for (int k = 0; k < 2; ++k) dst[m][k] = *(const PG8_LAS bf16x8*)(lds + PG8_SA(b, h) + aoff + m * 2048 + k * 1024); } while (0)
#define PG8_LDB(dst, b, h) do { _Pragma("unroll") for (int n = 0; n < 2; ++n) _Pragma("unroll") for (int k = 0; k < 2; ++k) dst[n][k] = *(const PG8_LAS bf16x8*)(lds + PG8_SB(b, h) + boff + n * 2048 + k * 1024); } while (0)
#define PG8_MMA(ai, bj, At, Bt) do { __builtin_amdgcn_s_setprio(1); _Pragma("unroll") for (int m = 0; m < 4; ++m) _Pragma("unroll") for (int n = 0; n < 2; ++n) _Pragma("unroll") for (int k = 0; k < 2; ++k) \
        acc[ai][bj][m][n] = __builtin_amdgcn_mfma_f32_16x16x32_bf16(Bt[n][k], At[m][k], acc[ai][bj][m][n], 0, 0, 0); __builtin_amdgcn_s_setprio(0); } while (0)
#define PG8_WAIT_V(n) asm volatile("s_waitcnt vmcnt(" #n ")" ::: "memory")
#define PG8_WAIT_L(n) asm volatile("s_waitcnt lgkmcnt(" #n ")" ::: "memory")
#define PG8_BAR __builtin_amdgcn_s_barrier()
#define PG8_SCHED __builtin_amdgcn_sched_barrier(0)
    Unit cur, nxt; int ui = 0;
    if (!S.next(0, cur)) return;
    f32x4 acc[2][2][4][2];
#pragma unroll
    for (int a = 0; a < 2; ++a)
#pragma unroll
        for (int b = 0; b < 2; ++b)
#pragma unroll
            for (int m = 0; m < 4; ++m)
#pragma unroll
                for (int n = 0; n < 2; ++n) acc[a][b][m][n] = (f32x4){0.f, 0.f, 0.f, 0.f};
    bf16x8 At[4][2], B0[2][2], B1[2][2];
    const char* cA = (const char*)g.A + (size_t)cur.pm * tstep; const char* cB = (const char*)g.Bt + (size_t)cur.pn * tstep;
    S.a_ready(cur);
    if constexpr (SP2) {
        PG8_STAGE(PG8_SB(0, 0), cB, voffB); PG8_STAGE(PG8_SB(0, 1), cB + hstep, voffB); PG8_STAGE(PG8_SA(0, 0), cA, voffA); PG8_STAGE(PG8_SA(0, 1), cA + hstep, voffA);
        if (wr == 1) PG8_BAR;
        PG8_WAIT_V(2); PG8_BAR;
        PG8_STAGE(PG8_SB(1, 0), cB + kstep, voffB); PG8_STAGE(PG8_SA(1, 0), cA + kstep, voffA); PG8_STAGE(PG8_SB(1, 1), cB + hstep + kstep, voffB);
        PG8_WAIT_V(6); PG8_BAR;
    } else {
        PG8_STAGE(PG8_SB(0, 0), cB, voffB); PG8_STAGE(PG8_SA(0, 0), cA, voffA); PG8_STAGE(PG8_SB(0, 1), cB + hstep, voffB); PG8_STAGE(PG8_SA(0, 1), cA + hstep, voffA);
        if (wr == 1) PG8_BAR;
        PG8_WAIT_V(4); PG8_BAR;
        PG8_STAGE(PG8_SB(1, 0), cB + kstep, voffB); PG8_STAGE(PG8_SA(1, 0), cA + kstep, voffA); PG8_STAGE(PG8_SB(1, 1), cB + hstep + kstep, voffB);
        PG8_WAIT_V(6); PG8_BAR;
    }
    for (;;) {
        const bool has_next = S.next(ui + 1, nxt);
        const char* nA = has_next ? (const char*)g.A + (size_t)nxt.pm * tstep : cA; const char* nB = has_next ? (const char*)g.Bt + (size_t)nxt.pn * tstep : cB;
        for (int t = 0; t < nt; t += 2) {
            const bool last = (t == nt - 2);
            const char* a1 = cA + (size_t)(t + 1) * kstep;
            const char* a2 = last ? nA : cA + (size_t)(t + 2) * kstep; const char* b2 = last ? nB : cB + (size_t)(t + 2) * kstep;
            const char* a3 = a2 + kstep; const char* b3 = b2 + kstep;
            if (last && has_next) S.a_ready(nxt);
            if constexpr (SP2) {
            PG8_LDB(B0, 0, 0); PG8_LDB(B1, 0, 1); PG8_SCHED; PG8_LDA(At, 0, 0); PG8_STAGE(PG8_SA(1, 1), a1 + hstep, voffA);
            PG8_WAIT_V(8); PG8_WAIT_L(0); PG8_BAR; PG8_MMA(0, 0, At, B0); PG8_MMA(0, 1, At, B1); PG8_BAR; PG8_SCHED;
            PG8_LDA(At, 0, 1); PG8_STAGE(PG8_SB(0, 0), b2, voffB); PG8_STAGE(PG8_SB(0, 1), b2 + hstep, voffB); PG8_STAGE(PG8_SA(0, 0), a2, voffA);
            PG8_WAIT_V(8); PG8_WAIT_L(0); PG8_BAR; PG8_MMA(1, 0, At, B0); PG8_MMA(1, 1, At, B1); PG8_BAR; PG8_SCHED;
            PG8_LDB(B0, 1, 0); PG8_LDB(B1, 1, 1); PG8_SCHED; PG8_LDA(At, 1, 0); PG8_STAGE(PG8_SA(0, 1), a2 + hstep, voffA);
            PG8_WAIT_V(8); PG8_WAIT_L(0); PG8_BAR; PG8_MMA(0, 0, At, B0); PG8_MMA(0, 1, At, B1); PG8_BAR; PG8_SCHED;
            PG8_LDA(At, 1, 1); PG8_STAGE(PG8_SB(1, 0), b3, voffB); PG8_STAGE(PG8_SB(1, 1), b3 + hstep, voffB); PG8_STAGE(PG8_SA(1, 0), a3, voffA);
            PG8_WAIT_V(8); PG8_WAIT_L(0); PG8_BAR; PG8_MMA(1, 0, At, B0); PG8_MMA(1, 1, At, B1); PG8_BAR; PG8_SCHED;
            } else {
            PG8_LDB(B0, 0, 0); PG8_SCHED; PG8_LDA(At, 0, 0); PG8_STAGE(PG8_SA(1, 1), a1 + hstep, voffA);
            PG8_WAIT_L(8); PG8_BAR; PG8_WAIT_L(0); PG8_MMA(0, 0, At, B0); PG8_BAR; PG8_SCHED;
            PG8_LDB(B1, 0, 1); PG8_STAGE(PG8_SB(0, 0), b2, voffB);
            PG8_BAR; PG8_WAIT_L(0); PG8_MMA(0, 1, At, B1); PG8_BAR;
            PG8_LDA(At, 0, 1); PG8_STAGE(PG8_SA(0, 0), a2, voffA);
            PG8_BAR; PG8_WAIT_L(0); PG8_MMA(1, 0, At, B0); PG8_BAR; PG8_SCHED;
            PG8_STAGE(PG8_SB(0, 1), b2 + hstep, voffB);
            PG8_WAIT_V(6); PG8_BAR; PG8_MMA(1, 1, At, B1); PG8_BAR;
            PG8_LDB(B0, 1, 0); PG8_SCHED; PG8_LDA(At, 1, 0); PG8_STAGE(PG8_SA(0, 1), a2 + hstep, voffA);
            PG8_WAIT_L(8); PG8_BAR; PG8_WAIT_L(0); PG8_MMA(0, 0, At, B0); PG8_BAR; PG8_SCHED;
            PG8_LDB(B1, 1, 1); PG8_STAGE(PG8_SB(1, 0), b3, voffB);
            PG8_BAR; PG8_WAIT_L(0); PG8_MMA(0, 1, At, B1); PG8_BAR;
            PG8_LDA(At, 1, 1); PG8_STAGE(PG8_SA(1, 0), a3, voffA);
            PG8_BAR; PG8_WAIT_L(0); PG8_MMA(1, 0, At, B0); PG8_BAR; PG8_SCHED;
            PG8_STAGE(PG8_SB(1, 1), b3 + hstep, voffB);
            PG8_WAIT_V(6); PG8_BAR; PG8_MMA(1, 1, At, B1); PG8_BAR;
            }
        }
        if constexpr (ALIGN_EPI) { if (wr == 0) PG8_BAR; }
        if constexpr (!Epi::AFTER_DRAIN) { E(acc, cur, wr, wc, fr, fq); S.done(cur); }
        if (!has_next) break;
#pragma unroll
        for (int a = 0; a < 2; ++a)
#pragma unroll
            for (int b = 0; b < 2; ++b)
#pragma unroll
                for (int m = 0; m < 4; ++m)
#pragma unroll
                    for (int n = 0; n < 2; ++n) acc[a][b][m][n] = (f32x4){0.f, 0.f, 0.f, 0.f};
        cur = nxt; cA = nA; cB = nB; ++ui;
        if constexpr (ALIGN_EPI) { if (wr == 1) PG8_BAR; }
    }
    PG8_WAIT_V(0);
    if constexpr (!ALIGN_EPI) { if (wr == 0) PG8_BAR; }
    PG8_BAR;
    if constexpr (Epi::AFTER_DRAIN) { E.fused(acc, cur, wr, wc, fr, fq, lds, wid, lane); S.done(cur); }
#undef PG8_SA
#undef PG8_SB
#undef PG8_STAGE
#undef PG8_LDA
#undef PG8_LDB
#undef PG8_MMA
#undef PG8_WAIT_V
#undef PG8_WAIT_L
#undef PG8_BAR
#undef PG8_SCHED
}
}
#ifndef PG8_SP2
#define PG8_SP2 true
#endif
#ifndef PG8_ALIGN
#define PG8_ALIGN true
#endif

constexpr int NWAVES = 8;
constexpr int NTOK = 32768, DM = 1024, SEQ = 2048, NBATCH = 16, INW = 3584;
constexpr int C_DQ = 0, C_DK = 512, C_DV = 1024, C_HQ = 1536, C_HF = 2048, C_HI = 2560, C_HG = 3072;
constexpr float EPS = 1e-6f;
constexpr float QSCALE = 0.125f * 1.4426950408889634f;
constexpr float LAM_INIT = 0.2f;
constexpr int NEXP_SEL = 128;

constexpr size_t MiB = 1u << 20;
constexpr size_t WS_CTL = 0, CTL_ZERO_BYTES = 1 * MiB;
constexpr size_t WS_SMALL = 1 * MiB;
constexpr size_t WS_WIN = 2 * MiB;
constexpr size_t WS_WOUT = 10 * MiB;
constexpr size_t WS_W2 = 12 * MiB;
constexpr size_t WS_U8 = 17 * MiB;
constexpr size_t WS_V8 = 33 * MiB;
constexpr size_t WS_SU = 49 * MiB;
constexpr size_t WS_SV = 49 * MiB + 512 * 1024;
constexpr size_t WS_X8 = 50 * MiB;
constexpr size_t WS_SX = 116 * MiB;
constexpr size_t WS_GSU = 120 * MiB;
constexpr size_t WS_HN = 84 * MiB;
constexpr size_t WS_PROJ = 148 * MiB;
constexpr size_t WS_HN2 = 148 * MiB;
constexpr size_t WS_SC = 212 * MiB;
constexpr size_t WS_PO = 212 * MiB;
constexpr size_t WS_IDX = 468 * MiB;
constexpr size_t WS_GATE = 484 * MiB;
constexpr size_t WS_END = 500 * MiB;
constexpr int SM_LB = 0, SM_LAM = 512, SM_BIAS = 1024;
constexpr int CW_BAR = 4096;
constexpr int CW_ATTQ = 8192;
constexpr int CW_SSQ = 131072;

constexpr int RING_OFF = 0, RING_BYTES = 139264;
constexpr int LDSCTL_OFF = RING_BYTES, MISC_OFF = LDSCTL_OFF + 320;
constexpr int LDS_BYTES = 147456;

#define GAS __attribute__((address_space(1)))
#define LAS __attribute__((address_space(3)))
typedef unsigned short bf16;
typedef unsigned v4u __attribute__((ext_vector_type(4)));
typedef unsigned v2u __attribute__((ext_vector_type(2)));
typedef float f32x4 __attribute__((ext_vector_type(4)));
typedef short bf16x8 __attribute__((ext_vector_type(8)));
typedef GAS unsigned gu32;
typedef long l2 __attribute__((ext_vector_type(2)));
typedef int v4i __attribute__((ext_vector_type(4)));
#define RLX_AGENT __ATOMIC_RELAXED, __HIP_MEMORY_SCOPE_AGENT
#define LDS_WAIT() asm volatile("s_waitcnt lgkmcnt(0)" ::: "memory")
#define VM_WAIT() asm volatile("s_waitcnt vmcnt(0)" ::: "memory")
__device__ __forceinline__ unsigned f2bf(float f) { unsigned u = __builtin_bit_cast(unsigned, f); return (u + 0x7fffu + ((u >> 16) & 1u)) >> 16; }
__device__ __forceinline__ unsigned pk2(float lo, float hi) { return f2bf(lo) | (f2bf(hi) << 16); }
__device__ __forceinline__ float bflo(unsigned w) { return __builtin_bit_cast(float, w << 16); }
__device__ __forceinline__ float bfhi(unsigned w) { return __builtin_bit_cast(float, w & 0xffff0000u); }

#define XB_TMO      128
#define XB_XCNT(j)  (256  + 64 * (j))
#define XB_XSUB(j)  (1280 + 64 * (j))
#define XB_XGEN(j)  (2304 + 64 * (j))
#define XB_TOP      3328
#define XB_TOPGEN   3392
#define XCD_BAR_WORDS 3456
#define XB_SPIN_CAP (1u << 18)
__device__ __forceinline__ unsigned xb_ld(unsigned* p)              { return __hip_atomic_load(p, __ATOMIC_RELAXED, __HIP_MEMORY_SCOPE_AGENT); }
__device__ __forceinline__ unsigned xb_add(unsigned* p, unsigned v) { return __hip_atomic_fetch_add(p, v, __ATOMIC_RELAXED, __HIP_MEMORY_SCOPE_AGENT); }
__device__ __forceinline__ unsigned xb_xcc_id() { return (unsigned)__builtin_amdgcn_s_getreg((3 << 11) | 20) & 0xFu; }
#define XB_SPIN(cond, bar) do { unsigned _sp = 0; while (cond) { __builtin_amdgcn_s_sleep(1); \
    if ((++_sp & 255u) == 0u) { if (xb_ld(&(bar)[XB_TMO])) break; if (_sp > XB_SPIN_CAP) { atomicAdd(&(bar)[XB_TMO], 1u); break; } } } } while (0)
struct XcdBarrier { unsigned* bar; unsigned x; volatile LAS unsigned* st; };
__device__ __forceinline__ XcdBarrier xcd_barrier_post(unsigned* bar, volatile LAS unsigned* st) {
    XcdBarrier b; b.bar = bar; b.x = xb_xcc_id(); b.st = st;
    if (threadIdx.x == 0) (void)xb_add(&bar[XB_XCNT(b.x)], 1u);
    return b;
}
__device__ __forceinline__ void xcd_barrier_complete(unsigned* bar, unsigned x, unsigned& nloc, unsigned& nx) {
    const unsigned G = gridDim.x * gridDim.y * gridDim.z;
    unsigned sum, cnt, mine, sp = 0u;
    for (;;) {
        sum = 0u; cnt = 0u; mine = 0u;
#pragma unroll
        for (unsigned j = 0; j < 16; ++j) { const unsigned c = xb_ld(&bar[XB_XCNT(j)]); sum += c; cnt += (c > 0u) ? 1u : 0u; mine = (j == x) ? c : mine; }
        if (sum == G) break;
        __builtin_amdgcn_s_sleep(1);
        if ((++sp & 255u) == 0u) { if (xb_ld(&bar[XB_TMO])) break; if (sp > XB_SPIN_CAP) { atomicAdd(&bar[XB_TMO], 1u); break; } }
    }
    nloc = mine > 0u ? mine : 1u; nx = cnt > 0u ? cnt : 1u;
}
__device__ __forceinline__ void xcd_barrier(const XcdBarrier& b) {
    asm volatile("s_waitcnt vmcnt(0)" ::: "memory");
    __syncthreads();
    if (threadIdx.x == 0) {
        unsigned* bar = b.bar;
        __builtin_amdgcn_s_waitcnt(0);
        unsigned nloc = b.st[0], nx = b.st[1];
        if (nloc == 0u) { xcd_barrier_complete(bar, b.x, nloc, nx); b.st[0] = nloc; b.st[1] = nx; }
        const unsigned old = xb_add(&bar[XB_XSUB(b.x)], 1u);
        const unsigned gen = old / nloc;
        if (old + 1u == (gen + 1u) * nloc) {
            __builtin_amdgcn_fence(__ATOMIC_RELEASE, "agent");
            asm volatile("s_waitcnt vmcnt(0)" ::: "memory");
            const unsigned og = xb_add(&bar[XB_TOP], 1u);
            const unsigned tg = og / nx;
            if (og + 1u == (tg + 1u) * nx) xb_add(&bar[XB_TOPGEN], 1u);
            else XB_SPIN(xb_ld(&bar[XB_TOPGEN]) == tg, bar);
            __builtin_amdgcn_fence(__ATOMIC_ACQUIRE, "agent");
            xb_add(&bar[XB_XGEN(b.x)], 1u);
            asm volatile("s_waitcnt vmcnt(0)" ::: "memory");
        } else {
            XB_SPIN(xb_ld(&bar[XB_XGEN(b.x)]) == gen, bar);
            __builtin_amdgcn_fence(__ATOMIC_ACQUIRE, "agent");
            asm volatile("s_waitcnt vmcnt(0)" ::: "memory");
        }
    }
    __syncthreads();
}

#define SCHED_FENCE() __builtin_amdgcn_sched_barrier(0)
__device__ __forceinline__ float gelu_as(float v) {
    const float av = fabsf(v), t = __builtin_amdgcn_rcpf(av * 0.2316418882f + 1.0f);
    float q = t * 0.5307027145f + (-0.7265760135f); q = q * t + 0.7107068705f; q = q * t + (-0.142248368f); q = q * t + 0.127414796f; q = q * t;
    const float e = __builtin_amdgcn_exp2f((v * v) * (-0.72134752044f));
    const float mm = v * (q * e);
    return v < 0.f ? mm : v - mm;
}
struct Frame {
    LAS unsigned char* lds;
    volatile LAS unsigned* MISC;
    int tid, lane, wave, vcu, G;
    const float* in[18]; float* out; unsigned char* ws;
};
__device__ __forceinline__ float wave_sum(float v) {
#pragma unroll
    for (int o = 1; o < 64; o <<= 1) v += __shfl_xor(v, o);
    return v;
}
__device__ __forceinline__ float sigmoidf_(float x) { return 1.f / (1.f + __expf(-x)); }

__device__ __forceinline__ void p0_transpose_item(const float* W, int K, int N, bf16* WT, int row_off, LAS float* scr, int item, int lane) {
    const int nblk = N / 32, kb = item / nblk, nb = item % nblk, k0 = 64 * kb, n0 = 32 * nb;
#pragma unroll 8
    for (int i = 0; i < 32; ++i) { const int kk = 2 * i + (lane >> 5); scr[kk * 33 + (lane & 31)] = W[(size_t)(k0 + kk) * N + n0 + (lane & 31)]; }
    LDS_WAIT(); asm volatile("" ::: "memory");
    const int c = lane & 7;
#pragma unroll
    for (int j = 0; j < 4; ++j) { const int n = (lane >> 3) + 8 * j; const LAS float* s = scr + (8 * c) * 33 + n;
        v4u o; o.x = pk2(s[0 * 33], s[1 * 33]); o.y = pk2(s[2 * 33], s[3 * 33]); o.z = pk2(s[4 * 33], s[5 * 33]); o.w = pk2(s[6 * 33], s[7 * 33]);
        *(GAS v4u*)(WT + (size_t)(row_off + n0 + n) * K + k0 + 8 * c) = o; }
    LDS_WAIT(); asm volatile("" ::: "memory");
}

__device__ __forceinline__ void quant_vals_fp8(const f32x4 (&v)[4], unsigned char* dst, float* dq, int lane, size_t slice_stride) {
    float mx = 0.f;
#pragma unroll
    for (int j = 0; j < 4; ++j) mx = fmaxf(mx, fmaxf(fmaxf(fabsf(v[j].x), fabsf(v[j].y)), fmaxf(fabsf(v[j].z), fabsf(v[j].w))));
#pragma unroll
    for (int o = 1; o < 64; o <<= 1) mx = fmaxf(mx, __shfl_xor(mx, o));
    const float qs = mx > 0.f ? 224.f / mx : 1.f;
#pragma unroll
    for (int j = 0; j < 4; ++j) { int p = __builtin_amdgcn_cvt_pk_fp8_f32(v[j].x * qs, v[j].y * qs, 0, false); p = __builtin_amdgcn_cvt_pk_fp8_f32(v[j].z * qs, v[j].w * qs, p, true);
        const int d = 4 * lane + 256 * j; *(GAS unsigned*)(dst + (slice_stride ? (size_t)(d >> 7) * slice_stride + (d & 127) : (size_t)d)) = (unsigned)p; }
    if (lane == 0) *dq = mx > 0.f ? mx * (1.f / 224.f) : 1.f;
}
__device__ __forceinline__ void quant_row_fp8(const float* src, unsigned char* dst, float* dq, int lane, size_t slice_stride) {
    const GAS f32x4* xr = (const GAS f32x4*)src + lane; f32x4 v[4];
#pragma unroll
    for (int j = 0; j < 4; ++j) v[j] = xr[64 * j];
    quant_vals_fp8(v, dst, dq, lane, slice_stride);
}
__device__ __forceinline__ void p0_prologue(Frame& F) {
    LAS float* scr = (LAS float*)(F.lds + RING_OFF + F.wave * 16384);
    const int gw = F.vcu * NWAVES + F.wave, NGW = F.G * NWAVES;
    bf16* WinT = (bf16*)(F.ws + WS_WIN); bf16* WoutT = (bf16*)(F.ws + WS_WOUT); bf16* W2T = (bf16*)(F.ws + WS_W2);
    float* small = (float*)(F.ws + WS_SMALL);
    if (blockIdx.x == 0) {
        const int t = F.tid;
        { const float l0 = F.in[9][t], l1 = F.in[9][512 + t]; small[SM_LB + t] = 1.f / (1.f + expf(l1 - l0)); }
        { const int h = t >> 7, n = t & 127; int bk;
          if (n < 16) bk = n; else { bk = 16 + (int)(logf((float)n * (1.f / 16.f)) / logf(8.f) * 16.f); bk = bk > 31 ? 31 : bk; }
          small[SM_BIAS + t] = F.in[8][bk * 4 + h] * 1.4426950408889634f; }
        if (F.wave == 0) {
            const float a = wave_sum(F.in[3][F.lane] * F.in[4][F.lane]), b = wave_sum(F.in[5][F.lane] * F.in[6][F.lane]);
            if (F.lane == 0) small[SM_LAM] = expf(a) - expf(b) + LAM_INIT;
        }
    }
    constexpr int I_IN = (DM / 64) * (INW / 32), I_OUT = (DM / 64) * (DM / 32);
    for (int it = gw; it < I_IN + I_OUT; it += NGW) {
        if (it < I_IN) p0_transpose_item(F.in[2], DM, INW, WinT, 0, scr, it, F.lane);
        else p0_transpose_item(F.in[11], DM, DM, WoutT, 0, scr, it - I_IN, F.lane);
    }
    for (int u = F.vcu; u < 256; u += F.G) {
        const int hc = u >> 4, kb = u & 15, k = kb * 64 + F.lane;
        const GAS f32x4* wrow = (const GAS f32x4*)(F.in[13] + (size_t)k * 2048 + hc * 128);
        float a[16];
#pragma unroll
        for (int nn = 0; nn < 16; ++nn) a[nn] = 0.f;
        const float* kr = F.in[14] + ((size_t)hc * 128 + F.wave * 16) * 128;
        for (int i = 0; i < 32; ++i) {
            const f32x4 w = wrow[i];
#pragma unroll
            for (int nn = 0; nn < 16; ++nn) { const float* kk = kr + nn * 128 + 4 * i; a[nn] += (kk[0] * w.x + kk[1] * w.y) + (kk[2] * w.z + kk[3] * w.w); }
        }
        const float g2k = F.in[12][k];
#pragma unroll
        for (int nn = 0; nn < 16; ++nn) W2T[((size_t)hc * 128 + F.wave * 16 + nn) * DM + k] = (bf16)f2bf(a[nn] * g2k);
    }
    bf16* HN = (bf16*)(F.ws + WS_HN);
    for (int m = gw; m < NTOK; m += 2 * NGW) {
        const int m2 = m + NGW;
        const GAS f32x4* xa = (const GAS f32x4*)(F.in[0] + (size_t)m * DM) + F.lane; const GAS f32x4* xb = (const GAS f32x4*)(F.in[0] + (size_t)(m2 < NTOK ? m2 : m) * DM) + F.lane;
        const GAS f32x4* gr = (const GAS f32x4*)F.in[1] + F.lane;
        f32x4 va[4], vb[4]; float sa = 0.f, sb = 0.f;
#pragma unroll
        for (int j = 0; j < 4; ++j) { va[j] = xa[64 * j]; vb[j] = xb[64 * j]; }
#pragma unroll
        for (int j = 0; j < 4; ++j) { sa += (va[j].x * va[j].x + va[j].y * va[j].y) + (va[j].z * va[j].z + va[j].w * va[j].w); sb += (vb[j].x * vb[j].x + vb[j].y * vb[j].y) + (vb[j].z * vb[j].z + vb[j].w * vb[j].w); }
#pragma unroll
        for (int o = 1; o < 64; o <<= 1) { sa += __shfl_xor(sa, o); sb += __shfl_xor(sb, o); }
        const float ra = 1.f / sqrtf(sa * (1.f / DM) + EPS), rb = 1.f / sqrtf(sb * (1.f / DM) + EPS);
        GAS unsigned long long* oa = (GAS unsigned long long*)(HN + (size_t)m * DM) + F.lane; GAS unsigned long long* ob = (GAS unsigned long long*)(HN + (size_t)m2 * DM) + F.lane;
#pragma unroll
        for (int j = 0; j < 4; ++j) { const f32x4 gg = gr[64 * j];
            oa[64 * j] = (unsigned long long)pk2(va[j].x * ra * gg.x, va[j].y * ra * gg.y) | ((unsigned long long)pk2(va[j].z * ra * gg.z, va[j].w * ra * gg.w) << 32);
            if (m2 < NTOK) ob[64 * j] = (unsigned long long)pk2(vb[j].x * rb * gg.x, vb[j].y * rb * gg.y) | ((unsigned long long)pk2(vb[j].z * rb * gg.z, vb[j].w * rb * gg.w) << 32); }
    }
}


constexpr int QCHUNKS = 2 * 16384 / 64;
__device__ __forceinline__ void quant_chunk(Frame& F, int c) {
    unsigned char* U8 = F.ws + WS_U8; unsigned char* V8 = F.ws + WS_V8; float* SU = (float*)(F.ws + WS_SU); float* SV = (float*)(F.ws + WS_SV);
#pragma unroll 1
    for (int k = 0; k < 8; ++k) { const int rr = 64 * c + 8 * F.wave + k;
        if (rr < 16384) quant_row_fp8(F.in[15] + (size_t)rr * DM, U8 + (size_t)rr * 128, SU + rr, F.lane, (size_t)16384 * 128);
        else { const int e = rr - 16384; quant_row_fp8(F.in[16] + (size_t)e * DM, V8 + (size_t)e * 128, SV + e, F.lane, (size_t)16384 * 128); } }
}

__device__ __forceinline__ void quant_drain(Frame& F) {
    unsigned* qctr = (unsigned*)(F.ws + WS_CTL) + CW_ATTQ + 128;
    for (;;) {
        __syncthreads();
        if (F.tid == 0) F.MISC[13] = __hip_atomic_fetch_add(qctr, 1u, __ATOMIC_RELAXED, __HIP_MEMORY_SCOPE_AGENT);
        __syncthreads();
        const int qc = (int)F.MISC[13];
        if (qc >= QCHUNKS) break;
        quant_chunk(F, qc);
    }
}

typedef float f32x16 __attribute__((ext_vector_type(16)));
typedef short s16x4 __attribute__((ext_vector_type(4)));
typedef short v4i16_t __attribute__((ext_vector_type(4)));
typedef float f32x2_t __attribute__((ext_vector_type(2))); typedef __bf16 bf16x2_t __attribute__((ext_vector_type(2)));
__device__ __forceinline__ unsigned cvtpk_bf16(float lo, float hi) { f32x2_t v = {lo, hi}; bf16x2_t b = __builtin_convertvector(v, bf16x2_t); return __builtin_bit_cast(unsigned, b); }
__device__ __forceinline__ float xhalf_max(float v) { return fmaxf(v, __shfl_xor(v, 32)); }
__device__ __forceinline__ float xhalf_sum(float v) { return v + __shfl_xor(v, 32); }
__device__ __forceinline__ float max3f_(float a, float b, float c) { float r; asm("v_max3_f32 %0, %1, %2, %3" : "=v"(r) : "v"(a), "v"(b), "v"(c)); return r; }
constexpr int AT_KP = 144, AT_VP = 320, AT_K1 = 64 * AT_KP, AT_V = 2 * AT_K1, AT_BUF = AT_V + 64 * AT_VP;
constexpr int AT_XO = 0, AT_YB = 65536, AT_YP = 272, AT_TAB = 100352, AT_Q = 100864;
static_assert(AT_Q + 8 * 4096 <= RING_BYTES, "attention LDS map");
__device__ __forceinline__ void attn_mfma(Frame& F, int qslot) {
    const bf16* PROJ = (const bf16*)(F.ws + WS_PROJ); bf16* MIXED = (bf16*)(F.ws + WS_HN);
    const float* small = (const float*)(F.ws + WS_SMALL);
    LAS unsigned char* lds = F.lds;
    LAS float* TAB = (LAS float*)(lds + AT_TAB);
    const int tid = F.tid, lane = F.lane, wave = F.wave, map = wave >> 2, qt = wave & 3, r32 = lane & 31, hi = lane >> 5;
    const float lam = small[SM_LAM];
    const int koff = map * AT_K1 + r32 * AT_KP + hi * 16;
    const int voff = AT_V + (4 * hi + ((lane & 15) >> 2)) * AT_VP + (16 * ((lane >> 4) & 1) + 4 * (lane & 3)) * 2;
    unsigned* qctr = (unsigned*)(F.ws + WS_CTL) + CW_ATTQ + 64 * qslot;
    for (;;) {
        __syncthreads();
        if (tid == 0) F.MISC[12] = __hip_atomic_fetch_add(qctr, 1u, __ATOMIC_RELAXED, __HIP_MEMORY_SCOPE_AGENT);
        __syncthreads();
        const int L = (int)F.MISC[12];
        if (L >= 1024) break;
        const int qb = 15 - (L >> 6), bh = L & 63;
        const int b = bh >> 2, h = bh & 3, q0 = qb * 128; const size_t tok0 = (size_t)b * SEQ;
        const int NT = (q0 + 128) / 64;
        if (tid < 128) TAB[tid] = small[SM_BIAS + h * 128 + tid];
        LAS unsigned char* qlds = lds + AT_Q + wave * 4096 + lane * 16;
        { const bf16* qrow = PROJ + (tok0 + q0 + 32 * qt + r32) * INW + C_DQ + h * 128 + map * 64 + 8 * hi;
#pragma unroll
          for (int s4 = 0; s4 < 4; ++s4) *(LAS bf16x8*)(qlds + 1024 * s4) = *(const GAS bf16x8*)(qrow + 16 * s4); }
        const bf16* ksrc = PROJ + (tok0 + (tid >> 4)) * INW + C_DK + h * 128 + (tid & 15) * 8;
        const bf16* vsrc = PROJ + (tok0 + (tid >> 4)) * INW + C_DV + h * 128 + (tid & 15) * 8;
        const int kdst = ((tid & 15) >> 3) * AT_K1 + (tid >> 4) * AT_KP + (tid & 7) * 16, vdst = AT_V + (tid >> 4) * AT_VP + (tid & 15) * 16;
        v4u krA[2], vrA[2], krB[2], vrB[2];
#pragma unroll
        for (int i = 0; i < 2; ++i) { krB[i] = *(const GAS v4u*)(ksrc + (size_t)(32 * i) * INW); vrB[i] = *(const GAS v4u*)(vsrc + (size_t)(32 * i) * INW); }
#pragma unroll
        for (int i = 0; i < 2; ++i) { krA[i] = *(const GAS v4u*)(ksrc + (size_t)(64 + 32 * i) * INW); vrA[i] = *(const GAS v4u*)(vsrc + (size_t)(64 + 32 * i) * INW); }
#pragma unroll
        for (int i = 0; i < 2; ++i) { *(LAS v4u*)(lds + kdst + 32 * i * AT_KP) = krB[i]; *(LAS v4u*)(lds + vdst + 32 * i * AT_VP) = vrB[i]; }
        __syncthreads();
        const float bfar = TAB[127];
        f32x16 o[4];
#pragma unroll
        for (int mt = 0; mt < 4; ++mt) o[mt] = (f32x16){0.f,0.f,0.f,0.f,0.f,0.f,0.f,0.f,0.f,0.f,0.f,0.f,0.f,0.f,0.f,0.f};
        float mrun = -INFINITY, lsum = 0.f;
        const int qlo = q0 + 32 * qt, qpos = qlo + r32;
#pragma unroll
        for (int i = 0; i < 2; ++i) { if (2 < NT) { krB[i] = *(const GAS v4u*)(ksrc + (size_t)(128 + 32 * i) * INW); vrB[i] = *(const GAS v4u*)(vsrc + (size_t)(128 + 32 * i) * INW); } }
        for (int j2 = 0; j2 < NT; j2 += 2) {
          { const int j = j2;
            const int bo = (j & 1) * AT_BUF, bn = ((j + 1) & 1) * AT_BUF;
            if (64 * j <= qlo + 31) {
                f32x16 s0 = (f32x16){0.f,0.f,0.f,0.f,0.f,0.f,0.f,0.f,0.f,0.f,0.f,0.f,0.f,0.f,0.f,0.f}, s1 = s0;
#pragma unroll
                for (int s4 = 0; s4 < 4; ++s4) {
                    const bf16x8 a0 = *(const LAS bf16x8*)(lds + bo + koff + 32 * s4), a1 = *(const LAS bf16x8*)(lds + bo + koff + 32 * AT_KP + 32 * s4);
                    const bf16x8 qfr = *(const LAS bf16x8*)(qlds + 1024 * s4);
                    s0 = __builtin_amdgcn_mfma_f32_32x32x16_bf16(a0, qfr, s0, 0, 0, 0);
                    s1 = __builtin_amdgcn_mfma_f32_32x32x16_bf16(a1, qfr, s1, 0, 0, 0);
                }
                float tm, cadd;
                if (qlo - (64 * j + 63) < 127) {
                    const int kb = 64 * j + 4 * hi; tm = -INFINITY;
#pragma unroll
                    for (int r = 0; r < 16; ++r) { const int n0 = qpos - (kb + (r & 3) + 8 * (r >> 2)), n1 = n0 - 32;
                        float b0 = TAB[n0 > 127 ? 127 : (n0 < 0 ? 0 : n0)], b1 = TAB[n1 > 127 ? 127 : (n1 < 0 ? 0 : n1)];
                        asm volatile("" : "+v"(b0), "+v"(b1));
                        s0[r] = n0 < 0 ? -INFINITY : s0[r] + b0; s1[r] = n1 < 0 ? -INFINITY : s1[r] + b1; tm = max3f_(tm, s0[r], s1[r]); }
                    cadd = 0.f;
                } else {
                    tm = max3f_(s0[0], s1[0], s0[1]);
#pragma unroll
                    for (int r = 1; r < 15; ++r) tm = max3f_(tm, s1[r], s0[r + 1]);
                    tm = fmaxf(tm, s1[15]);
                    tm += bfar; cadd = bfar;
                }
                tm = xhalf_max(tm);
                if (__any(tm > mrun + 8.f)) {
                    const float mnew = fmaxf(mrun, tm), alpha = __builtin_amdgcn_exp2f(mrun - mnew);
                    lsum *= alpha; mrun = mnew;
#pragma unroll
                    for (int mt = 0; mt < 4; ++mt) o[mt] = o[mt] * alpha;
                }
                const float c = cadd - mrun; float psum = 0.f;
#pragma unroll
                for (int r = 0; r < 16; ++r) { s0[r] = __builtin_amdgcn_exp2f(s0[r] + c); s1[r] = __builtin_amdgcn_exp2f(s1[r] + c); psum += s0[r] + s1[r]; }
                lsum += psum;
#pragma unroll
                for (int kt2 = 0; kt2 < 2; ++kt2)
#pragma unroll
                    for (int sp = 0; sp < 2; ++sp) {
                        v4u pw;
                        if (kt2 == 0) { pw.x = cvtpk_bf16(s0[8 * sp], s0[8 * sp + 1]); pw.y = cvtpk_bf16(s0[8 * sp + 2], s0[8 * sp + 3]); pw.z = cvtpk_bf16(s0[8 * sp + 4], s0[8 * sp + 5]); pw.w = cvtpk_bf16(s0[8 * sp + 6], s0[8 * sp + 7]); }
                        else          { pw.x = cvtpk_bf16(s1[8 * sp], s1[8 * sp + 1]); pw.y = cvtpk_bf16(s1[8 * sp + 2], s1[8 * sp + 3]); pw.z = cvtpk_bf16(s1[8 * sp + 4], s1[8 * sp + 5]); pw.w = cvtpk_bf16(s1[8 * sp + 6], s1[8 * sp + 7]); }
                        const bf16x8 pf = __builtin_bit_cast(bf16x8, pw);
#pragma unroll
                        for (int mt = 0; mt < 4; ++mt) {
                            LAS unsigned char* vp = lds + bo + voff + (32 * kt2 + 16 * sp) * AT_VP + 64 * mt;
                            const s16x4 lo = __builtin_bit_cast(s16x4, __builtin_amdgcn_ds_read_tr16_b64_v4i16((LAS v4i16_t*)vp));
                            const s16x4 hi4 = __builtin_bit_cast(s16x4, __builtin_amdgcn_ds_read_tr16_b64_v4i16((LAS v4i16_t*)(vp + 8 * AT_VP)));
                            const bf16x8 af = (bf16x8){lo[0], lo[1], lo[2], lo[3], hi4[0], hi4[1], hi4[2], hi4[3]};
                            o[mt] = __builtin_amdgcn_mfma_f32_32x32x16_bf16(af, pf, o[mt], 0, 0, 0);
                        }
                    }
            }
            if (j + 1 < NT) {
#pragma unroll
                for (int i = 0; i < 2; ++i) { *(LAS v4u*)(lds + bn + kdst + 32 * i * AT_KP) = krA[i]; *(LAS v4u*)(lds + bn + vdst + 32 * i * AT_VP) = vrA[i]; }
                if (j + 3 < NT) {
#pragma unroll
                    for (int i = 0; i < 2; ++i) { krA[i] = *(const GAS v4u*)(ksrc + (size_t)(64 * (j + 3) + 32 * i) * INW); vrA[i] = *(const GAS v4u*)(vsrc + (size_t)(64 * (j + 3) + 32 * i) * INW); }
                }
            }
            __syncthreads();
                  }
          { const int j = j2 + 1;
            const int bo = (j & 1) * AT_BUF, bn = ((j + 1) & 1) * AT_BUF;
            if (64 * j <= qlo + 31) {
                f32x16 s0 = (f32x16){0.f,0.f,0.f,0.f,0.f,0.f,0.f,0.f,0.f,0.f,0.f,0.f,0.f,0.f,0.f,0.f}, s1 = s0;
#pragma unroll
                for (int s4 = 0; s4 < 4; ++s4) {
                    const bf16x8 a0 = *(const LAS bf16x8*)(lds + bo + koff + 32 * s4), a1 = *(const LAS bf16x8*)(lds + bo + koff + 32 * AT_KP + 32 * s4);
                    const bf16x8 qfr = *(const LAS bf16x8*)(qlds + 1024 * s4);
                    s0 = __builtin_amdgcn_mfma_f32_32x32x16_bf16(a0, qfr, s0, 0, 0, 0);
                    s1 = __builtin_amdgcn_mfma_f32_32x32x16_bf16(a1, qfr, s1, 0, 0, 0);
                }
                float tm, cadd;
                if (qlo - (64 * j + 63) < 127) {
                    const int kb = 64 * j + 4 * hi; tm = -INFINITY;
#pragma unroll
                    for (int r = 0; r < 16; ++r) { const int n0 = qpos - (kb + (r & 3) + 8 * (r >> 2)), n1 = n0 - 32;
                        float b0 = TAB[n0 > 127 ? 127 : (n0 < 0 ? 0 : n0)], b1 = TAB[n1 > 127 ? 127 : (n1 < 0 ? 0 : n1)];
                        asm volatile("" : "+v"(b0), "+v"(b1));
                        s0[r] = n0 < 0 ? -INFINITY : s0[r] + b0; s1[r] = n1 < 0 ? -INFINITY : s1[r] + b1; tm = max3f_(tm, s0[r], s1[r]); }
                    cadd = 0.f;
                } else {
                    tm = max3f_(s0[0], s1[0], s0[1]);
#pragma unroll
                    for (int r = 1; r < 15; ++r) tm = max3f_(tm, s1[r], s0[r + 1]);
                    tm = fmaxf(tm, s1[15]);
                    tm += bfar; cadd = bfar;
                }
                tm = xhalf_max(tm);
                if (__any(tm > mrun + 8.f)) {
                    const float mnew = fmaxf(mrun, tm), alpha = __builtin_amdgcn_exp2f(mrun - mnew);
                    lsum *= alpha; mrun = mnew;
#pragma unroll
                    for (int mt = 0; mt < 4; ++mt) o[mt] = o[mt] * alpha;
                }
                const float c = cadd - mrun; float psum = 0.f;
#pragma unroll
                for (int r = 0; r < 16; ++r) { s0[r] = __builtin_amdgcn_exp2f(s0[r] + c); s1[r] = __builtin_amdgcn_exp2f(s1[r] + c); psum += s0[r] + s1[r]; }
                lsum += psum;
#pragma unroll
                for (int kt2 = 0; kt2 < 2; ++kt2)
#pragma unroll
                    for (int sp = 0; sp < 2; ++sp) {
                        v4u pw;
                        if (kt2 == 0) { pw.x = cvtpk_bf16(s0[8 * sp], s0[8 * sp + 1]); pw.y = cvtpk_bf16(s0[8 * sp + 2], s0[8 * sp + 3]); pw.z = cvtpk_bf16(s0[8 * sp + 4], s0[8 * sp + 5]); pw.w = cvtpk_bf16(s0[8 * sp + 6], s0[8 * sp + 7]); }
                        else          { pw.x = cvtpk_bf16(s1[8 * sp], s1[8 * sp + 1]); pw.y = cvtpk_bf16(s1[8 * sp + 2], s1[8 * sp + 3]); pw.z = cvtpk_bf16(s1[8 * sp + 4], s1[8 * sp + 5]); pw.w = cvtpk_bf16(s1[8 * sp + 6], s1[8 * sp + 7]); }
                        const bf16x8 pf = __builtin_bit_cast(bf16x8, pw);
#pragma unroll
                        for (int mt = 0; mt < 4; ++mt) {
                            LAS unsigned char* vp = lds + bo + voff + (32 * kt2 + 16 * sp) * AT_VP + 64 * mt;
                            const s16x4 lo = __builtin_bit_cast(s16x4, __builtin_amdgcn_ds_read_tr16_b64_v4i16((LAS v4i16_t*)vp));
                            const s16x4 hi4 = __builtin_bit_cast(s16x4, __builtin_amdgcn_ds_read_tr16_b64_v4i16((LAS v4i16_t*)(vp + 8 * AT_VP)));
                            const bf16x8 af = (bf16x8){lo[0], lo[1], lo[2], lo[3], hi4[0], hi4[1], hi4[2], hi4[3]};
                            o[mt] = __builtin_amdgcn_mfma_f32_32x32x16_bf16(af, pf, o[mt], 0, 0, 0);
                        }
                    }
            }
            if (j + 1 < NT) {
#pragma unroll
                for (int i = 0; i < 2; ++i) { *(LAS v4u*)(lds + bn + kdst + 32 * i * AT_KP) = krB[i]; *(LAS v4u*)(lds + bn + vdst + 32 * i * AT_VP) = vrB[i]; }
                if (j + 3 < NT) {
#pragma unroll
                    for (int i = 0; i < 2; ++i) { krB[i] = *(const GAS v4u*)(ksrc + (size_t)(64 * (j + 3) + 32 * i) * INW); vrB[i] = *(const GAS v4u*)(vsrc + (size_t)(64 * (j + 3) + 32 * i) * INW); }
                }
            }
            __syncthreads();
                  }
        }
        const float inv = 1.f / xhalf_sum(lsum);
        LAS float* XO = (LAS float*)(lds + AT_XO) + qt * 4096 + r32;
        if (map == 1) {
            const float sc = inv * lam;
#pragma unroll
            for (int mt = 0; mt < 4; ++mt)
#pragma unroll
                for (int r = 0; r < 16; ++r) XO[(32 * mt + (r & 3) + 8 * (r >> 2) + 4 * hi) * 32] = o[mt][r] * sc;
        }
        __syncthreads();
        if (map == 0) {
            float ss = 0.f;
#pragma unroll
            for (int mt = 0; mt < 4; ++mt)
#pragma unroll
                for (int r = 0; r < 16; ++r) { const float a = o[mt][r] * inv - XO[(32 * mt + (r & 3) + 8 * (r >> 2) + 4 * hi) * 32]; o[mt][r] = a; ss += a * a; }
            ss = xhalf_sum(ss);
            const float rr = (1.f - LAM_INIT) / sqrtf(ss * (1.f / 128.f) + EPS);
            LAS unsigned char* yb = lds + AT_YB + qt * (32 * AT_YP);
#pragma unroll
            for (int mt = 0; mt < 4; ++mt)
#pragma unroll
                for (int r4 = 0; r4 < 4; ++r4) { const int dv = 32 * mt + 8 * r4 + 4 * hi; const f32x4 gg = *(const GAS f32x4*)(F.in[7] + dv);
                    v2u w; w.x = cvtpk_bf16(o[mt][4 * r4] * rr * gg.x, o[mt][4 * r4 + 1] * rr * gg.y); w.y = cvtpk_bf16(o[mt][4 * r4 + 2] * rr * gg.z, o[mt][4 * r4 + 3] * rr * gg.w);
                    *(LAS v2u*)(yb + r32 * AT_YP + dv * 2) = w; }
            LDS_WAIT(); asm volatile("" ::: "memory");
            bf16* obase = MIXED + (tok0 + q0 + 32 * qt) * DM + h * 128;
#pragma unroll
            for (int i = 0; i < 8; ++i) { const int id = lane + 64 * i, row = id >> 4, cch = id & 15;
                const v4u w = *(const LAS v4u*)(yb + row * AT_YP + cch * 16); *(GAS v4u*)(obase + (size_t)row * DM + cch * 8) = w; }
        }
    }
}


constexpr int HG_P = 272, HG_KP = 80, HG_VP = 320;
constexpr int HG_QD = 0, HG_KI = 32 * HG_P, HG_KDT = 2 * 32 * HG_P, HG_V = HG_KDT + 128 * HG_KP, HG_CD = HG_V + 32 * HG_VP, HG_BUF = HG_CD + 512;
constexpr int HG_OA = 2 * HG_BUF, HG_OB = HG_OA + 32 * 128 * 4;
static_assert(HG_OB + 32 * 128 * 4 <= RING_BYTES, "hgrn LDS map");
__device__ __forceinline__ bf16x8 pack8(const f32x16& x, int s) {
    v4u p; p.x = cvtpk_bf16(x[8 * s], x[8 * s + 1]); p.y = cvtpk_bf16(x[8 * s + 2], x[8 * s + 3]); p.z = cvtpk_bf16(x[8 * s + 4], x[8 * s + 5]); p.w = cvtpk_bf16(x[8 * s + 6], x[8 * s + 7]);
    return __builtin_bit_cast(bf16x8, p);
}
__device__ __forceinline__ bf16x8 tr_pair(LAS unsigned char* p0, LAS unsigned char* p1) {
    const s16x4 lo = __builtin_bit_cast(s16x4, __builtin_amdgcn_ds_read_tr16_b64_v4i16((LAS v4i16_t*)p0));
    const s16x4 hi4 = __builtin_bit_cast(s16x4, __builtin_amdgcn_ds_read_tr16_b64_v4i16((LAS v4i16_t*)p1));
    return (bf16x8){lo[0], lo[1], lo[2], lo[3], hi4[0], hi4[1], hi4[2], hi4[3]};
}
__device__ __forceinline__ void hgrn_mfma(Frame& F) {
    const bf16* PROJ = (const bf16*)(F.ws + WS_PROJ); bf16* MIXED = (bf16*)(F.ws + WS_HN);
    const float* small = (const float*)(F.ws + WS_SMALL);
    LAS unsigned char* lds = F.lds;
    const int tid = F.tid, lane = F.lane, wave = F.wave, r32 = lane & 31, hh = lane >> 5;
    const int dvt = wave & 3, dkh = wave >> 2;
    const int pc = lane & 31, pdk8 = 16 * wave + 8 * (lane >> 5);
    const int kdoff = (((lane & 15) >> 2)) * HG_VP + (16 * ((lane >> 4) & 1) + 4 * (lane & 3)) * 2;
    const int vc = tid >> 4, vseg = tid & 15;
    const int troff = (((lane & 15) >> 2)) * HG_VP + (32 * dvt + 16 * ((lane >> 4) & 1) + 4 * (lane & 3)) * 2;
    for (int u = F.vcu; u < 64; u += F.G) {
        const int b = u >> 2, h = u & 3; const size_t tok0 = (size_t)b * SEQ;
        const f32x4 lbA = *(const GAS f32x4*)(small + SM_LB + h * 128 + pdk8), lbB = *(const GAS f32x4*)(small + SM_LB + h * 128 + pdk8 + 4);
        const float lbv[8] = {lbA.x, lbA.y, lbA.z, lbA.w, lbB.x, lbB.y, lbB.z, lbB.w};
        const f32x4 g0 = *(const GAS f32x4*)(F.in[10] + 8 * vseg), g1 = *(const GAS f32x4*)(F.in[10] + 8 * vseg + 4);
        f32x16 S0, S1;
#pragma unroll
        for (int r = 0; r < 16; ++r) { S0[r] = 0.f; S1[r] = 0.f; }
        v4u rqA, rfA, rqB, rfB, rvA, rgA, rvB, rgB;
#define HG_LOAD(S, chn) do { const bf16* p_ = PROJ + (tok0 + 32 * (chn) + pc) * INW + h * 128 + pdk8; \
            asm volatile("global_load_dwordx4 %0, %1, off" : "=v"(rq##S) : "v"(p_ + C_HQ) : "memory"); \
            asm volatile("global_load_dwordx4 %0, %1, off" : "=v"(rf##S) : "v"(p_ + C_HF) : "memory"); \
            asm volatile("global_load_dwordx4 %0, %1, off" : "=v"(rv##S) : "v"(PROJ + (tok0 + 32 * (chn) + vc) * INW + C_HI + h * 128 + vseg * 8) : "memory"); } while (0)
#define HG_LOADG(S, chn) do { asm volatile("global_load_dwordx4 %0, %1, off" : "=v"(rg##S) : "v"(PROJ + (tok0 + 32 * (chn) + vc) * INW + C_HG + h * 128 + vseg * 8) : "memory"); } while (0)
#define HG_WAIT_RAW(S) asm volatile("s_waitcnt vmcnt(7)" : "+v"(rq##S), "+v"(rf##S), "+v"(rv##S) :: "memory")
#define HG_WAIT_G(S) asm volatile("s_waitcnt vmcnt(8)" : "+v"(rg##S) :: "memory")
        HG_LOAD(A, 0); HG_LOADG(A, 0); HG_LOAD(B, 1); HG_LOADG(B, 1);
        asm volatile("s_waitcnt vmcnt(0)" : "+v"(rvA), "+v"(rgA), "+v"(rvB), "+v"(rgB) :: "memory");
        __syncthreads();
        for (int ch2 = 0; ch2 < SEQ / 32; ch2 += 2) {
          { const int ch = ch2;
            LAS unsigned char* bufp = lds + (ch & 1) * HG_BUF;
            HG_WAIT_RAW(A);
            { float bb[8], fv[8];
              const unsigned fw[4] = {rfA.x, rfA.y, rfA.z, rfA.w}, qw[4] = {rqA.x, rqA.y, rqA.z, rqA.w};
#pragma unroll
              for (int i = 0; i < 8; ++i) { const float x = (i & 1) ? bfhi(fw[i >> 1]) : bflo(fw[i >> 1]); const float f = lbv[i] + (1.f - lbv[i]) * __builtin_amdgcn_rcpf(1.f + __expf(-x)); fv[i] = f; bb[i] = f; }
#pragma unroll
              for (int i = 0; i < 8; ++i) { float x = bb[i];
                  x *= __builtin_bit_cast(float, __builtin_amdgcn_update_dpp(0x3f800000, __builtin_bit_cast(int, x), 0x111, 0xf, 0xf, false));
                  x *= __builtin_bit_cast(float, __builtin_amdgcn_update_dpp(0x3f800000, __builtin_bit_cast(int, x), 0x112, 0xf, 0xf, false));
                  x *= __builtin_bit_cast(float, __builtin_amdgcn_update_dpp(0x3f800000, __builtin_bit_cast(int, x), 0x114, 0xf, 0xf, false));
                  x *= __builtin_bit_cast(float, __builtin_amdgcn_update_dpp(0x3f800000, __builtin_bit_cast(int, x), 0x118, 0xf, 0xf, false));
                  x *= __builtin_bit_cast(float, __builtin_amdgcn_update_dpp(0x3f800000, __builtin_bit_cast(int, x), 0x142, 0xa, 0xf, false));
                  bb[i] = x; }
              unsigned qd[8], ki[8], kd[8]; float cdv[8];
#pragma unroll
              for (int i = 0; i < 8; ++i) { const float elast = __shfl(bb[i], (lane & 32) + 31);
                  const float e = bb[i], ei = __builtin_amdgcn_rcpf(bb[i]), ed = elast * ei;
                  const float xq = (i & 1) ? bfhi(qw[i >> 1]) : bflo(qw[i >> 1]); const float q = xq * __builtin_amdgcn_rcpf(1.f + __expf(-xq)); const float k = 1.f - fv[i];
                  qd[i] = f2bf(q * e); ki[i] = f2bf(k * ei); kd[i] = f2bf(k * ed); cdv[i] = elast; }
              *(LAS v4u*)(bufp + HG_QD + pc * HG_P + pdk8 * 2) = (v4u){qd[0] | (qd[1] << 16), qd[2] | (qd[3] << 16), qd[4] | (qd[5] << 16), qd[6] | (qd[7] << 16)};
              *(LAS v4u*)(bufp + HG_KI + pc * HG_P + pdk8 * 2) = (v4u){ki[0] | (ki[1] << 16), ki[2] | (ki[3] << 16), ki[4] | (ki[5] << 16), ki[6] | (ki[7] << 16)};
              *(LAS v4u*)(bufp + HG_KDT + pc * HG_VP + pdk8 * 2) = (v4u){kd[0] | (kd[1] << 16), kd[2] | (kd[3] << 16), kd[4] | (kd[5] << 16), kd[6] | (kd[7] << 16)};
              if (pc == 31) { *(LAS f32x4*)(bufp + HG_CD + pdk8 * 4) = (f32x4){cdv[0], cdv[1], cdv[2], cdv[3]}; *(LAS f32x4*)(bufp + HG_CD + pdk8 * 4 + 16) = (f32x4){cdv[4], cdv[5], cdv[6], cdv[7]}; }
              *(LAS v4u*)(bufp + HG_V + vc * HG_VP + vseg * 16) = rvA; }
            HG_LOAD(A, (ch + 2 < SEQ / 32 ? ch + 2 : SEQ / 32 - 1));
            __syncthreads();
            f32x16 o;
#pragma unroll
            for (int r = 0; r < 16; ++r) o[r] = 0.f;
#pragma unroll
            for (int kk = 0; kk < 2; ++kk)
#pragma unroll
                for (int s2 = 0; s2 < 2; ++s2) {
                    LAS unsigned char* qa = bufp + HG_QD + r32 * HG_P + (32 * (2 * dkh + kk) + 16 * s2 + 4 * hh) * 2;
                    const v2u a0 = *(const LAS v2u*)qa, a1 = *(const LAS v2u*)(qa + 16);
                    const bf16x8 af = __builtin_bit_cast(bf16x8, (v4u){a0.x, a0.y, a1.x, a1.y});
                    o = __builtin_amdgcn_mfma_f32_32x32x16_bf16(af, pack8(kk == 0 ? S0 : S1, s2), o, 0, 0, 0);
                }
            if (wave < 4) {
                f32x16 X;
#pragma unroll
                for (int r = 0; r < 16; ++r) X[r] = 0.f;
#pragma unroll
                for (int s8 = 0; s8 < 8; ++s8) {
                    const bf16x8 af = *(const LAS bf16x8*)(bufp + HG_KI + r32 * HG_P + (16 * s8 + 8 * hh) * 2);
                    const bf16x8 bfr = *(const LAS bf16x8*)(bufp + HG_QD + r32 * HG_P + (16 * s8 + 8 * hh) * 2);
                    X = __builtin_amdgcn_mfma_f32_32x32x16_bf16(af, bfr, X, 0, 0, 0);
                }
#pragma unroll
                for (int r = 0; r < 16; ++r) { const int cp = (r & 3) + 8 * (r >> 2) + 4 * hh; X[r] = cp > r32 ? 0.f : X[r]; }
#pragma unroll
                for (int s2 = 0; s2 < 2; ++s2) {
                    LAS unsigned char* vp = bufp + HG_V + troff + (16 * s2 + 4 * hh) * HG_VP;
                    o = __builtin_amdgcn_mfma_f32_32x32x16_bf16(pack8(X, s2), tr_pair(vp, vp + 8 * HG_VP), o, 0, 0, 0);
                }
            }
            { LAS float* ob = (LAS float*)(lds + (wave < 4 ? HG_OA : HG_OB)) + 32 * dvt + r32;
#pragma unroll
              for (int r = 0; r < 16; ++r) ob[((r & 3) + 8 * (r >> 2) + 4 * hh) * 128] = o[r]; }
#pragma unroll
            for (int kk = 0; kk < 2; ++kk) {
                const int dk0 = 32 * (2 * dkh + kk);
                const LAS float* cdp = (const LAS float*)(bufp + HG_CD) + dk0 + 4 * hh;
#pragma unroll
                for (int r4 = 0; r4 < 4; ++r4) { const f32x4 c4 = *(const LAS f32x4*)(cdp + 8 * r4);
                    if (kk == 0) { S0[4 * r4] *= c4.x; S0[4 * r4 + 1] *= c4.y; S0[4 * r4 + 2] *= c4.z; S0[4 * r4 + 3] *= c4.w; }
                    else         { S1[4 * r4] *= c4.x; S1[4 * r4 + 1] *= c4.y; S1[4 * r4 + 2] *= c4.z; S1[4 * r4 + 3] *= c4.w; } }
#pragma unroll
                for (int s2 = 0; s2 < 2; ++s2) {
                    LAS unsigned char* kp = bufp + HG_KDT + kdoff + (16 * s2 + 8 * hh) * HG_VP + dk0 * 2;
                    const bf16x8 af = tr_pair(kp, kp + 4 * HG_VP);
                    LAS unsigned char* vp = bufp + HG_V + troff + (16 * s2 + 8 * hh) * HG_VP;
                    const bf16x8 bfr = tr_pair(vp, vp + 4 * HG_VP);
                    if (kk == 0) S0 = __builtin_amdgcn_mfma_f32_32x32x16_bf16(af, bfr, S0, 0, 0, 0);
                    else         S1 = __builtin_amdgcn_mfma_f32_32x32x16_bf16(af, bfr, S1, 0, 0, 0);
                }
            }
            __syncthreads();
            { const LAS float* oa = (const LAS float*)(lds + HG_OA) + vc * 128 + 8 * vseg; const LAS float* ob = (const LAS float*)(lds + HG_OB) + vc * 128 + 8 * vseg;
              const f32x4 x0 = *(const LAS f32x4*)oa + *(const LAS f32x4*)ob, x1 = *(const LAS f32x4*)(oa + 4) + *(const LAS f32x4*)(ob + 4);
              float ss = (x0.x * x0.x + x0.y * x0.y) + (x0.z * x0.z + x0.w * x0.w) + (x1.x * x1.x + x1.y * x1.y) + (x1.z * x1.z + x1.w * x1.w);
              ss += __shfl_xor(ss, 1); ss += __shfl_xor(ss, 2); ss += __shfl_xor(ss, 4); ss += __shfl_xor(ss, 8);
              const float rr = 1.f / sqrtf(ss * (1.f / 128.f) + EPS);
              const size_t tok = tok0 + 32 * ch + vc;
              HG_WAIT_G(A);
              const unsigned ga[4] = {rgA.x, rgA.y, rgA.z, rgA.w};
              const float ov[8] = {x0.x, x0.y, x0.z, x0.w, x1.x, x1.y, x1.z, x1.w}; const float gg[8] = {g0.x, g0.y, g0.z, g0.w, g1.x, g1.y, g1.z, g1.w};
              unsigned w[4];
#pragma unroll
              for (int j = 0; j < 4; ++j) { const float a0 = bflo(ga[j]), a1 = bfhi(ga[j]);
                  w[j] = pk2(ov[2 * j] * rr * gg[2 * j] * (a0 * __builtin_amdgcn_rcpf(1.f + __expf(-a0))), ov[2 * j + 1] * rr * gg[2 * j + 1] * (a1 * __builtin_amdgcn_rcpf(1.f + __expf(-a1)))); }
              *(GAS v4u*)(MIXED + tok * DM + 512 + h * 128 + 8 * vseg) = (v4u){w[0], w[1], w[2], w[3]}; }
            HG_LOADG(A, (ch + 2 < SEQ / 32 ? ch + 2 : SEQ / 32 - 1));
          }
          { const int ch = ch2 + 1;
            LAS unsigned char* bufp = lds + (ch & 1) * HG_BUF;
            HG_WAIT_RAW(B);
            { float bb[8], fv[8];
              const unsigned fw[4] = {rfB.x, rfB.y, rfB.z, rfB.w}, qw[4] = {rqB.x, rqB.y, rqB.z, rqB.w};
#pragma unroll
              for (int i = 0; i < 8; ++i) { const float x = (i & 1) ? bfhi(fw[i >> 1]) : bflo(fw[i >> 1]); const float f = lbv[i] + (1.f - lbv[i]) * __builtin_amdgcn_rcpf(1.f + __expf(-x)); fv[i] = f; bb[i] = f; }
#pragma unroll
              for (int i = 0; i < 8; ++i) { float x = bb[i];
                  x *= __builtin_bit_cast(float, __builtin_amdgcn_update_dpp(0x3f800000, __builtin_bit_cast(int, x), 0x111, 0xf, 0xf, false));
                  x *= __builtin_bit_cast(float, __builtin_amdgcn_update_dpp(0x3f800000, __builtin_bit_cast(int, x), 0x112, 0xf, 0xf, false));
                  x *= __builtin_bit_cast(float, __builtin_amdgcn_update_dpp(0x3f800000, __builtin_bit_cast(int, x), 0x114, 0xf, 0xf, false));
                  x *= __builtin_bit_cast(float, __builtin_amdgcn_update_dpp(0x3f800000, __builtin_bit_cast(int, x), 0x118, 0xf, 0xf, false));
                  x *= __builtin_bit_cast(float, __builtin_amdgcn_update_dpp(0x3f800000, __builtin_bit_cast(int, x), 0x142, 0xa, 0xf, false));
                  bb[i] = x; }
              unsigned qd[8], ki[8], kd[8]; float cdv[8];
#pragma unroll
              for (int i = 0; i < 8; ++i) { const float elast = __shfl(bb[i], (lane & 32) + 31);
                  const float e = bb[i], ei = __builtin_amdgcn_rcpf(bb[i]), ed = elast * ei;
                  const float xq = (i & 1) ? bfhi(qw[i >> 1]) : bflo(qw[i >> 1]); const float q = xq * __builtin_amdgcn_rcpf(1.f + __expf(-xq)); const float k = 1.f - fv[i];
                  qd[i] = f2bf(q * e); ki[i] = f2bf(k * ei); kd[i] = f2bf(k * ed); cdv[i] = elast; }
              *(LAS v4u*)(bufp + HG_QD + pc * HG_P + pdk8 * 2) = (v4u){qd[0] | (qd[1] << 16), qd[2] | (qd[3] << 16), qd[4] | (qd[5] << 16), qd[6] | (qd[7] << 16)};
              *(LAS v4u*)(bufp + HG_KI + pc * HG_P + pdk8 * 2) = (v4u){ki[0] | (ki[1] << 16), ki[2] | (ki[3] << 16), ki[4] | (ki[5] << 16), ki[6] | (ki[7] << 16)};
              *(LAS v4u*)(bufp + HG_KDT + pc * HG_VP + pdk8 * 2) = (v4u){kd[0] | (kd[1] << 16), kd[2] | (kd[3] << 16), kd[4] | (kd[5] << 16), kd[6] | (kd[7] << 16)};
              if (pc == 31) { *(LAS f32x4*)(bufp + HG_CD + pdk8 * 4) = (f32x4){cdv[0], cdv[1], cdv[2], cdv[3]}; *(LAS f32x4*)(bufp + HG_CD + pdk8 * 4 + 16) = (f32x4){cdv[4], cdv[5], cdv[6], cdv[7]}; }
              *(LAS v4u*)(bufp + HG_V + vc * HG_VP + vseg * 16) = rvB; }
            HG_LOAD(B, (ch + 2 < SEQ / 32 ? ch + 2 : SEQ / 32 - 1));
            __syncthreads();
            f32x16 o;
#pragma unroll
            for (int r = 0; r < 16; ++r) o[r] = 0.f;
#pragma unroll
            for (int kk = 0; kk < 2; ++kk)
#pragma unroll
                for (int s2 = 0; s2 < 2; ++s2) {
                    LAS unsigned char* qa = bufp + HG_QD + r32 * HG_P + (32 * (2 * dkh + kk) + 16 * s2 + 4 * hh) * 2;
                    const v2u a0 = *(const LAS v2u*)qa, a1 = *(const LAS v2u*)(qa + 16);
                    const bf16x8 af = __builtin_bit_cast(bf16x8, (v4u){a0.x, a0.y, a1.x, a1.y});
                    o = __builtin_amdgcn_mfma_f32_32x32x16_bf16(af, pack8(kk == 0 ? S0 : S1, s2), o, 0, 0, 0);
                }
            if (wave < 4) {
                f32x16 X;
#pragma unroll
                for (int r = 0; r < 16; ++r) X[r] = 0.f;
#pragma unroll
                for (int s8 = 0; s8 < 8; ++s8) {
                    const bf16x8 af = *(const LAS bf16x8*)(bufp + HG_KI + r32 * HG_P + (16 * s8 + 8 * hh) * 2);
                    const bf16x8 bfr = *(const LAS bf16x8*)(bufp + HG_QD + r32 * HG_P + (16 * s8 + 8 * hh) * 2);
                    X = __builtin_amdgcn_mfma_f32_32x32x16_bf16(af, bfr, X, 0, 0, 0);
                }
#pragma unroll
                for (int r = 0; r < 16; ++r) { const int cp = (r & 3) + 8 * (r >> 2) + 4 * hh; X[r] = cp > r32 ? 0.f : X[r]; }
#pragma unroll
                for (int s2 = 0; s2 < 2; ++s2) {
                    LAS unsigned char* vp = bufp + HG_V + troff + (16 * s2 + 4 * hh) * HG_VP;
                    o = __builtin_amdgcn_mfma_f32_32x32x16_bf16(pack8(X, s2), tr_pair(vp, vp + 8 * HG_VP), o, 0, 0, 0);
                }
            }
            { LAS float* ob = (LAS float*)(lds + (wave < 4 ? HG_OA : HG_OB)) + 32 * dvt + r32;
#pragma unroll
              for (int r = 0; r < 16; ++r) ob[((r & 3) + 8 * (r >> 2) + 4 * hh) * 128] = o[r]; }
#pragma unroll
            for (int kk = 0; kk < 2; ++kk) {
                const int dk0 = 32 * (2 * dkh + kk);
                const LAS float* cdp = (const LAS float*)(bufp + HG_CD) + dk0 + 4 * hh;
#pragma unroll
                for (int r4 = 0; r4 < 4; ++r4) { const f32x4 c4 = *(const LAS f32x4*)(cdp + 8 * r4);
                    if (kk == 0) { S0[4 * r4] *= c4.x; S0[4 * r4 + 1] *= c4.y; S0[4 * r4 + 2] *= c4.z; S0[4 * r4 + 3] *= c4.w; }
                    else         { S1[4 * r4] *= c4.x; S1[4 * r4 + 1] *= c4.y; S1[4 * r4 + 2] *= c4.z; S1[4 * r4 + 3] *= c4.w; } }
#pragma unroll
                for (int s2 = 0; s2 < 2; ++s2) {
                    LAS unsigned char* kp = bufp + HG_KDT + kdoff + (16 * s2 + 8 * hh) * HG_VP + dk0 * 2;
                    const bf16x8 af = tr_pair(kp, kp + 4 * HG_VP);
                    LAS unsigned char* vp = bufp + HG_V + troff + (16 * s2 + 8 * hh) * HG_VP;
                    const bf16x8 bfr = tr_pair(vp, vp + 4 * HG_VP);
                    if (kk == 0) S0 = __builtin_amdgcn_mfma_f32_32x32x16_bf16(af, bfr, S0, 0, 0, 0);
                    else         S1 = __builtin_amdgcn_mfma_f32_32x32x16_bf16(af, bfr, S1, 0, 0, 0);
                }
            }
            __syncthreads();
            { const LAS float* oa = (const LAS float*)(lds + HG_OA) + vc * 128 + 8 * vseg; const LAS float* ob = (const LAS float*)(lds + HG_OB) + vc * 128 + 8 * vseg;
              const f32x4 x0 = *(const LAS f32x4*)oa + *(const LAS f32x4*)ob, x1 = *(const LAS f32x4*)(oa + 4) + *(const LAS f32x4*)(ob + 4);
              float ss = (x0.x * x0.x + x0.y * x0.y) + (x0.z * x0.z + x0.w * x0.w) + (x1.x * x1.x + x1.y * x1.y) + (x1.z * x1.z + x1.w * x1.w);
              ss += __shfl_xor(ss, 1); ss += __shfl_xor(ss, 2); ss += __shfl_xor(ss, 4); ss += __shfl_xor(ss, 8);
              const float rr = 1.f / sqrtf(ss * (1.f / 128.f) + EPS);
              const size_t tok = tok0 + 32 * ch + vc;
              HG_WAIT_G(B);
              const unsigned ga[4] = {rgB.x, rgB.y, rgB.z, rgB.w};
              const float ov[8] = {x0.x, x0.y, x0.z, x0.w, x1.x, x1.y, x1.z, x1.w}; const float gg[8] = {g0.x, g0.y, g0.z, g0.w, g1.x, g1.y, g1.z, g1.w};
              unsigned w[4];
#pragma unroll
              for (int j = 0; j < 4; ++j) { const float a0 = bflo(ga[j]), a1 = bfhi(ga[j]);
                  w[j] = pk2(ov[2 * j] * rr * gg[2 * j] * (a0 * __builtin_amdgcn_rcpf(1.f + __expf(-a0))), ov[2 * j + 1] * rr * gg[2 * j + 1] * (a1 * __builtin_amdgcn_rcpf(1.f + __expf(-a1)))); }
              *(GAS v4u*)(MIXED + tok * DM + 512 + h * 128 + 8 * vseg) = (v4u){w[0], w[1], w[2], w[3]}; }
            HG_LOADG(B, (ch + 2 < SEQ / 32 ? ch + 2 : SEQ / 32 - 1));
          }
        }
#undef HG_LOAD
#undef HG_LOADG
#undef HG_WAIT_RAW
#undef HG_WAIT_G
    }
}

template <int N> __device__ __forceinline__ unsigned row_ror(unsigned x) { return (unsigned)__builtin_amdgcn_update_dpp((int)x, (int)x, 0x120 + N, 0xf, 0xf, false); }
__device__ __forceinline__ unsigned umax_(unsigned a, unsigned b) { return a > b ? a : b; }
__device__ __forceinline__ unsigned umin_(unsigned a, unsigned b) { return a < b ? a : b; }
__device__ __forceinline__ unsigned row_umax16(unsigned x) {
    unsigned y;
    asm volatile("s_nop 1\n\tv_max_u32_dpp %0, %1, %1 row_ror:1 row_mask:0xf bank_mask:0xf\n\t"
                 "s_nop 1\n\tv_max_u32_dpp %0, %0, %0 row_ror:2 row_mask:0xf bank_mask:0xf\n\t"
                 "s_nop 1\n\tv_max_u32_dpp %0, %0, %0 row_ror:4 row_mask:0xf bank_mask:0xf\n\t"
                 "s_nop 1\n\tv_max_u32_dpp %0, %0, %0 row_ror:8 row_mask:0xf bank_mask:0xf"
                 : "=&v"(y) : "v"(x));
    return y;
}
__device__ __forceinline__ float row_fsum16(float v) {
    v += __builtin_bit_cast(float, row_ror<1>(__builtin_bit_cast(unsigned, v))); v += __builtin_bit_cast(float, row_ror<2>(__builtin_bit_cast(unsigned, v)));
    v += __builtin_bit_cast(float, row_ror<4>(__builtin_bit_cast(unsigned, v))); v += __builtin_bit_cast(float, row_ror<8>(__builtin_bit_cast(unsigned, v))); return v; }
__device__ __forceinline__ unsigned h2key(unsigned x) { return (x & 0x80000000u) ? (~x & 0xffff0000u) : (x | 0x80000000u); }
__device__ __forceinline__ float hkey2f(unsigned k) { const unsigned hb = ((k & 0x80000000u) ? (k & 0x7fff0000u) : (~k & 0xffff0000u)) >> 16; return (float)__builtin_bit_cast(_Float16, (unsigned short)hb); }
__device__ __forceinline__ unsigned f2key(float f) { const unsigned u = __builtin_bit_cast(unsigned, f); return (u & 0x80000000u) ? ~u : (u | 0x80000000u); }
__device__ __forceinline__ float key2f(unsigned k) { const unsigned u = (k & 0x80000000u) ? (k & 0x7fffffffu) : ~k; return __builtin_bit_cast(float, u); }
__device__ __forceinline__ unsigned pair_code(int s) {
    if (s < 16) return (unsigned)s;
    if (s < 24) return 16u + (unsigned)(s - 16);
    if (s < 29) return 32u + (unsigned)(s - 24);
    if (s < 33) return 48u + (unsigned)(s - 29);
    if (s < 36) return 64u + (unsigned)(s - 33);
    if (s < 42) return 80u + 16u * (unsigned)((s - 36) >> 1) + (unsigned)((s - 36) & 1);
    if (s < 50) return 128u + 16u * (unsigned)(s - 42);
    return 0xFFu;
}
#define CAS_(a, b) do { const unsigned hi_ = umax_(a, b), lo_ = umin_(a, b); a = hi_; b = lo_; } while (0)
__device__ __forceinline__ unsigned topk_stage1(const unsigned short* SC, int th, int c, int l15) {
    const int t = th >> 3, h = th & 7;
    const v4u sv = *(const GAS v4u*)(SC + (size_t)t * 2048 + h * 256 + c * 128 + l15 * 8);
    const unsigned nb = 127u - 8u * (unsigned)l15;
    unsigned k0 = h2key(sv.x << 16) | nb, k1 = h2key(sv.x & 0xffff0000u) | (nb - 1u), k2 = h2key(sv.y << 16) | (nb - 2u), k3 = h2key(sv.y & 0xffff0000u) | (nb - 3u);
    unsigned k4 = h2key(sv.z << 16) | (nb - 4u), k5 = h2key(sv.z & 0xffff0000u) | (nb - 5u), k6 = h2key(sv.w << 16) | (nb - 6u), k7 = h2key(sv.w & 0xffff0000u) | (nb - 7u);
    CAS_(k0, k1); CAS_(k2, k3); CAS_(k4, k5); CAS_(k6, k7); CAS_(k0, k2); CAS_(k1, k3); CAS_(k4, k6); CAS_(k5, k7); CAS_(k1, k2); CAS_(k5, k6); CAS_(k0, k4); CAS_(k3, k7);
    CAS_(k1, k5); CAS_(k2, k6); CAS_(k1, k4); CAS_(k3, k6); CAS_(k2, k4); CAS_(k3, k5); CAS_(k3, k4);
    unsigned res = 0u;
#pragma unroll
    for (int r = 0; r < 16; ++r) {
        const unsigned m = row_umax16(k0); const bool pop = (k0 == m);
        k0 = pop ? k1 : k0; k1 = pop ? k2 : k1; k2 = pop ? k3 : k2; k3 = pop ? k4 : k3; k4 = pop ? k5 : k4; k5 = pop ? k6 : k5; k6 = pop ? k7 : k6; k7 = pop ? 0u : k7;
        res = (l15 == r) ? m : res;
    }
    return res;
}
__device__ __forceinline__ void topk_v2(Frame& F) {
    const unsigned short* SC = (const unsigned short*)(F.ws + WS_SC); int* IDX = (int*)(F.ws + WS_IDX); float* GATE = (float*)(F.ws + WS_GATE); float* GSU = (float*)(F.ws + WS_GSU);
    const float* SU = (const float*)(F.ws + WS_SU); const float* SV = (const float*)(F.ws + WS_SV);
    const int gw = F.vcu * NWAVES + F.wave, NGW = F.G * NWAVES, lane = F.lane, l15 = lane & 15, row = lane >> 4, c = row & 1, rbase = lane & 48;
    const unsigned pc0 = pair_code(l15), pc1 = pair_code(l15 + 16), pc2 = pair_code(l15 + 32), pc3 = pair_code(l15 + 48);
    const int src1 = l15 + 32 * (row & 1), src2 = src1 + 16;
    for (int it0 = gw * 32; it0 < NTOK * 2; it0 += NGW * 32)
    for (int it = it0; it < it0 + 32; ++it) {
        const int thb = 4 * it;
        const unsigned resA = topk_stage1(SC, thb + (row >> 1), c, l15), resB = topk_stage1(SC, thb + 2 + (row >> 1), c, l15);
        const unsigned a1 = (unsigned)__shfl((int)resA, src1), a2 = (unsigned)__shfl((int)resA, src2), b1 = (unsigned)__shfl((int)resB, src1), b2 = (unsigned)__shfl((int)resB, src2);
        const unsigned S1 = row < 2 ? a1 : b1, S2 = row < 2 ? a2 : b2;
        unsigned c0, c1, c2, c3;
#define TK_CAND(CK, PC) do { const unsigned ka_ = (unsigned)__shfl((int)S1, rbase + (int)((PC) >> 4 & 15u)), kb_ = (unsigned)__shfl((int)S2, rbase + (int)((PC) & 15u)); \
            const float sm_ = hkey2f(ka_) + hkey2f(kb_); CK = (PC) == 0xFFu ? 0u : ((f2key(sm_) & ~0xFFu) | (255u - (PC))); } while (0)
        TK_CAND(c0, pc0); TK_CAND(c1, pc1); TK_CAND(c2, pc2); TK_CAND(c3, pc3);
#undef TK_CAND
        CAS_(c0, c1); CAS_(c2, c3); CAS_(c0, c2); CAS_(c1, c3); CAS_(c1, c2);
        unsigned res2 = 0u;
#pragma unroll
        for (int r = 0; r < 16; ++r) {
            const unsigned m = row_umax16(c0); const bool pop = (c0 == m);
            c0 = pop ? c1 : c0; c1 = pop ? c2 : c1; c2 = pop ? c3 : c2; c3 = pop ? 0u : c3;
            res2 = (l15 == r) ? m : res2;
        }
        const unsigned code = 255u - (res2 & 0xFFu);
        const unsigned ka = (unsigned)__shfl((int)S1, rbase + (int)(code >> 4 & 15u)), kb = (unsigned)__shfl((int)S2, rbase + (int)(code & 15u));
        const float ts = hkey2f(ka) + hkey2f(kb);
        const int e = (int)((127u - (ka & 0x7Fu)) * 128u + (127u - (kb & 0x7Fu)));
        const float tmax = __builtin_bit_cast(float, (unsigned)__shfl((int)__builtin_bit_cast(unsigned, ts), rbase));
        const float ex = __expf(ts - tmax);
        const float sum = row_fsum16(ex);
        const int th = thb + row;
        const size_t o = (size_t)(th >> 3) * NEXP_SEL + (th & 7) * 16 + l15;
        IDX[o] = e; GATE[o] = ex / sum * SV[e]; GSU[o] = SU[e];
    }
}

constexpr int PG_TOK = 16;
constexpr int PG_IDX = 0, PG_HID = 4096, PG_SA = PG_HID + 8192, PG_TB = PG_SA + 64, PG_WB = PG_TB + 4096;
static_assert(PG_WB % 16 == 0 && PG_TB % 16 == 0 && NWAVES * PG_WB <= RING_BYTES, "gather LDS map");
__device__ __forceinline__ void peer_sliced(Frame& F) {
    const unsigned char* U8T = F.ws + WS_U8; const unsigned char* V8T = F.ws + WS_V8; const unsigned char* X8 = F.ws + WS_X8;
    const float* SSQ = (const float*)(F.ws + WS_CTL) + CW_SSQ;
    const int* IDX = (const int*)(F.ws + WS_IDX); const float* GATE = (const float*)(F.ws + WS_GATE); const float* GSU = (const float*)(F.ws + WS_GSU); const float* gf = F.in[17];
    bf16* PO = (bf16*)(F.ws + WS_PO); const bf16* HB = (const bf16*)(F.ws + WS_HN2);
    const int gw = F.vcu * NWAVES + F.wave, NGW = F.G * NWAVES, lane = F.lane, m = lane & 15, g = lane >> 4;
    const int row8 = lane >> 3, piece = lane & 7;
    LAS unsigned char* wb = F.lds + F.wave * PG_WB;
    LAS unsigned short* idxs = (LAS unsigned short*)(wb + PG_IDX);
    LAS float* hid = (LAS float*)(wb + PG_HID);
    LAS float* sqp = hid + 64 + lane;
    LAS float* sai = (LAS float*)(wb + PG_SA);
    LAS unsigned char* tb = wb + PG_TB;
    const int p8 = m & 7; const unsigned bsh = 8u * (unsigned)(p8 & 3); const bool bhi = (p8 >> 2) != 0;
    constexpr size_t SLICE = (size_t)16384 * 128;
    const int usw = 16 * (piece ^ ((row8 >> 1) & 3));
    const int urd0 = m * 128 + 16 * ((2 * g) ^ ((m >> 1) & 7)), urd1 = m * 128 + 16 * ((2 * g + 1) ^ ((m >> 1) & 7));
    for (int blk = gw; blk < NTOK / PG_TOK; blk += NGW) {
        const int t0 = blk * PG_TOK;
#pragma unroll
        for (int k = 0; k < 32; ++k) { const int id = lane + 64 * k; idxs[id] = (unsigned short)IDX[(size_t)t0 * NEXP_SEL + id]; }
        LDS_WAIT(); asm volatile("" ::: "memory");
        for (int p = 0; p < 8; ++p) {
            const unsigned char* Up = U8T + (size_t)p * SLICE;
            const unsigned char* Xp = X8 + (size_t)t0 * DM + 128 * p + 32 * g;
            v4u ab[2][16]; l2 xs[2][2];
#define PGU_ISSUE(i_, buf_) do { _Pragma("unroll") for (int k = 0; k < 16; ++k) { const unsigned e = idxs[(i_) * 128 + 8 * k + row8]; \
                ab[buf_][k] = *(const GAS v4u*)(Up + (size_t)e * 128 + (usw ^ ((k & 1) ? 64 : 0))); } \
                xs[buf_][0] = *(const GAS l2*)(Xp + (size_t)(i_) * DM); xs[buf_][1] = *(const GAS l2*)(Xp + (size_t)(i_) * DM + 16); } while (0)
#define PGU_BODY(i_, cur_, nxt_) do { if ((i_) + 1 < PG_TOK) PGU_ISSUE((i_) + 1, nxt_); SCHED_FENCE(); \
                _Pragma("unroll") for (int rb = 0; rb < 4; ++rb) { LAS f32x4* hp0 = (LAS f32x4*)(hid + (i_) * 128 + 32 * rb + 4 * g); LAS f32x4* hp1 = hp0 + 4; \
                    _Pragma("unroll") for (int q4 = 0; q4 < 4; ++q4) *(LAS v4u*)(tb + 1024 * q4 + 16 * lane) = ab[cur_][4 * rb + q4]; \
                    f32x4 acc0 = p == 0 ? (f32x4){0.f, 0.f, 0.f, 0.f} : *hp0, acc1 = p == 0 ? (f32x4){0.f, 0.f, 0.f, 0.f} : *hp1; \
                    const l2 a0 = *(const LAS l2*)(tb + urd0), a1 = *(const LAS l2*)(tb + urd1), b0 = *(const LAS l2*)(tb + 2048 + urd0), b1 = *(const LAS l2*)(tb + 2048 + urd1); \
                    acc0 = __builtin_amdgcn_mfma_f32_16x16x32_fp8_bf8(a0.x, xs[cur_][0].x, acc0, 0, 0, 0); acc1 = __builtin_amdgcn_mfma_f32_16x16x32_fp8_bf8(b0.x, xs[cur_][0].x, acc1, 0, 0, 0); \
                    acc0 = __builtin_amdgcn_mfma_f32_16x16x32_fp8_bf8(a0.y, xs[cur_][0].y, acc0, 0, 0, 0); acc1 = __builtin_amdgcn_mfma_f32_16x16x32_fp8_bf8(b0.y, xs[cur_][0].y, acc1, 0, 0, 0); \
                    acc0 = __builtin_amdgcn_mfma_f32_16x16x32_fp8_bf8(a1.x, xs[cur_][1].x, acc0, 0, 0, 0); acc1 = __builtin_amdgcn_mfma_f32_16x16x32_fp8_bf8(b1.x, xs[cur_][1].x, acc1, 0, 0, 0); \
                    acc0 = __builtin_amdgcn_mfma_f32_16x16x32_fp8_bf8(a1.y, xs[cur_][1].y, acc0, 0, 0, 0); acc1 = __builtin_amdgcn_mfma_f32_16x16x32_fp8_bf8(b1.y, xs[cur_][1].y, acc1, 0, 0, 0); \
                    if (m == 0) { *hp0 = acc0; *hp1 = acc1; } } SCHED_FENCE(); } while (0)
            PGU_ISSUE(0, 0);
            for (int i2 = 0; i2 < PG_TOK; i2 += 2) { PGU_BODY(i2, 0, 1); PGU_BODY(i2 + 1, 1, 0); }
#undef PGU_ISSUE
#undef PGU_BODY
            LDS_WAIT(); asm volatile("" ::: "memory");
        }
        for (int i = 0; i < PG_TOK; ++i) {
            const int t = t0 + i; const float sx = 1.f / sqrtf(SSQ[t] * (1.f / DM) + EPS);
            float w[8][4]; float amax = 0.f;
#pragma unroll
            for (int r = 0; r < 8; ++r) { const f32x4 h4 = *(const LAS f32x4*)(hid + i * 128 + 16 * r + 4 * g);
                const f32x4 su4 = *(const GAS f32x4*)(GSU + (size_t)t * NEXP_SEL + 16 * r + 4 * g), gv4 = *(const GAS f32x4*)(GATE + (size_t)t * NEXP_SEL + 16 * r + 4 * g);
#pragma unroll
                for (int j = 0; j < 4; ++j) { w[r][j] = gelu_as(h4[j] * su4[j] * sx) * gv4[j]; amax = fmaxf(amax, fabsf(w[r][j])); } }
            amax = fmaxf(amax, __shfl_xor(amax, 16)); amax = fmaxf(amax, __shfl_xor(amax, 32));
            const float sa = amax > 0.f ? 224.f / amax : 1.f;
            LDS_WAIT(); asm volatile("" ::: "memory");
            if (m == 0) {
                LAS unsigned char* wrow = (LAS unsigned char*)(hid + i * 128);
#pragma unroll
                for (int r = 0; r < 8; ++r) { int pk = __builtin_amdgcn_cvt_pk_fp8_f32(w[r][0] * sa, w[r][1] * sa, 0, false); pk = __builtin_amdgcn_cvt_pk_fp8_f32(w[r][2] * sa, w[r][3] * sa, pk, true);
                    wrow[4 * r + g] = (unsigned char)pk; wrow[32 + 4 * r + g] = (unsigned char)(pk >> 8); wrow[64 + 4 * r + g] = (unsigned char)(pk >> 16); wrow[96 + 4 * r + g] = (unsigned char)(pk >> 24); }
            }
            if (lane == 0) sai[i] = amax > 0.f ? amax * (1.f / 224.f) : 1.f;
        }
        LDS_WAIT(); asm volatile("" ::: "memory");
        for (int p = 0; p < 8; ++p) {
            const unsigned char* Vp = V8T + (size_t)p * SLICE + 16 * piece;
            v4u va[2][16];
#define PGV_ISSUE(i_, buf_) do { _Pragma("unroll") for (int k = 0; k < 16; ++k) { const unsigned e = idxs[(i_) * 128 + 8 * k + row8]; va[buf_][k] = *(const GAS v4u*)(Vp + (size_t)e * 128); } } while (0)
#define PGV_BODY(i_, cur_, nxt_) do { if ((i_) + 1 < PG_TOK) PGV_ISSUE((i_) + 1, nxt_); \
                const LAS v4u* wp = (const LAS v4u*)((LAS unsigned char*)(hid + (i_) * 128) + 32 * g); const v4u w0 = wp[0], w1 = wp[1]; \
                const unsigned ww[8] = {w0.x, w0.y, w0.z, w0.w, w1.x, w1.y, w1.z, w1.w}; \
                SCHED_FENCE(); f32x4 c = (f32x4){0.f, 0.f, 0.f, 0.f}; \
                _Pragma("unroll") for (int kb = 0; kb < 4; ++kb) { \
                    _Pragma("unroll") for (int q4 = 0; q4 < 4; ++q4) *(LAS v4u*)(tb + 1024 * q4 + 16 * lane) = va[cur_][4 * kb + q4]; \
                    long rr_[8]; \
                    _Pragma("unroll") for (int q4 = 0; q4 < 4; ++q4) { rr_[2 * q4] = *(const LAS long*)(tb + 1024 * q4 + g * 128 + 8 * m); rr_[2 * q4 + 1] = *(const LAS long*)(tb + 1024 * q4 + (4 + g) * 128 + 8 * m); } \
                    _Pragma("unroll") for (int q8 = 0; q8 < 8; ++q8) { const int q = 8 * kb + q8; const unsigned a8 = ((ww[q >> 2] >> (8 * (q & 3))) & 0xffu) << bsh; const long bop = (long)(bhi ? ((unsigned long long)a8 << 32) : (unsigned long long)a8); \
                      c = __builtin_amdgcn_mfma_f32_16x16x32_fp8_fp8(rr_[q8], bop, c, 0, 0, 0); } } \
                SCHED_FENCE(); \
                { const float isa = sai[i_]; LAS unsigned short* ob = (LAS unsigned short*)(tb) + 32 * g + (m & 7);         \
                  if (m < 8) { ob[0] = (unsigned short)f2bf(c[0] * isa); ob[8] = (unsigned short)f2bf(c[1] * isa); ob[16] = (unsigned short)f2bf(c[2] * isa); ob[24] = (unsigned short)f2bf(c[3] * isa); } \
                  const v4u ov = *(const LAS v4u*)(tb + 16 * (lane & 15)); \
                  if (lane < 16) *(GAS v4u*)(PO + (size_t)(t0 + (i_)) * DM + 128 * p + 8 * lane) = ov; } } while (0)
            PGV_ISSUE(0, 0);
            for (int i2 = 0; i2 < PG_TOK; i2 += 2) { PGV_BODY(i2, 0, 1); PGV_BODY(i2 + 1, 1, 0); }
#undef PGV_ISSUE
#undef PGV_BODY
        }
        LDS_WAIT(); asm volatile("" ::: "memory");
        VM_WAIT();
        for (int i = 0; i < PG_TOK; i += 2) {
            GAS f32x4* hrA = (GAS f32x4*)(F.out + (size_t)(t0 + i) * DM) + lane; GAS f32x4* hrB = hrA + DM / 4;
            const GAS v2u* prA = (const GAS v2u*)(PO + (size_t)(t0 + i) * DM) + lane; const GAS v2u* prB = prA + DM / 4;
            const GAS v2u* hbA = (const GAS v2u*)(HB + (size_t)(t0 + i) * DM) + lane; const GAS v2u* hbB = hbA + DM / 4;
            v2u pa[4], pb[4], ha[4], hb2[4];
#pragma unroll
            for (int j = 0; j < 4; ++j) { pa[j] = prA[64 * j]; ha[j] = hbA[64 * j]; pb[j] = prB[64 * j]; hb2[j] = hbB[64 * j]; }
            f32x4 ya[4], yb[4]; float sa = 0.f, sb = 0.f;
#pragma unroll
            for (int j = 0; j < 4; ++j) {
                ya[j] = (f32x4){bflo(ha[j].x), bfhi(ha[j].x), bflo(ha[j].y), bfhi(ha[j].y)} + (f32x4){bflo(pa[j].x), bfhi(pa[j].x), bflo(pa[j].y), bfhi(pa[j].y)};
                yb[j] = (f32x4){bflo(hb2[j].x), bfhi(hb2[j].x), bflo(hb2[j].y), bfhi(hb2[j].y)} + (f32x4){bflo(pb[j].x), bfhi(pb[j].x), bflo(pb[j].y), bfhi(pb[j].y)};
                sa += (ya[j].x * ya[j].x + ya[j].y * ya[j].y) + (ya[j].z * ya[j].z + ya[j].w * ya[j].w); sb += (yb[j].x * yb[j].x + yb[j].y * yb[j].y) + (yb[j].z * yb[j].z + yb[j].w * yb[j].w); }
#pragma unroll
            for (int o = 1; o < 64; o <<= 1) { sa += __shfl_xor(sa, o); sb += __shfl_xor(sb, o); }
            const float ra = 1.f / sqrtf(sa * (1.f / DM) + EPS), rb = 1.f / sqrtf(sb * (1.f / DM) + EPS);
#pragma unroll
            for (int j = 0; j < 4; ++j) { const f32x4 gg = *((const GAS f32x4*)gf + lane + 64 * j); hrA[64 * j] = ya[j] * ra * gg; hrB[64 * j] = yb[j] * rb * gg; }
        }
        LDS_WAIT(); asm volatile("" ::: "memory");
    }
}

struct Args { const float* in[18]; float* out; unsigned char* ws; int ph_lo, ph_hi; };
__global__ void __launch_bounds__(NWAVES * 64, 2) hymba_fwd(Args args) {
    extern __shared__ __attribute__((aligned(16))) unsigned char lds[];
    Frame F;
    F.lds = (LAS unsigned char*)lds;
    F.MISC = (volatile LAS unsigned*)(F.lds + MISC_OFF);
    F.tid = threadIdx.x; F.lane = F.tid & 63; F.wave = __builtin_amdgcn_readfirstlane(F.tid >> 6);
    F.G = gridDim.x; { const int bx = blockIdx.x; F.vcu = (F.G % 8 == 0) ? (bx % 8) * (F.G / 8) + bx / 8 : bx; }
#pragma unroll
    for (int i = 0; i < 18; ++i) F.in[i] = args.in[i];
    F.out = args.out; F.ws = args.ws;
    for (int u = F.tid; u < (LDS_BYTES - LDSCTL_OFF) / 4; u += NWAVES * 64) ((LAS unsigned*)(F.lds + LDSCTL_OFF))[u] = 0u;
    __syncthreads();
    const int lo = args.ph_lo, hi = args.ph_hi;
    const bool multi = (hi - lo) > 1;
    XcdBarrier bar; bar.bar = (unsigned*)(F.ws + WS_CTL) + CW_BAR; bar.x = 0; bar.st = nullptr;
    if (multi) bar = xcd_barrier_post((unsigned*)(F.ws + WS_CTL) + CW_BAR, F.MISC + 8);
#define IN(k) (lo <= (k) && (k) < hi)
#define SEAM(k) do { if (IN(k) && IN((k) + 1)) xcd_barrier(bar); } while (0)

    if (IN(0)) { p0_prologue(F); } SEAM(0);
    if (IN(1)) {
        pg8::Gemm g{(const pg8::bf16_t*)(F.ws + WS_HN), (const pg8::bf16_t*)(F.ws + WS_WIN), NTOK, INW, DM}; pg8::StaticOrder S; S.init(NTOK, INW, F.G, (int)blockIdx.x);
        pg8::EpiProj E{(pg8::bf16_t*)(F.ws + WS_PROJ), INW, 2, QSCALE};
        pg8::gemm_phase<pg8::EpiProj, pg8::StaticOrder, PG8_ALIGN, PG8_SP2>(F.lds + RING_OFF, g, S, E);
    } SEAM(1);
    if (IN(2)) { hgrn_mfma(F); }
    if (IN(3)) { quant_drain(F); attn_mfma(F, 0); }
    if (IN(3) && IN(4)) xcd_barrier(bar);
    if (IN(4)) {
        pg8::Gemm g{(const pg8::bf16_t*)(F.ws + WS_HN), (const pg8::bf16_t*)(F.ws + WS_WOUT), NTOK, DM, DM}; pg8::StaticOrder S; S.init(NTOK, DM, F.G, (int)blockIdx.x);
        pg8::EpiMix E{DM, F.in[0], F.in[12], (pg8::bf16_t*)(F.ws + WS_HN2), F.ws + WS_X8, (float*)(F.ws + WS_CTL) + CW_SSQ};
        pg8::gemm_phase<pg8::EpiMix, pg8::StaticOrder, false, PG8_SP2>(F.lds + RING_OFF, g, S, E);
    }
    if (IN(4) && IN(6)) xcd_barrier(bar);
    if (IN(6)) {
        pg8::Gemm g{(const pg8::bf16_t*)(F.ws + WS_HN2), (const pg8::bf16_t*)(F.ws + WS_W2), NTOK, 2048, DM}; pg8::StaticOrder S; S.init(NTOK, 2048, F.G, (int)blockIdx.x);
        pg8::EpiScaleRow E{(_Float16*)(F.ws + WS_SC), 2048, (const float*)(F.ws + WS_CTL) + CW_SSQ, 1.f / DM, EPS};
        pg8::gemm_phase<pg8::EpiScaleRow, pg8::StaticOrder, PG8_ALIGN, PG8_SP2>(F.lds + RING_OFF, g, S, E);
    } SEAM(6);
    if (IN(7)) { topk_v2(F); }
    if (IN(7) && IN(8)) { VM_WAIT(); }
    if (IN(8)) { peer_sliced(F); }
#undef IN
#undef SEAM
}

extern "C" void kernel_launch(void* const* d_in, const int* in_sizes, int n_in, void* d_out, int out_size, void* d_ws, size_t ws_size, hipStream_t stream) {
    static int grid = 0;
    if (grid == 0) {
        if (n_in != 18 || in_sizes[0] != NTOK * DM || out_size != NTOK * DM || ws_size < WS_END) { fprintf(stderr, "kernel_launch: unexpected shapes (n_in %d, in0 %d, out %d, ws %zu); nothing launched\n", n_in, n_in > 0 ? in_sizes[0] : -1, out_size, ws_size); grid = -1; return; }
        int dev = 0, cus = 0, per_cu = 0;
        if (hipGetDevice(&dev) != hipSuccess || hipDeviceGetAttribute(&cus, hipDeviceAttributeMultiprocessorCount, dev) != hipSuccess) { grid = -1; return; }
        if (hipFuncSetAttribute((const void*)hymba_fwd, hipFuncAttributeMaxDynamicSharedMemorySize, LDS_BYTES) != hipSuccess) { fprintf(stderr, "kernel_launch: hipFuncSetAttribute failed\n"); grid = -1; return; }
        if (hipOccupancyMaxActiveBlocksPerMultiprocessor(&per_cu, (const void*)hymba_fwd, NWAVES * 64, LDS_BYTES) != hipSuccess || per_cu < 1)
            fprintf(stderr, "kernel_launch: note: occupancy query reports %d workgroups per CU\n", per_cu);
        (void)hipGetLastError();
        grid = cus;
    }
    if (grid < 0) return;
    if (hipMemsetAsync((char*)d_ws + WS_CTL, 0, CTL_ZERO_BYTES, stream) != hipSuccess) return;
    Args a{};
    for (int i = 0; i < 18; ++i) a.in[i] = (const float*)d_in[i];
    a.out = (float*)d_out; a.ws = (unsigned char*)d_ws; a.ph_lo = 0; a.ph_hi = 9;
    hipLaunchKernelGGL(hymba_fwd, dim3(grid), dim3(NWAVES * 64), LDS_BYTES, stream, a);
}
```

```cpp
#include <hip/hip_runtime.h>
#include <cstdio>
#include <cstdint>
#include <cmath>
namespace pg8 {
#define PG8_LAS __attribute__((address_space(3)))
typedef unsigned short bf16_t;
typedef short bf16x8 __attribute__((ext_vector_type(8)));
typedef float f32x4 __attribute__((ext_vector_type(4)));
typedef unsigned u32x4 __attribute__((ext_vector_type(4)));
constexpr int BM = 256, BK = 64, HALF = 128, HTB = HALF * BK * 2  , STAGE_BYTES = 8 * HTB, NXCD = 8, WGM = 8;

__host__ __device__ __forceinline__ int lds_byte(int r, int c) { const int st = (r >> 4) * 2 + (c >> 5), rr = r & 15, cc = c & 31, ob = rr * 64 + cc * 2; return st * 1024 + (ob ^ (((ob >> 9) & 1) << 5)); }
__host__ __device__ __forceinline__ void stage_rc(int b, int& R, int& C) { const int st = b / 1024, sb = b % 1024, swz = sb ^ (((sb >> 9) & 1) << 5); R = (st >> 1) * 16 + swz / 64; C = (st & 1) * 32 + (swz % 64) / 2; }
__host__ __device__ __forceinline__ int perm32(int rho) { const int n = rho >> 4, i = rho & 15; return 8 * (i >> 2) + 4 * n + (i & 3); }

struct Unit { int pm, pn; };
struct Gemm { const bf16_t* A; const bf16_t* Bt; int M, N, K; };

struct StaticOrder {
    int nM, nN, nwg, G, c;
    __host__ __device__ void init(int M, int N, int G_, int c_) { nM = M / BM; nN = N / BM; nwg = nM * nN; G = G_; c = c_; }
    __host__ __device__ bool next(int i, Unit& u) const {
        const long L = (long)i * G + c; if (L >= nwg) return false;
        int wgid = (int)L; { const int q = nwg / NXCD, r = nwg % NXCD, xcd = wgid % NXCD, off = wgid / NXCD; wgid = (xcd < r ? xcd * (q + 1) : r * (q + 1) + (xcd - r) * q) + off; }
        const int nig = WGM * nN, gid = wgid / nig, fm = gid * WGM, gsz = (nM - fm) < WGM ? (nM - fm) : WGM;
        u.pm = fm + ((wgid % nig) % gsz); u.pn = (wgid % nig) / gsz; return true;
    }
    __device__ __forceinline__ void a_ready(const Unit&) const {}
    __device__ __forceinline__ void done(const Unit&) const {}
};
__device__ __forceinline__ unsigned cvt_pk_bf16(float lo, float hi) { unsigned r; asm volatile("v_cvt_pk_bf16_f32 %0, %1, %2" : "=v"(r) : "v"(lo), "v"(hi)); return r; }
typedef float f32x2 __attribute__((ext_vector_type(2)));
__device__ __forceinline__ f32x2 gelu_pk(f32x2 v) {
    const f32x2 av = __builtin_elementwise_abs(v), d = av * 0.2316418882f + 1.0f;
    f32x2 t; t.x = __builtin_amdgcn_rcpf(d.x); t.y = __builtin_amdgcn_rcpf(d.y);
    f32x2 q = t * 0.5307027145f + (-0.7265760135f); q = q * t + 0.7107068705f; q = q * t + (-0.142248368f); q = q * t + 0.127414796f; q = q * t;
    const f32x2 s = (v * v) * (-0.72134752044f);
    f32x2 e; e.x = __builtin_amdgcn_exp2f(s.x); e.y = __builtin_amdgcn_exp2f(s.y);
    const f32x2 m = v * (q * e), r = v - m;
    f32x2 o; o.x = v.x < 0.f ? m.x : r.x; o.y = v.y < 0.f ? m.y : r.y; return o;
}
struct EpiProj {
    static constexpr bool PERM = true, AFTER_DRAIN = false;
    bf16_t* O; int ldc; int qtiles; float qscale;
    __device__ __forceinline__ void operator()(const f32x4 (&acc)[2][2][4][2], const Unit& u, int wr, int wc, int fr, int fq) const {
        const int row0 = u.pm * BM + wr * 64 + fr, col0 = u.pn * BM + wc * 32 + 8 * fq;
        const float sc = (u.pn < qtiles) ? qscale : 1.f;
#pragma unroll
        for (int ai = 0; ai < 2; ++ai)
#pragma unroll
            for (int m = 0; m < 4; ++m) { bf16_t* rowp = O + (size_t)(row0 + ai * HALF + m * 16) * ldc + col0;
#pragma unroll
                for (int bj = 0; bj < 2; ++bj) { const f32x4 v0 = acc[ai][bj][m][0] * sc, v1 = acc[ai][bj][m][1] * sc;
                    u32x4 w; w.x = cvt_pk_bf16(v0[0], v0[1]); w.y = cvt_pk_bf16(v0[2], v0[3]); w.z = cvt_pk_bf16(v1[0], v1[1]); w.w = cvt_pk_bf16(v1[2], v1[3]);
                    *(u32x4*)(rowp + bj * HALF) = w; } }
    }
};
struct EpiF32Res {
    static constexpr bool PERM = false, AFTER_DRAIN = false;
    float* C; int ldc; const float* res;
    __device__ __forceinline__ void operator()(const f32x4 (&acc)[2][2][4][2], const Unit& u, int wr, int wc, int fr, int fq) const {
        const int row0 = u.pm * BM + wr * 64 + fr, col0 = u.pn * BM + wc * 32 + 4 * fq;
#pragma unroll
        for (int ai = 0; ai < 2; ++ai)
#pragma unroll
            for (int m = 0; m < 4; ++m) { const size_t off = (size_t)(row0 + ai * HALF + m * 16) * ldc + col0;
#pragma unroll
                for (int bj = 0; bj < 2; ++bj)
#pragma unroll
                    for (int n = 0; n < 2; ++n) { f32x4 o = acc[ai][bj][m][n]; if (res) o = o + *(const f32x4*)(res + off + bj * HALF + n * 16);
                        *(f32x4*)(C + off + bj * HALF + n * 16) = o; } }
    }
};

struct EpiMix {
    static constexpr bool PERM = true, AFTER_DRAIN = false;
    int ldc; const float* res; const float* g2; bf16_t* HB; unsigned char* XB; float* ssq;
    __device__ __forceinline__ void operator()(const f32x4 (&acc)[2][2][4][2], const Unit& u, int wr, int wc, int fr, int fq) const {
        const int row0 = u.pm * BM + wr * 64 + fr, col0 = u.pn * BM + wc * 32 + 8 * fq;
        f32x4 gv[2][2];
#pragma unroll
        for (int bj = 0; bj < 2; ++bj)
#pragma unroll
            for (int n = 0; n < 2; ++n) gv[bj][n] = *(const f32x4*)(g2 + col0 + bj * HALF + 4 * n);
#pragma unroll
        for (int ai = 0; ai < 2; ++ai)
#pragma unroll
            for (int m = 0; m < 4; ++m) { const int row = row0 + ai * HALF + m * 16; const size_t off = (size_t)row * ldc + col0; float sq = 0.f;
#pragma unroll
                for (int bj = 0; bj < 2; ++bj) {
                    const f32x4 h0 = acc[ai][bj][m][0] + *(const f32x4*)(res + off + bj * HALF), h1 = acc[ai][bj][m][1] + *(const f32x4*)(res + off + bj * HALF + 4);
                    sq += (h0[0] * h0[0] + h0[1] * h0[1]) + (h0[2] * h0[2] + h0[3] * h0[3]) + (h1[0] * h1[0] + h1[1] * h1[1]) + (h1[2] * h1[2] + h1[3] * h1[3]);
                    u32x4 w; w.x = cvt_pk_bf16(h0[0], h0[1]); w.y = cvt_pk_bf16(h0[2], h0[3]); w.z = cvt_pk_bf16(h1[0], h1[1]); w.w = cvt_pk_bf16(h1[2], h1[3]);
                    *(u32x4*)(HB + off + bj * HALF) = w;
                    const f32x4 g0 = h0 * gv[bj][0], g1 = h1 * gv[bj][1];
                    int p0 = __builtin_amdgcn_cvt_pk_bf8_f32(g0[0], g0[1], 0, false); p0 = __builtin_amdgcn_cvt_pk_bf8_f32(g0[2], g0[3], p0, true);
                    int p1 = __builtin_amdgcn_cvt_pk_bf8_f32(g1[0], g1[1], 0, false); p1 = __builtin_amdgcn_cvt_pk_bf8_f32(g1[2], g1[3], p1, true);
                    typedef unsigned u32x2 __attribute__((ext_vector_type(2)));
                    *(u32x2*)(XB + off + bj * HALF) = (u32x2){(unsigned)p0, (unsigned)p1}; }
                sq += __shfl_xor(sq, 16); sq += __shfl_xor(sq, 32);
                if (fq == 0) atomicAdd(ssq + row, sq); }
    }
};
struct EpiScaleRow {
    static constexpr bool PERM = true, AFTER_DRAIN = false;
    _Float16* C; int ldc; const float* ssq; float invk, eps;
    __device__ __forceinline__ void operator()(const f32x4 (&acc)[2][2][4][2], const Unit& u, int wr, int wc, int fr, int fq) const {
        typedef _Float16 h2 __attribute__((ext_vector_type(2)));
        const int row0 = u.pm * BM + wr * 64 + fr, col0 = u.pn * BM + wc * 32 + 8 * fq;
#pragma unroll
        for (int ai = 0; ai < 2; ++ai)
#pragma unroll
            for (int m = 0; m < 4; ++m) { const int row = row0 + ai * HALF + m * 16; const size_t off = (size_t)row * ldc + col0; const float rs = 1.f / sqrtf(ssq[row] * invk + eps);
#pragma unroll
                for (int bj = 0; bj < 2; ++bj) { const f32x4 v0 = acc[ai][bj][m][0] * rs, v1 = acc[ai][bj][m][1] * rs;
                    const h2 p0 = {(_Float16)v0[0], (_Float16)v0[1]}, p1 = {(_Float16)v0[2], (_Float16)v0[3]}, p2 = {(_Float16)v1[0], (_Float16)v1[1]}, p3 = {(_Float16)v1[2], (_Float16)v1[3]};
                    u32x4 w; w.x = __builtin_bit_cast(unsigned, p0); w.y = __builtin_bit_cast(unsigned, p1); w.z = __builtin_bit_cast(unsigned, p2); w.w = __builtin_bit_cast(unsigned, p3);
                    *(u32x4*)(C + off + bj * HALF) = w; } }
    }
};
template <class Epi, class Sched, bool ALIGN_EPI = false, bool SP2 = false>
__device__ __forceinline__ void gemm_phase(PG8_LAS unsigned char* lds, const Gemm g, const Sched& S, const Epi& E) {
    const int tid = threadIdx.x, wid = __builtin_amdgcn_readfirstlane(tid >> 6), lane = tid & 63, wr = wid >> 2, wc = wid & 3, fr = lane & 15, fq = lane >> 4;
    const int K = g.K, nt = K / BK;
    unsigned voffA[2], voffB[2];
#pragma unroll
    for (int i = 0; i < 2; ++i) { int R, C; stage_rc(tid * 16 + i * 8192, R, C); const int Rb = Epi::PERM ? ((R & ~31) + perm32(R & 31)) : R;
        voffA[i] = (unsigned)(R * K + C) * 2u; voffB[i] = (unsigned)(Rb * K + C) * 2u; }
    const size_t kstep = (size_t)(BK * 2);
    const size_t hstep = (size_t)HALF * K * 2;
    const size_t tstep = 2 * hstep;
    const unsigned ldsw = (unsigned)wid * 1024u;
    const int aoff = lds_byte(wr * 64 + fr, fq * 8), boff = lds_byte(wc * 32 + fr, fq * 8);
#define PG8_SA(b, h) (((b) * 2 + (h)) * HTB)
#define PG8_SB(b, h) ((4 + (b) * 2 + (h)) * HTB)
#define PG8_STAGE(bufoff, gbase, voff) do { _Pragma("unroll") for (int _i = 0; _i < 2; ++_i) \
        __builtin_amdgcn_global_load_lds((const unsigned*)((const char*)(gbase) + (voff)[_i]), (PG8_LAS unsigned*)(lds + (bufoff) + ldsw + _i * 8192), 16, 0, 0); } while (0)
#define PG8_LDA(dst, b, h) do { _Pragma("unroll") for (int m = 0; m < 4; ++m) _Pragma("unroll") for (int k = 0; k < 2; ++k) dst[m][k] = *(const PG8_LAS bf16x8*)(lds + PG8_SA(b, h) + aoff + m * 2048 + k * 1024); } while (0)
#define PG8_LDB(dst, b, h) do { _Pragma("unroll") for (int n = 0; n < 2; ++n) _Pragma("unroll") for (int k = 0; k < 2; ++k) dst[n][k] = *(const PG8_LAS bf16x8*)(lds + PG8_SB(b, h) + boff + n * 2048 + k * 1024); } while (0)
#define PG8_MMA(ai, bj, At, Bt) do { __builtin_amdgcn_s_setprio(1); _Pragma("unroll") for (int m = 0; m < 4; ++m) _Pragma("unroll") for (int n = 0; n < 2; ++n) _Pragma("unroll") for (int k = 0; k < 2; ++k) \
        acc[ai][bj][m][n] = __builtin_amdgcn_mfma_f32_16x16x32_bf16(Bt[n][k], At[m][k], acc[ai][bj][m][n], 0, 0, 0); __builtin_amdgcn_s_setprio(0); } while (0)
#define PG8_WAIT_V(n) asm volatile("s_waitcnt vmcnt(" #n ")" ::: "memory")
#define PG8_WAIT_L(n) asm volatile("s_waitcnt lgkmcnt(" #n ")" ::: "memory")
#define PG8_BAR __builtin_amdgcn_s_barrier()
#define PG8_SCHED __builtin_amdgcn_sched_barrier(0)
    Unit cur, nxt; int ui = 0;
    if (!S.next(0, cur)) return;
    f32x4 acc[2][2][4][2];
#pragma unroll
    for (int a = 0; a < 2; ++a)
#pragma unroll
        for (int b = 0; b < 2; ++b)
#pragma unroll
            for (int m = 0; m < 4; ++m)
#pragma unroll
                for (int n = 0; n < 2; ++n) acc[a][b][m][n] = (f32x4){0.f, 0.f, 0.f, 0.f};
    bf16x8 At[4][2], B0[2][2], B1[2][2];
    const char* cA = (const char*)g.A + (size_t)cur.pm * tstep; const char* cB = (const char*)g.Bt + (size_t)cur.pn * tstep;
    S.a_ready(cur);
    if constexpr (SP2) {
        PG8_STAGE(PG8_SB(0, 0), cB, voffB); PG8_STAGE(PG8_SB(0, 1), cB + hstep, voffB); PG8_STAGE(PG8_SA(0, 0), cA, voffA); PG8_STAGE(PG8_SA(0, 1), cA + hstep, voffA);
        if (wr == 1) PG8_BAR;
        PG8_WAIT_V(2); PG8_BAR;
        PG8_STAGE(PG8_SB(1, 0), cB + kstep, voffB); PG8_STAGE(PG8_SA(1, 0), cA + kstep, voffA); PG8_STAGE(PG8_SB(1, 1), cB + hstep + kstep, voffB);
        PG8_WAIT_V(6); PG8_BAR;
    } else {
        PG8_STAGE(PG8_SB(0, 0), cB, voffB); PG8_STAGE(PG8_SA(0, 0), cA, voffA); PG8_STAGE(PG8_SB(0, 1), cB + hstep, voffB); PG8_STAGE(PG8_SA(0, 1), cA + hstep, voffA);
        if (wr == 1) PG8_BAR;
        PG8_WAIT_V(4); PG8_BAR;
        PG8_STAGE(PG8_SB(1, 0), cB + kstep, voffB); PG8_STAGE(PG8_SA(1, 0), cA + kstep, voffA); PG8_STAGE(PG8_SB(1, 1), cB + hstep + kstep, voffB);
        PG8_WAIT_V(6); PG8_BAR;
    }
    for (;;) {
        const bool has_next = S.next(ui + 1, nxt);
        const char* nA = has_next ? (const char*)g.A + (size_t)nxt.pm * tstep : cA; const char* nB = has_next ? (const char*)g.Bt + (size_t)nxt.pn * tstep : cB;
        for (int t = 0; t < nt; t += 2) {
            const bool last = (t == nt - 2);
            const char* a1 = cA + (size_t)(t + 1) * kstep;
            const char* a2 = last ? nA : cA + (size_t)(t + 2) * kstep; const char* b2 = last ? nB : cB + (size_t)(t + 2) * kstep;
            const char* a3 = a2 + kstep; const char* b3 = b2 + kstep;
            if (last && has_next) S.a_ready(nxt);
            if constexpr (SP2) {
            PG8_LDB(B0, 0, 0); PG8_LDB(B1, 0, 1); PG8_SCHED; PG8_LDA(At, 0, 0); PG8_STAGE(PG8_SA(1, 1), a1 + hstep, voffA);
            PG8_WAIT_V(8); PG8_WAIT_L(0); PG8_BAR; PG8_MMA(0, 0, At, B0); PG8_MMA(0, 1, At, B1); PG8_BAR; PG8_SCHED;
            PG8_LDA(At, 0, 1); PG8_STAGE(PG8_SB(0, 0), b2, voffB); PG8_STAGE(PG8_SB(0, 1), b2 + hstep, voffB); PG8_STAGE(PG8_SA(0, 0), a2, voffA);
            PG8_WAIT_V(8); PG8_WAIT_L(0); PG8_BAR; PG8_MMA(1, 0, At, B0); PG8_MMA(1, 1, At, B1); PG8_BAR; PG8_SCHED;
            PG8_LDB(B0, 1, 0); PG8_LDB(B1, 1, 1); PG8_SCHED; PG8_LDA(At, 1, 0); PG8_STAGE(PG8_SA(0, 1), a2 + hstep, voffA);
            PG8_WAIT_V(8); PG8_WAIT_L(0); PG8_BAR; PG8_MMA(0, 0, At, B0); PG8_MMA(0, 1, At, B1); PG8_BAR; PG8_SCHED;
            PG8_LDA(At, 1, 1); PG8_STAGE(PG8_SB(1, 0), b3, voffB); PG8_STAGE(PG8_SB(1, 1), b3 + hstep, voffB); PG8_STAGE(PG8_SA(1, 0), a3, voffA);
            PG8_WAIT_V(8); PG8_WAIT_L(0); PG8_BAR; PG8_MMA(1, 0, At, B0); PG8_MMA(1, 1, At, B1); PG8_BAR; PG8_SCHED;
            } else {
            PG8_LDB(B0, 0, 0); PG8_SCHED; PG8_LDA(At, 0, 0); PG8_STAGE(PG8_SA(1, 1), a1 + hstep, voffA);
            PG8_WAIT_L(8); PG8_BAR; PG8_WAIT_L(0); PG8_MMA(0, 0, At, B0); PG8_BAR; PG8_SCHED;
            PG8_LDB(B1, 0, 1); PG8_STAGE(PG8_SB(0, 0), b2, voffB);
            PG8_BAR; PG8_WAIT_L(0); PG8_MMA(0, 1, At, B1); PG8_BAR;
            PG8_LDA(At, 0, 1); PG8_STAGE(PG8_SA(0, 0), a2, voffA);
            PG8_BAR; PG8_WAIT_L(0); PG8_MMA(1, 0, At, B0); PG8_BAR; PG8_SCHED;
            PG8_STAGE(PG8_SB(0, 1), b2 + hstep, voffB);
            PG8_WAIT_V(6); PG8_BAR; PG8_MMA(1, 1, At, B1); PG8_BAR;
            PG8_LDB(B0, 1, 0); PG8_SCHED; PG8_LDA(At, 1, 0); PG8_STAGE(PG8_SA(0, 1), a2 + hstep, voffA);
            PG8_WAIT_L(8); PG8_BAR; PG8_WAIT_L(0); PG8_MMA(0, 0, At, B0); PG8_BAR; PG8_SCHED;
            PG8_LDB(B1, 1, 1); PG8_STAGE(PG8_SB(1, 0), b3, voffB);
            PG8_BAR; PG8_WAIT_L(0); PG8_MMA(0, 1, At, B1); PG8_BAR;
            PG8_LDA(At, 1, 1); PG8_STAGE(PG8_SA(1, 0), a3, voffA);
            PG8_BAR; PG8_WAIT_L(0); PG8_MMA(1, 0, At, B0); PG8_BAR; PG8_SCHED;
            PG8_STAGE(PG8_SB(1, 1), b3 + hstep, voffB);
            PG8_WAIT_V(6); PG8_BAR; PG8_MMA(1, 1, At, B1); PG8_BAR;
            }
        }
        if constexpr (ALIGN_EPI) { if (wr == 0) PG8_BAR; }
        if constexpr (!Epi::AFTER_DRAIN) { E(acc, cur, wr, wc, fr, fq); S.done(cur); }
        if (!has_next) break;
#pragma unroll
        for (int a = 0; a < 2; ++a)
#pragma unroll
            for (int b = 0; b < 2; ++b)
#pragma unroll
                for (int m = 0; m < 4; ++m)
#pragma unroll
                    for (int n = 0; n < 2; ++n) acc[a][b][m][n] = (f32x4){0.f, 0.f, 0.f, 0.f};
        cur = nxt; cA = nA; cB = nB; ++ui;
        if constexpr (ALIGN_EPI) { if (wr == 1) PG8_BAR; }
    }
    PG8_WAIT_V(0);
    if constexpr (!ALIGN_EPI) { if (wr == 0) PG8_BAR; }
    PG8_BAR;
    if constexpr (Epi::AFTER_DRAIN) { E.fused(acc, cur, wr, wc, fr, fq, lds, wid, lane); S.done(cur); }
#undef PG8_SA
#undef PG8_SB
#undef PG8_STAGE
#undef PG8_LDA
#undef PG8_LDB
#undef PG8_MMA
#undef PG8_WAIT_V
#undef PG8_WAIT_L
#undef PG8_BAR
#undef PG8_SCHED
}
}
#ifndef PG8_SP2
#define PG8_SP2 true
#endif
#ifndef PG8_ALIGN
#define PG8_ALIGN true
#endif

constexpr int NWAVES = 8;
constexpr int NTOK = 32768, DM = 1024, SEQ = 2048, NBATCH = 16, INW = 3584;
constexpr int C_DQ = 0, C_DK = 512, C_DV = 1024, C_HQ = 1536, C_HF = 2048, C_HI = 2560, C_HG = 3072;
constexpr float EPS = 1e-6f;
constexpr float QSCALE = 0.125f * 1.4426950408889634f;
constexpr float LAM_INIT = 0.2f;
constexpr int NEXP_SEL = 128;

constexpr size_t MiB = 1u << 20;
constexpr size_t WS_CTL = 0, CTL_ZERO_BYTES = 1 * MiB;
constexpr size_t WS_SMALL = 1 * MiB;
constexpr size_t WS_WIN = 2 * MiB;
constexpr size_t WS_WOUT = 10 * MiB;
constexpr size_t WS_W2 = 12 * MiB;
constexpr size_t WS_U8 = 17 * MiB;
constexpr size_t WS_V8 = 33 * MiB;
constexpr size_t WS_SU = 49 * MiB;
constexpr size_t WS_SV = 49 * MiB + 512 * 1024;
constexpr size_t WS_X8 = 50 * MiB;
constexpr size_t WS_SX = 116 * MiB;
constexpr size_t WS_GSU = 120 * MiB;
constexpr size_t WS_HN = 84 * MiB;
constexpr size_t WS_PROJ = 148 * MiB;
constexpr size_t WS_HN2 = 148 * MiB;
constexpr size_t WS_SC = 212 * MiB;
constexpr size_t WS_PO = 212 * MiB;
constexpr size_t WS_IDX = 468 * MiB;
constexpr size_t WS_GATE = 484 * MiB;
constexpr size_t WS_END = 500 * MiB;
constexpr int SM_LB = 0, SM_LAM = 512, SM_BIAS = 1024;
constexpr int CW_BAR = 4096;
constexpr int CW_ATTQ = 8192;
constexpr int CW_SSQ = 131072;

constexpr int RING_OFF = 0, RING_BYTES = 139264;
constexpr int LDSCTL_OFF = RING_BYTES, MISC_OFF = LDSCTL_OFF + 320;
constexpr int LDS_BYTES = 147456;

#define GAS __attribute__((address_space(1)))
#define LAS __attribute__((address_space(3)))
typedef unsigned short bf16;
typedef unsigned v4u __attribute__((ext_vector_type(4)));
typedef unsigned v2u __attribute__((ext_vector_type(2)));
typedef float f32x4 __attribute__((ext_vector_type(4)));
typedef short bf16x8 __attribute__((ext_vector_type(8)));
typedef GAS unsigned gu32;
typedef long l2 __attribute__((ext_vector_type(2)));
typedef int v4i __attribute__((ext_vector_type(4)));
#define RLX_AGENT __ATOMIC_RELAXED, __HIP_MEMORY_SCOPE_AGENT
#define LDS_WAIT() asm volatile("s_waitcnt lgkmcnt(0)" ::: "memory")
#define VM_WAIT() asm volatile("s_waitcnt vmcnt(0)" ::: "memory")
__device__ __forceinline__ unsigned f2bf(float f) { unsigned u = __builtin_bit_cast(unsigned, f); return (u + 0x7fffu + ((u >> 16) & 1u)) >> 16; }
__device__ __forceinline__ unsigned pk2(float lo, float hi) { return f2bf(lo) | (f2bf(hi) << 16); }
__device__ __forceinline__ float bflo(unsigned w) { return __builtin_bit_cast(float, w << 16); }
__device__ __forceinline__ float bfhi(unsigned w) { return __builtin_bit_cast(float, w & 0xffff0000u); }

#define XB_TMO      128
#define XB_XCNT(j)  (256  + 64 * (j))
#define XB_XSUB(j)  (1280 + 64 * (j))
#define XB_XGEN(j)  (2304 + 64 * (j))
#define XB_TOP      3328
#define XB_TOPGEN   3392
#define XCD_BAR_WORDS 3456
#define XB_SPIN_CAP (1u << 18)
__device__ __forceinline__ unsigned xb_ld(unsigned* p)              { return __hip_atomic_load(p, __ATOMIC_RELAXED, __HIP_MEMORY_SCOPE_AGENT); }
__device__ __forceinline__ unsigned xb_add(unsigned* p, unsigned v) { return __hip_atomic_fetch_add(p, v, __ATOMIC_RELAXED, __HIP_MEMORY_SCOPE_AGENT); }
__device__ __forceinline__ unsigned xb_xcc_id() { return (unsigned)__builtin_amdgcn_s_getreg((3 << 11) | 20) & 0xFu; }
#define XB_SPIN(cond, bar) do { unsigned _sp = 0; while (cond) { __builtin_amdgcn_s_sleep(1); \
    if ((++_sp & 255u) == 0u) { if (xb_ld(&(bar)[XB_TMO])) break; if (_sp > XB_SPIN_CAP) { atomicAdd(&(bar)[XB_TMO], 1u); break; } } } } while (0)
struct XcdBarrier { unsigned* bar; unsigned x; volatile LAS unsigned* st; };
__device__ __forceinline__ XcdBarrier xcd_barrier_post(unsigned* bar, volatile LAS unsigned* st) {
    XcdBarrier b; b.bar = bar; b.x = xb_xcc_id(); b.st = st;
    if (threadIdx.x == 0) (void)xb_add(&bar[XB_XCNT(b.x)], 1u);
    return b;
}
__device__ __forceinline__ void xcd_barrier_complete(unsigned* bar, unsigned x, unsigned& nloc, unsigned& nx) {
    const unsigned G = gridDim.x * gridDim.y * gridDim.z;
    unsigned sum, cnt, mine, sp = 0u;
    for (;;) {
        sum = 0u; cnt = 0u; mine = 0u;
#pragma unroll
        for (unsigned j = 0; j < 16; ++j) { const unsigned c = xb_ld(&bar[XB_XCNT(j)]); sum += c; cnt += (c > 0u) ? 1u : 0u; mine = (j == x) ? c : mine; }
        if (sum == G) break;
        __builtin_amdgcn_s_sleep(1);
        if ((++sp & 255u) == 0u) { if (xb_ld(&bar[XB_TMO])) break; if (sp > XB_SPIN_CAP) { atomicAdd(&bar[XB_TMO], 1u); break; } }
    }
    nloc = mine > 0u ? mine : 1u; nx = cnt > 0u ? cnt : 1u;
}
__device__ __forceinline__ void xcd_barrier(const XcdBarrier& b) {
    asm volatile("s_waitcnt vmcnt(0)" ::: "memory");
    __syncthreads();
    if (threadIdx.x == 0) {
        unsigned* bar = b.bar;
        __builtin_amdgcn_s_waitcnt(0);
        unsigned nloc = b.st[0], nx = b.st[1];
        if (nloc == 0u) { xcd_barrier_complete(bar, b.x, nloc, nx); b.st[0] = nloc; b.st[1] = nx; }
        const unsigned old = xb_add(&bar[XB_XSUB(b.x)], 1u);
        const unsigned gen = old / nloc;
        if (old + 1u == (gen + 1u) * nloc) {
            __builtin_amdgcn_fence(__ATOMIC_RELEASE, "agent");
            asm volatile("s_waitcnt vmcnt(0)" ::: "memory");
            const unsigned og = xb_add(&bar[XB_TOP], 1u);
            const unsigned tg = og / nx;
            if (og + 1u == (tg + 1u) * nx) xb_add(&bar[XB_TOPGEN], 1u);
            else XB_SPIN(xb_ld(&bar[XB_TOPGEN]) == tg, bar);
            __builtin_amdgcn_fence(__ATOMIC_ACQUIRE, "agent");
            xb_add(&bar[XB_XGEN(b.x)], 1u);
            asm volatile("s_waitcnt vmcnt(0)" ::: "memory");
        } else {
            XB_SPIN(xb_ld(&bar[XB_XGEN(b.x)]) == gen, bar);
            __builtin_amdgcn_fence(__ATOMIC_ACQUIRE, "agent");
            asm volatile("s_waitcnt vmcnt(0)" ::: "memory");
        }
    }
    __syncthreads();
}

#define SCHED_FENCE() __builtin_amdgcn_sched_barrier(0)
__device__ __forceinline__ float gelu_as(float v) {
    const float av = fabsf(v), t = __builtin_amdgcn_rcpf(av * 0.2316418882f + 1.0f);
    float q = t * 0.5307027145f + (-0.7265760135f); q = q * t + 0.7107068705f; q = q * t + (-0.142248368f); q = q * t + 0.127414796f; q = q * t;
    const float e = __builtin_amdgcn_exp2f((v * v) * (-0.72134752044f));
    const float mm = v * (q * e);
    return v < 0.f ? mm : v - mm;
}
struct Frame {
    LAS unsigned char* lds;
    volatile LAS unsigned* MISC;
    int tid, lane, wave, vcu, G;
    const float* in[18]; float* out; unsigned char* ws;
};
__device__ __forceinline__ float wave_sum(float v) {
#pragma unroll
    for (int o = 1; o < 64; o <<= 1) v += __shfl_xor(v, o);
    return v;
}
__device__ __forceinline__ float sigmoidf_(float x) { return 1.f / (1.f + __expf(-x)); }

__device__ __forceinline__ void p0_transpose_item(const float* W, int K, int N, bf16* WT, int row_off, LAS float* scr, int item, int lane) {
    const int nblk = N / 32, kb = item / nblk, nb = item % nblk, k0 = 64 * kb, n0 = 32 * nb;
#pragma unroll 8
    for (int i = 0; i < 32; ++i) { const int kk = 2 * i + (lane >> 5); scr[kk * 33 + (lane & 31)] = W[(size_t)(k0 + kk) * N + n0 + (lane & 31)]; }
    LDS_WAIT(); asm volatile("" ::: "memory");
    const int c = lane & 7;
#pragma unroll
    for (int j = 0; j < 4; ++j) { const int n = (lane >> 3) + 8 * j; const LAS float* s = scr + (8 * c) * 33 + n;
        v4u o; o.x = pk2(s[0 * 33], s[1 * 33]); o.y = pk2(s[2 * 33], s[3 * 33]); o.z = pk2(s[4 * 33], s[5 * 33]); o.w = pk2(s[6 * 33], s[7 * 33]);
        *(GAS v4u*)(WT + (size_t)(row_off + n0 + n) * K + k0 + 8 * c) = o; }
    LDS_WAIT(); asm volatile("" ::: "memory");
}

__device__ __forceinline__ void quant_vals_fp8(const f32x4 (&v)[4], unsigned char* dst, float* dq, int lane, size_t slice_stride) {
    float mx = 0.f;
#pragma unroll
    for (int j = 0; j < 4; ++j) mx = fmaxf(mx, fmaxf(fmaxf(fabsf(v[j].x), fabsf(v[j].y)), fmaxf(fabsf(v[j].z), fabsf(v[j].w))));
#pragma unroll
    for (int o = 1; o < 64; o <<= 1) mx = fmaxf(mx, __shfl_xor(mx, o));
    const float qs = mx > 0.f ? 224.f / mx : 1.f;
#pragma unroll
    for (int j = 0; j < 4; ++j) { int p = __builtin_amdgcn_cvt_pk_fp8_f32(v[j].x * qs, v[j].y * qs, 0, false); p = __builtin_amdgcn_cvt_pk_fp8_f32(v[j].z * qs, v[j].w * qs, p, true);
        const int d = 4 * lane + 256 * j; *(GAS unsigned*)(dst + (slice_stride ? (size_t)(d >> 7) * slice_stride + (d & 127) : (size_t)d)) = (unsigned)p; }
    if (lane == 0) *dq = mx > 0.f ? mx * (1.f / 224.f) : 1.f;
}
__device__ __forceinline__ void quant_row_fp8(const float* src, unsigned char* dst, float* dq, int lane, size_t slice_stride) {
    const GAS f32x4* xr = (const GAS f32x4*)src + lane; f32x4 v[4];
#pragma unroll
    for (int j = 0; j < 4; ++j) v[j] = xr[64 * j];
    quant_vals_fp8(v, dst, dq, lane, slice_stride);
}
__device__ __forceinline__ void p0_prologue(Frame& F) {
    LAS float* scr = (LAS float*)(F.lds + RING_OFF + F.wave * 16384);
    const int gw = F.vcu * NWAVES + F.wave, NGW = F.G * NWAVES;
    bf16* WinT = (bf16*)(F.ws + WS_WIN); bf16* WoutT = (bf16*)(F.ws + WS_WOUT); bf16* W2T = (bf16*)(F.ws + WS_W2);
    float* small = (float*)(F.ws + WS_SMALL);
    if (blockIdx.x == 0) {
        const int t = F.tid;
        { const float l0 = F.in[9][t], l1 = F.in[9][512 + t]; small[SM_LB + t] = 1.f / (1.f + expf(l1 - l0)); }
        { const int h = t >> 7, n = t & 127; int bk;
          if (n < 16) bk = n; else { bk = 16 + (int)(logf((float)n * (1.f / 16.f)) / logf(8.f) * 16.f); bk = bk > 31 ? 31 : bk; }
          small[SM_BIAS + t] = F.in[8][bk * 4 + h] * 1.4426950408889634f; }
        if (F.wave == 0) {
            const float a = wave_sum(F.in[3][F.lane] * F.in[4][F.lane]), b = wave_sum(F.in[5][F.lane] * F.in[6][F.lane]);
            if (F.lane == 0) small[SM_LAM] = expf(a) - expf(b) + LAM_INIT;
        }
    }
    constexpr int I_IN = (DM / 64) * (INW / 32), I_OUT = (DM / 64) * (DM / 32);
    for (int it = gw; it < I_IN + I_OUT; it += NGW) {
        if (it < I_IN) p0_transpose_item(F.in[2], DM, INW, WinT, 0, scr, it, F.lane);
        else p0_transpose_item(F.in[11], DM, DM, WoutT, 0, scr, it - I_IN, F.lane);
    }
    for (int u = F.vcu; u < 256; u += F.G) {
        const int hc = u >> 4, kb = u & 15, k = kb * 64 + F.lane;
        const GAS f32x4* wrow = (const GAS f32x4*)(F.in[13] + (size_t)k * 2048 + hc * 128);
        float a[16];
#pragma unroll
        for (int nn = 0; nn < 16; ++nn) a[nn] = 0.f;
        const float* kr = F.in[14] + ((size_t)hc * 128 + F.wave * 16) * 128;
        for (int i = 0; i < 32; ++i) {
            const f32x4 w = wrow[i];
#pragma unroll
            for (int nn = 0; nn < 16; ++nn) { const float* kk = kr + nn * 128 + 4 * i; a[nn] += (kk[0] * w.x + kk[1] * w.y) + (kk[2] * w.z + kk[3] * w.w); }
        }
        const float g2k = F.in[12][k];
#pragma unroll
        for (int nn = 0; nn < 16; ++nn) W2T[((size_t)hc * 128 + F.wave * 16 + nn) * DM + k] = (bf16)f2bf(a[nn] * g2k);
    }
    bf16* HN = (bf16*)(F.ws + WS_HN);
    for (int m = gw; m < NTOK; m += 2 * NGW) {
        const int m2 = m + NGW;
        const GAS f32x4* xa = (const GAS f32x4*)(F.in[0] + (size_t)m * DM) + F.lane; const GAS f32x4* xb = (const GAS f32x4*)(F.in[0] + (size_t)(m2 < NTOK ? m2 : m) * DM) + F.lane;
        const GAS f32x4* gr = (const GAS f32x4*)F.in[1] + F.lane;
        f32x4 va[4], vb[4]; float sa = 0.f, sb = 0.f;
#pragma unroll
        for (int j = 0; j < 4; ++j) { va[j] = xa[64 * j]; vb[j] = xb[64 * j]; }
#pragma unroll
        for (int j = 0; j < 4; ++j) { sa += (va[j].x * va[j].x + va[j].y * va[j].y) + (va[j].z * va[j].z + va[j].w * va[j].w); sb += (vb[j].x * vb[j].x + vb[j].y * vb[j].y) + (vb[j].z * vb[j].z + vb[j].w * vb[j].w); }
#pragma unroll
        for (int o = 1; o < 64; o <<= 1) { sa += __shfl_xor(sa, o); sb += __shfl_xor(sb, o); }
        const float ra = 1.f / sqrtf(sa * (1.f / DM) + EPS), rb = 1.f / sqrtf(sb * (1.f / DM) + EPS);
        GAS unsigned long long* oa = (GAS unsigned long long*)(HN + (size_t)m * DM) + F.lane; GAS unsigned long long* ob = (GAS unsigned long long*)(HN + (size_t)m2 * DM) + F.lane;
#pragma unroll
        for (int j = 0; j < 4; ++j) { const f32x4 gg = gr[64 * j];
            oa[64 * j] = (unsigned long long)pk2(va[j].x * ra * gg.x, va[j].y * ra * gg.y) | ((unsigned long long)pk2(va[j].z * ra * gg.z, va[j].w * ra * gg.w) << 32);
            if (m2 < NTOK) ob[64 * j] = (unsigned long long)pk2(vb[j].x * rb * gg.x, vb[j].y * rb * gg.y) | ((unsigned long long)pk2(vb[j].z * rb * gg.z, vb[j].w * rb * gg.w) << 32); }
    }
}


constexpr int QCHUNKS = 2 * 16384 / 64;
__device__ __forceinline__ void quant_chunk(Frame& F, int c) {
    unsigned char* U8 = F.ws + WS_U8; unsigned char* V8 = F.ws + WS_V8; float* SU = (float*)(F.ws + WS_SU); float* SV = (float*)(F.ws + WS_SV);
#pragma unroll 1
    for (int k = 0; k < 8; ++k) { const int rr = 64 * c + 8 * F.wave + k;
        if (rr < 16384) quant_row_fp8(F.in[15] + (size_t)rr * DM, U8 + (size_t)rr * 128, SU + rr, F.lane, (size_t)16384 * 128);
        else { const int e = rr - 16384; quant_row_fp8(F.in[16] + (size_t)e * DM, V8 + (size_t)e * 128, SV + e, F.lane, (size_t)16384 * 128); } }
}

__device__ __forceinline__ void quant_drain(Frame& F) {
    unsigned* qctr = (unsigned*)(F.ws + WS_CTL) + CW_ATTQ + 128;
    for (;;) {
        __syncthreads();
        if (F.tid == 0) F.MISC[13] = __hip_atomic_fetch_add(qctr, 1u, __ATOMIC_RELAXED, __HIP_MEMORY_SCOPE_AGENT);
        __syncthreads();
        const int qc = (int)F.MISC[13];
        if (qc >= QCHUNKS) break;
        quant_chunk(F, qc);
    }
}

typedef float f32x16 __attribute__((ext_vector_type(16)));
typedef short s16x4 __attribute__((ext_vector_type(4)));
typedef short v4i16_t __attribute__((ext_vector_type(4)));
typedef float f32x2_t __attribute__((ext_vector_type(2))); typedef __bf16 bf16x2_t __attribute__((ext_vector_type(2)));
__device__ __forceinline__ unsigned cvtpk_bf16(float lo, float hi) { f32x2_t v = {lo, hi}; bf16x2_t b = __builtin_convertvector(v, bf16x2_t); return __builtin_bit_cast(unsigned, b); }
__device__ __forceinline__ float xhalf_max(float v) { return fmaxf(v, __shfl_xor(v, 32)); }
__device__ __forceinline__ float xhalf_sum(float v) { return v + __shfl_xor(v, 32); }
__device__ __forceinline__ float max3f_(float a, float b, float c) { float r; asm("v_max3_f32 %0, %1, %2, %3" : "=v"(r) : "v"(a), "v"(b), "v"(c)); return r; }
constexpr int AT_KP = 144, AT_VP = 320, AT_K1 = 64 * AT_KP, AT_V = 2 * AT_K1, AT_BUF = AT_V + 64 * AT_VP;
constexpr int AT_XO = 0, AT_YB = 65536, AT_YP = 272, AT_TAB = 100352, AT_Q = 100864;
static_assert(AT_Q + 8 * 4096 <= RING_BYTES, "attention LDS map");
__device__ __forceinline__ void attn_mfma(Frame& F, int qslot) {
    const bf16* PROJ = (const bf16*)(F.ws + WS_PROJ); bf16* MIXED = (bf16*)(F.ws + WS_HN);
    const float* small = (const float*)(F.ws + WS_SMALL);
    LAS unsigned char* lds = F.lds;
    LAS float* TAB = (LAS float*)(lds + AT_TAB);
    const int tid = F.tid, lane = F.lane, wave = F.wave, map = wave >> 2, qt = wave & 3, r32 = lane & 31, hi = lane >> 5;
    const float lam = small[SM_LAM];
    const int koff = map * AT_K1 + r32 * AT_KP + hi * 16;
    const int voff = AT_V + (4 * hi + ((lane & 15) >> 2)) * AT_VP + (16 * ((lane >> 4) & 1) + 4 * (lane & 3)) * 2;
    unsigned* qctr = (unsigned*)(F.ws + WS_CTL) + CW_ATTQ + 64 * qslot;
    for (;;) {
        __syncthreads();
        if (tid == 0) F.MISC[12] = __hip_atomic_fetch_add(qctr, 1u, __ATOMIC_RELAXED, __HIP_MEMORY_SCOPE_AGENT);
        __syncthreads();
        const int L = (int)F.MISC[12];
        if (L >= 1024) break;
        const int qb = 15 - (L >> 6), bh = L & 63;
        const int b = bh >> 2, h = bh & 3, q0 = qb * 128; const size_t tok0 = (size_t)b * SEQ;
        const int NT = (q0 + 128) / 64;
        if (tid < 128) TAB[tid] = small[SM_BIAS + h * 128 + tid];
        LAS unsigned char* qlds = lds + AT_Q + wave * 4096 + lane * 16;
        { const bf16* qrow = PROJ + (tok0 + q0 + 32 * qt + r32) * INW + C_DQ + h * 128 + map * 64 + 8 * hi;
#pragma unroll
          for (int s4 = 0; s4 < 4; ++s4) *(LAS bf16x8*)(qlds + 1024 * s4) = *(const GAS bf16x8*)(qrow + 16 * s4); }
        const bf16* ksrc = PROJ + (tok0 + (tid >> 4)) * INW + C_DK + h * 128 + (tid & 15) * 8;
        const bf16* vsrc = PROJ + (tok0 + (tid >> 4)) * INW + C_DV + h * 128 + (tid & 15) * 8;
        const int kdst = ((tid & 15) >> 3) * AT_K1 + (tid >> 4) * AT_KP + (tid & 7) * 16, vdst = AT_V + (tid >> 4) * AT_VP + (tid & 15) * 16;
        v4u krA[2], vrA[2], krB[2], vrB[2];
#pragma unroll
        for (int i = 0; i < 2; ++i) { krB[i] = *(const GAS v4u*)(ksrc + (size_t)(32 * i) * INW); vrB[i] = *(const GAS v4u*)(vsrc + (size_t)(32 * i) * INW); }
#pragma unroll
        for (int i = 0; i < 2; ++i) { krA[i] = *(const GAS v4u*)(ksrc + (size_t)(64 + 32 * i) * INW); vrA[i] = *(const GAS v4u*)(vsrc + (size_t)(64 + 32 * i) * INW); }
#pragma unroll
        for (int i = 0; i < 2; ++i) { *(LAS v4u*)(lds + kdst + 32 * i * AT_KP) = krB[i]; *(LAS v4u*)(lds + vdst + 32 * i * AT_VP) = vrB[i]; }
        __syncthreads();
        const float bfar = TAB[127];
        f32x16 o[4];
#pragma unroll
        for (int mt = 0; mt < 4; ++mt) o[mt] = (f32x16){0.f,0.f,0.f,0.f,0.f,0.f,0.f,0.f,0.f,0.f,0.f,0.f,0.f,0.f,0.f,0.f};
        float mrun = -INFINITY, lsum = 0.f;
        const int qlo = q0 + 32 * qt, qpos = qlo + r32;
#pragma unroll
        for (int i = 0; i < 2; ++i) { if (2 < NT) { krB[i] = *(const GAS v4u*)(ksrc + (size_t)(128 + 32 * i) * INW); vrB[i] = *(const GAS v4u*)(vsrc + (size_t)(128 + 32 * i) * INW); } }
        for (int j2 = 0; j2 < NT; j2 += 2) {
          { const int j = j2;
            const int bo = (j & 1) * AT_BUF, bn = ((j + 1) & 1) * AT_BUF;
            if (64 * j <= qlo + 31) {
                f32x16 s0 = (f32x16){0.f,0.f,0.f,0.f,0.f,0.f,0.f,0.f,0.f,0.f,0.f,0.f,0.f,0.f,0.f,0.f}, s1 = s0;
#pragma unroll
                for (int s4 = 0; s4 < 4; ++s4) {
                    const bf16x8 a0 = *(const LAS bf16x8*)(lds + bo + koff + 32 * s4), a1 = *(const LAS bf16x8*)(lds + bo + koff + 32 * AT_KP + 32 * s4);
                    const bf16x8 qfr = *(const LAS bf16x8*)(qlds + 1024 * s4);
                    s0 = __builtin_amdgcn_mfma_f32_32x32x16_bf16(a0, qfr, s0, 0, 0, 0);
                    s1 = __builtin_amdgcn_mfma_f32_32x32x16_bf16(a1, qfr, s1, 0, 0, 0);
                }
                float tm, cadd;
                if (qlo - (64 * j + 63) < 127) {
                    const int kb = 64 * j + 4 * hi; tm = -INFINITY;
#pragma unroll
                    for (int r = 0; r < 16; ++r) { const int n0 = qpos - (kb + (r & 3) + 8 * (r >> 2)), n1 = n0 - 32;
                        float b0 = TAB[n0 > 127 ? 127 : (n0 < 0 ? 0 : n0)], b1 = TAB[n1 > 127 ? 127 : (n1 < 0 ? 0 : n1)];
                        asm volatile("" : "+v"(b0), "+v"(b1));
                        s0[r] = n0 < 0 ? -INFINITY : s0[r] + b0; s1[r] = n1 < 0 ? -INFINITY : s1[r] + b1; tm = max3f_(tm, s0[r], s1[r]); }
                    cadd = 0.f;
                } else {
                    tm = max3f_(s0[0], s1[0], s0[1]);
#pragma unroll
                    for (int r = 1; r < 15; ++r) tm = max3f_(tm, s1[r], s0[r + 1]);
                    tm = fmaxf(tm, s1[15]);
                    tm += bfar; cadd = bfar;
                }
                tm = xhalf_max(tm);
                if (__any(tm > mrun + 8.f)) {
                    const float mnew = fmaxf(mrun, tm), alpha = __builtin_amdgcn_exp2f(mrun - mnew);
                    lsum *= alpha; mrun = mnew;
#pragma unroll
                    for (int mt = 0; mt < 4; ++mt) o[mt] = o[mt] * alpha;
                }
                const float c = cadd - mrun; float psum = 0.f;
#pragma unroll
                for (int r = 0; r < 16; ++r) { s0[r] = __builtin_amdgcn_exp2f(s0[r] + c); s1[r] = __builtin_amdgcn_exp2f(s1[r] + c); psum += s0[r] + s1[r]; }
                lsum += psum;
#pragma unroll
                for (int kt2 = 0; kt2 < 2; ++kt2)
#pragma unroll
                    for (int sp = 0; sp < 2; ++sp) {
                        v4u pw;
                        if (kt2 == 0) { pw.x = cvtpk_bf16(s0[8 * sp], s0[8 * sp + 1]); pw.y = cvtpk_bf16(s0[8 * sp + 2], s0[8 * sp + 3]); pw.z = cvtpk_bf16(s0[8 * sp + 4], s0[8 * sp + 5]); pw.w = cvtpk_bf16(s0[8 * sp + 6], s0[8 * sp + 7]); }
                        else          { pw.x = cvtpk_bf16(s1[8 * sp], s1[8 * sp + 1]); pw.y = cvtpk_bf16(s1[8 * sp + 2], s1[8 * sp + 3]); pw.z = cvtpk_bf16(s1[8 * sp + 4], s1[8 * sp + 5]); pw.w = cvtpk_bf16(s1[8 * sp + 6], s1[8 * sp + 7]); }
                        const bf16x8 pf = __builtin_bit_cast(bf16x8, pw);
#pragma unroll
                        for (int mt = 0; mt < 4; ++mt) {
                            LAS unsigned char* vp = lds + bo + voff + (32 * kt2 + 16 * sp) * AT_VP + 64 * mt;
                            const s16x4 lo = __builtin_bit_cast(s16x4, __builtin_amdgcn_ds_read_tr16_b64_v4i16((LAS v4i16_t*)vp));
                            const s16x4 hi4 = __builtin_bit_cast(s16x4, __builtin_amdgcn_ds_read_tr16_b64_v4i16((LAS v4i16_t*)(vp + 8 * AT_VP)));
                            const bf16x8 af = (bf16x8){lo[0], lo[1], lo[2], lo[3], hi4[0], hi4[1], hi4[2], hi4[3]};
                            o[mt] = __builtin_amdgcn_mfma_f32_32x32x16_bf16(af, pf, o[mt], 0, 0, 0);
                        }
                    }
            }
            if (j + 1 < NT) {
#pragma unroll
                for (int i = 0; i < 2; ++i) { *(LAS v4u*)(lds + bn + kdst + 32 * i * AT_KP) = krA[i]; *(LAS v4u*)(lds + bn + vdst + 32 * i * AT_VP) = vrA[i]; }
                if (j + 3 < NT) {
#pragma unroll
                    for (int i = 0; i < 2; ++i) { krA[i] = *(const GAS v4u*)(ksrc + (size_t)(64 * (j + 3) + 32 * i) * INW); vrA[i] = *(const GAS v4u*)(vsrc + (size_t)(64 * (j + 3) + 32 * i) * INW); }
                }
            }
            __syncthreads();
                  }
          { const int j = j2 + 1;
            const int bo = (j & 1) * AT_BUF, bn = ((j + 1) & 1) * AT_BUF;
            if (64 * j <= qlo + 31) {
                f32x16 s0 = (f32x16){0.f,0.f,0.f,0.f,0.f,0.f,0.f,0.f,0.f,0.f,0.f,0.f,0.f,0.f,0.f,0.f}, s1 = s0;
#pragma unroll
                for (int s4 = 0; s4 < 4; ++s4) {
                    const bf16x8 a0 = *(const LAS bf16x8*)(lds + bo + koff + 32 * s4), a1 = *(const LAS bf16x8*)(lds + bo + koff + 32 * AT_KP + 32 * s4);
                    const bf16x8 qfr = *(const LAS bf16x8*)(qlds + 1024 * s4);
                    s0 = __builtin_amdgcn_mfma_f32_32x32x16_bf16(a0, qfr, s0, 0, 0, 0);
                    s1 = __builtin_amdgcn_mfma_f32_32x32x16_bf16(a1, qfr, s1, 0, 0, 0);
                }
                float tm, cadd;
                if (qlo - (64 * j + 63) < 127) {
                    const int kb = 64 * j + 4 * hi; tm = -INFINITY;
#pragma unroll
                    for (int r = 0; r < 16; ++r) { const int n0 = qpos - (kb + (r & 3) + 8 * (r >> 2)), n1 = n0 - 32;
                        float b0 = TAB[n0 > 127 ? 127 : (n0 < 0 ? 0 : n0)], b1 = TAB[n1 > 127 ? 127 : (n1 < 0 ? 0 : n1)];
                        asm volatile("" : "+v"(b0), "+v"(b1));
                        s0[r] = n0 < 0 ? -INFINITY : s0[r] + b0; s1[r] = n1 < 0 ? -INFINITY : s1[r] + b1; tm = max3f_(tm, s0[r], s1[r]); }
                    cadd = 0.f;
                } else {
                    tm = max3f_(s0[0], s1[0], s0[1]);
#pragma unroll
                    for (int r = 1; r < 15; ++r) tm = max3f_(tm, s1[r], s0[r + 1]);
                    tm = fmaxf(tm, s1[15]);
                    tm += bfar; cadd = bfar;
                }
                tm = xhalf_max(tm);
                if (__any(tm > mrun + 8.f)) {
                    const float mnew = fmaxf(mrun, tm), alpha = __builtin_amdgcn_exp2f(mrun - mnew);
                    lsum *= alpha; mrun = mnew;
#pragma unroll
                    for (int mt = 0; mt < 4; ++mt) o[mt] = o[mt] * alpha;
                }
                const float c = cadd - mrun; float psum = 0.f;
#pragma unroll
                for (int r = 0; r < 16; ++r) { s0[r] = __builtin_amdgcn_exp2f(s0[r] + c); s1[r] = __builtin_amdgcn_exp2f(s1[r] + c); psum += s0[r] + s1[r]; }
                lsum += psum;
#pragma unroll
                for (int kt2 = 0; kt2 < 2; ++kt2)
#pragma unroll
                    for (int sp = 0; sp < 2; ++sp) {
                        v4u pw;
                        if (kt2 == 0) { pw.x = cvtpk_bf16(s0[8 * sp], s0[8 * sp + 1]); pw.y = cvtpk_bf16(s0[8 * sp + 2], s0[8 * sp + 3]); pw.z = cvtpk_bf16(s0[8 * sp + 4], s0[8 * sp + 5]); pw.w = cvtpk_bf16(s0[8 * sp + 6], s0[8 * sp + 7]); }
                        else          { pw.x = cvtpk_bf16(s1[8 * sp], s1[8 * sp + 1]); pw.y = cvtpk_bf16(s1[8 * sp + 2], s1[8 * sp + 3]); pw.z = cvtpk_bf16(s1[8 * sp + 4], s1[8 * sp + 5]); pw.w = cvtpk_bf16(s1[8 * sp + 6], s1[8 * sp + 7]); }
                        const bf16x8 pf = __builtin_bit_cast(bf16x8, pw);
#pragma unroll
                        for (int mt = 0; mt < 4; ++mt) {
                            LAS unsigned char* vp = lds + bo + voff + (32 * kt2 + 16 * sp) * AT_VP + 64 * mt;
                            const s16x4 lo = __builtin_bit_cast(s16x4, __builtin_amdgcn_ds_read_tr16_b64_v4i16((LAS v4i16_t*)vp));
                            const s16x4 hi4 = __builtin_bit_cast(s16x4, __builtin_amdgcn_ds_read_tr16_b64_v4i16((LAS v4i16_t*)(vp + 8 * AT_VP)));
                            const bf16x8 af = (bf16x8){lo[0], lo[1], lo[2], lo[3], hi4[0], hi4[1], hi4[2], hi4[3]};
                            o[mt] = __builtin_amdgcn_mfma_f32_32x32x16_bf16(af, pf, o[mt], 0, 0, 0);
                        }
                    }
            }
            if (j + 1 < NT) {
#pragma unroll
                for (int i = 0; i < 2; ++i) { *(LAS v4u*)(lds + bn + kdst + 32 * i * AT_KP) = krB[i]; *(LAS v4u*)(lds + bn + vdst + 32 * i * AT_VP) = vrB[i]; }
                if (j + 3 < NT) {
#pragma unroll
                    for (int i = 0; i < 2; ++i) { krB[i] = *(const GAS v4u*)(ksrc + (size_t)(64 * (j + 3) + 32 * i) * INW); vrB[i] = *(const GAS v4u*)(vsrc + (size_t)(64 * (j + 3) + 32 * i) * INW); }
                }
            }
            __syncthreads();
                  }
        }
        const float inv = 1.f / xhalf_sum(lsum);
        LAS float* XO = (LAS float*)(lds + AT_XO) + qt * 4096 + r32;
        if (map == 1) {
            const float sc = inv * lam;
#pragma unroll
            for (int mt = 0; mt < 4; ++mt)
#pragma unroll
                for (int r = 0; r < 16; ++r) XO[(32 * mt + (r & 3) + 8 * (r >> 2) + 4 * hi) * 32] = o[mt][r] * sc;
        }
        __syncthreads();
        if (map == 0) {
            float ss = 0.f;
#pragma unroll
            for (int mt = 0; mt < 4; ++mt)
#pragma unroll
                for (int r = 0; r < 16; ++r) { const float a = o[mt][r] * inv - XO[(32 * mt + (r & 3) + 8 * (r >> 2) + 4 * hi) * 32]; o[mt][r] = a; ss += a * a; }
            ss = xhalf_sum(ss);
            const float rr = (1.f - LAM_INIT) / sqrtf(ss * (1.f / 128.f) + EPS);
            LAS unsigned char* yb = lds + AT_YB + qt * (32 * AT_YP);
#pragma unroll
            for (int mt = 0; mt < 4; ++mt)
#pragma unroll
                for (int r4 = 0; r4 < 4; ++r4) { const int dv = 32 * mt + 8 * r4 + 4 * hi; const f32x4 gg = *(const GAS f32x4*)(F.in[7] + dv);
                    v2u w; w.x = cvtpk_bf16(o[mt][4 * r4] * rr * gg.x, o[mt][4 * r4 + 1] * rr * gg.y); w.y = cvtpk_bf16(o[mt][4 * r4 + 2] * rr * gg.z, o[mt][4 * r4 + 3] * rr * gg.w);
                    *(LAS v2u*)(yb + r32 * AT_YP + dv * 2) = w; }
            LDS_WAIT(); asm volatile("" ::: "memory");
            bf16* obase = MIXED + (tok0 + q0 + 32 * qt) * DM + h * 128;
#pragma unroll
            for (int i = 0; i < 8; ++i) { const int id = lane + 64 * i, row = id >> 4, cch = id & 15;
                const v4u w = *(const LAS v4u*)(yb + row * AT_YP + cch * 16); *(GAS v4u*)(obase + (size_t)row * DM + cch * 8) = w; }
        }
    }
}


constexpr int HG_P = 272, HG_KP = 80, HG_VP = 320;
constexpr int HG_QD = 0, HG_KI = 32 * HG_P, HG_KDT = 2 * 32 * HG_P, HG_V = HG_KDT + 128 * HG_KP, HG_CD = HG_V + 32 * HG_VP, HG_BUF = HG_CD + 512;
constexpr int HG_OA = 2 * HG_BUF, HG_OB = HG_OA + 32 * 128 * 4;
static_assert(HG_OB + 32 * 128 * 4 <= RING_BYTES, "hgrn LDS map");
__device__ __forceinline__ bf16x8 pack8(const f32x16& x, int s) {
    v4u p; p.x = cvtpk_bf16(x[8 * s], x[8 * s + 1]); p.y = cvtpk_bf16(x[8 * s + 2], x[8 * s + 3]); p.z = cvtpk_bf16(x[8 * s + 4], x[8 * s + 5]); p.w = cvtpk_bf16(x[8 * s + 6], x[8 * s + 7]);
    return __builtin_bit_cast(bf16x8, p);
}
__device__ __forceinline__ bf16x8 tr_pair(LAS unsigned char* p0, LAS unsigned char* p1) {
    const s16x4 lo = __builtin_bit_cast(s16x4, __builtin_amdgcn_ds_read_tr16_b64_v4i16((LAS v4i16_t*)p0));
    const s16x4 hi4 = __builtin_bit_cast(s16x4, __builtin_amdgcn_ds_read_tr16_b64_v4i16((LAS v4i16_t*)p1));
    return (bf16x8){lo[0], lo[1], lo[2], lo[3], hi4[0], hi4[1], hi4[2], hi4[3]};
}
__device__ __forceinline__ void hgrn_mfma(Frame& F) {
    const bf16* PROJ = (const bf16*)(F.ws + WS_PROJ); bf16* MIXED = (bf16*)(F.ws + WS_HN);
    const float* small = (const float*)(F.ws + WS_SMALL);
    LAS unsigned char* lds = F.lds;
    const int tid = F.tid, lane = F.lane, wave = F.wave, r32 = lane & 31, hh = lane >> 5;
    const int dvt = wave & 3, dkh = wave >> 2;
    const int pc = lane & 31, pdk8 = 16 * wave + 8 * (lane >> 5);
    const int kdoff = (((lane & 15) >> 2)) * HG_VP + (16 * ((lane >> 4) & 1) + 4 * (lane & 3)) * 2;
    const int vc = tid >> 4, vseg = tid & 15;
    const int troff = (((lane & 15) >> 2)) * HG_VP + (32 * dvt + 16 * ((lane >> 4) & 1) + 4 * (lane & 3)) * 2;
    for (int u = F.vcu; u < 64; u += F.G) {
        const int b = u >> 2, h = u & 3; const size_t tok0 = (size_t)b * SEQ;
        const f32x4 lbA = *(const GAS f32x4*)(small + SM_LB + h * 128 + pdk8), lbB = *(const GAS f32x4*)(small + SM_LB + h * 128 + pdk8 + 4);
        const float lbv[8] = {lbA.x, lbA.y, lbA.z, lbA.w, lbB.x, lbB.y, lbB.z, lbB.w};
        const f32x4 g0 = *(const GAS f32x4*)(F.in[10] + 8 * vseg), g1 = *(const GAS f32x4*)(F.in[10] + 8 * vseg + 4);
        f32x16 S0, S1;
#pragma unroll
        for (int r = 0; r < 16; ++r) { S0[r] = 0.f; S1[r] = 0.f; }
        v4u rqA, rfA, rqB, rfB, rvA, rgA, rvB, rgB;
#define HG_LOAD(S, chn) do { const bf16* p_ = PROJ + (tok0 + 32 * (chn) + pc) * INW + h * 128 + pdk8; \
            asm volatile("global_load_dwordx4 %0, %1, off" : "=v"(rq##S) : "v"(p_ + C_HQ) : "memory"); \
            asm volatile("global_load_dwordx4 %0, %1, off" : "=v"(rf##S) : "v"(p_ + C_HF) : "memory"); \
            asm volatile("global_load_dwordx4 %0, %1, off" : "=v"(rv##S) : "v"(PROJ + (tok0 + 32 * (chn) + vc) * INW + C_HI + h * 128 + vseg * 8) : "memory"); } while (0)
#define HG_LOADG(S, chn) do { asm volatile("global_load_dwordx4 %0, %1, off" : "=v"(rg##S) : "v"(PROJ + (tok0 + 32 * (chn) + vc) * INW + C_HG + h * 128 + vseg * 8) : "memory"); } while (0)
#define HG_WAIT_RAW(S) asm volatile("s_waitcnt vmcnt(7)" : "+v"(rq##S), "+v"(rf##S), "+v"(rv##S) :: "memory")
#define HG_WAIT_G(S) asm volatile("s_waitcnt vmcnt(8)" : "+v"(rg##S) :: "memory")
        HG_LOAD(A, 0); HG_LOADG(A, 0); HG_LOAD(B, 1); HG_LOADG(B, 1);
        asm volatile("s_waitcnt vmcnt(0)" : "+v"(rvA), "+v"(rgA), "+v"(rvB), "+v"(rgB) :: "memory");
        __syncthreads();
        for (int ch2 = 0; ch2 < SEQ / 32; ch2 += 2) {
          { const int ch = ch2;
            LAS unsigned char* bufp = lds + (ch & 1) * HG_BUF;
            HG_WAIT_RAW(A);
            { float bb[8], fv[8];
              const unsigned fw[4] = {rfA.x, rfA.y, rfA.z, rfA.w}, qw[4] = {rqA.x, rqA.y, rqA.z, rqA.w};
#pragma unroll
              for (int i = 0; i < 8; ++i) { const float x = (i & 1) ? bfhi(fw[i >> 1]) : bflo(fw[i >> 1]); const float f = lbv[i] + (1.f - lbv[i]) * __builtin_amdgcn_rcpf(1.f + __expf(-x)); fv[i] = f; bb[i] = f; }
#pragma unroll
              for (int i = 0; i < 8; ++i) { float x = bb[i];
                  x *= __builtin_bit_cast(float, __builtin_amdgcn_update_dpp(0x3f800000, __builtin_bit_cast(int, x), 0x111, 0xf, 0xf, false));
                  x *= __builtin_bit_cast(float, __builtin_amdgcn_update_dpp(0x3f800000, __builtin_bit_cast(int, x), 0x112, 0xf, 0xf, false));
                  x *= __builtin_bit_cast(float, __builtin_amdgcn_update_dpp(0x3f800000, __builtin_bit_cast(int, x), 0x114, 0xf, 0xf, false));
                  x *= __builtin_bit_cast(float, __builtin_amdgcn_update_dpp(0x3f800000, __builtin_bit_cast(int, x), 0x118, 0xf, 0xf, false));
                  x *= __builtin_bit_cast(float, __builtin_amdgcn_update_dpp(0x3f800000, __builtin_bit_cast(int, x), 0x142, 0xa, 0xf, false));
                  bb[i] = x; }
              unsigned qd[8], ki[8], kd[8]; float cdv[8];
#pragma unroll
              for (int i = 0; i < 8; ++i) { const float elast = __shfl(bb[i], (lane & 32) + 31);
                  const float e = bb[i], ei = __builtin_amdgcn_rcpf(bb[i]), ed = elast * ei;
                  const float xq = (i & 1) ? bfhi(qw[i >> 1]) : bflo(qw[i >> 1]); const float q = xq * __builtin_amdgcn_rcpf(1.f + __expf(-xq)); const float k = 1.f - fv[i];
                  qd[i] = f2bf(q * e); ki[i] = f2bf(k * ei); kd[i] = f2bf(k * ed); cdv[i] = elast; }
              *(LAS v4u*)(bufp + HG_QD + pc * HG_P + pdk8 * 2) = (v4u){qd[0] | (qd[1] << 16), qd[2] | (qd[3] << 16), qd[4] | (qd[5] << 16), qd[6] | (qd[7] << 16)};
              *(LAS v4u*)(bufp + HG_KI + pc * HG_P + pdk8 * 2) = (v4u){ki[0] | (ki[1] << 16), ki[2] | (ki[3] << 16), ki[4] | (ki[5] << 16), ki[6] | (ki[7] << 16)};
              *(LAS v4u*)(bufp + HG_KDT + pc * HG_VP + pdk8 * 2) = (v4u){kd[0] | (kd[1] << 16), kd[2] | (kd[3] << 16), kd[4] | (kd[5] << 16), kd[6] | (kd[7] << 16)};
              if (pc == 31) { *(LAS f32x4*)(bufp + HG_CD + pdk8 * 4) = (f32x4){cdv[0], cdv[1], cdv[2], cdv[3]}; *(LAS f32x4*)(bufp + HG_CD + pdk8 * 4 + 16) = (f32x4){cdv[4], cdv[5], cdv[6], cdv[7]}; }
              *(LAS v4u*)(bufp + HG_V + vc * HG_VP + vseg * 16) = rvA; }
            HG_LOAD(A, (ch + 2 < SEQ / 32 ? ch + 2 : SEQ / 32 - 1));
            __syncthreads();
            f32x16 o;
#pragma unroll
            for (int r = 0; r < 16; ++r) o[r] = 0.f;
#pragma unroll
            for (int kk = 0; kk < 2; ++kk)
#pragma unroll
                for (int s2 = 0; s2 < 2; ++s2) {
                    LAS unsigned char* qa = bufp + HG_QD + r32 * HG_P + (32 * (2 * dkh + kk) + 16 * s2 + 4 * hh) * 2;
                    const v2u a0 = *(const LAS v2u*)qa, a1 = *(const LAS v2u*)(qa + 16);
                    const bf16x8 af = __builtin_bit_cast(bf16x8, (v4u){a0.x, a0.y, a1.x, a1.y});
                    o = __builtin_amdgcn_mfma_f32_32x32x16_bf16(af, pack8(kk == 0 ? S0 : S1, s2), o, 0, 0, 0);
                }
            if (wave < 4) {
                f32x16 X;
#pragma unroll
                for (int r = 0; r < 16; ++r) X[r] = 0.f;
#pragma unroll
                for (int s8 = 0; s8 < 8; ++s8) {
                    const bf16x8 af = *(const LAS bf16x8*)(bufp + HG_KI + r32 * HG_P + (16 * s8 + 8 * hh) * 2);
                    const bf16x8 bfr = *(const LAS bf16x8*)(bufp + HG_QD + r32 * HG_P + (16 * s8 + 8 * hh) * 2);
                    X = __builtin_amdgcn_mfma_f32_32x32x16_bf16(af, bfr, X, 0, 0, 0);
                }
#pragma unroll
                for (int r = 0; r < 16; ++r) { const int cp = (r & 3) + 8 * (r >> 2) + 4 * hh; X[r] = cp > r32 ? 0.f : X[r]; }
#pragma unroll
                for (int s2 = 0; s2 < 2; ++s2) {
                    LAS unsigned char* vp = bufp + HG_V + troff + (16 * s2 + 4 * hh) * HG_VP;
                    o = __builtin_amdgcn_mfma_f32_32x32x16_bf16(pack8(X, s2), tr_pair(vp, vp + 8 * HG_VP), o, 0, 0, 0);
                }
            }
            { LAS float* ob = (LAS float*)(lds + (wave < 4 ? HG_OA : HG_OB)) + 32 * dvt + r32;
#pragma unroll
              for (int r = 0; r < 16; ++r) ob[((r & 3) + 8 * (r >> 2) + 4 * hh) * 128] = o[r]; }
#pragma unroll
            for (int kk = 0; kk < 2; ++kk) {
                const int dk0 = 32 * (2 * dkh + kk);
                const LAS float* cdp = (const LAS float*)(bufp + HG_CD) + dk0 + 4 * hh;
#pragma unroll
                for (int r4 = 0; r4 < 4; ++r4) { const f32x4 c4 = *(const LAS f32x4*)(cdp + 8 * r4);
                    if (kk == 0) { S0[4 * r4] *= c4.x; S0[4 * r4 + 1] *= c4.y; S0[4 * r4 + 2] *= c4.z; S0[4 * r4 + 3] *= c4.w; }
                    else         { S1[4 * r4] *= c4.x; S1[4 * r4 + 1] *= c4.y; S1[4 * r4 + 2] *= c4.z; S1[4 * r4 + 3] *= c4.w; } }
#pragma unroll
                for (int s2 = 0; s2 < 2; ++s2) {
                    LAS unsigned char* kp = bufp + HG_KDT + kdoff + (16 * s2 + 8 * hh) * HG_VP + dk0 * 2;
                    const bf16x8 af = tr_pair(kp, kp + 4 * HG_VP);
                    LAS unsigned char* vp = bufp + HG_V + troff + (16 * s2 + 8 * hh) * HG_VP;
                    const bf16x8 bfr = tr_pair(vp, vp + 4 * HG_VP);
                    if (kk == 0) S0 = __builtin_amdgcn_mfma_f32_32x32x16_bf16(af, bfr, S0, 0, 0, 0);
                    else         S1 = __builtin_amdgcn_mfma_f32_32x32x16_bf16(af, bfr, S1, 0, 0, 0);
                }
            }
            __syncthreads();
            { const LAS float* oa = (const LAS float*)(lds + HG_OA) + vc * 128 + 8 * vseg; const LAS float* ob = (const LAS float*)(lds + HG_OB) + vc * 128 + 8 * vseg;
              const f32x4 x0 = *(const LAS f32x4*)oa + *(const LAS f32x4*)ob, x1 = *(const LAS f32x4*)(oa + 4) + *(const LAS f32x4*)(ob + 4);
              float ss = (x0.x * x0.x + x0.y * x0.y) + (x0.z * x0.z + x0.w * x0.w) + (x1.x * x1.x + x1.y * x1.y) + (x1.z * x1.z + x1.w * x1.w);
              ss += __shfl_xor(ss, 1); ss += __shfl_xor(ss, 2); ss += __shfl_xor(ss, 4); ss += __shfl_xor(ss, 8);
              const float rr = 1.f / sqrtf(ss * (1.f / 128.f) + EPS);
              const size_t tok = tok0 + 32 * ch + vc;
              HG_WAIT_G(A);
              const unsigned ga[4] = {rgA.x, rgA.y, rgA.z, rgA.w};
              const float ov[8] = {x0.x, x0.y, x0.z, x0.w, x1.x, x1.y, x1.z, x1.w}; const float gg[8] = {g0.x, g0.y, g0.z, g0.w, g1.x, g1.y, g1.z, g1.w};
              unsigned w[4];
#pragma unroll
              for (int j = 0; j < 4; ++j) { const float a0 = bflo(ga[j]), a1 = bfhi(ga[j]);
                  w[j] = pk2(ov[2 * j] * rr * gg[2 * j] * (a0 * __builtin_amdgcn_rcpf(1.f + __expf(-a0))), ov[2 * j + 1] * rr * gg[2 * j + 1] * (a1 * __builtin_amdgcn_rcpf(1.f + __expf(-a1)))); }
              *(GAS v4u*)(MIXED + tok * DM + 512 + h * 128 + 8 * vseg) = (v4u){w[0], w[1], w[2], w[3]}; }
            HG_LOADG(A, (ch + 2 < SEQ / 32 ? ch + 2 : SEQ / 32 - 1));
          }
          { const int ch = ch2 + 1;
            LAS unsigned char* bufp = lds + (ch & 1) * HG_BUF;
            HG_WAIT_RAW(B);
            { float bb[8], fv[8];
              const unsigned fw[4] = {rfB.x, rfB.y, rfB.z, rfB.w}, qw[4] = {rqB.x, rqB.y, rqB.z, rqB.w};
#pragma unroll
              for (int i = 0; i < 8; ++i) { const float x = (i & 1) ? bfhi(fw[i >> 1]) : bflo(fw[i >> 1]); const float f = lbv[i] + (1.f - lbv[i]) * __builtin_amdgcn_rcpf(1.f + __expf(-x)); fv[i] = f; bb[i] = f; }
#pragma unroll
              for (int i = 0; i < 8; ++i) { float x = bb[i];
                  x *= __builtin_bit_cast(float, __builtin_amdgcn_update_dpp(0x3f800000, __builtin_bit_cast(int, x), 0x111, 0xf, 0xf, false));
                  x *= __builtin_bit_cast(float, __builtin_amdgcn_update_dpp(0x3f800000, __builtin_bit_cast(int, x), 0x112, 0xf, 0xf, false));
                  x *= __builtin_bit_cast(float, __builtin_amdgcn_update_dpp(0x3f800000, __builtin_bit_cast(int, x), 0x114, 0xf, 0xf, false));
                  x *= __builtin_bit_cast(float, __builtin_amdgcn_update_dpp(0x3f800000, __builtin_bit_cast(int, x), 0x118, 0xf, 0xf, false));
                  x *= __builtin_bit_cast(float, __builtin_amdgcn_update_dpp(0x3f800000, __builtin_bit_cast(int, x), 0x142, 0xa, 0xf, false));
                  bb[i] = x; }
              unsigned qd[8], ki[8], kd[8]; float cdv[8];
#pragma unroll
              for (int i = 0; i < 8; ++i) { const float elast = __shfl(bb[i], (lane & 32) + 31);
                  const float e = bb[i], ei = __builtin_amdgcn_rcpf(bb[i]), ed = elast * ei;
                  const float xq = (i & 1) ? bfhi(qw[i >> 1]) : bflo(qw[i >> 1]); const float q = xq * __builtin_amdgcn_rcpf(1.f + __expf(-xq)); const float k = 1.f - fv[i];
                  qd[i] = f2bf(q * e); ki[i] = f2bf(k * ei); kd[i] = f2bf(k * ed); cdv[i] = elast; }
              *(LAS v4u*)(bufp + HG_QD + pc * HG_P + pdk8 * 2) = (v4u){qd[0] | (qd[1] << 16), qd[2] | (qd[3] << 16), qd[4] | (qd[5] << 16), qd[6] | (qd[7] << 16)};
              *(LAS v4u*)(bufp + HG_KI + pc * HG_P + pdk8 * 2) = (v4u){ki[0] | (ki[1] << 16), ki[2] | (ki[3] << 16), ki[4] | (ki[5] << 16), ki[6] | (ki[7] << 16)};
              *(LAS v4u*)(bufp + HG_KDT + pc * HG_VP + pdk8 * 2) = (v4u){kd[0] | (kd[1] << 16), kd[2] | (kd[3] << 16), kd[4] | (kd[5] << 16), kd[6] | (kd[7] << 16)};
              if (pc == 31) { *(LAS f32x4*)(bufp + HG_CD + pdk8 * 4) = (f32x4){cdv[0], cdv[1], cdv[2], cdv[3]}; *(LAS f32x4*)(bufp + HG_CD + pdk8 * 4 + 16) = (f32x4){cdv[4], cdv[5], cdv[6], cdv[7]}; }
              *(LAS v4u*)(bufp + HG_V + vc * HG_VP + vseg * 16) = rvB; }
            HG_LOAD(B, (ch + 2 < SEQ / 32 ? ch + 2 : SEQ / 32 - 1));
            __syncthreads();
            f32x16 o;
#pragma unroll
            for (int r = 0; r < 16; ++r) o[r] = 0.f;
#pragma unroll
            for (int kk = 0; kk < 2; ++kk)
#pragma unroll
                for (int s2 = 0; s2 < 2; ++s2) {
                    LAS unsigned char* qa = bufp + HG_QD + r32 * HG_P + (32 * (2 * dkh + kk) + 16 * s2 + 4 * hh) * 2;
                    const v2u a0 = *(const LAS v2u*)qa, a1 = *(const LAS v2u*)(qa + 16);
                    const bf16x8 af = __builtin_bit_cast(bf16x8, (v4u){a0.x, a0.y, a1.x, a1.y});
                    o = __builtin_amdgcn_mfma_f32_32x32x16_bf16(af, pack8(kk == 0 ? S0 : S1, s2), o, 0, 0, 0);
                }
            if (wave < 4) {
                f32x16 X;
#pragma unroll
                for (int r = 0; r < 16; ++r) X[r] = 0.f;
#pragma unroll
                for (int s8 = 0; s8 < 8; ++s8) {
                    const bf16x8 af = *(const LAS bf16x8*)(bufp + HG_KI + r32 * HG_P + (16 * s8 + 8 * hh) * 2);
                    const bf16x8 bfr = *(const LAS bf16x8*)(bufp + HG_QD + r32 * HG_P + (16 * s8 + 8 * hh) * 2);
                    X = __builtin_amdgcn_mfma_f32_32x32x16_bf16(af, bfr, X, 0, 0, 0);
                }
#pragma unroll
                for (int r = 0; r < 16; ++r) { const int cp = (r & 3) + 8 * (r >> 2) + 4 * hh; X[r] = cp > r32 ? 0.f : X[r]; }
#pragma unroll
                for (int s2 = 0; s2 < 2; ++s2) {
                    LAS unsigned char* vp = bufp + HG_V + troff + (16 * s2 + 4 * hh) * HG_VP;
                    o = __builtin_amdgcn_mfma_f32_32x32x16_bf16(pack8(X, s2), tr_pair(vp, vp + 8 * HG_VP), o, 0, 0, 0);
                }
            }
            { LAS float* ob = (LAS float*)(lds + (wave < 4 ? HG_OA : HG_OB)) + 32 * dvt + r32;
#pragma unroll
              for (int r = 0; r < 16; ++r) ob[((r & 3) + 8 * (r >> 2) + 4 * hh) * 128] = o[r]; }
#pragma unroll
            for (int kk = 0; kk < 2; ++kk) {
                const int dk0 = 32 * (2 * dkh + kk);
                const LAS float* cdp = (const LAS float*)(bufp + HG_CD) + dk0 + 4 * hh;
#pragma unroll
                for (int r4 = 0; r4 < 4; ++r4) { const f32x4 c4 = *(const LAS f32x4*)(cdp + 8 * r4);
                    if (kk == 0) { S0[4 * r4] *= c4.x; S0[4 * r4 + 1] *= c4.y; S0[4 * r4 + 2] *= c4.z; S0[4 * r4 + 3] *= c4.w; }
                    else         { S1[4 * r4] *= c4.x; S1[4 * r4 + 1] *= c4.y; S1[4 * r4 + 2] *= c4.z; S1[4 * r4 + 3] *= c4.w; } }
#pragma unroll
                for (int s2 = 0; s2 < 2; ++s2) {
                    LAS unsigned char* kp = bufp + HG_KDT + kdoff + (16 * s2 + 8 * hh) * HG_VP + dk0 * 2;
                    const bf16x8 af = tr_pair(kp, kp + 4 * HG_VP);
                    LAS unsigned char* vp = bufp + HG_V + troff + (16 * s2 + 8 * hh) * HG_VP;
                    const bf16x8 bfr = tr_pair(vp, vp + 4 * HG_VP);
                    if (kk == 0) S0 = __builtin_amdgcn_mfma_f32_32x32x16_bf16(af, bfr, S0, 0, 0, 0);
                    else         S1 = __builtin_amdgcn_mfma_f32_32x32x16_bf16(af, bfr, S1, 0, 0, 0);
                }
            }
            __syncthreads();
            { const LAS float* oa = (const LAS float*)(lds + HG_OA) + vc * 128 + 8 * vseg; const LAS float* ob = (const LAS float*)(lds + HG_OB) + vc * 128 + 8 * vseg;
              const f32x4 x0 = *(const LAS f32x4*)oa + *(const LAS f32x4*)ob, x1 = *(const LAS f32x4*)(oa + 4) + *(const LAS f32x4*)(ob + 4);
              float ss = (x0.x * x0.x + x0.y * x0.y) + (x0.z * x0.z + x0.w * x0.w) + (x1.x * x1.x + x1.y * x1.y) + (x1.z * x1.z + x1.w * x1.w);
              ss += __shfl_xor(ss, 1); ss += __shfl_xor(ss, 2); ss += __shfl_xor(ss, 4); ss += __shfl_xor(ss, 8);
              const float rr = 1.f / sqrtf(ss * (1.f / 128.f) + EPS);
              const size_t tok = tok0 + 32 * ch + vc;
              HG_WAIT_G(B);
              const unsigned ga[4] = {rgB.x, rgB.y, rgB.z, rgB.w};
              const float ov[8] = {x0.x, x0.y, x0.z, x0.w, x1.x, x1.y, x1.z, x1.w}; const float gg[8] = {g0.x, g0.y, g0.z, g0.w, g1.x, g1.y, g1.z, g1.w};
              unsigned w[4];
#pragma unroll
              for (int j = 0; j < 4; ++j) { const float a0 = bflo(ga[j]), a1 = bfhi(ga[j]);
                  w[j] = pk2(ov[2 * j] * rr * gg[2 * j] * (a0 * __builtin_amdgcn_rcpf(1.f + __expf(-a0))), ov[2 * j + 1] * rr * gg[2 * j + 1] * (a1 * __builtin_amdgcn_rcpf(1.f + __expf(-a1)))); }
              *(GAS v4u*)(MIXED + tok * DM + 512 + h * 128 + 8 * vseg) = (v4u){w[0], w[1], w[2], w[3]}; }
            HG_LOADG(B, (ch + 2 < SEQ / 32 ? ch + 2 : SEQ / 32 - 1));
          }
        }
#undef HG_LOAD
#undef HG_LOADG
#undef HG_WAIT_RAW
#undef HG_WAIT_G
    }
}

template <int N> __device__ __forceinline__ unsigned row_ror(unsigned x) { return (unsigned)__builtin_amdgcn_update_dpp((int)x, (int)x, 0x120 + N, 0xf, 0xf, false); }
__device__ __forceinline__ unsigned umax_(unsigned a, unsigned b) { return a > b ? a : b; }
__device__ __forceinline__ unsigned umin_(unsigned a, unsigned b) { return a < b ? a : b; }
__device__ __forceinline__ unsigned row_umax16(unsigned x) {
    unsigned y;
    asm volatile("s_nop 1\n\tv_max_u32_dpp %0, %1, %1 row_ror:1 row_mask:0xf bank_mask:0xf\n\t"
                 "s_nop 1\n\tv_max_u32_dpp %0, %0, %0 row_ror:2 row_mask:0xf bank_mask:0xf\n\t"
                 "s_nop 1\n\tv_max_u32_dpp %0, %0, %0 row_ror:4 row_mask:0xf bank_mask:0xf\n\t"
                 "s_nop 1\n\tv_max_u32_dpp %0, %0, %0 row_ror:8 row_mask:0xf bank_mask:0xf"
                 : "=&v"(y) : "v"(x));
    return y;
}
__device__ __forceinline__ float row_fsum16(float v) {
    v += __builtin_bit_cast(float, row_ror<1>(__builtin_bit_cast(unsigned, v))); v += __builtin_bit_cast(float, row_ror<2>(__builtin_bit_cast(unsigned, v)));
    v += __builtin_bit_cast(float, row_ror<4>(__builtin_bit_cast(unsigned, v))); v += __builtin_bit_cast(float, row_ror<8>(__builtin_bit_cast(unsigned, v))); return v; }
__device__ __forceinline__ unsigned h2key(unsigned x) { return (x & 0x80000000u) ? (~x & 0xffff0000u) : (x | 0x80000000u); }
__device__ __forceinline__ float hkey2f(unsigned k) { const unsigned hb = ((k & 0x80000000u) ? (k & 0x7fff0000u) : (~k & 0xffff0000u)) >> 16; return (float)__builtin_bit_cast(_Float16, (unsigned short)hb); }
__device__ __forceinline__ unsigned f2key(float f) { const unsigned u = __builtin_bit_cast(unsigned, f); return (u & 0x80000000u) ? ~u : (u | 0x80000000u); }
__device__ __forceinline__ float key2f(unsigned k) { const unsigned u = (k & 0x80000000u) ? (k & 0x7fffffffu) : ~k; return __builtin_bit_cast(float, u); }
__device__ __forceinline__ unsigned pair_code(int s) {
    if (s < 16) return (unsigned)s;
    if (s < 24) return 16u + (unsigned)(s - 16);
    if (s < 29) return 32u + (unsigned)(s - 24);
    if (s < 33) return 48u + (unsigned)(s - 29);
    if (s < 36) return 64u + (unsigned)(s - 33);
    if (s < 42) return 80u + 16u * (unsigned)((s - 36) >> 1) + (unsigned)((s - 36) & 1);
    if (s < 50) return 128u + 16u * (unsigned)(s - 42);
    return 0xFFu;
}
#define CAS_(a, b) do { const unsigned hi_ = umax_(a, b), lo_ = umin_(a, b); a = hi_; b = lo_; } while (0)
__device__ __forceinline__ unsigned topk_stage1(const unsigned short* SC, int th, int c, int l15) {
    const int t = th >> 3, h = th & 7;
    const v4u sv = *(const GAS v4u*)(SC + (size_t)t * 2048 + h * 256 + c * 128 + l15 * 8);
    const unsigned nb = 127u - 8u * (unsigned)l15;
    unsigned k0 = h2key(sv.x << 16) | nb, k1 = h2key(sv.x & 0xffff0000u) | (nb - 1u), k2 = h2key(sv.y << 16) | (nb - 2u), k3 = h2key(sv.y & 0xffff0000u) | (nb - 3u);
    unsigned k4 = h2key(sv.z << 16) | (nb - 4u), k5 = h2key(sv.z & 0xffff0000u) | (nb - 5u), k6 = h2key(sv.w << 16) | (nb - 6u), k7 = h2key(sv.w & 0xffff0000u) | (nb - 7u);
    CAS_(k0, k1); CAS_(k2, k3); CAS_(k4, k5); CAS_(k6, k7); CAS_(k0, k2); CAS_(k1, k3); CAS_(k4, k6); CAS_(k5, k7); CAS_(k1, k2); CAS_(k5, k6); CAS_(k0, k4); CAS_(k3, k7);
    CAS_(k1, k5); CAS_(k2, k6); CAS_(k1, k4); CAS_(k3, k6); CAS_(k2, k4); CAS_(k3, k5); CAS_(k3, k4);
    unsigned res = 0u;
#pragma unroll
    for (int r = 0; r < 16; ++r) {
        const unsigned m = row_umax16(k0); const bool pop = (k0 == m);
        k0 = pop ? k1 : k0; k1 = pop ? k2 : k1; k2 = pop ? k3 : k2; k3 = pop ? k4 : k3; k4 = pop ? k5 : k4; k5 = pop ? k6 : k5; k6 = pop ? k7 : k6; k7 = pop ? 0u : k7;
        res = (l15 == r) ? m : res;
    }
    return res;
}
__device__ __forceinline__ void topk_v2(Frame& F) {
    const unsigned short* SC = (const unsigned short*)(F.ws + WS_SC); int* IDX = (int*)(F.ws + WS_IDX); float* GATE = (float*)(F.ws + WS_GATE); float* GSU = (float*)(F.ws + WS_GSU);
    const float* SU = (const float*)(F.ws + WS_SU); const float* SV = (const float*)(F.ws + WS_SV);
    const int gw = F.vcu * NWAVES + F.wave, NGW = F.G * NWAVES, lane = F.lane, l15 = lane & 15, row = lane >> 4, c = row & 1, rbase = lane & 48;
    const unsigned pc0 = pair_code(l15), pc1 = pair_code(l15 + 16), pc2 = pair_code(l15 + 32), pc3 = pair_code(l15 + 48);
    const int src1 = l15 + 32 * (row & 1), src2 = src1 + 16;
    for (int it0 = gw * 32; it0 < NTOK * 2; it0 += NGW * 32)
    for (int it = it0; it < it0 + 32; ++it) {
        const int thb = 4 * it;
        const unsigned resA = topk_stage1(SC, thb + (row >> 1), c, l15), resB = topk_stage1(SC, thb + 2 + (row >> 1), c, l15);
        const unsigned a1 = (unsigned)__shfl((int)resA, src1), a2 = (unsigned)__shfl((int)resA, src2), b1 = (unsigned)__shfl((int)resB, src1), b2 = (unsigned)__shfl((int)resB, src2);
        const unsigned S1 = row < 2 ? a1 : b1, S2 = row < 2 ? a2 : b2;
        unsigned c0, c1, c2, c3;
#define TK_CAND(CK, PC) do { const unsigned ka_ = (unsigned)__shfl((int)S1, rbase + (int)((PC) >> 4 & 15u)), kb_ = (unsigned)__shfl((int)S2, rbase + (int)((PC) & 15u)); \
            const float sm_ = hkey2f(ka_) + hkey2f(kb_); CK = (PC) == 0xFFu ? 0u : ((f2key(sm_) & ~0xFFu) | (255u - (PC))); } while (0)
        TK_CAND(c0, pc0); TK_CAND(c1, pc1); TK_CAND(c2, pc2); TK_CAND(c3, pc3);
#undef TK_CAND
        CAS_(c0, c1); CAS_(c2, c3); CAS_(c0, c2); CAS_(c1, c3); CAS_(c1, c2);
        unsigned res2 = 0u;
#pragma unroll
        for (int r = 0; r < 16; ++r) {
            const unsigned m = row_umax16(c0); const bool pop = (c0 == m);
            c0 = pop ? c1 : c0; c1 = pop ? c2 : c1; c2 = pop ? c3 : c2; c3 = pop ? 0u : c3;
            res2 = (l15 == r) ? m : res2;
        }
        const unsigned code = 255u - (res2 & 0xFFu);
        const unsigned ka = (unsigned)__shfl((int)S1, rbase + (int)(code >> 4 & 15u)), kb = (unsigned)__shfl((int)S2, rbase + (int)(code & 15u));
        const float ts = hkey2f(ka) + hkey2f(kb);
        const int e = (int)((127u - (ka & 0x7Fu)) * 128u + (127u - (kb & 0x7Fu)));
        const float tmax = __builtin_bit_cast(float, (unsigned)__shfl((int)__builtin_bit_cast(unsigned, ts), rbase));
        const float ex = __expf(ts - tmax);
        const float sum = row_fsum16(ex);
        const int th = thb + row;
        const size_t o = (size_t)(th >> 3) * NEXP_SEL + (th & 7) * 16 + l15;
        IDX[o] = e; GATE[o] = ex / sum * SV[e]; GSU[o] = SU[e];
    }
}

constexpr int PG_TOK = 16;
constexpr int PG_IDX = 0, PG_HID = 4096, PG_SA = PG_HID + 8192, PG_TB = PG_SA + 64, PG_WB = PG_TB + 4096;
static_assert(PG_WB % 16 == 0 && PG_TB % 16 == 0 && NWAVES * PG_WB <= RING_BYTES, "gather LDS map");
__device__ __forceinline__ void peer_sliced(Frame& F) {
    const unsigned char* U8T = F.ws + WS_U8; const unsigned char* V8T = F.ws + WS_V8; const unsigned char* X8 = F.ws + WS_X8;
    const float* SSQ = (const float*)(F.ws + WS_CTL) + CW_SSQ;
    const int* IDX = (const int*)(F.ws + WS_IDX); const float* GATE = (const float*)(F.ws + WS_GATE); const float* GSU = (const float*)(F.ws + WS_GSU); const float* gf = F.in[17];
    bf16* PO = (bf16*)(F.ws + WS_PO); const bf16* HB = (const bf16*)(F.ws + WS_HN2);
    const int gw = F.vcu * NWAVES + F.wave, NGW = F.G * NWAVES, lane = F.lane, m = lane & 15, g = lane >> 4;
    const int row8 = lane >> 3, piece = lane & 7;
    LAS unsigned char* wb = F.lds + F.wave * PG_WB;
    LAS unsigned short* idxs = (LAS unsigned short*)(wb + PG_IDX);
    LAS float* hid = (LAS float*)(wb + PG_HID);
    LAS float* sqp = hid + 64 + lane;
    LAS float* sai = (LAS float*)(wb + PG_SA);
    LAS unsigned char* tb = wb + PG_TB;
    const int p8 = m & 7; const unsigned bsh = 8u * (unsigned)(p8 & 3); const bool bhi = (p8 >> 2) != 0;
    constexpr size_t SLICE = (size_t)16384 * 128;
    const int usw = 16 * (piece ^ ((row8 >> 1) & 3));
    const int urd0 = m * 128 + 16 * ((2 * g) ^ ((m >> 1) & 7)), urd1 = m * 128 + 16 * ((2 * g + 1) ^ ((m >> 1) & 7));
    for (int blk = gw; blk < NTOK / PG_TOK; blk += NGW) {
        const int t0 = blk * PG_TOK;
#pragma unroll
        for (int k = 0; k < 32; ++k) { const int id = lane + 64 * k; idxs[id] = (unsigned short)IDX[(size_t)t0 * NEXP_SEL + id]; }
        LDS_WAIT(); asm volatile("" ::: "memory");
        for (int p = 0; p < 8; ++p) {
            const unsigned char* Up = U8T + (size_t)p * SLICE;
            const unsigned char* Xp = X8 + (size_t)t0 * DM + 128 * p + 32 * g;
            v4u ab[2][16]; l2 xs[2][2];
#define PGU_ISSUE(i_, buf_) do { _Pragma("unroll") for (int k = 0; k < 16; ++k) { const unsigned e = idxs[(i_) * 128 + 8 * k + row8]; \
                ab[buf_][k] = *(const GAS v4u*)(Up + (size_t)e * 128 + (usw ^ ((k & 1) ? 64 : 0))); } \
                xs[buf_][0] = *(const GAS l2*)(Xp + (size_t)(i_) * DM); xs[buf_][1] = *(const GAS l2*)(Xp + (size_t)(i_) * DM + 16); } while (0)
#define PGU_BODY(i_, cur_, nxt_) do { if ((i_) + 1 < PG_TOK) PGU_ISSUE((i_) + 1, nxt_); SCHED_FENCE(); \
                _Pragma("unroll") for (int rb = 0; rb < 4; ++rb) { LAS f32x4* hp0 = (LAS f32x4*)(hid + (i_) * 128 + 32 * rb + 4 * g); LAS f32x4* hp1 = hp0 + 4; \
                    _Pragma("unroll") for (int q4 = 0; q4 < 4; ++q4) *(LAS v4u*)(tb + 1024 * q4 + 16 * lane) = ab[cur_][4 * rb + q4]; \
                    f32x4 acc0 = p == 0 ? (f32x4){0.f, 0.f, 0.f, 0.f} : *hp0, acc1 = p == 0 ? (f32x4){0.f, 0.f, 0.f, 0.f} : *hp1; \
                    const l2 a0 = *(const LAS l2*)(tb + urd0), a1 = *(const LAS l2*)(tb + urd1), b0 = *(const LAS l2*)(tb + 2048 + urd0), b1 = *(const LAS l2*)(tb + 2048 + urd1); \
                    acc0 = __builtin_amdgcn_mfma_f32_16x16x32_fp8_bf8(a0.x, xs[cur_][0].x, acc0, 0, 0, 0); acc1 = __builtin_amdgcn_mfma_f32_16x16x32_fp8_bf8(b0.x, xs[cur_][0].x, acc1, 0, 0, 0); \
                    acc0 = __builtin_amdgcn_mfma_f32_16x16x32_fp8_bf8(a0.y, xs[cur_][0].y, acc0, 0, 0, 0); acc1 = __builtin_amdgcn_mfma_f32_16x16x32_fp8_bf8(b0.y, xs[cur_][0].y, acc1, 0, 0, 0); \
                    acc0 = __builtin_amdgcn_mfma_f32_16x16x32_fp8_bf8(a1.x, xs[cur_][1].x, acc0, 0, 0, 0); acc1 = __builtin_amdgcn_mfma_f32_16x16x32_fp8_bf8(b1.x, xs[cur_][1].x, acc1, 0, 0, 0); \
                    acc0 = __builtin_amdgcn_mfma_f32_16x16x32_fp8_bf8(a1.y, xs[cur_][1].y, acc0, 0, 0, 0); acc1 = __builtin_amdgcn_mfma_f32_16x16x32_fp8_bf8(b1.y, xs[cur_][1].y, acc1, 0, 0, 0); \
                    if (m == 0) { *hp0 = acc0; *hp1 = acc1; } } SCHED_FENCE(); } while (0)
            PGU_ISSUE(0, 0);
            for (int i2 = 0; i2 < PG_TOK; i2 += 2) { PGU_BODY(i2, 0, 1); PGU_BODY(i2 + 1, 1, 0); }
#undef PGU_ISSUE
#undef PGU_BODY
            LDS_WAIT(); asm volatile("" ::: "memory");
        }
        for (int i = 0; i < PG_TOK; ++i) {
            const int t = t0 + i; const float sx = 1.f / sqrtf(SSQ[t] * (1.f / DM) + EPS);
            float w[8][4]; float amax = 0.f;
#pragma unroll
            for (int r = 0; r < 8; ++r) { const f32x4 h4 = *(const LAS f32x4*)(hid + i * 128 + 16 * r + 4 * g);
                const f32x4 su4 = *(const GAS f32x4*)(GSU + (size_t)t * NEXP_SEL + 16 * r + 4 * g), gv4 = *(const GAS f32x4*)(GATE + (size_t)t * NEXP_SEL + 16 * r + 4 * g);
#pragma unroll
                for (int j = 0; j < 4; ++j) { w[r][j] = gelu_as(h4[j] * su4[j] * sx) * gv4[j]; amax = fmaxf(amax, fabsf(w[r][j])); } }
            amax = fmaxf(amax, __shfl_xor(amax, 16)); amax = fmaxf(amax, __shfl_xor(amax, 32));
            const float sa = amax > 0.f ? 224.f / amax : 1.f;
            LDS_WAIT(); asm volatile("" ::: "memory");
            if (m == 0) {
                LAS unsigned char* wrow = (LAS unsigned char*)(hid + i * 128);
#pragma unroll
                for (int r = 0; r < 8; ++r) { int pk = __builtin_amdgcn_cvt_pk_fp8_f32(w[r][0] * sa, w[r][1] * sa, 0, false); pk = __builtin_amdgcn_cvt_pk_fp8_f32(w[r][2] * sa, w[r][3] * sa, pk, true);
                    wrow[4 * r + g] = (unsigned char)pk; wrow[32 + 4 * r + g] = (unsigned char)(pk >> 8); wrow[64 + 4 * r + g] = (unsigned char)(pk >> 16); wrow[96 + 4 * r + g] = (unsigned char)(pk >> 24); }
            }
            if (lane == 0) sai[i] = amax > 0.f ? amax * (1.f / 224.f) : 1.f;
        }
        LDS_WAIT(); asm volatile("" ::: "memory");
        for (int p = 0; p < 8; ++p) {
            const unsigned char* Vp = V8T + (size_t)p * SLICE + 16 * piece;
            v4u va[2][16];
#define PGV_ISSUE(i_, buf_) do { _Pragma("unroll") for (int k = 0; k < 16; ++k) { const unsigned e = idxs[(i_) * 128 + 8 * k + row8]; va[buf_][k] = *(const GAS v4u*)(Vp + (size_t)e * 128); } } while (0)
#define PGV_BODY(i_, cur_, nxt_) do { if ((i_) + 1 < PG_TOK) PGV_ISSUE((i_) + 1, nxt_); \
                const LAS v4u* wp = (const LAS v4u*)((LAS unsigned char*)(hid + (i_) * 128) + 32 * g); const v4u w0 = wp[0], w1 = wp[1]; \
                const unsigned ww[8] = {w0.x, w0.y, w0.z, w0.w, w1.x, w1.y, w1.z, w1.w}; \
                SCHED_FENCE(); f32x4 c = (f32x4){0.f, 0.f, 0.f, 0.f}; \
                _Pragma("unroll") for (int kb = 0; kb < 4; ++kb) { \
                    _Pragma("unroll") for (int q4 = 0; q4 < 4; ++q4) *(LAS v4u*)(tb + 1024 * q4 + 16 * lane) = va[cur_][4 * kb + q4]; \
                    long rr_[8]; \
                    _Pragma("unroll") for (int q4 = 0; q4 < 4; ++q4) { rr_[2 * q4] = *(const LAS long*)(tb + 1024 * q4 + g * 128 + 8 * m); rr_[2 * q4 + 1] = *(const LAS long*)(tb + 1024 * q4 + (4 + g) * 128 + 8 * m); } \
                    _Pragma("unroll") for (int q8 = 0; q8 < 8; ++q8) { const int q = 8 * kb + q8; const unsigned a8 = ((ww[q >> 2] >> (8 * (q & 3))) & 0xffu) << bsh; const long bop = (long)(bhi ? ((unsigned long long)a8 << 32) : (unsigned long long)a8); \
                      c = __builtin_amdgcn_mfma_f32_16x16x32_fp8_fp8(rr_[q8], bop, c, 0, 0, 0); } } \
                SCHED_FENCE(); \
                { const float isa = sai[i_]; LAS unsigned short* ob = (LAS unsigned short*)(tb) + 32 * g + (m & 7);         \
                  if (m < 8) { ob[0] = (unsigned short)f2bf(c[0] * isa); ob[8] = (unsigned short)f2bf(c[1] * isa); ob[16] = (unsigned short)f2bf(c[2] * isa); ob[24] = (unsigned short)f2bf(c[3] * isa); } \
                  const v4u ov = *(const LAS v4u*)(tb + 16 * (lane & 15)); \
                  if (lane < 16) __builtin_nontemporal_store(ov, (GAS v4u*)(PO + (size_t)(t0 + (i_)) * DM + 128 * p + 8 * lane)); } } while (0)
            PGV_ISSUE(0, 0);
            for (int i2 = 0; i2 < PG_TOK; i2 += 2) { PGV_BODY(i2, 0, 1); PGV_BODY(i2 + 1, 1, 0); }
#undef PGV_ISSUE
#undef PGV_BODY
        }
        LDS_WAIT(); asm volatile("" ::: "memory");
        VM_WAIT();
        for (int i = 0; i < PG_TOK; i += 2) {
            GAS f32x4* hrA = (GAS f32x4*)(F.out + (size_t)(t0 + i) * DM) + lane; GAS f32x4* hrB = hrA + DM / 4;
            const GAS v2u* prA = (const GAS v2u*)(PO + (size_t)(t0 + i) * DM) + lane; const GAS v2u* prB = prA + DM / 4;
            const GAS v2u* hbA = (const GAS v2u*)(HB + (size_t)(t0 + i) * DM) + lane; const GAS v2u* hbB = hbA + DM / 4;
            v2u pa[4], pb[4], ha[4], hb2[4];
#pragma unroll
            for (int j = 0; j < 4; ++j) { pa[j] = prA[64 * j]; ha[j] = hbA[64 * j]; pb[j] = prB[64 * j]; hb2[j] = hbB[64 * j]; }
            f32x4 ya[4], yb[4]; float sa = 0.f, sb = 0.f;
#pragma unroll
            for (int j = 0; j < 4; ++j) {
                ya[j] = (f32x4){bflo(ha[j].x), bfhi(ha[j].x), bflo(ha[j].y), bfhi(ha[j].y)} + (f32x4){bflo(pa[j].x), bfhi(pa[j].x), bflo(pa[j].y), bfhi(pa[j].y)};
                yb[j] = (f32x4){bflo(hb2[j].x), bfhi(hb2[j].x), bflo(hb2[j].y), bfhi(hb2[j].y)} + (f32x4){bflo(pb[j].x), bfhi(pb[j].x), bflo(pb[j].y), bfhi(pb[j].y)};
                sa += (ya[j].x * ya[j].x + ya[j].y * ya[j].y) + (ya[j].z * ya[j].z + ya[j].w * ya[j].w); sb += (yb[j].x * yb[j].x + yb[j].y * yb[j].y) + (yb[j].z * yb[j].z + yb[j].w * yb[j].w); }
#pragma unroll
            for (int o = 1; o < 64; o <<= 1) { sa += __shfl_xor(sa, o); sb += __shfl_xor(sb, o); }
            const float ra = 1.f / sqrtf(sa * (1.f / DM) + EPS), rb = 1.f / sqrtf(sb * (1.f / DM) + EPS);
#pragma unroll
            for (int j = 0; j < 4; ++j) { const f32x4 gg = *((const GAS f32x4*)gf + lane + 64 * j); hrA[64 * j] = ya[j] * ra * gg; hrB[64 * j] = yb[j] * rb * gg; }
        }
        LDS_WAIT(); asm volatile("" ::: "memory");
    }
}

struct Args { const float* in[18]; float* out; unsigned char* ws; int ph_lo, ph_hi; };
__global__ void __launch_bounds__(NWAVES * 64, 2) hymba_fwd(Args args) {
    extern __shared__ __attribute__((aligned(16))) unsigned char lds[];
    Frame F;
    F.lds = (LAS unsigned char*)lds;
    F.MISC = (volatile LAS unsigned*)(F.lds + MISC_OFF);
    F.tid = threadIdx.x; F.lane = F.tid & 63; F.wave = __builtin_amdgcn_readfirstlane(F.tid >> 6);
    F.G = gridDim.x; { const int bx = blockIdx.x; F.vcu = (F.G % 8 == 0) ? (bx % 8) * (F.G / 8) + bx / 8 : bx; }
#pragma unroll
    for (int i = 0; i < 18; ++i) F.in[i] = args.in[i];
    F.out = args.out; F.ws = args.ws;
    for (int u = F.tid; u < (LDS_BYTES - LDSCTL_OFF) / 4; u += NWAVES * 64) ((LAS unsigned*)(F.lds + LDSCTL_OFF))[u] = 0u;
    __syncthreads();
    const int lo = args.ph_lo, hi = args.ph_hi;
    const bool multi = (hi - lo) > 1;
    XcdBarrier bar; bar.bar = (unsigned*)(F.ws + WS_CTL) + CW_BAR; bar.x = 0; bar.st = nullptr;
    if (multi) bar = xcd_barrier_post((unsigned*)(F.ws + WS_CTL) + CW_BAR, F.MISC + 8);
#define IN(k) (lo <= (k) && (k) < hi)
#define SEAM(k) do { if (IN(k) && IN((k) + 1)) xcd_barrier(bar); } while (0)

    if (IN(0)) { p0_prologue(F); } SEAM(0);
    if (IN(1)) {
        pg8::Gemm g{(const pg8::bf16_t*)(F.ws + WS_HN), (const pg8::bf16_t*)(F.ws + WS_WIN), NTOK, INW, DM}; pg8::StaticOrder S; S.init(NTOK, INW, F.G, (int)blockIdx.x);
        pg8::EpiProj E{(pg8::bf16_t*)(F.ws + WS_PROJ), INW, 2, QSCALE};
        pg8::gemm_phase<pg8::EpiProj, pg8::StaticOrder, PG8_ALIGN, PG8_SP2>(F.lds + RING_OFF, g, S, E);
    } SEAM(1);
    if (IN(2)) { hgrn_mfma(F); }
    if (IN(3)) { quant_drain(F); attn_mfma(F, 0); }
    if (IN(3) && IN(4)) xcd_barrier(bar);
    if (IN(4)) {
        pg8::Gemm g{(const pg8::bf16_t*)(F.ws + WS_HN), (const pg8::bf16_t*)(F.ws + WS_WOUT), NTOK, DM, DM}; pg8::StaticOrder S; S.init(NTOK, DM, F.G, (int)blockIdx.x);
        pg8::EpiMix E{DM, F.in[0], F.in[12], (pg8::bf16_t*)(F.ws + WS_HN2), F.ws + WS_X8, (float*)(F.ws + WS_CTL) + CW_SSQ};
        pg8::gemm_phase<pg8::EpiMix, pg8::StaticOrder, PG8_ALIGN, PG8_SP2>(F.lds + RING_OFF, g, S, E);
    }
    if (IN(4) && IN(6)) xcd_barrier(bar);
    if (IN(6)) {
        pg8::Gemm g{(const pg8::bf16_t*)(F.ws + WS_HN2), (const pg8::bf16_t*)(F.ws + WS_W2), NTOK, 2048, DM}; pg8::StaticOrder S; S.init(NTOK, 2048, F.G, (int)blockIdx.x);
        pg8::EpiScaleRow E{(_Float16*)(F.ws + WS_SC), 2048, (const float*)(F.ws + WS_CTL) + CW_SSQ, 1.f / DM, EPS};
        pg8::gemm_phase<pg8::EpiScaleRow, pg8::StaticOrder, PG8_ALIGN, PG8_SP2>(F.lds + RING_OFF, g, S, E);
    } SEAM(6);
    if (IN(7)) { topk_v2(F); }
    if (IN(7) && IN(8)) { VM_WAIT(); }
    if (IN(8)) { peer_sliced(F); }
#undef IN
#undef SEAM
}

extern "C" void kernel_launch(void* const* d_in, const int* in_sizes, int n_in, void* d_out, int out_size, void* d_ws, size_t ws_size, hipStream_t stream) {
    static int grid = 0;
    if (grid == 0) {
        if (n_in != 18 || in_sizes[0] != NTOK * DM || out_size != NTOK * DM || ws_size < WS_END) { fprintf(stderr, "kernel_launch: unexpected shapes (n_in %d, in0 %d, out %d, ws %zu); nothing launched\n", n_in, n_in > 0 ? in_sizes[0] : -1, out_size, ws_size); grid = -1; return; }
        int dev = 0, cus = 0, per_cu = 0;
        if (hipGetDevice(&dev) != hipSuccess || hipDeviceGetAttribute(&cus, hipDeviceAttributeMultiprocessorCount, dev) != hipSuccess) { grid = -1; return; }
        if (hipFuncSetAttribute((const void*)hymba_fwd, hipFuncAttributeMaxDynamicSharedMemorySize, LDS_BYTES) != hipSuccess) { fprintf(stderr, "kernel_launch: hipFuncSetAttribute failed\n"); grid = -1; return; }
        if (hipOccupancyMaxActiveBlocksPerMultiprocessor(&per_cu, (const void*)hymba_fwd, NWAVES * 64, LDS_BYTES) != hipSuccess || per_cu < 1)
            fprintf(stderr, "kernel_launch: note: occupancy query reports %d workgroups per CU\n", per_cu);
        (void)hipGetLastError();
        grid = cus;
    }
    if (grid < 0) return;
    if (hipMemsetAsync((char*)d_ws + WS_CTL, 0, CTL_ZERO_BYTES, stream) != hipSuccess) return;
    Args a{};
    for (int i = 0; i < 18; ++i) a.in[i] = (const float*)d_in[i];
    a.out = (float*)d_out; a.ws = (unsigned char*)d_ws; a.ph_lo = 0; a.ph_hi = 9;
    hipLaunchKernelGGL(hymba_fwd, dim3(grid), dim3(NWAVES * 64), LDS_BYTES, stream, a);
}
```

```cpp
#include <hip/hip_runtime.h>
#include <cstdio>
#include <cstdint>
#include <cmath>
namespace pg8 {
#define PG8_LAS __attribute__((address_space(3)))
typedef unsigned short bf16_t;
typedef short bf16x8 __attribute__((ext_vector_type(8)));
typedef float f32x4 __attribute__((ext_vector_type(4)));
typedef unsigned u32x4 __attribute__((ext_vector_type(4)));
constexpr int BM = 256, BK = 64, HALF = 128, HTB = HALF * BK * 2  , STAGE_BYTES = 8 * HTB, NXCD = 8, WGM = 8;

__host__ __device__ __forceinline__ int lds_byte(int r, int c) { const int st = (r >> 4) * 2 + (c >> 5), rr = r & 15, cc = c & 31, ob = rr * 64 + cc * 2; return st * 1024 + (ob ^ (((ob >> 9) & 1) << 5)); }
__host__ __device__ __forceinline__ void stage_rc(int b, int& R, int& C) { const int st = b / 1024, sb = b % 1024, swz = sb ^ (((sb >> 9) & 1) << 5); R = (st >> 1) * 16 + swz / 64; C = (st & 1) * 32 + (swz % 64) / 2; }
__host__ __device__ __forceinline__ int perm32(int rho) { const int n = rho >> 4, i = rho & 15; return 8 * (i >> 2) + 4 * n + (i & 3); }

struct Unit { int pm, pn; };
struct Gemm { const bf16_t* A; const bf16_t* Bt; int M, N, K; };

struct StaticOrder {
    int nM, nN, nwg, G, c;
    __host__ __device__ void init(int M, int N, int G_, int c_) { nM = M / BM; nN = N / BM; nwg = nM * nN; G = G_; c = c_; }
    __host__ __device__ bool next(int i, Unit& u) const {
        const long L = (long)i * G + c; if (L >= nwg) return false;
        int wgid = (int)L; { const int q = nwg / NXCD, r = nwg % NXCD, xcd = wgid % NXCD, off = wgid / NXCD; wgid = (xcd < r ? xcd * (q + 1) : r * (q + 1) + (xcd - r) * q) + off; }
        const int nig = WGM * nN, gid = wgid / nig, fm = gid * WGM, gsz = (nM - fm) < WGM ? (nM - fm) : WGM;
        u.pm = fm + ((wgid % nig) % gsz); u.pn = (wgid % nig) / gsz; return true;
    }
    __device__ __forceinline__ void a_ready(const Unit&) const {}
    __device__ __forceinline__ void done(const Unit&) const {}
};
__device__ __forceinline__ unsigned cvt_pk_bf16(float lo, float hi) { unsigned r; asm volatile("v_cvt_pk_bf16_f32 %0, %1, %2" : "=v"(r) : "v"(lo), "v"(hi)); return r; }
typedef float f32x2 __attribute__((ext_vector_type(2)));
__device__ __forceinline__ f32x2 gelu_pk(f32x2 v) {
    const f32x2 av = __builtin_elementwise_abs(v), d = av * 0.2316418882f + 1.0f;
    f32x2 t; t.x = __builtin_amdgcn_rcpf(d.x); t.y = __builtin_amdgcn_rcpf(d.y);
    f32x2 q = t * 0.5307027145f + (-0.7265760135f); q = q * t + 0.7107068705f; q = q * t + (-0.142248368f); q = q * t + 0.127414796f; q = q * t;
    const f32x2 s = (v * v) * (-0.72134752044f);
    f32x2 e; e.x = __builtin_amdgcn_exp2f(s.x); e.y = __builtin_amdgcn_exp2f(s.y);
    const f32x2 m = v * (q * e), r = v - m;
    f32x2 o; o.x = v.x < 0.f ? m.x : r.x; o.y = v.y < 0.f ? m.y : r.y; return o;
}
struct EpiProj {
    static constexpr bool PERM = true, AFTER_DRAIN = false;
    bf16_t* O; int ldc; int qtiles; float qscale;
    __device__ __forceinline__ void operator()(const f32x4 (&acc)[2][2][4][2], const Unit& u, int wr, int wc, int fr, int fq) const {
        const int row0 = u.pm * BM + wr * 64 + fr, col0 = u.pn * BM + wc * 32 + 8 * fq;
        const float sc = (u.pn < qtiles) ? qscale : 1.f;
#pragma unroll
        for (int ai = 0; ai < 2; ++ai)
#pragma unroll
            for (int m = 0; m < 4; ++m) { bf16_t* rowp = O + (size_t)(row0 + ai * HALF + m * 16) * ldc + col0;
#pragma unroll
                for (int bj = 0; bj < 2; ++bj) { const f32x4 v0 = acc[ai][bj][m][0] * sc, v1 = acc[ai][bj][m][1] * sc;
                    u32x4 w; w.x = cvt_pk_bf16(v0[0], v0[1]); w.y = cvt_pk_bf16(v0[2], v0[3]); w.z = cvt_pk_bf16(v1[0], v1[1]); w.w = cvt_pk_bf16(v1[2], v1[3]);
                    *(u32x4*)(rowp + bj * HALF) = w; } }
    }
};
struct EpiF32Res {
    static constexpr bool PERM = false, AFTER_DRAIN = false;
    float* C; int ldc; const float* res;
    __device__ __forceinline__ void operator()(const f32x4 (&acc)[2][2][4][2], const Unit& u, int wr, int wc, int fr, int fq) const {
        const int row0 = u.pm * BM + wr * 64 + fr, col0 = u.pn * BM + wc * 32 + 4 * fq;
#pragma unroll
        for (int ai = 0; ai < 2; ++ai)
#pragma unroll
            for (int m = 0; m < 4; ++m) { const size_t off = (size_t)(row0 + ai * HALF + m * 16) * ldc + col0;
#pragma unroll
                for (int bj = 0; bj < 2; ++bj)
#pragma unroll
                    for (int n = 0; n < 2; ++n) { f32x4 o = acc[ai][bj][m][n]; if (res) o = o + *(const f32x4*)(res + off + bj * HALF + n * 16);
                        *(f32x4*)(C + off + bj * HALF + n * 16) = o; } }
    }
};

struct EpiMix {
    static constexpr bool PERM = true, AFTER_DRAIN = false;
    int ldc; const float* res; const float* g2; bf16_t* HB; unsigned char* XB; float* ssq;
    __device__ __forceinline__ void operator()(const f32x4 (&acc)[2][2][4][2], const Unit& u, int wr, int wc, int fr, int fq) const {
        const int row0 = u.pm * BM + wr * 64 + fr, col0 = u.pn * BM + wc * 32 + 8 * fq;
        f32x4 gv[2][2];
#pragma unroll
        for (int bj = 0; bj < 2; ++bj)
#pragma unroll
            for (int n = 0; n < 2; ++n) gv[bj][n] = *(const f32x4*)(g2 + col0 + bj * HALF + 4 * n);
#pragma unroll
        for (int ai = 0; ai < 2; ++ai)
#pragma unroll
            for (int m = 0; m < 4; ++m) { const int row = row0 + ai * HALF + m * 16; const size_t off = (size_t)row * ldc + col0; float sq = 0.f;
#pragma unroll
                for (int bj = 0; bj < 2; ++bj) {
                    const f32x4 h0 = acc[ai][bj][m][0] + *(const f32x4*)(res + off + bj * HALF), h1 = acc[ai][bj][m][1] + *(const f32x4*)(res + off + bj * HALF + 4);
                    sq += (h0[0] * h0[0] + h0[1] * h0[1]) + (h0[2] * h0[2] + h0[3] * h0[3]) + (h1[0] * h1[0] + h1[1] * h1[1]) + (h1[2] * h1[2] + h1[3] * h1[3]);
                    u32x4 w; w.x = cvt_pk_bf16(h0[0], h0[1]); w.y = cvt_pk_bf16(h0[2], h0[3]); w.z = cvt_pk_bf16(h1[0], h1[1]); w.w = cvt_pk_bf16(h1[2], h1[3]);
                    *(u32x4*)(HB + off + bj * HALF) = w;
                    const f32x4 g0 = h0 * gv[bj][0], g1 = h1 * gv[bj][1];
                    int p0 = __builtin_amdgcn_cvt_pk_bf8_f32(g0[0], g0[1], 0, false); p0 = __builtin_amdgcn_cvt_pk_bf8_f32(g0[2], g0[3], p0, true);
                    int p1 = __builtin_amdgcn_cvt_pk_bf8_f32(g1[0], g1[1], 0, false); p1 = __builtin_amdgcn_cvt_pk_bf8_f32(g1[2], g1[3], p1, true);
                    typedef unsigned u32x2 __attribute__((ext_vector_type(2)));
                    *(u32x2*)(XB + off + bj * HALF) = (u32x2){(unsigned)p0, (unsigned)p1}; }
                sq += __shfl_xor(sq, 16); sq += __shfl_xor(sq, 32);
                if (fq == 0) atomicAdd(ssq + row, sq); }
    }
};
struct EpiScaleRow {
    static constexpr bool PERM = true, AFTER_DRAIN = false;
    _Float16* C; int ldc; const float* ssq; float invk, eps;
    __device__ __forceinline__ void operator()(const f32x4 (&acc)[2][2][4][2], const Unit& u, int wr, int wc, int fr, int fq) const {
        typedef _Float16 h2 __attribute__((ext_vector_type(2)));
        const int row0 = u.pm * BM + wr * 64 + fr, col0 = u.pn * BM + wc * 32 + 8 * fq;
#pragma unroll
        for (int ai = 0; ai < 2; ++ai)
#pragma unroll
            for (int m = 0; m < 4; ++m) { const int row = row0 + ai * HALF + m * 16; const size_t off = (size_t)row * ldc + col0; const float rs = 1.f / sqrtf(ssq[row] * invk + eps);
#pragma unroll
                for (int bj = 0; bj < 2; ++bj) { const f32x4 v0 = acc[ai][bj][m][0] * rs, v1 = acc[ai][bj][m][1] * rs;
                    const h2 p0 = {(_Float16)v0[0], (_Float16)v0[1]}, p1 = {(_Float16)v0[2], (_Float16)v0[3]}, p2 = {(_Float16)v1[0], (_Float16)v1[1]}, p3 = {(_Float16)v1[2], (_Float16)v1[3]};
                    u32x4 w; w.x = __builtin_bit_cast(unsigned, p0); w.y = __builtin_bit_cast(unsigned, p1); w.z = __builtin_bit_cast(unsigned, p2); w.w = __builtin_bit_cast(unsigned, p3);
                    *(u32x4*)(C + off + bj * HALF) = w; } }
    }
};
template <class Epi, class Sched, bool ALIGN_EPI = false, bool SP2 = false>
__device__ __forceinline__ void gemm_phase(PG8_LAS unsigned char* lds, const Gemm g, const Sched& S, const Epi& E) {
    const int tid = threadIdx.x, wid = __builtin_amdgcn_readfirstlane(tid >> 6), lane = tid & 63, wr = wid >> 2, wc = wid & 3, fr = lane & 15, fq = lane >> 4;
    const int K = g.K, nt = K / BK;
    unsigned voffA[2], voffB[2];
#pragma unroll
    for (int i = 0; i < 2; ++i) { int R, C; stage_rc(tid * 16 + i * 8192, R, C); const int Rb = Epi::PERM ? ((R & ~31) + perm32(R & 31)) : R;
        voffA[i] = (unsigned)(R * K + C) * 2u; voffB[i] = (unsigned)(Rb * K + C) * 2u; }
    const size_t kstep = (size_t)(BK * 2);
    const size_t hstep = (size_t)HALF * K * 2;
    const size_t tstep = 2 * hstep;
    const unsigned ldsw = (unsigned)wid * 1024u;
    const int aoff = lds_byte(wr * 64 + fr, fq * 8), boff = lds_byte(wc * 32 + fr, fq * 8);
#define PG8_SA(b, h) (((b) * 2 + (h)) * HTB)
#define PG8_SB(b, h) ((4 + (b) * 2 + (h)) * HTB)
#define PG8_STAGE(bufoff, gbase, voff) do { _Pragma("unroll") for (int _i = 0; _i < 2; ++_i) \
        __builtin_amdgcn_global_load_lds((const unsigned*)((const char*)(gbase) + (voff)[_i]), (PG8_LAS unsigned*)(lds + (bufoff) + ldsw + _i * 8192), 16, 0, 0); } while (0)
#define PG8_LDA(dst, b, h) do { _Pragma("unroll") for (int m = 0; m < 4; ++m) _Pragma("unroll") for (int k = 0; k < 2; ++k) dst[m][k] = *(const PG8_LAS bf16x8*)(lds + PG8_SA(b, h) + aoff + m * 2048 + k * 1024); } while (0)
#define PG8_LDB(dst, b, h) do { _Pragma("unroll") for (int n = 0; n < 2; ++n) _Pragma("unroll") for (int k = 0; k < 2; ++k) dst[n][k] = *(const PG8_LAS bf16x8*)(lds + PG8_SB(b, h) + boff + n * 2048 + k * 1024); } while (0)
#define PG8_MMA(ai, bj, At, Bt) do { __builtin_amdgcn_s_setprio(1); _Pragma("unroll") for (int m = 0; m < 4; ++m) _Pragma("unroll") for (int n = 0; n < 2; ++n) _Pragma("unroll") for (int k = 0; k < 2; ++k) \
        acc[ai][bj][m][n] = __builtin_amdgcn_mfma_f32_16x16x32_bf16(Bt[n][k], At[m][k], acc[ai][bj][m][n], 0, 0, 0); __builtin_amdgcn_s_setprio(0); } while (0)
#define PG8_WAIT_V(n) asm volatile("s_waitcnt vmcnt(" #n ")" ::: "memory")
#define PG8_WAIT_L(n) asm volatile("s_waitcnt lgkmcnt(" #n ")" ::: "memory")
#define PG8_BAR __builtin_amdgcn_s_barrier()
#define PG8_SCHED __builtin_amdgcn_sched_barrier(0)
    Unit cur, nxt; int ui = 0;
    if (!S.next(0, cur)) return;
    f32x4 acc[2][2][4][2];
#pragma unroll
    for (int a = 0; a < 2; ++a)
#pragma unroll
        for (int b = 0; b < 2; ++b)
#pragma unroll
            for (int m = 0; m < 4; ++m)
#pragma unroll
                for (int n = 0; n < 2; ++n) acc[a][b][m][n] = (f32x4){0.f, 0.f, 0.f, 0.f};
    bf16x8 At[4][2], B0[2][2], B1[2][2];
    const char* cA = (const char*)g.A + (size_t)cur.pm * tstep; const char* cB = (const char*)g.Bt + (size_t)cur.pn * tstep;
    S.a_ready(cur);
    if constexpr (SP2) {
        PG8_STAGE(PG8_SB(0, 0), cB, voffB); PG8_STAGE(PG8_SB(0, 1), cB + hstep, voffB); PG8_STAGE(PG8_SA(0, 0), cA, voffA); PG8_STAGE(PG8_SA(0, 1), cA + hstep, voffA);
        if (wr == 1) PG8_BAR;
        PG8_WAIT_V(2); PG8_BAR;
        PG8_STAGE(PG8_SB(1, 0), cB + kstep, voffB); PG8_STAGE(PG8_SA(1, 0), cA + kstep, voffA); PG8_STAGE(PG8_SB(1, 1), cB + hstep + kstep, voffB);
        PG8_WAIT_V(6); PG8_BAR;
    } else {
        PG8_STAGE(PG8_SB(0, 0), cB, voffB); PG8_STAGE(PG8_SA(0, 0), cA, voffA); PG8_STAGE(PG8_SB(0, 1), cB + hstep, voffB); PG8_STAGE(PG8_SA(0, 1), cA + hstep, voffA);
        if (wr == 1) PG8_BAR;
        PG8_WAIT_V(4); PG8_BAR;
        PG8_STAGE(PG8_SB(1, 0), cB + kstep, voffB); PG8_STAGE(PG8_SA(1, 0), cA + kstep, voffA); PG8_STAGE(PG8_SB(1, 1), cB + hstep + kstep, voffB);
        PG8_WAIT_V(6); PG8_BAR;
    }
    for (;;) {
        const bool has_next = S.next(ui + 1, nxt);
        const char* nA = has_next ? (const char*)g.A + (size_t)nxt.pm * tstep : cA; const char* nB = has_next ? (const char*)g.Bt + (size_t)nxt.pn * tstep : cB;
        for (int t = 0; t < nt; t += 2) {
            const bool last = (t == nt - 2);
            const char* a1 = cA + (size_t)(t + 1) * kstep;
            const char* a2 = last ? nA : cA + (size_t)(t + 2) * kstep; const char* b2 = last ? nB : cB + (size_t)(t + 2) * kstep;
            const char* a3 = a2 + kstep; const char* b3 = b2 + kstep;
            if (last && has_next) S.a_ready(nxt);
            if constexpr (SP2) {
            PG8_LDB(B0, 0, 0); PG8_LDB(B1, 0, 1); PG8_SCHED; PG8_LDA(At, 0, 0); PG8_STAGE(PG8_SA(1, 1), a1 + hstep, voffA);
            PG8_WAIT_V(8); PG8_WAIT_L(0); PG8_BAR; PG8_MMA(0, 0, At, B0); PG8_MMA(0, 1, At, B1); PG8_BAR; PG8_SCHED;
            PG8_LDA(At, 0, 1); PG8_STAGE(PG8_SB(0, 0), b2, voffB); PG8_STAGE(PG8_SB(0, 1), b2 + hstep, voffB); PG8_STAGE(PG8_SA(0, 0), a2, voffA);
            PG8_WAIT_V(8); PG8_WAIT_L(0); PG8_BAR; PG8_MMA(1, 0, At, B0); PG8_MMA(1, 1, At, B1); PG8_BAR; PG8_SCHED;
            PG8_LDB(B0, 1, 0); PG8_LDB(B1, 1, 1); PG8_SCHED; PG8_LDA(At, 1, 0); PG8_STAGE(PG8_SA(0, 1), a2 + hstep, voffA);
            PG8_WAIT_V(8); PG8_WAIT_L(0); PG8_BAR; PG8_MMA(0, 0, At, B0); PG8_MMA(0, 1, At, B1); PG8_BAR; PG8_SCHED;
            PG8_LDA(At, 1, 1); PG8_STAGE(PG8_SB(1, 0), b3, voffB); PG8_STAGE(PG8_SB(1, 1), b3 + hstep, voffB); PG8_STAGE(PG8_SA(1, 0), a3, voffA);
            PG8_WAIT_V(8); PG8_WAIT_L(0); PG8_BAR; PG8_MMA(1, 0, At, B0); PG8_MMA(1, 1, At, B1); PG8_BAR; PG8_SCHED;
            } else {
            PG8_LDB(B0, 0, 0); PG8_SCHED; PG8_LDA(At, 0, 0); PG8_STAGE(PG8_SA(1, 1), a1 + hstep, voffA);
            PG8_WAIT_L(8); PG8_BAR; PG8_WAIT_L(0); PG8_MMA(0, 0, At, B0); PG8_BAR; PG8_SCHED;
            PG8_LDB(B1, 0, 1); PG8_STAGE(PG8_SB(0, 0), b2, voffB);
            PG8_BAR; PG8_WAIT_L(0); PG8_MMA(0, 1, At, B1); PG8_BAR;
            PG8_LDA(At, 0, 1); PG8_STAGE(PG8_SA(0, 0), a2, voffA);
            PG8_BAR; PG8_WAIT_L(0); PG8_MMA(1, 0, At, B0); PG8_BAR; PG8_SCHED;
            PG8_STAGE(PG8_SB(0, 1), b2 + hstep, voffB);
            PG8_WAIT_V(6); PG8_BAR; PG8_MMA(1, 1, At, B1); PG8_BAR;
            PG8_LDB(B0, 1, 0); PG8_SCHED; PG8_LDA(At, 1, 0); PG8_STAGE(PG8_SA(0, 1), a2 + hstep, voffA);
            PG8_WAIT_L(8); PG8_BAR; PG8_WAIT_L(0); PG8_MMA(0, 0, At, B0); PG8_BAR; PG8_SCHED;
            PG8_LDB(B1, 1, 1); PG8_STAGE(PG8_SB(1, 0), b3, voffB);
            PG8_BAR; PG8_WAIT_L(0); PG8_MMA(0, 1, At, B1); PG8_BAR;
            PG8_LDA(At, 1, 1); PG8_STAGE(PG8_SA(1, 0), a3, voffA);
            PG8_BAR; PG8_WAIT_L(0); PG8_MMA(1, 0, At, B0); PG8_BAR; PG8_SCHED;
            PG8_STAGE(PG8_SB(1, 1), b3 + hstep, voffB);
            PG8_WAIT_V(6); PG8_BAR; PG8_MMA(1, 1, At, B1); PG8_BAR;
            }
        }
        if constexpr (ALIGN_EPI) { if (wr == 0) PG8_BAR; }
        if constexpr (!Epi::AFTER_DRAIN) { E(acc, cur, wr, wc, fr, fq); S.done(cur); }
        if (!has_next) break;
#pragma unroll
        for (int a = 0; a < 2; ++a)
#pragma unroll
            for (int b = 0; b < 2; ++b)
#pragma unroll
                for (int m = 0; m < 4; ++m)
#pragma unroll
                    for (int n = 0; n < 2; ++n) acc[a][b][m][n] = (f32x4){0.f, 0.f, 0.f, 0.f};
        cur = nxt; cA = nA; cB = nB; ++ui;
        if constexpr (ALIGN_EPI) { if (wr == 1) PG8_BAR; }
    }
    PG8_WAIT_V(0);
    if constexpr (!ALIGN_EPI) { if (wr == 0) PG8_BAR; }
    PG8_BAR;
    if constexpr (Epi::AFTER_DRAIN) { E.fused(acc, cur, wr, wc, fr, fq, lds, wid, lane); S.done(cur); }
#undef PG8_SA
#undef PG8_SB
#undef PG8_STAGE
#undef PG8_LDA
#undef PG8_LDB
#undef PG8_MMA
#undef PG8_WAIT_V
#undef PG8_WAIT_L
#undef PG8_BAR
#undef PG8_SCHED
}
}
#ifndef PG8_SP2
#define PG8_SP2 true
#endif
#ifndef PG8_ALIGN
#define PG8_ALIGN true
#endif

constexpr int NWAVES = 8;
constexpr int NTOK = 32768, DM = 1024, SEQ = 2048, NBATCH = 16, INW = 3584;
constexpr int C_DQ = 0, C_DK = 512, C_DV = 1024, C_HQ = 1536, C_HF = 2048, C_HI = 2560, C_HG = 3072;
constexpr float EPS = 1e-6f;
constexpr float QSCALE = 0.125f * 1.4426950408889634f;
constexpr float LAM_INIT = 0.2f;
constexpr int NEXP_SEL = 128;

constexpr size_t MiB = 1u << 20;
constexpr size_t WS_CTL = 0, CTL_ZERO_BYTES = 1 * MiB;
constexpr size_t WS_SMALL = 1 * MiB;
constexpr size_t WS_WIN = 2 * MiB;
constexpr size_t WS_WOUT = 10 * MiB;
constexpr size_t WS_W2 = 12 * MiB;
constexpr size_t WS_U8 = 17 * MiB;
constexpr size_t WS_V8 = 33 * MiB;
constexpr size_t WS_SU = 49 * MiB;
constexpr size_t WS_SV = 49 * MiB + 512 * 1024;
constexpr size_t WS_X8 = 50 * MiB;
constexpr size_t WS_SX = 116 * MiB;
constexpr size_t WS_GSU = 120 * MiB;
constexpr size_t WS_HN = 84 * MiB;
constexpr size_t WS_PROJ = 148 * MiB;
constexpr size_t WS_HN2 = 148 * MiB;
constexpr size_t WS_SC = 212 * MiB;
constexpr size_t WS_PO = 212 * MiB;
constexpr size_t WS_IDX = 468 * MiB;
constexpr size_t WS_GATE = 484 * MiB;
constexpr size_t WS_END = 500 * MiB;
constexpr int SM_LB = 0, SM_LAM = 512, SM_BIAS = 1024;
constexpr int CW_BAR = 4096;
constexpr int CW_ATTQ = 8192;
constexpr int CW_SSQ = 131072;

constexpr int RING_OFF = 0, RING_BYTES = 139264;
constexpr int LDSCTL_OFF = RING_BYTES, MISC_OFF = LDSCTL_OFF + 320;
constexpr int LDS_BYTES = 147456;

#define GAS __attribute__((address_space(1)))
#define LAS __attribute__((address_space(3)))
typedef unsigned short bf16;
typedef unsigned v4u __attribute__((ext_vector_type(4)));
typedef unsigned v2u __attribute__((ext_vector_type(2)));
typedef float f32x4 __attribute__((ext_vector_type(4)));
typedef short bf16x8 __attribute__((ext_vector_type(8)));
typedef GAS unsigned gu32;
typedef long l2 __attribute__((ext_vector_type(2)));
typedef int v4i __attribute__((ext_vector_type(4)));
#define RLX_AGENT __ATOMIC_RELAXED, __HIP_MEMORY_SCOPE_AGENT
#define LDS_WAIT() asm volatile("s_waitcnt lgkmcnt(0)" ::: "memory")
#define VM_WAIT() asm volatile("s_waitcnt vmcnt(0)" ::: "memory")
__device__ __forceinline__ unsigned f2bf(float f) { unsigned u = __builtin_bit_cast(unsigned, f); return (u + 0x7fffu + ((u >> 16) & 1u)) >> 16; }
__device__ __forceinline__ unsigned pk2(float lo, float hi) { return f2bf(lo) | (f2bf(hi) << 16); }
__device__ __forceinline__ float bflo(unsigned w) { return __builtin_bit_cast(float, w << 16); }
__device__ __forceinline__ float bfhi(unsigned w) { return __builtin_bit_cast(float, w & 0xffff0000u); }

#define XB_TMO      128
#define XB_XCNT(j)  (256  + 64 * (j))
#define XB_XSUB(j)  (1280 + 64 * (j))
#define XB_XGEN(j)  (2304 + 64 * (j))
#define XB_TOP      3328
#define XB_TOPGEN   3392
#define XCD_BAR_WORDS 3456
#define XB_SPIN_CAP (1u << 18)
__device__ __forceinline__ unsigned xb_ld(unsigned* p)              { return __hip_atomic_load(p, __ATOMIC_RELAXED, __HIP_MEMORY_SCOPE_AGENT); }
__device__ __forceinline__ unsigned xb_add(unsigned* p, unsigned v) { return __hip_atomic_fetch_add(p, v, __ATOMIC_RELAXED, __HIP_MEMORY_SCOPE_AGENT); }
__device__ __forceinline__ unsigned xb_xcc_id() { return (unsigned)__builtin_amdgcn_s_getreg((3 << 11) | 20) & 0xFu; }
#define XB_SPIN(cond, bar) do { unsigned _sp = 0; while (cond) { __builtin_amdgcn_s_sleep(1); \
    if ((++_sp & 255u) == 0u) { if (xb_ld(&(bar)[XB_TMO])) break; if (_sp > XB_SPIN_CAP) { atomicAdd(&(bar)[XB_TMO], 1u); break; } } } } while (0)
struct XcdBarrier { unsigned* bar; unsigned x; volatile LAS unsigned* st; };
__device__ __forceinline__ XcdBarrier xcd_barrier_post(unsigned* bar, volatile LAS unsigned* st) {
    XcdBarrier b; b.bar = bar; b.x = xb_xcc_id(); b.st = st;
    if (threadIdx.x == 0) (void)xb_add(&bar[XB_XCNT(b.x)], 1u);
    return b;
}
__device__ __forceinline__ void xcd_barrier_complete(unsigned* bar, unsigned x, unsigned& nloc, unsigned& nx) {
    const unsigned G = gridDim.x * gridDim.y * gridDim.z;
    unsigned sum, cnt, mine, sp = 0u;
    for (;;) {
        sum = 0u; cnt = 0u; mine = 0u;
#pragma unroll
        for (unsigned j = 0; j < 16; ++j) { const unsigned c = xb_ld(&bar[XB_XCNT(j)]); sum += c; cnt += (c > 0u) ? 1u : 0u; mine = (j == x) ? c : mine; }
        if (sum == G) break;
        __builtin_amdgcn_s_sleep(1);
        if ((++sp & 255u) == 0u) { if (xb_ld(&bar[XB_TMO])) break; if (sp > XB_SPIN_CAP) { atomicAdd(&bar[XB_TMO], 1u); break; } }
    }
    nloc = mine > 0u ? mine : 1u; nx = cnt > 0u ? cnt : 1u;
}
__device__ __forceinline__ void xcd_barrier(const XcdBarrier& b) {
    asm volatile("s_waitcnt vmcnt(0)" ::: "memory");
    __syncthreads();
    if (threadIdx.x == 0) {
        unsigned* bar = b.bar;
        __builtin_amdgcn_s_waitcnt(0);
        unsigned nloc = b.st[0], nx = b.st[1];
        if (nloc == 0u) { xcd_barrier_complete(bar, b.x, nloc, nx); b.st[0] = nloc; b.st[1] = nx; }
        const unsigned old = xb_add(&bar[XB_XSUB(b.x)], 1u);
        const unsigned gen = old / nloc;
        if (old + 1u == (gen + 1u) * nloc) {
            __builtin_amdgcn_fence(__ATOMIC_RELEASE, "agent");
            asm volatile("s_waitcnt vmcnt(0)" ::: "memory");
            const unsigned og = xb_add(&bar[XB_TOP], 1u);
            const unsigned tg = og / nx;
            if (og + 1u == (tg + 1u) * nx) xb_add(&bar[XB_TOPGEN], 1u);
            else XB_SPIN(xb_ld(&bar[XB_TOPGEN]) == tg, bar);
            __builtin_amdgcn_fence(__ATOMIC_ACQUIRE, "agent");
            xb_add(&bar[XB_XGEN(b.x)], 1u);
            asm volatile("s_waitcnt vmcnt(0)" ::: "memory");
        } else {
            XB_SPIN(xb_ld(&bar[XB_XGEN(b.x)]) == gen, bar);
            __builtin_amdgcn_fence(__ATOMIC_ACQUIRE, "agent");
            asm volatile("s_waitcnt vmcnt(0)" ::: "memory");
        }
    }
    __syncthreads();
}

#define SCHED_FENCE() __builtin_amdgcn_sched_barrier(0)
__device__ __forceinline__ float gelu_as(float v) {
    const float av = fabsf(v), t = __builtin_amdgcn_rcpf(av * 0.2316418882f + 1.0f);
    float q = t * 0.5307027145f + (-0.7265760135f); q = q * t + 0.7107068705f; q = q * t + (-0.142248368f); q = q * t + 0.127414796f; q = q * t;
    const float e = __builtin_amdgcn_exp2f((v * v) * (-0.72134752044f));
    const float mm = v * (q * e);
    return v < 0.f ? mm : v - mm;
}
struct Frame {
    LAS unsigned char* lds;
    volatile LAS unsigned* MISC;
    int tid, lane, wave, vcu, G;
    const float* in[18]; float* out; unsigned char* ws;
};
__device__ __forceinline__ float wave_sum(float v) {
#pragma unroll
    for (int o = 1; o < 64; o <<= 1) v += __shfl_xor(v, o);
    return v;
}
__device__ __forceinline__ float sigmoidf_(float x) { return 1.f / (1.f + __expf(-x)); }

__device__ __forceinline__ void p0_transpose_item(const float* W, int K, int N, bf16* WT, int row_off, LAS float* scr, int item, int lane) {
    const int nblk = N / 32, kb = item / nblk, nb = item % nblk, k0 = 64 * kb, n0 = 32 * nb;
#pragma unroll 8
    for (int i = 0; i < 32; ++i) { const int kk = 2 * i + (lane >> 5); scr[kk * 33 + (lane & 31)] = W[(size_t)(k0 + kk) * N + n0 + (lane & 31)]; }
    LDS_WAIT(); asm volatile("" ::: "memory");
    const int c = lane & 7;
#pragma unroll
    for (int j = 0; j < 4; ++j) { const int n = (lane >> 3) + 8 * j; const LAS float* s = scr + (8 * c) * 33 + n;
        v4u o; o.x = pk2(s[0 * 33], s[1 * 33]); o.y = pk2(s[2 * 33], s[3 * 33]); o.z = pk2(s[4 * 33], s[5 * 33]); o.w = pk2(s[6 * 33], s[7 * 33]);
        *(GAS v4u*)(WT + (size_t)(row_off + n0 + n) * K + k0 + 8 * c) = o; }
    LDS_WAIT(); asm volatile("" ::: "memory");
}

__device__ __forceinline__ void quant_vals_fp8(const f32x4 (&v)[4], unsigned char* dst, float* dq, int lane, size_t slice_stride) {
    float mx = 0.f;
#pragma unroll
    for (int j = 0; j < 4; ++j) mx = fmaxf(mx, fmaxf(fmaxf(fabsf(v[j].x), fabsf(v[j].y)), fmaxf(fabsf(v[j].z), fabsf(v[j].w))));
#pragma unroll
    for (int o = 1; o < 64; o <<= 1) mx = fmaxf(mx, __shfl_xor(mx, o));
    const float qs = mx > 0.f ? 224.f / mx : 1.f;
#pragma unroll
    for (int j = 0; j < 4; ++j) { int p = __builtin_amdgcn_cvt_pk_fp8_f32(v[j].x * qs, v[j].y * qs, 0, false); p = __builtin_amdgcn_cvt_pk_fp8_f32(v[j].z * qs, v[j].w * qs, p, true);
        const int d = 4 * lane + 256 * j; *(GAS unsigned*)(dst + (slice_stride ? (size_t)(d >> 7) * slice_stride + (d & 127) : (size_t)d)) = (unsigned)p; }
    if (lane == 0) *dq = mx > 0.f ? mx * (1.f / 224.f) : 1.f;
}
__device__ __forceinline__ void quant_row_fp8(const float* src, unsigned char* dst, float* dq, int lane, size_t slice_stride) {
    const GAS f32x4* xr = (const GAS f32x4*)src + lane; f32x4 v[4];
#pragma unroll
    for (int j = 0; j < 4; ++j) v[j] = xr[64 * j];
    quant_vals_fp8(v, dst, dq, lane, slice_stride);
}
__device__ __forceinline__ void p0_prologue(Frame& F) {
    LAS float* scr = (LAS float*)(F.lds + RING_OFF + F.wave * 16384);
    const int gw = F.vcu * NWAVES + F.wave, NGW = F.G * NWAVES;
    bf16* WinT = (bf16*)(F.ws + WS_WIN); bf16* WoutT = (bf16*)(F.ws + WS_WOUT); bf16* W2T = (bf16*)(F.ws + WS_W2);
    float* small = (float*)(F.ws + WS_SMALL);
    if (blockIdx.x == 0) {
        const int t = F.tid;
        { const float l0 = F.in[9][t], l1 = F.in[9][512 + t]; small[SM_LB + t] = 1.f / (1.f + expf(l1 - l0)); }
        { const int h = t >> 7, n = t & 127; int bk;
          if (n < 16) bk = n; else { bk = 16 + (int)(logf((float)n * (1.f / 16.f)) / logf(8.f) * 16.f); bk = bk > 31 ? 31 : bk; }
          small[SM_BIAS + t] = F.in[8][bk * 4 + h] * 1.4426950408889634f; }
        if (F.wave == 0) {
            const float a = wave_sum(F.in[3][F.lane] * F.in[4][F.lane]), b = wave_sum(F.in[5][F.lane] * F.in[6][F.lane]);
            if (F.lane == 0) small[SM_LAM] = expf(a) - expf(b) + LAM_INIT;
        }
    }
    constexpr int I_IN = (DM / 64) * (INW / 32), I_OUT = (DM / 64) * (DM / 32);
    for (int it = gw; it < I_IN + I_OUT; it += NGW) {
        if (it < I_IN) p0_transpose_item(F.in[2], DM, INW, WinT, 0, scr, it, F.lane);
        else p0_transpose_item(F.in[11], DM, DM, WoutT, 0, scr, it - I_IN, F.lane);
    }
    for (int u = F.vcu; u < 256; u += F.G) {
        const int hc = u >> 4, kb = u & 15, k = kb * 64 + F.lane;
        const GAS f32x4* wrow = (const GAS f32x4*)(F.in[13] + (size_t)k * 2048 + hc * 128);
        float a[16];
#pragma unroll
        for (int nn = 0; nn < 16; ++nn) a[nn] = 0.f;
        const float* kr = F.in[14] + ((size_t)hc * 128 + F.wave * 16) * 128;
        for (int i = 0; i < 32; ++i) {
            const f32x4 w = wrow[i];
#pragma unroll
            for (int nn = 0; nn < 16; ++nn) { const float* kk = kr + nn * 128 + 4 * i; a[nn] += (kk[0] * w.x + kk[1] * w.y) + (kk[2] * w.z + kk[3] * w.w); }
        }
        const float g2k = F.in[12][k];
#pragma unroll
        for (int nn = 0; nn < 16; ++nn) W2T[((size_t)hc * 128 + F.wave * 16 + nn) * DM + k] = (bf16)f2bf(a[nn] * g2k);
    }
    bf16* HN = (bf16*)(F.ws + WS_HN);
    for (int m = gw; m < NTOK; m += 2 * NGW) {
        const int m2 = m + NGW;
        const GAS f32x4* xa = (const GAS f32x4*)(F.in[0] + (size_t)m * DM) + F.lane; const GAS f32x4* xb = (const GAS f32x4*)(F.in[0] + (size_t)(m2 < NTOK ? m2 : m) * DM) + F.lane;
        const GAS f32x4* gr = (const GAS f32x4*)F.in[1] + F.lane;
        f32x4 va[4], vb[4]; float sa = 0.f, sb = 0.f;
#pragma unroll
        for (int j = 0; j < 4; ++j) { va[j] = xa[64 * j]; vb[j] = xb[64 * j]; }
#pragma unroll
        for (int j = 0; j < 4; ++j) { sa += (va[j].x * va[j].x + va[j].y * va[j].y) + (va[j].z * va[j].z + va[j].w * va[j].w); sb += (vb[j].x * vb[j].x + vb[j].y * vb[j].y) + (vb[j].z * vb[j].z + vb[j].w * vb[j].w); }
#pragma unroll
        for (int o = 1; o < 64; o <<= 1) { sa += __shfl_xor(sa, o); sb += __shfl_xor(sb, o); }
        const float ra = 1.f / sqrtf(sa * (1.f / DM) + EPS), rb = 1.f / sqrtf(sb * (1.f / DM) + EPS);
        GAS unsigned long long* oa = (GAS unsigned long long*)(HN + (size_t)m * DM) + F.lane; GAS unsigned long long* ob = (GAS unsigned long long*)(HN + (size_t)m2 * DM) + F.lane;
#pragma unroll
        for (int j = 0; j < 4; ++j) { const f32x4 gg = gr[64 * j];
            oa[64 * j] = (unsigned long long)pk2(va[j].x * ra * gg.x, va[j].y * ra * gg.y) | ((unsigned long long)pk2(va[j].z * ra * gg.z, va[j].w * ra * gg.w) << 32);
            if (m2 < NTOK) ob[64 * j] = (unsigned long long)pk2(vb[j].x * rb * gg.x, vb[j].y * rb * gg.y) | ((unsigned long long)pk2(vb[j].z * rb * gg.z, vb[j].w * rb * gg.w) << 32); }
    }
}


constexpr int QCHUNKS = 2 * 16384 / 64;
__device__ __forceinline__ void quant_chunk(Frame& F, int c) {
    unsigned char* U8 = F.ws + WS_U8; unsigned char* V8 = F.ws + WS_V8; float* SU = (float*)(F.ws + WS_SU); float* SV = (float*)(F.ws + WS_SV);
#pragma unroll 1
    for (int k = 0; k < 8; ++k) { const int rr = 64 * c + 8 * F.wave + k;
        if (rr < 16384) quant_row_fp8(F.in[15] + (size_t)rr * DM, U8 + (size_t)rr * 128, SU + rr, F.lane, (size_t)16384 * 128);
        else { const int e = rr - 16384; quant_row_fp8(F.in[16] + (size_t)e * DM, V8 + (size_t)e * 128, SV + e, F.lane, (size_t)16384 * 128); } }
}

__device__ __forceinline__ void quant_drain(Frame& F) {
    unsigned* qctr = (unsigned*)(F.ws + WS_CTL) + CW_ATTQ + 128;
    for (;;) {
        __syncthreads();
        if (F.tid == 0) F.MISC[13] = __hip_atomic_fetch_add(qctr, 1u, __ATOMIC_RELAXED, __HIP_MEMORY_SCOPE_AGENT);
        __syncthreads();
        const int qc = (int)F.MISC[13];
        if (qc >= QCHUNKS) break;
        quant_chunk(F, qc);
    }
}

typedef float f32x16 __attribute__((ext_vector_type(16)));
typedef short s16x4 __attribute__((ext_vector_type(4)));
typedef short v4i16_t __attribute__((ext_vector_type(4)));
typedef float f32x2_t __attribute__((ext_vector_type(2))); typedef __bf16 bf16x2_t __attribute__((ext_vector_type(2)));
__device__ __forceinline__ unsigned cvtpk_bf16(float lo, float hi) { f32x2_t v = {lo, hi}; bf16x2_t b = __builtin_convertvector(v, bf16x2_t); return __builtin_bit_cast(unsigned, b); }
__device__ __forceinline__ float xhalf_max(float v) { return fmaxf(v, __shfl_xor(v, 32)); }
__device__ __forceinline__ float xhalf_sum(float v) { return v + __shfl_xor(v, 32); }
__device__ __forceinline__ float max3f_(float a, float b, float c) { float r; asm("v_max3_f32 %0, %1, %2, %3" : "=v"(r) : "v"(a), "v"(b), "v"(c)); return r; }
constexpr int AT_KP = 144, AT_VP = 320, AT_K1 = 64 * AT_KP, AT_V = 2 * AT_K1, AT_BUF = AT_V + 64 * AT_VP;
constexpr int AT_XO = 0, AT_YB = 65536, AT_YP = 272, AT_TAB = 100352, AT_Q = 100864;
static_assert(AT_Q + 8 * 4096 <= RING_BYTES, "attention LDS map");
__device__ __forceinline__ void attn_mfma(Frame& F, int qslot) {
    const bf16* PROJ = (const bf16*)(F.ws + WS_PROJ); bf16* MIXED = (bf16*)(F.ws + WS_HN);
    const float* small = (const float*)(F.ws + WS_SMALL);
    LAS unsigned char* lds = F.lds;
    LAS float* TAB = (LAS float*)(lds + AT_TAB);
    const int tid = F.tid, lane = F.lane, wave = F.wave, map = wave >> 2, qt = wave & 3, r32 = lane & 31, hi = lane >> 5;
    const float lam = small[SM_LAM];
    const int koff = map * AT_K1 + r32 * AT_KP + hi * 16;
    const int voff = AT_V + (4 * hi + ((lane & 15) >> 2)) * AT_VP + (16 * ((lane >> 4) & 1) + 4 * (lane & 3)) * 2;
    unsigned* qctr = (unsigned*)(F.ws + WS_CTL) + CW_ATTQ + 64 * qslot;
    for (;;) {
        __syncthreads();
        if (tid == 0) F.MISC[12] = __hip_atomic_fetch_add(qctr, 1u, __ATOMIC_RELAXED, __HIP_MEMORY_SCOPE_AGENT);
        __syncthreads();
        const int L = (int)F.MISC[12];
        if (L >= 1024) break;
        const int qb = 15 - (L >> 6), bh = L & 63;
        const int b = bh >> 2, h = bh & 3, q0 = qb * 128; const size_t tok0 = (size_t)b * SEQ;
        const int NT = (q0 + 128) / 64;
        if (tid < 128) TAB[tid] = small[SM_BIAS + h * 128 + tid];
        LAS unsigned char* qlds = lds + AT_Q + wave * 4096 + lane * 16;
        { const bf16* qrow = PROJ + (tok0 + q0 + 32 * qt + r32) * INW + C_DQ + h * 128 + map * 64 + 8 * hi;
#pragma unroll
          for (int s4 = 0; s4 < 4; ++s4) *(LAS bf16x8*)(qlds + 1024 * s4) = *(const GAS bf16x8*)(qrow + 16 * s4); }
        const bf16* ksrc = PROJ + (tok0 + (tid >> 4)) * INW + C_DK + h * 128 + (tid & 15) * 8;
        const bf16* vsrc = PROJ + (tok0 + (tid >> 4)) * INW + C_DV + h * 128 + (tid & 15) * 8;
        const int kdst = ((tid & 15) >> 3) * AT_K1 + (tid >> 4) * AT_KP + (tid & 7) * 16, vdst = AT_V + (tid >> 4) * AT_VP + (tid & 15) * 16;
        v4u krA[2], vrA[2], krB[2], vrB[2];
#pragma unroll
        for (int i = 0; i < 2; ++i) { krB[i] = *(const GAS v4u*)(ksrc + (size_t)(32 * i) * INW); vrB[i] = *(const GAS v4u*)(vsrc + (size_t)(32 * i) * INW); }
#pragma unroll
        for (int i = 0; i < 2; ++i) { krA[i] = *(const GAS v4u*)(ksrc + (size_t)(64 + 32 * i) * INW); vrA[i] = *(const GAS v4u*)(vsrc + (size_t)(64 + 32 * i) * INW); }
#pragma unroll
        for (int i = 0; i < 2; ++i) { *(LAS v4u*)(lds + kdst + 32 * i * AT_KP) = krB[i]; *(LAS v4u*)(lds + vdst + 32 * i * AT_VP) = vrB[i]; }
        __syncthreads();
        const float bfar = TAB[127];
        f32x16 o[4];
#pragma unroll
        for (int mt = 0; mt < 4; ++mt) o[mt] = (f32x16){0.f,0.f,0.f,0.f,0.f,0.f,0.f,0.f,0.f,0.f,0.f,0.f,0.f,0.f,0.f,0.f};
        float mrun = -INFINITY, lsum = 0.f;
        const int qlo = q0 + 32 * qt, qpos = qlo + r32;
#pragma unroll
        for (int i = 0; i < 2; ++i) { if (2 < NT) { krB[i] = *(const GAS v4u*)(ksrc + (size_t)(128 + 32 * i) * INW); vrB[i] = *(const GAS v4u*)(vsrc + (size_t)(128 + 32 * i) * INW); } }
        for (int j2 = 0; j2 < NT; j2 += 2) {
          { const int j = j2;
            const int bo = (j & 1) * AT_BUF, bn = ((j + 1) & 1) * AT_BUF;
            if (64 * j <= qlo + 31) {
                f32x16 s0 = (f32x16){0.f,0.f,0.f,0.f,0.f,0.f,0.f,0.f,0.f,0.f,0.f,0.f,0.f,0.f,0.f,0.f}, s1 = s0;
#pragma unroll
                for (int s4 = 0; s4 < 4; ++s4) {
                    const bf16x8 a0 = *(const LAS bf16x8*)(lds + bo + koff + 32 * s4), a1 = *(const LAS bf16x8*)(lds + bo + koff + 32 * AT_KP + 32 * s4);
                    const bf16x8 qfr = *(const LAS bf16x8*)(qlds + 1024 * s4);
                    s0 = __builtin_amdgcn_mfma_f32_32x32x16_bf16(a0, qfr, s0, 0, 0, 0);
                    s1 = __builtin_amdgcn_mfma_f32_32x32x16_bf16(a1, qfr, s1, 0, 0, 0);
                }
                float tm, cadd;
                if (qlo - (64 * j + 63) < 127) {
                    const int kb = 64 * j + 4 * hi; tm = -INFINITY;
#pragma unroll
                    for (int r = 0; r < 16; ++r) { const int n0 = qpos - (kb + (r & 3) + 8 * (r >> 2)), n1 = n0 - 32;
                        float b0 = TAB[n0 > 127 ? 127 : (n0 < 0 ? 0 : n0)], b1 = TAB[n1 > 127 ? 127 : (n1 < 0 ? 0 : n1)];
                        asm volatile("" : "+v"(b0), "+v"(b1));
                        s0[r] = n0 < 0 ? -INFINITY : s0[r] + b0; s1[r] = n1 < 0 ? -INFINITY : s1[r] + b1; tm = max3f_(tm, s0[r], s1[r]); }
                    cadd = 0.f;
                } else {
                    tm = max3f_(s0[0], s1[0], s0[1]);
#pragma unroll
                    for (int r = 1; r < 15; ++r) tm = max3f_(tm, s1[r], s0[r + 1]);
                    tm = fmaxf(tm, s1[15]);
                    tm += bfar; cadd = bfar;
                }
                tm = xhalf_max(tm);
                if (__any(tm > mrun + 8.f)) {
                    const float mnew = fmaxf(mrun, tm), alpha = __builtin_amdgcn_exp2f(mrun - mnew);
                    lsum *= alpha; mrun = mnew;
#pragma unroll
                    for (int mt = 0; mt < 4; ++mt) o[mt] = o[mt] * alpha;
                }
                const float c = cadd - mrun; float psum = 0.f;
#pragma unroll
                for (int r = 0; r < 16; ++r) { s0[r] = __builtin_amdgcn_exp2f(s0[r] + c); s1[r] = __builtin_amdgcn_exp2f(s1[r] + c); psum += s0[r] + s1[r]; }
                lsum += psum;
#pragma unroll
                for (int kt2 = 0; kt2 < 2; ++kt2)
#pragma unroll
                    for (int sp = 0; sp < 2; ++sp) {
                        v4u pw;
                        if (kt2 == 0) { pw.x = cvtpk_bf16(s0[8 * sp], s0[8 * sp + 1]); pw.y = cvtpk_bf16(s0[8 * sp + 2], s0[8 * sp + 3]); pw.z = cvtpk_bf16(s0[8 * sp + 4], s0[8 * sp + 5]); pw.w = cvtpk_bf16(s0[8 * sp + 6], s0[8 * sp + 7]); }
                        else          { pw.x = cvtpk_bf16(s1[8 * sp], s1[8 * sp + 1]); pw.y = cvtpk_bf16(s1[8 * sp + 2], s1[8 * sp + 3]); pw.z = cvtpk_bf16(s1[8 * sp + 4], s1[8 * sp + 5]); pw.w = cvtpk_bf16(s1[8 * sp + 6], s1[8 * sp + 7]); }
                        const bf16x8 pf = __builtin_bit_cast(bf16x8, pw);
#pragma unroll
                        for (int mt = 0; mt < 4; ++mt) {
                            LAS unsigned char* vp = lds + bo + voff + (32 * kt2 + 16 * sp) * AT_VP + 64 * mt;
                            const s16x4 lo = __builtin_bit_cast(s16x4, __builtin_amdgcn_ds_read_tr16_b64_v4i16((LAS v4i16_t*)vp));
                            const s16x4 hi4 = __builtin_bit_cast(s16x4, __builtin_amdgcn_ds_read_tr16_b64_v4i16((LAS v4i16_t*)(vp + 8 * AT_VP)));
                            const bf16x8 af = (bf16x8){lo[0], lo[1], lo[2], lo[3], hi4[0], hi4[1], hi4[2], hi4[3]};
                            o[mt] = __builtin_amdgcn_mfma_f32_32x32x16_bf16(af, pf, o[mt], 0, 0, 0);
                        }
                    }
            }
            if (j + 1 < NT) {
#pragma unroll
                for (int i = 0; i < 2; ++i) { *(LAS v4u*)(lds + bn + kdst + 32 * i * AT_KP) = krA[i]; *(LAS v4u*)(lds + bn + vdst + 32 * i * AT_VP) = vrA[i]; }
                if (j + 3 < NT) {
#pragma unroll
                    for (int i = 0; i < 2; ++i) { krA[i] = *(const GAS v4u*)(ksrc + (size_t)(64 * (j + 3) + 32 * i) * INW); vrA[i] = *(const GAS v4u*)(vsrc + (size_t)(64 * (j + 3) + 32 * i) * INW); }
                }
            }
            __syncthreads();
                  }
          { const int j = j2 + 1;
            const int bo = (j & 1) * AT_BUF, bn = ((j + 1) & 1) * AT_BUF;
            if (64 * j <= qlo + 31) {
                f32x16 s0 = (f32x16){0.f,0.f,0.f,0.f,0.f,0.f,0.f,0.f,0.f,0.f,0.f,0.f,0.f,0.f,0.f,0.f}, s1 = s0;
#pragma unroll
                for (int s4 = 0; s4 < 4; ++s4) {
                    const bf16x8 a0 = *(const LAS bf16x8*)(lds + bo + koff + 32 * s4), a1 = *(const LAS bf16x8*)(lds + bo + koff + 32 * AT_KP + 32 * s4);
                    const bf16x8 qfr = *(const LAS bf16x8*)(qlds + 1024 * s4);
                    s0 = __builtin_amdgcn_mfma_f32_32x32x16_bf16(a0, qfr, s0, 0, 0, 0);
                    s1 = __builtin_amdgcn_mfma_f32_32x32x16_bf16(a1, qfr, s1, 0, 0, 0);
                }
                float tm, cadd;
                if (qlo - (64 * j + 63) < 127) {
                    const int kb = 64 * j + 4 * hi; tm = -INFINITY;
#pragma unroll
                    for (int r = 0; r < 16; ++r) { const int n0 = qpos - (kb + (r & 3) + 8 * (r >> 2)), n1 = n0 - 32;
                        float b0 = TAB[n0 > 127 ? 127 : (n0 < 0 ? 0 : n0)], b1 = TAB[n1 > 127 ? 127 : (n1 < 0 ? 0 : n1)];
                        asm volatile("" : "+v"(b0), "+v"(b1));
                        s0[r] = n0 < 0 ? -INFINITY : s0[r] + b0; s1[r] = n1 < 0 ? -INFINITY : s1[r] + b1; tm = max3f_(tm, s0[r], s1[r]); }
                    cadd = 0.f;
                } else {
                    tm = max3f_(s0[0], s1[0], s0[1]);
#pragma unroll
                    for (int r = 1; r < 15; ++r) tm = max3f_(tm, s1[r], s0[r + 1]);
                    tm = fmaxf(tm, s1[15]);
                    tm += bfar; cadd = bfar;
                }
                tm = xhalf_max(tm);
                if (__any(tm > mrun + 8.f)) {
                    const float mnew = fmaxf(mrun, tm), alpha = __builtin_amdgcn_exp2f(mrun - mnew);
                    lsum *= alpha; mrun = mnew;
#pragma unroll
                    for (int mt = 0; mt < 4; ++mt) o[mt] = o[mt] * alpha;
                }
                const float c = cadd - mrun; float psum = 0.f;
#pragma unroll
                for (int r = 0; r < 16; ++r) { s0[r] = __builtin_amdgcn_exp2f(s0[r] + c); s1[r] = __builtin_amdgcn_exp2f(s1[r] + c); psum += s0[r] + s1[r]; }
                lsum += psum;
#pragma unroll
                for (int kt2 = 0; kt2 < 2; ++kt2)
#pragma unroll
                    for (int sp = 0; sp < 2; ++sp) {
                        v4u pw;
                        if (kt2 == 0) { pw.x = cvtpk_bf16(s0[8 * sp], s0[8 * sp + 1]); pw.y = cvtpk_bf16(s0[8 * sp + 2], s0[8 * sp + 3]); pw.z = cvtpk_bf16(s0[8 * sp + 4], s0[8 * sp + 5]); pw.w = cvtpk_bf16(s0[8 * sp + 6], s0[8 * sp + 7]); }
                        else          { pw.x = cvtpk_bf16(s1[8 * sp], s1[8 * sp + 1]); pw.y = cvtpk_bf16(s1[8 * sp + 2], s1[8 * sp + 3]); pw.z = cvtpk_bf16(s1[8 * sp + 4], s1[8 * sp + 5]); pw.w = cvtpk_bf16(s1[8 * sp + 6], s1[8 * sp + 7]); }
                        const bf16x8 pf = __builtin_bit_cast(bf16x8, pw);
#pragma unroll
                        for (int mt = 0; mt < 4; ++mt) {
                            LAS unsigned char* vp = lds + bo + voff + (32 * kt2 + 16 * sp) * AT_VP + 64 * mt;
                            const s16x4 lo = __builtin_bit_cast(s16x4, __builtin_amdgcn_ds_read_tr16_b64_v4i16((LAS v4i16_t*)vp));
                            const s16x4 hi4 = __builtin_bit_cast(s16x4, __builtin_amdgcn_ds_read_tr16_b64_v4i16((LAS v4i16_t*)(vp + 8 * AT_VP)));
                            const bf16x8 af = (bf16x8){lo[0], lo[1], lo[2], lo[3], hi4[0], hi4[1], hi4[2], hi4[3]};
                            o[mt] = __builtin_amdgcn_mfma_f32_32x32x16_bf16(af, pf, o[mt], 0, 0, 0);
                        }
                    }
            }
            if (j + 1 < NT) {
#pragma unroll
                for (int i = 0; i < 2; ++i) { *(LAS v4u*)(lds + bn + kdst + 32 * i * AT_KP) = krB[i]; *(LAS v4u*)(lds + bn + vdst + 32 * i * AT_VP) = vrB[i]; }
                if (j + 3 < NT) {
#pragma unroll
                    for (int i = 0; i < 2; ++i) { krB[i] = *(const GAS v4u*)(ksrc + (size_t)(64 * (j + 3) + 32 * i) * INW); vrB[i] = *(const GAS v4u*)(vsrc + (size_t)(64 * (j + 3) + 32 * i) * INW); }
                }
            }
            __syncthreads();
                  }
        }
        const float inv = 1.f / xhalf_sum(lsum);
        LAS float* XO = (LAS float*)(lds + AT_XO) + qt * 4096 + r32;
        if (map == 1) {
            const float sc = inv * lam;
#pragma unroll
            for (int mt = 0; mt < 4; ++mt)
#pragma unroll
                for (int r = 0; r < 16; ++r) XO[(32 * mt + (r & 3) + 8 * (r >> 2) + 4 * hi) * 32] = o[mt][r] * sc;
        }
        __syncthreads();
        if (map == 0) {
            float ss = 0.f;
#pragma unroll
            for (int mt = 0; mt < 4; ++mt)
#pragma unroll
                for (int r = 0; r < 16; ++r) { const float a = o[mt][r] * inv - XO[(32 * mt + (r & 3) + 8 * (r >> 2) + 4 * hi) * 32]; o[mt][r] = a; ss += a * a; }
            ss = xhalf_sum(ss);
            const float rr = (1.f - LAM_INIT) / sqrtf(ss * (1.f / 128.f) + EPS);
            LAS unsigned char* yb = lds + AT_YB + qt * (32 * AT_YP);
#pragma unroll
            for (int mt = 0; mt < 4; ++mt)
#pragma unroll
                for (int r4 = 0; r4 < 4; ++r4) { const int dv = 32 * mt + 8 * r4 + 4 * hi; const f32x4 gg = *(const GAS f32x4*)(F.in[7] + dv);
                    v2u w; w.x = cvtpk_bf16(o[mt][4 * r4] * rr * gg.x, o[mt][4 * r4 + 1] * rr * gg.y); w.y = cvtpk_bf16(o[mt][4 * r4 + 2] * rr * gg.z, o[mt][4 * r4 + 3] * rr * gg.w);
                    *(LAS v2u*)(yb + r32 * AT_YP + dv * 2) = w; }
            LDS_WAIT(); asm volatile("" ::: "memory");
            bf16* obase = MIXED + (tok0 + q0 + 32 * qt) * DM + h * 128;
#pragma unroll
            for (int i = 0; i < 8; ++i) { const int id = lane + 64 * i, row = id >> 4, cch = id & 15;
                const v4u w = *(const LAS v4u*)(yb + row * AT_YP + cch * 16); *(GAS v4u*)(obase + (size_t)row * DM + cch * 8) = w; }
        }
    }
}


constexpr int HG_P = 272, HG_KP = 80, HG_VP = 320;
constexpr int HG_QD = 0, HG_KI = 32 * HG_P, HG_KDT = 2 * 32 * HG_P, HG_V = HG_KDT + 128 * HG_KP, HG_CD = HG_V + 32 * HG_VP, HG_BUF = HG_CD + 512;
constexpr int HG_OA = 2 * HG_BUF, HG_OB = HG_OA + 32 * 128 * 4;
static_assert(HG_OB + 32 * 128 * 4 <= RING_BYTES, "hgrn LDS map");
__device__ __forceinline__ bf16x8 pack8(const f32x16& x, int s) {
    v4u p; p.x = cvtpk_bf16(x[8 * s], x[8 * s + 1]); p.y = cvtpk_bf16(x[8 * s + 2], x[8 * s + 3]); p.z = cvtpk_bf16(x[8 * s + 4], x[8 * s + 5]); p.w = cvtpk_bf16(x[8 * s + 6], x[8 * s + 7]);
    return __builtin_bit_cast(bf16x8, p);
}
__device__ __forceinline__ bf16x8 tr_pair(LAS unsigned char* p0, LAS unsigned char* p1) {
    const s16x4 lo = __builtin_bit_cast(s16x4, __builtin_amdgcn_ds_read_tr16_b64_v4i16((LAS v4i16_t*)p0));
    const s16x4 hi4 = __builtin_bit_cast(s16x4, __builtin_amdgcn_ds_read_tr16_b64_v4i16((LAS v4i16_t*)p1));
    return (bf16x8){lo[0], lo[1], lo[2], lo[3], hi4[0], hi4[1], hi4[2], hi4[3]};
}
__device__ __forceinline__ void hgrn_mfma(Frame& F) {
    const bf16* PROJ = (const bf16*)(F.ws + WS_PROJ); bf16* MIXED = (bf16*)(F.ws + WS_HN);
    const float* small = (const float*)(F.ws + WS_SMALL);
    LAS unsigned char* lds = F.lds;
    const int tid = F.tid, lane = F.lane, wave = F.wave, r32 = lane & 31, hh = lane >> 5;
    const int dvt = wave & 3, dkh = wave >> 2;
    const int pc = lane & 31, pdk8 = 16 * wave + 8 * (lane >> 5);
    const int kdoff = (((lane & 15) >> 2)) * HG_VP + (16 * ((lane >> 4) & 1) + 4 * (lane & 3)) * 2;
    const int vc = tid >> 4, vseg = tid & 15;
    const int troff = (((lane & 15) >> 2)) * HG_VP + (32 * dvt + 16 * ((lane >> 4) & 1) + 4 * (lane & 3)) * 2;
    for (int u = (int)blockIdx.x; u < 64; u += F.G) {
        const int b = u >> 2, h = u & 3; const size_t tok0 = (size_t)b * SEQ;
        const f32x4 lbA = *(const GAS f32x4*)(small + SM_LB + h * 128 + pdk8), lbB = *(const GAS f32x4*)(small + SM_LB + h * 128 + pdk8 + 4);
        const float lbv[8] = {lbA.x, lbA.y, lbA.z, lbA.w, lbB.x, lbB.y, lbB.z, lbB.w};
        const f32x4 g0 = *(const GAS f32x4*)(F.in[10] + 8 * vseg), g1 = *(const GAS f32x4*)(F.in[10] + 8 * vseg + 4);
        f32x16 S0, S1;
#pragma unroll
        for (int r = 0; r < 16; ++r) { S0[r] = 0.f; S1[r] = 0.f; }
        v4u rqA, rfA, rqB, rfB, rvA, rgA, rvB, rgB;
#define HG_LOAD(S, chn) do { const bf16* p_ = PROJ + (tok0 + 32 * (chn) + pc) * INW + h * 128 + pdk8; \
            asm volatile("global_load_dwordx4 %0, %1, off" : "=v"(rq##S) : "v"(p_ + C_HQ) : "memory"); \
            asm volatile("global_load_dwordx4 %0, %1, off" : "=v"(rf##S) : "v"(p_ + C_HF) : "memory"); \
            asm volatile("global_load_dwordx4 %0, %1, off" : "=v"(rv##S) : "v"(PROJ + (tok0 + 32 * (chn) + vc) * INW + C_HI + h * 128 + vseg * 8) : "memory"); } while (0)
#define HG_LOADG(S, chn) do { asm volatile("global_load_dwordx4 %0, %1, off" : "=v"(rg##S) : "v"(PROJ + (tok0 + 32 * (chn) + vc) * INW + C_HG + h * 128 + vseg * 8) : "memory"); } while (0)
#define HG_WAIT_RAW(S) asm volatile("s_waitcnt vmcnt(7)" : "+v"(rq##S), "+v"(rf##S), "+v"(rv##S) :: "memory")
#define HG_WAIT_G(S) asm volatile("s_waitcnt vmcnt(8)" : "+v"(rg##S) :: "memory")
        HG_LOAD(A, 0); HG_LOADG(A, 0); HG_LOAD(B, 1); HG_LOADG(B, 1);
        asm volatile("s_waitcnt vmcnt(0)" : "+v"(rvA), "+v"(rgA), "+v"(rvB), "+v"(rgB) :: "memory");
        __syncthreads();
        for (int ch2 = 0; ch2 < SEQ / 32; ch2 += 2) {
          { const int ch = ch2;
            LAS unsigned char* bufp = lds + (ch & 1) * HG_BUF;
            HG_WAIT_RAW(A);
            { float bb[8], fv[8];
              const unsigned fw[4] = {rfA.x, rfA.y, rfA.z, rfA.w}, qw[4] = {rqA.x, rqA.y, rqA.z, rqA.w};
#pragma unroll
              for (int i = 0; i < 8; ++i) { const float x = (i & 1) ? bfhi(fw[i >> 1]) : bflo(fw[i >> 1]); const float f = lbv[i] + (1.f - lbv[i]) * __builtin_amdgcn_rcpf(1.f + __expf(-x)); fv[i] = f; bb[i] = f; }
#pragma unroll
              for (int i = 0; i < 8; ++i) { float x = bb[i];
                  x *= __builtin_bit_cast(float, __builtin_amdgcn_update_dpp(0x3f800000, __builtin_bit_cast(int, x), 0x111, 0xf, 0xf, false));
                  x *= __builtin_bit_cast(float, __builtin_amdgcn_update_dpp(0x3f800000, __builtin_bit_cast(int, x), 0x112, 0xf, 0xf, false));
                  x *= __builtin_bit_cast(float, __builtin_amdgcn_update_dpp(0x3f800000, __builtin_bit_cast(int, x), 0x114, 0xf, 0xf, false));
                  x *= __builtin_bit_cast(float, __builtin_amdgcn_update_dpp(0x3f800000, __builtin_bit_cast(int, x), 0x118, 0xf, 0xf, false));
                  x *= __builtin_bit_cast(float, __builtin_amdgcn_update_dpp(0x3f800000, __builtin_bit_cast(int, x), 0x142, 0xa, 0xf, false));
                  bb[i] = x; }
              unsigned qd[8], ki[8], kd[8]; float cdv[8];
#pragma unroll
              for (int i = 0; i < 8; ++i) { const float elast = __shfl(bb[i], (lane & 32) + 31);
                  const float e = bb[i], ei = __builtin_amdgcn_rcpf(bb[i]), ed = elast * ei;
                  const float xq = (i & 1) ? bfhi(qw[i >> 1]) : bflo(qw[i >> 1]); const float q = xq * __builtin_amdgcn_rcpf(1.f + __expf(-xq)); const float k = 1.f - fv[i];
                  qd[i] = f2bf(q * e); ki[i] = f2bf(k * ei); kd[i] = f2bf(k * ed); cdv[i] = elast; }
              *(LAS v4u*)(bufp + HG_QD + pc * HG_P + pdk8 * 2) = (v4u){qd[0] | (qd[1] << 16), qd[2] | (qd[3] << 16), qd[4] | (qd[5] << 16), qd[6] | (qd[7] << 16)};
              *(LAS v4u*)(bufp + HG_KI + pc * HG_P + pdk8 * 2) = (v4u){ki[0] | (ki[1] << 16), ki[2] | (ki[3] << 16), ki[4] | (ki[5] << 16), ki[6] | (ki[7] << 16)};
              *(LAS v4u*)(bufp + HG_KDT + pc * HG_VP + pdk8 * 2) = (v4u){kd[0] | (kd[1] << 16), kd[2] | (kd[3] << 16), kd[4] | (kd[5] << 16), kd[6] | (kd[7] << 16)};
              if (pc == 31) { *(LAS f32x4*)(bufp + HG_CD + pdk8 * 4) = (f32x4){cdv[0], cdv[1], cdv[2], cdv[3]}; *(LAS f32x4*)(bufp + HG_CD + pdk8 * 4 + 16) = (f32x4){cdv[4], cdv[5], cdv[6], cdv[7]}; }
              *(LAS v4u*)(bufp + HG_V + vc * HG_VP + vseg * 16) = rvA; }
            HG_LOAD(A, (ch + 2 < SEQ / 32 ? ch + 2 : SEQ / 32 - 1));
            __syncthreads();
            f32x16 o;
#pragma unroll
            for (int r = 0; r < 16; ++r) o[r] = 0.f;
#pragma unroll
            for (int kk = 0; kk < 2; ++kk)
#pragma unroll
                for (int s2 = 0; s2 < 2; ++s2) {
                    LAS unsigned char* qa = bufp + HG_QD + r32 * HG_P + (32 * (2 * dkh + kk) + 16 * s2 + 4 * hh) * 2;
                    const v2u a0 = *(const LAS v2u*)qa, a1 = *(const LAS v2u*)(qa + 16);
                    const bf16x8 af = __builtin_bit_cast(bf16x8, (v4u){a0.x, a0.y, a1.x, a1.y});
                    o = __builtin_amdgcn_mfma_f32_32x32x16_bf16(af, pack8(kk == 0 ? S0 : S1, s2), o, 0, 0, 0);
                }
            if (wave < 4) {
                f32x16 X;
#pragma unroll
                for (int r = 0; r < 16; ++r) X[r] = 0.f;
#pragma unroll
                for (int s8 = 0; s8 < 8; ++s8) {
                    const bf16x8 af = *(const LAS bf16x8*)(bufp + HG_KI + r32 * HG_P + (16 * s8 + 8 * hh) * 2);
                    const bf16x8 bfr = *(const LAS bf16x8*)(bufp + HG_QD + r32 * HG_P + (16 * s8 + 8 * hh) * 2);
                    X = __builtin_amdgcn_mfma_f32_32x32x16_bf16(af, bfr, X, 0, 0, 0);
                }
#pragma unroll
                for (int r = 0; r < 16; ++r) { const int cp = (r & 3) + 8 * (r >> 2) + 4 * hh; X[r] = cp > r32 ? 0.f : X[r]; }
#pragma unroll
                for (int s2 = 0; s2 < 2; ++s2) {
                    LAS unsigned char* vp = bufp + HG_V + troff + (16 * s2 + 4 * hh) * HG_VP;
                    o = __builtin_amdgcn_mfma_f32_32x32x16_bf16(pack8(X, s2), tr_pair(vp, vp + 8 * HG_VP), o, 0, 0, 0);
                }
            }
            { LAS float* ob = (LAS float*)(lds + (wave < 4 ? HG_OA : HG_OB)) + 32 * dvt + r32;
#pragma unroll
              for (int r = 0; r < 16; ++r) ob[((r & 3) + 8 * (r >> 2) + 4 * hh) * 128] = o[r]; }
#pragma unroll
            for (int kk = 0; kk < 2; ++kk) {
                const int dk0 = 32 * (2 * dkh + kk);
                const LAS float* cdp = (const LAS float*)(bufp + HG_CD) + dk0 + 4 * hh;
#pragma unroll
                for (int r4 = 0; r4 < 4; ++r4) { const f32x4 c4 = *(const LAS f32x4*)(cdp + 8 * r4);
                    if (kk == 0) { S0[4 * r4] *= c4.x; S0[4 * r4 + 1] *= c4.y; S0[4 * r4 + 2] *= c4.z; S0[4 * r4 + 3] *= c4.w; }
                    else         { S1[4 * r4] *= c4.x; S1[4 * r4 + 1] *= c4.y; S1[4 * r4 + 2] *= c4.z; S1[4 * r4 + 3] *= c4.w; } }
#pragma unroll
                for (int s2 = 0; s2 < 2; ++s2) {
                    LAS unsigned char* kp = bufp + HG_KDT + kdoff + (16 * s2 + 8 * hh) * HG_VP + dk0 * 2;
                    const bf16x8 af = tr_pair(kp, kp + 4 * HG_VP);
                    LAS unsigned char* vp = bufp + HG_V + troff + (16 * s2 + 8 * hh) * HG_VP;
                    const bf16x8 bfr = tr_pair(vp, vp + 4 * HG_VP);
                    if (kk == 0) S0 = __builtin_amdgcn_mfma_f32_32x32x16_bf16(af, bfr, S0, 0, 0, 0);
                    else         S1 = __builtin_amdgcn_mfma_f32_32x32x16_bf16(af, bfr, S1, 0, 0, 0);
                }
            }
            __syncthreads();
            { const LAS float* oa = (const LAS float*)(lds + HG_OA) + vc * 128 + 8 * vseg; const LAS float* ob = (const LAS float*)(lds + HG_OB) + vc * 128 + 8 * vseg;
              const f32x4 x0 = *(const LAS f32x4*)oa + *(const LAS f32x4*)ob, x1 = *(const LAS f32x4*)(oa + 4) + *(const LAS f32x4*)(ob + 4);
              float ss = (x0.x * x0.x + x0.y * x0.y) + (x0.z * x0.z + x0.w * x0.w) + (x1.x * x1.x + x1.y * x1.y) + (x1.z * x1.z + x1.w * x1.w);
              ss += __shfl_xor(ss, 1); ss += __shfl_xor(ss, 2); ss += __shfl_xor(ss, 4); ss += __shfl_xor(ss, 8);
              const float rr = 1.f / sqrtf(ss * (1.f / 128.f) + EPS);
              const size_t tok = tok0 + 32 * ch + vc;
              HG_WAIT_G(A);
              const unsigned ga[4] = {rgA.x, rgA.y, rgA.z, rgA.w};
              const float ov[8] = {x0.x, x0.y, x0.z, x0.w, x1.x, x1.y, x1.z, x1.w}; const float gg[8] = {g0.x, g0.y, g0.z, g0.w, g1.x, g1.y, g1.z, g1.w};
              unsigned w[4];
#pragma unroll
              for (int j = 0; j < 4; ++j) { const float a0 = bflo(ga[j]), a1 = bfhi(ga[j]);
                  w[j] = pk2(ov[2 * j] * rr * gg[2 * j] * (a0 * __builtin_amdgcn_rcpf(1.f + __expf(-a0))), ov[2 * j + 1] * rr * gg[2 * j + 1] * (a1 * __builtin_amdgcn_rcpf(1.f + __expf(-a1)))); }
              *(GAS v4u*)(MIXED + tok * DM + 512 + h * 128 + 8 * vseg) = (v4u){w[0], w[1], w[2], w[3]}; }
            HG_LOADG(A, (ch + 2 < SEQ / 32 ? ch + 2 : SEQ / 32 - 1));
          }
          { const int ch = ch2 + 1;
            LAS unsigned char* bufp = lds + (ch & 1) * HG_BUF;
            HG_WAIT_RAW(B);
            { float bb[8], fv[8];
              const unsigned fw[4] = {rfB.x, rfB.y, rfB.z, rfB.w}, qw[4] = {rqB.x, rqB.y, rqB.z, rqB.w};
#pragma unroll
              for (int i = 0; i < 8; ++i) { const float x = (i & 1) ? bfhi(fw[i >> 1]) : bflo(fw[i >> 1]); const float f = lbv[i] + (1.f - lbv[i]) * __builtin_amdgcn_rcpf(1.f + __expf(-x)); fv[i] = f; bb[i] = f; }
#pragma unroll
              for (int i = 0; i < 8; ++i) { float x = bb[i];
                  x *= __builtin_bit_cast(float, __builtin_amdgcn_update_dpp(0x3f800000, __builtin_bit_cast(int, x), 0x111, 0xf, 0xf, false));
                  x *= __builtin_bit_cast(float, __builtin_amdgcn_update_dpp(0x3f800000, __builtin_bit_cast(int, x), 0x112, 0xf, 0xf, false));
                  x *= __builtin_bit_cast(float, __builtin_amdgcn_update_dpp(0x3f800000, __builtin_bit_cast(int, x), 0x114, 0xf, 0xf, false));
                  x *= __builtin_bit_cast(float, __builtin_amdgcn_update_dpp(0x3f800000, __builtin_bit_cast(int, x), 0x118, 0xf, 0xf, false));
                  x *= __builtin_bit_cast(float, __builtin_amdgcn_update_dpp(0x3f800000, __builtin_bit_cast(int, x), 0x142, 0xa, 0xf, false));
                  bb[i] = x; }
              unsigned qd[8], ki[8], kd[8]; float cdv[8];
#pragma unroll
              for (int i = 0; i < 8; ++i) { const float elast = __shfl(bb[i], (lane & 32) + 31);
                  const float e = bb[i], ei = __builtin_amdgcn_rcpf(bb[i]), ed = elast * ei;
                  const float xq = (i & 1) ? bfhi(qw[i >> 1]) : bflo(qw[i >> 1]); const float q = xq * __builtin_amdgcn_rcpf(1.f + __expf(-xq)); const float k = 1.f - fv[i];
                  qd[i] = f2bf(q * e); ki[i] = f2bf(k * ei); kd[i] = f2bf(k * ed); cdv[i] = elast; }
              *(LAS v4u*)(bufp + HG_QD + pc * HG_P + pdk8 * 2) = (v4u){qd[0] | (qd[1] << 16), qd[2] | (qd[3] << 16), qd[4] | (qd[5] << 16), qd[6] | (qd[7] << 16)};
              *(LAS v4u*)(bufp + HG_KI + pc * HG_P + pdk8 * 2) = (v4u){ki[0] | (ki[1] << 16), ki[2] | (ki[3] << 16), ki[4] | (ki[5] << 16), ki[6] | (ki[7] << 16)};
              *(LAS v4u*)(bufp + HG_KDT + pc * HG_VP + pdk8 * 2) = (v4u){kd[0] | (kd[1] << 16), kd[2] | (kd[3] << 16), kd[4] | (kd[5] << 16), kd[6] | (kd[7] << 16)};
              if (pc == 31) { *(LAS f32x4*)(bufp + HG_CD + pdk8 * 4) = (f32x4){cdv[0], cdv[1], cdv[2], cdv[3]}; *(LAS f32x4*)(bufp + HG_CD + pdk8 * 4 + 16) = (f32x4){cdv[4], cdv[5], cdv[6], cdv[7]}; }
              *(LAS v4u*)(bufp + HG_V + vc * HG_VP + vseg * 16) = rvB; }
            HG_LOAD(B, (ch + 2 < SEQ / 32 ? ch + 2 : SEQ / 32 - 1));
            __syncthreads();
            f32x16 o;
#pragma unroll
            for (int r = 0; r < 16; ++r) o[r] = 0.f;
#pragma unroll
            for (int kk = 0; kk < 2; ++kk)
#pragma unroll
                for (int s2 = 0; s2 < 2; ++s2) {
                    LAS unsigned char* qa = bufp + HG_QD + r32 * HG_P + (32 * (2 * dkh + kk) + 16 * s2 + 4 * hh) * 2;
                    const v2u a0 = *(const LAS v2u*)qa, a1 = *(const LAS v2u*)(qa + 16);
                    const bf16x8 af = __builtin_bit_cast(bf16x8, (v4u){a0.x, a0.y, a1.x, a1.y});
                    o = __builtin_amdgcn_mfma_f32_32x32x16_bf16(af, pack8(kk == 0 ? S0 : S1, s2), o, 0, 0, 0);
                }
            if (wave < 4) {
                f32x16 X;
#pragma unroll
                for (int r = 0; r < 16; ++r) X[r] = 0.f;
#pragma unroll
                for (int s8 = 0; s8 < 8; ++s8) {
                    const bf16x8 af = *(const LAS bf16x8*)(bufp + HG_KI + r32 * HG_P + (16 * s8 + 8 * hh) * 2);
                    const bf16x8 bfr = *(const LAS bf16x8*)(bufp + HG_QD + r32 * HG_P + (16 * s8 + 8 * hh) * 2);
                    X = __builtin_amdgcn_mfma_f32_32x32x16_bf16(af, bfr, X, 0, 0, 0);
                }
#pragma unroll
                for (int r = 0; r < 16; ++r) { const int cp = (r & 3) + 8 * (r >> 2) + 4 * hh; X[r] = cp > r32 ? 0.f : X[r]; }
#pragma unroll
                for (int s2 = 0; s2 < 2; ++s2) {
                    LAS unsigned char* vp = bufp + HG_V + troff + (16 * s2 + 4 * hh) * HG_VP;
                    o = __builtin_amdgcn_mfma_f32_32x32x16_bf16(pack8(X, s2), tr_pair(vp, vp + 8 * HG_VP), o, 0, 0, 0);
                }
            }
            { LAS float* ob = (LAS float*)(lds + (wave < 4 ? HG_OA : HG_OB)) + 32 * dvt + r32;
#pragma unroll
              for (int r = 0; r < 16; ++r) ob[((r & 3) + 8 * (r >> 2) + 4 * hh) * 128] = o[r]; }
#pragma unroll
            for (int kk = 0; kk < 2; ++kk) {
                const int dk0 = 32 * (2 * dkh + kk);
                const LAS float* cdp = (const LAS float*)(bufp + HG_CD) + dk0 + 4 * hh;
#pragma unroll
                for (int r4 = 0; r4 < 4; ++r4) { const f32x4 c4 = *(const LAS f32x4*)(cdp + 8 * r4);
                    if (kk == 0) { S0[4 * r4] *= c4.x; S0[4 * r4 + 1] *= c4.y; S0[4 * r4 + 2] *= c4.z; S0[4 * r4 + 3] *= c4.w; }
                    else         { S1[4 * r4] *= c4.x; S1[4 * r4 + 1] *= c4.y; S1[4 * r4 + 2] *= c4.z; S1[4 * r4 + 3] *= c4.w; } }
#pragma unroll
                for (int s2 = 0; s2 < 2; ++s2) {
                    LAS unsigned char* kp = bufp + HG_KDT + kdoff + (16 * s2 + 8 * hh) * HG_VP + dk0 * 2;
                    const bf16x8 af = tr_pair(kp, kp + 4 * HG_VP);
                    LAS unsigned char* vp = bufp + HG_V + troff + (16 * s2 + 8 * hh) * HG_VP;
                    const bf16x8 bfr = tr_pair(vp, vp + 4 * HG_VP);
                    if (kk == 0) S0 = __builtin_amdgcn_mfma_f32_32x32x16_bf16(af, bfr, S0, 0, 0, 0);
                    else         S1 = __builtin_amdgcn_mfma_f32_32x32x16_bf16(af, bfr, S1, 0, 0, 0);
                }
            }
            __syncthreads();
            { const LAS float* oa = (const LAS float*)(lds + HG_OA) + vc * 128 + 8 * vseg; const LAS float* ob = (const LAS float*)(lds + HG_OB) + vc * 128 + 8 * vseg;
              const f32x4 x0 = *(const LAS f32x4*)oa + *(const LAS f32x4*)ob, x1 = *(const LAS f32x4*)(oa + 4) + *(const LAS f32x4*)(ob + 4);
              float ss = (x0.x * x0.x + x0.y * x0.y) + (x0.z * x0.z + x0.w * x0.w) + (x1.x * x1.x + x1.y * x1.y) + (x1.z * x1.z + x1.w * x1.w);
              ss += __shfl_xor(ss, 1); ss += __shfl_xor(ss, 2); ss += __shfl_xor(ss, 4); ss += __shfl_xor(ss, 8);
              const float rr = 1.f / sqrtf(ss * (1.f / 128.f) + EPS);
              const size_t tok = tok0 + 32 * ch + vc;
              HG_WAIT_G(B);
              const unsigned ga[4] = {rgB.x, rgB.y, rgB.z, rgB.w};
              const float ov[8] = {x0.x, x0.y, x0.z, x0.w, x1.x, x1.y, x1.z, x1.w}; const float gg[8] = {g0.x, g0.y, g0.z, g0.w, g1.x, g1.y, g1.z, g1.w};
              unsigned w[4];
#pragma unroll
              for (int j = 0; j < 4; ++j) { const float a0 = bflo(ga[j]), a1 = bfhi(ga[j]);
                  w[j] = pk2(ov[2 * j] * rr * gg[2 * j] * (a0 * __builtin_amdgcn_rcpf(1.f + __expf(-a0))), ov[2 * j + 1] * rr * gg[2 * j + 1] * (a1 * __builtin_amdgcn_rcpf(1.f + __expf(-a1)))); }
              *(GAS v4u*)(MIXED + tok * DM + 512 + h * 128 + 8 * vseg) = (v4u){w[0], w[1], w[2], w[3]}; }
            HG_LOADG(B, (ch + 2 < SEQ / 32 ? ch + 2 : SEQ / 32 - 1));
          }
        }
#undef HG_LOAD
#undef HG_LOADG
#undef HG_WAIT_RAW
#undef HG_WAIT_G
    }
}

template <int N> __device__ __forceinline__ unsigned row_ror(unsigned x) { return (unsigned)__builtin_amdgcn_update_dpp((int)x, (int)x, 0x120 + N, 0xf, 0xf, false); }
__device__ __forceinline__ unsigned umax_(unsigned a, unsigned b) { return a > b ? a : b; }
__device__ __forceinline__ unsigned umin_(unsigned a, unsigned b) { return a < b ? a : b; }
__device__ __forceinline__ unsigned row_umax16(unsigned x) {
    unsigned y;
    asm volatile("s_nop 1\n\tv_max_u32_dpp %0, %1, %1 row_ror:1 row_mask:0xf bank_mask:0xf\n\t"
                 "s_nop 1\n\tv_max_u32_dpp %0, %0, %0 row_ror:2 row_mask:0xf bank_mask:0xf\n\t"
                 "s_nop 1\n\tv_max_u32_dpp %0, %0, %0 row_ror:4 row_mask:0xf bank_mask:0xf\n\t"
                 "s_nop 1\n\tv_max_u32_dpp %0, %0, %0 row_ror:8 row_mask:0xf bank_mask:0xf"
                 : "=&v"(y) : "v"(x));
    return y;
}
__device__ __forceinline__ float row_fsum16(float v) {
    v += __builtin_bit_cast(float, row_ror<1>(__builtin_bit_cast(unsigned, v))); v += __builtin_bit_cast(float, row_ror<2>(__builtin_bit_cast(unsigned, v)));
    v += __builtin_bit_cast(float, row_ror<4>(__builtin_bit_cast(unsigned, v))); v += __builtin_bit_cast(float, row_ror<8>(__builtin_bit_cast(unsigned, v))); return v; }
__device__ __forceinline__ unsigned h2key(unsigned x) { return (x & 0x80000000u) ? (~x & 0xffff0000u) : (x | 0x80000000u); }
__device__ __forceinline__ float hkey2f(unsigned k) { const unsigned hb = ((k & 0x80000000u) ? (k & 0x7fff0000u) : (~k & 0xffff0000u)) >> 16; return (float)__builtin_bit_cast(_Float16, (unsigned short)hb); }
__device__ __forceinline__ unsigned f2key(float f) { const unsigned u = __builtin_bit_cast(unsigned, f); return (u & 0x80000000u) ? ~u : (u | 0x80000000u); }
__device__ __forceinline__ float key2f(unsigned k) { const unsigned u = (k & 0x80000000u) ? (k & 0x7fffffffu) : ~k; return __builtin_bit_cast(float, u); }
__device__ __forceinline__ unsigned pair_code(int s) {
    if (s < 16) return (unsigned)s;
    if (s < 24) return 16u + (unsigned)(s - 16);
    if (s < 29) return 32u + (unsigned)(s - 24);
    if (s < 33) return 48u + (unsigned)(s - 29);
    if (s < 36) return 64u + (unsigned)(s - 33);
    if (s < 42) return 80u + 16u * (unsigned)((s - 36) >> 1) + (unsigned)((s - 36) & 1);
    if (s < 50) return 128u + 16u * (unsigned)(s - 42);
    return 0xFFu;
}
#define CAS_(a, b) do { const unsigned hi_ = umax_(a, b), lo_ = umin_(a, b); a = hi_; b = lo_; } while (0)
__device__ __forceinline__ unsigned topk_stage1(const unsigned short* SC, int th, int c, int l15) {
    const int t = th >> 3, h = th & 7;
    const v4u sv = *(const GAS v4u*)(SC + (size_t)t * 2048 + h * 256 + c * 128 + l15 * 8);
    const unsigned nb = 127u - 8u * (unsigned)l15;
    unsigned k0 = h2key(sv.x << 16) | nb, k1 = h2key(sv.x & 0xffff0000u) | (nb - 1u), k2 = h2key(sv.y << 16) | (nb - 2u), k3 = h2key(sv.y & 0xffff0000u) | (nb - 3u);
    unsigned k4 = h2key(sv.z << 16) | (nb - 4u), k5 = h2key(sv.z & 0xffff0000u) | (nb - 5u), k6 = h2key(sv.w << 16) | (nb - 6u), k7 = h2key(sv.w & 0xffff0000u) | (nb - 7u);
    CAS_(k0, k1); CAS_(k2, k3); CAS_(k4, k5); CAS_(k6, k7); CAS_(k0, k2); CAS_(k1, k3); CAS_(k4, k6); CAS_(k5, k7); CAS_(k1, k2); CAS_(k5, k6); CAS_(k0, k4); CAS_(k3, k7);
    CAS_(k1, k5); CAS_(k2, k6); CAS_(k1, k4); CAS_(k3, k6); CAS_(k2, k4); CAS_(k3, k5); CAS_(k3, k4);
    unsigned res = 0u;
#pragma unroll
    for (int r = 0; r < 16; ++r) {
        const unsigned m = row_umax16(k0); const bool pop = (k0 == m);
        k0 = pop ? k1 : k0; k1 = pop ? k2 : k1; k2 = pop ? k3 : k2; k3 = pop ? k4 : k3; k4 = pop ? k5 : k4; k5 = pop ? k6 : k5; k6 = pop ? k7 : k6; k7 = pop ? 0u : k7;
        res = (l15 == r) ? m : res;
    }
    return res;
}
__device__ __forceinline__ void topk_v2(Frame& F) {
    const unsigned short* SC = (const unsigned short*)(F.ws + WS_SC); int* IDX = (int*)(F.ws + WS_IDX); float* GATE = (float*)(F.ws + WS_GATE); float* GSU = (float*)(F.ws + WS_GSU);
    const float* SU = (const float*)(F.ws + WS_SU); const float* SV = (const float*)(F.ws + WS_SV);
    const int gw = F.vcu * NWAVES + F.wave, NGW = F.G * NWAVES, lane = F.lane, l15 = lane & 15, row = lane >> 4, c = row & 1, rbase = lane & 48;
    const unsigned pc0 = pair_code(l15), pc1 = pair_code(l15 + 16), pc2 = pair_code(l15 + 32), pc3 = pair_code(l15 + 48);
    const int src1 = l15 + 32 * (row & 1), src2 = src1 + 16;
    for (int it0 = gw * 32; it0 < NTOK * 2; it0 += NGW * 32)
    for (int it = it0; it < it0 + 32; ++it) {
        const int thb = 4 * it;
        const unsigned resA = topk_stage1(SC, thb + (row >> 1), c, l15), resB = topk_stage1(SC, thb + 2 + (row >> 1), c, l15);
        const unsigned a1 = (unsigned)__shfl((int)resA, src1), a2 = (unsigned)__shfl((int)resA, src2), b1 = (unsigned)__shfl((int)resB, src1), b2 = (unsigned)__shfl((int)resB, src2);
        const unsigned S1 = row < 2 ? a1 : b1, S2 = row < 2 ? a2 : b2;
        unsigned c0, c1, c2, c3;
#define TK_CAND(CK, PC) do { const unsigned ka_ = (unsigned)__shfl((int)S1, rbase + (int)((PC) >> 4 & 15u)), kb_ = (unsigned)__shfl((int)S2, rbase + (int)((PC) & 15u)); \
            const float sm_ = hkey2f(ka_) + hkey2f(kb_); CK = (PC) == 0xFFu ? 0u : ((f2key(sm_) & ~0xFFu) | (255u - (PC))); } while (0)
        TK_CAND(c0, pc0); TK_CAND(c1, pc1); TK_CAND(c2, pc2); TK_CAND(c3, pc3);
#undef TK_CAND
        CAS_(c0, c1); CAS_(c2, c3); CAS_(c0, c2); CAS_(c1, c3); CAS_(c1, c2);
        unsigned res2 = 0u;
#pragma unroll
        for (int r = 0; r < 16; ++r) {
            const unsigned m = row_umax16(c0); const bool pop = (c0 == m);
            c0 = pop ? c1 : c0; c1 = pop ? c2 : c1; c2 = pop ? c3 : c2; c3 = pop ? 0u : c3;
            res2 = (l15 == r) ? m : res2;
        }
        const unsigned code = 255u - (res2 & 0xFFu);
        const unsigned ka = (unsigned)__shfl((int)S1, rbase + (int)(code >> 4 & 15u)), kb = (unsigned)__shfl((int)S2, rbase + (int)(code & 15u));
        const float ts = hkey2f(ka) + hkey2f(kb);
        const int e = (int)((127u - (ka & 0x7Fu)) * 128u + (127u - (kb & 0x7Fu)));
        const float tmax = __builtin_bit_cast(float, (unsigned)__shfl((int)__builtin_bit_cast(unsigned, ts), rbase));
        const float ex = __expf(ts - tmax);
        const float sum = row_fsum16(ex);
        const int th = thb + row;
        const size_t o = (size_t)(th >> 3) * NEXP_SEL + (th & 7) * 16 + l15;
        IDX[o] = e; GATE[o] = ex / sum * SV[e]; GSU[o] = SU[e];
    }
}

constexpr int PG_TOK = 16;
constexpr int PG_IDX = 0, PG_HID = 4096, PG_SA = PG_HID + 8192, PG_TB = PG_SA + 64, PG_WB = PG_TB + 4096;
static_assert(PG_WB % 16 == 0 && PG_TB % 16 == 0 && NWAVES * PG_WB <= RING_BYTES, "gather LDS map");
__device__ __forceinline__ void peer_sliced(Frame& F) {
    const unsigned char* U8T = F.ws + WS_U8; const unsigned char* V8T = F.ws + WS_V8; const unsigned char* X8 = F.ws + WS_X8;
    const float* SSQ = (const float*)(F.ws + WS_CTL) + CW_SSQ;
    const int* IDX = (const int*)(F.ws + WS_IDX); const float* GATE = (const float*)(F.ws + WS_GATE); const float* GSU = (const float*)(F.ws + WS_GSU); const float* gf = F.in[17];
    bf16* PO = (bf16*)(F.ws + WS_PO); const bf16* HB = (const bf16*)(F.ws + WS_HN2);
    const int gw = F.vcu * NWAVES + F.wave, NGW = F.G * NWAVES, lane = F.lane, m = lane & 15, g = lane >> 4;
    const int row8 = lane >> 3, piece = lane & 7;
    LAS unsigned char* wb = F.lds + F.wave * PG_WB;
    LAS unsigned short* idxs = (LAS unsigned short*)(wb + PG_IDX);
    LAS float* hid = (LAS float*)(wb + PG_HID);
    LAS float* sqp = hid + 64 + lane;
    LAS float* sai = (LAS float*)(wb + PG_SA);
    LAS unsigned char* tb = wb + PG_TB;
    const int p8 = m & 7; const unsigned bsh = 8u * (unsigned)(p8 & 3); const bool bhi = (p8 >> 2) != 0;
    constexpr size_t SLICE = (size_t)16384 * 128;
    const int usw = 16 * (piece ^ ((row8 >> 1) & 3));
    const int urd0 = m * 128 + 16 * ((2 * g) ^ ((m >> 1) & 7)), urd1 = m * 128 + 16 * ((2 * g + 1) ^ ((m >> 1) & 7));
    for (int blk = gw; blk < NTOK / PG_TOK; blk += NGW) {
        const int t0 = blk * PG_TOK;
#pragma unroll
        for (int k = 0; k < 32; ++k) { const int id = lane + 64 * k; idxs[id] = (unsigned short)IDX[(size_t)t0 * NEXP_SEL + id]; }
        LDS_WAIT(); asm volatile("" ::: "memory");
        for (int p = 0; p < 8; ++p) {
            const unsigned char* Up = U8T + (size_t)p * SLICE;
            const unsigned char* Xp = X8 + (size_t)t0 * DM + 128 * p + 32 * g;
            v4u ab[2][16]; l2 xs[2][2];
#define PGU_ISSUE(i_, buf_) do { _Pragma("unroll") for (int k = 0; k < 16; ++k) { const unsigned e = idxs[(i_) * 128 + 8 * k + row8]; \
                ab[buf_][k] = *(const GAS v4u*)(Up + (size_t)e * 128 + (usw ^ ((k & 1) ? 64 : 0))); } \
                xs[buf_][0] = *(const GAS l2*)(Xp + (size_t)(i_) * DM); xs[buf_][1] = *(const GAS l2*)(Xp + (size_t)(i_) * DM + 16); } while (0)
#define PGU_BODY(i_, cur_, nxt_) do { if ((i_) + 1 < PG_TOK) PGU_ISSUE((i_) + 1, nxt_); SCHED_FENCE(); \
                _Pragma("unroll") for (int rb = 0; rb < 4; ++rb) { LAS f32x4* hp0 = (LAS f32x4*)(hid + (i_) * 128 + 32 * rb + 4 * g); LAS f32x4* hp1 = hp0 + 4; \
                    _Pragma("unroll") for (int q4 = 0; q4 < 4; ++q4) *(LAS v4u*)(tb + 1024 * q4 + 16 * lane) = ab[cur_][4 * rb + q4]; \
                    f32x4 acc0 = p == 0 ? (f32x4){0.f, 0.f, 0.f, 0.f} : *hp0, acc1 = p == 0 ? (f32x4){0.f, 0.f, 0.f, 0.f} : *hp1; \
                    const l2 a0 = *(const LAS l2*)(tb + urd0), a1 = *(const LAS l2*)(tb + urd1), b0 = *(const LAS l2*)(tb + 2048 + urd0), b1 = *(const LAS l2*)(tb + 2048 + urd1); \
                    acc0 = __builtin_amdgcn_mfma_f32_16x16x32_fp8_bf8(a0.x, xs[cur_][0].x, acc0, 0, 0, 0); acc1 = __builtin_amdgcn_mfma_f32_16x16x32_fp8_bf8(b0.x, xs[cur_][0].x, acc1, 0, 0, 0); \
                    acc0 = __builtin_amdgcn_mfma_f32_16x16x32_fp8_bf8(a0.y, xs[cur_][0].y, acc0, 0, 0, 0); acc1 = __builtin_amdgcn_mfma_f32_16x16x32_fp8_bf8(b0.y, xs[cur_][0].y, acc1, 0, 0, 0); \
                    acc0 = __builtin_amdgcn_mfma_f32_16x16x32_fp8_bf8(a1.x, xs[cur_][1].x, acc0, 0, 0, 0); acc1 = __builtin_amdgcn_mfma_f32_16x16x32_fp8_bf8(b1.x, xs[cur_][1].x, acc1, 0, 0, 0); \
                    acc0 = __builtin_amdgcn_mfma_f32_16x16x32_fp8_bf8(a1.y, xs[cur_][1].y, acc0, 0, 0, 0); acc1 = __builtin_amdgcn_mfma_f32_16x16x32_fp8_bf8(b1.y, xs[cur_][1].y, acc1, 0, 0, 0); \
                    if (m == 0) { *hp0 = acc0; *hp1 = acc1; } } SCHED_FENCE(); } while (0)
            PGU_ISSUE(0, 0);
            for (int i2 = 0; i2 < PG_TOK; i2 += 2) { PGU_BODY(i2, 0, 1); PGU_BODY(i2 + 1, 1, 0); }
#undef PGU_ISSUE
#undef PGU_BODY
            LDS_WAIT(); asm volatile("" ::: "memory");
        }
        for (int i = 0; i < PG_TOK; ++i) {
            const int t = t0 + i; const float sx = 1.f / sqrtf(SSQ[t] * (1.f / DM) + EPS);
            float w[8][4]; float amax = 0.f;
#pragma unroll
            for (int r = 0; r < 8; ++r) { const f32x4 h4 = *(const LAS f32x4*)(hid + i * 128 + 16 * r + 4 * g);
                const f32x4 su4 = *(const GAS f32x4*)(GSU + (size_t)t * NEXP_SEL + 16 * r + 4 * g), gv4 = *(const GAS f32x4*)(GATE + (size_t)t * NEXP_SEL + 16 * r + 4 * g);
#pragma unroll
                for (int j = 0; j < 4; ++j) { w[r][j] = gelu_as(h4[j] * su4[j] * sx) * gv4[j]; amax = fmaxf(amax, fabsf(w[r][j])); } }
            amax = fmaxf(amax, __shfl_xor(amax, 16)); amax = fmaxf(amax, __shfl_xor(amax, 32));
            const float sa = amax > 0.f ? 224.f / amax : 1.f;
            LDS_WAIT(); asm volatile("" ::: "memory");
            if (m == 0) {
                LAS unsigned char* wrow = (LAS unsigned char*)(hid + i * 128);
#pragma unroll
                for (int r = 0; r < 8; ++r) { int pk = __builtin_amdgcn_cvt_pk_fp8_f32(w[r][0] * sa, w[r][1] * sa, 0, false); pk = __builtin_amdgcn_cvt_pk_fp8_f32(w[r][2] * sa, w[r][3] * sa, pk, true);
                    wrow[4 * r + g] = (unsigned char)pk; wrow[32 + 4 * r + g] = (unsigned char)(pk >> 8); wrow[64 + 4 * r + g] = (unsigned char)(pk >> 16); wrow[96 + 4 * r + g] = (unsigned char)(pk >> 24); }
            }
            if (lane == 0) sai[i] = amax > 0.f ? amax * (1.f / 224.f) : 1.f;
        }
        LDS_WAIT(); asm volatile("" ::: "memory");
        for (int p = 0; p < 8; ++p) {
            const unsigned char* Vp = V8T + (size_t)p * SLICE + 16 * piece;
            v4u va[2][16];
#define PGV_ISSUE(i_, buf_) do { _Pragma("unroll") for (int k = 0; k < 16; ++k) { const unsigned e = idxs[(i_) * 128 + 8 * k + row8]; va[buf_][k] = *(const GAS v4u*)(Vp + (size_t)e * 128); } } while (0)
#define PGV_BODY(i_, cur_, nxt_) do { if ((i_) + 1 < PG_TOK) PGV_ISSUE((i_) + 1, nxt_); \
                const LAS v4u* wp = (const LAS v4u*)((LAS unsigned char*)(hid + (i_) * 128) + 32 * g); const v4u w0 = wp[0], w1 = wp[1]; \
                const unsigned ww[8] = {w0.x, w0.y, w0.z, w0.w, w1.x, w1.y, w1.z, w1.w}; \
                SCHED_FENCE(); f32x4 c = (f32x4){0.f, 0.f, 0.f, 0.f}; \
                _Pragma("unroll") for (int kb = 0; kb < 4; ++kb) { \
                    _Pragma("unroll") for (int q4 = 0; q4 < 4; ++q4) *(LAS v4u*)(tb + 1024 * q4 + 16 * lane) = va[cur_][4 * kb + q4]; \
                    long rr_[8]; \
                    _Pragma("unroll") for (int q4 = 0; q4 < 4; ++q4) { rr_[2 * q4] = *(const LAS long*)(tb + 1024 * q4 + g * 128 + 8 * m); rr_[2 * q4 + 1] = *(const LAS long*)(tb + 1024 * q4 + (4 + g) * 128 + 8 * m); } \
                    _Pragma("unroll") for (int q8 = 0; q8 < 8; ++q8) { const int q = 8 * kb + q8; const unsigned a8 = ((ww[q >> 2] >> (8 * (q & 3))) & 0xffu) << bsh; const long bop = (long)(bhi ? ((unsigned long long)a8 << 32) : (unsigned long long)a8); \
                      c = __builtin_amdgcn_mfma_f32_16x16x32_fp8_fp8(rr_[q8], bop, c, 0, 0, 0); } } \
                SCHED_FENCE(); \
                { const float isa = sai[i_]; LAS unsigned short* ob = (LAS unsigned short*)(tb) + 32 * g + (m & 7);         \
                  if (m < 8) { ob[0] = (unsigned short)f2bf(c[0] * isa); ob[8] = (unsigned short)f2bf(c[1] * isa); ob[16] = (unsigned short)f2bf(c[2] * isa); ob[24] = (unsigned short)f2bf(c[3] * isa); } \
                  const v4u ov = *(const LAS v4u*)(tb + 16 * (lane & 15)); \
                  if (lane < 16) *(GAS v4u*)(PO + (size_t)(t0 + (i_)) * DM + 128 * p + 8 * lane) = ov; } } while (0)
            PGV_ISSUE(0, 0);
            for (int i2 = 0; i2 < PG_TOK; i2 += 2) { PGV_BODY(i2, 0, 1); PGV_BODY(i2 + 1, 1, 0); }
#undef PGV_ISSUE
#undef PGV_BODY
        }
        LDS_WAIT(); asm volatile("" ::: "memory");
        VM_WAIT();
        for (int i = 0; i < PG_TOK; i += 2) {
            GAS f32x4* hrA = (GAS f32x4*)(F.out + (size_t)(t0 + i) * DM) + lane; GAS f32x4* hrB = hrA + DM / 4;
            const GAS v2u* prA = (const GAS v2u*)(PO + (size_t)(t0 + i) * DM) + lane; const GAS v2u* prB = prA + DM / 4;
            const GAS v2u* hbA = (const GAS v2u*)(HB + (size_t)(t0 + i) * DM) + lane; const GAS v2u* hbB = hbA + DM / 4;
            v2u pa[4], pb[4], ha[4], hb2[4];
#pragma unroll
            for (int j = 0; j < 4; ++j) { pa[j] = prA[64 * j]; ha[j] = hbA[64 * j]; pb[j] = prB[64 * j]; hb2[j] = hbB[64 * j]; }
            f32x4 ya[4], yb[4]; float sa = 0.f, sb = 0.f;
#pragma unroll
            for (int j = 0; j < 4; ++j) {
                ya[j] = (f32x4){bflo(ha[j].x), bfhi(ha[j].x), bflo(ha[j].y), bfhi(ha[j].y)} + (f32x4){bflo(pa[j].x), bfhi(pa[j].x), bflo(pa[j].y), bfhi(pa[j].y)};
                yb[j] = (f32x4){bflo(hb2[j].x), bfhi(hb2[j].x), bflo(hb2[j].y), bfhi(hb2[j].y)} + (f32x4){bflo(pb[j].x), bfhi(pb[j].x), bflo(pb[j].y), bfhi(pb[j].y)};
                sa += (ya[j].x * ya[j].x + ya[j].y * ya[j].y) + (ya[j].z * ya[j].z + ya[j].w * ya[j].w); sb += (yb[j].x * yb[j].x + yb[j].y * yb[j].y) + (yb[j].z * yb[j].z + yb[j].w * yb[j].w); }
#pragma unroll
            for (int o = 1; o < 64; o <<= 1) { sa += __shfl_xor(sa, o); sb += __shfl_xor(sb, o); }
            const float ra = 1.f / sqrtf(sa * (1.f / DM) + EPS), rb = 1.f / sqrtf(sb * (1.f / DM) + EPS);
#pragma unroll
            for (int j = 0; j < 4; ++j) { const f32x4 gg = *((const GAS f32x4*)gf + lane + 64 * j); hrA[64 * j] = ya[j] * ra * gg; hrB[64 * j] = yb[j] * rb * gg; }
        }
        LDS_WAIT(); asm volatile("" ::: "memory");
    }
}

struct Args { const float* in[18]; float* out; unsigned char* ws; int ph_lo, ph_hi; };
__global__ void __launch_bounds__(NWAVES * 64, 2) hymba_fwd(Args args) {
    extern __shared__ __attribute__((aligned(16))) unsigned char lds[];
    Frame F;
    F.lds = (LAS unsigned char*)lds;
    F.MISC = (volatile LAS unsigned*)(F.lds + MISC_OFF);
    F.tid = threadIdx.x; F.lane = F.tid & 63; F.wave = __builtin_amdgcn_readfirstlane(F.tid >> 6);
    F.G = gridDim.x; { const int bx = blockIdx.x; F.vcu = (F.G % 8 == 0) ? (bx % 8) * (F.G / 8) + bx / 8 : bx; }
#pragma unroll
    for (int i = 0; i < 18; ++i) F.in[i] = args.in[i];
    F.out = args.out; F.ws = args.ws;
    for (int u = F.tid; u < (LDS_BYTES - LDSCTL_OFF) / 4; u += NWAVES * 64) ((LAS unsigned*)(F.lds + LDSCTL_OFF))[u] = 0u;
    __syncthreads();
    const int lo = args.ph_lo, hi = args.ph_hi;
    const bool multi = (hi - lo) > 1;
    XcdBarrier bar; bar.bar = (unsigned*)(F.ws + WS_CTL) + CW_BAR; bar.x = 0; bar.st = nullptr;
    if (multi) bar = xcd_barrier_post((unsigned*)(F.ws + WS_CTL) + CW_BAR, F.MISC + 8);
#define IN(k) (lo <= (k) && (k) < hi)
#define SEAM(k) do { if (IN(k) && IN((k) + 1)) xcd_barrier(bar); } while (0)

    if (IN(0)) { p0_prologue(F); } SEAM(0);
    if (IN(1)) {
        pg8::Gemm g{(const pg8::bf16_t*)(F.ws + WS_HN), (const pg8::bf16_t*)(F.ws + WS_WIN), NTOK, INW, DM}; pg8::StaticOrder S; S.init(NTOK, INW, F.G, (int)blockIdx.x);
        pg8::EpiProj E{(pg8::bf16_t*)(F.ws + WS_PROJ), INW, 2, QSCALE};
        pg8::gemm_phase<pg8::EpiProj, pg8::StaticOrder, PG8_ALIGN, PG8_SP2>(F.lds + RING_OFF, g, S, E);
    } SEAM(1);
    if (IN(2)) { hgrn_mfma(F); }
    if (IN(3)) { quant_drain(F); attn_mfma(F, 0); }
    if (IN(3) && IN(4)) xcd_barrier(bar);
    if (IN(4)) {
        pg8::Gemm g{(const pg8::bf16_t*)(F.ws + WS_HN), (const pg8::bf16_t*)(F.ws + WS_WOUT), NTOK, DM, DM}; pg8::StaticOrder S; S.init(NTOK, DM, F.G, (int)blockIdx.x);
        pg8::EpiMix E{DM, F.in[0], F.in[12], (pg8::bf16_t*)(F.ws + WS_HN2), F.ws + WS_X8, (float*)(F.ws + WS_CTL) + CW_SSQ};
        pg8::gemm_phase<pg8::EpiMix, pg8::StaticOrder, PG8_ALIGN, PG8_SP2>(F.lds + RING_OFF, g, S, E);
    }
    if (IN(4) && IN(6)) xcd_barrier(bar);
    if (IN(6)) {
        pg8::Gemm g{(const pg8::bf16_t*)(F.ws + WS_HN2), (const pg8::bf16_t*)(F.ws + WS_W2), NTOK, 2048, DM}; pg8::StaticOrder S; S.init(NTOK, 2048, F.G, (int)blockIdx.x);
        pg8::EpiScaleRow E{(_Float16*)(F.ws + WS_SC), 2048, (const float*)(F.ws + WS_CTL) + CW_SSQ, 1.f / DM, EPS};
        pg8::gemm_phase<pg8::EpiScaleRow, pg8::StaticOrder, PG8_ALIGN, PG8_SP2>(F.lds + RING_OFF, g, S, E);
    } SEAM(6);
    if (IN(7)) { topk_v2(F); }
    if (IN(7) && IN(8)) { VM_WAIT(); }
    if (IN(8)) { peer_sliced(F); }
#undef IN
#undef SEAM
}

extern "C" void kernel_launch(void* const* d_in, const int* in_sizes, int n_in, void* d_out, int out_size, void* d_ws, size_t ws_size, hipStream_t stream) {
    static int grid = 0;
    if (grid == 0) {
        if (n_in != 18 || in_sizes[0] != NTOK * DM || out_size != NTOK * DM || ws_size < WS_END) { fprintf(stderr, "kernel_launch: unexpected shapes (n_in %d, in0 %d, out %d, ws %zu); nothing launched\n", n_in, n_in > 0 ? in_sizes[0] : -1, out_size, ws_size); grid = -1; return; }
        int dev = 0, cus = 0, per_cu = 0;
        if (hipGetDevice(&dev) != hipSuccess || hipDeviceGetAttribute(&cus, hipDeviceAttributeMultiprocessorCount, dev) != hipSuccess) { grid = -1; return; }
        if (hipFuncSetAttribute((const void*)hymba_fwd, hipFuncAttributeMaxDynamicSharedMemorySize, LDS_BYTES) != hipSuccess) { fprintf(stderr, "kernel_launch: hipFuncSetAttribute failed\n"); grid = -1; return; }
        if (hipOccupancyMaxActiveBlocksPerMultiprocessor(&per_cu, (const void*)hymba_fwd, NWAVES * 64, LDS_BYTES) != hipSuccess || per_cu < 1)
            fprintf(stderr, "kernel_launch: note: occupancy query reports %d workgroups per CU\n", per_cu);
        (void)hipGetLastError();
        grid = cus;
    }
    if (grid < 0) return;
    if (hipMemsetAsync((char*)d_ws + WS_CTL, 0, CTL_ZERO_BYTES, stream) != hipSuccess) return;
    Args a{};
    for (int i = 0; i < 18; ++i) a.in[i] = (const float*)d_in[i];
    a.out = (float*)d_out; a.ws = (unsigned char*)d_ws; a.ph_lo = 0; a.ph_hi = 9;
    hipLaunchKernelGGL(hymba_fwd, dim3(grid), dim3(NWAVES * 64), LDS_BYTES, stream, a);
}
```

```cpp
#include <hip/hip_runtime.h>
#include <cstdio>
#include <cstdint>
#include <cmath>
namespace pg8 {
#define PG8_LAS __attribute__((address_space(3)))
typedef unsigned short bf16_t;
typedef short bf16x8 __attribute__((ext_vector_type(8)));
typedef float f32x4 __attribute__((ext_vector_type(4)));
typedef unsigned u32x4 __attribute__((ext_vector_type(4)));
constexpr int BM = 256, BK = 64, HALF = 128, HTB = HALF * BK * 2  , STAGE_BYTES = 8 * HTB, NXCD = 8, WGM = 8;

__host__ __device__ __forceinline__ int lds_byte(int r, int c) { const int st = (r >> 4) * 2 + (c >> 5), rr = r & 15, cc = c & 31, ob = rr * 64 + cc * 2; return st * 1024 + (ob ^ (((ob >> 9) & 1) << 5)); }
__host__ __device__ __forceinline__ void stage_rc(int b, int& R, int& C) { const int st = b / 1024, sb = b % 1024, swz = sb ^ (((sb >> 9) & 1) << 5); R = (st >> 1) * 16 + swz / 64; C = (st & 1) * 32 + (swz % 64) / 2; }
__host__ __device__ __forceinline__ int perm32(int rho) { const int n = rho >> 4, i = rho & 15; return 8 * (i >> 2) + 4 * n + (i & 3); }

struct Unit { int pm, pn; };
struct Gemm { const bf16_t* A; const bf16_t* Bt; int M, N, K; };

struct StaticOrder {
    int nM, nN, nwg, G, c;
    __host__ __device__ void init(int M, int N, int G_, int c_) { nM = M / BM; nN = N / BM; nwg = nM * nN; G = G_; c = c_; }
    __host__ __device__ bool next(int i, Unit& u) const {
        const long L = (long)i * G + c; if (L >= nwg) return false;
        int wgid = (int)L; { const int q = nwg / NXCD, r = nwg % NXCD, xcd = wgid % NXCD, off = wgid / NXCD; wgid = (xcd < r ? xcd * (q + 1) : r * (q + 1) + (xcd - r) * q) + off; }
        const int nig = WGM * nN, gid = wgid / nig, fm = gid * WGM, gsz = (nM - fm) < WGM ? (nM - fm) : WGM;
        u.pm = fm + ((wgid % nig) % gsz); u.pn = (wgid % nig) / gsz; return true;
    }
    __device__ __forceinline__ void a_ready(const Unit&) const {}
    __device__ __forceinline__ void done(const Unit&) const {}
};
__device__ __forceinline__ unsigned cvt_pk_bf16(float lo, float hi) { unsigned r; asm volatile("v_cvt_pk_bf16_f32 %0, %1, %2" : "=v"(r) : "v"(lo), "v"(hi)); return r; }
typedef float f32x2 __attribute__((ext_vector_type(2)));
__device__ __forceinline__ f32x2 gelu_pk(f32x2 v) {
    const f32x2 av = __builtin_elementwise_abs(v), d = av * 0.2316418882f + 1.0f;
    f32x2 t; t.x = __builtin_amdgcn_rcpf(d.x); t.y = __builtin_amdgcn_rcpf(d.y);
    f32x2 q = t * 0.5307027145f + (-0.7265760135f); q = q * t + 0.7107068705f; q = q * t + (-0.142248368f); q = q * t + 0.127414796f; q = q * t;
    const f32x2 s = (v * v) * (-0.72134752044f);
    f32x2 e; e.x = __builtin_amdgcn_exp2f(s.x); e.y = __builtin_amdgcn_exp2f(s.y);
    const f32x2 m = v * (q * e), r = v - m;
    f32x2 o; o.x = v.x < 0.f ? m.x : r.x; o.y = v.y < 0.f ? m.y : r.y; return o;
}
struct EpiProj {
    static constexpr bool PERM = true, AFTER_DRAIN = false;
    bf16_t* O; int ldc; int qtiles; float qscale;
    __device__ __forceinline__ void operator()(const f32x4 (&acc)[2][2][4][2], const Unit& u, int wr, int wc, int fr, int fq) const {
        const int row0 = u.pm * BM + wr * 64 + fr, col0 = u.pn * BM + wc * 32 + 8 * fq;
        const float sc = (u.pn < qtiles) ? qscale : 1.f;
#pragma unroll
        for (int ai = 0; ai < 2; ++ai)
#pragma unroll
            for (int m = 0; m < 4; ++m) { bf16_t* rowp = O + (size_t)(row0 + ai * HALF + m * 16) * ldc + col0;
#pragma unroll
                for (int bj = 0; bj < 2; ++bj) { const f32x4 v0 = acc[ai][bj][m][0] * sc, v1 = acc[ai][bj][m][1] * sc;
                    u32x4 w; w.x = cvt_pk_bf16(v0[0], v0[1]); w.y = cvt_pk_bf16(v0[2], v0[3]); w.z = cvt_pk_bf16(v1[0], v1[1]); w.w = cvt_pk_bf16(v1[2], v1[3]);
                    *(u32x4*)(rowp + bj * HALF) = w; } }
    }
};
struct EpiF32Res {
    static constexpr bool PERM = false, AFTER_DRAIN = false;
    float* C; int ldc; const float* res;
    __device__ __forceinline__ void operator()(const f32x4 (&acc)[2][2][4][2], const Unit& u, int wr, int wc, int fr, int fq) const {
        const int row0 = u.pm * BM + wr * 64 + fr, col0 = u.pn * BM + wc * 32 + 4 * fq;
#pragma unroll
        for (int ai = 0; ai < 2; ++ai)
#pragma unroll
            for (int m = 0; m < 4; ++m) { const size_t off = (size_t)(row0 + ai * HALF + m * 16) * ldc + col0;
#pragma unroll
                for (int bj = 0; bj < 2; ++bj)
#pragma unroll
                    for (int n = 0; n < 2; ++n) { f32x4 o = acc[ai][bj][m][n]; if (res) o = o + *(const f32x4*)(res + off + bj * HALF + n * 16);
                        *(f32x4*)(C + off + bj * HALF + n * 16) = o; } }
    }
};

struct EpiMix {
    static constexpr bool PERM = true, AFTER_DRAIN = false;
    int ldc; const float* res; const float* g2; bf16_t* HB; unsigned char* XB; float* ssq;
    __device__ __forceinline__ void operator()(const f32x4 (&acc)[2][2][4][2], const Unit& u, int wr, int wc, int fr, int fq) const {
        const int row0 = u.pm * BM + wr * 64 + fr, col0 = u.pn * BM + wc * 32 + 8 * fq;
        f32x4 gv[2][2];
#pragma unroll
        for (int bj = 0; bj < 2; ++bj)
#pragma unroll
            for (int n = 0; n < 2; ++n) gv[bj][n] = *(const f32x4*)(g2 + col0 + bj * HALF + 4 * n);
#pragma unroll
        for (int ai = 0; ai < 2; ++ai)
#pragma unroll
            for (int m = 0; m < 4; ++m) { const int row = row0 + ai * HALF + m * 16; const size_t off = (size_t)row * ldc + col0; float sq = 0.f;
#pragma unroll
                for (int bj = 0; bj < 2; ++bj) {
                    const f32x4 h0 = acc[ai][bj][m][0] + *(const f32x4*)(res + off + bj * HALF), h1 = acc[ai][bj][m][1] + *(const f32x4*)(res + off + bj * HALF + 4);
                    sq += (h0[0] * h0[0] + h0[1] * h0[1]) + (h0[2] * h0[2] + h0[3] * h0[3]) + (h1[0] * h1[0] + h1[1] * h1[1]) + (h1[2] * h1[2] + h1[3] * h1[3]);
                    u32x4 w; w.x = cvt_pk_bf16(h0[0], h0[1]); w.y = cvt_pk_bf16(h0[2], h0[3]); w.z = cvt_pk_bf16(h1[0], h1[1]); w.w = cvt_pk_bf16(h1[2], h1[3]);
                    *(u32x4*)(HB + off + bj * HALF) = w;
                    const f32x4 g0 = h0 * gv[bj][0], g1 = h1 * gv[bj][1];
                    int p0 = __builtin_amdgcn_cvt_pk_bf8_f32(g0[0], g0[1], 0, false); p0 = __builtin_amdgcn_cvt_pk_bf8_f32(g0[2], g0[3], p0, true);
                    int p1 = __builtin_amdgcn_cvt_pk_bf8_f32(g1[0], g1[1], 0, false); p1 = __builtin_amdgcn_cvt_pk_bf8_f32(g1[2], g1[3], p1, true);
                    typedef unsigned u32x2 __attribute__((ext_vector_type(2)));
                    *(u32x2*)(XB + off + bj * HALF) = (u32x2){(unsigned)p0, (unsigned)p1}; }
                sq += __shfl_xor(sq, 16); sq += __shfl_xor(sq, 32);
                if (fq == 0) atomicAdd(ssq + row, sq); }
    }
};
struct EpiScaleRow {
    static constexpr bool PERM = true, AFTER_DRAIN = false;
    _Float16* C; int ldc; const float* ssq; float invk, eps;
    __device__ __forceinline__ void operator()(const f32x4 (&acc)[2][2][4][2], const Unit& u, int wr, int wc, int fr, int fq) const {
        typedef _Float16 h2 __attribute__((ext_vector_type(2)));
        const int row0 = u.pm * BM + wr * 64 + fr, col0 = u.pn * BM + wc * 32 + 8 * fq;
#pragma unroll
        for (int ai = 0; ai < 2; ++ai)
#pragma unroll
            for (int m = 0; m < 4; ++m) { const int row = row0 + ai * HALF + m * 16; const size_t off = (size_t)row * ldc + col0; const float rs = 1.f / sqrtf(ssq[row] * invk + eps);
#pragma unroll
                for (int bj = 0; bj < 2; ++bj) { const f32x4 v0 = acc[ai][bj][m][0] * rs, v1 = acc[ai][bj][m][1] * rs;
                    const h2 p0 = {(_Float16)v0[0], (_Float16)v0[1]}, p1 = {(_Float16)v0[2], (_Float16)v0[3]}, p2 = {(_Float16)v1[0], (_Float16)v1[1]}, p3 = {(_Float16)v1[2], (_Float16)v1[3]};
                    u32x4 w; w.x = __builtin_bit_cast(unsigned, p0); w.y = __builtin_bit_cast(unsigned, p1); w.z = __builtin_bit_cast(unsigned, p2); w.w = __builtin_bit_cast(unsigned, p3);
                    *(u32x4*)(C + off + bj * HALF) = w; } }
    }
};
template <class Epi, class Sched, bool ALIGN_EPI = false, bool SP2 = false>
__device__ __forceinline__ void gemm_phase(PG8_LAS unsigned char* lds, const Gemm g, const Sched& S, const Epi& E) {
    const int tid = threadIdx.x, wid = __builtin_amdgcn_readfirstlane(tid >> 6), lane = tid & 63, wr = wid >> 2, wc = wid & 3, fr = lane & 15, fq = lane >> 4;
    const int K = g.K, nt = K / BK;
    unsigned voffA[2], voffB[2];
#pragma unroll
    for (int i = 0; i < 2; ++i) { int R, C; stage_rc(tid * 16 + i * 8192, R, C); const int Rb = Epi::PERM ? ((R & ~31) + perm32(R & 31)) : R;
        voffA[i] = (unsigned)(R * K + C) * 2u; voffB[i] = (unsigned)(Rb * K + C) * 2u; }
    const size_t kstep = (size_t)(BK * 2);
    const size_t hstep = (size_t)HALF * K * 2;
    const size_t tstep = 2 * hstep;
    const unsigned ldsw = (unsigned)wid * 1024u;
    const int aoff = lds_byte(wr * 64 + fr, fq * 8), boff = lds_byte(wc * 32 + fr, fq * 8);
#define PG8_SA(b, h) (((b) * 2 + (h)) * HTB)
#define PG8_SB(b, h) ((4 + (b) * 2 + (h)) * HTB)
#define PG8_STAGE(bufoff, gbase, voff) do { _Pragma("unroll") for (int _i = 0; _i < 2; ++_i) \
        __builtin_amdgcn_global_load_lds((const unsigned*)((const char*)(gbase) + (voff)[_i]), (PG8_LAS unsigned*)(lds + (bufoff) + ldsw + _i * 8192), 16, 0, 0); } while (0)
#define PG8_LDA(dst, b, h) do { _Pragma("unroll") for (int m = 0; m < 4; ++m) _Pragma("unroll") for (int k = 0; k < 2; ++k) dst[m][k] = *(const PG8_LAS bf16x8*)(lds + PG8_SA(b, h) + aoff + m * 2048 + k * 1024); } while (0)
#define PG8_LDB(dst, b, h) do { _Pragma("unroll") for (int n = 0; n < 2; ++n) _Pragma("unroll") for (int k = 0; k < 2; ++k) dst[n][k] = *(const PG8_LAS bf16x8*)(lds + PG8_SB(b, h) + boff + n * 2048 + k * 1024); } while (0)
#define PG8_MMA(ai, bj, At, Bt) do { __builtin_amdgcn_s_setprio(1); _Pragma("unroll") for (int m = 0; m < 4; ++m) _Pragma("unroll") for (int n = 0; n < 2; ++n) _Pragma("unroll") for (int k = 0; k < 2; ++k) \
        acc[ai][bj][m][n] = __builtin_amdgcn_mfma_f32_16x16x32_bf16(Bt[n][k], At[m][k], acc[ai][bj][m][n], 0, 0, 0); __builtin_amdgcn_s_setprio(0); } while (0)
#define PG8_WAIT_V(n) asm volatile("s_waitcnt vmcnt(" #n ")" ::: "memory")
#define PG8_WAIT_L(n) asm volatile("s_waitcnt lgkmcnt(" #n ")" ::: "memory")
#define PG8_BAR __builtin_amdgcn_s_barrier()
#define PG8_SCHED __builtin_amdgcn_sched_barrier(0)
    Unit cur, nxt; int ui = 0;
    if (!S.next(0, cur)) return;
    f32x4 acc[2][2][4][2];
#pragma unroll
    for (int a = 0; a < 2; ++a)
#pragma unroll
        for (int b = 0; b < 2; ++b)
#pragma unroll
            for (int m = 0; m < 4; ++m)
#pragma unroll
                for (int n = 0; n < 2; ++n) acc[a][b][m][n] = (f32x4){0.f, 0.f, 0.f, 0.f};
    bf16x8 At[4][2], B0[2][2], B1[2][2];
    const char* cA = (const char*)g.A + (size_t)cur.pm * tstep; const char* cB = (const char*)g.Bt + (size_t)cur.pn * tstep;
    S.a_ready(cur);
    if constexpr (SP2) {
        PG8_STAGE(PG8_SB(0, 0), cB, voffB); PG8_STAGE(PG8_SB(0, 1), cB + hstep, voffB); PG8_STAGE(PG8_SA(0, 0), cA, voffA); PG8_STAGE(PG8_SA(0, 1), cA + hstep, voffA);
        if (wr == 1) PG8_BAR;
        PG8_WAIT_V(2); PG8_BAR;
        PG8_STAGE(PG8_SB(1, 0), cB + kstep, voffB); PG8_STAGE(PG8_SA(1, 0), cA + kstep, voffA); PG8_STAGE(PG8_SB(1, 1), cB + hstep + kstep, voffB);
        PG8_WAIT_V(6); PG8_BAR;
    } else {
        PG8_STAGE(PG8_SB(0, 0), cB, voffB); PG8_STAGE(PG8_SA(0, 0), cA, voffA); PG8_STAGE(PG8_SB(0, 1), cB + hstep, voffB); PG8_STAGE(PG8_SA(0, 1), cA + hstep, voffA);
        if (wr == 1) PG8_BAR;
        PG8_WAIT_V(4); PG8_BAR;
        PG8_STAGE(PG8_SB(1, 0), cB + kstep, voffB); PG8_STAGE(PG8_SA(1, 0), cA + kstep, voffA); PG8_STAGE(PG8_SB(1, 1), cB + hstep + kstep, voffB);
        PG8_WAIT_V(6); PG8_BAR;
    }
    for (;;) {
        const bool has_next = S.next(ui + 1, nxt);
        const char* nA = has_next ? (const char*)g.A + (size_t)nxt.pm * tstep : cA; const char* nB = has_next ? (const char*)g.Bt + (size_t)nxt.pn * tstep : cB;
        for (int t = 0; t < nt; t += 2) {
            const bool last = (t == nt - 2);
            const char* a1 = cA + (size_t)(t + 1) * kstep;
            const char* a2 = last ? nA : cA + (size_t)(t + 2) * kstep; const char* b2 = last ? nB : cB + (size_t)(t + 2) * kstep;
            const char* a3 = a2 + kstep; const char* b3 = b2 + kstep;
            if (last && has_next) S.a_ready(nxt);
            if constexpr (SP2) {
            PG8_LDB(B0, 0, 0); PG8_LDB(B1, 0, 1); PG8_SCHED; PG8_LDA(At, 0, 0); PG8_STAGE(PG8_SA(1, 1), a1 + hstep, voffA);
            PG8_WAIT_V(8); PG8_WAIT_L(0); PG8_BAR; PG8_MMA(0, 0, At, B0); PG8_MMA(0, 1, At, B1); PG8_BAR; PG8_SCHED;
            PG8_LDA(At, 0, 1); PG8_STAGE(PG8_SB(0, 0), b2, voffB); PG8_STAGE(PG8_SB(0, 1), b2 + hstep, voffB); PG8_STAGE(PG8_SA(0, 0), a2, voffA);
            PG8_WAIT_V(8); PG8_WAIT_L(0); PG8_BAR; PG8_MMA(1, 0, At, B0); PG8_MMA(1, 1, At, B1); PG8_BAR; PG8_SCHED;
            PG8_LDB(B0, 1, 0); PG8_LDB(B1, 1, 1); PG8_SCHED; PG8_LDA(At, 1, 0); PG8_STAGE(PG8_SA(0, 1), a2 + hstep, voffA);
            PG8_WAIT_V(8); PG8_WAIT_L(0); PG8_BAR; PG8_MMA(0, 0, At, B0); PG8_MMA(0, 1, At, B1); PG8_BAR; PG8_SCHED;
            PG8_LDA(At, 1, 1); PG8_STAGE(PG8_SB(1, 0), b3, voffB); PG8_STAGE(PG8_SB(1, 1), b3 + hstep, voffB); PG8_STAGE(PG8_SA(1, 0), a3, voffA);
            PG8_WAIT_V(8); PG8_WAIT_L(0); PG8_BAR; PG8_MMA(1, 0, At, B0); PG8_MMA(1, 1, At, B1); PG8_BAR; PG8_SCHED;
            } else {
            PG8_LDB(B0, 0, 0); PG8_SCHED; PG8_LDA(At, 0, 0); PG8_STAGE(PG8_SA(1, 1), a1 + hstep, voffA);
            PG8_WAIT_L(8); PG8_BAR; PG8_WAIT_L(0); PG8_MMA(0, 0, At, B0); PG8_BAR; PG8_SCHED;
            PG8_LDB(B1, 0, 1); PG8_STAGE(PG8_SB(0, 0), b2, voffB);
            PG8_BAR; PG8_WAIT_L(0); PG8_MMA(0, 1, At, B1); PG8_BAR;
            PG8_LDA(At, 0, 1); PG8_STAGE(PG8_SA(0, 0), a2, voffA);
            PG8_BAR; PG8_WAIT_L(0); PG8_MMA(1, 0, At, B0); PG8_BAR; PG8_SCHED;
            PG8_STAGE(PG8_SB(0, 1), b2 + hstep, voffB);
            PG8_WAIT_V(6); PG8_BAR; PG8_MMA(1, 1, At, B1); PG8_BAR;
            PG8_LDB(B0, 1, 0); PG8_SCHED; PG8_LDA(At, 1, 0); PG8_STAGE(PG8_SA(0, 1), a2 + hstep, voffA);
            PG8_WAIT_L(8); PG8_BAR; PG8_WAIT_L(0); PG8_MMA(0, 0, At, B0); PG8_BAR; PG8_SCHED;
            PG8_LDB(B1, 1, 1); PG8_STAGE(PG8_SB(1, 0), b3, voffB);
            PG8_BAR; PG8_WAIT_L(0); PG8_MMA(0, 1, At, B1); PG8_BAR;
            PG8_LDA(At, 1, 1); PG8_STAGE(PG8_SA(1, 0), a3, voffA);
            PG8_BAR; PG8_WAIT_L(0); PG8_MMA(1, 0, At, B0); PG8_BAR; PG8_SCHED;
            PG8_STAGE(PG8_SB(1, 1), b3 + hstep, voffB);
            PG8_WAIT_V(6); PG8_BAR; PG8_MMA(1, 1, At, B1); PG8_BAR;
            }
        }
        if constexpr (ALIGN_EPI) { if (wr == 0) PG8_BAR; }
        if constexpr (!Epi::AFTER_DRAIN) { E(acc, cur, wr, wc, fr, fq); S.done(cur); }
        if (!has_next) break;
#pragma unroll
        for (int a = 0; a < 2; ++a)
#pragma unroll
            for (int b = 0; b < 2; ++b)
#pragma unroll
                for (int m = 0; m < 4; ++m)
#pragma unroll
                    for (int n = 0; n < 2; ++n) acc[a][b][m][n] = (f32x4){0.f, 0.f, 0.f, 0.f};
        cur = nxt; cA = nA; cB = nB; ++ui;
        if constexpr (ALIGN_EPI) { if (wr == 1) PG8_BAR; }
    }
    PG8_WAIT_V(0);
    if constexpr (!ALIGN_EPI) { if (wr == 0) PG8_BAR; }
    PG8_BAR;
    if constexpr (Epi::AFTER_DRAIN) { E.fused(acc, cur, wr, wc, fr, fq, lds, wid, lane); S.done(cur); }
#undef PG8_SA
#undef PG8_SB
#undef PG8_STAGE
#undef PG8_LDA
#undef PG8_LDB
#undef PG8_MMA
#undef PG8_WAIT_V
#undef PG8_WAIT_L
#undef PG8_BAR
#undef PG8_SCHED
}
}
#ifndef PG8_SP2
#define PG8_SP2 true
#endif
#ifndef PG8_ALIGN
#define PG8_ALIGN true
#endif

constexpr int NWAVES = 8;
constexpr int NTOK = 32768, DM = 1024, SEQ = 2048, NBATCH = 16, INW = 3584;
constexpr int C_DQ = 0, C_DK = 512, C_DV = 1024, C_HQ = 1536, C_HF = 2048, C_HI = 2560, C_HG = 3072;
constexpr float EPS = 1e-6f;
constexpr float QSCALE = 0.125f * 1.4426950408889634f;
constexpr float LAM_INIT = 0.2f;
constexpr int NEXP_SEL = 128;

constexpr size_t MiB = 1u << 20;
constexpr size_t WS_CTL = 0, CTL_ZERO_BYTES = 1 * MiB;
constexpr size_t WS_SMALL = 1 * MiB;
constexpr size_t WS_WIN = 2 * MiB;
constexpr size_t WS_WOUT = 10 * MiB;
constexpr size_t WS_W2 = 12 * MiB;
constexpr size_t WS_U8 = 17 * MiB;
constexpr size_t WS_V8 = 33 * MiB;
constexpr size_t WS_SU = 49 * MiB;
constexpr size_t WS_SV = 49 * MiB + 512 * 1024;
constexpr size_t WS_X8 = 50 * MiB;
constexpr size_t WS_SX = 116 * MiB;
constexpr size_t WS_GSU = 120 * MiB;
constexpr size_t WS_HN = 84 * MiB;
constexpr size_t WS_PROJ = 148 * MiB;
constexpr size_t WS_HN2 = 148 * MiB;
constexpr size_t WS_SC = 212 * MiB;
constexpr size_t WS_PO = 352 * MiB;
constexpr size_t WS_IDX = 468 * MiB;
constexpr size_t WS_GATE = 484 * MiB;
constexpr size_t WS_END = 500 * MiB;
constexpr int SM_LB = 0, SM_LAM = 512, SM_BIAS = 1024;
constexpr int CW_BAR = 4096;
constexpr int CW_ATTQ = 8192;
constexpr int CW_SSQ = 131072;

constexpr int RING_OFF = 0, RING_BYTES = 139264;
constexpr int LDSCTL_OFF = RING_BYTES, MISC_OFF = LDSCTL_OFF + 320;
constexpr int LDS_BYTES = 147456;

#define GAS __attribute__((address_space(1)))
#define LAS __attribute__((address_space(3)))
typedef unsigned short bf16;
typedef unsigned v4u __attribute__((ext_vector_type(4)));
typedef unsigned v2u __attribute__((ext_vector_type(2)));
typedef float f32x4 __attribute__((ext_vector_type(4)));
typedef short bf16x8 __attribute__((ext_vector_type(8)));
typedef GAS unsigned gu32;
typedef long l2 __attribute__((ext_vector_type(2)));
typedef int v4i __attribute__((ext_vector_type(4)));
#define RLX_AGENT __ATOMIC_RELAXED, __HIP_MEMORY_SCOPE_AGENT
#define LDS_WAIT() asm volatile("s_waitcnt lgkmcnt(0)" ::: "memory")
#define VM_WAIT() asm volatile("s_waitcnt vmcnt(0)" ::: "memory")
__device__ __forceinline__ unsigned f2bf(float f) { unsigned u = __builtin_bit_cast(unsigned, f); return (u + 0x7fffu + ((u >> 16) & 1u)) >> 16; }
__device__ __forceinline__ unsigned pk2(float lo, float hi) { return f2bf(lo) | (f2bf(hi) << 16); }
__device__ __forceinline__ float bflo(unsigned w) { return __builtin_bit_cast(float, w << 16); }
__device__ __forceinline__ float bfhi(unsigned w) { return __builtin_bit_cast(float, w & 0xffff0000u); }

#define XB_TMO      128
#define XB_XCNT(j)  (256  + 64 * (j))
#define XB_XSUB(j)  (1280 + 64 * (j))
#define XB_XGEN(j)  (2304 + 64 * (j))
#define XB_TOP      3328
#define XB_TOPGEN   3392
#define XCD_BAR_WORDS 3456
#define XB_SPIN_CAP (1u << 18)
__device__ __forceinline__ unsigned xb_ld(unsigned* p)              { return __hip_atomic_load(p, __ATOMIC_RELAXED, __HIP_MEMORY_SCOPE_AGENT); }
__device__ __forceinline__ unsigned xb_add(unsigned* p, unsigned v) { return __hip_atomic_fetch_add(p, v, __ATOMIC_RELAXED, __HIP_MEMORY_SCOPE_AGENT); }
__device__ __forceinline__ unsigned xb_xcc_id() { return (unsigned)__builtin_amdgcn_s_getreg((3 << 11) | 20) & 0xFu; }
#define XB_SPIN(cond, bar) do { unsigned _sp = 0; while (cond) { __builtin_amdgcn_s_sleep(1); \
    if ((++_sp & 255u) == 0u) { if (xb_ld(&(bar)[XB_TMO])) break; if (_sp > XB_SPIN_CAP) { atomicAdd(&(bar)[XB_TMO], 1u); break; } } } } while (0)
struct XcdBarrier { unsigned* bar; unsigned x; volatile LAS unsigned* st; };
__device__ __forceinline__ XcdBarrier xcd_barrier_post(unsigned* bar, volatile LAS unsigned* st) {
    XcdBarrier b; b.bar = bar; b.x = xb_xcc_id(); b.st = st;
    if (threadIdx.x == 0) (void)xb_add(&bar[XB_XCNT(b.x)], 1u);
    return b;
}
__device__ __forceinline__ void xcd_barrier_complete(unsigned* bar, unsigned x, unsigned& nloc, unsigned& nx) {
    const unsigned G = gridDim.x * gridDim.y * gridDim.z;
    unsigned sum, cnt, mine, sp = 0u;
    for (;;) {
        sum = 0u; cnt = 0u; mine = 0u;
#pragma unroll
        for (unsigned j = 0; j < 16; ++j) { const unsigned c = xb_ld(&bar[XB_XCNT(j)]); sum += c; cnt += (c > 0u) ? 1u : 0u; mine = (j == x) ? c : mine; }
        if (sum == G) break;
        __builtin_amdgcn_s_sleep(1);
        if ((++sp & 255u) == 0u) { if (xb_ld(&bar[XB_TMO])) break; if (sp > XB_SPIN_CAP) { atomicAdd(&bar[XB_TMO], 1u); break; } }
    }
    nloc = mine > 0u ? mine : 1u; nx = cnt > 0u ? cnt : 1u;
}
__device__ __forceinline__ void xcd_barrier(const XcdBarrier& b) {
    asm volatile("s_waitcnt vmcnt(0)" ::: "memory");
    __syncthreads();
    if (threadIdx.x == 0) {
        unsigned* bar = b.bar;
        __builtin_amdgcn_s_waitcnt(0);
        unsigned nloc = b.st[0], nx = b.st[1];
        if (nloc == 0u) { xcd_barrier_complete(bar, b.x, nloc, nx); b.st[0] = nloc; b.st[1] = nx; }
        const unsigned old = xb_add(&bar[XB_XSUB(b.x)], 1u);
        const unsigned gen = old / nloc;
        if (old + 1u == (gen + 1u) * nloc) {
            __builtin_amdgcn_fence(__ATOMIC_RELEASE, "agent");
            asm volatile("s_waitcnt vmcnt(0)" ::: "memory");
            const unsigned og = xb_add(&bar[XB_TOP], 1u);
            const unsigned tg = og / nx;
            if (og + 1u == (tg + 1u) * nx) xb_add(&bar[XB_TOPGEN], 1u);
            else XB_SPIN(xb_ld(&bar[XB_TOPGEN]) == tg, bar);
            __builtin_amdgcn_fence(__ATOMIC_ACQUIRE, "agent");
            xb_add(&bar[XB_XGEN(b.x)], 1u);
            asm volatile("s_waitcnt vmcnt(0)" ::: "memory");
        } else {
            XB_SPIN(xb_ld(&bar[XB_XGEN(b.x)]) == gen, bar);
            __builtin_amdgcn_fence(__ATOMIC_ACQUIRE, "agent");
            asm volatile("s_waitcnt vmcnt(0)" ::: "memory");
        }
    }
    __syncthreads();
}

#define SCHED_FENCE() __builtin_amdgcn_sched_barrier(0)
__device__ __forceinline__ float gelu_as(float v) {
    const float av = fabsf(v), t = __builtin_amdgcn_rcpf(av * 0.2316418882f + 1.0f);
    float q = t * 0.5307027145f + (-0.7265760135f); q = q * t + 0.7107068705f; q = q * t + (-0.142248368f); q = q * t + 0.127414796f; q = q * t;
    const float e = __builtin_amdgcn_exp2f((v * v) * (-0.72134752044f));
    const float mm = v * (q * e);
    return v < 0.f ? mm : v - mm;
}
struct Frame {
    LAS unsigned char* lds;
    volatile LAS unsigned* MISC;
    int tid, lane, wave, vcu, G;
    const float* in[18]; float* out; unsigned char* ws;
};
__device__ __forceinline__ float wave_sum(float v) {
#pragma unroll
    for (int o = 1; o < 64; o <<= 1) v += __shfl_xor(v, o);
    return v;
}
__device__ __forceinline__ float sigmoidf_(float x) { return 1.f / (1.f + __expf(-x)); }

__device__ __forceinline__ void p0_transpose_item(const float* W, int K, int N, bf16* WT, int row_off, LAS float* scr, int item, int lane) {
    const int nblk = N / 32, kb = item / nblk, nb = item % nblk, k0 = 64 * kb, n0 = 32 * nb;
#pragma unroll 8
    for (int i = 0; i < 32; ++i) { const int kk = 2 * i + (lane >> 5); scr[kk * 33 + (lane & 31)] = W[(size_t)(k0 + kk) * N + n0 + (lane & 31)]; }
    LDS_WAIT(); asm volatile("" ::: "memory");
    const int c = lane & 7;
#pragma unroll
    for (int j = 0; j < 4; ++j) { const int n = (lane >> 3) + 8 * j; const LAS float* s = scr + (8 * c) * 33 + n;
        v4u o; o.x = pk2(s[0 * 33], s[1 * 33]); o.y = pk2(s[2 * 33], s[3 * 33]); o.z = pk2(s[4 * 33], s[5 * 33]); o.w = pk2(s[6 * 33], s[7 * 33]);
        *(GAS v4u*)(WT + (size_t)(row_off + n0 + n) * K + k0 + 8 * c) = o; }
    LDS_WAIT(); asm volatile("" ::: "memory");
}

__device__ __forceinline__ void quant_vals_fp8(const f32x4 (&v)[4], unsigned char* dst, float* dq, int lane, size_t slice_stride) {
    float mx = 0.f;
#pragma unroll
    for (int j = 0; j < 4; ++j) mx = fmaxf(mx, fmaxf(fmaxf(fabsf(v[j].x), fabsf(v[j].y)), fmaxf(fabsf(v[j].z), fabsf(v[j].w))));
#pragma unroll
    for (int o = 1; o < 64; o <<= 1) mx = fmaxf(mx, __shfl_xor(mx, o));
    const float qs = mx > 0.f ? 224.f / mx : 1.f;
#pragma unroll
    for (int j = 0; j < 4; ++j) { int p = __builtin_amdgcn_cvt_pk_fp8_f32(v[j].x * qs, v[j].y * qs, 0, false); p = __builtin_amdgcn_cvt_pk_fp8_f32(v[j].z * qs, v[j].w * qs, p, true);
        const int d = 4 * lane + 256 * j; *(GAS unsigned*)(dst + (slice_stride ? (size_t)(d >> 7) * slice_stride + (d & 127) : (size_t)d)) = (unsigned)p; }
    if (lane == 0) *dq = mx > 0.f ? mx * (1.f / 224.f) : 1.f;
}
__device__ __forceinline__ void quant_row_fp8(const float* src, unsigned char* dst, float* dq, int lane, size_t slice_stride) {
    const GAS f32x4* xr = (const GAS f32x4*)src + lane; f32x4 v[4];
#pragma unroll
    for (int j = 0; j < 4; ++j) v[j] = xr[64 * j];
    quant_vals_fp8(v, dst, dq, lane, slice_stride);
}
__device__ __forceinline__ void p0_prologue(Frame& F) {
    LAS float* scr = (LAS float*)(F.lds + RING_OFF + F.wave * 16384);
    const int gw = F.vcu * NWAVES + F.wave, NGW = F.G * NWAVES;
    bf16* WinT = (bf16*)(F.ws + WS_WIN); bf16* WoutT = (bf16*)(F.ws + WS_WOUT); bf16* W2T = (bf16*)(F.ws + WS_W2);
    float* small = (float*)(F.ws + WS_SMALL);
    if (blockIdx.x == 0) {
        const int t = F.tid;
        { const float l0 = F.in[9][t], l1 = F.in[9][512 + t]; small[SM_LB + t] = 1.f / (1.f + expf(l1 - l0)); }
        { const int h = t >> 7, n = t & 127; int bk;
          if (n < 16) bk = n; else { bk = 16 + (int)(logf((float)n * (1.f / 16.f)) / logf(8.f) * 16.f); bk = bk > 31 ? 31 : bk; }
          small[SM_BIAS + t] = F.in[8][bk * 4 + h] * 1.4426950408889634f; }
        if (F.wave == 0) {
            const float a = wave_sum(F.in[3][F.lane] * F.in[4][F.lane]), b = wave_sum(F.in[5][F.lane] * F.in[6][F.lane]);
            if (F.lane == 0) small[SM_LAM] = expf(a) - expf(b) + LAM_INIT;
        }
    }
    constexpr int I_IN = (DM / 64) * (INW / 32), I_OUT = (DM / 64) * (DM / 32);
    for (int it = gw; it < I_IN + I_OUT; it += NGW) {
        if (it < I_IN) p0_transpose_item(F.in[2], DM, INW, WinT, 0, scr, it, F.lane);
        else p0_transpose_item(F.in[11], DM, DM, WoutT, 0, scr, it - I_IN, F.lane);
    }
    for (int u = F.vcu; u < 256; u += F.G) {
        const int hc = u >> 4, kb = u & 15, k = kb * 64 + F.lane;
        const GAS f32x4* wrow = (const GAS f32x4*)(F.in[13] + (size_t)k * 2048 + hc * 128);
        float a[16];
#pragma unroll
        for (int nn = 0; nn < 16; ++nn) a[nn] = 0.f;
        const float* kr = F.in[14] + ((size_t)hc * 128 + F.wave * 16) * 128;
        for (int i = 0; i < 32; ++i) {
            const f32x4 w = wrow[i];
#pragma unroll
            for (int nn = 0; nn < 16; ++nn) { const float* kk = kr + nn * 128 + 4 * i; a[nn] += (kk[0] * w.x + kk[1] * w.y) + (kk[2] * w.z + kk[3] * w.w); }
        }
        const float g2k = F.in[12][k];
#pragma unroll
        for (int nn = 0; nn < 16; ++nn) W2T[((size_t)hc * 128 + F.wave * 16 + nn) * DM + k] = (bf16)f2bf(a[nn] * g2k);
    }
    bf16* HN = (bf16*)(F.ws + WS_HN);
    for (int m = gw; m < NTOK; m += 2 * NGW) {
        const int m2 = m + NGW;
        const GAS f32x4* xa = (const GAS f32x4*)(F.in[0] + (size_t)m * DM) + F.lane; const GAS f32x4* xb = (const GAS f32x4*)(F.in[0] + (size_t)(m2 < NTOK ? m2 : m) * DM) + F.lane;
        const GAS f32x4* gr = (const GAS f32x4*)F.in[1] + F.lane;
        f32x4 va[4], vb[4]; float sa = 0.f, sb = 0.f;
#pragma unroll
        for (int j = 0; j < 4; ++j) { va[j] = xa[64 * j]; vb[j] = xb[64 * j]; }
#pragma unroll
        for (int j = 0; j < 4; ++j) { sa += (va[j].x * va[j].x + va[j].y * va[j].y) + (va[j].z * va[j].z + va[j].w * va[j].w); sb += (vb[j].x * vb[j].x + vb[j].y * vb[j].y) + (vb[j].z * vb[j].z + vb[j].w * vb[j].w); }
#pragma unroll
        for (int o = 1; o < 64; o <<= 1) { sa += __shfl_xor(sa, o); sb += __shfl_xor(sb, o); }
        const float ra = 1.f / sqrtf(sa * (1.f / DM) + EPS), rb = 1.f / sqrtf(sb * (1.f / DM) + EPS);
        GAS unsigned long long* oa = (GAS unsigned long long*)(HN + (size_t)m * DM) + F.lane; GAS unsigned long long* ob = (GAS unsigned long long*)(HN + (size_t)m2 * DM) + F.lane;
#pragma unroll
        for (int j = 0; j < 4; ++j) { const f32x4 gg = gr[64 * j];
            oa[64 * j] = (unsigned long long)pk2(va[j].x * ra * gg.x, va[j].y * ra * gg.y) | ((unsigned long long)pk2(va[j].z * ra * gg.z, va[j].w * ra * gg.w) << 32);
            if (m2 < NTOK) ob[64 * j] = (unsigned long long)pk2(vb[j].x * rb * gg.x, vb[j].y * rb * gg.y) | ((unsigned long long)pk2(vb[j].z * rb * gg.z, vb[j].w * rb * gg.w) << 32); }
    }
}


constexpr int QCHUNKS = 2 * 16384 / 64;
__device__ __forceinline__ void quant_chunk(Frame& F, int c) {
    unsigned char* U8 = F.ws + WS_U8; unsigned char* V8 = F.ws + WS_V8; float* SU = (float*)(F.ws + WS_SU); float* SV = (float*)(F.ws + WS_SV);
#pragma unroll 1
    for (int k = 0; k < 8; ++k) { const int rr = 64 * c + 8 * F.wave + k;
        if (rr < 16384) quant_row_fp8(F.in[15] + (size_t)rr * DM, U8 + (size_t)rr * 128, SU + rr, F.lane, (size_t)16384 * 128);
        else { const int e = rr - 16384; quant_row_fp8(F.in[16] + (size_t)e * DM, V8 + (size_t)e * 128, SV + e, F.lane, (size_t)16384 * 128); } }
}

__device__ __forceinline__ void quant_drain(Frame& F) {
    unsigned* qctr = (unsigned*)(F.ws + WS_CTL) + CW_ATTQ + 128;
    for (;;) {
        __syncthreads();
        if (F.tid == 0) F.MISC[13] = __hip_atomic_fetch_add(qctr, 1u, __ATOMIC_RELAXED, __HIP_MEMORY_SCOPE_AGENT);
        __syncthreads();
        const int qc = (int)F.MISC[13];
        if (qc >= QCHUNKS) break;
        quant_chunk(F, qc);
    }
}

typedef float f32x16 __attribute__((ext_vector_type(16)));
typedef short s16x4 __attribute__((ext_vector_type(4)));
typedef short v4i16_t __attribute__((ext_vector_type(4)));
typedef float f32x2_t __attribute__((ext_vector_type(2))); typedef __bf16 bf16x2_t __attribute__((ext_vector_type(2)));
__device__ __forceinline__ unsigned cvtpk_bf16(float lo, float hi) { f32x2_t v = {lo, hi}; bf16x2_t b = __builtin_convertvector(v, bf16x2_t); return __builtin_bit_cast(unsigned, b); }
__device__ __forceinline__ float xhalf_max(float v) { return fmaxf(v, __shfl_xor(v, 32)); }
__device__ __forceinline__ float xhalf_sum(float v) { return v + __shfl_xor(v, 32); }
__device__ __forceinline__ float max3f_(float a, float b, float c) { float r; asm("v_max3_f32 %0, %1, %2, %3" : "=v"(r) : "v"(a), "v"(b), "v"(c)); return r; }
constexpr int AT_KP = 144, AT_VP = 320, AT_K1 = 64 * AT_KP, AT_V = 2 * AT_K1, AT_BUF = AT_V + 64 * AT_VP;
constexpr int AT_XO = 0, AT_YB = 65536, AT_YP = 272, AT_TAB = 100352, AT_Q = 100864;
static_assert(AT_Q + 8 * 4096 <= RING_BYTES, "attention LDS map");
__device__ __forceinline__ void attn_mfma(Frame& F, int qslot) {
    const bf16* PROJ = (const bf16*)(F.ws + WS_PROJ); bf16* MIXED = (bf16*)(F.ws + WS_HN);
    const float* small = (const float*)(F.ws + WS_SMALL);
    LAS unsigned char* lds = F.lds;
    LAS float* TAB = (LAS float*)(lds + AT_TAB);
    const int tid = F.tid, lane = F.lane, wave = F.wave, map = wave >> 2, qt = wave & 3, r32 = lane & 31, hi = lane >> 5;
    const float lam = small[SM_LAM];
    const int koff = map * AT_K1 + r32 * AT_KP + hi * 16;
    const int voff = AT_V + (4 * hi + ((lane & 15) >> 2)) * AT_VP + (16 * ((lane >> 4) & 1) + 4 * (lane & 3)) * 2;
    unsigned* qctr = (unsigned*)(F.ws + WS_CTL) + CW_ATTQ + 64 * qslot;
    for (;;) {
        __syncthreads();
        if (tid == 0) F.MISC[12] = __hip_atomic_fetch_add(qctr, 1u, __ATOMIC_RELAXED, __HIP_MEMORY_SCOPE_AGENT);
        __syncthreads();
        const int L = (int)F.MISC[12];
        if (L >= 1024) break;
        const int qb = 15 - (L >> 6), bh = L & 63;
        const int b = bh >> 2, h = bh & 3, q0 = qb * 128; const size_t tok0 = (size_t)b * SEQ;
        const int NT = (q0 + 128) / 64;
        if (tid < 128) TAB[tid] = small[SM_BIAS + h * 128 + tid];
        LAS unsigned char* qlds = lds + AT_Q + wave * 4096 + lane * 16;
        { const bf16* qrow = PROJ + (tok0 + q0 + 32 * qt + r32) * INW + C_DQ + h * 128 + map * 64 + 8 * hi;
#pragma unroll
          for (int s4 = 0; s4 < 4; ++s4) *(LAS bf16x8*)(qlds + 1024 * s4) = *(const GAS bf16x8*)(qrow + 16 * s4); }
        const bf16* ksrc = PROJ + (tok0 + (tid >> 4)) * INW + C_DK + h * 128 + (tid & 15) * 8;
        const bf16* vsrc = PROJ + (tok0 + (tid >> 4)) * INW + C_DV + h * 128 + (tid & 15) * 8;
        const int kdst = ((tid & 15) >> 3) * AT_K1 + (tid >> 4) * AT_KP + (tid & 7) * 16, vdst = AT_V + (tid >> 4) * AT_VP + (tid & 15) * 16;
        v4u krA[2], vrA[2], krB[2], vrB[2];
#pragma unroll
        for (int i = 0; i < 2; ++i) { krB[i] = *(const GAS v4u*)(ksrc + (size_t)(32 * i) * INW); vrB[i] = *(const GAS v4u*)(vsrc + (size_t)(32 * i) * INW); }
#pragma unroll
        for (int i = 0; i < 2; ++i) { krA[i] = *(const GAS v4u*)(ksrc + (size_t)(64 + 32 * i) * INW); vrA[i] = *(const GAS v4u*)(vsrc + (size_t)(64 + 32 * i) * INW); }
#pragma unroll
        for (int i = 0; i < 2; ++i) { *(LAS v4u*)(lds + kdst + 32 * i * AT_KP) = krB[i]; *(LAS v4u*)(lds + vdst + 32 * i * AT_VP) = vrB[i]; }
        __syncthreads();
        const float bfar = TAB[127];
        f32x16 o[4];
#pragma unroll
        for (int mt = 0; mt < 4; ++mt) o[mt] = (f32x16){0.f,0.f,0.f,0.f,0.f,0.f,0.f,0.f,0.f,0.f,0.f,0.f,0.f,0.f,0.f,0.f};
        float mrun = -INFINITY, lsum = 0.f;
        const int qlo = q0 + 32 * qt, qpos = qlo + r32;
#pragma unroll
        for (int i = 0; i < 2; ++i) { if (2 < NT) { krB[i] = *(const GAS v4u*)(ksrc + (size_t)(128 + 32 * i) * INW); vrB[i] = *(const GAS v4u*)(vsrc + (size_t)(128 + 32 * i) * INW); } }
        for (int j2 = 0; j2 < NT; j2 += 2) {
          { const int j = j2;
            const int bo = (j & 1) * AT_BUF, bn = ((j + 1) & 1) * AT_BUF;
            if (64 * j <= qlo + 31) {
                f32x16 s0 = (f32x16){0.f,0.f,0.f,0.f,0.f,0.f,0.f,0.f,0.f,0.f,0.f,0.f,0.f,0.f,0.f,0.f}, s1 = s0;
#pragma unroll
                for (int s4 = 0; s4 < 4; ++s4) {
                    const bf16x8 a0 = *(const LAS bf16x8*)(lds + bo + koff + 32 * s4), a1 = *(const LAS bf16x8*)(lds + bo + koff + 32 * AT_KP + 32 * s4);
                    const bf16x8 qfr = *(const LAS bf16x8*)(qlds + 1024 * s4);
                    s0 = __builtin_amdgcn_mfma_f32_32x32x16_bf16(a0, qfr, s0, 0, 0, 0);
                    s1 = __builtin_amdgcn_mfma_f32_32x32x16_bf16(a1, qfr, s1, 0, 0, 0);
                }
                float tm, cadd;
                if (qlo - (64 * j + 63) < 127) {
                    const int kb = 64 * j + 4 * hi; tm = -INFINITY;
#pragma unroll
                    for (int r = 0; r < 16; ++r) { const int n0 = qpos - (kb + (r & 3) + 8 * (r >> 2)), n1 = n0 - 32;
                        float b0 = TAB[n0 > 127 ? 127 : (n0 < 0 ? 0 : n0)], b1 = TAB[n1 > 127 ? 127 : (n1 < 0 ? 0 : n1)];
                        asm volatile("" : "+v"(b0), "+v"(b1));
                        s0[r] = n0 < 0 ? -INFINITY : s0[r] + b0; s1[r] = n1 < 0 ? -INFINITY : s1[r] + b1; tm = max3f_(tm, s0[r], s1[r]); }
                    cadd = 0.f;
                } else {
                    tm = max3f_(s0[0], s1[0], s0[1]);
#pragma unroll
                    for (int r = 1; r < 15; ++r) tm = max3f_(tm, s1[r], s0[r + 1]);
                    tm = fmaxf(tm, s1[15]);
                    tm += bfar; cadd = bfar;
                }
                tm = xhalf_max(tm);
                if (__any(tm > mrun + 8.f)) {
                    const float mnew = fmaxf(mrun, tm), alpha = __builtin_amdgcn_exp2f(mrun - mnew);
                    lsum *= alpha; mrun = mnew;
#pragma unroll
                    for (int mt = 0; mt < 4; ++mt) o[mt] = o[mt] * alpha;
                }
                const float c = cadd - mrun; float psum = 0.f;
#pragma unroll
                for (int r = 0; r < 16; ++r) { s0[r] = __builtin_amdgcn_exp2f(s0[r] + c); s1[r] = __builtin_amdgcn_exp2f(s1[r] + c); psum += s0[r] + s1[r]; }
                lsum += psum;
#pragma unroll
                for (int kt2 = 0; kt2 < 2; ++kt2)
#pragma unroll
                    for (int sp = 0; sp < 2; ++sp) {
                        v4u pw;
                        if (kt2 == 0) { pw.x = cvtpk_bf16(s0[8 * sp], s0[8 * sp + 1]); pw.y = cvtpk_bf16(s0[8 * sp + 2], s0[8 * sp + 3]); pw.z = cvtpk_bf16(s0[8 * sp + 4], s0[8 * sp + 5]); pw.w = cvtpk_bf16(s0[8 * sp + 6], s0[8 * sp + 7]); }
                        else          { pw.x = cvtpk_bf16(s1[8 * sp], s1[8 * sp + 1]); pw.y = cvtpk_bf16(s1[8 * sp + 2], s1[8 * sp + 3]); pw.z = cvtpk_bf16(s1[8 * sp + 4], s1[8 * sp + 5]); pw.w = cvtpk_bf16(s1[8 * sp + 6], s1[8 * sp + 7]); }
                        const bf16x8 pf = __builtin_bit_cast(bf16x8, pw);
#pragma unroll
                        for (int mt = 0; mt < 4; ++mt) {
                            LAS unsigned char* vp = lds + bo + voff + (32 * kt2 + 16 * sp) * AT_VP + 64 * mt;
                            const s16x4 lo = __builtin_bit_cast(s16x4, __builtin_amdgcn_ds_read_tr16_b64_v4i16((LAS v4i16_t*)vp));
                            const s16x4 hi4 = __builtin_bit_cast(s16x4, __builtin_amdgcn_ds_read_tr16_b64_v4i16((LAS v4i16_t*)(vp + 8 * AT_VP)));
                            const bf16x8 af = (bf16x8){lo[0], lo[1], lo[2], lo[3], hi4[0], hi4[1], hi4[2], hi4[3]};
                            o[mt] = __builtin_amdgcn_mfma_f32_32x32x16_bf16(af, pf, o[mt], 0, 0, 0);
                        }
                    }
            }
            if (j + 1 < NT) {
#pragma unroll
                for (int i = 0; i < 2; ++i) { *(LAS v4u*)(lds + bn + kdst + 32 * i * AT_KP) = krA[i]; *(LAS v4u*)(lds + bn + vdst + 32 * i * AT_VP) = vrA[i]; }
                if (j + 3 < NT) {
#pragma unroll
                    for (int i = 0; i < 2; ++i) { krA[i] = *(const GAS v4u*)(ksrc + (size_t)(64 * (j + 3) + 32 * i) * INW); vrA[i] = *(const GAS v4u*)(vsrc + (size_t)(64 * (j + 3) + 32 * i) * INW); }
                }
            }
            __syncthreads();
                  }
          { const int j = j2 + 1;
            const int bo = (j & 1) * AT_BUF, bn = ((j + 1) & 1) * AT_BUF;
            if (64 * j <= qlo + 31) {
                f32x16 s0 = (f32x16){0.f,0.f,0.f,0.f,0.f,0.f,0.f,0.f,0.f,0.f,0.f,0.f,0.f,0.f,0.f,0.f}, s1 = s0;
#pragma unroll
                for (int s4 = 0; s4 < 4; ++s4) {
                    const bf16x8 a0 = *(const LAS bf16x8*)(lds + bo + koff + 32 * s4), a1 = *(const LAS bf16x8*)(lds + bo + koff + 32 * AT_KP + 32 * s4);
                    const bf16x8 qfr = *(const LAS bf16x8*)(qlds + 1024 * s4);
                    s0 = __builtin_amdgcn_mfma_f32_32x32x16_bf16(a0, qfr, s0, 0, 0, 0);
                    s1 = __builtin_amdgcn_mfma_f32_32x32x16_bf16(a1, qfr, s1, 0, 0, 0);
                }
                float tm, cadd;
                if (qlo - (64 * j + 63) < 127) {
                    const int kb = 64 * j + 4 * hi; tm = -INFINITY;
#pragma unroll
                    for (int r = 0; r < 16; ++r) { const int n0 = qpos - (kb + (r & 3) + 8 * (r >> 2)), n1 = n0 - 32;
                        float b0 = TAB[n0 > 127 ? 127 : (n0 < 0 ? 0 : n0)], b1 = TAB[n1 > 127 ? 127 : (n1 < 0 ? 0 : n1)];
                        asm volatile("" : "+v"(b0), "+v"(b1));
                        s0[r] = n0 < 0 ? -INFINITY : s0[r] + b0; s1[r] = n1 < 0 ? -INFINITY : s1[r] + b1; tm = max3f_(tm, s0[r], s1[r]); }
                    cadd = 0.f;
                } else {
                    tm = max3f_(s0[0], s1[0], s0[1]);
#pragma unroll
                    for (int r = 1; r < 15; ++r) tm = max3f_(tm, s1[r], s0[r + 1]);
                    tm = fmaxf(tm, s1[15]);
                    tm += bfar; cadd = bfar;
                }
                tm = xhalf_max(tm);
                if (__any(tm > mrun + 8.f)) {
                    const float mnew = fmaxf(mrun, tm), alpha = __builtin_amdgcn_exp2f(mrun - mnew);
                    lsum *= alpha; mrun = mnew;
#pragma unroll
                    for (int mt = 0; mt < 4; ++mt) o[mt] = o[mt] * alpha;
                }
                const float c = cadd - mrun; float psum = 0.f;
#pragma unroll
                for (int r = 0; r < 16; ++r) { s0[r] = __builtin_amdgcn_exp2f(s0[r] + c); s1[r] = __builtin_amdgcn_exp2f(s1[r] + c); psum += s0[r] + s1[r]; }
                lsum += psum;
#pragma unroll
                for (int kt2 = 0; kt2 < 2; ++kt2)
#pragma unroll
                    for (int sp = 0; sp < 2; ++sp) {
                        v4u pw;
                        if (kt2 == 0) { pw.x = cvtpk_bf16(s0[8 * sp], s0[8 * sp + 1]); pw.y = cvtpk_bf16(s0[8 * sp + 2], s0[8 * sp + 3]); pw.z = cvtpk_bf16(s0[8 * sp + 4], s0[8 * sp + 5]); pw.w = cvtpk_bf16(s0[8 * sp + 6], s0[8 * sp + 7]); }
                        else          { pw.x = cvtpk_bf16(s1[8 * sp], s1[8 * sp + 1]); pw.y = cvtpk_bf16(s1[8 * sp + 2], s1[8 * sp + 3]); pw.z = cvtpk_bf16(s1[8 * sp + 4], s1[8 * sp + 5]); pw.w = cvtpk_bf16(s1[8 * sp + 6], s1[8 * sp + 7]); }
                        const bf16x8 pf = __builtin_bit_cast(bf16x8, pw);
#pragma unroll
                        for (int mt = 0; mt < 4; ++mt) {
                            LAS unsigned char* vp = lds + bo + voff + (32 * kt2 + 16 * sp) * AT_VP + 64 * mt;
                            const s16x4 lo = __builtin_bit_cast(s16x4, __builtin_amdgcn_ds_read_tr16_b64_v4i16((LAS v4i16_t*)vp));
                            const s16x4 hi4 = __builtin_bit_cast(s16x4, __builtin_amdgcn_ds_read_tr16_b64_v4i16((LAS v4i16_t*)(vp + 8 * AT_VP)));
                            const bf16x8 af = (bf16x8){lo[0], lo[1], lo[2], lo[3], hi4[0], hi4[1], hi4[2], hi4[3]};
                            o[mt] = __builtin_amdgcn_mfma_f32_32x32x16_bf16(af, pf, o[mt], 0, 0, 0);
                        }
                    }
            }
            if (j + 1 < NT) {
#pragma unroll
                for (int i = 0; i < 2; ++i) { *(LAS v4u*)(lds + bn + kdst + 32 * i * AT_KP) = krB[i]; *(LAS v4u*)(lds + bn + vdst + 32 * i * AT_VP) = vrB[i]; }
                if (j + 3 < NT) {
#pragma unroll
                    for (int i = 0; i < 2; ++i) { krB[i] = *(const GAS v4u*)(ksrc + (size_t)(64 * (j + 3) + 32 * i) * INW); vrB[i] = *(const GAS v4u*)(vsrc + (size_t)(64 * (j + 3) + 32 * i) * INW); }
                }
            }
            __syncthreads();
                  }
        }
        const float inv = 1.f / xhalf_sum(lsum);
        LAS float* XO = (LAS float*)(lds + AT_XO) + qt * 4096 + r32;
        if (map == 1) {
            const float sc = inv * lam;
#pragma unroll
            for (int mt = 0; mt < 4; ++mt)
#pragma unroll
                for (int r = 0; r < 16; ++r) XO[(32 * mt + (r & 3) + 8 * (r >> 2) + 4 * hi) * 32] = o[mt][r] * sc;
        }
        __syncthreads();
        if (map == 0) {
            float ss = 0.f;
#pragma unroll
            for (int mt = 0; mt < 4; ++mt)
#pragma unroll
                for (int r = 0; r < 16; ++r) { const float a = o[mt][r] * inv - XO[(32 * mt + (r & 3) + 8 * (r >> 2) + 4 * hi) * 32]; o[mt][r] = a; ss += a * a; }
            ss = xhalf_sum(ss);
            const float rr = (1.f - LAM_INIT) / sqrtf(ss * (1.f / 128.f) + EPS);
            LAS unsigned char* yb = lds + AT_YB + qt * (32 * AT_YP);
#pragma unroll
            for (int mt = 0; mt < 4; ++mt)
#pragma unroll
                for (int r4 = 0; r4 < 4; ++r4) { const int dv = 32 * mt + 8 * r4 + 4 * hi; const f32x4 gg = *(const GAS f32x4*)(F.in[7] + dv);
                    v2u w; w.x = cvtpk_bf16(o[mt][4 * r4] * rr * gg.x, o[mt][4 * r4 + 1] * rr * gg.y); w.y = cvtpk_bf16(o[mt][4 * r4 + 2] * rr * gg.z, o[mt][4 * r4 + 3] * rr * gg.w);
                    *(LAS v2u*)(yb + r32 * AT_YP + dv * 2) = w; }
            LDS_WAIT(); asm volatile("" ::: "memory");
            bf16* obase = MIXED + (tok0 + q0 + 32 * qt) * DM + h * 128;
#pragma unroll
            for (int i = 0; i < 8; ++i) { const int id = lane + 64 * i, row = id >> 4, cch = id & 15;
                const v4u w = *(const LAS v4u*)(yb + row * AT_YP + cch * 16); *(GAS v4u*)(obase + (size_t)row * DM + cch * 8) = w; }
        }
    }
}


constexpr int HG_P = 272, HG_KP = 80, HG_VP = 320;
constexpr int HG_QD = 0, HG_KI = 32 * HG_P, HG_KDT = 2 * 32 * HG_P, HG_V = HG_KDT + 128 * HG_KP, HG_CD = HG_V + 32 * HG_VP, HG_BUF = HG_CD + 512;
constexpr int HG_OA = 2 * HG_BUF, HG_OB = HG_OA + 32 * 128 * 4;
static_assert(HG_OB + 32 * 128 * 4 <= RING_BYTES, "hgrn LDS map");
__device__ __forceinline__ bf16x8 pack8(const f32x16& x, int s) {
    v4u p; p.x = cvtpk_bf16(x[8 * s], x[8 * s + 1]); p.y = cvtpk_bf16(x[8 * s + 2], x[8 * s + 3]); p.z = cvtpk_bf16(x[8 * s + 4], x[8 * s + 5]); p.w = cvtpk_bf16(x[8 * s + 6], x[8 * s + 7]);
    return __builtin_bit_cast(bf16x8, p);
}
__device__ __forceinline__ bf16x8 tr_pair(LAS unsigned char* p0, LAS unsigned char* p1) {
    const s16x4 lo = __builtin_bit_cast(s16x4, __builtin_amdgcn_ds_read_tr16_b64_v4i16((LAS v4i16_t*)p0));
    const s16x4 hi4 = __builtin_bit_cast(s16x4, __builtin_amdgcn_ds_read_tr16_b64_v4i16((LAS v4i16_t*)p1));
    return (bf16x8){lo[0], lo[1], lo[2], lo[3], hi4[0], hi4[1], hi4[2], hi4[3]};
}
__device__ __forceinline__ void hgrn_mfma(Frame& F) {
    const bf16* PROJ = (const bf16*)(F.ws + WS_PROJ); bf16* MIXED = (bf16*)(F.ws + WS_HN);
    const float* small = (const float*)(F.ws + WS_SMALL);
    LAS unsigned char* lds = F.lds;
    const int tid = F.tid, lane = F.lane, wave = F.wave, r32 = lane & 31, hh = lane >> 5;
    const int dvt = wave & 3, dkh = wave >> 2;
    const int pc = lane & 31, pdk8 = 16 * wave + 8 * (lane >> 5);
    const int kdoff = (((lane & 15) >> 2)) * HG_VP + (16 * ((lane >> 4) & 1) + 4 * (lane & 3)) * 2;
    const int vc = tid >> 4, vseg = tid & 15;
    const int troff = (((lane & 15) >> 2)) * HG_VP + (32 * dvt + 16 * ((lane >> 4) & 1) + 4 * (lane & 3)) * 2;
    for (int u = F.vcu; u < 64; u += F.G) {
        const int b = u >> 2, h = u & 3; const size_t tok0 = (size_t)b * SEQ;
        const f32x4 lbA = *(const GAS f32x4*)(small + SM_LB + h * 128 + pdk8), lbB = *(const GAS f32x4*)(small + SM_LB + h * 128 + pdk8 + 4);
        const float lbv[8] = {lbA.x, lbA.y, lbA.z, lbA.w, lbB.x, lbB.y, lbB.z, lbB.w};
        const f32x4 g0 = *(const GAS f32x4*)(F.in[10] + 8 * vseg), g1 = *(const GAS f32x4*)(F.in[10] + 8 * vseg + 4);
        f32x16 S0, S1;
#pragma unroll
        for (int r = 0; r < 16; ++r) { S0[r] = 0.f; S1[r] = 0.f; }
        v4u rqA, rfA, rqB, rfB, rvA, rgA, rvB, rgB;
#define HG_LOAD(S, chn) do { const bf16* p_ = PROJ + (tok0 + 32 * (chn) + pc) * INW + h * 128 + pdk8; \
            asm volatile("global_load_dwordx4 %0, %1, off" : "=v"(rq##S) : "v"(p_ + C_HQ) : "memory"); \
            asm volatile("global_load_dwordx4 %0, %1, off" : "=v"(rf##S) : "v"(p_ + C_HF) : "memory"); \
            asm volatile("global_load_dwordx4 %0, %1, off" : "=v"(rv##S) : "v"(PROJ + (tok0 + 32 * (chn) + vc) * INW + C_HI + h * 128 + vseg * 8) : "memory"); } while (0)
#define HG_LOADG(S, chn) do { asm volatile("global_load_dwordx4 %0, %1, off" : "=v"(rg##S) : "v"(PROJ + (tok0 + 32 * (chn) + vc) * INW + C_HG + h * 128 + vseg * 8) : "memory"); } while (0)
#define HG_WAIT_RAW(S) asm volatile("s_waitcnt vmcnt(7)" : "+v"(rq##S), "+v"(rf##S), "+v"(rv##S) :: "memory")
#define HG_WAIT_G(S) asm volatile("s_waitcnt vmcnt(8)" : "+v"(rg##S) :: "memory")
        HG_LOAD(A, 0); HG_LOADG(A, 0); HG_LOAD(B, 1); HG_LOADG(B, 1);
        asm volatile("s_waitcnt vmcnt(0)" : "+v"(rvA), "+v"(rgA), "+v"(rvB), "+v"(rgB) :: "memory");
        __syncthreads();
        for (int ch2 = 0; ch2 < SEQ / 32; ch2 += 2) {
          { const int ch = ch2;
            LAS unsigned char* bufp = lds + (ch & 1) * HG_BUF;
            HG_WAIT_RAW(A);
            { float bb[8], fv[8];
              const unsigned fw[4] = {rfA.x, rfA.y, rfA.z, rfA.w}, qw[4] = {rqA.x, rqA.y, rqA.z, rqA.w};
#pragma unroll
              for (int i = 0; i < 8; ++i) { const float x = (i & 1) ? bfhi(fw[i >> 1]) : bflo(fw[i >> 1]); const float f = lbv[i] + (1.f - lbv[i]) * __builtin_amdgcn_rcpf(1.f + __expf(-x)); fv[i] = f; bb[i] = f; }
#pragma unroll
              for (int i = 0; i < 8; ++i) { float x = bb[i];
                  x *= __builtin_bit_cast(float, __builtin_amdgcn_update_dpp(0x3f800000, __builtin_bit_cast(int, x), 0x111, 0xf, 0xf, false));
                  x *= __builtin_bit_cast(float, __builtin_amdgcn_update_dpp(0x3f800000, __builtin_bit_cast(int, x), 0x112, 0xf, 0xf, false));
                  x *= __builtin_bit_cast(float, __builtin_amdgcn_update_dpp(0x3f800000, __builtin_bit_cast(int, x), 0x114, 0xf, 0xf, false));
                  x *= __builtin_bit_cast(float, __builtin_amdgcn_update_dpp(0x3f800000, __builtin_bit_cast(int, x), 0x118, 0xf, 0xf, false));
                  x *= __builtin_bit_cast(float, __builtin_amdgcn_update_dpp(0x3f800000, __builtin_bit_cast(int, x), 0x142, 0xa, 0xf, false));
                  bb[i] = x; }
              unsigned qd[8], ki[8], kd[8]; float cdv[8];
#pragma unroll
              for (int i = 0; i < 8; ++i) { const float elast = __shfl(bb[i], (lane & 32) + 31);
                  const float e = bb[i], ei = __builtin_amdgcn_rcpf(bb[i]), ed = elast * ei;
                  const float xq = (i & 1) ? bfhi(qw[i >> 1]) : bflo(qw[i >> 1]); const float q = xq * __builtin_amdgcn_rcpf(1.f + __expf(-xq)); const float k = 1.f - fv[i];
                  qd[i] = f2bf(q * e); ki[i] = f2bf(k * ei); kd[i] = f2bf(k * ed); cdv[i] = elast; }
              *(LAS v4u*)(bufp + HG_QD + pc * HG_P + pdk8 * 2) = (v4u){qd[0] | (qd[1] << 16), qd[2] | (qd[3] << 16), qd[4] | (qd[5] << 16), qd[6] | (qd[7] << 16)};
              *(LAS v4u*)(bufp + HG_KI + pc * HG_P + pdk8 * 2) = (v4u){ki[0] | (ki[1] << 16), ki[2] | (ki[3] << 16), ki[4] | (ki[5] << 16), ki[6] | (ki[7] << 16)};
              *(LAS v4u*)(bufp + HG_KDT + pc * HG_VP + pdk8 * 2) = (v4u){kd[0] | (kd[1] << 16), kd[2] | (kd[3] << 16), kd[4] | (kd[5] << 16), kd[6] | (kd[7] << 16)};
              if (pc == 31) { *(LAS f32x4*)(bufp + HG_CD + pdk8 * 4) = (f32x4){cdv[0], cdv[1], cdv[2], cdv[3]}; *(LAS f32x4*)(bufp + HG_CD + pdk8 * 4 + 16) = (f32x4){cdv[4], cdv[5], cdv[6], cdv[7]}; }
              *(LAS v4u*)(bufp + HG_V + vc * HG_VP + vseg * 16) = rvA; }
            HG_LOAD(A, (ch + 2 < SEQ / 32 ? ch + 2 : SEQ / 32 - 1));
            __syncthreads();
            f32x16 o;
#pragma unroll
            for (int r = 0; r < 16; ++r) o[r] = 0.f;
#pragma unroll
            for (int kk = 0; kk < 2; ++kk)
#pragma unroll
                for (int s2 = 0; s2 < 2; ++s2) {
                    LAS unsigned char* qa = bufp + HG_QD + r32 * HG_P + (32 * (2 * dkh + kk) + 16 * s2 + 4 * hh) * 2;
                    const v2u a0 = *(const LAS v2u*)qa, a1 = *(const LAS v2u*)(qa + 16);
                    const bf16x8 af = __builtin_bit_cast(bf16x8, (v4u){a0.x, a0.y, a1.x, a1.y});
                    o = __builtin_amdgcn_mfma_f32_32x32x16_bf16(af, pack8(kk == 0 ? S0 : S1, s2), o, 0, 0, 0);
                }
            if (wave < 4) {
                f32x16 X;
#pragma unroll
                for (int r = 0; r < 16; ++r) X[r] = 0.f;
#pragma unroll
                for (int s8 = 0; s8 < 8; ++s8) {
                    const bf16x8 af = *(const LAS bf16x8*)(bufp + HG_KI + r32 * HG_P + (16 * s8 + 8 * hh) * 2);
                    const bf16x8 bfr = *(const LAS bf16x8*)(bufp + HG_QD + r32 * HG_P + (16 * s8 + 8 * hh) * 2);
                    X = __builtin_amdgcn_mfma_f32_32x32x16_bf16(af, bfr, X, 0, 0, 0);
                }
#pragma unroll
                for (int r = 0; r < 16; ++r) { const int cp = (r & 3) + 8 * (r >> 2) + 4 * hh; X[r] = cp > r32 ? 0.f : X[r]; }
#pragma unroll
                for (int s2 = 0; s2 < 2; ++s2) {
                    LAS unsigned char* vp = bufp + HG_V + troff + (16 * s2 + 4 * hh) * HG_VP;
                    o = __builtin_amdgcn_mfma_f32_32x32x16_bf16(pack8(X, s2), tr_pair(vp, vp + 8 * HG_VP), o, 0, 0, 0);
                }
            }
            { LAS float* ob = (LAS float*)(lds + (wave < 4 ? HG_OA : HG_OB)) + 32 * dvt + r32;
#pragma unroll
              for (int r = 0; r < 16; ++r) ob[((r & 3) + 8 * (r >> 2) + 4 * hh) * 128] = o[r]; }
#pragma unroll
            for (int kk = 0; kk < 2; ++kk) {
                const int dk0 = 32 * (2 * dkh + kk);
                const LAS float* cdp = (const LAS float*)(bufp + HG_CD) + dk0 + 4 * hh;
#pragma unroll
                for (int r4 = 0; r4 < 4; ++r4) { const f32x4 c4 = *(const LAS f32x4*)(cdp + 8 * r4);
                    if (kk == 0) { S0[4 * r4] *= c4.x; S0[4 * r4 + 1] *= c4.y; S0[4 * r4 + 2] *= c4.z; S0[4 * r4 + 3] *= c4.w; }
                    else         { S1[4 * r4] *= c4.x; S1[4 * r4 + 1] *= c4.y; S1[4 * r4 + 2] *= c4.z; S1[4 * r4 + 3] *= c4.w; } }
#pragma unroll
                for (int s2 = 0; s2 < 2; ++s2) {
                    LAS unsigned char* kp = bufp + HG_KDT + kdoff + (16 * s2 + 8 * hh) * HG_VP + dk0 * 2;
                    const bf16x8 af = tr_pair(kp, kp + 4 * HG_VP);
                    LAS unsigned char* vp = bufp + HG_V + troff + (16 * s2 + 8 * hh) * HG_VP;
                    const bf16x8 bfr = tr_pair(vp, vp + 4 * HG_VP);
                    if (kk == 0) S0 = __builtin_amdgcn_mfma_f32_32x32x16_bf16(af, bfr, S0, 0, 0, 0);
                    else         S1 = __builtin_amdgcn_mfma_f32_32x32x16_bf16(af, bfr, S1, 0, 0, 0);
                }
            }
            __syncthreads();
            { const LAS float* oa = (const LAS float*)(lds + HG_OA) + vc * 128 + 8 * vseg; const LAS float* ob = (const LAS float*)(lds + HG_OB) + vc * 128 + 8 * vseg;
              const f32x4 x0 = *(const LAS f32x4*)oa + *(const LAS f32x4*)ob, x1 = *(const LAS f32x4*)(oa + 4) + *(const LAS f32x4*)(ob + 4);
              float ss = (x0.x * x0.x + x0.y * x0.y) + (x0.z * x0.z + x0.w * x0.w) + (x1.x * x1.x + x1.y * x1.y) + (x1.z * x1.z + x1.w * x1.w);
              ss += __shfl_xor(ss, 1); ss += __shfl_xor(ss, 2); ss += __shfl_xor(ss, 4); ss += __shfl_xor(ss, 8);
              const float rr = 1.f / sqrtf(ss * (1.f / 128.f) + EPS);
              const size_t tok = tok0 + 32 * ch + vc;
              HG_WAIT_G(A);
              const unsigned ga[4] = {rgA.x, rgA.y, rgA.z, rgA.w};
              const float ov[8] = {x0.x, x0.y, x0.z, x0.w, x1.x, x1.y, x1.z, x1.w}; const float gg[8] = {g0.x, g0.y, g0.z, g0.w, g1.x, g1.y, g1.z, g1.w};
              unsigned w[4];
#pragma unroll
              for (int j = 0; j < 4; ++j) { const float a0 = bflo(ga[j]), a1 = bfhi(ga[j]);
                  w[j] = pk2(ov[2 * j] * rr * gg[2 * j] * (a0 * __builtin_amdgcn_rcpf(1.f + __expf(-a0))), ov[2 * j + 1] * rr * gg[2 * j + 1] * (a1 * __builtin_amdgcn_rcpf(1.f + __expf(-a1)))); }
              *(GAS v4u*)(MIXED + tok * DM + 512 + h * 128 + 8 * vseg) = (v4u){w[0], w[1], w[2], w[3]}; }
            HG_LOADG(A, (ch + 2 < SEQ / 32 ? ch + 2 : SEQ / 32 - 1));
          }
          { const int ch = ch2 + 1;
            LAS unsigned char* bufp = lds + (ch & 1) * HG_BUF;
            HG_WAIT_RAW(B);
            { float bb[8], fv[8];
              const unsigned fw[4] = {rfB.x, rfB.y, rfB.z, rfB.w}, qw[4] = {rqB.x, rqB.y, rqB.z, rqB.w};
#pragma unroll
              for (int i = 0; i < 8; ++i) { const float x = (i & 1) ? bfhi(fw[i >> 1]) : bflo(fw[i >> 1]); const float f = lbv[i] + (1.f - lbv[i]) * __builtin_amdgcn_rcpf(1.f + __expf(-x)); fv[i] = f; bb[i] = f; }
#pragma unroll
              for (int i = 0; i < 8; ++i) { float x = bb[i];
                  x *= __builtin_bit_cast(float, __builtin_amdgcn_update_dpp(0x3f800000, __builtin_bit_cast(int, x), 0x111, 0xf, 0xf, false));
                  x *= __builtin_bit_cast(float, __builtin_amdgcn_update_dpp(0x3f800000, __builtin_bit_cast(int, x), 0x112, 0xf, 0xf, false));
                  x *= __builtin_bit_cast(float, __builtin_amdgcn_update_dpp(0x3f800000, __builtin_bit_cast(int, x), 0x114, 0xf, 0xf, false));
                  x *= __builtin_bit_cast(float, __builtin_amdgcn_update_dpp(0x3f800000, __builtin_bit_cast(int, x), 0x118, 0xf, 0xf, false));
                  x *= __builtin_bit_cast(float, __builtin_amdgcn_update_dpp(0x3f800000, __builtin_bit_cast(int, x), 0x142, 0xa, 0xf, false));
                  bb[i] = x; }
              unsigned qd[8], ki[8], kd[8]; float cdv[8];
#pragma unroll
              for (int i = 0; i < 8; ++i) { const float elast = __shfl(bb[i], (lane & 32) + 31);
                  const float e = bb[i], ei = __builtin_amdgcn_rcpf(bb[i]), ed = elast * ei;
                  const float xq = (i & 1) ? bfhi(qw[i >> 1]) : bflo(qw[i >> 1]); const float q = xq * __builtin_amdgcn_rcpf(1.f + __expf(-xq)); const float k = 1.f - fv[i];
                  qd[i] = f2bf(q * e); ki[i] = f2bf(k * ei); kd[i] = f2bf(k * ed); cdv[i] = elast; }
              *(LAS v4u*)(bufp + HG_QD + pc * HG_P + pdk8 * 2) = (v4u){qd[0] | (qd[1] << 16), qd[2] | (qd[3] << 16), qd[4] | (qd[5] << 16), qd[6] | (qd[7] << 16)};
              *(LAS v4u*)(bufp + HG_KI + pc * HG_P + pdk8 * 2) = (v4u){ki[0] | (ki[1] << 16), ki[2] | (ki[3] << 16), ki[4] | (ki[5] << 16), ki[6] | (ki[7] << 16)};
              *(LAS v4u*)(bufp + HG_KDT + pc * HG_VP + pdk8 * 2) = (v4u){kd[0] | (kd[1] << 16), kd[2] | (kd[3] << 16), kd[4] | (kd[5] << 16), kd[6] | (kd[7] << 16)};
              if (pc == 31) { *(LAS f32x4*)(bufp + HG_CD + pdk8 * 4) = (f32x4){cdv[0], cdv[1], cdv[2], cdv[3]}; *(LAS f32x4*)(bufp + HG_CD + pdk8 * 4 + 16) = (f32x4){cdv[4], cdv[5], cdv[6], cdv[7]}; }
              *(LAS v4u*)(bufp + HG_V + vc * HG_VP + vseg * 16) = rvB; }
            HG_LOAD(B, (ch + 2 < SEQ / 32 ? ch + 2 : SEQ / 32 - 1));
            __syncthreads();
            f32x16 o;
#pragma unroll
            for (int r = 0; r < 16; ++r) o[r] = 0.f;
#pragma unroll
            for (int kk = 0; kk < 2; ++kk)
#pragma unroll
                for (int s2 = 0; s2 < 2; ++s2) {
                    LAS unsigned char* qa = bufp + HG_QD + r32 * HG_P + (32 * (2 * dkh + kk) + 16 * s2 + 4 * hh) * 2;
                    const v2u a0 = *(const LAS v2u*)qa, a1 = *(const LAS v2u*)(qa + 16);
                    const bf16x8 af = __builtin_bit_cast(bf16x8, (v4u){a0.x, a0.y, a1.x, a1.y});
                    o = __builtin_amdgcn_mfma_f32_32x32x16_bf16(af, pack8(kk == 0 ? S0 : S1, s2), o, 0, 0, 0);
                }
            if (wave < 4) {
                f32x16 X;
#pragma unroll
                for (int r = 0; r < 16; ++r) X[r] = 0.f;
#pragma unroll
                for (int s8 = 0; s8 < 8; ++s8) {
                    const bf16x8 af = *(const LAS bf16x8*)(bufp + HG_KI + r32 * HG_P + (16 * s8 + 8 * hh) * 2);
                    const bf16x8 bfr = *(const LAS bf16x8*)(bufp + HG_QD + r32 * HG_P + (16 * s8 + 8 * hh) * 2);
                    X = __builtin_amdgcn_mfma_f32_32x32x16_bf16(af, bfr, X, 0, 0, 0);
                }
#pragma unroll
                for (int r = 0; r < 16; ++r) { const int cp = (r & 3) + 8 * (r >> 2) + 4 * hh; X[r] = cp > r32 ? 0.f : X[r]; }
#pragma unroll
                for (int s2 = 0; s2 < 2; ++s2) {
                    LAS unsigned char* vp = bufp + HG_V + troff + (16 * s2 + 4 * hh) * HG_VP;
                    o = __builtin_amdgcn_mfma_f32_32x32x16_bf16(pack8(X, s2), tr_pair(vp, vp + 8 * HG_VP), o, 0, 0, 0);
                }
            }
            { LAS float* ob = (LAS float*)(lds + (wave < 4 ? HG_OA : HG_OB)) + 32 * dvt + r32;
#pragma unroll
              for (int r = 0; r < 16; ++r) ob[((r & 3) + 8 * (r >> 2) + 4 * hh) * 128] = o[r]; }
#pragma unroll
            for (int kk = 0; kk < 2; ++kk) {
                const int dk0 = 32 * (2 * dkh + kk);
                const LAS float* cdp = (const LAS float*)(bufp + HG_CD) + dk0 + 4 * hh;
#pragma unroll
                for (int r4 = 0; r4 < 4; ++r4) { const f32x4 c4 = *(const LAS f32x4*)(cdp + 8 * r4);
                    if (kk == 0) { S0[4 * r4] *= c4.x; S0[4 * r4 + 1] *= c4.y; S0[4 * r4 + 2] *= c4.z; S0[4 * r4 + 3] *= c4.w; }
                    else         { S1[4 * r4] *= c4.x; S1[4 * r4 + 1] *= c4.y; S1[4 * r4 + 2] *= c4.z; S1[4 * r4 + 3] *= c4.w; } }
#pragma unroll
                for (int s2 = 0; s2 < 2; ++s2) {
                    LAS unsigned char* kp = bufp + HG_KDT + kdoff + (16 * s2 + 8 * hh) * HG_VP + dk0 * 2;
                    const bf16x8 af = tr_pair(kp, kp + 4 * HG_VP);
                    LAS unsigned char* vp = bufp + HG_V + troff + (16 * s2 + 8 * hh) * HG_VP;
                    const bf16x8 bfr = tr_pair(vp, vp + 4 * HG_VP);
                    if (kk == 0) S0 = __builtin_amdgcn_mfma_f32_32x32x16_bf16(af, bfr, S0, 0, 0, 0);
                    else         S1 = __builtin_amdgcn_mfma_f32_32x32x16_bf16(af, bfr, S1, 0, 0, 0);
                }
            }
            __syncthreads();
            { const LAS float* oa = (const LAS float*)(lds + HG_OA) + vc * 128 + 8 * vseg; const LAS float* ob = (const LAS float*)(lds + HG_OB) + vc * 128 + 8 * vseg;
              const f32x4 x0 = *(const LAS f32x4*)oa + *(const LAS f32x4*)ob, x1 = *(const LAS f32x4*)(oa + 4) + *(const LAS f32x4*)(ob + 4);
              float ss = (x0.x * x0.x + x0.y * x0.y) + (x0.z * x0.z + x0.w * x0.w) + (x1.x * x1.x + x1.y * x1.y) + (x1.z * x1.z + x1.w * x1.w);
              ss += __shfl_xor(ss, 1); ss += __shfl_xor(ss, 2); ss += __shfl_xor(ss, 4); ss += __shfl_xor(ss, 8);
              const float rr = 1.f / sqrtf(ss * (1.f / 128.f) + EPS);
              const size_t tok = tok0 + 32 * ch + vc;
              HG_WAIT_G(B);
              const unsigned ga[4] = {rgB.x, rgB.y, rgB.z, rgB.w};
              const float ov[8] = {x0.x, x0.y, x0.z, x0.w, x1.x, x1.y, x1.z, x1.w}; const float gg[8] = {g0.x, g0.y, g0.z, g0.w, g1.x, g1.y, g1.z, g1.w};
              unsigned w[4];
#pragma unroll
              for (int j = 0; j < 4; ++j) { const float a0 = bflo(ga[j]), a1 = bfhi(ga[j]);
                  w[j] = pk2(ov[2 * j] * rr * gg[2 * j] * (a0 * __builtin_amdgcn_rcpf(1.f + __expf(-a0))), ov[2 * j + 1] * rr * gg[2 * j + 1] * (a1 * __builtin_amdgcn_rcpf(1.f + __expf(-a1)))); }
              *(GAS v4u*)(MIXED + tok * DM + 512 + h * 128 + 8 * vseg) = (v4u){w[0], w[1], w[2], w[3]}; }
            HG_LOADG(B, (ch + 2 < SEQ / 32 ? ch + 2 : SEQ / 32 - 1));
          }
        }
#undef HG_LOAD
#undef HG_LOADG
#undef HG_WAIT_RAW
#undef HG_WAIT_G
    }
}

template <int N> __device__ __forceinline__ unsigned row_ror(unsigned x) { return (unsigned)__builtin_amdgcn_update_dpp((int)x, (int)x, 0x120 + N, 0xf, 0xf, false); }
__device__ __forceinline__ unsigned umax_(unsigned a, unsigned b) { return a > b ? a : b; }
__device__ __forceinline__ unsigned umin_(unsigned a, unsigned b) { return a < b ? a : b; }
__device__ __forceinline__ unsigned row_umax16(unsigned x) {
    unsigned y;
    asm volatile("s_nop 1\n\tv_max_u32_dpp %0, %1, %1 row_ror:1 row_mask:0xf bank_mask:0xf\n\t"
                 "s_nop 1\n\tv_max_u32_dpp %0, %0, %0 row_ror:2 row_mask:0xf bank_mask:0xf\n\t"
                 "s_nop 1\n\tv_max_u32_dpp %0, %0, %0 row_ror:4 row_mask:0xf bank_mask:0xf\n\t"
                 "s_nop 1\n\tv_max_u32_dpp %0, %0, %0 row_ror:8 row_mask:0xf bank_mask:0xf"
                 : "=&v"(y) : "v"(x));
    return y;
}
__device__ __forceinline__ float row_fsum16(float v) {
    v += __builtin_bit_cast(float, row_ror<1>(__builtin_bit_cast(unsigned, v))); v += __builtin_bit_cast(float, row_ror<2>(__builtin_bit_cast(unsigned, v)));
    v += __builtin_bit_cast(float, row_ror<4>(__builtin_bit_cast(unsigned, v))); v += __builtin_bit_cast(float, row_ror<8>(__builtin_bit_cast(unsigned, v))); return v; }
__device__ __forceinline__ unsigned h2key(unsigned x) { return (x & 0x80000000u) ? (~x & 0xffff0000u) : (x | 0x80000000u); }
__device__ __forceinline__ float hkey2f(unsigned k) { const unsigned hb = ((k & 0x80000000u) ? (k & 0x7fff0000u) : (~k & 0xffff0000u)) >> 16; return (float)__builtin_bit_cast(_Float16, (unsigned short)hb); }
__device__ __forceinline__ unsigned f2key(float f) { const unsigned u = __builtin_bit_cast(unsigned, f); return (u & 0x80000000u) ? ~u : (u | 0x80000000u); }
__device__ __forceinline__ float key2f(unsigned k) { const unsigned u = (k & 0x80000000u) ? (k & 0x7fffffffu) : ~k; return __builtin_bit_cast(float, u); }
__device__ __forceinline__ unsigned pair_code(int s) {
    if (s < 16) return (unsigned)s;
    if (s < 24) return 16u + (unsigned)(s - 16);
    if (s < 29) return 32u + (unsigned)(s - 24);
    if (s < 33) return 48u + (unsigned)(s - 29);
    if (s < 36) return 64u + (unsigned)(s - 33);
    if (s < 42) return 80u + 16u * (unsigned)((s - 36) >> 1) + (unsigned)((s - 36) & 1);
    if (s < 50) return 128u + 16u * (unsigned)(s - 42);
    return 0xFFu;
}
#define CAS_(a, b) do { const unsigned hi_ = umax_(a, b), lo_ = umin_(a, b); a = hi_; b = lo_; } while (0)
__device__ __forceinline__ unsigned topk_stage1(const unsigned short* SC, int th, int c, int l15) {
    const int t = th >> 3, h = th & 7;
    const v4u sv = *(const GAS v4u*)(SC + (size_t)t * 2048 + h * 256 + c * 128 + l15 * 8);
    const unsigned nb = 127u - 8u * (unsigned)l15;
    unsigned k0 = h2key(sv.x << 16) | nb, k1 = h2key(sv.x & 0xffff0000u) | (nb - 1u), k2 = h2key(sv.y << 16) | (nb - 2u), k3 = h2key(sv.y & 0xffff0000u) | (nb - 3u);
    unsigned k4 = h2key(sv.z << 16) | (nb - 4u), k5 = h2key(sv.z & 0xffff0000u) | (nb - 5u), k6 = h2key(sv.w << 16) | (nb - 6u), k7 = h2key(sv.w & 0xffff0000u) | (nb - 7u);
    CAS_(k0, k1); CAS_(k2, k3); CAS_(k4, k5); CAS_(k6, k7); CAS_(k0, k2); CAS_(k1, k3); CAS_(k4, k6); CAS_(k5, k7); CAS_(k1, k2); CAS_(k5, k6); CAS_(k0, k4); CAS_(k3, k7);
    CAS_(k1, k5); CAS_(k2, k6); CAS_(k1, k4); CAS_(k3, k6); CAS_(k2, k4); CAS_(k3, k5); CAS_(k3, k4);
    unsigned res = 0u;
#pragma unroll
    for (int r = 0; r < 16; ++r) {
        const unsigned m = row_umax16(k0); const bool pop = (k0 == m);
        k0 = pop ? k1 : k0; k1 = pop ? k2 : k1; k2 = pop ? k3 : k2; k3 = pop ? k4 : k3; k4 = pop ? k5 : k4; k5 = pop ? k6 : k5; k6 = pop ? k7 : k6; k7 = pop ? 0u : k7;
        res = (l15 == r) ? m : res;
    }
    return res;
}
__device__ __forceinline__ void topk_v2(Frame& F) {
    const unsigned short* SC = (const unsigned short*)(F.ws + WS_SC); int* IDX = (int*)(F.ws + WS_IDX); float* GATE = (float*)(F.ws + WS_GATE); float* GSU = (float*)(F.ws + WS_GSU);
    const float* SU = (const float*)(F.ws + WS_SU); const float* SV = (const float*)(F.ws + WS_SV);
    const int gw = F.vcu * NWAVES + F.wave, NGW = F.G * NWAVES, lane = F.lane, l15 = lane & 15, row = lane >> 4, c = row & 1, rbase = lane & 48;
    const unsigned pc0 = pair_code(l15), pc1 = pair_code(l15 + 16), pc2 = pair_code(l15 + 32), pc3 = pair_code(l15 + 48);
    const int src1 = l15 + 32 * (row & 1), src2 = src1 + 16;
    for (int it0 = gw * 32; it0 < NTOK * 2; it0 += NGW * 32)
    for (int it = it0; it < it0 + 32; ++it) {
        const int thb = 4 * it;
        const unsigned resA = topk_stage1(SC, thb + (row >> 1), c, l15), resB = topk_stage1(SC, thb + 2 + (row >> 1), c, l15);
        const unsigned a1 = (unsigned)__shfl((int)resA, src1), a2 = (unsigned)__shfl((int)resA, src2), b1 = (unsigned)__shfl((int)resB, src1), b2 = (unsigned)__shfl((int)resB, src2);
        const unsigned S1 = row < 2 ? a1 : b1, S2 = row < 2 ? a2 : b2;
        unsigned c0, c1, c2, c3;
#define TK_CAND(CK, PC) do { const unsigned ka_ = (unsigned)__shfl((int)S1, rbase + (int)((PC) >> 4 & 15u)), kb_ = (unsigned)__shfl((int)S2, rbase + (int)((PC) & 15u)); \
            const float sm_ = hkey2f(ka_) + hkey2f(kb_); CK = (PC) == 0xFFu ? 0u : ((f2key(sm_) & ~0xFFu) | (255u - (PC))); } while (0)
        TK_CAND(c0, pc0); TK_CAND(c1, pc1); TK_CAND(c2, pc2); TK_CAND(c3, pc3);
#undef TK_CAND
        CAS_(c0, c1); CAS_(c2, c3); CAS_(c0, c2); CAS_(c1, c3); CAS_(c1, c2);
        unsigned res2 = 0u;
#pragma unroll
        for (int r = 0; r < 16; ++r) {
            const unsigned m = row_umax16(c0); const bool pop = (c0 == m);
            c0 = pop ? c1 : c0; c1 = pop ? c2 : c1; c2 = pop ? c3 : c2; c3 = pop ? 0u : c3;
            res2 = (l15 == r) ? m : res2;
        }
        const unsigned code = 255u - (res2 & 0xFFu);
        const unsigned ka = (unsigned)__shfl((int)S1, rbase + (int)(code >> 4 & 15u)), kb = (unsigned)__shfl((int)S2, rbase + (int)(code & 15u));
        const float ts = hkey2f(ka) + hkey2f(kb);
        const int e = (int)((127u - (ka & 0x7Fu)) * 128u + (127u - (kb & 0x7Fu)));
        const float tmax = __builtin_bit_cast(float, (unsigned)__shfl((int)__builtin_bit_cast(unsigned, ts), rbase));
        const float ex = __expf(ts - tmax);
        const float sum = row_fsum16(ex);
        const int th = thb + row;
        const size_t o = (size_t)(th >> 3) * NEXP_SEL + (th & 7) * 16 + l15;
        IDX[o] = e; GATE[o] = ex / sum * SV[e]; GSU[o] = SU[e];
    }
}

constexpr int PG_TOK = 16;
constexpr int PG_IDX = 0, PG_HID = 4096, PG_SA = PG_HID + 8192, PG_TB = PG_SA + 64, PG_WB = PG_TB + 4096;
static_assert(PG_WB % 16 == 0 && PG_TB % 16 == 0 && NWAVES * PG_WB <= RING_BYTES, "gather LDS map");
__device__ __forceinline__ void peer_sliced(Frame& F) {
    const unsigned char* U8T = F.ws + WS_U8; const unsigned char* V8T = F.ws + WS_V8; const unsigned char* X8 = F.ws + WS_X8;
    const float* SSQ = (const float*)(F.ws + WS_CTL) + CW_SSQ;
    const int* IDX = (const int*)(F.ws + WS_IDX); const float* GATE = (const float*)(F.ws + WS_GATE); const float* GSU = (const float*)(F.ws + WS_GSU); const float* gf = F.in[17];
    bf16* PO = (bf16*)(F.ws + WS_PO); const bf16* HB = (const bf16*)(F.ws + WS_HN2);
    const int gw = F.vcu * NWAVES + F.wave, NGW = F.G * NWAVES, lane = F.lane, m = lane & 15, g = lane >> 4;
    const int row8 = lane >> 3, piece = lane & 7;
    LAS unsigned char* wb = F.lds + F.wave * PG_WB;
    LAS unsigned short* idxs = (LAS unsigned short*)(wb + PG_IDX);
    LAS float* hid = (LAS float*)(wb + PG_HID);
    LAS float* sqp = hid + 64 + lane;
    LAS float* sai = (LAS float*)(wb + PG_SA);
    LAS unsigned char* tb = wb + PG_TB;
    const int p8 = m & 7; const unsigned bsh = 8u * (unsigned)(p8 & 3); const bool bhi = (p8 >> 2) != 0;
    constexpr size_t SLICE = (size_t)16384 * 128;
    const int usw = 16 * (piece ^ ((row8 >> 1) & 3));
    const int urd0 = m * 128 + 16 * ((2 * g) ^ ((m >> 1) & 7)), urd1 = m * 128 + 16 * ((2 * g + 1) ^ ((m >> 1) & 7));
    for (int blk = gw; blk < NTOK / PG_TOK; blk += NGW) {
        const int t0 = blk * PG_TOK;
#pragma unroll
        for (int k = 0; k < 32; ++k) { const int id = lane + 64 * k; idxs[id] = (unsigned short)IDX[(size_t)t0 * NEXP_SEL + id]; }
        LDS_WAIT(); asm volatile("" ::: "memory");
        for (int p = 0; p < 8; ++p) {
            const unsigned char* Up = U8T + (size_t)p * SLICE;
            const unsigned char* Xp = X8 + (size_t)t0 * DM + 128 * p + 32 * g;
            v4u ab[2][16]; l2 xs[2][2];
#define PGU_ISSUE(i_, buf_) do { _Pragma("unroll") for (int k = 0; k < 16; ++k) { const unsigned e = idxs[(i_) * 128 + 8 * k + row8]; \
                ab[buf_][k] = *(const GAS v4u*)(Up + (size_t)e * 128 + (usw ^ ((k & 1) ? 64 : 0))); } \
                xs[buf_][0] = *(const GAS l2*)(Xp + (size_t)(i_) * DM); xs[buf_][1] = *(const GAS l2*)(Xp + (size_t)(i_) * DM + 16); } while (0)
#define PGU_BODY(i_, cur_, nxt_) do { if ((i_) + 1 < PG_TOK) PGU_ISSUE((i_) + 1, nxt_); SCHED_FENCE(); \
                _Pragma("unroll") for (int rb = 0; rb < 4; ++rb) { LAS f32x4* hp0 = (LAS f32x4*)(hid + (i_) * 128 + 32 * rb + 4 * g); LAS f32x4* hp1 = hp0 + 4; \
                    _Pragma("unroll") for (int q4 = 0; q4 < 4; ++q4) *(LAS v4u*)(tb + 1024 * q4 + 16 * lane) = ab[cur_][4 * rb + q4]; \
                    f32x4 acc0 = p == 0 ? (f32x4){0.f, 0.f, 0.f, 0.f} : *hp0, acc1 = p == 0 ? (f32x4){0.f, 0.f, 0.f, 0.f} : *hp1; \
                    const l2 a0 = *(const LAS l2*)(tb + urd0), a1 = *(const LAS l2*)(tb + urd1), b0 = *(const LAS l2*)(tb + 2048 + urd0), b1 = *(const LAS l2*)(tb + 2048 + urd1); \
                    acc0 = __builtin_amdgcn_mfma_f32_16x16x32_fp8_bf8(a0.x, xs[cur_][0].x, acc0, 0, 0, 0); acc1 = __builtin_amdgcn_mfma_f32_16x16x32_fp8_bf8(b0.x, xs[cur_][0].x, acc1, 0, 0, 0); \
                    acc0 = __builtin_amdgcn_mfma_f32_16x16x32_fp8_bf8(a0.y, xs[cur_][0].y, acc0, 0, 0, 0); acc1 = __builtin_amdgcn_mfma_f32_16x16x32_fp8_bf8(b0.y, xs[cur_][0].y, acc1, 0, 0, 0); \
                    acc0 = __builtin_amdgcn_mfma_f32_16x16x32_fp8_bf8(a1.x, xs[cur_][1].x, acc0, 0, 0, 0); acc1 = __builtin_amdgcn_mfma_f32_16x16x32_fp8_bf8(b1.x, xs[cur_][1].x, acc1, 0, 0, 0); \
                    acc0 = __builtin_amdgcn_mfma_f32_16x16x32_fp8_bf8(a1.y, xs[cur_][1].y, acc0, 0, 0, 0); acc1 = __builtin_amdgcn_mfma_f32_16x16x32_fp8_bf8(b1.y, xs[cur_][1].y, acc1, 0, 0, 0); \
                    if (m == 0) { *hp0 = acc0; *hp1 = acc1; } } SCHED_FENCE(); } while (0)
            PGU_ISSUE(0, 0);
            for (int i2 = 0; i2 < PG_TOK; i2 += 2) { PGU_BODY(i2, 0, 1); PGU_BODY(i2 + 1, 1, 0); }
#undef PGU_ISSUE
#undef PGU_BODY
            LDS_WAIT(); asm volatile("" ::: "memory");
        }
        for (int i = 0; i < PG_TOK; ++i) {
            const int t = t0 + i; const float sx = 1.f / sqrtf(SSQ[t] * (1.f / DM) + EPS);
            float w[8][4]; float amax = 0.f;
#pragma unroll
            for (int r = 0; r < 8; ++r) { const f32x4 h4 = *(const LAS f32x4*)(hid + i * 128 + 16 * r + 4 * g);
                const f32x4 su4 = *(const GAS f32x4*)(GSU + (size_t)t * NEXP_SEL + 16 * r + 4 * g), gv4 = *(const GAS f32x4*)(GATE + (size_t)t * NEXP_SEL + 16 * r + 4 * g);
#pragma unroll
                for (int j = 0; j < 4; ++j) { w[r][j] = gelu_as(h4[j] * su4[j] * sx) * gv4[j]; amax = fmaxf(amax, fabsf(w[r][j])); } }
            amax = fmaxf(amax, __shfl_xor(amax, 16)); amax = fmaxf(amax, __shfl_xor(amax, 32));
            const float sa = amax > 0.f ? 224.f / amax : 1.f;
            LDS_WAIT(); asm volatile("" ::: "memory");
            if (m == 0) {
                LAS unsigned char* wrow = (LAS unsigned char*)(hid + i * 128);
#pragma unroll
                for (int r = 0; r < 8; ++r) { int pk = __builtin_amdgcn_cvt_pk_fp8_f32(w[r][0] * sa, w[r][1] * sa, 0, false); pk = __builtin_amdgcn_cvt_pk_fp8_f32(w[r][2] * sa, w[r][3] * sa, pk, true);
                    wrow[4 * r + g] = (unsigned char)pk; wrow[32 + 4 * r + g] = (unsigned char)(pk >> 8); wrow[64 + 4 * r + g] = (unsigned char)(pk >> 16); wrow[96 + 4 * r + g] = (unsigned char)(pk >> 24); }
            }
            if (lane == 0) sai[i] = amax > 0.f ? amax * (1.f / 224.f) : 1.f;
        }
        LDS_WAIT(); asm volatile("" ::: "memory");
        for (int p = 0; p < 8; ++p) {
            const unsigned char* Vp = V8T + (size_t)p * SLICE + 16 * piece;
            v4u va[2][16];
#define PGV_ISSUE(i_, buf_) do { _Pragma("unroll") for (int k = 0; k < 16; ++k) { const unsigned e = idxs[(i_) * 128 + 8 * k + row8]; va[buf_][k] = *(const GAS v4u*)(Vp + (size_t)e * 128); } } while (0)
#define PGV_BODY(i_, cur_, nxt_) do { if ((i_) + 1 < PG_TOK) PGV_ISSUE((i_) + 1, nxt_); \
                const LAS v4u* wp = (const LAS v4u*)((LAS unsigned char*)(hid + (i_) * 128) + 32 * g); const v4u w0 = wp[0], w1 = wp[1]; \
                const unsigned ww[8] = {w0.x, w0.y, w0.z, w0.w, w1.x, w1.y, w1.z, w1.w}; \
                SCHED_FENCE(); f32x4 c = (f32x4){0.f, 0.f, 0.f, 0.f}; \
                _Pragma("unroll") for (int kb = 0; kb < 4; ++kb) { \
                    _Pragma("unroll") for (int q4 = 0; q4 < 4; ++q4) *(LAS v4u*)(tb + 1024 * q4 + 16 * lane) = va[cur_][4 * kb + q4]; \
                    long rr_[8]; \
                    _Pragma("unroll") for (int q4 = 0; q4 < 4; ++q4) { rr_[2 * q4] = *(const LAS long*)(tb + 1024 * q4 + g * 128 + 8 * m); rr_[2 * q4 + 1] = *(const LAS long*)(tb + 1024 * q4 + (4 + g) * 128 + 8 * m); } \
                    _Pragma("unroll") for (int q8 = 0; q8 < 8; ++q8) { const int q = 8 * kb + q8; const unsigned a8 = ((ww[q >> 2] >> (8 * (q & 3))) & 0xffu) << bsh; const long bop = (long)(bhi ? ((unsigned long long)a8 << 32) : (unsigned long long)a8); \
                      c = __builtin_amdgcn_mfma_f32_16x16x32_fp8_fp8(rr_[q8], bop, c, 0, 0, 0); } } \
                SCHED_FENCE(); \
                { const float isa = sai[i_]; LAS unsigned short* ob = (LAS unsigned short*)(tb) + 32 * g + (m & 7);         \
                  if (m < 8) { ob[0] = (unsigned short)f2bf(c[0] * isa); ob[8] = (unsigned short)f2bf(c[1] * isa); ob[16] = (unsigned short)f2bf(c[2] * isa); ob[24] = (unsigned short)f2bf(c[3] * isa); } \
                  const v4u ov = *(const LAS v4u*)(tb + 16 * (lane & 15)); \
                  if (lane < 16) *(GAS v4u*)(PO + (size_t)(t0 + (i_)) * DM + 128 * p + 8 * lane) = ov; } } while (0)
            PGV_ISSUE(0, 0);
            for (int i2 = 0; i2 < PG_TOK; i2 += 2) { PGV_BODY(i2, 0, 1); PGV_BODY(i2 + 1, 1, 0); }
#undef PGV_ISSUE
#undef PGV_BODY
        }
        LDS_WAIT(); asm volatile("" ::: "memory");
        VM_WAIT();
        for (int i = 0; i < PG_TOK; i += 2) {
            GAS f32x4* hrA = (GAS f32x4*)(F.out + (size_t)(t0 + i) * DM) + lane; GAS f32x4* hrB = hrA + DM / 4;
            const GAS v2u* prA = (const GAS v2u*)(PO + (size_t)(t0 + i) * DM) + lane; const GAS v2u* prB = prA + DM / 4;
            const GAS v2u* hbA = (const GAS v2u*)(HB + (size_t)(t0 + i) * DM) + lane; const GAS v2u* hbB = hbA + DM / 4;
            v2u pa[4], pb[4], ha[4], hb2[4];
#pragma unroll
            for (int j = 0; j < 4; ++j) { pa[j] = prA[64 * j]; ha[j] = hbA[64 * j]; pb[j] = prB[64 * j]; hb2[j] = hbB[64 * j]; }
            f32x4 ya[4], yb[4]; float sa = 0.f, sb = 0.f;
#pragma unroll
            for (int j = 0; j < 4; ++j) {
                ya[j] = (f32x4){bflo(ha[j].x), bfhi(ha[j].x), bflo(ha[j].y), bfhi(ha[j].y)} + (f32x4){bflo(pa[j].x), bfhi(pa[j].x), bflo(pa[j].y), bfhi(pa[j].y)};
                yb[j] = (f32x4){bflo(hb2[j].x), bfhi(hb2[j].x), bflo(hb2[j].y), bfhi(hb2[j].y)} + (f32x4){bflo(pb[j].x), bfhi(pb[j].x), bflo(pb[j].y), bfhi(pb[j].y)};
                sa += (ya[j].x * ya[j].x + ya[j].y * ya[j].y) + (ya[j].z * ya[j].z + ya[j].w * ya[j].w); sb += (yb[j].x * yb[j].x + yb[j].y * yb[j].y) + (yb[j].z * yb[j].z + yb[j].w * yb[j].w); }
#pragma unroll
            for (int o = 1; o < 64; o <<= 1) { sa += __shfl_xor(sa, o); sb += __shfl_xor(sb, o); }
            const float ra = 1.f / sqrtf(sa * (1.f / DM) + EPS), rb = 1.f / sqrtf(sb * (1.f / DM) + EPS);
#pragma unroll
            for (int j = 0; j < 4; ++j) { const f32x4 gg = *((const GAS f32x4*)gf + lane + 64 * j); hrA[64 * j] = ya[j] * ra * gg; hrB[64 * j] = yb[j] * rb * gg; }
        }
        LDS_WAIT(); asm volatile("" ::: "memory");
    }
}

struct Args { const float* in[18]; float* out; unsigned char* ws; int ph_lo, ph_hi; };
__global__ void __launch_bounds__(NWAVES * 64, 2) hymba_fwd(Args args) {
    extern __shared__ __attribute__((aligned(16))) unsigned char lds[];
    Frame F;
    F.lds = (LAS unsigned char*)lds;
    F.MISC = (volatile LAS unsigned*)(F.lds + MISC_OFF);
    F.tid = threadIdx.x; F.lane = F.tid & 63; F.wave = __builtin_amdgcn_readfirstlane(F.tid >> 6);
    F.G = gridDim.x; { const int bx = blockIdx.x; F.vcu = (F.G % 8 == 0) ? (bx % 8) * (F.G / 8) + bx / 8 : bx; }
#pragma unroll
    for (int i = 0; i < 18; ++i) F.in[i] = args.in[i];
    F.out = args.out; F.ws = args.ws;
    for (int u = F.tid; u < (LDS_BYTES - LDSCTL_OFF) / 4; u += NWAVES * 64) ((LAS unsigned*)(F.lds + LDSCTL_OFF))[u] = 0u;
    __syncthreads();
    const int lo = args.ph_lo, hi = args.ph_hi;
    const bool multi = (hi - lo) > 1;
    XcdBarrier bar; bar.bar = (unsigned*)(F.ws + WS_CTL) + CW_BAR; bar.x = 0; bar.st = nullptr;
    if (multi) bar = xcd_barrier_post((unsigned*)(F.ws + WS_CTL) + CW_BAR, F.MISC + 8);
#define IN(k) (lo <= (k) && (k) < hi)
#define SEAM(k) do { if (IN(k) && IN((k) + 1)) xcd_barrier(bar); } while (0)

    if (IN(0)) { p0_prologue(F); } SEAM(0);
    if (IN(1)) {
        pg8::Gemm g{(const pg8::bf16_t*)(F.ws + WS_HN), (const pg8::bf16_t*)(F.ws + WS_WIN), NTOK, INW, DM}; pg8::StaticOrder S; S.init(NTOK, INW, F.G, (int)blockIdx.x);
        pg8::EpiProj E{(pg8::bf16_t*)(F.ws + WS_PROJ), INW, 2, QSCALE};
        pg8::gemm_phase<pg8::EpiProj, pg8::StaticOrder, PG8_ALIGN, PG8_SP2>(F.lds + RING_OFF, g, S, E);
    } SEAM(1);
    if (IN(2)) { hgrn_mfma(F); }
    if (IN(3)) { quant_drain(F); attn_mfma(F, 0); }
    if (IN(3) && IN(4)) xcd_barrier(bar);
    if (IN(4)) {
        pg8::Gemm g{(const pg8::bf16_t*)(F.ws + WS_HN), (const pg8::bf16_t*)(F.ws + WS_WOUT), NTOK, DM, DM}; pg8::StaticOrder S; S.init(NTOK, DM, F.G, (int)blockIdx.x);
        pg8::EpiMix E{DM, F.in[0], F.in[12], (pg8::bf16_t*)(F.ws + WS_HN2), F.ws + WS_X8, (float*)(F.ws + WS_CTL) + CW_SSQ};
        pg8::gemm_phase<pg8::EpiMix, pg8::StaticOrder, PG8_ALIGN, PG8_SP2>(F.lds + RING_OFF, g, S, E);
    }
    if (IN(4) && IN(6)) xcd_barrier(bar);
    if (IN(6)) {
        pg8::Gemm g{(const pg8::bf16_t*)(F.ws + WS_HN2), (const pg8::bf16_t*)(F.ws + WS_W2), NTOK, 2048, DM}; pg8::StaticOrder S; S.init(NTOK, 2048, F.G, (int)blockIdx.x);
        pg8::EpiScaleRow E{(_Float16*)(F.ws + WS_SC), 2048, (const float*)(F.ws + WS_CTL) + CW_SSQ, 1.f / DM, EPS};
        pg8::gemm_phase<pg8::EpiScaleRow, pg8::StaticOrder, PG8_ALIGN, PG8_SP2>(F.lds + RING_OFF, g, S, E);
    } SEAM(6);
    if (IN(7)) { topk_v2(F); }
    if (IN(7) && IN(8)) { VM_WAIT(); }
    if (IN(8)) { peer_sliced(F); }
#undef IN
#undef SEAM
}

extern "C" void kernel_launch(void* const* d_in, const int* in_sizes, int n_in, void* d_out, int out_size, void* d_ws, size_t ws_size, hipStream_t stream) {
    static int grid = 0;
    if (grid == 0) {
        if (n_in != 18 || in_sizes[0] != NTOK * DM || out_size != NTOK * DM || ws_size < WS_END) { fprintf(stderr, "kernel_launch: unexpected shapes (n_in %d, in0 %d, out %d, ws %zu); nothing launched\n", n_in, n_in > 0 ? in_sizes[0] : -1, out_size, ws_size); grid = -1; return; }
        int dev = 0, cus = 0, per_cu = 0;
        if (hipGetDevice(&dev) != hipSuccess || hipDeviceGetAttribute(&cus, hipDeviceAttributeMultiprocessorCount, dev) != hipSuccess) { grid = -1; return; }
        if (hipFuncSetAttribute((const void*)hymba_fwd, hipFuncAttributeMaxDynamicSharedMemorySize, LDS_BYTES) != hipSuccess) { fprintf(stderr, "kernel_launch: hipFuncSetAttribute failed\n"); grid = -1; return; }
        if (hipOccupancyMaxActiveBlocksPerMultiprocessor(&per_cu, (const void*)hymba_fwd, NWAVES * 64, LDS_BYTES) != hipSuccess || per_cu < 1)
            fprintf(stderr, "kernel_launch: note: occupancy query reports %d workgroups per CU\n", per_cu);
        (void)hipGetLastError();
        grid = cus;
    }
    if (grid < 0) return;
    if (hipMemsetAsync((char*)d_ws + WS_CTL, 0, CTL_ZERO_BYTES, stream) != hipSuccess) return;
    Args a{};
    for (int i = 0; i < 18; ++i) a.in[i] = (const float*)d_in[i];
    a.out = (float*)d_out; a.ws = (unsigned char*)d_ws; a.ph_lo = 0; a.ph_hi = 9;
    hipLaunchKernelGGL(hymba_fwd, dim3(grid), dim3(NWAVES * 64), LDS_BYTES, stream, a);
}
```

```cpp
#include <hip/hip_runtime.h>
#include <cstdio>
#include <cstdint>
#include <cmath>
namespace pg8 {
#define PG8_LAS __attribute__((address_space(3)))
typedef unsigned short bf16_t;
typedef short bf16x8 __attribute__((ext_vector_type(8)));
typedef float f32x4 __attribute__((ext_vector_type(4)));
typedef unsigned u32x4 __attribute__((ext_vector_type(4)));
constexpr int BM = 256, BK = 64, HALF = 128, HTB = HALF * BK * 2  , STAGE_BYTES = 8 * HTB, NXCD = 8, WGM = 8;

__host__ __device__ __forceinline__ int lds_byte(int r, int c) { const int st = (r >> 4) * 2 + (c >> 5), rr = r & 15, cc = c & 31, ob = rr * 64 + cc * 2; return st * 1024 + (ob ^ (((ob >> 9) & 1) << 5)); }
__host__ __device__ __forceinline__ void stage_rc(int b, int& R, int& C) { const int st = b / 1024, sb = b % 1024, swz = sb ^ (((sb >> 9) & 1) << 5); R = (st >> 1) * 16 + swz / 64; C = (st & 1) * 32 + (swz % 64) / 2; }
__host__ __device__ __forceinline__ int perm32(int rho) { const int n = rho >> 4, i = rho & 15; return 8 * (i >> 2) + 4 * n + (i & 3); }

struct Unit { int pm, pn; };
struct Gemm { const bf16_t* A; const bf16_t* Bt; int M, N, K; };

struct StaticOrder {
    int nM, nN, nwg, G, c;
    __host__ __device__ void init(int M, int N, int G_, int c_) { nM = M / BM; nN = N / BM; nwg = nM * nN; G = G_; c = c_; }
    __host__ __device__ bool next(int i, Unit& u) const {
        const long L = (long)i * G + c; if (L >= nwg) return false;
        int wgid = (int)L; { const int q = nwg / NXCD, r = nwg % NXCD, xcd = wgid % NXCD, off = wgid / NXCD; wgid = (xcd < r ? xcd * (q + 1) : r * (q + 1) + (xcd - r) * q) + off; }
        const int nig = WGM * nN, gid = wgid / nig, fm = gid * WGM, gsz = (nM - fm) < WGM ? (nM - fm) : WGM;
        u.pm = fm + ((wgid % nig) % gsz); u.pn = (wgid % nig) / gsz; return true;
    }
    __device__ __forceinline__ void a_ready(const Unit&) const {}
    __device__ __forceinline__ void done(const Unit&) const {}
};
__device__ __forceinline__ unsigned cvt_pk_bf16(float lo, float hi) { unsigned r; asm volatile("v_cvt_pk_bf16_f32 %0, %1, %2" : "=v"(r) : "v"(lo), "v"(hi)); return r; }
typedef float f32x2 __attribute__((ext_vector_type(2)));
__device__ __forceinline__ f32x2 gelu_pk(f32x2 v) {
    const f32x2 av = __builtin_elementwise_abs(v), d = av * 0.2316418882f + 1.0f;
    f32x2 t; t.x = __builtin_amdgcn_rcpf(d.x); t.y = __builtin_amdgcn_rcpf(d.y);
    f32x2 q = t * 0.5307027145f + (-0.7265760135f); q = q * t + 0.7107068705f; q = q * t + (-0.142248368f); q = q * t + 0.127414796f; q = q * t;
    const f32x2 s = (v * v) * (-0.72134752044f);
    f32x2 e; e.x = __builtin_amdgcn_exp2f(s.x); e.y = __builtin_amdgcn_exp2f(s.y);
    const f32x2 m = v * (q * e), r = v - m;
    f32x2 o; o.x = v.x < 0.f ? m.x : r.x; o.y = v.y < 0.f ? m.y : r.y; return o;
}
struct EpiProj {
    static constexpr bool PERM = true, AFTER_DRAIN = false;
    bf16_t* O; int ldc; int qtiles; float qscale;
    __device__ __forceinline__ void operator()(const f32x4 (&acc)[2][2][4][2], const Unit& u, int wr, int wc, int fr, int fq) const {
        const int row0 = u.pm * BM + wr * 64 + fr, col0 = u.pn * BM + wc * 32 + 8 * fq;
        const float sc = (u.pn < qtiles) ? qscale : 1.f;
#pragma unroll
        for (int ai = 0; ai < 2; ++ai)
#pragma unroll
            for (int m = 0; m < 4; ++m) { bf16_t* rowp = O + (size_t)(row0 + ai * HALF + m * 16) * ldc + col0;
#pragma unroll
                for (int bj = 0; bj < 2; ++bj) { const f32x4 v0 = acc[ai][bj][m][0] * sc, v1 = acc[ai][bj][m][1] * sc;
                    u32x4 w; w.x = cvt_pk_bf16(v0[0], v0[1]); w.y = cvt_pk_bf16(v0[2], v0[3]); w.z = cvt_pk_bf16(v1[0], v1[1]); w.w = cvt_pk_bf16(v1[2], v1[3]);
                    *(u32x4*)(rowp + bj * HALF) = w; } }
    }
};
struct EpiF32Res {
    static constexpr bool PERM = false, AFTER_DRAIN = false;
    float* C; int ldc; const float* res;
    __device__ __forceinline__ void operator()(const f32x4 (&acc)[2][2][4][2], const Unit& u, int wr, int wc, int fr, int fq) const {
        const int row0 = u.pm * BM + wr * 64 + fr, col0 = u.pn * BM + wc * 32 + 4 * fq;
#pragma unroll
        for (int ai = 0; ai < 2; ++ai)
#pragma unroll
            for (int m = 0; m < 4; ++m) { const size_t off = (size_t)(row0 + ai * HALF + m * 16) * ldc + col0;
#pragma unroll
                for (int bj = 0; bj < 2; ++bj)
#pragma unroll
                    for (int n = 0; n < 2; ++n) { f32x4 o = acc[ai][bj][m][n]; if (res) o = o + *(const f32x4*)(res + off + bj * HALF + n * 16);
                        *(f32x4*)(C + off + bj * HALF + n * 16) = o; } }
    }
};

struct EpiMix {
    static constexpr bool PERM = true, AFTER_DRAIN = false;
    int ldc; const float* res; const float* g2; bf16_t* HB; unsigned char* XB; float* ssq;
    __device__ __forceinline__ void operator()(const f32x4 (&acc)[2][2][4][2], const Unit& u, int wr, int wc, int fr, int fq) const {
        const int row0 = u.pm * BM + wr * 64 + fr, col0 = u.pn * BM + wc * 32 + 8 * fq;
        f32x4 gv[2][2];
#pragma unroll
        for (int bj = 0; bj < 2; ++bj)
#pragma unroll
            for (int n = 0; n < 2; ++n) gv[bj][n] = *(const f32x4*)(g2 + col0 + bj * HALF + 4 * n);
#pragma unroll
        for (int ai = 0; ai < 2; ++ai)
#pragma unroll
            for (int m = 0; m < 4; ++m) { const int row = row0 + ai * HALF + m * 16; const size_t off = (size_t)row * ldc + col0; float sq = 0.f;
#pragma unroll
                for (int bj = 0; bj < 2; ++bj) {
                    const f32x4 h0 = acc[ai][bj][m][0] + *(const f32x4*)(res + off + bj * HALF), h1 = acc[ai][bj][m][1] + *(const f32x4*)(res + off + bj * HALF + 4);
                    sq += (h0[0] * h0[0] + h0[1] * h0[1]) + (h0[2] * h0[2] + h0[3] * h0[3]) + (h1[0] * h1[0] + h1[1] * h1[1]) + (h1[2] * h1[2] + h1[3] * h1[3]);
                    u32x4 w; w.x = cvt_pk_bf16(h0[0], h0[1]); w.y = cvt_pk_bf16(h0[2], h0[3]); w.z = cvt_pk_bf16(h1[0], h1[1]); w.w = cvt_pk_bf16(h1[2], h1[3]);
                    *(u32x4*)(HB + off + bj * HALF) = w;
                    const f32x4 g0 = h0 * gv[bj][0], g1 = h1 * gv[bj][1];
                    int p0 = __builtin_amdgcn_cvt_pk_bf8_f32(g0[0], g0[1], 0, false); p0 = __builtin_amdgcn_cvt_pk_bf8_f32(g0[2], g0[3], p0, true);
                    int p1 = __builtin_amdgcn_cvt_pk_bf8_f32(g1[0], g1[1], 0, false); p1 = __builtin_amdgcn_cvt_pk_bf8_f32(g1[2], g1[3], p1, true);
                    typedef unsigned u32x2 __attribute__((ext_vector_type(2)));
                    *(u32x2*)(XB + off + bj * HALF) = (u32x2){(unsigned)p0, (unsigned)p1}; }
                sq += __shfl_xor(sq, 16); sq += __shfl_xor(sq, 32);
                if (fq == 0) atomicAdd(ssq + row, sq); }
    }
};
struct EpiScaleRow {
    static constexpr bool PERM = true, AFTER_DRAIN = false;
    _Float16* C; int ldc; const float* ssq; float invk, eps;
    __device__ __forceinline__ void operator()(const f32x4 (&acc)[2][2][4][2], const Unit& u, int wr, int wc, int fr, int fq) const {
        typedef _Float16 h2 __attribute__((ext_vector_type(2)));
        const int row0 = u.pm * BM + wr * 64 + fr, col0 = u.pn * BM + wc * 32 + 8 * fq;
#pragma unroll
        for (int ai = 0; ai < 2; ++ai)
#pragma unroll
            for (int m = 0; m < 4; ++m) { const int row = row0 + ai * HALF + m * 16; const size_t off = (size_t)row * ldc + col0; const float rs = 1.f / sqrtf(ssq[row] * invk + eps);
#pragma unroll
                for (int bj = 0; bj < 2; ++bj) { const f32x4 v0 = acc[ai][bj][m][0] * rs, v1 = acc[ai][bj][m][1] * rs;
                    const h2 p0 = {(_Float16)v0[0], (_Float16)v0[1]}, p1 = {(_Float16)v0[2], (_Float16)v0[3]}, p2 = {(_Float16)v1[0], (_Float16)v1[1]}, p3 = {(_Float16)v1[2], (_Float16)v1[3]};
                    u32x4 w; w.x = __builtin_bit_cast(unsigned, p0); w.y = __builtin_bit_cast(unsigned, p1); w.z = __builtin_bit_cast(unsigned, p2); w.w = __builtin_bit_cast(unsigned, p3);
                    *(u32x4*)(C + off + bj * HALF) = w; } }
    }
};
template <class Epi, class Sched, bool ALIGN_EPI = false, bool SP2 = false>
__device__ __forceinline__ void gemm_phase(PG8_LAS unsigned char* lds, const Gemm g, const Sched& S, const Epi& E) {
    const int tid = threadIdx.x, wid = __builtin_amdgcn_readfirstlane(tid >> 6), lane = tid & 63, wr = wid >> 2, wc = wid & 3, fr = lane & 15, fq = lane >> 4;
    const int K = g.K, nt = K / BK;
    unsigned voffA[2], voffB[2];
#pragma unroll
    for (int i = 0; i < 2; ++i) { int R, C; stage_rc(tid * 16 + i * 8192, R, C); const int Rb = Epi::PERM ? ((R & ~31) + perm32(R & 31)) : R;
        voffA[i] = (unsigned)(R * K + C) * 2u; voffB[i] = (unsigned)(Rb * K + C) * 2u; }
    const size_t kstep = (size_t)(BK * 2);
    const size_t hstep = (size_t)HALF * K * 2;
    const size_t tstep = 2 * hstep;
    const unsigned ldsw = (unsigned)wid * 1024u;
    const int aoff = lds_byte(wr * 64 + fr, fq * 8), boff = lds_byte(wc * 32 + fr, fq * 8);
#define PG8_SA(b, h) (((b) * 2 + (h)) * HTB)
#define PG8_SB(b, h) ((4 + (b) * 2 + (h)) * HTB)
#define PG8_STAGE(bufoff, gbase, voff) do { _Pragma("unroll") for (int _i = 0; _i < 2; ++_i) \
        __builtin_amdgcn_global_load_lds((const unsigned*)((const char*)(gbase) + (voff)[_i]), (PG8_LAS unsigned*)(lds + (bufoff) + ldsw + _i * 8192), 16, 0, 0); } while (0)
#define PG8_LDA(dst, b, h) do { _Pragma("unroll") for (int m = 0; m < 4; ++m) _Pragma("unroll") for (int k = 0; k < 2; ++k) dst[m][k] = *(const PG8_LAS bf16x8*)(lds + PG8_SA(b, h) + aoff + m * 2048 + k * 1024); } while (0)
#define PG8_LDB(dst, b, h) do { _Pragma("unroll") for (int n = 0; n < 2; ++n) _Pragma("unroll") for (int k = 0; k < 2; ++k) dst[n][k] = *(const PG8_LAS bf16x8*)(lds + PG8_SB(b, h) + boff + n * 2048 + k * 1024); } while (0)
#define PG8_MMA(ai, bj, At, Bt) do { __builtin_amdgcn_s_setprio(1); _Pragma("unroll") for (int m = 0; m < 4; ++m) _Pragma("unroll") for (int n = 0; n < 2; ++n) _Pragma("unroll") for (int k = 0; k < 2; ++k) \
        acc[ai][bj][m][n] = __builtin_amdgcn_mfma_f32_16x16x32_bf16(Bt[n][k], At[m][k], acc[ai][bj][m][n], 0, 0, 0); __builtin_amdgcn_s_setprio(0); } while (0)
#define PG8_WAIT_V(n) asm volatile("s_waitcnt vmcnt(" #n ")" ::: "memory")
#define PG8_WAIT_L(n) asm volatile("s_waitcnt lgkmcnt(" #n ")" ::: "memory")
#define PG8_BAR __builtin_amdgcn_s_barrier()
#define PG8_SCHED __builtin_amdgcn_sched_barrier(0)
    Unit cur, nxt; int ui = 0;
    if (!S.next(0, cur)) return;
    f32x4 acc[2][2][4][2];
#pragma unroll
    for (int a = 0; a < 2; ++a)
#pragma unroll
        for (int b = 0; b < 2; ++b)
#pragma unroll
            for (int m = 0; m < 4; ++m)
#pragma unroll
                for (int n = 0; n < 2; ++n) acc[a][b][m][n] = (f32x4){0.f, 0.f, 0.f, 0.f};
    bf16x8 At[4][2], B0[2][2], B1[2][2];
    const char* cA = (const char*)g.A + (size_t)cur.pm * tstep; const char* cB = (const char*)g.Bt + (size_t)cur.pn * tstep;
    S.a_ready(cur);
    if constexpr (SP2) {
        PG8_STAGE(PG8_SB(0, 0), cB, voffB); PG8_STAGE(PG8_SB(0, 1), cB + hstep, voffB); PG8_STAGE(PG8_SA(0, 0), cA, voffA); PG8_STAGE(PG8_SA(0, 1), cA + hstep, voffA);
        if (wr == 1) PG8_BAR;
        PG8_WAIT_V(2); PG8_BAR;
        PG8_STAGE(PG8_SB(1, 0), cB + kstep, voffB); PG8_STAGE(PG8_SA(1, 0), cA + kstep, voffA); PG8_STAGE(PG8_SB(1, 1), cB + hstep + kstep, voffB);
        PG8_WAIT_V(6); PG8_BAR;
    } else {
        PG8_STAGE(PG8_SB(0, 0), cB, voffB); PG8_STAGE(PG8_SA(0, 0), cA, voffA); PG8_STAGE(PG8_SB(0, 1), cB + hstep, voffB); PG8_STAGE(PG8_SA(0, 1), cA + hstep, voffA);
        if (wr == 1) PG8_BAR;
        PG8_WAIT_V(4); PG8_BAR;
        PG8_STAGE(PG8_SB(1, 0), cB + kstep, voffB); PG8_STAGE(PG8_SA(1, 0), cA + kstep, voffA); PG8_STAGE(PG8_SB(1, 1), cB + hstep + kstep, voffB);
        PG8_WAIT_V(6); PG8_BAR;
    }
    for (;;) {
        const bool has_next = S.next(ui + 1, nxt);
        const char* nA = has_next ? (const char*)g.A + (size_t)nxt.pm * tstep : cA; const char* nB = has_next ? (const char*)g.Bt + (size_t)nxt.pn * tstep : cB;
        for (int t = 0; t < nt; t += 2) {
            const bool last = (t == nt - 2);
            const char* a1 = cA + (size_t)(t + 1) * kstep;
            const char* a2 = last ? nA : cA + (size_t)(t + 2) * kstep; const char* b2 = last ? nB : cB + (size_t)(t + 2) * kstep;
            const char* a3 = a2 + kstep; const char* b3 = b2 + kstep;
            if (last && has_next) S.a_ready(nxt);
            if constexpr (SP2) {
            PG8_LDB(B0, 0, 0); PG8_LDB(B1, 0, 1); PG8_SCHED; PG8_LDA(At, 0, 0); PG8_STAGE(PG8_SA(1, 1), a1 + hstep, voffA);
            PG8_WAIT_V(8); PG8_WAIT_L(0); PG8_BAR; PG8_MMA(0, 0, At, B0); PG8_MMA(0, 1, At, B1); PG8_BAR; PG8_SCHED;
            PG8_LDA(At, 0, 1); PG8_STAGE(PG8_SB(0, 0), b2, voffB); PG8_STAGE(PG8_SB(0, 1), b2 + hstep, voffB); PG8_STAGE(PG8_SA(0, 0), a2, voffA);
            PG8_WAIT_V(8); PG8_WAIT_L(0); PG8_BAR; PG8_MMA(1, 0, At, B0); PG8_MMA(1, 1, At, B1); PG8_BAR; PG8_SCHED;
            PG8_LDB(B0, 1, 0); PG8_LDB(B1, 1, 1); PG8_SCHED; PG8_LDA(At, 1, 0); PG8_STAGE(PG8_SA(0, 1), a2 + hstep, voffA);
            PG8_WAIT_V(8); PG8_WAIT_L(0); PG8_BAR; PG8_MMA(0, 0, At, B0); PG8_MMA(0, 1, At, B1); PG8_BAR; PG8_SCHED;
            PG8_LDA(At, 1, 1); PG8_STAGE(PG8_SB(1, 0), b3, voffB); PG8_STAGE(PG8_SB(1, 1), b3 + hstep, voffB); PG8_STAGE(PG8_SA(1, 0), a3, voffA);
            PG8_WAIT_V(8); PG8_WAIT_L(0); PG8_BAR; PG8_MMA(1, 0, At, B0); PG8_MMA(1, 1, At, B1); PG8_BAR; PG8_SCHED;
            } else {
            PG8_LDB(B0, 0, 0); PG8_SCHED; PG8_LDA(At, 0, 0); PG8_STAGE(PG8_SA(1, 1), a1 + hstep, voffA);
            PG8_WAIT_L(8); PG8_BAR; PG8_WAIT_L(0); PG8_MMA(0, 0, At, B0); PG8_BAR; PG8_SCHED;
            PG8_LDB(B1, 0, 1); PG8_STAGE(PG8_SB(0, 0), b2, voffB);
            PG8_BAR; PG8_WAIT_L(0); PG8_MMA(0, 1, At, B1); PG8_BAR;
            PG8_LDA(At, 0, 1); PG8_STAGE(PG8_SA(0, 0), a2, voffA);
            PG8_BAR; PG8_WAIT_L(0); PG8_MMA(1, 0, At, B0); PG8_BAR; PG8_SCHED;
            PG8_STAGE(PG8_SB(0, 1), b2 + hstep, voffB);
            PG8_WAIT_V(6); PG8_BAR; PG8_MMA(1, 1, At, B1); PG8_BAR;
            PG8_LDB(B0, 1, 0); PG8_SCHED; PG8_LDA(At, 1, 0); PG8_STAGE(PG8_SA(0, 1), a2 + hstep, voffA);
            PG8_WAIT_L(8); PG8_BAR; PG8_WAIT_L(0); PG8_MMA(0, 0, At, B0); PG8_BAR; PG8_SCHED;
            PG8_LDB(B1, 1, 1); PG8_STAGE(PG8_SB(1, 0), b3, voffB);
            PG8_BAR; PG8_WAIT_L(0); PG8_MMA(0, 1, At, B1); PG8_BAR;
            PG8_LDA(At, 1, 1); PG8_STAGE(PG8_SA(1, 0), a3, voffA);
            PG8_BAR; PG8_WAIT_L(0); PG8_MMA(1, 0, At, B0); PG8_BAR; PG8_SCHED;
            PG8_STAGE(PG8_SB(1, 1), b3 + hstep, voffB);
            PG8_WAIT_V(6); PG8_BAR; PG8_MMA(1, 1, At, B1); PG8_BAR;
            }
        }
        if constexpr (ALIGN_EPI) { if (wr == 0) PG8_BAR; }
        if constexpr (!Epi::AFTER_DRAIN) { E(acc, cur, wr, wc, fr, fq); S.done(cur); }
        if (!has_next) break;
#pragma unroll
        for (int a = 0; a < 2; ++a)
#pragma unroll
            for (int b = 0; b < 2; ++b)
#pragma unroll
                for (int m = 0; m < 4; ++m)
#pragma unroll
                    for (int n = 0; n < 2; ++n) acc[a][b][m][n] = (f32x4){0.f, 0.f, 0.f, 0.f};
        cur = nxt; cA = nA; cB = nB; ++ui;
        if constexpr (ALIGN_EPI) { if (wr == 1) PG8_BAR; }
    }
    PG8_WAIT_V(0);
    if constexpr (!ALIGN_EPI) { if (wr == 0) PG8_BAR; }
    PG8_BAR;
    if constexpr (Epi::AFTER_DRAIN) { E.fused(acc, cur, wr, wc, fr, fq, lds, wid, lane); S.done(cur); }
#undef PG8_SA
#undef PG8_SB
#undef PG8_STAGE
#undef PG8_LDA
#undef PG8_LDB
#undef PG8_MMA
#undef PG8_WAIT_V
#undef PG8_WAIT_L
#undef PG8_BAR
#undef PG8_SCHED
}
}
#ifndef PG8_SP2
#define PG8_SP2 true
#endif
#ifndef PG8_ALIGN
#define PG8_ALIGN true
#endif

constexpr int NWAVES = 8;
constexpr int NTOK = 32768, DM = 1024, SEQ = 2048, NBATCH = 16, INW = 3584;
constexpr int C_DQ = 0, C_DK = 512, C_DV = 1024, C_HQ = 1536, C_HF = 2048, C_HI = 2560, C_HG = 3072;
constexpr float EPS = 1e-6f;
constexpr float QSCALE = 0.125f * 1.4426950408889634f;
constexpr float LAM_INIT = 0.2f;
constexpr int NEXP_SEL = 128;

constexpr size_t MiB = 1u << 20;
constexpr size_t WS_CTL = 0, CTL_ZERO_BYTES = 1 * MiB;
constexpr size_t WS_SMALL = 1 * MiB;
constexpr size_t WS_WIN = 2 * MiB;
constexpr size_t WS_WOUT = 10 * MiB;
constexpr size_t WS_W2 = 12 * MiB;
constexpr size_t WS_U8 = 17 * MiB;
constexpr size_t WS_V8 = 33 * MiB;
constexpr size_t WS_SU = 49 * MiB;
constexpr size_t WS_SV = 49 * MiB + 512 * 1024;
constexpr size_t WS_X8 = 50 * MiB;
constexpr size_t WS_SX = 116 * MiB;
constexpr size_t WS_GSU = 120 * MiB;
constexpr size_t WS_HN = 84 * MiB;
constexpr size_t WS_PROJ = 148 * MiB;
constexpr size_t WS_HN2 = 148 * MiB;
constexpr size_t WS_SC = 212 * MiB;
constexpr size_t WS_PO = 352 * MiB;
constexpr size_t WS_IDX = 468 * MiB;
constexpr size_t WS_GATE = 484 * MiB;
constexpr size_t WS_END = 500 * MiB;
constexpr int SM_LB = 0, SM_LAM = 512, SM_BIAS = 1024;
constexpr int CW_BAR = 4096;
constexpr int CW_ATTQ = 8192;
constexpr int CW_SSQ = 131072;

constexpr int RING_OFF = 0, RING_BYTES = 139264;
constexpr int LDSCTL_OFF = RING_BYTES, MISC_OFF = LDSCTL_OFF + 320;
constexpr int LDS_BYTES = 147456;

#define GAS __attribute__((address_space(1)))
#define LAS __attribute__((address_space(3)))
typedef unsigned short bf16;
typedef unsigned v4u __attribute__((ext_vector_type(4)));
typedef unsigned v2u __attribute__((ext_vector_type(2)));
typedef float f32x4 __attribute__((ext_vector_type(4)));
typedef short bf16x8 __attribute__((ext_vector_type(8)));
typedef GAS unsigned gu32;
typedef long l2 __attribute__((ext_vector_type(2)));
typedef int v4i __attribute__((ext_vector_type(4)));
#define RLX_AGENT __ATOMIC_RELAXED, __HIP_MEMORY_SCOPE_AGENT
#define LDS_WAIT() asm volatile("s_waitcnt lgkmcnt(0)" ::: "memory")
#define VM_WAIT() asm volatile("s_waitcnt vmcnt(0)" ::: "memory")
__device__ __forceinline__ unsigned f2bf(float f) { unsigned u = __builtin_bit_cast(unsigned, f); return (u + 0x7fffu + ((u >> 16) & 1u)) >> 16; }
__device__ __forceinline__ unsigned pk2(float lo, float hi) { return f2bf(lo) | (f2bf(hi) << 16); }
__device__ __forceinline__ float bflo(unsigned w) { return __builtin_bit_cast(float, w << 16); }
__device__ __forceinline__ float bfhi(unsigned w) { return __builtin_bit_cast(float, w & 0xffff0000u); }

#define XB_TMO      128
#define XB_XCNT(j)  (256  + 64 * (j))
#define XB_XSUB(j)  (1280 + 64 * (j))
#define XB_XGEN(j)  (2304 + 64 * (j))
#define XB_TOP      3328
#define XB_TOPGEN   3392
#define XCD_BAR_WORDS 3456
#define XB_SPIN_CAP (1u << 18)
__device__ __forceinline__ unsigned xb_ld(unsigned* p)              { return __hip_atomic_load(p, __ATOMIC_RELAXED, __HIP_MEMORY_SCOPE_AGENT); }
__device__ __forceinline__ unsigned xb_add(unsigned* p, unsigned v) { return __hip_atomic_fetch_add(p, v, __ATOMIC_RELAXED, __HIP_MEMORY_SCOPE_AGENT); }
__device__ __forceinline__ unsigned xb_xcc_id() { return (unsigned)__builtin_amdgcn_s_getreg((3 << 11) | 20) & 0xFu; }
#define XB_SPIN(cond, bar) do { unsigned _sp = 0; while (cond) { __builtin_amdgcn_s_sleep(1); \
    if ((++_sp & 255u) == 0u) { if (xb_ld(&(bar)[XB_TMO])) break; if (_sp > XB_SPIN_CAP) { atomicAdd(&(bar)[XB_TMO], 1u); break; } } } } while (0)
struct XcdBarrier { unsigned* bar; unsigned x; volatile LAS unsigned* st; };
__device__ __forceinline__ XcdBarrier xcd_barrier_post(unsigned* bar, volatile LAS unsigned* st) {
    XcdBarrier b; b.bar = bar; b.x = xb_xcc_id(); b.st = st;
    if (threadIdx.x == 0) (void)xb_add(&bar[XB_XCNT(b.x)], 1u);
    return b;
}
__device__ __forceinline__ void xcd_barrier_complete(unsigned* bar, unsigned x, unsigned& nloc, unsigned& nx) {
    const unsigned G = gridDim.x * gridDim.y * gridDim.z;
    unsigned sum, cnt, mine, sp = 0u;
    for (;;) {
        sum = 0u; cnt = 0u; mine = 0u;
#pragma unroll
        for (unsigned j = 0; j < 16; ++j) { const unsigned c = xb_ld(&bar[XB_XCNT(j)]); sum += c; cnt += (c > 0u) ? 1u : 0u; mine = (j == x) ? c : mine; }
        if (sum == G) break;
        __builtin_amdgcn_s_sleep(1);
        if ((++sp & 255u) == 0u) { if (xb_ld(&bar[XB_TMO])) break; if (sp > XB_SPIN_CAP) { atomicAdd(&bar[XB_TMO], 1u); break; } }
    }
    nloc = mine > 0u ? mine : 1u; nx = cnt > 0u ? cnt : 1u;
}
__device__ __forceinline__ void xcd_barrier(const XcdBarrier& b) {
    asm volatile("s_waitcnt vmcnt(0)" ::: "memory");
    __syncthreads();
    if (threadIdx.x == 0) {
        unsigned* bar = b.bar;
        __builtin_amdgcn_s_waitcnt(0);
        unsigned nloc = b.st[0], nx = b.st[1];
        if (nloc == 0u) { xcd_barrier_complete(bar, b.x, nloc, nx); b.st[0] = nloc; b.st[1] = nx; }
        const unsigned old = xb_add(&bar[XB_XSUB(b.x)], 1u);
        const unsigned gen = old / nloc;
        if (old + 1u == (gen + 1u) * nloc) {
            __builtin_amdgcn_fence(__ATOMIC_RELEASE, "agent");
            asm volatile("s_waitcnt vmcnt(0)" ::: "memory");
            const unsigned og = xb_add(&bar[XB_TOP], 1u);
            const unsigned tg = og / nx;
            if (og + 1u == (tg + 1u) * nx) xb_add(&bar[XB_TOPGEN], 1u);
            else XB_SPIN(xb_ld(&bar[XB_TOPGEN]) == tg, bar);
            __builtin_amdgcn_fence(__ATOMIC_ACQUIRE, "agent");
            xb_add(&bar[XB_XGEN(b.x)], 1u);
            asm volatile("s_waitcnt vmcnt(0)" ::: "memory");
        } else {
            XB_SPIN(xb_ld(&bar[XB_XGEN(b.x)]) == gen, bar);
            __builtin_amdgcn_fence(__ATOMIC_ACQUIRE, "agent");
            asm volatile("s_waitcnt vmcnt(0)" ::: "memory");
        }
    }
    __syncthreads();
}

#define SCHED_FENCE() __builtin_amdgcn_sched_barrier(0)
__device__ __forceinline__ float gelu_as(float v) {
    const float av = fabsf(v), t = __builtin_amdgcn_rcpf(av * 0.2316418882f + 1.0f);
    float q = t * 0.5307027145f + (-0.7265760135f); q = q * t + 0.7107068705f; q = q * t + (-0.142248368f); q = q * t + 0.127414796f; q = q * t;
    const float e = __builtin_amdgcn_exp2f((v * v) * (-0.72134752044f));
    const float mm = v * (q * e);
    return v < 0.f ? mm : v - mm;
}
struct Frame {
    LAS unsigned char* lds;
    volatile LAS unsigned* MISC;
    int tid, lane, wave, vcu, G;
    const float* in[18]; float* out; unsigned char* ws;
};
__device__ __forceinline__ float wave_sum(float v) {
#pragma unroll
    for (int o = 1; o < 64; o <<= 1) v += __shfl_xor(v, o);
    return v;
}
__device__ __forceinline__ float sigmoidf_(float x) { return 1.f / (1.f + __expf(-x)); }

__device__ __forceinline__ void p0_transpose_item(const float* W, int K, int N, bf16* WT, int row_off, LAS float* scr, int item, int lane) {
    const int nblk = N / 32, kb = item / nblk, nb = item % nblk, k0 = 64 * kb, n0 = 32 * nb;
#pragma unroll 8
    for (int i = 0; i < 32; ++i) { const int kk = 2 * i + (lane >> 5); scr[kk * 33 + (lane & 31)] = W[(size_t)(k0 + kk) * N + n0 + (lane & 31)]; }
    LDS_WAIT(); asm volatile("" ::: "memory");
    const int c = lane & 7;
#pragma unroll
    for (int j = 0; j < 4; ++j) { const int n = (lane >> 3) + 8 * j; const LAS float* s = scr + (8 * c) * 33 + n;
        v4u o; o.x = pk2(s[0 * 33], s[1 * 33]); o.y = pk2(s[2 * 33], s[3 * 33]); o.z = pk2(s[4 * 33], s[5 * 33]); o.w = pk2(s[6 * 33], s[7 * 33]);
        *(GAS v4u*)(WT + (size_t)(row_off + n0 + n) * K + k0 + 8 * c) = o; }
    LDS_WAIT(); asm volatile("" ::: "memory");
}

__device__ __forceinline__ void quant_vals_fp8(const f32x4 (&v)[4], unsigned char* dst, float* dq, int lane, size_t slice_stride) {
    float mx = 0.f;
#pragma unroll
    for (int j = 0; j < 4; ++j) mx = fmaxf(mx, fmaxf(fmaxf(fabsf(v[j].x), fabsf(v[j].y)), fmaxf(fabsf(v[j].z), fabsf(v[j].w))));
#pragma unroll
    for (int o = 1; o < 64; o <<= 1) mx = fmaxf(mx, __shfl_xor(mx, o));
    const float qs = mx > 0.f ? 224.f / mx : 1.f;
#pragma unroll
    for (int j = 0; j < 4; ++j) { int p = __builtin_amdgcn_cvt_pk_fp8_f32(v[j].x * qs, v[j].y * qs, 0, false); p = __builtin_amdgcn_cvt_pk_fp8_f32(v[j].z * qs, v[j].w * qs, p, true);
        const int d = 4 * lane + 256 * j; *(GAS unsigned*)(dst + (slice_stride ? (size_t)(d >> 7) * slice_stride + (d & 127) : (size_t)d)) = (unsigned)p; }
    if (lane == 0) *dq = mx > 0.f ? mx * (1.f / 224.f) : 1.f;
}
__device__ __forceinline__ void quant_row_fp8(const float* src, unsigned char* dst, float* dq, int lane, size_t slice_stride) {
    const GAS f32x4* xr = (const GAS f32x4*)src + lane; f32x4 v[4];
#pragma unroll
    for (int j = 0; j < 4; ++j) v[j] = xr[64 * j];
    quant_vals_fp8(v, dst, dq, lane, slice_stride);
}
__device__ __forceinline__ void p0_prologue(Frame& F) {
    LAS float* scr = (LAS float*)(F.lds + RING_OFF + F.wave * 16384);
    const int gw = F.vcu * NWAVES + F.wave, NGW = F.G * NWAVES;
    bf16* WinT = (bf16*)(F.ws + WS_WIN); bf16* WoutT = (bf16*)(F.ws + WS_WOUT); bf16* W2T = (bf16*)(F.ws + WS_W2);
    float* small = (float*)(F.ws + WS_SMALL);
    if (blockIdx.x == 0) {
        const int t = F.tid;
        { const float l0 = F.in[9][t], l1 = F.in[9][512 + t]; small[SM_LB + t] = 1.f / (1.f + expf(l1 - l0)); }
        { const int h = t >> 7, n = t & 127; int bk;
          if (n < 16) bk = n; else { bk = 16 + (int)(logf((float)n * (1.f / 16.f)) / logf(8.f) * 16.f); bk = bk > 31 ? 31 : bk; }
          small[SM_BIAS + t] = F.in[8][bk * 4 + h] * 1.4426950408889634f; }
        if (F.wave == 0) {
            const float a = wave_sum(F.in[3][F.lane] * F.in[4][F.lane]), b = wave_sum(F.in[5][F.lane] * F.in[6][F.lane]);
            if (F.lane == 0) small[SM_LAM] = expf(a) - expf(b) + LAM_INIT;
        }
    }
    constexpr int I_IN = (DM / 64) * (INW / 32), I_OUT = (DM / 64) * (DM / 32);
    for (int it = gw; it < I_IN + I_OUT; it += NGW) {
        if (it < I_IN) p0_transpose_item(F.in[2], DM, INW, WinT, 0, scr, it, F.lane);
        else p0_transpose_item(F.in[11], DM, DM, WoutT, 0, scr, it - I_IN, F.lane);
    }
    for (int u = F.vcu; u < 256; u += F.G) {
        const int hc = u >> 4, kb = u & 15, k = kb * 64 + F.lane;
        const GAS f32x4* wrow = (const GAS f32x4*)(F.in[13] + (size_t)k * 2048 + hc * 128);
        float a[16];
#pragma unroll
        for (int nn = 0; nn < 16; ++nn) a[nn] = 0.f;
        const float* kr = F.in[14] + ((size_t)hc * 128 + F.wave * 16) * 128;
        for (int i = 0; i < 32; ++i) {
            const f32x4 w = wrow[i];
#pragma unroll
            for (int nn = 0; nn < 16; ++nn) { const float* kk = kr + nn * 128 + 4 * i; a[nn] += (kk[0] * w.x + kk[1] * w.y) + (kk[2] * w.z + kk[3] * w.w); }
        }
        const float g2k = F.in[12][k];
#pragma unroll
        for (int nn = 0; nn < 16; ++nn) W2T[((size_t)hc * 128 + F.wave * 16 + nn) * DM + k] = (bf16)f2bf(a[nn] * g2k);
    }
    bf16* HN = (bf16*)(F.ws + WS_HN);
    for (int m = gw; m < NTOK; m += 2 * NGW) {
        const int m2 = m + NGW;
        const GAS f32x4* xa = (const GAS f32x4*)(F.in[0] + (size_t)m * DM) + F.lane; const GAS f32x4* xb = (const GAS f32x4*)(F.in[0] + (size_t)(m2 < NTOK ? m2 : m) * DM) + F.lane;
        const GAS f32x4* gr = (const GAS f32x4*)F.in[1] + F.lane;
        f32x4 va[4], vb[4]; float sa = 0.f, sb = 0.f;
#pragma unroll
        for (int j = 0; j < 4; ++j) { va[j] = xa[64 * j]; vb[j] = xb[64 * j]; }
#pragma unroll
        for (int j = 0; j < 4; ++j) { sa += (va[j].x * va[j].x + va[j].y * va[j].y) + (va[j].z * va[j].z + va[j].w * va[j].w); sb += (vb[j].x * vb[j].x + vb[j].y * vb[j].y) + (vb[j].z * vb[j].z + vb[j].w * vb[j].w); }
#pragma unroll
        for (int o = 1; o < 64; o <<= 1) { sa += __shfl_xor(sa, o); sb += __shfl_xor(sb, o); }
        const float ra = 1.f / sqrtf(sa * (1.f / DM) + EPS), rb = 1.f / sqrtf(sb * (1.f / DM) + EPS);
        GAS unsigned long long* oa = (GAS unsigned long long*)(HN + (size_t)m * DM) + F.lane; GAS unsigned long long* ob = (GAS unsigned long long*)(HN + (size_t)m2 * DM) + F.lane;
#pragma unroll
        for (int j = 0; j < 4; ++j) { const f32x4 gg = gr[64 * j];
            oa[64 * j] = (unsigned long long)pk2(va[j].x * ra * gg.x, va[j].y * ra * gg.y) | ((unsigned long long)pk2(va[j].z * ra * gg.z, va[j].w * ra * gg.w) << 32);
            if (m2 < NTOK) ob[64 * j] = (unsigned long long)pk2(vb[j].x * rb * gg.x, vb[j].y * rb * gg.y) | ((unsigned long long)pk2(vb[j].z * rb * gg.z, vb[j].w * rb * gg.w) << 32); }
    }
}


constexpr int QCHUNKS = 2 * 16384 / 64;
__device__ __forceinline__ void quant_chunk(Frame& F, int c) {
    unsigned char* U8 = F.ws + WS_U8; unsigned char* V8 = F.ws + WS_V8; float* SU = (float*)(F.ws + WS_SU); float* SV = (float*)(F.ws + WS_SV);
#pragma unroll 1
    for (int k = 0; k < 8; ++k) { const int rr = 64 * c + 8 * F.wave + k;
        if (rr < 16384) quant_row_fp8(F.in[15] + (size_t)rr * DM, U8 + (size_t)rr * 128, SU + rr, F.lane, (size_t)16384 * 128);
        else { const int e = rr - 16384; quant_row_fp8(F.in[16] + (size_t)e * DM, V8 + (size_t)e * 128, SV + e, F.lane, (size_t)16384 * 128); } }
}

__device__ __forceinline__ void quant_drain(Frame& F) {
    unsigned* qctr = (unsigned*)(F.ws + WS_CTL) + CW_ATTQ + 128;
    for (;;) {
        __syncthreads();
        if (F.tid == 0) F.MISC[13] = __hip_atomic_fetch_add(qctr, 1u, __ATOMIC_RELAXED, __HIP_MEMORY_SCOPE_AGENT);
        __syncthreads();
        const int qc = (int)F.MISC[13];
        if (qc >= QCHUNKS) break;
        quant_chunk(F, qc);
    }
}

typedef float f32x16 __attribute__((ext_vector_type(16)));
typedef short s16x4 __attribute__((ext_vector_type(4)));
typedef short v4i16_t __attribute__((ext_vector_type(4)));
typedef float f32x2_t __attribute__((ext_vector_type(2))); typedef __bf16 bf16x2_t __attribute__((ext_vector_type(2)));
__device__ __forceinline__ unsigned cvtpk_bf16(float lo, float hi) { f32x2_t v = {lo, hi}; bf16x2_t b = __builtin_convertvector(v, bf16x2_t); return __builtin_bit_cast(unsigned, b); }
__device__ __forceinline__ float xhalf_max(float v) { return fmaxf(v, __shfl_xor(v, 32)); }
__device__ __forceinline__ float xhalf_sum(float v) { return v + __shfl_xor(v, 32); }
__device__ __forceinline__ float max3f_(float a, float b, float c) { float r; asm("v_max3_f32 %0, %1, %2, %3" : "=v"(r) : "v"(a), "v"(b), "v"(c)); return r; }
constexpr int AT_KP = 144, AT_VP = 320, AT_K1 = 64 * AT_KP, AT_V = 2 * AT_K1, AT_BUF = AT_V + 64 * AT_VP;
constexpr int AT_XO = 0, AT_YB = 65536, AT_YP = 272, AT_TAB = 100352, AT_Q = 100864;
static_assert(AT_Q + 8 * 4096 <= RING_BYTES, "attention LDS map");
__device__ __forceinline__ void attn_mfma(Frame& F, int qslot) {
    const bf16* PROJ = (const bf16*)(F.ws + WS_PROJ); bf16* MIXED = (bf16*)(F.ws + WS_HN);
    const float* small = (const float*)(F.ws + WS_SMALL);
    LAS unsigned char* lds = F.lds;
    LAS float* TAB = (LAS float*)(lds + AT_TAB);
    const int tid = F.tid, lane = F.lane, wave = F.wave, map = wave >> 2, qt = wave & 3, r32 = lane & 31, hi = lane >> 5;
    const float lam = small[SM_LAM];
    const int koff = map * AT_K1 + r32 * AT_KP + hi * 16;
    const int voff = AT_V + (4 * hi + ((lane & 15) >> 2)) * AT_VP + (16 * ((lane >> 4) & 1) + 4 * (lane & 3)) * 2;
    unsigned* qctr = (unsigned*)(F.ws + WS_CTL) + CW_ATTQ + 64 * qslot;
    for (;;) {
        __syncthreads();
        if (tid == 0) F.MISC[12] = __hip_atomic_fetch_add(qctr, 1u, __ATOMIC_RELAXED, __HIP_MEMORY_SCOPE_AGENT);
        __syncthreads();
        const int L = (int)F.MISC[12];
        if (L >= 1024) break;
        const int qb = 15 - (L >> 6), bh = L & 63;
        const int b = bh >> 2, h = bh & 3, q0 = qb * 128; const size_t tok0 = (size_t)b * SEQ;
        const int NT = (q0 + 128) / 64;
        if (tid < 128) TAB[tid] = small[SM_BIAS + h * 128 + tid];
        LAS unsigned char* qlds = lds + AT_Q + wave * 4096 + lane * 16;
        { const bf16* qrow = PROJ + (tok0 + q0 + 32 * qt + r32) * INW + C_DQ + h * 128 + map * 64 + 8 * hi;
#pragma unroll
          for (int s4 = 0; s4 < 4; ++s4) *(LAS bf16x8*)(qlds + 1024 * s4) = *(const GAS bf16x8*)(qrow + 16 * s4); }
        const bf16* ksrc = PROJ + (tok0 + (tid >> 4)) * INW + C_DK + h * 128 + (tid & 15) * 8;
        const bf16* vsrc = PROJ + (tok0 + (tid >> 4)) * INW + C_DV + h * 128 + (tid & 15) * 8;
        const int kdst = ((tid & 15) >> 3) * AT_K1 + (tid >> 4) * AT_KP + (tid & 7) * 16, vdst = AT_V + (tid >> 4) * AT_VP + (tid & 15) * 16;
        v4u krA[2], vrA[2], krB[2], vrB[2];
#pragma unroll
        for (int i = 0; i < 2; ++i) { krB[i] = *(const GAS v4u*)(ksrc + (size_t)(32 * i) * INW); vrB[i] = *(const GAS v4u*)(vsrc + (size_t)(32 * i) * INW); }
#pragma unroll
        for (int i = 0; i < 2; ++i) { krA[i] = *(const GAS v4u*)(ksrc + (size_t)(64 + 32 * i) * INW); vrA[i] = *(const GAS v4u*)(vsrc + (size_t)(64 + 32 * i) * INW); }
#pragma unroll
        for (int i = 0; i < 2; ++i) { *(LAS v4u*)(lds + kdst + 32 * i * AT_KP) = krB[i]; *(LAS v4u*)(lds + vdst + 32 * i * AT_VP) = vrB[i]; }
        __syncthreads();
        const float bfar = TAB[127];
        f32x16 o[4];
#pragma unroll
        for (int mt = 0; mt < 4; ++mt) o[mt] = (f32x16){0.f,0.f,0.f,0.f,0.f,0.f,0.f,0.f,0.f,0.f,0.f,0.f,0.f,0.f,0.f,0.f};
        float mrun = -INFINITY, lsum = 0.f;
        const int qlo = q0 + 32 * qt, qpos = qlo + r32;
#pragma unroll
        for (int i = 0; i < 2; ++i) { if (2 < NT) { krB[i] = *(const GAS v4u*)(ksrc + (size_t)(128 + 32 * i) * INW); vrB[i] = *(const GAS v4u*)(vsrc + (size_t)(128 + 32 * i) * INW); } }
        for (int j2 = 0; j2 < NT; j2 += 2) {
          { const int j = j2;
            const int bo = (j & 1) * AT_BUF, bn = ((j + 1) & 1) * AT_BUF;
            if (64 * j <= qlo + 31) {
                f32x16 s0 = (f32x16){0.f,0.f,0.f,0.f,0.f,0.f,0.f,0.f,0.f,0.f,0.f,0.f,0.f,0.f,0.f,0.f}, s1 = s0;
#pragma unroll
                for (int s4 = 0; s4 < 4; ++s4) {
                    const bf16x8 a0 = *(const LAS bf16x8*)(lds + bo + koff + 32 * s4), a1 = *(const LAS bf16x8*)(lds + bo + koff + 32 * AT_KP + 32 * s4);
                    const bf16x8 qfr = *(const LAS bf16x8*)(qlds + 1024 * s4);
                    s0 = __builtin_amdgcn_mfma_f32_32x32x16_bf16(a0, qfr, s0, 0, 0, 0);
                    s1 = __builtin_amdgcn_mfma_f32_32x32x16_bf16(a1, qfr, s1, 0, 0, 0);
                }
                float tm, cadd;
                if (qlo - (64 * j + 63) < 127) {
                    const int kb = 64 * j + 4 * hi; tm = -INFINITY;
#pragma unroll
                    for (int r = 0; r < 16; ++r) { const int n0 = qpos - (kb + (r & 3) + 8 * (r >> 2)), n1 = n0 - 32;
                        float b0 = TAB[n0 > 127 ? 127 : (n0 < 0 ? 0 : n0)], b1 = TAB[n1 > 127 ? 127 : (n1 < 0 ? 0 : n1)];
                        asm volatile("" : "+v"(b0), "+v"(b1));
                        s0[r] = n0 < 0 ? -INFINITY : s0[r] + b0; s1[r] = n1 < 0 ? -INFINITY : s1[r] + b1; tm = max3f_(tm, s0[r], s1[r]); }
                    cadd = 0.f;
                } else {
                    tm = max3f_(s0[0], s1[0], s0[1]);
#pragma unroll
                    for (int r = 1; r < 15; ++r) tm = max3f_(tm, s1[r], s0[r + 1]);
                    tm = fmaxf(tm, s1[15]);
                    tm += bfar; cadd = bfar;
                }
                tm = xhalf_max(tm);
                if (__any(tm > mrun + 8.f)) {
                    const float mnew = fmaxf(mrun, tm), alpha = __builtin_amdgcn_exp2f(mrun - mnew);
                    lsum *= alpha; mrun = mnew;
#pragma unroll
                    for (int mt = 0; mt < 4; ++mt) o[mt] = o[mt] * alpha;
                }
                const float c = cadd - mrun; float psum = 0.f;
#pragma unroll
                for (int r = 0; r < 16; ++r) { s0[r] = __builtin_amdgcn_exp2f(s0[r] + c); s1[r] = __builtin_amdgcn_exp2f(s1[r] + c); psum += s0[r] + s1[r]; }
                lsum += psum;
#pragma unroll
                for (int kt2 = 0; kt2 < 2; ++kt2)
#pragma unroll
                    for (int sp = 0; sp < 2; ++sp) {
                        v4u pw;
                        if (kt2 == 0) { pw.x = cvtpk_bf16(s0[8 * sp], s0[8 * sp + 1]); pw.y = cvtpk_bf16(s0[8 * sp + 2], s0[8 * sp + 3]); pw.z = cvtpk_bf16(s0[8 * sp + 4], s0[8 * sp + 5]); pw.w = cvtpk_bf16(s0[8 * sp + 6], s0[8 * sp + 7]); }
                        else          { pw.x = cvtpk_bf16(s1[8 * sp], s1[8 * sp + 1]); pw.y = cvtpk_bf16(s1[8 * sp + 2], s1[8 * sp + 3]); pw.z = cvtpk_bf16(s1[8 * sp + 4], s1[8 * sp + 5]); pw.w = cvtpk_bf16(s1[8 * sp + 6], s1[8 * sp + 7]); }
                        const bf16x8 pf = __builtin_bit_cast(bf16x8, pw);
#pragma unroll
                        for (int mt = 0; mt < 4; ++mt) {
                            LAS unsigned char* vp = lds + bo + voff + (32 * kt2 + 16 * sp) * AT_VP + 64 * mt;
                            const s16x4 lo = __builtin_bit_cast(s16x4, __builtin_amdgcn_ds_read_tr16_b64_v4i16((LAS v4i16_t*)vp));
                            const s16x4 hi4 = __builtin_bit_cast(s16x4, __builtin_amdgcn_ds_read_tr16_b64_v4i16((LAS v4i16_t*)(vp + 8 * AT_VP)));
                            const bf16x8 af = (bf16x8){lo[0], lo[1], lo[2], lo[3], hi4[0], hi4[1], hi4[2], hi4[3]};
                            o[mt] = __builtin_amdgcn_mfma_f32_32x32x16_bf16(af, pf, o[mt], 0, 0, 0);
                        }
                    }
            }
            if (j + 1 < NT) {
#pragma unroll
                for (int i = 0; i < 2; ++i) { *(LAS v4u*)(lds + bn + kdst + 32 * i * AT_KP) = krA[i]; *(LAS v4u*)(lds + bn + vdst + 32 * i * AT_VP) = vrA[i]; }
                if (j + 3 < NT) {
#pragma unroll
                    for (int i = 0; i < 2; ++i) { krA[i] = *(const GAS v4u*)(ksrc + (size_t)(64 * (j + 3) + 32 * i) * INW); vrA[i] = *(const GAS v4u*)(vsrc + (size_t)(64 * (j + 3) + 32 * i) * INW); }
                }
            }
            __syncthreads();
                  }
          { const int j = j2 + 1;
            const int bo = (j & 1) * AT_BUF, bn = ((j + 1) & 1) * AT_BUF;
            if (64 * j <= qlo + 31) {
                f32x16 s0 = (f32x16){0.f,0.f,0.f,0.f,0.f,0.f,0.f,0.f,0.f,0.f,0.f,0.f,0.f,0.f,0.f,0.f}, s1 = s0;
#pragma unroll
                for (int s4 = 0; s4 < 4; ++s4) {
                    const bf16x8 a0 = *(const LAS bf16x8*)(lds + bo + koff + 32 * s4), a1 = *(const LAS bf16x8*)(lds + bo + koff + 32 * AT_KP + 32 * s4);
                    const bf16x8 qfr = *(const LAS bf16x8*)(qlds + 1024 * s4);
                    s0 = __builtin_amdgcn_mfma_f32_32x32x16_bf16(a0, qfr, s0, 0, 0, 0);
                    s1 = __builtin_amdgcn_mfma_f32_32x32x16_bf16(a1, qfr, s1, 0, 0, 0);
                }
                float tm, cadd;
                if (qlo - (64 * j + 63) < 127) {
                    const int kb = 64 * j + 4 * hi; tm = -INFINITY;
#pragma unroll
                    for (int r = 0; r < 16; ++r) { const int n0 = qpos - (kb + (r & 3) + 8 * (r >> 2)), n1 = n0 - 32;
                        float b0 = TAB[n0 > 127 ? 127 : (n0 < 0 ? 0 : n0)], b1 = TAB[n1 > 127 ? 127 : (n1 < 0 ? 0 : n1)];
                        asm volatile("" : "+v"(b0), "+v"(b1));
                        s0[r] = n0 < 0 ? -INFINITY : s0[r] + b0; s1[r] = n1 < 0 ? -INFINITY : s1[r] + b1; tm = max3f_(tm, s0[r], s1[r]); }
                    cadd = 0.f;
                } else {
                    tm = max3f_(s0[0], s1[0], s0[1]);
#pragma unroll
                    for (int r = 1; r < 15; ++r) tm = max3f_(tm, s1[r], s0[r + 1]);
                    tm = fmaxf(tm, s1[15]);
                    tm += bfar; cadd = bfar;
                }
                tm = xhalf_max(tm);
                if (__any(tm > mrun + 8.f)) {
                    const float mnew = fmaxf(mrun, tm), alpha = __builtin_amdgcn_exp2f(mrun - mnew);
                    lsum *= alpha; mrun = mnew;
#pragma unroll
                    for (int mt = 0; mt < 4; ++mt) o[mt] = o[mt] * alpha;
                }
                const float c = cadd - mrun; float psum = 0.f;
#pragma unroll
                for (int r = 0; r < 16; ++r) { s0[r] = __builtin_amdgcn_exp2f(s0[r] + c); s1[r] = __builtin_amdgcn_exp2f(s1[r] + c); psum += s0[r] + s1[r]; }
                lsum += psum;
#pragma unroll
                for (int kt2 = 0; kt2 < 2; ++kt2)
#pragma unroll
                    for (int sp = 0; sp < 2; ++sp) {
                        v4u pw;
                        if (kt2 == 0) { pw.x = cvtpk_bf16(s0[8 * sp], s0[8 * sp + 1]); pw.y = cvtpk_bf16(s0[8 * sp + 2], s0[8 * sp + 3]); pw.z = cvtpk_bf16(s0[8 * sp + 4], s0[8 * sp + 5]); pw.w = cvtpk_bf16(s0[8 * sp + 6], s0[8 * sp + 7]); }
                        else          { pw.x = cvtpk_bf16(s1[8 * sp], s1[8 * sp + 1]); pw.y = cvtpk_bf16(s1[8 * sp + 2], s1[8 * sp + 3]); pw.z = cvtpk_bf16(s1[8 * sp + 4], s1[8 * sp + 5]); pw.w = cvtpk_bf16(s1[8 * sp + 6], s1[8 * sp + 7]); }
                        const bf16x8 pf = __builtin_bit_cast(bf16x8, pw);
#pragma unroll
                        for (int mt = 0; mt < 4; ++mt) {
                            LAS unsigned char* vp = lds + bo + voff + (32 * kt2 + 16 * sp) * AT_VP + 64 * mt;
                            const s16x4 lo = __builtin_bit_cast(s16x4, __builtin_amdgcn_ds_read_tr16_b64_v4i16((LAS v4i16_t*)vp));
                            const s16x4 hi4 = __builtin_bit_cast(s16x4, __builtin_amdgcn_ds_read_tr16_b64_v4i16((LAS v4i16_t*)(vp + 8 * AT_VP)));
                            const bf16x8 af = (bf16x8){lo[0], lo[1], lo[2], lo[3], hi4[0], hi4[1], hi4[2], hi4[3]};
                            o[mt] = __builtin_amdgcn_mfma_f32_32x32x16_bf16(af, pf, o[mt], 0, 0, 0);
                        }
                    }
            }
            if (j + 1 < NT) {
#pragma unroll
                for (int i = 0; i < 2; ++i) { *(LAS v4u*)(lds + bn + kdst + 32 * i * AT_KP) = krB[i]; *(LAS v4u*)(lds + bn + vdst + 32 * i * AT_VP) = vrB[i]; }
                if (j + 3 < NT) {
#pragma unroll
                    for (int i = 0; i < 2; ++i) { krB[i] = *(const GAS v4u*)(ksrc + (size_t)(64 * (j + 3) + 32 * i) * INW); vrB[i] = *(const GAS v4u*)(vsrc + (size_t)(64 * (j + 3) + 32 * i) * INW); }
                }
            }
            __syncthreads();
                  }
        }
        const float inv = 1.f / xhalf_sum(lsum);
        LAS float* XO = (LAS float*)(lds + AT_XO) + qt * 4096 + r32;
        if (map == 1) {
            const float sc = inv * lam;
#pragma unroll
            for (int mt = 0; mt < 4; ++mt)
#pragma unroll
                for (int r = 0; r < 16; ++r) XO[(32 * mt + (r & 3) + 8 * (r >> 2) + 4 * hi) * 32] = o[mt][r] * sc;
        }
        __syncthreads();
        if (map == 0) {
            float ss = 0.f;
#pragma unroll
            for (int mt = 0; mt < 4; ++mt)
#pragma unroll
                for (int r = 0; r < 16; ++r) { const float a = o[mt][r] * inv - XO[(32 * mt + (r & 3) + 8 * (r >> 2) + 4 * hi) * 32]; o[mt][r] = a; ss += a * a; }
            ss = xhalf_sum(ss);
            const float rr = (1.f - LAM_INIT) / sqrtf(ss * (1.f / 128.f) + EPS);
            LAS unsigned char* yb = lds + AT_YB + qt * (32 * AT_YP);
#pragma unroll
            for (int mt = 0; mt < 4; ++mt)
#pragma unroll
                for (int r4 = 0; r4 < 4; ++r4) { const int dv = 32 * mt + 8 * r4 + 4 * hi; const f32x4 gg = *(const GAS f32x4*)(F.in[7] + dv);
                    v2u w; w.x = cvtpk_bf16(o[mt][4 * r4] * rr * gg.x, o[mt][4 * r4 + 1] * rr * gg.y); w.y = cvtpk_bf16(o[mt][4 * r4 + 2] * rr * gg.z, o[mt][4 * r4 + 3] * rr * gg.w);
                    *(LAS v2u*)(yb + r32 * AT_YP + dv * 2) = w; }
            LDS_WAIT(); asm volatile("" ::: "memory");
            bf16* obase = MIXED + (tok0 + q0 + 32 * qt) * DM + h * 128;
#pragma unroll
            for (int i = 0; i < 8; ++i) { const int id = lane + 64 * i, row = id >> 4, cch = id & 15;
                const v4u w = *(const LAS v4u*)(yb + row * AT_YP + cch * 16); *(GAS v4u*)(obase + (size_t)row * DM + cch * 8) = w; }
        }
    }
}


constexpr int HG_P = 272, HG_KP = 80, HG_VP = 320;
constexpr int HG_QD = 0, HG_KI = 32 * HG_P, HG_KDT = 2 * 32 * HG_P, HG_V = HG_KDT + 128 * HG_KP, HG_CD = HG_V + 32 * HG_VP, HG_BUF = HG_CD + 512;
constexpr int HG_OA = 2 * HG_BUF, HG_OB = HG_OA + 32 * 128 * 4;
static_assert(HG_OB + 32 * 128 * 4 <= RING_BYTES, "hgrn LDS map");
__device__ __forceinline__ bf16x8 pack8(const f32x16& x, int s) {
    v4u p; p.x = cvtpk_bf16(x[8 * s], x[8 * s + 1]); p.y = cvtpk_bf16(x[8 * s + 2], x[8 * s + 3]); p.z = cvtpk_bf16(x[8 * s + 4], x[8 * s + 5]); p.w = cvtpk_bf16(x[8 * s + 6], x[8 * s + 7]);
    return __builtin_bit_cast(bf16x8, p);
}
__device__ __forceinline__ bf16x8 tr_pair(LAS unsigned char* p0, LAS unsigned char* p1) {
    const s16x4 lo = __builtin_bit_cast(s16x4, __builtin_amdgcn_ds_read_tr16_b64_v4i16((LAS v4i16_t*)p0));
    const s16x4 hi4 = __builtin_bit_cast(s16x4, __builtin_amdgcn_ds_read_tr16_b64_v4i16((LAS v4i16_t*)p1));
    return (bf16x8){lo[0], lo[1], lo[2], lo[3], hi4[0], hi4[1], hi4[2], hi4[3]};
}
__device__ __forceinline__ void hgrn_mfma(Frame& F) {
    const bf16* PROJ = (const bf16*)(F.ws + WS_PROJ); bf16* MIXED = (bf16*)(F.ws + WS_HN);
    const float* small = (const float*)(F.ws + WS_SMALL);
    LAS unsigned char* lds = F.lds;
    const int tid = F.tid, lane = F.lane, wave = F.wave, r32 = lane & 31, hh = lane >> 5;
    const int dvt = wave & 3, dkh = wave >> 2;
    const int pc = lane & 31, pdk8 = 16 * wave + 8 * (lane >> 5);
    const int kdoff = (((lane & 15) >> 2)) * HG_VP + (16 * ((lane >> 4) & 1) + 4 * (lane & 3)) * 2;
    const int vc = tid >> 4, vseg = tid & 15;
    const int troff = (((lane & 15) >> 2)) * HG_VP + (32 * dvt + 16 * ((lane >> 4) & 1) + 4 * (lane & 3)) * 2;
    for (int u = F.vcu; u < 64; u += F.G) {
        const int b = u >> 2, h = u & 3; const size_t tok0 = (size_t)b * SEQ;
        const f32x4 lbA = *(const GAS f32x4*)(small + SM_LB + h * 128 + pdk8), lbB = *(const GAS f32x4*)(small + SM_LB + h * 128 + pdk8 + 4);
        const float lbv[8] = {lbA.x, lbA.y, lbA.z, lbA.w, lbB.x, lbB.y, lbB.z, lbB.w};
        const f32x4 g0 = *(const GAS f32x4*)(F.in[10] + 8 * vseg), g1 = *(const GAS f32x4*)(F.in[10] + 8 * vseg + 4);
        f32x16 S0, S1;
#pragma unroll
        for (int r = 0; r < 16; ++r) { S0[r] = 0.f; S1[r] = 0.f; }
        v4u rqA, rfA, rqB, rfB, rvA, rgA, rvB, rgB;
#define HG_LOAD(S, chn) do { const bf16* p_ = PROJ + (tok0 + 32 * (chn) + pc) * INW + h * 128 + pdk8; \
            asm volatile("global_load_dwordx4 %0, %1, off" : "=v"(rq##S) : "v"(p_ + C_HQ) : "memory"); \
            asm volatile("global_load_dwordx4 %0, %1, off" : "=v"(rf##S) : "v"(p_ + C_HF) : "memory"); \
            asm volatile("global_load_dwordx4 %0, %1, off" : "=v"(rv##S) : "v"(PROJ + (tok0 + 32 * (chn) + vc) * INW + C_HI + h * 128 + vseg * 8) : "memory"); } while (0)
#define HG_LOADG(S, chn) do { asm volatile("global_load_dwordx4 %0, %1, off" : "=v"(rg##S) : "v"(PROJ + (tok0 + 32 * (chn) + vc) * INW + C_HG + h * 128 + vseg * 8) : "memory"); } while (0)
#define HG_WAIT_RAW(S) asm volatile("s_waitcnt vmcnt(7)" : "+v"(rq##S), "+v"(rf##S), "+v"(rv##S) :: "memory")
#define HG_WAIT_G(S) asm volatile("s_waitcnt vmcnt(8)" : "+v"(rg##S) :: "memory")
        HG_LOAD(A, 0); HG_LOADG(A, 0); HG_LOAD(B, 1); HG_LOADG(B, 1);
        asm volatile("s_waitcnt vmcnt(0)" : "+v"(rvA), "+v"(rgA), "+v"(rvB), "+v"(rgB) :: "memory");
        __syncthreads();
        for (int ch2 = 0; ch2 < SEQ / 32; ch2 += 2) {
          { const int ch = ch2;
            LAS unsigned char* bufp = lds + (ch & 1) * HG_BUF;
            HG_WAIT_RAW(A);
            { float bb[8], fv[8];
              const unsigned fw[4] = {rfA.x, rfA.y, rfA.z, rfA.w}, qw[4] = {rqA.x, rqA.y, rqA.z, rqA.w};
#pragma unroll
              for (int i = 0; i < 8; ++i) { const float x = (i & 1) ? bfhi(fw[i >> 1]) : bflo(fw[i >> 1]); const float f = lbv[i] + (1.f - lbv[i]) * __builtin_amdgcn_rcpf(1.f + __expf(-x)); fv[i] = f; bb[i] = f; }
#pragma unroll
              for (int i = 0; i < 8; ++i) { float x = bb[i];
                  x *= __builtin_bit_cast(float, __builtin_amdgcn_update_dpp(0x3f800000, __builtin_bit_cast(int, x), 0x111, 0xf, 0xf, false));
                  x *= __builtin_bit_cast(float, __builtin_amdgcn_update_dpp(0x3f800000, __builtin_bit_cast(int, x), 0x112, 0xf, 0xf, false));
                  x *= __builtin_bit_cast(float, __builtin_amdgcn_update_dpp(0x3f800000, __builtin_bit_cast(int, x), 0x114, 0xf, 0xf, false));
                  x *= __builtin_bit_cast(float, __builtin_amdgcn_update_dpp(0x3f800000, __builtin_bit_cast(int, x), 0x118, 0xf, 0xf, false));
                  x *= __builtin_bit_cast(float, __builtin_amdgcn_update_dpp(0x3f800000, __builtin_bit_cast(int, x), 0x142, 0xa, 0xf, false));
                  bb[i] = x; }
              unsigned qd[8], ki[8], kd[8]; float cdv[8];
#pragma unroll
              for (int i = 0; i < 8; ++i) { const float elast = __shfl(bb[i], (lane & 32) + 31);
                  const float e = bb[i], ei = __builtin_amdgcn_rcpf(bb[i]), ed = elast * ei;
                  const float xq = (i & 1) ? bfhi(qw[i >> 1]) : bflo(qw[i >> 1]); const float q = xq * __builtin_amdgcn_rcpf(1.f + __expf(-xq)); const float k = 1.f - fv[i];
                  qd[i] = f2bf(q * e); ki[i] = f2bf(k * ei); kd[i] = f2bf(k * ed); cdv[i] = elast; }
              *(LAS v4u*)(bufp + HG_QD + pc * HG_P + pdk8 * 2) = (v4u){qd[0] | (qd[1] << 16), qd[2] | (qd[3] << 16), qd[4] | (qd[5] << 16), qd[6] | (qd[7] << 16)};
              *(LAS v4u*)(bufp + HG_KI + pc * HG_P + pdk8 * 2) = (v4u){ki[0] | (ki[1] << 16), ki[2] | (ki[3] << 16), ki[4] | (ki[5] << 16), ki[6] | (ki[7] << 16)};
              *(LAS v4u*)(bufp + HG_KDT + pc * HG_VP + pdk8 * 2) = (v4u){kd[0] | (kd[1] << 16), kd[2] | (kd[3] << 16), kd[4] | (kd[5] << 16), kd[6] | (kd[7] << 16)};
              if (pc == 31) { *(LAS f32x4*)(bufp + HG_CD + pdk8 * 4) = (f32x4){cdv[0], cdv[1], cdv[2], cdv[3]}; *(LAS f32x4*)(bufp + HG_CD + pdk8 * 4 + 16) = (f32x4){cdv[4], cdv[5], cdv[6], cdv[7]}; }
              *(LAS v4u*)(bufp + HG_V + vc * HG_VP + vseg * 16) = rvA; }
            HG_LOAD(A, (ch + 2 < SEQ / 32 ? ch + 2 : SEQ / 32 - 1));
            __syncthreads();
            f32x16 o;
#pragma unroll
            for (int r = 0; r < 16; ++r) o[r] = 0.f;
#pragma unroll
            for (int kk = 0; kk < 2; ++kk)
#pragma unroll
                for (int s2 = 0; s2 < 2; ++s2) {
                    LAS unsigned char* qa = bufp + HG_QD + r32 * HG_P + (32 * (2 * dkh + kk) + 16 * s2 + 4 * hh) * 2;
                    const v2u a0 = *(const LAS v2u*)qa, a1 = *(const LAS v2u*)(qa + 16);
                    const bf16x8 af = __builtin_bit_cast(bf16x8, (v4u){a0.x, a0.y, a1.x, a1.y});
                    o = __builtin_amdgcn_mfma_f32_32x32x16_bf16(af, pack8(kk == 0 ? S0 : S1, s2), o, 0, 0, 0);
                }
            if (wave < 4) {
                f32x16 X;
#pragma unroll
                for (int r = 0; r < 16; ++r) X[r] = 0.f;
#pragma unroll
                for (int s8 = 0; s8 < 8; ++s8) {
                    const bf16x8 af = *(const LAS bf16x8*)(bufp + HG_KI + r32 * HG_P + (16 * s8 + 8 * hh) * 2);
                    const bf16x8 bfr = *(const LAS bf16x8*)(bufp + HG_QD + r32 * HG_P + (16 * s8 + 8 * hh) * 2);
                    X = __builtin_amdgcn_mfma_f32_32x32x16_bf16(af, bfr, X, 0, 0, 0);
                }
#pragma unroll
                for (int r = 0; r < 16; ++r) { const int cp = (r & 3) + 8 * (r >> 2) + 4 * hh; X[r] = cp > r32 ? 0.f : X[r]; }
#pragma unroll
                for (int s2 = 0; s2 < 2; ++s2) {
                    LAS unsigned char* vp = bufp + HG_V + troff + (16 * s2 + 4 * hh) * HG_VP;
                    o = __builtin_amdgcn_mfma_f32_32x32x16_bf16(pack8(X, s2), tr_pair(vp, vp + 8 * HG_VP), o, 0, 0, 0);
                }
            }
            { LAS float* ob = (LAS float*)(lds + (wave < 4 ? HG_OA : HG_OB)) + 32 * dvt + r32;
#pragma unroll
              for (int r = 0; r < 16; ++r) ob[((r & 3) + 8 * (r >> 2) + 4 * hh) * 128] = o[r]; }
#pragma unroll
            for (int kk = 0; kk < 2; ++kk) {
                const int dk0 = 32 * (2 * dkh + kk);
                const LAS float* cdp = (const LAS float*)(bufp + HG_CD) + dk0 + 4 * hh;
#pragma unroll
                for (int r4 = 0; r4 < 4; ++r4) { const f32x4 c4 = *(const LAS f32x4*)(cdp + 8 * r4);
                    if (kk == 0) { S0[4 * r4] *= c4.x; S0[4 * r4 + 1] *= c4.y; S0[4 * r4 + 2] *= c4.z; S0[4 * r4 + 3] *= c4.w; }
                    else         { S1[4 * r4] *= c4.x; S1[4 * r4 + 1] *= c4.y; S1[4 * r4 + 2] *= c4.z; S1[4 * r4 + 3] *= c4.w; } }
#pragma unroll
                for (int s2 = 0; s2 < 2; ++s2) {
                    LAS unsigned char* kp = bufp + HG_KDT + kdoff + (16 * s2 + 8 * hh) * HG_VP + dk0 * 2;
                    const bf16x8 af = tr_pair(kp, kp + 4 * HG_VP);
                    LAS unsigned char* vp = bufp + HG_V + troff + (16 * s2 + 8 * hh) * HG_VP;
                    const bf16x8 bfr = tr_pair(vp, vp + 4 * HG_VP);
                    if (kk == 0) S0 = __builtin_amdgcn_mfma_f32_32x32x16_bf16(af, bfr, S0, 0, 0, 0);
                    else         S1 = __builtin_amdgcn_mfma_f32_32x32x16_bf16(af, bfr, S1, 0, 0, 0);
                }
            }
            __syncthreads();
            { const LAS float* oa = (const LAS float*)(lds + HG_OA) + vc * 128 + 8 * vseg; const LAS float* ob = (const LAS float*)(lds + HG_OB) + vc * 128 + 8 * vseg;
              const f32x4 x0 = *(const LAS f32x4*)oa + *(const LAS f32x4*)ob, x1 = *(const LAS f32x4*)(oa + 4) + *(const LAS f32x4*)(ob + 4);
              float ss = (x0.x * x0.x + x0.y * x0.y) + (x0.z * x0.z + x0.w * x0.w) + (x1.x * x1.x + x1.y * x1.y) + (x1.z * x1.z + x1.w * x1.w);
              ss += __shfl_xor(ss, 1); ss += __shfl_xor(ss, 2); ss += __shfl_xor(ss, 4); ss += __shfl_xor(ss, 8);
              const float rr = 1.f / sqrtf(ss * (1.f / 128.f) + EPS);
              const size_t tok = tok0 + 32 * ch + vc;
              HG_WAIT_G(A);
              const unsigned ga[4] = {rgA.x, rgA.y, rgA.z, rgA.w};
              const float ov[8] = {x0.x, x0.y, x0.z, x0.w, x1.x, x1.y, x1.z, x1.w}; const float gg[8] = {g0.x, g0.y, g0.z, g0.w, g1.x, g1.y, g1.z, g1.w};
              unsigned w[4];
#pragma unroll
              for (int j = 0; j < 4; ++j) { const float a0 = bflo(ga[j]), a1 = bfhi(ga[j]);
                  w[j] = pk2(ov[2 * j] * rr * gg[2 * j] * (a0 * __builtin_amdgcn_rcpf(1.f + __expf(-a0))), ov[2 * j + 1] * rr * gg[2 * j + 1] * (a1 * __builtin_amdgcn_rcpf(1.f + __expf(-a1)))); }
              *(GAS v4u*)(MIXED + tok * DM + 512 + h * 128 + 8 * vseg) = (v4u){w[0], w[1], w[2], w[3]}; }
            HG_LOADG(A, (ch + 2 < SEQ / 32 ? ch + 2 : SEQ / 32 - 1));
          }
          { const int ch = ch2 + 1;
            LAS unsigned char* bufp = lds + (ch & 1) * HG_BUF;
            HG_WAIT_RAW(B);
            { float bb[8], fv[8];
              const unsigned fw[4] = {rfB.x, rfB.y, rfB.z, rfB.w}, qw[4] = {rqB.x, rqB.y, rqB.z, rqB.w};
#pragma unroll
              for (int i = 0; i < 8; ++i) { const float x = (i & 1) ? bfhi(fw[i >> 1]) : bflo(fw[i >> 1]); const float f = lbv[i] + (1.f - lbv[i]) * __builtin_amdgcn_rcpf(1.f + __expf(-x)); fv[i] = f; bb[i] = f; }
#pragma unroll
              for (int i = 0; i < 8; ++i) { float x = bb[i];
                  x *= __builtin_bit_cast(float, __builtin_amdgcn_update_dpp(0x3f800000, __builtin_bit_cast(int, x), 0x111, 0xf, 0xf, false));
                  x *= __builtin_bit_cast(float, __builtin_amdgcn_update_dpp(0x3f800000, __builtin_bit_cast(int, x), 0x112, 0xf, 0xf, false));
                  x *= __builtin_bit_cast(float, __builtin_amdgcn_update_dpp(0x3f800000, __builtin_bit_cast(int, x), 0x114, 0xf, 0xf, false));
                  x *= __builtin_bit_cast(float, __builtin_amdgcn_update_dpp(0x3f800000, __builtin_bit_cast(int, x), 0x118, 0xf, 0xf, false));
                  x *= __builtin_bit_cast(float, __builtin_amdgcn_update_dpp(0x3f800000, __builtin_bit_cast(int, x), 0x142, 0xa, 0xf, false));
                  bb[i] = x; }
              unsigned qd[8], ki[8], kd[8]; float cdv[8];
#pragma unroll
              for (int i = 0; i < 8; ++i) { const float elast = __shfl(bb[i], (lane & 32) + 31);
                  const float e = bb[i], ei = __builtin_amdgcn_rcpf(bb[i]), ed = elast * ei;
                  const float xq = (i & 1) ? bfhi(qw[i >> 1]) : bflo(qw[i >> 1]); const float q = xq * __builtin_amdgcn_rcpf(1.f + __expf(-xq)); const float k = 1.f - fv[i];
                  qd[i] = f2bf(q * e); ki[i] = f2bf(k * ei); kd[i] = f2bf(k * ed); cdv[i] = elast; }
              *(LAS v4u*)(bufp + HG_QD + pc * HG_P + pdk8 * 2) = (v4u){qd[0] | (qd[1] << 16), qd[2] | (qd[3] << 16), qd[4] | (qd[5] << 16), qd[6] | (qd[7] << 16)};
              *(LAS v4u*)(bufp + HG_KI + pc * HG_P + pdk8 * 2) = (v4u){ki[0] | (ki[1] << 16), ki[2] | (ki[3] << 16), ki[4] | (ki[5] << 16), ki[6] | (ki[7] << 16)};
              *(LAS v4u*)(bufp + HG_KDT + pc * HG_VP + pdk8 * 2) = (v4u){kd[0] | (kd[1] << 16), kd[2] | (kd[3] << 16), kd[4] | (kd[5] << 16), kd[6] | (kd[7] << 16)};
              if (pc == 31) { *(LAS f32x4*)(bufp + HG_CD + pdk8 * 4) = (f32x4){cdv[0], cdv[1], cdv[2], cdv[3]}; *(LAS f32x4*)(bufp + HG_CD + pdk8 * 4 + 16) = (f32x4){cdv[4], cdv[5], cdv[6], cdv[7]}; }
              *(LAS v4u*)(bufp + HG_V + vc * HG_VP + vseg * 16) = rvB; }
            HG_LOAD(B, (ch + 2 < SEQ / 32 ? ch + 2 : SEQ / 32 - 1));
            __syncthreads();
            f32x16 o;
#pragma unroll
            for (int r = 0; r < 16; ++r) o[r] = 0.f;
#pragma unroll
            for (int kk = 0; kk < 2; ++kk)
#pragma unroll
                for (int s2 = 0; s2 < 2; ++s2) {
                    LAS unsigned char* qa = bufp + HG_QD + r32 * HG_P + (32 * (2 * dkh + kk) + 16 * s2 + 4 * hh) * 2;
                    const v2u a0 = *(const LAS v2u*)qa, a1 = *(const LAS v2u*)(qa + 16);
                    const bf16x8 af = __builtin_bit_cast(bf16x8, (v4u){a0.x, a0.y, a1.x, a1.y});
                    o = __builtin_amdgcn_mfma_f32_32x32x16_bf16(af, pack8(kk == 0 ? S0 : S1, s2), o, 0, 0, 0);
                }
            if (wave < 4) {
                f32x16 X;
#pragma unroll
                for (int r = 0; r < 16; ++r) X[r] = 0.f;
#pragma unroll
                for (int s8 = 0; s8 < 8; ++s8) {
                    const bf16x8 af = *(const LAS bf16x8*)(bufp + HG_KI + r32 * HG_P + (16 * s8 + 8 * hh) * 2);
                    const bf16x8 bfr = *(const LAS bf16x8*)(bufp + HG_QD + r32 * HG_P + (16 * s8 + 8 * hh) * 2);
                    X = __builtin_amdgcn_mfma_f32_32x32x16_bf16(af, bfr, X, 0, 0, 0);
                }
#pragma unroll
                for (int r = 0; r < 16; ++r) { const int cp = (r & 3) + 8 * (r >> 2) + 4 * hh; X[r] = cp > r32 ? 0.f : X[r]; }
#pragma unroll
                for (int s2 = 0; s2 < 2; ++s2) {
                    LAS unsigned char* vp = bufp + HG_V + troff + (16 * s2 + 4 * hh) * HG_VP;
                    o = __builtin_amdgcn_mfma_f32_32x32x16_bf16(pack8(X, s2), tr_pair(vp, vp + 8 * HG_VP), o, 0, 0, 0);
                }
            }
            { LAS float* ob = (LAS float*)(lds + (wave < 4 ? HG_OA : HG_OB)) + 32 * dvt + r32;
#pragma unroll
              for (int r = 0; r < 16; ++r) ob[((r & 3) + 8 * (r >> 2) + 4 * hh) * 128] = o[r]; }
#pragma unroll
            for (int kk = 0; kk < 2; ++kk) {
                const int dk0 = 32 * (2 * dkh + kk);
                const LAS float* cdp = (const LAS float*)(bufp + HG_CD) + dk0 + 4 * hh;
#pragma unroll
                for (int r4 = 0; r4 < 4; ++r4) { const f32x4 c4 = *(const LAS f32x4*)(cdp + 8 * r4);
                    if (kk == 0) { S0[4 * r4] *= c4.x; S0[4 * r4 + 1] *= c4.y; S0[4 * r4 + 2] *= c4.z; S0[4 * r4 + 3] *= c4.w; }
                    else         { S1[4 * r4] *= c4.x; S1[4 * r4 + 1] *= c4.y; S1[4 * r4 + 2] *= c4.z; S1[4 * r4 + 3] *= c4.w; } }
#pragma unroll
                for (int s2 = 0; s2 < 2; ++s2) {
                    LAS unsigned char* kp = bufp + HG_KDT + kdoff + (16 * s2 + 8 * hh) * HG_VP + dk0 * 2;
                    const bf16x8 af = tr_pair(kp, kp + 4 * HG_VP);
                    LAS unsigned char* vp = bufp + HG_V + troff + (16 * s2 + 8 * hh) * HG_VP;
                    const bf16x8 bfr = tr_pair(vp, vp + 4 * HG_VP);
                    if (kk == 0) S0 = __builtin_amdgcn_mfma_f32_32x32x16_bf16(af, bfr, S0, 0, 0, 0);
                    else         S1 = __builtin_amdgcn_mfma_f32_32x32x16_bf16(af, bfr, S1, 0, 0, 0);
                }
            }
            __syncthreads();
            { const LAS float* oa = (const LAS float*)(lds + HG_OA) + vc * 128 + 8 * vseg; const LAS float* ob = (const LAS float*)(lds + HG_OB) + vc * 128 + 8 * vseg;
              const f32x4 x0 = *(const LAS f32x4*)oa + *(const LAS f32x4*)ob, x1 = *(const LAS f32x4*)(oa + 4) + *(const LAS f32x4*)(ob + 4);
              float ss = (x0.x * x0.x + x0.y * x0.y) + (x0.z * x0.z + x0.w * x0.w) + (x1.x * x1.x + x1.y * x1.y) + (x1.z * x1.z + x1.w * x1.w);
              ss += __shfl_xor(ss, 1); ss += __shfl_xor(ss, 2); ss += __shfl_xor(ss, 4); ss += __shfl_xor(ss, 8);
              const float rr = 1.f / sqrtf(ss * (1.f / 128.f) + EPS);
              const size_t tok = tok0 + 32 * ch + vc;
              HG_WAIT_G(B);
              const unsigned ga[4] = {rgB.x, rgB.y, rgB.z, rgB.w};
              const float ov[8] = {x0.x, x0.y, x0.z, x0.w, x1.x, x1.y, x1.z, x1.w}; const float gg[8] = {g0.x, g0.y, g0.z, g0.w, g1.x, g1.y, g1.z, g1.w};
              unsigned w[4];
#pragma unroll
              for (int j = 0; j < 4; ++j) { const float a0 = bflo(ga[j]), a1 = bfhi(ga[j]);
                  w[j] = pk2(ov[2 * j] * rr * gg[2 * j] * (a0 * __builtin_amdgcn_rcpf(1.f + __expf(-a0))), ov[2 * j + 1] * rr * gg[2 * j + 1] * (a1 * __builtin_amdgcn_rcpf(1.f + __expf(-a1)))); }
              *(GAS v4u*)(MIXED + tok * DM + 512 + h * 128 + 8 * vseg) = (v4u){w[0], w[1], w[2], w[3]}; }
            HG_LOADG(B, (ch + 2 < SEQ / 32 ? ch + 2 : SEQ / 32 - 1));
          }
        }
#undef HG_LOAD
#undef HG_LOADG
#undef HG_WAIT_RAW
#undef HG_WAIT_G
    }
}

template <int N> __device__ __forceinline__ unsigned row_ror(unsigned x) { return (unsigned)__builtin_amdgcn_update_dpp((int)x, (int)x, 0x120 + N, 0xf, 0xf, false); }
__device__ __forceinline__ unsigned umax_(unsigned a, unsigned b) { return a > b ? a : b; }
__device__ __forceinline__ unsigned umin_(unsigned a, unsigned b) { return a < b ? a : b; }
__device__ __forceinline__ unsigned row_umax16(unsigned x) {
    unsigned y;
    asm volatile("s_nop 1\n\tv_max_u32_dpp %0, %1, %1 row_ror:1 row_mask:0xf bank_mask:0xf\n\t"
                 "s_nop 1\n\tv_max_u32_dpp %0, %0, %0 row_ror:2 row_mask:0xf bank_mask:0xf\n\t"
                 "s_nop 1\n\tv_max_u32_dpp %0, %0, %0 row_ror:4 row_mask:0xf bank_mask:0xf\n\t"
                 "s_nop 1\n\tv_max_u32_dpp %0, %0, %0 row_ror:8 row_mask:0xf bank_mask:0xf"
                 : "=&v"(y) : "v"(x));
    return y;
}
__device__ __forceinline__ float row_fsum16(float v) {
    v += __builtin_bit_cast(float, row_ror<1>(__builtin_bit_cast(unsigned, v))); v += __builtin_bit_cast(float, row_ror<2>(__builtin_bit_cast(unsigned, v)));
    v += __builtin_bit_cast(float, row_ror<4>(__builtin_bit_cast(unsigned, v))); v += __builtin_bit_cast(float, row_ror<8>(__builtin_bit_cast(unsigned, v))); return v; }
__device__ __forceinline__ unsigned h2key(unsigned x) { return (x & 0x80000000u) ? (~x & 0xffff0000u) : (x | 0x80000000u); }
__device__ __forceinline__ float hkey2f(unsigned k) { const unsigned hb = ((k & 0x80000000u) ? (k & 0x7fff0000u) : (~k & 0xffff0000u)) >> 16; return (float)__builtin_bit_cast(_Float16, (unsigned short)hb); }
__device__ __forceinline__ unsigned f2key(float f) { const unsigned u = __builtin_bit_cast(unsigned, f); return (u & 0x80000000u) ? ~u : (u | 0x80000000u); }
__device__ __forceinline__ float key2f(unsigned k) { const unsigned u = (k & 0x80000000u) ? (k & 0x7fffffffu) : ~k; return __builtin_bit_cast(float, u); }
__device__ __forceinline__ unsigned pair_code(int s) {
    if (s < 16) return (unsigned)s;
    if (s < 24) return 16u + (unsigned)(s - 16);
    if (s < 29) return 32u + (unsigned)(s - 24);
    if (s < 33) return 48u + (unsigned)(s - 29);
    if (s < 36) return 64u + (unsigned)(s - 33);
    if (s < 42) return 80u + 16u * (unsigned)((s - 36) >> 1) + (unsigned)((s - 36) & 1);
    if (s < 50) return 128u + 16u * (unsigned)(s - 42);
    return 0xFFu;
}
#define CAS_(a, b) do { const unsigned hi_ = umax_(a, b), lo_ = umin_(a, b); a = hi_; b = lo_; } while (0)
__device__ __forceinline__ void row_umax16_x2(unsigned xa, unsigned xb, unsigned& ya, unsigned& yb) {
    asm volatile("s_nop 1\n\tv_max_u32_dpp %0, %2, %2 row_ror:1 row_mask:0xf bank_mask:0xf\n\tv_max_u32_dpp %1, %3, %3 row_ror:1 row_mask:0xf bank_mask:0xf\n\t"
                 "s_nop 0\n\tv_max_u32_dpp %0, %0, %0 row_ror:2 row_mask:0xf bank_mask:0xf\n\tv_max_u32_dpp %1, %1, %1 row_ror:2 row_mask:0xf bank_mask:0xf\n\t"
                 "s_nop 0\n\tv_max_u32_dpp %0, %0, %0 row_ror:4 row_mask:0xf bank_mask:0xf\n\tv_max_u32_dpp %1, %1, %1 row_ror:4 row_mask:0xf bank_mask:0xf\n\t"
                 "s_nop 0\n\tv_max_u32_dpp %0, %0, %0 row_ror:8 row_mask:0xf bank_mask:0xf\n\tv_max_u32_dpp %1, %1, %1 row_ror:8 row_mask:0xf bank_mask:0xf"
                 : "=&v"(ya), "=&v"(yb) : "v"(xa), "v"(xb));
}
#define TK_LOADSORT(P, th_) \
    unsigned P##0, P##1, P##2, P##3, P##4, P##5, P##6, P##7; \
    { const v4u sv = *(const GAS v4u*)(SC + (size_t)((th_) >> 3) * 2048 + ((th_) & 7) * 256 + c * 128 + l15 * 8); const unsigned nb = 127u - 8u * (unsigned)l15; \
      P##0 = h2key(sv.x << 16) | nb; P##1 = h2key(sv.x & 0xffff0000u) | (nb - 1u); P##2 = h2key(sv.y << 16) | (nb - 2u); P##3 = h2key(sv.y & 0xffff0000u) | (nb - 3u); \
      P##4 = h2key(sv.z << 16) | (nb - 4u); P##5 = h2key(sv.z & 0xffff0000u) | (nb - 5u); P##6 = h2key(sv.w << 16) | (nb - 6u); P##7 = h2key(sv.w & 0xffff0000u) | (nb - 7u); \
      CAS_(P##0, P##1); CAS_(P##2, P##3); CAS_(P##4, P##5); CAS_(P##6, P##7); CAS_(P##0, P##2); CAS_(P##1, P##3); CAS_(P##4, P##6); CAS_(P##5, P##7); CAS_(P##1, P##2); CAS_(P##5, P##6); CAS_(P##0, P##4); CAS_(P##3, P##7); \
      CAS_(P##1, P##5); CAS_(P##2, P##6); CAS_(P##1, P##4); CAS_(P##3, P##6); CAS_(P##2, P##4); CAS_(P##3, P##5); CAS_(P##3, P##4); }
#define TK_POP(P, m_) do { const bool pop_ = (P##0 == (m_)); P##0 = pop_ ? P##1 : P##0; P##1 = pop_ ? P##2 : P##1; P##2 = pop_ ? P##3 : P##2; P##3 = pop_ ? P##4 : P##3; \
      P##4 = pop_ ? P##5 : P##4; P##5 = pop_ ? P##6 : P##5; P##6 = pop_ ? P##7 : P##6; P##7 = pop_ ? 0u : P##7; } while (0)
__device__ __forceinline__ void topk_stage1x2(const unsigned short* SC, int thA, int thB, int c, int l15, unsigned& resA, unsigned& resB) {
    TK_LOADSORT(ka, thA) TK_LOADSORT(kb, thB)
    unsigned ra = 0u, rb = 0u;
#pragma unroll
    for (int r = 0; r < 16; ++r) {
        unsigned ma, mb; row_umax16_x2(ka0, kb0, ma, mb);
        TK_POP(ka, ma); TK_POP(kb, mb);
        ra = (l15 == r) ? ma : ra; rb = (l15 == r) ? mb : rb;
    }
    resA = ra; resB = rb;
}
__device__ __forceinline__ void topk_v2(Frame& F) {
    const unsigned short* SC = (const unsigned short*)(F.ws + WS_SC); int* IDX = (int*)(F.ws + WS_IDX); float* GATE = (float*)(F.ws + WS_GATE); float* GSU = (float*)(F.ws + WS_GSU);
    const float* SU = (const float*)(F.ws + WS_SU); const float* SV = (const float*)(F.ws + WS_SV);
    const int gw = F.vcu * NWAVES + F.wave, NGW = F.G * NWAVES, lane = F.lane, l15 = lane & 15, row = lane >> 4, c = row & 1, rbase = lane & 48;
    const unsigned pc0 = pair_code(l15), pc1 = pair_code(l15 + 16), pc2 = pair_code(l15 + 32), pc3 = pair_code(l15 + 48);
    const int src1 = l15 + 32 * (row & 1), src2 = src1 + 16;
    for (int it0 = gw * 32; it0 < NTOK * 2; it0 += NGW * 32)
    for (int it = it0; it < it0 + 32; ++it) {
        const int thb = 4 * it;
        unsigned resA, resB; topk_stage1x2(SC, thb + (row >> 1), thb + 2 + (row >> 1), c, l15, resA, resB);
        const unsigned a1 = (unsigned)__shfl((int)resA, src1), a2 = (unsigned)__shfl((int)resA, src2), b1 = (unsigned)__shfl((int)resB, src1), b2 = (unsigned)__shfl((int)resB, src2);
        const unsigned S1 = row < 2 ? a1 : b1, S2 = row < 2 ? a2 : b2;
        unsigned c0, c1, c2, c3;
#define TK_CAND(CK, PC) do { const unsigned ka_ = (unsigned)__shfl((int)S1, rbase + (int)((PC) >> 4 & 15u)), kb_ = (unsigned)__shfl((int)S2, rbase + (int)((PC) & 15u)); \
            const float sm_ = hkey2f(ka_) + hkey2f(kb_); CK = (PC) == 0xFFu ? 0u : ((f2key(sm_) & ~0xFFu) | (255u - (PC))); } while (0)
        TK_CAND(c0, pc0); TK_CAND(c1, pc1); TK_CAND(c2, pc2); TK_CAND(c3, pc3);
#undef TK_CAND
        CAS_(c0, c1); CAS_(c2, c3); CAS_(c0, c2); CAS_(c1, c3); CAS_(c1, c2);
        unsigned res2 = 0u;
#pragma unroll
        for (int r = 0; r < 16; ++r) {
            const unsigned m = row_umax16(c0); const bool pop = (c0 == m);
            c0 = pop ? c1 : c0; c1 = pop ? c2 : c1; c2 = pop ? c3 : c2; c3 = pop ? 0u : c3;
            res2 = (l15 == r) ? m : res2;
        }
        const unsigned code = 255u - (res2 & 0xFFu);
        const unsigned ka = (unsigned)__shfl((int)S1, rbase + (int)(code >> 4 & 15u)), kb = (unsigned)__shfl((int)S2, rbase + (int)(code & 15u));
        const float ts = hkey2f(ka) + hkey2f(kb);
        const int e = (int)((127u - (ka & 0x7Fu)) * 128u + (127u - (kb & 0x7Fu)));
        const float tmax = __builtin_bit_cast(float, (unsigned)__shfl((int)__builtin_bit_cast(unsigned, ts), rbase));
        const float ex = __expf(ts - tmax);
        const float sum = row_fsum16(ex);
        const int th = thb + row;
        const size_t o = (size_t)(th >> 3) * NEXP_SEL + (th & 7) * 16 + l15;
        IDX[o] = e; GATE[o] = ex / sum * SV[e]; GSU[o] = SU[e];
    }
}

constexpr int PG_TOK = 16;
constexpr int PG_IDX = 0, PG_HID = 4096, PG_SA = PG_HID + 8192, PG_TB = PG_SA + 64, PG_WB = PG_TB + 4096;
static_assert(PG_WB % 16 == 0 && PG_TB % 16 == 0 && NWAVES * PG_WB <= RING_BYTES, "gather LDS map");
__device__ __forceinline__ void peer_sliced(Frame& F) {
    const unsigned char* U8T = F.ws + WS_U8; const unsigned char* V8T = F.ws + WS_V8; const unsigned char* X8 = F.ws + WS_X8;
    const float* SSQ = (const float*)(F.ws + WS_CTL) + CW_SSQ;
    const int* IDX = (const int*)(F.ws + WS_IDX); const float* GATE = (const float*)(F.ws + WS_GATE); const float* GSU = (const float*)(F.ws + WS_GSU); const float* gf = F.in[17];
    bf16* PO = (bf16*)(F.ws + WS_PO); const bf16* HB = (const bf16*)(F.ws + WS_HN2);
    const int gw = F.vcu * NWAVES + F.wave, NGW = F.G * NWAVES, lane = F.lane, m = lane & 15, g = lane >> 4;
    const int row8 = lane >> 3, piece = lane & 7;
    LAS unsigned char* wb = F.lds + F.wave * PG_WB;
    LAS unsigned short* idxs = (LAS unsigned short*)(wb + PG_IDX);
    LAS float* hid = (LAS float*)(wb + PG_HID);
    LAS float* sqp = hid + 64 + lane;
    LAS float* sai = (LAS float*)(wb + PG_SA);
    LAS unsigned char* tb = wb + PG_TB;
    const int p8 = m & 7; const unsigned bsh = 8u * (unsigned)(p8 & 3); const bool bhi = (p8 >> 2) != 0;
    constexpr size_t SLICE = (size_t)16384 * 128;
    const int usw = 16 * (piece ^ ((row8 >> 1) & 3));
    const int urd0 = m * 128 + 16 * ((2 * g) ^ ((m >> 1) & 7)), urd1 = m * 128 + 16 * ((2 * g + 1) ^ ((m >> 1) & 7));
    for (int blk = gw; blk < NTOK / PG_TOK; blk += NGW) {
        const int t0 = blk * PG_TOK;
#pragma unroll
        for (int k = 0; k < 32; ++k) { const int id = lane + 64 * k; idxs[id] = (unsigned short)IDX[(size_t)t0 * NEXP_SEL + id]; }
        LDS_WAIT(); asm volatile("" ::: "memory");
        for (int p = 0; p < 8; ++p) {
            const unsigned char* Up = U8T + (size_t)p * SLICE;
            const unsigned char* Xp = X8 + (size_t)t0 * DM + 128 * p + 32 * g;
            v4u ab[2][16]; l2 xs[2][2];
#define PGU_ISSUE(i_, buf_) do { _Pragma("unroll") for (int k = 0; k < 16; ++k) { const unsigned e = idxs[(i_) * 128 + 8 * k + row8]; \
                ab[buf_][k] = *(const GAS v4u*)(Up + (size_t)e * 128 + (usw ^ ((k & 1) ? 64 : 0))); } \
                xs[buf_][0] = *(const GAS l2*)(Xp + (size_t)(i_) * DM); xs[buf_][1] = *(const GAS l2*)(Xp + (size_t)(i_) * DM + 16); } while (0)
#define PGU_BODY(i_, cur_, nxt_) do { if ((i_) + 1 < PG_TOK) PGU_ISSUE((i_) + 1, nxt_); SCHED_FENCE(); \
                _Pragma("unroll") for (int rb = 0; rb < 4; ++rb) { LAS f32x4* hp0 = (LAS f32x4*)(hid + (i_) * 128 + 32 * rb + 4 * g); LAS f32x4* hp1 = hp0 + 4; \
                    _Pragma("unroll") for (int q4 = 0; q4 < 4; ++q4) *(LAS v4u*)(tb + 1024 * q4 + 16 * lane) = ab[cur_][4 * rb + q4]; \
                    f32x4 acc0 = p == 0 ? (f32x4){0.f, 0.f, 0.f, 0.f} : *hp0, acc1 = p == 0 ? (f32x4){0.f, 0.f, 0.f, 0.f} : *hp1; \
                    const l2 a0 = *(const LAS l2*)(tb + urd0), a1 = *(const LAS l2*)(tb + urd1), b0 = *(const LAS l2*)(tb + 2048 + urd0), b1 = *(const LAS l2*)(tb + 2048 + urd1); \
                    acc0 = __builtin_amdgcn_mfma_f32_16x16x32_fp8_bf8(a0.x, xs[cur_][0].x, acc0, 0, 0, 0); acc1 = __builtin_amdgcn_mfma_f32_16x16x32_fp8_bf8(b0.x, xs[cur_][0].x, acc1, 0, 0, 0); \
                    acc0 = __builtin_amdgcn_mfma_f32_16x16x32_fp8_bf8(a0.y, xs[cur_][0].y, acc0, 0, 0, 0); acc1 = __builtin_amdgcn_mfma_f32_16x16x32_fp8_bf8(b0.y, xs[cur_][0].y, acc1, 0, 0, 0); \
                    acc0 = __builtin_amdgcn_mfma_f32_16x16x32_fp8_bf8(a1.x, xs[cur_][1].x, acc0, 0, 0, 0); acc1 = __builtin_amdgcn_mfma_f32_16x16x32_fp8_bf8(b1.x, xs[cur_][1].x, acc1, 0, 0, 0); \
                    acc0 = __builtin_amdgcn_mfma_f32_16x16x32_fp8_bf8(a1.y, xs[cur_][1].y, acc0, 0, 0, 0); acc1 = __builtin_amdgcn_mfma_f32_16x16x32_fp8_bf8(b1.y, xs[cur_][1].y, acc1, 0, 0, 0); \
                    if (m == 0) { *hp0 = acc0; *hp1 = acc1; } } SCHED_FENCE(); } while (0)
            PGU_ISSUE(0, 0);
            for (int i2 = 0; i2 < PG_TOK; i2 += 2) { PGU_BODY(i2, 0, 1); PGU_BODY(i2 + 1, 1, 0); }
#undef PGU_ISSUE
#undef PGU_BODY
            LDS_WAIT(); asm volatile("" ::: "memory");
        }
        for (int i = 0; i < PG_TOK; ++i) {
            const int t = t0 + i; const float sx = 1.f / sqrtf(SSQ[t] * (1.f / DM) + EPS);
            float w[8][4]; float amax = 0.f;
#pragma unroll
            for (int r = 0; r < 8; ++r) { const f32x4 h4 = *(const LAS f32x4*)(hid + i * 128 + 16 * r + 4 * g);
                const f32x4 su4 = *(const GAS f32x4*)(GSU + (size_t)t * NEXP_SEL + 16 * r + 4 * g), gv4 = *(const GAS f32x4*)(GATE + (size_t)t * NEXP_SEL + 16 * r + 4 * g);
#pragma unroll
                for (int j = 0; j < 4; ++j) { w[r][j] = gelu_as(h4[j] * su4[j] * sx) * gv4[j]; amax = fmaxf(amax, fabsf(w[r][j])); } }
            amax = fmaxf(amax, __shfl_xor(amax, 16)); amax = fmaxf(amax, __shfl_xor(amax, 32));
            const float sa = amax > 0.f ? 224.f / amax : 1.f;
            LDS_WAIT(); asm volatile("" ::: "memory");
            if (m == 0) {
                LAS unsigned char* wrow = (LAS unsigned char*)(hid + i * 128);
#pragma unroll
                for (int r = 0; r < 8; ++r) { int pk = __builtin_amdgcn_cvt_pk_fp8_f32(w[r][0] * sa, w[r][1] * sa, 0, false); pk = __builtin_amdgcn_cvt_pk_fp8_f32(w[r][2] * sa, w[r][3] * sa, pk, true);
                    wrow[4 * r + g] = (unsigned char)pk; wrow[32 + 4 * r + g] = (unsigned char)(pk >> 8); wrow[64 + 4 * r + g] = (unsigned char)(pk >> 16); wrow[96 + 4 * r + g] = (unsigned char)(pk >> 24); }
            }
            if (lane == 0) sai[i] = amax > 0.f ? amax * (1.f / 224.f) : 1.f;
        }
        LDS_WAIT(); asm volatile("" ::: "memory");
        for (int p = 0; p < 8; ++p) {
            const unsigned char* Vp = V8T + (size_t)p * SLICE + 16 * piece;
            v4u va[2][16];
#define PGV_ISSUE(i_, buf_) do { _Pragma("unroll") for (int k = 0; k < 16; ++k) { const unsigned e = idxs[(i_) * 128 + 8 * k + row8]; va[buf_][k] = *(const GAS v4u*)(Vp + (size_t)e * 128); } } while (0)
#define PGV_BODY(i_, cur_, nxt_) do { if ((i_) + 1 < PG_TOK) PGV_ISSUE((i_) + 1, nxt_); \
                const LAS v4u* wp = (const LAS v4u*)((LAS unsigned char*)(hid + (i_) * 128) + 32 * g); const v4u w0 = wp[0], w1 = wp[1]; \
                const unsigned ww[8] = {w0.x, w0.y, w0.z, w0.w, w1.x, w1.y, w1.z, w1.w}; \
                SCHED_FENCE(); f32x4 c = (f32x4){0.f, 0.f, 0.f, 0.f}; \
                _Pragma("unroll") for (int kb = 0; kb < 4; ++kb) { \
                    _Pragma("unroll") for (int q4 = 0; q4 < 4; ++q4) *(LAS v4u*)(tb + 1024 * q4 + 16 * lane) = va[cur_][4 * kb + q4]; \
                    long rr_[8]; \
                    _Pragma("unroll") for (int q4 = 0; q4 < 4; ++q4) { rr_[2 * q4] = *(const LAS long*)(tb + 1024 * q4 + g * 128 + 8 * m); rr_[2 * q4 + 1] = *(const LAS long*)(tb + 1024 * q4 + (4 + g) * 128 + 8 * m); } \
                    _Pragma("unroll") for (int q8 = 0; q8 < 8; ++q8) { const int q = 8 * kb + q8; const unsigned a8 = ((ww[q >> 2] >> (8 * (q & 3))) & 0xffu) << bsh; const long bop = (long)(bhi ? ((unsigned long long)a8 << 32) : (unsigned long long)a8); \
                      c = __builtin_amdgcn_mfma_f32_16x16x32_fp8_fp8(rr_[q8], bop, c, 0, 0, 0); } } \
                SCHED_FENCE(); \
                { const float isa = sai[i_]; LAS unsigned short* ob = (LAS unsigned short*)(tb) + 32 * g + (m & 7);         \
                  if (m < 8) { ob[0] = (unsigned short)f2bf(c[0] * isa); ob[8] = (unsigned short)f2bf(c[1] * isa); ob[16] = (unsigned short)f2bf(c[2] * isa); ob[24] = (unsigned short)f2bf(c[3] * isa); } \
                  const v4u ov = *(const LAS v4u*)(tb + 16 * (lane & 15)); \
                  if (lane < 16) *(GAS v4u*)(PO + (size_t)(t0 + (i_)) * DM + 128 * p + 8 * lane) = ov; } } while (0)
            PGV_ISSUE(0, 0);
            for (int i2 = 0; i2 < PG_TOK; i2 += 2) { PGV_BODY(i2, 0, 1); PGV_BODY(i2 + 1, 1, 0); }
#undef PGV_ISSUE
#undef PGV_BODY
        }
        LDS_WAIT(); asm volatile("" ::: "memory");
        VM_WAIT();
        for (int i = 0; i < PG_TOK; i += 2) {
            GAS f32x4* hrA = (GAS f32x4*)(F.out + (size_t)(t0 + i) * DM) + lane; GAS f32x4* hrB = hrA + DM / 4;
            const GAS v2u* prA = (const GAS v2u*)(PO + (size_t)(t0 + i) * DM) + lane; const GAS v2u* prB = prA + DM / 4;
            const GAS v2u* hbA = (const GAS v2u*)(HB + (size_t)(t0 + i) * DM) + lane; const GAS v2u* hbB = hbA + DM / 4;
            v2u pa[4], pb[4], ha[4], hb2[4];
#pragma unroll
            for (int j = 0; j < 4; ++j) { pa[j] = prA[64 * j]; ha[j] = hbA[64 * j]; pb[j] = prB[64 * j]; hb2[j] = hbB[64 * j]; }
            f32x4 ya[4], yb[4]; float sa = 0.f, sb = 0.f;
#pragma unroll
            for (int j = 0; j < 4; ++j) {
                ya[j] = (f32x4){bflo(ha[j].x), bfhi(ha[j].x), bflo(ha[j].y), bfhi(ha[j].y)} + (f32x4){bflo(pa[j].x), bfhi(pa[j].x), bflo(pa[j].y), bfhi(pa[j].y)};
                yb[j] = (f32x4){bflo(hb2[j].x), bfhi(hb2[j].x), bflo(hb2[j].y), bfhi(hb2[j].y)} + (f32x4){bflo(pb[j].x), bfhi(pb[j].x), bflo(pb[j].y), bfhi(pb[j].y)};
                sa += (ya[j].x * ya[j].x + ya[j].y * ya[j].y) + (ya[j].z * ya[j].z + ya[j].w * ya[j].w); sb += (yb[j].x * yb[j].x + yb[j].y * yb[j].y) + (yb[j].z * yb[j].z + yb[j].w * yb[j].w); }
#pragma unroll
            for (int o = 1; o < 64; o <<= 1) { sa += __shfl_xor(sa, o); sb += __shfl_xor(sb, o); }
            const float ra = 1.f / sqrtf(sa * (1.f / DM) + EPS), rb = 1.f / sqrtf(sb * (1.f / DM) + EPS);
#pragma unroll
            for (int j = 0; j < 4; ++j) { const f32x4 gg = *((const GAS f32x4*)gf + lane + 64 * j); hrA[64 * j] = ya[j] * ra * gg; hrB[64 * j] = yb[j] * rb * gg; }
        }
        LDS_WAIT(); asm volatile("" ::: "memory");
    }
}

struct Args { const float* in[18]; float* out; unsigned char* ws; int ph_lo, ph_hi; };
__global__ void __launch_bounds__(NWAVES * 64, 2) hymba_fwd(Args args) {
    extern __shared__ __attribute__((aligned(16))) unsigned char lds[];
    Frame F;
    F.lds = (LAS unsigned char*)lds;
    F.MISC = (volatile LAS unsigned*)(F.lds + MISC_OFF);
    F.tid = threadIdx.x; F.lane = F.tid & 63; F.wave = __builtin_amdgcn_readfirstlane(F.tid >> 6);
    F.G = gridDim.x; { const int bx = blockIdx.x; F.vcu = (F.G % 8 == 0) ? (bx % 8) * (F.G / 8) + bx / 8 : bx; }
#pragma unroll
    for (int i = 0; i < 18; ++i) F.in[i] = args.in[i];
    F.out = args.out; F.ws = args.ws;
    for (int u = F.tid; u < (LDS_BYTES - LDSCTL_OFF) / 4; u += NWAVES * 64) ((LAS unsigned*)(F.lds + LDSCTL_OFF))[u] = 0u;
    __syncthreads();
    const int lo = args.ph_lo, hi = args.ph_hi;
    const bool multi = (hi - lo) > 1;
    XcdBarrier bar; bar.bar = (unsigned*)(F.ws + WS_CTL) + CW_BAR; bar.x = 0; bar.st = nullptr;
    if (multi) bar = xcd_barrier_post((unsigned*)(F.ws + WS_CTL) + CW_BAR, F.MISC + 8);
#define IN(k) (lo <= (k) && (k) < hi)
#define SEAM(k) do { if (IN(k) && IN((k) + 1)) xcd_barrier(bar); } while (0)

    if (IN(0)) { p0_prologue(F); } SEAM(0);
    if (IN(1)) {
        pg8::Gemm g{(const pg8::bf16_t*)(F.ws + WS_HN), (const pg8::bf16_t*)(F.ws + WS_WIN), NTOK, INW, DM}; pg8::StaticOrder S; S.init(NTOK, INW, F.G, (int)blockIdx.x);
        pg8::EpiProj E{(pg8::bf16_t*)(F.ws + WS_PROJ), INW, 2, QSCALE};
        pg8::gemm_phase<pg8::EpiProj, pg8::StaticOrder, PG8_ALIGN, PG8_SP2>(F.lds + RING_OFF, g, S, E);
    } SEAM(1);
    if (IN(2)) { hgrn_mfma(F); }
    if (IN(3)) { quant_drain(F); attn_mfma(F, 0); }
    if (IN(3) && IN(4)) xcd_barrier(bar);
    if (IN(4)) {
        pg8::Gemm g{(const pg8::bf16_t*)(F.ws + WS_HN), (const pg8::bf16_t*)(F.ws + WS_WOUT), NTOK, DM, DM}; pg8::StaticOrder S; S.init(NTOK, DM, F.G, (int)blockIdx.x);
        pg8::EpiMix E{DM, F.in[0], F.in[12], (pg8::bf16_t*)(F.ws + WS_HN2), F.ws + WS_X8, (float*)(F.ws + WS_CTL) + CW_SSQ};
        pg8::gemm_phase<pg8::EpiMix, pg8::StaticOrder, PG8_ALIGN, PG8_SP2>(F.lds + RING_OFF, g, S, E);
    }
    if (IN(4) && IN(6)) xcd_barrier(bar);
    if (IN(6)) {
        pg8::Gemm g{(const pg8::bf16_t*)(F.ws + WS_HN2), (const pg8::bf16_t*)(F.ws + WS_W2), NTOK, 2048, DM}; pg8::StaticOrder S; S.init(NTOK, 2048, F.G, (int)blockIdx.x);
        pg8::EpiScaleRow E{(_Float16*)(F.ws + WS_SC), 2048, (const float*)(F.ws + WS_CTL) + CW_SSQ, 1.f / DM, EPS};
        pg8::gemm_phase<pg8::EpiScaleRow, pg8::StaticOrder, PG8_ALIGN, PG8_SP2>(F.lds + RING_OFF, g, S, E);
    } SEAM(6);
    if (IN(7)) { topk_v2(F); }
    if (IN(7) && IN(8)) { VM_WAIT(); }
    if (IN(8)) { peer_sliced(F); }
#undef IN
#undef SEAM
}

extern "C" void kernel_launch(void* const* d_in, const int* in_sizes, int n_in, void* d_out, int out_size, void* d_ws, size_t ws_size, hipStream_t stream) {
    static int grid = 0;
    if (grid == 0) {
        if (n_in != 18 || in_sizes[0] != NTOK * DM || out_size != NTOK * DM || ws_size < WS_END) { fprintf(stderr, "kernel_launch: unexpected shapes (n_in %d, in0 %d, out %d, ws %zu); nothing launched\n", n_in, n_in > 0 ? in_sizes[0] : -1, out_size, ws_size); grid = -1; return; }
        int dev = 0, cus = 0, per_cu = 0;
        if (hipGetDevice(&dev) != hipSuccess || hipDeviceGetAttribute(&cus, hipDeviceAttributeMultiprocessorCount, dev) != hipSuccess) { grid = -1; return; }
        if (hipFuncSetAttribute((const void*)hymba_fwd, hipFuncAttributeMaxDynamicSharedMemorySize, LDS_BYTES) != hipSuccess) { fprintf(stderr, "kernel_launch: hipFuncSetAttribute failed\n"); grid = -1; return; }
        if (hipOccupancyMaxActiveBlocksPerMultiprocessor(&per_cu, (const void*)hymba_fwd, NWAVES * 64, LDS_BYTES) != hipSuccess || per_cu < 1)
            fprintf(stderr, "kernel_launch: note: occupancy query reports %d workgroups per CU\n", per_cu);
        (void)hipGetLastError();
        grid = cus;
    }
    if (grid < 0) return;
    if (hipMemsetAsync((char*)d_ws + WS_CTL, 0, CTL_ZERO_BYTES, stream) != hipSuccess) return;
    Args a{};
    for (int i = 0; i < 18; ++i) a.in[i] = (const float*)d_in[i];
    a.out = (float*)d_out; a.ws = (unsigned char*)d_ws; a.ph_lo = 0; a.ph_hi = 9;
    hipLaunchKernelGGL(hymba_fwd, dim3(grid), dim3(NWAVES * 64), LDS_BYTES, stream, a);
}
```

```cpp
#include <hip/hip_runtime.h>
#include <cstdio>
#include <cstdint>
#include <cmath>
namespace pg8 {
#define PG8_LAS __attribute__((address_space(3)))
typedef unsigned short bf16_t;
typedef short bf16x8 __attribute__((ext_vector_type(8)));
typedef float f32x4 __attribute__((ext_vector_type(4)));
typedef unsigned u32x4 __attribute__((ext_vector_type(4)));
constexpr int BM = 256, BK = 64, HALF = 128, HTB = HALF * BK * 2  , STAGE_BYTES = 8 * HTB, NXCD = 8, WGM = 8;

__host__ __device__ __forceinline__ int lds_byte(int r, int c) { const int st = (r >> 4) * 2 + (c >> 5), rr = r & 15, cc = c & 31, ob = rr * 64 + cc * 2; return st * 1024 + (ob ^ (((ob >> 9) & 1) << 5)); }
__host__ __device__ __forceinline__ void stage_rc(int b, int& R, int& C) { const int st = b / 1024, sb = b % 1024, swz = sb ^ (((sb >> 9) & 1) << 5); R = (st >> 1) * 16 + swz / 64; C = (st & 1) * 32 + (swz % 64) / 2; }
__host__ __device__ __forceinline__ int perm32(int rho) { const int n = rho >> 4, i = rho & 15; return 8 * (i >> 2) + 4 * n + (i & 3); }

struct Unit { int pm, pn; };
struct Gemm { const bf16_t* A; const bf16_t* Bt; int M, N, K; };

struct StaticOrder {
    int nM, nN, nwg, G, c;
    __host__ __device__ void init(int M, int N, int G_, int c_) { nM = M / BM; nN = N / BM; nwg = nM * nN; G = G_; c = c_; }
    __host__ __device__ bool next(int i, Unit& u) const {
        const long L = (long)i * G + c; if (L >= nwg) return false;
        int wgid = (int)L; { const int q = nwg / NXCD, r = nwg % NXCD, xcd = wgid % NXCD, off = wgid / NXCD; wgid = (xcd < r ? xcd * (q + 1) : r * (q + 1) + (xcd - r) * q) + off; }
        const int nig = WGM * nN, gid = wgid / nig, fm = gid * WGM, gsz = (nM - fm) < WGM ? (nM - fm) : WGM;
        u.pm = fm + ((wgid % nig) % gsz); u.pn = (wgid % nig) / gsz; return true;
    }
    __device__ __forceinline__ void a_ready(const Unit&) const {}
    __device__ __forceinline__ void done(const Unit&) const {}
};
__device__ __forceinline__ unsigned cvt_pk_bf16(float lo, float hi) { unsigned r; asm volatile("v_cvt_pk_bf16_f32 %0, %1, %2" : "=v"(r) : "v"(lo), "v"(hi)); return r; }
typedef float f32x2 __attribute__((ext_vector_type(2)));
__device__ __forceinline__ f32x2 gelu_pk(f32x2 v) {
    const f32x2 av = __builtin_elementwise_abs(v), d = av * 0.2316418882f + 1.0f;
    f32x2 t; t.x = __builtin_amdgcn_rcpf(d.x); t.y = __builtin_amdgcn_rcpf(d.y);
    f32x2 q = t * 0.5307027145f + (-0.7265760135f); q = q * t + 0.7107068705f; q = q * t + (-0.142248368f); q = q * t + 0.127414796f; q = q * t;
    const f32x2 s = (v * v) * (-0.72134752044f);
    f32x2 e; e.x = __builtin_amdgcn_exp2f(s.x); e.y = __builtin_amdgcn_exp2f(s.y);
    const f32x2 m = v * (q * e), r = v - m;
    f32x2 o; o.x = v.x < 0.f ? m.x : r.x; o.y = v.y < 0.f ? m.y : r.y; return o;
}
struct EpiProj {
    static constexpr bool PERM = true, AFTER_DRAIN = false;
    bf16_t* O; int ldc; int qtiles; float qscale;
    __device__ __forceinline__ void operator()(const f32x4 (&acc)[2][2][4][2], const Unit& u, int wr, int wc, int fr, int fq) const {
        const int row0 = u.pm * BM + wr * 64 + fr, col0 = u.pn * BM + wc * 32 + 8 * fq;
        const float sc = (u.pn < qtiles) ? qscale : 1.f;
#pragma unroll
        for (int ai = 0; ai < 2; ++ai)
#pragma unroll
            for (int m = 0; m < 4; ++m) { bf16_t* rowp = O + (size_t)(row0 + ai * HALF + m * 16) * ldc + col0;
#pragma unroll
                for (int bj = 0; bj < 2; ++bj) { const f32x4 v0 = acc[ai][bj][m][0] * sc, v1 = acc[ai][bj][m][1] * sc;
                    u32x4 w; w.x = cvt_pk_bf16(v0[0], v0[1]); w.y = cvt_pk_bf16(v0[2], v0[3]); w.z = cvt_pk_bf16(v1[0], v1[1]); w.w = cvt_pk_bf16(v1[2], v1[3]);
                    *(u32x4*)(rowp + bj * HALF) = w; } }
    }
};
struct EpiF32Res {
    static constexpr bool PERM = false, AFTER_DRAIN = false;
    float* C; int ldc; const float* res;
    __device__ __forceinline__ void operator()(const f32x4 (&acc)[2][2][4][2], const Unit& u, int wr, int wc, int fr, int fq) const {
        const int row0 = u.pm * BM + wr * 64 + fr, col0 = u.pn * BM + wc * 32 + 4 * fq;
#pragma unroll
        for (int ai = 0; ai < 2; ++ai)
#pragma unroll
            for (int m = 0; m < 4; ++m) { const size_t off = (size_t)(row0 + ai * HALF + m * 16) * ldc + col0;
#pragma unroll
                for (int bj = 0; bj < 2; ++bj)
#pragma unroll
                    for (int n = 0; n < 2; ++n) { f32x4 o = acc[ai][bj][m][n]; if (res) o = o + *(const f32x4*)(res + off + bj * HALF + n * 16);
                        *(f32x4*)(C + off + bj * HALF + n * 16) = o; } }
    }
};

struct EpiMix {
    static constexpr bool PERM = true, AFTER_DRAIN = false;
    int ldc; const float* res; const float* g2; bf16_t* HB; unsigned char* XB; float* ssq;
    __device__ __forceinline__ void operator()(const f32x4 (&acc)[2][2][4][2], const Unit& u, int wr, int wc, int fr, int fq) const {
        const int row0 = u.pm * BM + wr * 64 + fr, col0 = u.pn * BM + wc * 32 + 8 * fq;
        f32x4 gv[2][2];
#pragma unroll
        for (int bj = 0; bj < 2; ++bj)
#pragma unroll
            for (int n = 0; n < 2; ++n) gv[bj][n] = *(const f32x4*)(g2 + col0 + bj * HALF + 4 * n);
#pragma unroll
        for (int ai = 0; ai < 2; ++ai)
#pragma unroll
            for (int m = 0; m < 4; ++m) { const int row = row0 + ai * HALF + m * 16; const size_t off = (size_t)row * ldc + col0; float sq = 0.f;
#pragma unroll
                for (int bj = 0; bj < 2; ++bj) {
                    const f32x4 h0 = acc[ai][bj][m][0] + *(const f32x4*)(res + off + bj * HALF), h1 = acc[ai][bj][m][1] + *(const f32x4*)(res + off + bj * HALF + 4);
                    sq += (h0[0] * h0[0] + h0[1] * h0[1]) + (h0[2] * h0[2] + h0[3] * h0[3]) + (h1[0] * h1[0] + h1[1] * h1[1]) + (h1[2] * h1[2] + h1[3] * h1[3]);
                    u32x4 w; w.x = cvt_pk_bf16(h0[0], h0[1]); w.y = cvt_pk_bf16(h0[2], h0[3]); w.z = cvt_pk_bf16(h1[0], h1[1]); w.w = cvt_pk_bf16(h1[2], h1[3]);
                    *(u32x4*)(HB + off + bj * HALF) = w;
                    const f32x4 g0 = h0 * gv[bj][0], g1 = h1 * gv[bj][1];
                    int p0 = __builtin_amdgcn_cvt_pk_bf8_f32(g0[0], g0[1], 0, false); p0 = __builtin_amdgcn_cvt_pk_bf8_f32(g0[2], g0[3], p0, true);
                    int p1 = __builtin_amdgcn_cvt_pk_bf8_f32(g1[0], g1[1], 0, false); p1 = __builtin_amdgcn_cvt_pk_bf8_f32(g1[2], g1[3], p1, true);
                    typedef unsigned u32x2 __attribute__((ext_vector_type(2)));
                    *(u32x2*)(XB + off + bj * HALF) = (u32x2){(unsigned)p0, (unsigned)p1}; }
                sq += __shfl_xor(sq, 16); sq += __shfl_xor(sq, 32);
                if (fq == 0) atomicAdd(ssq + row, sq); }
    }
};
struct EpiScaleRow {
    static constexpr bool PERM = true, AFTER_DRAIN = false;
    _Float16* C; int ldc; const float* ssq; float invk, eps;
    __device__ __forceinline__ void operator()(const f32x4 (&acc)[2][2][4][2], const Unit& u, int wr, int wc, int fr, int fq) const {
        typedef _Float16 h2 __attribute__((ext_vector_type(2)));
        const int row0 = u.pm * BM + wr * 64 + fr, col0 = u.pn * BM + wc * 32 + 8 * fq;
#pragma unroll
        for (int ai = 0; ai < 2; ++ai)
#pragma unroll
            for (int m = 0; m < 4; ++m) { const int row = row0 + ai * HALF + m * 16; const size_t off = (size_t)row * ldc + col0; const float rs = 1.f / sqrtf(ssq[row] * invk + eps);
#pragma unroll
                for (int bj = 0; bj < 2; ++bj) { const f32x4 v0 = acc[ai][bj][m][0] * rs, v1 = acc[ai][bj][m][1] * rs;
                    const h2 p0 = {(_Float16)v0[0], (_Float16)v0[1]}, p1 = {(_Float16)v0[2], (_Float16)v0[3]}, p2 = {(_Float16)v1[0], (_Float16)v1[1]}, p3 = {(_Float16)v1[2], (_Float16)v1[3]};
                    u32x4 w; w.x = __builtin_bit_cast(unsigned, p0); w.y = __builtin_bit_cast(unsigned, p1); w.z = __builtin_bit_cast(unsigned, p2); w.w = __builtin_bit_cast(unsigned, p3);
                    *(u32x4*)(C + off + bj * HALF) = w; } }
    }
};
template <class Epi, class Sched, bool ALIGN_EPI = false, bool SP2 = false>
__device__ __forceinline__ void gemm_phase(PG8_LAS unsigned char* lds, const Gemm g, const Sched& S, const Epi& E) {
    const int tid = threadIdx.x, wid = __builtin_amdgcn_readfirstlane(tid >> 6), lane = tid & 63, wr = wid >> 2, wc = wid & 3, fr = lane & 15, fq = lane >> 4;
    const int K = g.K, nt = K / BK;
    unsigned voffA[2], voffB[2];
#pragma unroll
    for (int i = 0; i < 2; ++i) { int R, C; stage_rc(tid * 16 + i * 8192, R, C); const int Rb = Epi::PERM ? ((R & ~31) + perm32(R & 31)) : R;
        voffA[i] = (unsigned)(R * K + C) * 2u; voffB[i] = (unsigned)(Rb * K + C) * 2u; }
    const size_t kstep = (size_t)(BK * 2);
    const size_t hstep = (size_t)HALF * K * 2;
    const size_t tstep = 2 * hstep;
    const unsigned ldsw = (unsigned)wid * 1024u;
    const int aoff = lds_byte(wr * 64 + fr, fq * 8), boff = lds_byte(wc * 32 + fr, fq * 8);
#define PG8_SA(b, h) (((b) * 2 + (h)) * HTB)
#define PG8_SB(b, h) ((4 + (b) * 2 + (h)) * HTB)
#define PG8_STAGE(bufoff, gbase, voff) do { _Pragma("unroll") for (int _i = 0; _i < 2; ++_i) \
        __builtin_amdgcn_global_load_lds((const unsigned*)((const char*)(gbase) + (voff)[_i]), (PG8_LAS unsigned*)(lds + (bufoff) + ldsw + _i * 8192), 16, 0, 0); } while (0)
#define PG8_LDA(dst, b, h) do { _Pragma("unroll") for (int m = 0; m < 4; ++m) _Pragma("unroll") for (int k = 0; k < 2; ++k) dst[m][k] = *(const PG8_LAS bf16x8*)(lds + PG8_SA(b, h) + aoff + m * 2048 + k * 1024); } while (0)
#define PG8_LDB(dst, b, h) do { _Pragma("unroll") for (int n = 0; n < 2; ++n) _Pragma("unroll") for (int k = 0; k < 2; ++k) dst[n][k] = *(const PG8_LAS bf16x8*)(lds + PG8_SB(b, h) + boff + n * 2048 + k * 1024); } while (0)
#define PG8_MMA(ai, bj, At, Bt) do { __builtin_amdgcn_s_setprio(1); _Pragma("unroll") for (int m = 0; m < 4; ++m) _Pragma("unroll") for (int n = 0; n < 2; ++n) _Pragma("unroll") for (int k = 0; k < 2; ++k) \
        acc[ai][bj][m][n] = __builtin_amdgcn_mfma_f32_16x16x32_bf16(Bt[n][k], At[m][k], acc[ai][bj][m][n], 0, 0, 0); __builtin_amdgcn_s_setprio(0); } while (0)
#define PG8_WAIT_V(n) asm volatile("s_waitcnt vmcnt(" #n ")" ::: "memory")
#define PG8_WAIT_L(n) asm volatile("s_waitcnt lgkmcnt(" #n ")" ::: "memory")
#define PG8_BAR __builtin_amdgcn_s_barrier()
#define PG8_SCHED __builtin_amdgcn_sched_barrier(0)
    Unit cur, nxt; int ui = 0;
    if (!S.next(0, cur)) return;
    f32x4 acc[2][2][4][2];
#pragma unroll
    for (int a = 0; a < 2; ++a)
#pragma unroll
        for (int b = 0; b < 2; ++b)
#pragma unroll
            for (int m = 0; m < 4; ++m)
#pragma unroll
                for (int n = 0; n < 2; ++n) acc[a][b][m][n] = (f32x4){0.f, 0.f, 0.f, 0.f};
    bf16x8 At[4][2], B0[2][2], B1[2][2];
    const char* cA = (const char*)g.A + (size_t)cur.pm * tstep; const char* cB = (const char*)g.Bt + (size_t)cur.pn * tstep;
    S.a_ready(cur);
    if constexpr (SP2) {
        PG8_STAGE(PG8_SB(0, 0), cB, voffB); PG8_STAGE(PG8_SB(0, 1), cB + hstep, voffB); PG8_STAGE(PG8_SA(0, 0), cA, voffA); PG8_STAGE(PG8_SA(0, 1), cA + hstep, voffA);
        if (wr == 1) PG8_BAR;
        PG8_WAIT_V(2); PG8_BAR;
        PG8_STAGE(PG8_SB(1, 0), cB + kstep, voffB); PG8_STAGE(PG8_SA(1, 0), cA + kstep, voffA); PG8_STAGE(PG8_SB(1, 1), cB + hstep + kstep, voffB);
        PG8_WAIT_V(6); PG8_BAR;
    } else {
        PG8_STAGE(PG8_SB(0, 0), cB, voffB); PG8_STAGE(PG8_SA(0, 0), cA, voffA); PG8_STAGE(PG8_SB(0, 1), cB + hstep, voffB); PG8_STAGE(PG8_SA(0, 1), cA + hstep, voffA);
        if (wr == 1) PG8_BAR;
        PG8_WAIT_V(4); PG8_BAR;
        PG8_STAGE(PG8_SB(1, 0), cB + kstep, voffB); PG8_STAGE(PG8_SA(1, 0), cA + kstep, voffA); PG8_STAGE(PG8_SB(1, 1), cB + hstep + kstep, voffB);
        PG8_WAIT_V(6); PG8_BAR;
    }
    for (;;) {
        const bool has_next = S.next(ui + 1, nxt);
        const char* nA = has_next ? (const char*)g.A + (size_t)nxt.pm * tstep : cA; const char* nB = has_next ? (const char*)g.Bt + (size_t)nxt.pn * tstep : cB;
        for (int t = 0; t < nt; t += 2) {
            const bool last = (t == nt - 2);
            const char* a1 = cA + (size_t)(t + 1) * kstep;
            const char* a2 = last ? nA : cA + (size_t)(t + 2) * kstep; const char* b2 = last ? nB : cB + (size_t)(t + 2) * kstep;
            const char* a3 = a2 + kstep; const char* b3 = b2 + kstep;
            if (last && has_next) S.a_ready(nxt);
            if constexpr (SP2) {
            PG8_LDB(B0, 0, 0); PG8_LDB(B1, 0, 1); PG8_SCHED; PG8_LDA(At, 0, 0); PG8_STAGE(PG8_SA(1, 1), a1 + hstep, voffA);
            PG8_WAIT_V(8); PG8_WAIT_L(0); PG8_BAR; PG8_MMA(0, 0, At, B0); PG8_MMA(0, 1, At, B1); PG8_BAR; PG8_SCHED;
            PG8_LDA(At, 0, 1); PG8_STAGE(PG8_SB(0, 0), b2, voffB); PG8_STAGE(PG8_SB(0, 1), b2 + hstep, voffB); PG8_STAGE(PG8_SA(0, 0), a2, voffA);
            PG8_WAIT_V(8); PG8_WAIT_L(0); PG8_BAR; PG8_MMA(1, 0, At, B0); PG8_MMA(1, 1, At, B1); PG8_BAR; PG8_SCHED;
            PG8_LDB(B0, 1, 0); PG8_LDB(B1, 1, 1); PG8_SCHED; PG8_LDA(At, 1, 0); PG8_STAGE(PG8_SA(0, 1), a2 + hstep, voffA);
            PG8_WAIT_V(8); PG8_WAIT_L(0); PG8_BAR; PG8_MMA(0, 0, At, B0); PG8_MMA(0, 1, At, B1); PG8_BAR; PG8_SCHED;
            PG8_LDA(At, 1, 1); PG8_STAGE(PG8_SB(1, 0), b3, voffB); PG8_STAGE(PG8_SB(1, 1), b3 + hstep, voffB); PG8_STAGE(PG8_SA(1, 0), a3, voffA);
            PG8_WAIT_V(8); PG8_WAIT_L(0); PG8_BAR; PG8_MMA(1, 0, At, B0); PG8_MMA(1, 1, At, B1); PG8_BAR; PG8_SCHED;
            } else {
            PG8_LDB(B0, 0, 0); PG8_SCHED; PG8_LDA(At, 0, 0); PG8_STAGE(PG8_SA(1, 1), a1 + hstep, voffA);
            PG8_WAIT_L(8); PG8_BAR; PG8_WAIT_L(0); PG8_MMA(0, 0, At, B0); PG8_BAR; PG8_SCHED;
            PG8_LDB(B1, 0, 1); PG8_STAGE(PG8_SB(0, 0), b2, voffB);
            PG8_BAR; PG8_WAIT_L(0); PG8_MMA(0, 1, At, B1); PG8_BAR;
            PG8_LDA(At, 0, 1); PG8_STAGE(PG8_SA(0, 0), a2, voffA);
            PG8_BAR; PG8_WAIT_L(0); PG8_MMA(1, 0, At, B0); PG8_BAR; PG8_SCHED;
            PG8_STAGE(PG8_SB(0, 1), b2 + hstep, voffB);
            PG8_WAIT_V(6); PG8_BAR; PG8_MMA(1, 1, At, B1); PG8_BAR;
            PG8_LDB(B0, 1, 0); PG8_SCHED; PG8_LDA(At, 1, 0); PG8_STAGE(PG8_SA(0, 1), a2 + hstep, voffA);
            PG8_WAIT_L(8); PG8_BAR; PG8_WAIT_L(0); PG8_MMA(0, 0, At, B0); PG8_BAR; PG8_SCHED;
            PG8_LDB(B1, 1, 1); PG8_STAGE(PG8_SB(1, 0), b3, voffB);
            PG8_BAR; PG8_WAIT_L(0); PG8_MMA(0, 1, At, B1); PG8_BAR;
            PG8_LDA(At, 1, 1); PG8_STAGE(PG8_SA(1, 0), a3, voffA);
            PG8_BAR; PG8_WAIT_L(0); PG8_MMA(1, 0, At, B0); PG8_BAR; PG8_SCHED;
            PG8_STAGE(PG8_SB(1, 1), b3 + hstep, voffB);
            PG8_WAIT_V(6); PG8_BAR; PG8_MMA(1, 1, At, B1); PG8_BAR;
            }
        }
        if constexpr (ALIGN_EPI) { if (wr == 0) PG8_BAR; }
        if constexpr (!Epi::AFTER_DRAIN) { E(acc, cur, wr, wc, fr, fq); S.done(cur); }
        if (!has_next) break;
#pragma unroll
        for (int a = 0; a < 2; ++a)
#pragma unroll
            for (int b = 0; b < 2; ++b)
#pragma unroll
                for (int m = 0; m < 4; ++m)
#pragma unroll
                    for (int n = 0; n < 2; ++n) acc[a][b][m][n] = (f32x4){0.f, 0.f, 0.f, 0.f};
        cur = nxt; cA = nA; cB = nB; ++ui;
        if constexpr (ALIGN_EPI) { if (wr == 1) PG8_BAR; }
    }
    PG8_WAIT_V(0);
    if constexpr (!ALIGN_EPI) { if (wr == 0) PG8_BAR; }
    PG8_BAR;
    if constexpr (Epi::AFTER_DRAIN) { E.fused(acc, cur, wr, wc, fr, fq, lds, wid, lane); S.done(cur); }
#undef PG8_SA
#undef PG8_SB
#undef PG8_STAGE
#undef PG8_LDA
#undef PG8_LDB
#undef PG8_MMA
#undef PG8_WAIT_V
#undef PG8_WAIT_L
#undef PG8_BAR
#undef PG8_SCHED
}
}
#ifndef PG8_SP2
#define PG8_SP2 true
#endif
#ifndef PG8_ALIGN
#define PG8_ALIGN true
#endif

constexpr int NWAVES = 8;
constexpr int NTOK = 32768, DM = 1024, SEQ = 2048, NBATCH = 16, INW = 3584;
constexpr int C_DQ = 0, C_DK = 512, C_DV = 1024, C_HQ = 1536, C_HF = 2048, C_HI = 2560, C_HG = 3072;
constexpr float EPS = 1e-6f;
constexpr float QSCALE = 0.125f * 1.4426950408889634f;
constexpr float LAM_INIT = 0.2f;
constexpr int NEXP_SEL = 128;

constexpr size_t MiB = 1u << 20;
constexpr size_t WS_CTL = 0, CTL_ZERO_BYTES = 1 * MiB;
constexpr size_t WS_SMALL = 1 * MiB;
constexpr size_t WS_WIN = 2 * MiB;
constexpr size_t WS_WOUT = 10 * MiB;
constexpr size_t WS_W2 = 12 * MiB;
constexpr size_t WS_U8 = 17 * MiB;
constexpr size_t WS_V8 = 33 * MiB;
constexpr size_t WS_SU = 49 * MiB;
constexpr size_t WS_SV = 49 * MiB + 512 * 1024;
constexpr size_t WS_X8 = 50 * MiB;
constexpr size_t WS_SX = 116 * MiB;
constexpr size_t WS_GSU = 120 * MiB;
constexpr size_t WS_HN = 84 * MiB;
constexpr size_t WS_PROJ = 148 * MiB;
constexpr size_t WS_HN2 = 148 * MiB;
constexpr size_t WS_SC = 212 * MiB;
constexpr size_t WS_PO = 352 * MiB;
constexpr size_t WS_IDX = 468 * MiB;
constexpr size_t WS_GATE = 484 * MiB;
constexpr size_t WS_END = 500 * MiB;
constexpr int SM_LB = 0, SM_LAM = 512, SM_BIAS = 1024;
constexpr int CW_BAR = 4096;
constexpr int CW_ATTQ = 8192;
constexpr int CW_SSQ = 131072;

constexpr int RING_OFF = 0, RING_BYTES = 139264;
constexpr int LDSCTL_OFF = RING_BYTES, MISC_OFF = LDSCTL_OFF + 320;
constexpr int LDS_BYTES = 147456;

#define GAS __attribute__((address_space(1)))
#define LAS __attribute__((address_space(3)))
typedef unsigned short bf16;
typedef unsigned v4u __attribute__((ext_vector_type(4)));
typedef unsigned v2u __attribute__((ext_vector_type(2)));
typedef float f32x4 __attribute__((ext_vector_type(4)));
typedef short bf16x8 __attribute__((ext_vector_type(8)));
typedef GAS unsigned gu32;
typedef long l2 __attribute__((ext_vector_type(2)));
typedef int v4i __attribute__((ext_vector_type(4)));
#define RLX_AGENT __ATOMIC_RELAXED, __HIP_MEMORY_SCOPE_AGENT
#define LDS_WAIT() asm volatile("s_waitcnt lgkmcnt(0)" ::: "memory")
#define VM_WAIT() asm volatile("s_waitcnt vmcnt(0)" ::: "memory")
__device__ __forceinline__ unsigned f2bf(float f) { unsigned u = __builtin_bit_cast(unsigned, f); return (u + 0x7fffu + ((u >> 16) & 1u)) >> 16; }
__device__ __forceinline__ unsigned pk2(float lo, float hi) { return f2bf(lo) | (f2bf(hi) << 16); }
__device__ __forceinline__ float bflo(unsigned w) { return __builtin_bit_cast(float, w << 16); }
__device__ __forceinline__ float bfhi(unsigned w) { return __builtin_bit_cast(float, w & 0xffff0000u); }

#define XB_TMO      128
#define XB_XCNT(j)  (256  + 64 * (j))
#define XB_XSUB(j)  (1280 + 64 * (j))
#define XB_XGEN(j)  (2304 + 64 * (j))
#define XB_TOP      3328
#define XB_TOPGEN   3392
#define XCD_BAR_WORDS 3456
#define XB_SPIN_CAP (1u << 18)
__device__ __forceinline__ unsigned xb_ld(unsigned* p)              { return __hip_atomic_load(p, __ATOMIC_RELAXED, __HIP_MEMORY_SCOPE_AGENT); }
__device__ __forceinline__ unsigned xb_add(unsigned* p, unsigned v) { return __hip_atomic_fetch_add(p, v, __ATOMIC_RELAXED, __HIP_MEMORY_SCOPE_AGENT); }
__device__ __forceinline__ unsigned xb_xcc_id() { return (unsigned)__builtin_amdgcn_s_getreg((3 << 11) | 20) & 0xFu; }
#define XB_SPIN(cond, bar) do { unsigned _sp = 0; while (cond) { __builtin_amdgcn_s_sleep(1); \
    if ((++_sp & 255u) == 0u) { if (xb_ld(&(bar)[XB_TMO])) break; if (_sp > XB_SPIN_CAP) { atomicAdd(&(bar)[XB_TMO], 1u); break; } } } } while (0)
struct XcdBarrier { unsigned* bar; unsigned x; volatile LAS unsigned* st; };
__device__ __forceinline__ XcdBarrier xcd_barrier_post(unsigned* bar, volatile LAS unsigned* st) {
    XcdBarrier b; b.bar = bar; b.x = xb_xcc_id(); b.st = st;
    if (threadIdx.x == 0) (void)xb_add(&bar[XB_XCNT(b.x)], 1u);
    return b;
}
__device__ __forceinline__ void xcd_barrier_complete(unsigned* bar, unsigned x, unsigned& nloc, unsigned& nx) {
    const unsigned G = gridDim.x * gridDim.y * gridDim.z;
    unsigned sum, cnt, mine, sp = 0u;
    for (;;) {
        sum = 0u; cnt = 0u; mine = 0u;
#pragma unroll
        for (unsigned j = 0; j < 16; ++j) { const unsigned c = xb_ld(&bar[XB_XCNT(j)]); sum += c; cnt += (c > 0u) ? 1u : 0u; mine = (j == x) ? c : mine; }
        if (sum == G) break;
        __builtin_amdgcn_s_sleep(1);
        if ((++sp & 255u) == 0u) { if (xb_ld(&bar[XB_TMO])) break; if (sp > XB_SPIN_CAP) { atomicAdd(&bar[XB_TMO], 1u); break; } }
    }
    nloc = mine > 0u ? mine : 1u; nx = cnt > 0u ? cnt : 1u;
}
__device__ __forceinline__ void xcd_barrier(const XcdBarrier& b) {
    asm volatile("s_waitcnt vmcnt(0)" ::: "memory");
    __syncthreads();
    if (threadIdx.x == 0) {
        unsigned* bar = b.bar;
        __builtin_amdgcn_s_waitcnt(0);
        unsigned nloc = b.st[0], nx = b.st[1];
        if (nloc == 0u) { xcd_barrier_complete(bar, b.x, nloc, nx); b.st[0] = nloc; b.st[1] = nx; }
        const unsigned old = xb_add(&bar[XB_XSUB(b.x)], 1u);
        const unsigned gen = old / nloc;
        if (old + 1u == (gen + 1u) * nloc) {
            __builtin_amdgcn_fence(__ATOMIC_RELEASE, "agent");
            asm volatile("s_waitcnt vmcnt(0)" ::: "memory");
            const unsigned og = xb_add(&bar[XB_TOP], 1u);
            const unsigned tg = og / nx;
            if (og + 1u == (tg + 1u) * nx) xb_add(&bar[XB_TOPGEN], 1u);
            else XB_SPIN(xb_ld(&bar[XB_TOPGEN]) == tg, bar);
            __builtin_amdgcn_fence(__ATOMIC_ACQUIRE, "agent");
            xb_add(&bar[XB_XGEN(b.x)], 1u);
            asm volatile("s_waitcnt vmcnt(0)" ::: "memory");
        } else {
            XB_SPIN(xb_ld(&bar[XB_XGEN(b.x)]) == gen, bar);
            __builtin_amdgcn_fence(__ATOMIC_ACQUIRE, "agent");
            asm volatile("s_waitcnt vmcnt(0)" ::: "memory");
        }
    }
    __syncthreads();
}

#define SCHED_FENCE() __builtin_amdgcn_sched_barrier(0)
__device__ __forceinline__ float gelu_as(float v) {
    const float av = fabsf(v), t = __builtin_amdgcn_rcpf(av * 0.2316418882f + 1.0f);
    float q = t * 0.5307027145f + (-0.7265760135f); q = q * t + 0.7107068705f; q = q * t + (-0.142248368f); q = q * t + 0.127414796f; q = q * t;
    const float e = __builtin_amdgcn_exp2f((v * v) * (-0.72134752044f));
    const float mm = v * (q * e);
    return v < 0.f ? mm : v - mm;
}
struct Frame {
    LAS unsigned char* lds;
    volatile LAS unsigned* MISC;
    int tid, lane, wave, vcu, G;
    const float* in[18]; float* out; unsigned char* ws;
};
__device__ __forceinline__ float wave_sum(float v) {
#pragma unroll
    for (int o = 1; o < 64; o <<= 1) v += __shfl_xor(v, o);
    return v;
}
__device__ __forceinline__ float sigmoidf_(float x) { return 1.f / (1.f + __expf(-x)); }

__device__ __forceinline__ void p0_transpose_item(const float* W, int K, int N, bf16* WT, int row_off, LAS float* scr, int item, int lane) {
    const int nblk = N / 32, kb = item / nblk, nb = item % nblk, k0 = 64 * kb, n0 = 32 * nb;
#pragma unroll 8
    for (int i = 0; i < 32; ++i) { const int kk = 2 * i + (lane >> 5); scr[kk * 33 + (lane & 31)] = W[(size_t)(k0 + kk) * N + n0 + (lane & 31)]; }
    LDS_WAIT(); asm volatile("" ::: "memory");
    const int c = lane & 7;
#pragma unroll
    for (int j = 0; j < 4; ++j) { const int n = (lane >> 3) + 8 * j; const LAS float* s = scr + (8 * c) * 33 + n;
        v4u o; o.x = pk2(s[0 * 33], s[1 * 33]); o.y = pk2(s[2 * 33], s[3 * 33]); o.z = pk2(s[4 * 33], s[5 * 33]); o.w = pk2(s[6 * 33], s[7 * 33]);
        *(GAS v4u*)(WT + (size_t)(row_off + n0 + n) * K + k0 + 8 * c) = o; }
    LDS_WAIT(); asm volatile("" ::: "memory");
}

__device__ __forceinline__ void quant_vals_fp8(const f32x4 (&v)[4], unsigned char* dst, float* dq, int lane, size_t slice_stride) {
    float mx = 0.f;
#pragma unroll
    for (int j = 0; j < 4; ++j) mx = fmaxf(mx, fmaxf(fmaxf(fabsf(v[j].x), fabsf(v[j].y)), fmaxf(fabsf(v[j].z), fabsf(v[j].w))));
#pragma unroll
    for (int o = 1; o < 64; o <<= 1) mx = fmaxf(mx, __shfl_xor(mx, o));
    const float qs = mx > 0.f ? 224.f / mx : 1.f;
#pragma unroll
    for (int j = 0; j < 4; ++j) { int p = __builtin_amdgcn_cvt_pk_fp8_f32(v[j].x * qs, v[j].y * qs, 0, false); p = __builtin_amdgcn_cvt_pk_fp8_f32(v[j].z * qs, v[j].w * qs, p, true);
        const int d = 4 * lane + 256 * j; *(GAS unsigned*)(dst + (slice_stride ? (size_t)(d >> 7) * slice_stride + (d & 127) : (size_t)d)) = (unsigned)p; }
    if (lane == 0) *dq = mx > 0.f ? mx * (1.f / 224.f) : 1.f;
}
__device__ __forceinline__ void quant_row_fp8(const float* src, unsigned char* dst, float* dq, int lane, size_t slice_stride) {
    const GAS f32x4* xr = (const GAS f32x4*)src + lane; f32x4 v[4];
#pragma unroll
    for (int j = 0; j < 4; ++j) v[j] = xr[64 * j];
    quant_vals_fp8(v, dst, dq, lane, slice_stride);
}
__device__ __forceinline__ void p0_prologue(Frame& F) {
    LAS float* scr = (LAS float*)(F.lds + RING_OFF + F.wave * 16384);
    const int gw = F.vcu * NWAVES + F.wave, NGW = F.G * NWAVES;
    bf16* WinT = (bf16*)(F.ws + WS_WIN); bf16* WoutT = (bf16*)(F.ws + WS_WOUT); bf16* W2T = (bf16*)(F.ws + WS_W2);
    float* small = (float*)(F.ws + WS_SMALL);
    if (blockIdx.x == 0) {
        const int t = F.tid;
        { const float l0 = F.in[9][t], l1 = F.in[9][512 + t]; small[SM_LB + t] = 1.f / (1.f + expf(l1 - l0)); }
        { const int h = t >> 7, n = t & 127; int bk;
          if (n < 16) bk = n; else { bk = 16 + (int)(logf((float)n * (1.f / 16.f)) / logf(8.f) * 16.f); bk = bk > 31 ? 31 : bk; }
          small[SM_BIAS + t] = F.in[8][bk * 4 + h] * 1.4426950408889634f; }
        if (F.wave == 0) {
            const float a = wave_sum(F.in[3][F.lane] * F.in[4][F.lane]), b = wave_sum(F.in[5][F.lane] * F.in[6][F.lane]);
            if (F.lane == 0) small[SM_LAM] = expf(a) - expf(b) + LAM_INIT;
        }
    }
    constexpr int I_IN = (DM / 64) * (INW / 32), I_OUT = (DM / 64) * (DM / 32);
    for (int it = gw; it < I_IN + I_OUT; it += NGW) {
        if (it < I_IN) p0_transpose_item(F.in[2], DM, INW, WinT, 0, scr, it, F.lane);
        else p0_transpose_item(F.in[11], DM, DM, WoutT, 0, scr, it - I_IN, F.lane);
    }
    for (int u = F.vcu; u < 256; u += F.G) {
        const int hc = u >> 4, kb = u & 15, k = kb * 64 + F.lane;
        const GAS f32x4* wrow = (const GAS f32x4*)(F.in[13] + (size_t)k * 2048 + hc * 128);
        float a[16];
#pragma unroll
        for (int nn = 0; nn < 16; ++nn) a[nn] = 0.f;
        const float* kr = F.in[14] + ((size_t)hc * 128 + F.wave * 16) * 128;
        for (int i = 0; i < 32; ++i) {
            const f32x4 w = wrow[i];
#pragma unroll
            for (int nn = 0; nn < 16; ++nn) { const float* kk = kr + nn * 128 + 4 * i; a[nn] += (kk[0] * w.x + kk[1] * w.y) + (kk[2] * w.z + kk[3] * w.w); }
        }
        const float g2k = F.in[12][k];
#pragma unroll
        for (int nn = 0; nn < 16; ++nn) W2T[((size_t)hc * 128 + F.wave * 16 + nn) * DM + k] = (bf16)f2bf(a[nn] * g2k);
    }
    bf16* HN = (bf16*)(F.ws + WS_HN);
    for (int m = gw; m < NTOK; m += 2 * NGW) {
        const int m2 = m + NGW;
        const GAS f32x4* xa = (const GAS f32x4*)(F.in[0] + (size_t)m * DM) + F.lane; const GAS f32x4* xb = (const GAS f32x4*)(F.in[0] + (size_t)(m2 < NTOK ? m2 : m) * DM) + F.lane;
        const GAS f32x4* gr = (const GAS f32x4*)F.in[1] + F.lane;
        f32x4 va[4], vb[4]; float sa = 0.f, sb = 0.f;
#pragma unroll
        for (int j = 0; j < 4; ++j) { va[j] = xa[64 * j]; vb[j] = xb[64 * j]; }
#pragma unroll
        for (int j = 0; j < 4; ++j) { sa += (va[j].x * va[j].x + va[j].y * va[j].y) + (va[j].z * va[j].z + va[j].w * va[j].w); sb += (vb[j].x * vb[j].x + vb[j].y * vb[j].y) + (vb[j].z * vb[j].z + vb[j].w * vb[j].w); }
#pragma unroll
        for (int o = 1; o < 64; o <<= 1) { sa += __shfl_xor(sa, o); sb += __shfl_xor(sb, o); }
        const float ra = 1.f / sqrtf(sa * (1.f / DM) + EPS), rb = 1.f / sqrtf(sb * (1.f / DM) + EPS);
        GAS unsigned long long* oa = (GAS unsigned long long*)(HN + (size_t)m * DM) + F.lane; GAS unsigned long long* ob = (GAS unsigned long long*)(HN + (size_t)m2 * DM) + F.lane;
#pragma unroll
        for (int j = 0; j < 4; ++j) { const f32x4 gg = gr[64 * j];
            oa[64 * j] = (unsigned long long)pk2(va[j].x * ra * gg.x, va[j].y * ra * gg.y) | ((unsigned long long)pk2(va[j].z * ra * gg.z, va[j].w * ra * gg.w) << 32);
            if (m2 < NTOK) ob[64 * j] = (unsigned long long)pk2(vb[j].x * rb * gg.x, vb[j].y * rb * gg.y) | ((unsigned long long)pk2(vb[j].z * rb * gg.z, vb[j].w * rb * gg.w) << 32); }
    }
}


constexpr int QCHUNKS = 2 * 16384 / 64;
__device__ __forceinline__ void quant_chunk(Frame& F, int c) {
    unsigned char* U8 = F.ws + WS_U8; unsigned char* V8 = F.ws + WS_V8; float* SU = (float*)(F.ws + WS_SU); float* SV = (float*)(F.ws + WS_SV);
#pragma unroll 1
    for (int k = 0; k < 8; ++k) { const int rr = 64 * c + 8 * F.wave + k;
        if (rr < 16384) quant_row_fp8(F.in[15] + (size_t)rr * DM, U8 + (size_t)rr * 128, SU + rr, F.lane, (size_t)16384 * 128);
        else { const int e = rr - 16384; quant_row_fp8(F.in[16] + (size_t)e * DM, V8 + (size_t)e * 128, SV + e, F.lane, (size_t)16384 * 128); } }
}

__device__ __forceinline__ void quant_drain(Frame& F) {
    unsigned* qctr = (unsigned*)(F.ws + WS_CTL) + CW_ATTQ + 128;
    for (;;) {
        __syncthreads();
        if (F.tid == 0) F.MISC[13] = __hip_atomic_fetch_add(qctr, 1u, __ATOMIC_RELAXED, __HIP_MEMORY_SCOPE_AGENT);
        __syncthreads();
        const int qc = (int)F.MISC[13];
        if (qc >= QCHUNKS) break;
        quant_chunk(F, qc);
    }
}

typedef float f32x16 __attribute__((ext_vector_type(16)));
typedef short s16x4 __attribute__((ext_vector_type(4)));
typedef short v4i16_t __attribute__((ext_vector_type(4)));
typedef float f32x2_t __attribute__((ext_vector_type(2))); typedef __bf16 bf16x2_t __attribute__((ext_vector_type(2)));
__device__ __forceinline__ unsigned cvtpk_bf16(float lo, float hi) { f32x2_t v = {lo, hi}; bf16x2_t b = __builtin_convertvector(v, bf16x2_t); return __builtin_bit_cast(unsigned, b); }
__device__ __forceinline__ float xhalf_max(float v) { return fmaxf(v, __shfl_xor(v, 32)); }
__device__ __forceinline__ float xhalf_sum(float v) { return v + __shfl_xor(v, 32); }
__device__ __forceinline__ float max3f_(float a, float b, float c) { float r; asm("v_max3_f32 %0, %1, %2, %3" : "=v"(r) : "v"(a), "v"(b), "v"(c)); return r; }
constexpr int AT_KP = 144, AT_VP = 320, AT_K1 = 64 * AT_KP, AT_V = 2 * AT_K1, AT_BUF = AT_V + 64 * AT_VP;
constexpr int AT_XO = 0, AT_YB = 65536, AT_YP = 272, AT_Q = 100864, AT_TAB = AT_Q + 8 * 4096;
static_assert(AT_TAB + 320 * 4 <= RING_BYTES && AT_YB + 4 * 32 * AT_YP <= AT_Q, "attention LDS map");
__device__ __forceinline__ void attn_mfma(Frame& F, int qslot) {
    const bf16* PROJ = (const bf16*)(F.ws + WS_PROJ); bf16* MIXED = (bf16*)(F.ws + WS_HN);
    const float* small = (const float*)(F.ws + WS_SMALL);
    LAS unsigned char* lds = F.lds;
    LAS float* TAB = (LAS float*)(lds + AT_TAB);
    const int tid = F.tid, lane = F.lane, wave = F.wave, map = wave >> 2, qt = wave & 3, r32 = lane & 31, hi = lane >> 5;
    const float lam = small[SM_LAM];
    const int koff = map * AT_K1 + r32 * AT_KP + hi * 16;
    const int voff = AT_V + (4 * hi + ((lane & 15) >> 2)) * AT_VP + (16 * ((lane >> 4) & 1) + 4 * (lane & 3)) * 2;
    unsigned* qctr = (unsigned*)(F.ws + WS_CTL) + CW_ATTQ + 64 * qslot;
    for (;;) {
        __syncthreads();
        if (tid == 0) F.MISC[12] = __hip_atomic_fetch_add(qctr, 1u, __ATOMIC_RELAXED, __HIP_MEMORY_SCOPE_AGENT);
        __syncthreads();
        const int L = (int)F.MISC[12];
        if (L >= 1024) break;
        const int qb = 15 - (L >> 6), bh = L & 63;
        const int b = bh >> 2, h = bh & 3, q0 = qb * 128; const size_t tok0 = (size_t)b * SEQ;
        const int NT = (q0 + 128) / 64;
        if (tid < 320) { const int n = tid - 96; TAB[tid] = n < 0 ? -INFINITY : small[SM_BIAS + h * 128 + (n > 127 ? 127 : n)]; }
        LAS unsigned char* qlds = lds + AT_Q + wave * 4096 + lane * 16;
        { const bf16* qrow = PROJ + (tok0 + q0 + 32 * qt + r32) * INW + C_DQ + h * 128 + map * 64 + 8 * hi;
#pragma unroll
          for (int s4 = 0; s4 < 4; ++s4) *(LAS bf16x8*)(qlds + 1024 * s4) = *(const GAS bf16x8*)(qrow + 16 * s4); }
        const bf16* ksrc = PROJ + (tok0 + (tid >> 4)) * INW + C_DK + h * 128 + (tid & 15) * 8;
        const bf16* vsrc = PROJ + (tok0 + (tid >> 4)) * INW + C_DV + h * 128 + (tid & 15) * 8;
        const int kdst = ((tid & 15) >> 3) * AT_K1 + (tid >> 4) * AT_KP + (tid & 7) * 16, vdst = AT_V + (tid >> 4) * AT_VP + (tid & 15) * 16;
        v4u krA[2], vrA[2], krB[2], vrB[2];
#pragma unroll
        for (int i = 0; i < 2; ++i) { krB[i] = *(const GAS v4u*)(ksrc + (size_t)(32 * i) * INW); vrB[i] = *(const GAS v4u*)(vsrc + (size_t)(32 * i) * INW); }
#pragma unroll
        for (int i = 0; i < 2; ++i) { krA[i] = *(const GAS v4u*)(ksrc + (size_t)(64 + 32 * i) * INW); vrA[i] = *(const GAS v4u*)(vsrc + (size_t)(64 + 32 * i) * INW); }
#pragma unroll
        for (int i = 0; i < 2; ++i) { *(LAS v4u*)(lds + kdst + 32 * i * AT_KP) = krB[i]; *(LAS v4u*)(lds + vdst + 32 * i * AT_VP) = vrB[i]; }
        __syncthreads();
        const float bfar = TAB[96 + 127];
        f32x16 o[4];
#pragma unroll
        for (int mt = 0; mt < 4; ++mt) o[mt] = (f32x16){0.f,0.f,0.f,0.f,0.f,0.f,0.f,0.f,0.f,0.f,0.f,0.f,0.f,0.f,0.f,0.f};
        float mrun = -INFINITY, lsum = 0.f;
        const int qlo = q0 + 32 * qt, qpos = qlo + r32;
#pragma unroll
        for (int i = 0; i < 2; ++i) { if (2 < NT) { krB[i] = *(const GAS v4u*)(ksrc + (size_t)(128 + 32 * i) * INW); vrB[i] = *(const GAS v4u*)(vsrc + (size_t)(128 + 32 * i) * INW); } }
        for (int j2 = 0; j2 < NT; j2 += 2) {
          { const int j = j2;
            const int bo = (j & 1) * AT_BUF, bn = ((j + 1) & 1) * AT_BUF;
            if (64 * j <= qlo + 31) {
                f32x16 s0 = (f32x16){0.f,0.f,0.f,0.f,0.f,0.f,0.f,0.f,0.f,0.f,0.f,0.f,0.f,0.f,0.f,0.f}, s1 = s0;
#pragma unroll
                for (int s4 = 0; s4 < 4; ++s4) {
                    const bf16x8 a0 = *(const LAS bf16x8*)(lds + bo + koff + 32 * s4), a1 = *(const LAS bf16x8*)(lds + bo + koff + 32 * AT_KP + 32 * s4);
                    const bf16x8 qfr = *(const LAS bf16x8*)(qlds + 1024 * s4);
                    s0 = __builtin_amdgcn_mfma_f32_32x32x16_bf16(a0, qfr, s0, 0, 0, 0);
                    s1 = __builtin_amdgcn_mfma_f32_32x32x16_bf16(a1, qfr, s1, 0, 0, 0);
                }
                float tm, cadd;
                if (qlo - (64 * j + 63) < 127) {
                    const LAS float* rp = TAB + (qpos - 64 * j - 4 * hi + 96 - 59); tm = -INFINITY;
#pragma unroll
                    for (int r = 0; r < 16; ++r) { const int off = (r & 3) + 8 * (r >> 2);
                        s0[r] += rp[59 - off]; s1[r] += rp[27 - off]; tm = max3f_(tm, s0[r], s1[r]); }
                    cadd = 0.f;
                } else {
                    tm = max3f_(s0[0], s1[0], s0[1]);
#pragma unroll
                    for (int r = 1; r < 15; ++r) tm = max3f_(tm, s1[r], s0[r + 1]);
                    tm = fmaxf(tm, s1[15]);
                    tm += bfar; cadd = bfar;
                }
                tm = xhalf_max(tm);
                if (__any(tm > mrun + 8.f)) {
                    const float mnew = fmaxf(mrun, tm), alpha = __builtin_amdgcn_exp2f(mrun - mnew);
                    lsum *= alpha; mrun = mnew;
#pragma unroll
                    for (int mt = 0; mt < 4; ++mt) o[mt] = o[mt] * alpha;
                }
                const float c = cadd - mrun; float psum = 0.f;
#pragma unroll
                for (int r = 0; r < 16; ++r) { s0[r] = __builtin_amdgcn_exp2f(s0[r] + c); s1[r] = __builtin_amdgcn_exp2f(s1[r] + c); psum += s0[r] + s1[r]; }
                lsum += psum;
#pragma unroll
                for (int kt2 = 0; kt2 < 2; ++kt2)
#pragma unroll
                    for (int sp = 0; sp < 2; ++sp) {
                        v4u pw;
                        if (kt2 == 0) { pw.x = cvtpk_bf16(s0[8 * sp], s0[8 * sp + 1]); pw.y = cvtpk_bf16(s0[8 * sp + 2], s0[8 * sp + 3]); pw.z = cvtpk_bf16(s0[8 * sp + 4], s0[8 * sp + 5]); pw.w = cvtpk_bf16(s0[8 * sp + 6], s0[8 * sp + 7]); }
                        else          { pw.x = cvtpk_bf16(s1[8 * sp], s1[8 * sp + 1]); pw.y = cvtpk_bf16(s1[8 * sp + 2], s1[8 * sp + 3]); pw.z = cvtpk_bf16(s1[8 * sp + 4], s1[8 * sp + 5]); pw.w = cvtpk_bf16(s1[8 * sp + 6], s1[8 * sp + 7]); }
                        const bf16x8 pf = __builtin_bit_cast(bf16x8, pw);
#pragma unroll
                        for (int mt = 0; mt < 4; ++mt) {
                            LAS unsigned char* vp = lds + bo + voff + (32 * kt2 + 16 * sp) * AT_VP + 64 * mt;
                            const s16x4 lo = __builtin_bit_cast(s16x4, __builtin_amdgcn_ds_read_tr16_b64_v4i16((LAS v4i16_t*)vp));
                            const s16x4 hi4 = __builtin_bit_cast(s16x4, __builtin_amdgcn_ds_read_tr16_b64_v4i16((LAS v4i16_t*)(vp + 8 * AT_VP)));
                            const bf16x8 af = (bf16x8){lo[0], lo[1], lo[2], lo[3], hi4[0], hi4[1], hi4[2], hi4[3]};
                            o[mt] = __builtin_amdgcn_mfma_f32_32x32x16_bf16(af, pf, o[mt], 0, 0, 0);
                        }
                    }
            }
            if (j + 1 < NT) {
#pragma unroll
                for (int i = 0; i < 2; ++i) { *(LAS v4u*)(lds + bn + kdst + 32 * i * AT_KP) = krA[i]; *(LAS v4u*)(lds + bn + vdst + 32 * i * AT_VP) = vrA[i]; }
                if (j + 3 < NT) {
#pragma unroll
                    for (int i = 0; i < 2; ++i) { krA[i] = *(const GAS v4u*)(ksrc + (size_t)(64 * (j + 3) + 32 * i) * INW); vrA[i] = *(const GAS v4u*)(vsrc + (size_t)(64 * (j + 3) + 32 * i) * INW); }
                }
            }
            __syncthreads();
                  }
          { const int j = j2 + 1;
            const int bo = (j & 1) * AT_BUF, bn = ((j + 1) & 1) * AT_BUF;
            if (64 * j <= qlo + 31) {
                f32x16 s0 = (f32x16){0.f,0.f,0.f,0.f,0.f,0.f,0.f,0.f,0.f,0.f,0.f,0.f,0.f,0.f,0.f,0.f}, s1 = s0;
#pragma unroll
                for (int s4 = 0; s4 < 4; ++s4) {
                    const bf16x8 a0 = *(const LAS bf16x8*)(lds + bo + koff + 32 * s4), a1 = *(const LAS bf16x8*)(lds + bo + koff + 32 * AT_KP + 32 * s4);
                    const bf16x8 qfr = *(const LAS bf16x8*)(qlds + 1024 * s4);
                    s0 = __builtin_amdgcn_mfma_f32_32x32x16_bf16(a0, qfr, s0, 0, 0, 0);
                    s1 = __builtin_amdgcn_mfma_f32_32x32x16_bf16(a1, qfr, s1, 0, 0, 0);
                }
                float tm, cadd;
                if (qlo - (64 * j + 63) < 127) {
                    const LAS float* rp = TAB + (qpos - 64 * j - 4 * hi + 96 - 59); tm = -INFINITY;
#pragma unroll
                    for (int r = 0; r < 16; ++r) { const int off = (r & 3) + 8 * (r >> 2);
                        s0[r] += rp[59 - off]; s1[r] += rp[27 - off]; tm = max3f_(tm, s0[r], s1[r]); }
                    cadd = 0.f;
                } else {
                    tm = max3f_(s0[0], s1[0], s0[1]);
#pragma unroll
                    for (int r = 1; r < 15; ++r) tm = max3f_(tm, s1[r], s0[r + 1]);
                    tm = fmaxf(tm, s1[15]);
                    tm += bfar; cadd = bfar;
                }
                tm = xhalf_max(tm);
                if (__any(tm > mrun + 8.f)) {
                    const float mnew = fmaxf(mrun, tm), alpha = __builtin_amdgcn_exp2f(mrun - mnew);
                    lsum *= alpha; mrun = mnew;
#pragma unroll
                    for (int mt = 0; mt < 4; ++mt) o[mt] = o[mt] * alpha;
                }
                const float c = cadd - mrun; float psum = 0.f;
#pragma unroll
                for (int r = 0; r < 16; ++r) { s0[r] = __builtin_amdgcn_exp2f(s0[r] + c); s1[r] = __builtin_amdgcn_exp2f(s1[r] + c); psum += s0[r] + s1[r]; }
                lsum += psum;
#pragma unroll
                for (int kt2 = 0; kt2 < 2; ++kt2)
#pragma unroll
                    for (int sp = 0; sp < 2; ++sp) {
                        v4u pw;
                        if (kt2 == 0) { pw.x = cvtpk_bf16(s0[8 * sp], s0[8 * sp + 1]); pw.y = cvtpk_bf16(s0[8 * sp + 2], s0[8 * sp + 3]); pw.z = cvtpk_bf16(s0[8 * sp + 4], s0[8 * sp + 5]); pw.w = cvtpk_bf16(s0[8 * sp + 6], s0[8 * sp + 7]); }
                        else          { pw.x = cvtpk_bf16(s1[8 * sp], s1[8 * sp + 1]); pw.y = cvtpk_bf16(s1[8 * sp + 2], s1[8 * sp + 3]); pw.z = cvtpk_bf16(s1[8 * sp + 4], s1[8 * sp + 5]); pw.w = cvtpk_bf16(s1[8 * sp + 6], s1[8 * sp + 7]); }
                        const bf16x8 pf = __builtin_bit_cast(bf16x8, pw);
#pragma unroll
                        for (int mt = 0; mt < 4; ++mt) {
                            LAS unsigned char* vp = lds + bo + voff + (32 * kt2 + 16 * sp) * AT_VP + 64 * mt;
                            const s16x4 lo = __builtin_bit_cast(s16x4, __builtin_amdgcn_ds_read_tr16_b64_v4i16((LAS v4i16_t*)vp));
                            const s16x4 hi4 = __builtin_bit_cast(s16x4, __builtin_amdgcn_ds_read_tr16_b64_v4i16((LAS v4i16_t*)(vp + 8 * AT_VP)));
                            const bf16x8 af = (bf16x8){lo[0], lo[1], lo[2], lo[3], hi4[0], hi4[1], hi4[2], hi4[3]};
                            o[mt] = __builtin_amdgcn_mfma_f32_32x32x16_bf16(af, pf, o[mt], 0, 0, 0);
                        }
                    }
            }
            if (j + 1 < NT) {
#pragma unroll
                for (int i = 0; i < 2; ++i) { *(LAS v4u*)(lds + bn + kdst + 32 * i * AT_KP) = krB[i]; *(LAS v4u*)(lds + bn + vdst + 32 * i * AT_VP) = vrB[i]; }
                if (j + 3 < NT) {
#pragma unroll
                    for (int i = 0; i < 2; ++i) { krB[i] = *(const GAS v4u*)(ksrc + (size_t)(64 * (j + 3) + 32 * i) * INW); vrB[i] = *(const GAS v4u*)(vsrc + (size_t)(64 * (j + 3) + 32 * i) * INW); }
                }
            }
            __syncthreads();
                  }
        }
        const float inv = 1.f / xhalf_sum(lsum);
        LAS float* XO = (LAS float*)(lds + AT_XO) + qt * 4096 + r32;
        if (map == 1) {
            const float sc = inv * lam;
#pragma unroll
            for (int mt = 0; mt < 4; ++mt)
#pragma unroll
                for (int r = 0; r < 16; ++r) XO[(32 * mt + (r & 3) + 8 * (r >> 2) + 4 * hi) * 32] = o[mt][r] * sc;
        }
        __syncthreads();
        if (map == 0) {
            float ss = 0.f;
#pragma unroll
            for (int mt = 0; mt < 4; ++mt)
#pragma unroll
                for (int r = 0; r < 16; ++r) { const float a = o[mt][r] * inv - XO[(32 * mt + (r & 3) + 8 * (r >> 2) + 4 * hi) * 32]; o[mt][r] = a; ss += a * a; }
            ss = xhalf_sum(ss);
            const float rr = (1.f - LAM_INIT) / sqrtf(ss * (1.f / 128.f) + EPS);
            LAS unsigned char* yb = lds + AT_YB + qt * (32 * AT_YP);
#pragma unroll
            for (int mt = 0; mt < 4; ++mt)
#pragma unroll
                for (int r4 = 0; r4 < 4; ++r4) { const int dv = 32 * mt + 8 * r4 + 4 * hi; const f32x4 gg = *(const GAS f32x4*)(F.in[7] + dv);
                    v2u w; w.x = cvtpk_bf16(o[mt][4 * r4] * rr * gg.x, o[mt][4 * r4 + 1] * rr * gg.y); w.y = cvtpk_bf16(o[mt][4 * r4 + 2] * rr * gg.z, o[mt][4 * r4 + 3] * rr * gg.w);
                    *(LAS v2u*)(yb + r32 * AT_YP + dv * 2) = w; }
            LDS_WAIT(); asm volatile("" ::: "memory");
            bf16* obase = MIXED + (tok0 + q0 + 32 * qt) * DM + h * 128;
#pragma unroll
            for (int i = 0; i < 8; ++i) { const int id = lane + 64 * i, row = id >> 4, cch = id & 15;
                const v4u w = *(const LAS v4u*)(yb + row * AT_YP + cch * 16); *(GAS v4u*)(obase + (size_t)row * DM + cch * 8) = w; }
        }
    }
}


constexpr int HG_P = 272, HG_KP = 80, HG_VP = 320;
constexpr int HG_QD = 0, HG_KI = 32 * HG_P, HG_KDT = 2 * 32 * HG_P, HG_V = HG_KDT + 128 * HG_KP, HG_CD = HG_V + 32 * HG_VP, HG_BUF = HG_CD + 512;
constexpr int HG_OA = 2 * HG_BUF, HG_OB = HG_OA + 32 * 128 * 4;
static_assert(HG_OB + 32 * 128 * 4 <= RING_BYTES, "hgrn LDS map");
__device__ __forceinline__ bf16x8 pack8(const f32x16& x, int s) {
    v4u p; p.x = cvtpk_bf16(x[8 * s], x[8 * s + 1]); p.y = cvtpk_bf16(x[8 * s + 2], x[8 * s + 3]); p.z = cvtpk_bf16(x[8 * s + 4], x[8 * s + 5]); p.w = cvtpk_bf16(x[8 * s + 6], x[8 * s + 7]);
    return __builtin_bit_cast(bf16x8, p);
}
__device__ __forceinline__ bf16x8 tr_pair(LAS unsigned char* p0, LAS unsigned char* p1) {
    const s16x4 lo = __builtin_bit_cast(s16x4, __builtin_amdgcn_ds_read_tr16_b64_v4i16((LAS v4i16_t*)p0));
    const s16x4 hi4 = __builtin_bit_cast(s16x4, __builtin_amdgcn_ds_read_tr16_b64_v4i16((LAS v4i16_t*)p1));
    return (bf16x8){lo[0], lo[1], lo[2], lo[3], hi4[0], hi4[1], hi4[2], hi4[3]};
}
__device__ __forceinline__ void hgrn_mfma(Frame& F) {
    const bf16* PROJ = (const bf16*)(F.ws + WS_PROJ); bf16* MIXED = (bf16*)(F.ws + WS_HN);
    const float* small = (const float*)(F.ws + WS_SMALL);
    LAS unsigned char* lds = F.lds;
    const int tid = F.tid, lane = F.lane, wave = F.wave, r32 = lane & 31, hh = lane >> 5;
    const int dvt = wave & 3, dkh = wave >> 2;
    const int pc = lane & 31, pdk8 = 16 * wave + 8 * (lane >> 5);
    const int kdoff = (((lane & 15) >> 2)) * HG_VP + (16 * ((lane >> 4) & 1) + 4 * (lane & 3)) * 2;
    const int vc = tid >> 4, vseg = tid & 15;
    const int troff = (((lane & 15) >> 2)) * HG_VP + (32 * dvt + 16 * ((lane >> 4) & 1) + 4 * (lane & 3)) * 2;
    for (int u = F.vcu; u < 64; u += F.G) {
        const int b = u >> 2, h = u & 3; const size_t tok0 = (size_t)b * SEQ;
        const f32x4 lbA = *(const GAS f32x4*)(small + SM_LB + h * 128 + pdk8), lbB = *(const GAS f32x4*)(small + SM_LB + h * 128 + pdk8 + 4);
        const float lbv[8] = {lbA.x, lbA.y, lbA.z, lbA.w, lbB.x, lbB.y, lbB.z, lbB.w};
        const f32x4 g0 = *(const GAS f32x4*)(F.in[10] + 8 * vseg), g1 = *(const GAS f32x4*)(F.in[10] + 8 * vseg + 4);
        f32x16 S0, S1;
#pragma unroll
        for (int r = 0; r < 16; ++r) { S0[r] = 0.f; S1[r] = 0.f; }
        v4u rqA, rfA, rqB, rfB, rvA, rgA, rvB, rgB;
#define HG_LOAD(S, chn) do { const bf16* p_ = PROJ + (tok0 + 32 * (chn) + pc) * INW + h * 128 + pdk8; \
            asm volatile("global_load_dwordx4 %0, %1, off" : "=v"(rq##S) : "v"(p_ + C_HQ) : "memory"); \
            asm volatile("global_load_dwordx4 %0, %1, off" : "=v"(rf##S) : "v"(p_ + C_HF) : "memory"); \
            asm volatile("global_load_dwordx4 %0, %1, off" : "=v"(rv##S) : "v"(PROJ + (tok0 + 32 * (chn) + vc) * INW + C_HI + h * 128 + vseg * 8) : "memory"); } while (0)
#define HG_LOADG(S, chn) do { asm volatile("global_load_dwordx4 %0, %1, off" : "=v"(rg##S) : "v"(PROJ + (tok0 + 32 * (chn) + vc) * INW + C_HG + h * 128 + vseg * 8) : "memory"); } while (0)
#define HG_WAIT_RAW(S) asm volatile("s_waitcnt vmcnt(7)" : "+v"(rq##S), "+v"(rf##S), "+v"(rv##S) :: "memory")
#define HG_WAIT_G(S) asm volatile("s_waitcnt vmcnt(8)" : "+v"(rg##S) :: "memory")
        HG_LOAD(A, 0); HG_LOADG(A, 0); HG_LOAD(B, 1); HG_LOADG(B, 1);
        asm volatile("s_waitcnt vmcnt(0)" : "+v"(rvA), "+v"(rgA), "+v"(rvB), "+v"(rgB) :: "memory");
        __syncthreads();
        for (int ch2 = 0; ch2 < SEQ / 32; ch2 += 2) {
          { const int ch = ch2;
            LAS unsigned char* bufp = lds + (ch & 1) * HG_BUF;
            HG_WAIT_RAW(A);
            { float bb[8], fv[8];
              const unsigned fw[4] = {rfA.x, rfA.y, rfA.z, rfA.w}, qw[4] = {rqA.x, rqA.y, rqA.z, rqA.w};
#pragma unroll
              for (int i = 0; i < 8; ++i) { const float x = (i & 1) ? bfhi(fw[i >> 1]) : bflo(fw[i >> 1]); const float f = lbv[i] + (1.f - lbv[i]) * __builtin_amdgcn_rcpf(1.f + __expf(-x)); fv[i] = f; bb[i] = f; }
#pragma unroll
              for (int i = 0; i < 8; ++i) { float x = bb[i];
                  x *= __builtin_bit_cast(float, __builtin_amdgcn_update_dpp(0x3f800000, __builtin_bit_cast(int, x), 0x111, 0xf, 0xf, false));
                  x *= __builtin_bit_cast(float, __builtin_amdgcn_update_dpp(0x3f800000, __builtin_bit_cast(int, x), 0x112, 0xf, 0xf, false));
                  x *= __builtin_bit_cast(float, __builtin_amdgcn_update_dpp(0x3f800000, __builtin_bit_cast(int, x), 0x114, 0xf, 0xf, false));
                  x *= __builtin_bit_cast(float, __builtin_amdgcn_update_dpp(0x3f800000, __builtin_bit_cast(int, x), 0x118, 0xf, 0xf, false));
                  x *= __builtin_bit_cast(float, __builtin_amdgcn_update_dpp(0x3f800000, __builtin_bit_cast(int, x), 0x142, 0xa, 0xf, false));
                  bb[i] = x; }
              float qd[8], ki[8], kd[8], cdv[8];
#pragma unroll
              for (int i = 0; i < 8; ++i) { const float elast = __shfl(bb[i], (lane & 32) + 31);
                  const float e = bb[i], ei = __builtin_amdgcn_rcpf(bb[i]), ed = elast * ei;
                  const float xq = (i & 1) ? bfhi(qw[i >> 1]) : bflo(qw[i >> 1]); const float q = xq * __builtin_amdgcn_rcpf(1.f + __expf(-xq)); const float k = 1.f - fv[i];
                  qd[i] = q * e; ki[i] = k * ei; kd[i] = k * ed; cdv[i] = elast; }
              *(LAS v4u*)(bufp + HG_QD + pc * HG_P + pdk8 * 2) = (v4u){cvtpk_bf16(qd[0], qd[1]), cvtpk_bf16(qd[2], qd[3]), cvtpk_bf16(qd[4], qd[5]), cvtpk_bf16(qd[6], qd[7])};
              *(LAS v4u*)(bufp + HG_KI + pc * HG_P + pdk8 * 2) = (v4u){cvtpk_bf16(ki[0], ki[1]), cvtpk_bf16(ki[2], ki[3]), cvtpk_bf16(ki[4], ki[5]), cvtpk_bf16(ki[6], ki[7])};
              *(LAS v4u*)(bufp + HG_KDT + pc * HG_VP + pdk8 * 2) = (v4u){cvtpk_bf16(kd[0], kd[1]), cvtpk_bf16(kd[2], kd[3]), cvtpk_bf16(kd[4], kd[5]), cvtpk_bf16(kd[6], kd[7])};
              if (pc == 31) { *(LAS f32x4*)(bufp + HG_CD + pdk8 * 4) = (f32x4){cdv[0], cdv[1], cdv[2], cdv[3]}; *(LAS f32x4*)(bufp + HG_CD + pdk8 * 4 + 16) = (f32x4){cdv[4], cdv[5], cdv[6], cdv[7]}; }
              *(LAS v4u*)(bufp + HG_V + vc * HG_VP + vseg * 16) = rvA; }
            HG_LOAD(A, (ch + 2 < SEQ / 32 ? ch + 2 : SEQ / 32 - 1));
            __syncthreads();
            f32x16 o;
#pragma unroll
            for (int r = 0; r < 16; ++r) o[r] = 0.f;
#pragma unroll
            for (int kk = 0; kk < 2; ++kk)
#pragma unroll
                for (int s2 = 0; s2 < 2; ++s2) {
                    LAS unsigned char* qa = bufp + HG_QD + r32 * HG_P + (32 * (2 * dkh + kk) + 16 * s2 + 4 * hh) * 2;
                    const v2u a0 = *(const LAS v2u*)qa, a1 = *(const LAS v2u*)(qa + 16);
                    const bf16x8 af = __builtin_bit_cast(bf16x8, (v4u){a0.x, a0.y, a1.x, a1.y});
                    o = __builtin_amdgcn_mfma_f32_32x32x16_bf16(af, pack8(kk == 0 ? S0 : S1, s2), o, 0, 0, 0);
                }
            if (wave < 4) {
                f32x16 X;
#pragma unroll
                for (int r = 0; r < 16; ++r) X[r] = 0.f;
#pragma unroll
                for (int s8 = 0; s8 < 8; ++s8) {
                    const bf16x8 af = *(const LAS bf16x8*)(bufp + HG_KI + r32 * HG_P + (16 * s8 + 8 * hh) * 2);
                    const bf16x8 bfr = *(const LAS bf16x8*)(bufp + HG_QD + r32 * HG_P + (16 * s8 + 8 * hh) * 2);
                    X = __builtin_amdgcn_mfma_f32_32x32x16_bf16(af, bfr, X, 0, 0, 0);
                }
#pragma unroll
                for (int r = 0; r < 16; ++r) { const int cp = (r & 3) + 8 * (r >> 2) + 4 * hh; X[r] = cp > r32 ? 0.f : X[r]; }
#pragma unroll
                for (int s2 = 0; s2 < 2; ++s2) {
                    LAS unsigned char* vp = bufp + HG_V + troff + (16 * s2 + 4 * hh) * HG_VP;
                    o = __builtin_amdgcn_mfma_f32_32x32x16_bf16(pack8(X, s2), tr_pair(vp, vp + 8 * HG_VP), o, 0, 0, 0);
                }
            }
            { LAS float* ob = (LAS float*)(lds + (wave < 4 ? HG_OA : HG_OB)) + 32 * dvt + r32;
#pragma unroll
              for (int r = 0; r < 16; ++r) ob[((r & 3) + 8 * (r >> 2) + 4 * hh) * 128] = o[r]; }
#pragma unroll
            for (int kk = 0; kk < 2; ++kk) {
                const int dk0 = 32 * (2 * dkh + kk);
                const LAS float* cdp = (const LAS float*)(bufp + HG_CD) + dk0 + 4 * hh;
#pragma unroll
                for (int r4 = 0; r4 < 4; ++r4) { const f32x4 c4 = *(const LAS f32x4*)(cdp + 8 * r4);
                    if (kk == 0) { S0[4 * r4] *= c4.x; S0[4 * r4 + 1] *= c4.y; S0[4 * r4 + 2] *= c4.z; S0[4 * r4 + 3] *= c4.w; }
                    else         { S1[4 * r4] *= c4.x; S1[4 * r4 + 1] *= c4.y; S1[4 * r4 + 2] *= c4.z; S1[4 * r4 + 3] *= c4.w; } }
#pragma unroll
                for (int s2 = 0; s2 < 2; ++s2) {
                    LAS unsigned char* kp = bufp + HG_KDT + kdoff + (16 * s2 + 8 * hh) * HG_VP + dk0 * 2;
                    const bf16x8 af = tr_pair(kp, kp + 4 * HG_VP);
                    LAS unsigned char* vp = bufp + HG_V + troff + (16 * s2 + 8 * hh) * HG_VP;
                    const bf16x8 bfr = tr_pair(vp, vp + 4 * HG_VP);
                    if (kk == 0) S0 = __builtin_amdgcn_mfma_f32_32x32x16_bf16(af, bfr, S0, 0, 0, 0);
                    else         S1 = __builtin_amdgcn_mfma_f32_32x32x16_bf16(af, bfr, S1, 0, 0, 0);
                }
            }
            __syncthreads();
            { const LAS float* oa = (const LAS float*)(lds + HG_OA) + vc * 128 + 8 * vseg; const LAS float* ob = (const LAS float*)(lds + HG_OB) + vc * 128 + 8 * vseg;
              const f32x4 x0 = *(const LAS f32x4*)oa + *(const LAS f32x4*)ob, x1 = *(const LAS f32x4*)(oa + 4) + *(const LAS f32x4*)(ob + 4);
              float ss = (x0.x * x0.x + x0.y * x0.y) + (x0.z * x0.z + x0.w * x0.w) + (x1.x * x1.x + x1.y * x1.y) + (x1.z * x1.z + x1.w * x1.w);
              ss += __shfl_xor(ss, 1); ss += __shfl_xor(ss, 2); ss += __shfl_xor(ss, 4); ss += __shfl_xor(ss, 8);
              const float rr = __builtin_amdgcn_rsqf(ss * (1.f / 128.f) + EPS);
              const size_t tok = tok0 + 32 * ch + vc;
              HG_WAIT_G(A);
              const unsigned ga[4] = {rgA.x, rgA.y, rgA.z, rgA.w};
              const float ov[8] = {x0.x, x0.y, x0.z, x0.w, x1.x, x1.y, x1.z, x1.w}; const float gg[8] = {g0.x, g0.y, g0.z, g0.w, g1.x, g1.y, g1.z, g1.w};
              unsigned w[4];
#pragma unroll
              for (int j = 0; j < 4; ++j) { const float a0 = bflo(ga[j]), a1 = bfhi(ga[j]);
                  w[j] = cvtpk_bf16(ov[2 * j] * rr * gg[2 * j] * (a0 * __builtin_amdgcn_rcpf(1.f + __expf(-a0))), ov[2 * j + 1] * rr * gg[2 * j + 1] * (a1 * __builtin_amdgcn_rcpf(1.f + __expf(-a1)))); }
              *(GAS v4u*)(MIXED + tok * DM + 512 + h * 128 + 8 * vseg) = (v4u){w[0], w[1], w[2], w[3]}; }
            HG_LOADG(A, (ch + 2 < SEQ / 32 ? ch + 2 : SEQ / 32 - 1));
          }
          { const int ch = ch2 + 1;
            LAS unsigned char* bufp = lds + (ch & 1) * HG_BUF;
            HG_WAIT_RAW(B);
            { float bb[8], fv[8];
              const unsigned fw[4] = {rfB.x, rfB.y, rfB.z, rfB.w}, qw[4] = {rqB.x, rqB.y, rqB.z, rqB.w};
#pragma unroll
              for (int i = 0; i < 8; ++i) { const float x = (i & 1) ? bfhi(fw[i >> 1]) : bflo(fw[i >> 1]); const float f = lbv[i] + (1.f - lbv[i]) * __builtin_amdgcn_rcpf(1.f + __expf(-x)); fv[i] = f; bb[i] = f; }
#pragma unroll
              for (int i = 0; i < 8; ++i) { float x = bb[i];
                  x *= __builtin_bit_cast(float, __builtin_amdgcn_update_dpp(0x3f800000, __builtin_bit_cast(int, x), 0x111, 0xf, 0xf, false));
                  x *= __builtin_bit_cast(float, __builtin_amdgcn_update_dpp(0x3f800000, __builtin_bit_cast(int, x), 0x112, 0xf, 0xf, false));
                  x *= __builtin_bit_cast(float, __builtin_amdgcn_update_dpp(0x3f800000, __builtin_bit_cast(int, x), 0x114, 0xf, 0xf, false));
                  x *= __builtin_bit_cast(float, __builtin_amdgcn_update_dpp(0x3f800000, __builtin_bit_cast(int, x), 0x118, 0xf, 0xf, false));
                  x *= __builtin_bit_cast(float, __builtin_amdgcn_update_dpp(0x3f800000, __builtin_bit_cast(int, x), 0x142, 0xa, 0xf, false));
                  bb[i] = x; }
              float qd[8], ki[8], kd[8], cdv[8];
#pragma unroll
              for (int i = 0; i < 8; ++i) { const float elast = __shfl(bb[i], (lane & 32) + 31);
                  const float e = bb[i], ei = __builtin_amdgcn_rcpf(bb[i]), ed = elast * ei;
                  const float xq = (i & 1) ? bfhi(qw[i >> 1]) : bflo(qw[i >> 1]); const float q = xq * __builtin_amdgcn_rcpf(1.f + __expf(-xq)); const float k = 1.f - fv[i];
                  qd[i] = q * e; ki[i] = k * ei; kd[i] = k * ed; cdv[i] = elast; }
              *(LAS v4u*)(bufp + HG_QD + pc * HG_P + pdk8 * 2) = (v4u){cvtpk_bf16(qd[0], qd[1]), cvtpk_bf16(qd[2], qd[3]), cvtpk_bf16(qd[4], qd[5]), cvtpk_bf16(qd[6], qd[7])};
              *(LAS v4u*)(bufp + HG_KI + pc * HG_P + pdk8 * 2) = (v4u){cvtpk_bf16(ki[0], ki[1]), cvtpk_bf16(ki[2], ki[3]), cvtpk_bf16(ki[4], ki[5]), cvtpk_bf16(ki[6], ki[7])};
              *(LAS v4u*)(bufp + HG_KDT + pc * HG_VP + pdk8 * 2) = (v4u){cvtpk_bf16(kd[0], kd[1]), cvtpk_bf16(kd[2], kd[3]), cvtpk_bf16(kd[4], kd[5]), cvtpk_bf16(kd[6], kd[7])};
              if (pc == 31) { *(LAS f32x4*)(bufp + HG_CD + pdk8 * 4) = (f32x4){cdv[0], cdv[1], cdv[2], cdv[3]}; *(LAS f32x4*)(bufp + HG_CD + pdk8 * 4 + 16) = (f32x4){cdv[4], cdv[5], cdv[6], cdv[7]}; }
              *(LAS v4u*)(bufp + HG_V + vc * HG_VP + vseg * 16) = rvB; }
            HG_LOAD(B, (ch + 2 < SEQ / 32 ? ch + 2 : SEQ / 32 - 1));
            __syncthreads();
            f32x16 o;
#pragma unroll
            for (int r = 0; r < 16; ++r) o[r] = 0.f;
#pragma unroll
            for (int kk = 0; kk < 2; ++kk)
#pragma unroll
                for (int s2 = 0; s2 < 2; ++s2) {
                    LAS unsigned char* qa = bufp + HG_QD + r32 * HG_P + (32 * (2 * dkh + kk) + 16 * s2 + 4 * hh) * 2;
                    const v2u a0 = *(const LAS v2u*)qa, a1 = *(const LAS v2u*)(qa + 16);
                    const bf16x8 af = __builtin_bit_cast(bf16x8, (v4u){a0.x, a0.y, a1.x, a1.y});
                    o = __builtin_amdgcn_mfma_f32_32x32x16_bf16(af, pack8(kk == 0 ? S0 : S1, s2), o, 0, 0, 0);
                }
            if (wave < 4) {
                f32x16 X;
#pragma unroll
                for (int r = 0; r < 16; ++r) X[r] = 0.f;
#pragma unroll
                for (int s8 = 0; s8 < 8; ++s8) {
                    const bf16x8 af = *(const LAS bf16x8*)(bufp + HG_KI + r32 * HG_P + (16 * s8 + 8 * hh) * 2);
                    const bf16x8 bfr = *(const LAS bf16x8*)(bufp + HG_QD + r32 * HG_P + (16 * s8 + 8 * hh) * 2);
                    X = __builtin_amdgcn_mfma_f32_32x32x16_bf16(af, bfr, X, 0, 0, 0);
                }
#pragma unroll
                for (int r = 0; r < 16; ++r) { const int cp = (r & 3) + 8 * (r >> 2) + 4 * hh; X[r] = cp > r32 ? 0.f : X[r]; }
#pragma unroll
                for (int s2 = 0; s2 < 2; ++s2) {
                    LAS unsigned char* vp = bufp + HG_V + troff + (16 * s2 + 4 * hh) * HG_VP;
                    o = __builtin_amdgcn_mfma_f32_32x32x16_bf16(pack8(X, s2), tr_pair(vp, vp + 8 * HG_VP), o, 0, 0, 0);
                }
            }
            { LAS float* ob = (LAS float*)(lds + (wave < 4 ? HG_OA : HG_OB)) + 32 * dvt + r32;
#pragma unroll
              for (int r = 0; r < 16; ++r) ob[((r & 3) + 8 * (r >> 2) + 4 * hh) * 128] = o[r]; }
#pragma unroll
            for (int kk = 0; kk < 2; ++kk) {
                const int dk0 = 32 * (2 * dkh + kk);
                const LAS float* cdp = (const LAS float*)(bufp + HG_CD) + dk0 + 4 * hh;
#pragma unroll
                for (int r4 = 0; r4 < 4; ++r4) { const f32x4 c4 = *(const LAS f32x4*)(cdp + 8 * r4);
                    if (kk == 0) { S0[4 * r4] *= c4.x; S0[4 * r4 + 1] *= c4.y; S0[4 * r4 + 2] *= c4.z; S0[4 * r4 + 3] *= c4.w; }
                    else         { S1[4 * r4] *= c4.x; S1[4 * r4 + 1] *= c4.y; S1[4 * r4 + 2] *= c4.z; S1[4 * r4 + 3] *= c4.w; } }
#pragma unroll
                for (int s2 = 0; s2 < 2; ++s2) {
                    LAS unsigned char* kp = bufp + HG_KDT + kdoff + (16 * s2 + 8 * hh) * HG_VP + dk0 * 2;
                    const bf16x8 af = tr_pair(kp, kp + 4 * HG_VP);
                    LAS unsigned char* vp = bufp + HG_V + troff + (16 * s2 + 8 * hh) * HG_VP;
                    const bf16x8 bfr = tr_pair(vp, vp + 4 * HG_VP);
                    if (kk == 0) S0 = __builtin_amdgcn_mfma_f32_32x32x16_bf16(af, bfr, S0, 0, 0, 0);
                    else         S1 = __builtin_amdgcn_mfma_f32_32x32x16_bf16(af, bfr, S1, 0, 0, 0);
                }
            }
            __syncthreads();
            { const LAS float* oa = (const LAS float*)(lds + HG_OA) + vc * 128 + 8 * vseg; const LAS float* ob = (const LAS float*)(lds + HG_OB) + vc * 128 + 8 * vseg;
              const f32x4 x0 = *(const LAS f32x4*)oa + *(const LAS f32x4*)ob, x1 = *(const LAS f32x4*)(oa + 4) + *(const LAS f32x4*)(ob + 4);
              float ss = (x0.x * x0.x + x0.y * x0.y) + (x0.z * x0.z + x0.w * x0.w) + (x1.x * x1.x + x1.y * x1.y) + (x1.z * x1.z + x1.w * x1.w);
              ss += __shfl_xor(ss, 1); ss += __shfl_xor(ss, 2); ss += __shfl_xor(ss, 4); ss += __shfl_xor(ss, 8);
              const float rr = __builtin_amdgcn_rsqf(ss * (1.f / 128.f) + EPS);
              const size_t tok = tok0 + 32 * ch + vc;
              HG_WAIT_G(B);
              const unsigned ga[4] = {rgB.x, rgB.y, rgB.z, rgB.w};
              const float ov[8] = {x0.x, x0.y, x0.z, x0.w, x1.x, x1.y, x1.z, x1.w}; const float gg[8] = {g0.x, g0.y, g0.z, g0.w, g1.x, g1.y, g1.z, g1.w};
              unsigned w[4];
#pragma unroll
              for (int j = 0; j < 4; ++j) { const float a0 = bflo(ga[j]), a1 = bfhi(ga[j]);
                  w[j] = cvtpk_bf16(ov[2 * j] * rr * gg[2 * j] * (a0 * __builtin_amdgcn_rcpf(1.f + __expf(-a0))), ov[2 * j + 1] * rr * gg[2 * j + 1] * (a1 * __builtin_amdgcn_rcpf(1.f + __expf(-a1)))); }
              *(GAS v4u*)(MIXED + tok * DM + 512 + h * 128 + 8 * vseg) = (v4u){w[0], w[1], w[2], w[3]}; }
            HG_LOADG(B, (ch + 2 < SEQ / 32 ? ch + 2 : SEQ / 32 - 1));
          }
        }
#undef HG_LOAD
#undef HG_LOADG
#undef HG_WAIT_RAW
#undef HG_WAIT_G
    }
}

template <int N> __device__ __forceinline__ unsigned row_ror(unsigned x) { return (unsigned)__builtin_amdgcn_update_dpp((int)x, (int)x, 0x120 + N, 0xf, 0xf, false); }
__device__ __forceinline__ unsigned umax_(unsigned a, unsigned b) { return a > b ? a : b; }
__device__ __forceinline__ unsigned umin_(unsigned a, unsigned b) { return a < b ? a : b; }
__device__ __forceinline__ unsigned row_umax16(unsigned x) {
    unsigned y;
    asm volatile("s_nop 1\n\tv_max_u32_dpp %0, %1, %1 row_ror:1 row_mask:0xf bank_mask:0xf\n\t"
                 "s_nop 1\n\tv_max_u32_dpp %0, %0, %0 row_ror:2 row_mask:0xf bank_mask:0xf\n\t"
                 "s_nop 1\n\tv_max_u32_dpp %0, %0, %0 row_ror:4 row_mask:0xf bank_mask:0xf\n\t"
                 "s_nop 1\n\tv_max_u32_dpp %0, %0, %0 row_ror:8 row_mask:0xf bank_mask:0xf"
                 : "=&v"(y) : "v"(x));
    return y;
}
__device__ __forceinline__ float row_fsum16(float v) {
    v += __builtin_bit_cast(float, row_ror<1>(__builtin_bit_cast(unsigned, v))); v += __builtin_bit_cast(float, row_ror<2>(__builtin_bit_cast(unsigned, v)));
    v += __builtin_bit_cast(float, row_ror<4>(__builtin_bit_cast(unsigned, v))); v += __builtin_bit_cast(float, row_ror<8>(__builtin_bit_cast(unsigned, v))); return v; }
__device__ __forceinline__ unsigned h2key(unsigned x) { return (x & 0x80000000u) ? (~x & 0xffff0000u) : (x | 0x80000000u); }
__device__ __forceinline__ float hkey2f(unsigned k) { const unsigned hb = ((k & 0x80000000u) ? (k & 0x7fff0000u) : (~k & 0xffff0000u)) >> 16; return (float)__builtin_bit_cast(_Float16, (unsigned short)hb); }
__device__ __forceinline__ unsigned f2key(float f) { const unsigned u = __builtin_bit_cast(unsigned, f); return (u & 0x80000000u) ? ~u : (u | 0x80000000u); }
__device__ __forceinline__ float key2f(unsigned k) { const unsigned u = (k & 0x80000000u) ? (k & 0x7fffffffu) : ~k; return __builtin_bit_cast(float, u); }
__device__ __forceinline__ unsigned pair_code(int s) {
    if (s < 16) return (unsigned)s;
    if (s < 24) return 16u + (unsigned)(s - 16);
    if (s < 29) return 32u + (unsigned)(s - 24);
    if (s < 33) return 48u + (unsigned)(s - 29);
    if (s < 36) return 64u + (unsigned)(s - 33);
    if (s < 42) return 80u + 16u * (unsigned)((s - 36) >> 1) + (unsigned)((s - 36) & 1);
    if (s < 50) return 128u + 16u * (unsigned)(s - 42);
    return 0xFFu;
}
#define CAS_(a, b) do { const unsigned hi_ = umax_(a, b), lo_ = umin_(a, b); a = hi_; b = lo_; } while (0)
__device__ __forceinline__ void row_umax16_x2(unsigned xa, unsigned xb, unsigned& ya, unsigned& yb) {
    asm volatile("s_nop 1\n\tv_max_u32_dpp %0, %2, %2 row_ror:1 row_mask:0xf bank_mask:0xf\n\tv_max_u32_dpp %1, %3, %3 row_ror:1 row_mask:0xf bank_mask:0xf\n\t"
                 "s_nop 0\n\tv_max_u32_dpp %0, %0, %0 row_ror:2 row_mask:0xf bank_mask:0xf\n\tv_max_u32_dpp %1, %1, %1 row_ror:2 row_mask:0xf bank_mask:0xf\n\t"
                 "s_nop 0\n\tv_max_u32_dpp %0, %0, %0 row_ror:4 row_mask:0xf bank_mask:0xf\n\tv_max_u32_dpp %1, %1, %1 row_ror:4 row_mask:0xf bank_mask:0xf\n\t"
                 "s_nop 0\n\tv_max_u32_dpp %0, %0, %0 row_ror:8 row_mask:0xf bank_mask:0xf\n\tv_max_u32_dpp %1, %1, %1 row_ror:8 row_mask:0xf bank_mask:0xf"
                 : "=&v"(ya), "=&v"(yb) : "v"(xa), "v"(xb));
}
#define TK_LOADSORT(P, th_) \
    unsigned P##0, P##1, P##2, P##3, P##4, P##5, P##6, P##7; \
    { const v4u sv = *(const GAS v4u*)(SC + (size_t)((th_) >> 3) * 2048 + ((th_) & 7) * 256 + c * 128 + l15 * 8); const unsigned nb = 127u - 8u * (unsigned)l15; \
      P##0 = h2key(sv.x << 16) | nb; P##1 = h2key(sv.x & 0xffff0000u) | (nb - 1u); P##2 = h2key(sv.y << 16) | (nb - 2u); P##3 = h2key(sv.y & 0xffff0000u) | (nb - 3u); \
      P##4 = h2key(sv.z << 16) | (nb - 4u); P##5 = h2key(sv.z & 0xffff0000u) | (nb - 5u); P##6 = h2key(sv.w << 16) | (nb - 6u); P##7 = h2key(sv.w & 0xffff0000u) | (nb - 7u); \
      CAS_(P##0, P##1); CAS_(P##2, P##3); CAS_(P##4, P##5); CAS_(P##6, P##7); CAS_(P##0, P##2); CAS_(P##1, P##3); CAS_(P##4, P##6); CAS_(P##5, P##7); CAS_(P##1, P##2); CAS_(P##5, P##6); CAS_(P##0, P##4); CAS_(P##3, P##7); \
      CAS_(P##1, P##5); CAS_(P##2, P##6); CAS_(P##1, P##4); CAS_(P##3, P##6); CAS_(P##2, P##4); CAS_(P##3, P##5); CAS_(P##3, P##4); }
#define TK_POP(P, m_) do { const bool pop_ = (P##0 == (m_)); P##0 = pop_ ? P##1 : P##0; P##1 = pop_ ? P##2 : P##1; P##2 = pop_ ? P##3 : P##2; P##3 = pop_ ? P##4 : P##3; \
      P##4 = pop_ ? P##5 : P##4; P##5 = pop_ ? P##6 : P##5; P##6 = pop_ ? P##7 : P##6; P##7 = pop_ ? 0u : P##7; } while (0)
__device__ __forceinline__ void topk_stage1x2(const unsigned short* SC, int thA, int thB, int c, int l15, unsigned& resA, unsigned& resB) {
    TK_LOADSORT(ka, thA) TK_LOADSORT(kb, thB)
    unsigned ra = 0u, rb = 0u;
#pragma unroll
    for (int r = 0; r < 16; ++r) {
        unsigned ma, mb; row_umax16_x2(ka0, kb0, ma, mb);
        TK_POP(ka, ma); TK_POP(kb, mb);
        ra = (l15 == r) ? ma : ra; rb = (l15 == r) ? mb : rb;
    }
    resA = ra; resB = rb;
}
__device__ __forceinline__ void topk_v2(Frame& F) {
    const unsigned short* SC = (const unsigned short*)(F.ws + WS_SC); int* IDX = (int*)(F.ws + WS_IDX); float* GATE = (float*)(F.ws + WS_GATE); float* GSU = (float*)(F.ws + WS_GSU);
    const float* SU = (const float*)(F.ws + WS_SU); const float* SV = (const float*)(F.ws + WS_SV);
    const int gw = F.vcu * NWAVES + F.wave, NGW = F.G * NWAVES, lane = F.lane, l15 = lane & 15, row = lane >> 4, c = row & 1, rbase = lane & 48;
    const unsigned pc0 = pair_code(l15), pc1 = pair_code(l15 + 16), pc2 = pair_code(l15 + 32), pc3 = pair_code(l15 + 48);
    const int src1 = l15 + 32 * (row & 1), src2 = src1 + 16;
    for (int it0 = gw * 32; it0 < NTOK * 2; it0 += NGW * 32)
    for (int it = it0; it < it0 + 32; ++it) {
        const int thb = 4 * it;
        unsigned resA, resB; topk_stage1x2(SC, thb + (row >> 1), thb + 2 + (row >> 1), c, l15, resA, resB);
        const unsigned a1 = (unsigned)__shfl((int)resA, src1), a2 = (unsigned)__shfl((int)resA, src2), b1 = (unsigned)__shfl((int)resB, src1), b2 = (unsigned)__shfl((int)resB, src2);
        const unsigned S1 = row < 2 ? a1 : b1, S2 = row < 2 ? a2 : b2;
        unsigned c0, c1, c2, c3;
#define TK_CAND(CK, PC) do { const unsigned ka_ = (unsigned)__shfl((int)S1, rbase + (int)((PC) >> 4 & 15u)), kb_ = (unsigned)__shfl((int)S2, rbase + (int)((PC) & 15u)); \
            const float sm_ = hkey2f(ka_) + hkey2f(kb_); CK = (PC) == 0xFFu ? 0u : ((f2key(sm_) & ~0xFFu) | (255u - (PC))); } while (0)
        TK_CAND(c0, pc0); TK_CAND(c1, pc1); TK_CAND(c2, pc2); TK_CAND(c3, pc3);
#undef TK_CAND
        CAS_(c0, c1); CAS_(c2, c3); CAS_(c0, c2); CAS_(c1, c3); CAS_(c1, c2);
        unsigned res2 = 0u;
#pragma unroll
        for (int r = 0; r < 16; ++r) {
            const unsigned m = row_umax16(c0); const bool pop = (c0 == m);
            c0 = pop ? c1 : c0; c1 = pop ? c2 : c1; c2 = pop ? c3 : c2; c3 = pop ? 0u : c3;
            res2 = (l15 == r) ? m : res2;
        }
        const unsigned code = 255u - (res2 & 0xFFu);
        const unsigned ka = (unsigned)__shfl((int)S1, rbase + (int)(code >> 4 & 15u)), kb = (unsigned)__shfl((int)S2, rbase + (int)(code & 15u));
        const float ts = hkey2f(ka) + hkey2f(kb);
        const int e = (int)((127u - (ka & 0x7Fu)) * 128u + (127u - (kb & 0x7Fu)));
        const float tmax = __builtin_bit_cast(float, (unsigned)__shfl((int)__builtin_bit_cast(unsigned, ts), rbase));
        const float ex = __expf(ts - tmax);
        const float sum = row_fsum16(ex);
        const int th = thb + row;
        const size_t o = (size_t)(th >> 3) * NEXP_SEL + (th & 7) * 16 + l15;
        IDX[o] = e; GATE[o] = ex / sum * SV[e]; GSU[o] = SU[e];
    }
}

constexpr int PG_TOK = 16;
constexpr int PG_IDX = 0, PG_HID = 4096, PG_SA = PG_HID + 8192, PG_TB = PG_SA + 64, PG_WB = PG_TB + 4096;
static_assert(PG_WB % 16 == 0 && PG_TB % 16 == 0 && NWAVES * PG_WB <= RING_BYTES, "gather LDS map");
__device__ __forceinline__ void peer_sliced(Frame& F) {
    const unsigned char* U8T = F.ws + WS_U8; const unsigned char* V8T = F.ws + WS_V8; const unsigned char* X8 = F.ws + WS_X8;
    const float* SSQ = (const float*)(F.ws + WS_CTL) + CW_SSQ;
    const int* IDX = (const int*)(F.ws + WS_IDX); const float* GATE = (const float*)(F.ws + WS_GATE); const float* GSU = (const float*)(F.ws + WS_GSU); const float* gf = F.in[17];
    bf16* PO = (bf16*)(F.ws + WS_PO); const bf16* HB = (const bf16*)(F.ws + WS_HN2);
    const int gw = F.vcu * NWAVES + F.wave, NGW = F.G * NWAVES, lane = F.lane, m = lane & 15, g = lane >> 4;
    const int row8 = lane >> 3, piece = lane & 7;
    LAS unsigned char* wb = F.lds + F.wave * PG_WB;
    LAS unsigned short* idxs = (LAS unsigned short*)(wb + PG_IDX);
    LAS float* hid = (LAS float*)(wb + PG_HID);
    LAS float* sqp = hid + 64 + lane;
    LAS float* sai = (LAS float*)(wb + PG_SA);
    LAS unsigned char* tb = wb + PG_TB;
    const int p8 = m & 7; const unsigned bsh = 8u * (unsigned)(p8 & 3); const bool bhi = (p8 >> 2) != 0;
    constexpr size_t SLICE = (size_t)16384 * 128;
    const int usw = 16 * (piece ^ ((row8 >> 1) & 3));
    const int urd0 = m * 128 + 16 * ((2 * g) ^ ((m >> 1) & 7)), urd1 = m * 128 + 16 * ((2 * g + 1) ^ ((m >> 1) & 7));
    for (int blk = gw; blk < NTOK / PG_TOK; blk += NGW) {
        const int t0 = blk * PG_TOK;
#pragma unroll
        for (int k = 0; k < 32; ++k) { const int id = lane + 64 * k; idxs[id] = (unsigned short)IDX[(size_t)t0 * NEXP_SEL + id]; }
        LDS_WAIT(); asm volatile("" ::: "memory");
        for (int p = 0; p < 8; ++p) {
            const unsigned char* Up = U8T + (size_t)p * SLICE;
            const unsigned char* Xp = X8 + (size_t)t0 * DM + 128 * p + 32 * g;
            v4u ab[2][16]; l2 xs[2][2];
#define PGU_ISSUE(i_, buf_) do { _Pragma("unroll") for (int k = 0; k < 16; ++k) { const unsigned e = idxs[(i_) * 128 + 8 * k + row8]; \
                ab[buf_][k] = *(const GAS v4u*)(Up + (size_t)e * 128 + (usw ^ ((k & 1) ? 64 : 0))); } \
                xs[buf_][0] = *(const GAS l2*)(Xp + (size_t)(i_) * DM); xs[buf_][1] = *(const GAS l2*)(Xp + (size_t)(i_) * DM + 16); } while (0)
#define PGU_BODY(i_, cur_, nxt_) do { if ((i_) + 1 < PG_TOK) PGU_ISSUE((i_) + 1, nxt_); SCHED_FENCE(); \
                _Pragma("unroll") for (int rb = 0; rb < 4; ++rb) { LAS f32x4* hp0 = (LAS f32x4*)(hid + (i_) * 128 + 32 * rb + 4 * g); LAS f32x4* hp1 = hp0 + 4; \
                    _Pragma("unroll") for (int q4 = 0; q4 < 4; ++q4) *(LAS v4u*)(tb + 1024 * q4 + 16 * lane) = ab[cur_][4 * rb + q4]; \
                    f32x4 acc0 = p == 0 ? (f32x4){0.f, 0.f, 0.f, 0.f} : *hp0, acc1 = p == 0 ? (f32x4){0.f, 0.f, 0.f, 0.f} : *hp1; \
                    const l2 a0 = *(const LAS l2*)(tb + urd0), a1 = *(const LAS l2*)(tb + urd1), b0 = *(const LAS l2*)(tb + 2048 + urd0), b1 = *(const LAS l2*)(tb + 2048 + urd1); \
                    acc0 = __builtin_amdgcn_mfma_f32_16x16x32_fp8_bf8(a0.x, xs[cur_][0].x, acc0, 0, 0, 0); acc1 = __builtin_amdgcn_mfma_f32_16x16x32_fp8_bf8(b0.x, xs[cur_][0].x, acc1, 0, 0, 0); \
                    acc0 = __builtin_amdgcn_mfma_f32_16x16x32_fp8_bf8(a0.y, xs[cur_][0].y, acc0, 0, 0, 0); acc1 = __builtin_amdgcn_mfma_f32_16x16x32_fp8_bf8(b0.y, xs[cur_][0].y, acc1, 0, 0, 0); \
                    acc0 = __builtin_amdgcn_mfma_f32_16x16x32_fp8_bf8(a1.x, xs[cur_][1].x, acc0, 0, 0, 0); acc1 = __builtin_amdgcn_mfma_f32_16x16x32_fp8_bf8(b1.x, xs[cur_][1].x, acc1, 0, 0, 0); \
                    acc0 = __builtin_amdgcn_mfma_f32_16x16x32_fp8_bf8(a1.y, xs[cur_][1].y, acc0, 0, 0, 0); acc1 = __builtin_amdgcn_mfma_f32_16x16x32_fp8_bf8(b1.y, xs[cur_][1].y, acc1, 0, 0, 0); \
                    if (m == 0) { *hp0 = acc0; *hp1 = acc1; } } SCHED_FENCE(); } while (0)
            PGU_ISSUE(0, 0);
            for (int i2 = 0; i2 < PG_TOK; i2 += 2) { PGU_BODY(i2, 0, 1); PGU_BODY(i2 + 1, 1, 0); }
#undef PGU_ISSUE
#undef PGU_BODY
            LDS_WAIT(); asm volatile("" ::: "memory");
        }
        for (int i = 0; i < PG_TOK; ++i) {
            const int t = t0 + i; const float sx = 1.f / sqrtf(SSQ[t] * (1.f / DM) + EPS);
            float w[8][4]; float amax = 0.f;
#pragma unroll
            for (int r = 0; r < 8; ++r) { const f32x4 h4 = *(const LAS f32x4*)(hid + i * 128 + 16 * r + 4 * g);
                const f32x4 su4 = *(const GAS f32x4*)(GSU + (size_t)t * NEXP_SEL + 16 * r + 4 * g), gv4 = *(const GAS f32x4*)(GATE + (size_t)t * NEXP_SEL + 16 * r + 4 * g);
#pragma unroll
                for (int j = 0; j < 4; ++j) { w[r][j] = gelu_as(h4[j] * su4[j] * sx) * gv4[j]; amax = fmaxf(amax, fabsf(w[r][j])); } }
            amax = fmaxf(amax, __shfl_xor(amax, 16)); amax = fmaxf(amax, __shfl_xor(amax, 32));
            const float sa = amax > 0.f ? 224.f / amax : 1.f;
            LDS_WAIT(); asm volatile("" ::: "memory");
            if (m == 0) {
                LAS unsigned char* wrow = (LAS unsigned char*)(hid + i * 128);
#pragma unroll
                for (int r = 0; r < 8; ++r) { int pk = __builtin_amdgcn_cvt_pk_fp8_f32(w[r][0] * sa, w[r][1] * sa, 0, false); pk = __builtin_amdgcn_cvt_pk_fp8_f32(w[r][2] * sa, w[r][3] * sa, pk, true);
                    wrow[4 * r + g] = (unsigned char)pk; wrow[32 + 4 * r + g] = (unsigned char)(pk >> 8); wrow[64 + 4 * r + g] = (unsigned char)(pk >> 16); wrow[96 + 4 * r + g] = (unsigned char)(pk >> 24); }
            }
            if (lane == 0) sai[i] = amax > 0.f ? amax * (1.f / 224.f) : 1.f;
        }
        LDS_WAIT(); asm volatile("" ::: "memory");
        for (int p = 0; p < 8; ++p) {
            const unsigned char* Vp = V8T + (size_t)p * SLICE + 16 * piece;
            v4u va[2][16];
#define PGV_ISSUE(i_, buf_) do { _Pragma("unroll") for (int k = 0; k < 16; ++k) { const unsigned e = idxs[(i_) * 128 + 8 * k + row8]; va[buf_][k] = *(const GAS v4u*)(Vp + (size_t)e * 128); } } while (0)
#define PGV_BODY(i_, cur_, nxt_) do { if ((i_) + 1 < PG_TOK) PGV_ISSUE((i_) + 1, nxt_); \
                const LAS v4u* wp = (const LAS v4u*)((LAS unsigned char*)(hid + (i_) * 128) + 32 * g); const v4u w0 = wp[0], w1 = wp[1]; \
                const unsigned ww[8] = {w0.x, w0.y, w0.z, w0.w, w1.x, w1.y, w1.z, w1.w}; \
                SCHED_FENCE(); f32x4 c = (f32x4){0.f, 0.f, 0.f, 0.f}; \
                _Pragma("unroll") for (int kb = 0; kb < 4; ++kb) { \
                    _Pragma("unroll") for (int q4 = 0; q4 < 4; ++q4) *(LAS v4u*)(tb + 1024 * q4 + 16 * lane) = va[cur_][4 * kb + q4]; \
                    long rr_[8]; \
                    _Pragma("unroll") for (int q4 = 0; q4 < 4; ++q4) { rr_[2 * q4] = *(const LAS long*)(tb + 1024 * q4 + g * 128 + 8 * m); rr_[2 * q4 + 1] = *(const LAS long*)(tb + 1024 * q4 + (4 + g) * 128 + 8 * m); } \
                    _Pragma("unroll") for (int q8 = 0; q8 < 8; ++q8) { const int q = 8 * kb + q8; const unsigned a8 = ((ww[q >> 2] >> (8 * (q & 3))) & 0xffu) << bsh; const long bop = (long)(bhi ? ((unsigned long long)a8 << 32) : (unsigned long long)a8); \
                      c = __builtin_amdgcn_mfma_f32_16x16x32_fp8_fp8(rr_[q8], bop, c, 0, 0, 0); } } \
                SCHED_FENCE(); \
                { const float isa = sai[i_]; LAS unsigned short* ob = (LAS unsigned short*)(tb) + 32 * g + (m & 7);         \
                  if (m < 8) { ob[0] = (unsigned short)f2bf(c[0] * isa); ob[8] = (unsigned short)f2bf(c[1] * isa); ob[16] = (unsigned short)f2bf(c[2] * isa); ob[24] = (unsigned short)f2bf(c[3] * isa); } \
                  const v4u ov = *(const LAS v4u*)(tb + 16 * (lane & 15)); \
                  if (lane < 16) *(GAS v4u*)(PO + (size_t)(t0 + (i_)) * DM + 128 * p + 8 * lane) = ov; } } while (0)
            PGV_ISSUE(0, 0);
            for (int i2 = 0; i2 < PG_TOK; i2 += 2) { PGV_BODY(i2, 0, 1); PGV_BODY(i2 + 1, 1, 0); }
#undef PGV_ISSUE
#undef PGV_BODY
        }
        LDS_WAIT(); asm volatile("" ::: "memory");
        VM_WAIT();
        for (int i = 0; i < PG_TOK; i += 2) {
            GAS f32x4* hrA = (GAS f32x4*)(F.out + (size_t)(t0 + i) * DM) + lane; GAS f32x4* hrB = hrA + DM / 4;
            const GAS v2u* prA = (const GAS v2u*)(PO + (size_t)(t0 + i) * DM) + lane; const GAS v2u* prB = prA + DM / 4;
            const GAS v2u* hbA = (const GAS v2u*)(HB + (size_t)(t0 + i) * DM) + lane; const GAS v2u* hbB = hbA + DM / 4;
            v2u pa[4], pb[4], ha[4], hb2[4];
#pragma unroll
            for (int j = 0; j < 4; ++j) { pa[j] = prA[64 * j]; ha[j] = hbA[64 * j]; pb[j] = prB[64 * j]; hb2[j] = hbB[64 * j]; }
            f32x4 ya[4], yb[4]; float sa = 0.f, sb = 0.f;
#pragma unroll
            for (int j = 0; j < 4; ++j) {
                ya[j] = (f32x4){bflo(ha[j].x), bfhi(ha[j].x), bflo(ha[j].y), bfhi(ha[j].y)} + (f32x4){bflo(pa[j].x), bfhi(pa[j].x), bflo(pa[j].y), bfhi(pa[j].y)};
                yb[j] = (f32x4){bflo(hb2[j].x), bfhi(hb2[j].x), bflo(hb2[j].y), bfhi(hb2[j].y)} + (f32x4){bflo(pb[j].x), bfhi(pb[j].x), bflo(pb[j].y), bfhi(pb[j].y)};
                sa += (ya[j].x * ya[j].x + ya[j].y * ya[j].y) + (ya[j].z * ya[j].z + ya[j].w * ya[j].w); sb += (yb[j].x * yb[j].x + yb[j].y * yb[j].y) + (yb[j].z * yb[j].z + yb[j].w * yb[j].w); }
#pragma unroll
            for (int o = 1; o < 64; o <<= 1) { sa += __shfl_xor(sa, o); sb += __shfl_xor(sb, o); }
            const float ra = 1.f / sqrtf(sa * (1.f / DM) + EPS), rb = 1.f / sqrtf(sb * (1.f / DM) + EPS);
#pragma unroll
            for (int j = 0; j < 4; ++j) { const f32x4 gg = *((const GAS f32x4*)gf + lane + 64 * j); hrA[64 * j] = ya[j] * ra * gg; hrB[64 * j] = yb[j] * rb * gg; }
        }
        LDS_WAIT(); asm volatile("" ::: "memory");
    }
}

struct Args { const float* in[18]; float* out; unsigned char* ws; int ph_lo, ph_hi; };
__global__ void __launch_bounds__(NWAVES * 64, 2) hymba_fwd(Args args) {
    extern __shared__ __attribute__((aligned(16))) unsigned char lds[];
    Frame F;
    F.lds = (LAS unsigned char*)lds;
    F.MISC = (volatile LAS unsigned*)(F.lds + MISC_OFF);
    F.tid = threadIdx.x; F.lane = F.tid & 63; F.wave = __builtin_amdgcn_readfirstlane(F.tid >> 6);
    F.G = gridDim.x; { const int bx = blockIdx.x; F.vcu = (F.G % 8 == 0) ? (bx % 8) * (F.G / 8) + bx / 8 : bx; }
#pragma unroll
    for (int i = 0; i < 18; ++i) F.in[i] = args.in[i];
    F.out = args.out; F.ws = args.ws;
    for (int u = F.tid; u < (LDS_BYTES - LDSCTL_OFF) / 4; u += NWAVES * 64) ((LAS unsigned*)(F.lds + LDSCTL_OFF))[u] = 0u;
    __syncthreads();
    const int lo = args.ph_lo, hi = args.ph_hi;
    const bool multi = (hi - lo) > 1;
    XcdBarrier bar; bar.bar = (unsigned*)(F.ws + WS_CTL) + CW_BAR; bar.x = 0; bar.st = nullptr;
    if (multi) bar = xcd_barrier_post((unsigned*)(F.ws + WS_CTL) + CW_BAR, F.MISC + 8);
#define IN(k) (lo <= (k) && (k) < hi)
#define SEAM(k) do { if (IN(k) && IN((k) + 1)) xcd_barrier(bar); } while (0)

    if (IN(0)) { p0_prologue(F); } SEAM(0);
    if (IN(1)) {
        pg8::Gemm g{(const pg8::bf16_t*)(F.ws + WS_HN), (const pg8::bf16_t*)(F.ws + WS_WIN), NTOK, INW, DM}; pg8::StaticOrder S; S.init(NTOK, INW, F.G, (int)blockIdx.x);
        pg8::EpiProj E{(pg8::bf16_t*)(F.ws + WS_PROJ), INW, 2, QSCALE};
        pg8::gemm_phase<pg8::EpiProj, pg8::StaticOrder, PG8_ALIGN, PG8_SP2>(F.lds + RING_OFF, g, S, E);
    } SEAM(1);
    if (IN(2)) { hgrn_mfma(F); }
    if (IN(3)) { quant_drain(F); attn_mfma(F, 0); }
    if (IN(3) && IN(4)) xcd_barrier(bar);
    if (IN(4)) {
        pg8::Gemm g{(const pg8::bf16_t*)(F.ws + WS_HN), (const pg8::bf16_t*)(F.ws + WS_WOUT), NTOK, DM, DM}; pg8::StaticOrder S; S.init(NTOK, DM, F.G, (int)blockIdx.x);
        pg8::EpiMix E{DM, F.in[0], F.in[12], (pg8::bf16_t*)(F.ws + WS_HN2), F.ws + WS_X8, (float*)(F.ws + WS_CTL) + CW_SSQ};
        pg8::gemm_phase<pg8::EpiMix, pg8::StaticOrder, PG8_ALIGN, PG8_SP2>(F.lds + RING_OFF, g, S, E);
    }
    if (IN(4) && IN(6)) xcd_barrier(bar);
    if (IN(6)) {
        pg8::Gemm g{(const pg8::bf16_t*)(F.ws + WS_HN2), (const pg8::bf16_t*)(F.ws + WS_W2), NTOK, 2048, DM}; pg8::StaticOrder S; S.init(NTOK, 2048, F.G, (int)blockIdx.x);
        pg8::EpiScaleRow E{(_Float16*)(F.ws + WS_SC), 2048, (const float*)(F.ws + WS_CTL) + CW_SSQ, 1.f / DM, EPS};
        pg8::gemm_phase<pg8::EpiScaleRow, pg8::StaticOrder, PG8_ALIGN, PG8_SP2>(F.lds + RING_OFF, g, S, E);
    } SEAM(6);
    if (IN(7)) { topk_v2(F); }
    if (IN(7) && IN(8)) { VM_WAIT(); }
    if (IN(8)) { peer_sliced(F); }
#undef IN
#undef SEAM
}

extern "C" void kernel_launch(void* const* d_in, const int* in_sizes, int n_in, void* d_out, int out_size, void* d_ws, size_t ws_size, hipStream_t stream) {
    static int grid = 0;
    if (grid == 0) {
        if (n_in != 18 || in_sizes[0] != NTOK * DM || out_size != NTOK * DM || ws_size < WS_END) { fprintf(stderr, "kernel_launch: unexpected shapes (n_in %d, in0 %d, out %d, ws %zu); nothing launched\n", n_in, n_in > 0 ? in_sizes[0] : -1, out_size, ws_size); grid = -1; return; }
        int dev = 0, cus = 0, per_cu = 0;
        if (hipGetDevice(&dev) != hipSuccess || hipDeviceGetAttribute(&cus, hipDeviceAttributeMultiprocessorCount, dev) != hipSuccess) { grid = -1; return; }
        if (hipFuncSetAttribute((const void*)hymba_fwd, hipFuncAttributeMaxDynamicSharedMemorySize, LDS_BYTES) != hipSuccess) { fprintf(stderr, "kernel_launch: hipFuncSetAttribute failed\n"); grid = -1; return; }
        if (hipOccupancyMaxActiveBlocksPerMultiprocessor(&per_cu, (const void*)hymba_fwd, NWAVES * 64, LDS_BYTES) != hipSuccess || per_cu < 1)
            fprintf(stderr, "kernel_launch: note: occupancy query reports %d workgroups per CU\n", per_cu);
        (void)hipGetLastError();
        grid = cus;
    }
    if (grid < 0) return;
    if (hipMemsetAsync((char*)d_ws + WS_CTL, 0, CTL_ZERO_BYTES, stream) != hipSuccess) return;
    Args a{};
    for (int i = 0; i < 18; ++i) a.in[i] = (const float*)d_in[i];
    a.out = (float*)d_out; a.ws = (unsigned char*)d_ws; a.ph_lo = 0; a.ph_hi = 9;
    hipLaunchKernelGGL(hymba_fwd, dim3(grid), dim3(NWAVES * 64), LDS_BYTES, stream, a);
}
```

```cpp
#include <hip/hip_runtime.h>
#include <cstdio>
#include <cstdint>
#include <cmath>
namespace pg8 {
#define PG8_LAS __attribute__((address_space(3)))
typedef unsigned short bf16_t;
typedef short bf16x8 __attribute__((ext_vector_type(8)));
typedef float f32x4 __attribute__((ext_vector_type(4)));
typedef unsigned u32x4 __attribute__((ext_vector_type(4)));
constexpr int BM = 256, BK = 64, HALF = 128, HTB = HALF * BK * 2  , STAGE_BYTES = 8 * HTB, NXCD = 8, WGM = 8;

__host__ __device__ __forceinline__ int lds_byte(int r, int c) { const int st = (r >> 4) * 2 + (c >> 5), rr = r & 15, cc = c & 31, ob = rr * 64 + cc * 2; return st * 1024 + (ob ^ (((ob >> 9) & 1) << 5)); }
__host__ __device__ __forceinline__ void stage_rc(int b, int& R, int& C) { const int st = b / 1024, sb = b % 1024, swz = sb ^ (((sb >> 9) & 1) << 5); R = (st >> 1) * 16 + swz / 64; C = (st & 1) * 32 + (swz % 64) / 2; }
__host__ __device__ __forceinline__ int perm32(int rho) { const int n = rho >> 4, i = rho & 15; return 8 * (i >> 2) + 4 * n + (i & 3); }

struct Unit { int pm, pn; };
struct Gemm { const bf16_t* A; const bf16_t* Bt; int M, N, K; };

struct StaticOrder {
    int nM, nN, nwg, G, c;
    __host__ __device__ void init(int M, int N, int G_, int c_) { nM = M / BM; nN = N / BM; nwg = nM * nN; G = G_; c = c_; }
    __host__ __device__ bool next(int i, Unit& u) const {
        const long L = (long)i * G + c; if (L >= nwg) return false;
        int wgid = (int)L; { const int q = nwg / NXCD, r = nwg % NXCD, xcd = wgid % NXCD, off = wgid / NXCD; wgid = (xcd < r ? xcd * (q + 1) : r * (q + 1) + (xcd - r) * q) + off; }
        const int nig = WGM * nN, gid = wgid / nig, fm = gid * WGM, gsz = (nM - fm) < WGM ? (nM - fm) : WGM;
        u.pm = fm + ((wgid % nig) % gsz); u.pn = (wgid % nig) / gsz; return true;
    }
    __device__ __forceinline__ void a_ready(const Unit&) const {}
    __device__ __forceinline__ void done(const Unit&) const {}
};
__device__ __forceinline__ unsigned cvt_pk_bf16(float lo, float hi) { unsigned r; asm volatile("v_cvt_pk_bf16_f32 %0, %1, %2" : "=v"(r) : "v"(lo), "v"(hi)); return r; }
typedef float f32x2 __attribute__((ext_vector_type(2)));
__device__ __forceinline__ f32x2 gelu_pk(f32x2 v) {
    const f32x2 av = __builtin_elementwise_abs(v), d = av * 0.2316418882f + 1.0f;
    f32x2 t; t.x = __builtin_amdgcn_rcpf(d.x); t.y = __builtin_amdgcn_rcpf(d.y);
    f32x2 q = t * 0.5307027145f + (-0.7265760135f); q = q * t + 0.7107068705f; q = q * t + (-0.142248368f); q = q * t + 0.127414796f; q = q * t;
    const f32x2 s = (v * v) * (-0.72134752044f);
    f32x2 e; e.x = __builtin_amdgcn_exp2f(s.x); e.y = __builtin_amdgcn_exp2f(s.y);
    const f32x2 m = v * (q * e), r = v - m;
    f32x2 o; o.x = v.x < 0.f ? m.x : r.x; o.y = v.y < 0.f ? m.y : r.y; return o;
}
struct EpiProj {
    static constexpr bool PERM = true, AFTER_DRAIN = false;
    bf16_t* O; int ldc; int qtiles; float qscale;
    __device__ __forceinline__ void operator()(const f32x4 (&acc)[2][2][4][2], const Unit& u, int wr, int wc, int fr, int fq) const {
        const int row0 = u.pm * BM + wr * 64 + fr, col0 = u.pn * BM + wc * 32 + 8 * fq;
        const float sc = (u.pn < qtiles) ? qscale : 1.f;
#pragma unroll
        for (int ai = 0; ai < 2; ++ai)
#pragma unroll
            for (int m = 0; m < 4; ++m) { bf16_t* rowp = O + (size_t)(row0 + ai * HALF + m * 16) * ldc + col0;
#pragma unroll
                for (int bj = 0; bj < 2; ++bj) { const f32x4 v0 = acc[ai][bj][m][0] * sc, v1 = acc[ai][bj][m][1] * sc;
                    u32x4 w; w.x = cvt_pk_bf16(v0[0], v0[1]); w.y = cvt_pk_bf16(v0[2], v0[3]); w.z = cvt_pk_bf16(v1[0], v1[1]); w.w = cvt_pk_bf16(v1[2], v1[3]);
                    *(u32x4*)(rowp + bj * HALF) = w; } }
    }
};
struct EpiF32Res {
    static constexpr bool PERM = false, AFTER_DRAIN = false;
    float* C; int ldc; const float* res;
    __device__ __forceinline__ void operator()(const f32x4 (&acc)[2][2][4][2], const Unit& u, int wr, int wc, int fr, int fq) const {
        const int row0 = u.pm * BM + wr * 64 + fr, col0 = u.pn * BM + wc * 32 + 4 * fq;
#pragma unroll
        for (int ai = 0; ai < 2; ++ai)
#pragma unroll
            for (int m = 0; m < 4; ++m) { const size_t off = (size_t)(row0 + ai * HALF + m * 16) * ldc + col0;
#pragma unroll
                for (int bj = 0; bj < 2; ++bj)
#pragma unroll
                    for (int n = 0; n < 2; ++n) { f32x4 o = acc[ai][bj][m][n]; if (res) o = o + *(const f32x4*)(res + off + bj * HALF + n * 16);
                        *(f32x4*)(C + off + bj * HALF + n * 16) = o; } }
    }
};

struct EpiMix {
    static constexpr bool PERM = true, AFTER_DRAIN = false;
    int ldc; const float* res; const float* g2; bf16_t* HB; unsigned char* XB; float* ssq;
    __device__ __forceinline__ void operator()(const f32x4 (&acc)[2][2][4][2], const Unit& u, int wr, int wc, int fr, int fq) const {
        const int row0 = u.pm * BM + wr * 64 + fr, col0 = u.pn * BM + wc * 32 + 8 * fq;
        f32x4 gv[2][2];
#pragma unroll
        for (int bj = 0; bj < 2; ++bj)
#pragma unroll
            for (int n = 0; n < 2; ++n) gv[bj][n] = *(const f32x4*)(g2 + col0 + bj * HALF + 4 * n);
#pragma unroll
        for (int ai = 0; ai < 2; ++ai)
#pragma unroll
            for (int m = 0; m < 4; ++m) { const int row = row0 + ai * HALF + m * 16; const size_t off = (size_t)row * ldc + col0; float sq = 0.f;
#pragma unroll
                for (int bj = 0; bj < 2; ++bj) {
                    const f32x4 h0 = acc[ai][bj][m][0] + *(const f32x4*)(res + off + bj * HALF), h1 = acc[ai][bj][m][1] + *(const f32x4*)(res + off + bj * HALF + 4);
                    sq += (h0[0] * h0[0] + h0[1] * h0[1]) + (h0[2] * h0[2] + h0[3] * h0[3]) + (h1[0] * h1[0] + h1[1] * h1[1]) + (h1[2] * h1[2] + h1[3] * h1[3]);
                    u32x4 w; w.x = cvt_pk_bf16(h0[0], h0[1]); w.y = cvt_pk_bf16(h0[2], h0[3]); w.z = cvt_pk_bf16(h1[0], h1[1]); w.w = cvt_pk_bf16(h1[2], h1[3]);
                    *(u32x4*)(HB + off + bj * HALF) = w;
                    const f32x4 g0 = h0 * gv[bj][0], g1 = h1 * gv[bj][1];
                    int p0 = __builtin_amdgcn_cvt_pk_bf8_f32(g0[0], g0[1], 0, false); p0 = __builtin_amdgcn_cvt_pk_bf8_f32(g0[2], g0[3], p0, true);
                    int p1 = __builtin_amdgcn_cvt_pk_bf8_f32(g1[0], g1[1], 0, false); p1 = __builtin_amdgcn_cvt_pk_bf8_f32(g1[2], g1[3], p1, true);
                    typedef unsigned u32x2 __attribute__((ext_vector_type(2)));
                    *(u32x2*)(XB + off + bj * HALF) = (u32x2){(unsigned)p0, (unsigned)p1}; }
                sq += __shfl_xor(sq, 16); sq += __shfl_xor(sq, 32);
                if (fq == 0) atomicAdd(ssq + row, sq); }
    }
};
struct EpiScaleRow {
    static constexpr bool PERM = true, AFTER_DRAIN = false;
    _Float16* C; int ldc; const float* ssq; float invk, eps;
    __device__ __forceinline__ void operator()(const f32x4 (&acc)[2][2][4][2], const Unit& u, int wr, int wc, int fr, int fq) const {
        typedef _Float16 h2 __attribute__((ext_vector_type(2)));
        const int row0 = u.pm * BM + wr * 64 + fr, col0 = u.pn * BM + wc * 32 + 8 * fq;
#pragma unroll
        for (int ai = 0; ai < 2; ++ai)
#pragma unroll
            for (int m = 0; m < 4; ++m) { const int row = row0 + ai * HALF + m * 16; const size_t off = (size_t)row * ldc + col0; const float rs = 1.f / sqrtf(ssq[row] * invk + eps);
#pragma unroll
                for (int bj = 0; bj < 2; ++bj) { const f32x4 v0 = acc[ai][bj][m][0] * rs, v1 = acc[ai][bj][m][1] * rs;
                    const h2 p0 = {(_Float16)v0[0], (_Float16)v0[1]}, p1 = {(_Float16)v0[2], (_Float16)v0[3]}, p2 = {(_Float16)v1[0], (_Float16)v1[1]}, p3 = {(_Float16)v1[2], (_Float16)v1[3]};
                    u32x4 w; w.x = __builtin_bit_cast(unsigned, p0); w.y = __builtin_bit_cast(unsigned, p1); w.z = __builtin_bit_cast(unsigned, p2); w.w = __builtin_bit_cast(unsigned, p3);
                    *(u32x4*)(C + off + bj * HALF) = w; } }
    }
};
template <class Epi, class Sched, bool ALIGN_EPI = false, bool SP2 = false>
__device__ __forceinline__ void gemm_phase(PG8_LAS unsigned char* lds, const Gemm g, const Sched& S, const Epi& E) {
    const int tid = threadIdx.x, wid = __builtin_amdgcn_readfirstlane(tid >> 6), lane = tid & 63, wr = wid >> 2, wc = wid & 3, fr = lane & 15, fq = lane >> 4;
    const int K = g.K, nt = K / BK;
    unsigned voffA[2], voffB[2];
#pragma unroll
    for (int i = 0; i < 2; ++i) { int R, C; stage_rc(tid * 16 + i * 8192, R, C); const int Rb = Epi::PERM ? ((R & ~31) + perm32(R & 31)) : R;
        voffA[i] = (unsigned)(R * K + C) * 2u; voffB[i] = (unsigned)(Rb * K + C) * 2u; }
    const size_t kstep = (size_t)(BK * 2);
    const size_t hstep = (size_t)HALF * K * 2;
    const size_t tstep = 2 * hstep;
    const unsigned ldsw = (unsigned)wid * 1024u;
    const int aoff = lds_byte(wr * 64 + fr, fq * 8), boff = lds_byte(wc * 32 + fr, fq * 8);
#define PG8_SA(b, h) (((b) * 2 + (h)) * HTB)
#define PG8_SB(b, h) ((4 + (b) * 2 + (h)) * HTB)
#define PG8_STAGE(bufoff, gbase, voff) do { _Pragma("unroll") for (int _i = 0; _i < 2; ++_i) \
        __builtin_amdgcn_global_load_lds((const unsigned*)((const char*)(gbase) + (voff)[_i]), (PG8_LAS unsigned*)(lds + (bufoff) + ldsw + _i * 8192), 16, 0, 0); } while (0)
#define PG8_LDA(dst, b, h) do { _Pragma("unroll") for (int m = 0; m < 4; ++m) _Pragma("unroll") for (int k = 0; k < 2; ++k) dst[m][k] = *(const PG8_LAS bf16x8*)(lds + PG8_SA(b, h) + aoff + m * 2048 + k * 1024); } while (0)
#define PG8_LDB(dst, b, h) do { _Pragma("unroll") for (int n = 0; n < 2; ++n) _Pragma("unroll") for (int k = 0; k < 2; ++k) dst[n][k] = *(const PG8_LAS bf16x8*)(lds + PG8_SB(b, h) + boff + n * 2048 + k * 1024); } while (0)
#define PG8_MMA(ai, bj, At, Bt) do { __builtin_amdgcn_s_setprio(1); _Pragma("unroll") for (int m = 0; m < 4; ++m) _Pragma("unroll") for (int n = 0; n < 2; ++n) _Pragma("unroll") for (int k = 0; k < 2; ++k) \
        acc[ai][bj][m][n] = __builtin_amdgcn_mfma_f32_16x16x32_bf16(Bt[n][k], At[m][k], acc[ai][bj][m][n], 0, 0, 0); __builtin_amdgcn_s_setprio(0); } while (0)
#define PG8_WAIT_V(n) asm volatile("s_waitcnt vmcnt(" #n ")" ::: "memory")
#define PG8_WAIT_L(n) asm volatile("s_waitcnt lgkmcnt(" #n ")" ::: "memory")
#define PG8_BAR __builtin_amdgcn_s_barrier()
#define PG8_SCHED __builtin_amdgcn_sched_barrier(0)
    Unit cur, nxt; int ui = 0;
    if (!S.next(0, cur)) return;
    f32x4 acc[2][2][4][2];
#pragma unroll
    for (int a = 0; a < 2; ++a)
#pragma unroll
        for (int b = 0; b < 2; ++b)
#pragma unroll
            for (int m = 0; m < 4; ++m)
#pragma unroll
                for (int n = 0; n < 2; ++n) acc[a][b][m][n] = (f32x4){0.f, 0.f, 0.f, 0.f};
    bf16x8 At[4][2], B0[2][2], B1[2][2];
    const char* cA = (const char*)g.A + (size_t)cur.pm * tstep; const char* cB = (const char*)g.Bt + (size_t)cur.pn * tstep;
    S.a_ready(cur);
    if constexpr (SP2) {
        PG8_STAGE(PG8_SB(0, 0), cB, voffB); PG8_STAGE(PG8_SB(0, 1), cB + hstep, voffB); PG8_STAGE(PG8_SA(0, 0), cA, voffA); PG8_STAGE(PG8_SA(0, 1), cA + hstep, voffA);
        if (wr == 1) PG8_BAR;
        PG8_WAIT_V(2); PG8_BAR;
        PG8_STAGE(PG8_SB(1, 0), cB + kstep, voffB); PG8_STAGE(PG8_SA(1, 0), cA + kstep, voffA); PG8_STAGE(PG8_SB(1, 1), cB + hstep + kstep, voffB);
        PG8_WAIT_V(6); PG8_BAR;
    } else {
        PG8_STAGE(PG8_SB(0, 0), cB, voffB); PG8_STAGE(PG8_SA(0, 0), cA, voffA); PG8_STAGE(PG8_SB(0, 1), cB + hstep, voffB); PG8_STAGE(PG8_SA(0, 1), cA + hstep, voffA);
        if (wr == 1) PG8_BAR;
        PG8_WAIT_V(4); PG8_BAR;
        PG8_STAGE(PG8_SB(1, 0), cB + kstep, voffB); PG8_STAGE(PG8_SA(1, 0), cA + kstep, voffA); PG8_STAGE(PG8_SB(1, 1), cB + hstep + kstep, voffB);
        PG8_WAIT_V(6); PG8_BAR;
    }
    for (;;) {
        const bool has_next = S.next(ui + 1, nxt);
        const char* nA = has_next ? (const char*)g.A + (size_t)nxt.pm * tstep : cA; const char* nB = has_next ? (const char*)g.Bt + (size_t)nxt.pn * tstep : cB;
        for (int t = 0; t < nt; t += 2) {
            const bool last = (t == nt - 2);
            const char* a1 = cA + (size_t)(t + 1) * kstep;
            const char* a2 = last ? nA : cA + (size_t)(t + 2) * kstep; const char* b2 = last ? nB : cB + (size_t)(t + 2) * kstep;
            const char* a3 = a2 + kstep; const char* b3 = b2 + kstep;
            if (last && has_next) S.a_ready(nxt);
            if constexpr (SP2) {
            PG8_LDB(B0, 0, 0); PG8_LDB(B1, 0, 1); PG8_SCHED; PG8_LDA(At, 0, 0); PG8_STAGE(PG8_SA(1, 1), a1 + hstep, voffA);
            PG8_WAIT_V(8); PG8_WAIT_L(0); PG8_BAR; PG8_MMA(0, 0, At, B0); PG8_MMA(0, 1, At, B1); PG8_BAR; PG8_SCHED;
            PG8_LDA(At, 0, 1); PG8_STAGE(PG8_SB(0, 0), b2, voffB); PG8_STAGE(PG8_SB(0, 1), b2 + hstep, voffB); PG8_STAGE(PG8_SA(0, 0), a2, voffA);
            PG8_WAIT_V(8); PG8_WAIT_L(0); PG8_BAR; PG8_MMA(1, 0, At, B0); PG8_MMA(1, 1, At, B1); PG8_BAR; PG8_SCHED;
            PG8_LDB(B0, 1, 0); PG8_LDB(B1, 1, 1); PG8_SCHED; PG8_LDA(At, 1, 0); PG8_STAGE(PG8_SA(0, 1), a2 + hstep, voffA);
            PG8_WAIT_V(8); PG8_WAIT_L(0); PG8_BAR; PG8_MMA(0, 0, At, B0); PG8_MMA(0, 1, At, B1); PG8_BAR; PG8_SCHED;
            PG8_LDA(At, 1, 1); PG8_STAGE(PG8_SB(1, 0), b3, voffB); PG8_STAGE(PG8_SB(1, 1), b3 + hstep, voffB); PG8_STAGE(PG8_SA(1, 0), a3, voffA);
            PG8_WAIT_V(8); PG8_WAIT_L(0); PG8_BAR; PG8_MMA(1, 0, At, B0); PG8_MMA(1, 1, At, B1); PG8_BAR; PG8_SCHED;
            } else {
            PG8_LDB(B0, 0, 0); PG8_SCHED; PG8_LDA(At, 0, 0); PG8_STAGE(PG8_SA(1, 1), a1 + hstep, voffA);
            PG8_WAIT_L(8); PG8_BAR; PG8_WAIT_L(0); PG8_MMA(0, 0, At, B0); PG8_BAR; PG8_SCHED;
            PG8_LDB(B1, 0, 1); PG8_STAGE(PG8_SB(0, 0), b2, voffB);
            PG8_BAR; PG8_WAIT_L(0); PG8_MMA(0, 1, At, B1); PG8_BAR;
            PG8_LDA(At, 0, 1); PG8_STAGE(PG8_SA(0, 0), a2, voffA);
            PG8_BAR; PG8_WAIT_L(0); PG8_MMA(1, 0, At, B0); PG8_BAR; PG8_SCHED;
            PG8_STAGE(PG8_SB(0, 1), b2 + hstep, voffB);
            PG8_WAIT_V(6); PG8_BAR; PG8_MMA(1, 1, At, B1); PG8_BAR;
            PG8_LDB(B0, 1, 0); PG8_SCHED; PG8_LDA(At, 1, 0); PG8_STAGE(PG8_SA(0, 1), a2 + hstep, voffA);
            PG8_WAIT_L(8); PG8_BAR; PG8_WAIT_L(0); PG8_MMA(0, 0, At, B0); PG8_BAR; PG8_SCHED;
            PG8_LDB(B1, 1, 1); PG8_STAGE(PG8_SB(1, 0), b3, voffB);
            PG8_BAR; PG8_WAIT_L(0); PG8_MMA(0, 1, At, B1); PG8_BAR;
            PG8_LDA(At, 1, 1); PG8_STAGE(PG8_SA(1, 0), a3, voffA);
            PG8_BAR; PG8_WAIT_L(0); PG8_MMA(1, 0, At, B0); PG8_BAR; PG8_SCHED;
            PG8_STAGE(PG8_SB(1, 1), b3 + hstep, voffB);
            PG8_WAIT_V(6); PG8_BAR; PG8_MMA(1, 1, At, B1); PG8_BAR;
            }
        }
        if constexpr (ALIGN_EPI) { if (wr == 0) PG8_BAR; }
        if constexpr (!Epi::AFTER_DRAIN) { E(acc, cur, wr, wc, fr, fq); S.done(cur); }
        if (!has_next) break;
#pragma unroll
        for (int a = 0; a < 2; ++a)
#pragma unroll
            for (int b = 0; b < 2; ++b)
#pragma unroll
                for (int m = 0; m < 4; ++m)
#pragma unroll
                    for (int n = 0; n < 2; ++n) acc[a][b][m][n] = (f32x4){0.f, 0.f, 0.f, 0.f};
        cur = nxt; cA = nA; cB = nB; ++ui;
        if constexpr (ALIGN_EPI) { if (wr == 1) PG8_BAR; }
    }
    PG8_WAIT_V(0);
    if constexpr (!ALIGN_EPI) { if (wr == 0) PG8_BAR; }
    PG8_BAR;
    if constexpr (Epi::AFTER_DRAIN) { E.fused(acc, cur, wr, wc, fr, fq, lds, wid, lane); S.done(cur); }
#undef PG8_SA
#undef PG8_SB
#undef PG8_STAGE
#undef PG8_LDA
#undef PG8_LDB
#undef PG8_MMA
#undef PG8_WAIT_V
#undef PG8_WAIT_L
#undef PG8_BAR
#undef PG8_SCHED
}
}
#ifndef PG8_SP2
#define PG8_SP2 true
#endif
#ifndef PG8_ALIGN
#define PG8_ALIGN true
#endif

constexpr int NWAVES = 8;
constexpr int NTOK = 32768, DM = 1024, SEQ = 2048, NBATCH = 16, INW = 3584;
constexpr int C_DQ = 0, C_DK = 512, C_DV = 1024, C_HQ = 1536, C_HF = 2048, C_HI = 2560, C_HG = 3072;
constexpr float EPS = 1e-6f;
constexpr float QSCALE = 0.125f * 1.4426950408889634f;
constexpr float LAM_INIT = 0.2f;
constexpr int NEXP_SEL = 128;

constexpr size_t MiB = 1u << 20;
constexpr size_t WS_CTL = 0, CTL_ZERO_BYTES = 1 * MiB;
constexpr size_t WS_SMALL = 1 * MiB;
constexpr size_t WS_WIN = 2 * MiB;
constexpr size_t WS_WOUT = 10 * MiB;
constexpr size_t WS_W2 = 12 * MiB;
constexpr size_t WS_U8 = 17 * MiB;
constexpr size_t WS_V8 = 33 * MiB;
constexpr size_t WS_SU = 49 * MiB;
constexpr size_t WS_SV = 49 * MiB + 512 * 1024;
constexpr size_t WS_X8 = 50 * MiB;
constexpr size_t WS_SX = 116 * MiB;
constexpr size_t WS_GSU = 120 * MiB;
constexpr size_t WS_HN = 84 * MiB;
constexpr size_t WS_PROJ = 148 * MiB;
constexpr size_t WS_HN2 = 148 * MiB;
constexpr size_t WS_SC = 212 * MiB;
constexpr size_t WS_PO = 352 * MiB;
constexpr size_t WS_IDX = 468 * MiB;
constexpr size_t WS_GATE = 484 * MiB;
constexpr size_t WS_END = 500 * MiB;
constexpr int SM_LB = 0, SM_LAM = 512, SM_BIAS = 1024;
constexpr int CW_BAR = 4096;
constexpr int CW_ATTQ = 8192;
constexpr int CW_SSQ = 131072;

constexpr int RING_OFF = 0, RING_BYTES = 139264;
constexpr int LDSCTL_OFF = RING_BYTES, MISC_OFF = LDSCTL_OFF + 320;
constexpr int LDS_BYTES = 147456;

#define GAS __attribute__((address_space(1)))
#define LAS __attribute__((address_space(3)))
typedef unsigned short bf16;
typedef unsigned v4u __attribute__((ext_vector_type(4)));
typedef unsigned v2u __attribute__((ext_vector_type(2)));
typedef float f32x4 __attribute__((ext_vector_type(4)));
typedef short bf16x8 __attribute__((ext_vector_type(8)));
typedef GAS unsigned gu32;
typedef long l2 __attribute__((ext_vector_type(2)));
typedef int v4i __attribute__((ext_vector_type(4)));
#define RLX_AGENT __ATOMIC_RELAXED, __HIP_MEMORY_SCOPE_AGENT
#define LDS_WAIT() asm volatile("s_waitcnt lgkmcnt(0)" ::: "memory")
#define VM_WAIT() asm volatile("s_waitcnt vmcnt(0)" ::: "memory")
__device__ __forceinline__ unsigned f2bf(float f) { unsigned u = __builtin_bit_cast(unsigned, f); return (u + 0x7fffu + ((u >> 16) & 1u)) >> 16; }
__device__ __forceinline__ unsigned pk2(float lo, float hi) { return f2bf(lo) | (f2bf(hi) << 16); }
__device__ __forceinline__ float bflo(unsigned w) { return __builtin_bit_cast(float, w << 16); }
__device__ __forceinline__ float bfhi(unsigned w) { return __builtin_bit_cast(float, w & 0xffff0000u); }

#define XB_TMO      128
#define XB_XCNT(j)  (256  + 64 * (j))
#define XB_XSUB(j)  (1280 + 64 * (j))
#define XB_XGEN(j)  (2304 + 64 * (j))
#define XB_TOP      3328
#define XB_TOPGEN   3392
#define XCD_BAR_WORDS 3456
#define XB_SPIN_CAP (1u << 18)
__device__ __forceinline__ unsigned xb_ld(unsigned* p)              { return __hip_atomic_load(p, __ATOMIC_RELAXED, __HIP_MEMORY_SCOPE_AGENT); }
__device__ __forceinline__ unsigned xb_add(unsigned* p, unsigned v) { return __hip_atomic_fetch_add(p, v, __ATOMIC_RELAXED, __HIP_MEMORY_SCOPE_AGENT); }
__device__ __forceinline__ unsigned xb_xcc_id() { return (unsigned)__builtin_amdgcn_s_getreg((3 << 11) | 20) & 0xFu; }
#define XB_SPIN(cond, bar) do { unsigned _sp = 0; while (cond) { __builtin_amdgcn_s_sleep(1); \
    if ((++_sp & 255u) == 0u) { if (xb_ld(&(bar)[XB_TMO])) break; if (_sp > XB_SPIN_CAP) { atomicAdd(&(bar)[XB_TMO], 1u); break; } } } } while (0)
struct XcdBarrier { unsigned* bar; unsigned x; volatile LAS unsigned* st; };
__device__ __forceinline__ XcdBarrier xcd_barrier_post(unsigned* bar, volatile LAS unsigned* st) {
    XcdBarrier b; b.bar = bar; b.x = xb_xcc_id(); b.st = st;
    if (threadIdx.x == 0) (void)xb_add(&bar[XB_XCNT(b.x)], 1u);
    return b;
}
__device__ __forceinline__ void xcd_barrier_complete(unsigned* bar, unsigned x, unsigned& nloc, unsigned& nx) {
    const unsigned G = gridDim.x * gridDim.y * gridDim.z;
    unsigned sum, cnt, mine, sp = 0u;
    for (;;) {
        sum = 0u; cnt = 0u; mine = 0u;
#pragma unroll
        for (unsigned j = 0; j < 16; ++j) { const unsigned c = xb_ld(&bar[XB_XCNT(j)]); sum += c; cnt += (c > 0u) ? 1u : 0u; mine = (j == x) ? c : mine; }
        if (sum == G) break;
        __builtin_amdgcn_s_sleep(1);
        if ((++sp & 255u) == 0u) { if (xb_ld(&bar[XB_TMO])) break; if (sp > XB_SPIN_CAP) { atomicAdd(&bar[XB_TMO], 1u); break; } }
    }
    nloc = mine > 0u ? mine : 1u; nx = cnt > 0u ? cnt : 1u;
}
__device__ __forceinline__ void xcd_barrier(const XcdBarrier& b) {
    asm volatile("s_waitcnt vmcnt(0)" ::: "memory");
    __syncthreads();
    if (threadIdx.x == 0) {
        unsigned* bar = b.bar;
        __builtin_amdgcn_s_waitcnt(0);
        unsigned nloc = b.st[0], nx = b.st[1];
        if (nloc == 0u) { xcd_barrier_complete(bar, b.x, nloc, nx); b.st[0] = nloc; b.st[1] = nx; }
        const unsigned old = xb_add(&bar[XB_XSUB(b.x)], 1u);
        const unsigned gen = old / nloc;
        if (old + 1u == (gen + 1u) * nloc) {
            __builtin_amdgcn_fence(__ATOMIC_RELEASE, "agent");
            asm volatile("s_waitcnt vmcnt(0)" ::: "memory");
            const unsigned og = xb_add(&bar[XB_TOP], 1u);
            const unsigned tg = og / nx;
            if (og + 1u == (tg + 1u) * nx) xb_add(&bar[XB_TOPGEN], 1u);
            else XB_SPIN(xb_ld(&bar[XB_TOPGEN]) == tg, bar);
            __builtin_amdgcn_fence(__ATOMIC_ACQUIRE, "agent");
            xb_add(&bar[XB_XGEN(b.x)], 1u);
            asm volatile("s_waitcnt vmcnt(0)" ::: "memory");
        } else {
            XB_SPIN(xb_ld(&bar[XB_XGEN(b.x)]) == gen, bar);
            __builtin_amdgcn_fence(__ATOMIC_ACQUIRE, "agent");
            asm volatile("s_waitcnt vmcnt(0)" ::: "memory");
        }
    }
    __syncthreads();
}

#define SCHED_FENCE() __builtin_amdgcn_sched_barrier(0)
__device__ __forceinline__ float gelu_as(float v) {
    const float av = fabsf(v), t = __builtin_amdgcn_rcpf(av * 0.2316418882f + 1.0f);
    float q = t * 0.5307027145f + (-0.7265760135f); q = q * t + 0.7107068705f; q = q * t + (-0.142248368f); q = q * t + 0.127414796f; q = q * t;
    const float e = __builtin_amdgcn_exp2f((v * v) * (-0.72134752044f));
    const float mm = v * (q * e);
    return v < 0.f ? mm : v - mm;
}
struct Frame {
    LAS unsigned char* lds;
    volatile LAS unsigned* MISC;
    int tid, lane, wave, vcu, G;
    const float* in[18]; float* out; unsigned char* ws;
};
__device__ __forceinline__ float wave_sum(float v) {
#pragma unroll
    for (int o = 1; o < 64; o <<= 1) v += __shfl_xor(v, o);
    return v;
}
__device__ __forceinline__ float sigmoidf_(float x) { return 1.f / (1.f + __expf(-x)); }

__device__ __forceinline__ void p0_transpose_item(const float* W, int K, int N, bf16* WT, int row_off, LAS float* scr, int item, int lane) {
    const int nblk = N / 32, kb = item / nblk, nb = item % nblk, k0 = 64 * kb, n0 = 32 * nb;
#pragma unroll 8
    for (int i = 0; i < 32; ++i) { const int kk = 2 * i + (lane >> 5); scr[kk * 33 + (lane & 31)] = W[(size_t)(k0 + kk) * N + n0 + (lane & 31)]; }
    LDS_WAIT(); asm volatile("" ::: "memory");
    const int c = lane & 7;
#pragma unroll
    for (int j = 0; j < 4; ++j) { const int n = (lane >> 3) + 8 * j; const LAS float* s = scr + (8 * c) * 33 + n;
        v4u o; o.x = pk2(s[0 * 33], s[1 * 33]); o.y = pk2(s[2 * 33], s[3 * 33]); o.z = pk2(s[4 * 33], s[5 * 33]); o.w = pk2(s[6 * 33], s[7 * 33]);
        *(GAS v4u*)(WT + (size_t)(row_off + n0 + n) * K + k0 + 8 * c) = o; }
    LDS_WAIT(); asm volatile("" ::: "memory");
}

__device__ __forceinline__ void quant_vals_fp8(const f32x4 (&v)[4], unsigned char* dst, float* dq, int lane, size_t slice_stride) {
    float mx = 0.f;
#pragma unroll
    for (int j = 0; j < 4; ++j) mx = fmaxf(mx, fmaxf(fmaxf(fabsf(v[j].x), fabsf(v[j].y)), fmaxf(fabsf(v[j].z), fabsf(v[j].w))));
#pragma unroll
    for (int o = 1; o < 64; o <<= 1) mx = fmaxf(mx, __shfl_xor(mx, o));
    const float qs = mx > 0.f ? 224.f / mx : 1.f;
#pragma unroll
    for (int j = 0; j < 4; ++j) { int p = __builtin_amdgcn_cvt_pk_fp8_f32(v[j].x * qs, v[j].y * qs, 0, false); p = __builtin_amdgcn_cvt_pk_fp8_f32(v[j].z * qs, v[j].w * qs, p, true);
        const int d = 4 * lane + 256 * j; *(GAS unsigned*)(dst + (slice_stride ? (size_t)(d >> 7) * slice_stride + (d & 127) : (size_t)d)) = (unsigned)p; }
    if (lane == 0) *dq = mx > 0.f ? mx * (1.f / 224.f) : 1.f;
}
__device__ __forceinline__ void quant_row_fp8(const float* src, unsigned char* dst, float* dq, int lane, size_t slice_stride) {
    const GAS f32x4* xr = (const GAS f32x4*)src + lane; f32x4 v[4];
#pragma unroll
    for (int j = 0; j < 4; ++j) v[j] = xr[64 * j];
    quant_vals_fp8(v, dst, dq, lane, slice_stride);
}
__device__ __forceinline__ void p0_prologue(Frame& F) {
    LAS float* scr = (LAS float*)(F.lds + RING_OFF + F.wave * 16384);
    const int gw = F.vcu * NWAVES + F.wave, NGW = F.G * NWAVES;
    bf16* WinT = (bf16*)(F.ws + WS_WIN); bf16* WoutT = (bf16*)(F.ws + WS_WOUT); bf16* W2T = (bf16*)(F.ws + WS_W2);
    float* small = (float*)(F.ws + WS_SMALL);
    if (blockIdx.x == 0) {
        const int t = F.tid;
        { const float l0 = F.in[9][t], l1 = F.in[9][512 + t]; small[SM_LB + t] = 1.f / (1.f + expf(l1 - l0)); }
        { const int h = t >> 7, n = t & 127; int bk;
          if (n < 16) bk = n; else { bk = 16 + (int)(logf((float)n * (1.f / 16.f)) / logf(8.f) * 16.f); bk = bk > 31 ? 31 : bk; }
          small[SM_BIAS + t] = F.in[8][bk * 4 + h] * 1.4426950408889634f; }
        if (F.wave == 0) {
            const float a = wave_sum(F.in[3][F.lane] * F.in[4][F.lane]), b = wave_sum(F.in[5][F.lane] * F.in[6][F.lane]);
            if (F.lane == 0) small[SM_LAM] = expf(a) - expf(b) + LAM_INIT;
        }
    }
    constexpr int I_IN = (DM / 64) * (INW / 32), I_OUT = (DM / 64) * (DM / 32);
    for (int it = gw; it < I_IN + I_OUT; it += NGW) {
        if (it < I_IN) p0_transpose_item(F.in[2], DM, INW, WinT, 0, scr, it, F.lane);
        else p0_transpose_item(F.in[11], DM, DM, WoutT, 0, scr, it - I_IN, F.lane);
    }
    for (int u = F.vcu; u < 256; u += F.G) {
        const int hc = u >> 4, kb = u & 15, k = kb * 64 + F.lane;
        const GAS f32x4* wrow = (const GAS f32x4*)(F.in[13] + (size_t)k * 2048 + hc * 128);
        float a[16];
#pragma unroll
        for (int nn = 0; nn < 16; ++nn) a[nn] = 0.f;
        const float* kr = F.in[14] + ((size_t)hc * 128 + F.wave * 16) * 128;
        for (int i = 0; i < 32; ++i) {
            const f32x4 w = wrow[i];
#pragma unroll
            for (int nn = 0; nn < 16; ++nn) { const float* kk = kr + nn * 128 + 4 * i; a[nn] += (kk[0] * w.x + kk[1] * w.y) + (kk[2] * w.z + kk[3] * w.w); }
        }
        const float g2k = F.in[12][k];
#pragma unroll
        for (int nn = 0; nn < 16; ++nn) W2T[((size_t)hc * 128 + F.wave * 16 + nn) * DM + k] = (bf16)f2bf(a[nn] * g2k);
    }
    bf16* HN = (bf16*)(F.ws + WS_HN);
    for (int m = gw; m < NTOK; m += 2 * NGW) {
        const int m2 = m + NGW;
        const GAS f32x4* xa = (const GAS f32x4*)(F.in[0] + (size_t)m * DM) + F.lane; const GAS f32x4* xb = (const GAS f32x4*)(F.in[0] + (size_t)(m2 < NTOK ? m2 : m) * DM) + F.lane;
        const GAS f32x4* gr = (const GAS f32x4*)F.in[1] + F.lane;
        f32x4 va[4], vb[4]; float sa = 0.f, sb = 0.f;
#pragma unroll
        for (int j = 0; j < 4; ++j) { va[j] = xa[64 * j]; vb[j] = xb[64 * j]; }
#pragma unroll
        for (int j = 0; j < 4; ++j) { sa += (va[j].x * va[j].x + va[j].y * va[j].y) + (va[j].z * va[j].z + va[j].w * va[j].w); sb += (vb[j].x * vb[j].x + vb[j].y * vb[j].y) + (vb[j].z * vb[j].z + vb[j].w * vb[j].w); }
#pragma unroll
        for (int o = 1; o < 64; o <<= 1) { sa += __shfl_xor(sa, o); sb += __shfl_xor(sb, o); }
        const float ra = 1.f / sqrtf(sa * (1.f / DM) + EPS), rb = 1.f / sqrtf(sb * (1.f / DM) + EPS);
        GAS unsigned long long* oa = (GAS unsigned long long*)(HN + (size_t)m * DM) + F.lane; GAS unsigned long long* ob = (GAS unsigned long long*)(HN + (size_t)m2 * DM) + F.lane;
#pragma unroll
        for (int j = 0; j < 4; ++j) { const f32x4 gg = gr[64 * j];
            oa[64 * j] = (unsigned long long)pk2(va[j].x * ra * gg.x, va[j].y * ra * gg.y) | ((unsigned long long)pk2(va[j].z * ra * gg.z, va[j].w * ra * gg.w) << 32);
            if (m2 < NTOK) ob[64 * j] = (unsigned long long)pk2(vb[j].x * rb * gg.x, vb[j].y * rb * gg.y) | ((unsigned long long)pk2(vb[j].z * rb * gg.z, vb[j].w * rb * gg.w) << 32); }
    }
}


constexpr int QCHUNKS = 2 * 16384 / 64;
__device__ __forceinline__ void quant_chunk(Frame& F, int c) {
    unsigned char* U8 = F.ws + WS_U8; unsigned char* V8 = F.ws + WS_V8; float* SU = (float*)(F.ws + WS_SU); float* SV = (float*)(F.ws + WS_SV);
#pragma unroll 1
    for (int k = 0; k < 8; ++k) { const int rr = 64 * c + 8 * F.wave + k;
        if (rr < 16384) quant_row_fp8(F.in[15] + (size_t)rr * DM, U8 + (size_t)rr * 128, SU + rr, F.lane, (size_t)16384 * 128);
        else { const int e = rr - 16384; quant_row_fp8(F.in[16] + (size_t)e * DM, V8 + (size_t)e * 128, SV + e, F.lane, (size_t)16384 * 128); } }
}

__device__ __forceinline__ void quant_drain(Frame& F) {
    unsigned* qctr = (unsigned*)(F.ws + WS_CTL) + CW_ATTQ + 128;
    for (;;) {
        __syncthreads();
        if (F.tid == 0) F.MISC[13] = __hip_atomic_fetch_add(qctr, 1u, __ATOMIC_RELAXED, __HIP_MEMORY_SCOPE_AGENT);
        __syncthreads();
        const int qc = (int)F.MISC[13];
        if (qc >= QCHUNKS) break;
        quant_chunk(F, qc);
    }
}

typedef float f32x16 __attribute__((ext_vector_type(16)));
typedef short s16x4 __attribute__((ext_vector_type(4)));
typedef short v4i16_t __attribute__((ext_vector_type(4)));
typedef float f32x2_t __attribute__((ext_vector_type(2))); typedef __bf16 bf16x2_t __attribute__((ext_vector_type(2)));
__device__ __forceinline__ unsigned cvtpk_bf16(float lo, float hi) { f32x2_t v = {lo, hi}; bf16x2_t b = __builtin_convertvector(v, bf16x2_t); return __builtin_bit_cast(unsigned, b); }
__device__ __forceinline__ float xhalf_max(float v) { return fmaxf(v, __shfl_xor(v, 32)); }
__device__ __forceinline__ float xhalf_sum(float v) { return v + __shfl_xor(v, 32); }
__device__ __forceinline__ float max3f_(float a, float b, float c) { float r; asm("v_max3_f32 %0, %1, %2, %3" : "=v"(r) : "v"(a), "v"(b), "v"(c)); return r; }
constexpr int AT_KP = 144, AT_VP = 320, AT_K1 = 64 * AT_KP, AT_V = 2 * AT_K1, AT_BUF = AT_V + 64 * AT_VP;
constexpr int AT_XO = 0, AT_YB = 65536, AT_YP = 272, AT_Q = 100864, AT_TAB = AT_Q + 8 * 4096;
static_assert(AT_TAB + 320 * 4 <= RING_BYTES && AT_YB + 4 * 32 * AT_YP <= AT_Q, "attention LDS map");
__device__ __forceinline__ void attn_mfma(Frame& F, int qslot) {
    const bf16* PROJ = (const bf16*)(F.ws + WS_PROJ); bf16* MIXED = (bf16*)(F.ws + WS_HN);
    const float* small = (const float*)(F.ws + WS_SMALL);
    LAS unsigned char* lds = F.lds;
    LAS float* TAB = (LAS float*)(lds + AT_TAB);
    const int tid = F.tid, lane = F.lane, wave = F.wave, map = wave >> 2, qt = wave & 3, r32 = lane & 31, hi = lane >> 5;
    const float lam = small[SM_LAM];
    const int koff = map * AT_K1 + r32 * AT_KP + hi * 16;
    const int voff = AT_V + (4 * hi + ((lane & 15) >> 2)) * AT_VP + (16 * ((lane >> 4) & 1) + 4 * (lane & 3)) * 2;
    unsigned* qctr = (unsigned*)(F.ws + WS_CTL) + CW_ATTQ + 64 * qslot;
    for (;;) {
        __syncthreads();
        if (tid == 0) F.MISC[12] = __hip_atomic_fetch_add(qctr, 1u, __ATOMIC_RELAXED, __HIP_MEMORY_SCOPE_AGENT);
        __syncthreads();
        const int L = (int)F.MISC[12];
        if (L >= 1024) break;
        const int qb = 15 - (L >> 6), bh = L & 63;
        const int b = bh >> 2, h = bh & 3, q0 = qb * 128; const size_t tok0 = (size_t)b * SEQ;
        const int NT = (q0 + 128) / 64;
        if (tid < 320) { const int n = tid - 96; TAB[tid] = n < 0 ? -INFINITY : small[SM_BIAS + h * 128 + (n > 127 ? 127 : n)]; }
        LAS unsigned char* qlds = lds + AT_Q + wave * 4096 + lane * 16;
        { const bf16* qrow = PROJ + (tok0 + q0 + 32 * qt + r32) * INW + C_DQ + h * 128 + map * 64 + 8 * hi;
#pragma unroll
          for (int s4 = 0; s4 < 4; ++s4) *(LAS bf16x8*)(qlds + 1024 * s4) = *(const GAS bf16x8*)(qrow + 16 * s4); }
        const bf16* ksrc = PROJ + (tok0 + (tid >> 4)) * INW + C_DK + h * 128 + (tid & 15) * 8;
        const bf16* vsrc = PROJ + (tok0 + (tid >> 4)) * INW + C_DV + h * 128 + (tid & 15) * 8;
        const int kdst = ((tid & 15) >> 3) * AT_K1 + (tid >> 4) * AT_KP + (tid & 7) * 16, vdst = AT_V + (tid >> 4) * AT_VP + (tid & 15) * 16;
        v4u krA[2], vrA[2], krB[2], vrB[2];
#pragma unroll
        for (int i = 0; i < 2; ++i) { krB[i] = *(const GAS v4u*)(ksrc + (size_t)(32 * i) * INW); vrB[i] = *(const GAS v4u*)(vsrc + (size_t)(32 * i) * INW); }
#pragma unroll
        for (int i = 0; i < 2; ++i) { krA[i] = *(const GAS v4u*)(ksrc + (size_t)(64 + 32 * i) * INW); vrA[i] = *(const GAS v4u*)(vsrc + (size_t)(64 + 32 * i) * INW); }
#pragma unroll
        for (int i = 0; i < 2; ++i) { *(LAS v4u*)(lds + kdst + 32 * i * AT_KP) = krB[i]; *(LAS v4u*)(lds + vdst + 32 * i * AT_VP) = vrB[i]; }
        __syncthreads();
        const float bfar = TAB[96 + 127];
        f32x16 o[4];
#pragma unroll
        for (int mt = 0; mt < 4; ++mt) o[mt] = (f32x16){0.f,0.f,0.f,0.f,0.f,0.f,0.f,0.f,0.f,0.f,0.f,0.f,0.f,0.f,0.f,0.f};
        float mrun = -INFINITY, lsum = 0.f;
        const int qlo = q0 + 32 * qt, qpos = qlo + r32;
#pragma unroll
        for (int i = 0; i < 2; ++i) { if (2 < NT) { krB[i] = *(const GAS v4u*)(ksrc + (size_t)(128 + 32 * i) * INW); vrB[i] = *(const GAS v4u*)(vsrc + (size_t)(128 + 32 * i) * INW); } }
        for (int j2 = 0; j2 < NT; j2 += 2) {
          { const int j = j2;
            const int bo = (j & 1) * AT_BUF, bn = ((j + 1) & 1) * AT_BUF;
            if (64 * j <= qlo + 31) {
                f32x16 s0 = (f32x16){0.f,0.f,0.f,0.f,0.f,0.f,0.f,0.f,0.f,0.f,0.f,0.f,0.f,0.f,0.f,0.f}, s1 = s0;
#pragma unroll
                for (int s4 = 0; s4 < 4; ++s4) {
                    const bf16x8 a0 = *(const LAS bf16x8*)(lds + bo + koff + 32 * s4), a1 = *(const LAS bf16x8*)(lds + bo + koff + 32 * AT_KP + 32 * s4);
                    const bf16x8 qfr = *(const LAS bf16x8*)(qlds + 1024 * s4);
                    s0 = __builtin_amdgcn_mfma_f32_32x32x16_bf16(a0, qfr, s0, 0, 0, 0);
                    s1 = __builtin_amdgcn_mfma_f32_32x32x16_bf16(a1, qfr, s1, 0, 0, 0);
                }
                float tm, cadd;
                if (qlo - (64 * j + 63) < 127) {
                    const LAS float* rp = TAB + (qpos - 64 * j - 4 * hi + 96 - 59); tm = -INFINITY;
#pragma unroll
                    for (int r = 0; r < 16; ++r) { const int off = (r & 3) + 8 * (r >> 2);
                        s0[r] += rp[59 - off]; s1[r] += rp[27 - off]; tm = max3f_(tm, s0[r], s1[r]); }
                    cadd = 0.f;
                } else {
                    tm = max3f_(s0[0], s1[0], s0[1]);
#pragma unroll
                    for (int r = 1; r < 15; ++r) tm = max3f_(tm, s1[r], s0[r + 1]);
                    tm = fmaxf(tm, s1[15]);
                    tm += bfar; cadd = bfar;
                }
                tm = xhalf_max(tm);
                if (__any(tm > mrun + 8.f)) {
                    const float mnew = fmaxf(mrun, tm), alpha = __builtin_amdgcn_exp2f(mrun - mnew);
                    lsum *= alpha; mrun = mnew;
#pragma unroll
                    for (int mt = 0; mt < 4; ++mt) o[mt] = o[mt] * alpha;
                }
                const float c = cadd - mrun; float psum = 0.f;
#pragma unroll
                for (int r = 0; r < 16; ++r) { s0[r] = __builtin_amdgcn_exp2f(s0[r] + c); s1[r] = __builtin_amdgcn_exp2f(s1[r] + c); psum += s0[r] + s1[r]; }
                lsum += psum;
#pragma unroll
                for (int kt2 = 0; kt2 < 2; ++kt2)
#pragma unroll
                    for (int sp = 0; sp < 2; ++sp) {
                        v4u pw;
                        if (kt2 == 0) { pw.x = cvtpk_bf16(s0[8 * sp], s0[8 * sp + 1]); pw.y = cvtpk_bf16(s0[8 * sp + 2], s0[8 * sp + 3]); pw.z = cvtpk_bf16(s0[8 * sp + 4], s0[8 * sp + 5]); pw.w = cvtpk_bf16(s0[8 * sp + 6], s0[8 * sp + 7]); }
                        else          { pw.x = cvtpk_bf16(s1[8 * sp], s1[8 * sp + 1]); pw.y = cvtpk_bf16(s1[8 * sp + 2], s1[8 * sp + 3]); pw.z = cvtpk_bf16(s1[8 * sp + 4], s1[8 * sp + 5]); pw.w = cvtpk_bf16(s1[8 * sp + 6], s1[8 * sp + 7]); }
                        const bf16x8 pf = __builtin_bit_cast(bf16x8, pw);
#pragma unroll
                        for (int mt = 0; mt < 4; ++mt) {
                            LAS unsigned char* vp = lds + bo + voff + (32 * kt2 + 16 * sp) * AT_VP + 64 * mt;
                            const s16x4 lo = __builtin_bit_cast(s16x4, __builtin_amdgcn_ds_read_tr16_b64_v4i16((LAS v4i16_t*)vp));
                            const s16x4 hi4 = __builtin_bit_cast(s16x4, __builtin_amdgcn_ds_read_tr16_b64_v4i16((LAS v4i16_t*)(vp + 8 * AT_VP)));
                            const bf16x8 af = (bf16x8){lo[0], lo[1], lo[2], lo[3], hi4[0], hi4[1], hi4[2], hi4[3]};
                            o[mt] = __builtin_amdgcn_mfma_f32_32x32x16_bf16(af, pf, o[mt], 0, 0, 0);
                        }
                    }
            }
            if (j + 1 < NT) {
#pragma unroll
                for (int i = 0; i < 2; ++i) { *(LAS v4u*)(lds + bn + kdst + 32 * i * AT_KP) = krA[i]; *(LAS v4u*)(lds + bn + vdst + 32 * i * AT_VP) = vrA[i]; }
                if (j + 3 < NT) {
#pragma unroll
                    for (int i = 0; i < 2; ++i) { krA[i] = *(const GAS v4u*)(ksrc + (size_t)(64 * (j + 3) + 32 * i) * INW); vrA[i] = *(const GAS v4u*)(vsrc + (size_t)(64 * (j + 3) + 32 * i) * INW); }
                }
            }
            __syncthreads();
                  }
          { const int j = j2 + 1;
            const int bo = (j & 1) * AT_BUF, bn = ((j + 1) & 1) * AT_BUF;
            if (64 * j <= qlo + 31) {
                f32x16 s0 = (f32x16){0.f,0.f,0.f,0.f,0.f,0.f,0.f,0.f,0.f,0.f,0.f,0.f,0.f,0.f,0.f,0.f}, s1 = s0;
#pragma unroll
                for (int s4 = 0; s4 < 4; ++s4) {
                    const bf16x8 a0 = *(const LAS bf16x8*)(lds + bo + koff + 32 * s4), a1 = *(const LAS bf16x8*)(lds + bo + koff + 32 * AT_KP + 32 * s4);
                    const bf16x8 qfr = *(const LAS bf16x8*)(qlds + 1024 * s4);
                    s0 = __builtin_amdgcn_mfma_f32_32x32x16_bf16(a0, qfr, s0, 0, 0, 0);
                    s1 = __builtin_amdgcn_mfma_f32_32x32x16_bf16(a1, qfr, s1, 0, 0, 0);
                }
                float tm, cadd;
                if (qlo - (64 * j + 63) < 127) {
                    const LAS float* rp = TAB + (qpos - 64 * j - 4 * hi + 96 - 59); tm = -INFINITY;
#pragma unroll
                    for (int r = 0; r < 16; ++r) { const int off = (r & 3) + 8 * (r >> 2);
                        s0[r] += rp[59 - off]; s1[r] += rp[27 - off]; tm = max3f_(tm, s0[r], s1[r]); }
                    cadd = 0.f;
                } else {
                    tm = max3f_(s0[0], s1[0], s0[1]);
#pragma unroll
                    for (int r = 1; r < 15; ++r) tm = max3f_(tm, s1[r], s0[r + 1]);
                    tm = fmaxf(tm, s1[15]);
                    tm += bfar; cadd = bfar;
                }
                tm = xhalf_max(tm);
                if (__any(tm > mrun + 8.f)) {
                    const float mnew = fmaxf(mrun, tm), alpha = __builtin_amdgcn_exp2f(mrun - mnew);
                    lsum *= alpha; mrun = mnew;
#pragma unroll
                    for (int mt = 0; mt < 4; ++mt) o[mt] = o[mt] * alpha;
                }
                const float c = cadd - mrun; float psum = 0.f;
#pragma unroll
                for (int r = 0; r < 16; ++r) { s0[r] = __builtin_amdgcn_exp2f(s0[r] + c); s1[r] = __builtin_amdgcn_exp2f(s1[r] + c); psum += s0[r] + s1[r]; }
                lsum += psum;
#pragma unroll
                for (int kt2 = 0; kt2 < 2; ++kt2)
#pragma unroll
                    for (int sp = 0; sp < 2; ++sp) {
                        v4u pw;
                        if (kt2 == 0) { pw.x = cvtpk_bf16(s0[8 * sp], s0[8 * sp + 1]); pw.y = cvtpk_bf16(s0[8 * sp + 2], s0[8 * sp + 3]); pw.z = cvtpk_bf16(s0[8 * sp + 4], s0[8 * sp + 5]); pw.w = cvtpk_bf16(s0[8 * sp + 6], s0[8 * sp + 7]); }
                        else          { pw.x = cvtpk_bf16(s1[8 * sp], s1[8 * sp + 1]); pw.y = cvtpk_bf16(s1[8 * sp + 2], s1[8 * sp + 3]); pw.z = cvtpk_bf16(s1[8 * sp + 4], s1[8 * sp + 5]); pw.w = cvtpk_bf16(s1[8 * sp + 6], s1[8 * sp + 7]); }
                        const bf16x8 pf = __builtin_bit_cast(bf16x8, pw);
#pragma unroll
                        for (int mt = 0; mt < 4; ++mt) {
                            LAS unsigned char* vp = lds + bo + voff + (32 * kt2 + 16 * sp) * AT_VP + 64 * mt;
                            const s16x4 lo = __builtin_bit_cast(s16x4, __builtin_amdgcn_ds_read_tr16_b64_v4i16((LAS v4i16_t*)vp));
                            const s16x4 hi4 = __builtin_bit_cast(s16x4, __builtin_amdgcn_ds_read_tr16_b64_v4i16((LAS v4i16_t*)(vp + 8 * AT_VP)));
                            const bf16x8 af = (bf16x8){lo[0], lo[1], lo[2], lo[3], hi4[0], hi4[1], hi4[2], hi4[3]};
                            o[mt] = __builtin_amdgcn_mfma_f32_32x32x16_bf16(af, pf, o[mt], 0, 0, 0);
                        }
                    }
            }
            if (j + 1 < NT) {
#pragma unroll
                for (int i = 0; i < 2; ++i) { *(LAS v4u*)(lds + bn + kdst + 32 * i * AT_KP) = krB[i]; *(LAS v4u*)(lds + bn + vdst + 32 * i * AT_VP) = vrB[i]; }
                if (j + 3 < NT) {
#pragma unroll
                    for (int i = 0; i < 2; ++i) { krB[i] = *(const GAS v4u*)(ksrc + (size_t)(64 * (j + 3) + 32 * i) * INW); vrB[i] = *(const GAS v4u*)(vsrc + (size_t)(64 * (j + 3) + 32 * i) * INW); }
                }
            }
            __syncthreads();
                  }
        }
        const float inv = 1.f / xhalf_sum(lsum);
        LAS float* XO = (LAS float*)(lds + AT_XO) + qt * 4096 + r32;
        if (map == 1) {
            const float sc = inv * lam;
#pragma unroll
            for (int mt = 0; mt < 4; ++mt)
#pragma unroll
                for (int r = 0; r < 16; ++r) XO[(32 * mt + (r & 3) + 8 * (r >> 2) + 4 * hi) * 32] = o[mt][r] * sc;
        }
        __syncthreads();
        if (map == 0) {
            float ss = 0.f;
#pragma unroll
            for (int mt = 0; mt < 4; ++mt)
#pragma unroll
                for (int r = 0; r < 16; ++r) { const float a = o[mt][r] * inv - XO[(32 * mt + (r & 3) + 8 * (r >> 2) + 4 * hi) * 32]; o[mt][r] = a; ss += a * a; }
            ss = xhalf_sum(ss);
            const float rr = (1.f - LAM_INIT) / sqrtf(ss * (1.f / 128.f) + EPS);
            LAS unsigned char* yb = lds + AT_YB + qt * (32 * AT_YP);
#pragma unroll
            for (int mt = 0; mt < 4; ++mt)
#pragma unroll
                for (int r4 = 0; r4 < 4; ++r4) { const int dv = 32 * mt + 8 * r4 + 4 * hi; const f32x4 gg = *(const GAS f32x4*)(F.in[7] + dv);
                    v2u w; w.x = cvtpk_bf16(o[mt][4 * r4] * rr * gg.x, o[mt][4 * r4 + 1] * rr * gg.y); w.y = cvtpk_bf16(o[mt][4 * r4 + 2] * rr * gg.z, o[mt][4 * r4 + 3] * rr * gg.w);
                    *(LAS v2u*)(yb + r32 * AT_YP + dv * 2) = w; }
            LDS_WAIT(); asm volatile("" ::: "memory");
            bf16* obase = MIXED + (tok0 + q0 + 32 * qt) * DM + h * 128;
#pragma unroll
            for (int i = 0; i < 8; ++i) { const int id = lane + 64 * i, row = id >> 4, cch = id & 15;
                const v4u w = *(const LAS v4u*)(yb + row * AT_YP + cch * 16); *(GAS v4u*)(obase + (size_t)row * DM + cch * 8) = w; }
        }
    }
}


constexpr int HG_P = 272, HG_KP = 80, HG_VP = 320, HG_GP = 272, HG_OP = 136;
constexpr int HG_QD = 0, HG_KI = 32 * HG_P, HG_KDT = 2 * 32 * HG_P, HG_V = HG_KDT + 128 * HG_KP, HG_CD = HG_V + 32 * HG_VP, HG_G = HG_CD + 512, HG_BUF = HG_G + 32 * HG_GP;
constexpr int HG_O = 2 * HG_BUF;
static_assert(HG_O + 32 * HG_OP * 4 <= RING_BYTES, "hgrn LDS map");
__device__ __forceinline__ bf16x8 pack8(const f32x16& x, int s) {
    v4u p; p.x = cvtpk_bf16(x[8 * s], x[8 * s + 1]); p.y = cvtpk_bf16(x[8 * s + 2], x[8 * s + 3]); p.z = cvtpk_bf16(x[8 * s + 4], x[8 * s + 5]); p.w = cvtpk_bf16(x[8 * s + 6], x[8 * s + 7]);
    return __builtin_bit_cast(bf16x8, p);
}
__device__ __forceinline__ bf16x8 tr_pair(LAS unsigned char* p0, LAS unsigned char* p1) {
    const s16x4 lo = __builtin_bit_cast(s16x4, __builtin_amdgcn_ds_read_tr16_b64_v4i16((LAS v4i16_t*)p0));
    const s16x4 hi4 = __builtin_bit_cast(s16x4, __builtin_amdgcn_ds_read_tr16_b64_v4i16((LAS v4i16_t*)p1));
    return (bf16x8){lo[0], lo[1], lo[2], lo[3], hi4[0], hi4[1], hi4[2], hi4[3]};
}
#define DPPF_(x, ctrl) __builtin_bit_cast(float, __builtin_amdgcn_update_dpp(0, __builtin_bit_cast(int, (x)), (ctrl), 0xf, 0xf, true))
__device__ __forceinline__ void hg_prep8(LAS unsigned char* bufp, const v4u rq, const v4u rf, const f32x4 lbA, const f32x4 lbB, int pc, int dk8, int lane) {
    const float lbv[8] = {lbA.x, lbA.y, lbA.z, lbA.w, lbB.x, lbB.y, lbB.z, lbB.w};
    float bb[8], fv[8];
    const unsigned fw[4] = {rf.x, rf.y, rf.z, rf.w}, qw[4] = {rq.x, rq.y, rq.z, rq.w};
#pragma unroll
    for (int i = 0; i < 8; ++i) { const float x = (i & 1) ? bfhi(fw[i >> 1]) : bflo(fw[i >> 1]); const float f = lbv[i] + (1.f - lbv[i]) * __builtin_amdgcn_rcpf(1.f + __expf(-x)); fv[i] = f; bb[i] = f; }
#pragma unroll
    for (int i = 0; i < 8; ++i) { float x = bb[i];
        x *= __builtin_bit_cast(float, __builtin_amdgcn_update_dpp(0x3f800000, __builtin_bit_cast(int, x), 0x111, 0xf, 0xf, false));
        x *= __builtin_bit_cast(float, __builtin_amdgcn_update_dpp(0x3f800000, __builtin_bit_cast(int, x), 0x112, 0xf, 0xf, false));
        x *= __builtin_bit_cast(float, __builtin_amdgcn_update_dpp(0x3f800000, __builtin_bit_cast(int, x), 0x114, 0xf, 0xf, false));
        x *= __builtin_bit_cast(float, __builtin_amdgcn_update_dpp(0x3f800000, __builtin_bit_cast(int, x), 0x118, 0xf, 0xf, false));
        x *= __builtin_bit_cast(float, __builtin_amdgcn_update_dpp(0x3f800000, __builtin_bit_cast(int, x), 0x142, 0xa, 0xf, false));
        bb[i] = x; }
    float qd[8], ki[8], kd[8], cdv[8];
#pragma unroll
    for (int i = 0; i < 8; ++i) { const float elast = __shfl(bb[i], (lane & 32) + 31);
        const float e = bb[i], ei = __builtin_amdgcn_rcpf(bb[i]), ed = elast * ei;
        const float xq = (i & 1) ? bfhi(qw[i >> 1]) : bflo(qw[i >> 1]); const float q = xq * __builtin_amdgcn_rcpf(1.f + __expf(-xq)); const float k = 1.f - fv[i];
        qd[i] = q * e; ki[i] = k * ei; kd[i] = k * ed; cdv[i] = elast; }
    *(LAS v4u*)(bufp + HG_QD + pc * HG_P + dk8 * 2) = (v4u){cvtpk_bf16(qd[0], qd[1]), cvtpk_bf16(qd[2], qd[3]), cvtpk_bf16(qd[4], qd[5]), cvtpk_bf16(qd[6], qd[7])};
    *(LAS v4u*)(bufp + HG_KI + pc * HG_P + dk8 * 2) = (v4u){cvtpk_bf16(ki[0], ki[1]), cvtpk_bf16(ki[2], ki[3]), cvtpk_bf16(ki[4], ki[5]), cvtpk_bf16(ki[6], ki[7])};
    *(LAS v4u*)(bufp + HG_KDT + pc * HG_VP + dk8 * 2) = (v4u){cvtpk_bf16(kd[0], kd[1]), cvtpk_bf16(kd[2], kd[3]), cvtpk_bf16(kd[4], kd[5]), cvtpk_bf16(kd[6], kd[7])};
    if (pc == 31) { *(LAS f32x4*)(bufp + HG_CD + dk8 * 4) = (f32x4){cdv[0], cdv[1], cdv[2], cdv[3]}; *(LAS f32x4*)(bufp + HG_CD + dk8 * 4 + 16) = (f32x4){cdv[4], cdv[5], cdv[6], cdv[7]}; }
}
__device__ __forceinline__ void hgrn_mfma(Frame& F) {
    const bf16* PROJ = (const bf16*)(F.ws + WS_PROJ); bf16* MIXED = (bf16*)(F.ws + WS_HN);
    const float* small = (const float*)(F.ws + WS_SMALL);
    LAS unsigned char* lds = F.lds;
    const int tid = F.tid, lane = F.lane, wave = F.wave, r32 = lane & 31, hh = lane >> 5;
    for (int u = F.vcu; u < 64; u += F.G) {
        const int b = u >> 2, h = u & 3; const size_t tok0 = (size_t)b * SEQ;
        __syncthreads();
        if (wave >= 4) {
            const int pt = tid - 256, pc = lane & 31, dkA = 16 * (wave - 4) + 8 * hh;
            const int vcA = pt >> 4, vseg = pt & 15;
            const f32x4 lb0 = *(const GAS f32x4*)(small + SM_LB + h * 128 + dkA), lb1 = *(const GAS f32x4*)(small + SM_LB + h * 128 + dkA + 4);
            const f32x4 lb2 = *(const GAS f32x4*)(small + SM_LB + h * 128 + dkA + 64), lb3 = *(const GAS f32x4*)(small + SM_LB + h * 128 + dkA + 68);
            v4u q0A, f0A, v0A, g0A, q1A, f1A, v1A, g1A, q0B, f0B, v0B, g0B, q1B, f1B, v1B, g1B;
#define HP_LOAD(S, chn) do { const bf16* p_ = PROJ + (tok0 + 32 * (chn) + pc) * INW + h * 128 + dkA; const bf16* v_ = PROJ + (tok0 + 32 * (chn) + vcA) * INW + h * 128 + vseg * 8; \
            asm volatile("global_load_dwordx4 %0, %1, off" : "=v"(q0##S) : "v"(p_ + C_HQ) : "memory"); \
            asm volatile("global_load_dwordx4 %0, %1, off" : "=v"(f0##S) : "v"(p_ + C_HF) : "memory"); \
            asm volatile("global_load_dwordx4 %0, %1, off" : "=v"(v0##S) : "v"(v_ + C_HI) : "memory"); \
            asm volatile("global_load_dwordx4 %0, %1, off" : "=v"(g0##S) : "v"(v_ + C_HG) : "memory"); \
            asm volatile("global_load_dwordx4 %0, %1, off" : "=v"(q1##S) : "v"(p_ + C_HQ + 64) : "memory"); \
            asm volatile("global_load_dwordx4 %0, %1, off" : "=v"(f1##S) : "v"(p_ + C_HF + 64) : "memory"); \
            asm volatile("global_load_dwordx4 %0, %1, off" : "=v"(v1##S) : "v"(v_ + (size_t)16 * INW + C_HI) : "memory"); \
            asm volatile("global_load_dwordx4 %0, %1, off" : "=v"(g1##S) : "v"(v_ + (size_t)16 * INW + C_HG) : "memory"); } while (0)
#define HP_WAIT(S) asm volatile("s_waitcnt vmcnt(8)" : "+v"(q0##S), "+v"(f0##S), "+v"(v0##S), "+v"(g0##S), "+v"(q1##S), "+v"(f1##S), "+v"(v1##S), "+v"(g1##S) :: "memory")
#define HP_PASS0(S, bufp) do { hg_prep8(bufp, q0##S, f0##S, lb0, lb1, pc, dkA, lane); \
            *(LAS v4u*)((bufp) + HG_V + vcA * HG_VP + vseg * 16) = v0##S; *(LAS v4u*)((bufp) + HG_V + (vcA + 16) * HG_VP + vseg * 16) = v1##S; \
            *(LAS v4u*)((bufp) + HG_G + vcA * HG_GP + vseg * 16) = g0##S; *(LAS v4u*)((bufp) + HG_G + (vcA + 16) * HG_GP + vseg * 16) = g1##S; } while (0)
#define HP_PASS1(S, bufp) hg_prep8(bufp, q1##S, f1##S, lb2, lb3, pc, dkA + 64, lane)
            HP_LOAD(A, 0); HP_LOAD(B, 1);
            HP_WAIT(A); HP_PASS0(A, lds); HP_PASS1(A, lds);
            HP_LOAD(A, 2);
            for (int ch2 = 0; ch2 < SEQ / 32; ch2 += 2) {
                __syncthreads();
                HP_WAIT(B); HP_PASS0(B, lds + HG_BUF);
                __syncthreads();
                HP_PASS1(B, lds + HG_BUF);
                HP_LOAD(B, (ch2 + 3 < SEQ / 32 ? ch2 + 3 : SEQ / 32 - 1));
                __syncthreads();
                HP_WAIT(A); HP_PASS0(A, lds);
                __syncthreads();
                HP_PASS1(A, lds);
                HP_LOAD(A, (ch2 + 4 < SEQ / 32 ? ch2 + 4 : SEQ / 32 - 1));
            }
            asm volatile("s_waitcnt vmcnt(0)" : "+v"(q0A), "+v"(f0A), "+v"(v0A), "+v"(g0A), "+v"(q1A), "+v"(f1A), "+v"(v1A), "+v"(g1A), "+v"(q0B), "+v"(f0B), "+v"(v0B), "+v"(g0B), "+v"(q1B), "+v"(f1B), "+v"(v1B), "+v"(g1B) :: "memory");
#undef HP_LOAD
#undef HP_WAIT
#undef HP_PASS0
#undef HP_PASS1
        } else {
            const int dvt = wave;
            const int kdoff = (((lane & 15) >> 2)) * HG_VP + (16 * ((lane >> 4) & 1) + 4 * (lane & 3)) * 2;
            const int troff = (((lane & 15) >> 2)) * HG_VP + (32 * dvt + 16 * ((lane >> 4) & 1) + 4 * (lane & 3)) * 2;
            const int vc = tid >> 3, sg = tid & 7;
            const f32x4 ga0 = *(const GAS f32x4*)(F.in[10] + 8 * sg), ga1 = *(const GAS f32x4*)(F.in[10] + 8 * sg + 4);
            const f32x4 gb0 = *(const GAS f32x4*)(F.in[10] + 64 + 8 * sg), gb1 = *(const GAS f32x4*)(F.in[10] + 64 + 8 * sg + 4);
            f32x16 S0, S1, S2, S3;
#pragma unroll
            for (int r = 0; r < 16; ++r) { S0[r] = 0.f; S1[r] = 0.f; S2[r] = 0.f; S3[r] = 0.f; }
            for (int ch = 0; ch < SEQ / 32; ++ch) {
                LAS unsigned char* bufp = lds + (ch & 1) * HG_BUF;
                __syncthreads();
                f32x16 o, o2, X, X2;
#pragma unroll
                for (int r = 0; r < 16; ++r) { o[r] = 0.f; o2[r] = 0.f; X[r] = 0.f; X2[r] = 0.f; }
#pragma unroll
                for (int kk = 0; kk < 4; ++kk)
#pragma unroll
                    for (int s2 = 0; s2 < 2; ++s2) {
                        LAS unsigned char* qa = bufp + HG_QD + r32 * HG_P + (32 * kk + 16 * s2 + 4 * hh) * 2;
                        const v2u a0 = *(const LAS v2u*)qa, a1 = *(const LAS v2u*)(qa + 16);
                        const bf16x8 af = __builtin_bit_cast(bf16x8, (v4u){a0.x, a0.y, a1.x, a1.y});
                        const bf16x8 sb = pack8(kk == 0 ? S0 : kk == 1 ? S1 : kk == 2 ? S2 : S3, s2);
                        if (kk < 2) o = __builtin_amdgcn_mfma_f32_32x32x16_bf16(af, sb, o, 0, 0, 0);
                        else        o2 = __builtin_amdgcn_mfma_f32_32x32x16_bf16(af, sb, o2, 0, 0, 0);
                    }
#pragma unroll
                for (int s8 = 0; s8 < 8; ++s8) {
                    const bf16x8 af = *(const LAS bf16x8*)(bufp + HG_KI + r32 * HG_P + (16 * s8 + 8 * hh) * 2);
                    const bf16x8 bfr = *(const LAS bf16x8*)(bufp + HG_QD + r32 * HG_P + (16 * s8 + 8 * hh) * 2);
                    if (s8 < 4) X = __builtin_amdgcn_mfma_f32_32x32x16_bf16(af, bfr, X, 0, 0, 0);
                    else        X2 = __builtin_amdgcn_mfma_f32_32x32x16_bf16(af, bfr, X2, 0, 0, 0);
                }
#pragma unroll
                for (int r = 0; r < 16; ++r) { const int cp = (r & 3) + 8 * (r >> 2) + 4 * hh; X[r] = cp > r32 ? 0.f : X[r] + X2[r]; o[r] += o2[r]; }
#pragma unroll
                for (int s2 = 0; s2 < 2; ++s2) {
                    LAS unsigned char* vp = bufp + HG_V + troff + (16 * s2 + 4 * hh) * HG_VP;
                    o = __builtin_amdgcn_mfma_f32_32x32x16_bf16(pack8(X, s2), tr_pair(vp, vp + 8 * HG_VP), o, 0, 0, 0);
                }
                { LAS float* ob = (LAS float*)(lds + HG_O) + 32 * dvt + r32;
#pragma unroll
                  for (int r = 0; r < 16; ++r) ob[((r & 3) + 8 * (r >> 2) + 4 * hh) * HG_OP] = o[r]; }
                __syncthreads();
#pragma unroll
                for (int kk = 0; kk < 4; ++kk) {
                    const int dk0 = 32 * kk;
                    const LAS float* cdp = (const LAS float*)(bufp + HG_CD) + dk0 + 4 * hh;
#pragma unroll
                    for (int r4 = 0; r4 < 4; ++r4) { const f32x4 c4 = *(const LAS f32x4*)(cdp + 8 * r4);
                        if (kk == 0)      { S0[4 * r4] *= c4.x; S0[4 * r4 + 1] *= c4.y; S0[4 * r4 + 2] *= c4.z; S0[4 * r4 + 3] *= c4.w; }
                        else if (kk == 1) { S1[4 * r4] *= c4.x; S1[4 * r4 + 1] *= c4.y; S1[4 * r4 + 2] *= c4.z; S1[4 * r4 + 3] *= c4.w; }
                        else if (kk == 2) { S2[4 * r4] *= c4.x; S2[4 * r4 + 1] *= c4.y; S2[4 * r4 + 2] *= c4.z; S2[4 * r4 + 3] *= c4.w; }
                        else              { S3[4 * r4] *= c4.x; S3[4 * r4 + 1] *= c4.y; S3[4 * r4 + 2] *= c4.z; S3[4 * r4 + 3] *= c4.w; } }
#pragma unroll
                    for (int s2 = 0; s2 < 2; ++s2) {
                        LAS unsigned char* kp = bufp + HG_KDT + kdoff + (16 * s2 + 8 * hh) * HG_VP + dk0 * 2;
                        const bf16x8 af = tr_pair(kp, kp + 4 * HG_VP);
                        LAS unsigned char* vp = bufp + HG_V + troff + (16 * s2 + 8 * hh) * HG_VP;
                        const bf16x8 bfr = tr_pair(vp, vp + 4 * HG_VP);
                        if (kk == 0)      S0 = __builtin_amdgcn_mfma_f32_32x32x16_bf16(af, bfr, S0, 0, 0, 0);
                        else if (kk == 1) S1 = __builtin_amdgcn_mfma_f32_32x32x16_bf16(af, bfr, S1, 0, 0, 0);
                        else if (kk == 2) S2 = __builtin_amdgcn_mfma_f32_32x32x16_bf16(af, bfr, S2, 0, 0, 0);
                        else              S3 = __builtin_amdgcn_mfma_f32_32x32x16_bf16(af, bfr, S3, 0, 0, 0);
                    }
                }
                { const LAS float* op = (const LAS float*)(lds + HG_O) + vc * HG_OP + 8 * sg;
                  const f32x4 x0 = *(const LAS f32x4*)op, x1 = *(const LAS f32x4*)(op + 4), x2 = *(const LAS f32x4*)(op + 64), x3 = *(const LAS f32x4*)(op + 68);
                  const v4u gwa = *(const LAS v4u*)(bufp + HG_G + vc * HG_GP + sg * 16), gwb = *(const LAS v4u*)(bufp + HG_G + vc * HG_GP + (sg + 8) * 16);
                  float ss = ((x0.x * x0.x + x0.y * x0.y) + (x0.z * x0.z + x0.w * x0.w)) + ((x1.x * x1.x + x1.y * x1.y) + (x1.z * x1.z + x1.w * x1.w))
                           + ((x2.x * x2.x + x2.y * x2.y) + (x2.z * x2.z + x2.w * x2.w)) + ((x3.x * x3.x + x3.y * x3.y) + (x3.z * x3.z + x3.w * x3.w));
                  ss += DPPF_(ss, 0xB1); ss += DPPF_(ss, 0x4E); ss += DPPF_(ss, 0x141);
                  const float rr = __builtin_amdgcn_rsqf(ss * (1.f / 128.f) + EPS);
                  const size_t tok = tok0 + 32 * ch + vc;
                  const unsigned gwa_[4] = {gwa.x, gwa.y, gwa.z, gwa.w}, gwb_[4] = {gwb.x, gwb.y, gwb.z, gwb.w};
                  const float ova[8] = {x0.x, x0.y, x0.z, x0.w, x1.x, x1.y, x1.z, x1.w}, ovb[8] = {x2.x, x2.y, x2.z, x2.w, x3.x, x3.y, x3.z, x3.w};
                  const float gga[8] = {ga0.x, ga0.y, ga0.z, ga0.w, ga1.x, ga1.y, ga1.z, ga1.w}, ggb[8] = {gb0.x, gb0.y, gb0.z, gb0.w, gb1.x, gb1.y, gb1.z, gb1.w};
                  unsigned wa[4], wb[4];
#pragma unroll
                  for (int j = 0; j < 4; ++j) { const float a0 = bflo(gwa_[j]), a1 = bfhi(gwa_[j]), b0 = bflo(gwb_[j]), b1 = bfhi(gwb_[j]);
                      wa[j] = cvtpk_bf16(ova[2 * j] * rr * gga[2 * j] * (a0 * __builtin_amdgcn_rcpf(1.f + __expf(-a0))), ova[2 * j + 1] * rr * gga[2 * j + 1] * (a1 * __builtin_amdgcn_rcpf(1.f + __expf(-a1))));
                      wb[j] = cvtpk_bf16(ovb[2 * j] * rr * ggb[2 * j] * (b0 * __builtin_amdgcn_rcpf(1.f + __expf(-b0))), ovb[2 * j + 1] * rr * ggb[2 * j + 1] * (b1 * __builtin_amdgcn_rcpf(1.f + __expf(-b1)))); }
                  bf16* dst = MIXED + tok * DM + 512 + h * 128 + 8 * sg;
                  *(GAS v4u*)dst = (v4u){wa[0], wa[1], wa[2], wa[3]}; *(GAS v4u*)(dst + 64) = (v4u){wb[0], wb[1], wb[2], wb[3]}; }
            }
        }
    }
}
template <int N> __device__ __forceinline__ unsigned row_ror(unsigned x) { return (unsigned)__builtin_amdgcn_update_dpp((int)x, (int)x, 0x120 + N, 0xf, 0xf, false); }
__device__ __forceinline__ unsigned umax_(unsigned a, unsigned b) { return a > b ? a : b; }
__device__ __forceinline__ unsigned umin_(unsigned a, unsigned b) { return a < b ? a : b; }
__device__ __forceinline__ unsigned row_umax16(unsigned x) {
    unsigned y;
    asm volatile("s_nop 1\n\tv_max_u32_dpp %0, %1, %1 row_ror:1 row_mask:0xf bank_mask:0xf\n\t"
                 "s_nop 1\n\tv_max_u32_dpp %0, %0, %0 row_ror:2 row_mask:0xf bank_mask:0xf\n\t"
                 "s_nop 1\n\tv_max_u32_dpp %0, %0, %0 row_ror:4 row_mask:0xf bank_mask:0xf\n\t"
                 "s_nop 1\n\tv_max_u32_dpp %0, %0, %0 row_ror:8 row_mask:0xf bank_mask:0xf"
                 : "=&v"(y) : "v"(x));
    return y;
}
__device__ __forceinline__ float row_fsum16(float v) {
    v += __builtin_bit_cast(float, row_ror<1>(__builtin_bit_cast(unsigned, v))); v += __builtin_bit_cast(float, row_ror<2>(__builtin_bit_cast(unsigned, v)));
    v += __builtin_bit_cast(float, row_ror<4>(__builtin_bit_cast(unsigned, v))); v += __builtin_bit_cast(float, row_ror<8>(__builtin_bit_cast(unsigned, v))); return v; }
__device__ __forceinline__ unsigned h2key(unsigned x) { return (x & 0x80000000u) ? (~x & 0xffff0000u) : (x | 0x80000000u); }
__device__ __forceinline__ float hkey2f(unsigned k) { const unsigned hb = ((k & 0x80000000u) ? (k & 0x7fff0000u) : (~k & 0xffff0000u)) >> 16; return (float)__builtin_bit_cast(_Float16, (unsigned short)hb); }
__device__ __forceinline__ unsigned f2key(float f) { const unsigned u = __builtin_bit_cast(unsigned, f); return (u & 0x80000000u) ? ~u : (u | 0x80000000u); }
__device__ __forceinline__ float key2f(unsigned k) { const unsigned u = (k & 0x80000000u) ? (k & 0x7fffffffu) : ~k; return __builtin_bit_cast(float, u); }
__device__ __forceinline__ unsigned pair_code(int s) {
    if (s < 16) return (unsigned)s;
    if (s < 24) return 16u + (unsigned)(s - 16);
    if (s < 29) return 32u + (unsigned)(s - 24);
    if (s < 33) return 48u + (unsigned)(s - 29);
    if (s < 36) return 64u + (unsigned)(s - 33);
    if (s < 42) return 80u + 16u * (unsigned)((s - 36) >> 1) + (unsigned)((s - 36) & 1);
    if (s < 50) return 128u + 16u * (unsigned)(s - 42);
    return 0xFFu;
}
#define CAS_(a, b) do { const unsigned hi_ = umax_(a, b), lo_ = umin_(a, b); a = hi_; b = lo_; } while (0)
__device__ __forceinline__ void row_umax16_x2(unsigned xa, unsigned xb, unsigned& ya, unsigned& yb) {
    asm volatile("s_nop 1\n\tv_max_u32_dpp %0, %2, %2 row_ror:1 row_mask:0xf bank_mask:0xf\n\tv_max_u32_dpp %1, %3, %3 row_ror:1 row_mask:0xf bank_mask:0xf\n\t"
                 "s_nop 0\n\tv_max_u32_dpp %0, %0, %0 row_ror:2 row_mask:0xf bank_mask:0xf\n\tv_max_u32_dpp %1, %1, %1 row_ror:2 row_mask:0xf bank_mask:0xf\n\t"
                 "s_nop 0\n\tv_max_u32_dpp %0, %0, %0 row_ror:4 row_mask:0xf bank_mask:0xf\n\tv_max_u32_dpp %1, %1, %1 row_ror:4 row_mask:0xf bank_mask:0xf\n\t"
                 "s_nop 0\n\tv_max_u32_dpp %0, %0, %0 row_ror:8 row_mask:0xf bank_mask:0xf\n\tv_max_u32_dpp %1, %1, %1 row_ror:8 row_mask:0xf bank_mask:0xf"
                 : "=&v"(ya), "=&v"(yb) : "v"(xa), "v"(xb));
}
#define TK_LOADSORT(P, th_) \
    unsigned P##0, P##1, P##2, P##3, P##4, P##5, P##6, P##7; \
    { const v4u sv = *(const GAS v4u*)(SC + (size_t)((th_) >> 3) * 2048 + ((th_) & 7) * 256 + c * 128 + l15 * 8); const unsigned nb = 127u - 8u * (unsigned)l15; \
      P##0 = h2key(sv.x << 16) | nb; P##1 = h2key(sv.x & 0xffff0000u) | (nb - 1u); P##2 = h2key(sv.y << 16) | (nb - 2u); P##3 = h2key(sv.y & 0xffff0000u) | (nb - 3u); \
      P##4 = h2key(sv.z << 16) | (nb - 4u); P##5 = h2key(sv.z & 0xffff0000u) | (nb - 5u); P##6 = h2key(sv.w << 16) | (nb - 6u); P##7 = h2key(sv.w & 0xffff0000u) | (nb - 7u); \
      CAS_(P##0, P##1); CAS_(P##2, P##3); CAS_(P##4, P##5); CAS_(P##6, P##7); CAS_(P##0, P##2); CAS_(P##1, P##3); CAS_(P##4, P##6); CAS_(P##5, P##7); CAS_(P##1, P##2); CAS_(P##5, P##6); CAS_(P##0, P##4); CAS_(P##3, P##7); \
      CAS_(P##1, P##5); CAS_(P##2, P##6); CAS_(P##1, P##4); CAS_(P##3, P##6); CAS_(P##2, P##4); CAS_(P##3, P##5); CAS_(P##3, P##4); }
#define TK_POP(P, m_) do { const bool pop_ = (P##0 == (m_)); P##0 = pop_ ? P##1 : P##0; P##1 = pop_ ? P##2 : P##1; P##2 = pop_ ? P##3 : P##2; P##3 = pop_ ? P##4 : P##3; \
      P##4 = pop_ ? P##5 : P##4; P##5 = pop_ ? P##6 : P##5; P##6 = pop_ ? P##7 : P##6; P##7 = pop_ ? 0u : P##7; } while (0)
__device__ __forceinline__ void topk_stage1x2(const unsigned short* SC, int thA, int thB, int c, int l15, unsigned& resA, unsigned& resB) {
    TK_LOADSORT(ka, thA) TK_LOADSORT(kb, thB)
    unsigned ra = 0u, rb = 0u;
#pragma unroll
    for (int r = 0; r < 16; ++r) {
        unsigned ma, mb; row_umax16_x2(ka0, kb0, ma, mb);
        TK_POP(ka, ma); TK_POP(kb, mb);
        ra = (l15 == r) ? ma : ra; rb = (l15 == r) ? mb : rb;
    }
    resA = ra; resB = rb;
}
__device__ __forceinline__ void topk_v2(Frame& F) {
    const unsigned short* SC = (const unsigned short*)(F.ws + WS_SC); int* IDX = (int*)(F.ws + WS_IDX); float* GATE = (float*)(F.ws + WS_GATE); float* GSU = (float*)(F.ws + WS_GSU);
    const float* SU = (const float*)(F.ws + WS_SU); const float* SV = (const float*)(F.ws + WS_SV);
    const int gw = F.vcu * NWAVES + F.wave, NGW = F.G * NWAVES, lane = F.lane, l15 = lane & 15, row = lane >> 4, c = row & 1, rbase = lane & 48;
    const unsigned pc0 = pair_code(l15), pc1 = pair_code(l15 + 16), pc2 = pair_code(l15 + 32), pc3 = pair_code(l15 + 48);
    const int src1 = l15 + 32 * (row & 1), src2 = src1 + 16;
    for (int it0 = gw * 32; it0 < NTOK * 2; it0 += NGW * 32)
    for (int it = it0; it < it0 + 32; ++it) {
        const int thb = 4 * it;
        unsigned resA, resB; topk_stage1x2(SC, thb + (row >> 1), thb + 2 + (row >> 1), c, l15, resA, resB);
        const unsigned a1 = (unsigned)__shfl((int)resA, src1), a2 = (unsigned)__shfl((int)resA, src2), b1 = (unsigned)__shfl((int)resB, src1), b2 = (unsigned)__shfl((int)resB, src2);
        const unsigned S1 = row < 2 ? a1 : b1, S2 = row < 2 ? a2 : b2;
        unsigned c0, c1, c2, c3;
#define TK_CAND(CK, PC) do { const unsigned ka_ = (unsigned)__shfl((int)S1, rbase + (int)((PC) >> 4 & 15u)), kb_ = (unsigned)__shfl((int)S2, rbase + (int)((PC) & 15u)); \
            const float sm_ = hkey2f(ka_) + hkey2f(kb_); CK = (PC) == 0xFFu ? 0u : ((f2key(sm_) & ~0xFFu) | (255u - (PC))); } while (0)
        TK_CAND(c0, pc0); TK_CAND(c1, pc1); TK_CAND(c2, pc2); TK_CAND(c3, pc3);
#undef TK_CAND
        CAS_(c0, c1); CAS_(c2, c3); CAS_(c0, c2); CAS_(c1, c3); CAS_(c1, c2);
        unsigned res2 = 0u;
#pragma unroll
        for (int r = 0; r < 16; ++r) {
            const unsigned m = row_umax16(c0); const bool pop = (c0 == m);
            c0 = pop ? c1 : c0; c1 = pop ? c2 : c1; c2 = pop ? c3 : c2; c3 = pop ? 0u : c3;
            res2 = (l15 == r) ? m : res2;
        }
        const unsigned code = 255u - (res2 & 0xFFu);
        const unsigned ka = (unsigned)__shfl((int)S1, rbase + (int)(code >> 4 & 15u)), kb = (unsigned)__shfl((int)S2, rbase + (int)(code & 15u));
        const float ts = hkey2f(ka) + hkey2f(kb);
        const int e = (int)((127u - (ka & 0x7Fu)) * 128u + (127u - (kb & 0x7Fu)));
        const float tmax = __builtin_bit_cast(float, (unsigned)__shfl((int)__builtin_bit_cast(unsigned, ts), rbase));
        const float ex = __expf(ts - tmax);
        const float sum = row_fsum16(ex);
        const int th = thb + row;
        const size_t o = (size_t)(th >> 3) * NEXP_SEL + (th & 7) * 16 + l15;
        IDX[o] = e; GATE[o] = ex / sum * SV[e]; GSU[o] = SU[e];
    }
}

constexpr int PG_TOK = 16;
constexpr int PG_IDX = 0, PG_HID = 4096, PG_SA = PG_HID + 8192, PG_TB = PG_SA + 64, PG_WB = PG_TB + 4096;
static_assert(PG_WB % 16 == 0 && PG_TB % 16 == 0 && NWAVES * PG_WB <= RING_BYTES, "gather LDS map");
__device__ __forceinline__ void peer_sliced(Frame& F) {
    const unsigned char* U8T = F.ws + WS_U8; const unsigned char* V8T = F.ws + WS_V8; const unsigned char* X8 = F.ws + WS_X8;
    const float* SSQ = (const float*)(F.ws + WS_CTL) + CW_SSQ;
    const int* IDX = (const int*)(F.ws + WS_IDX); const float* GATE = (const float*)(F.ws + WS_GATE); const float* GSU = (const float*)(F.ws + WS_GSU); const float* gf = F.in[17];
    bf16* PO = (bf16*)(F.ws + WS_PO); const bf16* HB = (const bf16*)(F.ws + WS_HN2);
    const int gw = F.vcu * NWAVES + F.wave, NGW = F.G * NWAVES, lane = F.lane, m = lane & 15, g = lane >> 4;
    const int row8 = lane >> 3, piece = lane & 7;
    LAS unsigned char* wb = F.lds + F.wave * PG_WB;
    LAS unsigned short* idxs = (LAS unsigned short*)(wb + PG_IDX);
    LAS float* hid = (LAS float*)(wb + PG_HID);
    LAS float* sqp = hid + 64 + lane;
    LAS float* sai = (LAS float*)(wb + PG_SA);
    LAS unsigned char* tb = wb + PG_TB;
    const int p8 = m & 7; const unsigned bsh = 8u * (unsigned)(p8 & 3); const bool bhi = (p8 >> 2) != 0;
    constexpr size_t SLICE = (size_t)16384 * 128;
    const int usw = 16 * (piece ^ ((row8 >> 1) & 3));
    const int urd0 = m * 128 + 16 * ((2 * g) ^ ((m >> 1) & 7)), urd1 = m * 128 + 16 * ((2 * g + 1) ^ ((m >> 1) & 7));
    for (int blk = gw; blk < NTOK / PG_TOK; blk += NGW) {
        const int t0 = blk * PG_TOK;
#pragma unroll
        for (int k = 0; k < 32; ++k) { const int id = lane + 64 * k; idxs[id] = (unsigned short)IDX[(size_t)t0 * NEXP_SEL + id]; }
        LDS_WAIT(); asm volatile("" ::: "memory");
        for (int p = 0; p < 8; ++p) {
            const unsigned char* Up = U8T + (size_t)p * SLICE;
            const unsigned char* Xp = X8 + (size_t)t0 * DM + 128 * p + 32 * g;
            v4u ab[2][16]; l2 xs[2][2];
#define PGU_ISSUE(i_, buf_) do { _Pragma("unroll") for (int k = 0; k < 16; ++k) { const unsigned e = idxs[(i_) * 128 + 8 * k + row8]; \
                ab[buf_][k] = *(const GAS v4u*)(Up + (size_t)e * 128 + (usw ^ ((k & 1) ? 64 : 0))); } \
                xs[buf_][0] = *(const GAS l2*)(Xp + (size_t)(i_) * DM); xs[buf_][1] = *(const GAS l2*)(Xp + (size_t)(i_) * DM + 16); } while (0)
#define PGU_BODY(i_, cur_, nxt_) do { if ((i_) + 1 < PG_TOK) PGU_ISSUE((i_) + 1, nxt_); SCHED_FENCE(); \
                _Pragma("unroll") for (int rb = 0; rb < 4; ++rb) { LAS f32x4* hp0 = (LAS f32x4*)(hid + (i_) * 128 + 32 * rb + 4 * g); LAS f32x4* hp1 = hp0 + 4; \
                    _Pragma("unroll") for (int q4 = 0; q4 < 4; ++q4) *(LAS v4u*)(tb + 1024 * q4 + 16 * lane) = ab[cur_][4 * rb + q4]; \
                    f32x4 acc0 = p == 0 ? (f32x4){0.f, 0.f, 0.f, 0.f} : *hp0, acc1 = p == 0 ? (f32x4){0.f, 0.f, 0.f, 0.f} : *hp1; \
                    const l2 a0 = *(const LAS l2*)(tb + urd0), a1 = *(const LAS l2*)(tb + urd1), b0 = *(const LAS l2*)(tb + 2048 + urd0), b1 = *(const LAS l2*)(tb + 2048 + urd1); \
                    acc0 = __builtin_amdgcn_mfma_f32_16x16x32_fp8_bf8(a0.x, xs[cur_][0].x, acc0, 0, 0, 0); acc1 = __builtin_amdgcn_mfma_f32_16x16x32_fp8_bf8(b0.x, xs[cur_][0].x, acc1, 0, 0, 0); \
                    acc0 = __builtin_amdgcn_mfma_f32_16x16x32_fp8_bf8(a0.y, xs[cur_][0].y, acc0, 0, 0, 0); acc1 = __builtin_amdgcn_mfma_f32_16x16x32_fp8_bf8(b0.y, xs[cur_][0].y, acc1, 0, 0, 0); \
                    acc0 = __builtin_amdgcn_mfma_f32_16x16x32_fp8_bf8(a1.x, xs[cur_][1].x, acc0, 0, 0, 0); acc1 = __builtin_amdgcn_mfma_f32_16x16x32_fp8_bf8(b1.x, xs[cur_][1].x, acc1, 0, 0, 0); \
                    acc0 = __builtin_amdgcn_mfma_f32_16x16x32_fp8_bf8(a1.y, xs[cur_][1].y, acc0, 0, 0, 0); acc1 = __builtin_amdgcn_mfma_f32_16x16x32_fp8_bf8(b1.y, xs[cur_][1].y, acc1, 0, 0, 0); \
                    if (m == 0) { *hp0 = acc0; *hp1 = acc1; } } SCHED_FENCE(); } while (0)
            PGU_ISSUE(0, 0);
            for (int i2 = 0; i2 < PG_TOK; i2 += 2) { PGU_BODY(i2, 0, 1); PGU_BODY(i2 + 1, 1, 0); }
#undef PGU_ISSUE
#undef PGU_BODY
            LDS_WAIT(); asm volatile("" ::: "memory");
        }
        for (int i = 0; i < PG_TOK; ++i) {
            const int t = t0 + i; const float sx = 1.f / sqrtf(SSQ[t] * (1.f / DM) + EPS);
            float w[8][4]; float amax = 0.f;
#pragma unroll
            for (int r = 0; r < 8; ++r) { const f32x4 h4 = *(const LAS f32x4*)(hid + i * 128 + 16 * r + 4 * g);
                const f32x4 su4 = *(const GAS f32x4*)(GSU + (size_t)t * NEXP_SEL + 16 * r + 4 * g), gv4 = *(const GAS f32x4*)(GATE + (size_t)t * NEXP_SEL + 16 * r + 4 * g);
#pragma unroll
                for (int j = 0; j < 4; ++j) { w[r][j] = gelu_as(h4[j] * su4[j] * sx) * gv4[j]; amax = fmaxf(amax, fabsf(w[r][j])); } }
            amax = fmaxf(amax, __shfl_xor(amax, 16)); amax = fmaxf(amax, __shfl_xor(amax, 32));
            const float sa = amax > 0.f ? 224.f / amax : 1.f;
            LDS_WAIT(); asm volatile("" ::: "memory");
            if (m == 0) {
                LAS unsigned char* wrow = (LAS unsigned char*)(hid + i * 128);
#pragma unroll
                for (int r = 0; r < 8; ++r) { int pk = __builtin_amdgcn_cvt_pk_fp8_f32(w[r][0] * sa, w[r][1] * sa, 0, false); pk = __builtin_amdgcn_cvt_pk_fp8_f32(w[r][2] * sa, w[r][3] * sa, pk, true);
                    wrow[4 * r + g] = (unsigned char)pk; wrow[32 + 4 * r + g] = (unsigned char)(pk >> 8); wrow[64 + 4 * r + g] = (unsigned char)(pk >> 16); wrow[96 + 4 * r + g] = (unsigned char)(pk >> 24); }
            }
            if (lane == 0) sai[i] = amax > 0.f ? amax * (1.f / 224.f) : 1.f;
        }
        LDS_WAIT(); asm volatile("" ::: "memory");
        for (int p = 0; p < 8; ++p) {
            const unsigned char* Vp = V8T + (size_t)p * SLICE + 16 * piece;
            v4u va[2][16];
#define PGV_ISSUE(i_, buf_) do { _Pragma("unroll") for (int k = 0; k < 16; ++k) { const unsigned e = idxs[(i_) * 128 + 8 * k + row8]; va[buf_][k] = *(const GAS v4u*)(Vp + (size_t)e * 128); } } while (0)
#define PGV_BODY(i_, cur_, nxt_) do { if ((i_) + 1 < PG_TOK) PGV_ISSUE((i_) + 1, nxt_); \
                const LAS v4u* wp = (const LAS v4u*)((LAS unsigned char*)(hid + (i_) * 128) + 32 * g); const v4u w0 = wp[0], w1 = wp[1]; \
                const unsigned ww[8] = {w0.x, w0.y, w0.z, w0.w, w1.x, w1.y, w1.z, w1.w}; \
                SCHED_FENCE(); f32x4 c = (f32x4){0.f, 0.f, 0.f, 0.f}; \
                _Pragma("unroll") for (int kb = 0; kb < 4; ++kb) { \
                    _Pragma("unroll") for (int q4 = 0; q4 < 4; ++q4) *(LAS v4u*)(tb + 1024 * q4 + 16 * lane) = va[cur_][4 * kb + q4]; \
                    long rr_[8]; \
                    _Pragma("unroll") for (int q4 = 0; q4 < 4; ++q4) { rr_[2 * q4] = *(const LAS long*)(tb + 1024 * q4 + g * 128 + 8 * m); rr_[2 * q4 + 1] = *(const LAS long*)(tb + 1024 * q4 + (4 + g) * 128 + 8 * m); } \
                    _Pragma("unroll") for (int q8 = 0; q8 < 8; ++q8) { const int q = 8 * kb + q8; const unsigned a8 = ((ww[q >> 2] >> (8 * (q & 3))) & 0xffu) << bsh; const long bop = (long)(bhi ? ((unsigned long long)a8 << 32) : (unsigned long long)a8); \
                      c = __builtin_amdgcn_mfma_f32_16x16x32_fp8_fp8(rr_[q8], bop, c, 0, 0, 0); } } \
                SCHED_FENCE(); \
                { const float isa = sai[i_]; LAS unsigned short* ob = (LAS unsigned short*)(tb) + 32 * g + (m & 7);         \
                  if (m < 8) { ob[0] = (unsigned short)f2bf(c[0] * isa); ob[8] = (unsigned short)f2bf(c[1] * isa); ob[16] = (unsigned short)f2bf(c[2] * isa); ob[24] = (unsigned short)f2bf(c[3] * isa); } \
                  const v4u ov = *(const LAS v4u*)(tb + 16 * (lane & 15)); \
                  if (lane < 16) *(GAS v4u*)(PO + (size_t)(t0 + (i_)) * DM + 128 * p + 8 * lane) = ov; } } while (0)
            PGV_ISSUE(0, 0);
            for (int i2 = 0; i2 < PG_TOK; i2 += 2) { PGV_BODY(i2, 0, 1); PGV_BODY(i2 + 1, 1, 0); }
#undef PGV_ISSUE
#undef PGV_BODY
        }
        LDS_WAIT(); asm volatile("" ::: "memory");
        VM_WAIT();
        for (int i = 0; i < PG_TOK; i += 2) {
            GAS f32x4* hrA = (GAS f32x4*)(F.out + (size_t)(t0 + i) * DM) + lane; GAS f32x4* hrB = hrA + DM / 4;
            const GAS v2u* prA = (const GAS v2u*)(PO + (size_t)(t0 + i) * DM) + lane; const GAS v2u* prB = prA + DM / 4;
            const GAS v2u* hbA = (const GAS v2u*)(HB + (size_t)(t0 + i) * DM) + lane; const GAS v2u* hbB = hbA + DM / 4;
            v2u pa[4], pb[4], ha[4], hb2[4];
#pragma unroll
            for (int j = 0; j < 4; ++j) { pa[j] = prA[64 * j]; ha[j] = hbA[64 * j]; pb[j] = prB[64 * j]; hb2[j] = hbB[64 * j]; }
            f32x4 ya[4], yb[4]; float sa = 0.f, sb = 0.f;
#pragma unroll
            for (int j = 0; j < 4; ++j) {
                ya[j] = (f32x4){bflo(ha[j].x), bfhi(ha[j].x), bflo(ha[j].y), bfhi(ha[j].y)} + (f32x4){bflo(pa[j].x), bfhi(pa[j].x), bflo(pa[j].y), bfhi(pa[j].y)};
                yb[j] = (f32x4){bflo(hb2[j].x), bfhi(hb2[j].x), bflo(hb2[j].y), bfhi(hb2[j].y)} + (f32x4){bflo(pb[j].x), bfhi(pb[j].x), bflo(pb[j].y), bfhi(pb[j].y)};
                sa += (ya[j].x * ya[j].x + ya[j].y * ya[j].y) + (ya[j].z * ya[j].z + ya[j].w * ya[j].w); sb += (yb[j].x * yb[j].x + yb[j].y * yb[j].y) + (yb[j].z * yb[j].z + yb[j].w * yb[j].w); }
#pragma unroll
            for (int o = 1; o < 64; o <<= 1) { sa += __shfl_xor(sa, o); sb += __shfl_xor(sb, o); }
            const float ra = 1.f / sqrtf(sa * (1.f / DM) + EPS), rb = 1.f / sqrtf(sb * (1.f / DM) + EPS);
#pragma unroll
            for (int j = 0; j < 4; ++j) { const f32x4 gg = *((const GAS f32x4*)gf + lane + 64 * j); hrA[64 * j] = ya[j] * ra * gg; hrB[64 * j] = yb[j] * rb * gg; }
        }
        LDS_WAIT(); asm volatile("" ::: "memory");
    }
}

struct Args { const float* in[18]; float* out; unsigned char* ws; int ph_lo, ph_hi; };
__global__ void __launch_bounds__(NWAVES * 64, 2) hymba_fwd(Args args) {
    extern __shared__ __attribute__((aligned(16))) unsigned char lds[];
    Frame F;
    F.lds = (LAS unsigned char*)lds;
    F.MISC = (volatile LAS unsigned*)(F.lds + MISC_OFF);
    F.tid = threadIdx.x; F.lane = F.tid & 63; F.wave = __builtin_amdgcn_readfirstlane(F.tid >> 6);
    F.G = gridDim.x; { const int bx = blockIdx.x; F.vcu = (F.G % 8 == 0) ? (bx % 8) * (F.G / 8) + bx / 8 : bx; }
#pragma unroll
    for (int i = 0; i < 18; ++i) F.in[i] = args.in[i];
    F.out = args.out; F.ws = args.ws;
    for (int u = F.tid; u < (LDS_BYTES - LDSCTL_OFF) / 4; u += NWAVES * 64) ((LAS unsigned*)(F.lds + LDSCTL_OFF))[u] = 0u;
    __syncthreads();
    const int lo = args.ph_lo, hi = args.ph_hi;
    const bool multi = (hi - lo) > 1;
    XcdBarrier bar; bar.bar = (unsigned*)(F.ws + WS_CTL) + CW_BAR; bar.x = 0; bar.st = nullptr;
    if (multi) bar = xcd_barrier_post((unsigned*)(F.ws + WS_CTL) + CW_BAR, F.MISC + 8);
#define IN(k) (lo <= (k) && (k) < hi)
#define SEAM(k) do { if (IN(k) && IN((k) + 1)) xcd_barrier(bar); } while (0)

    if (IN(0)) { p0_prologue(F); } SEAM(0);
    if (IN(1)) {
        pg8::Gemm g{(const pg8::bf16_t*)(F.ws + WS_HN), (const pg8::bf16_t*)(F.ws + WS_WIN), NTOK, INW, DM}; pg8::StaticOrder S; S.init(NTOK, INW, F.G, (int)blockIdx.x);
        pg8::EpiProj E{(pg8::bf16_t*)(F.ws + WS_PROJ), INW, 2, QSCALE};
        pg8::gemm_phase<pg8::EpiProj, pg8::StaticOrder, PG8_ALIGN, PG8_SP2>(F.lds + RING_OFF, g, S, E);
    } SEAM(1);
    if (IN(2)) { hgrn_mfma(F); }
    if (IN(3)) { quant_drain(F); attn_mfma(F, 0); }
    if (IN(3) && IN(4)) xcd_barrier(bar);
    if (IN(4)) {
        pg8::Gemm g{(const pg8::bf16_t*)(F.ws + WS_HN), (const pg8::bf16_t*)(F.ws + WS_WOUT), NTOK, DM, DM}; pg8::StaticOrder S; S.init(NTOK, DM, F.G, (int)blockIdx.x);
        pg8::EpiMix E{DM, F.in[0], F.in[12], (pg8::bf16_t*)(F.ws + WS_HN2), F.ws + WS_X8, (float*)(F.ws + WS_CTL) + CW_SSQ};
        pg8::gemm_phase<pg8::EpiMix, pg8::StaticOrder, PG8_ALIGN, PG8_SP2>(F.lds + RING_OFF, g, S, E);
    }
    if (IN(4) && IN(6)) xcd_barrier(bar);
    if (IN(6)) {
        pg8::Gemm g{(const pg8::bf16_t*)(F.ws + WS_HN2), (const pg8::bf16_t*)(F.ws + WS_W2), NTOK, 2048, DM}; pg8::StaticOrder S; S.init(NTOK, 2048, F.G, (int)blockIdx.x);
        pg8::EpiScaleRow E{(_Float16*)(F.ws + WS_SC), 2048, (const float*)(F.ws + WS_CTL) + CW_SSQ, 1.f / DM, EPS};
        pg8::gemm_phase<pg8::EpiScaleRow, pg8::StaticOrder, PG8_ALIGN, PG8_SP2>(F.lds + RING_OFF, g, S, E);
    } SEAM(6);
    if (IN(7)) { topk_v2(F); }
    if (IN(7) && IN(8)) { VM_WAIT(); }
    if (IN(8)) { peer_sliced(F); }
#undef IN
#undef SEAM
}

extern "C" void kernel_launch(void* const* d_in, const int* in_sizes, int n_in, void* d_out, int out_size, void* d_ws, size_t ws_size, hipStream_t stream) {
    static int grid = 0;
    if (grid == 0) {
        if (n_in != 18 || in_sizes[0] != NTOK * DM || out_size != NTOK * DM || ws_size < WS_END) { fprintf(stderr, "kernel_launch: unexpected shapes (n_in %d, in0 %d, out %d, ws %zu); nothing launched\n", n_in, n_in > 0 ? in_sizes[0] : -1, out_size, ws_size); grid = -1; return; }
        int dev = 0, cus = 0, per_cu = 0;
        if (hipGetDevice(&dev) != hipSuccess || hipDeviceGetAttribute(&cus, hipDeviceAttributeMultiprocessorCount, dev) != hipSuccess) { grid = -1; return; }
        if (hipFuncSetAttribute((const void*)hymba_fwd, hipFuncAttributeMaxDynamicSharedMemorySize, LDS_BYTES) != hipSuccess) { fprintf(stderr, "kernel_launch: hipFuncSetAttribute failed\n"); grid = -1; return; }
        if (hipOccupancyMaxActiveBlocksPerMultiprocessor(&per_cu, (const void*)hymba_fwd, NWAVES * 64, LDS_BYTES) != hipSuccess || per_cu < 1)
            fprintf(stderr, "kernel_launch: note: occupancy query reports %d workgroups per CU\n", per_cu);
        (void)hipGetLastError();
        grid = cus;
    }
    if (grid < 0) return;
    if (hipMemsetAsync((char*)d_ws + WS_CTL, 0, CTL_ZERO_BYTES, stream) != hipSuccess) return;
    Args a{};
    for (int i = 0; i < 18; ++i) a.in[i] = (const float*)d_in[i];
    a.out = (float*)d_out; a.ws = (unsigned char*)d_ws; a.ph_lo = 0; a.ph_hi = 9;
    hipLaunchKernelGGL(hymba_fwd, dim3(grid), dim3(NWAVES * 64), LDS_BYTES, stream, a);
}
```

```cpp
#include <hip/hip_runtime.h>
#include <cstdio>
#include <cstdint>
#include <cmath>
namespace pg8 {
#define PG8_LAS __attribute__((address_space(3)))
typedef unsigned short bf16_t;
typedef short bf16x8 __attribute__((ext_vector_type(8)));
typedef float f32x4 __attribute__((ext_vector_type(4)));
typedef unsigned u32x4 __attribute__((ext_vector_type(4)));
constexpr int BM = 256, BK = 64, HALF = 128, HTB = HALF * BK * 2  , STAGE_BYTES = 8 * HTB, NXCD = 8, WGM = 8;

__host__ __device__ __forceinline__ int lds_byte(int r, int c) { const int st = (r >> 4) * 2 + (c >> 5), rr = r & 15, cc = c & 31, ob = rr * 64 + cc * 2; return st * 1024 + (ob ^ (((ob >> 9) & 1) << 5)); }
__host__ __device__ __forceinline__ void stage_rc(int b, int& R, int& C) { const int st = b / 1024, sb = b % 1024, swz = sb ^ (((sb >> 9) & 1) << 5); R = (st >> 1) * 16 + swz / 64; C = (st & 1) * 32 + (swz % 64) / 2; }
__host__ __device__ __forceinline__ int perm32(int rho) { const int n = rho >> 4, i = rho & 15; return 8 * (i >> 2) + 4 * n + (i & 3); }

struct Unit { int pm, pn; };
struct Gemm { const bf16_t* A; const bf16_t* Bt; int M, N, K; };

struct StaticOrder {
    int nM, nN, nwg, G, c;
    __host__ __device__ void init(int M, int N, int G_, int c_) { nM = M / BM; nN = N / BM; nwg = nM * nN; G = G_; c = c_; }
    __host__ __device__ bool next(int i, Unit& u) const {
        const long L = (long)i * G + c; if (L >= nwg) return false;
        int wgid = (int)L; { const int q = nwg / NXCD, r = nwg % NXCD, xcd = wgid % NXCD, off = wgid / NXCD; wgid = (xcd < r ? xcd * (q + 1) : r * (q + 1) + (xcd - r) * q) + off; }
        const int nig = WGM * nN, gid = wgid / nig, fm = gid * WGM, gsz = (nM - fm) < WGM ? (nM - fm) : WGM;
        u.pm = fm + ((wgid % nig) % gsz); u.pn = (wgid % nig) / gsz; return true;
    }
    __device__ __forceinline__ void a_ready(const Unit&) const {}
    __device__ __forceinline__ void done(const Unit&) const {}
};
__device__ __forceinline__ unsigned cvt_pk_bf16(float lo, float hi) { unsigned r; asm volatile("v_cvt_pk_bf16_f32 %0, %1, %2" : "=v"(r) : "v"(lo), "v"(hi)); return r; }
typedef float f32x2 __attribute__((ext_vector_type(2)));
__device__ __forceinline__ f32x2 gelu_pk(f32x2 v) {
    const f32x2 av = __builtin_elementwise_abs(v), d = av * 0.2316418882f + 1.0f;
    f32x2 t; t.x = __builtin_amdgcn_rcpf(d.x); t.y = __builtin_amdgcn_rcpf(d.y);
    f32x2 q = t * 0.5307027145f + (-0.7265760135f); q = q * t + 0.7107068705f; q = q * t + (-0.142248368f); q = q * t + 0.127414796f; q = q * t;
    const f32x2 s = (v * v) * (-0.72134752044f);
    f32x2 e; e.x = __builtin_amdgcn_exp2f(s.x); e.y = __builtin_amdgcn_exp2f(s.y);
    const f32x2 m = v * (q * e), r = v - m;
    f32x2 o; o.x = v.x < 0.f ? m.x : r.x; o.y = v.y < 0.f ? m.y : r.y; return o;
}
struct EpiProj {
    static constexpr bool PERM = true, AFTER_DRAIN = false;
    bf16_t* O; int ldc; int qtiles; float qscale;
    __device__ __forceinline__ void operator()(const f32x4 (&acc)[2][2][4][2], const Unit& u, int wr, int wc, int fr, int fq) const {
        const int row0 = u.pm * BM + wr * 64 + fr, col0 = u.pn * BM + wc * 32 + 8 * fq;
        const float sc = (u.pn < qtiles) ? qscale : 1.f;
#pragma unroll
        for (int ai = 0; ai < 2; ++ai)
#pragma unroll
            for (int m = 0; m < 4; ++m) { bf16_t* rowp = O + (size_t)(row0 + ai * HALF + m * 16) * ldc + col0;
#pragma unroll
                for (int bj = 0; bj < 2; ++bj) { const f32x4 v0 = acc[ai][bj][m][0] * sc, v1 = acc[ai][bj][m][1] * sc;
                    u32x4 w; w.x = cvt_pk_bf16(v0[0], v0[1]); w.y = cvt_pk_bf16(v0[2], v0[3]); w.z = cvt_pk_bf16(v1[0], v1[1]); w.w = cvt_pk_bf16(v1[2], v1[3]);
                    *(u32x4*)(rowp + bj * HALF) = w; } }
    }
};
struct EpiF32Res {
    static constexpr bool PERM = false, AFTER_DRAIN = false;
    float* C; int ldc; const float* res;
    __device__ __forceinline__ void operator()(const f32x4 (&acc)[2][2][4][2], const Unit& u, int wr, int wc, int fr, int fq) const {
        const int row0 = u.pm * BM + wr * 64 + fr, col0 = u.pn * BM + wc * 32 + 4 * fq;
#pragma unroll
        for (int ai = 0; ai < 2; ++ai)
#pragma unroll
            for (int m = 0; m < 4; ++m) { const size_t off = (size_t)(row0 + ai * HALF + m * 16) * ldc + col0;
#pragma unroll
                for (int bj = 0; bj < 2; ++bj)
#pragma unroll
                    for (int n = 0; n < 2; ++n) { f32x4 o = acc[ai][bj][m][n]; if (res) o = o + *(const f32x4*)(res + off + bj * HALF + n * 16);
                        *(f32x4*)(C + off + bj * HALF + n * 16) = o; } }
    }
};

struct EpiMix {
    static constexpr bool PERM = true, AFTER_DRAIN = false;
    int ldc; const float* res; const float* g2; bf16_t* HB; unsigned char* XB; float* ssq;
    __device__ __forceinline__ void operator()(const f32x4 (&acc)[2][2][4][2], const Unit& u, int wr, int wc, int fr, int fq) const {
        const int row0 = u.pm * BM + wr * 64 + fr, col0 = u.pn * BM + wc * 32 + 8 * fq;
        f32x4 gv[2][2];
#pragma unroll
        for (int bj = 0; bj < 2; ++bj)
#pragma unroll
            for (int n = 0; n < 2; ++n) gv[bj][n] = *(const f32x4*)(g2 + col0 + bj * HALF + 4 * n);
#pragma unroll
        for (int ai = 0; ai < 2; ++ai)
#pragma unroll
            for (int m = 0; m < 4; ++m) { const int row = row0 + ai * HALF + m * 16; const size_t off = (size_t)row * ldc + col0; float sq = 0.f;
#pragma unroll
                for (int bj = 0; bj < 2; ++bj) {
                    const f32x4 h0 = acc[ai][bj][m][0] + *(const f32x4*)(res + off + bj * HALF), h1 = acc[ai][bj][m][1] + *(const f32x4*)(res + off + bj * HALF + 4);
                    sq += (h0[0] * h0[0] + h0[1] * h0[1]) + (h0[2] * h0[2] + h0[3] * h0[3]) + (h1[0] * h1[0] + h1[1] * h1[1]) + (h1[2] * h1[2] + h1[3] * h1[3]);
                    u32x4 w; w.x = cvt_pk_bf16(h0[0], h0[1]); w.y = cvt_pk_bf16(h0[2], h0[3]); w.z = cvt_pk_bf16(h1[0], h1[1]); w.w = cvt_pk_bf16(h1[2], h1[3]);
                    *(u32x4*)(HB + off + bj * HALF) = w;
                    const f32x4 g0 = h0 * gv[bj][0], g1 = h1 * gv[bj][1];
                    int p0 = __builtin_amdgcn_cvt_pk_bf8_f32(g0[0], g0[1], 0, false); p0 = __builtin_amdgcn_cvt_pk_bf8_f32(g0[2], g0[3], p0, true);
                    int p1 = __builtin_amdgcn_cvt_pk_bf8_f32(g1[0], g1[1], 0, false); p1 = __builtin_amdgcn_cvt_pk_bf8_f32(g1[2], g1[3], p1, true);
                    typedef unsigned u32x2 __attribute__((ext_vector_type(2)));
                    *(u32x2*)(XB + off + bj * HALF) = (u32x2){(unsigned)p0, (unsigned)p1}; }
                sq += __shfl_xor(sq, 16); sq += __shfl_xor(sq, 32);
                if (fq == 0) atomicAdd(ssq + row, sq); }
    }
};
struct EpiScaleRow {
    static constexpr bool PERM = true, AFTER_DRAIN = false;
    _Float16* C; int ldc; const float* ssq; float invk, eps;
    __device__ __forceinline__ void operator()(const f32x4 (&acc)[2][2][4][2], const Unit& u, int wr, int wc, int fr, int fq) const {
        typedef _Float16 h2 __attribute__((ext_vector_type(2)));
        const int row0 = u.pm * BM + wr * 64 + fr, col0 = u.pn * BM + wc * 32 + 8 * fq;
#pragma unroll
        for (int ai = 0; ai < 2; ++ai)
#pragma unroll
            for (int m = 0; m < 4; ++m) { const int row = row0 + ai * HALF + m * 16; const size_t off = (size_t)row * ldc + col0; const float rs = 1.f / sqrtf(ssq[row] * invk + eps);
#pragma unroll
                for (int bj = 0; bj < 2; ++bj) { const f32x4 v0 = acc[ai][bj][m][0] * rs, v1 = acc[ai][bj][m][1] * rs;
                    const h2 p0 = {(_Float16)v0[0], (_Float16)v0[1]}, p1 = {(_Float16)v0[2], (_Float16)v0[3]}, p2 = {(_Float16)v1[0], (_Float16)v1[1]}, p3 = {(_Float16)v1[2], (_Float16)v1[3]};
                    u32x4 w; w.x = __builtin_bit_cast(unsigned, p0); w.y = __builtin_bit_cast(unsigned, p1); w.z = __builtin_bit_cast(unsigned, p2); w.w = __builtin_bit_cast(unsigned, p3);
                    *(u32x4*)(C + off + bj * HALF) = w; } }
    }
};
template <class Epi, class Sched, bool ALIGN_EPI = false, bool SP2 = false>
__device__ __forceinline__ void gemm_phase(PG8_LAS unsigned char* lds, const Gemm g, const Sched& S, const Epi& E) {
    const int tid = threadIdx.x, wid = __builtin_amdgcn_readfirstlane(tid >> 6), lane = tid & 63, wr = wid >> 2, wc = wid & 3, fr = lane & 15, fq = lane >> 4;
    const int K = g.K, nt = K / BK;
    unsigned voffA[2], voffB[2];
#pragma unroll
    for (int i = 0; i < 2; ++i) { int R, C; stage_rc(tid * 16 + i * 8192, R, C); const int Rb = Epi::PERM ? ((R & ~31) + perm32(R & 31)) : R;
        voffA[i] = (unsigned)(R * K + C) * 2u; voffB[i] = (unsigned)(Rb * K + C) * 2u; }
    const size_t kstep = (size_t)(BK * 2);
    const size_t hstep = (size_t)HALF * K * 2;
    const size_t tstep = 2 * hstep;
    const unsigned ldsw = (unsigned)wid * 1024u;
    const int aoff = lds_byte(wr * 64 + fr, fq * 8), boff = lds_byte(wc * 32 + fr, fq * 8);
#define PG8_SA(b, h) (((b) * 2 + (h)) * HTB)
#define PG8_SB(b, h) ((4 + (b) * 2 + (h)) * HTB)
#define PG8_STAGE(bufoff, gbase, voff) do { _Pragma("unroll") for (int _i = 0; _i < 2; ++_i) \
        __builtin_amdgcn_global_load_lds((const unsigned*)((const char*)(gbase) + (voff)[_i]), (PG8_LAS unsigned*)(lds + (bufoff) + ldsw + _i * 8192), 16, 0, 0); } while (0)
#define PG8_LDA(dst, b, h) do { _Pragma("unroll") for (int m = 0; m < 4; ++m) _Pragma("unroll") for (int k = 0; k < 2; ++k) dst[m][k] = *(const PG8_LAS bf16x8*)(lds + PG8_SA(b, h) + aoff + m * 2048 + k * 1024); } while (0)
#define PG8_LDB(dst, b, h) do { _Pragma("unroll") for (int n = 0; n < 2; ++n) _Pragma("unroll") for (int k = 0; k < 2; ++k) dst[n][k] = *(const PG8_LAS bf16x8*)(lds + PG8_SB(b, h) + boff + n * 2048 + k * 1024); } while (0)
#define PG8_MMA(ai, bj, At, Bt) do { __builtin_amdgcn_s_setprio(1); _Pragma("unroll") for (int m = 0; m < 4; ++m) _Pragma("unroll") for (int n = 0; n < 2; ++n) _Pragma("unroll") for (int k = 0; k < 2; ++k) \
        acc[ai][bj][m][n] = __builtin_amdgcn_mfma_f32_16x16x32_bf16(Bt[n][k], At[m][k], acc[ai][bj][m][n], 0, 0, 0); __builtin_amdgcn_s_setprio(0); } while (0)
#define PG8_WAIT_V(n) asm volatile("s_waitcnt vmcnt(" #n ")" ::: "memory")
#define PG8_WAIT_L(n) asm volatile("s_waitcnt lgkmcnt(" #n ")" ::: "memory")
#define PG8_BAR __builtin_amdgcn_s_barrier()
#define PG8_SCHED __builtin_amdgcn_sched_barrier(0)
    Unit cur, nxt; int ui = 0;
    if (!S.next(0, cur)) return;
    f32x4 acc[2][2][4][2];
#pragma unroll
    for (int a = 0; a < 2; ++a)
#pragma unroll
        for (int b = 0; b < 2; ++b)
#pragma unroll
            for (int m = 0; m < 4; ++m)
#pragma unroll
                for (int n = 0; n < 2; ++n) acc[a][b][m][n] = (f32x4){0.f, 0.f, 0.f, 0.f};
    bf16x8 At[4][2], B0[2][2], B1[2][2];
    const char* cA = (const char*)g.A + (size_t)cur.pm * tstep; const char* cB = (const char*)g.Bt + (size_t)cur.pn * tstep;
    S.a_ready(cur);
    if constexpr (SP2) {
        PG8_STAGE(PG8_SB(0, 0), cB, voffB); PG8_STAGE(PG8_SB(0, 1), cB + hstep, voffB); PG8_STAGE(PG8_SA(0, 0), cA, voffA); PG8_STAGE(PG8_SA(0, 1), cA + hstep, voffA);
        if (wr == 1) PG8_BAR;
        PG8_WAIT_V(2); PG8_BAR;
        PG8_STAGE(PG8_SB(1, 0), cB + kstep, voffB); PG8_STAGE(PG8_SA(1, 0), cA + kstep, voffA); PG8_STAGE(PG8_SB(1, 1), cB + hstep + kstep, voffB);
        PG8_WAIT_V(6); PG8_BAR;
    } else {
        PG8_STAGE(PG8_SB(0, 0), cB, voffB); PG8_STAGE(PG8_SA(0, 0), cA, voffA); PG8_STAGE(PG8_SB(0, 1), cB + hstep, voffB); PG8_STAGE(PG8_SA(0, 1), cA + hstep, voffA);
        if (wr == 1) PG8_BAR;
        PG8_WAIT_V(4); PG8_BAR;
        PG8_STAGE(PG8_SB(1, 0), cB + kstep, voffB); PG8_STAGE(PG8_SA(1, 0), cA + kstep, voffA); PG8_STAGE(PG8_SB(1, 1), cB + hstep + kstep, voffB);
        PG8_WAIT_V(6); PG8_BAR;
    }
    for (;;) {
        const bool has_next = S.next(ui + 1, nxt);
        const char* nA = has_next ? (const char*)g.A + (size_t)nxt.pm * tstep : cA; const char* nB = has_next ? (const char*)g.Bt + (size_t)nxt.pn * tstep : cB;
        for (int t = 0; t < nt; t += 2) {
            const bool last = (t == nt - 2);
            const char* a1 = cA + (size_t)(t + 1) * kstep;
            const char* a2 = last ? nA : cA + (size_t)(t + 2) * kstep; const char* b2 = last ? nB : cB + (size_t)(t + 2) * kstep;
            const char* a3 = a2 + kstep; const char* b3 = b2 + kstep;
            if (last && has_next) S.a_ready(nxt);
            if constexpr (SP2) {
            PG8_LDB(B0, 0, 0); PG8_LDB(B1, 0, 1); PG8_SCHED; PG8_LDA(At, 0, 0); PG8_STAGE(PG8_SA(1, 1), a1 + hstep, voffA);
            PG8_WAIT_V(8); PG8_WAIT_L(0); PG8_BAR; PG8_MMA(0, 0, At, B0); PG8_MMA(0, 1, At, B1); PG8_BAR; PG8_SCHED;
            PG8_LDA(At, 0, 1); PG8_STAGE(PG8_SB(0, 0), b2, voffB); PG8_STAGE(PG8_SB(0, 1), b2 + hstep, voffB); PG8_STAGE(PG8_SA(0, 0), a2, voffA);
            PG8_WAIT_V(8); PG8_WAIT_L(0); PG8_BAR; PG8_MMA(1, 0, At, B0); PG8_MMA(1, 1, At, B1); PG8_BAR; PG8_SCHED;
            PG8_LDB(B0, 1, 0); PG8_LDB(B1, 1, 1); PG8_SCHED; PG8_LDA(At, 1, 0); PG8_STAGE(PG8_SA(0, 1), a2 + hstep, voffA);
            PG8_WAIT_V(8); PG8_WAIT_L(0); PG8_BAR; PG8_MMA(0, 0, At, B0); PG8_MMA(0, 1, At, B1); PG8_BAR; PG8_SCHED;
            PG8_LDA(At, 1, 1); PG8_STAGE(PG8_SB(1, 0), b3, voffB); PG8_STAGE(PG8_SB(1, 1), b3 + hstep, voffB); PG8_STAGE(PG8_SA(1, 0), a3, voffA);
            PG8_WAIT_V(8); PG8_WAIT_L(0); PG8_BAR; PG8_MMA(1, 0, At, B0); PG8_MMA(1, 1, At, B1); PG8_BAR; PG8_SCHED;
            } else {
            PG8_LDB(B0, 0, 0); PG8_SCHED; PG8_LDA(At, 0, 0); PG8_STAGE(PG8_SA(1, 1), a1 + hstep, voffA);
            PG8_WAIT_L(8); PG8_BAR; PG8_WAIT_L(0); PG8_MMA(0, 0, At, B0); PG8_BAR; PG8_SCHED;
            PG8_LDB(B1, 0, 1); PG8_STAGE(PG8_SB(0, 0), b2, voffB);
            PG8_BAR; PG8_WAIT_L(0); PG8_MMA(0, 1, At, B1); PG8_BAR;
            PG8_LDA(At, 0, 1); PG8_STAGE(PG8_SA(0, 0), a2, voffA);
            PG8_BAR; PG8_WAIT_L(0); PG8_MMA(1, 0, At, B0); PG8_BAR; PG8_SCHED;
            PG8_STAGE(PG8_SB(0, 1), b2 + hstep, voffB);
            PG8_WAIT_V(6); PG8_BAR; PG8_MMA(1, 1, At, B1); PG8_BAR;
            PG8_LDB(B0, 1, 0); PG8_SCHED; PG8_LDA(At, 1, 0); PG8_STAGE(PG8_SA(0, 1), a2 + hstep, voffA);
            PG8_WAIT_L(8); PG8_BAR; PG8_WAIT_L(0); PG8_MMA(0, 0, At, B0); PG8_BAR; PG8_SCHED;
            PG8_LDB(B1, 1, 1); PG8_STAGE(PG8_SB(1, 0), b3, voffB);
            PG8_BAR; PG8_WAIT_L(0); PG8_MMA(0, 1, At, B1); PG8_BAR;
            PG8_LDA(At, 1, 1); PG8_STAGE(PG8_SA(1, 0), a3, voffA);
            PG8_BAR; PG8_WAIT_L(0); PG8_MMA(1, 0, At, B0); PG8_BAR; PG8_SCHED;
            PG8_STAGE(PG8_SB(1, 1), b3 + hstep, voffB);
            PG8_WAIT_V(6); PG8_BAR; PG8_MMA(1, 1, At, B1); PG8_BAR;
            }
        }
        if constexpr (ALIGN_EPI) { if (wr == 0) PG8_BAR; }
        if constexpr (!Epi::AFTER_DRAIN) { E(acc, cur, wr, wc, fr, fq); S.done(cur); }
        if (!has_next) break;
#pragma unroll
        for (int a = 0; a < 2; ++a)
#pragma unroll
            for (int b = 0; b < 2; ++b)
#pragma unroll
                for (int m = 0; m < 4; ++m)
#pragma unroll
                    for (int n = 0; n < 2; ++n) acc[a][b][m][n] = (f32x4){0.f, 0.f, 0.f, 0.f};
        cur = nxt; cA = nA; cB = nB; ++ui;
        if constexpr (ALIGN_EPI) { if (wr == 1) PG8_BAR; }
    }
    PG8_WAIT_V(0);
    if constexpr (!ALIGN_EPI) { if (wr == 0) PG8_BAR; }
    PG8_BAR;
    if constexpr (Epi::AFTER_DRAIN) { E.fused(acc, cur, wr, wc, fr, fq, lds, wid, lane); S.done(cur); }
#undef PG8_SA
#undef PG8_SB
#undef PG8_STAGE
#undef PG8_LDA
#undef PG8_LDB
#undef PG8_MMA
#undef PG8_WAIT_V
#undef PG8_WAIT_L
#undef PG8_BAR
#undef PG8_SCHED
}
}
#ifndef PG8_SP2
#define PG8_SP2 true
#endif
#ifndef PG8_ALIGN
#define PG8_ALIGN true
#endif

constexpr int NWAVES = 8;
constexpr int NTOK = 32768, DM = 1024, SEQ = 2048, NBATCH = 16, INW = 3584;
constexpr int C_DQ = 0, C_DK = 512, C_DV = 1024, C_HQ = 1536, C_HF = 2048, C_HI = 2560, C_HG = 3072;
constexpr float EPS = 1e-6f;
constexpr float QSCALE = 0.125f * 1.4426950408889634f;
constexpr float LAM_INIT = 0.2f;
constexpr int NEXP_SEL = 128;

constexpr size_t MiB = 1u << 20;
constexpr size_t WS_CTL = 0, CTL_ZERO_BYTES = 1 * MiB;
constexpr size_t WS_SMALL = 1 * MiB;
constexpr size_t WS_WIN = 2 * MiB;
constexpr size_t WS_WOUT = 10 * MiB;
constexpr size_t WS_W2 = 12 * MiB;
constexpr size_t WS_U8 = 17 * MiB;
constexpr size_t WS_V8 = 33 * MiB;
constexpr size_t WS_SU = 49 * MiB;
constexpr size_t WS_SV = 49 * MiB + 512 * 1024;
constexpr size_t WS_X8 = 50 * MiB;
constexpr size_t WS_SX = 116 * MiB;
constexpr size_t WS_GSU = 120 * MiB;
constexpr size_t WS_HN = 84 * MiB;
constexpr size_t WS_PROJ = 148 * MiB;
constexpr size_t WS_HN2 = 148 * MiB;
constexpr size_t WS_SC = 212 * MiB;
constexpr size_t WS_PO = 352 * MiB;
constexpr size_t WS_IDX = 468 * MiB;
constexpr size_t WS_GATE = 484 * MiB;
constexpr size_t WS_END = 500 * MiB;
constexpr int SM_LB = 0, SM_LAM = 512, SM_BIAS = 1024;
constexpr int CW_BAR = 4096;
constexpr int CW_ATTQ = 8192;
constexpr int CW_SSQ = 131072;

constexpr int RING_OFF = 0, RING_BYTES = 139264;
constexpr int LDSCTL_OFF = RING_BYTES, MISC_OFF = LDSCTL_OFF + 320;
constexpr int LDS_BYTES = 147456;

#define GAS __attribute__((address_space(1)))
#define LAS __attribute__((address_space(3)))
typedef unsigned short bf16;
typedef unsigned v4u __attribute__((ext_vector_type(4)));
typedef unsigned v2u __attribute__((ext_vector_type(2)));
typedef float f32x4 __attribute__((ext_vector_type(4)));
typedef short bf16x8 __attribute__((ext_vector_type(8)));
typedef GAS unsigned gu32;
typedef long l2 __attribute__((ext_vector_type(2)));
typedef int v4i __attribute__((ext_vector_type(4)));
#define RLX_AGENT __ATOMIC_RELAXED, __HIP_MEMORY_SCOPE_AGENT
#define LDS_WAIT() asm volatile("s_waitcnt lgkmcnt(0)" ::: "memory")
#define VM_WAIT() asm volatile("s_waitcnt vmcnt(0)" ::: "memory")
__device__ __forceinline__ unsigned f2bf(float f) { unsigned u = __builtin_bit_cast(unsigned, f); return (u + 0x7fffu + ((u >> 16) & 1u)) >> 16; }
__device__ __forceinline__ unsigned pk2(float lo, float hi) { return f2bf(lo) | (f2bf(hi) << 16); }
__device__ __forceinline__ float bflo(unsigned w) { return __builtin_bit_cast(float, w << 16); }
__device__ __forceinline__ float bfhi(unsigned w) { return __builtin_bit_cast(float, w & 0xffff0000u); }

#define XB_TMO      128
#define XB_XCNT(j)  (256  + 64 * (j))
#define XB_XSUB(j)  (1280 + 64 * (j))
#define XB_XGEN(j)  (2304 + 64 * (j))
#define XB_TOP      3328
#define XB_TOPGEN   3392
#define XCD_BAR_WORDS 3456
#define XB_SPIN_CAP (1u << 18)
__device__ __forceinline__ unsigned xb_ld(unsigned* p)              { return __hip_atomic_load(p, __ATOMIC_RELAXED, __HIP_MEMORY_SCOPE_AGENT); }
__device__ __forceinline__ unsigned xb_add(unsigned* p, unsigned v) { return __hip_atomic_fetch_add(p, v, __ATOMIC_RELAXED, __HIP_MEMORY_SCOPE_AGENT); }
__device__ __forceinline__ unsigned xb_xcc_id() { return (unsigned)__builtin_amdgcn_s_getreg((3 << 11) | 20) & 0xFu; }
#define XB_SPIN(cond, bar) do { unsigned _sp = 0; while (cond) { __builtin_amdgcn_s_sleep(1); \
    if ((++_sp & 255u) == 0u) { if (xb_ld(&(bar)[XB_TMO])) break; if (_sp > XB_SPIN_CAP) { atomicAdd(&(bar)[XB_TMO], 1u); break; } } } } while (0)
struct XcdBarrier { unsigned* bar; unsigned x; volatile LAS unsigned* st; };
__device__ __forceinline__ XcdBarrier xcd_barrier_post(unsigned* bar, volatile LAS unsigned* st) {
    XcdBarrier b; b.bar = bar; b.x = xb_xcc_id(); b.st = st;
    if (threadIdx.x == 0) (void)xb_add(&bar[XB_XCNT(b.x)], 1u);
    return b;
}
__device__ __forceinline__ void xcd_barrier_complete(unsigned* bar, unsigned x, unsigned& nloc, unsigned& nx) {
    const unsigned G = gridDim.x * gridDim.y * gridDim.z;
    unsigned sum, cnt, mine, sp = 0u;
    for (;;) {
        sum = 0u; cnt = 0u; mine = 0u;
#pragma unroll
        for (unsigned j = 0; j < 16; ++j) { const unsigned c = xb_ld(&bar[XB_XCNT(j)]); sum += c; cnt += (c > 0u) ? 1u : 0u; mine = (j == x) ? c : mine; }
        if (sum == G) break;
        __builtin_amdgcn_s_sleep(1);
        if ((++sp & 255u) == 0u) { if (xb_ld(&bar[XB_TMO])) break; if (sp > XB_SPIN_CAP) { atomicAdd(&bar[XB_TMO], 1u); break; } }
    }
    nloc = mine > 0u ? mine : 1u; nx = cnt > 0u ? cnt : 1u;
}
__device__ __forceinline__ void xcd_barrier(const XcdBarrier& b) {
    asm volatile("s_waitcnt vmcnt(0)" ::: "memory");
    __syncthreads();
    if (threadIdx.x == 0) {
        unsigned* bar = b.bar;
        __builtin_amdgcn_s_waitcnt(0);
        unsigned nloc = b.st[0], nx = b.st[1];
        if (nloc == 0u) { xcd_barrier_complete(bar, b.x, nloc, nx); b.st[0] = nloc; b.st[1] = nx; }
        const unsigned old = xb_add(&bar[XB_XSUB(b.x)], 1u);
        const unsigned gen = old / nloc;
        if (old + 1u == (gen + 1u) * nloc) {
            __builtin_amdgcn_fence(__ATOMIC_RELEASE, "agent");
            asm volatile("s_waitcnt vmcnt(0)" ::: "memory");
            const unsigned og = xb_add(&bar[XB_TOP], 1u);
            const unsigned tg = og / nx;
            if (og + 1u == (tg + 1u) * nx) xb_add(&bar[XB_TOPGEN], 1u);
            else XB_SPIN(xb_ld(&bar[XB_TOPGEN]) == tg, bar);
            __builtin_amdgcn_fence(__ATOMIC_ACQUIRE, "agent");
            xb_add(&bar[XB_XGEN(b.x)], 1u);
            asm volatile("s_waitcnt vmcnt(0)" ::: "memory");
        } else {
            XB_SPIN(xb_ld(&bar[XB_XGEN(b.x)]) == gen, bar);
            __builtin_amdgcn_fence(__ATOMIC_ACQUIRE, "agent");
            asm volatile("s_waitcnt vmcnt(0)" ::: "memory");
        }
    }
    __syncthreads();
}

#define SCHED_FENCE() __builtin_amdgcn_sched_barrier(0)
__device__ __forceinline__ float gelu_as(float v) {
    const float av = fabsf(v), t = __builtin_amdgcn_rcpf(av * 0.2316418882f + 1.0f);
    float q = t * 0.5307027145f + (-0.7265760135f); q = q * t + 0.7107068705f; q = q * t + (-0.142248368f); q = q * t + 0.127414796f; q = q * t;
    const float e = __builtin_amdgcn_exp2f((v * v) * (-0.72134752044f));
    const float mm = v * (q * e);
    return v < 0.f ? mm : v - mm;
}
struct Frame {
    LAS unsigned char* lds;
    volatile LAS unsigned* MISC;
    int tid, lane, wave, vcu, G;
    const float* in[18]; float* out; unsigned char* ws;
};
__device__ __forceinline__ float wave_sum(float v) {
#pragma unroll
    for (int o = 1; o < 64; o <<= 1) v += __shfl_xor(v, o);
    return v;
}
__device__ __forceinline__ float sigmoidf_(float x) { return 1.f / (1.f + __expf(-x)); }

__device__ __forceinline__ void p0_transpose_item(const float* W, int K, int N, bf16* WT, int row_off, LAS float* scr, int item, int lane) {
    const int nblk = N / 32, kb = item / nblk, nb = item % nblk, k0 = 64 * kb, n0 = 32 * nb;
#pragma unroll 8
    for (int i = 0; i < 32; ++i) { const int kk = 2 * i + (lane >> 5); scr[kk * 33 + (lane & 31)] = W[(size_t)(k0 + kk) * N + n0 + (lane & 31)]; }
    LDS_WAIT(); asm volatile("" ::: "memory");
    const int c = lane & 7;
#pragma unroll
    for (int j = 0; j < 4; ++j) { const int n = (lane >> 3) + 8 * j; const LAS float* s = scr + (8 * c) * 33 + n;
        v4u o; o.x = pk2(s[0 * 33], s[1 * 33]); o.y = pk2(s[2 * 33], s[3 * 33]); o.z = pk2(s[4 * 33], s[5 * 33]); o.w = pk2(s[6 * 33], s[7 * 33]);
        *(GAS v4u*)(WT + (size_t)(row_off + n0 + n) * K + k0 + 8 * c) = o; }
    LDS_WAIT(); asm volatile("" ::: "memory");
}

__device__ __forceinline__ void quant_vals_fp8(const f32x4 (&v)[4], unsigned char* dst, float* dq, int lane, size_t slice_stride) {
    float mx = 0.f;
#pragma unroll
    for (int j = 0; j < 4; ++j) mx = fmaxf(mx, fmaxf(fmaxf(fabsf(v[j].x), fabsf(v[j].y)), fmaxf(fabsf(v[j].z), fabsf(v[j].w))));
#pragma unroll
    for (int o = 1; o < 64; o <<= 1) mx = fmaxf(mx, __shfl_xor(mx, o));
    const float qs = mx > 0.f ? 224.f / mx : 1.f;
#pragma unroll
    for (int j = 0; j < 4; ++j) { int p = __builtin_amdgcn_cvt_pk_fp8_f32(v[j].x * qs, v[j].y * qs, 0, false); p = __builtin_amdgcn_cvt_pk_fp8_f32(v[j].z * qs, v[j].w * qs, p, true);
        const int d = 4 * lane + 256 * j; *(GAS unsigned*)(dst + (slice_stride ? (size_t)(d >> 7) * slice_stride + (d & 127) : (size_t)d)) = (unsigned)p; }
    if (lane == 0) *dq = mx > 0.f ? mx * (1.f / 224.f) : 1.f;
}
__device__ __forceinline__ void quant_row_fp8(const float* src, unsigned char* dst, float* dq, int lane, size_t slice_stride) {
    const GAS f32x4* xr = (const GAS f32x4*)src + lane; f32x4 v[4];
#pragma unroll
    for (int j = 0; j < 4; ++j) v[j] = xr[64 * j];
    quant_vals_fp8(v, dst, dq, lane, slice_stride);
}
__device__ __forceinline__ void p0_prologue(Frame& F) {
    LAS float* scr = (LAS float*)(F.lds + RING_OFF + F.wave * 16384);
    const int gw = F.vcu * NWAVES + F.wave, NGW = F.G * NWAVES;
    bf16* WinT = (bf16*)(F.ws + WS_WIN); bf16* WoutT = (bf16*)(F.ws + WS_WOUT); bf16* W2T = (bf16*)(F.ws + WS_W2);
    float* small = (float*)(F.ws + WS_SMALL);
    if (blockIdx.x == 0) {
        const int t = F.tid;
        { const float l0 = F.in[9][t], l1 = F.in[9][512 + t]; small[SM_LB + t] = 1.f / (1.f + expf(l1 - l0)); }
        { const int h = t >> 7, n = t & 127; int bk;
          if (n < 16) bk = n; else { bk = 16 + (int)(logf((float)n * (1.f / 16.f)) / logf(8.f) * 16.f); bk = bk > 31 ? 31 : bk; }
          small[SM_BIAS + t] = F.in[8][bk * 4 + h] * 1.4426950408889634f; }
        if (F.wave == 0) {
            const float a = wave_sum(F.in[3][F.lane] * F.in[4][F.lane]), b = wave_sum(F.in[5][F.lane] * F.in[6][F.lane]);
            if (F.lane == 0) small[SM_LAM] = expf(a) - expf(b) + LAM_INIT;
        }
    }
    constexpr int I_IN = (DM / 64) * (INW / 32), I_OUT = (DM / 64) * (DM / 32);
    for (int it = gw; it < I_IN + I_OUT; it += NGW) {
        if (it < I_IN) p0_transpose_item(F.in[2], DM, INW, WinT, 0, scr, it, F.lane);
        else p0_transpose_item(F.in[11], DM, DM, WoutT, 0, scr, it - I_IN, F.lane);
    }
    for (int u = F.vcu; u < 256; u += F.G) {
        const int hc = u >> 4, kb = u & 15, k = kb * 64 + F.lane;
        const GAS f32x4* wrow = (const GAS f32x4*)(F.in[13] + (size_t)k * 2048 + hc * 128);
        float a[16];
#pragma unroll
        for (int nn = 0; nn < 16; ++nn) a[nn] = 0.f;
        const float* kr = F.in[14] + ((size_t)hc * 128 + F.wave * 16) * 128;
        for (int i = 0; i < 32; ++i) {
            const f32x4 w = wrow[i];
#pragma unroll
            for (int nn = 0; nn < 16; ++nn) { const float* kk = kr + nn * 128 + 4 * i; a[nn] += (kk[0] * w.x + kk[1] * w.y) + (kk[2] * w.z + kk[3] * w.w); }
        }
        const float g2k = F.in[12][k];
#pragma unroll
        for (int nn = 0; nn < 16; ++nn) W2T[((size_t)hc * 128 + F.wave * 16 + nn) * DM + k] = (bf16)f2bf(a[nn] * g2k);
    }
    bf16* HN = (bf16*)(F.ws + WS_HN);
    for (int m = gw; m < NTOK; m += 2 * NGW) {
        const int m2 = m + NGW;
        const GAS f32x4* xa = (const GAS f32x4*)(F.in[0] + (size_t)m * DM) + F.lane; const GAS f32x4* xb = (const GAS f32x4*)(F.in[0] + (size_t)(m2 < NTOK ? m2 : m) * DM) + F.lane;
        const GAS f32x4* gr = (const GAS f32x4*)F.in[1] + F.lane;
        f32x4 va[4], vb[4]; float sa = 0.f, sb = 0.f;
#pragma unroll
        for (int j = 0; j < 4; ++j) { va[j] = xa[64 * j]; vb[j] = xb[64 * j]; }
#pragma unroll
        for (int j = 0; j < 4; ++j) { sa += (va[j].x * va[j].x + va[j].y * va[j].y) + (va[j].z * va[j].z + va[j].w * va[j].w); sb += (vb[j].x * vb[j].x + vb[j].y * vb[j].y) + (vb[j].z * vb[j].z + vb[j].w * vb[j].w); }
#pragma unroll
        for (int o = 1; o < 64; o <<= 1) { sa += __shfl_xor(sa, o); sb += __shfl_xor(sb, o); }
        const float ra = 1.f / sqrtf(sa * (1.f / DM) + EPS), rb = 1.f / sqrtf(sb * (1.f / DM) + EPS);
        GAS unsigned long long* oa = (GAS unsigned long long*)(HN + (size_t)m * DM) + F.lane; GAS unsigned long long* ob = (GAS unsigned long long*)(HN + (size_t)m2 * DM) + F.lane;
#pragma unroll
        for (int j = 0; j < 4; ++j) { const f32x4 gg = gr[64 * j];
            oa[64 * j] = (unsigned long long)pk2(va[j].x * ra * gg.x, va[j].y * ra * gg.y) | ((unsigned long long)pk2(va[j].z * ra * gg.z, va[j].w * ra * gg.w) << 32);
            if (m2 < NTOK) ob[64 * j] = (unsigned long long)pk2(vb[j].x * rb * gg.x, vb[j].y * rb * gg.y) | ((unsigned long long)pk2(vb[j].z * rb * gg.z, vb[j].w * rb * gg.w) << 32); }
    }
}


constexpr int QCHUNKS = 2 * 16384 / 64;
__device__ __forceinline__ void quant_chunk(Frame& F, int c) {
    unsigned char* U8 = F.ws + WS_U8; unsigned char* V8 = F.ws + WS_V8; float* SU = (float*)(F.ws + WS_SU); float* SV = (float*)(F.ws + WS_SV);
#pragma unroll 1
    for (int k = 0; k < 8; ++k) { const int rr = 64 * c + 8 * F.wave + k;
        if (rr < 16384) quant_row_fp8(F.in[15] + (size_t)rr * DM, U8 + (size_t)rr * 128, SU + rr, F.lane, (size_t)16384 * 128);
        else { const int e = rr - 16384; quant_row_fp8(F.in[16] + (size_t)e * DM, V8 + (size_t)e * 128, SV + e, F.lane, (size_t)16384 * 128); } }
}

__device__ __forceinline__ void quant_drain(Frame& F) {
    unsigned* qctr = (unsigned*)(F.ws + WS_CTL) + CW_ATTQ + 128;
    for (;;) {
        __syncthreads();
        if (F.tid == 0) F.MISC[13] = __hip_atomic_fetch_add(qctr, 1u, __ATOMIC_RELAXED, __HIP_MEMORY_SCOPE_AGENT);
        __syncthreads();
        const int qc = (int)F.MISC[13];
        if (qc >= QCHUNKS) break;
        quant_chunk(F, qc);
    }
}

typedef float f32x16 __attribute__((ext_vector_type(16)));
typedef short s16x4 __attribute__((ext_vector_type(4)));
typedef short v4i16_t __attribute__((ext_vector_type(4)));
typedef float f32x2_t __attribute__((ext_vector_type(2))); typedef __bf16 bf16x2_t __attribute__((ext_vector_type(2)));
__device__ __forceinline__ unsigned cvtpk_bf16(float lo, float hi) { f32x2_t v = {lo, hi}; bf16x2_t b = __builtin_convertvector(v, bf16x2_t); return __builtin_bit_cast(unsigned, b); }
__device__ __forceinline__ float xhalf_max(float v) { return fmaxf(v, __shfl_xor(v, 32)); }
__device__ __forceinline__ float xhalf_sum(float v) { return v + __shfl_xor(v, 32); }
__device__ __forceinline__ float max3f_(float a, float b, float c) { float r; asm("v_max3_f32 %0, %1, %2, %3" : "=v"(r) : "v"(a), "v"(b), "v"(c)); return r; }
constexpr int AT_KP = 144, AT_VP = 320, AT_K1 = 64 * AT_KP, AT_KS = 2 * AT_K1, AT_V0 = 2 * AT_KS, AT_VS = 64 * AT_VP;
constexpr int AT_XO = 0, AT_YB = 65536, AT_YP = 272, AT_Q = 100864, AT_TAB = AT_Q + 8 * 4096;
static_assert(AT_TAB + 320 * 4 <= RING_BYTES && AT_YB + 4 * 32 * AT_YP <= AT_Q && AT_V0 + 3 * AT_VS <= AT_Q, "attention LDS map");
#define AT_MFMA(a, b, c) __builtin_amdgcn_mfma_f32_32x32x16_bf16(a, b, c, 0, 0, 0)
#define AT_SGB(mask, n) __builtin_amdgcn_sched_group_barrier(mask, n, 0)
__device__ __forceinline__ void attn_mfma(Frame& F, int qslot) {
    const bf16* PROJ = (const bf16*)(F.ws + WS_PROJ); bf16* MIXED = (bf16*)(F.ws + WS_HN);
    const float* small = (const float*)(F.ws + WS_SMALL);
    LAS unsigned char* lds = F.lds;
    LAS float* TAB = (LAS float*)(lds + AT_TAB);
    const int tid = F.tid, lane = F.lane, wave = F.wave, map = wave >> 2, qt = wave & 3, r32 = lane & 31, hi = lane >> 5;
    const int koff = map * AT_K1 + r32 * AT_KP + hi * 16;
    const int voff = AT_V0 + (4 * hi + ((lane & 15) >> 2)) * AT_VP + (16 * ((lane >> 4) & 1) + 4 * (lane & 3)) * 2;
    unsigned* qctr = (unsigned*)(F.ws + WS_CTL) + CW_ATTQ + 64 * qslot;
    for (;;) {
        __syncthreads();
        if (tid == 0) F.MISC[12] = __hip_atomic_fetch_add(qctr, 1u, __ATOMIC_RELAXED, __HIP_MEMORY_SCOPE_AGENT);
        __syncthreads();
        const int L = (int)F.MISC[12];
        if (L >= 1024) break;
        const int qb = 15 - (L >> 6), bh = L & 63;
        const int b = bh >> 2, h = bh & 3, q0 = qb * 128; const size_t tok0 = (size_t)b * SEQ;
        const int NT = (q0 + 128) / 64;
        int tidu = F.tid; asm volatile("" : "+v"(tidu));
        if (tidu < 320) { const int n = tidu - 96; TAB[tidu] = n < 0 ? -INFINITY : small[SM_BIAS + h * 128 + (n > 127 ? 127 : n)]; }
        LAS unsigned char* qlds = lds + AT_Q + wave * 4096 + lane * 16;
        { const bf16* qrow = PROJ + (tok0 + q0 + 32 * qt + r32) * INW + C_DQ + h * 128 + map * 64 + 8 * hi;
#pragma unroll
          for (int s4 = 0; s4 < 4; ++s4) *(LAS bf16x8*)(qlds + 1024 * s4) = *(const GAS bf16x8*)(qrow + 16 * s4); }
        const unsigned char* projb = (const unsigned char*)PROJ;
        const unsigned ksrc = (unsigned)(((tok0 + (tidu >> 4)) * INW + C_DK + h * 128 + (tidu & 15) * 8) * 2), vsrc = ksrc + (C_DV - C_DK) * 2;
        const int kdst = ((tidu & 15) >> 3) * AT_K1 + (tidu >> 4) * AT_KP + (tidu & 7) * 16, vdst = AT_V0 + (tidu >> 4) * AT_VP + (tidu & 15) * 16;
#define AT_GLD(src, row) (*(const GAS v4u*)(projb + (size_t)((src) + (unsigned)((row) * (INW * 2)))))
        v4u kr[2], vr[2];
#pragma unroll
        for (int i = 0; i < 2; ++i) { kr[i] = AT_GLD(ksrc, 32 * i); vr[i] = AT_GLD(vsrc, 32 * i); }
#pragma unroll
        for (int i = 0; i < 2; ++i) { *(LAS v4u*)(lds + kdst + 32 * i * AT_KP) = kr[i]; *(LAS v4u*)(lds + vdst + 32 * i * AT_VP) = vr[i]; }
#pragma unroll
        for (int i = 0; i < 2; ++i) { kr[i] = AT_GLD(ksrc, 64 + 32 * i); vr[i] = AT_GLD(vsrc, 64 + 32 * i); }
        __syncthreads();
        const float bfar = TAB[96 + 127];
        f32x16 o[4];
#pragma unroll
        for (int mt = 0; mt < 4; ++mt) o[mt] = (f32x16){0.f,0.f,0.f,0.f,0.f,0.f,0.f,0.f,0.f,0.f,0.f,0.f,0.f,0.f,0.f,0.f};
        float mrun = -INFINITY, lsum = 0.f, alpha = 1.f, cexp = 0.f; bool resc = false;
        const int qlo = q0 + 32 * qt, qpos = qlo + r32;
        const int NTW = NT - 1 + (qt >> 1);
        f32x16 pA0, pA1, pB0, pB1;
        int vs_prev = 0, vs_cur = 0, vs_next = AT_VS;
#define AT_ROT() do { vs_prev = vs_cur; vs_cur = vs_next; vs_next = (vs_next == 2 * AT_VS) ? 0 : vs_next + AT_VS; } while (0)
#define AT_Z16 (f32x16){0.f,0.f,0.f,0.f,0.f,0.f,0.f,0.f,0.f,0.f,0.f,0.f,0.f,0.f,0.f,0.f}
#define AT_SBAR() __builtin_amdgcn_sched_barrier(0)
#define AT_PIN(x) asm volatile("" : "+v"(x))
        bf16x8 kAa, kAb, kAq, kBa, kBb, kBq; s16x4 f0l, f0h, f1l, f1h;
#define AT_KRD2(S, KB, s4) do { k##S##a = *(const LAS bf16x8*)(lds + (KB) + koff + 32 * (s4)); k##S##b = *(const LAS bf16x8*)(lds + (KB) + koff + 32 * AT_KP + 32 * (s4)); } while (0)
#define AT_KRDQ(S, s4) do { k##S##q = *(const LAS bf16x8*)(qlds + 1024 * (s4)); } while (0)
#define AT_VRD(Fn, g) do { LAS unsigned char* vp_ = vb_ + (32 * ((g) >> 3) + 16 * (((g) >> 2) & 1)) * AT_VP + 64 * ((g) & 3); \
            Fn##l = __builtin_bit_cast(s16x4, __builtin_amdgcn_ds_read_tr16_b64_v4i16((LAS v4i16_t*)vp_)); Fn##h = __builtin_bit_cast(s16x4, __builtin_amdgcn_ds_read_tr16_b64_v4i16((LAS v4i16_t*)(vp_ + 8 * AT_VP))); } while (0)
#define AT_VFR(Fn) (bf16x8){Fn##l[0], Fn##l[1], Fn##l[2], Fn##l[3], Fn##h[0], Fn##h[1], Fn##h[2], Fn##h[3]}
#define AT_GAPA(MF, RD, FILL, P, g, PK) do { MF; RD; \
            if (FILL) { const float e0_ = P[4 * ((g) & 3)], e1_ = P[4 * ((g) & 3) + 1], e2_ = P[4 * ((g) & 3) + 2], e3_ = P[4 * ((g) & 3) + 3]; \
                sacc_ += e0_; sacc_ += e1_; sacc_ += e2_; sacc_ += e3_; \
                PK[2 * (g)] = __builtin_bit_cast(float, cvtpk_bf16(e0_, e1_)); PK[2 * (g) + 1] = __builtin_bit_cast(float, cvtpk_bf16(e2_, e3_)); AT_PIN(PK); AT_PIN(sacc_); } \
            AT_SBAR(); } while (0)
#define AT_PHASE_A(C0, C1, P0, P1, KB, FILL) do { float sacc_ = 0.f; \
            AT_SBAR(); AT_KRD2(A, KB, 0); AT_KRDQ(A, 0); AT_SBAR(); \
            AT_GAPA(C0 = AT_MFMA(kAa, kAq, AT_Z16), AT_KRD2(B, KB, 1), FILL, P0, 0, P0); \
            AT_GAPA(C1 = AT_MFMA(kAb, kAq, AT_Z16), AT_KRDQ(B, 1),     FILL, P0, 1, P0); \
            AT_GAPA(C0 = AT_MFMA(kBa, kBq, C0),     AT_KRD2(A, KB, 2), FILL, P0, 2, P0); \
            AT_GAPA(C1 = AT_MFMA(kBb, kBq, C1),     AT_KRDQ(A, 2),     FILL, P0, 3, P0); \
            AT_GAPA(C0 = AT_MFMA(kAa, kAq, C0),     AT_KRD2(B, KB, 3), FILL, P1, 4, P0); \
            AT_GAPA(C1 = AT_MFMA(kAb, kAq, C1),     AT_KRDQ(B, 3),     FILL, P1, 5, P0); \
            AT_GAPA(C0 = AT_MFMA(kBa, kBq, C0),     (void)0,           FILL, P1, 6, P0); \
            AT_GAPA(C1 = AT_MFMA(kBb, kBq, C1),     (void)0,           FILL, P1, 7, P0); \
            lsum += sacc_; } while (0)
#define AT_MID(C0, C1, t) do { float tm, cadd; \
            if (qlo - (64 * (t) + 63) < 127) { \
                const LAS float* rp = TAB + (qpos - 64 * (t) - 4 * hi + 96 - 59); tm = -INFINITY; \
                _Pragma("unroll") for (int r = 0; r < 16; ++r) { const int off = (r & 3) + 8 * (r >> 2); C0[r] += rp[59 - off]; C1[r] += rp[27 - off]; tm = max3f_(tm, C0[r], C1[r]); } \
                cadd = 0.f; \
            } else { \
                tm = max3f_(C0[0], C1[0], C0[1]); \
                _Pragma("unroll") for (int r = 1; r < 15; ++r) tm = max3f_(tm, C1[r], C0[r + 1]); \
                tm = fmaxf(tm, C1[15]); tm += bfar; cadd = bfar; } \
            tm = xhalf_max(tm); resc = false; \
            if (__any(tm > mrun + 8.f)) { const float mnew = fmaxf(mrun, tm); alpha = __builtin_amdgcn_exp2f(mrun - mnew); lsum *= alpha; mrun = mnew; resc = true; } \
            cexp = cadd - mrun; } while (0)
#define AT_EXP(C0, C1) do { _Pragma("unroll") for (int r = 0; r < 16; ++r) { C0[r] = __builtin_amdgcn_exp2f(C0[r] + cexp); C1[r] = __builtin_amdgcn_exp2f(C1[r] + cexp); } } while (0)
#define AT_GAPB(Fn, g, PK, C, DOEXP) do { o[(g) & 3] = AT_MFMA(AT_VFR(Fn), __builtin_bit_cast(bf16x8, (f32x4){PK[4 * ((g) >> 2)], PK[4 * ((g) >> 2) + 1], PK[4 * ((g) >> 2) + 2], PK[4 * ((g) >> 2) + 3]}), o[(g) & 3]); \
            if ((g) + 2 < 16) AT_VRD(Fn, (g) + 2); \
            if (DOEXP) { C[2 * ((g) & 7)] = __builtin_amdgcn_exp2f(C[2 * ((g) & 7)] + cexp); C[2 * ((g) & 7) + 1] = __builtin_amdgcn_exp2f(C[2 * ((g) & 7) + 1] + cexp); AT_PIN(C); } \
            AT_SBAR(); } while (0)
#define AT_PHASE_B(C0, C1, PK, VB, DOEXP) do { LAS unsigned char* vb_ = lds + (VB) + voff; \
            AT_SBAR(); AT_VRD(f0, 0); AT_VRD(f1, 1); AT_SBAR(); \
            AT_GAPB(f0, 0, PK, C0, DOEXP);  AT_GAPB(f1, 1, PK, C0, DOEXP);  AT_GAPB(f0, 2, PK, C0, DOEXP);  AT_GAPB(f1, 3, PK, C0, DOEXP); \
            AT_GAPB(f0, 4, PK, C0, DOEXP);  AT_GAPB(f1, 5, PK, C0, DOEXP);  AT_GAPB(f0, 6, PK, C0, DOEXP);  AT_GAPB(f1, 7, PK, C0, DOEXP); \
            AT_GAPB(f0, 8, PK, C1, DOEXP);  AT_GAPB(f1, 9, PK, C1, DOEXP);  AT_GAPB(f0, 10, PK, C1, DOEXP); AT_GAPB(f1, 11, PK, C1, DOEXP); \
            AT_GAPB(f0, 12, PK, C1, DOEXP); AT_GAPB(f1, 13, PK, C1, DOEXP); AT_GAPB(f0, 14, PK, C1, DOEXP); AT_GAPB(f1, 15, PK, C1, DOEXP); } while (0)
#define AT_RESC() do { if (resc) { _Pragma("unroll") for (int mt = 0; mt < 4; ++mt) o[mt] = o[mt] * alpha; } } while (0)
#define AT_STAGE(t) do { if ((t) + 1 < NT) { \
                _Pragma("unroll") for (int i = 0; i < 2; ++i) { *(LAS v4u*)(lds + (((t) + 1) & 1) * AT_KS + kdst + 32 * i * AT_KP) = kr[i]; *(LAS v4u*)(lds + vs_next + vdst + 32 * i * AT_VP) = vr[i]; } \
                if ((t) + 2 < NT) { _Pragma("unroll") for (int i = 0; i < 2; ++i) { kr[i] = AT_GLD(ksrc, 64 * ((t) + 2) + 32 * i); vr[i] = AT_GLD(vsrc, 64 * ((t) + 2) + 32 * i); } } } \
            __syncthreads(); AT_ROT(); } while (0)
#define AT_STEP(C0, C1, P0, P1, t) do { \
            AT_PHASE_A(C0, C1, P0, P1, ((t) & 1) * AT_KS, 1); \
            AT_MID(C0, C1, t); \
            AT_PHASE_B(C0, C1, P0, vs_prev, 1); \
            AT_RESC(); } while (0)
#define AT_PACK(P0, P1) do { float ps_ = 0.f; \
            _Pragma("unroll") for (int r = 0; r < 16; ++r) ps_ += P0[r] + P1[r]; \
            lsum += ps_; \
            _Pragma("unroll") for (int w = 0; w < 8; ++w) { const float lo_ = P0[2 * w], hi_ = P0[2 * w + 1]; P0[w] = __builtin_bit_cast(float, cvtpk_bf16(lo_, hi_)); } \
            _Pragma("unroll") for (int w = 0; w < 8; ++w) P0[8 + w] = __builtin_bit_cast(float, cvtpk_bf16(P1[2 * w], P1[2 * w + 1])); } while (0)
        AT_PHASE_A(pA0, pA1, pA0, pA1, 0, 0); AT_MID(pA0, pA1, 0); AT_EXP(pA0, pA1); AT_RESC();
        AT_STAGE(0);
        int t = 1;
        for (; t + 1 < NT; t += 2) {
            AT_STEP(pB0, pB1, pA0, pA1, t);     AT_STAGE(t);
            AT_STEP(pA0, pA1, pB0, pB1, t + 1); AT_STAGE(t + 1);
        }
        if (NTW == NT) {
            AT_STEP(pB0, pB1, pA0, pA1, t); AT_ROT();
            AT_PACK(pB0, pB1); AT_PHASE_B(pB0, pB1, pB0, vs_prev, 0);
        } else {
            AT_PACK(pA0, pA1); AT_PHASE_B(pA0, pA1, pA0, vs_prev, 0);
        }
        __syncthreads();
        { int lane_e = F.lane; asm volatile("" : "+v"(lane_e));
        const int lane = lane_e, r32 = lane & 31, hi = lane >> 5;
        const float inv = 1.f / xhalf_sum(lsum);
        LAS float* XO = (LAS float*)(lds + AT_XO) + qt * 4096 + r32;
        if (map == 1) {
            const float sc = inv * small[SM_LAM];
#pragma unroll
            for (int mt = 0; mt < 4; ++mt)
#pragma unroll
                for (int r = 0; r < 16; ++r) XO[(32 * mt + (r & 3) + 8 * (r >> 2) + 4 * hi) * 32] = o[mt][r] * sc;
        }
        __syncthreads();
        if (map == 0) {
            float ss = 0.f;
#pragma unroll
            for (int mt = 0; mt < 4; ++mt)
#pragma unroll
                for (int r = 0; r < 16; ++r) { const float a = o[mt][r] * inv - XO[(32 * mt + (r & 3) + 8 * (r >> 2) + 4 * hi) * 32]; o[mt][r] = a; ss += a * a; }
            ss = xhalf_sum(ss);
            const float rr = (1.f - LAM_INIT) / sqrtf(ss * (1.f / 128.f) + EPS);
            LAS unsigned char* yb = lds + AT_YB + qt * (32 * AT_YP);
#pragma unroll
            for (int mt = 0; mt < 4; ++mt)
#pragma unroll
                for (int r4 = 0; r4 < 4; ++r4) { const int dv = 32 * mt + 8 * r4 + 4 * hi; const f32x4 gg = *(const GAS f32x4*)(F.in[7] + dv);
                    v2u w; w.x = cvtpk_bf16(o[mt][4 * r4] * rr * gg.x, o[mt][4 * r4 + 1] * rr * gg.y); w.y = cvtpk_bf16(o[mt][4 * r4 + 2] * rr * gg.z, o[mt][4 * r4 + 3] * rr * gg.w);
                    *(LAS v2u*)(yb + r32 * AT_YP + dv * 2) = w; }
            LDS_WAIT(); asm volatile("" ::: "memory");
            bf16* obase = MIXED + (tok0 + q0 + 32 * qt) * DM + h * 128;
#pragma unroll
            for (int i = 0; i < 8; ++i) { const int id = lane + 64 * i, row = id >> 4, cch = id & 15;
                const v4u w = *(const LAS v4u*)(yb + row * AT_YP + cch * 16); *(GAS v4u*)(obase + (size_t)row * DM + cch * 8) = w; }
        } }
#undef AT_ROT
#undef AT_GLD
#undef AT_KRD2
#undef AT_KRDQ
#undef AT_VRD
#undef AT_VFR
#undef AT_GAPA
#undef AT_GAPB
#undef AT_PHASE_A
#undef AT_PHASE_B
#undef AT_PACK
#undef AT_MID
#undef AT_EXP
#undef AT_RESC
#undef AT_STAGE
#undef AT_STEP
    }
}

constexpr int HG_P = 272, HG_KP = 80, HG_VP = 320, HG_GP = 272, HG_OP = 136;
constexpr int HG_QD = 0, HG_KI = 32 * HG_P, HG_KDT = 2 * 32 * HG_P, HG_V = HG_KDT + 128 * HG_KP, HG_CD = HG_V + 32 * HG_VP, HG_G = HG_CD + 512, HG_BUF = HG_G + 32 * HG_GP;
constexpr int HG_O = 2 * HG_BUF;
static_assert(HG_O + 32 * HG_OP * 4 <= RING_BYTES, "hgrn LDS map");
__device__ __forceinline__ bf16x8 pack8(const f32x16& x, int s) {
    v4u p; p.x = cvtpk_bf16(x[8 * s], x[8 * s + 1]); p.y = cvtpk_bf16(x[8 * s + 2], x[8 * s + 3]); p.z = cvtpk_bf16(x[8 * s + 4], x[8 * s + 5]); p.w = cvtpk_bf16(x[8 * s + 6], x[8 * s + 7]);
    return __builtin_bit_cast(bf16x8, p);
}
__device__ __forceinline__ bf16x8 tr_pair(LAS unsigned char* p0, LAS unsigned char* p1) {
    const s16x4 lo = __builtin_bit_cast(s16x4, __builtin_amdgcn_ds_read_tr16_b64_v4i16((LAS v4i16_t*)p0));
    const s16x4 hi4 = __builtin_bit_cast(s16x4, __builtin_amdgcn_ds_read_tr16_b64_v4i16((LAS v4i16_t*)p1));
    return (bf16x8){lo[0], lo[1], lo[2], lo[3], hi4[0], hi4[1], hi4[2], hi4[3]};
}
#define DPPF_(x, ctrl) __builtin_bit_cast(float, __builtin_amdgcn_update_dpp(0, __builtin_bit_cast(int, (x)), (ctrl), 0xf, 0xf, true))
__device__ __forceinline__ void hg_prep8(LAS unsigned char* bufp, const v4u rq, const v4u rf, const f32x4 lbA, const f32x4 lbB, int pc, int dk8, int lane) {
    const float lbv[8] = {lbA.x, lbA.y, lbA.z, lbA.w, lbB.x, lbB.y, lbB.z, lbB.w};
    float bb[8], fv[8];
    const unsigned fw[4] = {rf.x, rf.y, rf.z, rf.w}, qw[4] = {rq.x, rq.y, rq.z, rq.w};
#pragma unroll
    for (int i = 0; i < 8; ++i) { const float x = (i & 1) ? bfhi(fw[i >> 1]) : bflo(fw[i >> 1]); const float f = lbv[i] + (1.f - lbv[i]) * __builtin_amdgcn_rcpf(1.f + __expf(-x)); fv[i] = f; bb[i] = f; }
#pragma unroll
    for (int i = 0; i < 8; ++i) { float x = bb[i];
        x *= __builtin_bit_cast(float, __builtin_amdgcn_update_dpp(0x3f800000, __builtin_bit_cast(int, x), 0x111, 0xf, 0xf, false));
        x *= __builtin_bit_cast(float, __builtin_amdgcn_update_dpp(0x3f800000, __builtin_bit_cast(int, x), 0x112, 0xf, 0xf, false));
        x *= __builtin_bit_cast(float, __builtin_amdgcn_update_dpp(0x3f800000, __builtin_bit_cast(int, x), 0x114, 0xf, 0xf, false));
        x *= __builtin_bit_cast(float, __builtin_amdgcn_update_dpp(0x3f800000, __builtin_bit_cast(int, x), 0x118, 0xf, 0xf, false));
        x *= __builtin_bit_cast(float, __builtin_amdgcn_update_dpp(0x3f800000, __builtin_bit_cast(int, x), 0x142, 0xa, 0xf, false));
        bb[i] = x; }
    float qd[8], ki[8], kd[8], cdv[8];
#pragma unroll
    for (int i = 0; i < 8; ++i) { const float elast = __shfl(bb[i], (lane & 32) + 31);
        const float e = bb[i], ei = __builtin_amdgcn_rcpf(bb[i]), ed = elast * ei;
        const float xq = (i & 1) ? bfhi(qw[i >> 1]) : bflo(qw[i >> 1]); const float q = xq * __builtin_amdgcn_rcpf(1.f + __expf(-xq)); const float k = 1.f - fv[i];
        qd[i] = q * e; ki[i] = k * ei; kd[i] = k * ed; cdv[i] = elast; }
    *(LAS v4u*)(bufp + HG_QD + pc * HG_P + dk8 * 2) = (v4u){cvtpk_bf16(qd[0], qd[1]), cvtpk_bf16(qd[2], qd[3]), cvtpk_bf16(qd[4], qd[5]), cvtpk_bf16(qd[6], qd[7])};
    *(LAS v4u*)(bufp + HG_KI + pc * HG_P + dk8 * 2) = (v4u){cvtpk_bf16(ki[0], ki[1]), cvtpk_bf16(ki[2], ki[3]), cvtpk_bf16(ki[4], ki[5]), cvtpk_bf16(ki[6], ki[7])};
    *(LAS v4u*)(bufp + HG_KDT + pc * HG_VP + dk8 * 2) = (v4u){cvtpk_bf16(kd[0], kd[1]), cvtpk_bf16(kd[2], kd[3]), cvtpk_bf16(kd[4], kd[5]), cvtpk_bf16(kd[6], kd[7])};
    if (pc == 31) { *(LAS f32x4*)(bufp + HG_CD + dk8 * 4) = (f32x4){cdv[0], cdv[1], cdv[2], cdv[3]}; *(LAS f32x4*)(bufp + HG_CD + dk8 * 4 + 16) = (f32x4){cdv[4], cdv[5], cdv[6], cdv[7]}; }
}
__device__ __forceinline__ void hgrn_mfma(Frame& F) {
    const bf16* PROJ = (const bf16*)(F.ws + WS_PROJ); bf16* MIXED = (bf16*)(F.ws + WS_HN);
    const float* small = (const float*)(F.ws + WS_SMALL);
    LAS unsigned char* lds = F.lds;
    const int tid = F.tid, lane = F.lane, wave = F.wave, r32 = lane & 31, hh = lane >> 5;
    for (int u = F.vcu; u < 64; u += F.G) {
        const int b = u >> 2, h = u & 3; const size_t tok0 = (size_t)b * SEQ;
        __syncthreads();
        if (wave >= 4) {
            const int pt = tid - 256, pc = lane & 31, dkA = 16 * (wave - 4) + 8 * hh;
            const int vcA = pt >> 4, vseg = pt & 15;
            const f32x4 lb0 = *(const GAS f32x4*)(small + SM_LB + h * 128 + dkA), lb1 = *(const GAS f32x4*)(small + SM_LB + h * 128 + dkA + 4);
            const f32x4 lb2 = *(const GAS f32x4*)(small + SM_LB + h * 128 + dkA + 64), lb3 = *(const GAS f32x4*)(small + SM_LB + h * 128 + dkA + 68);
            v4u q0A, f0A, v0A, g0A, q1A, f1A, v1A, g1A, q0B, f0B, v0B, g0B, q1B, f1B, v1B, g1B;
#define HP_LOAD(S, chn) do { const bf16* p_ = PROJ + (tok0 + 32 * (chn) + pc) * INW + h * 128 + dkA; const bf16* v_ = PROJ + (tok0 + 32 * (chn) + vcA) * INW + h * 128 + vseg * 8; \
            asm volatile("global_load_dwordx4 %0, %1, off" : "=v"(q0##S) : "v"(p_ + C_HQ) : "memory"); \
            asm volatile("global_load_dwordx4 %0, %1, off" : "=v"(f0##S) : "v"(p_ + C_HF) : "memory"); \
            asm volatile("global_load_dwordx4 %0, %1, off" : "=v"(v0##S) : "v"(v_ + C_HI) : "memory"); \
            asm volatile("global_load_dwordx4 %0, %1, off" : "=v"(g0##S) : "v"(v_ + C_HG) : "memory"); \
            asm volatile("global_load_dwordx4 %0, %1, off" : "=v"(q1##S) : "v"(p_ + C_HQ + 64) : "memory"); \
            asm volatile("global_load_dwordx4 %0, %1, off" : "=v"(f1##S) : "v"(p_ + C_HF + 64) : "memory"); \
            asm volatile("global_load_dwordx4 %0, %1, off" : "=v"(v1##S) : "v"(v_ + (size_t)16 * INW + C_HI) : "memory"); \
            asm volatile("global_load_dwordx4 %0, %1, off" : "=v"(g1##S) : "v"(v_ + (size_t)16 * INW + C_HG) : "memory"); } while (0)
#define HP_WAIT(S) asm volatile("s_waitcnt vmcnt(8)" : "+v"(q0##S), "+v"(f0##S), "+v"(v0##S), "+v"(g0##S), "+v"(q1##S), "+v"(f1##S), "+v"(v1##S), "+v"(g1##S) :: "memory")
#define HP_PASS0(S, bufp) do { hg_prep8(bufp, q0##S, f0##S, lb0, lb1, pc, dkA, lane); \
            *(LAS v4u*)((bufp) + HG_V + vcA * HG_VP + vseg * 16) = v0##S; *(LAS v4u*)((bufp) + HG_V + (vcA + 16) * HG_VP + vseg * 16) = v1##S; \
            *(LAS v4u*)((bufp) + HG_G + vcA * HG_GP + vseg * 16) = g0##S; *(LAS v4u*)((bufp) + HG_G + (vcA + 16) * HG_GP + vseg * 16) = g1##S; } while (0)
#define HP_PASS1(S, bufp) hg_prep8(bufp, q1##S, f1##S, lb2, lb3, pc, dkA + 64, lane)
            HP_LOAD(A, 0); HP_LOAD(B, 1);
            HP_WAIT(A); HP_PASS0(A, lds); HP_PASS1(A, lds);
            HP_LOAD(A, 2);
            for (int ch2 = 0; ch2 < SEQ / 32; ch2 += 2) {
                __syncthreads();
                HP_WAIT(B); HP_PASS0(B, lds + HG_BUF);
                __syncthreads();
                HP_PASS1(B, lds + HG_BUF);
                HP_LOAD(B, (ch2 + 3 < SEQ / 32 ? ch2 + 3 : SEQ / 32 - 1));
                __syncthreads();
                HP_WAIT(A); HP_PASS0(A, lds);
                __syncthreads();
                HP_PASS1(A, lds);
                HP_LOAD(A, (ch2 + 4 < SEQ / 32 ? ch2 + 4 : SEQ / 32 - 1));
            }
            asm volatile("s_waitcnt vmcnt(0)" : "+v"(q0A), "+v"(f0A), "+v"(v0A), "+v"(g0A), "+v"(q1A), "+v"(f1A), "+v"(v1A), "+v"(g1A), "+v"(q0B), "+v"(f0B), "+v"(v0B), "+v"(g0B), "+v"(q1B), "+v"(f1B), "+v"(v1B), "+v"(g1B) :: "memory");
#undef HP_LOAD
#undef HP_WAIT
#undef HP_PASS0
#undef HP_PASS1
        } else {
            const int dvt = wave;
            const int kdoff = (((lane & 15) >> 2)) * HG_VP + (16 * ((lane >> 4) & 1) + 4 * (lane & 3)) * 2;
            const int troff = (((lane & 15) >> 2)) * HG_VP + (32 * dvt + 16 * ((lane >> 4) & 1) + 4 * (lane & 3)) * 2;
            const int vc = tid >> 3, sg = tid & 7;
            const f32x4 ga0 = *(const GAS f32x4*)(F.in[10] + 8 * sg), ga1 = *(const GAS f32x4*)(F.in[10] + 8 * sg + 4);
            const f32x4 gb0 = *(const GAS f32x4*)(F.in[10] + 64 + 8 * sg), gb1 = *(const GAS f32x4*)(F.in[10] + 64 + 8 * sg + 4);
            f32x16 S0, S1, S2, S3;
#pragma unroll
            for (int r = 0; r < 16; ++r) { S0[r] = 0.f; S1[r] = 0.f; S2[r] = 0.f; S3[r] = 0.f; }
            for (int ch = 0; ch < SEQ / 32; ++ch) {
                LAS unsigned char* bufp = lds + (ch & 1) * HG_BUF;
                __syncthreads();
                f32x16 o, o2, X, X2;
#pragma unroll
                for (int r = 0; r < 16; ++r) { o[r] = 0.f; o2[r] = 0.f; X[r] = 0.f; X2[r] = 0.f; }
#pragma unroll
                for (int kk = 0; kk < 4; ++kk)
#pragma unroll
                    for (int s2 = 0; s2 < 2; ++s2) {
                        LAS unsigned char* qa = bufp + HG_QD + r32 * HG_P + (32 * kk + 16 * s2 + 4 * hh) * 2;
                        const v2u a0 = *(const LAS v2u*)qa, a1 = *(const LAS v2u*)(qa + 16);
                        const bf16x8 af = __builtin_bit_cast(bf16x8, (v4u){a0.x, a0.y, a1.x, a1.y});
                        const bf16x8 sb = pack8(kk == 0 ? S0 : kk == 1 ? S1 : kk == 2 ? S2 : S3, s2);
                        if (kk < 2) o = __builtin_amdgcn_mfma_f32_32x32x16_bf16(af, sb, o, 0, 0, 0);
                        else        o2 = __builtin_amdgcn_mfma_f32_32x32x16_bf16(af, sb, o2, 0, 0, 0);
                    }
#pragma unroll
                for (int s8 = 0; s8 < 8; ++s8) {
                    const bf16x8 af = *(const LAS bf16x8*)(bufp + HG_KI + r32 * HG_P + (16 * s8 + 8 * hh) * 2);
                    const bf16x8 bfr = *(const LAS bf16x8*)(bufp + HG_QD + r32 * HG_P + (16 * s8 + 8 * hh) * 2);
                    if (s8 < 4) X = __builtin_amdgcn_mfma_f32_32x32x16_bf16(af, bfr, X, 0, 0, 0);
                    else        X2 = __builtin_amdgcn_mfma_f32_32x32x16_bf16(af, bfr, X2, 0, 0, 0);
                }
#pragma unroll
                for (int r = 0; r < 16; ++r) { const int cp = (r & 3) + 8 * (r >> 2) + 4 * hh; X[r] = cp > r32 ? 0.f : X[r] + X2[r]; o[r] += o2[r]; }
#pragma unroll
                for (int s2 = 0; s2 < 2; ++s2) {
                    LAS unsigned char* vp = bufp + HG_V + troff + (16 * s2 + 4 * hh) * HG_VP;
                    o = __builtin_amdgcn_mfma_f32_32x32x16_bf16(pack8(X, s2), tr_pair(vp, vp + 8 * HG_VP), o, 0, 0, 0);
                }
                { LAS float* ob = (LAS float*)(lds + HG_O) + 32 * dvt + r32;
#pragma unroll
                  for (int r = 0; r < 16; ++r) ob[((r & 3) + 8 * (r >> 2) + 4 * hh) * HG_OP] = o[r]; }
                __syncthreads();
#pragma unroll
                for (int kk = 0; kk < 4; ++kk) {
                    const int dk0 = 32 * kk;
                    const LAS float* cdp = (const LAS float*)(bufp + HG_CD) + dk0 + 4 * hh;
#pragma unroll
                    for (int r4 = 0; r4 < 4; ++r4) { const f32x4 c4 = *(const LAS f32x4*)(cdp + 8 * r4);
                        if (kk == 0)      { S0[4 * r4] *= c4.x; S0[4 * r4 + 1] *= c4.y; S0[4 * r4 + 2] *= c4.z; S0[4 * r4 + 3] *= c4.w; }
                        else if (kk == 1) { S1[4 * r4] *= c4.x; S1[4 * r4 + 1] *= c4.y; S1[4 * r4 + 2] *= c4.z; S1[4 * r4 + 3] *= c4.w; }
                        else if (kk == 2) { S2[4 * r4] *= c4.x; S2[4 * r4 + 1] *= c4.y; S2[4 * r4 + 2] *= c4.z; S2[4 * r4 + 3] *= c4.w; }
                        else              { S3[4 * r4] *= c4.x; S3[4 * r4 + 1] *= c4.y; S3[4 * r4 + 2] *= c4.z; S3[4 * r4 + 3] *= c4.w; } }
#pragma unroll
                    for (int s2 = 0; s2 < 2; ++s2) {
                        LAS unsigned char* kp = bufp + HG_KDT + kdoff + (16 * s2 + 8 * hh) * HG_VP + dk0 * 2;
                        const bf16x8 af = tr_pair(kp, kp + 4 * HG_VP);
                        LAS unsigned char* vp = bufp + HG_V + troff + (16 * s2 + 8 * hh) * HG_VP;
                        const bf16x8 bfr = tr_pair(vp, vp + 4 * HG_VP);
                        if (kk == 0)      S0 = __builtin_amdgcn_mfma_f32_32x32x16_bf16(af, bfr, S0, 0, 0, 0);
                        else if (kk == 1) S1 = __builtin_amdgcn_mfma_f32_32x32x16_bf16(af, bfr, S1, 0, 0, 0);
                        else if (kk == 2) S2 = __builtin_amdgcn_mfma_f32_32x32x16_bf16(af, bfr, S2, 0, 0, 0);
                        else              S3 = __builtin_amdgcn_mfma_f32_32x32x16_bf16(af, bfr, S3, 0, 0, 0);
                    }
                }
                { const LAS float* op = (const LAS float*)(lds + HG_O) + vc * HG_OP + 8 * sg;
                  const f32x4 x0 = *(const LAS f32x4*)op, x1 = *(const LAS f32x4*)(op + 4), x2 = *(const LAS f32x4*)(op + 64), x3 = *(const LAS f32x4*)(op + 68);
                  const v4u gwa = *(const LAS v4u*)(bufp + HG_G + vc * HG_GP + sg * 16), gwb = *(const LAS v4u*)(bufp + HG_G + vc * HG_GP + (sg + 8) * 16);
                  float ss = ((x0.x * x0.x + x0.y * x0.y) + (x0.z * x0.z + x0.w * x0.w)) + ((x1.x * x1.x + x1.y * x1.y) + (x1.z * x1.z + x1.w * x1.w))
                           + ((x2.x * x2.x + x2.y * x2.y) + (x2.z * x2.z + x2.w * x2.w)) + ((x3.x * x3.x + x3.y * x3.y) + (x3.z * x3.z + x3.w * x3.w));
                  ss += DPPF_(ss, 0xB1); ss += DPPF_(ss, 0x4E); ss += DPPF_(ss, 0x141);
                  const float rr = __builtin_amdgcn_rsqf(ss * (1.f / 128.f) + EPS);
                  const size_t tok = tok0 + 32 * ch + vc;
                  const unsigned gwa_[4] = {gwa.x, gwa.y, gwa.z, gwa.w}, gwb_[4] = {gwb.x, gwb.y, gwb.z, gwb.w};
                  const float ova[8] = {x0.x, x0.y, x0.z, x0.w, x1.x, x1.y, x1.z, x1.w}, ovb[8] = {x2.x, x2.y, x2.z, x2.w, x3.x, x3.y, x3.z, x3.w};
                  const float gga[8] = {ga0.x, ga0.y, ga0.z, ga0.w, ga1.x, ga1.y, ga1.z, ga1.w}, ggb[8] = {gb0.x, gb0.y, gb0.z, gb0.w, gb1.x, gb1.y, gb1.z, gb1.w};
                  unsigned wa[4], wb[4];
#pragma unroll
                  for (int j = 0; j < 4; ++j) { const float a0 = bflo(gwa_[j]), a1 = bfhi(gwa_[j]), b0 = bflo(gwb_[j]), b1 = bfhi(gwb_[j]);
                      wa[j] = cvtpk_bf16(ova[2 * j] * rr * gga[2 * j] * (a0 * __builtin_amdgcn_rcpf(1.f + __expf(-a0))), ova[2 * j + 1] * rr * gga[2 * j + 1] * (a1 * __builtin_amdgcn_rcpf(1.f + __expf(-a1))));
                      wb[j] = cvtpk_bf16(ovb[2 * j] * rr * ggb[2 * j] * (b0 * __builtin_amdgcn_rcpf(1.f + __expf(-b0))), ovb[2 * j + 1] * rr * ggb[2 * j + 1] * (b1 * __builtin_amdgcn_rcpf(1.f + __expf(-b1)))); }
                  bf16* dst = MIXED + tok * DM + 512 + h * 128 + 8 * sg;
                  *(GAS v4u*)dst = (v4u){wa[0], wa[1], wa[2], wa[3]}; *(GAS v4u*)(dst + 64) = (v4u){wb[0], wb[1], wb[2], wb[3]}; }
            }
        }
    }
}
template <int N> __device__ __forceinline__ unsigned row_ror(unsigned x) { return (unsigned)__builtin_amdgcn_update_dpp((int)x, (int)x, 0x120 + N, 0xf, 0xf, false); }
__device__ __forceinline__ unsigned umax_(unsigned a, unsigned b) { return a > b ? a : b; }
__device__ __forceinline__ unsigned umin_(unsigned a, unsigned b) { return a < b ? a : b; }
__device__ __forceinline__ unsigned row_umax16(unsigned x) {
    unsigned y;
    asm volatile("s_nop 1\n\tv_max_u32_dpp %0, %1, %1 row_ror:1 row_mask:0xf bank_mask:0xf\n\t"
                 "s_nop 1\n\tv_max_u32_dpp %0, %0, %0 row_ror:2 row_mask:0xf bank_mask:0xf\n\t"
                 "s_nop 1\n\tv_max_u32_dpp %0, %0, %0 row_ror:4 row_mask:0xf bank_mask:0xf\n\t"
                 "s_nop 1\n\tv_max_u32_dpp %0, %0, %0 row_ror:8 row_mask:0xf bank_mask:0xf"
                 : "=&v"(y) : "v"(x));
    return y;
}
__device__ __forceinline__ float row_fsum16(float v) {
    v += __builtin_bit_cast(float, row_ror<1>(__builtin_bit_cast(unsigned, v))); v += __builtin_bit_cast(float, row_ror<2>(__builtin_bit_cast(unsigned, v)));
    v += __builtin_bit_cast(float, row_ror<4>(__builtin_bit_cast(unsigned, v))); v += __builtin_bit_cast(float, row_ror<8>(__builtin_bit_cast(unsigned, v))); return v; }
__device__ __forceinline__ unsigned h2key(unsigned x) { return (x & 0x80000000u) ? (~x & 0xffff0000u) : (x | 0x80000000u); }
__device__ __forceinline__ float hkey2f(unsigned k) { const unsigned hb = ((k & 0x80000000u) ? (k & 0x7fff0000u) : (~k & 0xffff0000u)) >> 16; return (float)__builtin_bit_cast(_Float16, (unsigned short)hb); }
__device__ __forceinline__ unsigned f2key(float f) { const unsigned u = __builtin_bit_cast(unsigned, f); return (u & 0x80000000u) ? ~u : (u | 0x80000000u); }
__device__ __forceinline__ float key2f(unsigned k) { const unsigned u = (k & 0x80000000u) ? (k & 0x7fffffffu) : ~k; return __builtin_bit_cast(float, u); }
__device__ __forceinline__ unsigned pair_code(int s) {
    if (s < 16) return (unsigned)s;
    if (s < 24) return 16u + (unsigned)(s - 16);
    if (s < 29) return 32u + (unsigned)(s - 24);
    if (s < 33) return 48u + (unsigned)(s - 29);
    if (s < 36) return 64u + (unsigned)(s - 33);
    if (s < 42) return 80u + 16u * (unsigned)((s - 36) >> 1) + (unsigned)((s - 36) & 1);
    if (s < 50) return 128u + 16u * (unsigned)(s - 42);
    return 0xFFu;
}
#define CAS_(a, b) do { const unsigned hi_ = umax_(a, b), lo_ = umin_(a, b); a = hi_; b = lo_; } while (0)
__device__ __forceinline__ void row_umax16_x2(unsigned xa, unsigned xb, unsigned& ya, unsigned& yb) {
    asm volatile("s_nop 1\n\tv_max_u32_dpp %0, %2, %2 row_ror:1 row_mask:0xf bank_mask:0xf\n\tv_max_u32_dpp %1, %3, %3 row_ror:1 row_mask:0xf bank_mask:0xf\n\t"
                 "s_nop 0\n\tv_max_u32_dpp %0, %0, %0 row_ror:2 row_mask:0xf bank_mask:0xf\n\tv_max_u32_dpp %1, %1, %1 row_ror:2 row_mask:0xf bank_mask:0xf\n\t"
                 "s_nop 0\n\tv_max_u32_dpp %0, %0, %0 row_ror:4 row_mask:0xf bank_mask:0xf\n\tv_max_u32_dpp %1, %1, %1 row_ror:4 row_mask:0xf bank_mask:0xf\n\t"
                 "s_nop 0\n\tv_max_u32_dpp %0, %0, %0 row_ror:8 row_mask:0xf bank_mask:0xf\n\tv_max_u32_dpp %1, %1, %1 row_ror:8 row_mask:0xf bank_mask:0xf"
                 : "=&v"(ya), "=&v"(yb) : "v"(xa), "v"(xb));
}
#define TK_LOADSORT(P, th_) \
    unsigned P##0, P##1, P##2, P##3, P##4, P##5, P##6, P##7; \
    { const v4u sv = *(const GAS v4u*)(SC + (size_t)((th_) >> 3) * 2048 + ((th_) & 7) * 256 + c * 128 + l15 * 8); const unsigned nb = 127u - 8u * (unsigned)l15; \
      P##0 = h2key(sv.x << 16) | nb; P##1 = h2key(sv.x & 0xffff0000u) | (nb - 1u); P##2 = h2key(sv.y << 16) | (nb - 2u); P##3 = h2key(sv.y & 0xffff0000u) | (nb - 3u); \
      P##4 = h2key(sv.z << 16) | (nb - 4u); P##5 = h2key(sv.z & 0xffff0000u) | (nb - 5u); P##6 = h2key(sv.w << 16) | (nb - 6u); P##7 = h2key(sv.w & 0xffff0000u) | (nb - 7u); \
      CAS_(P##0, P##1); CAS_(P##2, P##3); CAS_(P##4, P##5); CAS_(P##6, P##7); CAS_(P##0, P##2); CAS_(P##1, P##3); CAS_(P##4, P##6); CAS_(P##5, P##7); CAS_(P##1, P##2); CAS_(P##5, P##6); CAS_(P##0, P##4); CAS_(P##3, P##7); \
      CAS_(P##1, P##5); CAS_(P##2, P##6); CAS_(P##1, P##4); CAS_(P##3, P##6); CAS_(P##2, P##4); CAS_(P##3, P##5); CAS_(P##3, P##4); }
#define TK_POP(P, m_) do { const bool pop_ = (P##0 == (m_)); P##0 = pop_ ? P##1 : P##0; P##1 = pop_ ? P##2 : P##1; P##2 = pop_ ? P##3 : P##2; P##3 = pop_ ? P##4 : P##3; \
      P##4 = pop_ ? P##5 : P##4; P##5 = pop_ ? P##6 : P##5; P##6 = pop_ ? P##7 : P##6; P##7 = pop_ ? 0u : P##7; } while (0)
__device__ __forceinline__ void topk_stage1x2(const unsigned short* SC, int thA, int thB, int c, int l15, unsigned& resA, unsigned& resB) {
    TK_LOADSORT(ka, thA) TK_LOADSORT(kb, thB)
    unsigned ra = 0u, rb = 0u;
#pragma unroll
    for (int r = 0; r < 16; ++r) {
        unsigned ma, mb; row_umax16_x2(ka0, kb0, ma, mb);
        TK_POP(ka, ma); TK_POP(kb, mb);
        ra = (l15 == r) ? ma : ra; rb = (l15 == r) ? mb : rb;
    }
    resA = ra; resB = rb;
}
__device__ __forceinline__ void topk_v2(Frame& F) {
    const unsigned short* SC = (const unsigned short*)(F.ws + WS_SC); int* IDX = (int*)(F.ws + WS_IDX); float* GATE = (float*)(F.ws + WS_GATE); float* GSU = (float*)(F.ws + WS_GSU);
    const float* SU = (const float*)(F.ws + WS_SU); const float* SV = (const float*)(F.ws + WS_SV);
    const int gw = F.vcu * NWAVES + F.wave, NGW = F.G * NWAVES, lane = F.lane, l15 = lane & 15, row = lane >> 4, c = row & 1, rbase = lane & 48;
    const unsigned pc0 = pair_code(l15), pc1 = pair_code(l15 + 16), pc2 = pair_code(l15 + 32), pc3 = pair_code(l15 + 48);
    const int src1 = l15 + 32 * (row & 1), src2 = src1 + 16;
    for (int it0 = gw * 32; it0 < NTOK * 2; it0 += NGW * 32)
    for (int it = it0; it < it0 + 32; ++it) {
        const int thb = 4 * it;
        unsigned resA, resB; topk_stage1x2(SC, thb + (row >> 1), thb + 2 + (row >> 1), c, l15, resA, resB);
        const unsigned a1 = (unsigned)__shfl((int)resA, src1), a2 = (unsigned)__shfl((int)resA, src2), b1 = (unsigned)__shfl((int)resB, src1), b2 = (unsigned)__shfl((int)resB, src2);
        const unsigned S1 = row < 2 ? a1 : b1, S2 = row < 2 ? a2 : b2;
        unsigned c0, c1, c2, c3;
#define TK_CAND(CK, PC) do { const unsigned ka_ = (unsigned)__shfl((int)S1, rbase + (int)((PC) >> 4 & 15u)), kb_ = (unsigned)__shfl((int)S2, rbase + (int)((PC) & 15u)); \
            const float sm_ = hkey2f(ka_) + hkey2f(kb_); CK = (PC) == 0xFFu ? 0u : ((f2key(sm_) & ~0xFFu) | (255u - (PC))); } while (0)
        TK_CAND(c0, pc0); TK_CAND(c1, pc1); TK_CAND(c2, pc2); TK_CAND(c3, pc3);
#undef TK_CAND
        CAS_(c0, c1); CAS_(c2, c3); CAS_(c0, c2); CAS_(c1, c3); CAS_(c1, c2);
        unsigned res2 = 0u;
#pragma unroll
        for (int r = 0; r < 16; ++r) {
            const unsigned m = row_umax16(c0); const bool pop = (c0 == m);
            c0 = pop ? c1 : c0; c1 = pop ? c2 : c1; c2 = pop ? c3 : c2; c3 = pop ? 0u : c3;
            res2 = (l15 == r) ? m : res2;
        }
        const unsigned code = 255u - (res2 & 0xFFu);
        const unsigned ka = (unsigned)__shfl((int)S1, rbase + (int)(code >> 4 & 15u)), kb = (unsigned)__shfl((int)S2, rbase + (int)(code & 15u));
        const float ts = hkey2f(ka) + hkey2f(kb);
        const int e = (int)((127u - (ka & 0x7Fu)) * 128u + (127u - (kb & 0x7Fu)));
        const float tmax = __builtin_bit_cast(float, (unsigned)__shfl((int)__builtin_bit_cast(unsigned, ts), rbase));
        const float ex = __expf(ts - tmax);
        const float sum = row_fsum16(ex);
        const int th = thb + row;
        const size_t o = (size_t)(th >> 3) * NEXP_SEL + (th & 7) * 16 + l15;
        IDX[o] = e; GATE[o] = ex / sum * SV[e]; GSU[o] = SU[e];
    }
}

constexpr int PG_TOK = 16;
constexpr int PG_IDX = 0, PG_HID = 4096, PG_SA = PG_HID + 8192, PG_TB = PG_SA + 64, PG_WB = PG_TB + 4096;
static_assert(PG_WB % 16 == 0 && PG_TB % 16 == 0 && NWAVES * PG_WB <= RING_BYTES, "gather LDS map");
__device__ __forceinline__ void peer_sliced(Frame& F) {
    const unsigned char* U8T = F.ws + WS_U8; const unsigned char* V8T = F.ws + WS_V8; const unsigned char* X8 = F.ws + WS_X8;
    const float* SSQ = (const float*)(F.ws + WS_CTL) + CW_SSQ;
    const int* IDX = (const int*)(F.ws + WS_IDX); const float* GATE = (const float*)(F.ws + WS_GATE); const float* GSU = (const float*)(F.ws + WS_GSU); const float* gf = F.in[17];
    bf16* PO = (bf16*)(F.ws + WS_PO); const bf16* HB = (const bf16*)(F.ws + WS_HN2);
    const int gw = F.vcu * NWAVES + F.wave, NGW = F.G * NWAVES, lane = F.lane, m = lane & 15, g = lane >> 4;
    const int row8 = lane >> 3, piece = lane & 7;
    LAS unsigned char* wb = F.lds + F.wave * PG_WB;
    LAS unsigned short* idxs = (LAS unsigned short*)(wb + PG_IDX);
    LAS float* hid = (LAS float*)(wb + PG_HID);
    LAS float* sqp = hid + 64 + lane;
    LAS float* sai = (LAS float*)(wb + PG_SA);
    LAS unsigned char* tb = wb + PG_TB;
    const int p8 = m & 7; const unsigned bsh = 8u * (unsigned)(p8 & 3); const bool bhi = (p8 >> 2) != 0;
    constexpr size_t SLICE = (size_t)16384 * 128;
    const int usw = 16 * (piece ^ ((row8 >> 1) & 3));
    const int urd0 = m * 128 + 16 * ((2 * g) ^ ((m >> 1) & 7)), urd1 = m * 128 + 16 * ((2 * g + 1) ^ ((m >> 1) & 7));
    for (int blk = gw; blk < NTOK / PG_TOK; blk += NGW) {
        const int t0 = blk * PG_TOK;
#pragma unroll
        for (int k = 0; k < 32; ++k) { const int id = lane + 64 * k; idxs[id] = (unsigned short)IDX[(size_t)t0 * NEXP_SEL + id]; }
        LDS_WAIT(); asm volatile("" ::: "memory");
        for (int p = 0; p < 8; ++p) {
            const unsigned char* Up = U8T + (size_t)p * SLICE;
            const unsigned char* Xp = X8 + (size_t)t0 * DM + 128 * p + 32 * g;
            v4u ab[2][16]; l2 xs[2][2];
#define PGU_ISSUE(i_, buf_) do { _Pragma("unroll") for (int k = 0; k < 16; ++k) { const unsigned e = idxs[(i_) * 128 + 8 * k + row8]; \
                ab[buf_][k] = *(const GAS v4u*)(Up + (size_t)e * 128 + (usw ^ ((k & 1) ? 64 : 0))); } \
                xs[buf_][0] = *(const GAS l2*)(Xp + (size_t)(i_) * DM); xs[buf_][1] = *(const GAS l2*)(Xp + (size_t)(i_) * DM + 16); } while (0)
#define PGU_BODY(i_, cur_, nxt_) do { if ((i_) + 1 < PG_TOK) PGU_ISSUE((i_) + 1, nxt_); SCHED_FENCE(); \
                _Pragma("unroll") for (int rb = 0; rb < 4; ++rb) { LAS f32x4* hp0 = (LAS f32x4*)(hid + (i_) * 128 + 32 * rb + 4 * g); LAS f32x4* hp1 = hp0 + 4; \
                    _Pragma("unroll") for (int q4 = 0; q4 < 4; ++q4) *(LAS v4u*)(tb + 1024 * q4 + 16 * lane) = ab[cur_][4 * rb + q4]; \
                    f32x4 acc0 = p == 0 ? (f32x4){0.f, 0.f, 0.f, 0.f} : *hp0, acc1 = p == 0 ? (f32x4){0.f, 0.f, 0.f, 0.f} : *hp1; \
                    const l2 a0 = *(const LAS l2*)(tb + urd0), a1 = *(const LAS l2*)(tb + urd1), b0 = *(const LAS l2*)(tb + 2048 + urd0), b1 = *(const LAS l2*)(tb + 2048 + urd1); \
                    acc0 = __builtin_amdgcn_mfma_f32_16x16x32_fp8_bf8(a0.x, xs[cur_][0].x, acc0, 0, 0, 0); acc1 = __builtin_amdgcn_mfma_f32_16x16x32_fp8_bf8(b0.x, xs[cur_][0].x, acc1, 0, 0, 0); \
                    acc0 = __builtin_amdgcn_mfma_f32_16x16x32_fp8_bf8(a0.y, xs[cur_][0].y, acc0, 0, 0, 0); acc1 = __builtin_amdgcn_mfma_f32_16x16x32_fp8_bf8(b0.y, xs[cur_][0].y, acc1, 0, 0, 0); \
                    acc0 = __builtin_amdgcn_mfma_f32_16x16x32_fp8_bf8(a1.x, xs[cur_][1].x, acc0, 0, 0, 0); acc1 = __builtin_amdgcn_mfma_f32_16x16x32_fp8_bf8(b1.x, xs[cur_][1].x, acc1, 0, 0, 0); \
                    acc0 = __builtin_amdgcn_mfma_f32_16x16x32_fp8_bf8(a1.y, xs[cur_][1].y, acc0, 0, 0, 0); acc1 = __builtin_amdgcn_mfma_f32_16x16x32_fp8_bf8(b1.y, xs[cur_][1].y, acc1, 0, 0, 0); \
                    if (m == 0) { *hp0 = acc0; *hp1 = acc1; } } SCHED_FENCE(); } while (0)
            PGU_ISSUE(0, 0);
            for (int i2 = 0; i2 < PG_TOK; i2 += 2) { PGU_BODY(i2, 0, 1); PGU_BODY(i2 + 1, 1, 0); }
#undef PGU_ISSUE
#undef PGU_BODY
            LDS_WAIT(); asm volatile("" ::: "memory");
        }
        for (int i = 0; i < PG_TOK; ++i) {
            const int t = t0 + i; const float sx = 1.f / sqrtf(SSQ[t] * (1.f / DM) + EPS);
            float w[8][4]; float amax = 0.f;
#pragma unroll
            for (int r = 0; r < 8; ++r) { const f32x4 h4 = *(const LAS f32x4*)(hid + i * 128 + 16 * r + 4 * g);
                const f32x4 su4 = *(const GAS f32x4*)(GSU + (size_t)t * NEXP_SEL + 16 * r + 4 * g), gv4 = *(const GAS f32x4*)(GATE + (size_t)t * NEXP_SEL + 16 * r + 4 * g);
#pragma unroll
                for (int j = 0; j < 4; ++j) { w[r][j] = gelu_as(h4[j] * su4[j] * sx) * gv4[j]; amax = fmaxf(amax, fabsf(w[r][j])); } }
            amax = fmaxf(amax, __shfl_xor(amax, 16)); amax = fmaxf(amax, __shfl_xor(amax, 32));
            const float sa = amax > 0.f ? 224.f / amax : 1.f;
            LDS_WAIT(); asm volatile("" ::: "memory");
            if (m == 0) {
                LAS unsigned char* wrow = (LAS unsigned char*)(hid + i * 128);
#pragma unroll
                for (int r = 0; r < 8; ++r) { int pk = __builtin_amdgcn_cvt_pk_fp8_f32(w[r][0] * sa, w[r][1] * sa, 0, false); pk = __builtin_amdgcn_cvt_pk_fp8_f32(w[r][2] * sa, w[r][3] * sa, pk, true);
                    wrow[4 * r + g] = (unsigned char)pk; wrow[32 + 4 * r + g] = (unsigned char)(pk >> 8); wrow[64 + 4 * r + g] = (unsigned char)(pk >> 16); wrow[96 + 4 * r + g] = (unsigned char)(pk >> 24); }
            }
            if (lane == 0) sai[i] = amax > 0.f ? amax * (1.f / 224.f) : 1.f;
        }
        LDS_WAIT(); asm volatile("" ::: "memory");
        for (int p = 0; p < 8; ++p) {
            const unsigned char* Vp = V8T + (size_t)p * SLICE + 16 * piece;
            v4u va[2][16];
#define PGV_ISSUE(i_, buf_) do { _Pragma("unroll") for (int k = 0; k < 16; ++k) { const unsigned e = idxs[(i_) * 128 + 8 * k + row8]; va[buf_][k] = *(const GAS v4u*)(Vp + (size_t)e * 128); } } while (0)
#define PGV_BODY(i_, cur_, nxt_) do { if ((i_) + 1 < PG_TOK) PGV_ISSUE((i_) + 1, nxt_); \
                const LAS v4u* wp = (const LAS v4u*)((LAS unsigned char*)(hid + (i_) * 128) + 32 * g); const v4u w0 = wp[0], w1 = wp[1]; \
                const unsigned ww[8] = {w0.x, w0.y, w0.z, w0.w, w1.x, w1.y, w1.z, w1.w}; \
                SCHED_FENCE(); f32x4 c = (f32x4){0.f, 0.f, 0.f, 0.f}; \
                _Pragma("unroll") for (int kb = 0; kb < 4; ++kb) { \
                    _Pragma("unroll") for (int q4 = 0; q4 < 4; ++q4) *(LAS v4u*)(tb + 1024 * q4 + 16 * lane) = va[cur_][4 * kb + q4]; \
                    long rr_[8]; \
                    _Pragma("unroll") for (int q4 = 0; q4 < 4; ++q4) { rr_[2 * q4] = *(const LAS long*)(tb + 1024 * q4 + g * 128 + 8 * m); rr_[2 * q4 + 1] = *(const LAS long*)(tb + 1024 * q4 + (4 + g) * 128 + 8 * m); } \
                    _Pragma("unroll") for (int q8 = 0; q8 < 8; ++q8) { const int q = 8 * kb + q8; const unsigned a8 = ((ww[q >> 2] >> (8 * (q & 3))) & 0xffu) << bsh; const long bop = (long)(bhi ? ((unsigned long long)a8 << 32) : (unsigned long long)a8); \
                      c = __builtin_amdgcn_mfma_f32_16x16x32_fp8_fp8(rr_[q8], bop, c, 0, 0, 0); } } \
                SCHED_FENCE(); \
                { const float isa = sai[i_]; LAS unsigned short* ob = (LAS unsigned short*)(tb) + 32 * g + (m & 7);         \
                  if (m < 8) { ob[0] = (unsigned short)f2bf(c[0] * isa); ob[8] = (unsigned short)f2bf(c[1] * isa); ob[16] = (unsigned short)f2bf(c[2] * isa); ob[24] = (unsigned short)f2bf(c[3] * isa); } \
                  const v4u ov = *(const LAS v4u*)(tb + 16 * (lane & 15)); \
                  if (lane < 16) *(GAS v4u*)(PO + (size_t)(t0 + (i_)) * DM + 128 * p + 8 * lane) = ov; } } while (0)
            PGV_ISSUE(0, 0);
            for (int i2 = 0; i2 < PG_TOK; i2 += 2) { PGV_BODY(i2, 0, 1); PGV_BODY(i2 + 1, 1, 0); }
#undef PGV_ISSUE
#undef PGV_BODY
        }
        LDS_WAIT(); asm volatile("" ::: "memory");
        VM_WAIT();
        for (int i = 0; i < PG_TOK; i += 2) {
            GAS f32x4* hrA = (GAS f32x4*)(F.out + (size_t)(t0 + i) * DM) + lane; GAS f32x4* hrB = hrA + DM / 4;
            const GAS v2u* prA = (const GAS v2u*)(PO + (size_t)(t0 + i) * DM) + lane; const GAS v2u* prB = prA + DM / 4;
            const GAS v2u* hbA = (const GAS v2u*)(HB + (size_t)(t0 + i) * DM) + lane; const GAS v2u* hbB = hbA + DM / 4;
            v2u pa[4], pb[4], ha[4], hb2[4];
#pragma unroll
            for (int j = 0; j < 4; ++j) { pa[j] = prA[64 * j]; ha[j] = hbA[64 * j]; pb[j] = prB[64 * j]; hb2[j] = hbB[64 * j]; }
            f32x4 ya[4], yb[4]; float sa = 0.f, sb = 0.f;
#pragma unroll
            for (int j = 0; j < 4; ++j) {
                ya[j] = (f32x4){bflo(ha[j].x), bfhi(ha[j].x), bflo(ha[j].y), bfhi(ha[j].y)} + (f32x4){bflo(pa[j].x), bfhi(pa[j].x), bflo(pa[j].y), bfhi(pa[j].y)};
                yb[j] = (f32x4){bflo(hb2[j].x), bfhi(hb2[j].x), bflo(hb2[j].y), bfhi(hb2[j].y)} + (f32x4){bflo(pb[j].x), bfhi(pb[j].x), bflo(pb[j].y), bfhi(pb[j].y)};
                sa += (ya[j].x * ya[j].x + ya[j].y * ya[j].y) + (ya[j].z * ya[j].z + ya[j].w * ya[j].w); sb += (yb[j].x * yb[j].x + yb[j].y * yb[j].y) + (yb[j].z * yb[j].z + yb[j].w * yb[j].w); }
#pragma unroll
            for (int o = 1; o < 64; o <<= 1) { sa += __shfl_xor(sa, o); sb += __shfl_xor(sb, o); }
            const float ra = 1.f / sqrtf(sa * (1.f / DM) + EPS), rb = 1.f / sqrtf(sb * (1.f / DM) + EPS);
#pragma unroll
            for (int j = 0; j < 4; ++j) { const f32x4 gg = *((const GAS f32x4*)gf + lane + 64 * j); hrA[64 * j] = ya[j] * ra * gg; hrB[64 * j] = yb[j] * rb * gg; }
        }
        LDS_WAIT(); asm volatile("" ::: "memory");
    }
}

struct Args { const float* in[18]; float* out; unsigned char* ws; int ph_lo, ph_hi; };
__global__ void __launch_bounds__(NWAVES * 64, 2) hymba_fwd(Args args) {
    extern __shared__ __attribute__((aligned(16))) unsigned char lds[];
    Frame F;
    F.lds = (LAS unsigned char*)lds;
    F.MISC = (volatile LAS unsigned*)(F.lds + MISC_OFF);
    F.tid = threadIdx.x; F.lane = F.tid & 63; F.wave = __builtin_amdgcn_readfirstlane(F.tid >> 6);
    F.G = gridDim.x; { const int bx = blockIdx.x; F.vcu = (F.G % 8 == 0) ? (bx % 8) * (F.G / 8) + bx / 8 : bx; }
#pragma unroll
    for (int i = 0; i < 18; ++i) F.in[i] = args.in[i];
    F.out = args.out; F.ws = args.ws;
    for (int u = F.tid; u < (LDS_BYTES - LDSCTL_OFF) / 4; u += NWAVES * 64) ((LAS unsigned*)(F.lds + LDSCTL_OFF))[u] = 0u;
    __syncthreads();
    const int lo = args.ph_lo, hi = args.ph_hi;
    const bool multi = (hi - lo) > 1;
    XcdBarrier bar; bar.bar = (unsigned*)(F.ws + WS_CTL) + CW_BAR; bar.x = 0; bar.st = nullptr;
    if (multi) bar = xcd_barrier_post((unsigned*)(F.ws + WS_CTL) + CW_BAR, F.MISC + 8);
#define IN(k) (lo <= (k) && (k) < hi)
#define SEAM(k) do { if (IN(k) && IN((k) + 1)) xcd_barrier(bar); } while (0)

    if (IN(0)) { p0_prologue(F); } SEAM(0);
    if (IN(1)) {
        pg8::Gemm g{(const pg8::bf16_t*)(F.ws + WS_HN), (const pg8::bf16_t*)(F.ws + WS_WIN), NTOK, INW, DM}; pg8::StaticOrder S; S.init(NTOK, INW, F.G, (int)blockIdx.x);
        pg8::EpiProj E{(pg8::bf16_t*)(F.ws + WS_PROJ), INW, 2, QSCALE};
        pg8::gemm_phase<pg8::EpiProj, pg8::StaticOrder, PG8_ALIGN, PG8_SP2>(F.lds + RING_OFF, g, S, E);
    } SEAM(1);
    if (IN(2)) { hgrn_mfma(F); }
    if (IN(3)) { quant_drain(F); attn_mfma(F, 0); }
    if (IN(3) && IN(4)) xcd_barrier(bar);
    if (IN(4)) {
        pg8::Gemm g{(const pg8::bf16_t*)(F.ws + WS_HN), (const pg8::bf16_t*)(F.ws + WS_WOUT), NTOK, DM, DM}; pg8::StaticOrder S; S.init(NTOK, DM, F.G, (int)blockIdx.x);
        pg8::EpiMix E{DM, F.in[0], F.in[12], (pg8::bf16_t*)(F.ws + WS_HN2), F.ws + WS_X8, (float*)(F.ws + WS_CTL) + CW_SSQ};
        pg8::gemm_phase<pg8::EpiMix, pg8::StaticOrder, PG8_ALIGN, PG8_SP2>(F.lds + RING_OFF, g, S, E);
    }
    if (IN(4) && IN(6)) xcd_barrier(bar);
    if (IN(6)) {
        pg8::Gemm g{(const pg8::bf16_t*)(F.ws + WS_HN2), (const pg8::bf16_t*)(F.ws + WS_W2), NTOK, 2048, DM}; pg8::StaticOrder S; S.init(NTOK, 2048, F.G, (int)blockIdx.x);
        pg8::EpiScaleRow E{(_Float16*)(F.ws + WS_SC), 2048, (const float*)(F.ws + WS_CTL) + CW_SSQ, 1.f / DM, EPS};
        pg8::gemm_phase<pg8::EpiScaleRow, pg8::StaticOrder, PG8_ALIGN, PG8_SP2>(F.lds + RING_OFF, g, S, E);
    } SEAM(6);
    if (IN(7)) { topk_v2(F); }
    if (IN(7) && IN(8)) { VM_WAIT(); }
    if (IN(8)) { peer_sliced(F); }
#undef IN
#undef SEAM
}

extern "C" void kernel_launch(void* const* d_in, const int* in_sizes, int n_in, void* d_out, int out_size, void* d_ws, size_t ws_size, hipStream_t stream) {
    static int grid = 0;
    if (grid == 0) {
        if (n_in != 18 || in_sizes[0] != NTOK * DM || out_size != NTOK * DM || ws_size < WS_END) { fprintf(stderr, "kernel_launch: unexpected shapes (n_in %d, in0 %d, out %d, ws %zu); nothing launched\n", n_in, n_in > 0 ? in_sizes[0] : -1, out_size, ws_size); grid = -1; return; }
        int dev = 0, cus = 0, per_cu = 0;
        if (hipGetDevice(&dev) != hipSuccess || hipDeviceGetAttribute(&cus, hipDeviceAttributeMultiprocessorCount, dev) != hipSuccess) { grid = -1; return; }
        if (hipFuncSetAttribute((const void*)hymba_fwd, hipFuncAttributeMaxDynamicSharedMemorySize, LDS_BYTES) != hipSuccess) { fprintf(stderr, "kernel_launch: hipFuncSetAttribute failed\n"); grid = -1; return; }
        if (hipOccupancyMaxActiveBlocksPerMultiprocessor(&per_cu, (const void*)hymba_fwd, NWAVES * 64, LDS_BYTES) != hipSuccess || per_cu < 1)
            fprintf(stderr, "kernel_launch: note: occupancy query reports %d workgroups per CU\n", per_cu);
        (void)hipGetLastError();
        grid = cus;
    }
    if (grid < 0) return;
    if (hipMemsetAsync((char*)d_ws + WS_CTL, 0, CTL_ZERO_BYTES, stream) != hipSuccess) return;
    Args a{};
    for (int i = 0; i < 18; ++i) a.in[i] = (const float*)d_in[i];
    a.out = (float*)d_out; a.ws = (unsigned char*)d_ws; a.ph_lo = 0; a.ph_hi = 9;
    hipLaunchKernelGGL(hymba_fwd, dim3(grid), dim3(NWAVES * 64), LDS_BYTES, stream, a);
}
```

```cpp
#include <hip/hip_runtime.h>
#include <cstdio>
#include <cstdint>
#include <cmath>
namespace pg8 {
#define PG8_LAS __attribute__((address_space(3)))
typedef unsigned short bf16_t;
typedef short bf16x8 __attribute__((ext_vector_type(8)));
typedef float f32x4 __attribute__((ext_vector_type(4)));
typedef unsigned u32x4 __attribute__((ext_vector_type(4)));
constexpr int BM = 256, BK = 64, HALF = 128, HTB = HALF * BK * 2  , STAGE_BYTES = 8 * HTB, NXCD = 8, WGM = 8;

__host__ __device__ __forceinline__ int lds_byte(int r, int c) { const int st = (r >> 4) * 2 + (c >> 5), rr = r & 15, cc = c & 31, ob = rr * 64 + cc * 2; return st * 1024 + (ob ^ (((ob >> 9) & 1) << 5)); }
__host__ __device__ __forceinline__ void stage_rc(int b, int& R, int& C) { const int st = b / 1024, sb = b % 1024, swz = sb ^ (((sb >> 9) & 1) << 5); R = (st >> 1) * 16 + swz / 64; C = (st & 1) * 32 + (swz % 64) / 2; }
__host__ __device__ __forceinline__ int perm32(int rho) { const int n = rho >> 4, i = rho & 15; return 8 * (i >> 2) + 4 * n + (i & 3); }

struct Unit { int pm, pn; };
struct Gemm { const bf16_t* A; const bf16_t* Bt; int M, N, K; };

struct StaticOrder {
    int nM, nN, nwg, G, c;
    __host__ __device__ void init(int M, int N, int G_, int c_) { nM = M / BM; nN = N / BM; nwg = nM * nN; G = G_; c = c_; }
    __host__ __device__ bool next(int i, Unit& u) const {
        const long L = (long)i * G + c; if (L >= nwg) return false;
        int wgid = (int)L; { const int q = nwg / NXCD, r = nwg % NXCD, xcd = wgid % NXCD, off = wgid / NXCD; wgid = (xcd < r ? xcd * (q + 1) : r * (q + 1) + (xcd - r) * q) + off; }
        const int nig = WGM * nN, gid = wgid / nig, fm = gid * WGM, gsz = (nM - fm) < WGM ? (nM - fm) : WGM;
        u.pm = fm + ((wgid % nig) % gsz); u.pn = (wgid % nig) / gsz; return true;
    }
    __device__ __forceinline__ void a_ready(const Unit&) const {}
    __device__ __forceinline__ void done(const Unit&) const {}
};
__device__ __forceinline__ unsigned cvt_pk_bf16(float lo, float hi) { unsigned r; asm volatile("v_cvt_pk_bf16_f32 %0, %1, %2" : "=v"(r) : "v"(lo), "v"(hi)); return r; }
typedef float f32x2 __attribute__((ext_vector_type(2)));
__device__ __forceinline__ f32x2 gelu_pk(f32x2 v) {
    const f32x2 av = __builtin_elementwise_abs(v), d = av * 0.2316418882f + 1.0f;
    f32x2 t; t.x = __builtin_amdgcn_rcpf(d.x); t.y = __builtin_amdgcn_rcpf(d.y);
    f32x2 q = t * 0.5307027145f + (-0.7265760135f); q = q * t + 0.7107068705f; q = q * t + (-0.142248368f); q = q * t + 0.127414796f; q = q * t;
    const f32x2 s = (v * v) * (-0.72134752044f);
    f32x2 e; e.x = __builtin_amdgcn_exp2f(s.x); e.y = __builtin_amdgcn_exp2f(s.y);
    const f32x2 m = v * (q * e), r = v - m;
    f32x2 o; o.x = v.x < 0.f ? m.x : r.x; o.y = v.y < 0.f ? m.y : r.y; return o;
}
struct EpiProj {
    static constexpr bool PERM = true, AFTER_DRAIN = false;
    bf16_t* O; int ldc; int qtiles; float qscale;
    __device__ __forceinline__ void operator()(const f32x4 (&acc)[2][2][4][2], const Unit& u, int wr, int wc, int fr, int fq) const {
        const int row0 = u.pm * BM + wr * 64 + fr, col0 = u.pn * BM + wc * 32 + 8 * fq;
        const float sc = (u.pn < qtiles) ? qscale : 1.f;
#pragma unroll
        for (int ai = 0; ai < 2; ++ai)
#pragma unroll
            for (int m = 0; m < 4; ++m) { bf16_t* rowp = O + (size_t)(row0 + ai * HALF + m * 16) * ldc + col0;
#pragma unroll
                for (int bj = 0; bj < 2; ++bj) { const f32x4 v0 = acc[ai][bj][m][0] * sc, v1 = acc[ai][bj][m][1] * sc;
                    u32x4 w; w.x = cvt_pk_bf16(v0[0], v0[1]); w.y = cvt_pk_bf16(v0[2], v0[3]); w.z = cvt_pk_bf16(v1[0], v1[1]); w.w = cvt_pk_bf16(v1[2], v1[3]);
                    *(u32x4*)(rowp + bj * HALF) = w; } }
    }
};
struct EpiF32Res {
    static constexpr bool PERM = false, AFTER_DRAIN = false;
    float* C; int ldc; const float* res;
    __device__ __forceinline__ void operator()(const f32x4 (&acc)[2][2][4][2], const Unit& u, int wr, int wc, int fr, int fq) const {
        const int row0 = u.pm * BM + wr * 64 + fr, col0 = u.pn * BM + wc * 32 + 4 * fq;
#pragma unroll
        for (int ai = 0; ai < 2; ++ai)
#pragma unroll
            for (int m = 0; m < 4; ++m) { const size_t off = (size_t)(row0 + ai * HALF + m * 16) * ldc + col0;
#pragma unroll
                for (int bj = 0; bj < 2; ++bj)
#pragma unroll
                    for (int n = 0; n < 2; ++n) { f32x4 o = acc[ai][bj][m][n]; if (res) o = o + *(const f32x4*)(res + off + bj * HALF + n * 16);
                        *(f32x4*)(C + off + bj * HALF + n * 16) = o; } }
    }
};

struct EpiMix {
    static constexpr bool PERM = true, AFTER_DRAIN = false;
    int ldc; const float* res; const float* g2; bf16_t* HB; unsigned char* XB; float* ssq;
    __device__ __forceinline__ void operator()(const f32x4 (&acc)[2][2][4][2], const Unit& u, int wr, int wc, int fr, int fq) const {
        const int row0 = u.pm * BM + wr * 64 + fr, col0 = u.pn * BM + wc * 32 + 8 * fq;
        f32x4 gv[2][2];
#pragma unroll
        for (int bj = 0; bj < 2; ++bj)
#pragma unroll
            for (int n = 0; n < 2; ++n) gv[bj][n] = *(const f32x4*)(g2 + col0 + bj * HALF + 4 * n);
#pragma unroll
        for (int ai = 0; ai < 2; ++ai)
#pragma unroll
            for (int m = 0; m < 4; ++m) { const int row = row0 + ai * HALF + m * 16; const size_t off = (size_t)row * ldc + col0; float sq = 0.f;
#pragma unroll
                for (int bj = 0; bj < 2; ++bj) {
                    const f32x4 h0 = acc[ai][bj][m][0] + *(const f32x4*)(res + off + bj * HALF), h1 = acc[ai][bj][m][1] + *(const f32x4*)(res + off + bj * HALF + 4);
                    sq += (h0[0] * h0[0] + h0[1] * h0[1]) + (h0[2] * h0[2] + h0[3] * h0[3]) + (h1[0] * h1[0] + h1[1] * h1[1]) + (h1[2] * h1[2] + h1[3] * h1[3]);
                    u32x4 w; w.x = cvt_pk_bf16(h0[0], h0[1]); w.y = cvt_pk_bf16(h0[2], h0[3]); w.z = cvt_pk_bf16(h1[0], h1[1]); w.w = cvt_pk_bf16(h1[2], h1[3]);
                    *(u32x4*)(HB + off + bj * HALF) = w;
                    const f32x4 g0 = h0 * gv[bj][0], g1 = h1 * gv[bj][1];
                    int p0 = __builtin_amdgcn_cvt_pk_bf8_f32(g0[0], g0[1], 0, false); p0 = __builtin_amdgcn_cvt_pk_bf8_f32(g0[2], g0[3], p0, true);
                    int p1 = __builtin_amdgcn_cvt_pk_bf8_f32(g1[0], g1[1], 0, false); p1 = __builtin_amdgcn_cvt_pk_bf8_f32(g1[2], g1[3], p1, true);
                    typedef unsigned u32x2 __attribute__((ext_vector_type(2)));
                    *(u32x2*)(XB + off + bj * HALF) = (u32x2){(unsigned)p0, (unsigned)p1}; }
                sq += __shfl_xor(sq, 16); sq += __shfl_xor(sq, 32);
                if (fq == 0) atomicAdd(ssq + row, sq); }
    }
};
struct EpiScaleRow {
    static constexpr bool PERM = true, AFTER_DRAIN = false;
    _Float16* C; int ldc; const float* ssq; float invk, eps;
    __device__ __forceinline__ void operator()(const f32x4 (&acc)[2][2][4][2], const Unit& u, int wr, int wc, int fr, int fq) const {
        typedef _Float16 h2 __attribute__((ext_vector_type(2)));
        const int row0 = u.pm * BM + wr * 64 + fr, col0 = u.pn * BM + wc * 32 + 8 * fq;
#pragma unroll
        for (int ai = 0; ai < 2; ++ai)
#pragma unroll
            for (int m = 0; m < 4; ++m) { const int row = row0 + ai * HALF + m * 16; const size_t off = (size_t)row * ldc + col0; const float rs = 1.f / sqrtf(ssq[row] * invk + eps);
#pragma unroll
                for (int bj = 0; bj < 2; ++bj) { const f32x4 v0 = acc[ai][bj][m][0] * rs, v1 = acc[ai][bj][m][1] * rs;
                    const h2 p0 = {(_Float16)v0[0], (_Float16)v0[1]}, p1 = {(_Float16)v0[2], (_Float16)v0[3]}, p2 = {(_Float16)v1[0], (_Float16)v1[1]}, p3 = {(_Float16)v1[2], (_Float16)v1[3]};
                    u32x4 w; w.x = __builtin_bit_cast(unsigned, p0); w.y = __builtin_bit_cast(unsigned, p1); w.z = __builtin_bit_cast(unsigned, p2); w.w = __builtin_bit_cast(unsigned, p3);
                    *(u32x4*)(C + off + bj * HALF) = w; } }
    }
};
template <class Epi, class Sched, bool ALIGN_EPI = false, bool SP2 = false>
__device__ __forceinline__ void gemm_phase(PG8_LAS unsigned char* lds, const Gemm g, const Sched& S, const Epi& E) {
    const int tid = threadIdx.x, wid = __builtin_amdgcn_readfirstlane(tid >> 6), lane = tid & 63, wr = wid >> 2, wc = wid & 3, fr = lane & 15, fq = lane >> 4;
    const int K = g.K, nt = K / BK;
    unsigned voffA[2], voffB[2];
#pragma unroll
    for (int i = 0; i < 2; ++i) { int R, C; stage_rc(tid * 16 + i * 8192, R, C); const int Rb = Epi::PERM ? ((R & ~31) + perm32(R & 31)) : R;
        voffA[i] = (unsigned)(R * K + C) * 2u; voffB[i] = (unsigned)(Rb * K + C) * 2u; }
    const size_t kstep = (size_t)(BK * 2);
    const size_t hstep = (size_t)HALF * K * 2;
    const size_t tstep = 2 * hstep;
    const unsigned ldsw = (unsigned)wid * 1024u;
    const int aoff = lds_byte(wr * 64 + fr, fq * 8), boff = lds_byte(wc * 32 + fr, fq * 8);
#define PG8_SA(b, h) (((b) * 2 + (h)) * HTB)
#define PG8_SB(b, h) ((4 + (b) * 2 + (h)) * HTB)
#define PG8_STAGE(bufoff, gbase, voff) do { _Pragma("unroll") for (int _i = 0; _i < 2; ++_i) \
        __builtin_amdgcn_global_load_lds((const unsigned*)((const char*)(gbase) + (voff)[_i]), (PG8_LAS unsigned*)(lds + (bufoff) + ldsw + _i * 8192), 16, 0, 0); } while (0)
#define PG8_LDA(dst, b, h) do { _Pragma("unroll") for (int m = 0; m < 4; ++m) _Pragma("unroll") for (int k = 0; k < 2; ++k) dst[m][k] = *(const PG8_LAS bf16x8*)(lds + PG8_SA(b, h) + aoff + m * 2048 + k * 1024); } while (0)
#define PG8_LDB(dst, b, h) do { _Pragma("unroll") for (int n = 0; n < 2; ++n) _Pragma("unroll") for (int k = 0; k < 2; ++k) dst[n][k] = *(const PG8_LAS bf16x8*)(lds + PG8_SB(b, h) + boff + n * 2048 + k * 1024); } while (0)
#define PG8_MMA(ai, bj, At, Bt) do { __builtin_amdgcn_s_setprio(1); _Pragma("unroll") for (int m = 0; m < 4; ++m) _Pragma("unroll") for (int n = 0; n < 2; ++n) _Pragma("unroll") for (int k = 0; k < 2; ++k) \
        acc[ai][bj][m][n] = __builtin_amdgcn_mfma_f32_16x16x32_bf16(Bt[n][k], At[m][k], acc[ai][bj][m][n], 0, 0, 0); __builtin_amdgcn_s_setprio(0); } while (0)
#define PG8_WAIT_V(n) asm volatile("s_waitcnt vmcnt(" #n ")" ::: "memory")
#define PG8_WAIT_L(n) asm volatile("s_waitcnt lgkmcnt(" #n ")" ::: "memory")
#define PG8_BAR __builtin_amdgcn_s_barrier()
#define PG8_SCHED __builtin_amdgcn_sched_barrier(0)
    Unit cur, nxt; int ui = 0;
    if (!S.next(0, cur)) return;
    f32x4 acc[2][2][4][2];
#pragma unroll
    for (int a = 0; a < 2; ++a)
#pragma unroll
        for (int b = 0; b < 2; ++b)
#pragma unroll
            for (int m = 0; m < 4; ++m)
#pragma unroll
                for (int n = 0; n < 2; ++n) acc[a][b][m][n] = (f32x4){0.f, 0.f, 0.f, 0.f};
    bf16x8 At[4][2], B0[2][2], B1[2][2];
    const char* cA = (const char*)g.A + (size_t)cur.pm * tstep; const char* cB = (const char*)g.Bt + (size_t)cur.pn * tstep;
    S.a_ready(cur);
    if constexpr (SP2) {
        PG8_STAGE(PG8_SB(0, 0), cB, voffB); PG8_STAGE(PG8_SB(0, 1), cB + hstep, voffB); PG8_STAGE(PG8_SA(0, 0), cA, voffA); PG8_STAGE(PG8_SA(0, 1), cA + hstep, voffA);
        if (wr == 1) PG8_BAR;
        PG8_WAIT_V(2); PG8_BAR;
        PG8_STAGE(PG8_SB(1, 0), cB + kstep, voffB); PG8_STAGE(PG8_SA(1, 0), cA + kstep, voffA); PG8_STAGE(PG8_SB(1, 1), cB + hstep + kstep, voffB);
        PG8_WAIT_V(6); PG8_BAR;
    } else {
        PG8_STAGE(PG8_SB(0, 0), cB, voffB); PG8_STAGE(PG8_SA(0, 0), cA, voffA); PG8_STAGE(PG8_SB(0, 1), cB + hstep, voffB); PG8_STAGE(PG8_SA(0, 1), cA + hstep, voffA);
        if (wr == 1) PG8_BAR;
        PG8_WAIT_V(4); PG8_BAR;
        PG8_STAGE(PG8_SB(1, 0), cB + kstep, voffB); PG8_STAGE(PG8_SA(1, 0), cA + kstep, voffA); PG8_STAGE(PG8_SB(1, 1), cB + hstep + kstep, voffB);
        PG8_WAIT_V(6); PG8_BAR;
    }
    for (;;) {
        const bool has_next = S.next(ui + 1, nxt);
        const char* nA = has_next ? (const char*)g.A + (size_t)nxt.pm * tstep : cA; const char* nB = has_next ? (const char*)g.Bt + (size_t)nxt.pn * tstep : cB;
        for (int t = 0; t < nt; t += 2) {
            const bool last = (t == nt - 2);
            const char* a1 = cA + (size_t)(t + 1) * kstep;
            const char* a2 = last ? nA : cA + (size_t)(t + 2) * kstep; const char* b2 = last ? nB : cB + (size_t)(t + 2) * kstep;
            const char* a3 = a2 + kstep; const char* b3 = b2 + kstep;
            if (last && has_next) S.a_ready(nxt);
            if constexpr (SP2) {
            PG8_LDB(B0, 0, 0); PG8_LDB(B1, 0, 1); PG8_SCHED; PG8_LDA(At, 0, 0); PG8_STAGE(PG8_SA(1, 1), a1 + hstep, voffA);
            PG8_WAIT_V(8); PG8_WAIT_L(0); PG8_BAR; PG8_MMA(0, 0, At, B0); PG8_MMA(0, 1, At, B1); PG8_BAR; PG8_SCHED;
            PG8_LDA(At, 0, 1); PG8_STAGE(PG8_SB(0, 0), b2, voffB); PG8_STAGE(PG8_SB(0, 1), b2 + hstep, voffB); PG8_STAGE(PG8_SA(0, 0), a2, voffA);
            PG8_WAIT_V(8); PG8_WAIT_L(0); PG8_BAR; PG8_MMA(1, 0, At, B0); PG8_MMA(1, 1, At, B1); PG8_BAR; PG8_SCHED;
            PG8_LDB(B0, 1, 0); PG8_LDB(B1, 1, 1); PG8_SCHED; PG8_LDA(At, 1, 0); PG8_STAGE(PG8_SA(0, 1), a2 + hstep, voffA);
            PG8_WAIT_V(8); PG8_WAIT_L(0); PG8_BAR; PG8_MMA(0, 0, At, B0); PG8_MMA(0, 1, At, B1); PG8_BAR; PG8_SCHED;
            PG8_LDA(At, 1, 1); PG8_STAGE(PG8_SB(1, 0), b3, voffB); PG8_STAGE(PG8_SB(1, 1), b3 + hstep, voffB); PG8_STAGE(PG8_SA(1, 0), a3, voffA);
            PG8_WAIT_V(8); PG8_WAIT_L(0); PG8_BAR; PG8_MMA(1, 0, At, B0); PG8_MMA(1, 1, At, B1); PG8_BAR; PG8_SCHED;
            } else {
            PG8_LDB(B0, 0, 0); PG8_SCHED; PG8_LDA(At, 0, 0); PG8_STAGE(PG8_SA(1, 1), a1 + hstep, voffA);
            PG8_WAIT_L(8); PG8_BAR; PG8_WAIT_L(0); PG8_MMA(0, 0, At, B0); PG8_BAR; PG8_SCHED;
            PG8_LDB(B1, 0, 1); PG8_STAGE(PG8_SB(0, 0), b2, voffB);
            PG8_BAR; PG8_WAIT_L(0); PG8_MMA(0, 1, At, B1); PG8_BAR;
            PG8_LDA(At, 0, 1); PG8_STAGE(PG8_SA(0, 0), a2, voffA);
            PG8_BAR; PG8_WAIT_L(0); PG8_MMA(1, 0, At, B0); PG8_BAR; PG8_SCHED;
            PG8_STAGE(PG8_SB(0, 1), b2 + hstep, voffB);
            PG8_WAIT_V(6); PG8_BAR; PG8_MMA(1, 1, At, B1); PG8_BAR;
            PG8_LDB(B0, 1, 0); PG8_SCHED; PG8_LDA(At, 1, 0); PG8_STAGE(PG8_SA(0, 1), a2 + hstep, voffA);
            PG8_WAIT_L(8); PG8_BAR; PG8_WAIT_L(0); PG8_MMA(0, 0, At, B0); PG8_BAR; PG8_SCHED;
            PG8_LDB(B1, 1, 1); PG8_STAGE(PG8_SB(1, 0), b3, voffB);
            PG8_BAR; PG8_WAIT_L(0); PG8_MMA(0, 1, At, B1); PG8_BAR;
            PG8_LDA(At, 1, 1); PG8_STAGE(PG8_SA(1, 0), a3, voffA);
            PG8_BAR; PG8_WAIT_L(0); PG8_MMA(1, 0, At, B0); PG8_BAR; PG8_SCHED;
            PG8_STAGE(PG8_SB(1, 1), b3 + hstep, voffB);
            PG8_WAIT_V(6); PG8_BAR; PG8_MMA(1, 1, At, B1); PG8_BAR;
            }
        }
        if constexpr (ALIGN_EPI) { if (wr == 0) PG8_BAR; }
        if constexpr (!Epi::AFTER_DRAIN) { E(acc, cur, wr, wc, fr, fq); S.done(cur); }
        if (!has_next) break;
#pragma unroll
        for (int a = 0; a < 2; ++a)
#pragma unroll
            for (int b = 0; b < 2; ++b)
#pragma unroll
                for (int m = 0; m < 4; ++m)
#pragma unroll
                    for (int n = 0; n < 2; ++n) acc[a][b][m][n] = (f32x4){0.f, 0.f, 0.f, 0.f};
        cur = nxt; cA = nA; cB = nB; ++ui;
        if constexpr (ALIGN_EPI) { if (wr == 1) PG8_BAR; }
    }
    PG8_WAIT_V(0);
    if constexpr (!ALIGN_EPI) { if (wr == 0) PG8_BAR; }
    PG8_BAR;
    if constexpr (Epi::AFTER_DRAIN) { E.fused(acc, cur, wr, wc, fr, fq, lds, wid, lane); S.done(cur); }
#undef PG8_SA
#undef PG8_SB
#undef PG8_STAGE
#undef PG8_LDA
#undef PG8_LDB
#undef PG8_MMA
#undef PG8_WAIT_V
#undef PG8_WAIT_L
#undef PG8_BAR
#undef PG8_SCHED
}
}
#ifndef PG8_SP2
#define PG8_SP2 true
#endif
#ifndef PG8_ALIGN
#define PG8_ALIGN true
#endif

constexpr int NWAVES = 8;
constexpr int NTOK = 32768, DM = 1024, SEQ = 2048, NBATCH = 16, INW = 3584;
constexpr int C_DQ = 0, C_DK = 512, C_DV = 1024, C_HQ = 1536, C_HF = 2048, C_HI = 2560, C_HG = 3072;
constexpr float EPS = 1e-6f;
constexpr float QSCALE = 0.125f * 1.4426950408889634f;
constexpr float LAM_INIT = 0.2f;
constexpr int NEXP_SEL = 128;

constexpr size_t MiB = 1u << 20;
constexpr size_t WS_CTL = 0, CTL_ZERO_BYTES = 1 * MiB;
constexpr size_t WS_SMALL = 1 * MiB;
constexpr size_t WS_WIN = 2 * MiB;
constexpr size_t WS_WOUT = 10 * MiB;
constexpr size_t WS_W2 = 12 * MiB;
constexpr size_t WS_U8 = 17 * MiB;
constexpr size_t WS_V8 = 33 * MiB;
constexpr size_t WS_SU = 49 * MiB;
constexpr size_t WS_SV = 49 * MiB + 512 * 1024;
constexpr size_t WS_X8 = 50 * MiB;
constexpr size_t WS_SX = 116 * MiB;
constexpr size_t WS_GSU = 120 * MiB;
constexpr size_t WS_HN = 84 * MiB;
constexpr size_t WS_PROJ = 148 * MiB;
constexpr size_t WS_HN2 = 148 * MiB;
constexpr size_t WS_SC = 212 * MiB;
constexpr size_t WS_PO = 352 * MiB;
constexpr size_t WS_IDX = 468 * MiB;
constexpr size_t WS_GATE = 484 * MiB;
constexpr size_t WS_END = 500 * MiB;
constexpr int SM_LB = 0, SM_LAM = 512, SM_BIAS = 1024;
constexpr int CW_BAR = 4096;
constexpr int CW_ATTQ = 8192;
constexpr int CW_SSQ = 131072;

constexpr int RING_OFF = 0, RING_BYTES = 139264;
constexpr int LDSCTL_OFF = RING_BYTES, MISC_OFF = LDSCTL_OFF + 320;
constexpr int LDS_BYTES = 147456;

#define GAS __attribute__((address_space(1)))
#define LAS __attribute__((address_space(3)))
typedef unsigned short bf16;
typedef unsigned v4u __attribute__((ext_vector_type(4)));
typedef unsigned v2u __attribute__((ext_vector_type(2)));
typedef float f32x4 __attribute__((ext_vector_type(4)));
typedef short bf16x8 __attribute__((ext_vector_type(8)));
typedef GAS unsigned gu32;
typedef long l2 __attribute__((ext_vector_type(2)));
typedef int v4i __attribute__((ext_vector_type(4)));
#define RLX_AGENT __ATOMIC_RELAXED, __HIP_MEMORY_SCOPE_AGENT
#define LDS_WAIT() asm volatile("s_waitcnt lgkmcnt(0)" ::: "memory")
#define VM_WAIT() asm volatile("s_waitcnt vmcnt(0)" ::: "memory")
__device__ __forceinline__ unsigned f2bf(float f) { unsigned u = __builtin_bit_cast(unsigned, f); return (u + 0x7fffu + ((u >> 16) & 1u)) >> 16; }
__device__ __forceinline__ unsigned pk2(float lo, float hi) { return f2bf(lo) | (f2bf(hi) << 16); }
__device__ __forceinline__ float bflo(unsigned w) { return __builtin_bit_cast(float, w << 16); }
__device__ __forceinline__ float bfhi(unsigned w) { return __builtin_bit_cast(float, w & 0xffff0000u); }

#define XB_TMO      128
#define XB_XCNT(j)  (256  + 64 * (j))
#define XB_XSUB(j)  (1280 + 64 * (j))
#define XB_XGEN(j)  (2304 + 64 * (j))
#define XB_TOP      3328
#define XB_TOPGEN   3392
#define XCD_BAR_WORDS 3456
#define XB_SPIN_CAP (1u << 18)
__device__ __forceinline__ unsigned xb_ld(unsigned* p)              { return __hip_atomic_load(p, __ATOMIC_RELAXED, __HIP_MEMORY_SCOPE_AGENT); }
__device__ __forceinline__ unsigned xb_add(unsigned* p, unsigned v) { return __hip_atomic_fetch_add(p, v, __ATOMIC_RELAXED, __HIP_MEMORY_SCOPE_AGENT); }
__device__ __forceinline__ unsigned xb_xcc_id() { return (unsigned)__builtin_amdgcn_s_getreg((3 << 11) | 20) & 0xFu; }
#define XB_SPIN(cond, bar) do { unsigned _sp = 0; while (cond) { __builtin_amdgcn_s_sleep(1); \
    if ((++_sp & 255u) == 0u) { if (xb_ld(&(bar)[XB_TMO])) break; if (_sp > XB_SPIN_CAP) { atomicAdd(&(bar)[XB_TMO], 1u); break; } } } } while (0)
struct XcdBarrier { unsigned* bar; unsigned x; volatile LAS unsigned* st; };
__device__ __forceinline__ XcdBarrier xcd_barrier_post(unsigned* bar, volatile LAS unsigned* st) {
    XcdBarrier b; b.bar = bar; b.x = xb_xcc_id(); b.st = st;
    if (threadIdx.x == 0) (void)xb_add(&bar[XB_XCNT(b.x)], 1u);
    return b;
}
__device__ __forceinline__ void xcd_barrier_complete(unsigned* bar, unsigned x, unsigned& nloc, unsigned& nx) {
    const unsigned G = gridDim.x * gridDim.y * gridDim.z;
    unsigned sum, cnt, mine, sp = 0u;
    for (;;) {
        sum = 0u; cnt = 0u; mine = 0u;
#pragma unroll
        for (unsigned j = 0; j < 16; ++j) { const unsigned c = xb_ld(&bar[XB_XCNT(j)]); sum += c; cnt += (c > 0u) ? 1u : 0u; mine = (j == x) ? c : mine; }
        if (sum == G) break;
        __builtin_amdgcn_s_sleep(1);
        if ((++sp & 255u) == 0u) { if (xb_ld(&bar[XB_TMO])) break; if (sp > XB_SPIN_CAP) { atomicAdd(&bar[XB_TMO], 1u); break; } }
    }
    nloc = mine > 0u ? mine : 1u; nx = cnt > 0u ? cnt : 1u;
}
__device__ __forceinline__ void xcd_barrier(const XcdBarrier& b) {
    asm volatile("s_waitcnt vmcnt(0)" ::: "memory");
    __syncthreads();
    if (threadIdx.x == 0) {
        unsigned* bar = b.bar;
        __builtin_amdgcn_s_waitcnt(0);
        unsigned nloc = b.st[0], nx = b.st[1];
        if (nloc == 0u) { xcd_barrier_complete(bar, b.x, nloc, nx); b.st[0] = nloc; b.st[1] = nx; }
        const unsigned old = xb_add(&bar[XB_XSUB(b.x)], 1u);
        const unsigned gen = old / nloc;
        if (old + 1u == (gen + 1u) * nloc) {
            __builtin_amdgcn_fence(__ATOMIC_RELEASE, "agent");
            asm volatile("s_waitcnt vmcnt(0)" ::: "memory");
            const unsigned og = xb_add(&bar[XB_TOP], 1u);
            const unsigned tg = og / nx;
            if (og + 1u == (tg + 1u) * nx) xb_add(&bar[XB_TOPGEN], 1u);
            else XB_SPIN(xb_ld(&bar[XB_TOPGEN]) == tg, bar);
            __builtin_amdgcn_fence(__ATOMIC_ACQUIRE, "agent");
            xb_add(&bar[XB_XGEN(b.x)], 1u);
            asm volatile("s_waitcnt vmcnt(0)" ::: "memory");
        } else {
            XB_SPIN(xb_ld(&bar[XB_XGEN(b.x)]) == gen, bar);
            __builtin_amdgcn_fence(__ATOMIC_ACQUIRE, "agent");
            asm volatile("s_waitcnt vmcnt(0)" ::: "memory");
        }
    }
    __syncthreads();
}

#define SCHED_FENCE() __builtin_amdgcn_sched_barrier(0)
__device__ __forceinline__ float gelu_as(float v) {
    const float av = fabsf(v), t = __builtin_amdgcn_rcpf(av * 0.2316418882f + 1.0f);
    float q = t * 0.5307027145f + (-0.7265760135f); q = q * t + 0.7107068705f; q = q * t + (-0.142248368f); q = q * t + 0.127414796f; q = q * t;
    const float e = __builtin_amdgcn_exp2f((v * v) * (-0.72134752044f));
    const float mm = v * (q * e);
    return v < 0.f ? mm : v - mm;
}
struct Frame {
    LAS unsigned char* lds;
    volatile LAS unsigned* MISC;
    int tid, lane, wave, vcu, G;
    const float* in[18]; float* out; unsigned char* ws;
};
__device__ __forceinline__ float wave_sum(float v) {
#pragma unroll
    for (int o = 1; o < 64; o <<= 1) v += __shfl_xor(v, o);
    return v;
}
__device__ __forceinline__ float sigmoidf_(float x) { return 1.f / (1.f + __expf(-x)); }

__device__ __forceinline__ void p0_transpose_item(const float* W, int K, int N, bf16* WT, int row_off, LAS float* scr, int item, int lane) {
    const int nblk = N / 32, kb = item / nblk, nb = item % nblk, k0 = 64 * kb, n0 = 32 * nb;
#pragma unroll 8
    for (int i = 0; i < 32; ++i) { const int kk = 2 * i + (lane >> 5); scr[kk * 33 + (lane & 31)] = W[(size_t)(k0 + kk) * N + n0 + (lane & 31)]; }
    LDS_WAIT(); asm volatile("" ::: "memory");
    const int c = lane & 7;
#pragma unroll
    for (int j = 0; j < 4; ++j) { const int n = (lane >> 3) + 8 * j; const LAS float* s = scr + (8 * c) * 33 + n;
        v4u o; o.x = pk2(s[0 * 33], s[1 * 33]); o.y = pk2(s[2 * 33], s[3 * 33]); o.z = pk2(s[4 * 33], s[5 * 33]); o.w = pk2(s[6 * 33], s[7 * 33]);
        *(GAS v4u*)(WT + (size_t)(row_off + n0 + n) * K + k0 + 8 * c) = o; }
    LDS_WAIT(); asm volatile("" ::: "memory");
}

__device__ __forceinline__ void quant_vals_fp8(const f32x4 (&v)[4], unsigned char* dst, float* dq, int lane, size_t slice_stride) {
    float mx = 0.f;
#pragma unroll
    for (int j = 0; j < 4; ++j) mx = fmaxf(mx, fmaxf(fmaxf(fabsf(v[j].x), fabsf(v[j].y)), fmaxf(fabsf(v[j].z), fabsf(v[j].w))));
#pragma unroll
    for (int o = 1; o < 64; o <<= 1) mx = fmaxf(mx, __shfl_xor(mx, o));
    const float qs = mx > 0.f ? 224.f / mx : 1.f;
#pragma unroll
    for (int j = 0; j < 4; ++j) { int p = __builtin_amdgcn_cvt_pk_fp8_f32(v[j].x * qs, v[j].y * qs, 0, false); p = __builtin_amdgcn_cvt_pk_fp8_f32(v[j].z * qs, v[j].w * qs, p, true);
        const int d = 4 * lane + 256 * j; *(GAS unsigned*)(dst + (slice_stride ? (size_t)(d >> 7) * slice_stride + (d & 127) : (size_t)d)) = (unsigned)p; }
    if (lane == 0) *dq = mx > 0.f ? mx * (1.f / 224.f) : 1.f;
}
__device__ __forceinline__ unsigned fp4_code(float v) { const float a = fabsf(v);
    const unsigned c = (a > 2.5f) + (a > 3.5f) + (a > 5.f) + (a > 7.f) + (a > 10.f) + (a > 14.f) + (a > 20.f);
    return c | (v < 0.f ? 8u : 0u); }
__device__ __forceinline__ void quant_row_fp4(const float* src, unsigned char* dst, float* dq, int lane, size_t slice_stride) {
    const GAS f32x4* xr = (const GAS f32x4*)src + lane; f32x4 v[4];
#pragma unroll
    for (int j = 0; j < 4; ++j) v[j] = xr[64 * j];
    float mx = 0.f;
#pragma unroll
    for (int j = 0; j < 4; ++j) mx = fmaxf(mx, fmaxf(fmaxf(fabsf(v[j].x), fabsf(v[j].y)), fmaxf(fabsf(v[j].z), fabsf(v[j].w))));
#pragma unroll
    for (int o = 1; o < 64; o <<= 1) mx = fmaxf(mx, __shfl_xor(mx, o));
    const float qs = mx > 0.f ? 24.f / mx : 1.f;
#pragma unroll
    for (int j = 0; j < 4; ++j) {
        const unsigned c4 = fp4_code(v[j].x * qs) | (fp4_code(v[j].y * qs) << 8) | (fp4_code(v[j].z * qs) << 16) | (fp4_code(v[j].w * qs) << 24);
        const unsigned pn = (unsigned)__builtin_amdgcn_update_dpp(0, (int)c4, 0xB1, 0xf, 0xf, true);
        const unsigned pa = ((c4 & 0x08080808u) << 4) | ((c4 & 0x07070707u) << 1), pb = ((pn & 0x07070707u) << 4) | ((pn & 0x08080808u) >> 3);
        if (!(lane & 1)) *(GAS unsigned*)(dst + (size_t)j * slice_stride + 4 * (lane >> 1)) = pa | pb; }
    if (lane == 0) *dq = mx > 0.f ? mx * (1.f / 24.f) : 1.f;
}
__device__ __forceinline__ void quant_row_fp8(const float* src, unsigned char* dst, float* dq, int lane, size_t slice_stride) {
    const GAS f32x4* xr = (const GAS f32x4*)src + lane; f32x4 v[4];
#pragma unroll
    for (int j = 0; j < 4; ++j) v[j] = xr[64 * j];
    quant_vals_fp8(v, dst, dq, lane, slice_stride);
}
__device__ __forceinline__ void p0_prologue(Frame& F) {
    LAS float* scr = (LAS float*)(F.lds + RING_OFF + F.wave * 16384);
    const int gw = F.vcu * NWAVES + F.wave, NGW = F.G * NWAVES;
    bf16* WinT = (bf16*)(F.ws + WS_WIN); bf16* WoutT = (bf16*)(F.ws + WS_WOUT); bf16* W2T = (bf16*)(F.ws + WS_W2);
    float* small = (float*)(F.ws + WS_SMALL);
    if (blockIdx.x == 0) {
        const int t = F.tid;
        { const float l0 = F.in[9][t], l1 = F.in[9][512 + t]; small[SM_LB + t] = 1.f / (1.f + expf(l1 - l0)); }
        { const int h = t >> 7, n = t & 127; int bk;
          if (n < 16) bk = n; else { bk = 16 + (int)(logf((float)n * (1.f / 16.f)) / logf(8.f) * 16.f); bk = bk > 31 ? 31 : bk; }
          small[SM_BIAS + t] = F.in[8][bk * 4 + h] * 1.4426950408889634f; }
        if (F.wave == 0) {
            const float a = wave_sum(F.in[3][F.lane] * F.in[4][F.lane]), b = wave_sum(F.in[5][F.lane] * F.in[6][F.lane]);
            if (F.lane == 0) small[SM_LAM] = expf(a) - expf(b) + LAM_INIT;
        }
    }
    constexpr int I_IN = (DM / 64) * (INW / 32), I_OUT = (DM / 64) * (DM / 32);
    for (int it = gw; it < I_IN + I_OUT; it += NGW) {
        if (it < I_IN) p0_transpose_item(F.in[2], DM, INW, WinT, 0, scr, it, F.lane);
        else p0_transpose_item(F.in[11], DM, DM, WoutT, 0, scr, it - I_IN, F.lane);
    }
    for (int u = F.vcu; u < 256; u += F.G) {
        const int hc = u >> 4, kb = u & 15, k = kb * 64 + F.lane;
        const GAS f32x4* wrow = (const GAS f32x4*)(F.in[13] + (size_t)k * 2048 + hc * 128);
        float a[16];
#pragma unroll
        for (int nn = 0; nn < 16; ++nn) a[nn] = 0.f;
        const float* kr = F.in[14] + ((size_t)hc * 128 + F.wave * 16) * 128;
        for (int i = 0; i < 32; ++i) {
            const f32x4 w = wrow[i];
#pragma unroll
            for (int nn = 0; nn < 16; ++nn) { const float* kk = kr + nn * 128 + 4 * i; a[nn] += (kk[0] * w.x + kk[1] * w.y) + (kk[2] * w.z + kk[3] * w.w); }
        }
        const float g2k = F.in[12][k];
#pragma unroll
        for (int nn = 0; nn < 16; ++nn) W2T[((size_t)hc * 128 + F.wave * 16 + nn) * DM + k] = (bf16)f2bf(a[nn] * g2k);
    }
    bf16* HN = (bf16*)(F.ws + WS_HN);
    for (int m = gw; m < NTOK; m += 2 * NGW) {
        const int m2 = m + NGW;
        const GAS f32x4* xa = (const GAS f32x4*)(F.in[0] + (size_t)m * DM) + F.lane; const GAS f32x4* xb = (const GAS f32x4*)(F.in[0] + (size_t)(m2 < NTOK ? m2 : m) * DM) + F.lane;
        const GAS f32x4* gr = (const GAS f32x4*)F.in[1] + F.lane;
        f32x4 va[4], vb[4]; float sa = 0.f, sb = 0.f;
#pragma unroll
        for (int j = 0; j < 4; ++j) { va[j] = xa[64 * j]; vb[j] = xb[64 * j]; }
#pragma unroll
        for (int j = 0; j < 4; ++j) { sa += (va[j].x * va[j].x + va[j].y * va[j].y) + (va[j].z * va[j].z + va[j].w * va[j].w); sb += (vb[j].x * vb[j].x + vb[j].y * vb[j].y) + (vb[j].z * vb[j].z + vb[j].w * vb[j].w); }
#pragma unroll
        for (int o = 1; o < 64; o <<= 1) { sa += __shfl_xor(sa, o); sb += __shfl_xor(sb, o); }
        const float ra = 1.f / sqrtf(sa * (1.f / DM) + EPS), rb = 1.f / sqrtf(sb * (1.f / DM) + EPS);
        GAS unsigned long long* oa = (GAS unsigned long long*)(HN + (size_t)m * DM) + F.lane; GAS unsigned long long* ob = (GAS unsigned long long*)(HN + (size_t)m2 * DM) + F.lane;
#pragma unroll
        for (int j = 0; j < 4; ++j) { const f32x4 gg = gr[64 * j];
            oa[64 * j] = (unsigned long long)pk2(va[j].x * ra * gg.x, va[j].y * ra * gg.y) | ((unsigned long long)pk2(va[j].z * ra * gg.z, va[j].w * ra * gg.w) << 32);
            if (m2 < NTOK) ob[64 * j] = (unsigned long long)pk2(vb[j].x * rb * gg.x, vb[j].y * rb * gg.y) | ((unsigned long long)pk2(vb[j].z * rb * gg.z, vb[j].w * rb * gg.w) << 32); }
    }
}


constexpr int QCHUNKS = 2 * 16384 / 64;
__device__ __forceinline__ void quant_chunk(Frame& F, int c) {
    unsigned char* U8 = F.ws + WS_U8; unsigned char* V8 = F.ws + WS_V8; float* SU = (float*)(F.ws + WS_SU); float* SV = (float*)(F.ws + WS_SV);
#pragma unroll 1
    for (int k = 0; k < 8; ++k) { const int rr = 64 * c + 8 * F.wave + k;
        if (rr < 16384) quant_row_fp4(F.in[15] + (size_t)rr * DM, U8 + (size_t)rr * 128, SU + rr, F.lane, (size_t)16384 * 128);
        else { const int e = rr - 16384; quant_row_fp8(F.in[16] + (size_t)e * DM, V8 + (size_t)e * 128, SV + e, F.lane, (size_t)16384 * 128); } }
}

__device__ __forceinline__ void quant_drain(Frame& F) {
    unsigned* qctr = (unsigned*)(F.ws + WS_CTL) + CW_ATTQ + 128;
    if (F.tid == 0) F.MISC[13] = __hip_atomic_fetch_add(qctr, 1u, __ATOMIC_RELAXED, __HIP_MEMORY_SCOPE_AGENT);
    for (int it = 0;; ++it) {
        __syncthreads();
        const int qc = (int)F.MISC[13 + (it & 1)];
        if (qc >= QCHUNKS) break;
        unsigned nx = 0u;
        if (F.tid == 0) nx = __hip_atomic_fetch_add(qctr, 1u, __ATOMIC_RELAXED, __HIP_MEMORY_SCOPE_AGENT);
        quant_chunk(F, qc);
        if (F.tid == 0) F.MISC[13 + ((it + 1) & 1)] = nx;
    }
}

typedef float f32x16 __attribute__((ext_vector_type(16)));
typedef short s16x4 __attribute__((ext_vector_type(4)));
typedef short v4i16_t __attribute__((ext_vector_type(4)));
typedef float f32x2_t __attribute__((ext_vector_type(2))); typedef __bf16 bf16x2_t __attribute__((ext_vector_type(2)));
__device__ __forceinline__ unsigned cvtpk_bf16(float lo, float hi) { f32x2_t v = {lo, hi}; bf16x2_t b = __builtin_convertvector(v, bf16x2_t); return __builtin_bit_cast(unsigned, b); }
__device__ __forceinline__ float xhalf_max(float v) { return fmaxf(v, __shfl_xor(v, 32)); }
__device__ __forceinline__ float xhalf_sum(float v) { return v + __shfl_xor(v, 32); }
__device__ __forceinline__ float max3f_(float a, float b, float c) { float r; asm("v_max3_f32 %0, %1, %2, %3" : "=v"(r) : "v"(a), "v"(b), "v"(c)); return r; }
constexpr int AT_KP = 144, AT_VP = 320, AT_K1 = 64 * AT_KP, AT_KS = 2 * AT_K1, AT_V0 = 2 * AT_KS, AT_VS = 64 * AT_VP;
constexpr int AT_XO = 0, AT_YB = 65536, AT_YP = 272, AT_Q = 100864, AT_TAB = AT_Q + 8 * 4096;
static_assert(AT_TAB + 320 * 4 <= RING_BYTES && AT_YB + 4 * 32 * AT_YP <= AT_Q && AT_V0 + 3 * AT_VS <= AT_Q, "attention LDS map");
#define AT_MFMA(a, b, c) __builtin_amdgcn_mfma_f32_32x32x16_bf16(a, b, c, 0, 0, 0)
#define AT_SGB(mask, n) __builtin_amdgcn_sched_group_barrier(mask, n, 0)
__device__ __forceinline__ void attn_mfma(Frame& F, int qslot) {
    const bf16* PROJ = (const bf16*)(F.ws + WS_PROJ); bf16* MIXED = (bf16*)(F.ws + WS_HN);
    const float* small = (const float*)(F.ws + WS_SMALL);
    LAS unsigned char* lds = F.lds;
    LAS float* TAB = (LAS float*)(lds + AT_TAB);
    const int tid = F.tid, lane = F.lane, wave = F.wave, map = wave >> 2, qt = wave & 3, r32 = lane & 31, hi = lane >> 5;
    const int koff = map * AT_K1 + r32 * AT_KP + hi * 16;
    const int voff = AT_V0 + (4 * hi + ((lane & 15) >> 2)) * AT_VP + (16 * ((lane >> 4) & 1) + 4 * (lane & 3)) * 2;
    unsigned* qctr = (unsigned*)(F.ws + WS_CTL) + CW_ATTQ + 64 * qslot;
    if (tid == 0) F.MISC[12] = __hip_atomic_fetch_add(qctr, 1u, __ATOMIC_RELAXED, __HIP_MEMORY_SCOPE_AGENT);
    for (;;) {
        __syncthreads();
        const int L = (int)F.MISC[12];
        if (L >= 1024) break;
        unsigned nxtu = 0u;
        if (tid == 0) nxtu = __hip_atomic_fetch_add(qctr, 1u, __ATOMIC_RELAXED, __HIP_MEMORY_SCOPE_AGENT);
        const int qb = 15 - (L >> 6), bh = L & 63;
        const int b = bh >> 2, h = bh & 3, q0 = qb * 128; const size_t tok0 = (size_t)b * SEQ;
        const int NT = (q0 + 128) / 64;
        int tidu = F.tid; asm volatile("" : "+v"(tidu));
        if (tidu < 320) { const int n = tidu - 96; TAB[tidu] = n < 0 ? -INFINITY : small[SM_BIAS + h * 128 + (n > 127 ? 127 : n)]; }
        bf16x8 qf0, qf1, qf2, qf3;
        { const bf16* qrow = PROJ + (tok0 + q0 + 32 * qt + r32) * INW + C_DQ + h * 128 + map * 64 + 8 * hi;
          qf0 = *(const GAS bf16x8*)(qrow); qf1 = *(const GAS bf16x8*)(qrow + 16); qf2 = *(const GAS bf16x8*)(qrow + 32); qf3 = *(const GAS bf16x8*)(qrow + 48); }
        const unsigned char* projb = (const unsigned char*)PROJ;
        const unsigned ksrc = (unsigned)(((tok0 + (tidu >> 4)) * INW + C_DK + h * 128 + (tidu & 15) * 8) * 2), vsrc = ksrc + (C_DV - C_DK) * 2;
        const int kdst = ((tidu & 15) >> 3) * AT_K1 + (tidu >> 4) * AT_KP + (tidu & 7) * 16, vdst = AT_V0 + (tidu >> 4) * AT_VP + (tidu & 15) * 16;
#define AT_GLD(src, row) (*(const GAS v4u*)(projb + (size_t)((src) + (unsigned)((row) * (INW * 2)))))
        v4u kr[2], vr[2];
#pragma unroll
        for (int i = 0; i < 2; ++i) { kr[i] = AT_GLD(ksrc, 32 * i); vr[i] = AT_GLD(vsrc, 32 * i); }
#pragma unroll
        for (int i = 0; i < 2; ++i) { *(LAS v4u*)(lds + kdst + 32 * i * AT_KP) = kr[i]; *(LAS v4u*)(lds + vdst + 32 * i * AT_VP) = vr[i]; }
#pragma unroll
        for (int i = 0; i < 2; ++i) { kr[i] = AT_GLD(ksrc, 64 + 32 * i); vr[i] = AT_GLD(vsrc, 64 + 32 * i); }
        __syncthreads();
        const float bfar = TAB[96 + 127];
        f32x16 o[4];
#pragma unroll
        for (int mt = 0; mt < 4; ++mt) o[mt] = (f32x16){0.f,0.f,0.f,0.f,0.f,0.f,0.f,0.f,0.f,0.f,0.f,0.f,0.f,0.f,0.f,0.f};
        float mrun = -INFINITY, lsum = 0.f, alpha = 1.f, cexp = 0.f; bool resc = false;
        const int qlo = q0 + 32 * qt, qpos = qlo + r32;
        const int NTW = NT - 1 + (qt >> 1);
        f32x16 pA0, pA1, pB0, pB1;
        int vs_prev = 0, vs_cur = 0, vs_next = AT_VS;
#define AT_ROT() do { vs_prev = vs_cur; vs_cur = vs_next; vs_next = (vs_next == 2 * AT_VS) ? 0 : vs_next + AT_VS; } while (0)
#define AT_Z16 (f32x16){0.f,0.f,0.f,0.f,0.f,0.f,0.f,0.f,0.f,0.f,0.f,0.f,0.f,0.f,0.f,0.f}
#define AT_SBAR() __builtin_amdgcn_sched_barrier(0)
#define AT_PIN(x) asm volatile("" : "+v"(x))
        bf16x8 kAa, kAb, kBa, kBb; s16x4 f0l, f0h, f1l, f1h;
#define AT_KRD2(S, KB, s4) do { k##S##a = *(const LAS bf16x8*)(lds + (KB) + koff + 32 * (s4)); k##S##b = *(const LAS bf16x8*)(lds + (KB) + koff + 32 * AT_KP + 32 * (s4)); } while (0)
#define AT_VRD(Fn, g) do { LAS unsigned char* vp_ = vb_ + (32 * ((g) >> 3) + 16 * (((g) >> 2) & 1)) * AT_VP + 64 * ((g) & 3); \
            Fn##l = __builtin_bit_cast(s16x4, __builtin_amdgcn_ds_read_tr16_b64_v4i16((LAS v4i16_t*)vp_)); Fn##h = __builtin_bit_cast(s16x4, __builtin_amdgcn_ds_read_tr16_b64_v4i16((LAS v4i16_t*)(vp_ + 8 * AT_VP))); } while (0)
#define AT_VFR(Fn) (bf16x8){Fn##l[0], Fn##l[1], Fn##l[2], Fn##l[3], Fn##h[0], Fn##h[1], Fn##h[2], Fn##h[3]}
#define AT_GAPA(MF, RD, FILL, P, g, PK) do { MF; RD; \
            if (FILL) { const float e0_ = P[4 * ((g) & 3)], e1_ = P[4 * ((g) & 3) + 1], e2_ = P[4 * ((g) & 3) + 2], e3_ = P[4 * ((g) & 3) + 3]; \
                sacc_ += e0_; sacc_ += e1_; sacc_ += e2_; sacc_ += e3_; \
                PK[2 * (g)] = __builtin_bit_cast(float, cvtpk_bf16(e0_, e1_)); PK[2 * (g) + 1] = __builtin_bit_cast(float, cvtpk_bf16(e2_, e3_)); AT_PIN(PK); AT_PIN(sacc_); } \
            AT_SBAR(); } while (0)
#define AT_PHASE_A(C0, C1, P0, P1, KB, FILL) do { float sacc_ = 0.f; \
            AT_SBAR(); AT_KRD2(A, KB, 0); AT_SBAR(); \
            AT_GAPA(C0 = AT_MFMA(kAa, qf0, AT_Z16), AT_KRD2(B, KB, 1), FILL, P0, 0, P0); \
            AT_GAPA(C1 = AT_MFMA(kAb, qf0, AT_Z16), (void)0,           FILL, P0, 1, P0); \
            AT_GAPA(C0 = AT_MFMA(kBa, qf1, C0),     AT_KRD2(A, KB, 2), FILL, P0, 2, P0); \
            AT_GAPA(C1 = AT_MFMA(kBb, qf1, C1),     (void)0,           FILL, P0, 3, P0); \
            AT_GAPA(C0 = AT_MFMA(kAa, qf2, C0),     AT_KRD2(B, KB, 3), FILL, P1, 4, P0); \
            AT_GAPA(C1 = AT_MFMA(kAb, qf2, C1),     (void)0,           FILL, P1, 5, P0); \
            AT_GAPA(C0 = AT_MFMA(kBa, qf3, C0),     (void)0,           FILL, P1, 6, P0); \
            AT_GAPA(C1 = AT_MFMA(kBb, qf3, C1),     (void)0,           FILL, P1, 7, P0); \
            lsum += sacc_; } while (0)
#define AT_MID(C0, C1, t) do { float tm, cadd; \
            if (qlo - (64 * (t) + 63) < 127) { \
                const LAS float* rp = TAB + (qpos - 64 * (t) - 4 * hi + 96 - 59); tm = -INFINITY; \
                _Pragma("unroll") for (int r = 0; r < 16; ++r) { const int off = (r & 3) + 8 * (r >> 2); C0[r] += rp[59 - off]; C1[r] += rp[27 - off]; tm = max3f_(tm, C0[r], C1[r]); } \
                cadd = 0.f; \
            } else { \
                tm = max3f_(C0[0], C1[0], C0[1]); \
                _Pragma("unroll") for (int r = 1; r < 15; ++r) tm = max3f_(tm, C1[r], C0[r + 1]); \
                tm = fmaxf(tm, C1[15]); tm += bfar; cadd = bfar; } \
            tm = xhalf_max(tm); resc = false; \
            if (__any(tm > mrun + 8.f)) { const float mnew = fmaxf(mrun, tm); alpha = __builtin_amdgcn_exp2f(mrun - mnew); lsum *= alpha; mrun = mnew; resc = true; } \
            cexp = cadd - mrun; } while (0)
#define AT_EXP(C0, C1) do { _Pragma("unroll") for (int r = 0; r < 16; ++r) { C0[r] = __builtin_amdgcn_exp2f(C0[r] + cexp); C1[r] = __builtin_amdgcn_exp2f(C1[r] + cexp); } } while (0)
#define AT_GAPB(Fn, g, PK, C, DOEXP) do { o[(g) & 3] = AT_MFMA(AT_VFR(Fn), __builtin_bit_cast(bf16x8, (f32x4){PK[4 * ((g) >> 2)], PK[4 * ((g) >> 2) + 1], PK[4 * ((g) >> 2) + 2], PK[4 * ((g) >> 2) + 3]}), o[(g) & 3]); \
            if ((g) + 2 < 16) AT_VRD(Fn, (g) + 2); \
            if (DOEXP) { C[2 * ((g) & 7)] = __builtin_amdgcn_exp2f(C[2 * ((g) & 7)] + cexp); C[2 * ((g) & 7) + 1] = __builtin_amdgcn_exp2f(C[2 * ((g) & 7) + 1] + cexp); AT_PIN(C); } \
            AT_SBAR(); } while (0)
#define AT_PHASE_B(C0, C1, PK, VB, DOEXP) do { LAS unsigned char* vb_ = lds + (VB) + voff; \
            AT_SBAR(); AT_VRD(f0, 0); AT_VRD(f1, 1); AT_SBAR(); \
            AT_GAPB(f0, 0, PK, C0, DOEXP);  AT_GAPB(f1, 1, PK, C0, DOEXP);  AT_GAPB(f0, 2, PK, C0, DOEXP);  AT_GAPB(f1, 3, PK, C0, DOEXP); \
            AT_GAPB(f0, 4, PK, C0, DOEXP);  AT_GAPB(f1, 5, PK, C0, DOEXP);  AT_GAPB(f0, 6, PK, C0, DOEXP);  AT_GAPB(f1, 7, PK, C0, DOEXP); \
            AT_GAPB(f0, 8, PK, C1, DOEXP);  AT_GAPB(f1, 9, PK, C1, DOEXP);  AT_GAPB(f0, 10, PK, C1, DOEXP); AT_GAPB(f1, 11, PK, C1, DOEXP); \
            AT_GAPB(f0, 12, PK, C1, DOEXP); AT_GAPB(f1, 13, PK, C1, DOEXP); AT_GAPB(f0, 14, PK, C1, DOEXP); AT_GAPB(f1, 15, PK, C1, DOEXP); } while (0)
#define AT_RESC() do { if (resc) { _Pragma("unroll") for (int mt = 0; mt < 4; ++mt) o[mt] = o[mt] * alpha; } } while (0)
#define AT_STAGE(t) do { if ((t) + 1 < NT) { \
                _Pragma("unroll") for (int i = 0; i < 2; ++i) { *(LAS v4u*)(lds + (((t) + 1) & 1) * AT_KS + kdst + 32 * i * AT_KP) = kr[i]; *(LAS v4u*)(lds + vs_next + vdst + 32 * i * AT_VP) = vr[i]; } \
                if ((t) + 2 < NT) { _Pragma("unroll") for (int i = 0; i < 2; ++i) { kr[i] = AT_GLD(ksrc, 64 * ((t) + 2) + 32 * i); vr[i] = AT_GLD(vsrc, 64 * ((t) + 2) + 32 * i); } } } \
            __syncthreads(); AT_ROT(); } while (0)
#define AT_STEP(C0, C1, P0, P1, t) do { \
            AT_PHASE_A(C0, C1, P0, P1, ((t) & 1) * AT_KS, 1); \
            AT_MID(C0, C1, t); \
            AT_PHASE_B(C0, C1, P0, vs_prev, 1); \
            AT_RESC(); } while (0)
#define AT_PACK(P0, P1) do { float ps_ = 0.f; \
            _Pragma("unroll") for (int r = 0; r < 16; ++r) ps_ += P0[r] + P1[r]; \
            lsum += ps_; \
            _Pragma("unroll") for (int w = 0; w < 8; ++w) { const float lo_ = P0[2 * w], hi_ = P0[2 * w + 1]; P0[w] = __builtin_bit_cast(float, cvtpk_bf16(lo_, hi_)); } \
            _Pragma("unroll") for (int w = 0; w < 8; ++w) P0[8 + w] = __builtin_bit_cast(float, cvtpk_bf16(P1[2 * w], P1[2 * w + 1])); } while (0)
        AT_PHASE_A(pA0, pA1, pA0, pA1, 0, 0); AT_MID(pA0, pA1, 0); AT_EXP(pA0, pA1); AT_RESC();
        AT_STAGE(0);
        if (tid == 0) F.MISC[12] = nxtu;
        int t = 1;
        for (; t + 1 < NT; t += 2) {
            AT_STEP(pB0, pB1, pA0, pA1, t);     AT_STAGE(t);
            AT_STEP(pA0, pA1, pB0, pB1, t + 1); AT_STAGE(t + 1);
        }
        if (NTW == NT) {
            AT_STEP(pB0, pB1, pA0, pA1, t); AT_ROT();
            AT_PACK(pB0, pB1); AT_PHASE_B(pB0, pB1, pB0, vs_prev, 0);
        } else {
            AT_PACK(pA0, pA1); AT_PHASE_B(pA0, pA1, pA0, vs_prev, 0);
        }
        __syncthreads();
        { int lane_e = F.lane; asm volatile("" : "+v"(lane_e));
        const int lane = lane_e, r32 = lane & 31, hi = lane >> 5;
        const float inv = 1.f / xhalf_sum(lsum);
        LAS float* XO = (LAS float*)(lds + AT_XO) + qt * 4096 + r32;
        if (map == 1) {
            const float sc = inv * small[SM_LAM];
#pragma unroll
            for (int mt = 0; mt < 4; ++mt)
#pragma unroll
                for (int r = 0; r < 16; ++r) XO[(32 * mt + (r & 3) + 8 * (r >> 2) + 4 * hi) * 32] = o[mt][r] * sc;
        }
        __syncthreads();
        if (map == 0) {
            float ss = 0.f;
#pragma unroll
            for (int mt = 0; mt < 4; ++mt)
#pragma unroll
                for (int r = 0; r < 16; ++r) { const float a = o[mt][r] * inv - XO[(32 * mt + (r & 3) + 8 * (r >> 2) + 4 * hi) * 32]; o[mt][r] = a; ss += a * a; }
            ss = xhalf_sum(ss);
            const float rr = (1.f - LAM_INIT) / sqrtf(ss * (1.f / 128.f) + EPS);
            LAS unsigned char* yb = lds + AT_YB + qt * (32 * AT_YP);
#pragma unroll
            for (int mt = 0; mt < 4; ++mt)
#pragma unroll
                for (int r4 = 0; r4 < 4; ++r4) { const int dv = 32 * mt + 8 * r4 + 4 * hi; const f32x4 gg = *(const GAS f32x4*)(F.in[7] + dv);
                    v2u w; w.x = cvtpk_bf16(o[mt][4 * r4] * rr * gg.x, o[mt][4 * r4 + 1] * rr * gg.y); w.y = cvtpk_bf16(o[mt][4 * r4 + 2] * rr * gg.z, o[mt][4 * r4 + 3] * rr * gg.w);
                    *(LAS v2u*)(yb + r32 * AT_YP + dv * 2) = w; }
            LDS_WAIT(); asm volatile("" ::: "memory");
            bf16* obase = MIXED + (tok0 + q0 + 32 * qt) * DM + h * 128;
#pragma unroll
            for (int i = 0; i < 8; ++i) { const int id = lane + 64 * i, row = id >> 4, cch = id & 15;
                const v4u w = *(const LAS v4u*)(yb + row * AT_YP + cch * 16); *(GAS v4u*)(obase + (size_t)row * DM + cch * 8) = w; }
        } }
#undef AT_ROT
#undef AT_GLD
#undef AT_KRD2
#undef AT_VRD
#undef AT_VFR
#undef AT_GAPA
#undef AT_GAPB
#undef AT_PHASE_A
#undef AT_PHASE_B
#undef AT_PACK
#undef AT_MID
#undef AT_EXP
#undef AT_RESC
#undef AT_STAGE
#undef AT_STEP
    }
}

constexpr int HG_P = 288, HG_VP = 320, HG_GP = 272, HG_OP = 136;
constexpr int HG_QD = 0, HG_KI = 32 * HG_P, HG_V = 2 * 32 * HG_P, HG_CD = HG_V + 32 * HG_VP, HG_G = HG_CD + 512, HG_BUF = HG_G + 32 * HG_GP;
constexpr int HG_O = 2 * HG_BUF;
static_assert(HG_O + 32 * HG_OP * 4 <= RING_BYTES, "hgrn LDS map");
__device__ __forceinline__ bf16x8 pack8(const f32x16& x, int s) {
    v4u p; p.x = cvtpk_bf16(x[8 * s], x[8 * s + 1]); p.y = cvtpk_bf16(x[8 * s + 2], x[8 * s + 3]); p.z = cvtpk_bf16(x[8 * s + 4], x[8 * s + 5]); p.w = cvtpk_bf16(x[8 * s + 6], x[8 * s + 7]);
    return __builtin_bit_cast(bf16x8, p);
}
__device__ __forceinline__ bf16x8 tr_pair(LAS unsigned char* p0, LAS unsigned char* p1) {
    const s16x4 lo = __builtin_bit_cast(s16x4, __builtin_amdgcn_ds_read_tr16_b64_v4i16((LAS v4i16_t*)p0));
    const s16x4 hi4 = __builtin_bit_cast(s16x4, __builtin_amdgcn_ds_read_tr16_b64_v4i16((LAS v4i16_t*)p1));
    return (bf16x8){lo[0], lo[1], lo[2], lo[3], hi4[0], hi4[1], hi4[2], hi4[3]};
}
#define DPPF_(x, ctrl) __builtin_bit_cast(float, __builtin_amdgcn_update_dpp(0, __builtin_bit_cast(int, (x)), (ctrl), 0xf, 0xf, true))
__device__ __forceinline__ void hg_prep8(LAS unsigned char* bufp, const v4u rq, const v4u rf, const f32x4 lbA, const f32x4 lbB, int pc, int dk8, int lane) {
    const float lbv[8] = {lbA.x, lbA.y, lbA.z, lbA.w, lbB.x, lbB.y, lbB.z, lbB.w};
    float bb[8], fv[8];
    const unsigned fw[4] = {rf.x, rf.y, rf.z, rf.w}, qw[4] = {rq.x, rq.y, rq.z, rq.w};
#pragma unroll
    for (int i = 0; i < 8; ++i) { const float x = (i & 1) ? bfhi(fw[i >> 1]) : bflo(fw[i >> 1]); const float f = lbv[i] + (1.f - lbv[i]) * __builtin_amdgcn_rcpf(1.f + __expf(-x)); fv[i] = f; bb[i] = f; }
#define HG_SCAN_STEP(ctrl) asm volatile("s_nop 1\n\tv_mul_f32_dpp %0, %0, %0 " ctrl "\n\tv_mul_f32_dpp %1, %1, %1 " ctrl "\n\tv_mul_f32_dpp %2, %2, %2 " ctrl "\n\tv_mul_f32_dpp %3, %3, %3 " ctrl "\n\t" \
        "v_mul_f32_dpp %4, %4, %4 " ctrl "\n\tv_mul_f32_dpp %5, %5, %5 " ctrl "\n\tv_mul_f32_dpp %6, %6, %6 " ctrl "\n\tv_mul_f32_dpp %7, %7, %7 " ctrl \
        : "+v"(bb[0]), "+v"(bb[1]), "+v"(bb[2]), "+v"(bb[3]), "+v"(bb[4]), "+v"(bb[5]), "+v"(bb[6]), "+v"(bb[7]))
    HG_SCAN_STEP("row_shr:1 row_mask:0xf bank_mask:0xf");
    HG_SCAN_STEP("row_shr:2 row_mask:0xf bank_mask:0xf");
    HG_SCAN_STEP("row_shr:4 row_mask:0xf bank_mask:0xf");
    HG_SCAN_STEP("row_shr:8 row_mask:0xf bank_mask:0xf");
    HG_SCAN_STEP("row_bcast:15 row_mask:0xa bank_mask:0xf");
#undef HG_SCAN_STEP
    float qd[8], ki[8];
#pragma unroll
    for (int i = 0; i < 8; ++i) { const float e = bb[i], ei = __builtin_amdgcn_rcpf(bb[i]);
        const float xq = (i & 1) ? bfhi(qw[i >> 1]) : bflo(qw[i >> 1]); const float q = xq * __builtin_amdgcn_rcpf(1.f + __expf(-xq)); const float k = 1.f - fv[i];
        qd[i] = q * e; ki[i] = k * ei; }
    *(LAS v4u*)(bufp + HG_QD + pc * HG_P + dk8 * 2) = (v4u){cvtpk_bf16(qd[0], qd[1]), cvtpk_bf16(qd[2], qd[3]), cvtpk_bf16(qd[4], qd[5]), cvtpk_bf16(qd[6], qd[7])};
    *(LAS v4u*)(bufp + HG_KI + pc * HG_P + dk8 * 2) = (v4u){cvtpk_bf16(ki[0], ki[1]), cvtpk_bf16(ki[2], ki[3]), cvtpk_bf16(ki[4], ki[5]), cvtpk_bf16(ki[6], ki[7])};
    if (pc == 31) { *(LAS f32x4*)(bufp + HG_CD + dk8 * 4) = (f32x4){bb[0], bb[1], bb[2], bb[3]}; *(LAS f32x4*)(bufp + HG_CD + dk8 * 4 + 16) = (f32x4){bb[4], bb[5], bb[6], bb[7]}; }
}
__device__ __forceinline__ void hgrn_mfma(Frame& F) {
    const bf16* PROJ = (const bf16*)(F.ws + WS_PROJ); bf16* MIXED = (bf16*)(F.ws + WS_HN);
    const float* small = (const float*)(F.ws + WS_SMALL);
    LAS unsigned char* lds = F.lds;
    const int tid = F.tid, lane = F.lane, wave = F.wave, r32 = lane & 31, hh = lane >> 5;
    for (int u = F.vcu; u < 64; u += F.G) {
        const int b = u >> 2, h = u & 3; const size_t tok0 = (size_t)b * SEQ;
        __syncthreads();
        if (wave >= 4) {
            const int pt = tid - 256, pc = lane & 31, dkA = 16 * (wave - 4) + 8 * hh;
            const int vcA = pt >> 4, vseg = pt & 15;
            const f32x4 lb0 = *(const GAS f32x4*)(small + SM_LB + h * 128 + dkA), lb1 = *(const GAS f32x4*)(small + SM_LB + h * 128 + dkA + 4);
            const f32x4 lb2 = *(const GAS f32x4*)(small + SM_LB + h * 128 + dkA + 64), lb3 = *(const GAS f32x4*)(small + SM_LB + h * 128 + dkA + 68);
            v4u q0A, f0A, v0A, g0A, q1A, f1A, v1A, g1A, q0B, f0B, v0B, g0B, q1B, f1B, v1B, g1B, q0C, f0C, v0C, g0C, q1C, f1C, v1C, g1C, q0D, f0D, v0D, g0D, q1D, f1D, v1D, g1D;
#define HP_LOAD(S, chn) do { const bf16* p_ = PROJ + (tok0 + 32 * (chn) + pc) * INW + h * 128 + dkA; const bf16* v_ = PROJ + (tok0 + 32 * (chn) + vcA) * INW + h * 128 + vseg * 8; \
            asm volatile("global_load_dwordx4 %0, %1, off" : "=v"(q0##S) : "v"(p_ + C_HQ) : "memory"); \
            asm volatile("global_load_dwordx4 %0, %1, off" : "=v"(f0##S) : "v"(p_ + C_HF) : "memory"); \
            asm volatile("global_load_dwordx4 %0, %1, off" : "=v"(v0##S) : "v"(v_ + C_HI) : "memory"); \
            asm volatile("global_load_dwordx4 %0, %1, off" : "=v"(g0##S) : "v"(v_ + C_HG) : "memory"); \
            asm volatile("global_load_dwordx4 %0, %1, off" : "=v"(q1##S) : "v"(p_ + C_HQ + 64) : "memory"); \
            asm volatile("global_load_dwordx4 %0, %1, off" : "=v"(f1##S) : "v"(p_ + C_HF + 64) : "memory"); \
            asm volatile("global_load_dwordx4 %0, %1, off" : "=v"(v1##S) : "v"(v_ + (size_t)16 * INW + C_HI) : "memory"); \
            asm volatile("global_load_dwordx4 %0, %1, off" : "=v"(g1##S) : "v"(v_ + (size_t)16 * INW + C_HG) : "memory"); } while (0)
#define HP_WAIT(S) asm volatile("s_waitcnt vmcnt(24)" : "+v"(q0##S), "+v"(f0##S), "+v"(v0##S), "+v"(g0##S), "+v"(q1##S), "+v"(f1##S), "+v"(v1##S), "+v"(g1##S) :: "memory")
#define HP_PASS0(S, bufp) do { hg_prep8(bufp, q0##S, f0##S, lb0, lb1, pc, dkA, lane); \
            *(LAS v4u*)((bufp) + HG_V + vcA * HG_VP + vseg * 16) = v0##S; *(LAS v4u*)((bufp) + HG_V + (vcA + 16) * HG_VP + vseg * 16) = v1##S; \
            *(LAS v4u*)((bufp) + HG_G + vcA * HG_GP + vseg * 16) = g0##S; *(LAS v4u*)((bufp) + HG_G + (vcA + 16) * HG_GP + vseg * 16) = g1##S; } while (0)
#define HP_PASS1(S, bufp) hg_prep8(bufp, q1##S, f1##S, lb2, lb3, pc, dkA + 64, lane)
#define HP_CL(c) ((c) < SEQ / 32 ? (c) : SEQ / 32 - 1)
            HP_LOAD(A, 0); HP_LOAD(B, 1); HP_LOAD(C, 2); HP_LOAD(D, 3);
            HP_WAIT(A); HP_PASS0(A, lds); HP_PASS1(A, lds);
            HP_LOAD(A, 4);
            for (int ch4 = 0; ch4 < SEQ / 32; ch4 += 4) {
                __syncthreads();
                HP_WAIT(B); HP_PASS0(B, lds + HG_BUF);
                __syncthreads();
                HP_PASS1(B, lds + HG_BUF); HP_LOAD(B, HP_CL(ch4 + 5));
                __syncthreads();
                HP_WAIT(C); HP_PASS0(C, lds);
                __syncthreads();
                HP_PASS1(C, lds); HP_LOAD(C, HP_CL(ch4 + 6));
                __syncthreads();
                HP_WAIT(D); HP_PASS0(D, lds + HG_BUF);
                __syncthreads();
                HP_PASS1(D, lds + HG_BUF); HP_LOAD(D, HP_CL(ch4 + 7));
                __syncthreads();
                HP_WAIT(A); HP_PASS0(A, lds);
                __syncthreads();
                HP_PASS1(A, lds); HP_LOAD(A, HP_CL(ch4 + 8));
            }
            asm volatile("s_waitcnt vmcnt(0)" : "+v"(q0A), "+v"(f0A), "+v"(v0A), "+v"(g0A), "+v"(q1A), "+v"(f1A), "+v"(v1A), "+v"(g1A), "+v"(q0B), "+v"(f0B), "+v"(v0B), "+v"(g0B), "+v"(q1B), "+v"(f1B), "+v"(v1B), "+v"(g1B) :: "memory");
            asm volatile("" : "+v"(q0C), "+v"(f0C), "+v"(v0C), "+v"(g0C), "+v"(q1C), "+v"(f1C), "+v"(v1C), "+v"(g1C), "+v"(q0D), "+v"(f0D), "+v"(v0D), "+v"(g0D), "+v"(q1D), "+v"(f1D), "+v"(v1D), "+v"(g1D) :: "memory");
#undef HP_CL
#undef HP_LOAD
#undef HP_WAIT
#undef HP_PASS0
#undef HP_PASS1
        } else {
            const int dvt = wave;
            const int kdoff = (((lane & 15) >> 2)) * HG_P + (16 * ((lane >> 4) & 1) + 4 * (lane & 3)) * 2;
            const int troff = (((lane & 15) >> 2)) * HG_VP + (32 * dvt + 16 * ((lane >> 4) & 1) + 4 * (lane & 3)) * 2;
            const int vc = tid >> 3, sg = tid & 7;
            const f32x4 ga0 = *(const GAS f32x4*)(F.in[10] + 8 * sg), ga1 = *(const GAS f32x4*)(F.in[10] + 8 * sg + 4);
            const f32x4 gb0 = *(const GAS f32x4*)(F.in[10] + 64 + 8 * sg), gb1 = *(const GAS f32x4*)(F.in[10] + 64 + 8 * sg + 4);
            f32x16 S0, S1, S2, S3;
#pragma unroll
            for (int r = 0; r < 16; ++r) { S0[r] = 0.f; S1[r] = 0.f; S2[r] = 0.f; S3[r] = 0.f; }
            for (int ch = 0; ch < SEQ / 32; ++ch) {
                LAS unsigned char* bufp = lds + (ch & 1) * HG_BUF;
                __syncthreads();
                f32x16 o, X;
#pragma unroll
                for (int r = 0; r < 16; ++r) { o[r] = 0.f; X[r] = 0.f; }
                bf16x8 qaf[8], kif[8], qdf[8];
                __builtin_amdgcn_sched_barrier(0);
#pragma unroll
                for (int i = 0; i < 8; ++i) { LAS unsigned char* qa = bufp + HG_QD + r32 * HG_P + (16 * i + 4 * hh) * 2;
                    const v2u a0 = *(const LAS v2u*)qa, a1 = *(const LAS v2u*)(qa + 16); qaf[i] = __builtin_bit_cast(bf16x8, (v4u){a0.x, a0.y, a1.x, a1.y}); }
#pragma unroll
                for (int s8 = 0; s8 < 4; ++s8) { kif[s8] = *(const LAS bf16x8*)(bufp + HG_KI + r32 * HG_P + (16 * s8 + 8 * hh) * 2); qdf[s8] = *(const LAS bf16x8*)(bufp + HG_QD + r32 * HG_P + (16 * s8 + 8 * hh) * 2); }
                __builtin_amdgcn_sched_barrier(0);
#pragma unroll
                for (int i = 0; i < 8; ++i)
                    o = __builtin_amdgcn_mfma_f32_32x32x16_bf16(qaf[i], pack8((i >> 1) == 0 ? S0 : (i >> 1) == 1 ? S1 : (i >> 1) == 2 ? S2 : S3, i & 1), o, 0, 0, 0);
#pragma unroll
                for (int s8 = 4; s8 < 8; ++s8) { kif[s8] = *(const LAS bf16x8*)(bufp + HG_KI + r32 * HG_P + (16 * s8 + 8 * hh) * 2); qdf[s8] = *(const LAS bf16x8*)(bufp + HG_QD + r32 * HG_P + (16 * s8 + 8 * hh) * 2); }
                bf16x8 vx0, vx1;
                { LAS unsigned char* vp = bufp + HG_V + troff + (4 * hh) * HG_VP; vx0 = tr_pair(vp, vp + 8 * HG_VP); vx1 = tr_pair(vp + 16 * HG_VP, vp + 24 * HG_VP); }
                __builtin_amdgcn_sched_barrier(0);
#pragma unroll
                for (int s8 = 0; s8 < 8; ++s8) X = __builtin_amdgcn_mfma_f32_32x32x16_bf16(kif[s8], qdf[s8], X, 0, 0, 0);
                __builtin_amdgcn_sched_barrier(0);
#pragma unroll
                for (int r = 0; r < 16; ++r) { const int cp = (r & 3) + 8 * (r >> 2) + 4 * hh; X[r] = cp > r32 ? 0.f : X[r]; }
                o = __builtin_amdgcn_mfma_f32_32x32x16_bf16(pack8(X, 0), vx0, o, 0, 0, 0);
                o = __builtin_amdgcn_mfma_f32_32x32x16_bf16(pack8(X, 1), vx1, o, 0, 0, 0);
                { LAS float* ob = (LAS float*)(lds + HG_O) + 32 * dvt + r32;
#pragma unroll
                  for (int r = 0; r < 16; ++r) ob[((r & 3) + 8 * (r >> 2) + 4 * hh) * HG_OP] = o[r]; }
                __syncthreads();
                { bf16x8 kaf[8], vbf[2];
                  __builtin_amdgcn_sched_barrier(0);
#pragma unroll
                  for (int s2 = 0; s2 < 2; ++s2) { LAS unsigned char* vp = bufp + HG_V + troff + (16 * s2 + 8 * hh) * HG_VP; vbf[s2] = tr_pair(vp, vp + 4 * HG_VP); }
#pragma unroll
                  for (int i = 0; i < 8; ++i) { LAS unsigned char* kp = bufp + HG_KI + kdoff + (16 * (i & 1) + 8 * hh) * HG_P + 32 * (i >> 1) * 2;
                      kaf[i] = tr_pair(kp, kp + 4 * HG_P); }
                  __builtin_amdgcn_sched_barrier(0);
#pragma unroll
                  for (int i = 0; i < 8; ++i) {
                      if ((i >> 1) == 0)      S0 = __builtin_amdgcn_mfma_f32_32x32x16_bf16(kaf[i], vbf[i & 1], S0, 0, 0, 0);
                      else if ((i >> 1) == 1) S1 = __builtin_amdgcn_mfma_f32_32x32x16_bf16(kaf[i], vbf[i & 1], S1, 0, 0, 0);
                      else if ((i >> 1) == 2) S2 = __builtin_amdgcn_mfma_f32_32x32x16_bf16(kaf[i], vbf[i & 1], S2, 0, 0, 0);
                      else                    S3 = __builtin_amdgcn_mfma_f32_32x32x16_bf16(kaf[i], vbf[i & 1], S3, 0, 0, 0);
                  }
                  __builtin_amdgcn_sched_barrier(0); }
#pragma unroll
                for (int kk = 0; kk < 4; ++kk) {
                    const LAS float* cdp = (const LAS float*)(bufp + HG_CD) + 32 * kk + 4 * hh;
#pragma unroll
                    for (int r4 = 0; r4 < 4; ++r4) { const f32x4 c4 = *(const LAS f32x4*)(cdp + 8 * r4);
                        if (kk == 0)      { S0[4 * r4] *= c4.x; S0[4 * r4 + 1] *= c4.y; S0[4 * r4 + 2] *= c4.z; S0[4 * r4 + 3] *= c4.w; }
                        else if (kk == 1) { S1[4 * r4] *= c4.x; S1[4 * r4 + 1] *= c4.y; S1[4 * r4 + 2] *= c4.z; S1[4 * r4 + 3] *= c4.w; }
                        else if (kk == 2) { S2[4 * r4] *= c4.x; S2[4 * r4 + 1] *= c4.y; S2[4 * r4 + 2] *= c4.z; S2[4 * r4 + 3] *= c4.w; }
                        else              { S3[4 * r4] *= c4.x; S3[4 * r4 + 1] *= c4.y; S3[4 * r4 + 2] *= c4.z; S3[4 * r4 + 3] *= c4.w; } }
                }
                { const LAS float* op = (const LAS float*)(lds + HG_O) + vc * HG_OP + 8 * sg;
                  const f32x4 x0 = *(const LAS f32x4*)op, x1 = *(const LAS f32x4*)(op + 4), x2 = *(const LAS f32x4*)(op + 64), x3 = *(const LAS f32x4*)(op + 68);
                  const v4u gwa = *(const LAS v4u*)(bufp + HG_G + vc * HG_GP + sg * 16), gwb = *(const LAS v4u*)(bufp + HG_G + vc * HG_GP + (sg + 8) * 16);
                  float ss = ((x0.x * x0.x + x0.y * x0.y) + (x0.z * x0.z + x0.w * x0.w)) + ((x1.x * x1.x + x1.y * x1.y) + (x1.z * x1.z + x1.w * x1.w))
                           + ((x2.x * x2.x + x2.y * x2.y) + (x2.z * x2.z + x2.w * x2.w)) + ((x3.x * x3.x + x3.y * x3.y) + (x3.z * x3.z + x3.w * x3.w));
                  ss += DPPF_(ss, 0xB1); ss += DPPF_(ss, 0x4E); ss += DPPF_(ss, 0x141);
                  const float rr = __builtin_amdgcn_rsqf(ss * (1.f / 128.f) + EPS);
                  const size_t tok = tok0 + 32 * ch + vc;
                  const unsigned gwa_[4] = {gwa.x, gwa.y, gwa.z, gwa.w}, gwb_[4] = {gwb.x, gwb.y, gwb.z, gwb.w};
                  const float ova[8] = {x0.x, x0.y, x0.z, x0.w, x1.x, x1.y, x1.z, x1.w}, ovb[8] = {x2.x, x2.y, x2.z, x2.w, x3.x, x3.y, x3.z, x3.w};
                  const float gga[8] = {ga0.x, ga0.y, ga0.z, ga0.w, ga1.x, ga1.y, ga1.z, ga1.w}, ggb[8] = {gb0.x, gb0.y, gb0.z, gb0.w, gb1.x, gb1.y, gb1.z, gb1.w};
                  unsigned wa[4], wb[4];
#pragma unroll
                  for (int j = 0; j < 4; ++j) { const float a0 = bflo(gwa_[j]), a1 = bfhi(gwa_[j]), b0 = bflo(gwb_[j]), b1 = bfhi(gwb_[j]);
                      wa[j] = cvtpk_bf16(ova[2 * j] * rr * gga[2 * j] * (a0 * __builtin_amdgcn_rcpf(1.f + __expf(-a0))), ova[2 * j + 1] * rr * gga[2 * j + 1] * (a1 * __builtin_amdgcn_rcpf(1.f + __expf(-a1))));
                      wb[j] = cvtpk_bf16(ovb[2 * j] * rr * ggb[2 * j] * (b0 * __builtin_amdgcn_rcpf(1.f + __expf(-b0))), ovb[2 * j + 1] * rr * ggb[2 * j + 1] * (b1 * __builtin_amdgcn_rcpf(1.f + __expf(-b1)))); }
                  bf16* dst = MIXED + tok * DM + 512 + h * 128 + 8 * sg;
                  *(GAS v4u*)dst = (v4u){wa[0], wa[1], wa[2], wa[3]}; *(GAS v4u*)(dst + 64) = (v4u){wb[0], wb[1], wb[2], wb[3]}; }
            }
        }
    }
}
template <int N> __device__ __forceinline__ unsigned row_ror(unsigned x) { return (unsigned)__builtin_amdgcn_update_dpp((int)x, (int)x, 0x120 + N, 0xf, 0xf, false); }
__device__ __forceinline__ unsigned umax_(unsigned a, unsigned b) { return a > b ? a : b; }
__device__ __forceinline__ unsigned umin_(unsigned a, unsigned b) { return a < b ? a : b; }
__device__ __forceinline__ unsigned row_umax16(unsigned x) {
    unsigned y;
    asm volatile("s_nop 1\n\tv_max_u32_dpp %0, %1, %1 row_ror:1 row_mask:0xf bank_mask:0xf\n\t"
                 "s_nop 1\n\tv_max_u32_dpp %0, %0, %0 row_ror:2 row_mask:0xf bank_mask:0xf\n\t"
                 "s_nop 1\n\tv_max_u32_dpp %0, %0, %0 row_ror:4 row_mask:0xf bank_mask:0xf\n\t"
                 "s_nop 1\n\tv_max_u32_dpp %0, %0, %0 row_ror:8 row_mask:0xf bank_mask:0xf"
                 : "=&v"(y) : "v"(x));
    return y;
}
__device__ __forceinline__ float row_fsum16(float v) {
    v += __builtin_bit_cast(float, row_ror<1>(__builtin_bit_cast(unsigned, v))); v += __builtin_bit_cast(float, row_ror<2>(__builtin_bit_cast(unsigned, v)));
    v += __builtin_bit_cast(float, row_ror<4>(__builtin_bit_cast(unsigned, v))); v += __builtin_bit_cast(float, row_ror<8>(__builtin_bit_cast(unsigned, v))); return v; }
__device__ __forceinline__ unsigned h2key(unsigned x) { return (x & 0x80000000u) ? (~x & 0xffff0000u) : (x | 0x80000000u); }
__device__ __forceinline__ float hkey2f(unsigned k) { const unsigned hb = ((k & 0x80000000u) ? (k & 0x7fff0000u) : (~k & 0xffff0000u)) >> 16; return (float)__builtin_bit_cast(_Float16, (unsigned short)hb); }
__device__ __forceinline__ unsigned f2key(float f) { const unsigned u = __builtin_bit_cast(unsigned, f); return (u & 0x80000000u) ? ~u : (u | 0x80000000u); }
__device__ __forceinline__ float key2f(unsigned k) { const unsigned u = (k & 0x80000000u) ? (k & 0x7fffffffu) : ~k; return __builtin_bit_cast(float, u); }
__device__ __forceinline__ unsigned pair_code(int s) {
    if (s < 16) return (unsigned)s;
    if (s < 24) return 16u + (unsigned)(s - 16);
    if (s < 29) return 32u + (unsigned)(s - 24);
    if (s < 33) return 48u + (unsigned)(s - 29);
    if (s < 36) return 64u + (unsigned)(s - 33);
    if (s < 42) return 80u + 16u * (unsigned)((s - 36) >> 1) + (unsigned)((s - 36) & 1);
    if (s < 50) return 128u + 16u * (unsigned)(s - 42);
    return 0xFFu;
}
#define CAS_(a, b) do { const unsigned hi_ = umax_(a, b), lo_ = umin_(a, b); a = hi_; b = lo_; } while (0)
__device__ __forceinline__ void row_umax16_x2(unsigned xa, unsigned xb, unsigned& ya, unsigned& yb) {
    asm volatile("s_nop 1\n\tv_max_u32_dpp %0, %2, %2 row_ror:1 row_mask:0xf bank_mask:0xf\n\tv_max_u32_dpp %1, %3, %3 row_ror:1 row_mask:0xf bank_mask:0xf\n\t"
                 "s_nop 0\n\tv_max_u32_dpp %0, %0, %0 row_ror:2 row_mask:0xf bank_mask:0xf\n\tv_max_u32_dpp %1, %1, %1 row_ror:2 row_mask:0xf bank_mask:0xf\n\t"
                 "s_nop 0\n\tv_max_u32_dpp %0, %0, %0 row_ror:4 row_mask:0xf bank_mask:0xf\n\tv_max_u32_dpp %1, %1, %1 row_ror:4 row_mask:0xf bank_mask:0xf\n\t"
                 "s_nop 0\n\tv_max_u32_dpp %0, %0, %0 row_ror:8 row_mask:0xf bank_mask:0xf\n\tv_max_u32_dpp %1, %1, %1 row_ror:8 row_mask:0xf bank_mask:0xf"
                 : "=&v"(ya), "=&v"(yb) : "v"(xa), "v"(xb));
}
__device__ __forceinline__ void row_umax16_x4(unsigned xa, unsigned xb, unsigned xc, unsigned xd, unsigned& ya, unsigned& yb, unsigned& yc, unsigned& yd) {
    asm volatile("s_nop 1\n\tv_max_u32_dpp %0, %4, %4 row_ror:1 row_mask:0xf bank_mask:0xf\n\tv_max_u32_dpp %1, %5, %5 row_ror:1 row_mask:0xf bank_mask:0xf\n\t"
                 "v_max_u32_dpp %2, %6, %6 row_ror:1 row_mask:0xf bank_mask:0xf\n\tv_max_u32_dpp %3, %7, %7 row_ror:1 row_mask:0xf bank_mask:0xf\n\t"
                 "v_max_u32_dpp %0, %0, %0 row_ror:2 row_mask:0xf bank_mask:0xf\n\tv_max_u32_dpp %1, %1, %1 row_ror:2 row_mask:0xf bank_mask:0xf\n\t"
                 "v_max_u32_dpp %2, %2, %2 row_ror:2 row_mask:0xf bank_mask:0xf\n\tv_max_u32_dpp %3, %3, %3 row_ror:2 row_mask:0xf bank_mask:0xf\n\t"
                 "v_max_u32_dpp %0, %0, %0 row_ror:4 row_mask:0xf bank_mask:0xf\n\tv_max_u32_dpp %1, %1, %1 row_ror:4 row_mask:0xf bank_mask:0xf\n\t"
                 "v_max_u32_dpp %2, %2, %2 row_ror:4 row_mask:0xf bank_mask:0xf\n\tv_max_u32_dpp %3, %3, %3 row_ror:4 row_mask:0xf bank_mask:0xf\n\t"
                 "v_max_u32_dpp %0, %0, %0 row_ror:8 row_mask:0xf bank_mask:0xf\n\tv_max_u32_dpp %1, %1, %1 row_ror:8 row_mask:0xf bank_mask:0xf\n\t"
                 "v_max_u32_dpp %2, %2, %2 row_ror:8 row_mask:0xf bank_mask:0xf\n\tv_max_u32_dpp %3, %3, %3 row_ror:8 row_mask:0xf bank_mask:0xf"
                 : "=&v"(ya), "=&v"(yb), "=&v"(yc), "=&v"(yd) : "v"(xa), "v"(xb), "v"(xc), "v"(xd));
}
#define TK_LOAD(th_) (*(const GAS v4u*)(SC + (size_t)((th_) >> 3) * 2048 + ((th_) & 7) * 256 + c * 128 + l15 * 8))
#define TK_LOADSORT(P, sv_) \
    unsigned P##0, P##1, P##2, P##3, P##4, P##5, P##6, P##7; \
    { const v4u sv = (sv_); const unsigned nb = 127u - 8u * (unsigned)l15; \
      P##0 = h2key(sv.x << 16) | nb; P##1 = h2key(sv.x & 0xffff0000u) | (nb - 1u); P##2 = h2key(sv.y << 16) | (nb - 2u); P##3 = h2key(sv.y & 0xffff0000u) | (nb - 3u); \
      P##4 = h2key(sv.z << 16) | (nb - 4u); P##5 = h2key(sv.z & 0xffff0000u) | (nb - 5u); P##6 = h2key(sv.w << 16) | (nb - 6u); P##7 = h2key(sv.w & 0xffff0000u) | (nb - 7u); \
      CAS_(P##0, P##1); CAS_(P##2, P##3); CAS_(P##4, P##5); CAS_(P##6, P##7); CAS_(P##0, P##2); CAS_(P##1, P##3); CAS_(P##4, P##6); CAS_(P##5, P##7); CAS_(P##1, P##2); CAS_(P##5, P##6); CAS_(P##0, P##4); CAS_(P##3, P##7); \
      CAS_(P##1, P##5); CAS_(P##2, P##6); CAS_(P##1, P##4); CAS_(P##3, P##6); CAS_(P##2, P##4); CAS_(P##3, P##5); CAS_(P##3, P##4); }
#define TK_POP(P, m_) do { const bool pop_ = (P##0 == (m_)); P##0 = pop_ ? P##1 : P##0; P##1 = pop_ ? P##2 : P##1; P##2 = pop_ ? P##3 : P##2; P##3 = pop_ ? P##4 : P##3; \
      P##4 = pop_ ? P##5 : P##4; P##5 = pop_ ? P##6 : P##5; P##6 = pop_ ? P##7 : P##6; P##7 = pop_ ? 0u : P##7; } while (0)
__device__ __forceinline__ void topk_stage1x2(const v4u svA, const v4u svB, int l15, unsigned& resA, unsigned& resB) {
    TK_LOADSORT(ka, svA) TK_LOADSORT(kb, svB)
    unsigned ra = 0u, rb = 0u;
#pragma unroll
    for (int r = 0; r < 16; ++r) {
        unsigned ma, mb; row_umax16_x2(ka0, kb0, ma, mb);
        TK_POP(ka, ma); TK_POP(kb, mb);
        ra = (l15 == r) ? ma : ra; rb = (l15 == r) ? mb : rb;
    }
    resA = ra; resB = rb;
}
__device__ __forceinline__ void topk_stage1x4(const v4u svA, const v4u svB, const v4u svC, const v4u svD, int l15, unsigned& resA, unsigned& resB, unsigned& resC, unsigned& resD) {
    TK_LOADSORT(ka, svA) TK_LOADSORT(kb, svB) TK_LOADSORT(kc, svC) TK_LOADSORT(kd, svD)
    unsigned ra = 0u, rb = 0u, rc = 0u, rd = 0u;
#pragma unroll
    for (int r = 0; r < 16; ++r) {
        unsigned ma, mb, mc, md; row_umax16_x4(ka0, kb0, kc0, kd0, ma, mb, mc, md);
        TK_POP(ka, ma); TK_POP(kb, mb); TK_POP(kc, mc); TK_POP(kd, md);
        ra = (l15 == r) ? ma : ra; rb = (l15 == r) ? mb : rb; rc = (l15 == r) ? mc : rc; rd = (l15 == r) ? md : rd;
    }
    resA = ra; resB = rb; resC = rc; resD = rd;
}
__device__ __forceinline__ void topk_v2(Frame& F) {
    const unsigned short* SC = (const unsigned short*)(F.ws + WS_SC); int* IDX = (int*)(F.ws + WS_IDX); float* GATE = (float*)(F.ws + WS_GATE); float* GSU = (float*)(F.ws + WS_GSU);
    const float* SU = (const float*)(F.ws + WS_SU); const float* SV = (const float*)(F.ws + WS_SV);
    const int gw = F.vcu * NWAVES + F.wave, NGW = F.G * NWAVES, lane = F.lane, l15 = lane & 15, row = lane >> 4, c = row & 1, rbase = lane & 48;
    const unsigned pc0 = pair_code(l15), pc1 = pair_code(l15 + 16), pc2 = pair_code(l15 + 32), pc3 = pair_code(l15 + 48);
    const int src1 = l15 + 32 * (row & 1), src2 = src1 + 16;
    for (int it0 = gw * 32; it0 < NTOK * 2; it0 += NGW * 32) {
    v4u svA = TK_LOAD(4 * it0 + (row >> 1)), svB = TK_LOAD(4 * it0 + 2 + (row >> 1)), svC = TK_LOAD(4 * it0 + 4 + (row >> 1)), svD = TK_LOAD(4 * it0 + 6 + (row >> 1));
    for (int it = it0; it < it0 + 32; it += 2) {
        const int thb = 4 * it; const int thn = 4 * (it + 2 < it0 + 32 ? it + 2 : it);
        const v4u nvA = TK_LOAD(thn + (row >> 1)), nvB = TK_LOAD(thn + 2 + (row >> 1)), nvC = TK_LOAD(thn + 4 + (row >> 1)), nvD = TK_LOAD(thn + 6 + (row >> 1));
        unsigned resA, resB, resC, resD; topk_stage1x4(svA, svB, svC, svD, l15, resA, resB, resC, resD); svA = nvA; svB = nvB; svC = nvC; svD = nvD;
#define TK_S12(RA_, RB_, S1_, S2_) const unsigned S1_##a = (unsigned)__shfl((int)RA_, src1), S2_##a = (unsigned)__shfl((int)RA_, src2), S1_##b = (unsigned)__shfl((int)RB_, src1), S2_##b = (unsigned)__shfl((int)RB_, src2); \
        const unsigned S1_ = row < 2 ? S1_##a : S1_##b, S2_ = row < 2 ? S2_##a : S2_##b
        TK_S12(resA, resB, S1x, S2x); TK_S12(resC, resD, S1y, S2y);
#undef TK_S12
        unsigned c0, c1, c2, c3, d0, d1, d2, d3;
#define TK_CAND(CK, PC, S1_, S2_) do { const unsigned ka_ = (unsigned)__shfl((int)S1_, rbase + (int)((PC) >> 4 & 15u)), kb_ = (unsigned)__shfl((int)S2_, rbase + (int)((PC) & 15u)); \
            const float sm_ = hkey2f(ka_) + hkey2f(kb_); CK = (PC) == 0xFFu ? 0u : ((f2key(sm_) & ~0xFFu) | (255u - (PC))); } while (0)
        TK_CAND(c0, pc0, S1x, S2x); TK_CAND(c1, pc1, S1x, S2x); TK_CAND(c2, pc2, S1x, S2x); TK_CAND(c3, pc3, S1x, S2x);
        TK_CAND(d0, pc0, S1y, S2y); TK_CAND(d1, pc1, S1y, S2y); TK_CAND(d2, pc2, S1y, S2y); TK_CAND(d3, pc3, S1y, S2y);
#undef TK_CAND
        CAS_(c0, c1); CAS_(c2, c3); CAS_(c0, c2); CAS_(c1, c3); CAS_(c1, c2);
        CAS_(d0, d1); CAS_(d2, d3); CAS_(d0, d2); CAS_(d1, d3); CAS_(d1, d2);
        unsigned res2x = 0u, res2y = 0u;
#pragma unroll
        for (int r = 0; r < 16; ++r) {
            unsigned mx, my; row_umax16_x2(c0, d0, mx, my);
            const bool popx = (c0 == mx), popy = (d0 == my);
            c0 = popx ? c1 : c0; c1 = popx ? c2 : c1; c2 = popx ? c3 : c2; c3 = popx ? 0u : c3;
            d0 = popy ? d1 : d0; d1 = popy ? d2 : d1; d2 = popy ? d3 : d2; d3 = popy ? 0u : d3;
            res2x = (l15 == r) ? mx : res2x; res2y = (l15 == r) ? my : res2y;
        }
#define TK_FIN(RES2_, S1_, S2_, TH_) do { const unsigned code = 255u - ((RES2_) & 0xFFu); \
            const unsigned ka = (unsigned)__shfl((int)S1_, rbase + (int)(code >> 4 & 15u)), kb = (unsigned)__shfl((int)S2_, rbase + (int)(code & 15u)); \
            const float ts = hkey2f(ka) + hkey2f(kb); \
            const int e = (int)((127u - (ka & 0x7Fu)) * 128u + (127u - (kb & 0x7Fu))); \
            const float sve = SV[e], sue = SU[e];                                \
            const float tmax = __builtin_bit_cast(float, (unsigned)__shfl((int)__builtin_bit_cast(unsigned, ts), rbase)); \
            const float ex = __expf(ts - tmax); \
            const float sum = row_fsum16(ex); \
            const int th = (TH_) + row; \
            const size_t o = (size_t)(th >> 3) * NEXP_SEL + (th & 7) * 16 + l15; \
            IDX[o] = e; GATE[o] = ex / sum * sve; GSU[o] = sue; } while (0)
        TK_FIN(res2x, S1x, S2x, thb); TK_FIN(res2y, S1y, S2y, thb + 4);
#undef TK_FIN
    } }
}

constexpr int PG_TOK = 16;
constexpr int PG_IDX = 0, PG_HID = 4096, PG_SA = PG_HID + 8192, PG_TB = PG_SA + 64, PG_WB = PG_TB + 4096;
static_assert(PG_WB % 16 == 0 && PG_TB % 16 == 0 && NWAVES * PG_WB <= RING_BYTES, "gather LDS map");
typedef int pgv4i __attribute__((ext_vector_type(4))); typedef int pgv8i __attribute__((ext_vector_type(8)));
__device__ __forceinline__ pgv8i pg_cat8(const l2 a, const l2 b) { const pgv4i x = __builtin_bit_cast(pgv4i, a), y = __builtin_bit_cast(pgv4i, b); return __builtin_shufflevector(x, y, 0, 1, 2, 3, 4, 5, 6, 7); }
__device__ __forceinline__ pgv8i pg_fp4_to_fp8(const l2 a) { const pgv4i x = __builtin_bit_cast(pgv4i, a); pgv8i r;
#pragma unroll
    for (int q = 0; q < 4; ++q) { const unsigned w = (unsigned)x[q];
        r[2 * q] = (int)((w & 0x8E8E8E8Eu) | 0x40404040u);
        r[2 * q + 1] = (int)((((w >> 3) & 0x0E0E0E0Eu) | 0x40404040u) | ((w << 7) & 0x80808080u)); }
    return r; }
__device__ __forceinline__ void peer_sliced(Frame& F) {
    const unsigned char* U8T = F.ws + WS_U8; const unsigned char* V8T = F.ws + WS_V8; const unsigned char* X8 = F.ws + WS_X8;
    const float* SSQ = (const float*)(F.ws + WS_CTL) + CW_SSQ;
    const int* IDX = (const int*)(F.ws + WS_IDX); const float* GATE = (const float*)(F.ws + WS_GATE); const float* GSU = (const float*)(F.ws + WS_GSU); const float* gf = F.in[17];
    bf16* PO = (bf16*)(F.ws + WS_PO); const bf16* HB = (const bf16*)(F.ws + WS_HN2);
    const int gw = F.vcu * NWAVES + F.wave, NGW = F.G * NWAVES, lane = F.lane, m = lane & 15, g = lane >> 4;
    const int row8 = lane >> 3, piece = lane & 7;
    LAS unsigned char* wb = F.lds + F.wave * PG_WB;
    LAS unsigned short* idxs = (LAS unsigned short*)(wb + PG_IDX);
    LAS float* hid = (LAS float*)(wb + PG_HID);
    LAS float* sqp = hid + 64 + lane;
    LAS float* sai = (LAS float*)(wb + PG_SA);
    LAS unsigned char* tb = wb + PG_TB;
    const int p8 = m & 7; const unsigned bsh = 8u * (unsigned)(p8 & 3); const bool bhi = (p8 >> 2) != 0;
    constexpr size_t SLICE = (size_t)16384 * 128;
    const int usw = 16 * (piece ^ ((row8 >> 1) & 3));
    const int urd0 = m * 128 + 16 * ((2 * g) ^ ((m >> 1) & 7)), urd1 = m * 128 + 16 * ((2 * g + 1) ^ ((m >> 1) & 7));
    for (int blk = gw; blk < NTOK / PG_TOK; blk += NGW) {
        const int t0 = blk * PG_TOK;
#pragma unroll
        for (int k = 0; k < 32; ++k) { const int id = lane + 64 * k;
            idxs[16 * (lane & 7) + (lane >> 3) + 128 * (k >> 1) + 8 * (k & 1)] = (unsigned short)IDX[(size_t)t0 * NEXP_SEL + id]; }
#pragma unroll
        for (int k = 0; k < 8; ++k) *(LAS f32x4*)(hid + 4 * (lane + 64 * k)) = (f32x4){0.f, 0.f, 0.f, 0.f};
        LDS_WAIT(); asm volatile("" ::: "memory");
        v4u ab[2][16]; l2 xs[2][4];
#define PGU_ISSUE_AT(UP_, XP_, i_, buf_) do { _Pragma("unroll") for (int k = 0; k < 16; ++k) { const unsigned e = idxs[(i_) * 128 + 16 * row8 + k]; \
                ab[buf_][k] = *(const GAS v4u*)((UP_) + (size_t)(e * 128u + (unsigned)(usw ^ ((k & 1) ? 64 : 0)))); } \
                _Pragma("unroll") for (int q = 0; q < 4; ++q) xs[buf_][q] = *(const GAS l2*)((XP_) + (size_t)(unsigned)(64 * g + (i_) * DM + 16 * q)); } while (0)
        PGU_ISSUE_AT(U8T, X8 + (size_t)t0 * DM, 0, 0);
        for (int p = 0; p < 4; ++p) {
            const unsigned char* Up = U8T + (size_t)p * SLICE;
            const unsigned char* Xp = X8 + (size_t)t0 * DM + 256 * p;
#define PGU_WR(i_, cur_, rb_, S_) do { _Pragma("unroll") for (int q4 = 0; q4 < 4; ++q4) *(LAS v4u*)(tb + 1024 * q4 + 16 * lane) = ab[cur_][4 * (rb_) + q4]; \
                S_##0 = *(const LAS l2*)(tb + urd0); S_##1 = *(const LAS l2*)(tb + urd1); S_##2 = *(const LAS l2*)(tb + 2048 + urd0); S_##3 = *(const LAS l2*)(tb + 2048 + urd1); \
                S_##c0 = *(const LAS f32x4*)(hid + (i_) * 128 + 32 * (rb_) + 4 * g); S_##c1 = *(const LAS f32x4*)(hid + (i_) * 128 + 32 * (rb_) + 16 + 4 * g); } while (0)
#define PGU_MF(i_, cur_, rb_, S_) do { f32x4 acc0 = S_##c0, acc1 = S_##c1; \
                const pgv8i x0_ = pg_cat8(xs[cur_][0], xs[cur_][1]), x1_ = pg_cat8(xs[cur_][2], xs[cur_][3]); \
                acc0 = __builtin_amdgcn_mfma_scale_f32_16x16x128_f8f6f4(pg_fp4_to_fp8(S_##0), x0_, acc0, 1, 1, 0, 0x7f7f7f7f, 0, 0x7f7f7f7f); acc1 = __builtin_amdgcn_mfma_scale_f32_16x16x128_f8f6f4(pg_fp4_to_fp8(S_##2), x0_, acc1, 1, 1, 0, 0x7f7f7f7f, 0, 0x7f7f7f7f); \
                acc0 = __builtin_amdgcn_mfma_scale_f32_16x16x128_f8f6f4(pg_fp4_to_fp8(S_##1), x1_, acc0, 1, 1, 0, 0x7f7f7f7f, 0, 0x7f7f7f7f); acc1 = __builtin_amdgcn_mfma_scale_f32_16x16x128_f8f6f4(pg_fp4_to_fp8(S_##3), x1_, acc1, 1, 1, 0, 0x7f7f7f7f, 0, 0x7f7f7f7f); \
                LAS float* hp_ = hid + (i_) * 128 + 32 * (rb_) + 4 * g; \
                asm volatile("s_nop 7\n\ts_mov_b32 exec_lo, 0x10001\n\ts_mov_b32 exec_hi, 0x10001\n\t" \
                             "ds_write_b128 %0, %1\n\tds_write_b128 %0, %2 offset:64\n\t" \
                             "s_mov_b64 exec, -1" \
                             :: "v"(hp_), "v"(acc0), "v"(acc1) : "memory"); } while (0)
#define PGU_BODY(i_, cur_, nxt_) do { { const bool wr_ = (i_) + 1 == PG_TOK; const int nx_ = wr_ ? 0 : (i_) + 1; const unsigned char* un_ = wr_ ? Up + SLICE : Up; const unsigned char* xn_ = wr_ ? Xp + 256 : Xp; PGU_ISSUE_AT(un_, xn_, nx_, nxt_); } SCHED_FENCE(); \
                l2 fa0, fa1, fa2, fa3, fb0, fb1, fb2, fb3; f32x4 fac0, fac1, fbc0, fbc1; \
                PGU_WR(i_, cur_, 0, fa); PGU_WR(i_, cur_, 1, fb); SCHED_FENCE(); \
                PGU_MF(i_, cur_, 0, fa); SCHED_FENCE(); PGU_WR(i_, cur_, 2, fa); SCHED_FENCE(); \
                PGU_MF(i_, cur_, 1, fb); SCHED_FENCE(); PGU_WR(i_, cur_, 3, fb); SCHED_FENCE(); \
                PGU_MF(i_, cur_, 2, fa); SCHED_FENCE(); PGU_MF(i_, cur_, 3, fb); SCHED_FENCE(); } while (0)
            for (int i2 = 0; i2 < PG_TOK; i2 += 2) { PGU_BODY(i2, 0, 1); PGU_BODY(i2 + 1, 1, 0); }
#undef PGU_BODY
#undef PGU_WR
#undef PGU_MF
            LDS_WAIT(); asm volatile("" ::: "memory");
        }
        { f32x2_t suv[16], gvv[16], hv[16];
          float sxl = SSQ[t0 + (lane & 15)]; sxl = 1.f / sqrtf(sxl * (1.f / DM) + EPS);
#pragma unroll
          for (int i = 0; i < PG_TOK; ++i) { suv[i] = *(const GAS f32x2_t*)(GSU + (size_t)(t0 + i) * NEXP_SEL + 2 * lane); gvv[i] = *(const GAS f32x2_t*)(GATE + (size_t)(t0 + i) * NEXP_SEL + 2 * lane); }
#pragma unroll
          for (int i = 0; i < PG_TOK; ++i) hv[i] = *(const LAS f32x2_t*)(hid + i * 128 + 2 * lane);
          float w0[16], w1[16], am[16];
#pragma unroll
          for (int i = 0; i < PG_TOK; ++i) { const float sx = __builtin_bit_cast(float, __builtin_amdgcn_readlane(__builtin_bit_cast(int, sxl), i));
              w0[i] = gelu_as(hv[i].x * suv[i].x * sx) * gvv[i].x; w1[i] = gelu_as(hv[i].y * suv[i].y * sx) * gvv[i].y; am[i] = fmaxf(fabsf(w0[i]), fabsf(w1[i])); }
#pragma unroll
          for (int o = 1; o < 64; o <<= 1)
#pragma unroll
              for (int i = 0; i < PG_TOK; ++i) am[i] = fmaxf(am[i], __shfl_xor(am[i], o));
          LDS_WAIT(); asm volatile("" ::: "memory");
#pragma unroll
          for (int i = 0; i < PG_TOK; ++i) { const float sa = am[i] > 0.f ? 224.f / am[i] : 1.f;
              const int pk = __builtin_amdgcn_cvt_pk_fp8_f32(w0[i] * sa, w1[i] * sa, 0, false);
              LAS unsigned char* wq = (LAS unsigned char*)(hid + i * 128) + 32 * (lane & 3) + (lane >> 2);
              wq[0] = (unsigned char)pk; wq[16] = (unsigned char)(pk >> 8);
              if (lane == 0) sai[i] = am[i] > 0.f ? am[i] * (1.f / 224.f) : 1.f; }
        }
        LDS_WAIT(); asm volatile("" ::: "memory");
        v4u va[2][16];
#define PGV_ISSUE_AT(VP_, i_, buf_) do { _Pragma("unroll") for (int k = 0; k < 16; ++k) { const unsigned e = idxs[(i_) * 128 + 16 * row8 + k]; va[buf_][k] = *(const GAS v4u*)((VP_) + (size_t)(e * 128u + 16u * (unsigned)piece)); } } while (0)
        PGV_ISSUE_AT(V8T, 0, 0);
        for (int p = 0; p < 8; ++p) {
            const unsigned char* Vp = V8T + (size_t)p * SLICE;
#define PGV_BODY(i_, cur_, nxt_) do { { const bool wr_ = (i_) + 1 == PG_TOK; const int nx_ = wr_ ? 0 : (i_) + 1; const unsigned char* vn_ = wr_ ? Vp + SLICE : Vp; PGV_ISSUE_AT(vn_, nx_, nxt_); } \
                const v4u w4_ = *(const LAS v4u*)((LAS unsigned char*)(hid + (i_) * 128) + 16 * row8); \
                const unsigned ww[4] = {w4_.x, w4_.y, w4_.z, w4_.w}; \
                SCHED_FENCE(); f32x4 cl = (f32x4){0.f, 0.f, 0.f, 0.f}, chh = (f32x4){0.f, 0.f, 0.f, 0.f}; \
                _Pragma("unroll") for (int k = 0; k < 16; ++k) { \
                    const unsigned a8 = ((ww[k >> 2] >> (8 * (k & 3))) & 0xffu) << bsh; const long bop = (long)(bhi ? ((unsigned long long)a8 << 32) : (unsigned long long)a8); \
                    const long alo = (long)(((unsigned long long)va[cur_][k].y << 32) | (unsigned long long)va[cur_][k].x), ahi = (long)(((unsigned long long)va[cur_][k].w << 32) | (unsigned long long)va[cur_][k].z); \
                    cl = __builtin_amdgcn_mfma_f32_16x16x32_fp8_fp8(alo, bop, cl, 0, 0, 0); chh = __builtin_amdgcn_mfma_f32_16x16x32_fp8_fp8(ahi, bop, chh, 0, 0, 0); } \
                SCHED_FENCE(); \
                _Pragma("unroll") for (int i4 = 0; i4 < 4; ++i4) { \
                    cl[i4] += __shfl(cl[i4], (lane + 40) & 63); chh[i4] += __shfl(chh[i4], (lane + 40) & 63); } \
                { const float isa = sai[i_]; LAS unsigned short* ob = (LAS unsigned short*)(tb) + 64 * g + m;         \
                  if (m < 8 && g < 2) { _Pragma("unroll") for (int i4 = 0; i4 < 4; ++i4) { ob[16 * i4] = (unsigned short)f2bf(cl[i4] * isa); ob[16 * i4 + 8] = (unsigned short)f2bf(chh[i4] * isa); } } \
                  const v4u ov = *(const LAS v4u*)(tb + 16 * (lane & 15)); \
                  if (lane < 16) *(GAS v4u*)(PO + (size_t)(t0 + (i_)) * DM + 128 * p + 8 * lane) = ov; } } while (0)
            for (int i2 = 0; i2 < PG_TOK; i2 += 2) { PGV_BODY(i2, 0, 1); PGV_BODY(i2 + 1, 1, 0); }
#undef PGV_BODY
        }
        LDS_WAIT(); asm volatile("" ::: "memory");
        VM_WAIT();
#undef PGU_ISSUE_AT
#undef PGV_ISSUE_AT
        { f32x4 ggv[4];
#pragma unroll
          for (int j = 0; j < 4; ++j) ggv[j] = *((const GAS f32x4*)gf + lane + 64 * j);
          v2u paX[4], pbX[4], haX[4], hbX[4], paY[4], pbY[4], haY[4], hbY[4];
#define PGF_LOAD(S_, i_) do { const GAS v2u* prA = (const GAS v2u*)(PO + (size_t)(t0 + (i_)) * DM) + lane; const GAS v2u* prB = prA + DM / 4; \
              const GAS v2u* hbA = (const GAS v2u*)(HB + (size_t)(t0 + (i_)) * DM) + lane; const GAS v2u* hbB = hbA + DM / 4; \
              _Pragma("unroll") for (int j = 0; j < 4; ++j) { pa##S_[j] = prA[64 * j]; ha##S_[j] = hbA[64 * j]; pb##S_[j] = prB[64 * j]; hb##S_[j] = hbB[64 * j]; } } while (0)
#define PGF_BODY(S_, i_) do { GAS f32x4* hrA = (GAS f32x4*)(F.out + (size_t)(t0 + (i_)) * DM) + lane; GAS f32x4* hrB = hrA + DM / 4; \
              f32x4 ya[4], yb[4]; float sa = 0.f, sb = 0.f; \
              _Pragma("unroll") for (int j = 0; j < 4; ++j) { \
                  ya[j] = (f32x4){bflo(ha##S_[j].x), bfhi(ha##S_[j].x), bflo(ha##S_[j].y), bfhi(ha##S_[j].y)} + (f32x4){bflo(pa##S_[j].x), bfhi(pa##S_[j].x), bflo(pa##S_[j].y), bfhi(pa##S_[j].y)}; \
                  yb[j] = (f32x4){bflo(hb##S_[j].x), bfhi(hb##S_[j].x), bflo(hb##S_[j].y), bfhi(hb##S_[j].y)} + (f32x4){bflo(pb##S_[j].x), bfhi(pb##S_[j].x), bflo(pb##S_[j].y), bfhi(pb##S_[j].y)}; \
                  sa += (ya[j].x * ya[j].x + ya[j].y * ya[j].y) + (ya[j].z * ya[j].z + ya[j].w * ya[j].w); sb += (yb[j].x * yb[j].x + yb[j].y * yb[j].y) + (yb[j].z * yb[j].z + yb[j].w * yb[j].w); } \
              _Pragma("unroll") for (int o = 1; o < 64; o <<= 1) { sa += __shfl_xor(sa, o); sb += __shfl_xor(sb, o); } \
              const float ra = 1.f / sqrtf(sa * (1.f / DM) + EPS), rb = 1.f / sqrtf(sb * (1.f / DM) + EPS); \
              _Pragma("unroll") for (int j = 0; j < 4; ++j) { hrA[64 * j] = ya[j] * ra * ggv[j]; hrB[64 * j] = yb[j] * rb * ggv[j]; } } while (0)
          PGF_LOAD(X, 0);
          for (int i = 0; i < PG_TOK; i += 4) { PGF_LOAD(Y, i + 2); PGF_BODY(X, i); PGF_LOAD(X, (i + 4) & (PG_TOK - 1)); PGF_BODY(Y, i + 2); }
#undef PGF_LOAD
#undef PGF_BODY
        }
        LDS_WAIT(); asm volatile("" ::: "memory");
    }
}

struct Args { const float* in[18]; float* out; unsigned char* ws; int ph_lo, ph_hi; };
__global__ void __launch_bounds__(NWAVES * 64, 2) hymba_fwd(Args args) {
    extern __shared__ __attribute__((aligned(16))) unsigned char lds[];
    Frame F;
    F.lds = (LAS unsigned char*)lds;
    F.MISC = (volatile LAS unsigned*)(F.lds + MISC_OFF);
    F.tid = threadIdx.x; F.lane = F.tid & 63; F.wave = __builtin_amdgcn_readfirstlane(F.tid >> 6);
    F.G = gridDim.x; { const int bx = blockIdx.x; F.vcu = (F.G % 8 == 0) ? (bx % 8) * (F.G / 8) + bx / 8 : bx; }
#pragma unroll
    for (int i = 0; i < 18; ++i) F.in[i] = args.in[i];
    F.out = args.out; F.ws = args.ws;
    for (int u = F.tid; u < (LDS_BYTES - LDSCTL_OFF) / 4; u += NWAVES * 64) ((LAS unsigned*)(F.lds + LDSCTL_OFF))[u] = 0u;
    __syncthreads();
    const int lo = args.ph_lo, hi = args.ph_hi;
    const bool multi = (hi - lo) > 1;
    XcdBarrier bar; bar.bar = (unsigned*)(F.ws + WS_CTL) + CW_BAR; bar.x = 0; bar.st = nullptr;
    if (multi) bar = xcd_barrier_post((unsigned*)(F.ws + WS_CTL) + CW_BAR, F.MISC + 8);
#define IN(k) (lo <= (k) && (k) < hi)
#define SEAM(k) do { if (IN(k) && IN((k) + 1)) xcd_barrier(bar); } while (0)

    if (IN(0)) { p0_prologue(F); } SEAM(0);
    if (IN(1)) {
        pg8::Gemm g{(const pg8::bf16_t*)(F.ws + WS_HN), (const pg8::bf16_t*)(F.ws + WS_WIN), NTOK, INW, DM}; pg8::StaticOrder S; S.init(NTOK, INW, F.G, (int)blockIdx.x);
        pg8::EpiProj E{(pg8::bf16_t*)(F.ws + WS_PROJ), INW, 2, QSCALE};
        pg8::gemm_phase<pg8::EpiProj, pg8::StaticOrder, PG8_ALIGN, PG8_SP2>(F.lds + RING_OFF, g, S, E);
    } SEAM(1);
    if (IN(2)) { hgrn_mfma(F); }
    if (IN(3)) { quant_drain(F); attn_mfma(F, 0); }
    if (IN(3) && IN(4)) xcd_barrier(bar);
    if (IN(4)) {
        pg8::Gemm g{(const pg8::bf16_t*)(F.ws + WS_HN), (const pg8::bf16_t*)(F.ws + WS_WOUT), NTOK, DM, DM}; pg8::StaticOrder S; S.init(NTOK, DM, F.G, (int)blockIdx.x);
        pg8::EpiMix E{DM, F.in[0], F.in[12], (pg8::bf16_t*)(F.ws + WS_HN2), F.ws + WS_X8, (float*)(F.ws + WS_CTL) + CW_SSQ};
        pg8::gemm_phase<pg8::EpiMix, pg8::StaticOrder, PG8_ALIGN, PG8_SP2>(F.lds + RING_OFF, g, S, E);
    }
    if (IN(4) && IN(6)) xcd_barrier(bar);
    if (IN(6)) {
        pg8::Gemm g{(const pg8::bf16_t*)(F.ws + WS_HN2), (const pg8::bf16_t*)(F.ws + WS_W2), NTOK, 2048, DM}; pg8::StaticOrder S; S.init(NTOK, 2048, F.G, (int)blockIdx.x);
        pg8::EpiScaleRow E{(_Float16*)(F.ws + WS_SC), 2048, (const float*)(F.ws + WS_CTL) + CW_SSQ, 1.f / DM, EPS};
        pg8::gemm_phase<pg8::EpiScaleRow, pg8::StaticOrder, PG8_ALIGN, PG8_SP2>(F.lds + RING_OFF, g, S, E);
    } SEAM(6);
    if (IN(7)) { topk_v2(F); }
    if (IN(7) && IN(8)) { VM_WAIT(); }
    if (IN(8)) { peer_sliced(F); }
#undef IN
#undef SEAM
}

extern "C" void kernel_launch(void* const* d_in, const int* in_sizes, int n_in, void* d_out, int out_size, void* d_ws, size_t ws_size, hipStream_t stream) {
    static int grid = 0;
    if (grid == 0) {
        if (n_in != 18 || in_sizes[0] != NTOK * DM || out_size != NTOK * DM || ws_size < WS_END) { fprintf(stderr, "kernel_launch: unexpected shapes (n_in %d, in0 %d, out %d, ws %zu); nothing launched\n", n_in, n_in > 0 ? in_sizes[0] : -1, out_size, ws_size); grid = -1; return; }
        int dev = 0, cus = 0, per_cu = 0;
        if (hipGetDevice(&dev) != hipSuccess || hipDeviceGetAttribute(&cus, hipDeviceAttributeMultiprocessorCount, dev) != hipSuccess) { grid = -1; return; }
        if (hipFuncSetAttribute((const void*)hymba_fwd, hipFuncAttributeMaxDynamicSharedMemorySize, LDS_BYTES) != hipSuccess) { fprintf(stderr, "kernel_launch: hipFuncSetAttribute failed\n"); grid = -1; return; }
        if (hipOccupancyMaxActiveBlocksPerMultiprocessor(&per_cu, (const void*)hymba_fwd, NWAVES * 64, LDS_BYTES) != hipSuccess || per_cu < 1)
            fprintf(stderr, "kernel_launch: note: occupancy query reports %d workgroups per CU\n", per_cu);
        (void)hipGetLastError();
        grid = cus;
    }
    if (grid < 0) return;
    if (hipMemsetAsync((char*)d_ws + WS_CTL, 0, CTL_ZERO_BYTES, stream) != hipSuccess) return;
    Args a{};
    for (int i = 0; i < 18; ++i) a.in[i] = (const float*)d_in[i];
    a.out = (float*)d_out; a.ws = (unsigned char*)d_ws; a.ph_lo = 0; a.ph_hi = 9;
    hipLaunchKernelGGL(hymba_fwd, dim3(grid), dim3(NWAVES * 64), LDS_BYTES, stream, a);
}
```

```cpp
#include <hip/hip_runtime.h>
#include <cstdio>
#include <cstdint>
#include <cmath>
namespace pg8 {
#define PG8_LAS __attribute__((address_space(3)))
typedef unsigned short bf16_t;
typedef short bf16x8 __attribute__((ext_vector_type(8)));
typedef float f32x4 __attribute__((ext_vector_type(4)));
typedef unsigned u32x4 __attribute__((ext_vector_type(4)));
constexpr int BM = 256, BK = 64, HALF = 128, HTB = HALF * BK * 2  , STAGE_BYTES = 8 * HTB, NXCD = 8, WGM = 8;

__host__ __device__ __forceinline__ int lds_byte(int r, int c) { const int st = (r >> 4) * 2 + (c >> 5), rr = r & 15, cc = c & 31, ob = rr * 64 + cc * 2; return st * 1024 + (ob ^ (((ob >> 9) & 1) << 5)); }
__host__ __device__ __forceinline__ void stage_rc(int b, int& R, int& C) { const int st = b / 1024, sb = b % 1024, swz = sb ^ (((sb >> 9) & 1) << 5); R = (st >> 1) * 16 + swz / 64; C = (st & 1) * 32 + (swz % 64) / 2; }
__host__ __device__ __forceinline__ int perm32(int rho) { const int n = rho >> 4, i = rho & 15; return 8 * (i >> 2) + 4 * n + (i & 3); }

struct Unit { int pm, pn; };
struct Gemm { const bf16_t* A; const bf16_t* Bt; int M, N, K; };

struct StaticOrder {
    int nM, nN, nwg, G, c;
    __host__ __device__ void init(int M, int N, int G_, int c_) { nM = M / BM; nN = N / BM; nwg = nM * nN; G = G_; c = c_; }
    __host__ __device__ bool next(int i, Unit& u) const {
        const long L = (long)i * G + c; if (L >= nwg) return false;
        int wgid = (int)L; { const int q = nwg / NXCD, r = nwg % NXCD, xcd = wgid % NXCD, off = wgid / NXCD; wgid = (xcd < r ? xcd * (q + 1) : r * (q + 1) + (xcd - r) * q) + off; }
        const int nig = WGM * nN, gid = wgid / nig, fm = gid * WGM, gsz = (nM - fm) < WGM ? (nM - fm) : WGM;
        u.pm = fm + ((wgid % nig) % gsz); u.pn = (wgid % nig) / gsz; return true;
    }
    __device__ __forceinline__ void a_ready(const Unit&) const {}
    __device__ __forceinline__ void done(const Unit&) const {}
};
__device__ __forceinline__ unsigned cvt_pk_bf16(float lo, float hi) { unsigned r; asm volatile("v_cvt_pk_bf16_f32 %0, %1, %2" : "=v"(r) : "v"(lo), "v"(hi)); return r; }
typedef float f32x2 __attribute__((ext_vector_type(2)));
__device__ __forceinline__ f32x2 gelu_pk(f32x2 v) {
    const f32x2 av = __builtin_elementwise_abs(v), d = av * 0.2316418882f + 1.0f;
    f32x2 t; t.x = __builtin_amdgcn_rcpf(d.x); t.y = __builtin_amdgcn_rcpf(d.y);
    f32x2 q = t * 0.5307027145f + (-0.7265760135f); q = q * t + 0.7107068705f; q = q * t + (-0.142248368f); q = q * t + 0.127414796f; q = q * t;
    const f32x2 s = (v * v) * (-0.72134752044f);
    f32x2 e; e.x = __builtin_amdgcn_exp2f(s.x); e.y = __builtin_amdgcn_exp2f(s.y);
    const f32x2 m = v * (q * e), r = v - m;
    f32x2 o; o.x = v.x < 0.f ? m.x : r.x; o.y = v.y < 0.f ? m.y : r.y; return o;
}
struct EpiProj {
    static constexpr bool PERM = true, AFTER_DRAIN = false;
    bf16_t* O; int ldc; int qtiles; float qscale;
    __device__ __forceinline__ void operator()(const f32x4 (&acc)[2][2][4][2], const Unit& u, int wr, int wc, int fr, int fq) const {
        const int row0 = u.pm * BM + wr * 64 + fr, col0 = u.pn * BM + wc * 32 + 8 * fq;
        const float sc = (u.pn < qtiles) ? qscale : 1.f;
#pragma unroll
        for (int ai = 0; ai < 2; ++ai)
#pragma unroll
            for (int m = 0; m < 4; ++m) { bf16_t* rowp = O + (size_t)(row0 + ai * HALF + m * 16) * ldc + col0;
#pragma unroll
                for (int bj = 0; bj < 2; ++bj) { const f32x4 v0 = acc[ai][bj][m][0] * sc, v1 = acc[ai][bj][m][1] * sc;
                    u32x4 w; w.x = cvt_pk_bf16(v0[0], v0[1]); w.y = cvt_pk_bf16(v0[2], v0[3]); w.z = cvt_pk_bf16(v1[0], v1[1]); w.w = cvt_pk_bf16(v1[2], v1[3]);
                    *(u32x4*)(rowp + bj * HALF) = w; } }
    }
};
struct EpiF32Res {
    static constexpr bool PERM = false, AFTER_DRAIN = false;
    float* C; int ldc; const float* res;
    __device__ __forceinline__ void operator()(const f32x4 (&acc)[2][2][4][2], const Unit& u, int wr, int wc, int fr, int fq) const {
        const int row0 = u.pm * BM + wr * 64 + fr, col0 = u.pn * BM + wc * 32 + 4 * fq;
#pragma unroll
        for (int ai = 0; ai < 2; ++ai)
#pragma unroll
            for (int m = 0; m < 4; ++m) { const size_t off = (size_t)(row0 + ai * HALF + m * 16) * ldc + col0;
#pragma unroll
                for (int bj = 0; bj < 2; ++bj)
#pragma unroll
                    for (int n = 0; n < 2; ++n) { f32x4 o = acc[ai][bj][m][n]; if (res) o = o + *(const f32x4*)(res + off + bj * HALF + n * 16);
                        *(f32x4*)(C + off + bj * HALF + n * 16) = o; } }
    }
};

struct EpiMix {
    static constexpr bool PERM = true, AFTER_DRAIN = false;
    int ldc; const float* res; const float* g2; bf16_t* HB; unsigned char* XB; float* ssq;
    __device__ __forceinline__ void operator()(const f32x4 (&acc)[2][2][4][2], const Unit& u, int wr, int wc, int fr, int fq) const {
        const int row0 = u.pm * BM + wr * 64 + fr, col0 = u.pn * BM + wc * 32 + 8 * fq;
        f32x4 gv[2][2];
#pragma unroll
        for (int bj = 0; bj < 2; ++bj)
#pragma unroll
            for (int n = 0; n < 2; ++n) gv[bj][n] = *(const f32x4*)(g2 + col0 + bj * HALF + 4 * n);
#pragma unroll
        for (int ai = 0; ai < 2; ++ai)
#pragma unroll
            for (int m = 0; m < 4; ++m) { const int row = row0 + ai * HALF + m * 16; const size_t off = (size_t)row * ldc + col0; float sq = 0.f;
#pragma unroll
                for (int bj = 0; bj < 2; ++bj) {
                    const f32x4 h0 = acc[ai][bj][m][0] + *(const f32x4*)(res + off + bj * HALF), h1 = acc[ai][bj][m][1] + *(const f32x4*)(res + off + bj * HALF + 4);
                    sq += (h0[0] * h0[0] + h0[1] * h0[1]) + (h0[2] * h0[2] + h0[3] * h0[3]) + (h1[0] * h1[0] + h1[1] * h1[1]) + (h1[2] * h1[2] + h1[3] * h1[3]);
                    u32x4 w; w.x = cvt_pk_bf16(h0[0], h0[1]); w.y = cvt_pk_bf16(h0[2], h0[3]); w.z = cvt_pk_bf16(h1[0], h1[1]); w.w = cvt_pk_bf16(h1[2], h1[3]);
                    *(u32x4*)(HB + off + bj * HALF) = w;
                    const f32x4 g0 = h0 * gv[bj][0], g1 = h1 * gv[bj][1];
                    int p0 = __builtin_amdgcn_cvt_pk_bf8_f32(g0[0], g0[1], 0, false); p0 = __builtin_amdgcn_cvt_pk_bf8_f32(g0[2], g0[3], p0, true);
                    int p1 = __builtin_amdgcn_cvt_pk_bf8_f32(g1[0], g1[1], 0, false); p1 = __builtin_amdgcn_cvt_pk_bf8_f32(g1[2], g1[3], p1, true);
                    typedef unsigned u32x2 __attribute__((ext_vector_type(2)));
                    *(u32x2*)(XB + off + bj * HALF) = (u32x2){(unsigned)p0, (unsigned)p1}; }
                sq += __shfl_xor(sq, 16); sq += __shfl_xor(sq, 32);
                if (fq == 0) atomicAdd(ssq + row, sq); }
    }
};
struct EpiScaleRow {
    static constexpr bool PERM = true, AFTER_DRAIN = false;
    _Float16* C; int ldc; const float* ssq; float invk, eps;
    __device__ __forceinline__ void operator()(const f32x4 (&acc)[2][2][4][2], const Unit& u, int wr, int wc, int fr, int fq) const {
        typedef _Float16 h2 __attribute__((ext_vector_type(2)));
        const int row0 = u.pm * BM + wr * 64 + fr, col0 = u.pn * BM + wc * 32 + 8 * fq;
#pragma unroll
        for (int ai = 0; ai < 2; ++ai)
#pragma unroll
            for (int m = 0; m < 4; ++m) { const int row = row0 + ai * HALF + m * 16; const size_t off = (size_t)row * ldc + col0; const float rs = 1.f / sqrtf(ssq[row] * invk + eps);
#pragma unroll
                for (int bj = 0; bj < 2; ++bj) { const f32x4 v0 = acc[ai][bj][m][0] * rs, v1 = acc[ai][bj][m][1] * rs;
                    const h2 p0 = {(_Float16)v0[0], (_Float16)v0[1]}, p1 = {(_Float16)v0[2], (_Float16)v0[3]}, p2 = {(_Float16)v1[0], (_Float16)v1[1]}, p3 = {(_Float16)v1[2], (_Float16)v1[3]};
                    u32x4 w; w.x = __builtin_bit_cast(unsigned, p0); w.y = __builtin_bit_cast(unsigned, p1); w.z = __builtin_bit_cast(unsigned, p2); w.w = __builtin_bit_cast(unsigned, p3);
                    *(u32x4*)(C + off + bj * HALF) = w; } }
    }
};
template <class Epi, class Sched, bool ALIGN_EPI = false, bool SP2 = false>
__device__ __forceinline__ void gemm_phase(PG8_LAS unsigned char* lds, const Gemm g, const Sched& S, const Epi& E) {
    const int tid = threadIdx.x, wid = __builtin_amdgcn_readfirstlane(tid >> 6), lane = tid & 63, wr = wid >> 2, wc = wid & 3, fr = lane & 15, fq = lane >> 4;
    const int K = g.K, nt = K / BK;
    unsigned voffA[2], voffB[2];
#pragma unroll
    for (int i = 0; i < 2; ++i) { int R, C; stage_rc(tid * 16 + i * 8192, R, C); const int Rb = Epi::PERM ? ((R & ~31) + perm32(R & 31)) : R;
        voffA[i] = (unsigned)(R * K + C) * 2u; voffB[i] = (unsigned)(Rb * K + C) * 2u; }
    const size_t kstep = (size_t)(BK * 2);
    const size_t hstep = (size_t)HALF * K * 2;
    const size_t tstep = 2 * hstep;
    const unsigned ldsw = (unsigned)wid * 1024u;
    const int aoff = lds_byte(wr * 64 + fr, fq * 8), boff = lds_byte(wc * 32 + fr, fq * 8);
#define PG8_SA(b, h) (((b) * 2 + (h)) * HTB)
#define PG8_SB(b, h) ((4 + (b) * 2 + (h)) * HTB)
#define PG8_STAGE(bufoff, gbase, voff) do { _Pragma("unroll") for (int _i = 0; _i < 2; ++_i) \
        __builtin_amdgcn_global_load_lds((const unsigned*)((const char*)(gbase) + (voff)[_i]), (PG8_LAS unsigned*)(lds + (bufoff) + ldsw + _i * 8192), 16, 0, 0); } while (0)
#define PG8_LDA(dst, b, h) do { _Pragma("unroll") for (int m = 0; m < 4; ++m) _Pragma("unroll") for (int k = 0; k < 2; ++k) dst[m][k] = *(const PG8_LAS bf16x8*)(lds + PG8_SA(b, h) + aoff + m * 2048 + k * 1024); } while (0)
#define PG8_LDB(dst, b, h) do { _Pragma("unroll") for (int n = 0; n < 2; ++n) _Pragma("unroll") for (int k = 0; k < 2; ++k) dst[n][k] = *(const PG8_LAS bf16x8*)(lds + PG8_SB(b, h) + boff + n * 2048 + k * 1024); } while (0)
#define PG8_MMA(ai, bj, At, Bt) do { __builtin_amdgcn_s_setprio(1); _Pragma("unroll") for (int m = 0; m < 4; ++m) _Pragma("unroll") for (int n = 0; n < 2; ++n) _Pragma("unroll") for (int k = 0; k < 2; ++k) \
        acc[ai][bj][m][n] = __builtin_amdgcn_mfma_f32_16x16x32_bf16(Bt[n][k], At[m][k], acc[ai][bj][m][n], 0, 0, 0); __builtin_amdgcn_s_setprio(0); } while (0)
#define PG8_WAIT_V(n) asm volatile("s_waitcnt vmcnt(" #n ")" ::: "memory")
#define PG8_WAIT_L(n) asm volatile("s_waitcnt lgkmcnt(" #n ")" ::: "memory")
#define PG8_BAR __builtin_amdgcn_s_barrier()
#define PG8_SCHED __builtin_amdgcn_sched_barrier(0)
    Unit cur, nxt; int ui = 0;
    if (!S.next(0, cur)) return;
    f32x4 acc[2][2][4][2];
#pragma unroll
    for (int a = 0; a < 2; ++a)
#pragma unroll
        for (int b = 0; b < 2; ++b)
#pragma unroll
            for (int m = 0; m < 4; ++m)
#pragma unroll
                for (int n = 0; n < 2; ++n) acc[a][b][m][n] = (f32x4){0.f, 0.f, 0.f, 0.f};
    bf16x8 At[4][2], B0[2][2], B1[2][2];
    const char* cA = (const char*)g.A + (size_t)cur.pm * tstep; const char* cB = (const char*)g.Bt + (size_t)cur.pn * tstep;
    S.a_ready(cur);
    if constexpr (SP2) {
        PG8_STAGE(PG8_SB(0, 0), cB, voffB); PG8_STAGE(PG8_SB(0, 1), cB + hstep, voffB); PG8_STAGE(PG8_SA(0, 0), cA, voffA); PG8_STAGE(PG8_SA(0, 1), cA + hstep, voffA);
        if (wr == 1) PG8_BAR;
        PG8_WAIT_V(2); PG8_BAR;
        PG8_STAGE(PG8_SB(1, 0), cB + kstep, voffB); PG8_STAGE(PG8_SA(1, 0), cA + kstep, voffA); PG8_STAGE(PG8_SB(1, 1), cB + hstep + kstep, voffB);
        PG8_WAIT_V(6); PG8_BAR;
    } else {
        PG8_STAGE(PG8_SB(0, 0), cB, voffB); PG8_STAGE(PG8_SA(0, 0), cA, voffA); PG8_STAGE(PG8_SB(0, 1), cB + hstep, voffB); PG8_STAGE(PG8_SA(0, 1), cA + hstep, voffA);
        if (wr == 1) PG8_BAR;
        PG8_WAIT_V(4); PG8_BAR;
        PG8_STAGE(PG8_SB(1, 0), cB + kstep, voffB); PG8_STAGE(PG8_SA(1, 0), cA + kstep, voffA); PG8_STAGE(PG8_SB(1, 1), cB + hstep + kstep, voffB);
        PG8_WAIT_V(6); PG8_BAR;
    }
    for (;;) {
        const bool has_next = S.next(ui + 1, nxt);
        const char* nA = has_next ? (const char*)g.A + (size_t)nxt.pm * tstep : cA; const char* nB = has_next ? (const char*)g.Bt + (size_t)nxt.pn * tstep : cB;
        for (int t = 0; t < nt; t += 2) {
            const bool last = (t == nt - 2);
            const char* a1 = cA + (size_t)(t + 1) * kstep;
            const char* a2 = last ? nA : cA + (size_t)(t + 2) * kstep; const char* b2 = last ? nB : cB + (size_t)(t + 2) * kstep;
            const char* a3 = a2 + kstep; const char* b3 = b2 + kstep;
            if (last && has_next) S.a_ready(nxt);
            if constexpr (SP2) {
            PG8_LDB(B0, 0, 0); PG8_LDB(B1, 0, 1); PG8_SCHED; PG8_LDA(At, 0, 0); PG8_STAGE(PG8_SA(1, 1), a1 + hstep, voffA);
            PG8_WAIT_V(8); PG8_WAIT_L(0); PG8_BAR; PG8_MMA(0, 0, At, B0); PG8_MMA(0, 1, At, B1); PG8_BAR; PG8_SCHED;
            PG8_LDA(At, 0, 1); PG8_STAGE(PG8_SB(0, 0), b2, voffB); PG8_STAGE(PG8_SB(0, 1), b2 + hstep, voffB); PG8_STAGE(PG8_SA(0, 0), a2, voffA);
            PG8_WAIT_V(8); PG8_WAIT_L(0); PG8_BAR; PG8_MMA(1, 0, At, B0); PG8_MMA(1, 1, At, B1); PG8_BAR; PG8_SCHED;
            PG8_LDB(B0, 1, 0); PG8_LDB(B1, 1, 1); PG8_SCHED; PG8_LDA(At, 1, 0); PG8_STAGE(PG8_SA(0, 1), a2 + hstep, voffA);
            PG8_WAIT_V(8); PG8_WAIT_L(0); PG8_BAR; PG8_MMA(0, 0, At, B0); PG8_MMA(0, 1, At, B1); PG8_BAR; PG8_SCHED;
            PG8_LDA(At, 1, 1); PG8_STAGE(PG8_SB(1, 0), b3, voffB); PG8_STAGE(PG8_SB(1, 1), b3 + hstep, voffB); PG8_STAGE(PG8_SA(1, 0), a3, voffA);
            PG8_WAIT_V(8); PG8_WAIT_L(0); PG8_BAR; PG8_MMA(1, 0, At, B0); PG8_MMA(1, 1, At, B1); PG8_BAR; PG8_SCHED;
            } else {
            PG8_LDB(B0, 0, 0); PG8_SCHED; PG8_LDA(At, 0, 0); PG8_STAGE(PG8_SA(1, 1), a1 + hstep, voffA);
            PG8_WAIT_L(8); PG8_BAR; PG8_WAIT_L(0); PG8_MMA(0, 0, At, B0); PG8_BAR; PG8_SCHED;
            PG8_LDB(B1, 0, 1); PG8_STAGE(PG8_SB(0, 0), b2, voffB);
            PG8_BAR; PG8_WAIT_L(0); PG8_MMA(0, 1, At, B1); PG8_BAR;
            PG8_LDA(At, 0, 1); PG8_STAGE(PG8_SA(0, 0), a2, voffA);
            PG8_BAR; PG8_WAIT_L(0); PG8_MMA(1, 0, At, B0); PG8_BAR; PG8_SCHED;
            PG8_STAGE(PG8_SB(0, 1), b2 + hstep, voffB);
            PG8_WAIT_V(6); PG8_BAR; PG8_MMA(1, 1, At, B1); PG8_BAR;
            PG8_LDB(B0, 1, 0); PG8_SCHED; PG8_LDA(At, 1, 0); PG8_STAGE(PG8_SA(0, 1), a2 + hstep, voffA);
            PG8_WAIT_L(8); PG8_BAR; PG8_WAIT_L(0); PG8_MMA(0, 0, At, B0); PG8_BAR; PG8_SCHED;
            PG8_LDB(B1, 1, 1); PG8_STAGE(PG8_SB(1, 0), b3, voffB);
            PG8_BAR; PG8_WAIT_L(0); PG8_MMA(0, 1, At, B1); PG8_BAR;
            PG8_LDA(At, 1, 1); PG8_STAGE(PG8_SA(1, 0), a3, voffA);
            PG8_BAR; PG8_WAIT_L(0); PG8_MMA(1, 0, At, B0); PG8_BAR; PG8_SCHED;
            PG8_STAGE(PG8_SB(1, 1), b3 + hstep, voffB);
            PG8_WAIT_V(6); PG8_BAR; PG8_MMA(1, 1, At, B1); PG8_BAR;
            }
        }
        if constexpr (ALIGN_EPI) { if (wr == 0) PG8_BAR; }
        if constexpr (!Epi::AFTER_DRAIN) { E(acc, cur, wr, wc, fr, fq); S.done(cur); }
        if (!has_next) break;
#pragma unroll
        for (int a = 0; a < 2; ++a)
#pragma unroll
            for (int b = 0; b < 2; ++b)
#pragma unroll
                for (int m = 0; m < 4; ++m)
#pragma unroll
                    for (int n = 0; n < 2; ++n) acc[a][b][m][n] = (f32x4){0.f, 0.f, 0.f, 0.f};
        cur = nxt; cA = nA; cB = nB; ++ui;
        if constexpr (ALIGN_EPI) { if (wr == 1) PG8_BAR; }
    }
    PG8_WAIT_V(0);
    if constexpr (!ALIGN_EPI) { if (wr == 0) PG8_BAR; }
    PG8_BAR;
    if constexpr (Epi::AFTER_DRAIN) { E.fused(acc, cur, wr, wc, fr, fq, lds, wid, lane); S.done(cur); }
#undef PG8_SA
#undef PG8_SB
#undef PG8_STAGE
#undef PG8_LDA
#undef PG8_LDB
#undef PG8_MMA
#undef PG8_WAIT_V
#undef PG8_WAIT_L
#undef PG8_BAR
#undef PG8_SCHED
}
}
#ifndef PG8_SP2
#define PG8_SP2 true
#endif
#ifndef PG8_ALIGN
#define PG8_ALIGN true
#endif

constexpr int NWAVES = 8;
constexpr int NTOK = 32768, DM = 1024, SEQ = 2048, NBATCH = 16, INW = 3584;
constexpr int C_DQ = 0, C_DK = 512, C_DV = 1024, C_HQ = 1536, C_HF = 2048, C_HI = 2560, C_HG = 3072;
constexpr float EPS = 1e-6f;
constexpr float QSCALE = 0.125f * 1.4426950408889634f;
constexpr float LAM_INIT = 0.2f;
constexpr int NEXP_SEL = 128;

constexpr size_t MiB = 1u << 20;
constexpr size_t WS_CTL = 0, CTL_ZERO_BYTES = 1 * MiB;
constexpr size_t WS_SMALL = 1 * MiB;
constexpr size_t WS_WIN = 2 * MiB;
constexpr size_t WS_WOUT = 10 * MiB;
constexpr size_t WS_W2 = 12 * MiB;
constexpr size_t WS_U8 = 17 * MiB;
constexpr size_t WS_V8 = 33 * MiB;
constexpr size_t WS_SU = 49 * MiB;
constexpr size_t WS_SV = 49 * MiB + 512 * 1024;
constexpr size_t WS_X8 = 50 * MiB;
constexpr size_t WS_SX = 116 * MiB;
constexpr size_t WS_GSU = 120 * MiB;
constexpr size_t WS_HN = 84 * MiB;
constexpr size_t WS_PROJ = 148 * MiB;
constexpr size_t WS_HN2 = 148 * MiB;
constexpr size_t WS_SC = 212 * MiB;
constexpr size_t WS_PO = 352 * MiB;
constexpr size_t WS_IDX = 468 * MiB;
constexpr size_t WS_GATE = 484 * MiB;
constexpr size_t WS_END = 500 * MiB;
constexpr int SM_LB = 0, SM_LAM = 512, SM_BIAS = 1024;
constexpr int CW_BAR = 4096;
constexpr int CW_ATTQ = 8192;
constexpr int CW_SSQ = 131072;

constexpr int RING_OFF = 0, RING_BYTES = 139264;
constexpr int LDSCTL_OFF = RING_BYTES, MISC_OFF = LDSCTL_OFF + 320;
constexpr int LDS_BYTES = 147456;

#define GAS __attribute__((address_space(1)))
#define LAS __attribute__((address_space(3)))
typedef unsigned short bf16;
typedef unsigned v4u __attribute__((ext_vector_type(4)));
typedef unsigned v2u __attribute__((ext_vector_type(2)));
typedef float f32x4 __attribute__((ext_vector_type(4)));
typedef short bf16x8 __attribute__((ext_vector_type(8)));
typedef GAS unsigned gu32;
typedef long l2 __attribute__((ext_vector_type(2)));
typedef int v4i __attribute__((ext_vector_type(4)));
#define RLX_AGENT __ATOMIC_RELAXED, __HIP_MEMORY_SCOPE_AGENT
#define LDS_WAIT() asm volatile("s_waitcnt lgkmcnt(0)" ::: "memory")
#define VM_WAIT() asm volatile("s_waitcnt vmcnt(0)" ::: "memory")
__device__ __forceinline__ unsigned f2bf(float f) { unsigned u = __builtin_bit_cast(unsigned, f); return (u + 0x7fffu + ((u >> 16) & 1u)) >> 16; }
__device__ __forceinline__ unsigned pk2(float lo, float hi) { return f2bf(lo) | (f2bf(hi) << 16); }
__device__ __forceinline__ float bflo(unsigned w) { return __builtin_bit_cast(float, w << 16); }
__device__ __forceinline__ float bfhi(unsigned w) { return __builtin_bit_cast(float, w & 0xffff0000u); }

#define XB_TMO      128
#define XB_XCNT(j)  (256  + 64 * (j))
#define XB_XSUB(j)  (1280 + 64 * (j))
#define XB_XGEN(j)  (2304 + 64 * (j))
#define XB_TOP      3328
#define XB_TOPGEN   3392
#define XCD_BAR_WORDS 3456
#define XB_SPIN_CAP (1u << 18)
__device__ __forceinline__ unsigned xb_ld(unsigned* p)              { return __hip_atomic_load(p, __ATOMIC_RELAXED, __HIP_MEMORY_SCOPE_AGENT); }
__device__ __forceinline__ unsigned xb_add(unsigned* p, unsigned v) { return __hip_atomic_fetch_add(p, v, __ATOMIC_RELAXED, __HIP_MEMORY_SCOPE_AGENT); }
__device__ __forceinline__ unsigned xb_xcc_id() { return (unsigned)__builtin_amdgcn_s_getreg((3 << 11) | 20) & 0xFu; }
#define XB_SPIN(cond, bar) do { unsigned _sp = 0; while (cond) { __builtin_amdgcn_s_sleep(1); \
    if ((++_sp & 255u) == 0u) { if (xb_ld(&(bar)[XB_TMO])) break; if (_sp > XB_SPIN_CAP) { atomicAdd(&(bar)[XB_TMO], 1u); break; } } } } while (0)
struct XcdBarrier { unsigned* bar; unsigned x; volatile LAS unsigned* st; };
__device__ __forceinline__ XcdBarrier xcd_barrier_post(unsigned* bar, volatile LAS unsigned* st) {
    XcdBarrier b; b.bar = bar; b.x = xb_xcc_id(); b.st = st;
    if (threadIdx.x == 0) (void)xb_add(&bar[XB_XCNT(b.x)], 1u);
    return b;
}
__device__ __forceinline__ void xcd_barrier_complete(unsigned* bar, unsigned x, unsigned& nloc, unsigned& nx) {
    const unsigned G = gridDim.x * gridDim.y * gridDim.z;
    unsigned sum, cnt, mine, sp = 0u;
    for (;;) {
        sum = 0u; cnt = 0u; mine = 0u;
#pragma unroll
        for (unsigned j = 0; j < 16; ++j) { const unsigned c = xb_ld(&bar[XB_XCNT(j)]); sum += c; cnt += (c > 0u) ? 1u : 0u; mine = (j == x) ? c : mine; }
        if (sum == G) break;
        __builtin_amdgcn_s_sleep(1);
        if ((++sp & 255u) == 0u) { if (xb_ld(&bar[XB_TMO])) break; if (sp > XB_SPIN_CAP) { atomicAdd(&bar[XB_TMO], 1u); break; } }
    }
    nloc = mine > 0u ? mine : 1u; nx = cnt > 0u ? cnt : 1u;
}
__device__ __forceinline__ void xcd_barrier(const XcdBarrier& b) {
    asm volatile("s_waitcnt vmcnt(0)" ::: "memory");
    __syncthreads();
    if (threadIdx.x == 0) {
        unsigned* bar = b.bar;
        __builtin_amdgcn_s_waitcnt(0);
        unsigned nloc = b.st[0], nx = b.st[1];
        if (nloc == 0u) { xcd_barrier_complete(bar, b.x, nloc, nx); b.st[0] = nloc; b.st[1] = nx; }
        const unsigned old = xb_add(&bar[XB_XSUB(b.x)], 1u);
        const unsigned gen = old / nloc;
        if (old + 1u == (gen + 1u) * nloc) {
            __builtin_amdgcn_fence(__ATOMIC_RELEASE, "agent");
            asm volatile("s_waitcnt vmcnt(0)" ::: "memory");
            const unsigned og = xb_add(&bar[XB_TOP], 1u);
            const unsigned tg = og / nx;
            if (og + 1u == (tg + 1u) * nx) xb_add(&bar[XB_TOPGEN], 1u);
            else XB_SPIN(xb_ld(&bar[XB_TOPGEN]) == tg, bar);
            __builtin_amdgcn_fence(__ATOMIC_ACQUIRE, "agent");
            xb_add(&bar[XB_XGEN(b.x)], 1u);
            asm volatile("s_waitcnt vmcnt(0)" ::: "memory");
        } else {
            XB_SPIN(xb_ld(&bar[XB_XGEN(b.x)]) == gen, bar);
            __builtin_amdgcn_fence(__ATOMIC_ACQUIRE, "agent");
            asm volatile("s_waitcnt vmcnt(0)" ::: "memory");
        }
    }
    __syncthreads();
}

#define SCHED_FENCE() __builtin_amdgcn_sched_barrier(0)
__device__ __forceinline__ float gelu_as(float v) {
    const float av = fabsf(v), t = __builtin_amdgcn_rcpf(av * 0.2316418882f + 1.0f);
    float q = t * 0.5307027145f + (-0.7265760135f); q = q * t + 0.7107068705f; q = q * t + (-0.142248368f); q = q * t + 0.127414796f; q = q * t;
    const float e = __builtin_amdgcn_exp2f((v * v) * (-0.72134752044f));
    const float mm = v * (q * e);
    return v < 0.f ? mm : v - mm;
}
struct Frame {
    LAS unsigned char* lds;
    volatile LAS unsigned* MISC;
    int tid, lane, wave, vcu, G;
    const float* in[18]; float* out; unsigned char* ws;
};
__device__ __forceinline__ float wave_sum(float v) {
#pragma unroll
    for (int o = 1; o < 64; o <<= 1) v += __shfl_xor(v, o);
    return v;
}
__device__ __forceinline__ float sigmoidf_(float x) { return 1.f / (1.f + __expf(-x)); }

__device__ __forceinline__ void p0_transpose_item(const float* W, int K, int N, bf16* WT, int row_off, LAS float* scr, int item, int lane) {
    const int nblk = N / 32, kb = item / nblk, nb = item % nblk, k0 = 64 * kb, n0 = 32 * nb;
#pragma unroll 8
    for (int i = 0; i < 32; ++i) { const int kk = 2 * i + (lane >> 5); scr[kk * 33 + (lane & 31)] = W[(size_t)(k0 + kk) * N + n0 + (lane & 31)]; }
    LDS_WAIT(); asm volatile("" ::: "memory");
    const int c = lane & 7;
#pragma unroll
    for (int j = 0; j < 4; ++j) { const int n = (lane >> 3) + 8 * j; const LAS float* s = scr + (8 * c) * 33 + n;
        v4u o; o.x = pk2(s[0 * 33], s[1 * 33]); o.y = pk2(s[2 * 33], s[3 * 33]); o.z = pk2(s[4 * 33], s[5 * 33]); o.w = pk2(s[6 * 33], s[7 * 33]);
        *(GAS v4u*)(WT + (size_t)(row_off + n0 + n) * K + k0 + 8 * c) = o; }
    LDS_WAIT(); asm volatile("" ::: "memory");
}

__device__ __forceinline__ void quant_vals_fp8(const f32x4 (&v)[4], unsigned char* dst, float* dq, int lane, size_t slice_stride) {
    float mx = 0.f;
#pragma unroll
    for (int j = 0; j < 4; ++j) mx = fmaxf(mx, fmaxf(fmaxf(fabsf(v[j].x), fabsf(v[j].y)), fmaxf(fabsf(v[j].z), fabsf(v[j].w))));
#pragma unroll
    for (int o = 1; o < 64; o <<= 1) mx = fmaxf(mx, __shfl_xor(mx, o));
    const float qs = mx > 0.f ? 224.f / mx : 1.f;
#pragma unroll
    for (int j = 0; j < 4; ++j) { int p = __builtin_amdgcn_cvt_pk_fp8_f32(v[j].x * qs, v[j].y * qs, 0, false); p = __builtin_amdgcn_cvt_pk_fp8_f32(v[j].z * qs, v[j].w * qs, p, true);
        const int d = 4 * lane + 256 * j; *(GAS unsigned*)(dst + (slice_stride ? (size_t)(d >> 7) * slice_stride + (d & 127) : (size_t)d)) = (unsigned)p; }
    if (lane == 0) *dq = mx > 0.f ? mx * (1.f / 224.f) : 1.f;
}
__device__ __forceinline__ unsigned fp4_code(float v) {
    const unsigned b = (__builtin_bit_cast(unsigned, v) & 0x7fffffffu) + 0x00200000u;
    const int c = (int)(b >> 22) - 256;
    return (unsigned)(c < 0 ? 0 : (c > 7 ? 7 : c)) | ((__builtin_bit_cast(unsigned, v) >> 28) & 8u); }
__device__ __forceinline__ void quant_row_fp4(const float* src, unsigned char* dst, float* dq, int lane, size_t slice_stride) {
    const GAS f32x4* xr = (const GAS f32x4*)src + lane; f32x4 v[4];
#pragma unroll
    for (int j = 0; j < 4; ++j) v[j] = xr[64 * j];
    float mx = 0.f;
#pragma unroll
    for (int j = 0; j < 4; ++j) mx = fmaxf(mx, fmaxf(fmaxf(fabsf(v[j].x), fabsf(v[j].y)), fmaxf(fabsf(v[j].z), fabsf(v[j].w))));
#pragma unroll
    for (int o = 1; o < 64; o <<= 1) mx = fmaxf(mx, __shfl_xor(mx, o));
    const float qs = mx > 0.f ? 24.f / mx : 1.f;
#pragma unroll
    for (int j = 0; j < 4; ++j) {
        const unsigned c4 = fp4_code(v[j].x * qs) | (fp4_code(v[j].y * qs) << 8) | (fp4_code(v[j].z * qs) << 16) | (fp4_code(v[j].w * qs) << 24);
        const unsigned pn = (unsigned)__builtin_amdgcn_update_dpp(0, (int)c4, 0xB1, 0xf, 0xf, true);
        const unsigned pa = ((c4 & 0x08080808u) << 4) | ((c4 & 0x07070707u) << 1), pb = ((pn & 0x07070707u) << 4) | ((pn & 0x08080808u) >> 3);
        if (!(lane & 1)) *(GAS unsigned*)(dst + (size_t)j * slice_stride + 4 * (lane >> 1)) = pa | pb; }
    if (lane == 0) *dq = mx > 0.f ? mx * (1.f / 24.f) : 1.f;
}
__device__ __forceinline__ void quant_row_fp8(const float* src, unsigned char* dst, float* dq, int lane, size_t slice_stride) {
    const GAS f32x4* xr = (const GAS f32x4*)src + lane; f32x4 v[4];
#pragma unroll
    for (int j = 0; j < 4; ++j) v[j] = xr[64 * j];
    quant_vals_fp8(v, dst, dq, lane, slice_stride);
}
__device__ __forceinline__ void p0_prologue(Frame& F) {
    LAS float* scr = (LAS float*)(F.lds + RING_OFF + F.wave * 16384);
    const int gw = F.vcu * NWAVES + F.wave, NGW = F.G * NWAVES;
    bf16* WinT = (bf16*)(F.ws + WS_WIN); bf16* WoutT = (bf16*)(F.ws + WS_WOUT); bf16* W2T = (bf16*)(F.ws + WS_W2);
    float* small = (float*)(F.ws + WS_SMALL);
    if (blockIdx.x == 0) {
        const int t = F.tid;
        { const float l0 = F.in[9][t], l1 = F.in[9][512 + t]; small[SM_LB + t] = 1.f / (1.f + expf(l1 - l0)); }
        { const int h = t >> 7, n = t & 127; int bk;
          if (n < 16) bk = n; else { bk = 16 + (int)(logf((float)n * (1.f / 16.f)) / logf(8.f) * 16.f); bk = bk > 31 ? 31 : bk; }
          small[SM_BIAS + t] = F.in[8][bk * 4 + h] * 1.4426950408889634f; }
        if (F.wave == 0) {
            const float a = wave_sum(F.in[3][F.lane] * F.in[4][F.lane]), b = wave_sum(F.in[5][F.lane] * F.in[6][F.lane]);
            if (F.lane == 0) small[SM_LAM] = expf(a) - expf(b) + LAM_INIT;
        }
    }
    constexpr int I_IN = (DM / 64) * (INW / 32), I_OUT = (DM / 64) * (DM / 32);
    for (int it = gw; it < I_IN + I_OUT; it += NGW) {
        if (it < I_IN) p0_transpose_item(F.in[2], DM, INW, WinT, 0, scr, it, F.lane);
        else p0_transpose_item(F.in[11], DM, DM, WoutT, 0, scr, it - I_IN, F.lane);
    }
    for (int u = F.vcu; u < 256; u += F.G) {
        const int hc = u >> 4, kb = u & 15, k = kb * 64 + F.lane;
        const GAS f32x4* wrow = (const GAS f32x4*)(F.in[13] + (size_t)k * 2048 + hc * 128);
        float a[16];
#pragma unroll
        for (int nn = 0; nn < 16; ++nn) a[nn] = 0.f;
        const float* kr = F.in[14] + ((size_t)hc * 128 + F.wave * 16) * 128;
        for (int i = 0; i < 32; ++i) {
            const f32x4 w = wrow[i];
#pragma unroll
            for (int nn = 0; nn < 16; ++nn) { const float* kk = kr + nn * 128 + 4 * i; a[nn] += (kk[0] * w.x + kk[1] * w.y) + (kk[2] * w.z + kk[3] * w.w); }
        }
        const float g2k = F.in[12][k];
#pragma unroll
        for (int nn = 0; nn < 16; ++nn) W2T[((size_t)hc * 128 + F.wave * 16 + nn) * DM + k] = (bf16)f2bf(a[nn] * g2k);
    }
    bf16* HN = (bf16*)(F.ws + WS_HN);
    for (int m = gw; m < NTOK; m += 2 * NGW) {
        const int m2 = m + NGW;
        const GAS f32x4* xa = (const GAS f32x4*)(F.in[0] + (size_t)m * DM) + F.lane; const GAS f32x4* xb = (const GAS f32x4*)(F.in[0] + (size_t)(m2 < NTOK ? m2 : m) * DM) + F.lane;
        const GAS f32x4* gr = (const GAS f32x4*)F.in[1] + F.lane;
        f32x4 va[4], vb[4]; float sa = 0.f, sb = 0.f;
#pragma unroll
        for (int j = 0; j < 4; ++j) { va[j] = xa[64 * j]; vb[j] = xb[64 * j]; }
#pragma unroll
        for (int j = 0; j < 4; ++j) { sa += (va[j].x * va[j].x + va[j].y * va[j].y) + (va[j].z * va[j].z + va[j].w * va[j].w); sb += (vb[j].x * vb[j].x + vb[j].y * vb[j].y) + (vb[j].z * vb[j].z + vb[j].w * vb[j].w); }
#pragma unroll
        for (int o = 1; o < 64; o <<= 1) { sa += __shfl_xor(sa, o); sb += __shfl_xor(sb, o); }
        const float ra = 1.f / sqrtf(sa * (1.f / DM) + EPS), rb = 1.f / sqrtf(sb * (1.f / DM) + EPS);
        GAS unsigned long long* oa = (GAS unsigned long long*)(HN + (size_t)m * DM) + F.lane; GAS unsigned long long* ob = (GAS unsigned long long*)(HN + (size_t)m2 * DM) + F.lane;
#pragma unroll
        for (int j = 0; j < 4; ++j) { const f32x4 gg = gr[64 * j];
            oa[64 * j] = (unsigned long long)pk2(va[j].x * ra * gg.x, va[j].y * ra * gg.y) | ((unsigned long long)pk2(va[j].z * ra * gg.z, va[j].w * ra * gg.w) << 32);
            if (m2 < NTOK) ob[64 * j] = (unsigned long long)pk2(vb[j].x * rb * gg.x, vb[j].y * rb * gg.y) | ((unsigned long long)pk2(vb[j].z * rb * gg.z, vb[j].w * rb * gg.w) << 32); }
    }
}


constexpr int QCHUNKS = 2 * 16384 / 64;
__device__ __forceinline__ void quant_chunk(Frame& F, int c) {
    unsigned char* U8 = F.ws + WS_U8; unsigned char* V8 = F.ws + WS_V8; float* SU = (float*)(F.ws + WS_SU); float* SV = (float*)(F.ws + WS_SV);
#pragma unroll 1
    for (int k = 0; k < 8; ++k) { const int rr = 64 * c + 8 * F.wave + k;
        if (rr < 16384) quant_row_fp4(F.in[15] + (size_t)rr * DM, U8 + (size_t)rr * 128, SU + rr, F.lane, (size_t)16384 * 128);
        else { const int e = rr - 16384; quant_row_fp8(F.in[16] + (size_t)e * DM, V8 + (size_t)e * 128, SV + e, F.lane, (size_t)16384 * 128); } }
}

__device__ __forceinline__ void quant_drain(Frame& F) {
    unsigned* qctr = (unsigned*)(F.ws + WS_CTL) + CW_ATTQ + 128;
    if (F.tid == 0) F.MISC[13] = __hip_atomic_fetch_add(qctr, 1u, __ATOMIC_RELAXED, __HIP_MEMORY_SCOPE_AGENT);
    for (int it = 0;; ++it) {
        __syncthreads();
        const int qc = (int)F.MISC[13 + (it & 1)];
        if (qc >= QCHUNKS) break;
        unsigned nx = 0u;
        if (F.tid == 0) nx = __hip_atomic_fetch_add(qctr, 1u, __ATOMIC_RELAXED, __HIP_MEMORY_SCOPE_AGENT);
        quant_chunk(F, qc);
        if (F.tid == 0) F.MISC[13 + ((it + 1) & 1)] = nx;
    }
}

typedef float f32x16 __attribute__((ext_vector_type(16)));
typedef short s16x4 __attribute__((ext_vector_type(4)));
typedef short v4i16_t __attribute__((ext_vector_type(4)));
typedef float f32x2_t __attribute__((ext_vector_type(2))); typedef __bf16 bf16x2_t __attribute__((ext_vector_type(2)));
__device__ __forceinline__ unsigned cvtpk_bf16(float lo, float hi) { f32x2_t v = {lo, hi}; bf16x2_t b = __builtin_convertvector(v, bf16x2_t); return __builtin_bit_cast(unsigned, b); }
__device__ __forceinline__ float xhalf_max(float v) { return fmaxf(v, __shfl_xor(v, 32)); }
__device__ __forceinline__ float xhalf_sum(float v) { return v + __shfl_xor(v, 32); }
__device__ __forceinline__ float max3f_(float a, float b, float c) { float r; asm("v_max3_f32 %0, %1, %2, %3" : "=v"(r) : "v"(a), "v"(b), "v"(c)); return r; }
constexpr int AT_KP = 144, AT_VP = 320, AT_K1 = 64 * AT_KP, AT_KS = 2 * AT_K1, AT_V0 = 2 * AT_KS, AT_VS = 64 * AT_VP;
constexpr int AT_XO = 0, AT_YB = 65536, AT_YP = 272, AT_Q = 100864, AT_TAB = AT_Q + 8 * 4096;
static_assert(AT_TAB + 320 * 4 <= RING_BYTES && AT_YB + 4 * 32 * AT_YP <= AT_Q && AT_V0 + 3 * AT_VS <= AT_Q, "attention LDS map");
#define AT_MFMA(a, b, c) __builtin_amdgcn_mfma_f32_32x32x16_bf16(a, b, c, 0, 0, 0)
#define AT_SGB(mask, n) __builtin_amdgcn_sched_group_barrier(mask, n, 0)
__device__ __forceinline__ void attn_mfma(Frame& F, int qslot) {
    const bf16* PROJ = (const bf16*)(F.ws + WS_PROJ); bf16* MIXED = (bf16*)(F.ws + WS_HN);
    const float* small = (const float*)(F.ws + WS_SMALL);
    LAS unsigned char* lds = F.lds;
    LAS float* TAB = (LAS float*)(lds + AT_TAB);
    const int tid = F.tid, lane = F.lane, wave = F.wave, map = wave >> 2, qt = wave & 3, r32 = lane & 31, hi = lane >> 5;
    const int koff = map * AT_K1 + r32 * AT_KP + hi * 16;
    const int voff = AT_V0 + (4 * hi + ((lane & 15) >> 2)) * AT_VP + (16 * ((lane >> 4) & 1) + 4 * (lane & 3)) * 2;
    unsigned* qctr = (unsigned*)(F.ws + WS_CTL) + CW_ATTQ + 64 * qslot;
    if (tid == 0) F.MISC[12] = __hip_atomic_fetch_add(qctr, 1u, __ATOMIC_RELAXED, __HIP_MEMORY_SCOPE_AGENT);
    for (;;) {
        __syncthreads();
        const int L = (int)F.MISC[12];
        if (L >= 1024) break;
        unsigned nxtu = 0u;
        if (tid == 0) nxtu = __hip_atomic_fetch_add(qctr, 1u, __ATOMIC_RELAXED, __HIP_MEMORY_SCOPE_AGENT);
        const int qb = 15 - (L >> 6), bh = L & 63;
        const int b = bh >> 2, h = bh & 3, q0 = qb * 128; const size_t tok0 = (size_t)b * SEQ;
        const int NT = (q0 + 128) / 64;
        int tidu = F.tid; asm volatile("" : "+v"(tidu));
        if (tidu < 320) { const int n = tidu - 96; TAB[tidu] = n < 0 ? -INFINITY : small[SM_BIAS + h * 128 + (n > 127 ? 127 : n)]; }
        bf16x8 qf0, qf1, qf2, qf3;
        { const bf16* qrow = PROJ + (tok0 + q0 + 32 * qt + r32) * INW + C_DQ + h * 128 + map * 64 + 8 * hi;
          qf0 = *(const GAS bf16x8*)(qrow); qf1 = *(const GAS bf16x8*)(qrow + 16); qf2 = *(const GAS bf16x8*)(qrow + 32); qf3 = *(const GAS bf16x8*)(qrow + 48); }
        const unsigned char* projb = (const unsigned char*)PROJ;
        const unsigned ksrc = (unsigned)(((tok0 + (tidu >> 4)) * INW + C_DK + h * 128 + (tidu & 15) * 8) * 2), vsrc = ksrc + (C_DV - C_DK) * 2;
        const int kdst = ((tidu & 15) >> 3) * AT_K1 + (tidu >> 4) * AT_KP + (tidu & 7) * 16, vdst = AT_V0 + (tidu >> 4) * AT_VP + (tidu & 15) * 16;
#define AT_GLD(src, row) (*(const GAS v4u*)(projb + (size_t)((src) + (unsigned)((row) * (INW * 2)))))
        v4u kr[2], vr[2];
#pragma unroll
        for (int i = 0; i < 2; ++i) { kr[i] = AT_GLD(ksrc, 32 * i); vr[i] = AT_GLD(vsrc, 32 * i); }
#pragma unroll
        for (int i = 0; i < 2; ++i) { *(LAS v4u*)(lds + kdst + 32 * i * AT_KP) = kr[i]; *(LAS v4u*)(lds + vdst + 32 * i * AT_VP) = vr[i]; }
#pragma unroll
        for (int i = 0; i < 2; ++i) { kr[i] = AT_GLD(ksrc, 64 + 32 * i); vr[i] = AT_GLD(vsrc, 64 + 32 * i); }
        __syncthreads();
        const float bfar = TAB[96 + 127];
        f32x16 o[4];
#pragma unroll
        for (int mt = 0; mt < 4; ++mt) o[mt] = (f32x16){0.f,0.f,0.f,0.f,0.f,0.f,0.f,0.f,0.f,0.f,0.f,0.f,0.f,0.f,0.f,0.f};
        float mrun = -INFINITY, lsum = 0.f, alpha = 1.f, cexp = 0.f; bool resc = false;
        const int qlo = q0 + 32 * qt, qpos = qlo + r32;
        const int NTW = NT - 1 + (qt >> 1);
        f32x16 pA0, pA1, pB0, pB1;
        int vs_prev = 0, vs_cur = 0, vs_next = AT_VS;
#define AT_ROT() do { vs_prev = vs_cur; vs_cur = vs_next; vs_next = (vs_next == 2 * AT_VS) ? 0 : vs_next + AT_VS; } while (0)
#define AT_Z16 (f32x16){0.f,0.f,0.f,0.f,0.f,0.f,0.f,0.f,0.f,0.f,0.f,0.f,0.f,0.f,0.f,0.f}
#define AT_SBAR() __builtin_amdgcn_sched_barrier(0)
#define AT_PIN(x) asm volatile("" : "+v"(x))
        bf16x8 kAa, kAb, kBa, kBb; s16x4 f0l, f0h, f1l, f1h;
#define AT_KRD2(S, KB, s4) do { k##S##a = *(const LAS bf16x8*)(lds + (KB) + koff + 32 * (s4)); k##S##b = *(const LAS bf16x8*)(lds + (KB) + koff + 32 * AT_KP + 32 * (s4)); } while (0)
#define AT_VRD(Fn, g) do { LAS unsigned char* vp_ = vb_ + (32 * ((g) >> 3) + 16 * (((g) >> 2) & 1)) * AT_VP + 64 * ((g) & 3); \
            Fn##l = __builtin_bit_cast(s16x4, __builtin_amdgcn_ds_read_tr16_b64_v4i16((LAS v4i16_t*)vp_)); Fn##h = __builtin_bit_cast(s16x4, __builtin_amdgcn_ds_read_tr16_b64_v4i16((LAS v4i16_t*)(vp_ + 8 * AT_VP))); } while (0)
#define AT_VFR(Fn) (bf16x8){Fn##l[0], Fn##l[1], Fn##l[2], Fn##l[3], Fn##h[0], Fn##h[1], Fn##h[2], Fn##h[3]}
#define AT_GAPA(MF, RD, FILL, P, g, PK) do { MF; RD; \
            if (FILL) { const float e0_ = P[4 * ((g) & 3)], e1_ = P[4 * ((g) & 3) + 1], e2_ = P[4 * ((g) & 3) + 2], e3_ = P[4 * ((g) & 3) + 3]; \
                sacc_ += e0_; sacc_ += e1_; sacc_ += e2_; sacc_ += e3_; \
                PK[2 * (g)] = __builtin_bit_cast(float, cvtpk_bf16(e0_, e1_)); PK[2 * (g) + 1] = __builtin_bit_cast(float, cvtpk_bf16(e2_, e3_)); AT_PIN(PK); AT_PIN(sacc_); } \
            AT_SBAR(); } while (0)
#define AT_PHASE_A(C0, C1, P0, P1, KB, FILL) do { float sacc_ = 0.f; \
            AT_SBAR(); AT_KRD2(A, KB, 0); AT_SBAR(); \
            AT_GAPA(C0 = AT_MFMA(kAa, qf0, AT_Z16), AT_KRD2(B, KB, 1), FILL, P0, 0, P0); \
            AT_GAPA(C1 = AT_MFMA(kAb, qf0, AT_Z16), (void)0,           FILL, P0, 1, P0); \
            AT_GAPA(C0 = AT_MFMA(kBa, qf1, C0),     AT_KRD2(A, KB, 2), FILL, P0, 2, P0); \
            AT_GAPA(C1 = AT_MFMA(kBb, qf1, C1),     (void)0,           FILL, P0, 3, P0); \
            AT_GAPA(C0 = AT_MFMA(kAa, qf2, C0),     AT_KRD2(B, KB, 3), FILL, P1, 4, P0); \
            AT_GAPA(C1 = AT_MFMA(kAb, qf2, C1),     (void)0,           FILL, P1, 5, P0); \
            AT_GAPA(C0 = AT_MFMA(kBa, qf3, C0),     (void)0,           FILL, P1, 6, P0); \
            AT_GAPA(C1 = AT_MFMA(kBb, qf3, C1),     (void)0,           FILL, P1, 7, P0); \
            lsum += sacc_; } while (0)
#define AT_MID(C0, C1, t) do { float tm, cadd; \
            if (qlo - (64 * (t) + 63) < 127) { \
                const LAS float* rp = TAB + (qpos - 64 * (t) - 4 * hi + 96 - 59); tm = -INFINITY; \
                _Pragma("unroll") for (int r = 0; r < 16; ++r) { const int off = (r & 3) + 8 * (r >> 2); C0[r] += rp[59 - off]; C1[r] += rp[27 - off]; tm = max3f_(tm, C0[r], C1[r]); } \
                cadd = 0.f; \
            } else { \
                tm = max3f_(C0[0], C1[0], C0[1]); \
                _Pragma("unroll") for (int r = 1; r < 15; ++r) tm = max3f_(tm, C1[r], C0[r + 1]); \
                tm = fmaxf(tm, C1[15]); tm += bfar; cadd = bfar; } \
            tm = xhalf_max(tm); resc = false; \
            if (__any(tm > mrun + 8.f)) { const float mnew = fmaxf(mrun, tm); alpha = __builtin_amdgcn_exp2f(mrun - mnew); lsum *= alpha; mrun = mnew; resc = true; } \
            cexp = cadd - mrun; } while (0)
#define AT_EXP(C0, C1) do { _Pragma("unroll") for (int r = 0; r < 16; ++r) { C0[r] = __builtin_amdgcn_exp2f(C0[r] + cexp); C1[r] = __builtin_amdgcn_exp2f(C1[r] + cexp); } } while (0)
#define AT_GAPB(Fn, g, PK, C, DOEXP) do { o[(g) & 3] = AT_MFMA(AT_VFR(Fn), __builtin_bit_cast(bf16x8, (f32x4){PK[4 * ((g) >> 2)], PK[4 * ((g) >> 2) + 1], PK[4 * ((g) >> 2) + 2], PK[4 * ((g) >> 2) + 3]}), o[(g) & 3]); \
            if ((g) + 2 < 16) AT_VRD(Fn, (g) + 2); \
            if (DOEXP) { C[2 * ((g) & 7)] = __builtin_amdgcn_exp2f(C[2 * ((g) & 7)] + cexp); C[2 * ((g) & 7) + 1] = __builtin_amdgcn_exp2f(C[2 * ((g) & 7) + 1] + cexp); AT_PIN(C); } \
            AT_SBAR(); } while (0)
#define AT_PHASE_B(C0, C1, PK, VB, DOEXP) do { LAS unsigned char* vb_ = lds + (VB) + voff; \
            AT_SBAR(); AT_VRD(f0, 0); AT_VRD(f1, 1); AT_SBAR(); \
            AT_GAPB(f0, 0, PK, C0, DOEXP);  AT_GAPB(f1, 1, PK, C0, DOEXP);  AT_GAPB(f0, 2, PK, C0, DOEXP);  AT_GAPB(f1, 3, PK, C0, DOEXP); \
            AT_GAPB(f0, 4, PK, C0, DOEXP);  AT_GAPB(f1, 5, PK, C0, DOEXP);  AT_GAPB(f0, 6, PK, C0, DOEXP);  AT_GAPB(f1, 7, PK, C0, DOEXP); \
            AT_GAPB(f0, 8, PK, C1, DOEXP);  AT_GAPB(f1, 9, PK, C1, DOEXP);  AT_GAPB(f0, 10, PK, C1, DOEXP); AT_GAPB(f1, 11, PK, C1, DOEXP); \
            AT_GAPB(f0, 12, PK, C1, DOEXP); AT_GAPB(f1, 13, PK, C1, DOEXP); AT_GAPB(f0, 14, PK, C1, DOEXP); AT_GAPB(f1, 15, PK, C1, DOEXP); } while (0)
#define AT_RESC() do { if (resc) { _Pragma("unroll") for (int mt = 0; mt < 4; ++mt) o[mt] = o[mt] * alpha; } } while (0)
#define AT_STAGE(t) do { if ((t) + 1 < NT) { \
                _Pragma("unroll") for (int i = 0; i < 2; ++i) { *(LAS v4u*)(lds + (((t) + 1) & 1) * AT_KS + kdst + 32 * i * AT_KP) = kr[i]; *(LAS v4u*)(lds + vs_next + vdst + 32 * i * AT_VP) = vr[i]; } \
                if ((t) + 2 < NT) { _Pragma("unroll") for (int i = 0; i < 2; ++i) { kr[i] = AT_GLD(ksrc, 64 * ((t) + 2) + 32 * i); vr[i] = AT_GLD(vsrc, 64 * ((t) + 2) + 32 * i); } } } \
            __syncthreads(); AT_ROT(); } while (0)
#define AT_STEP(C0, C1, P0, P1, t) do { \
            AT_PHASE_A(C0, C1, P0, P1, ((t) & 1) * AT_KS, 1); \
            AT_MID(C0, C1, t); \
            AT_PHASE_B(C0, C1, P0, vs_prev, 1); \
            AT_RESC(); } while (0)
#define AT_PACK(P0, P1) do { float ps_ = 0.f; \
            _Pragma("unroll") for (int r = 0; r < 16; ++r) ps_ += P0[r] + P1[r]; \
            lsum += ps_; \
            _Pragma("unroll") for (int w = 0; w < 8; ++w) { const float lo_ = P0[2 * w], hi_ = P0[2 * w + 1]; P0[w] = __builtin_bit_cast(float, cvtpk_bf16(lo_, hi_)); } \
            _Pragma("unroll") for (int w = 0; w < 8; ++w) P0[8 + w] = __builtin_bit_cast(float, cvtpk_bf16(P1[2 * w], P1[2 * w + 1])); } while (0)
        AT_PHASE_A(pA0, pA1, pA0, pA1, 0, 0); AT_MID(pA0, pA1, 0); AT_EXP(pA0, pA1); AT_RESC();
        AT_STAGE(0);
        if (tid == 0) F.MISC[12] = nxtu;
        int t = 1;
        for (; t + 1 < NT; t += 2) {
            AT_STEP(pB0, pB1, pA0, pA1, t);     AT_STAGE(t);
            AT_STEP(pA0, pA1, pB0, pB1, t + 1); AT_STAGE(t + 1);
        }
        if (NTW == NT) {
            AT_STEP(pB0, pB1, pA0, pA1, t); AT_ROT();
            AT_PACK(pB0, pB1); AT_PHASE_B(pB0, pB1, pB0, vs_prev, 0);
        } else {
            AT_PACK(pA0, pA1); AT_PHASE_B(pA0, pA1, pA0, vs_prev, 0);
        }
        __syncthreads();
        { int lane_e = F.lane; asm volatile("" : "+v"(lane_e));
        const int lane = lane_e, r32 = lane & 31, hi = lane >> 5;
        const float inv = 1.f / xhalf_sum(lsum);
        LAS float* XO = (LAS float*)(lds + AT_XO) + qt * 4096 + r32;
        if (map == 1) {
            const float sc = inv * small[SM_LAM];
#pragma unroll
            for (int mt = 0; mt < 4; ++mt)
#pragma unroll
                for (int r = 0; r < 16; ++r) XO[(32 * mt + (r & 3) + 8 * (r >> 2) + 4 * hi) * 32] = o[mt][r] * sc;
        }
        __syncthreads();
        if (map == 0) {
            float ss = 0.f;
#pragma unroll
            for (int mt = 0; mt < 4; ++mt)
#pragma unroll
                for (int r = 0; r < 16; ++r) { const float a = o[mt][r] * inv - XO[(32 * mt + (r & 3) + 8 * (r >> 2) + 4 * hi) * 32]; o[mt][r] = a; ss += a * a; }
            ss = xhalf_sum(ss);
            const float rr = (1.f - LAM_INIT) / sqrtf(ss * (1.f / 128.f) + EPS);
            LAS unsigned char* yb = lds + AT_YB + qt * (32 * AT_YP);
#pragma unroll
            for (int mt = 0; mt < 4; ++mt)
#pragma unroll
                for (int r4 = 0; r4 < 4; ++r4) { const int dv = 32 * mt + 8 * r4 + 4 * hi; const f32x4 gg = *(const GAS f32x4*)(F.in[7] + dv);
                    v2u w; w.x = cvtpk_bf16(o[mt][4 * r4] * rr * gg.x, o[mt][4 * r4 + 1] * rr * gg.y); w.y = cvtpk_bf16(o[mt][4 * r4 + 2] * rr * gg.z, o[mt][4 * r4 + 3] * rr * gg.w);
                    *(LAS v2u*)(yb + r32 * AT_YP + dv * 2) = w; }
            LDS_WAIT(); asm volatile("" ::: "memory");
            bf16* obase = MIXED + (tok0 + q0 + 32 * qt) * DM + h * 128;
#pragma unroll
            for (int i = 0; i < 8; ++i) { const int id = lane + 64 * i, row = id >> 4, cch = id & 15;
                const v4u w = *(const LAS v4u*)(yb + row * AT_YP + cch * 16); *(GAS v4u*)(obase + (size_t)row * DM + cch * 8) = w; }
        } }
#undef AT_ROT
#undef AT_GLD
#undef AT_KRD2
#undef AT_VRD
#undef AT_VFR
#undef AT_GAPA
#undef AT_GAPB
#undef AT_PHASE_A
#undef AT_PHASE_B
#undef AT_PACK
#undef AT_MID
#undef AT_EXP
#undef AT_RESC
#undef AT_STAGE
#undef AT_STEP
    }
}

constexpr int HG_P = 288, HG_VP = 320, HG_GP = 272, HG_OP = 136;
constexpr int HG_QD = 0, HG_KI = 32 * HG_P, HG_V = 2 * 32 * HG_P, HG_CD = HG_V + 32 * HG_VP, HG_G = HG_CD + 512, HG_BUF = HG_G + 32 * HG_GP;
constexpr int HG_O = 2 * HG_BUF;
static_assert(HG_O + 32 * HG_OP * 4 <= RING_BYTES, "hgrn LDS map");
__device__ __forceinline__ bf16x8 pack8(const f32x16& x, int s) {
    v4u p; p.x = cvtpk_bf16(x[8 * s], x[8 * s + 1]); p.y = cvtpk_bf16(x[8 * s + 2], x[8 * s + 3]); p.z = cvtpk_bf16(x[8 * s + 4], x[8 * s + 5]); p.w = cvtpk_bf16(x[8 * s + 6], x[8 * s + 7]);
    return __builtin_bit_cast(bf16x8, p);
}
__device__ __forceinline__ bf16x8 tr_pair(LAS unsigned char* p0, LAS unsigned char* p1) {
    const s16x4 lo = __builtin_bit_cast(s16x4, __builtin_amdgcn_ds_read_tr16_b64_v4i16((LAS v4i16_t*)p0));
    const s16x4 hi4 = __builtin_bit_cast(s16x4, __builtin_amdgcn_ds_read_tr16_b64_v4i16((LAS v4i16_t*)p1));
    return (bf16x8){lo[0], lo[1], lo[2], lo[3], hi4[0], hi4[1], hi4[2], hi4[3]};
}
#define DPPF_(x, ctrl) __builtin_bit_cast(float, __builtin_amdgcn_update_dpp(0, __builtin_bit_cast(int, (x)), (ctrl), 0xf, 0xf, true))
__device__ __forceinline__ void hg_prep8(LAS unsigned char* bufp, const v4u rq, const v4u rf, const f32x4 lbA, const f32x4 lbB, int pc, int dk8, int lane) {
    const float lbv[8] = {lbA.x, lbA.y, lbA.z, lbA.w, lbB.x, lbB.y, lbB.z, lbB.w};
    float bb[8], fv[8];
    const unsigned fw[4] = {rf.x, rf.y, rf.z, rf.w}, qw[4] = {rq.x, rq.y, rq.z, rq.w};
#pragma unroll
    for (int i = 0; i < 8; ++i) { const float x = (i & 1) ? bfhi(fw[i >> 1]) : bflo(fw[i >> 1]); const float f = lbv[i] + (1.f - lbv[i]) * __builtin_amdgcn_rcpf(1.f + __expf(-x)); fv[i] = f; bb[i] = f; }
#define HG_SCAN_STEP(ctrl) asm volatile("s_nop 1\n\tv_mul_f32_dpp %0, %0, %0 " ctrl "\n\tv_mul_f32_dpp %1, %1, %1 " ctrl "\n\tv_mul_f32_dpp %2, %2, %2 " ctrl "\n\tv_mul_f32_dpp %3, %3, %3 " ctrl "\n\t" \
        "v_mul_f32_dpp %4, %4, %4 " ctrl "\n\tv_mul_f32_dpp %5, %5, %5 " ctrl "\n\tv_mul_f32_dpp %6, %6, %6 " ctrl "\n\tv_mul_f32_dpp %7, %7, %7 " ctrl \
        : "+v"(bb[0]), "+v"(bb[1]), "+v"(bb[2]), "+v"(bb[3]), "+v"(bb[4]), "+v"(bb[5]), "+v"(bb[6]), "+v"(bb[7]))
    HG_SCAN_STEP("row_shr:1 row_mask:0xf bank_mask:0xf");
    HG_SCAN_STEP("row_shr:2 row_mask:0xf bank_mask:0xf");
    HG_SCAN_STEP("row_shr:4 row_mask:0xf bank_mask:0xf");
    HG_SCAN_STEP("row_shr:8 row_mask:0xf bank_mask:0xf");
    HG_SCAN_STEP("row_bcast:15 row_mask:0xa bank_mask:0xf");
#undef HG_SCAN_STEP
    float qd[8], ki[8];
#pragma unroll
    for (int i = 0; i < 8; ++i) { const float e = bb[i], ei = __builtin_amdgcn_rcpf(bb[i]);
        const float xq = (i & 1) ? bfhi(qw[i >> 1]) : bflo(qw[i >> 1]); const float q = xq * __builtin_amdgcn_rcpf(1.f + __expf(-xq)); const float k = 1.f - fv[i];
        qd[i] = q * e; ki[i] = k * ei; }
    *(LAS v4u*)(bufp + HG_QD + pc * HG_P + dk8 * 2) = (v4u){cvtpk_bf16(qd[0], qd[1]), cvtpk_bf16(qd[2], qd[3]), cvtpk_bf16(qd[4], qd[5]), cvtpk_bf16(qd[6], qd[7])};
    *(LAS v4u*)(bufp + HG_KI + pc * HG_P + dk8 * 2) = (v4u){cvtpk_bf16(ki[0], ki[1]), cvtpk_bf16(ki[2], ki[3]), cvtpk_bf16(ki[4], ki[5]), cvtpk_bf16(ki[6], ki[7])};
    if (pc == 31) { *(LAS f32x4*)(bufp + HG_CD + dk8 * 4) = (f32x4){bb[0], bb[1], bb[2], bb[3]}; *(LAS f32x4*)(bufp + HG_CD + dk8 * 4 + 16) = (f32x4){bb[4], bb[5], bb[6], bb[7]}; }
}
__device__ __forceinline__ void hgrn_mfma(Frame& F) {
    const bf16* PROJ = (const bf16*)(F.ws + WS_PROJ); bf16* MIXED = (bf16*)(F.ws + WS_HN);
    const float* small = (const float*)(F.ws + WS_SMALL);
    LAS unsigned char* lds = F.lds;
    const int tid = F.tid, lane = F.lane, wave = F.wave, r32 = lane & 31, hh = lane >> 5;
    for (int u = F.vcu; u < 64; u += F.G) {
        const int b = u >> 2, h = u & 3; const size_t tok0 = (size_t)b * SEQ;
        __syncthreads();
        if (wave >= 4) {
            const int pt = tid - 256, pc = lane & 31, dkA = 16 * (wave - 4) + 8 * hh;
            const int vcA = pt >> 4, vseg = pt & 15;
            const f32x4 lb0 = *(const GAS f32x4*)(small + SM_LB + h * 128 + dkA), lb1 = *(const GAS f32x4*)(small + SM_LB + h * 128 + dkA + 4);
            const f32x4 lb2 = *(const GAS f32x4*)(small + SM_LB + h * 128 + dkA + 64), lb3 = *(const GAS f32x4*)(small + SM_LB + h * 128 + dkA + 68);
            v4u q0A, f0A, v0A, g0A, q1A, f1A, v1A, g1A, q0B, f0B, v0B, g0B, q1B, f1B, v1B, g1B, q0C, f0C, v0C, g0C, q1C, f1C, v1C, g1C, q0D, f0D, v0D, g0D, q1D, f1D, v1D, g1D;
#define HP_LOAD(S, chn) do { const bf16* p_ = PROJ + (tok0 + 32 * (chn) + pc) * INW + h * 128 + dkA; const bf16* v_ = PROJ + (tok0 + 32 * (chn) + vcA) * INW + h * 128 + vseg * 8; \
            asm volatile("global_load_dwordx4 %0, %1, off" : "=v"(q0##S) : "v"(p_ + C_HQ) : "memory"); \
            asm volatile("global_load_dwordx4 %0, %1, off" : "=v"(f0##S) : "v"(p_ + C_HF) : "memory"); \
            asm volatile("global_load_dwordx4 %0, %1, off" : "=v"(v0##S) : "v"(v_ + C_HI) : "memory"); \
            asm volatile("global_load_dwordx4 %0, %1, off" : "=v"(g0##S) : "v"(v_ + C_HG) : "memory"); \
            asm volatile("global_load_dwordx4 %0, %1, off" : "=v"(q1##S) : "v"(p_ + C_HQ + 64) : "memory"); \
            asm volatile("global_load_dwordx4 %0, %1, off" : "=v"(f1##S) : "v"(p_ + C_HF + 64) : "memory"); \
            asm volatile("global_load_dwordx4 %0, %1, off" : "=v"(v1##S) : "v"(v_ + (size_t)16 * INW + C_HI) : "memory"); \
            asm volatile("global_load_dwordx4 %0, %1, off" : "=v"(g1##S) : "v"(v_ + (size_t)16 * INW + C_HG) : "memory"); } while (0)
#define HP_WAIT(S) asm volatile("s_waitcnt vmcnt(24)" : "+v"(q0##S), "+v"(f0##S), "+v"(v0##S), "+v"(g0##S), "+v"(q1##S), "+v"(f1##S), "+v"(v1##S), "+v"(g1##S) :: "memory")
#define HP_PASS0(S, bufp) do { hg_prep8(bufp, q0##S, f0##S, lb0, lb1, pc, dkA, lane); \
            *(LAS v4u*)((bufp) + HG_V + vcA * HG_VP + vseg * 16) = v0##S; *(LAS v4u*)((bufp) + HG_V + (vcA + 16) * HG_VP + vseg * 16) = v1##S; \
            *(LAS v4u*)((bufp) + HG_G + vcA * HG_GP + vseg * 16) = g0##S; *(LAS v4u*)((bufp) + HG_G + (vcA + 16) * HG_GP + vseg * 16) = g1##S; } while (0)
#define HP_PASS1(S, bufp) hg_prep8(bufp, q1##S, f1##S, lb2, lb3, pc, dkA + 64, lane)
#define HP_CL(c) ((c) < SEQ / 32 ? (c) : SEQ / 32 - 1)
            HP_LOAD(A, 0); HP_LOAD(B, 1); HP_LOAD(C, 2); HP_LOAD(D, 3);
            HP_WAIT(A); HP_PASS0(A, lds); HP_PASS1(A, lds);
            HP_LOAD(A, 4);
            for (int ch4 = 0; ch4 < SEQ / 32; ch4 += 4) {
                __syncthreads();
                HP_WAIT(B); HP_PASS0(B, lds + HG_BUF);
                __syncthreads();
                HP_PASS1(B, lds + HG_BUF); HP_LOAD(B, HP_CL(ch4 + 5));
                __syncthreads();
                HP_WAIT(C); HP_PASS0(C, lds);
                __syncthreads();
                HP_PASS1(C, lds); HP_LOAD(C, HP_CL(ch4 + 6));
                __syncthreads();
                HP_WAIT(D); HP_PASS0(D, lds + HG_BUF);
                __syncthreads();
                HP_PASS1(D, lds + HG_BUF); HP_LOAD(D, HP_CL(ch4 + 7));
                __syncthreads();
                HP_WAIT(A); HP_PASS0(A, lds);
                __syncthreads();
                HP_PASS1(A, lds); HP_LOAD(A, HP_CL(ch4 + 8));
            }
            asm volatile("s_waitcnt vmcnt(0)" : "+v"(q0A), "+v"(f0A), "+v"(v0A), "+v"(g0A), "+v"(q1A), "+v"(f1A), "+v"(v1A), "+v"(g1A), "+v"(q0B), "+v"(f0B), "+v"(v0B), "+v"(g0B), "+v"(q1B), "+v"(f1B), "+v"(v1B), "+v"(g1B) :: "memory");
            asm volatile("" : "+v"(q0C), "+v"(f0C), "+v"(v0C), "+v"(g0C), "+v"(q1C), "+v"(f1C), "+v"(v1C), "+v"(g1C), "+v"(q0D), "+v"(f0D), "+v"(v0D), "+v"(g0D), "+v"(q1D), "+v"(f1D), "+v"(v1D), "+v"(g1D) :: "memory");
#undef HP_CL
#undef HP_LOAD
#undef HP_WAIT
#undef HP_PASS0
#undef HP_PASS1
        } else {
            const int dvt = wave;
            const int kdoff = (((lane & 15) >> 2)) * HG_P + (16 * ((lane >> 4) & 1) + 4 * (lane & 3)) * 2;
            const int troff = (((lane & 15) >> 2)) * HG_VP + (32 * dvt + 16 * ((lane >> 4) & 1) + 4 * (lane & 3)) * 2;
            const int vc = tid >> 3, sg = tid & 7;
            const f32x4 ga0 = *(const GAS f32x4*)(F.in[10] + 8 * sg), ga1 = *(const GAS f32x4*)(F.in[10] + 8 * sg + 4);
            const f32x4 gb0 = *(const GAS f32x4*)(F.in[10] + 64 + 8 * sg), gb1 = *(const GAS f32x4*)(F.in[10] + 64 + 8 * sg + 4);
            f32x16 S0, S1, S2, S3;
#pragma unroll
            for (int r = 0; r < 16; ++r) { S0[r] = 0.f; S1[r] = 0.f; S2[r] = 0.f; S3[r] = 0.f; }
            for (int ch = 0; ch < SEQ / 32; ++ch) {
                LAS unsigned char* bufp = lds + (ch & 1) * HG_BUF;
                __syncthreads();
                f32x16 o, X;
#pragma unroll
                for (int r = 0; r < 16; ++r) { o[r] = 0.f; X[r] = 0.f; }
                bf16x8 qaf[8], kif[8], qdf[8];
                __builtin_amdgcn_sched_barrier(0);
#pragma unroll
                for (int i = 0; i < 8; ++i) { LAS unsigned char* qa = bufp + HG_QD + r32 * HG_P + (16 * i + 4 * hh) * 2;
                    const v2u a0 = *(const LAS v2u*)qa, a1 = *(const LAS v2u*)(qa + 16); qaf[i] = __builtin_bit_cast(bf16x8, (v4u){a0.x, a0.y, a1.x, a1.y}); }
#pragma unroll
                for (int s8 = 0; s8 < 4; ++s8) { kif[s8] = *(const LAS bf16x8*)(bufp + HG_KI + r32 * HG_P + (16 * s8 + 8 * hh) * 2); qdf[s8] = *(const LAS bf16x8*)(bufp + HG_QD + r32 * HG_P + (16 * s8 + 8 * hh) * 2); }
                __builtin_amdgcn_sched_barrier(0);
#pragma unroll
                for (int i = 0; i < 8; ++i)
                    o = __builtin_amdgcn_mfma_f32_32x32x16_bf16(qaf[i], pack8((i >> 1) == 0 ? S0 : (i >> 1) == 1 ? S1 : (i >> 1) == 2 ? S2 : S3, i & 1), o, 0, 0, 0);
#pragma unroll
                for (int s8 = 4; s8 < 8; ++s8) { kif[s8] = *(const LAS bf16x8*)(bufp + HG_KI + r32 * HG_P + (16 * s8 + 8 * hh) * 2); qdf[s8] = *(const LAS bf16x8*)(bufp + HG_QD + r32 * HG_P + (16 * s8 + 8 * hh) * 2); }
                bf16x8 vx0, vx1;
                { LAS unsigned char* vp = bufp + HG_V + troff + (4 * hh) * HG_VP; vx0 = tr_pair(vp, vp + 8 * HG_VP); vx1 = tr_pair(vp + 16 * HG_VP, vp + 24 * HG_VP); }
                __builtin_amdgcn_sched_barrier(0);
#pragma unroll
                for (int s8 = 0; s8 < 8; ++s8) X = __builtin_amdgcn_mfma_f32_32x32x16_bf16(kif[s8], qdf[s8], X, 0, 0, 0);
                __builtin_amdgcn_sched_barrier(0);
#pragma unroll
                for (int r = 0; r < 16; ++r) { const int cp = (r & 3) + 8 * (r >> 2) + 4 * hh; X[r] = cp > r32 ? 0.f : X[r]; }
                o = __builtin_amdgcn_mfma_f32_32x32x16_bf16(pack8(X, 0), vx0, o, 0, 0, 0);
                o = __builtin_amdgcn_mfma_f32_32x32x16_bf16(pack8(X, 1), vx1, o, 0, 0, 0);
                { LAS float* ob = (LAS float*)(lds + HG_O) + 32 * dvt + r32;
#pragma unroll
                  for (int r = 0; r < 16; ++r) ob[((r & 3) + 8 * (r >> 2) + 4 * hh) * HG_OP] = o[r]; }
                __syncthreads();
                { bf16x8 kaf[8], vbf[2];
                  __builtin_amdgcn_sched_barrier(0);
#pragma unroll
                  for (int s2 = 0; s2 < 2; ++s2) { LAS unsigned char* vp = bufp + HG_V + troff + (16 * s2 + 8 * hh) * HG_VP; vbf[s2] = tr_pair(vp, vp + 4 * HG_VP); }
#pragma unroll
                  for (int i = 0; i < 8; ++i) { LAS unsigned char* kp = bufp + HG_KI + kdoff + (16 * (i & 1) + 8 * hh) * HG_P + 32 * (i >> 1) * 2;
                      kaf[i] = tr_pair(kp, kp + 4 * HG_P); }
                  __builtin_amdgcn_sched_barrier(0);
#pragma unroll
                  for (int i = 0; i < 8; ++i) {
                      if ((i >> 1) == 0)      S0 = __builtin_amdgcn_mfma_f32_32x32x16_bf16(kaf[i], vbf[i & 1], S0, 0, 0, 0);
                      else if ((i >> 1) == 1) S1 = __builtin_amdgcn_mfma_f32_32x32x16_bf16(kaf[i], vbf[i & 1], S1, 0, 0, 0);
                      else if ((i >> 1) == 2) S2 = __builtin_amdgcn_mfma_f32_32x32x16_bf16(kaf[i], vbf[i & 1], S2, 0, 0, 0);
                      else                    S3 = __builtin_amdgcn_mfma_f32_32x32x16_bf16(kaf[i], vbf[i & 1], S3, 0, 0, 0);
                  }
                  __builtin_amdgcn_sched_barrier(0); }
#pragma unroll
                for (int kk = 0; kk < 4; ++kk) {
                    const LAS float* cdp = (const LAS float*)(bufp + HG_CD) + 32 * kk + 4 * hh;
#pragma unroll
                    for (int r4 = 0; r4 < 4; ++r4) { const f32x4 c4 = *(const LAS f32x4*)(cdp + 8 * r4);
                        if (kk == 0)      { S0[4 * r4] *= c4.x; S0[4 * r4 + 1] *= c4.y; S0[4 * r4 + 2] *= c4.z; S0[4 * r4 + 3] *= c4.w; }
                        else if (kk == 1) { S1[4 * r4] *= c4.x; S1[4 * r4 + 1] *= c4.y; S1[4 * r4 + 2] *= c4.z; S1[4 * r4 + 3] *= c4.w; }
                        else if (kk == 2) { S2[4 * r4] *= c4.x; S2[4 * r4 + 1] *= c4.y; S2[4 * r4 + 2] *= c4.z; S2[4 * r4 + 3] *= c4.w; }
                        else              { S3[4 * r4] *= c4.x; S3[4 * r4 + 1] *= c4.y; S3[4 * r4 + 2] *= c4.z; S3[4 * r4 + 3] *= c4.w; } }
                }
                { const LAS float* op = (const LAS float*)(lds + HG_O) + vc * HG_OP + 8 * sg;
                  const f32x4 x0 = *(const LAS f32x4*)op, x1 = *(const LAS f32x4*)(op + 4), x2 = *(const LAS f32x4*)(op + 64), x3 = *(const LAS f32x4*)(op + 68);
                  const v4u gwa = *(const LAS v4u*)(bufp + HG_G + vc * HG_GP + sg * 16), gwb = *(const LAS v4u*)(bufp + HG_G + vc * HG_GP + (sg + 8) * 16);
                  float ss = ((x0.x * x0.x + x0.y * x0.y) + (x0.z * x0.z + x0.w * x0.w)) + ((x1.x * x1.x + x1.y * x1.y) + (x1.z * x1.z + x1.w * x1.w))
                           + ((x2.x * x2.x + x2.y * x2.y) + (x2.z * x2.z + x2.w * x2.w)) + ((x3.x * x3.x + x3.y * x3.y) + (x3.z * x3.z + x3.w * x3.w));
                  ss += DPPF_(ss, 0xB1); ss += DPPF_(ss, 0x4E); ss += DPPF_(ss, 0x141);
                  const float rr = __builtin_amdgcn_rsqf(ss * (1.f / 128.f) + EPS);
                  const size_t tok = tok0 + 32 * ch + vc;
                  const unsigned gwa_[4] = {gwa.x, gwa.y, gwa.z, gwa.w}, gwb_[4] = {gwb.x, gwb.y, gwb.z, gwb.w};
                  const float ova[8] = {x0.x, x0.y, x0.z, x0.w, x1.x, x1.y, x1.z, x1.w}, ovb[8] = {x2.x, x2.y, x2.z, x2.w, x3.x, x3.y, x3.z, x3.w};
                  const float gga[8] = {ga0.x, ga0.y, ga0.z, ga0.w, ga1.x, ga1.y, ga1.z, ga1.w}, ggb[8] = {gb0.x, gb0.y, gb0.z, gb0.w, gb1.x, gb1.y, gb1.z, gb1.w};
                  unsigned wa[4], wb[4];
#pragma unroll
                  for (int j = 0; j < 4; ++j) { const float a0 = bflo(gwa_[j]), a1 = bfhi(gwa_[j]), b0 = bflo(gwb_[j]), b1 = bfhi(gwb_[j]);
                      wa[j] = cvtpk_bf16(ova[2 * j] * rr * gga[2 * j] * (a0 * __builtin_amdgcn_rcpf(1.f + __expf(-a0))), ova[2 * j + 1] * rr * gga[2 * j + 1] * (a1 * __builtin_amdgcn_rcpf(1.f + __expf(-a1))));
                      wb[j] = cvtpk_bf16(ovb[2 * j] * rr * ggb[2 * j] * (b0 * __builtin_amdgcn_rcpf(1.f + __expf(-b0))), ovb[2 * j + 1] * rr * ggb[2 * j + 1] * (b1 * __builtin_amdgcn_rcpf(1.f + __expf(-b1)))); }
                  bf16* dst = MIXED + tok * DM + 512 + h * 128 + 8 * sg;
                  *(GAS v4u*)dst = (v4u){wa[0], wa[1], wa[2], wa[3]}; *(GAS v4u*)(dst + 64) = (v4u){wb[0], wb[1], wb[2], wb[3]}; }
            }
        }
    }
}
template <int N> __device__ __forceinline__ unsigned row_ror(unsigned x) { return (unsigned)__builtin_amdgcn_update_dpp((int)x, (int)x, 0x120 + N, 0xf, 0xf, false); }
__device__ __forceinline__ unsigned umax_(unsigned a, unsigned b) { return a > b ? a : b; }
__device__ __forceinline__ unsigned umin_(unsigned a, unsigned b) { return a < b ? a : b; }
__device__ __forceinline__ unsigned row_umax16(unsigned x) {
    unsigned y;
    asm volatile("s_nop 1\n\tv_max_u32_dpp %0, %1, %1 row_ror:1 row_mask:0xf bank_mask:0xf\n\t"
                 "s_nop 1\n\tv_max_u32_dpp %0, %0, %0 row_ror:2 row_mask:0xf bank_mask:0xf\n\t"
                 "s_nop 1\n\tv_max_u32_dpp %0, %0, %0 row_ror:4 row_mask:0xf bank_mask:0xf\n\t"
                 "s_nop 1\n\tv_max_u32_dpp %0, %0, %0 row_ror:8 row_mask:0xf bank_mask:0xf"
                 : "=&v"(y) : "v"(x));
    return y;
}
__device__ __forceinline__ float row_fsum16(float v) {
    v += __builtin_bit_cast(float, row_ror<1>(__builtin_bit_cast(unsigned, v))); v += __builtin_bit_cast(float, row_ror<2>(__builtin_bit_cast(unsigned, v)));
    v += __builtin_bit_cast(float, row_ror<4>(__builtin_bit_cast(unsigned, v))); v += __builtin_bit_cast(float, row_ror<8>(__builtin_bit_cast(unsigned, v))); return v; }
__device__ __forceinline__ unsigned h2key(unsigned x) { return (x & 0x80000000u) ? (~x & 0xffff0000u) : (x | 0x80000000u); }
__device__ __forceinline__ float hkey2f(unsigned k) { const unsigned hb = ((k & 0x80000000u) ? (k & 0x7fff0000u) : (~k & 0xffff0000u)) >> 16; return (float)__builtin_bit_cast(_Float16, (unsigned short)hb); }
__device__ __forceinline__ unsigned f2key(float f) { const unsigned u = __builtin_bit_cast(unsigned, f); return (u & 0x80000000u) ? ~u : (u | 0x80000000u); }
__device__ __forceinline__ float key2f(unsigned k) { const unsigned u = (k & 0x80000000u) ? (k & 0x7fffffffu) : ~k; return __builtin_bit_cast(float, u); }
__device__ __forceinline__ unsigned pair_code(int s) {
    if (s < 16) return (unsigned)s;
    if (s < 24) return 16u + (unsigned)(s - 16);
    if (s < 29) return 32u + (unsigned)(s - 24);
    if (s < 33) return 48u + (unsigned)(s - 29);
    if (s < 36) return 64u + (unsigned)(s - 33);
    if (s < 42) return 80u + 16u * (unsigned)((s - 36) >> 1) + (unsigned)((s - 36) & 1);
    if (s < 50) return 128u + 16u * (unsigned)(s - 42);
    return 0xFFu;
}
#define CAS_(a, b) do { const unsigned hi_ = umax_(a, b), lo_ = umin_(a, b); a = hi_; b = lo_; } while (0)
__device__ __forceinline__ void row_umax16_x2(unsigned xa, unsigned xb, unsigned& ya, unsigned& yb) {
    asm volatile("s_nop 1\n\tv_max_u32_dpp %0, %2, %2 row_ror:1 row_mask:0xf bank_mask:0xf\n\tv_max_u32_dpp %1, %3, %3 row_ror:1 row_mask:0xf bank_mask:0xf\n\t"
                 "s_nop 0\n\tv_max_u32_dpp %0, %0, %0 row_ror:2 row_mask:0xf bank_mask:0xf\n\tv_max_u32_dpp %1, %1, %1 row_ror:2 row_mask:0xf bank_mask:0xf\n\t"
                 "s_nop 0\n\tv_max_u32_dpp %0, %0, %0 row_ror:4 row_mask:0xf bank_mask:0xf\n\tv_max_u32_dpp %1, %1, %1 row_ror:4 row_mask:0xf bank_mask:0xf\n\t"
                 "s_nop 0\n\tv_max_u32_dpp %0, %0, %0 row_ror:8 row_mask:0xf bank_mask:0xf\n\tv_max_u32_dpp %1, %1, %1 row_ror:8 row_mask:0xf bank_mask:0xf"
                 : "=&v"(ya), "=&v"(yb) : "v"(xa), "v"(xb));
}
__device__ __forceinline__ void row_umax16_x4(unsigned xa, unsigned xb, unsigned xc, unsigned xd, unsigned& ya, unsigned& yb, unsigned& yc, unsigned& yd) {
    asm volatile("s_nop 1\n\tv_max_u32_dpp %0, %4, %4 row_ror:1 row_mask:0xf bank_mask:0xf\n\tv_max_u32_dpp %1, %5, %5 row_ror:1 row_mask:0xf bank_mask:0xf\n\t"
                 "v_max_u32_dpp %2, %6, %6 row_ror:1 row_mask:0xf bank_mask:0xf\n\tv_max_u32_dpp %3, %7, %7 row_ror:1 row_mask:0xf bank_mask:0xf\n\t"
                 "v_max_u32_dpp %0, %0, %0 row_ror:2 row_mask:0xf bank_mask:0xf\n\tv_max_u32_dpp %1, %1, %1 row_ror:2 row_mask:0xf bank_mask:0xf\n\t"
                 "v_max_u32_dpp %2, %2, %2 row_ror:2 row_mask:0xf bank_mask:0xf\n\tv_max_u32_dpp %3, %3, %3 row_ror:2 row_mask:0xf bank_mask:0xf\n\t"
                 "v_max_u32_dpp %0, %0, %0 row_ror:4 row_mask:0xf bank_mask:0xf\n\tv_max_u32_dpp %1, %1, %1 row_ror:4 row_mask:0xf bank_mask:0xf\n\t"
                 "v_max_u32_dpp %2, %2, %2 row_ror:4 row_mask:0xf bank_mask:0xf\n\tv_max_u32_dpp %3, %3, %3 row_ror:4 row_mask:0xf bank_mask:0xf\n\t"
                 "v_max_u32_dpp %0, %0, %0 row_ror:8 row_mask:0xf bank_mask:0xf\n\tv_max_u32_dpp %1, %1, %1 row_ror:8 row_mask:0xf bank_mask:0xf\n\t"
                 "v_max_u32_dpp %2, %2, %2 row_ror:8 row_mask:0xf bank_mask:0xf\n\tv_max_u32_dpp %3, %3, %3 row_ror:8 row_mask:0xf bank_mask:0xf"
                 : "=&v"(ya), "=&v"(yb), "=&v"(yc), "=&v"(yd) : "v"(xa), "v"(xb), "v"(xc), "v"(xd));
}
#define TK_LOAD(th_) (*(const GAS v4u*)(SC + (size_t)((th_) >> 3) * 2048 + ((th_) & 7) * 256 + c * 128 + l15 * 8))
#define TK_LOADSORT(P, sv_) \
    unsigned P##0, P##1, P##2, P##3, P##4, P##5, P##6, P##7; \
    { const v4u sv = (sv_); const unsigned nb = 127u - 8u * (unsigned)l15; \
      P##0 = h2key(sv.x << 16) | nb; P##1 = h2key(sv.x & 0xffff0000u) | (nb - 1u); P##2 = h2key(sv.y << 16) | (nb - 2u); P##3 = h2key(sv.y & 0xffff0000u) | (nb - 3u); \
      P##4 = h2key(sv.z << 16) | (nb - 4u); P##5 = h2key(sv.z & 0xffff0000u) | (nb - 5u); P##6 = h2key(sv.w << 16) | (nb - 6u); P##7 = h2key(sv.w & 0xffff0000u) | (nb - 7u); \
      CAS_(P##0, P##1); CAS_(P##2, P##3); CAS_(P##4, P##5); CAS_(P##6, P##7); CAS_(P##0, P##2); CAS_(P##1, P##3); CAS_(P##4, P##6); CAS_(P##5, P##7); CAS_(P##1, P##2); CAS_(P##5, P##6); CAS_(P##0, P##4); CAS_(P##3, P##7); \
      CAS_(P##1, P##5); CAS_(P##2, P##6); CAS_(P##1, P##4); CAS_(P##3, P##6); CAS_(P##2, P##4); CAS_(P##3, P##5); CAS_(P##3, P##4); }
#define TK_POP(P, m_) do { const bool pop_ = (P##0 == (m_)); P##0 = pop_ ? P##1 : P##0; P##1 = pop_ ? P##2 : P##1; P##2 = pop_ ? P##3 : P##2; P##3 = pop_ ? P##4 : P##3; \
      P##4 = pop_ ? P##5 : P##4; P##5 = pop_ ? P##6 : P##5; P##6 = pop_ ? P##7 : P##6; P##7 = pop_ ? 0u : P##7; } while (0)
__device__ __forceinline__ void topk_stage1x2(const v4u svA, const v4u svB, int l15, unsigned& resA, unsigned& resB) {
    TK_LOADSORT(ka, svA) TK_LOADSORT(kb, svB)
    unsigned ra = 0u, rb = 0u;
#pragma unroll
    for (int r = 0; r < 16; ++r) {
        unsigned ma, mb; row_umax16_x2(ka0, kb0, ma, mb);
        TK_POP(ka, ma); TK_POP(kb, mb);
        ra = (l15 == r) ? ma : ra; rb = (l15 == r) ? mb : rb;
    }
    resA = ra; resB = rb;
}
__device__ __forceinline__ void topk_stage1x4(const v4u svA, const v4u svB, const v4u svC, const v4u svD, int l15, unsigned& resA, unsigned& resB, unsigned& resC, unsigned& resD) {
    TK_LOADSORT(ka, svA) TK_LOADSORT(kb, svB) TK_LOADSORT(kc, svC) TK_LOADSORT(kd, svD)
    unsigned ra = 0u, rb = 0u, rc = 0u, rd = 0u;
#pragma unroll
    for (int r = 0; r < 16; ++r) {
        unsigned ma, mb, mc, md; row_umax16_x4(ka0, kb0, kc0, kd0, ma, mb, mc, md);
        TK_POP(ka, ma); TK_POP(kb, mb); TK_POP(kc, mc); TK_POP(kd, md);
        ra = (l15 == r) ? ma : ra; rb = (l15 == r) ? mb : rb; rc = (l15 == r) ? mc : rc; rd = (l15 == r) ? md : rd;
    }
    resA = ra; resB = rb; resC = rc; resD = rd;
}
__device__ __forceinline__ void topk_v2(Frame& F) {
    const unsigned short* SC = (const unsigned short*)(F.ws + WS_SC); int* IDX = (int*)(F.ws + WS_IDX); float* GATE = (float*)(F.ws + WS_GATE); float* GSU = (float*)(F.ws + WS_GSU);
    const float* SU = (const float*)(F.ws + WS_SU); const float* SV = (const float*)(F.ws + WS_SV);
    const int gw = F.vcu * NWAVES + F.wave, NGW = F.G * NWAVES, lane = F.lane, l15 = lane & 15, row = lane >> 4, c = row & 1, rbase = lane & 48;
    const unsigned pc0 = pair_code(l15), pc1 = pair_code(l15 + 16), pc2 = pair_code(l15 + 32), pc3 = pair_code(l15 + 48);
    const int src1 = l15 + 32 * (row & 1), src2 = src1 + 16;
    for (int it0 = gw * 32; it0 < NTOK * 2; it0 += NGW * 32) {
    v4u svA = TK_LOAD(4 * it0 + (row >> 1)), svB = TK_LOAD(4 * it0 + 2 + (row >> 1)), svC = TK_LOAD(4 * it0 + 4 + (row >> 1)), svD = TK_LOAD(4 * it0 + 6 + (row >> 1));
    for (int it = it0; it < it0 + 32; it += 2) {
        const int thb = 4 * it; const int thn = 4 * (it + 2 < it0 + 32 ? it + 2 : it);
        const v4u nvA = TK_LOAD(thn + (row >> 1)), nvB = TK_LOAD(thn + 2 + (row >> 1)), nvC = TK_LOAD(thn + 4 + (row >> 1)), nvD = TK_LOAD(thn + 6 + (row >> 1));
        unsigned resA, resB, resC, resD; topk_stage1x4(svA, svB, svC, svD, l15, resA, resB, resC, resD); svA = nvA; svB = nvB; svC = nvC; svD = nvD;
#define TK_S12(RA_, RB_, S1_, S2_) const unsigned S1_##a = (unsigned)__shfl((int)RA_, src1), S2_##a = (unsigned)__shfl((int)RA_, src2), S1_##b = (unsigned)__shfl((int)RB_, src1), S2_##b = (unsigned)__shfl((int)RB_, src2); \
        const unsigned S1_ = row < 2 ? S1_##a : S1_##b, S2_ = row < 2 ? S2_##a : S2_##b
        TK_S12(resA, resB, S1x, S2x); TK_S12(resC, resD, S1y, S2y);
#undef TK_S12
        unsigned c0, c1, c2, c3, d0, d1, d2, d3;
#define TK_CAND(CK, PC, S1_, S2_) do { const unsigned ka_ = (unsigned)__shfl((int)S1_, rbase + (int)((PC) >> 4 & 15u)), kb_ = (unsigned)__shfl((int)S2_, rbase + (int)((PC) & 15u)); \
            const float sm_ = hkey2f(ka_) + hkey2f(kb_); CK = (PC) == 0xFFu ? 0u : ((f2key(sm_) & ~0xFFu) | (255u - (PC))); } while (0)
        TK_CAND(c0, pc0, S1x, S2x); TK_CAND(c1, pc1, S1x, S2x); TK_CAND(c2, pc2, S1x, S2x); TK_CAND(c3, pc3, S1x, S2x);
        TK_CAND(d0, pc0, S1y, S2y); TK_CAND(d1, pc1, S1y, S2y); TK_CAND(d2, pc2, S1y, S2y); TK_CAND(d3, pc3, S1y, S2y);
#undef TK_CAND
        CAS_(c0, c1); CAS_(c2, c3); CAS_(c0, c2); CAS_(c1, c3); CAS_(c1, c2);
        CAS_(d0, d1); CAS_(d2, d3); CAS_(d0, d2); CAS_(d1, d3); CAS_(d1, d2);
        unsigned res2x = 0u, res2y = 0u;
#pragma unroll
        for (int r = 0; r < 16; ++r) {
            unsigned mx, my; row_umax16_x2(c0, d0, mx, my);
            const bool popx = (c0 == mx), popy = (d0 == my);
            c0 = popx ? c1 : c0; c1 = popx ? c2 : c1; c2 = popx ? c3 : c2; c3 = popx ? 0u : c3;
            d0 = popy ? d1 : d0; d1 = popy ? d2 : d1; d2 = popy ? d3 : d2; d3 = popy ? 0u : d3;
            res2x = (l15 == r) ? mx : res2x; res2y = (l15 == r) ? my : res2y;
        }
#define TK_FIN(RES2_, S1_, S2_, TH_) do { const unsigned code = 255u - ((RES2_) & 0xFFu); \
            const unsigned ka = (unsigned)__shfl((int)S1_, rbase + (int)(code >> 4 & 15u)), kb = (unsigned)__shfl((int)S2_, rbase + (int)(code & 15u)); \
            const float ts = hkey2f(ka) + hkey2f(kb); \
            const int e = (int)((127u - (ka & 0x7Fu)) * 128u + (127u - (kb & 0x7Fu))); \
            const float sve = SV[e], sue = SU[e];                                \
            const float tmax = __builtin_bit_cast(float, (unsigned)__shfl((int)__builtin_bit_cast(unsigned, ts), rbase)); \
            const float ex = __expf(ts - tmax); \
            const float sum = row_fsum16(ex); \
            const int th = (TH_) + row; \
            const size_t o = (size_t)(th >> 3) * NEXP_SEL + (th & 7) * 16 + l15; \
            IDX[o] = e; GATE[o] = ex / sum * sve; GSU[o] = sue; } while (0)
        TK_FIN(res2x, S1x, S2x, thb); TK_FIN(res2y, S1y, S2y, thb + 4);
#undef TK_FIN
    } }
}

constexpr int PG_TOK = 16;
constexpr int PG_IDX = 0, PG_HID = 4096, PG_SA = PG_HID + 8192, PG_TB = PG_SA + 64, PG_WB = PG_TB + 4096;
static_assert(PG_WB % 16 == 0 && PG_TB % 16 == 0 && NWAVES * PG_WB <= RING_BYTES, "gather LDS map");
typedef int pgv4i __attribute__((ext_vector_type(4))); typedef int pgv8i __attribute__((ext_vector_type(8)));
__device__ __forceinline__ pgv8i pg_cat8(const l2 a, const l2 b) { const pgv4i x = __builtin_bit_cast(pgv4i, a), y = __builtin_bit_cast(pgv4i, b); return __builtin_shufflevector(x, y, 0, 1, 2, 3, 4, 5, 6, 7); }
__device__ __forceinline__ pgv8i pg_fp4_to_fp8(const l2 a) { const pgv4i x = __builtin_bit_cast(pgv4i, a); pgv8i r;
#pragma unroll
    for (int q = 0; q < 4; ++q) { const unsigned w = (unsigned)x[q];
        r[2 * q] = (int)((w & 0x8E8E8E8Eu) | 0x40404040u);
        r[2 * q + 1] = (int)((((w >> 3) & 0x0E0E0E0Eu) | 0x40404040u) | ((w << 7) & 0x80808080u)); }
    return r; }
__device__ __forceinline__ void peer_sliced(Frame& F) {
    const unsigned char* U8T = F.ws + WS_U8; const unsigned char* V8T = F.ws + WS_V8; const unsigned char* X8 = F.ws + WS_X8;
    const float* SSQ = (const float*)(F.ws + WS_CTL) + CW_SSQ;
    const int* IDX = (const int*)(F.ws + WS_IDX); const float* GATE = (const float*)(F.ws + WS_GATE); const float* GSU = (const float*)(F.ws + WS_GSU); const float* gf = F.in[17];
    bf16* PO = (bf16*)(F.ws + WS_PO); const bf16* HB = (const bf16*)(F.ws + WS_HN2);
    const int gw = F.vcu * NWAVES + F.wave, NGW = F.G * NWAVES, lane = F.lane, m = lane & 15, g = lane >> 4;
    const int row8 = lane >> 3, piece = lane & 7;
    LAS unsigned char* wb = F.lds + F.wave * PG_WB;
    LAS unsigned short* idxs = (LAS unsigned short*)(wb + PG_IDX);
    LAS float* hid = (LAS float*)(wb + PG_HID);
    LAS float* sqp = hid + 64 + lane;
    LAS float* sai = (LAS float*)(wb + PG_SA);
    LAS unsigned char* tb = wb + PG_TB;
    const int p8 = m & 7; const unsigned bsh = 8u * (unsigned)(p8 & 3); const bool bhi = (p8 >> 2) != 0;
    constexpr size_t SLICE = (size_t)16384 * 128;
    const int usw = 16 * (piece ^ ((row8 >> 1) & 3));
    const int urd0 = m * 128 + 16 * ((2 * g) ^ ((m >> 1) & 7)), urd1 = m * 128 + 16 * ((2 * g + 1) ^ ((m >> 1) & 7));
    for (int blk = gw; blk < NTOK / PG_TOK; blk += NGW) {
        const int t0 = blk * PG_TOK;
#pragma unroll
        for (int k = 0; k < 32; ++k) { const int id = lane + 64 * k;
            idxs[16 * (lane & 7) + (lane >> 3) + 128 * (k >> 1) + 8 * (k & 1)] = (unsigned short)IDX[(size_t)t0 * NEXP_SEL + id]; }
#pragma unroll
        for (int k = 0; k < 8; ++k) *(LAS f32x4*)(hid + 4 * (lane + 64 * k)) = (f32x4){0.f, 0.f, 0.f, 0.f};
        LDS_WAIT(); asm volatile("" ::: "memory");
        v4u ab[2][16]; l2 xs[2][4];
#define PGU_ISSUE_AT(UP_, XP_, i_, buf_) do { _Pragma("unroll") for (int k = 0; k < 16; ++k) { const unsigned e = idxs[(i_) * 128 + 16 * row8 + k]; \
                ab[buf_][k] = *(const GAS v4u*)((UP_) + (size_t)(e * 128u + (unsigned)(usw ^ ((k & 1) ? 64 : 0)))); } \
                _Pragma("unroll") for (int q = 0; q < 4; ++q) xs[buf_][q] = *(const GAS l2*)((XP_) + (size_t)(unsigned)(64 * g + (i_) * DM + 16 * q)); } while (0)
        PGU_ISSUE_AT(U8T, X8 + (size_t)t0 * DM, 0, 0);
        for (int p = 0; p < 4; ++p) {
            const unsigned char* Up = U8T + (size_t)p * SLICE;
            const unsigned char* Xp = X8 + (size_t)t0 * DM + 256 * p;
#define PGU_WR(i_, cur_, rb_, S_) do { _Pragma("unroll") for (int q4 = 0; q4 < 4; ++q4) *(LAS v4u*)(tb + 1024 * q4 + 16 * lane) = ab[cur_][4 * (rb_) + q4]; \
                S_##0 = *(const LAS l2*)(tb + urd0); S_##1 = *(const LAS l2*)(tb + urd1); S_##2 = *(const LAS l2*)(tb + 2048 + urd0); S_##3 = *(const LAS l2*)(tb + 2048 + urd1); \
                S_##c0 = *(const LAS f32x4*)(hid + (i_) * 128 + 32 * (rb_) + 4 * g); S_##c1 = *(const LAS f32x4*)(hid + (i_) * 128 + 32 * (rb_) + 16 + 4 * g); } while (0)
#define PGU_MF(i_, cur_, rb_, S_) do { f32x4 acc0 = S_##c0, acc1 = S_##c1; \
                const pgv8i x0_ = pg_cat8(xs[cur_][0], xs[cur_][1]), x1_ = pg_cat8(xs[cur_][2], xs[cur_][3]); \
                acc0 = __builtin_amdgcn_mfma_scale_f32_16x16x128_f8f6f4(pg_fp4_to_fp8(S_##0), x0_, acc0, 1, 1, 0, 0x7f7f7f7f, 0, 0x7f7f7f7f); acc1 = __builtin_amdgcn_mfma_scale_f32_16x16x128_f8f6f4(pg_fp4_to_fp8(S_##2), x0_, acc1, 1, 1, 0, 0x7f7f7f7f, 0, 0x7f7f7f7f); \
                acc0 = __builtin_amdgcn_mfma_scale_f32_16x16x128_f8f6f4(pg_fp4_to_fp8(S_##1), x1_, acc0, 1, 1, 0, 0x7f7f7f7f, 0, 0x7f7f7f7f); acc1 = __builtin_amdgcn_mfma_scale_f32_16x16x128_f8f6f4(pg_fp4_to_fp8(S_##3), x1_, acc1, 1, 1, 0, 0x7f7f7f7f, 0, 0x7f7f7f7f); \
                LAS float* hp_ = hid + (i_) * 128 + 32 * (rb_) + 4 * g; \
                asm volatile("s_nop 7\n\ts_mov_b32 exec_lo, 0x10001\n\ts_mov_b32 exec_hi, 0x10001\n\t" \
                             "ds_write_b128 %0, %1\n\tds_write_b128 %0, %2 offset:64\n\t" \
                             "s_mov_b64 exec, -1" \
                             :: "v"(hp_), "v"(acc0), "v"(acc1) : "memory"); } while (0)
#define PGU_BODY(i_, cur_, nxt_) do { { const bool wr_ = (i_) + 1 == PG_TOK; const int nx_ = wr_ ? 0 : (i_) + 1; const unsigned char* un_ = wr_ ? Up + SLICE : Up; const unsigned char* xn_ = wr_ ? Xp + 256 : Xp; PGU_ISSUE_AT(un_, xn_, nx_, nxt_); } SCHED_FENCE(); \
                l2 fa0, fa1, fa2, fa3, fb0, fb1, fb2, fb3; f32x4 fac0, fac1, fbc0, fbc1; \
                PGU_WR(i_, cur_, 0, fa); PGU_WR(i_, cur_, 1, fb); SCHED_FENCE(); \
                PGU_MF(i_, cur_, 0, fa); SCHED_FENCE(); PGU_WR(i_, cur_, 2, fa); SCHED_FENCE(); \
                PGU_MF(i_, cur_, 1, fb); SCHED_FENCE(); PGU_WR(i_, cur_, 3, fb); SCHED_FENCE(); \
                PGU_MF(i_, cur_, 2, fa); SCHED_FENCE(); PGU_MF(i_, cur_, 3, fb); SCHED_FENCE(); } while (0)
            for (int i2 = 0; i2 < PG_TOK; i2 += 2) { PGU_BODY(i2, 0, 1); PGU_BODY(i2 + 1, 1, 0); }
#undef PGU_BODY
#undef PGU_WR
#undef PGU_MF
            LDS_WAIT(); asm volatile("" ::: "memory");
        }
        { f32x2_t suv[16], gvv[16], hv[16];
          float sxl = SSQ[t0 + (lane & 15)]; sxl = 1.f / sqrtf(sxl * (1.f / DM) + EPS);
#pragma unroll
          for (int i = 0; i < PG_TOK; ++i) { suv[i] = *(const GAS f32x2_t*)(GSU + (size_t)(t0 + i) * NEXP_SEL + 2 * lane); gvv[i] = *(const GAS f32x2_t*)(GATE + (size_t)(t0 + i) * NEXP_SEL + 2 * lane); }
#pragma unroll
          for (int i = 0; i < PG_TOK; ++i) hv[i] = *(const LAS f32x2_t*)(hid + i * 128 + 2 * lane);
          float w0[16], w1[16], am[16];
#pragma unroll
          for (int i = 0; i < PG_TOK; ++i) { const float sx = __builtin_bit_cast(float, __builtin_amdgcn_readlane(__builtin_bit_cast(int, sxl), i));
              w0[i] = gelu_as(hv[i].x * suv[i].x * sx) * gvv[i].x; w1[i] = gelu_as(hv[i].y * suv[i].y * sx) * gvv[i].y; am[i] = fmaxf(fabsf(w0[i]), fabsf(w1[i])); }
#pragma unroll
          for (int o = 1; o < 64; o <<= 1)
#pragma unroll
              for (int i = 0; i < PG_TOK; ++i) am[i] = fmaxf(am[i], __shfl_xor(am[i], o));
          LDS_WAIT(); asm volatile("" ::: "memory");
#pragma unroll
          for (int i = 0; i < PG_TOK; ++i) { const float sa = am[i] > 0.f ? 224.f / am[i] : 1.f;
              const int pk = __builtin_amdgcn_cvt_pk_fp8_f32(w0[i] * sa, w1[i] * sa, 0, false);
              LAS unsigned char* wq = (LAS unsigned char*)(hid + i * 128) + 32 * (lane & 3) + (lane >> 2);
              wq[0] = (unsigned char)pk; wq[16] = (unsigned char)(pk >> 8);
              if (lane == 0) sai[i] = am[i] > 0.f ? am[i] * (1.f / 224.f) : 1.f; }
        }
        LDS_WAIT(); asm volatile("" ::: "memory");
        v4u va[2][16];
#define PGV_ISSUE_AT(VP_, i_, buf_) do { _Pragma("unroll") for (int k = 0; k < 16; ++k) { const unsigned e = idxs[(i_) * 128 + 16 * row8 + k]; va[buf_][k] = *(const GAS v4u*)((VP_) + (size_t)(e * 128u + 16u * (unsigned)piece)); } } while (0)
        PGV_ISSUE_AT(V8T, 0, 0);
        for (int p = 0; p < 8; ++p) {
            const unsigned char* Vp = V8T + (size_t)p * SLICE;
#define PGV_BODY(i_, cur_, nxt_) do { { const bool wr_ = (i_) + 1 == PG_TOK; const int nx_ = wr_ ? 0 : (i_) + 1; const unsigned char* vn_ = wr_ ? Vp + SLICE : Vp; PGV_ISSUE_AT(vn_, nx_, nxt_); } \
                const v4u w4_ = *(const LAS v4u*)((LAS unsigned char*)(hid + (i_) * 128) + 16 * row8); \
                const unsigned ww[4] = {w4_.x, w4_.y, w4_.z, w4_.w}; \
                SCHED_FENCE(); f32x4 cl = (f32x4){0.f, 0.f, 0.f, 0.f}, chh = (f32x4){0.f, 0.f, 0.f, 0.f}; \
                _Pragma("unroll") for (int k = 0; k < 16; ++k) { \
                    const unsigned a8 = ((ww[k >> 2] >> (8 * (k & 3))) & 0xffu) << bsh; const long bop = (long)(bhi ? ((unsigned long long)a8 << 32) : (unsigned long long)a8); \
                    const long alo = (long)(((unsigned long long)va[cur_][k].y << 32) | (unsigned long long)va[cur_][k].x), ahi = (long)(((unsigned long long)va[cur_][k].w << 32) | (unsigned long long)va[cur_][k].z); \
                    cl = __builtin_amdgcn_mfma_f32_16x16x32_fp8_fp8(alo, bop, cl, 0, 0, 0); chh = __builtin_amdgcn_mfma_f32_16x16x32_fp8_fp8(ahi, bop, chh, 0, 0, 0); } \
                SCHED_FENCE(); \
                _Pragma("unroll") for (int i4 = 0; i4 < 4; ++i4) { \
                    cl[i4] += __shfl(cl[i4], (lane + 40) & 63); chh[i4] += __shfl(chh[i4], (lane + 40) & 63); } \
                { const float isa = sai[i_]; LAS unsigned short* ob = (LAS unsigned short*)(tb) + 64 * g + m;         \
                  if (m < 8 && g < 2) { _Pragma("unroll") for (int i4 = 0; i4 < 4; ++i4) { ob[16 * i4] = (unsigned short)f2bf(cl[i4] * isa); ob[16 * i4 + 8] = (unsigned short)f2bf(chh[i4] * isa); } } \
                  const v4u ov = *(const LAS v4u*)(tb + 16 * (lane & 15)); \
                  if (lane < 16) *(GAS v4u*)(PO + (size_t)(t0 + (i_)) * DM + 128 * p + 8 * lane) = ov; } } while (0)
            for (int i2 = 0; i2 < PG_TOK; i2 += 2) { PGV_BODY(i2, 0, 1); PGV_BODY(i2 + 1, 1, 0); }
#undef PGV_BODY
        }
        LDS_WAIT(); asm volatile("" ::: "memory");
        VM_WAIT();
#undef PGU_ISSUE_AT
#undef PGV_ISSUE_AT
        { f32x4 ggv[4];
#pragma unroll
          for (int j = 0; j < 4; ++j) ggv[j] = *((const GAS f32x4*)gf + lane + 64 * j);
          v2u paX[4], pbX[4], haX[4], hbX[4], paY[4], pbY[4], haY[4], hbY[4];
#define PGF_LOAD(S_, i_) do { const GAS v2u* prA = (const GAS v2u*)(PO + (size_t)(t0 + (i_)) * DM) + lane; const GAS v2u* prB = prA + DM / 4; \
              const GAS v2u* hbA = (const GAS v2u*)(HB + (size_t)(t0 + (i_)) * DM) + lane; const GAS v2u* hbB = hbA + DM / 4; \
              _Pragma("unroll") for (int j = 0; j < 4; ++j) { pa##S_[j] = prA[64 * j]; ha##S_[j] = hbA[64 * j]; pb##S_[j] = prB[64 * j]; hb##S_[j] = hbB[64 * j]; } } while (0)
#define PGF_BODY(S_, i_) do { GAS f32x4* hrA = (GAS f32x4*)(F.out + (size_t)(t0 + (i_)) * DM) + lane; GAS f32x4* hrB = hrA + DM / 4; \
              f32x4 ya[4], yb[4]; float sa = 0.f, sb = 0.f; \
              _Pragma("unroll") for (int j = 0; j < 4; ++j) { \
                  ya[j] = (f32x4){bflo(ha##S_[j].x), bfhi(ha##S_[j].x), bflo(ha##S_[j].y), bfhi(ha##S_[j].y)} + (f32x4){bflo(pa##S_[j].x), bfhi(pa##S_[j].x), bflo(pa##S_[j].y), bfhi(pa##S_[j].y)}; \
                  yb[j] = (f32x4){bflo(hb##S_[j].x), bfhi(hb##S_[j].x), bflo(hb##S_[j].y), bfhi(hb##S_[j].y)} + (f32x4){bflo(pb##S_[j].x), bfhi(pb##S_[j].x), bflo(pb##S_[j].y), bfhi(pb##S_[j].y)}; \
                  sa += (ya[j].x * ya[j].x + ya[j].y * ya[j].y) + (ya[j].z * ya[j].z + ya[j].w * ya[j].w); sb += (yb[j].x * yb[j].x + yb[j].y * yb[j].y) + (yb[j].z * yb[j].z + yb[j].w * yb[j].w); } \
              _Pragma("unroll") for (int o = 1; o < 64; o <<= 1) { sa += __shfl_xor(sa, o); sb += __shfl_xor(sb, o); } \
              const float ra = 1.f / sqrtf(sa * (1.f / DM) + EPS), rb = 1.f / sqrtf(sb * (1.f / DM) + EPS); \
              _Pragma("unroll") for (int j = 0; j < 4; ++j) { hrA[64 * j] = ya[j] * ra * ggv[j]; hrB[64 * j] = yb[j] * rb * ggv[j]; } } while (0)
          PGF_LOAD(X, 0);
          for (int i = 0; i < PG_TOK; i += 4) { PGF_LOAD(Y, i + 2); PGF_BODY(X, i); PGF_LOAD(X, (i + 4) & (PG_TOK - 1)); PGF_BODY(Y, i + 2); }
#undef PGF_LOAD
#undef PGF_BODY
        }
        LDS_WAIT(); asm volatile("" ::: "memory");
    }
}

struct Args { const float* in[18]; float* out; unsigned char* ws; int ph_lo, ph_hi; };
__global__ void __launch_bounds__(NWAVES * 64, 2) hymba_fwd(Args args) {
    extern __shared__ __attribute__((aligned(16))) unsigned char lds[];
    Frame F;
    F.lds = (LAS unsigned char*)lds;
    F.MISC = (volatile LAS unsigned*)(F.lds + MISC_OFF);
    F.tid = threadIdx.x; F.lane = F.tid & 63; F.wave = __builtin_amdgcn_readfirstlane(F.tid >> 6);
    F.G = gridDim.x; { const int bx = blockIdx.x; F.vcu = (F.G % 8 == 0) ? (bx % 8) * (F.G / 8) + bx / 8 : bx; }
#pragma unroll
    for (int i = 0; i < 18; ++i) F.in[i] = args.in[i];
    F.out = args.out; F.ws = args.ws;
    for (int u = F.tid; u < (LDS_BYTES - LDSCTL_OFF) / 4; u += NWAVES * 64) ((LAS unsigned*)(F.lds + LDSCTL_OFF))[u] = 0u;
    __syncthreads();
    const int lo = args.ph_lo, hi = args.ph_hi;
    const bool multi = (hi - lo) > 1;
    XcdBarrier bar; bar.bar = (unsigned*)(F.ws + WS_CTL) + CW_BAR; bar.x = 0; bar.st = nullptr;
    if (multi) bar = xcd_barrier_post((unsigned*)(F.ws + WS_CTL) + CW_BAR, F.MISC + 8);
#define IN(k) (lo <= (k) && (k) < hi)
#define SEAM(k) do { if (IN(k) && IN((k) + 1)) xcd_barrier(bar); } while (0)

    if (IN(0)) { p0_prologue(F); } SEAM(0);
    if (IN(1)) {
        pg8::Gemm g{(const pg8::bf16_t*)(F.ws + WS_HN), (const pg8::bf16_t*)(F.ws + WS_WIN), NTOK, INW, DM}; pg8::StaticOrder S; S.init(NTOK, INW, F.G, (int)blockIdx.x);
        pg8::EpiProj E{(pg8::bf16_t*)(F.ws + WS_PROJ), INW, 2, QSCALE};
        pg8::gemm_phase<pg8::EpiProj, pg8::StaticOrder, PG8_ALIGN, PG8_SP2>(F.lds + RING_OFF, g, S, E);
    } SEAM(1);
    if (IN(2)) { hgrn_mfma(F); }
    if (IN(3)) { quant_drain(F); attn_mfma(F, 0); }
    if (IN(3) && IN(4)) xcd_barrier(bar);
    if (IN(4)) {
        pg8::Gemm g{(const pg8::bf16_t*)(F.ws + WS_HN), (const pg8::bf16_t*)(F.ws + WS_WOUT), NTOK, DM, DM}; pg8::StaticOrder S; S.init(NTOK, DM, F.G, (int)blockIdx.x);
        pg8::EpiMix E{DM, F.in[0], F.in[12], (pg8::bf16_t*)(F.ws + WS_HN2), F.ws + WS_X8, (float*)(F.ws + WS_CTL) + CW_SSQ};
        pg8::gemm_phase<pg8::EpiMix, pg8::StaticOrder, PG8_ALIGN, PG8_SP2>(F.lds + RING_OFF, g, S, E);
    }
    if (IN(4) && IN(6)) xcd_barrier(bar);
    if (IN(6)) {
        pg8::Gemm g{(const pg8::bf16_t*)(F.ws + WS_HN2), (const pg8::bf16_t*)(F.ws + WS_W2), NTOK, 2048, DM}; pg8::StaticOrder S; S.init(NTOK, 2048, F.G, (int)blockIdx.x);
        pg8::EpiScaleRow E{(_Float16*)(F.ws + WS_SC), 2048, (const float*)(F.ws + WS_CTL) + CW_SSQ, 1.f / DM, EPS};
        pg8::gemm_phase<pg8::EpiScaleRow, pg8::StaticOrder, PG8_ALIGN, PG8_SP2>(F.lds + RING_OFF, g, S, E);
    } SEAM(6);
    if (IN(7)) { topk_v2(F); }
    if (IN(7) && IN(8)) { VM_WAIT(); }
    if (IN(8)) { peer_sliced(F); }
#undef IN
#undef SEAM
}

extern "C" void kernel_launch(void* const* d_in, const int* in_sizes, int n_in, void* d_out, int out_size, void* d_ws, size_t ws_size, hipStream_t stream) {
    static int grid = 0;
    if (grid == 0) {
        if (n_in != 18 || in_sizes[0] != NTOK * DM || out_size != NTOK * DM || ws_size < WS_END) { fprintf(stderr, "kernel_launch: unexpected shapes (n_in %d, in0 %d, out %d, ws %zu); nothing launched\n", n_in, n_in > 0 ? in_sizes[0] : -1, out_size, ws_size); grid = -1; return; }
        int dev = 0, cus = 0, per_cu = 0;
        if (hipGetDevice(&dev) != hipSuccess || hipDeviceGetAttribute(&cus, hipDeviceAttributeMultiprocessorCount, dev) != hipSuccess) { grid = -1; return; }
        if (hipFuncSetAttribute((const void*)hymba_fwd, hipFuncAttributeMaxDynamicSharedMemorySize, LDS_BYTES) != hipSuccess) { fprintf(stderr, "kernel_launch: hipFuncSetAttribute failed\n"); grid = -1; return; }
        if (hipOccupancyMaxActiveBlocksPerMultiprocessor(&per_cu, (const void*)hymba_fwd, NWAVES * 64, LDS_BYTES) != hipSuccess || per_cu < 1)
            fprintf(stderr, "kernel_launch: note: occupancy query reports %d workgroups per CU\n", per_cu);
        (void)hipGetLastError();
        grid = cus;
    }
    if (grid < 0) return;
    if (hipMemsetAsync((char*)d_ws + WS_CTL, 0, CTL_ZERO_BYTES, stream) != hipSuccess) return;
    Args a{};
    for (int i = 0; i < 18; ++i) a.in[i] = (const float*)d_in[i];
    a.out = (float*)d_out; a.ws = (unsigned char*)d_ws; a.ph_lo = 0; a.ph_hi = 9;
    hipLaunchKernelGGL(hymba_fwd, dim3(grid), dim3(NWAVES * 64), LDS_BYTES, stream, a);
}
```

```cpp
#include <hip/hip_runtime.h>
#include <cstdio>
#include <cstdint>
#include <cmath>
namespace pg8 {
#define PG8_LAS __attribute__((address_space(3)))
typedef unsigned short bf16_t;
typedef short bf16x8 __attribute__((ext_vector_type(8)));
typedef float f32x4 __attribute__((ext_vector_type(4)));
typedef unsigned u32x4 __attribute__((ext_vector_type(4)));
constexpr int BM = 256, BK = 64, HALF = 128, HTB = HALF * BK * 2  , STAGE_BYTES = 8 * HTB, NXCD = 8, WGM = 8;

__host__ __device__ __forceinline__ int lds_byte(int r, int c) { const int st = (r >> 4) * 2 + (c >> 5), rr = r & 15, cc = c & 31, ob = rr * 64 + cc * 2; return st * 1024 + (ob ^ (((ob >> 9) & 1) << 5)); }
__host__ __device__ __forceinline__ void stage_rc(int b, int& R, int& C) { const int st = b / 1024, sb = b % 1024, swz = sb ^ (((sb >> 9) & 1) << 5); R = (st >> 1) * 16 + swz / 64; C = (st & 1) * 32 + (swz % 64) / 2; }
__host__ __device__ __forceinline__ int perm32(int rho) { const int n = rho >> 4, i = rho & 15; return 8 * (i >> 2) + 4 * n + (i & 3); }

struct Unit { int pm, pn; };
struct Gemm { const bf16_t* A; const bf16_t* Bt; int M, N, K; };

struct StaticOrder {
    int nM, nN, nwg, G, c;
    __host__ __device__ void init(int M, int N, int G_, int c_) { nM = M / BM; nN = N / BM; nwg = nM * nN; G = G_; c = c_; }
    __host__ __device__ bool next(int i, Unit& u) const {
        const long L = (long)i * G + c; if (L >= nwg) return false;
        int wgid = (int)L; { const int q = nwg / NXCD, r = nwg % NXCD, xcd = wgid % NXCD, off = wgid / NXCD; wgid = (xcd < r ? xcd * (q + 1) : r * (q + 1) + (xcd - r) * q) + off; }
        const int nig = WGM * nN, gid = wgid / nig, fm = gid * WGM, gsz = (nM - fm) < WGM ? (nM - fm) : WGM;
        u.pm = fm + ((wgid % nig) % gsz); u.pn = (wgid % nig) / gsz; return true;
    }
    __device__ __forceinline__ void a_ready(const Unit&) const {}
    __device__ __forceinline__ void done(const Unit&) const {}
};
__device__ __forceinline__ unsigned cvt_pk_bf16(float lo, float hi) { unsigned r; asm volatile("v_cvt_pk_bf16_f32 %0, %1, %2" : "=v"(r) : "v"(lo), "v"(hi)); return r; }
typedef float f32x2 __attribute__((ext_vector_type(2)));
__device__ __forceinline__ f32x2 gelu_pk(f32x2 v) {
    const f32x2 av = __builtin_elementwise_abs(v), d = av * 0.2316418882f + 1.0f;
    f32x2 t; t.x = __builtin_amdgcn_rcpf(d.x); t.y = __builtin_amdgcn_rcpf(d.y);
    f32x2 q = t * 0.5307027145f + (-0.7265760135f); q = q * t + 0.7107068705f; q = q * t + (-0.142248368f); q = q * t + 0.127414796f; q = q * t;
    const f32x2 s = (v * v) * (-0.72134752044f);
    f32x2 e; e.x = __builtin_amdgcn_exp2f(s.x); e.y = __builtin_amdgcn_exp2f(s.y);
    const f32x2 m = v * (q * e), r = v - m;
    f32x2 o; o.x = v.x < 0.f ? m.x : r.x; o.y = v.y < 0.f ? m.y : r.y; return o;
}
struct EpiProj {
    static constexpr bool PERM = true, AFTER_DRAIN = false;
    bf16_t* O; int ldc; int qtiles; float qscale;
    __device__ __forceinline__ void operator()(const f32x4 (&acc)[2][2][4][2], const Unit& u, int wr, int wc, int fr, int fq) const {
        const int row0 = u.pm * BM + wr * 64 + fr, col0 = u.pn * BM + wc * 32 + 8 * fq;
        const float sc = (u.pn < qtiles) ? qscale : 1.f;
#pragma unroll
        for (int ai = 0; ai < 2; ++ai)
#pragma unroll
            for (int m = 0; m < 4; ++m) { bf16_t* rowp = O + (size_t)(row0 + ai * HALF + m * 16) * ldc + col0;
#pragma unroll
                for (int bj = 0; bj < 2; ++bj) { const f32x4 v0 = acc[ai][bj][m][0] * sc, v1 = acc[ai][bj][m][1] * sc;
                    u32x4 w; w.x = cvt_pk_bf16(v0[0], v0[1]); w.y = cvt_pk_bf16(v0[2], v0[3]); w.z = cvt_pk_bf16(v1[0], v1[1]); w.w = cvt_pk_bf16(v1[2], v1[3]);
                    *(u32x4*)(rowp + bj * HALF) = w; } }
    }
};
struct EpiF32Res {
    static constexpr bool PERM = false, AFTER_DRAIN = false;
    float* C; int ldc; const float* res;
    __device__ __forceinline__ void operator()(const f32x4 (&acc)[2][2][4][2], const Unit& u, int wr, int wc, int fr, int fq) const {
        const int row0 = u.pm * BM + wr * 64 + fr, col0 = u.pn * BM + wc * 32 + 4 * fq;
#pragma unroll
        for (int ai = 0; ai < 2; ++ai)
#pragma unroll
            for (int m = 0; m < 4; ++m) { const size_t off = (size_t)(row0 + ai * HALF + m * 16) * ldc + col0;
#pragma unroll
                for (int bj = 0; bj < 2; ++bj)
#pragma unroll
                    for (int n = 0; n < 2; ++n) { f32x4 o = acc[ai][bj][m][n]; if (res) o = o + *(const f32x4*)(res + off + bj * HALF + n * 16);
                        *(f32x4*)(C + off + bj * HALF + n * 16) = o; } }
    }
};

struct EpiMix {
    static constexpr bool PERM = true, AFTER_DRAIN = false;
    int ldc; const float* res; const float* g2; bf16_t* HB; unsigned char* XB; float* ssq;
    __device__ __forceinline__ void operator()(const f32x4 (&acc)[2][2][4][2], const Unit& u, int wr, int wc, int fr, int fq) const {
        const int row0 = u.pm * BM + wr * 64 + fr, col0 = u.pn * BM + wc * 32 + 8 * fq;
        f32x4 gv[2][2];
#pragma unroll
        for (int bj = 0; bj < 2; ++bj)
#pragma unroll
            for (int n = 0; n < 2; ++n) gv[bj][n] = *(const f32x4*)(g2 + col0 + bj * HALF + 4 * n);
#pragma unroll
        for (int ai = 0; ai < 2; ++ai)
#pragma unroll
            for (int m = 0; m < 4; ++m) { const int row = row0 + ai * HALF + m * 16; const size_t off = (size_t)row * ldc + col0; float sq = 0.f;
#pragma unroll
                for (int bj = 0; bj < 2; ++bj) {
                    const f32x4 h0 = acc[ai][bj][m][0] + *(const f32x4*)(res + off + bj * HALF), h1 = acc[ai][bj][m][1] + *(const f32x4*)(res + off + bj * HALF + 4);
                    sq += (h0[0] * h0[0] + h0[1] * h0[1]) + (h0[2] * h0[2] + h0[3] * h0[3]) + (h1[0] * h1[0] + h1[1] * h1[1]) + (h1[2] * h1[2] + h1[3] * h1[3]);
                    u32x4 w; w.x = cvt_pk_bf16(h0[0], h0[1]); w.y = cvt_pk_bf16(h0[2], h0[3]); w.z = cvt_pk_bf16(h1[0], h1[1]); w.w = cvt_pk_bf16(h1[2], h1[3]);
                    *(u32x4*)(HB + off + bj * HALF) = w;
                    const f32x4 g0 = h0 * gv[bj][0], g1 = h1 * gv[bj][1];
                    int p0 = __builtin_amdgcn_cvt_pk_bf8_f32(g0[0], g0[1], 0, false); p0 = __builtin_amdgcn_cvt_pk_bf8_f32(g0[2], g0[3], p0, true);
                    int p1 = __builtin_amdgcn_cvt_pk_bf8_f32(g1[0], g1[1], 0, false); p1 = __builtin_amdgcn_cvt_pk_bf8_f32(g1[2], g1[3], p1, true);
                    typedef unsigned u32x2 __attribute__((ext_vector_type(2)));
                    *(u32x2*)(XB + off + bj * HALF) = (u32x2){(unsigned)p0, (unsigned)p1}; }
                sq += __shfl_xor(sq, 16); sq += __shfl_xor(sq, 32);
                if (fq == 0) atomicAdd(ssq + row, sq); }
    }
};
struct EpiScaleRow {
    static constexpr bool PERM = true, AFTER_DRAIN = false;
    _Float16* C; int ldc; const float* ssq; float invk, eps;
    __device__ __forceinline__ void operator()(const f32x4 (&acc)[2][2][4][2], const Unit& u, int wr, int wc, int fr, int fq) const {
        typedef _Float16 h2 __attribute__((ext_vector_type(2)));
        const int row0 = u.pm * BM + wr * 64 + fr, col0 = u.pn * BM + wc * 32 + 8 * fq;
#pragma unroll
        for (int ai = 0; ai < 2; ++ai)
#pragma unroll
            for (int m = 0; m < 4; ++m) { const int row = row0 + ai * HALF + m * 16; const size_t off = (size_t)row * ldc + col0; const float rs = 1.f / sqrtf(ssq[row] * invk + eps);
#pragma unroll
                for (int bj = 0; bj < 2; ++bj) { const f32x4 v0 = acc[ai][bj][m][0] * rs, v1 = acc[ai][bj][m][1] * rs;
                    const h2 p0 = {(_Float16)v0[0], (_Float16)v0[1]}, p1 = {(_Float16)v0[2], (_Float16)v0[3]}, p2 = {(_Float16)v1[0], (_Float16)v1[1]}, p3 = {(_Float16)v1[2], (_Float16)v1[3]};
                    u32x4 w; w.x = __builtin_bit_cast(unsigned, p0); w.y = __builtin_bit_cast(unsigned, p1); w.z = __builtin_bit_cast(unsigned, p2); w.w = __builtin_bit_cast(unsigned, p3);
                    *(u32x4*)(C + off + bj * HALF) = w; } }
    }
};
template <class Epi, class Sched, bool ALIGN_EPI = false, bool SP2 = false>
__device__ __forceinline__ void gemm_phase(PG8_LAS unsigned char* lds, const Gemm g, const Sched& S, const Epi& E) {
    const int tid = threadIdx.x, wid = __builtin_amdgcn_readfirstlane(tid >> 6), lane = tid & 63, wr = wid >> 2, wc = wid & 3, fr = lane & 15, fq = lane >> 4;
    const int K = g.K, nt = K / BK;
    unsigned voffA[2], voffB[2];
#pragma unroll
    for (int i = 0; i < 2; ++i) { int R, C; stage_rc(tid * 16 + i * 8192, R, C); const int Rb = Epi::PERM ? ((R & ~31) + perm32(R & 31)) : R;
        voffA[i] = (unsigned)(R * K + C) * 2u; voffB[i] = (unsigned)(Rb * K + C) * 2u; }
    const size_t kstep = (size_t)(BK * 2);
    const size_t hstep = (size_t)HALF * K * 2;
    const size_t tstep = 2 * hstep;
    const unsigned ldsw = (unsigned)wid * 1024u;
    const int aoff = lds_byte(wr * 64 + fr, fq * 8), boff = lds_byte(wc * 32 + fr, fq * 8);
#define PG8_SA(b, h) (((b) * 2 + (h)) * HTB)
#define PG8_SB(b, h) ((4 + (b) * 2 + (h)) * HTB)
#define PG8_STAGE(bufoff, gbase, voff) do { _Pragma("unroll") for (int _i = 0; _i < 2; ++_i) \
        __builtin_amdgcn_global_load_lds((const unsigned*)((const char*)(gbase) + (voff)[_i]), (PG8_LAS unsigned*)(lds + (bufoff) + ldsw + _i * 8192), 16, 0, 0); } while (0)
#define PG8_LDA(dst, b, h) do { _Pragma("unroll") for (int m = 0; m < 4; ++m) _Pragma("unroll") for (int k = 0; k < 2; ++k) dst[m][k] = *(const PG8_LAS bf16x8*)(lds + PG8_SA(b, h) + aoff + m * 2048 + k * 1024); } while (0)
#define PG8_LDB(dst, b, h) do { _Pragma("unroll") for (int n = 0; n < 2; ++n) _Pragma("unroll") for (int k = 0; k < 2; ++k) dst[n][k] = *(const PG8_LAS bf16x8*)(lds + PG8_SB(b, h) + boff + n * 2048 + k * 1024); } while (0)
#define PG8_MMA(ai, bj, At, Bt) do { __builtin_amdgcn_s_setprio(1); _Pragma("unroll") for (int m = 0; m < 4; ++m) _Pragma("unroll") for (int n = 0; n < 2; ++n) _Pragma("unroll") for (int k = 0; k < 2; ++k) \
        acc[ai][bj][m][n] = __builtin_amdgcn_mfma_f32_16x16x32_bf16(Bt[n][k], At[m][k], acc[ai][bj][m][n], 0, 0, 0); __builtin_amdgcn_s_setprio(0); } while (0)
#define PG8_WAIT_V(n) asm volatile("s_waitcnt vmcnt(" #n ")" ::: "memory")
#define PG8_WAIT_L(n) asm volatile("s_waitcnt lgkmcnt(" #n ")" ::: "memory")
#define PG8_BAR __builtin_amdgcn_s_barrier()
#define PG8_SCHED __builtin_amdgcn_sched_barrier(0)
    Unit cur, nxt; int ui = 0;
    if (!S.next(0, cur)) return;
    f32x4 acc[2][2][4][2];
#pragma unroll
    for (int a = 0; a < 2; ++a)
#pragma unroll
        for (int b = 0; b < 2; ++b)
#pragma unroll
            for (int m = 0; m < 4; ++m)
#pragma unroll
                for (int n = 0; n < 2; ++n) acc[a][b][m][n] = (f32x4){0.f, 0.f, 0.f, 0.f};
    bf16x8 At[4][2], B0[2][2], B1[2][2];
    const char* cA = (const char*)g.A + (size_t)cur.pm * tstep; const char* cB = (const char*)g.Bt + (size_t)cur.pn * tstep;
    S.a_ready(cur);
    if constexpr (SP2) {
        PG8_STAGE(PG8_SB(0, 0), cB, voffB); PG8_STAGE(PG8_SB(0, 1), cB + hstep, voffB); PG8_STAGE(PG8_SA(0, 0), cA, voffA); PG8_STAGE(PG8_SA(0, 1), cA + hstep, voffA);
        if (wr == 1) PG8_BAR;
        PG8_WAIT_V(2); PG8_BAR;
        PG8_STAGE(PG8_SB(1, 0), cB + kstep, voffB); PG8_STAGE(PG8_SA(1, 0), cA + kstep, voffA); PG8_STAGE(PG8_SB(1, 1), cB + hstep + kstep, voffB);
        PG8_WAIT_V(6); PG8_BAR;
    } else {
        PG8_STAGE(PG8_SB(0, 0), cB, voffB); PG8_STAGE(PG8_SA(0, 0), cA, voffA); PG8_STAGE(PG8_SB(0, 1), cB + hstep, voffB); PG8_STAGE(PG8_SA(0, 1), cA + hstep, voffA);
        if (wr == 1) PG8_BAR;
        PG8_WAIT_V(4); PG8_BAR;
        PG8_STAGE(PG8_SB(1, 0), cB + kstep, voffB); PG8_STAGE(PG8_SA(1, 0), cA + kstep, voffA); PG8_STAGE(PG8_SB(1, 1), cB + hstep + kstep, voffB);
        PG8_WAIT_V(6); PG8_BAR;
    }
    for (;;) {
        const bool has_next = S.next(ui + 1, nxt);
        const char* nA = has_next ? (const char*)g.A + (size_t)nxt.pm * tstep : cA; const char* nB = has_next ? (const char*)g.Bt + (size_t)nxt.pn * tstep : cB;
        for (int t = 0; t < nt; t += 2) {
            const bool last = (t == nt - 2);
            const char* a1 = cA + (size_t)(t + 1) * kstep;
            const char* a2 = last ? nA : cA + (size_t)(t + 2) * kstep; const char* b2 = last ? nB : cB + (size_t)(t + 2) * kstep;
            const char* a3 = a2 + kstep; const char* b3 = b2 + kstep;
            if (last && has_next) S.a_ready(nxt);
            if constexpr (SP2) {
            PG8_LDB(B0, 0, 0); PG8_LDB(B1, 0, 1); PG8_SCHED; PG8_LDA(At, 0, 0); PG8_STAGE(PG8_SA(1, 1), a1 + hstep, voffA);
            PG8_WAIT_V(8); PG8_WAIT_L(0); PG8_BAR; PG8_MMA(0, 0, At, B0); PG8_MMA(0, 1, At, B1); PG8_BAR; PG8_SCHED;
            PG8_LDA(At, 0, 1); PG8_STAGE(PG8_SB(0, 0), b2, voffB); PG8_STAGE(PG8_SB(0, 1), b2 + hstep, voffB); PG8_STAGE(PG8_SA(0, 0), a2, voffA);
            PG8_WAIT_V(8); PG8_WAIT_L(0); PG8_BAR; PG8_MMA(1, 0, At, B0); PG8_MMA(1, 1, At, B1); PG8_BAR; PG8_SCHED;
            PG8_LDB(B0, 1, 0); PG8_LDB(B1, 1, 1); PG8_SCHED; PG8_LDA(At, 1, 0); PG8_STAGE(PG8_SA(0, 1), a2 + hstep, voffA);
            PG8_WAIT_V(8); PG8_WAIT_L(0); PG8_BAR; PG8_MMA(0, 0, At, B0); PG8_MMA(0, 1, At, B1); PG8_BAR; PG8_SCHED;
            PG8_LDA(At, 1, 1); PG8_STAGE(PG8_SB(1, 0), b3, voffB); PG8_STAGE(PG8_SB(1, 1), b3 + hstep, voffB); PG8_STAGE(PG8_SA(1, 0), a3, voffA);
            PG8_WAIT_V(8); PG8_WAIT_L(0); PG8_BAR; PG8_MMA(1, 0, At, B0); PG8_MMA(1, 1, At, B1); PG8_BAR; PG8_SCHED;
            } else {
            PG8_LDB(B0, 0, 0); PG8_SCHED; PG8_LDA(At, 0, 0); PG8_STAGE(PG8_SA(1, 1), a1 + hstep, voffA);
            PG8_WAIT_L(8); PG8_BAR; PG8_WAIT_L(0); PG8_MMA(0, 0, At, B0); PG8_BAR; PG8_SCHED;
            PG8_LDB(B1, 0, 1); PG8_STAGE(PG8_SB(0, 0), b2, voffB);
            PG8_BAR; PG8_WAIT_L(0); PG8_MMA(0, 1, At, B1); PG8_BAR;
            PG8_LDA(At, 0, 1); PG8_STAGE(PG8_SA(0, 0), a2, voffA);
            PG8_BAR; PG8_WAIT_L(0); PG8_MMA(1, 0, At, B0); PG8_BAR; PG8_SCHED;
            PG8_STAGE(PG8_SB(0, 1), b2 + hstep, voffB);
            PG8_WAIT_V(6); PG8_BAR; PG8_MMA(1, 1, At, B1); PG8_BAR;
            PG8_LDB(B0, 1, 0); PG8_SCHED; PG8_LDA(At, 1, 0); PG8_STAGE(PG8_SA(0, 1), a2 + hstep, voffA);
            PG8_WAIT_L(8); PG8_BAR; PG8_WAIT_L(0); PG8_MMA(0, 0, At, B0); PG8_BAR; PG8_SCHED;
            PG8_LDB(B1, 1, 1); PG8_STAGE(PG8_SB(1, 0), b3, voffB);
            PG8_BAR; PG8_WAIT_L(0); PG8_MMA(0, 1, At, B1); PG8_BAR;
            PG8_LDA(At, 1, 1); PG8_STAGE(PG8_SA(1, 0), a3, voffA);
            PG8_BAR; PG8_WAIT_L(0); PG8_MMA(1, 0, At, B0); PG8_BAR; PG8_SCHED;
            PG8_STAGE(PG8_SB(1, 1), b3 + hstep, voffB);
            PG8_WAIT_V(6); PG8_BAR; PG8_MMA(1, 1, At, B1); PG8_BAR;
            }
        }
        if constexpr (ALIGN_EPI) { if (wr == 0) PG8_BAR; }
        if constexpr (!Epi::AFTER_DRAIN) { E(acc, cur, wr, wc, fr, fq); S.done(cur); }
        if (!has_next) break;
#pragma unroll
        for (int a = 0; a < 2; ++a)
#pragma unroll
            for (int b = 0; b < 2; ++b)
#pragma unroll
                for (int m = 0; m < 4; ++m)
#pragma unroll
                    for (int n = 0; n < 2; ++n) acc[a][b][m][n] = (f32x4){0.f, 0.f, 0.f, 0.f};
        cur = nxt; cA = nA; cB = nB; ++ui;
        if constexpr (ALIGN_EPI) { if (wr == 1) PG8_BAR; }
    }
    PG8_WAIT_V(0);
    if constexpr (!ALIGN_EPI) { if (wr == 0) PG8_BAR; }
    PG8_BAR;
    if constexpr (Epi::AFTER_DRAIN) { E.fused(acc, cur, wr, wc, fr, fq, lds, wid, lane); S.done(cur); }
#undef PG8_SA
#undef PG8_SB
#undef PG8_STAGE
#undef PG8_LDA
#undef PG8_LDB
#undef PG8_MMA
#undef PG8_WAIT_V
#undef PG8_WAIT_L
#undef PG8_BAR
#undef PG8_SCHED
}
}
#ifndef PG8_SP2
#define PG8_SP2 true
#endif
#ifndef PG8_ALIGN
#define PG8_ALIGN true
#endif

constexpr int NWAVES = 8;
constexpr int NTOK = 32768, DM = 1024, SEQ = 2048, NBATCH = 16, INW = 3584;
constexpr int C_DQ = 0, C_DK = 512, C_DV = 1024, C_HQ = 1536, C_HF = 2048, C_HI = 2560, C_HG = 3072;
constexpr float EPS = 1e-6f;
constexpr float QSCALE = 0.125f * 1.4426950408889634f;
constexpr float LAM_INIT = 0.2f;
constexpr int NEXP_SEL = 128;

constexpr size_t MiB = 1u << 20;
constexpr size_t WS_CTL = 0, CTL_ZERO_BYTES = 1 * MiB;
constexpr size_t WS_SMALL = 1 * MiB;
constexpr size_t WS_WIN = 2 * MiB;
constexpr size_t WS_WOUT = 10 * MiB;
constexpr size_t WS_W2 = 12 * MiB;
constexpr size_t WS_U8 = 17 * MiB;
constexpr size_t WS_V8 = 33 * MiB;
constexpr size_t WS_SU = 49 * MiB;
constexpr size_t WS_SV = 49 * MiB + 512 * 1024;
constexpr size_t WS_X8 = 50 * MiB;
constexpr size_t WS_SX = 116 * MiB;
constexpr size_t WS_GSU = 120 * MiB;
constexpr size_t WS_HN = 84 * MiB;
constexpr size_t WS_PROJ = 148 * MiB;
constexpr size_t WS_HN2 = 148 * MiB;
constexpr size_t WS_SC = 212 * MiB;
constexpr size_t WS_PO = 352 * MiB;
constexpr size_t WS_X4 = 420 * MiB;
constexpr size_t WS_IDX = 468 * MiB;
constexpr size_t WS_GATE = 484 * MiB;
constexpr size_t WS_END = 500 * MiB;
constexpr int SM_LB = 0, SM_LAM = 512, SM_BIAS = 1024;
constexpr int CW_BAR = 4096;
constexpr int CW_ATTQ = 8192;
constexpr int CW_SSQ = 131072;

constexpr int RING_OFF = 0, RING_BYTES = 139264;
constexpr int LDSCTL_OFF = RING_BYTES, MISC_OFF = LDSCTL_OFF + 320;
constexpr int LDS_BYTES = 147456;

#define GAS __attribute__((address_space(1)))
#define LAS __attribute__((address_space(3)))
typedef unsigned short bf16;
typedef unsigned v4u __attribute__((ext_vector_type(4)));
typedef unsigned v2u __attribute__((ext_vector_type(2)));
typedef float f32x4 __attribute__((ext_vector_type(4)));
typedef short bf16x8 __attribute__((ext_vector_type(8)));
typedef GAS unsigned gu32;
typedef long l2 __attribute__((ext_vector_type(2)));
typedef int v4i __attribute__((ext_vector_type(4)));
#define RLX_AGENT __ATOMIC_RELAXED, __HIP_MEMORY_SCOPE_AGENT
#define LDS_WAIT() asm volatile("s_waitcnt lgkmcnt(0)" ::: "memory")
#define VM_WAIT() asm volatile("s_waitcnt vmcnt(0)" ::: "memory")
__device__ __forceinline__ unsigned f2bf(float f) { unsigned u = __builtin_bit_cast(unsigned, f); return (u + 0x7fffu + ((u >> 16) & 1u)) >> 16; }
__device__ __forceinline__ unsigned pk2(float lo, float hi) { return f2bf(lo) | (f2bf(hi) << 16); }
__device__ __forceinline__ float bflo(unsigned w) { return __builtin_bit_cast(float, w << 16); }
__device__ __forceinline__ float bfhi(unsigned w) { return __builtin_bit_cast(float, w & 0xffff0000u); }

#define XB_TMO      128
#define XB_XCNT(j)  (256  + 64 * (j))
#define XB_XSUB(j)  (1280 + 64 * (j))
#define XB_XGEN(j)  (2304 + 64 * (j))
#define XB_TOP      3328
#define XB_TOPGEN   3392
#define XCD_BAR_WORDS 3456
#define XB_SPIN_CAP (1u << 18)
__device__ __forceinline__ unsigned xb_ld(unsigned* p)              { return __hip_atomic_load(p, __ATOMIC_RELAXED, __HIP_MEMORY_SCOPE_AGENT); }
__device__ __forceinline__ unsigned xb_add(unsigned* p, unsigned v) { return __hip_atomic_fetch_add(p, v, __ATOMIC_RELAXED, __HIP_MEMORY_SCOPE_AGENT); }
__device__ __forceinline__ unsigned xb_xcc_id() { return (unsigned)__builtin_amdgcn_s_getreg((3 << 11) | 20) & 0xFu; }
#define XB_SPIN(cond, bar) do { unsigned _sp = 0; while (cond) { __builtin_amdgcn_s_sleep(1); \
    if ((++_sp & 255u) == 0u) { if (xb_ld(&(bar)[XB_TMO])) break; if (_sp > XB_SPIN_CAP) { atomicAdd(&(bar)[XB_TMO], 1u); break; } } } } while (0)
struct XcdBarrier { unsigned* bar; unsigned x; volatile LAS unsigned* st; };
__device__ __forceinline__ XcdBarrier xcd_barrier_post(unsigned* bar, volatile LAS unsigned* st) {
    XcdBarrier b; b.bar = bar; b.x = xb_xcc_id(); b.st = st;
    if (threadIdx.x == 0) (void)xb_add(&bar[XB_XCNT(b.x)], 1u);
    return b;
}
__device__ __forceinline__ void xcd_barrier_complete(unsigned* bar, unsigned x, unsigned& nloc, unsigned& nx) {
    const unsigned G = gridDim.x * gridDim.y * gridDim.z;
    unsigned sum, cnt, mine, sp = 0u;
    for (;;) {
        sum = 0u; cnt = 0u; mine = 0u;
#pragma unroll
        for (unsigned j = 0; j < 16; ++j) { const unsigned c = xb_ld(&bar[XB_XCNT(j)]); sum += c; cnt += (c > 0u) ? 1u : 0u; mine = (j == x) ? c : mine; }
        if (sum == G) break;
        __builtin_amdgcn_s_sleep(1);
        if ((++sp & 255u) == 0u) { if (xb_ld(&bar[XB_TMO])) break; if (sp > XB_SPIN_CAP) { atomicAdd(&bar[XB_TMO], 1u); break; } }
    }
    nloc = mine > 0u ? mine : 1u; nx = cnt > 0u ? cnt : 1u;
}
__device__ __forceinline__ void xcd_barrier(const XcdBarrier& b) {
    asm volatile("s_waitcnt vmcnt(0)" ::: "memory");
    __syncthreads();
    if (threadIdx.x == 0) {
        unsigned* bar = b.bar;
        __builtin_amdgcn_s_waitcnt(0);
        unsigned nloc = b.st[0], nx = b.st[1];
        if (nloc == 0u) { xcd_barrier_complete(bar, b.x, nloc, nx); b.st[0] = nloc; b.st[1] = nx; }
        const unsigned old = xb_add(&bar[XB_XSUB(b.x)], 1u);
        const unsigned gen = old / nloc;
        if (old + 1u == (gen + 1u) * nloc) {
            __builtin_amdgcn_fence(__ATOMIC_RELEASE, "agent");
            asm volatile("s_waitcnt vmcnt(0)" ::: "memory");
            const unsigned og = xb_add(&bar[XB_TOP], 1u);
            const unsigned tg = og / nx;
            if (og + 1u == (tg + 1u) * nx) xb_add(&bar[XB_TOPGEN], 1u);
            else XB_SPIN(xb_ld(&bar[XB_TOPGEN]) == tg, bar);
            __builtin_amdgcn_fence(__ATOMIC_ACQUIRE, "agent");
            xb_add(&bar[XB_XGEN(b.x)], 1u);
            asm volatile("s_waitcnt vmcnt(0)" ::: "memory");
        } else {
            XB_SPIN(xb_ld(&bar[XB_XGEN(b.x)]) == gen, bar);
            __builtin_amdgcn_fence(__ATOMIC_ACQUIRE, "agent");
            asm volatile("s_waitcnt vmcnt(0)" ::: "memory");
        }
    }
    __syncthreads();
}

#define SCHED_FENCE() __builtin_amdgcn_sched_barrier(0)
__device__ __forceinline__ float gelu_as(float v) {
    const float av = fabsf(v), t = __builtin_amdgcn_rcpf(av * 0.2316418882f + 1.0f);
    float q = t * 0.5307027145f + (-0.7265760135f); q = q * t + 0.7107068705f; q = q * t + (-0.142248368f); q = q * t + 0.127414796f; q = q * t;
    const float e = __builtin_amdgcn_exp2f((v * v) * (-0.72134752044f));
    const float mm = v * (q * e);
    return v < 0.f ? mm : v - mm;
}
struct Frame {
    LAS unsigned char* lds;
    volatile LAS unsigned* MISC;
    int tid, lane, wave, vcu, G;
    const float* in[18]; float* out; unsigned char* ws;
};
__device__ __forceinline__ float wave_sum(float v) {
#pragma unroll
    for (int o = 1; o < 64; o <<= 1) v += __shfl_xor(v, o);
    return v;
}
__device__ __forceinline__ float sigmoidf_(float x) { return 1.f / (1.f + __expf(-x)); }

__device__ __forceinline__ void p0_transpose_item(const float* W, int K, int N, bf16* WT, int row_off, LAS float* scr, int item, int lane) {
    const int nblk = N / 32, kb = item / nblk, nb = item % nblk, k0 = 64 * kb, n0 = 32 * nb;
#pragma unroll 8
    for (int i = 0; i < 32; ++i) { const int kk = 2 * i + (lane >> 5); scr[kk * 33 + (lane & 31)] = W[(size_t)(k0 + kk) * N + n0 + (lane & 31)]; }
    LDS_WAIT(); asm volatile("" ::: "memory");
    const int c = lane & 7;
#pragma unroll
    for (int j = 0; j < 4; ++j) { const int n = (lane >> 3) + 8 * j; const LAS float* s = scr + (8 * c) * 33 + n;
        v4u o; o.x = pk2(s[0 * 33], s[1 * 33]); o.y = pk2(s[2 * 33], s[3 * 33]); o.z = pk2(s[4 * 33], s[5 * 33]); o.w = pk2(s[6 * 33], s[7 * 33]);
        *(GAS v4u*)(WT + (size_t)(row_off + n0 + n) * K + k0 + 8 * c) = o; }
    LDS_WAIT(); asm volatile("" ::: "memory");
}

__device__ __forceinline__ void quant_vals_fp8(const f32x4 (&v)[4], unsigned char* dst, float* dq, int lane, size_t slice_stride) {
    float mx = 0.f;
#pragma unroll
    for (int j = 0; j < 4; ++j) mx = fmaxf(mx, fmaxf(fmaxf(fabsf(v[j].x), fabsf(v[j].y)), fmaxf(fabsf(v[j].z), fabsf(v[j].w))));
#pragma unroll
    for (int o = 1; o < 64; o <<= 1) mx = fmaxf(mx, __shfl_xor(mx, o));
    const float qs = mx > 0.f ? 224.f / mx : 1.f;
#pragma unroll
    for (int j = 0; j < 4; ++j) { int p = __builtin_amdgcn_cvt_pk_fp8_f32(v[j].x * qs, v[j].y * qs, 0, false); p = __builtin_amdgcn_cvt_pk_fp8_f32(v[j].z * qs, v[j].w * qs, p, true);
        const int d = 4 * lane + 256 * j; *(GAS unsigned*)(dst + (slice_stride ? (size_t)(d >> 7) * slice_stride + (d & 127) : (size_t)d)) = (unsigned)p; }
    if (lane == 0) *dq = mx > 0.f ? mx * (1.f / 224.f) : 1.f;
}
__device__ __forceinline__ void quant_row_fp4(const float* src, unsigned char* dst, float* dq, int lane, size_t slice_stride) {
    const GAS f32x4* xr = (const GAS f32x4*)src + lane; f32x4 v[4];
#pragma unroll
    for (int j = 0; j < 4; ++j) v[j] = xr[64 * j];
    float mx = 0.f;
#pragma unroll
    for (int j = 0; j < 4; ++j) mx = fmaxf(mx, fmaxf(fmaxf(fabsf(v[j].x), fabsf(v[j].y)), fmaxf(fabsf(v[j].z), fabsf(v[j].w))));
#pragma unroll
    for (int o = 1; o < 64; o <<= 1) mx = fmaxf(mx, __shfl_xor(mx, o));
    const float qs = mx > 0.f ? 6.f / mx : 1.f;
#pragma unroll
    for (int j = 0; j < 4; ++j) { unsigned r = 0u;
        r = __builtin_amdgcn_cvt_scalef32_pk_fp4_f32(r, v[j].x * qs, v[j].y * qs, 1.0f, 0); r = __builtin_amdgcn_cvt_scalef32_pk_fp4_f32(r, v[j].z * qs, v[j].w * qs, 1.0f, 1);
        *(GAS unsigned short*)(dst + (size_t)j * slice_stride + 2 * lane) = (unsigned short)r; }
    if (lane == 0) *dq = mx > 0.f ? mx * (1.f / 6.f) : 1.f;
}
__device__ __forceinline__ void quant_row_fp8(const float* src, unsigned char* dst, float* dq, int lane, size_t slice_stride) {
    const GAS f32x4* xr = (const GAS f32x4*)src + lane; f32x4 v[4];
#pragma unroll
    for (int j = 0; j < 4; ++j) v[j] = xr[64 * j];
    quant_vals_fp8(v, dst, dq, lane, slice_stride);
}
__device__ __forceinline__ void p0_prologue(Frame& F) {
    LAS float* scr = (LAS float*)(F.lds + RING_OFF + F.wave * 16384);
    const int gw = F.vcu * NWAVES + F.wave, NGW = F.G * NWAVES;
    bf16* WinT = (bf16*)(F.ws + WS_WIN); bf16* WoutT = (bf16*)(F.ws + WS_WOUT); bf16* W2T = (bf16*)(F.ws + WS_W2);
    float* small = (float*)(F.ws + WS_SMALL);
    if (blockIdx.x == 0) {
        const int t = F.tid;
        { const float l0 = F.in[9][t], l1 = F.in[9][512 + t]; small[SM_LB + t] = 1.f / (1.f + expf(l1 - l0)); }
        { const int h = t >> 7, n = t & 127; int bk;
          if (n < 16) bk = n; else { bk = 16 + (int)(logf((float)n * (1.f / 16.f)) / logf(8.f) * 16.f); bk = bk > 31 ? 31 : bk; }
          small[SM_BIAS + t] = F.in[8][bk * 4 + h] * 1.4426950408889634f; }
        if (F.wave == 0) {
            const float a = wave_sum(F.in[3][F.lane] * F.in[4][F.lane]), b = wave_sum(F.in[5][F.lane] * F.in[6][F.lane]);
            if (F.lane == 0) small[SM_LAM] = expf(a) - expf(b) + LAM_INIT;
        }
    }
    constexpr int I_IN = (DM / 64) * (INW / 32), I_OUT = (DM / 64) * (DM / 32);
    for (int it = gw; it < I_IN + I_OUT; it += NGW) {
        if (it < I_IN) p0_transpose_item(F.in[2], DM, INW, WinT, 0, scr, it, F.lane);
        else p0_transpose_item(F.in[11], DM, DM, WoutT, 0, scr, it - I_IN, F.lane);
    }
    for (int u = F.vcu; u < 256; u += F.G) {
        const int hc = u >> 4, kb = u & 15, k = kb * 64 + F.lane;
        const GAS f32x4* wrow = (const GAS f32x4*)(F.in[13] + (size_t)k * 2048 + hc * 128);
        float a[16];
#pragma unroll
        for (int nn = 0; nn < 16; ++nn) a[nn] = 0.f;
        const float* kr = F.in[14] + ((size_t)hc * 128 + F.wave * 16) * 128;
        for (int i = 0; i < 32; ++i) {
            const f32x4 w = wrow[i];
#pragma unroll
            for (int nn = 0; nn < 16; ++nn) { const float* kk = kr + nn * 128 + 4 * i; a[nn] += (kk[0] * w.x + kk[1] * w.y) + (kk[2] * w.z + kk[3] * w.w); }
        }
        const float g2k = F.in[12][k];
#pragma unroll
        for (int nn = 0; nn < 16; ++nn) W2T[((size_t)hc * 128 + F.wave * 16 + nn) * DM + k] = (bf16)f2bf(a[nn] * g2k);
    }
    bf16* HN = (bf16*)(F.ws + WS_HN);
    for (int m = gw; m < NTOK; m += 2 * NGW) {
        const int m2 = m + NGW;
        const GAS f32x4* xa = (const GAS f32x4*)(F.in[0] + (size_t)m * DM) + F.lane; const GAS f32x4* xb = (const GAS f32x4*)(F.in[0] + (size_t)(m2 < NTOK ? m2 : m) * DM) + F.lane;
        const GAS f32x4* gr = (const GAS f32x4*)F.in[1] + F.lane;
        f32x4 va[4], vb[4]; float sa = 0.f, sb = 0.f;
#pragma unroll
        for (int j = 0; j < 4; ++j) { va[j] = xa[64 * j]; vb[j] = xb[64 * j]; }
#pragma unroll
        for (int j = 0; j < 4; ++j) { sa += (va[j].x * va[j].x + va[j].y * va[j].y) + (va[j].z * va[j].z + va[j].w * va[j].w); sb += (vb[j].x * vb[j].x + vb[j].y * vb[j].y) + (vb[j].z * vb[j].z + vb[j].w * vb[j].w); }
#pragma unroll
        for (int o = 1; o < 64; o <<= 1) { sa += __shfl_xor(sa, o); sb += __shfl_xor(sb, o); }
        const float ra = 1.f / sqrtf(sa * (1.f / DM) + EPS), rb = 1.f / sqrtf(sb * (1.f / DM) + EPS);
        GAS unsigned long long* oa = (GAS unsigned long long*)(HN + (size_t)m * DM) + F.lane; GAS unsigned long long* ob = (GAS unsigned long long*)(HN + (size_t)m2 * DM) + F.lane;
#pragma unroll
        for (int j = 0; j < 4; ++j) { const f32x4 gg = gr[64 * j];
            oa[64 * j] = (unsigned long long)pk2(va[j].x * ra * gg.x, va[j].y * ra * gg.y) | ((unsigned long long)pk2(va[j].z * ra * gg.z, va[j].w * ra * gg.w) << 32);
            if (m2 < NTOK) ob[64 * j] = (unsigned long long)pk2(vb[j].x * rb * gg.x, vb[j].y * rb * gg.y) | ((unsigned long long)pk2(vb[j].z * rb * gg.z, vb[j].w * rb * gg.w) << 32); }
    }
}


constexpr int QCHUNKS = 2 * 16384 / 64;
__device__ __forceinline__ void quant_chunk(Frame& F, int c) {
    unsigned char* U8 = F.ws + WS_U8; unsigned char* V8 = F.ws + WS_V8; float* SU = (float*)(F.ws + WS_SU); float* SV = (float*)(F.ws + WS_SV);
#pragma unroll 1
    for (int k = 0; k < 8; ++k) { const int rr = 64 * c + 8 * F.wave + k;
        if (rr < 16384) quant_row_fp4(F.in[15] + (size_t)rr * DM, U8 + (size_t)rr * 128, SU + rr, F.lane, (size_t)16384 * 128);
        else { const int e = rr - 16384; quant_row_fp8(F.in[16] + (size_t)e * DM, V8 + (size_t)e * 128, SV + e, F.lane, (size_t)16384 * 128); } }
}

__device__ __forceinline__ void quant_drain(Frame& F) {
    unsigned* qctr = (unsigned*)(F.ws + WS_CTL) + CW_ATTQ + 128;
    if (F.tid == 0) F.MISC[13] = __hip_atomic_fetch_add(qctr, 1u, __ATOMIC_RELAXED, __HIP_MEMORY_SCOPE_AGENT);
    for (int it = 0;; ++it) {
        __syncthreads();
        const int qc = (int)F.MISC[13 + (it & 1)];
        if (qc >= QCHUNKS) break;
        unsigned nx = 0u;
        if (F.tid == 0) nx = __hip_atomic_fetch_add(qctr, 1u, __ATOMIC_RELAXED, __HIP_MEMORY_SCOPE_AGENT);
        quant_chunk(F, qc);
        if (F.tid == 0) F.MISC[13 + ((it + 1) & 1)] = nx;
    }
}

typedef float f32x16 __attribute__((ext_vector_type(16)));
typedef short s16x4 __attribute__((ext_vector_type(4)));
typedef short v4i16_t __attribute__((ext_vector_type(4)));
typedef float f32x2_t __attribute__((ext_vector_type(2))); typedef __bf16 bf16x2_t __attribute__((ext_vector_type(2)));
__device__ __forceinline__ unsigned cvtpk_bf16(float lo, float hi) { f32x2_t v = {lo, hi}; bf16x2_t b = __builtin_convertvector(v, bf16x2_t); return __builtin_bit_cast(unsigned, b); }
__device__ __forceinline__ float xhalf_max(float v) { return fmaxf(v, __shfl_xor(v, 32)); }
__device__ __forceinline__ float xhalf_sum(float v) { return v + __shfl_xor(v, 32); }
__device__ __forceinline__ float max3f_(float a, float b, float c) { float r; asm("v_max3_f32 %0, %1, %2, %3" : "=v"(r) : "v"(a), "v"(b), "v"(c)); return r; }
constexpr int AT_KP = 144, AT_VP = 320, AT_K1 = 64 * AT_KP, AT_KS = 2 * AT_K1, AT_V0 = 2 * AT_KS, AT_VS = 64 * AT_VP;
constexpr int AT_XO = 0, AT_YB = 65536, AT_YP = 272, AT_Q = 100864, AT_TAB = AT_Q + 8 * 4096;
static_assert(AT_TAB + 320 * 4 <= RING_BYTES && AT_YB + 4 * 32 * AT_YP <= AT_Q && AT_V0 + 3 * AT_VS <= AT_Q, "attention LDS map");
#define AT_MFMA(a, b, c) __builtin_amdgcn_mfma_f32_32x32x16_bf16(a, b, c, 0, 0, 0)
#define AT_SGB(mask, n) __builtin_amdgcn_sched_group_barrier(mask, n, 0)
__device__ __forceinline__ void attn_mfma(Frame& F, int qslot) {
    const bf16* PROJ = (const bf16*)(F.ws + WS_PROJ); bf16* MIXED = (bf16*)(F.ws + WS_HN);
    const float* small = (const float*)(F.ws + WS_SMALL);
    LAS unsigned char* lds = F.lds;
    LAS float* TAB = (LAS float*)(lds + AT_TAB);
    const int tid = F.tid, lane = F.lane, wave = F.wave, map = wave >> 2, qt = wave & 3, r32 = lane & 31, hi = lane >> 5;
    const int koff = map * AT_K1 + r32 * AT_KP + hi * 16;
    const int voff = AT_V0 + (4 * hi + ((lane & 15) >> 2)) * AT_VP + (16 * ((lane >> 4) & 1) + 4 * (lane & 3)) * 2;
    unsigned* qctr = (unsigned*)(F.ws + WS_CTL) + CW_ATTQ + 64 * qslot;
    if (tid == 0) F.MISC[12] = __hip_atomic_fetch_add(qctr, 1u, __ATOMIC_RELAXED, __HIP_MEMORY_SCOPE_AGENT);
    for (;;) {
        __syncthreads();
        const int L = (int)F.MISC[12];
        if (L >= 1024) break;
        unsigned nxtu = 0u;
        if (tid == 0) nxtu = __hip_atomic_fetch_add(qctr, 1u, __ATOMIC_RELAXED, __HIP_MEMORY_SCOPE_AGENT);
        const int qb = 15 - (L >> 6), bh = L & 63;
        const int b = bh >> 2, h = bh & 3, q0 = qb * 128; const size_t tok0 = (size_t)b * SEQ;
        const int NT = (q0 + 128) / 64;
        int tidu = F.tid; asm volatile("" : "+v"(tidu));
        if (tidu < 320) { const int n = tidu - 96; TAB[tidu] = n < 0 ? -INFINITY : small[SM_BIAS + h * 128 + (n > 127 ? 127 : n)]; }
        bf16x8 qf0, qf1, qf2, qf3;
        { const bf16* qrow = PROJ + (tok0 + q0 + 32 * qt + r32) * INW + C_DQ + h * 128 + map * 64 + 8 * hi;
          qf0 = *(const GAS bf16x8*)(qrow); qf1 = *(const GAS bf16x8*)(qrow + 16); qf2 = *(const GAS bf16x8*)(qrow + 32); qf3 = *(const GAS bf16x8*)(qrow + 48); }
        const unsigned char* projb = (const unsigned char*)PROJ;
        const unsigned ksrc = (unsigned)(((tok0 + (tidu >> 4)) * INW + C_DK + h * 128 + (tidu & 15) * 8) * 2), vsrc = ksrc + (C_DV - C_DK) * 2;
        const int kdst = ((tidu & 15) >> 3) * AT_K1 + (tidu >> 4) * AT_KP + (tidu & 7) * 16, vdst = AT_V0 + (tidu >> 4) * AT_VP + (tidu & 15) * 16;
#define AT_GLD(src, row) (*(const GAS v4u*)(projb + (size_t)((src) + (unsigned)((row) * (INW * 2)))))
        v4u kr[2], vr[2];
#pragma unroll
        for (int i = 0; i < 2; ++i) { kr[i] = AT_GLD(ksrc, 32 * i); vr[i] = AT_GLD(vsrc, 32 * i); }
#pragma unroll
        for (int i = 0; i < 2; ++i) { *(LAS v4u*)(lds + kdst + 32 * i * AT_KP) = kr[i]; *(LAS v4u*)(lds + vdst + 32 * i * AT_VP) = vr[i]; }
#pragma unroll
        for (int i = 0; i < 2; ++i) { kr[i] = AT_GLD(ksrc, 64 + 32 * i); vr[i] = AT_GLD(vsrc, 64 + 32 * i); }
        __syncthreads();
        const float bfar = TAB[96 + 127];
        f32x16 o[4];
#pragma unroll
        for (int mt = 0; mt < 4; ++mt) o[mt] = (f32x16){0.f,0.f,0.f,0.f,0.f,0.f,0.f,0.f,0.f,0.f,0.f,0.f,0.f,0.f,0.f,0.f};
        float mrun = -INFINITY, lsum = 0.f, alpha = 1.f, cexp = 0.f; bool resc = false;
        const int qlo = q0 + 32 * qt, qpos = qlo + r32;
        const int NTW = NT - 1 + (qt >> 1);
        f32x16 pA0, pA1, pB0, pB1;
        int vs_prev = 0, vs_cur = 0, vs_next = AT_VS;
#define AT_ROT() do { vs_prev = vs_cur; vs_cur = vs_next; vs_next = (vs_next == 2 * AT_VS) ? 0 : vs_next + AT_VS; } while (0)
#define AT_Z16 (f32x16){0.f,0.f,0.f,0.f,0.f,0.f,0.f,0.f,0.f,0.f,0.f,0.f,0.f,0.f,0.f,0.f}
#define AT_SBAR() __builtin_amdgcn_sched_barrier(0)
#define AT_PIN(x) asm volatile("" : "+v"(x))
        bf16x8 kAa, kAb, kBa, kBb; s16x4 f0l, f0h, f1l, f1h;
#define AT_KRD2(S, KB, s4) do { k##S##a = *(const LAS bf16x8*)(lds + (KB) + koff + 32 * (s4)); k##S##b = *(const LAS bf16x8*)(lds + (KB) + koff + 32 * AT_KP + 32 * (s4)); } while (0)
#define AT_VRD(Fn, g) do { LAS unsigned char* vp_ = vb_ + (32 * ((g) >> 3) + 16 * (((g) >> 2) & 1)) * AT_VP + 64 * ((g) & 3); \
            Fn##l = __builtin_bit_cast(s16x4, __builtin_amdgcn_ds_read_tr16_b64_v4i16((LAS v4i16_t*)vp_)); Fn##h = __builtin_bit_cast(s16x4, __builtin_amdgcn_ds_read_tr16_b64_v4i16((LAS v4i16_t*)(vp_ + 8 * AT_VP))); } while (0)
#define AT_VFR(Fn) (bf16x8){Fn##l[0], Fn##l[1], Fn##l[2], Fn##l[3], Fn##h[0], Fn##h[1], Fn##h[2], Fn##h[3]}
#define AT_GAPA(MF, RD, FILL, P, g, PK) do { MF; RD; \
            if (FILL) { const float e0_ = P[4 * ((g) & 3)], e1_ = P[4 * ((g) & 3) + 1], e2_ = P[4 * ((g) & 3) + 2], e3_ = P[4 * ((g) & 3) + 3]; \
                sacc_ += e0_; sacc_ += e1_; sacc_ += e2_; sacc_ += e3_; \
                PK[2 * (g)] = __builtin_bit_cast(float, cvtpk_bf16(e0_, e1_)); PK[2 * (g) + 1] = __builtin_bit_cast(float, cvtpk_bf16(e2_, e3_)); AT_PIN(PK); AT_PIN(sacc_); } \
            AT_SBAR(); } while (0)
#define AT_PHASE_A(C0, C1, P0, P1, KB, FILL) do { float sacc_ = 0.f; \
            AT_SBAR(); AT_KRD2(A, KB, 0); AT_SBAR(); \
            AT_GAPA(C0 = AT_MFMA(kAa, qf0, AT_Z16), AT_KRD2(B, KB, 1), FILL, P0, 0, P0); \
            AT_GAPA(C1 = AT_MFMA(kAb, qf0, AT_Z16), (void)0,           FILL, P0, 1, P0); \
            AT_GAPA(C0 = AT_MFMA(kBa, qf1, C0),     AT_KRD2(A, KB, 2), FILL, P0, 2, P0); \
            AT_GAPA(C1 = AT_MFMA(kBb, qf1, C1),     (void)0,           FILL, P0, 3, P0); \
            AT_GAPA(C0 = AT_MFMA(kAa, qf2, C0),     AT_KRD2(B, KB, 3), FILL, P1, 4, P0); \
            AT_GAPA(C1 = AT_MFMA(kAb, qf2, C1),     (void)0,           FILL, P1, 5, P0); \
            AT_GAPA(C0 = AT_MFMA(kBa, qf3, C0),     (void)0,           FILL, P1, 6, P0); \
            AT_GAPA(C1 = AT_MFMA(kBb, qf3, C1),     (void)0,           FILL, P1, 7, P0); \
            lsum += sacc_; } while (0)
#define AT_MID(C0, C1, t) do { float tm, cadd; \
            if (qlo - (64 * (t) + 63) < 127) { \
                const LAS float* rp = TAB + (qpos - 64 * (t) - 4 * hi + 96 - 59); tm = -INFINITY; \
                _Pragma("unroll") for (int r = 0; r < 16; ++r) { const int off = (r & 3) + 8 * (r >> 2); C0[r] += rp[59 - off]; C1[r] += rp[27 - off]; tm = max3f_(tm, C0[r], C1[r]); } \
                cadd = 0.f; \
            } else { \
                tm = max3f_(C0[0], C1[0], C0[1]); \
                _Pragma("unroll") for (int r = 1; r < 15; ++r) tm = max3f_(tm, C1[r], C0[r + 1]); \
                tm = fmaxf(tm, C1[15]); tm += bfar; cadd = bfar; } \
            tm = xhalf_max(tm); resc = false; \
            if (__any(tm > mrun + 8.f)) { const float mnew = fmaxf(mrun, tm); alpha = __builtin_amdgcn_exp2f(mrun - mnew); lsum *= alpha; mrun = mnew; resc = true; } \
            cexp = cadd - mrun; } while (0)
#define AT_EXP(C0, C1) do { _Pragma("unroll") for (int r = 0; r < 16; ++r) { C0[r] = __builtin_amdgcn_exp2f(C0[r] + cexp); C1[r] = __builtin_amdgcn_exp2f(C1[r] + cexp); } } while (0)
#define AT_GAPB(Fn, g, PK, C, DOEXP) do { o[(g) & 3] = AT_MFMA(AT_VFR(Fn), __builtin_bit_cast(bf16x8, (f32x4){PK[4 * ((g) >> 2)], PK[4 * ((g) >> 2) + 1], PK[4 * ((g) >> 2) + 2], PK[4 * ((g) >> 2) + 3]}), o[(g) & 3]); \
            if ((g) + 2 < 16) AT_VRD(Fn, (g) + 2); \
            if (DOEXP) { C[2 * ((g) & 7)] = __builtin_amdgcn_exp2f(C[2 * ((g) & 7)] + cexp); C[2 * ((g) & 7) + 1] = __builtin_amdgcn_exp2f(C[2 * ((g) & 7) + 1] + cexp); AT_PIN(C); } \
            AT_SBAR(); } while (0)
#define AT_PHASE_B(C0, C1, PK, VB, DOEXP) do { LAS unsigned char* vb_ = lds + (VB) + voff; \
            AT_SBAR(); AT_VRD(f0, 0); AT_VRD(f1, 1); AT_SBAR(); \
            AT_GAPB(f0, 0, PK, C0, DOEXP);  AT_GAPB(f1, 1, PK, C0, DOEXP);  AT_GAPB(f0, 2, PK, C0, DOEXP);  AT_GAPB(f1, 3, PK, C0, DOEXP); \
            AT_GAPB(f0, 4, PK, C0, DOEXP);  AT_GAPB(f1, 5, PK, C0, DOEXP);  AT_GAPB(f0, 6, PK, C0, DOEXP);  AT_GAPB(f1, 7, PK, C0, DOEXP); \
            AT_GAPB(f0, 8, PK, C1, DOEXP);  AT_GAPB(f1, 9, PK, C1, DOEXP);  AT_GAPB(f0, 10, PK, C1, DOEXP); AT_GAPB(f1, 11, PK, C1, DOEXP); \
            AT_GAPB(f0, 12, PK, C1, DOEXP); AT_GAPB(f1, 13, PK, C1, DOEXP); AT_GAPB(f0, 14, PK, C1, DOEXP); AT_GAPB(f1, 15, PK, C1, DOEXP); } while (0)
#define AT_RESC() do { if (resc) { _Pragma("unroll") for (int mt = 0; mt < 4; ++mt) o[mt] = o[mt] * alpha; } } while (0)
#define AT_STAGE(t) do { if ((t) + 1 < NT) { \
                _Pragma("unroll") for (int i = 0; i < 2; ++i) { *(LAS v4u*)(lds + (((t) + 1) & 1) * AT_KS + kdst + 32 * i * AT_KP) = kr[i]; *(LAS v4u*)(lds + vs_next + vdst + 32 * i * AT_VP) = vr[i]; } \
                if ((t) + 2 < NT) { _Pragma("unroll") for (int i = 0; i < 2; ++i) { kr[i] = AT_GLD(ksrc, 64 * ((t) + 2) + 32 * i); vr[i] = AT_GLD(vsrc, 64 * ((t) + 2) + 32 * i); } } } \
            __syncthreads(); AT_ROT(); } while (0)
#define AT_STEP(C0, C1, P0, P1, t) do { \
            AT_PHASE_A(C0, C1, P0, P1, ((t) & 1) * AT_KS, 1); \
            AT_MID(C0, C1, t); \
            AT_PHASE_B(C0, C1, P0, vs_prev, 1); \
            AT_RESC(); } while (0)
#define AT_PACK(P0, P1) do { float ps_ = 0.f; \
            _Pragma("unroll") for (int r = 0; r < 16; ++r) ps_ += P0[r] + P1[r]; \
            lsum += ps_; \
            _Pragma("unroll") for (int w = 0; w < 8; ++w) { const float lo_ = P0[2 * w], hi_ = P0[2 * w + 1]; P0[w] = __builtin_bit_cast(float, cvtpk_bf16(lo_, hi_)); } \
            _Pragma("unroll") for (int w = 0; w < 8; ++w) P0[8 + w] = __builtin_bit_cast(float, cvtpk_bf16(P1[2 * w], P1[2 * w + 1])); } while (0)
        AT_PHASE_A(pA0, pA1, pA0, pA1, 0, 0); AT_MID(pA0, pA1, 0); AT_EXP(pA0, pA1); AT_RESC();
        AT_STAGE(0);
        if (tid == 0) F.MISC[12] = nxtu;
        int t = 1;
        for (; t + 1 < NT; t += 2) {
            AT_STEP(pB0, pB1, pA0, pA1, t);     AT_STAGE(t);
            AT_STEP(pA0, pA1, pB0, pB1, t + 1); AT_STAGE(t + 1);
        }
        if (NTW == NT) {
            AT_STEP(pB0, pB1, pA0, pA1, t); AT_ROT();
            AT_PACK(pB0, pB1); AT_PHASE_B(pB0, pB1, pB0, vs_prev, 0);
        } else {
            AT_PACK(pA0, pA1); AT_PHASE_B(pA0, pA1, pA0, vs_prev, 0);
        }
        __syncthreads();
        { int lane_e = F.lane; asm volatile("" : "+v"(lane_e));
        const int lane = lane_e, r32 = lane & 31, hi = lane >> 5;
        const float inv = 1.f / xhalf_sum(lsum);
        LAS float* XO = (LAS float*)(lds + AT_XO) + qt * 4096 + r32;
        if (map == 1) {
            const float sc = inv * small[SM_LAM];
#pragma unroll
            for (int mt = 0; mt < 4; ++mt)
#pragma unroll
                for (int r = 0; r < 16; ++r) XO[(32 * mt + (r & 3) + 8 * (r >> 2) + 4 * hi) * 32] = o[mt][r] * sc;
        }
        __syncthreads();
        if (map == 0) {
            float ss = 0.f;
#pragma unroll
            for (int mt = 0; mt < 4; ++mt)
#pragma unroll
                for (int r = 0; r < 16; ++r) { const float a = o[mt][r] * inv - XO[(32 * mt + (r & 3) + 8 * (r >> 2) + 4 * hi) * 32]; o[mt][r] = a; ss += a * a; }
            ss = xhalf_sum(ss);
            const float rr = (1.f - LAM_INIT) / sqrtf(ss * (1.f / 128.f) + EPS);
            LAS unsigned char* yb = lds + AT_YB + qt * (32 * AT_YP);
#pragma unroll
            for (int mt = 0; mt < 4; ++mt)
#pragma unroll
                for (int r4 = 0; r4 < 4; ++r4) { const int dv = 32 * mt + 8 * r4 + 4 * hi; const f32x4 gg = *(const GAS f32x4*)(F.in[7] + dv);
                    v2u w; w.x = cvtpk_bf16(o[mt][4 * r4] * rr * gg.x, o[mt][4 * r4 + 1] * rr * gg.y); w.y = cvtpk_bf16(o[mt][4 * r4 + 2] * rr * gg.z, o[mt][4 * r4 + 3] * rr * gg.w);
                    *(LAS v2u*)(yb + r32 * AT_YP + dv * 2) = w; }
            LDS_WAIT(); asm volatile("" ::: "memory");
            bf16* obase = MIXED + (tok0 + q0 + 32 * qt) * DM + h * 128;
#pragma unroll
            for (int i = 0; i < 8; ++i) { const int id = lane + 64 * i, row = id >> 4, cch = id & 15;
                const v4u w = *(const LAS v4u*)(yb + row * AT_YP + cch * 16); *(GAS v4u*)(obase + (size_t)row * DM + cch * 8) = w; }
        } }
#undef AT_ROT
#undef AT_GLD
#undef AT_KRD2
#undef AT_VRD
#undef AT_VFR
#undef AT_GAPA
#undef AT_GAPB
#undef AT_PHASE_A
#undef AT_PHASE_B
#undef AT_PACK
#undef AT_MID
#undef AT_EXP
#undef AT_RESC
#undef AT_STAGE
#undef AT_STEP
    }
}

constexpr int HG_P = 288, HG_VP = 320, HG_GP = 272, HG_OP = 136;
constexpr int HG_QD = 0, HG_KI = 32 * HG_P, HG_V = 2 * 32 * HG_P, HG_CD = HG_V + 32 * HG_VP, HG_G = HG_CD + 512, HG_BUF = HG_G + 32 * HG_GP;
constexpr int HG_O = 2 * HG_BUF;
static_assert(HG_O + 32 * HG_OP * 4 <= RING_BYTES, "hgrn LDS map");
__device__ __forceinline__ bf16x8 pack8(const f32x16& x, int s) {
    v4u p; p.x = cvtpk_bf16(x[8 * s], x[8 * s + 1]); p.y = cvtpk_bf16(x[8 * s + 2], x[8 * s + 3]); p.z = cvtpk_bf16(x[8 * s + 4], x[8 * s + 5]); p.w = cvtpk_bf16(x[8 * s + 6], x[8 * s + 7]);
    return __builtin_bit_cast(bf16x8, p);
}
__device__ __forceinline__ bf16x8 tr_pair(LAS unsigned char* p0, LAS unsigned char* p1) {
    const s16x4 lo = __builtin_bit_cast(s16x4, __builtin_amdgcn_ds_read_tr16_b64_v4i16((LAS v4i16_t*)p0));
    const s16x4 hi4 = __builtin_bit_cast(s16x4, __builtin_amdgcn_ds_read_tr16_b64_v4i16((LAS v4i16_t*)p1));
    return (bf16x8){lo[0], lo[1], lo[2], lo[3], hi4[0], hi4[1], hi4[2], hi4[3]};
}
#define DPPF_(x, ctrl) __builtin_bit_cast(float, __builtin_amdgcn_update_dpp(0, __builtin_bit_cast(int, (x)), (ctrl), 0xf, 0xf, true))
__device__ __forceinline__ void hg_prep8(LAS unsigned char* bufp, const v4u rq, const v4u rf, const f32x4 lbA, const f32x4 lbB, int pc, int dk8, int lane) {
    const float lbv[8] = {lbA.x, lbA.y, lbA.z, lbA.w, lbB.x, lbB.y, lbB.z, lbB.w};
    float bb[8], fv[8];
    const unsigned fw[4] = {rf.x, rf.y, rf.z, rf.w}, qw[4] = {rq.x, rq.y, rq.z, rq.w};
#pragma unroll
    for (int i = 0; i < 8; ++i) { const float x = (i & 1) ? bfhi(fw[i >> 1]) : bflo(fw[i >> 1]); const float f = lbv[i] + (1.f - lbv[i]) * __builtin_amdgcn_rcpf(1.f + __expf(-x)); fv[i] = f; bb[i] = f; }
#define HG_SCAN_STEP(ctrl) asm volatile("s_nop 1\n\tv_mul_f32_dpp %0, %0, %0 " ctrl "\n\tv_mul_f32_dpp %1, %1, %1 " ctrl "\n\tv_mul_f32_dpp %2, %2, %2 " ctrl "\n\tv_mul_f32_dpp %3, %3, %3 " ctrl "\n\t" \
        "v_mul_f32_dpp %4, %4, %4 " ctrl "\n\tv_mul_f32_dpp %5, %5, %5 " ctrl "\n\tv_mul_f32_dpp %6, %6, %6 " ctrl "\n\tv_mul_f32_dpp %7, %7, %7 " ctrl \
        : "+v"(bb[0]), "+v"(bb[1]), "+v"(bb[2]), "+v"(bb[3]), "+v"(bb[4]), "+v"(bb[5]), "+v"(bb[6]), "+v"(bb[7]))
    HG_SCAN_STEP("row_shr:1 row_mask:0xf bank_mask:0xf");
    HG_SCAN_STEP("row_shr:2 row_mask:0xf bank_mask:0xf");
    HG_SCAN_STEP("row_shr:4 row_mask:0xf bank_mask:0xf");
    HG_SCAN_STEP("row_shr:8 row_mask:0xf bank_mask:0xf");
    HG_SCAN_STEP("row_bcast:15 row_mask:0xa bank_mask:0xf");
#undef HG_SCAN_STEP
    float qd[8], ki[8];
#pragma unroll
    for (int i = 0; i < 8; ++i) { const float e = bb[i], ei = __builtin_amdgcn_rcpf(bb[i]);
        const float xq = (i & 1) ? bfhi(qw[i >> 1]) : bflo(qw[i >> 1]); const float q = xq * __builtin_amdgcn_rcpf(1.f + __expf(-xq)); const float k = 1.f - fv[i];
        qd[i] = q * e; ki[i] = k * ei; }
    *(LAS v4u*)(bufp + HG_QD + pc * HG_P + dk8 * 2) = (v4u){cvtpk_bf16(qd[0], qd[1]), cvtpk_bf16(qd[2], qd[3]), cvtpk_bf16(qd[4], qd[5]), cvtpk_bf16(qd[6], qd[7])};
    *(LAS v4u*)(bufp + HG_KI + pc * HG_P + dk8 * 2) = (v4u){cvtpk_bf16(ki[0], ki[1]), cvtpk_bf16(ki[2], ki[3]), cvtpk_bf16(ki[4], ki[5]), cvtpk_bf16(ki[6], ki[7])};
    if (pc == 31) { *(LAS f32x4*)(bufp + HG_CD + dk8 * 4) = (f32x4){bb[0], bb[1], bb[2], bb[3]}; *(LAS f32x4*)(bufp + HG_CD + dk8 * 4 + 16) = (f32x4){bb[4], bb[5], bb[6], bb[7]}; }
}
__device__ __forceinline__ void hgrn_mfma(Frame& F) {
    const bf16* PROJ = (const bf16*)(F.ws + WS_PROJ); bf16* MIXED = (bf16*)(F.ws + WS_HN);
    const float* small = (const float*)(F.ws + WS_SMALL);
    LAS unsigned char* lds = F.lds;
    const int tid = F.tid, lane = F.lane, wave = F.wave, r32 = lane & 31, hh = lane >> 5;
    for (int u = F.vcu; u < 64; u += F.G) {
        const int b = u >> 2, h = u & 3; const size_t tok0 = (size_t)b * SEQ;
        __syncthreads();
        if (wave >= 4) {
            const int pt = tid - 256, pc = lane & 31, dkA = 16 * (wave - 4) + 8 * hh;
            const int vcA = pt >> 4, vseg = pt & 15;
            const f32x4 lb0 = *(const GAS f32x4*)(small + SM_LB + h * 128 + dkA), lb1 = *(const GAS f32x4*)(small + SM_LB + h * 128 + dkA + 4);
            const f32x4 lb2 = *(const GAS f32x4*)(small + SM_LB + h * 128 + dkA + 64), lb3 = *(const GAS f32x4*)(small + SM_LB + h * 128 + dkA + 68);
            v4u q0A, f0A, v0A, g0A, q1A, f1A, v1A, g1A, q0B, f0B, v0B, g0B, q1B, f1B, v1B, g1B, q0C, f0C, v0C, g0C, q1C, f1C, v1C, g1C, q0D, f0D, v0D, g0D, q1D, f1D, v1D, g1D;
#define HP_LOAD(S, chn) do { const bf16* p_ = PROJ + (tok0 + 32 * (chn) + pc) * INW + h * 128 + dkA; const bf16* v_ = PROJ + (tok0 + 32 * (chn) + vcA) * INW + h * 128 + vseg * 8; \
            asm volatile("global_load_dwordx4 %0, %1, off" : "=v"(q0##S) : "v"(p_ + C_HQ) : "memory"); \
            asm volatile("global_load_dwordx4 %0, %1, off" : "=v"(f0##S) : "v"(p_ + C_HF) : "memory"); \
            asm volatile("global_load_dwordx4 %0, %1, off" : "=v"(v0##S) : "v"(v_ + C_HI) : "memory"); \
            asm volatile("global_load_dwordx4 %0, %1, off" : "=v"(g0##S) : "v"(v_ + C_HG) : "memory"); \
            asm volatile("global_load_dwordx4 %0, %1, off" : "=v"(q1##S) : "v"(p_ + C_HQ + 64) : "memory"); \
            asm volatile("global_load_dwordx4 %0, %1, off" : "=v"(f1##S) : "v"(p_ + C_HF + 64) : "memory"); \
            asm volatile("global_load_dwordx4 %0, %1, off" : "=v"(v1##S) : "v"(v_ + (size_t)16 * INW + C_HI) : "memory"); \
            asm volatile("global_load_dwordx4 %0, %1, off" : "=v"(g1##S) : "v"(v_ + (size_t)16 * INW + C_HG) : "memory"); } while (0)
#define HP_WAIT(S) asm volatile("s_waitcnt vmcnt(24)" : "+v"(q0##S), "+v"(f0##S), "+v"(v0##S), "+v"(g0##S), "+v"(q1##S), "+v"(f1##S), "+v"(v1##S), "+v"(g1##S) :: "memory")
#define HP_PASS0(S, bufp) do { hg_prep8(bufp, q0##S, f0##S, lb0, lb1, pc, dkA, lane); \
            *(LAS v4u*)((bufp) + HG_V + vcA * HG_VP + vseg * 16) = v0##S; *(LAS v4u*)((bufp) + HG_V + (vcA + 16) * HG_VP + vseg * 16) = v1##S; \
            *(LAS v4u*)((bufp) + HG_G + vcA * HG_GP + vseg * 16) = g0##S; *(LAS v4u*)((bufp) + HG_G + (vcA + 16) * HG_GP + vseg * 16) = g1##S; } while (0)
#define HP_PASS1(S, bufp) hg_prep8(bufp, q1##S, f1##S, lb2, lb3, pc, dkA + 64, lane)
#define HP_CL(c) ((c) < SEQ / 32 ? (c) : SEQ / 32 - 1)
            HP_LOAD(A, 0); HP_LOAD(B, 1); HP_LOAD(C, 2); HP_LOAD(D, 3);
            HP_WAIT(A); HP_PASS0(A, lds); HP_PASS1(A, lds);
            HP_LOAD(A, 4);
            for (int ch4 = 0; ch4 < SEQ / 32; ch4 += 4) {
                __syncthreads();
                HP_WAIT(B); HP_PASS0(B, lds + HG_BUF);
                __syncthreads();
                HP_PASS1(B, lds + HG_BUF); HP_LOAD(B, HP_CL(ch4 + 5));
                __syncthreads();
                HP_WAIT(C); HP_PASS0(C, lds);
                __syncthreads();
                HP_PASS1(C, lds); HP_LOAD(C, HP_CL(ch4 + 6));
                __syncthreads();
                HP_WAIT(D); HP_PASS0(D, lds + HG_BUF);
                __syncthreads();
                HP_PASS1(D, lds + HG_BUF); HP_LOAD(D, HP_CL(ch4 + 7));
                __syncthreads();
                HP_WAIT(A); HP_PASS0(A, lds);
                __syncthreads();
                HP_PASS1(A, lds); HP_LOAD(A, HP_CL(ch4 + 8));
            }
            asm volatile("s_waitcnt vmcnt(0)" : "+v"(q0A), "+v"(f0A), "+v"(v0A), "+v"(g0A), "+v"(q1A), "+v"(f1A), "+v"(v1A), "+v"(g1A), "+v"(q0B), "+v"(f0B), "+v"(v0B), "+v"(g0B), "+v"(q1B), "+v"(f1B), "+v"(v1B), "+v"(g1B) :: "memory");
            asm volatile("" : "+v"(q0C), "+v"(f0C), "+v"(v0C), "+v"(g0C), "+v"(q1C), "+v"(f1C), "+v"(v1C), "+v"(g1C), "+v"(q0D), "+v"(f0D), "+v"(v0D), "+v"(g0D), "+v"(q1D), "+v"(f1D), "+v"(v1D), "+v"(g1D) :: "memory");
#undef HP_CL
#undef HP_LOAD
#undef HP_WAIT
#undef HP_PASS0
#undef HP_PASS1
        } else {
            const int dvt = wave;
            const int kdoff = (((lane & 15) >> 2)) * HG_P + (16 * ((lane >> 4) & 1) + 4 * (lane & 3)) * 2;
            const int troff = (((lane & 15) >> 2)) * HG_VP + (32 * dvt + 16 * ((lane >> 4) & 1) + 4 * (lane & 3)) * 2;
            const int vc = tid >> 3, sg = tid & 7;
            const f32x4 ga0 = *(const GAS f32x4*)(F.in[10] + 8 * sg), ga1 = *(const GAS f32x4*)(F.in[10] + 8 * sg + 4);
            const f32x4 gb0 = *(const GAS f32x4*)(F.in[10] + 64 + 8 * sg), gb1 = *(const GAS f32x4*)(F.in[10] + 64 + 8 * sg + 4);
            f32x16 S0, S1, S2, S3;
#pragma unroll
            for (int r = 0; r < 16; ++r) { S0[r] = 0.f; S1[r] = 0.f; S2[r] = 0.f; S3[r] = 0.f; }
            for (int ch = 0; ch < SEQ / 32; ++ch) {
                LAS unsigned char* bufp = lds + (ch & 1) * HG_BUF;
                __syncthreads();
                f32x16 o, X;
#pragma unroll
                for (int r = 0; r < 16; ++r) { o[r] = 0.f; X[r] = 0.f; }
                bf16x8 qaf[8], kif[8], qdf[8];
                __builtin_amdgcn_sched_barrier(0);
#pragma unroll
                for (int i = 0; i < 8; ++i) { LAS unsigned char* qa = bufp + HG_QD + r32 * HG_P + (16 * i + 4 * hh) * 2;
                    const v2u a0 = *(const LAS v2u*)qa, a1 = *(const LAS v2u*)(qa + 16); qaf[i] = __builtin_bit_cast(bf16x8, (v4u){a0.x, a0.y, a1.x, a1.y}); }
#pragma unroll
                for (int s8 = 0; s8 < 4; ++s8) { kif[s8] = *(const LAS bf16x8*)(bufp + HG_KI + r32 * HG_P + (16 * s8 + 8 * hh) * 2); qdf[s8] = *(const LAS bf16x8*)(bufp + HG_QD + r32 * HG_P + (16 * s8 + 8 * hh) * 2); }
                __builtin_amdgcn_sched_barrier(0);
#pragma unroll
                for (int i = 0; i < 8; ++i)
                    o = __builtin_amdgcn_mfma_f32_32x32x16_bf16(qaf[i], pack8((i >> 1) == 0 ? S0 : (i >> 1) == 1 ? S1 : (i >> 1) == 2 ? S2 : S3, i & 1), o, 0, 0, 0);
#pragma unroll
                for (int s8 = 4; s8 < 8; ++s8) { kif[s8] = *(const LAS bf16x8*)(bufp + HG_KI + r32 * HG_P + (16 * s8 + 8 * hh) * 2); qdf[s8] = *(const LAS bf16x8*)(bufp + HG_QD + r32 * HG_P + (16 * s8 + 8 * hh) * 2); }
                bf16x8 vx0, vx1;
                { LAS unsigned char* vp = bufp + HG_V + troff + (4 * hh) * HG_VP; vx0 = tr_pair(vp, vp + 8 * HG_VP); vx1 = tr_pair(vp + 16 * HG_VP, vp + 24 * HG_VP); }
                __builtin_amdgcn_sched_barrier(0);
#pragma unroll
                for (int s8 = 0; s8 < 8; ++s8) X = __builtin_amdgcn_mfma_f32_32x32x16_bf16(kif[s8], qdf[s8], X, 0, 0, 0);
                __builtin_amdgcn_sched_barrier(0);
#pragma unroll
                for (int r = 0; r < 16; ++r) { const int cp = (r & 3) + 8 * (r >> 2) + 4 * hh; X[r] = cp > r32 ? 0.f : X[r]; }
                o = __builtin_amdgcn_mfma_f32_32x32x16_bf16(pack8(X, 0), vx0, o, 0, 0, 0);
                o = __builtin_amdgcn_mfma_f32_32x32x16_bf16(pack8(X, 1), vx1, o, 0, 0, 0);
                { LAS float* ob = (LAS float*)(lds + HG_O) + 32 * dvt + r32;
#pragma unroll
                  for (int r = 0; r < 16; ++r) ob[((r & 3) + 8 * (r >> 2) + 4 * hh) * HG_OP] = o[r]; }
                __syncthreads();
                { bf16x8 kaf[8], vbf[2];
                  __builtin_amdgcn_sched_barrier(0);
#pragma unroll
                  for (int s2 = 0; s2 < 2; ++s2) { LAS unsigned char* vp = bufp + HG_V + troff + (16 * s2 + 8 * hh) * HG_VP; vbf[s2] = tr_pair(vp, vp + 4 * HG_VP); }
#pragma unroll
                  for (int i = 0; i < 8; ++i) { LAS unsigned char* kp = bufp + HG_KI + kdoff + (16 * (i & 1) + 8 * hh) * HG_P + 32 * (i >> 1) * 2;
                      kaf[i] = tr_pair(kp, kp + 4 * HG_P); }
                  __builtin_amdgcn_sched_barrier(0);
#pragma unroll
                  for (int i = 0; i < 8; ++i) {
                      if ((i >> 1) == 0)      S0 = __builtin_amdgcn_mfma_f32_32x32x16_bf16(kaf[i], vbf[i & 1], S0, 0, 0, 0);
                      else if ((i >> 1) == 1) S1 = __builtin_amdgcn_mfma_f32_32x32x16_bf16(kaf[i], vbf[i & 1], S1, 0, 0, 0);
                      else if ((i >> 1) == 2) S2 = __builtin_amdgcn_mfma_f32_32x32x16_bf16(kaf[i], vbf[i & 1], S2, 0, 0, 0);
                      else                    S3 = __builtin_amdgcn_mfma_f32_32x32x16_bf16(kaf[i], vbf[i & 1], S3, 0, 0, 0);
                  }
                  __builtin_amdgcn_sched_barrier(0); }
#pragma unroll
                for (int kk = 0; kk < 4; ++kk) {
                    const LAS float* cdp = (const LAS float*)(bufp + HG_CD) + 32 * kk + 4 * hh;
#pragma unroll
                    for (int r4 = 0; r4 < 4; ++r4) { const f32x4 c4 = *(const LAS f32x4*)(cdp + 8 * r4);
                        if (kk == 0)      { S0[4 * r4] *= c4.x; S0[4 * r4 + 1] *= c4.y; S0[4 * r4 + 2] *= c4.z; S0[4 * r4 + 3] *= c4.w; }
                        else if (kk == 1) { S1[4 * r4] *= c4.x; S1[4 * r4 + 1] *= c4.y; S1[4 * r4 + 2] *= c4.z; S1[4 * r4 + 3] *= c4.w; }
                        else if (kk == 2) { S2[4 * r4] *= c4.x; S2[4 * r4 + 1] *= c4.y; S2[4 * r4 + 2] *= c4.z; S2[4 * r4 + 3] *= c4.w; }
                        else              { S3[4 * r4] *= c4.x; S3[4 * r4 + 1] *= c4.y; S3[4 * r4 + 2] *= c4.z; S3[4 * r4 + 3] *= c4.w; } }
                }
                { const LAS float* op = (const LAS float*)(lds + HG_O) + vc * HG_OP + 8 * sg;
                  const f32x4 x0 = *(const LAS f32x4*)op, x1 = *(const LAS f32x4*)(op + 4), x2 = *(const LAS f32x4*)(op + 64), x3 = *(const LAS f32x4*)(op + 68);
                  const v4u gwa = *(const LAS v4u*)(bufp + HG_G + vc * HG_GP + sg * 16), gwb = *(const LAS v4u*)(bufp + HG_G + vc * HG_GP + (sg + 8) * 16);
                  float ss = ((x0.x * x0.x + x0.y * x0.y) + (x0.z * x0.z + x0.w * x0.w)) + ((x1.x * x1.x + x1.y * x1.y) + (x1.z * x1.z + x1.w * x1.w))
                           + ((x2.x * x2.x + x2.y * x2.y) + (x2.z * x2.z + x2.w * x2.w)) + ((x3.x * x3.x + x3.y * x3.y) + (x3.z * x3.z + x3.w * x3.w));
                  ss += DPPF_(ss, 0xB1); ss += DPPF_(ss, 0x4E); ss += DPPF_(ss, 0x141);
                  const float rr = __builtin_amdgcn_rsqf(ss * (1.f / 128.f) + EPS);
                  const size_t tok = tok0 + 32 * ch + vc;
                  const unsigned gwa_[4] = {gwa.x, gwa.y, gwa.z, gwa.w}, gwb_[4] = {gwb.x, gwb.y, gwb.z, gwb.w};
                  const float ova[8] = {x0.x, x0.y, x0.z, x0.w, x1.x, x1.y, x1.z, x1.w}, ovb[8] = {x2.x, x2.y, x2.z, x2.w, x3.x, x3.y, x3.z, x3.w};
                  const float gga[8] = {ga0.x, ga0.y, ga0.z, ga0.w, ga1.x, ga1.y, ga1.z, ga1.w}, ggb[8] = {gb0.x, gb0.y, gb0.z, gb0.w, gb1.x, gb1.y, gb1.z, gb1.w};
                  unsigned wa[4], wb[4];
#pragma unroll
                  for (int j = 0; j < 4; ++j) { const float a0 = bflo(gwa_[j]), a1 = bfhi(gwa_[j]), b0 = bflo(gwb_[j]), b1 = bfhi(gwb_[j]);
                      wa[j] = cvtpk_bf16(ova[2 * j] * rr * gga[2 * j] * (a0 * __builtin_amdgcn_rcpf(1.f + __expf(-a0))), ova[2 * j + 1] * rr * gga[2 * j + 1] * (a1 * __builtin_amdgcn_rcpf(1.f + __expf(-a1))));
                      wb[j] = cvtpk_bf16(ovb[2 * j] * rr * ggb[2 * j] * (b0 * __builtin_amdgcn_rcpf(1.f + __expf(-b0))), ovb[2 * j + 1] * rr * ggb[2 * j + 1] * (b1 * __builtin_amdgcn_rcpf(1.f + __expf(-b1)))); }
                  bf16* dst = MIXED + tok * DM + 512 + h * 128 + 8 * sg;
                  *(GAS v4u*)dst = (v4u){wa[0], wa[1], wa[2], wa[3]}; *(GAS v4u*)(dst + 64) = (v4u){wb[0], wb[1], wb[2], wb[3]}; }
            }
        }
    }
}
template <int N> __device__ __forceinline__ unsigned row_ror(unsigned x) { return (unsigned)__builtin_amdgcn_update_dpp((int)x, (int)x, 0x120 + N, 0xf, 0xf, false); }
__device__ __forceinline__ unsigned umax_(unsigned a, unsigned b) { return a > b ? a : b; }
__device__ __forceinline__ unsigned umin_(unsigned a, unsigned b) { return a < b ? a : b; }
__device__ __forceinline__ unsigned row_umax16(unsigned x) {
    unsigned y;
    asm volatile("s_nop 1\n\tv_max_u32_dpp %0, %1, %1 row_ror:1 row_mask:0xf bank_mask:0xf\n\t"
                 "s_nop 1\n\tv_max_u32_dpp %0, %0, %0 row_ror:2 row_mask:0xf bank_mask:0xf\n\t"
                 "s_nop 1\n\tv_max_u32_dpp %0, %0, %0 row_ror:4 row_mask:0xf bank_mask:0xf\n\t"
                 "s_nop 1\n\tv_max_u32_dpp %0, %0, %0 row_ror:8 row_mask:0xf bank_mask:0xf"
                 : "=&v"(y) : "v"(x));
    return y;
}
__device__ __forceinline__ float row_fsum16(float v) {
    v += __builtin_bit_cast(float, row_ror<1>(__builtin_bit_cast(unsigned, v))); v += __builtin_bit_cast(float, row_ror<2>(__builtin_bit_cast(unsigned, v)));
    v += __builtin_bit_cast(float, row_ror<4>(__builtin_bit_cast(unsigned, v))); v += __builtin_bit_cast(float, row_ror<8>(__builtin_bit_cast(unsigned, v))); return v; }
__device__ __forceinline__ unsigned h2key(unsigned x) { return (x & 0x80000000u) ? (~x & 0xffff0000u) : (x | 0x80000000u); }
__device__ __forceinline__ float hkey2f(unsigned k) { const unsigned hb = ((k & 0x80000000u) ? (k & 0x7fff0000u) : (~k & 0xffff0000u)) >> 16; return (float)__builtin_bit_cast(_Float16, (unsigned short)hb); }
__device__ __forceinline__ unsigned f2key(float f) { const unsigned u = __builtin_bit_cast(unsigned, f); return (u & 0x80000000u) ? ~u : (u | 0x80000000u); }
__device__ __forceinline__ float key2f(unsigned k) { const unsigned u = (k & 0x80000000u) ? (k & 0x7fffffffu) : ~k; return __builtin_bit_cast(float, u); }
__device__ __forceinline__ unsigned pair_code(int s) {
    if (s < 16) return (unsigned)s;
    if (s < 24) return 16u + (unsigned)(s - 16);
    if (s < 29) return 32u + (unsigned)(s - 24);
    if (s < 33) return 48u + (unsigned)(s - 29);
    if (s < 36) return 64u + (unsigned)(s - 33);
    if (s < 42) return 80u + 16u * (unsigned)((s - 36) >> 1) + (unsigned)((s - 36) & 1);
    if (s < 50) return 128u + 16u * (unsigned)(s - 42);
    return 0xFFu;
}
#define CAS_(a, b) do { const unsigned hi_ = umax_(a, b), lo_ = umin_(a, b); a = hi_; b = lo_; } while (0)
__device__ __forceinline__ void row_umax16_x2(unsigned xa, unsigned xb, unsigned& ya, unsigned& yb) {
    asm volatile("s_nop 1\n\tv_max_u32_dpp %0, %2, %2 row_ror:1 row_mask:0xf bank_mask:0xf\n\tv_max_u32_dpp %1, %3, %3 row_ror:1 row_mask:0xf bank_mask:0xf\n\t"
                 "s_nop 0\n\tv_max_u32_dpp %0, %0, %0 row_ror:2 row_mask:0xf bank_mask:0xf\n\tv_max_u32_dpp %1, %1, %1 row_ror:2 row_mask:0xf bank_mask:0xf\n\t"
                 "s_nop 0\n\tv_max_u32_dpp %0, %0, %0 row_ror:4 row_mask:0xf bank_mask:0xf\n\tv_max_u32_dpp %1, %1, %1 row_ror:4 row_mask:0xf bank_mask:0xf\n\t"
                 "s_nop 0\n\tv_max_u32_dpp %0, %0, %0 row_ror:8 row_mask:0xf bank_mask:0xf\n\tv_max_u32_dpp %1, %1, %1 row_ror:8 row_mask:0xf bank_mask:0xf"
                 : "=&v"(ya), "=&v"(yb) : "v"(xa), "v"(xb));
}
__device__ __forceinline__ void row_umax16_x4(unsigned xa, unsigned xb, unsigned xc, unsigned xd, unsigned& ya, unsigned& yb, unsigned& yc, unsigned& yd) {
    asm volatile("s_nop 1\n\tv_max_u32_dpp %0, %4, %4 row_ror:1 row_mask:0xf bank_mask:0xf\n\tv_max_u32_dpp %1, %5, %5 row_ror:1 row_mask:0xf bank_mask:0xf\n\t"
                 "v_max_u32_dpp %2, %6, %6 row_ror:1 row_mask:0xf bank_mask:0xf\n\tv_max_u32_dpp %3, %7, %7 row_ror:1 row_mask:0xf bank_mask:0xf\n\t"
                 "v_max_u32_dpp %0, %0, %0 row_ror:2 row_mask:0xf bank_mask:0xf\n\tv_max_u32_dpp %1, %1, %1 row_ror:2 row_mask:0xf bank_mask:0xf\n\t"
                 "v_max_u32_dpp %2, %2, %2 row_ror:2 row_mask:0xf bank_mask:0xf\n\tv_max_u32_dpp %3, %3, %3 row_ror:2 row_mask:0xf bank_mask:0xf\n\t"
                 "v_max_u32_dpp %0, %0, %0 row_ror:4 row_mask:0xf bank_mask:0xf\n\tv_max_u32_dpp %1, %1, %1 row_ror:4 row_mask:0xf bank_mask:0xf\n\t"
                 "v_max_u32_dpp %2, %2, %2 row_ror:4 row_mask:0xf bank_mask:0xf\n\tv_max_u32_dpp %3, %3, %3 row_ror:4 row_mask:0xf bank_mask:0xf\n\t"
                 "v_max_u32_dpp %0, %0, %0 row_ror:8 row_mask:0xf bank_mask:0xf\n\tv_max_u32_dpp %1, %1, %1 row_ror:8 row_mask:0xf bank_mask:0xf\n\t"
                 "v_max_u32_dpp %2, %2, %2 row_ror:8 row_mask:0xf bank_mask:0xf\n\tv_max_u32_dpp %3, %3, %3 row_ror:8 row_mask:0xf bank_mask:0xf"
                 : "=&v"(ya), "=&v"(yb), "=&v"(yc), "=&v"(yd) : "v"(xa), "v"(xb), "v"(xc), "v"(xd));
}
#define TK_LOAD(th_) (*(const GAS v4u*)(SC + (size_t)((th_) >> 3) * 2048 + ((th_) & 7) * 256 + c * 128 + l15 * 8))
#define TK_LOADSORT(P, sv_) \
    unsigned P##0, P##1, P##2, P##3, P##4, P##5, P##6, P##7; \
    { const v4u sv = (sv_); const unsigned nb = 127u - 8u * (unsigned)l15; \
      P##0 = h2key(sv.x << 16) | nb; P##1 = h2key(sv.x & 0xffff0000u) | (nb - 1u); P##2 = h2key(sv.y << 16) | (nb - 2u); P##3 = h2key(sv.y & 0xffff0000u) | (nb - 3u); \
      P##4 = h2key(sv.z << 16) | (nb - 4u); P##5 = h2key(sv.z & 0xffff0000u) | (nb - 5u); P##6 = h2key(sv.w << 16) | (nb - 6u); P##7 = h2key(sv.w & 0xffff0000u) | (nb - 7u); \
      CAS_(P##0, P##1); CAS_(P##2, P##3); CAS_(P##4, P##5); CAS_(P##6, P##7); CAS_(P##0, P##2); CAS_(P##1, P##3); CAS_(P##4, P##6); CAS_(P##5, P##7); CAS_(P##1, P##2); CAS_(P##5, P##6); CAS_(P##0, P##4); CAS_(P##3, P##7); \
      CAS_(P##1, P##5); CAS_(P##2, P##6); CAS_(P##1, P##4); CAS_(P##3, P##6); CAS_(P##2, P##4); CAS_(P##3, P##5); CAS_(P##3, P##4); }
#define TK_POP(P, m_) do { const bool pop_ = (P##0 == (m_)); P##0 = pop_ ? P##1 : P##0; P##1 = pop_ ? P##2 : P##1; P##2 = pop_ ? P##3 : P##2; P##3 = pop_ ? P##4 : P##3; \
      P##4 = pop_ ? P##5 : P##4; P##5 = pop_ ? P##6 : P##5; P##6 = pop_ ? P##7 : P##6; P##7 = pop_ ? 0u : P##7; } while (0)
__device__ __forceinline__ void topk_stage1x2(const v4u svA, const v4u svB, int l15, unsigned& resA, unsigned& resB) {
    TK_LOADSORT(ka, svA) TK_LOADSORT(kb, svB)
    unsigned ra = 0u, rb = 0u;
#pragma unroll
    for (int r = 0; r < 16; ++r) {
        unsigned ma, mb; row_umax16_x2(ka0, kb0, ma, mb);
        TK_POP(ka, ma); TK_POP(kb, mb);
        ra = (l15 == r) ? ma : ra; rb = (l15 == r) ? mb : rb;
    }
    resA = ra; resB = rb;
}
__device__ __forceinline__ void topk_stage1x4(const v4u svA, const v4u svB, const v4u svC, const v4u svD, int l15, unsigned& resA, unsigned& resB, unsigned& resC, unsigned& resD) {
    TK_LOADSORT(ka, svA) TK_LOADSORT(kb, svB) TK_LOADSORT(kc, svC) TK_LOADSORT(kd, svD)
    unsigned ra = 0u, rb = 0u, rc = 0u, rd = 0u;
#pragma unroll
    for (int r = 0; r < 16; ++r) {
        unsigned ma, mb, mc, md; row_umax16_x4(ka0, kb0, kc0, kd0, ma, mb, mc, md);
        TK_POP(ka, ma); TK_POP(kb, mb); TK_POP(kc, mc); TK_POP(kd, md);
        ra = (l15 == r) ? ma : ra; rb = (l15 == r) ? mb : rb; rc = (l15 == r) ? mc : rc; rd = (l15 == r) ? md : rd;
    }
    resA = ra; resB = rb; resC = rc; resD = rd;
}
__device__ __forceinline__ void topk_v2(Frame& F) {
    const unsigned short* SC = (const unsigned short*)(F.ws + WS_SC); int* IDX = (int*)(F.ws + WS_IDX); float* GATE = (float*)(F.ws + WS_GATE); float* GSU = (float*)(F.ws + WS_GSU);
    const float* SU = (const float*)(F.ws + WS_SU); const float* SV = (const float*)(F.ws + WS_SV);
    const int gw = F.vcu * NWAVES + F.wave, NGW = F.G * NWAVES, lane = F.lane, l15 = lane & 15, row = lane >> 4, c = row & 1, rbase = lane & 48;
    const unsigned pc0 = pair_code(l15), pc1 = pair_code(l15 + 16), pc2 = pair_code(l15 + 32), pc3 = pair_code(l15 + 48);
    const int src1 = l15 + 32 * (row & 1), src2 = src1 + 16;
    for (int it0 = gw * 32; it0 < NTOK * 2; it0 += NGW * 32) {
    v4u svA = TK_LOAD(4 * it0 + (row >> 1)), svB = TK_LOAD(4 * it0 + 2 + (row >> 1)), svC = TK_LOAD(4 * it0 + 4 + (row >> 1)), svD = TK_LOAD(4 * it0 + 6 + (row >> 1));
    for (int it = it0; it < it0 + 32; it += 2) {
        const int thb = 4 * it; const int thn = 4 * (it + 2 < it0 + 32 ? it + 2 : it);
        const v4u nvA = TK_LOAD(thn + (row >> 1)), nvB = TK_LOAD(thn + 2 + (row >> 1)), nvC = TK_LOAD(thn + 4 + (row >> 1)), nvD = TK_LOAD(thn + 6 + (row >> 1));
        unsigned resA, resB, resC, resD; topk_stage1x4(svA, svB, svC, svD, l15, resA, resB, resC, resD); svA = nvA; svB = nvB; svC = nvC; svD = nvD;
#define TK_S12(RA_, RB_, S1_, S2_) const unsigned S1_##a = (unsigned)__shfl((int)RA_, src1), S2_##a = (unsigned)__shfl((int)RA_, src2), S1_##b = (unsigned)__shfl((int)RB_, src1), S2_##b = (unsigned)__shfl((int)RB_, src2); \
        const unsigned S1_ = row < 2 ? S1_##a : S1_##b, S2_ = row < 2 ? S2_##a : S2_##b
        TK_S12(resA, resB, S1x, S2x); TK_S12(resC, resD, S1y, S2y);
#undef TK_S12
        unsigned c0, c1, c2, c3, d0, d1, d2, d3;
#define TK_CAND(CK, PC, S1_, S2_) do { const unsigned ka_ = (unsigned)__shfl((int)S1_, rbase + (int)((PC) >> 4 & 15u)), kb_ = (unsigned)__shfl((int)S2_, rbase + (int)((PC) & 15u)); \
            const float sm_ = hkey2f(ka_) + hkey2f(kb_); CK = (PC) == 0xFFu ? 0u : ((f2key(sm_) & ~0xFFu) | (255u - (PC))); } while (0)
        TK_CAND(c0, pc0, S1x, S2x); TK_CAND(c1, pc1, S1x, S2x); TK_CAND(c2, pc2, S1x, S2x); TK_CAND(c3, pc3, S1x, S2x);
        TK_CAND(d0, pc0, S1y, S2y); TK_CAND(d1, pc1, S1y, S2y); TK_CAND(d2, pc2, S1y, S2y); TK_CAND(d3, pc3, S1y, S2y);
#undef TK_CAND
        CAS_(c0, c1); CAS_(c2, c3); CAS_(c0, c2); CAS_(c1, c3); CAS_(c1, c2);
        CAS_(d0, d1); CAS_(d2, d3); CAS_(d0, d2); CAS_(d1, d3); CAS_(d1, d2);
        unsigned res2x = 0u, res2y = 0u;
#pragma unroll
        for (int r = 0; r < 16; ++r) {
            unsigned mx, my; row_umax16_x2(c0, d0, mx, my);
            const bool popx = (c0 == mx), popy = (d0 == my);
            c0 = popx ? c1 : c0; c1 = popx ? c2 : c1; c2 = popx ? c3 : c2; c3 = popx ? 0u : c3;
            d0 = popy ? d1 : d0; d1 = popy ? d2 : d1; d2 = popy ? d3 : d2; d3 = popy ? 0u : d3;
            res2x = (l15 == r) ? mx : res2x; res2y = (l15 == r) ? my : res2y;
        }
#define TK_FIN(RES2_, S1_, S2_, TH_) do { const unsigned code = 255u - ((RES2_) & 0xFFu); \
            const unsigned ka = (unsigned)__shfl((int)S1_, rbase + (int)(code >> 4 & 15u)), kb = (unsigned)__shfl((int)S2_, rbase + (int)(code & 15u)); \
            const float ts = hkey2f(ka) + hkey2f(kb); \
            const int e = (int)((127u - (ka & 0x7Fu)) * 128u + (127u - (kb & 0x7Fu))); \
            const float sve = SV[e], sue = SU[e];                                \
            const float tmax = __builtin_bit_cast(float, (unsigned)__shfl((int)__builtin_bit_cast(unsigned, ts), rbase)); \
            const float ex = __expf(ts - tmax); \
            const float sum = row_fsum16(ex); \
            const int th = (TH_) + row; \
            const size_t o = (size_t)(th >> 3) * NEXP_SEL + (th & 7) * 16 + l15; \
            IDX[o] = e; GATE[o] = ex / sum * sve; GSU[o] = sue; } while (0)
        TK_FIN(res2x, S1x, S2x, thb); TK_FIN(res2y, S1y, S2y, thb + 4);
#undef TK_FIN
    } }
}

constexpr int PG_TOK = 16;
constexpr int PG_IDX = 0, PG_HID = 4096, PG_SA = PG_HID + 8192, PG_TB = PG_SA + 64, PG_WB = PG_TB + 4096;
static_assert(PG_WB % 16 == 0 && PG_TB % 16 == 0 && NWAVES * PG_WB <= RING_BYTES, "gather LDS map");
typedef int pgv4i __attribute__((ext_vector_type(4))); typedef int pgv8i __attribute__((ext_vector_type(8)));
__device__ __forceinline__ pgv8i pg_cat8(const l2 a, const l2 b) { const pgv4i x = __builtin_bit_cast(pgv4i, a), y = __builtin_bit_cast(pgv4i, b); return __builtin_shufflevector(x, y, 0, 1, 2, 3, 4, 5, 6, 7); }
__device__ __forceinline__ pgv8i pg_lo8(const l2 a) { const pgv4i x = __builtin_bit_cast(pgv4i, a); return (pgv8i){x[0], x[1], x[2], x[3], 0, 0, 0, 0}; }
__device__ __forceinline__ void peer_sliced(Frame& F) {
    const unsigned char* U8T = F.ws + WS_U8; const unsigned char* V8T = F.ws + WS_V8; const unsigned char* X8 = F.ws + WS_X8; unsigned char* X4 = F.ws + WS_X4;
    const float* SSQ = (const float*)(F.ws + WS_CTL) + CW_SSQ;
    const int* IDX = (const int*)(F.ws + WS_IDX); const float* GATE = (const float*)(F.ws + WS_GATE); const float* GSU = (const float*)(F.ws + WS_GSU); const float* gf = F.in[17];
    bf16* PO = (bf16*)(F.ws + WS_PO); const bf16* HB = (const bf16*)(F.ws + WS_HN2);
    const int gw = F.vcu * NWAVES + F.wave, NGW = F.G * NWAVES, lane = F.lane, m = lane & 15, g = lane >> 4;
    const int row8 = lane >> 3, piece = lane & 7;
    LAS unsigned char* wb = F.lds + F.wave * PG_WB;
    LAS unsigned short* idxs = (LAS unsigned short*)(wb + PG_IDX);
    LAS float* hid = (LAS float*)(wb + PG_HID);
    LAS float* sqp = hid + 64 + lane;
    LAS float* sai = (LAS float*)(wb + PG_SA);
    LAS unsigned char* tb = wb + PG_TB;
    const int p8 = m & 7; const unsigned bsh = 8u * (unsigned)(p8 & 3); const bool bhi = (p8 >> 2) != 0;
    constexpr size_t SLICE = (size_t)16384 * 128;
    const int usw = 16 * (piece ^ ((row8 >> 1) & 3));
    const int urd0 = m * 128 + 16 * ((2 * g) ^ ((m >> 1) & 7)), urd1 = m * 128 + 16 * ((2 * g + 1) ^ ((m >> 1) & 7));
    for (int blk = gw; blk < NTOK / PG_TOK; blk += NGW) {
        const int t0 = blk * PG_TOK;
#pragma unroll
        for (int k = 0; k < 32; ++k) { const int id = lane + 64 * k;
            idxs[16 * (lane & 7) + (lane >> 3) + 128 * (k >> 1) + 8 * (k & 1)] = (unsigned short)IDX[(size_t)t0 * NEXP_SEL + id]; }
#pragma unroll
        for (int k = 0; k < 8; ++k) *(LAS f32x4*)(hid + 4 * (lane + 64 * k)) = (f32x4){0.f, 0.f, 0.f, 0.f};
        LDS_WAIT(); asm volatile("" ::: "memory");
        float xdq = 1.f;
        { v4u xr[PG_TOK];
#pragma unroll
          for (int i = 0; i < PG_TOK; ++i) xr[i] = *(const GAS v4u*)(X8 + (size_t)(t0 + i) * DM + 16 * lane);
#pragma unroll
          for (int i = 0; i < PG_TOK; ++i) { const unsigned w_[4] = {xr[i].x, xr[i].y, xr[i].z, xr[i].w}; f32x2_t f_[8]; float am = 0.f;
#pragma unroll
              for (int q = 0; q < 4; ++q) { f_[2 * q] = __builtin_amdgcn_cvt_pk_f32_bf8((int)w_[q], false); f_[2 * q + 1] = __builtin_amdgcn_cvt_pk_f32_bf8((int)w_[q], true);
                  am = fmaxf(am, fmaxf(fmaxf(fabsf(f_[2 * q].x), fabsf(f_[2 * q].y)), fmaxf(fabsf(f_[2 * q + 1].x), fabsf(f_[2 * q + 1].y)))); }
#pragma unroll
              for (int o = 1; o < 64; o <<= 1) am = fmaxf(am, __shfl_xor(am, o));
              const float qs = am > 0.f ? 6.f / am : 1.f; unsigned r0 = 0u, r1 = 0u;
              r0 = __builtin_amdgcn_cvt_scalef32_pk_fp4_f32(r0, f_[0].x * qs, f_[0].y * qs, 1.0f, 0); r0 = __builtin_amdgcn_cvt_scalef32_pk_fp4_f32(r0, f_[1].x * qs, f_[1].y * qs, 1.0f, 1);
              r0 = __builtin_amdgcn_cvt_scalef32_pk_fp4_f32(r0, f_[2].x * qs, f_[2].y * qs, 1.0f, 2); r0 = __builtin_amdgcn_cvt_scalef32_pk_fp4_f32(r0, f_[3].x * qs, f_[3].y * qs, 1.0f, 3);
              r1 = __builtin_amdgcn_cvt_scalef32_pk_fp4_f32(r1, f_[4].x * qs, f_[4].y * qs, 1.0f, 0); r1 = __builtin_amdgcn_cvt_scalef32_pk_fp4_f32(r1, f_[5].x * qs, f_[5].y * qs, 1.0f, 1);
              r1 = __builtin_amdgcn_cvt_scalef32_pk_fp4_f32(r1, f_[6].x * qs, f_[6].y * qs, 1.0f, 2); r1 = __builtin_amdgcn_cvt_scalef32_pk_fp4_f32(r1, f_[7].x * qs, f_[7].y * qs, 1.0f, 3);
              *(GAS v2u*)(X4 + (size_t)(t0 + i) * 512 + 8 * lane) = (v2u){r0, r1};
              xdq = lane == i ? (am > 0.f ? am * (1.f / 6.f) : 1.f) : xdq; }
        }
        VM_WAIT();
        v4u ab[2][16]; l2 xs[2][2];
#define PGU_ISSUE_AT(UP_, XP_, i_, buf_) do { _Pragma("unroll") for (int k = 0; k < 16; ++k) { const unsigned e = idxs[(i_) * 128 + 16 * row8 + k]; \
                ab[buf_][k] = *(const GAS v4u*)((UP_) + (size_t)(e * 128u + (unsigned)(usw ^ ((k & 1) ? 64 : 0)))); } \
                _Pragma("unroll") for (int q = 0; q < 2; ++q) xs[buf_][q] = *(const GAS l2*)((XP_) + (size_t)(unsigned)(32 * g + (i_) * 512 + 16 * q)); } while (0)
        PGU_ISSUE_AT(U8T, X4 + (size_t)t0 * 512, 0, 0);
        for (int p = 0; p < 4; ++p) {
            const unsigned char* Up = U8T + (size_t)p * SLICE;
            const unsigned char* Xp = X4 + (size_t)t0 * 512 + 128 * p;
#define PGU_WR(i_, cur_, rb_, S_) do { _Pragma("unroll") for (int q4 = 0; q4 < 4; ++q4) *(LAS v4u*)(tb + 1024 * q4 + 16 * lane) = ab[cur_][4 * (rb_) + q4]; \
                S_##0 = *(const LAS l2*)(tb + urd0); S_##1 = *(const LAS l2*)(tb + urd1); S_##2 = *(const LAS l2*)(tb + 2048 + urd0); S_##3 = *(const LAS l2*)(tb + 2048 + urd1); \
                S_##c0 = *(const LAS f32x4*)(hid + (i_) * 128 + 32 * (rb_) + 4 * g); S_##c1 = *(const LAS f32x4*)(hid + (i_) * 128 + 32 * (rb_) + 16 + 4 * g); } while (0)
#define PGU_MF(i_, cur_, rb_, S_) do { f32x4 acc0 = S_##c0, acc1 = S_##c1; \
                const pgv8i x0_ = pg_lo8(xs[cur_][0]), x1_ = pg_lo8(xs[cur_][1]); \
                acc0 = __builtin_amdgcn_mfma_scale_f32_16x16x128_f8f6f4(pg_lo8(S_##0), x0_, acc0, 4, 4, 0, 0x7f7f7f7f, 0, 0x7f7f7f7f); acc1 = __builtin_amdgcn_mfma_scale_f32_16x16x128_f8f6f4(pg_lo8(S_##2), x0_, acc1, 4, 4, 0, 0x7f7f7f7f, 0, 0x7f7f7f7f); \
                acc0 = __builtin_amdgcn_mfma_scale_f32_16x16x128_f8f6f4(pg_lo8(S_##1), x1_, acc0, 4, 4, 0, 0x7f7f7f7f, 0, 0x7f7f7f7f); acc1 = __builtin_amdgcn_mfma_scale_f32_16x16x128_f8f6f4(pg_lo8(S_##3), x1_, acc1, 4, 4, 0, 0x7f7f7f7f, 0, 0x7f7f7f7f); \
                LAS float* hp_ = hid + (i_) * 128 + 32 * (rb_) + 4 * g; \
                asm volatile("s_nop 7\n\ts_mov_b32 exec_lo, 0x10001\n\ts_mov_b32 exec_hi, 0x10001\n\t" \
                             "ds_write_b128 %0, %1\n\tds_write_b128 %0, %2 offset:64\n\t" \
                             "s_mov_b64 exec, -1" \
                             :: "v"(hp_), "v"(acc0), "v"(acc1) : "memory"); } while (0)
#define PGU_BODY(i_, cur_, nxt_) do { { const bool wr_ = (i_) + 1 == PG_TOK; const int nx_ = wr_ ? 0 : (i_) + 1; const unsigned char* un_ = wr_ ? Up + SLICE : Up; const unsigned char* xn_ = wr_ ? Xp + 128 : Xp; PGU_ISSUE_AT(un_, xn_, nx_, nxt_); } SCHED_FENCE(); \
                l2 fa0, fa1, fa2, fa3, fb0, fb1, fb2, fb3; f32x4 fac0, fac1, fbc0, fbc1; \
                PGU_WR(i_, cur_, 0, fa); PGU_WR(i_, cur_, 1, fb); SCHED_FENCE(); \
                PGU_MF(i_, cur_, 0, fa); SCHED_FENCE(); PGU_WR(i_, cur_, 2, fa); SCHED_FENCE(); \
                PGU_MF(i_, cur_, 1, fb); SCHED_FENCE(); PGU_WR(i_, cur_, 3, fb); SCHED_FENCE(); \
                PGU_MF(i_, cur_, 2, fa); SCHED_FENCE(); PGU_MF(i_, cur_, 3, fb); SCHED_FENCE(); } while (0)
            for (int i2 = 0; i2 < PG_TOK; i2 += 2) { PGU_BODY(i2, 0, 1); PGU_BODY(i2 + 1, 1, 0); }
#undef PGU_BODY
#undef PGU_WR
#undef PGU_MF
            LDS_WAIT(); asm volatile("" ::: "memory");
        }
        { f32x2_t suv[16], gvv[16], hv[16];
          float sxl = SSQ[t0 + (lane & 15)]; sxl = xdq / sqrtf(sxl * (1.f / DM) + EPS);
#pragma unroll
          for (int i = 0; i < PG_TOK; ++i) { suv[i] = *(const GAS f32x2_t*)(GSU + (size_t)(t0 + i) * NEXP_SEL + 2 * lane); gvv[i] = *(const GAS f32x2_t*)(GATE + (size_t)(t0 + i) * NEXP_SEL + 2 * lane); }
#pragma unroll
          for (int i = 0; i < PG_TOK; ++i) hv[i] = *(const LAS f32x2_t*)(hid + i * 128 + 2 * lane);
          float w0[16], w1[16], am[16];
#pragma unroll
          for (int i = 0; i < PG_TOK; ++i) { const float sx = __builtin_bit_cast(float, __builtin_amdgcn_readlane(__builtin_bit_cast(int, sxl), i));
              w0[i] = gelu_as(hv[i].x * suv[i].x * sx) * gvv[i].x; w1[i] = gelu_as(hv[i].y * suv[i].y * sx) * gvv[i].y; am[i] = fmaxf(fabsf(w0[i]), fabsf(w1[i])); }
#pragma unroll
          for (int o = 1; o < 64; o <<= 1)
#pragma unroll
              for (int i = 0; i < PG_TOK; ++i) am[i] = fmaxf(am[i], __shfl_xor(am[i], o));
          LDS_WAIT(); asm volatile("" ::: "memory");
#pragma unroll
          for (int i = 0; i < PG_TOK; ++i) { const float sa = am[i] > 0.f ? 224.f / am[i] : 1.f;
              const int pk = __builtin_amdgcn_cvt_pk_fp8_f32(w0[i] * sa, w1[i] * sa, 0, false);
              LAS unsigned char* wq = (LAS unsigned char*)(hid + i * 128) + 32 * (lane & 3) + (lane >> 2);
              wq[0] = (unsigned char)pk; wq[16] = (unsigned char)(pk >> 8);
              if (lane == 0) sai[i] = am[i] > 0.f ? am[i] * (1.f / 224.f) : 1.f; }
        }
        LDS_WAIT(); asm volatile("" ::: "memory");
        v4u va[2][16];
#define PGV_ISSUE_AT(VP_, i_, buf_) do { _Pragma("unroll") for (int k = 0; k < 16; ++k) { const unsigned e = idxs[(i_) * 128 + 16 * row8 + k]; va[buf_][k] = *(const GAS v4u*)((VP_) + (size_t)(e * 128u + 16u * (unsigned)piece)); } } while (0)
        PGV_ISSUE_AT(V8T, 0, 0);
        for (int p = 0; p < 8; ++p) {
            const unsigned char* Vp = V8T + (size_t)p * SLICE;
#define PGV_BODY(i_, cur_, nxt_) do { { const bool wr_ = (i_) + 1 == PG_TOK; const int nx_ = wr_ ? 0 : (i_) + 1; const unsigned char* vn_ = wr_ ? Vp + SLICE : Vp; PGV_ISSUE_AT(vn_, nx_, nxt_); } \
                const v4u w4_ = *(const LAS v4u*)((LAS unsigned char*)(hid + (i_) * 128) + 16 * row8); \
                const unsigned ww[4] = {w4_.x, w4_.y, w4_.z, w4_.w}; \
                SCHED_FENCE(); f32x4 cl = (f32x4){0.f, 0.f, 0.f, 0.f}, chh = (f32x4){0.f, 0.f, 0.f, 0.f}; \
                _Pragma("unroll") for (int k = 0; k < 16; ++k) { \
                    const unsigned a8 = ((ww[k >> 2] >> (8 * (k & 3))) & 0xffu) << bsh; const long bop = (long)(bhi ? ((unsigned long long)a8 << 32) : (unsigned long long)a8); \
                    const long alo = (long)(((unsigned long long)va[cur_][k].y << 32) | (unsigned long long)va[cur_][k].x), ahi = (long)(((unsigned long long)va[cur_][k].w << 32) | (unsigned long long)va[cur_][k].z); \
                    cl = __builtin_amdgcn_mfma_f32_16x16x32_fp8_fp8(alo, bop, cl, 0, 0, 0); chh = __builtin_amdgcn_mfma_f32_16x16x32_fp8_fp8(ahi, bop, chh, 0, 0, 0); } \
                SCHED_FENCE(); \
                _Pragma("unroll") for (int i4 = 0; i4 < 4; ++i4) { \
                    cl[i4] += __shfl(cl[i4], (lane + 40) & 63); chh[i4] += __shfl(chh[i4], (lane + 40) & 63); } \
                { const float isa = sai[i_]; LAS unsigned short* ob = (LAS unsigned short*)(tb) + 64 * g + m;         \
                  if (m < 8 && g < 2) { _Pragma("unroll") for (int i4 = 0; i4 < 4; ++i4) { ob[16 * i4] = (unsigned short)f2bf(cl[i4] * isa); ob[16 * i4 + 8] = (unsigned short)f2bf(chh[i4] * isa); } } \
                  const v4u ov = *(const LAS v4u*)(tb + 16 * (lane & 15)); \
                  if (lane < 16) *(GAS v4u*)(PO + (size_t)(t0 + (i_)) * DM + 128 * p + 8 * lane) = ov; } } while (0)
            for (int i2 = 0; i2 < PG_TOK; i2 += 2) { PGV_BODY(i2, 0, 1); PGV_BODY(i2 + 1, 1, 0); }
#undef PGV_BODY
        }
        LDS_WAIT(); asm volatile("" ::: "memory");
        VM_WAIT();
#undef PGU_ISSUE_AT
#undef PGV_ISSUE_AT
        { f32x4 ggv[4];
#pragma unroll
          for (int j = 0; j < 4; ++j) ggv[j] = *((const GAS f32x4*)gf + lane + 64 * j);
          v2u paX[4], pbX[4], haX[4], hbX[4], paY[4], pbY[4], haY[4], hbY[4];
#define PGF_LOAD(S_, i_) do { const GAS v2u* prA = (const GAS v2u*)(PO + (size_t)(t0 + (i_)) * DM) + lane; const GAS v2u* prB = prA + DM / 4; \
              const GAS v2u* hbA = (const GAS v2u*)(HB + (size_t)(t0 + (i_)) * DM) + lane; const GAS v2u* hbB = hbA + DM / 4; \
              _Pragma("unroll") for (int j = 0; j < 4; ++j) { pa##S_[j] = prA[64 * j]; ha##S_[j] = hbA[64 * j]; pb##S_[j] = prB[64 * j]; hb##S_[j] = hbB[64 * j]; } } while (0)
#define PGF_BODY(S_, i_) do { GAS f32x4* hrA = (GAS f32x4*)(F.out + (size_t)(t0 + (i_)) * DM) + lane; GAS f32x4* hrB = hrA + DM / 4; \
              f32x4 ya[4], yb[4]; float sa = 0.f, sb = 0.f; \
              _Pragma("unroll") for (int j = 0; j < 4; ++j) { \
                  ya[j] = (f32x4){bflo(ha##S_[j].x), bfhi(ha##S_[j].x), bflo(ha##S_[j].y), bfhi(ha##S_[j].y)} + (f32x4){bflo(pa##S_[j].x), bfhi(pa##S_[j].x), bflo(pa##S_[j].y), bfhi(pa##S_[j].y)}; \
                  yb[j] = (f32x4){bflo(hb##S_[j].x), bfhi(hb##S_[j].x), bflo(hb##S_[j].y), bfhi(hb##S_[j].y)} + (f32x4){bflo(pb##S_[j].x), bfhi(pb##S_[j].x), bflo(pb##S_[j].y), bfhi(pb##S_[j].y)}; \
                  sa += (ya[j].x * ya[j].x + ya[j].y * ya[j].y) + (ya[j].z * ya[j].z + ya[j].w * ya[j].w); sb += (yb[j].x * yb[j].x + yb[j].y * yb[j].y) + (yb[j].z * yb[j].z + yb[j].w * yb[j].w); } \
              _Pragma("unroll") for (int o = 1; o < 64; o <<= 1) { sa += __shfl_xor(sa, o); sb += __shfl_xor(sb, o); } \
              const float ra = 1.f / sqrtf(sa * (1.f / DM) + EPS), rb = 1.f / sqrtf(sb * (1.f / DM) + EPS); \
              _Pragma("unroll") for (int j = 0; j < 4; ++j) { hrA[64 * j] = ya[j] * ra * ggv[j]; hrB[64 * j] = yb[j] * rb * ggv[j]; } } while (0)
          PGF_LOAD(X, 0);
          for (int i = 0; i < PG_TOK; i += 4) { PGF_LOAD(Y, i + 2); PGF_BODY(X, i); PGF_LOAD(X, (i + 4) & (PG_TOK - 1)); PGF_BODY(Y, i + 2); }
#undef PGF_LOAD
#undef PGF_BODY
        }
        LDS_WAIT(); asm volatile("" ::: "memory");
    }
}

struct Args { const float* in[18]; float* out; unsigned char* ws; int ph_lo, ph_hi; };
__global__ void __launch_bounds__(NWAVES * 64, 2) hymba_fwd(Args args) {
    extern __shared__ __attribute__((aligned(16))) unsigned char lds[];
    Frame F;
    F.lds = (LAS unsigned char*)lds;
    F.MISC = (volatile LAS unsigned*)(F.lds + MISC_OFF);
    F.tid = threadIdx.x; F.lane = F.tid & 63; F.wave = __builtin_amdgcn_readfirstlane(F.tid >> 6);
    F.G = gridDim.x; { const int bx = blockIdx.x; F.vcu = (F.G % 8 == 0) ? (bx % 8) * (F.G / 8) + bx / 8 : bx; }
#pragma unroll
    for (int i = 0; i < 18; ++i) F.in[i] = args.in[i];
    F.out = args.out; F.ws = args.ws;
    for (int u = F.tid; u < (LDS_BYTES - LDSCTL_OFF) / 4; u += NWAVES * 64) ((LAS unsigned*)(F.lds + LDSCTL_OFF))[u] = 0u;
    __syncthreads();
    const int lo = args.ph_lo, hi = args.ph_hi;
    const bool multi = (hi - lo) > 1;
    XcdBarrier bar; bar.bar = (unsigned*)(F.ws + WS_CTL) + CW_BAR; bar.x = 0; bar.st = nullptr;
    if (multi) bar = xcd_barrier_post((unsigned*)(F.ws + WS_CTL) + CW_BAR, F.MISC + 8);
#define IN(k) (lo <= (k) && (k) < hi)
#define SEAM(k) do { if (IN(k) && IN((k) + 1)) xcd_barrier(bar); } while (0)

    if (IN(0)) { p0_prologue(F); } SEAM(0);
    if (IN(1)) {
        pg8::Gemm g{(const pg8::bf16_t*)(F.ws + WS_HN), (const pg8::bf16_t*)(F.ws + WS_WIN), NTOK, INW, DM}; pg8::StaticOrder S; S.init(NTOK, INW, F.G, (int)blockIdx.x);
        pg8::EpiProj E{(pg8::bf16_t*)(F.ws + WS_PROJ), INW, 2, QSCALE};
        pg8::gemm_phase<pg8::EpiProj, pg8::StaticOrder, PG8_ALIGN, PG8_SP2>(F.lds + RING_OFF, g, S, E);
    } SEAM(1);
    if (IN(2)) { hgrn_mfma(F); }
    if (IN(3)) { quant_drain(F); attn_mfma(F, 0); }
    if (IN(3) && IN(4)) xcd_barrier(bar);
    if (IN(4)) {
        pg8::Gemm g{(const pg8::bf16_t*)(F.ws + WS_HN), (const pg8::bf16_t*)(F.ws + WS_WOUT), NTOK, DM, DM}; pg8::StaticOrder S; S.init(NTOK, DM, F.G, (int)blockIdx.x);
        pg8::EpiMix E{DM, F.in[0], F.in[12], (pg8::bf16_t*)(F.ws + WS_HN2), F.ws + WS_X8, (float*)(F.ws + WS_CTL) + CW_SSQ};
        pg8::gemm_phase<pg8::EpiMix, pg8::StaticOrder, PG8_ALIGN, PG8_SP2>(F.lds + RING_OFF, g, S, E);
    }
    if (IN(4) && IN(6)) xcd_barrier(bar);
    if (IN(6)) {
        pg8::Gemm g{(const pg8::bf16_t*)(F.ws + WS_HN2), (const pg8::bf16_t*)(F.ws + WS_W2), NTOK, 2048, DM}; pg8::StaticOrder S; S.init(NTOK, 2048, F.G, (int)blockIdx.x);
        pg8::EpiScaleRow E{(_Float16*)(F.ws + WS_SC), 2048, (const float*)(F.ws + WS_CTL) + CW_SSQ, 1.f / DM, EPS};
        pg8::gemm_phase<pg8::EpiScaleRow, pg8::StaticOrder, PG8_ALIGN, PG8_SP2>(F.lds + RING_OFF, g, S, E);
    } SEAM(6);
    if (IN(7)) { topk_v2(F); }
    if (IN(7) && IN(8)) { VM_WAIT(); }
    if (IN(8)) { peer_sliced(F); }
#undef IN
#undef SEAM
}

extern "C" void kernel_launch(void* const* d_in, const int* in_sizes, int n_in, void* d_out, int out_size, void* d_ws, size_t ws_size, hipStream_t stream) {
    static int grid = 0;
    if (grid == 0) {
        if (n_in != 18 || in_sizes[0] != NTOK * DM || out_size != NTOK * DM || ws_size < WS_END) { fprintf(stderr, "kernel_launch: unexpected shapes (n_in %d, in0 %d, out %d, ws %zu); nothing launched\n", n_in, n_in > 0 ? in_sizes[0] : -1, out_size, ws_size); grid = -1; return; }
        int dev = 0, cus = 0, per_cu = 0;
        if (hipGetDevice(&dev) != hipSuccess || hipDeviceGetAttribute(&cus, hipDeviceAttributeMultiprocessorCount, dev) != hipSuccess) { grid = -1; return; }
        if (hipFuncSetAttribute((const void*)hymba_fwd, hipFuncAttributeMaxDynamicSharedMemorySize, LDS_BYTES) != hipSuccess) { fprintf(stderr, "kernel_launch: hipFuncSetAttribute failed\n"); grid = -1; return; }
        if (hipOccupancyMaxActiveBlocksPerMultiprocessor(&per_cu, (const void*)hymba_fwd, NWAVES * 64, LDS_BYTES) != hipSuccess || per_cu < 1)
            fprintf(stderr, "kernel_launch: note: occupancy query reports %d workgroups per CU\n", per_cu);
        (void)hipGetLastError();
        grid = cus;
    }
    if (grid < 0) return;
    if (hipMemsetAsync((char*)d_ws + WS_CTL, 0, CTL_ZERO_BYTES, stream) != hipSuccess) return;
    Args a{};
    for (int i = 0; i < 18; ++i) a.in[i] = (const float*)d_in[i];
    a.out = (float*)d_out; a.ws = (unsigned char*)d_ws; a.ph_lo = 0; a.ph_hi = 9;
    hipLaunchKernelGGL(hymba_fwd, dim3(grid), dim3(NWAVES * 64), LDS_BYTES, stream, a);
}
```

```cpp
#include <hip/hip_runtime.h>
#include <cstdio>
#include <cstdint>
#include <cmath>
namespace pg8 {
#define PG8_LAS __attribute__((address_space(3)))
typedef unsigned short bf16_t;
typedef short bf16x8 __attribute__((ext_vector_type(8)));
typedef float f32x4 __attribute__((ext_vector_type(4)));
typedef unsigned u32x4 __attribute__((ext_vector_type(4)));
constexpr int BM = 256, BK = 64, HALF = 128, HTB = HALF * BK * 2  , STAGE_BYTES = 8 * HTB, NXCD = 8, WGM = 8;

__host__ __device__ __forceinline__ int lds_byte(int r, int c) { const int st = (r >> 4) * 2 + (c >> 5), rr = r & 15, cc = c & 31, ob = rr * 64 + cc * 2; return st * 1024 + (ob ^ (((ob >> 9) & 1) << 5)); }
__host__ __device__ __forceinline__ void stage_rc(int b, int& R, int& C) { const int st = b / 1024, sb = b % 1024, swz = sb ^ (((sb >> 9) & 1) << 5); R = (st >> 1) * 16 + swz / 64; C = (st & 1) * 32 + (swz % 64) / 2; }
__host__ __device__ __forceinline__ int perm32(int rho) { const int n = rho >> 4, i = rho & 15; return 8 * (i >> 2) + 4 * n + (i & 3); }

struct Unit { int pm, pn; };
struct Gemm { const bf16_t* A; const bf16_t* Bt; int M, N, K; };

struct StaticOrder {
    int nM, nN, nwg, G, c;
    __host__ __device__ void init(int M, int N, int G_, int c_) { nM = M / BM; nN = N / BM; nwg = nM * nN; G = G_; c = c_; }
    __host__ __device__ bool next(int i, Unit& u) const {
        const long L = (long)i * G + c; if (L >= nwg) return false;
        int wgid = (int)L; { const int q = nwg / NXCD, r = nwg % NXCD, xcd = wgid % NXCD, off = wgid / NXCD; wgid = (xcd < r ? xcd * (q + 1) : r * (q + 1) + (xcd - r) * q) + off; }
        const int nig = WGM * nN, gid = wgid / nig, fm = gid * WGM, gsz = (nM - fm) < WGM ? (nM - fm) : WGM;
        u.pm = fm + ((wgid % nig) % gsz); u.pn = (wgid % nig) / gsz; return true;
    }
    __device__ __forceinline__ void a_ready(const Unit&) const {}
    __device__ __forceinline__ void done(const Unit&) const {}
};
__device__ __forceinline__ unsigned cvt_pk_bf16(float lo, float hi) { unsigned r; asm volatile("v_cvt_pk_bf16_f32 %0, %1, %2" : "=v"(r) : "v"(lo), "v"(hi)); return r; }
typedef float f32x2 __attribute__((ext_vector_type(2)));
__device__ __forceinline__ f32x2 gelu_pk(f32x2 v) {
    const f32x2 av = __builtin_elementwise_abs(v), d = av * 0.2316418882f + 1.0f;
    f32x2 t; t.x = __builtin_amdgcn_rcpf(d.x); t.y = __builtin_amdgcn_rcpf(d.y);
    f32x2 q = t * 0.5307027145f + (-0.7265760135f); q = q * t + 0.7107068705f; q = q * t + (-0.142248368f); q = q * t + 0.127414796f; q = q * t;
    const f32x2 s = (v * v) * (-0.72134752044f);
    f32x2 e; e.x = __builtin_amdgcn_exp2f(s.x); e.y = __builtin_amdgcn_exp2f(s.y);
    const f32x2 m = v * (q * e), r = v - m;
    f32x2 o; o.x = v.x < 0.f ? m.x : r.x; o.y = v.y < 0.f ? m.y : r.y; return o;
}
struct EpiProj {
    static constexpr bool PERM = true, AFTER_DRAIN = false;
    bf16_t* O; int ldc; int qtiles; float qscale;
    __device__ __forceinline__ void operator()(const f32x4 (&acc)[2][2][4][2], const Unit& u, int wr, int wc, int fr, int fq) const {
        const int row0 = u.pm * BM + wr * 64 + fr, col0 = u.pn * BM + wc * 32 + 8 * fq;
        const float sc = (u.pn < qtiles) ? qscale : 1.f;
#pragma unroll
        for (int ai = 0; ai < 2; ++ai)
#pragma unroll
            for (int m = 0; m < 4; ++m) { bf16_t* rowp = O + (size_t)(row0 + ai * HALF + m * 16) * ldc + col0;
#pragma unroll
                for (int bj = 0; bj < 2; ++bj) { const f32x4 v0 = acc[ai][bj][m][0] * sc, v1 = acc[ai][bj][m][1] * sc;
                    u32x4 w; w.x = cvt_pk_bf16(v0[0], v0[1]); w.y = cvt_pk_bf16(v0[2], v0[3]); w.z = cvt_pk_bf16(v1[0], v1[1]); w.w = cvt_pk_bf16(v1[2], v1[3]);
                    *(u32x4*)(rowp + bj * HALF) = w; } }
    }
};
struct EpiF32Res {
    static constexpr bool PERM = false, AFTER_DRAIN = false;
    float* C; int ldc; const float* res;
    __device__ __forceinline__ void operator()(const f32x4 (&acc)[2][2][4][2], const Unit& u, int wr, int wc, int fr, int fq) const {
        const int row0 = u.pm * BM + wr * 64 + fr, col0 = u.pn * BM + wc * 32 + 4 * fq;
#pragma unroll
        for (int ai = 0; ai < 2; ++ai)
#pragma unroll
            for (int m = 0; m < 4; ++m) { const size_t off = (size_t)(row0 + ai * HALF + m * 16) * ldc + col0;
#pragma unroll
                for (int bj = 0; bj < 2; ++bj)
#pragma unroll
                    for (int n = 0; n < 2; ++n) { f32x4 o = acc[ai][bj][m][n]; if (res) o = o + *(const f32x4*)(res + off + bj * HALF + n * 16);
                        *(f32x4*)(C + off + bj * HALF + n * 16) = o; } }
    }
};

struct EpiMix {
    static constexpr bool PERM = true, AFTER_DRAIN = false;
    int ldc; const float* res; bf16_t* HB; float* ssq;
    __device__ __forceinline__ void operator()(const f32x4 (&acc)[2][2][4][2], const Unit& u, int wr, int wc, int fr, int fq) const {
        const int row0 = u.pm * BM + wr * 64 + fr, col0 = u.pn * BM + wc * 32 + 8 * fq;
#pragma unroll
        for (int ai = 0; ai < 2; ++ai)
#pragma unroll
            for (int m = 0; m < 4; ++m) { const int row = row0 + ai * HALF + m * 16; const size_t off = (size_t)row * ldc + col0; float sq = 0.f;
#pragma unroll
                for (int bj = 0; bj < 2; ++bj) {
                    const f32x4 h0 = acc[ai][bj][m][0] + *(const f32x4*)(res + off + bj * HALF), h1 = acc[ai][bj][m][1] + *(const f32x4*)(res + off + bj * HALF + 4);
                    sq += (h0[0] * h0[0] + h0[1] * h0[1]) + (h0[2] * h0[2] + h0[3] * h0[3]) + (h1[0] * h1[0] + h1[1] * h1[1]) + (h1[2] * h1[2] + h1[3] * h1[3]);
                    u32x4 w; w.x = cvt_pk_bf16(h0[0], h0[1]); w.y = cvt_pk_bf16(h0[2], h0[3]); w.z = cvt_pk_bf16(h1[0], h1[1]); w.w = cvt_pk_bf16(h1[2], h1[3]);
                    *(u32x4*)(HB + off + bj * HALF) = w; }
                sq += __shfl_xor(sq, 16); sq += __shfl_xor(sq, 32);
                if (fq == 0) atomicAdd(ssq + row, sq); }
    }
};
struct EpiScaleRow {
    static constexpr bool PERM = true, AFTER_DRAIN = false;
    _Float16* C; int ldc; const float* ssq; float invk, eps;
    __device__ __forceinline__ void operator()(const f32x4 (&acc)[2][2][4][2], const Unit& u, int wr, int wc, int fr, int fq) const {
        typedef _Float16 h2 __attribute__((ext_vector_type(2)));
        const int row0 = u.pm * BM + wr * 64 + fr, col0 = u.pn * BM + wc * 32 + 8 * fq;
#pragma unroll
        for (int ai = 0; ai < 2; ++ai)
#pragma unroll
            for (int m = 0; m < 4; ++m) { const int row = row0 + ai * HALF + m * 16; const size_t off = (size_t)row * ldc + col0; const float rs = 1.f / sqrtf(ssq[row] * invk + eps);
#pragma unroll
                for (int bj = 0; bj < 2; ++bj) { const f32x4 v0 = acc[ai][bj][m][0] * rs, v1 = acc[ai][bj][m][1] * rs;
                    const h2 p0 = {(_Float16)v0[0], (_Float16)v0[1]}, p1 = {(_Float16)v0[2], (_Float16)v0[3]}, p2 = {(_Float16)v1[0], (_Float16)v1[1]}, p3 = {(_Float16)v1[2], (_Float16)v1[3]};
                    u32x4 w; w.x = __builtin_bit_cast(unsigned, p0); w.y = __builtin_bit_cast(unsigned, p1); w.z = __builtin_bit_cast(unsigned, p2); w.w = __builtin_bit_cast(unsigned, p3);
                    *(u32x4*)(C + off + bj * HALF) = w; } }
    }
};
template <class Epi, class Sched, bool ALIGN_EPI = false, bool SP2 = false>
__device__ __forceinline__ void gemm_phase(PG8_LAS unsigned char* lds, const Gemm g, const Sched& S, const Epi& E) {
    const int tid = threadIdx.x, wid = __builtin_amdgcn_readfirstlane(tid >> 6), lane = tid & 63, wr = wid >> 2, wc = wid & 3, fr = lane & 15, fq = lane >> 4;
    const int K = g.K, nt = K / BK;
    unsigned voffA[2], voffB[2];
#pragma unroll
    for (int i = 0; i < 2; ++i) { int R, C; stage_rc(tid * 16 + i * 8192, R, C); const int Rb = Epi::PERM ? ((R & ~31) + perm32(R & 31)) : R;
        voffA[i] = (unsigned)(R * K + C) * 2u; voffB[i] = (unsigned)(Rb * K + C) * 2u; }
    const size_t kstep = (size_t)(BK * 2);
    const size_t hstep = (size_t)HALF * K * 2;
    const size_t tstep = 2 * hstep;
    const unsigned ldsw = (unsigned)wid * 1024u;
    const int aoff = lds_byte(wr * 64 + fr, fq * 8), boff = lds_byte(wc * 32 + fr, fq * 8);
#define PG8_SA(b, h) (((b) * 2 + (h)) * HTB)
#define PG8_SB(b, h) ((4 + (b) * 2 + (h)) * HTB)
#define PG8_STAGE(bufoff, gbase, voff) do { _Pragma("unroll") for (int _i = 0; _i < 2; ++_i) \
        __builtin_amdgcn_global_load_lds((const unsigned*)((const char*)(gbase) + (voff)[_i]), (PG8_LAS unsigned*)(lds + (bufoff) + ldsw + _i * 8192), 16, 0, 0); } while (0)
#define PG8_LDA(dst, b, h) do { _Pragma("unroll") for (int m = 0; m < 4; ++m) _Pragma("unroll") for (int k = 0; k < 2; ++k) dst[m][k] = *(const PG8_LAS bf16x8*)(lds + PG8_SA(b, h) + aoff + m * 2048 + k * 1024); } while (0)
#define PG8_LDB(dst, b, h) do { _Pragma("unroll") for (int n = 0; n < 2; ++n) _Pragma("unroll") for (int k = 0; k < 2; ++k) dst[n][k] = *(const PG8_LAS bf16x8*)(lds + PG8_SB(b, h) + boff + n * 2048 + k * 1024); } while (0)
#define PG8_MMA(ai, bj, At, Bt) do { __builtin_amdgcn_s_setprio(1); _Pragma("unroll") for (int m = 0; m < 4; ++m) _Pragma("unroll") for (int n = 0; n < 2; ++n) _Pragma("unroll") for (int k = 0; k < 2; ++k) \
        acc[ai][bj][m][n] = __builtin_amdgcn_mfma_f32_16x16x32_bf16(Bt[n][k], At[m][k], acc[ai][bj][m][n], 0, 0, 0); __builtin_amdgcn_s_setprio(0); } while (0)
#define PG8_WAIT_V(n) asm volatile("s_waitcnt vmcnt(" #n ")" ::: "memory")
#define PG8_WAIT_L(n) asm volatile("s_waitcnt lgkmcnt(" #n ")" ::: "memory")
#define PG8_BAR __builtin_amdgcn_s_barrier()
#define PG8_SCHED __builtin_amdgcn_sched_barrier(0)
    Unit cur, nxt; int ui = 0;
    if (!S.next(0, cur)) return;
    f32x4 acc[2][2][4][2];
#pragma unroll
    for (int a = 0; a < 2; ++a)
#pragma unroll
        for (int b = 0; b < 2; ++b)
#pragma unroll
            for (int m = 0; m < 4; ++m)
#pragma unroll
                for (int n = 0; n < 2; ++n) acc[a][b][m][n] = (f32x4){0.f, 0.f, 0.f, 0.f};
    bf16x8 At[4][2], B0[2][2], B1[2][2];
    const char* cA = (const char*)g.A + (size_t)cur.pm * tstep; const char* cB = (const char*)g.Bt + (size_t)cur.pn * tstep;
    S.a_ready(cur);
    if constexpr (SP2) {
        PG8_STAGE(PG8_SB(0, 0), cB, voffB); PG8_STAGE(PG8_SB(0, 1), cB + hstep, voffB); PG8_STAGE(PG8_SA(0, 0), cA, voffA); PG8_STAGE(PG8_SA(0, 1), cA + hstep, voffA);
        if (wr == 1) PG8_BAR;
        PG8_WAIT_V(2); PG8_BAR;
        PG8_STAGE(PG8_SB(1, 0), cB + kstep, voffB); PG8_STAGE(PG8_SA(1, 0), cA + kstep, voffA); PG8_STAGE(PG8_SB(1, 1), cB + hstep + kstep, voffB);
        PG8_WAIT_V(6); PG8_BAR;
    } else {
        PG8_STAGE(PG8_SB(0, 0), cB, voffB); PG8_STAGE(PG8_SA(0, 0), cA, voffA); PG8_STAGE(PG8_SB(0, 1), cB + hstep, voffB); PG8_STAGE(PG8_SA(0, 1), cA + hstep, voffA);
        if (wr == 1) PG8_BAR;
        PG8_WAIT_V(4); PG8_BAR;
        PG8_STAGE(PG8_SB(1, 0), cB + kstep, voffB); PG8_STAGE(PG8_SA(1, 0), cA + kstep, voffA); PG8_STAGE(PG8_SB(1, 1), cB + hstep + kstep, voffB);
        PG8_WAIT_V(6); PG8_BAR;
    }
    for (;;) {
        const bool has_next = S.next(ui + 1, nxt);
        const char* nA = has_next ? (const char*)g.A + (size_t)nxt.pm * tstep : cA; const char* nB = has_next ? (const char*)g.Bt + (size_t)nxt.pn * tstep : cB;
        for (int t = 0; t < nt; t += 2) {
            const bool last = (t == nt - 2);
            const char* a1 = cA + (size_t)(t + 1) * kstep;
            const char* a2 = last ? nA : cA + (size_t)(t + 2) * kstep; const char* b2 = last ? nB : cB + (size_t)(t + 2) * kstep;
            const char* a3 = a2 + kstep; const char* b3 = b2 + kstep;
            if (last && has_next) S.a_ready(nxt);
            if constexpr (SP2) {
            PG8_LDB(B0, 0, 0); PG8_LDB(B1, 0, 1); PG8_SCHED; PG8_LDA(At, 0, 0); PG8_STAGE(PG8_SA(1, 1), a1 + hstep, voffA);
            PG8_WAIT_V(8); PG8_WAIT_L(0); PG8_BAR; PG8_MMA(0, 0, At, B0); PG8_MMA(0, 1, At, B1); PG8_BAR; PG8_SCHED;
            PG8_LDA(At, 0, 1); PG8_STAGE(PG8_SB(0, 0), b2, voffB); PG8_STAGE(PG8_SB(0, 1), b2 + hstep, voffB); PG8_STAGE(PG8_SA(0, 0), a2, voffA);
            PG8_WAIT_V(8); PG8_WAIT_L(0); PG8_BAR; PG8_MMA(1, 0, At, B0); PG8_MMA(1, 1, At, B1); PG8_BAR; PG8_SCHED;
            PG8_LDB(B0, 1, 0); PG8_LDB(B1, 1, 1); PG8_SCHED; PG8_LDA(At, 1, 0); PG8_STAGE(PG8_SA(0, 1), a2 + hstep, voffA);
            PG8_WAIT_V(8); PG8_WAIT_L(0); PG8_BAR; PG8_MMA(0, 0, At, B0); PG8_MMA(0, 1, At, B1); PG8_BAR; PG8_SCHED;
            PG8_LDA(At, 1, 1); PG8_STAGE(PG8_SB(1, 0), b3, voffB); PG8_STAGE(PG8_SB(1, 1), b3 + hstep, voffB); PG8_STAGE(PG8_SA(1, 0), a3, voffA);
            PG8_WAIT_V(8); PG8_WAIT_L(0); PG8_BAR; PG8_MMA(1, 0, At, B0); PG8_MMA(1, 1, At, B1); PG8_BAR; PG8_SCHED;
            } else {
            PG8_LDB(B0, 0, 0); PG8_SCHED; PG8_LDA(At, 0, 0); PG8_STAGE(PG8_SA(1, 1), a1 + hstep, voffA);
            PG8_WAIT_L(8); PG8_BAR; PG8_WAIT_L(0); PG8_MMA(0, 0, At, B0); PG8_BAR; PG8_SCHED;
            PG8_LDB(B1, 0, 1); PG8_STAGE(PG8_SB(0, 0), b2, voffB);
            PG8_BAR; PG8_WAIT_L(0); PG8_MMA(0, 1, At, B1); PG8_BAR;
            PG8_LDA(At, 0, 1); PG8_STAGE(PG8_SA(0, 0), a2, voffA);
            PG8_BAR; PG8_WAIT_L(0); PG8_MMA(1, 0, At, B0); PG8_BAR; PG8_SCHED;
            PG8_STAGE(PG8_SB(0, 1), b2 + hstep, voffB);
            PG8_WAIT_V(6); PG8_BAR; PG8_MMA(1, 1, At, B1); PG8_BAR;
            PG8_LDB(B0, 1, 0); PG8_SCHED; PG8_LDA(At, 1, 0); PG8_STAGE(PG8_SA(0, 1), a2 + hstep, voffA);
            PG8_WAIT_L(8); PG8_BAR; PG8_WAIT_L(0); PG8_MMA(0, 0, At, B0); PG8_BAR; PG8_SCHED;
            PG8_LDB(B1, 1, 1); PG8_STAGE(PG8_SB(1, 0), b3, voffB);
            PG8_BAR; PG8_WAIT_L(0); PG8_MMA(0, 1, At, B1); PG8_BAR;
            PG8_LDA(At, 1, 1); PG8_STAGE(PG8_SA(1, 0), a3, voffA);
            PG8_BAR; PG8_WAIT_L(0); PG8_MMA(1, 0, At, B0); PG8_BAR; PG8_SCHED;
            PG8_STAGE(PG8_SB(1, 1), b3 + hstep, voffB);
            PG8_WAIT_V(6); PG8_BAR; PG8_MMA(1, 1, At, B1); PG8_BAR;
            }
        }
        if constexpr (ALIGN_EPI) { if (wr == 0) PG8_BAR; }
        if constexpr (!Epi::AFTER_DRAIN) { E(acc, cur, wr, wc, fr, fq); S.done(cur); }
        if (!has_next) break;
#pragma unroll
        for (int a = 0; a < 2; ++a)
#pragma unroll
            for (int b = 0; b < 2; ++b)
#pragma unroll
                for (int m = 0; m < 4; ++m)
#pragma unroll
                    for (int n = 0; n < 2; ++n) acc[a][b][m][n] = (f32x4){0.f, 0.f, 0.f, 0.f};
        cur = nxt; cA = nA; cB = nB; ++ui;
        if constexpr (ALIGN_EPI) { if (wr == 1) PG8_BAR; }
    }
    PG8_WAIT_V(0);
    if constexpr (!ALIGN_EPI) { if (wr == 0) PG8_BAR; }
    PG8_BAR;
    if constexpr (Epi::AFTER_DRAIN) { E.fused(acc, cur, wr, wc, fr, fq, lds, wid, lane); S.done(cur); }
#undef PG8_SA
#undef PG8_SB
#undef PG8_STAGE
#undef PG8_LDA
#undef PG8_LDB
#undef PG8_MMA
#undef PG8_WAIT_V
#undef PG8_WAIT_L
#undef PG8_BAR
#undef PG8_SCHED
}
}
#ifndef PG8_SP2
#define PG8_SP2 true
#endif
#ifndef PG8_ALIGN
#define PG8_ALIGN true
#endif

constexpr int NWAVES = 8;
constexpr int NTOK = 32768, DM = 1024, SEQ = 2048, NBATCH = 16, INW = 3584;
constexpr int C_DQ = 0, C_DK = 512, C_DV = 1024, C_HQ = 1536, C_HF = 2048, C_HI = 2560, C_HG = 3072;
constexpr float EPS = 1e-6f;
constexpr float QSCALE = 0.125f * 1.4426950408889634f;
constexpr float LAM_INIT = 0.2f;
constexpr int NEXP_SEL = 128;

constexpr size_t MiB = 1u << 20;
constexpr size_t WS_CTL = 0, CTL_ZERO_BYTES = 1 * MiB;
constexpr size_t WS_SMALL = 1 * MiB;
constexpr size_t WS_WIN = 2 * MiB;
constexpr size_t WS_WOUT = 10 * MiB;
constexpr size_t WS_W2 = 12 * MiB;
constexpr size_t WS_U8 = 17 * MiB;
constexpr size_t WS_V8 = 33 * MiB;
constexpr size_t WS_SU = 49 * MiB;
constexpr size_t WS_SV = 49 * MiB + 512 * 1024;
constexpr size_t WS_X8 = 50 * MiB;
constexpr size_t WS_SX = 116 * MiB;
constexpr size_t WS_GSU = 120 * MiB;
constexpr size_t WS_HN = 84 * MiB;
constexpr size_t WS_PROJ = 148 * MiB;
constexpr size_t WS_HN2 = 148 * MiB;
constexpr size_t WS_SC = 212 * MiB;
constexpr size_t WS_PO = 352 * MiB;
constexpr size_t WS_X4 = 420 * MiB;
constexpr size_t WS_IDX = 468 * MiB;
constexpr size_t WS_GATE = 484 * MiB;
constexpr size_t WS_END = 500 * MiB;
constexpr int SM_LB = 0, SM_LAM = 512, SM_BIAS = 1024;
constexpr int CW_BAR = 4096;
constexpr int CW_ATTQ = 8192;
constexpr int CW_SSQ = 131072;

constexpr int RING_OFF = 0, RING_BYTES = 139264;
constexpr int LDSCTL_OFF = RING_BYTES, MISC_OFF = LDSCTL_OFF + 320;
constexpr int LDS_BYTES = 147456;

#define GAS __attribute__((address_space(1)))
#define LAS __attribute__((address_space(3)))
typedef unsigned short bf16;
typedef unsigned v4u __attribute__((ext_vector_type(4)));
typedef unsigned v2u __attribute__((ext_vector_type(2)));
typedef float f32x4 __attribute__((ext_vector_type(4)));
typedef short bf16x8 __attribute__((ext_vector_type(8)));
typedef GAS unsigned gu32;
typedef long l2 __attribute__((ext_vector_type(2)));
typedef int v4i __attribute__((ext_vector_type(4)));
#define RLX_AGENT __ATOMIC_RELAXED, __HIP_MEMORY_SCOPE_AGENT
#define LDS_WAIT() asm volatile("s_waitcnt lgkmcnt(0)" ::: "memory")
#define VM_WAIT() asm volatile("s_waitcnt vmcnt(0)" ::: "memory")
__device__ __forceinline__ unsigned f2bf(float f) { unsigned u = __builtin_bit_cast(unsigned, f); return (u + 0x7fffu + ((u >> 16) & 1u)) >> 16; }
__device__ __forceinline__ unsigned pk2(float lo, float hi) { return f2bf(lo) | (f2bf(hi) << 16); }
__device__ __forceinline__ float bflo(unsigned w) { return __builtin_bit_cast(float, w << 16); }
__device__ __forceinline__ float bfhi(unsigned w) { return __builtin_bit_cast(float, w & 0xffff0000u); }

#define XB_TMO      128
#define XB_XCNT(j)  (256  + 64 * (j))
#define XB_XSUB(j)  (1280 + 64 * (j))
#define XB_XGEN(j)  (2304 + 64 * (j))
#define XB_TOP      3328
#define XB_TOPGEN   3392
#define XCD_BAR_WORDS 3456
#define XB_SPIN_CAP (1u << 18)
__device__ __forceinline__ unsigned xb_ld(unsigned* p)              { return __hip_atomic_load(p, __ATOMIC_RELAXED, __HIP_MEMORY_SCOPE_AGENT); }
__device__ __forceinline__ unsigned xb_add(unsigned* p, unsigned v) { return __hip_atomic_fetch_add(p, v, __ATOMIC_RELAXED, __HIP_MEMORY_SCOPE_AGENT); }
__device__ __forceinline__ unsigned xb_xcc_id() { return (unsigned)__builtin_amdgcn_s_getreg((3 << 11) | 20) & 0xFu; }
#define XB_SPIN(cond, bar) do { unsigned _sp = 0; while (cond) { __builtin_amdgcn_s_sleep(1); \
    if ((++_sp & 255u) == 0u) { if (xb_ld(&(bar)[XB_TMO])) break; if (_sp > XB_SPIN_CAP) { atomicAdd(&(bar)[XB_TMO], 1u); break; } } } } while (0)
struct XcdBarrier { unsigned* bar; unsigned x; volatile LAS unsigned* st; };
__device__ __forceinline__ XcdBarrier xcd_barrier_post(unsigned* bar, volatile LAS unsigned* st) {
    XcdBarrier b; b.bar = bar; b.x = xb_xcc_id(); b.st = st;
    if (threadIdx.x == 0) (void)xb_add(&bar[XB_XCNT(b.x)], 1u);
    return b;
}
__device__ __forceinline__ void xcd_barrier_complete(unsigned* bar, unsigned x, unsigned& nloc, unsigned& nx) {
    const unsigned G = gridDim.x * gridDim.y * gridDim.z;
    unsigned sum, cnt, mine, sp = 0u;
    for (;;) {
        sum = 0u; cnt = 0u; mine = 0u;
#pragma unroll
        for (unsigned j = 0; j < 16; ++j) { const unsigned c = xb_ld(&bar[XB_XCNT(j)]); sum += c; cnt += (c > 0u) ? 1u : 0u; mine = (j == x) ? c : mine; }
        if (sum == G) break;
        __builtin_amdgcn_s_sleep(1);
        if ((++sp & 255u) == 0u) { if (xb_ld(&bar[XB_TMO])) break; if (sp > XB_SPIN_CAP) { atomicAdd(&bar[XB_TMO], 1u); break; } }
    }
    nloc = mine > 0u ? mine : 1u; nx = cnt > 0u ? cnt : 1u;
}
__device__ __forceinline__ void xcd_barrier(const XcdBarrier& b) {
    asm volatile("s_waitcnt vmcnt(0)" ::: "memory");
    __syncthreads();
    if (threadIdx.x == 0) {
        unsigned* bar = b.bar;
        __builtin_amdgcn_s_waitcnt(0);
        unsigned nloc = b.st[0], nx = b.st[1];
        if (nloc == 0u) { xcd_barrier_complete(bar, b.x, nloc, nx); b.st[0] = nloc; b.st[1] = nx; }
        const unsigned old = xb_add(&bar[XB_XSUB(b.x)], 1u);
        const unsigned gen = old / nloc;
        if (old + 1u == (gen + 1u) * nloc) {
            __builtin_amdgcn_fence(__ATOMIC_RELEASE, "agent");
            asm volatile("s_waitcnt vmcnt(0)" ::: "memory");
            const unsigned og = xb_add(&bar[XB_TOP], 1u);
            const unsigned tg = og / nx;
            if (og + 1u == (tg + 1u) * nx) xb_add(&bar[XB_TOPGEN], 1u);
            else XB_SPIN(xb_ld(&bar[XB_TOPGEN]) == tg, bar);
            __builtin_amdgcn_fence(__ATOMIC_ACQUIRE, "agent");
            xb_add(&bar[XB_XGEN(b.x)], 1u);
            asm volatile("s_waitcnt vmcnt(0)" ::: "memory");
        } else {
            XB_SPIN(xb_ld(&bar[XB_XGEN(b.x)]) == gen, bar);
            __builtin_amdgcn_fence(__ATOMIC_ACQUIRE, "agent");
            asm volatile("s_waitcnt vmcnt(0)" ::: "memory");
        }
    }
    __syncthreads();
}

#define SCHED_FENCE() __builtin_amdgcn_sched_barrier(0)
__device__ __forceinline__ float gelu_as(float v) {
    const float av = fabsf(v), t = __builtin_amdgcn_rcpf(av * 0.2316418882f + 1.0f);
    float q = t * 0.5307027145f + (-0.7265760135f); q = q * t + 0.7107068705f; q = q * t + (-0.142248368f); q = q * t + 0.127414796f; q = q * t;
    const float e = __builtin_amdgcn_exp2f((v * v) * (-0.72134752044f));
    const float mm = v * (q * e);
    return v < 0.f ? mm : v - mm;
}
struct Frame {
    LAS unsigned char* lds;
    volatile LAS unsigned* MISC;
    int tid, lane, wave, vcu, G;
    const float* in[18]; float* out; unsigned char* ws;
};
__device__ __forceinline__ float wave_sum(float v) {
#pragma unroll
    for (int o = 1; o < 64; o <<= 1) v += __shfl_xor(v, o);
    return v;
}
__device__ __forceinline__ float sigmoidf_(float x) { return 1.f / (1.f + __expf(-x)); }

__device__ __forceinline__ void p0_transpose_item(const float* W, int K, int N, bf16* WT, int row_off, LAS float* scr, int item, int lane) {
    const int nblk = N / 32, kb = item / nblk, nb = item % nblk, k0 = 64 * kb, n0 = 32 * nb;
#pragma unroll 8
    for (int i = 0; i < 32; ++i) { const int kk = 2 * i + (lane >> 5); scr[kk * 33 + (lane & 31)] = W[(size_t)(k0 + kk) * N + n0 + (lane & 31)]; }
    LDS_WAIT(); asm volatile("" ::: "memory");
    const int c = lane & 7;
#pragma unroll
    for (int j = 0; j < 4; ++j) { const int n = (lane >> 3) + 8 * j; const LAS float* s = scr + (8 * c) * 33 + n;
        v4u o; o.x = pk2(s[0 * 33], s[1 * 33]); o.y = pk2(s[2 * 33], s[3 * 33]); o.z = pk2(s[4 * 33], s[5 * 33]); o.w = pk2(s[6 * 33], s[7 * 33]);
        *(GAS v4u*)(WT + (size_t)(row_off + n0 + n) * K + k0 + 8 * c) = o; }
    LDS_WAIT(); asm volatile("" ::: "memory");
}

__device__ __forceinline__ void quant_vals_fp8(const f32x4 (&v)[4], unsigned char* dst, float* dq, int lane, size_t slice_stride) {
    float mx = 0.f;
#pragma unroll
    for (int j = 0; j < 4; ++j) mx = fmaxf(mx, fmaxf(fmaxf(fabsf(v[j].x), fabsf(v[j].y)), fmaxf(fabsf(v[j].z), fabsf(v[j].w))));
#pragma unroll
    for (int o = 1; o < 64; o <<= 1) mx = fmaxf(mx, __shfl_xor(mx, o));
    const float qs = mx > 0.f ? 224.f / mx : 1.f;
#pragma unroll
    for (int j = 0; j < 4; ++j) { int p = __builtin_amdgcn_cvt_pk_fp8_f32(v[j].x * qs, v[j].y * qs, 0, false); p = __builtin_amdgcn_cvt_pk_fp8_f32(v[j].z * qs, v[j].w * qs, p, true);
        const int d = 4 * lane + 256 * j; *(GAS unsigned*)(dst + (slice_stride ? (size_t)(d >> 7) * slice_stride + (d & 127) : (size_t)d)) = (unsigned)p; }
    if (lane == 0) *dq = mx > 0.f ? mx * (1.f / 224.f) : 1.f;
}
__device__ __forceinline__ void quant_row_fp4(const float* src, unsigned char* dst, float* dq, int lane, size_t slice_stride) {
    const GAS f32x4* xr = (const GAS f32x4*)src + lane; f32x4 v[4];
#pragma unroll
    for (int j = 0; j < 4; ++j) v[j] = xr[64 * j];
    float mx = 0.f;
#pragma unroll
    for (int j = 0; j < 4; ++j) mx = fmaxf(mx, fmaxf(fmaxf(fabsf(v[j].x), fabsf(v[j].y)), fmaxf(fabsf(v[j].z), fabsf(v[j].w))));
#pragma unroll
    for (int o = 1; o < 64; o <<= 1) mx = fmaxf(mx, __shfl_xor(mx, o));
    const float qs = mx > 0.f ? 6.f / mx : 1.f;
#pragma unroll
    for (int j = 0; j < 4; ++j) { unsigned r = 0u;
        r = __builtin_amdgcn_cvt_scalef32_pk_fp4_f32(r, v[j].x * qs, v[j].y * qs, 1.0f, 0); r = __builtin_amdgcn_cvt_scalef32_pk_fp4_f32(r, v[j].z * qs, v[j].w * qs, 1.0f, 1);
        *(GAS unsigned short*)(dst + (size_t)j * slice_stride + 2 * lane) = (unsigned short)r; }
    if (lane == 0) *dq = mx > 0.f ? mx * (1.f / 6.f) : 1.f;
}
__device__ __forceinline__ void quant_row_fp8(const float* src, unsigned char* dst, float* dq, int lane, size_t slice_stride) {
    const GAS f32x4* xr = (const GAS f32x4*)src + lane; f32x4 v[4];
#pragma unroll
    for (int j = 0; j < 4; ++j) v[j] = xr[64 * j];
    quant_vals_fp8(v, dst, dq, lane, slice_stride);
}
__device__ __forceinline__ void p0_prologue(Frame& F) {
    LAS float* scr = (LAS float*)(F.lds + RING_OFF + F.wave * 16384);
    const int gw = F.vcu * NWAVES + F.wave, NGW = F.G * NWAVES;
    bf16* WinT = (bf16*)(F.ws + WS_WIN); bf16* WoutT = (bf16*)(F.ws + WS_WOUT); bf16* W2T = (bf16*)(F.ws + WS_W2);
    float* small = (float*)(F.ws + WS_SMALL);
    if (blockIdx.x == 0) {
        const int t = F.tid;
        { const float l0 = F.in[9][t], l1 = F.in[9][512 + t]; small[SM_LB + t] = 1.f / (1.f + expf(l1 - l0)); }
        { const int h = t >> 7, n = t & 127; int bk;
          if (n < 16) bk = n; else { bk = 16 + (int)(logf((float)n * (1.f / 16.f)) / logf(8.f) * 16.f); bk = bk > 31 ? 31 : bk; }
          small[SM_BIAS + t] = F.in[8][bk * 4 + h] * 1.4426950408889634f; }
        if (F.wave == 0) {
            const float a = wave_sum(F.in[3][F.lane] * F.in[4][F.lane]), b = wave_sum(F.in[5][F.lane] * F.in[6][F.lane]);
            if (F.lane == 0) small[SM_LAM] = expf(a) - expf(b) + LAM_INIT;
        }
    }
    constexpr int I_IN = (DM / 64) * (INW / 32), I_OUT = (DM / 64) * (DM / 32);
    for (int it = gw; it < I_IN + I_OUT; it += NGW) {
        if (it < I_IN) p0_transpose_item(F.in[2], DM, INW, WinT, 0, scr, it, F.lane);
        else p0_transpose_item(F.in[11], DM, DM, WoutT, 0, scr, it - I_IN, F.lane);
    }
    for (int u = F.vcu; u < 256; u += F.G) {
        const int hc = u >> 4, kb = u & 15, k = kb * 64 + F.lane;
        const GAS f32x4* wrow = (const GAS f32x4*)(F.in[13] + (size_t)k * 2048 + hc * 128);
        float a[16];
#pragma unroll
        for (int nn = 0; nn < 16; ++nn) a[nn] = 0.f;
        const float* kr = F.in[14] + ((size_t)hc * 128 + F.wave * 16) * 128;
        for (int i = 0; i < 32; ++i) {
            const f32x4 w = wrow[i];
#pragma unroll
            for (int nn = 0; nn < 16; ++nn) { const float* kk = kr + nn * 128 + 4 * i; a[nn] += (kk[0] * w.x + kk[1] * w.y) + (kk[2] * w.z + kk[3] * w.w); }
        }
        const float g2k = F.in[12][k];
#pragma unroll
        for (int nn = 0; nn < 16; ++nn) W2T[((size_t)hc * 128 + F.wave * 16 + nn) * DM + k] = (bf16)f2bf(a[nn] * g2k);
    }
    bf16* HN = (bf16*)(F.ws + WS_HN);
    for (int m = gw; m < NTOK; m += 2 * NGW) {
        const int m2 = m + NGW;
        const GAS f32x4* xa = (const GAS f32x4*)(F.in[0] + (size_t)m * DM) + F.lane; const GAS f32x4* xb = (const GAS f32x4*)(F.in[0] + (size_t)(m2 < NTOK ? m2 : m) * DM) + F.lane;
        const GAS f32x4* gr = (const GAS f32x4*)F.in[1] + F.lane;
        f32x4 va[4], vb[4]; float sa = 0.f, sb = 0.f;
#pragma unroll
        for (int j = 0; j < 4; ++j) { va[j] = xa[64 * j]; vb[j] = xb[64 * j]; }
#pragma unroll
        for (int j = 0; j < 4; ++j) { sa += (va[j].x * va[j].x + va[j].y * va[j].y) + (va[j].z * va[j].z + va[j].w * va[j].w); sb += (vb[j].x * vb[j].x + vb[j].y * vb[j].y) + (vb[j].z * vb[j].z + vb[j].w * vb[j].w); }
#pragma unroll
        for (int o = 1; o < 64; o <<= 1) { sa += __shfl_xor(sa, o); sb += __shfl_xor(sb, o); }
        const float ra = 1.f / sqrtf(sa * (1.f / DM) + EPS), rb = 1.f / sqrtf(sb * (1.f / DM) + EPS);
        GAS unsigned long long* oa = (GAS unsigned long long*)(HN + (size_t)m * DM) + F.lane; GAS unsigned long long* ob = (GAS unsigned long long*)(HN + (size_t)m2 * DM) + F.lane;
#pragma unroll
        for (int j = 0; j < 4; ++j) { const f32x4 gg = gr[64 * j];
            oa[64 * j] = (unsigned long long)pk2(va[j].x * ra * gg.x, va[j].y * ra * gg.y) | ((unsigned long long)pk2(va[j].z * ra * gg.z, va[j].w * ra * gg.w) << 32);
            if (m2 < NTOK) ob[64 * j] = (unsigned long long)pk2(vb[j].x * rb * gg.x, vb[j].y * rb * gg.y) | ((unsigned long long)pk2(vb[j].z * rb * gg.z, vb[j].w * rb * gg.w) << 32); }
    }
}


constexpr int QCHUNKS = 2 * 16384 / 64;
__device__ __forceinline__ void quant_chunk(Frame& F, int c) {
    unsigned char* U8 = F.ws + WS_U8; unsigned char* V8 = F.ws + WS_V8; float* SU = (float*)(F.ws + WS_SU); float* SV = (float*)(F.ws + WS_SV);
#pragma unroll 1
    for (int k = 0; k < 8; ++k) { const int rr = 64 * c + 8 * F.wave + k;
        if (rr < 16384) quant_row_fp4(F.in[15] + (size_t)rr * DM, U8 + (size_t)rr * 128, SU + rr, F.lane, (size_t)16384 * 128);
        else { const int e = rr - 16384; quant_row_fp8(F.in[16] + (size_t)e * DM, V8 + (size_t)e * 128, SV + e, F.lane, (size_t)16384 * 128); } }
}

__device__ __forceinline__ void quant_drain(Frame& F) {
    unsigned* qctr = (unsigned*)(F.ws + WS_CTL) + CW_ATTQ + 128;
    if (F.tid == 0) F.MISC[13] = __hip_atomic_fetch_add(qctr, 1u, __ATOMIC_RELAXED, __HIP_MEMORY_SCOPE_AGENT);
    for (int it = 0;; ++it) {
        __syncthreads();
        const int qc = (int)F.MISC[13 + (it & 1)];
        if (qc >= QCHUNKS) break;
        unsigned nx = 0u;
        if (F.tid == 0) nx = __hip_atomic_fetch_add(qctr, 1u, __ATOMIC_RELAXED, __HIP_MEMORY_SCOPE_AGENT);
        quant_chunk(F, qc);
        if (F.tid == 0) F.MISC[13 + ((it + 1) & 1)] = nx;
    }
}

typedef float f32x16 __attribute__((ext_vector_type(16)));
typedef short s16x4 __attribute__((ext_vector_type(4)));
typedef short v4i16_t __attribute__((ext_vector_type(4)));
typedef float f32x2_t __attribute__((ext_vector_type(2))); typedef __bf16 bf16x2_t __attribute__((ext_vector_type(2)));
__device__ __forceinline__ unsigned cvtpk_bf16(float lo, float hi) { f32x2_t v = {lo, hi}; bf16x2_t b = __builtin_convertvector(v, bf16x2_t); return __builtin_bit_cast(unsigned, b); }
__device__ __forceinline__ float xhalf_max(float v) { return fmaxf(v, __shfl_xor(v, 32)); }
__device__ __forceinline__ float xhalf_sum(float v) { return v + __shfl_xor(v, 32); }
__device__ __forceinline__ float max3f_(float a, float b, float c) { float r; asm("v_max3_f32 %0, %1, %2, %3" : "=v"(r) : "v"(a), "v"(b), "v"(c)); return r; }
constexpr int AT_KP = 144, AT_VP = 320, AT_K1 = 64 * AT_KP, AT_KS = 2 * AT_K1, AT_V0 = 2 * AT_KS, AT_VS = 64 * AT_VP;
constexpr int AT_XO = 0, AT_YB = 65536, AT_YP = 272, AT_Q = 100864, AT_TAB = AT_Q + 8 * 4096;
static_assert(AT_TAB + 320 * 4 <= RING_BYTES && AT_YB + 4 * 32 * AT_YP <= AT_Q && AT_V0 + 3 * AT_VS <= AT_Q, "attention LDS map");
#define AT_MFMA(a, b, c) __builtin_amdgcn_mfma_f32_32x32x16_bf16(a, b, c, 0, 0, 0)
#define AT_SGB(mask, n) __builtin_amdgcn_sched_group_barrier(mask, n, 0)
__device__ __forceinline__ void attn_mfma(Frame& F, int qslot) {
    const bf16* PROJ = (const bf16*)(F.ws + WS_PROJ); bf16* MIXED = (bf16*)(F.ws + WS_HN);
    const float* small = (const float*)(F.ws + WS_SMALL);
    LAS unsigned char* lds = F.lds;
    LAS float* TAB = (LAS float*)(lds + AT_TAB);
    const int tid = F.tid, lane = F.lane, wave = F.wave, map = wave >> 2, qt = wave & 3, r32 = lane & 31, hi = lane >> 5;
    const int koff = map * AT_K1 + r32 * AT_KP + hi * 16;
    const int voff = AT_V0 + (4 * hi + ((lane & 15) >> 2)) * AT_VP + (16 * ((lane >> 4) & 1) + 4 * (lane & 3)) * 2;
    unsigned* qctr = (unsigned*)(F.ws + WS_CTL) + CW_ATTQ + 64 * qslot;
    if (tid == 0) F.MISC[12] = __hip_atomic_fetch_add(qctr, 1u, __ATOMIC_RELAXED, __HIP_MEMORY_SCOPE_AGENT);
    for (;;) {
        __syncthreads();
        const int L = (int)F.MISC[12];
        if (L >= 1024) break;
        unsigned nxtu = 0u;
        if (tid == 0) nxtu = __hip_atomic_fetch_add(qctr, 1u, __ATOMIC_RELAXED, __HIP_MEMORY_SCOPE_AGENT);
        const int qb = 15 - (L >> 6), bh = L & 63;
        const int b = bh >> 2, h = bh & 3, q0 = qb * 128; const size_t tok0 = (size_t)b * SEQ;
        const int NT = (q0 + 128) / 64;
        int tidu = F.tid; asm volatile("" : "+v"(tidu));
        if (tidu < 320) { const int n = tidu - 96; TAB[tidu] = n < 0 ? -INFINITY : small[SM_BIAS + h * 128 + (n > 127 ? 127 : n)]; }
        bf16x8 qf0, qf1, qf2, qf3;
        { const bf16* qrow = PROJ + (tok0 + q0 + 32 * qt + r32) * INW + C_DQ + h * 128 + map * 64 + 8 * hi;
          qf0 = *(const GAS bf16x8*)(qrow); qf1 = *(const GAS bf16x8*)(qrow + 16); qf2 = *(const GAS bf16x8*)(qrow + 32); qf3 = *(const GAS bf16x8*)(qrow + 48); }
        const unsigned char* projb = (const unsigned char*)PROJ;
        const unsigned ksrc = (unsigned)(((tok0 + (tidu >> 4)) * INW + C_DK + h * 128 + (tidu & 15) * 8) * 2), vsrc = ksrc + (C_DV - C_DK) * 2;
        const int kdst = ((tidu & 15) >> 3) * AT_K1 + (tidu >> 4) * AT_KP + (tidu & 7) * 16, vdst = AT_V0 + (tidu >> 4) * AT_VP + (tidu & 15) * 16;
#define AT_GLD(src, row) (*(const GAS v4u*)(projb + (size_t)((src) + (unsigned)((row) * (INW * 2)))))
        v4u kr[2], vr[2];
#pragma unroll
        for (int i = 0; i < 2; ++i) { kr[i] = AT_GLD(ksrc, 32 * i); vr[i] = AT_GLD(vsrc, 32 * i); }
#pragma unroll
        for (int i = 0; i < 2; ++i) { *(LAS v4u*)(lds + kdst + 32 * i * AT_KP) = kr[i]; *(LAS v4u*)(lds + vdst + 32 * i * AT_VP) = vr[i]; }
#pragma unroll
        for (int i = 0; i < 2; ++i) { kr[i] = AT_GLD(ksrc, 64 + 32 * i); vr[i] = AT_GLD(vsrc, 64 + 32 * i); }
        __syncthreads();
        const float bfar = TAB[96 + 127];
        f32x16 o[4];
#pragma unroll
        for (int mt = 0; mt < 4; ++mt) o[mt] = (f32x16){0.f,0.f,0.f,0.f,0.f,0.f,0.f,0.f,0.f,0.f,0.f,0.f,0.f,0.f,0.f,0.f};
        float mrun = -INFINITY, lsum = 0.f, alpha = 1.f, cexp = 0.f; bool resc = false;
        const int qlo = q0 + 32 * qt, qpos = qlo + r32;
        const int NTW = NT - 1 + (qt >> 1);
        f32x16 pA0, pA1, pB0, pB1;
        int vs_prev = 0, vs_cur = 0, vs_next = AT_VS;
#define AT_ROT() do { vs_prev = vs_cur; vs_cur = vs_next; vs_next = (vs_next == 2 * AT_VS) ? 0 : vs_next + AT_VS; } while (0)
#define AT_Z16 (f32x16){0.f,0.f,0.f,0.f,0.f,0.f,0.f,0.f,0.f,0.f,0.f,0.f,0.f,0.f,0.f,0.f}
#define AT_SBAR() __builtin_amdgcn_sched_barrier(0)
#define AT_PIN(x) asm volatile("" : "+v"(x))
        bf16x8 kAa, kAb, kBa, kBb; s16x4 f0l, f0h, f1l, f1h;
#define AT_KRD2(S, KB, s4) do { k##S##a = *(const LAS bf16x8*)(lds + (KB) + koff + 32 * (s4)); k##S##b = *(const LAS bf16x8*)(lds + (KB) + koff + 32 * AT_KP + 32 * (s4)); } while (0)
#define AT_VRD(Fn, g) do { LAS unsigned char* vp_ = vb_ + (32 * ((g) >> 3) + 16 * (((g) >> 2) & 1)) * AT_VP + 64 * ((g) & 3); \
            Fn##l = __builtin_bit_cast(s16x4, __builtin_amdgcn_ds_read_tr16_b64_v4i16((LAS v4i16_t*)vp_)); Fn##h = __builtin_bit_cast(s16x4, __builtin_amdgcn_ds_read_tr16_b64_v4i16((LAS v4i16_t*)(vp_ + 8 * AT_VP))); } while (0)
#define AT_VFR(Fn) (bf16x8){Fn##l[0], Fn##l[1], Fn##l[2], Fn##l[3], Fn##h[0], Fn##h[1], Fn##h[2], Fn##h[3]}
#define AT_GAPA(MF, RD, FILL, P, g, PK) do { MF; RD; \
            if (FILL) { const float e0_ = P[4 * ((g) & 3)], e1_ = P[4 * ((g) & 3) + 1], e2_ = P[4 * ((g) & 3) + 2], e3_ = P[4 * ((g) & 3) + 3]; \
                sacc_ += e0_; sacc_ += e1_; sacc_ += e2_; sacc_ += e3_; \
                PK[2 * (g)] = __builtin_bit_cast(float, cvtpk_bf16(e0_, e1_)); PK[2 * (g) + 1] = __builtin_bit_cast(float, cvtpk_bf16(e2_, e3_)); AT_PIN(PK); AT_PIN(sacc_); } \
            AT_SBAR(); } while (0)
#define AT_PHASE_A(C0, C1, P0, P1, KB, FILL) do { float sacc_ = 0.f; \
            AT_SBAR(); AT_KRD2(A, KB, 0); AT_SBAR(); \
            AT_GAPA(C0 = AT_MFMA(kAa, qf0, AT_Z16), AT_KRD2(B, KB, 1), FILL, P0, 0, P0); \
            AT_GAPA(C1 = AT_MFMA(kAb, qf0, AT_Z16), (void)0,           FILL, P0, 1, P0); \
            AT_GAPA(C0 = AT_MFMA(kBa, qf1, C0),     AT_KRD2(A, KB, 2), FILL, P0, 2, P0); \
            AT_GAPA(C1 = AT_MFMA(kBb, qf1, C1),     (void)0,           FILL, P0, 3, P0); \
            AT_GAPA(C0 = AT_MFMA(kAa, qf2, C0),     AT_KRD2(B, KB, 3), FILL, P1, 4, P0); \
            AT_GAPA(C1 = AT_MFMA(kAb, qf2, C1),     (void)0,           FILL, P1, 5, P0); \
            AT_GAPA(C0 = AT_MFMA(kBa, qf3, C0),     (void)0,           FILL, P1, 6, P0); \
            AT_GAPA(C1 = AT_MFMA(kBb, qf3, C1),     (void)0,           FILL, P1, 7, P0); \
            lsum += sacc_; } while (0)
#define AT_MID(C0, C1, t) do { float tm, cadd; \
            if (qlo - (64 * (t) + 63) < 127) { \
                const LAS float* rp = TAB + (qpos - 64 * (t) - 4 * hi + 96 - 59); tm = -INFINITY; \
                _Pragma("unroll") for (int r = 0; r < 16; ++r) { const int off = (r & 3) + 8 * (r >> 2); C0[r] += rp[59 - off]; C1[r] += rp[27 - off]; tm = max3f_(tm, C0[r], C1[r]); } \
                cadd = 0.f; \
            } else { \
                tm = max3f_(C0[0], C1[0], C0[1]); \
                _Pragma("unroll") for (int r = 1; r < 15; ++r) tm = max3f_(tm, C1[r], C0[r + 1]); \
                tm = fmaxf(tm, C1[15]); tm += bfar; cadd = bfar; } \
            tm = xhalf_max(tm); resc = false; \
            if (__any(tm > mrun + 8.f)) { const float mnew = fmaxf(mrun, tm); alpha = __builtin_amdgcn_exp2f(mrun - mnew); lsum *= alpha; mrun = mnew; resc = true; } \
            cexp = cadd - mrun; } while (0)
#define AT_EXP(C0, C1) do { _Pragma("unroll") for (int r = 0; r < 16; ++r) { C0[r] = __builtin_amdgcn_exp2f(C0[r] + cexp); C1[r] = __builtin_amdgcn_exp2f(C1[r] + cexp); } } while (0)
#define AT_GAPB(Fn, g, PK, C, DOEXP) do { o[(g) & 3] = AT_MFMA(AT_VFR(Fn), __builtin_bit_cast(bf16x8, (f32x4){PK[4 * ((g) >> 2)], PK[4 * ((g) >> 2) + 1], PK[4 * ((g) >> 2) + 2], PK[4 * ((g) >> 2) + 3]}), o[(g) & 3]); \
            if ((g) + 2 < 16) AT_VRD(Fn, (g) + 2); \
            if (DOEXP) { C[2 * ((g) & 7)] = __builtin_amdgcn_exp2f(C[2 * ((g) & 7)] + cexp); C[2 * ((g) & 7) + 1] = __builtin_amdgcn_exp2f(C[2 * ((g) & 7) + 1] + cexp); AT_PIN(C); } \
            AT_SBAR(); } while (0)
#define AT_PHASE_B(C0, C1, PK, VB, DOEXP) do { LAS unsigned char* vb_ = lds + (VB) + voff; \
            AT_SBAR(); AT_VRD(f0, 0); AT_VRD(f1, 1); AT_SBAR(); \
            AT_GAPB(f0, 0, PK, C0, DOEXP);  AT_GAPB(f1, 1, PK, C0, DOEXP);  AT_GAPB(f0, 2, PK, C0, DOEXP);  AT_GAPB(f1, 3, PK, C0, DOEXP); \
            AT_GAPB(f0, 4, PK, C0, DOEXP);  AT_GAPB(f1, 5, PK, C0, DOEXP);  AT_GAPB(f0, 6, PK, C0, DOEXP);  AT_GAPB(f1, 7, PK, C0, DOEXP); \
            AT_GAPB(f0, 8, PK, C1, DOEXP);  AT_GAPB(f1, 9, PK, C1, DOEXP);  AT_GAPB(f0, 10, PK, C1, DOEXP); AT_GAPB(f1, 11, PK, C1, DOEXP); \
            AT_GAPB(f0, 12, PK, C1, DOEXP); AT_GAPB(f1, 13, PK, C1, DOEXP); AT_GAPB(f0, 14, PK, C1, DOEXP); AT_GAPB(f1, 15, PK, C1, DOEXP); } while (0)
#define AT_RESC() do { if (resc) { _Pragma("unroll") for (int mt = 0; mt < 4; ++mt) o[mt] = o[mt] * alpha; } } while (0)
#define AT_STAGE(t) do { if ((t) + 1 < NT) { \
                _Pragma("unroll") for (int i = 0; i < 2; ++i) { *(LAS v4u*)(lds + (((t) + 1) & 1) * AT_KS + kdst + 32 * i * AT_KP) = kr[i]; *(LAS v4u*)(lds + vs_next + vdst + 32 * i * AT_VP) = vr[i]; } \
                if ((t) + 2 < NT) { _Pragma("unroll") for (int i = 0; i < 2; ++i) { kr[i] = AT_GLD(ksrc, 64 * ((t) + 2) + 32 * i); vr[i] = AT_GLD(vsrc, 64 * ((t) + 2) + 32 * i); } } } \
            __syncthreads(); AT_ROT(); } while (0)
#define AT_STEP(C0, C1, P0, P1, t) do { \
            AT_PHASE_A(C0, C1, P0, P1, ((t) & 1) * AT_KS, 1); \
            AT_MID(C0, C1, t); \
            AT_PHASE_B(C0, C1, P0, vs_prev, 1); \
            AT_RESC(); } while (0)
#define AT_PACK(P0, P1) do { float ps_ = 0.f; \
            _Pragma("unroll") for (int r = 0; r < 16; ++r) ps_ += P0[r] + P1[r]; \
            lsum += ps_; \
            _Pragma("unroll") for (int w = 0; w < 8; ++w) { const float lo_ = P0[2 * w], hi_ = P0[2 * w + 1]; P0[w] = __builtin_bit_cast(float, cvtpk_bf16(lo_, hi_)); } \
            _Pragma("unroll") for (int w = 0; w < 8; ++w) P0[8 + w] = __builtin_bit_cast(float, cvtpk_bf16(P1[2 * w], P1[2 * w + 1])); } while (0)
        AT_PHASE_A(pA0, pA1, pA0, pA1, 0, 0); AT_MID(pA0, pA1, 0); AT_EXP(pA0, pA1); AT_RESC();
        AT_STAGE(0);
        if (tid == 0) F.MISC[12] = nxtu;
        int t = 1;
        for (; t + 1 < NT; t += 2) {
            AT_STEP(pB0, pB1, pA0, pA1, t);     AT_STAGE(t);
            AT_STEP(pA0, pA1, pB0, pB1, t + 1); AT_STAGE(t + 1);
        }
        if (NTW == NT) {
            AT_STEP(pB0, pB1, pA0, pA1, t); AT_ROT();
            AT_PACK(pB0, pB1); AT_PHASE_B(pB0, pB1, pB0, vs_prev, 0);
        } else {
            AT_PACK(pA0, pA1); AT_PHASE_B(pA0, pA1, pA0, vs_prev, 0);
        }
        __syncthreads();
        { int lane_e = F.lane; asm volatile("" : "+v"(lane_e));
        const int lane = lane_e, r32 = lane & 31, hi = lane >> 5;
        const float inv = 1.f / xhalf_sum(lsum);
        LAS float* XO = (LAS float*)(lds + AT_XO) + qt * 4096 + r32;
        if (map == 1) {
            const float sc = inv * small[SM_LAM];
#pragma unroll
            for (int mt = 0; mt < 4; ++mt)
#pragma unroll
                for (int r = 0; r < 16; ++r) XO[(32 * mt + (r & 3) + 8 * (r >> 2) + 4 * hi) * 32] = o[mt][r] * sc;
        }
        __syncthreads();
        if (map == 0) {
            float ss = 0.f;
#pragma unroll
            for (int mt = 0; mt < 4; ++mt)
#pragma unroll
                for (int r = 0; r < 16; ++r) { const float a = o[mt][r] * inv - XO[(32 * mt + (r & 3) + 8 * (r >> 2) + 4 * hi) * 32]; o[mt][r] = a; ss += a * a; }
            ss = xhalf_sum(ss);
            const float rr = (1.f - LAM_INIT) / sqrtf(ss * (1.f / 128.f) + EPS);
            LAS unsigned char* yb = lds + AT_YB + qt * (32 * AT_YP);
#pragma unroll
            for (int mt = 0; mt < 4; ++mt)
#pragma unroll
                for (int r4 = 0; r4 < 4; ++r4) { const int dv = 32 * mt + 8 * r4 + 4 * hi; const f32x4 gg = *(const GAS f32x4*)(F.in[7] + dv);
                    v2u w; w.x = cvtpk_bf16(o[mt][4 * r4] * rr * gg.x, o[mt][4 * r4 + 1] * rr * gg.y); w.y = cvtpk_bf16(o[mt][4 * r4 + 2] * rr * gg.z, o[mt][4 * r4 + 3] * rr * gg.w);
                    *(LAS v2u*)(yb + r32 * AT_YP + dv * 2) = w; }
            LDS_WAIT(); asm volatile("" ::: "memory");
            bf16* obase = MIXED + (tok0 + q0 + 32 * qt) * DM + h * 128;
#pragma unroll
            for (int i = 0; i < 8; ++i) { const int id = lane + 64 * i, row = id >> 4, cch = id & 15;
                const v4u w = *(const LAS v4u*)(yb + row * AT_YP + cch * 16); *(GAS v4u*)(obase + (size_t)row * DM + cch * 8) = w; }
        } }
#undef AT_ROT
#undef AT_GLD
#undef AT_KRD2
#undef AT_VRD
#undef AT_VFR
#undef AT_GAPA
#undef AT_GAPB
#undef AT_PHASE_A
#undef AT_PHASE_B
#undef AT_PACK
#undef AT_MID
#undef AT_EXP
#undef AT_RESC
#undef AT_STAGE
#undef AT_STEP
    }
}

constexpr int HG_P = 288, HG_VP = 320, HG_GP = 272, HG_OP = 136;
constexpr int HG_QD = 0, HG_KI = 32 * HG_P, HG_V = 2 * 32 * HG_P, HG_CD = HG_V + 32 * HG_VP, HG_G = HG_CD + 512, HG_BUF = HG_G + 32 * HG_GP;
constexpr int HG_O = 2 * HG_BUF;
static_assert(HG_O + 32 * HG_OP * 4 <= RING_BYTES, "hgrn LDS map");
__device__ __forceinline__ bf16x8 pack8(const f32x16& x, int s) {
    v4u p; p.x = cvtpk_bf16(x[8 * s], x[8 * s + 1]); p.y = cvtpk_bf16(x[8 * s + 2], x[8 * s + 3]); p.z = cvtpk_bf16(x[8 * s + 4], x[8 * s + 5]); p.w = cvtpk_bf16(x[8 * s + 6], x[8 * s + 7]);
    return __builtin_bit_cast(bf16x8, p);
}
__device__ __forceinline__ bf16x8 tr_pair(LAS unsigned char* p0, LAS unsigned char* p1) {
    const s16x4 lo = __builtin_bit_cast(s16x4, __builtin_amdgcn_ds_read_tr16_b64_v4i16((LAS v4i16_t*)p0));
    const s16x4 hi4 = __builtin_bit_cast(s16x4, __builtin_amdgcn_ds_read_tr16_b64_v4i16((LAS v4i16_t*)p1));
    return (bf16x8){lo[0], lo[1], lo[2], lo[3], hi4[0], hi4[1], hi4[2], hi4[3]};
}
#define DPPF_(x, ctrl) __builtin_bit_cast(float, __builtin_amdgcn_update_dpp(0, __builtin_bit_cast(int, (x)), (ctrl), 0xf, 0xf, true))
__device__ __forceinline__ void hg_prep8(LAS unsigned char* bufp, const v4u rq, const v4u rf, const f32x4 lbA, const f32x4 lbB, int pc, int dk8, int lane) {
    const float lbv[8] = {lbA.x, lbA.y, lbA.z, lbA.w, lbB.x, lbB.y, lbB.z, lbB.w};
    float bb[8], fv[8];
    const unsigned fw[4] = {rf.x, rf.y, rf.z, rf.w}, qw[4] = {rq.x, rq.y, rq.z, rq.w};
#pragma unroll
    for (int i = 0; i < 8; ++i) { const float x = (i & 1) ? bfhi(fw[i >> 1]) : bflo(fw[i >> 1]); const float f = lbv[i] + (1.f - lbv[i]) * __builtin_amdgcn_rcpf(1.f + __expf(-x)); fv[i] = f; bb[i] = f; }
#define HG_SCAN_STEP(ctrl) asm volatile("s_nop 1\n\tv_mul_f32_dpp %0, %0, %0 " ctrl "\n\tv_mul_f32_dpp %1, %1, %1 " ctrl "\n\tv_mul_f32_dpp %2, %2, %2 " ctrl "\n\tv_mul_f32_dpp %3, %3, %3 " ctrl "\n\t" \
        "v_mul_f32_dpp %4, %4, %4 " ctrl "\n\tv_mul_f32_dpp %5, %5, %5 " ctrl "\n\tv_mul_f32_dpp %6, %6, %6 " ctrl "\n\tv_mul_f32_dpp %7, %7, %7 " ctrl \
        : "+v"(bb[0]), "+v"(bb[1]), "+v"(bb[2]), "+v"(bb[3]), "+v"(bb[4]), "+v"(bb[5]), "+v"(bb[6]), "+v"(bb[7]))
    HG_SCAN_STEP("row_shr:1 row_mask:0xf bank_mask:0xf");
    HG_SCAN_STEP("row_shr:2 row_mask:0xf bank_mask:0xf");
    HG_SCAN_STEP("row_shr:4 row_mask:0xf bank_mask:0xf");
    HG_SCAN_STEP("row_shr:8 row_mask:0xf bank_mask:0xf");
    HG_SCAN_STEP("row_bcast:15 row_mask:0xa bank_mask:0xf");
#undef HG_SCAN_STEP
    float qd[8], ki[8];
#pragma unroll
    for (int i = 0; i < 8; ++i) { const float e = bb[i], ei = __builtin_amdgcn_rcpf(bb[i]);
        const float xq = (i & 1) ? bfhi(qw[i >> 1]) : bflo(qw[i >> 1]); const float q = xq * __builtin_amdgcn_rcpf(1.f + __expf(-xq)); const float k = 1.f - fv[i];
        qd[i] = q * e; ki[i] = k * ei; }
    *(LAS v4u*)(bufp + HG_QD + pc * HG_P + dk8 * 2) = (v4u){cvtpk_bf16(qd[0], qd[1]), cvtpk_bf16(qd[2], qd[3]), cvtpk_bf16(qd[4], qd[5]), cvtpk_bf16(qd[6], qd[7])};
    *(LAS v4u*)(bufp + HG_KI + pc * HG_P + dk8 * 2) = (v4u){cvtpk_bf16(ki[0], ki[1]), cvtpk_bf16(ki[2], ki[3]), cvtpk_bf16(ki[4], ki[5]), cvtpk_bf16(ki[6], ki[7])};
    if (pc == 31) { *(LAS f32x4*)(bufp + HG_CD + dk8 * 4) = (f32x4){bb[0], bb[1], bb[2], bb[3]}; *(LAS f32x4*)(bufp + HG_CD + dk8 * 4 + 16) = (f32x4){bb[4], bb[5], bb[6], bb[7]}; }
}
__device__ __forceinline__ void hgrn_mfma(Frame& F) {
    const bf16* PROJ = (const bf16*)(F.ws + WS_PROJ); bf16* MIXED = (bf16*)(F.ws + WS_HN);
    const float* small = (const float*)(F.ws + WS_SMALL);
    LAS unsigned char* lds = F.lds;
    const int tid = F.tid, lane = F.lane, wave = F.wave, r32 = lane & 31, hh = lane >> 5;
    for (int u = F.vcu; u < 64; u += F.G) {
        const int b = u >> 2, h = u & 3; const size_t tok0 = (size_t)b * SEQ;
        __syncthreads();
        if (wave >= 4) {
            const int pt = tid - 256, pc = lane & 31, dkA = 16 * (wave - 4) + 8 * hh;
            const int vcA = pt >> 4, vseg = pt & 15;
            const f32x4 lb0 = *(const GAS f32x4*)(small + SM_LB + h * 128 + dkA), lb1 = *(const GAS f32x4*)(small + SM_LB + h * 128 + dkA + 4);
            const f32x4 lb2 = *(const GAS f32x4*)(small + SM_LB + h * 128 + dkA + 64), lb3 = *(const GAS f32x4*)(small + SM_LB + h * 128 + dkA + 68);
            v4u q0A, f0A, v0A, g0A, q1A, f1A, v1A, g1A, q0B, f0B, v0B, g0B, q1B, f1B, v1B, g1B, q0C, f0C, v0C, g0C, q1C, f1C, v1C, g1C, q0D, f0D, v0D, g0D, q1D, f1D, v1D, g1D;
#define HP_LOAD(S, chn) do { const bf16* p_ = PROJ + (tok0 + 32 * (chn) + pc) * INW + h * 128 + dkA; const bf16* v_ = PROJ + (tok0 + 32 * (chn) + vcA) * INW + h * 128 + vseg * 8; \
            asm volatile("global_load_dwordx4 %0, %1, off" : "=v"(q0##S) : "v"(p_ + C_HQ) : "memory"); \
            asm volatile("global_load_dwordx4 %0, %1, off" : "=v"(f0##S) : "v"(p_ + C_HF) : "memory"); \
            asm volatile("global_load_dwordx4 %0, %1, off" : "=v"(v0##S) : "v"(v_ + C_HI) : "memory"); \
            asm volatile("global_load_dwordx4 %0, %1, off" : "=v"(g0##S) : "v"(v_ + C_HG) : "memory"); \
            asm volatile("global_load_dwordx4 %0, %1, off" : "=v"(q1##S) : "v"(p_ + C_HQ + 64) : "memory"); \
            asm volatile("global_load_dwordx4 %0, %1, off" : "=v"(f1##S) : "v"(p_ + C_HF + 64) : "memory"); \
            asm volatile("global_load_dwordx4 %0, %1, off" : "=v"(v1##S) : "v"(v_ + (size_t)16 * INW + C_HI) : "memory"); \
            asm volatile("global_load_dwordx4 %0, %1, off" : "=v"(g1##S) : "v"(v_ + (size_t)16 * INW + C_HG) : "memory"); } while (0)
#define HP_WAIT(S) asm volatile("s_waitcnt vmcnt(24)" : "+v"(q0##S), "+v"(f0##S), "+v"(v0##S), "+v"(g0##S), "+v"(q1##S), "+v"(f1##S), "+v"(v1##S), "+v"(g1##S) :: "memory")
#define HP_PASS0(S, bufp) do { hg_prep8(bufp, q0##S, f0##S, lb0, lb1, pc, dkA, lane); \
            *(LAS v4u*)((bufp) + HG_V + vcA * HG_VP + vseg * 16) = v0##S; *(LAS v4u*)((bufp) + HG_V + (vcA + 16) * HG_VP + vseg * 16) = v1##S; \
            *(LAS v4u*)((bufp) + HG_G + vcA * HG_GP + vseg * 16) = g0##S; *(LAS v4u*)((bufp) + HG_G + (vcA + 16) * HG_GP + vseg * 16) = g1##S; } while (0)
#define HP_PASS1(S, bufp) hg_prep8(bufp, q1##S, f1##S, lb2, lb3, pc, dkA + 64, lane)
#define HP_CL(c) ((c) < SEQ / 32 ? (c) : SEQ / 32 - 1)
            HP_LOAD(A, 0); HP_LOAD(B, 1); HP_LOAD(C, 2); HP_LOAD(D, 3);
            HP_WAIT(A); HP_PASS0(A, lds); HP_PASS1(A, lds);
            HP_LOAD(A, 4);
            for (int ch4 = 0; ch4 < SEQ / 32; ch4 += 4) {
                __syncthreads();
                HP_WAIT(B); HP_PASS0(B, lds + HG_BUF);
                __syncthreads();
                HP_PASS1(B, lds + HG_BUF); HP_LOAD(B, HP_CL(ch4 + 5));
                __syncthreads();
                HP_WAIT(C); HP_PASS0(C, lds);
                __syncthreads();
                HP_PASS1(C, lds); HP_LOAD(C, HP_CL(ch4 + 6));
                __syncthreads();
                HP_WAIT(D); HP_PASS0(D, lds + HG_BUF);
                __syncthreads();
                HP_PASS1(D, lds + HG_BUF); HP_LOAD(D, HP_CL(ch4 + 7));
                __syncthreads();
                HP_WAIT(A); HP_PASS0(A, lds);
                __syncthreads();
                HP_PASS1(A, lds); HP_LOAD(A, HP_CL(ch4 + 8));
            }
            asm volatile("s_waitcnt vmcnt(0)" : "+v"(q0A), "+v"(f0A), "+v"(v0A), "+v"(g0A), "+v"(q1A), "+v"(f1A), "+v"(v1A), "+v"(g1A), "+v"(q0B), "+v"(f0B), "+v"(v0B), "+v"(g0B), "+v"(q1B), "+v"(f1B), "+v"(v1B), "+v"(g1B) :: "memory");
            asm volatile("" : "+v"(q0C), "+v"(f0C), "+v"(v0C), "+v"(g0C), "+v"(q1C), "+v"(f1C), "+v"(v1C), "+v"(g1C), "+v"(q0D), "+v"(f0D), "+v"(v0D), "+v"(g0D), "+v"(q1D), "+v"(f1D), "+v"(v1D), "+v"(g1D) :: "memory");
#undef HP_CL
#undef HP_LOAD
#undef HP_WAIT
#undef HP_PASS0
#undef HP_PASS1
        } else {
            const int dvt = wave;
            const int kdoff = (((lane & 15) >> 2)) * HG_P + (16 * ((lane >> 4) & 1) + 4 * (lane & 3)) * 2;
            const int troff = (((lane & 15) >> 2)) * HG_VP + (32 * dvt + 16 * ((lane >> 4) & 1) + 4 * (lane & 3)) * 2;
            const int vc = tid >> 3, sg = tid & 7;
            const f32x4 ga0 = *(const GAS f32x4*)(F.in[10] + 8 * sg), ga1 = *(const GAS f32x4*)(F.in[10] + 8 * sg + 4);
            const f32x4 gb0 = *(const GAS f32x4*)(F.in[10] + 64 + 8 * sg), gb1 = *(const GAS f32x4*)(F.in[10] + 64 + 8 * sg + 4);
            f32x16 S0, S1, S2, S3;
#pragma unroll
            for (int r = 0; r < 16; ++r) { S0[r] = 0.f; S1[r] = 0.f; S2[r] = 0.f; S3[r] = 0.f; }
            for (int ch = 0; ch < SEQ / 32; ++ch) {
                LAS unsigned char* bufp = lds + (ch & 1) * HG_BUF;
                __syncthreads();
                f32x16 o, X;
#pragma unroll
                for (int r = 0; r < 16; ++r) { o[r] = 0.f; X[r] = 0.f; }
                bf16x8 qaf[8], kif[8], qdf[8];
                __builtin_amdgcn_sched_barrier(0);
#pragma unroll
                for (int i = 0; i < 8; ++i) { LAS unsigned char* qa = bufp + HG_QD + r32 * HG_P + (16 * i + 4 * hh) * 2;
                    const v2u a0 = *(const LAS v2u*)qa, a1 = *(const LAS v2u*)(qa + 16); qaf[i] = __builtin_bit_cast(bf16x8, (v4u){a0.x, a0.y, a1.x, a1.y}); }
#pragma unroll
                for (int s8 = 0; s8 < 4; ++s8) { kif[s8] = *(const LAS bf16x8*)(bufp + HG_KI + r32 * HG_P + (16 * s8 + 8 * hh) * 2); qdf[s8] = *(const LAS bf16x8*)(bufp + HG_QD + r32 * HG_P + (16 * s8 + 8 * hh) * 2); }
                __builtin_amdgcn_sched_barrier(0);
#pragma unroll
                for (int i = 0; i < 8; ++i)
                    o = __builtin_amdgcn_mfma_f32_32x32x16_bf16(qaf[i], pack8((i >> 1) == 0 ? S0 : (i >> 1) == 1 ? S1 : (i >> 1) == 2 ? S2 : S3, i & 1), o, 0, 0, 0);
#pragma unroll
                for (int s8 = 4; s8 < 8; ++s8) { kif[s8] = *(const LAS bf16x8*)(bufp + HG_KI + r32 * HG_P + (16 * s8 + 8 * hh) * 2); qdf[s8] = *(const LAS bf16x8*)(bufp + HG_QD + r32 * HG_P + (16 * s8 + 8 * hh) * 2); }
                bf16x8 vx0, vx1;
                { LAS unsigned char* vp = bufp + HG_V + troff + (4 * hh) * HG_VP; vx0 = tr_pair(vp, vp + 8 * HG_VP); vx1 = tr_pair(vp + 16 * HG_VP, vp + 24 * HG_VP); }
                __builtin_amdgcn_sched_barrier(0);
#pragma unroll
                for (int s8 = 0; s8 < 8; ++s8) X = __builtin_amdgcn_mfma_f32_32x32x16_bf16(kif[s8], qdf[s8], X, 0, 0, 0);
                __builtin_amdgcn_sched_barrier(0);
#pragma unroll
                for (int r = 0; r < 16; ++r) { const int cp = (r & 3) + 8 * (r >> 2) + 4 * hh; X[r] = cp > r32 ? 0.f : X[r]; }
                o = __builtin_amdgcn_mfma_f32_32x32x16_bf16(pack8(X, 0), vx0, o, 0, 0, 0);
                o = __builtin_amdgcn_mfma_f32_32x32x16_bf16(pack8(X, 1), vx1, o, 0, 0, 0);
                { LAS float* ob = (LAS float*)(lds + HG_O) + 32 * dvt + r32;
#pragma unroll
                  for (int r = 0; r < 16; ++r) ob[((r & 3) + 8 * (r >> 2) + 4 * hh) * HG_OP] = o[r]; }
                __syncthreads();
                { bf16x8 kaf[8], vbf[2];
                  __builtin_amdgcn_sched_barrier(0);
#pragma unroll
                  for (int s2 = 0; s2 < 2; ++s2) { LAS unsigned char* vp = bufp + HG_V + troff + (16 * s2 + 8 * hh) * HG_VP; vbf[s2] = tr_pair(vp, vp + 4 * HG_VP); }
#pragma unroll
                  for (int i = 0; i < 8; ++i) { LAS unsigned char* kp = bufp + HG_KI + kdoff + (16 * (i & 1) + 8 * hh) * HG_P + 32 * (i >> 1) * 2;
                      kaf[i] = tr_pair(kp, kp + 4 * HG_P); }
                  __builtin_amdgcn_sched_barrier(0);
#pragma unroll
                  for (int i = 0; i < 8; ++i) {
                      if ((i >> 1) == 0)      S0 = __builtin_amdgcn_mfma_f32_32x32x16_bf16(kaf[i], vbf[i & 1], S0, 0, 0, 0);
                      else if ((i >> 1) == 1) S1 = __builtin_amdgcn_mfma_f32_32x32x16_bf16(kaf[i], vbf[i & 1], S1, 0, 0, 0);
                      else if ((i >> 1) == 2) S2 = __builtin_amdgcn_mfma_f32_32x32x16_bf16(kaf[i], vbf[i & 1], S2, 0, 0, 0);
                      else                    S3 = __builtin_amdgcn_mfma_f32_32x32x16_bf16(kaf[i], vbf[i & 1], S3, 0, 0, 0);
                  }
                  __builtin_amdgcn_sched_barrier(0); }
#pragma unroll
                for (int kk = 0; kk < 4; ++kk) {
                    const LAS float* cdp = (const LAS float*)(bufp + HG_CD) + 32 * kk + 4 * hh;
#pragma unroll
                    for (int r4 = 0; r4 < 4; ++r4) { const f32x4 c4 = *(const LAS f32x4*)(cdp + 8 * r4);
                        if (kk == 0)      { S0[4 * r4] *= c4.x; S0[4 * r4 + 1] *= c4.y; S0[4 * r4 + 2] *= c4.z; S0[4 * r4 + 3] *= c4.w; }
                        else if (kk == 1) { S1[4 * r4] *= c4.x; S1[4 * r4 + 1] *= c4.y; S1[4 * r4 + 2] *= c4.z; S1[4 * r4 + 3] *= c4.w; }
                        else if (kk == 2) { S2[4 * r4] *= c4.x; S2[4 * r4 + 1] *= c4.y; S2[4 * r4 + 2] *= c4.z; S2[4 * r4 + 3] *= c4.w; }
                        else              { S3[4 * r4] *= c4.x; S3[4 * r4 + 1] *= c4.y; S3[4 * r4 + 2] *= c4.z; S3[4 * r4 + 3] *= c4.w; } }
                }
                { const LAS float* op = (const LAS float*)(lds + HG_O) + vc * HG_OP + 8 * sg;
                  const f32x4 x0 = *(const LAS f32x4*)op, x1 = *(const LAS f32x4*)(op + 4), x2 = *(const LAS f32x4*)(op + 64), x3 = *(const LAS f32x4*)(op + 68);
                  const v4u gwa = *(const LAS v4u*)(bufp + HG_G + vc * HG_GP + sg * 16), gwb = *(const LAS v4u*)(bufp + HG_G + vc * HG_GP + (sg + 8) * 16);
                  float ss = ((x0.x * x0.x + x0.y * x0.y) + (x0.z * x0.z + x0.w * x0.w)) + ((x1.x * x1.x + x1.y * x1.y) + (x1.z * x1.z + x1.w * x1.w))
                           + ((x2.x * x2.x + x2.y * x2.y) + (x2.z * x2.z + x2.w * x2.w)) + ((x3.x * x3.x + x3.y * x3.y) + (x3.z * x3.z + x3.w * x3.w));
                  ss += DPPF_(ss, 0xB1); ss += DPPF_(ss, 0x4E); ss += DPPF_(ss, 0x141);
                  const float rr = __builtin_amdgcn_rsqf(ss * (1.f / 128.f) + EPS);
                  const size_t tok = tok0 + 32 * ch + vc;
                  const unsigned gwa_[4] = {gwa.x, gwa.y, gwa.z, gwa.w}, gwb_[4] = {gwb.x, gwb.y, gwb.z, gwb.w};
                  const float ova[8] = {x0.x, x0.y, x0.z, x0.w, x1.x, x1.y, x1.z, x1.w}, ovb[8] = {x2.x, x2.y, x2.z, x2.w, x3.x, x3.y, x3.z, x3.w};
                  const float gga[8] = {ga0.x, ga0.y, ga0.z, ga0.w, ga1.x, ga1.y, ga1.z, ga1.w}, ggb[8] = {gb0.x, gb0.y, gb0.z, gb0.w, gb1.x, gb1.y, gb1.z, gb1.w};
                  unsigned wa[4], wb[4];
#pragma unroll
                  for (int j = 0; j < 4; ++j) { const float a0 = bflo(gwa_[j]), a1 = bfhi(gwa_[j]), b0 = bflo(gwb_[j]), b1 = bfhi(gwb_[j]);
                      wa[j] = cvtpk_bf16(ova[2 * j] * rr * gga[2 * j] * (a0 * __builtin_amdgcn_rcpf(1.f + __expf(-a0))), ova[2 * j + 1] * rr * gga[2 * j + 1] * (a1 * __builtin_amdgcn_rcpf(1.f + __expf(-a1))));
                      wb[j] = cvtpk_bf16(ovb[2 * j] * rr * ggb[2 * j] * (b0 * __builtin_amdgcn_rcpf(1.f + __expf(-b0))), ovb[2 * j + 1] * rr * ggb[2 * j + 1] * (b1 * __builtin_amdgcn_rcpf(1.f + __expf(-b1)))); }
                  bf16* dst = MIXED + tok * DM + 512 + h * 128 + 8 * sg;
                  *(GAS v4u*)dst = (v4u){wa[0], wa[1], wa[2], wa[3]}; *(GAS v4u*)(dst + 64) = (v4u){wb[0], wb[1], wb[2], wb[3]}; }
            }
        }
    }
}
template <int N> __device__ __forceinline__ unsigned row_ror(unsigned x) { return (unsigned)__builtin_amdgcn_update_dpp((int)x, (int)x, 0x120 + N, 0xf, 0xf, false); }
__device__ __forceinline__ unsigned umax_(unsigned a, unsigned b) { return a > b ? a : b; }
__device__ __forceinline__ unsigned umin_(unsigned a, unsigned b) { return a < b ? a : b; }
__device__ __forceinline__ unsigned row_umax16(unsigned x) {
    unsigned y;
    asm volatile("s_nop 1\n\tv_max_u32_dpp %0, %1, %1 row_ror:1 row_mask:0xf bank_mask:0xf\n\t"
                 "s_nop 1\n\tv_max_u32_dpp %0, %0, %0 row_ror:2 row_mask:0xf bank_mask:0xf\n\t"
                 "s_nop 1\n\tv_max_u32_dpp %0, %0, %0 row_ror:4 row_mask:0xf bank_mask:0xf\n\t"
                 "s_nop 1\n\tv_max_u32_dpp %0, %0, %0 row_ror:8 row_mask:0xf bank_mask:0xf"
                 : "=&v"(y) : "v"(x));
    return y;
}
__device__ __forceinline__ float row_fsum16(float v) {
    v += __builtin_bit_cast(float, row_ror<1>(__builtin_bit_cast(unsigned, v))); v += __builtin_bit_cast(float, row_ror<2>(__builtin_bit_cast(unsigned, v)));
    v += __builtin_bit_cast(float, row_ror<4>(__builtin_bit_cast(unsigned, v))); v += __builtin_bit_cast(float, row_ror<8>(__builtin_bit_cast(unsigned, v))); return v; }
__device__ __forceinline__ unsigned h2key(unsigned x) { return (x & 0x80000000u) ? (~x & 0xffff0000u) : (x | 0x80000000u); }
__device__ __forceinline__ float hkey2f(unsigned k) { const unsigned hb = ((k & 0x80000000u) ? (k & 0x7fff0000u) : (~k & 0xffff0000u)) >> 16; return (float)__builtin_bit_cast(_Float16, (unsigned short)hb); }
__device__ __forceinline__ unsigned f2key(float f) { const unsigned u = __builtin_bit_cast(unsigned, f); return (u & 0x80000000u) ? ~u : (u | 0x80000000u); }
__device__ __forceinline__ float key2f(unsigned k) { const unsigned u = (k & 0x80000000u) ? (k & 0x7fffffffu) : ~k; return __builtin_bit_cast(float, u); }
__device__ __forceinline__ unsigned pair_code(int s) {
    if (s < 16) return (unsigned)s;
    if (s < 24) return 16u + (unsigned)(s - 16);
    if (s < 29) return 32u + (unsigned)(s - 24);
    if (s < 33) return 48u + (unsigned)(s - 29);
    if (s < 36) return 64u + (unsigned)(s - 33);
    if (s < 42) return 80u + 16u * (unsigned)((s - 36) >> 1) + (unsigned)((s - 36) & 1);
    if (s < 50) return 128u + 16u * (unsigned)(s - 42);
    return 0xFFu;
}
#define CAS_(a, b) do { const unsigned hi_ = umax_(a, b), lo_ = umin_(a, b); a = hi_; b = lo_; } while (0)
__device__ __forceinline__ void row_umax16_x2(unsigned xa, unsigned xb, unsigned& ya, unsigned& yb) {
    asm volatile("s_nop 1\n\tv_max_u32_dpp %0, %2, %2 row_ror:1 row_mask:0xf bank_mask:0xf\n\tv_max_u32_dpp %1, %3, %3 row_ror:1 row_mask:0xf bank_mask:0xf\n\t"
                 "s_nop 0\n\tv_max_u32_dpp %0, %0, %0 row_ror:2 row_mask:0xf bank_mask:0xf\n\tv_max_u32_dpp %1, %1, %1 row_ror:2 row_mask:0xf bank_mask:0xf\n\t"
                 "s_nop 0\n\tv_max_u32_dpp %0, %0, %0 row_ror:4 row_mask:0xf bank_mask:0xf\n\tv_max_u32_dpp %1, %1, %1 row_ror:4 row_mask:0xf bank_mask:0xf\n\t"
                 "s_nop 0\n\tv_max_u32_dpp %0, %0, %0 row_ror:8 row_mask:0xf bank_mask:0xf\n\tv_max_u32_dpp %1, %1, %1 row_ror:8 row_mask:0xf bank_mask:0xf"
                 : "=&v"(ya), "=&v"(yb) : "v"(xa), "v"(xb));
}
__device__ __forceinline__ void row_umax16_x4(unsigned xa, unsigned xb, unsigned xc, unsigned xd, unsigned& ya, unsigned& yb, unsigned& yc, unsigned& yd) {
    asm volatile("s_nop 1\n\tv_max_u32_dpp %0, %4, %4 row_ror:1 row_mask:0xf bank_mask:0xf\n\tv_max_u32_dpp %1, %5, %5 row_ror:1 row_mask:0xf bank_mask:0xf\n\t"
                 "v_max_u32_dpp %2, %6, %6 row_ror:1 row_mask:0xf bank_mask:0xf\n\tv_max_u32_dpp %3, %7, %7 row_ror:1 row_mask:0xf bank_mask:0xf\n\t"
                 "v_max_u32_dpp %0, %0, %0 row_ror:2 row_mask:0xf bank_mask:0xf\n\tv_max_u32_dpp %1, %1, %1 row_ror:2 row_mask:0xf bank_mask:0xf\n\t"
                 "v_max_u32_dpp %2, %2, %2 row_ror:2 row_mask:0xf bank_mask:0xf\n\tv_max_u32_dpp %3, %3, %3 row_ror:2 row_mask:0xf bank_mask:0xf\n\t"
                 "v_max_u32_dpp %0, %0, %0 row_ror:4 row_mask:0xf bank_mask:0xf\n\tv_max_u32_dpp %1, %1, %1 row_ror:4 row_mask:0xf bank_mask:0xf\n\t"
                 "v_max_u32_dpp %2, %2, %2 row_ror:4 row_mask:0xf bank_mask:0xf\n\tv_max_u32_dpp %3, %3, %3 row_ror:4 row_mask:0xf bank_mask:0xf\n\t"
                 "v_max_u32_dpp %0, %0, %0 row_ror:8 row_mask:0xf bank_mask:0xf\n\tv_max_u32_dpp %1, %1, %1 row_ror:8 row_mask:0xf bank_mask:0xf\n\t"
                 "v_max_u32_dpp %2, %2, %2 row_ror:8 row_mask:0xf bank_mask:0xf\n\tv_max_u32_dpp %3, %3, %3 row_ror:8 row_mask:0xf bank_mask:0xf"
                 : "=&v"(ya), "=&v"(yb), "=&v"(yc), "=&v"(yd) : "v"(xa), "v"(xb), "v"(xc), "v"(xd));
}
#define TK_LOAD(th_) (*(const GAS v4u*)(SC + (size_t)((th_) >> 3) * 2048 + ((th_) & 7) * 256 + c * 128 + l15 * 8))
#define TK_LOADSORT(P, sv_) \
    unsigned P##0, P##1, P##2, P##3, P##4, P##5, P##6, P##7; \
    { const v4u sv = (sv_); const unsigned nb = 127u - 8u * (unsigned)l15; \
      P##0 = h2key(sv.x << 16) | nb; P##1 = h2key(sv.x & 0xffff0000u) | (nb - 1u); P##2 = h2key(sv.y << 16) | (nb - 2u); P##3 = h2key(sv.y & 0xffff0000u) | (nb - 3u); \
      P##4 = h2key(sv.z << 16) | (nb - 4u); P##5 = h2key(sv.z & 0xffff0000u) | (nb - 5u); P##6 = h2key(sv.w << 16) | (nb - 6u); P##7 = h2key(sv.w & 0xffff0000u) | (nb - 7u); \
      CAS_(P##0, P##1); CAS_(P##2, P##3); CAS_(P##4, P##5); CAS_(P##6, P##7); CAS_(P##0, P##2); CAS_(P##1, P##3); CAS_(P##4, P##6); CAS_(P##5, P##7); CAS_(P##1, P##2); CAS_(P##5, P##6); CAS_(P##0, P##4); CAS_(P##3, P##7); \
      CAS_(P##1, P##5); CAS_(P##2, P##6); CAS_(P##1, P##4); CAS_(P##3, P##6); CAS_(P##2, P##4); CAS_(P##3, P##5); CAS_(P##3, P##4); }
#define TK_POP(P, m_) do { const bool pop_ = (P##0 == (m_)); P##0 = pop_ ? P##1 : P##0; P##1 = pop_ ? P##2 : P##1; P##2 = pop_ ? P##3 : P##2; P##3 = pop_ ? P##4 : P##3; \
      P##4 = pop_ ? P##5 : P##4; P##5 = pop_ ? P##6 : P##5; P##6 = pop_ ? P##7 : P##6; P##7 = pop_ ? 0u : P##7; } while (0)
__device__ __forceinline__ void topk_stage1x2(const v4u svA, const v4u svB, int l15, unsigned& resA, unsigned& resB) {
    TK_LOADSORT(ka, svA) TK_LOADSORT(kb, svB)
    unsigned ra = 0u, rb = 0u;
#pragma unroll
    for (int r = 0; r < 16; ++r) {
        unsigned ma, mb; row_umax16_x2(ka0, kb0, ma, mb);
        TK_POP(ka, ma); TK_POP(kb, mb);
        ra = (l15 == r) ? ma : ra; rb = (l15 == r) ? mb : rb;
    }
    resA = ra; resB = rb;
}
__device__ __forceinline__ void topk_stage1x4(const v4u svA, const v4u svB, const v4u svC, const v4u svD, int l15, unsigned& resA, unsigned& resB, unsigned& resC, unsigned& resD) {
    TK_LOADSORT(ka, svA) TK_LOADSORT(kb, svB) TK_LOADSORT(kc, svC) TK_LOADSORT(kd, svD)
    unsigned ra = 0u, rb = 0u, rc = 0u, rd = 0u;
#pragma unroll
    for (int r = 0; r < 16; ++r) {
        unsigned ma, mb, mc, md; row_umax16_x4(ka0, kb0, kc0, kd0, ma, mb, mc, md);
        TK_POP(ka, ma); TK_POP(kb, mb); TK_POP(kc, mc); TK_POP(kd, md);
        ra = (l15 == r) ? ma : ra; rb = (l15 == r) ? mb : rb; rc = (l15 == r) ? mc : rc; rd = (l15 == r) ? md : rd;
    }
    resA = ra; resB = rb; resC = rc; resD = rd;
}
__device__ __forceinline__ void topk_v2(Frame& F) {
    const unsigned short* SC = (const unsigned short*)(F.ws + WS_SC); int* IDX = (int*)(F.ws + WS_IDX); float* GATE = (float*)(F.ws + WS_GATE); float* GSU = (float*)(F.ws + WS_GSU);
    const float* SU = (const float*)(F.ws + WS_SU); const float* SV = (const float*)(F.ws + WS_SV);
    const int gw = F.vcu * NWAVES + F.wave, NGW = F.G * NWAVES, lane = F.lane, l15 = lane & 15, row = lane >> 4, c = row & 1, rbase = lane & 48;
    const unsigned pc0 = pair_code(l15), pc1 = pair_code(l15 + 16), pc2 = pair_code(l15 + 32), pc3 = pair_code(l15 + 48);
    const int src1 = l15 + 32 * (row & 1), src2 = src1 + 16;
    for (int it0 = gw * 32; it0 < NTOK * 2; it0 += NGW * 32) {
    v4u svA = TK_LOAD(4 * it0 + (row >> 1)), svB = TK_LOAD(4 * it0 + 2 + (row >> 1)), svC = TK_LOAD(4 * it0 + 4 + (row >> 1)), svD = TK_LOAD(4 * it0 + 6 + (row >> 1));
    for (int it = it0; it < it0 + 32; it += 2) {
        const int thb = 4 * it; const int thn = 4 * (it + 2 < it0 + 32 ? it + 2 : it);
        const v4u nvA = TK_LOAD(thn + (row >> 1)), nvB = TK_LOAD(thn + 2 + (row >> 1)), nvC = TK_LOAD(thn + 4 + (row >> 1)), nvD = TK_LOAD(thn + 6 + (row >> 1));
        unsigned resA, resB, resC, resD; topk_stage1x4(svA, svB, svC, svD, l15, resA, resB, resC, resD); svA = nvA; svB = nvB; svC = nvC; svD = nvD;
#define TK_S12(RA_, RB_, S1_, S2_) const unsigned S1_##a = (unsigned)__shfl((int)RA_, src1), S2_##a = (unsigned)__shfl((int)RA_, src2), S1_##b = (unsigned)__shfl((int)RB_, src1), S2_##b = (unsigned)__shfl((int)RB_, src2); \
        const unsigned S1_ = row < 2 ? S1_##a : S1_##b, S2_ = row < 2 ? S2_##a : S2_##b
        TK_S12(resA, resB, S1x, S2x); TK_S12(resC, resD, S1y, S2y);
#undef TK_S12
        unsigned c0, c1, c2, c3, d0, d1, d2, d3;
#define TK_CAND(CK, PC, S1_, S2_) do { const unsigned ka_ = (unsigned)__shfl((int)S1_, rbase + (int)((PC) >> 4 & 15u)), kb_ = (unsigned)__shfl((int)S2_, rbase + (int)((PC) & 15u)); \
            const float sm_ = hkey2f(ka_) + hkey2f(kb_); CK = (PC) == 0xFFu ? 0u : ((f2key(sm_) & ~0xFFu) | (255u - (PC))); } while (0)
        TK_CAND(c0, pc0, S1x, S2x); TK_CAND(c1, pc1, S1x, S2x); TK_CAND(c2, pc2, S1x, S2x); TK_CAND(c3, pc3, S1x, S2x);
        TK_CAND(d0, pc0, S1y, S2y); TK_CAND(d1, pc1, S1y, S2y); TK_CAND(d2, pc2, S1y, S2y); TK_CAND(d3, pc3, S1y, S2y);
#undef TK_CAND
        CAS_(c0, c1); CAS_(c2, c3); CAS_(c0, c2); CAS_(c1, c3); CAS_(c1, c2);
        CAS_(d0, d1); CAS_(d2, d3); CAS_(d0, d2); CAS_(d1, d3); CAS_(d1, d2);
        unsigned res2x = 0u, res2y = 0u;
#pragma unroll
        for (int r = 0; r < 16; ++r) {
            unsigned mx, my; row_umax16_x2(c0, d0, mx, my);
            const bool popx = (c0 == mx), popy = (d0 == my);
            c0 = popx ? c1 : c0; c1 = popx ? c2 : c1; c2 = popx ? c3 : c2; c3 = popx ? 0u : c3;
            d0 = popy ? d1 : d0; d1 = popy ? d2 : d1; d2 = popy ? d3 : d2; d3 = popy ? 0u : d3;
            res2x = (l15 == r) ? mx : res2x; res2y = (l15 == r) ? my : res2y;
        }
#define TK_FIN(RES2_, S1_, S2_, TH_) do { const unsigned code = 255u - ((RES2_) & 0xFFu); \
            const unsigned ka = (unsigned)__shfl((int)S1_, rbase + (int)(code >> 4 & 15u)), kb = (unsigned)__shfl((int)S2_, rbase + (int)(code & 15u)); \
            const float ts = hkey2f(ka) + hkey2f(kb); \
            const int e = (int)((127u - (ka & 0x7Fu)) * 128u + (127u - (kb & 0x7Fu))); \
            const float sve = SV[e], sue = SU[e];                                \
            const float tmax = __builtin_bit_cast(float, (unsigned)__shfl((int)__builtin_bit_cast(unsigned, ts), rbase)); \
            const float ex = __expf(ts - tmax); \
            const float sum = row_fsum16(ex); \
            const int th = (TH_) + row; \
            const size_t o = (size_t)(th >> 3) * NEXP_SEL + (th & 7) * 16 + l15; \
            IDX[o] = e; GATE[o] = ex / sum * sve; GSU[o] = sue; } while (0)
        TK_FIN(res2x, S1x, S2x, thb); TK_FIN(res2y, S1y, S2y, thb + 4);
#undef TK_FIN
    } }
}

constexpr int PG_TOK = 16;
constexpr int PG_IDX = 0, PG_HID = 4096, PG_SA = PG_HID + 8192, PG_TB = PG_SA + 64, PG_WB = PG_TB + 4096;
static_assert(PG_WB % 16 == 0 && PG_TB % 16 == 0 && NWAVES * PG_WB <= RING_BYTES, "gather LDS map");
typedef int pgv4i __attribute__((ext_vector_type(4))); typedef int pgv8i __attribute__((ext_vector_type(8)));
__device__ __forceinline__ pgv8i pg_cat8(const l2 a, const l2 b) { const pgv4i x = __builtin_bit_cast(pgv4i, a), y = __builtin_bit_cast(pgv4i, b); return __builtin_shufflevector(x, y, 0, 1, 2, 3, 4, 5, 6, 7); }
__device__ __forceinline__ pgv8i pg_lo8(const l2 a) { const pgv4i x = __builtin_bit_cast(pgv4i, a); return (pgv8i){x[0], x[1], x[2], x[3], 0, 0, 0, 0}; }
__device__ __forceinline__ void peer_sliced(Frame& F) {
    const unsigned char* U8T = F.ws + WS_U8; const unsigned char* V8T = F.ws + WS_V8; const unsigned char* X8 = F.ws + WS_X8; unsigned char* X4 = F.ws + WS_X4;
    const float* SSQ = (const float*)(F.ws + WS_CTL) + CW_SSQ;
    const int* IDX = (const int*)(F.ws + WS_IDX); const float* GATE = (const float*)(F.ws + WS_GATE); const float* GSU = (const float*)(F.ws + WS_GSU); const float* gf = F.in[17];
    bf16* PO = (bf16*)(F.ws + WS_PO); const bf16* HB = (const bf16*)(F.ws + WS_HN2);
    const int gw = F.vcu * NWAVES + F.wave, NGW = F.G * NWAVES, lane = F.lane, m = lane & 15, g = lane >> 4;
    const int row8 = lane >> 3, piece = lane & 7;
    LAS unsigned char* wb = F.lds + F.wave * PG_WB;
    LAS unsigned short* idxs = (LAS unsigned short*)(wb + PG_IDX);
    LAS float* hid = (LAS float*)(wb + PG_HID);
    LAS float* sqp = hid + 64 + lane;
    LAS float* sai = (LAS float*)(wb + PG_SA);
    LAS unsigned char* tb = wb + PG_TB;
    const int p8 = m & 7; const unsigned bsh = 8u * (unsigned)(p8 & 3); const bool bhi = (p8 >> 2) != 0;
    constexpr size_t SLICE = (size_t)16384 * 128;
    const int usw = 16 * (piece ^ ((row8 >> 1) & 3));
    const int urd0 = m * 128 + 16 * ((2 * g) ^ ((m >> 1) & 7)), urd1 = m * 128 + 16 * ((2 * g + 1) ^ ((m >> 1) & 7));
    for (int blk = gw; blk < NTOK / PG_TOK; blk += NGW) {
        const int t0 = blk * PG_TOK;
#pragma unroll
        for (int k = 0; k < 32; ++k) { const int id = lane + 64 * k;
            idxs[16 * (lane & 7) + (lane >> 3) + 128 * (k >> 1) + 8 * (k & 1)] = (unsigned short)IDX[(size_t)t0 * NEXP_SEL + id]; }
#pragma unroll
        for (int k = 0; k < 8; ++k) *(LAS f32x4*)(hid + 4 * (lane + 64 * k)) = (f32x4){0.f, 0.f, 0.f, 0.f};
        LDS_WAIT(); asm volatile("" ::: "memory");
        float xdq = 1.f;
        { f32x4 g2v[4];
#pragma unroll
          for (int q = 0; q < 4; ++q) g2v[q] = *((const GAS f32x4*)F.in[12] + 4 * lane + q);
#pragma unroll
          for (int i0 = 0; i0 < PG_TOK; i0 += 8) { v4u xr[8][2];
#pragma unroll
            for (int i = 0; i < 8; ++i) { const GAS v4u* hp_ = (const GAS v4u*)(HB + (size_t)(t0 + i0 + i) * DM) + 2 * lane; xr[i][0] = hp_[0]; xr[i][1] = hp_[1]; }
#pragma unroll
            for (int i = 0; i < 8; ++i) { const unsigned w_[8] = {xr[i][0].x, xr[i][0].y, xr[i][0].z, xr[i][0].w, xr[i][1].x, xr[i][1].y, xr[i][1].z, xr[i][1].w}; float f_[16]; float am = 0.f;
#pragma unroll
              for (int q = 0; q < 8; ++q) { f_[2 * q] = bflo(w_[q]) * g2v[q >> 1][2 * (q & 1)]; f_[2 * q + 1] = bfhi(w_[q]) * g2v[q >> 1][2 * (q & 1) + 1]; am = fmaxf(am, fmaxf(fabsf(f_[2 * q]), fabsf(f_[2 * q + 1]))); }
#pragma unroll
              for (int o = 1; o < 64; o <<= 1) am = fmaxf(am, __shfl_xor(am, o));
              const float qs = am > 0.f ? 6.f / am : 1.f; unsigned r0 = 0u, r1 = 0u;
              r0 = __builtin_amdgcn_cvt_scalef32_pk_fp4_f32(r0, f_[0] * qs, f_[1] * qs, 1.0f, 0); r0 = __builtin_amdgcn_cvt_scalef32_pk_fp4_f32(r0, f_[2] * qs, f_[3] * qs, 1.0f, 1);
              r0 = __builtin_amdgcn_cvt_scalef32_pk_fp4_f32(r0, f_[4] * qs, f_[5] * qs, 1.0f, 2); r0 = __builtin_amdgcn_cvt_scalef32_pk_fp4_f32(r0, f_[6] * qs, f_[7] * qs, 1.0f, 3);
              r1 = __builtin_amdgcn_cvt_scalef32_pk_fp4_f32(r1, f_[8] * qs, f_[9] * qs, 1.0f, 0); r1 = __builtin_amdgcn_cvt_scalef32_pk_fp4_f32(r1, f_[10] * qs, f_[11] * qs, 1.0f, 1);
              r1 = __builtin_amdgcn_cvt_scalef32_pk_fp4_f32(r1, f_[12] * qs, f_[13] * qs, 1.0f, 2); r1 = __builtin_amdgcn_cvt_scalef32_pk_fp4_f32(r1, f_[14] * qs, f_[15] * qs, 1.0f, 3);
              *(GAS v2u*)(X4 + (size_t)(t0 + i0 + i) * 512 + 8 * lane) = (v2u){r0, r1};
              xdq = lane == i0 + i ? (am > 0.f ? am * (1.f / 6.f) : 1.f) : xdq; } }
        }
        VM_WAIT();
        v4u ab[2][16]; l2 xs[2][2];
#define PGU_ISSUE_AT(UP_, XP_, i_, buf_) do { _Pragma("unroll") for (int k = 0; k < 16; ++k) { const unsigned e = idxs[(i_) * 128 + 16 * row8 + k]; \
                ab[buf_][k] = *(const GAS v4u*)((UP_) + (size_t)(e * 128u + (unsigned)(usw ^ ((k & 1) ? 64 : 0)))); } \
                _Pragma("unroll") for (int q = 0; q < 2; ++q) xs[buf_][q] = *(const GAS l2*)((XP_) + (size_t)(unsigned)(32 * g + (i_) * 512 + 16 * q)); } while (0)
        PGU_ISSUE_AT(U8T, X4 + (size_t)t0 * 512, 0, 0);
        for (int p = 0; p < 4; ++p) {
            const unsigned char* Up = U8T + (size_t)p * SLICE;
            const unsigned char* Xp = X4 + (size_t)t0 * 512 + 128 * p;
#define PGU_WR(i_, cur_, rb_, S_) do { _Pragma("unroll") for (int q4 = 0; q4 < 4; ++q4) *(LAS v4u*)(tb + 1024 * q4 + 16 * lane) = ab[cur_][4 * (rb_) + q4]; \
                S_##0 = *(const LAS l2*)(tb + urd0); S_##1 = *(const LAS l2*)(tb + urd1); S_##2 = *(const LAS l2*)(tb + 2048 + urd0); S_##3 = *(const LAS l2*)(tb + 2048 + urd1); \
                S_##c0 = *(const LAS f32x4*)(hid + (i_) * 128 + 32 * (rb_) + 4 * g); S_##c1 = *(const LAS f32x4*)(hid + (i_) * 128 + 32 * (rb_) + 16 + 4 * g); } while (0)
#define PGU_MF(i_, cur_, rb_, S_) do { f32x4 acc0 = S_##c0, acc1 = S_##c1; \
                const pgv8i x0_ = pg_lo8(xs[cur_][0]), x1_ = pg_lo8(xs[cur_][1]); \
                acc0 = __builtin_amdgcn_mfma_scale_f32_16x16x128_f8f6f4(pg_lo8(S_##0), x0_, acc0, 4, 4, 0, 0x7f7f7f7f, 0, 0x7f7f7f7f); acc1 = __builtin_amdgcn_mfma_scale_f32_16x16x128_f8f6f4(pg_lo8(S_##2), x0_, acc1, 4, 4, 0, 0x7f7f7f7f, 0, 0x7f7f7f7f); \
                acc0 = __builtin_amdgcn_mfma_scale_f32_16x16x128_f8f6f4(pg_lo8(S_##1), x1_, acc0, 4, 4, 0, 0x7f7f7f7f, 0, 0x7f7f7f7f); acc1 = __builtin_amdgcn_mfma_scale_f32_16x16x128_f8f6f4(pg_lo8(S_##3), x1_, acc1, 4, 4, 0, 0x7f7f7f7f, 0, 0x7f7f7f7f); \
                LAS float* hp_ = hid + (i_) * 128 + 32 * (rb_) + 4 * g; \
                asm volatile("s_nop 7\n\ts_mov_b32 exec_lo, 0x10001\n\ts_mov_b32 exec_hi, 0x10001\n\t" \
                             "ds_write_b128 %0, %1\n\tds_write_b128 %0, %2 offset:64\n\t" \
                             "s_mov_b64 exec, -1" \
                             :: "v"(hp_), "v"(acc0), "v"(acc1) : "memory"); } while (0)
#define PGU_BODY(i_, cur_, nxt_) do { { const bool wr_ = (i_) + 1 == PG_TOK; const int nx_ = wr_ ? 0 : (i_) + 1; const unsigned char* un_ = wr_ ? Up + SLICE : Up; const unsigned char* xn_ = wr_ ? Xp + 128 : Xp; PGU_ISSUE_AT(un_, xn_, nx_, nxt_); } SCHED_FENCE(); \
                l2 fa0, fa1, fa2, fa3, fb0, fb1, fb2, fb3; f32x4 fac0, fac1, fbc0, fbc1; \
                PGU_WR(i_, cur_, 0, fa); PGU_WR(i_, cur_, 1, fb); SCHED_FENCE(); \
                PGU_MF(i_, cur_, 0, fa); SCHED_FENCE(); PGU_WR(i_, cur_, 2, fa); SCHED_FENCE(); \
                PGU_MF(i_, cur_, 1, fb); SCHED_FENCE(); PGU_WR(i_, cur_, 3, fb); SCHED_FENCE(); \
                PGU_MF(i_, cur_, 2, fa); SCHED_FENCE(); PGU_MF(i_, cur_, 3, fb); SCHED_FENCE(); } while (0)
            for (int i2 = 0; i2 < PG_TOK; i2 += 2) { PGU_BODY(i2, 0, 1); PGU_BODY(i2 + 1, 1, 0); }
#undef PGU_BODY
#undef PGU_WR
#undef PGU_MF
            LDS_WAIT(); asm volatile("" ::: "memory");
        }
        { f32x2_t suv[16], gvv[16], hv[16];
          float sxl = SSQ[t0 + (lane & 15)]; sxl = xdq / sqrtf(sxl * (1.f / DM) + EPS);
#pragma unroll
          for (int i = 0; i < PG_TOK; ++i) { suv[i] = *(const GAS f32x2_t*)(GSU + (size_t)(t0 + i) * NEXP_SEL + 2 * lane); gvv[i] = *(const GAS f32x2_t*)(GATE + (size_t)(t0 + i) * NEXP_SEL + 2 * lane); }
#pragma unroll
          for (int i = 0; i < PG_TOK; ++i) hv[i] = *(const LAS f32x2_t*)(hid + i * 128 + 2 * lane);
          float w0[16], w1[16], am[16];
#pragma unroll
          for (int i = 0; i < PG_TOK; ++i) { const float sx = __builtin_bit_cast(float, __builtin_amdgcn_readlane(__builtin_bit_cast(int, sxl), i));
              w0[i] = gelu_as(hv[i].x * suv[i].x * sx) * gvv[i].x; w1[i] = gelu_as(hv[i].y * suv[i].y * sx) * gvv[i].y; am[i] = fmaxf(fabsf(w0[i]), fabsf(w1[i])); }
#pragma unroll
          for (int o = 1; o < 64; o <<= 1)
#pragma unroll
              for (int i = 0; i < PG_TOK; ++i) am[i] = fmaxf(am[i], __shfl_xor(am[i], o));
          LDS_WAIT(); asm volatile("" ::: "memory");
#pragma unroll
          for (int i = 0; i < PG_TOK; ++i) { const float sa = am[i] > 0.f ? 224.f / am[i] : 1.f;
              const int pk = __builtin_amdgcn_cvt_pk_fp8_f32(w0[i] * sa, w1[i] * sa, 0, false);
              LAS unsigned char* wq = (LAS unsigned char*)(hid + i * 128) + 32 * (lane & 3) + (lane >> 2);
              wq[0] = (unsigned char)pk; wq[16] = (unsigned char)(pk >> 8);
              if (lane == 0) sai[i] = am[i] > 0.f ? am[i] * (1.f / 224.f) : 1.f; }
        }
        LDS_WAIT(); asm volatile("" ::: "memory");
        v4u va[2][16];
#define PGV_ISSUE_AT(VP_, i_, buf_) do { _Pragma("unroll") for (int k = 0; k < 16; ++k) { const unsigned e = idxs[(i_) * 128 + 16 * row8 + k]; va[buf_][k] = *(const GAS v4u*)((VP_) + (size_t)(e * 128u + 16u * (unsigned)piece)); } } while (0)
        PGV_ISSUE_AT(V8T, 0, 0);
        for (int p = 0; p < 8; ++p) {
            const unsigned char* Vp = V8T + (size_t)p * SLICE;
#define PGV_BODY(i_, cur_, nxt_) do { { const bool wr_ = (i_) + 1 == PG_TOK; const int nx_ = wr_ ? 0 : (i_) + 1; const unsigned char* vn_ = wr_ ? Vp + SLICE : Vp; PGV_ISSUE_AT(vn_, nx_, nxt_); } \
                const v4u w4_ = *(const LAS v4u*)((LAS unsigned char*)(hid + (i_) * 128) + 16 * row8); \
                const unsigned ww[4] = {w4_.x, w4_.y, w4_.z, w4_.w}; \
                SCHED_FENCE(); f32x4 cl = (f32x4){0.f, 0.f, 0.f, 0.f}, chh = (f32x4){0.f, 0.f, 0.f, 0.f}; \
                _Pragma("unroll") for (int k = 0; k < 16; ++k) { \
                    const unsigned a8 = ((ww[k >> 2] >> (8 * (k & 3))) & 0xffu) << bsh; const long bop = (long)(bhi ? ((unsigned long long)a8 << 32) : (unsigned long long)a8); \
                    const long alo = (long)(((unsigned long long)va[cur_][k].y << 32) | (unsigned long long)va[cur_][k].x), ahi = (long)(((unsigned long long)va[cur_][k].w << 32) | (unsigned long long)va[cur_][k].z); \
                    cl = __builtin_amdgcn_mfma_f32_16x16x32_fp8_fp8(alo, bop, cl, 0, 0, 0); chh = __builtin_amdgcn_mfma_f32_16x16x32_fp8_fp8(ahi, bop, chh, 0, 0, 0); } \
                SCHED_FENCE(); \
                _Pragma("unroll") for (int i4 = 0; i4 < 4; ++i4) { \
                    cl[i4] += __shfl(cl[i4], (lane + 40) & 63); chh[i4] += __shfl(chh[i4], (lane + 40) & 63); } \
                { const float isa = sai[i_]; LAS unsigned short* ob = (LAS unsigned short*)(tb) + 64 * g + m;         \
                  if (m < 8 && g < 2) { _Pragma("unroll") for (int i4 = 0; i4 < 4; ++i4) { ob[16 * i4] = (unsigned short)f2bf(cl[i4] * isa); ob[16 * i4 + 8] = (unsigned short)f2bf(chh[i4] * isa); } } \
                  const v4u ov = *(const LAS v4u*)(tb + 16 * (lane & 15)); \
                  if (lane < 16) *(GAS v4u*)(PO + (size_t)(t0 + (i_)) * DM + 128 * p + 8 * lane) = ov; } } while (0)
            for (int i2 = 0; i2 < PG_TOK; i2 += 2) { PGV_BODY(i2, 0, 1); PGV_BODY(i2 + 1, 1, 0); }
#undef PGV_BODY
        }
        LDS_WAIT(); asm volatile("" ::: "memory");
        VM_WAIT();
#undef PGU_ISSUE_AT
#undef PGV_ISSUE_AT
        { f32x4 ggv[4];
#pragma unroll
          for (int j = 0; j < 4; ++j) ggv[j] = *((const GAS f32x4*)gf + lane + 64 * j);
          v2u paX[4], pbX[4], haX[4], hbX[4], paY[4], pbY[4], haY[4], hbY[4];
#define PGF_LOAD(S_, i_) do { const GAS v2u* prA = (const GAS v2u*)(PO + (size_t)(t0 + (i_)) * DM) + lane; const GAS v2u* prB = prA + DM / 4; \
              const GAS v2u* hbA = (const GAS v2u*)(HB + (size_t)(t0 + (i_)) * DM) + lane; const GAS v2u* hbB = hbA + DM / 4; \
              _Pragma("unroll") for (int j = 0; j < 4; ++j) { pa##S_[j] = prA[64 * j]; ha##S_[j] = hbA[64 * j]; pb##S_[j] = prB[64 * j]; hb##S_[j] = hbB[64 * j]; } } while (0)
#define PGF_BODY(S_, i_) do { GAS f32x4* hrA = (GAS f32x4*)(F.out + (size_t)(t0 + (i_)) * DM) + lane; GAS f32x4* hrB = hrA + DM / 4; \
              f32x4 ya[4], yb[4]; float sa = 0.f, sb = 0.f; \
              _Pragma("unroll") for (int j = 0; j < 4; ++j) { \
                  ya[j] = (f32x4){bflo(ha##S_[j].x), bfhi(ha##S_[j].x), bflo(ha##S_[j].y), bfhi(ha##S_[j].y)} + (f32x4){bflo(pa##S_[j].x), bfhi(pa##S_[j].x), bflo(pa##S_[j].y), bfhi(pa##S_[j].y)}; \
                  yb[j] = (f32x4){bflo(hb##S_[j].x), bfhi(hb##S_[j].x), bflo(hb##S_[j].y), bfhi(hb##S_[j].y)} + (f32x4){bflo(pb##S_[j].x), bfhi(pb##S_[j].x), bflo(pb##S_[j].y), bfhi(pb##S_[j].y)}; \
                  sa += (ya[j].x * ya[j].x + ya[j].y * ya[j].y) + (ya[j].z * ya[j].z + ya[j].w * ya[j].w); sb += (yb[j].x * yb[j].x + yb[j].y * yb[j].y) + (yb[j].z * yb[j].z + yb[j].w * yb[j].w); } \
              _Pragma("unroll") for (int o = 1; o < 64; o <<= 1) { sa += __shfl_xor(sa, o); sb += __shfl_xor(sb, o); } \
              const float ra = 1.f / sqrtf(sa * (1.f / DM) + EPS), rb = 1.f / sqrtf(sb * (1.f / DM) + EPS); \
              _Pragma("unroll") for (int j = 0; j < 4; ++j) { hrA[64 * j] = ya[j] * ra * ggv[j]; hrB[64 * j] = yb[j] * rb * ggv[j]; } } while (0)
          PGF_LOAD(X, 0);
          for (int i = 0; i < PG_TOK; i += 4) { PGF_LOAD(Y, i + 2); PGF_BODY(X, i); PGF_LOAD(X, (i + 4) & (PG_TOK - 1)); PGF_BODY(Y, i + 2); }
#undef PGF_LOAD
#undef PGF_BODY
        }
        LDS_WAIT(); asm volatile("" ::: "memory");
    }
}

struct Args { const float* in[18]; float* out; unsigned char* ws; int ph_lo, ph_hi; };
__global__ void __launch_bounds__(NWAVES * 64, 2) hymba_fwd(Args args) {
    extern __shared__ __attribute__((aligned(16))) unsigned char lds[];
    Frame F;
    F.lds = (LAS unsigned char*)lds;
    F.MISC = (volatile LAS unsigned*)(F.lds + MISC_OFF);
    F.tid = threadIdx.x; F.lane = F.tid & 63; F.wave = __builtin_amdgcn_readfirstlane(F.tid >> 6);
    F.G = gridDim.x; { const int bx = blockIdx.x; F.vcu = (F.G % 8 == 0) ? (bx % 8) * (F.G / 8) + bx / 8 : bx; }
#pragma unroll
    for (int i = 0; i < 18; ++i) F.in[i] = args.in[i];
    F.out = args.out; F.ws = args.ws;
    for (int u = F.tid; u < (LDS_BYTES - LDSCTL_OFF) / 4; u += NWAVES * 64) ((LAS unsigned*)(F.lds + LDSCTL_OFF))[u] = 0u;
    __syncthreads();
    const int lo = args.ph_lo, hi = args.ph_hi;
    const bool multi = (hi - lo) > 1;
    XcdBarrier bar; bar.bar = (unsigned*)(F.ws + WS_CTL) + CW_BAR; bar.x = 0; bar.st = nullptr;
    if (multi) bar = xcd_barrier_post((unsigned*)(F.ws + WS_CTL) + CW_BAR, F.MISC + 8);
#define IN(k) (lo <= (k) && (k) < hi)
#define SEAM(k) do { if (IN(k) && IN((k) + 1)) xcd_barrier(bar); } while (0)

    if (IN(0)) { p0_prologue(F); } SEAM(0);
    if (IN(1)) {
        pg8::Gemm g{(const pg8::bf16_t*)(F.ws + WS_HN), (const pg8::bf16_t*)(F.ws + WS_WIN), NTOK, INW, DM}; pg8::StaticOrder S; S.init(NTOK, INW, F.G, (int)blockIdx.x);
        pg8::EpiProj E{(pg8::bf16_t*)(F.ws + WS_PROJ), INW, 2, QSCALE};
        pg8::gemm_phase<pg8::EpiProj, pg8::StaticOrder, PG8_ALIGN, PG8_SP2>(F.lds + RING_OFF, g, S, E);
    } SEAM(1);
    if (IN(2)) { hgrn_mfma(F); }
    if (IN(3)) { quant_drain(F); attn_mfma(F, 0); }
    if (IN(3) && IN(4)) xcd_barrier(bar);
    if (IN(4)) {
        pg8::Gemm g{(const pg8::bf16_t*)(F.ws + WS_HN), (const pg8::bf16_t*)(F.ws + WS_WOUT), NTOK, DM, DM}; pg8::StaticOrder S; S.init(NTOK, DM, F.G, (int)blockIdx.x);
        pg8::EpiMix E{DM, F.in[0], (pg8::bf16_t*)(F.ws + WS_HN2), (float*)(F.ws + WS_CTL) + CW_SSQ};
        pg8::gemm_phase<pg8::EpiMix, pg8::StaticOrder, PG8_ALIGN, PG8_SP2>(F.lds + RING_OFF, g, S, E);
    }
    if (IN(4) && IN(6)) xcd_barrier(bar);
    if (IN(6)) {
        pg8::Gemm g{(const pg8::bf16_t*)(F.ws + WS_HN2), (const pg8::bf16_t*)(F.ws + WS_W2), NTOK, 2048, DM}; pg8::StaticOrder S; S.init(NTOK, 2048, F.G, (int)blockIdx.x);
        pg8::EpiScaleRow E{(_Float16*)(F.ws + WS_SC), 2048, (const float*)(F.ws + WS_CTL) + CW_SSQ, 1.f / DM, EPS};
        pg8::gemm_phase<pg8::EpiScaleRow, pg8::StaticOrder, PG8_ALIGN, PG8_SP2>(F.lds + RING_OFF, g, S, E);
    } SEAM(6);
    if (IN(7)) { topk_v2(F); }
    if (IN(7) && IN(8)) { VM_WAIT(); }
    if (IN(8)) { peer_sliced(F); }
#undef IN
#undef SEAM
}

extern "C" void kernel_launch(void* const* d_in, const int* in_sizes, int n_in, void* d_out, int out_size, void* d_ws, size_t ws_size, hipStream_t stream) {
    static int grid = 0;
    if (grid == 0) {
        if (n_in != 18 || in_sizes[0] != NTOK * DM || out_size != NTOK * DM || ws_size < WS_END) { fprintf(stderr, "kernel_launch: unexpected shapes (n_in %d, in0 %d, out %d, ws %zu); nothing launched\n", n_in, n_in > 0 ? in_sizes[0] : -1, out_size, ws_size); grid = -1; return; }
        int dev = 0, cus = 0, per_cu = 0;
        if (hipGetDevice(&dev) != hipSuccess || hipDeviceGetAttribute(&cus, hipDeviceAttributeMultiprocessorCount, dev) != hipSuccess) { grid = -1; return; }
        if (hipFuncSetAttribute((const void*)hymba_fwd, hipFuncAttributeMaxDynamicSharedMemorySize, LDS_BYTES) != hipSuccess) { fprintf(stderr, "kernel_launch: hipFuncSetAttribute failed\n"); grid = -1; return; }
        if (hipOccupancyMaxActiveBlocksPerMultiprocessor(&per_cu, (const void*)hymba_fwd, NWAVES * 64, LDS_BYTES) != hipSuccess || per_cu < 1)
            fprintf(stderr, "kernel_launch: note: occupancy query reports %d workgroups per CU\n", per_cu);
        (void)hipGetLastError();
        grid = cus;
    }
    if (grid < 0) return;
    if (hipMemsetAsync((char*)d_ws + WS_CTL, 0, CTL_ZERO_BYTES, stream) != hipSuccess) return;
    Args a{};
    for (int i = 0; i < 18; ++i) a.in[i] = (const float*)d_in[i];
    a.out = (float*)d_out; a.ws = (unsigned char*)d_ws; a.ph_lo = 0; a.ph_hi = 9;
    hipLaunchKernelGGL(hymba_fwd, dim3(grid), dim3(NWAVES * 64), LDS_BYTES, stream, a);
}
```

```cpp
#include <hip/hip_runtime.h>
#include <cstdio>
#include <cstdint>
#include <cmath>
namespace pg8 {
#define PG8_LAS __attribute__((address_space(3)))
typedef unsigned short bf16_t;
typedef short bf16x8 __attribute__((ext_vector_type(8)));
typedef float f32x4 __attribute__((ext_vector_type(4)));
typedef unsigned u32x4 __attribute__((ext_vector_type(4)));
constexpr int BM = 256, BK = 64, HALF = 128, HTB = HALF * BK * 2  , STAGE_BYTES = 8 * HTB, NXCD = 8, WGM = 8;

__host__ __device__ __forceinline__ int lds_byte(int r, int c) { const int st = (r >> 4) * 2 + (c >> 5), rr = r & 15, cc = c & 31, ob = rr * 64 + cc * 2; return st * 1024 + (ob ^ (((ob >> 9) & 1) << 5)); }
__host__ __device__ __forceinline__ void stage_rc(int b, int& R, int& C) { const int st = b / 1024, sb = b % 1024, swz = sb ^ (((sb >> 9) & 1) << 5); R = (st >> 1) * 16 + swz / 64; C = (st & 1) * 32 + (swz % 64) / 2; }
__host__ __device__ __forceinline__ int perm32(int rho) { const int n = rho >> 4, i = rho & 15; return 8 * (i >> 2) + 4 * n + (i & 3); }

struct Unit { int pm, pn; };
struct Gemm { const bf16_t* A; const bf16_t* Bt; int M, N, K; };

struct StaticOrder {
    int nM, nN, nwg, G, c;
    __host__ __device__ void init(int M, int N, int G_, int c_) { nM = M / BM; nN = N / BM; nwg = nM * nN; G = G_; c = c_; }
    __host__ __device__ bool next(int i, Unit& u) const {
        const long L = (long)i * G + c; if (L >= nwg) return false;
        int wgid = (int)L; { const int q = nwg / NXCD, r = nwg % NXCD, xcd = wgid % NXCD, off = wgid / NXCD; wgid = (xcd < r ? xcd * (q + 1) : r * (q + 1) + (xcd - r) * q) + off; }
        const int nig = WGM * nN, gid = wgid / nig, fm = gid * WGM, gsz = (nM - fm) < WGM ? (nM - fm) : WGM;
        u.pm = fm + ((wgid % nig) % gsz); u.pn = (wgid % nig) / gsz; return true;
    }
    __device__ __forceinline__ void a_ready(const Unit&) const {}
    __device__ __forceinline__ void done(const Unit&) const {}
};
__device__ __forceinline__ unsigned cvt_pk_bf16(float lo, float hi) { unsigned r; asm volatile("v_cvt_pk_bf16_f32 %0, %1, %2" : "=v"(r) : "v"(lo), "v"(hi)); return r; }
typedef float f32x2 __attribute__((ext_vector_type(2)));
__device__ __forceinline__ f32x2 gelu_pk(f32x2 v) {
    const f32x2 av = __builtin_elementwise_abs(v), d = av * 0.2316418882f + 1.0f;
    f32x2 t; t.x = __builtin_amdgcn_rcpf(d.x); t.y = __builtin_amdgcn_rcpf(d.y);
    f32x2 q = t * 0.5307027145f + (-0.7265760135f); q = q * t + 0.7107068705f; q = q * t + (-0.142248368f); q = q * t + 0.127414796f; q = q * t;
    const f32x2 s = (v * v) * (-0.72134752044f);
    f32x2 e; e.x = __builtin_amdgcn_exp2f(s.x); e.y = __builtin_amdgcn_exp2f(s.y);
    const f32x2 m = v * (q * e), r = v - m;
    f32x2 o; o.x = v.x < 0.f ? m.x : r.x; o.y = v.y < 0.f ? m.y : r.y; return o;
}
struct EpiProj {
    static constexpr bool PERM = true, AFTER_DRAIN = false;
    bf16_t* O; int ldc; int qtiles; float qscale;
    __device__ __forceinline__ void operator()(const f32x4 (&acc)[2][2][4][2], const Unit& u, int wr, int wc, int fr, int fq) const {
        const int row0 = u.pm * BM + wr * 64 + fr, col0 = u.pn * BM + wc * 32 + 8 * fq;
        const float sc = (u.pn < qtiles) ? qscale : 1.f;
#pragma unroll
        for (int ai = 0; ai < 2; ++ai)
#pragma unroll
            for (int m = 0; m < 4; ++m) { bf16_t* rowp = O + (size_t)(row0 + ai * HALF + m * 16) * ldc + col0;
#pragma unroll
                for (int bj = 0; bj < 2; ++bj) { const f32x4 v0 = acc[ai][bj][m][0] * sc, v1 = acc[ai][bj][m][1] * sc;
                    u32x4 w; w.x = cvt_pk_bf16(v0[0], v0[1]); w.y = cvt_pk_bf16(v0[2], v0[3]); w.z = cvt_pk_bf16(v1[0], v1[1]); w.w = cvt_pk_bf16(v1[2], v1[3]);
                    *(u32x4*)(rowp + bj * HALF) = w; } }
    }
};
struct EpiF32Res {
    static constexpr bool PERM = false, AFTER_DRAIN = false;
    float* C; int ldc; const float* res;
    __device__ __forceinline__ void operator()(const f32x4 (&acc)[2][2][4][2], const Unit& u, int wr, int wc, int fr, int fq) const {
        const int row0 = u.pm * BM + wr * 64 + fr, col0 = u.pn * BM + wc * 32 + 4 * fq;
#pragma unroll
        for (int ai = 0; ai < 2; ++ai)
#pragma unroll
            for (int m = 0; m < 4; ++m) { const size_t off = (size_t)(row0 + ai * HALF + m * 16) * ldc + col0;
#pragma unroll
                for (int bj = 0; bj < 2; ++bj)
#pragma unroll
                    for (int n = 0; n < 2; ++n) { f32x4 o = acc[ai][bj][m][n]; if (res) o = o + *(const f32x4*)(res + off + bj * HALF + n * 16);
                        *(f32x4*)(C + off + bj * HALF + n * 16) = o; } }
    }
};

struct EpiMix {
    static constexpr bool PERM = true, AFTER_DRAIN = false;
    int ldc; const float* res; bf16_t* HB; float* ssq;
    __device__ __forceinline__ void operator()(const f32x4 (&acc)[2][2][4][2], const Unit& u, int wr, int wc, int fr, int fq) const {
        const int row0 = u.pm * BM + wr * 64 + fr, col0 = u.pn * BM + wc * 32 + 8 * fq;
#pragma unroll
        for (int ai = 0; ai < 2; ++ai)
#pragma unroll
            for (int m = 0; m < 4; ++m) { const int row = row0 + ai * HALF + m * 16; const size_t off = (size_t)row * ldc + col0; float sq = 0.f;
#pragma unroll
                for (int bj = 0; bj < 2; ++bj) {
                    const f32x4 h0 = acc[ai][bj][m][0] + *(const f32x4*)(res + off + bj * HALF), h1 = acc[ai][bj][m][1] + *(const f32x4*)(res + off + bj * HALF + 4);
                    sq += (h0[0] * h0[0] + h0[1] * h0[1]) + (h0[2] * h0[2] + h0[3] * h0[3]) + (h1[0] * h1[0] + h1[1] * h1[1]) + (h1[2] * h1[2] + h1[3] * h1[3]);
                    u32x4 w; w.x = cvt_pk_bf16(h0[0], h0[1]); w.y = cvt_pk_bf16(h0[2], h0[3]); w.z = cvt_pk_bf16(h1[0], h1[1]); w.w = cvt_pk_bf16(h1[2], h1[3]);
                    *(u32x4*)(HB + off + bj * HALF) = w; }
                sq += __shfl_xor(sq, 16); sq += __shfl_xor(sq, 32);
                if (fq == 0) atomicAdd(ssq + row, sq); }
    }
};
struct EpiScaleRow {
    static constexpr bool PERM = true, AFTER_DRAIN = false;
    _Float16* C; int ldc; const float* ssq; float invk, eps;
    __device__ __forceinline__ void operator()(const f32x4 (&acc)[2][2][4][2], const Unit& u, int wr, int wc, int fr, int fq) const {
        typedef _Float16 h2 __attribute__((ext_vector_type(2)));
        const int row0 = u.pm * BM + wr * 64 + fr, col0 = u.pn * BM + wc * 32 + 8 * fq;
#pragma unroll
        for (int ai = 0; ai < 2; ++ai)
#pragma unroll
            for (int m = 0; m < 4; ++m) { const int row = row0 + ai * HALF + m * 16; const size_t off = (size_t)row * ldc + col0; const float rs = 1.f / sqrtf(ssq[row] * invk + eps);
#pragma unroll
                for (int bj = 0; bj < 2; ++bj) { const f32x4 v0 = acc[ai][bj][m][0] * rs, v1 = acc[ai][bj][m][1] * rs;
                    const h2 p0 = {(_Float16)v0[0], (_Float16)v0[1]}, p1 = {(_Float16)v0[2], (_Float16)v0[3]}, p2 = {(_Float16)v1[0], (_Float16)v1[1]}, p3 = {(_Float16)v1[2], (_Float16)v1[3]};
                    u32x4 w; w.x = __builtin_bit_cast(unsigned, p0); w.y = __builtin_bit_cast(unsigned, p1); w.z = __builtin_bit_cast(unsigned, p2); w.w = __builtin_bit_cast(unsigned, p3);
                    *(u32x4*)(C + off + bj * HALF) = w; } }
    }
};
template <class Epi, class Sched, bool ALIGN_EPI = false, bool SP2 = false>
__device__ __forceinline__ void gemm_phase(PG8_LAS unsigned char* lds, const Gemm g, const Sched& S, const Epi& E) {
    const int tid = threadIdx.x, wid = __builtin_amdgcn_readfirstlane(tid >> 6), lane = tid & 63, wr = wid >> 2, wc = wid & 3, fr = lane & 15, fq = lane >> 4;
    const int K = g.K, nt = K / BK;
    unsigned voffA[2], voffB[2];
#pragma unroll
    for (int i = 0; i < 2; ++i) { int R, C; stage_rc(tid * 16 + i * 8192, R, C); const int Rb = Epi::PERM ? ((R & ~31) + perm32(R & 31)) : R;
        voffA[i] = (unsigned)(R * K + C) * 2u; voffB[i] = (unsigned)(Rb * K + C) * 2u; }
    const size_t kstep = (size_t)(BK * 2);
    const size_t hstep = (size_t)HALF * K * 2;
    const size_t tstep = 2 * hstep;
    const unsigned ldsw = (unsigned)wid * 1024u;
    const int aoff = lds_byte(wr * 64 + fr, fq * 8), boff = lds_byte(wc * 32 + fr, fq * 8);
#define PG8_SA(b, h) (((b) * 2 + (h)) * HTB)
#define PG8_SB(b, h) ((4 + (b) * 2 + (h)) * HTB)
#define PG8_STAGE(bufoff, gbase, voff) do { _Pragma("unroll") for (int _i = 0; _i < 2; ++_i) \
        __builtin_amdgcn_global_load_lds((const unsigned*)((const char*)(gbase) + (voff)[_i]), (PG8_LAS unsigned*)(lds + (bufoff) + ldsw + _i * 8192), 16, 0, 0); } while (0)
#define PG8_LDA(dst, b, h) do { _Pragma("unroll") for (int m = 0; m < 4; ++m) _Pragma("unroll") for (int k = 0; k < 2; ++k) dst[m][k] = *(const PG8_LAS bf16x8*)(lds + PG8_SA(b, h) + aoff + m * 2048 + k * 1024); } while (0)
#define PG8_LDB(dst, b, h) do { _Pragma("unroll") for (int n = 0; n < 2; ++n) _Pragma("unroll") for (int k = 0; k < 2; ++k) dst[n][k] = *(const PG8_LAS bf16x8*)(lds + PG8_SB(b, h) + boff + n * 2048 + k * 1024); } while (0)
#define PG8_MMA(ai, bj, At, Bt) do { __builtin_amdgcn_s_setprio(1); _Pragma("unroll") for (int m = 0; m < 4; ++m) _Pragma("unroll") for (int n = 0; n < 2; ++n) _Pragma("unroll") for (int k = 0; k < 2; ++k) \
        acc[ai][bj][m][n] = __builtin_amdgcn_mfma_f32_16x16x32_bf16(Bt[n][k], At[m][k], acc[ai][bj][m][n], 0, 0, 0); __builtin_amdgcn_s_setprio(0); } while (0)
#define PG8_WAIT_V(n) asm volatile("s_waitcnt vmcnt(" #n ")" ::: "memory")
#define PG8_WAIT_L(n) asm volatile("s_waitcnt lgkmcnt(" #n ")" ::: "memory")
#define PG8_BAR __builtin_amdgcn_s_barrier()
#define PG8_SCHED __builtin_amdgcn_sched_barrier(0)
    Unit cur, nxt; int ui = 0;
    if (!S.next(0, cur)) return;
    f32x4 acc[2][2][4][2];
#pragma unroll
    for (int a = 0; a < 2; ++a)
#pragma unroll
        for (int b = 0; b < 2; ++b)
#pragma unroll
            for (int m = 0; m < 4; ++m)
#pragma unroll
                for (int n = 0; n < 2; ++n) acc[a][b][m][n] = (f32x4){0.f, 0.f, 0.f, 0.f};
    bf16x8 At[4][2], B0[2][2], B1[2][2];
    const char* cA = (const char*)g.A + (size_t)cur.pm * tstep; const char* cB = (const char*)g.Bt + (size_t)cur.pn * tstep;
    S.a_ready(cur);
    if constexpr (SP2) {
        PG8_STAGE(PG8_SB(0, 0), cB, voffB); PG8_STAGE(PG8_SB(0, 1), cB + hstep, voffB); PG8_STAGE(PG8_SA(0, 0), cA, voffA); PG8_STAGE(PG8_SA(0, 1), cA + hstep, voffA);
        if (wr == 1) PG8_BAR;
        PG8_WAIT_V(2); PG8_BAR;
        PG8_STAGE(PG8_SB(1, 0), cB + kstep, voffB); PG8_STAGE(PG8_SA(1, 0), cA + kstep, voffA); PG8_STAGE(PG8_SB(1, 1), cB + hstep + kstep, voffB);
        PG8_WAIT_V(6); PG8_BAR;
    } else {
        PG8_STAGE(PG8_SB(0, 0), cB, voffB); PG8_STAGE(PG8_SA(0, 0), cA, voffA); PG8_STAGE(PG8_SB(0, 1), cB + hstep, voffB); PG8_STAGE(PG8_SA(0, 1), cA + hstep, voffA);
        if (wr == 1) PG8_BAR;
        PG8_WAIT_V(4); PG8_BAR;
        PG8_STAGE(PG8_SB(1, 0), cB + kstep, voffB); PG8_STAGE(PG8_SA(1, 0), cA + kstep, voffA); PG8_STAGE(PG8_SB(1, 1), cB + hstep + kstep, voffB);
        PG8_WAIT_V(6); PG8_BAR;
    }
    for (;;) {
        const bool has_next = S.next(ui + 1, nxt);
        const char* nA = has_next ? (const char*)g.A + (size_t)nxt.pm * tstep : cA; const char* nB = has_next ? (const char*)g.Bt + (size_t)nxt.pn * tstep : cB;
        for (int t = 0; t < nt; t += 2) {
            const bool last = (t == nt - 2);
            const char* a1 = cA + (size_t)(t + 1) * kstep;
            const char* a2 = last ? nA : cA + (size_t)(t + 2) * kstep; const char* b2 = last ? nB : cB + (size_t)(t + 2) * kstep;
            const char* a3 = a2 + kstep; const char* b3 = b2 + kstep;
            if (last && has_next) S.a_ready(nxt);
            if constexpr (SP2) {
            PG8_LDB(B0, 0, 0); PG8_LDB(B1, 0, 1); PG8_SCHED; PG8_LDA(At, 0, 0); PG8_STAGE(PG8_SA(1, 1), a1 + hstep, voffA);
            PG8_WAIT_V(8); PG8_WAIT_L(0); PG8_BAR; PG8_MMA(0, 0, At, B0); PG8_MMA(0, 1, At, B1); PG8_BAR; PG8_SCHED;
            PG8_LDA(At, 0, 1); PG8_STAGE(PG8_SB(0, 0), b2, voffB); PG8_STAGE(PG8_SB(0, 1), b2 + hstep, voffB); PG8_STAGE(PG8_SA(0, 0), a2, voffA);
            PG8_WAIT_V(8); PG8_WAIT_L(0); PG8_BAR; PG8_MMA(1, 0, At, B0); PG8_MMA(1, 1, At, B1); PG8_BAR; PG8_SCHED;
            PG8_LDB(B0, 1, 0); PG8_LDB(B1, 1, 1); PG8_SCHED; PG8_LDA(At, 1, 0); PG8_STAGE(PG8_SA(0, 1), a2 + hstep, voffA);
            PG8_WAIT_V(8); PG8_WAIT_L(0); PG8_BAR; PG8_MMA(0, 0, At, B0); PG8_MMA(0, 1, At, B1); PG8_BAR; PG8_SCHED;
            PG8_LDA(At, 1, 1); PG8_STAGE(PG8_SB(1, 0), b3, voffB); PG8_STAGE(PG8_SB(1, 1), b3 + hstep, voffB); PG8_STAGE(PG8_SA(1, 0), a3, voffA);
            PG8_WAIT_V(8); PG8_WAIT_L(0); PG8_BAR; PG8_MMA(1, 0, At, B0); PG8_MMA(1, 1, At, B1); PG8_BAR; PG8_SCHED;
            } else {
            PG8_LDB(B0, 0, 0); PG8_SCHED; PG8_LDA(At, 0, 0); PG8_STAGE(PG8_SA(1, 1), a1 + hstep, voffA);
            PG8_WAIT_L(8); PG8_BAR; PG8_WAIT_L(0); PG8_MMA(0, 0, At, B0); PG8_BAR; PG8_SCHED;
            PG8_LDB(B1, 0, 1); PG8_STAGE(PG8_SB(0, 0), b2, voffB);
            PG8_BAR; PG8_WAIT_L(0); PG8_MMA(0, 1, At, B1); PG8_BAR;
            PG8_LDA(At, 0, 1); PG8_STAGE(PG8_SA(0, 0), a2, voffA);
            PG8_BAR; PG8_WAIT_L(0); PG8_MMA(1, 0, At, B0); PG8_BAR; PG8_SCHED;
            PG8_STAGE(PG8_SB(0, 1), b2 + hstep, voffB);
            PG8_WAIT_V(6); PG8_BAR; PG8_MMA(1, 1, At, B1); PG8_BAR;
            PG8_LDB(B0, 1, 0); PG8_SCHED; PG8_LDA(At, 1, 0); PG8_STAGE(PG8_SA(0, 1), a2 + hstep, voffA);
            PG8_WAIT_L(8); PG8_BAR; PG8_WAIT_L(0); PG8_MMA(0, 0, At, B0); PG8_BAR; PG8_SCHED;
            PG8_LDB(B1, 1, 1); PG8_STAGE(PG8_SB(1, 0), b3, voffB);
            PG8_BAR; PG8_WAIT_L(0); PG8_MMA(0, 1, At, B1); PG8_BAR;
            PG8_LDA(At, 1, 1); PG8_STAGE(PG8_SA(1, 0), a3, voffA);
            PG8_BAR; PG8_WAIT_L(0); PG8_MMA(1, 0, At, B0); PG8_BAR; PG8_SCHED;
            PG8_STAGE(PG8_SB(1, 1), b3 + hstep, voffB);
            PG8_WAIT_V(6); PG8_BAR; PG8_MMA(1, 1, At, B1); PG8_BAR;
            }
        }
        if constexpr (ALIGN_EPI) { if (wr == 0) PG8_BAR; }
        if constexpr (!Epi::AFTER_DRAIN) { E(acc, cur, wr, wc, fr, fq); S.done(cur); }
        if (!has_next) break;
#pragma unroll
        for (int a = 0; a < 2; ++a)
#pragma unroll
            for (int b = 0; b < 2; ++b)
#pragma unroll
                for (int m = 0; m < 4; ++m)
#pragma unroll
                    for (int n = 0; n < 2; ++n) acc[a][b][m][n] = (f32x4){0.f, 0.f, 0.f, 0.f};
        cur = nxt; cA = nA; cB = nB; ++ui;
        if constexpr (ALIGN_EPI) { if (wr == 1) PG8_BAR; }
    }
    PG8_WAIT_V(0);
    if constexpr (!ALIGN_EPI) { if (wr == 0) PG8_BAR; }
    PG8_BAR;
    if constexpr (Epi::AFTER_DRAIN) { E.fused(acc, cur, wr, wc, fr, fq, lds, wid, lane); S.done(cur); }
#undef PG8_SA
#undef PG8_SB
#undef PG8_STAGE
#undef PG8_LDA
#undef PG8_LDB
#undef PG8_MMA
#undef PG8_WAIT_V
#undef PG8_WAIT_L
#undef PG8_BAR
#undef PG8_SCHED
}
}
#ifndef PG8_SP2
#define PG8_SP2 true
#endif
#ifndef PG8_ALIGN
#define PG8_ALIGN true
#endif

constexpr int NWAVES = 8;
constexpr int NTOK = 32768, DM = 1024, SEQ = 2048, NBATCH = 16, INW = 3584;
constexpr int C_DQ = 0, C_DK = 512, C_DV = 1024, C_HQ = 1536, C_HF = 2048, C_HI = 2560, C_HG = 3072;
constexpr float EPS = 1e-6f;
constexpr float QSCALE = 0.125f * 1.4426950408889634f;
constexpr float LAM_INIT = 0.2f;
constexpr int NEXP_SEL = 128;

constexpr size_t MiB = 1u << 20;
constexpr size_t WS_CTL = 0, CTL_ZERO_BYTES = 1 * MiB;
constexpr size_t WS_SMALL = 1 * MiB;
constexpr size_t WS_WIN = 2 * MiB;
constexpr size_t WS_WOUT = 10 * MiB;
constexpr size_t WS_W2 = 12 * MiB;
constexpr size_t WS_U8 = 17 * MiB;
constexpr size_t WS_V8 = 33 * MiB;
constexpr size_t WS_SU = 49 * MiB;
constexpr size_t WS_SV = 49 * MiB + 512 * 1024;
constexpr size_t WS_X8 = 50 * MiB;
constexpr size_t WS_SX = 116 * MiB;
constexpr size_t WS_GSU = 120 * MiB;
constexpr size_t WS_HN = 84 * MiB;
constexpr size_t WS_PROJ = 148 * MiB;
constexpr size_t WS_HN2 = 148 * MiB;
constexpr size_t WS_SC = 212 * MiB;
constexpr size_t WS_PO = 352 * MiB;
constexpr size_t WS_X4 = 420 * MiB;
constexpr size_t WS_IDX = 468 * MiB;
constexpr size_t WS_GATE = 484 * MiB;
constexpr size_t WS_END = 500 * MiB;
constexpr int SM_LB = 0, SM_LAM = 512, SM_BIAS = 1024;
constexpr int CW_BAR = 4096;
constexpr int CW_ATTQ = 8192;
constexpr int CW_SSQ = 131072;

constexpr int RING_OFF = 0, RING_BYTES = 139264;
constexpr int LDSCTL_OFF = RING_BYTES, MISC_OFF = LDSCTL_OFF + 320;
constexpr int LDS_BYTES = 147456;

#define GAS __attribute__((address_space(1)))
#define LAS __attribute__((address_space(3)))
typedef unsigned short bf16;
typedef unsigned v4u __attribute__((ext_vector_type(4)));
typedef unsigned v2u __attribute__((ext_vector_type(2)));
typedef float f32x4 __attribute__((ext_vector_type(4)));
typedef short bf16x8 __attribute__((ext_vector_type(8)));
typedef GAS unsigned gu32;
typedef long l2 __attribute__((ext_vector_type(2)));
typedef int v4i __attribute__((ext_vector_type(4)));
#define RLX_AGENT __ATOMIC_RELAXED, __HIP_MEMORY_SCOPE_AGENT
#define LDS_WAIT() asm volatile("s_waitcnt lgkmcnt(0)" ::: "memory")
#define VM_WAIT() asm volatile("s_waitcnt vmcnt(0)" ::: "memory")
__device__ __forceinline__ unsigned f2bf(float f) { unsigned u = __builtin_bit_cast(unsigned, f); return (u + 0x7fffu + ((u >> 16) & 1u)) >> 16; }
__device__ __forceinline__ unsigned pk2(float lo, float hi) { return f2bf(lo) | (f2bf(hi) << 16); }
__device__ __forceinline__ float bflo(unsigned w) { return __builtin_bit_cast(float, w << 16); }
__device__ __forceinline__ float bfhi(unsigned w) { return __builtin_bit_cast(float, w & 0xffff0000u); }

#define XB_TMO      128
#define XB_XCNT(j)  (256  + 64 * (j))
#define XB_XSUB(j)  (1280 + 64 * (j))
#define XB_XGEN(j)  (2304 + 64 * (j))
#define XB_TOP      3328
#define XB_TOPGEN   3392
#define XCD_BAR_WORDS 3456
#define XB_SPIN_CAP (1u << 18)
__device__ __forceinline__ unsigned xb_ld(unsigned* p)              { return __hip_atomic_load(p, __ATOMIC_RELAXED, __HIP_MEMORY_SCOPE_AGENT); }
__device__ __forceinline__ unsigned xb_add(unsigned* p, unsigned v) { return __hip_atomic_fetch_add(p, v, __ATOMIC_RELAXED, __HIP_MEMORY_SCOPE_AGENT); }
__device__ __forceinline__ unsigned xb_xcc_id() { return (unsigned)__builtin_amdgcn_s_getreg((3 << 11) | 20) & 0xFu; }
#define XB_SPIN(cond, bar) do { unsigned _sp = 0; while (cond) { __builtin_amdgcn_s_sleep(1); \
    if ((++_sp & 255u) == 0u) { if (xb_ld(&(bar)[XB_TMO])) break; if (_sp > XB_SPIN_CAP) { atomicAdd(&(bar)[XB_TMO], 1u); break; } } } } while (0)
struct XcdBarrier { unsigned* bar; unsigned x; volatile LAS unsigned* st; };
__device__ __forceinline__ XcdBarrier xcd_barrier_post(unsigned* bar, volatile LAS unsigned* st) {
    XcdBarrier b; b.bar = bar; b.x = xb_xcc_id(); b.st = st;
    if (threadIdx.x == 0) (void)xb_add(&bar[XB_XCNT(b.x)], 1u);
    return b;
}
__device__ __forceinline__ void xcd_barrier_complete(unsigned* bar, unsigned x, unsigned& nloc, unsigned& nx) {
    const unsigned G = gridDim.x * gridDim.y * gridDim.z;
    unsigned sum, cnt, mine, sp = 0u;
    for (;;) {
        sum = 0u; cnt = 0u; mine = 0u;
#pragma unroll
        for (unsigned j = 0; j < 16; ++j) { const unsigned c = xb_ld(&bar[XB_XCNT(j)]); sum += c; cnt += (c > 0u) ? 1u : 0u; mine = (j == x) ? c : mine; }
        if (sum == G) break;
        __builtin_amdgcn_s_sleep(1);
        if ((++sp & 255u) == 0u) { if (xb_ld(&bar[XB_TMO])) break; if (sp > XB_SPIN_CAP) { atomicAdd(&bar[XB_TMO], 1u); break; } }
    }
    nloc = mine > 0u ? mine : 1u; nx = cnt > 0u ? cnt : 1u;
}
__device__ __forceinline__ void xcd_barrier(const XcdBarrier& b) {
    asm volatile("s_waitcnt vmcnt(0)" ::: "memory");
    __syncthreads();
    if (threadIdx.x == 0) {
        unsigned* bar = b.bar;
        __builtin_amdgcn_s_waitcnt(0);
        unsigned nloc = b.st[0], nx = b.st[1];
        if (nloc == 0u) { xcd_barrier_complete(bar, b.x, nloc, nx); b.st[0] = nloc; b.st[1] = nx; }
        const unsigned old = xb_add(&bar[XB_XSUB(b.x)], 1u);
        const unsigned gen = old / nloc;
        if (old + 1u == (gen + 1u) * nloc) {
            __builtin_amdgcn_fence(__ATOMIC_RELEASE, "agent");
            asm volatile("s_waitcnt vmcnt(0)" ::: "memory");
            const unsigned og = xb_add(&bar[XB_TOP], 1u);
            const unsigned tg = og / nx;
            if (og + 1u == (tg + 1u) * nx) xb_add(&bar[XB_TOPGEN], 1u);
            else XB_SPIN(xb_ld(&bar[XB_TOPGEN]) == tg, bar);
            __builtin_amdgcn_fence(__ATOMIC_ACQUIRE, "agent");
            xb_add(&bar[XB_XGEN(b.x)], 1u);
            asm volatile("s_waitcnt vmcnt(0)" ::: "memory");
        } else {
            XB_SPIN(xb_ld(&bar[XB_XGEN(b.x)]) == gen, bar);
            __builtin_amdgcn_fence(__ATOMIC_ACQUIRE, "agent");
            asm volatile("s_waitcnt vmcnt(0)" ::: "memory");
        }
    }
    __syncthreads();
}

#define SCHED_FENCE() __builtin_amdgcn_sched_barrier(0)
__device__ __forceinline__ float gelu_as(float v) {
    const float av = fabsf(v), t = __builtin_amdgcn_rcpf(av * 0.2316418882f + 1.0f);
    float q = t * 0.5307027145f + (-0.7265760135f); q = q * t + 0.7107068705f; q = q * t + (-0.142248368f); q = q * t + 0.127414796f; q = q * t;
    const float e = __builtin_amdgcn_exp2f((v * v) * (-0.72134752044f));
    const float mm = v * (q * e);
    return v < 0.f ? mm : v - mm;
}
struct Frame {
    LAS unsigned char* lds;
    volatile LAS unsigned* MISC;
    int tid, lane, wave, vcu, G;
    const float* in[18]; float* out; unsigned char* ws;
};
__device__ __forceinline__ float wave_sum(float v) {
#pragma unroll
    for (int o = 1; o < 64; o <<= 1) v += __shfl_xor(v, o);
    return v;
}
__device__ __forceinline__ float sigmoidf_(float x) { return 1.f / (1.f + __expf(-x)); }

__device__ __forceinline__ void p0_transpose_item(const float* W, int K, int N, bf16* WT, int row_off, LAS float* scr, int item, int lane) {
    const int nblk = N / 32, kb = item / nblk, nb = item % nblk, k0 = 64 * kb, n0 = 32 * nb;
#pragma unroll 8
    for (int i = 0; i < 32; ++i) { const int kk = 2 * i + (lane >> 5); scr[kk * 33 + (lane & 31)] = W[(size_t)(k0 + kk) * N + n0 + (lane & 31)]; }
    LDS_WAIT(); asm volatile("" ::: "memory");
    const int c = lane & 7;
#pragma unroll
    for (int j = 0; j < 4; ++j) { const int n = (lane >> 3) + 8 * j; const LAS float* s = scr + (8 * c) * 33 + n;
        v4u o; o.x = pk2(s[0 * 33], s[1 * 33]); o.y = pk2(s[2 * 33], s[3 * 33]); o.z = pk2(s[4 * 33], s[5 * 33]); o.w = pk2(s[6 * 33], s[7 * 33]);
        *(GAS v4u*)(WT + (size_t)(row_off + n0 + n) * K + k0 + 8 * c) = o; }
    LDS_WAIT(); asm volatile("" ::: "memory");
}

__device__ __forceinline__ void quant_vals_fp8(const f32x4 (&v)[4], unsigned char* dst, float* dq, int lane, size_t slice_stride) {
    float mx = 0.f;
#pragma unroll
    for (int j = 0; j < 4; ++j) mx = fmaxf(mx, fmaxf(fmaxf(fabsf(v[j].x), fabsf(v[j].y)), fmaxf(fabsf(v[j].z), fabsf(v[j].w))));
#pragma unroll
    for (int o = 1; o < 64; o <<= 1) mx = fmaxf(mx, __shfl_xor(mx, o));
    const float qs = mx > 0.f ? 224.f / mx : 1.f;
#pragma unroll
    for (int j = 0; j < 4; ++j) { int p = __builtin_amdgcn_cvt_pk_fp8_f32(v[j].x * qs, v[j].y * qs, 0, false); p = __builtin_amdgcn_cvt_pk_fp8_f32(v[j].z * qs, v[j].w * qs, p, true);
        const int d = 4 * lane + 256 * j; *(GAS unsigned*)(dst + (slice_stride ? (size_t)(d >> 7) * slice_stride + (d & 127) : (size_t)d)) = (unsigned)p; }
    if (lane == 0) *dq = mx > 0.f ? mx * (1.f / 224.f) : 1.f;
}
__device__ __forceinline__ void quant_row_fp4(const float* src, unsigned char* dst, float* dq, int lane, size_t slice_stride) {
    const GAS f32x4* xr = (const GAS f32x4*)src + lane; f32x4 v[4];
#pragma unroll
    for (int j = 0; j < 4; ++j) v[j] = xr[64 * j];
    float mx = 0.f;
#pragma unroll
    for (int j = 0; j < 4; ++j) mx = fmaxf(mx, fmaxf(fmaxf(fabsf(v[j].x), fabsf(v[j].y)), fmaxf(fabsf(v[j].z), fabsf(v[j].w))));
#pragma unroll
    for (int o = 1; o < 64; o <<= 1) mx = fmaxf(mx, __shfl_xor(mx, o));
    const float qs = mx > 0.f ? 6.f / mx : 1.f;
#pragma unroll
    for (int j = 0; j < 4; ++j) { unsigned r = 0u;
        r = __builtin_amdgcn_cvt_scalef32_pk_fp4_f32(r, v[j].x * qs, v[j].y * qs, 1.0f, 0); r = __builtin_amdgcn_cvt_scalef32_pk_fp4_f32(r, v[j].z * qs, v[j].w * qs, 1.0f, 1);
        *(GAS unsigned short*)(dst + (size_t)j * slice_stride + 2 * lane) = (unsigned short)r; }
    if (lane == 0) *dq = mx > 0.f ? mx * (1.f / 6.f) : 1.f;
}
__device__ __forceinline__ void quant_row_fp8(const float* src, unsigned char* dst, float* dq, int lane, size_t slice_stride) {
    const GAS f32x4* xr = (const GAS f32x4*)src + lane; f32x4 v[4];
#pragma unroll
    for (int j = 0; j < 4; ++j) v[j] = xr[64 * j];
    quant_vals_fp8(v, dst, dq, lane, slice_stride);
}
__device__ __forceinline__ void p0_prologue(Frame& F) {
    LAS float* scr = (LAS float*)(F.lds + RING_OFF + F.wave * 16384);
    const int gw = F.vcu * NWAVES + F.wave, NGW = F.G * NWAVES;
    bf16* WinT = (bf16*)(F.ws + WS_WIN); bf16* WoutT = (bf16*)(F.ws + WS_WOUT); bf16* W2T = (bf16*)(F.ws + WS_W2);
    float* small = (float*)(F.ws + WS_SMALL);
    if (blockIdx.x == 0) {
        const int t = F.tid;
        { const float l0 = F.in[9][t], l1 = F.in[9][512 + t]; small[SM_LB + t] = 1.f / (1.f + expf(l1 - l0)); }
        { const int h = t >> 7, n = t & 127; int bk;
          if (n < 16) bk = n; else { bk = 16 + (int)(logf((float)n * (1.f / 16.f)) / logf(8.f) * 16.f); bk = bk > 31 ? 31 : bk; }
          small[SM_BIAS + t] = F.in[8][bk * 4 + h] * 1.4426950408889634f; }
        if (F.wave == 0) {
            const float a = wave_sum(F.in[3][F.lane] * F.in[4][F.lane]), b = wave_sum(F.in[5][F.lane] * F.in[6][F.lane]);
            if (F.lane == 0) small[SM_LAM] = expf(a) - expf(b) + LAM_INIT;
        }
    }
    constexpr int I_IN = (DM / 64) * (INW / 32), I_OUT = (DM / 64) * (DM / 32);
    for (int it = gw; it < I_IN + I_OUT; it += NGW) {
        if (it < I_IN) p0_transpose_item(F.in[2], DM, INW, WinT, 0, scr, it, F.lane);
        else p0_transpose_item(F.in[11], DM, DM, WoutT, 0, scr, it - I_IN, F.lane);
    }
    for (int u = F.vcu; u < 256; u += F.G) {
        const int hc = u >> 4, kb = u & 15, k = kb * 64 + F.lane;
        const GAS f32x4* wrow = (const GAS f32x4*)(F.in[13] + (size_t)k * 2048 + hc * 128);
        float a[16];
#pragma unroll
        for (int nn = 0; nn < 16; ++nn) a[nn] = 0.f;
        const float* kr = F.in[14] + ((size_t)hc * 128 + F.wave * 16) * 128;
        for (int i = 0; i < 32; ++i) {
            const f32x4 w = wrow[i];
#pragma unroll
            for (int nn = 0; nn < 16; ++nn) { const float* kk = kr + nn * 128 + 4 * i; a[nn] += (kk[0] * w.x + kk[1] * w.y) + (kk[2] * w.z + kk[3] * w.w); }
        }
        const float g2k = F.in[12][k];
#pragma unroll
        for (int nn = 0; nn < 16; ++nn) W2T[((size_t)hc * 128 + F.wave * 16 + nn) * DM + k] = (bf16)f2bf(a[nn] * g2k);
    }
    bf16* HN = (bf16*)(F.ws + WS_HN);
    for (int m = gw; m < NTOK; m += 2 * NGW) {
        const int m2 = m + NGW;
        const GAS f32x4* xa = (const GAS f32x4*)(F.in[0] + (size_t)m * DM) + F.lane; const GAS f32x4* xb = (const GAS f32x4*)(F.in[0] + (size_t)(m2 < NTOK ? m2 : m) * DM) + F.lane;
        const GAS f32x4* gr = (const GAS f32x4*)F.in[1] + F.lane;
        f32x4 va[4], vb[4]; float sa = 0.f, sb = 0.f;
#pragma unroll
        for (int j = 0; j < 4; ++j) { va[j] = xa[64 * j]; vb[j] = xb[64 * j]; }
#pragma unroll
        for (int j = 0; j < 4; ++j) { sa += (va[j].x * va[j].x + va[j].y * va[j].y) + (va[j].z * va[j].z + va[j].w * va[j].w); sb += (vb[j].x * vb[j].x + vb[j].y * vb[j].y) + (vb[j].z * vb[j].z + vb[j].w * vb[j].w); }
#pragma unroll
        for (int o = 1; o < 64; o <<= 1) { sa += __shfl_xor(sa, o); sb += __shfl_xor(sb, o); }
        const float ra = 1.f / sqrtf(sa * (1.f / DM) + EPS), rb = 1.f / sqrtf(sb * (1.f / DM) + EPS);
        GAS unsigned long long* oa = (GAS unsigned long long*)(HN + (size_t)m * DM) + F.lane; GAS unsigned long long* ob = (GAS unsigned long long*)(HN + (size_t)m2 * DM) + F.lane;
#pragma unroll
        for (int j = 0; j < 4; ++j) { const f32x4 gg = gr[64 * j];
            oa[64 * j] = (unsigned long long)pk2(va[j].x * ra * gg.x, va[j].y * ra * gg.y) | ((unsigned long long)pk2(va[j].z * ra * gg.z, va[j].w * ra * gg.w) << 32);
            if (m2 < NTOK) ob[64 * j] = (unsigned long long)pk2(vb[j].x * rb * gg.x, vb[j].y * rb * gg.y) | ((unsigned long long)pk2(vb[j].z * rb * gg.z, vb[j].w * rb * gg.w) << 32); }
    }
}


constexpr int QCHUNKS = 2 * 16384 / 64;
__device__ __forceinline__ void quant_chunk(Frame& F, int c) {
    unsigned char* U8 = F.ws + WS_U8; unsigned char* V8 = F.ws + WS_V8; float* SU = (float*)(F.ws + WS_SU); float* SV = (float*)(F.ws + WS_SV);
#pragma unroll 1
    for (int k = 0; k < 8; ++k) { const int rr = 64 * c + 8 * F.wave + k;
        if (rr < 16384) quant_row_fp4(F.in[15] + (size_t)rr * DM, U8 + (size_t)rr * 128, SU + rr, F.lane, (size_t)16384 * 128);
        else { const int e = rr - 16384; quant_row_fp8(F.in[16] + (size_t)e * DM, V8 + (size_t)e * 128, SV + e, F.lane, (size_t)16384 * 128); } }
}

__device__ __forceinline__ void quant_drain(Frame& F) {
    unsigned* qctr = (unsigned*)(F.ws + WS_CTL) + CW_ATTQ + 128;
    if (F.tid == 0) F.MISC[13] = __hip_atomic_fetch_add(qctr, 1u, __ATOMIC_RELAXED, __HIP_MEMORY_SCOPE_AGENT);
    for (int it = 0;; ++it) {
        __syncthreads();
        const int qc = (int)F.MISC[13 + (it & 1)];
        if (qc >= QCHUNKS) break;
        unsigned nx = 0u;
        if (F.tid == 0) nx = __hip_atomic_fetch_add(qctr, 1u, __ATOMIC_RELAXED, __HIP_MEMORY_SCOPE_AGENT);
        quant_chunk(F, qc);
        if (F.tid == 0) F.MISC[13 + ((it + 1) & 1)] = nx;
    }
}

typedef float f32x16 __attribute__((ext_vector_type(16)));
typedef short s16x4 __attribute__((ext_vector_type(4)));
typedef short v4i16_t __attribute__((ext_vector_type(4)));
typedef float f32x2_t __attribute__((ext_vector_type(2))); typedef __bf16 bf16x2_t __attribute__((ext_vector_type(2)));
__device__ __forceinline__ unsigned cvtpk_bf16(float lo, float hi) { f32x2_t v = {lo, hi}; bf16x2_t b = __builtin_convertvector(v, bf16x2_t); return __builtin_bit_cast(unsigned, b); }
__device__ __forceinline__ float xhalf_max(float v) { return fmaxf(v, __shfl_xor(v, 32)); }
__device__ __forceinline__ float xhalf_sum(float v) { return v + __shfl_xor(v, 32); }
__device__ __forceinline__ float max3f_(float a, float b, float c) { float r; asm("v_max3_f32 %0, %1, %2, %3" : "=v"(r) : "v"(a), "v"(b), "v"(c)); return r; }
constexpr int AT_KP = 144, AT_VP = 320, AT_K1 = 64 * AT_KP, AT_KS = 2 * AT_K1, AT_V0 = 2 * AT_KS, AT_VS = 64 * AT_VP;
constexpr int AT_XO = 0, AT_YB = 65536, AT_YP = 272, AT_Q = 100864, AT_TAB = AT_Q + 8 * 4096;
static_assert(AT_TAB + 320 * 4 <= RING_BYTES && AT_YB + 4 * 32 * AT_YP <= AT_Q && AT_V0 + 3 * AT_VS <= AT_Q, "attention LDS map");
#define AT_MFMA(a, b, c) __builtin_amdgcn_mfma_f32_32x32x16_bf16(a, b, c, 0, 0, 0)
#define AT_SGB(mask, n) __builtin_amdgcn_sched_group_barrier(mask, n, 0)
__device__ __forceinline__ void attn_mfma(Frame& F, int qslot) {
    const bf16* PROJ = (const bf16*)(F.ws + WS_PROJ); bf16* MIXED = (bf16*)(F.ws + WS_HN);
    const float* small = (const float*)(F.ws + WS_SMALL);
    LAS unsigned char* lds = F.lds;
    LAS float* TAB = (LAS float*)(lds + AT_TAB);
    const int tid = F.tid, lane = F.lane, wave = F.wave, map = wave >> 2, qt = wave & 3, r32 = lane & 31, hi = lane >> 5;
    const int koff = map * AT_K1 + r32 * AT_KP + hi * 16;
    const int voff = AT_V0 + (4 * hi + ((lane & 15) >> 2)) * AT_VP + (16 * ((lane >> 4) & 1) + 4 * (lane & 3)) * 2;
    unsigned* qctr = (unsigned*)(F.ws + WS_CTL) + CW_ATTQ + 64 * qslot;
    if (tid == 0) F.MISC[12] = __hip_atomic_fetch_add(qctr, 1u, __ATOMIC_RELAXED, __HIP_MEMORY_SCOPE_AGENT);
    for (;;) {
        __syncthreads();
        const int L = (int)F.MISC[12];
        if (L >= 1024) break;
        unsigned nxtu = 0u;
        if (tid == 0) nxtu = __hip_atomic_fetch_add(qctr, 1u, __ATOMIC_RELAXED, __HIP_MEMORY_SCOPE_AGENT);
        const int qb = 15 - (L >> 6), bh = L & 63;
        const int b = bh >> 2, h = bh & 3, q0 = qb * 128; const size_t tok0 = (size_t)b * SEQ;
        const int NT = (q0 + 128) / 64;
        int tidu = F.tid; asm volatile("" : "+v"(tidu));
        if (tidu < 320) { const int n = tidu - 96; TAB[tidu] = n < 0 ? -INFINITY : small[SM_BIAS + h * 128 + (n > 127 ? 127 : n)]; }
        bf16x8 qf0, qf1, qf2, qf3;
        { const bf16* qrow = PROJ + (tok0 + q0 + 32 * qt + r32) * INW + C_DQ + h * 128 + map * 64 + 8 * hi;
          qf0 = *(const GAS bf16x8*)(qrow); qf1 = *(const GAS bf16x8*)(qrow + 16); qf2 = *(const GAS bf16x8*)(qrow + 32); qf3 = *(const GAS bf16x8*)(qrow + 48); }
        const unsigned char* projb = (const unsigned char*)PROJ;
        const unsigned ksrc = (unsigned)(((tok0 + (tidu >> 4)) * INW + C_DK + h * 128 + (tidu & 15) * 8) * 2), vsrc = ksrc + (C_DV - C_DK) * 2;
        const int kdst = ((tidu & 15) >> 3) * AT_K1 + (tidu >> 4) * AT_KP + (tidu & 7) * 16, vdst = AT_V0 + (tidu >> 4) * AT_VP + (tidu & 15) * 16;
#define AT_GLD(src, row) (*(const GAS v4u*)(projb + (size_t)((src) + (unsigned)((row) * (INW * 2)))))
        v4u kr[2], vr[2];
#pragma unroll
        for (int i = 0; i < 2; ++i) { kr[i] = AT_GLD(ksrc, 32 * i); vr[i] = AT_GLD(vsrc, 32 * i); }
#pragma unroll
        for (int i = 0; i < 2; ++i) { *(LAS v4u*)(lds + kdst + 32 * i * AT_KP) = kr[i]; *(LAS v4u*)(lds + vdst + 32 * i * AT_VP) = vr[i]; }
#pragma unroll
        for (int i = 0; i < 2; ++i) { kr[i] = AT_GLD(ksrc, 64 + 32 * i); vr[i] = AT_GLD(vsrc, 64 + 32 * i); }
        __syncthreads();
        const float bfar = TAB[96 + 127];
        f32x16 o[4];
#pragma unroll
        for (int mt = 0; mt < 4; ++mt) o[mt] = (f32x16){0.f,0.f,0.f,0.f,0.f,0.f,0.f,0.f,0.f,0.f,0.f,0.f,0.f,0.f,0.f,0.f};
        float mrun = -INFINITY, lsum = 0.f, alpha = 1.f, cexp = 0.f; bool resc = false;
        const int qlo = q0 + 32 * qt, qpos = qlo + r32;
        const int NTW = NT - 1 + (qt >> 1);
        f32x16 pA0, pA1, pB0, pB1;
        int vs_prev = 0, vs_cur = 0, vs_next = AT_VS;
#define AT_ROT() do { vs_prev = vs_cur; vs_cur = vs_next; vs_next = (vs_next == 2 * AT_VS) ? 0 : vs_next + AT_VS; } while (0)
#define AT_Z16 (f32x16){0.f,0.f,0.f,0.f,0.f,0.f,0.f,0.f,0.f,0.f,0.f,0.f,0.f,0.f,0.f,0.f}
#define AT_SBAR() __builtin_amdgcn_sched_barrier(0)
#define AT_PIN(x) asm volatile("" : "+v"(x))
        bf16x8 kAa, kAb, kBa, kBb; s16x4 f0l, f0h, f1l, f1h;
#define AT_KRD2(S, KB, s4) do { k##S##a = *(const LAS bf16x8*)(lds + (KB) + koff + 32 * (s4)); k##S##b = *(const LAS bf16x8*)(lds + (KB) + koff + 32 * AT_KP + 32 * (s4)); } while (0)
#define AT_VRD(Fn, g) do { LAS unsigned char* vp_ = vb_ + (32 * ((g) >> 3) + 16 * (((g) >> 2) & 1)) * AT_VP + 64 * ((g) & 3); \
            Fn##l = __builtin_bit_cast(s16x4, __builtin_amdgcn_ds_read_tr16_b64_v4i16((LAS v4i16_t*)vp_)); Fn##h = __builtin_bit_cast(s16x4, __builtin_amdgcn_ds_read_tr16_b64_v4i16((LAS v4i16_t*)(vp_ + 8 * AT_VP))); } while (0)
#define AT_VFR(Fn) (bf16x8){Fn##l[0], Fn##l[1], Fn##l[2], Fn##l[3], Fn##h[0], Fn##h[1], Fn##h[2], Fn##h[3]}
#define AT_GAPA(MF, RD, FILL, P, g, PK) do { MF; RD; \
            if (FILL) { const float e0_ = P[4 * ((g) & 3)], e1_ = P[4 * ((g) & 3) + 1], e2_ = P[4 * ((g) & 3) + 2], e3_ = P[4 * ((g) & 3) + 3]; \
                sacc_ += e0_; sacc_ += e1_; sacc_ += e2_; sacc_ += e3_; \
                PK[2 * (g)] = __builtin_bit_cast(float, cvtpk_bf16(e0_, e1_)); PK[2 * (g) + 1] = __builtin_bit_cast(float, cvtpk_bf16(e2_, e3_)); AT_PIN(PK); AT_PIN(sacc_); } \
            AT_SBAR(); } while (0)
#define AT_PHASE_A(C0, C1, P0, P1, KB, FILL) do { float sacc_ = 0.f; \
            AT_SBAR(); AT_KRD2(A, KB, 0); AT_SBAR(); \
            AT_GAPA(C0 = AT_MFMA(kAa, qf0, AT_Z16), AT_KRD2(B, KB, 1), FILL, P0, 0, P0); \
            AT_GAPA(C1 = AT_MFMA(kAb, qf0, AT_Z16), (void)0,           FILL, P0, 1, P0); \
            AT_GAPA(C0 = AT_MFMA(kBa, qf1, C0),     AT_KRD2(A, KB, 2), FILL, P0, 2, P0); \
            AT_GAPA(C1 = AT_MFMA(kBb, qf1, C1),     (void)0,           FILL, P0, 3, P0); \
            AT_GAPA(C0 = AT_MFMA(kAa, qf2, C0),     AT_KRD2(B, KB, 3), FILL, P1, 4, P0); \
            AT_GAPA(C1 = AT_MFMA(kAb, qf2, C1),     (void)0,           FILL, P1, 5, P0); \
            AT_GAPA(C0 = AT_MFMA(kBa, qf3, C0),     (void)0,           FILL, P1, 6, P0); \
            AT_GAPA(C1 = AT_MFMA(kBb, qf3, C1),     (void)0,           FILL, P1, 7, P0); \
            lsum += sacc_; } while (0)
#define AT_MID(C0, C1, t) do { float tm, cadd; \
            if (qlo - (64 * (t) + 63) < 127) { \
                const LAS float* rp = TAB + (qpos - 64 * (t) - 4 * hi + 96 - 59); tm = -INFINITY; \
                _Pragma("unroll") for (int r = 0; r < 16; ++r) { const int off = (r & 3) + 8 * (r >> 2); C0[r] += rp[59 - off]; C1[r] += rp[27 - off]; tm = max3f_(tm, C0[r], C1[r]); } \
                cadd = 0.f; \
            } else { \
                tm = max3f_(C0[0], C1[0], C0[1]); \
                _Pragma("unroll") for (int r = 1; r < 15; ++r) tm = max3f_(tm, C1[r], C0[r + 1]); \
                tm = fmaxf(tm, C1[15]); tm += bfar; cadd = bfar; } \
            tm = xhalf_max(tm); resc = false; \
            if (__any(tm > mrun + 8.f)) { const float mnew = fmaxf(mrun, tm); alpha = __builtin_amdgcn_exp2f(mrun - mnew); lsum *= alpha; mrun = mnew; resc = true; } \
            cexp = cadd - mrun; } while (0)
#define AT_EXP(C0, C1) do { _Pragma("unroll") for (int r = 0; r < 16; ++r) { C0[r] = __builtin_amdgcn_exp2f(C0[r] + cexp); C1[r] = __builtin_amdgcn_exp2f(C1[r] + cexp); } } while (0)
#define AT_GAPB(Fn, g, PK, C, DOEXP) do { o[(g) & 3] = AT_MFMA(AT_VFR(Fn), __builtin_bit_cast(bf16x8, (f32x4){PK[4 * ((g) >> 2)], PK[4 * ((g) >> 2) + 1], PK[4 * ((g) >> 2) + 2], PK[4 * ((g) >> 2) + 3]}), o[(g) & 3]); \
            if ((g) + 2 < 16) AT_VRD(Fn, (g) + 2); \
            if (DOEXP) { C[2 * ((g) & 7)] = __builtin_amdgcn_exp2f(C[2 * ((g) & 7)] + cexp); C[2 * ((g) & 7) + 1] = __builtin_amdgcn_exp2f(C[2 * ((g) & 7) + 1] + cexp); AT_PIN(C); } \
            AT_SBAR(); } while (0)
#define AT_PHASE_B(C0, C1, PK, VB, DOEXP) do { LAS unsigned char* vb_ = lds + (VB) + voff; \
            AT_SBAR(); AT_VRD(f0, 0); AT_VRD(f1, 1); AT_SBAR(); \
            AT_GAPB(f0, 0, PK, C0, DOEXP);  AT_GAPB(f1, 1, PK, C0, DOEXP);  AT_GAPB(f0, 2, PK, C0, DOEXP);  AT_GAPB(f1, 3, PK, C0, DOEXP); \
            AT_GAPB(f0, 4, PK, C0, DOEXP);  AT_GAPB(f1, 5, PK, C0, DOEXP);  AT_GAPB(f0, 6, PK, C0, DOEXP);  AT_GAPB(f1, 7, PK, C0, DOEXP); \
            AT_GAPB(f0, 8, PK, C1, DOEXP);  AT_GAPB(f1, 9, PK, C1, DOEXP);  AT_GAPB(f0, 10, PK, C1, DOEXP); AT_GAPB(f1, 11, PK, C1, DOEXP); \
            AT_GAPB(f0, 12, PK, C1, DOEXP); AT_GAPB(f1, 13, PK, C1, DOEXP); AT_GAPB(f0, 14, PK, C1, DOEXP); AT_GAPB(f1, 15, PK, C1, DOEXP); } while (0)
#define AT_RESC() do { if (resc) { _Pragma("unroll") for (int mt = 0; mt < 4; ++mt) o[mt] = o[mt] * alpha; } } while (0)
#define AT_STAGE(t) do { if ((t) + 1 < NT) { \
                _Pragma("unroll") for (int i = 0; i < 2; ++i) { *(LAS v4u*)(lds + (((t) + 1) & 1) * AT_KS + kdst + 32 * i * AT_KP) = kr[i]; *(LAS v4u*)(lds + vs_next + vdst + 32 * i * AT_VP) = vr[i]; } \
                if ((t) + 2 < NT) { _Pragma("unroll") for (int i = 0; i < 2; ++i) { kr[i] = AT_GLD(ksrc, 64 * ((t) + 2) + 32 * i); vr[i] = AT_GLD(vsrc, 64 * ((t) + 2) + 32 * i); } } } \
            __syncthreads(); AT_ROT(); } while (0)
#define AT_STEP(C0, C1, P0, P1, t) do { \
            AT_PHASE_A(C0, C1, P0, P1, ((t) & 1) * AT_KS, 1); \
            AT_MID(C0, C1, t); \
            AT_PHASE_B(C0, C1, P0, vs_prev, 1); \
            AT_RESC(); } while (0)
#define AT_PACK(P0, P1) do { float ps_ = 0.f; \
            _Pragma("unroll") for (int r = 0; r < 16; ++r) ps_ += P0[r] + P1[r]; \
            lsum += ps_; \
            _Pragma("unroll") for (int w = 0; w < 8; ++w) { const float lo_ = P0[2 * w], hi_ = P0[2 * w + 1]; P0[w] = __builtin_bit_cast(float, cvtpk_bf16(lo_, hi_)); } \
            _Pragma("unroll") for (int w = 0; w < 8; ++w) P0[8 + w] = __builtin_bit_cast(float, cvtpk_bf16(P1[2 * w], P1[2 * w + 1])); } while (0)
        AT_PHASE_A(pA0, pA1, pA0, pA1, 0, 0); AT_MID(pA0, pA1, 0); AT_EXP(pA0, pA1); AT_RESC();
        AT_STAGE(0);
        if (tid == 0) F.MISC[12] = nxtu;
        int t = 1;
        for (; t + 1 < NT; t += 2) {
            AT_STEP(pB0, pB1, pA0, pA1, t);     AT_STAGE(t);
            AT_STEP(pA0, pA1, pB0, pB1, t + 1); AT_STAGE(t + 1);
        }
        if (NTW == NT) {
            AT_STEP(pB0, pB1, pA0, pA1, t); AT_ROT();
            AT_PACK(pB0, pB1); AT_PHASE_B(pB0, pB1, pB0, vs_prev, 0);
        } else {
            AT_PACK(pA0, pA1); AT_PHASE_B(pA0, pA1, pA0, vs_prev, 0);
        }
        __syncthreads();
        { int lane_e = F.lane; asm volatile("" : "+v"(lane_e));
        const int lane = lane_e, r32 = lane & 31, hi = lane >> 5;
        const float inv = 1.f / xhalf_sum(lsum);
        LAS float* XO = (LAS float*)(lds + AT_XO) + qt * 4096 + r32;
        if (map == 1) {
            const float sc = inv * small[SM_LAM];
#pragma unroll
            for (int mt = 0; mt < 4; ++mt)
#pragma unroll
                for (int r = 0; r < 16; ++r) XO[(32 * mt + (r & 3) + 8 * (r >> 2) + 4 * hi) * 32] = o[mt][r] * sc;
        }
        __syncthreads();
        if (map == 0) {
            float ss = 0.f;
#pragma unroll
            for (int mt = 0; mt < 4; ++mt)
#pragma unroll
                for (int r = 0; r < 16; ++r) { const float a = o[mt][r] * inv - XO[(32 * mt + (r & 3) + 8 * (r >> 2) + 4 * hi) * 32]; o[mt][r] = a; ss += a * a; }
            ss = xhalf_sum(ss);
            const float rr = (1.f - LAM_INIT) / sqrtf(ss * (1.f / 128.f) + EPS);
            LAS unsigned char* yb = lds + AT_YB + qt * (32 * AT_YP);
#pragma unroll
            for (int mt = 0; mt < 4; ++mt)
#pragma unroll
                for (int r4 = 0; r4 < 4; ++r4) { const int dv = 32 * mt + 8 * r4 + 4 * hi; const f32x4 gg = *(const GAS f32x4*)(F.in[7] + dv);
                    v2u w; w.x = cvtpk_bf16(o[mt][4 * r4] * rr * gg.x, o[mt][4 * r4 + 1] * rr * gg.y); w.y = cvtpk_bf16(o[mt][4 * r4 + 2] * rr * gg.z, o[mt][4 * r4 + 3] * rr * gg.w);
                    *(LAS v2u*)(yb + r32 * AT_YP + dv * 2) = w; }
            LDS_WAIT(); asm volatile("" ::: "memory");
            bf16* obase = MIXED + (tok0 + q0 + 32 * qt) * DM + h * 128;
#pragma unroll
            for (int i = 0; i < 8; ++i) { const int id = lane + 64 * i, row = id >> 4, cch = id & 15;
                const v4u w = *(const LAS v4u*)(yb + row * AT_YP + cch * 16); *(GAS v4u*)(obase + (size_t)row * DM + cch * 8) = w; }
        } }
#undef AT_ROT
#undef AT_GLD
#undef AT_KRD2
#undef AT_VRD
#undef AT_VFR
#undef AT_GAPA
#undef AT_GAPB
#undef AT_PHASE_A
#undef AT_PHASE_B
#undef AT_PACK
#undef AT_MID
#undef AT_EXP
#undef AT_RESC
#undef AT_STAGE
#undef AT_STEP
    }
}

constexpr int HG_P = 288, HG_VP = 320, HG_GP = 272, HG_OP = 136;
constexpr int HG_QD = 0, HG_KI = 32 * HG_P, HG_V = 2 * 32 * HG_P, HG_CD = HG_V + 32 * HG_VP, HG_G = HG_CD + 512, HG_BUF = HG_G + 32 * HG_GP;
constexpr int HG_O = 2 * HG_BUF;
static_assert(HG_O + 32 * HG_OP * 4 <= RING_BYTES, "hgrn LDS map");
__device__ __forceinline__ bf16x8 pack8(const f32x16& x, int s) {
    v4u p; p.x = cvtpk_bf16(x[8 * s], x[8 * s + 1]); p.y = cvtpk_bf16(x[8 * s + 2], x[8 * s + 3]); p.z = cvtpk_bf16(x[8 * s + 4], x[8 * s + 5]); p.w = cvtpk_bf16(x[8 * s + 6], x[8 * s + 7]);
    return __builtin_bit_cast(bf16x8, p);
}
__device__ __forceinline__ bf16x8 tr_pair(LAS unsigned char* p0, LAS unsigned char* p1) {
    const s16x4 lo = __builtin_bit_cast(s16x4, __builtin_amdgcn_ds_read_tr16_b64_v4i16((LAS v4i16_t*)p0));
    const s16x4 hi4 = __builtin_bit_cast(s16x4, __builtin_amdgcn_ds_read_tr16_b64_v4i16((LAS v4i16_t*)p1));
    return (bf16x8){lo[0], lo[1], lo[2], lo[3], hi4[0], hi4[1], hi4[2], hi4[3]};
}
#define DPPF_(x, ctrl) __builtin_bit_cast(float, __builtin_amdgcn_update_dpp(0, __builtin_bit_cast(int, (x)), (ctrl), 0xf, 0xf, true))
__device__ __forceinline__ void hg_prep8(LAS unsigned char* bufp, const v4u rq, const v4u rf, const f32x4 lbA, const f32x4 lbB, int pc, int dk8, int lane) {
    const float lbv[8] = {lbA.x, lbA.y, lbA.z, lbA.w, lbB.x, lbB.y, lbB.z, lbB.w};
    float bb[8], fv[8];
    const unsigned fw[4] = {rf.x, rf.y, rf.z, rf.w}, qw[4] = {rq.x, rq.y, rq.z, rq.w};
#pragma unroll
    for (int i = 0; i < 8; ++i) { const float x = (i & 1) ? bfhi(fw[i >> 1]) : bflo(fw[i >> 1]); const float f = lbv[i] + (1.f - lbv[i]) * __builtin_amdgcn_rcpf(1.f + __expf(-x)); fv[i] = f; bb[i] = f; }
#define HG_SCAN_STEP(ctrl) asm volatile("s_nop 1\n\tv_mul_f32_dpp %0, %0, %0 " ctrl "\n\tv_mul_f32_dpp %1, %1, %1 " ctrl "\n\tv_mul_f32_dpp %2, %2, %2 " ctrl "\n\tv_mul_f32_dpp %3, %3, %3 " ctrl "\n\t" \
        "v_mul_f32_dpp %4, %4, %4 " ctrl "\n\tv_mul_f32_dpp %5, %5, %5 " ctrl "\n\tv_mul_f32_dpp %6, %6, %6 " ctrl "\n\tv_mul_f32_dpp %7, %7, %7 " ctrl \
        : "+v"(bb[0]), "+v"(bb[1]), "+v"(bb[2]), "+v"(bb[3]), "+v"(bb[4]), "+v"(bb[5]), "+v"(bb[6]), "+v"(bb[7]))
    HG_SCAN_STEP("row_shr:1 row_mask:0xf bank_mask:0xf");
    HG_SCAN_STEP("row_shr:2 row_mask:0xf bank_mask:0xf");
    HG_SCAN_STEP("row_shr:4 row_mask:0xf bank_mask:0xf");
    HG_SCAN_STEP("row_shr:8 row_mask:0xf bank_mask:0xf");
    HG_SCAN_STEP("row_bcast:15 row_mask:0xa bank_mask:0xf");
#undef HG_SCAN_STEP
    float qd[8], ki[8];
#pragma unroll
    for (int i = 0; i < 8; ++i) { const float e = bb[i], ei = __builtin_amdgcn_rcpf(bb[i]);
        const float xq = (i & 1) ? bfhi(qw[i >> 1]) : bflo(qw[i >> 1]); const float q = xq * __builtin_amdgcn_rcpf(1.f + __expf(-xq)); const float k = 1.f - fv[i];
        qd[i] = q * e; ki[i] = k * ei; }
    *(LAS v4u*)(bufp + HG_QD + pc * HG_P + dk8 * 2) = (v4u){cvtpk_bf16(qd[0], qd[1]), cvtpk_bf16(qd[2], qd[3]), cvtpk_bf16(qd[4], qd[5]), cvtpk_bf16(qd[6], qd[7])};
    *(LAS v4u*)(bufp + HG_KI + pc * HG_P + dk8 * 2) = (v4u){cvtpk_bf16(ki[0], ki[1]), cvtpk_bf16(ki[2], ki[3]), cvtpk_bf16(ki[4], ki[5]), cvtpk_bf16(ki[6], ki[7])};
    if (pc == 31) { *(LAS f32x4*)(bufp + HG_CD + dk8 * 4) = (f32x4){bb[0], bb[1], bb[2], bb[3]}; *(LAS f32x4*)(bufp + HG_CD + dk8 * 4 + 16) = (f32x4){bb[4], bb[5], bb[6], bb[7]}; }
}
__device__ __forceinline__ void hgrn_mfma(Frame& F) {
    const bf16* PROJ = (const bf16*)(F.ws + WS_PROJ); bf16* MIXED = (bf16*)(F.ws + WS_HN);
    const float* small = (const float*)(F.ws + WS_SMALL);
    LAS unsigned char* lds = F.lds;
    const int tid = F.tid, lane = F.lane, wave = F.wave, r32 = lane & 31, hh = lane >> 5;
    for (int u = F.vcu; u < 64; u += F.G) {
        const int b = u >> 2, h = u & 3; const size_t tok0 = (size_t)b * SEQ;
        __syncthreads();
        if (wave >= 4) {
            const int pt = tid - 256, pc = lane & 31, dkA = 16 * (wave - 4) + 8 * hh;
            const int vcA = pt >> 4, vseg = pt & 15;
            const f32x4 lb0 = *(const GAS f32x4*)(small + SM_LB + h * 128 + dkA), lb1 = *(const GAS f32x4*)(small + SM_LB + h * 128 + dkA + 4);
            const f32x4 lb2 = *(const GAS f32x4*)(small + SM_LB + h * 128 + dkA + 64), lb3 = *(const GAS f32x4*)(small + SM_LB + h * 128 + dkA + 68);
            v4u q0A, f0A, v0A, g0A, q1A, f1A, v1A, g1A, q0B, f0B, v0B, g0B, q1B, f1B, v1B, g1B, q0C, f0C, v0C, g0C, q1C, f1C, v1C, g1C, q0D, f0D, v0D, g0D, q1D, f1D, v1D, g1D;
#define HP_LOAD(S, chn) do { const bf16* p_ = PROJ + (tok0 + 32 * (chn) + pc) * INW + h * 128 + dkA; const bf16* v_ = PROJ + (tok0 + 32 * (chn) + vcA) * INW + h * 128 + vseg * 8; \
            asm volatile("global_load_dwordx4 %0, %1, off" : "=v"(q0##S) : "v"(p_ + C_HQ) : "memory"); \
            asm volatile("global_load_dwordx4 %0, %1, off" : "=v"(f0##S) : "v"(p_ + C_HF) : "memory"); \
            asm volatile("global_load_dwordx4 %0, %1, off" : "=v"(v0##S) : "v"(v_ + C_HI) : "memory"); \
            asm volatile("global_load_dwordx4 %0, %1, off" : "=v"(g0##S) : "v"(v_ + C_HG) : "memory"); \
            asm volatile("global_load_dwordx4 %0, %1, off" : "=v"(q1##S) : "v"(p_ + C_HQ + 64) : "memory"); \
            asm volatile("global_load_dwordx4 %0, %1, off" : "=v"(f1##S) : "v"(p_ + C_HF + 64) : "memory"); \
            asm volatile("global_load_dwordx4 %0, %1, off" : "=v"(v1##S) : "v"(v_ + (size_t)16 * INW + C_HI) : "memory"); \
            asm volatile("global_load_dwordx4 %0, %1, off" : "=v"(g1##S) : "v"(v_ + (size_t)16 * INW + C_HG) : "memory"); } while (0)
#define HP_WAIT(S) asm volatile("s_waitcnt vmcnt(24)" : "+v"(q0##S), "+v"(f0##S), "+v"(v0##S), "+v"(g0##S), "+v"(q1##S), "+v"(f1##S), "+v"(v1##S), "+v"(g1##S) :: "memory")
#define HP_PASS0(S, bufp) do { hg_prep8(bufp, q0##S, f0##S, lb0, lb1, pc, dkA, lane); \
            *(LAS v4u*)((bufp) + HG_V + vcA * HG_VP + vseg * 16) = v0##S; *(LAS v4u*)((bufp) + HG_V + (vcA + 16) * HG_VP + vseg * 16) = v1##S; \
            *(LAS v4u*)((bufp) + HG_G + vcA * HG_GP + vseg * 16) = g0##S; *(LAS v4u*)((bufp) + HG_G + (vcA + 16) * HG_GP + vseg * 16) = g1##S; } while (0)
#define HP_PASS1(S, bufp) hg_prep8(bufp, q1##S, f1##S, lb2, lb3, pc, dkA + 64, lane)
#define HP_CL(c) ((c) < SEQ / 32 ? (c) : SEQ / 32 - 1)
            HP_LOAD(A, 0); HP_LOAD(B, 1); HP_LOAD(C, 2); HP_LOAD(D, 3);
            HP_WAIT(A); HP_PASS0(A, lds); HP_PASS1(A, lds);
            HP_LOAD(A, 4);
            for (int ch4 = 0; ch4 < SEQ / 32; ch4 += 4) {
                __syncthreads();
                HP_WAIT(B); HP_PASS0(B, lds + HG_BUF);
                __syncthreads();
                HP_PASS1(B, lds + HG_BUF); HP_LOAD(B, HP_CL(ch4 + 5));
                __syncthreads();
                HP_WAIT(C); HP_PASS0(C, lds);
                __syncthreads();
                HP_PASS1(C, lds); HP_LOAD(C, HP_CL(ch4 + 6));
                __syncthreads();
                HP_WAIT(D); HP_PASS0(D, lds + HG_BUF);
                __syncthreads();
                HP_PASS1(D, lds + HG_BUF); HP_LOAD(D, HP_CL(ch4 + 7));
                __syncthreads();
                HP_WAIT(A); HP_PASS0(A, lds);
                __syncthreads();
                HP_PASS1(A, lds); HP_LOAD(A, HP_CL(ch4 + 8));
            }
            asm volatile("s_waitcnt vmcnt(0)" : "+v"(q0A), "+v"(f0A), "+v"(v0A), "+v"(g0A), "+v"(q1A), "+v"(f1A), "+v"(v1A), "+v"(g1A), "+v"(q0B), "+v"(f0B), "+v"(v0B), "+v"(g0B), "+v"(q1B), "+v"(f1B), "+v"(v1B), "+v"(g1B) :: "memory");
            asm volatile("" : "+v"(q0C), "+v"(f0C), "+v"(v0C), "+v"(g0C), "+v"(q1C), "+v"(f1C), "+v"(v1C), "+v"(g1C), "+v"(q0D), "+v"(f0D), "+v"(v0D), "+v"(g0D), "+v"(q1D), "+v"(f1D), "+v"(v1D), "+v"(g1D) :: "memory");
#undef HP_CL
#undef HP_LOAD
#undef HP_WAIT
#undef HP_PASS0
#undef HP_PASS1
        } else {
            const int dvt = wave;
            const int kdoff = (((lane & 15) >> 2)) * HG_P + (16 * ((lane >> 4) & 1) + 4 * (lane & 3)) * 2;
            const int troff = (((lane & 15) >> 2)) * HG_VP + (32 * dvt + 16 * ((lane >> 4) & 1) + 4 * (lane & 3)) * 2;
            const int vc = tid >> 3, sg = tid & 7;
            const f32x4 ga0 = *(const GAS f32x4*)(F.in[10] + 8 * sg), ga1 = *(const GAS f32x4*)(F.in[10] + 8 * sg + 4);
            const f32x4 gb0 = *(const GAS f32x4*)(F.in[10] + 64 + 8 * sg), gb1 = *(const GAS f32x4*)(F.in[10] + 64 + 8 * sg + 4);
            f32x16 S0, S1, S2, S3;
#pragma unroll
            for (int r = 0; r < 16; ++r) { S0[r] = 0.f; S1[r] = 0.f; S2[r] = 0.f; S3[r] = 0.f; }
            for (int ch = 0; ch < SEQ / 32; ++ch) {
                LAS unsigned char* bufp = lds + (ch & 1) * HG_BUF;
                __syncthreads();
                f32x16 o, X;
#pragma unroll
                for (int r = 0; r < 16; ++r) { o[r] = 0.f; X[r] = 0.f; }
                bf16x8 qaf[8], kif[8], qdf[8];
                __builtin_amdgcn_sched_barrier(0);
#pragma unroll
                for (int i = 0; i < 8; ++i) { LAS unsigned char* qa = bufp + HG_QD + r32 * HG_P + (16 * i + 4 * hh) * 2;
                    const v2u a0 = *(const LAS v2u*)qa, a1 = *(const LAS v2u*)(qa + 16); qaf[i] = __builtin_bit_cast(bf16x8, (v4u){a0.x, a0.y, a1.x, a1.y}); }
#pragma unroll
                for (int s8 = 0; s8 < 4; ++s8) { kif[s8] = *(const LAS bf16x8*)(bufp + HG_KI + r32 * HG_P + (16 * s8 + 8 * hh) * 2); qdf[s8] = *(const LAS bf16x8*)(bufp + HG_QD + r32 * HG_P + (16 * s8 + 8 * hh) * 2); }
                __builtin_amdgcn_sched_barrier(0);
#pragma unroll
                for (int i = 0; i < 8; ++i)
                    o = __builtin_amdgcn_mfma_f32_32x32x16_bf16(qaf[i], pack8((i >> 1) == 0 ? S0 : (i >> 1) == 1 ? S1 : (i >> 1) == 2 ? S2 : S3, i & 1), o, 0, 0, 0);
#pragma unroll
                for (int s8 = 4; s8 < 8; ++s8) { kif[s8] = *(const LAS bf16x8*)(bufp + HG_KI + r32 * HG_P + (16 * s8 + 8 * hh) * 2); qdf[s8] = *(const LAS bf16x8*)(bufp + HG_QD + r32 * HG_P + (16 * s8 + 8 * hh) * 2); }
                bf16x8 vx0, vx1;
                { LAS unsigned char* vp = bufp + HG_V + troff + (4 * hh) * HG_VP; vx0 = tr_pair(vp, vp + 8 * HG_VP); vx1 = tr_pair(vp + 16 * HG_VP, vp + 24 * HG_VP); }
                __builtin_amdgcn_sched_barrier(0);
#pragma unroll
                for (int s8 = 0; s8 < 8; ++s8) X = __builtin_amdgcn_mfma_f32_32x32x16_bf16(kif[s8], qdf[s8], X, 0, 0, 0);
                __builtin_amdgcn_sched_barrier(0);
#pragma unroll
                for (int r = 0; r < 16; ++r) { const int cp = (r & 3) + 8 * (r >> 2) + 4 * hh; X[r] = cp > r32 ? 0.f : X[r]; }
                o = __builtin_amdgcn_mfma_f32_32x32x16_bf16(pack8(X, 0), vx0, o, 0, 0, 0);
                o = __builtin_amdgcn_mfma_f32_32x32x16_bf16(pack8(X, 1), vx1, o, 0, 0, 0);
                { LAS float* ob = (LAS float*)(lds + HG_O) + 32 * dvt + r32;
#pragma unroll
                  for (int r = 0; r < 16; ++r) ob[((r & 3) + 8 * (r >> 2) + 4 * hh) * HG_OP] = o[r]; }
                __syncthreads();
                { bf16x8 kaf[8], vbf[2];
                  __builtin_amdgcn_sched_barrier(0);
#pragma unroll
                  for (int s2 = 0; s2 < 2; ++s2) { LAS unsigned char* vp = bufp + HG_V + troff + (16 * s2 + 8 * hh) * HG_VP; vbf[s2] = tr_pair(vp, vp + 4 * HG_VP); }
#pragma unroll
                  for (int i = 0; i < 8; ++i) { LAS unsigned char* kp = bufp + HG_KI + kdoff + (16 * (i & 1) + 8 * hh) * HG_P + 32 * (i >> 1) * 2;
                      kaf[i] = tr_pair(kp, kp + 4 * HG_P); }
                  __builtin_amdgcn_sched_barrier(0);
#pragma unroll
                  for (int i = 0; i < 8; ++i) {
                      if ((i >> 1) == 0)      S0 = __builtin_amdgcn_mfma_f32_32x32x16_bf16(kaf[i], vbf[i & 1], S0, 0, 0, 0);
                      else if ((i >> 1) == 1) S1 = __builtin_amdgcn_mfma_f32_32x32x16_bf16(kaf[i], vbf[i & 1], S1, 0, 0, 0);
                      else if ((i >> 1) == 2) S2 = __builtin_amdgcn_mfma_f32_32x32x16_bf16(kaf[i], vbf[i & 1], S2, 0, 0, 0);
                      else                    S3 = __builtin_amdgcn_mfma_f32_32x32x16_bf16(kaf[i], vbf[i & 1], S3, 0, 0, 0);
                  }
                  __builtin_amdgcn_sched_barrier(0); }
#pragma unroll
                for (int kk = 0; kk < 4; ++kk) {
                    const LAS float* cdp = (const LAS float*)(bufp + HG_CD) + 32 * kk + 4 * hh;
#pragma unroll
                    for (int r4 = 0; r4 < 4; ++r4) { const f32x4 c4 = *(const LAS f32x4*)(cdp + 8 * r4);
                        if (kk == 0)      { S0[4 * r4] *= c4.x; S0[4 * r4 + 1] *= c4.y; S0[4 * r4 + 2] *= c4.z; S0[4 * r4 + 3] *= c4.w; }
                        else if (kk == 1) { S1[4 * r4] *= c4.x; S1[4 * r4 + 1] *= c4.y; S1[4 * r4 + 2] *= c4.z; S1[4 * r4 + 3] *= c4.w; }
                        else if (kk == 2) { S2[4 * r4] *= c4.x; S2[4 * r4 + 1] *= c4.y; S2[4 * r4 + 2] *= c4.z; S2[4 * r4 + 3] *= c4.w; }
                        else              { S3[4 * r4] *= c4.x; S3[4 * r4 + 1] *= c4.y; S3[4 * r4 + 2] *= c4.z; S3[4 * r4 + 3] *= c4.w; } }
                }
                { const LAS float* op = (const LAS float*)(lds + HG_O) + vc * HG_OP + 8 * sg;
                  const f32x4 x0 = *(const LAS f32x4*)op, x1 = *(const LAS f32x4*)(op + 4), x2 = *(const LAS f32x4*)(op + 64), x3 = *(const LAS f32x4*)(op + 68);
                  const v4u gwa = *(const LAS v4u*)(bufp + HG_G + vc * HG_GP + sg * 16), gwb = *(const LAS v4u*)(bufp + HG_G + vc * HG_GP + (sg + 8) * 16);
                  float ss = ((x0.x * x0.x + x0.y * x0.y) + (x0.z * x0.z + x0.w * x0.w)) + ((x1.x * x1.x + x1.y * x1.y) + (x1.z * x1.z + x1.w * x1.w))
                           + ((x2.x * x2.x + x2.y * x2.y) + (x2.z * x2.z + x2.w * x2.w)) + ((x3.x * x3.x + x3.y * x3.y) + (x3.z * x3.z + x3.w * x3.w));
                  ss += DPPF_(ss, 0xB1); ss += DPPF_(ss, 0x4E); ss += DPPF_(ss, 0x141);
                  const float rr = __builtin_amdgcn_rsqf(ss * (1.f / 128.f) + EPS);
                  const size_t tok = tok0 + 32 * ch + vc;
                  const unsigned gwa_[4] = {gwa.x, gwa.y, gwa.z, gwa.w}, gwb_[4] = {gwb.x, gwb.y, gwb.z, gwb.w};
                  const float ova[8] = {x0.x, x0.y, x0.z, x0.w, x1.x, x1.y, x1.z, x1.w}, ovb[8] = {x2.x, x2.y, x2.z, x2.w, x3.x, x3.y, x3.z, x3.w};
                  const float gga[8] = {ga0.x, ga0.y, ga0.z, ga0.w, ga1.x, ga1.y, ga1.z, ga1.w}, ggb[8] = {gb0.x, gb0.y, gb0.z, gb0.w, gb1.x, gb1.y, gb1.z, gb1.w};
                  unsigned wa[4], wb[4];
#pragma unroll
                  for (int j = 0; j < 4; ++j) { const float a0 = bflo(gwa_[j]), a1 = bfhi(gwa_[j]), b0 = bflo(gwb_[j]), b1 = bfhi(gwb_[j]);
                      wa[j] = cvtpk_bf16(ova[2 * j] * rr * gga[2 * j] * (a0 * __builtin_amdgcn_rcpf(1.f + __expf(-a0))), ova[2 * j + 1] * rr * gga[2 * j + 1] * (a1 * __builtin_amdgcn_rcpf(1.f + __expf(-a1))));
                      wb[j] = cvtpk_bf16(ovb[2 * j] * rr * ggb[2 * j] * (b0 * __builtin_amdgcn_rcpf(1.f + __expf(-b0))), ovb[2 * j + 1] * rr * ggb[2 * j + 1] * (b1 * __builtin_amdgcn_rcpf(1.f + __expf(-b1)))); }
                  bf16* dst = MIXED + tok * DM + 512 + h * 128 + 8 * sg;
                  *(GAS v4u*)dst = (v4u){wa[0], wa[1], wa[2], wa[3]}; *(GAS v4u*)(dst + 64) = (v4u){wb[0], wb[1], wb[2], wb[3]}; }
            }
        }
    }
}
template <int N> __device__ __forceinline__ unsigned row_ror(unsigned x) { return (unsigned)__builtin_amdgcn_update_dpp((int)x, (int)x, 0x120 + N, 0xf, 0xf, false); }
__device__ __forceinline__ unsigned umax_(unsigned a, unsigned b) { return a > b ? a : b; }
__device__ __forceinline__ unsigned umin_(unsigned a, unsigned b) { return a < b ? a : b; }
__device__ __forceinline__ unsigned row_umax16(unsigned x) {
    unsigned y;
    asm volatile("s_nop 1\n\tv_max_u32_dpp %0, %1, %1 row_ror:1 row_mask:0xf bank_mask:0xf\n\t"
                 "s_nop 1\n\tv_max_u32_dpp %0, %0, %0 row_ror:2 row_mask:0xf bank_mask:0xf\n\t"
                 "s_nop 1\n\tv_max_u32_dpp %0, %0, %0 row_ror:4 row_mask:0xf bank_mask:0xf\n\t"
                 "s_nop 1\n\tv_max_u32_dpp %0, %0, %0 row_ror:8 row_mask:0xf bank_mask:0xf"
                 : "=&v"(y) : "v"(x));
    return y;
}
__device__ __forceinline__ float row_fsum16(float v) {
    v += __builtin_bit_cast(float, row_ror<1>(__builtin_bit_cast(unsigned, v))); v += __builtin_bit_cast(float, row_ror<2>(__builtin_bit_cast(unsigned, v)));
    v += __builtin_bit_cast(float, row_ror<4>(__builtin_bit_cast(unsigned, v))); v += __builtin_bit_cast(float, row_ror<8>(__builtin_bit_cast(unsigned, v))); return v; }
__device__ __forceinline__ unsigned h2key(unsigned x) { return (x & 0x80000000u) ? (~x & 0xffff0000u) : (x | 0x80000000u); }
__device__ __forceinline__ float hkey2f(unsigned k) { const unsigned hb = ((k & 0x80000000u) ? (k & 0x7fff0000u) : (~k & 0xffff0000u)) >> 16; return (float)__builtin_bit_cast(_Float16, (unsigned short)hb); }
__device__ __forceinline__ unsigned f2key(float f) { const unsigned u = __builtin_bit_cast(unsigned, f); return (u & 0x80000000u) ? ~u : (u | 0x80000000u); }
__device__ __forceinline__ float key2f(unsigned k) { const unsigned u = (k & 0x80000000u) ? (k & 0x7fffffffu) : ~k; return __builtin_bit_cast(float, u); }
__device__ __forceinline__ unsigned pair_code(int s) {
    if (s < 16) return (unsigned)s;
    if (s < 24) return 16u + (unsigned)(s - 16);
    if (s < 29) return 32u + (unsigned)(s - 24);
    if (s < 33) return 48u + (unsigned)(s - 29);
    if (s < 36) return 64u + (unsigned)(s - 33);
    if (s < 42) return 80u + 16u * (unsigned)((s - 36) >> 1) + (unsigned)((s - 36) & 1);
    if (s < 50) return 128u + 16u * (unsigned)(s - 42);
    return 0xFFu;
}
#define CAS_(a, b) do { const unsigned hi_ = umax_(a, b), lo_ = umin_(a, b); a = hi_; b = lo_; } while (0)
__device__ __forceinline__ void row_umax16_x2(unsigned xa, unsigned xb, unsigned& ya, unsigned& yb) {
    asm volatile("s_nop 1\n\tv_max_u32_dpp %0, %2, %2 row_ror:1 row_mask:0xf bank_mask:0xf\n\tv_max_u32_dpp %1, %3, %3 row_ror:1 row_mask:0xf bank_mask:0xf\n\t"
                 "s_nop 0\n\tv_max_u32_dpp %0, %0, %0 row_ror:2 row_mask:0xf bank_mask:0xf\n\tv_max_u32_dpp %1, %1, %1 row_ror:2 row_mask:0xf bank_mask:0xf\n\t"
                 "s_nop 0\n\tv_max_u32_dpp %0, %0, %0 row_ror:4 row_mask:0xf bank_mask:0xf\n\tv_max_u32_dpp %1, %1, %1 row_ror:4 row_mask:0xf bank_mask:0xf\n\t"
                 "s_nop 0\n\tv_max_u32_dpp %0, %0, %0 row_ror:8 row_mask:0xf bank_mask:0xf\n\tv_max_u32_dpp %1, %1, %1 row_ror:8 row_mask:0xf bank_mask:0xf"
                 : "=&v"(ya), "=&v"(yb) : "v"(xa), "v"(xb));
}
__device__ __forceinline__ void row_umax16_x4(unsigned xa, unsigned xb, unsigned xc, unsigned xd, unsigned& ya, unsigned& yb, unsigned& yc, unsigned& yd) {
    asm volatile("s_nop 1\n\tv_max_u32_dpp %0, %4, %4 row_ror:1 row_mask:0xf bank_mask:0xf\n\tv_max_u32_dpp %1, %5, %5 row_ror:1 row_mask:0xf bank_mask:0xf\n\t"
                 "v_max_u32_dpp %2, %6, %6 row_ror:1 row_mask:0xf bank_mask:0xf\n\tv_max_u32_dpp %3, %7, %7 row_ror:1 row_mask:0xf bank_mask:0xf\n\t"
                 "v_max_u32_dpp %0, %0, %0 row_ror:2 row_mask:0xf bank_mask:0xf\n\tv_max_u32_dpp %1, %1, %1 row_ror:2 row_mask:0xf bank_mask:0xf\n\t"
                 "v_max_u32_dpp %2, %2, %2 row_ror:2 row_mask:0xf bank_mask:0xf\n\tv_max_u32_dpp %3, %3, %3 row_ror:2 row_mask:0xf bank_mask:0xf\n\t"
                 "v_max_u32_dpp %0, %0, %0 row_ror:4 row_mask:0xf bank_mask:0xf\n\tv_max_u32_dpp %1, %1, %1 row_ror:4 row_mask:0xf bank_mask:0xf\n\t"
                 "v_max_u32_dpp %2, %2, %2 row_ror:4 row_mask:0xf bank_mask:0xf\n\tv_max_u32_dpp %3, %3, %3 row_ror:4 row_mask:0xf bank_mask:0xf\n\t"
                 "v_max_u32_dpp %0, %0, %0 row_ror:8 row_mask:0xf bank_mask:0xf\n\tv_max_u32_dpp %1, %1, %1 row_ror:8 row_mask:0xf bank_mask:0xf\n\t"
                 "v_max_u32_dpp %2, %2, %2 row_ror:8 row_mask:0xf bank_mask:0xf\n\tv_max_u32_dpp %3, %3, %3 row_ror:8 row_mask:0xf bank_mask:0xf"
                 : "=&v"(ya), "=&v"(yb), "=&v"(yc), "=&v"(yd) : "v"(xa), "v"(xb), "v"(xc), "v"(xd));
}
#define TK_LOAD(th_) (*(const GAS v4u*)(SC + (size_t)((th_) >> 3) * 2048 + ((th_) & 7) * 256 + c * 128 + l15 * 8))
#define TK_LOADSORT(P, sv_) \
    unsigned P##0, P##1, P##2, P##3, P##4, P##5, P##6, P##7; \
    { const v4u sv = (sv_); const unsigned nb = 127u - 8u * (unsigned)l15; \
      P##0 = h2key(sv.x << 16) | nb; P##1 = h2key(sv.x & 0xffff0000u) | (nb - 1u); P##2 = h2key(sv.y << 16) | (nb - 2u); P##3 = h2key(sv.y & 0xffff0000u) | (nb - 3u); \
      P##4 = h2key(sv.z << 16) | (nb - 4u); P##5 = h2key(sv.z & 0xffff0000u) | (nb - 5u); P##6 = h2key(sv.w << 16) | (nb - 6u); P##7 = h2key(sv.w & 0xffff0000u) | (nb - 7u); \
      CAS_(P##0, P##1); CAS_(P##2, P##3); CAS_(P##4, P##5); CAS_(P##6, P##7); CAS_(P##0, P##2); CAS_(P##1, P##3); CAS_(P##4, P##6); CAS_(P##5, P##7); CAS_(P##1, P##2); CAS_(P##5, P##6); CAS_(P##0, P##4); CAS_(P##3, P##7); \
      CAS_(P##1, P##5); CAS_(P##2, P##6); CAS_(P##1, P##4); CAS_(P##3, P##6); CAS_(P##2, P##4); CAS_(P##3, P##5); CAS_(P##3, P##4); }
#define TK_POP(P, m_) do { const bool pop_ = (P##0 == (m_)); P##0 = pop_ ? P##1 : P##0; P##1 = pop_ ? P##2 : P##1; P##2 = pop_ ? P##3 : P##2; P##3 = pop_ ? P##4 : P##3; \
      P##4 = pop_ ? P##5 : P##4; P##5 = pop_ ? P##6 : P##5; P##6 = pop_ ? P##7 : P##6; P##7 = pop_ ? 0u : P##7; } while (0)
__device__ __forceinline__ void topk_stage1x2(const v4u svA, const v4u svB, int l15, unsigned& resA, unsigned& resB) {
    TK_LOADSORT(ka, svA) TK_LOADSORT(kb, svB)
    unsigned ra = 0u, rb = 0u;
#pragma unroll
    for (int r = 0; r < 16; ++r) {
        unsigned ma, mb; row_umax16_x2(ka0, kb0, ma, mb);
        TK_POP(ka, ma); TK_POP(kb, mb);
        ra = (l15 == r) ? ma : ra; rb = (l15 == r) ? mb : rb;
    }
    resA = ra; resB = rb;
}
__device__ __forceinline__ void topk_stage1x4(const v4u svA, const v4u svB, const v4u svC, const v4u svD, int l15, unsigned& resA, unsigned& resB, unsigned& resC, unsigned& resD) {
    TK_LOADSORT(ka, svA) TK_LOADSORT(kb, svB) TK_LOADSORT(kc, svC) TK_LOADSORT(kd, svD)
    unsigned ra = 0u, rb = 0u, rc = 0u, rd = 0u;
#pragma unroll
    for (int r = 0; r < 16; ++r) {
        unsigned ma, mb, mc, md; row_umax16_x4(ka0, kb0, kc0, kd0, ma, mb, mc, md);
        TK_POP(ka, ma); TK_POP(kb, mb); TK_POP(kc, mc); TK_POP(kd, md);
        ra = (l15 == r) ? ma : ra; rb = (l15 == r) ? mb : rb; rc = (l15 == r) ? mc : rc; rd = (l15 == r) ? md : rd;
    }
    resA = ra; resB = rb; resC = rc; resD = rd;
}
__device__ __forceinline__ void topk_v2(Frame& F) {
    const unsigned short* SC = (const unsigned short*)(F.ws + WS_SC); int* IDX = (int*)(F.ws + WS_IDX); float* GATE = (float*)(F.ws + WS_GATE); float* GSU = (float*)(F.ws + WS_GSU);
    const float* SU = (const float*)(F.ws + WS_SU); const float* SV = (const float*)(F.ws + WS_SV);
    const int gw = F.vcu * NWAVES + F.wave, NGW = F.G * NWAVES, lane = F.lane, l15 = lane & 15, row = lane >> 4, c = row & 1, rbase = lane & 48;
    const unsigned pc0 = pair_code(l15), pc1 = pair_code(l15 + 16), pc2 = pair_code(l15 + 32), pc3 = pair_code(l15 + 48);
    const int src1 = l15 + 32 * (row & 1), src2 = src1 + 16;
    for (int it0 = gw * 32; it0 < NTOK * 2; it0 += NGW * 32) {
    v4u svA = TK_LOAD(4 * it0 + (row >> 1)), svB = TK_LOAD(4 * it0 + 2 + (row >> 1)), svC = TK_LOAD(4 * it0 + 4 + (row >> 1)), svD = TK_LOAD(4 * it0 + 6 + (row >> 1));
    for (int it = it0; it < it0 + 32; it += 2) {
        const int thb = 4 * it; const int thn = 4 * (it + 2 < it0 + 32 ? it + 2 : it);
        const v4u nvA = TK_LOAD(thn + (row >> 1)), nvB = TK_LOAD(thn + 2 + (row >> 1)), nvC = TK_LOAD(thn + 4 + (row >> 1)), nvD = TK_LOAD(thn + 6 + (row >> 1));
        unsigned resA, resB, resC, resD; topk_stage1x4(svA, svB, svC, svD, l15, resA, resB, resC, resD); svA = nvA; svB = nvB; svC = nvC; svD = nvD;
#define TK_S12(RA_, RB_, S1_, S2_) const unsigned S1_##a = (unsigned)__shfl((int)RA_, src1), S2_##a = (unsigned)__shfl((int)RA_, src2), S1_##b = (unsigned)__shfl((int)RB_, src1), S2_##b = (unsigned)__shfl((int)RB_, src2); \
        const unsigned S1_ = row < 2 ? S1_##a : S1_##b, S2_ = row < 2 ? S2_##a : S2_##b
        TK_S12(resA, resB, S1x, S2x); TK_S12(resC, resD, S1y, S2y);
#undef TK_S12
        unsigned c0, c1, c2, c3, d0, d1, d2, d3;
#define TK_CAND(CK, PC, S1_, S2_) do { const unsigned ka_ = (unsigned)__shfl((int)S1_, rbase + (int)((PC) >> 4 & 15u)), kb_ = (unsigned)__shfl((int)S2_, rbase + (int)((PC) & 15u)); \
            const float sm_ = hkey2f(ka_) + hkey2f(kb_); CK = (PC) == 0xFFu ? 0u : ((f2key(sm_) & ~0xFFu) | (255u - (PC))); } while (0)
        TK_CAND(c0, pc0, S1x, S2x); TK_CAND(c1, pc1, S1x, S2x); TK_CAND(c2, pc2, S1x, S2x); TK_CAND(c3, pc3, S1x, S2x);
        TK_CAND(d0, pc0, S1y, S2y); TK_CAND(d1, pc1, S1y, S2y); TK_CAND(d2, pc2, S1y, S2y); TK_CAND(d3, pc3, S1y, S2y);
#undef TK_CAND
        CAS_(c0, c1); CAS_(c2, c3); CAS_(c0, c2); CAS_(c1, c3); CAS_(c1, c2);
        CAS_(d0, d1); CAS_(d2, d3); CAS_(d0, d2); CAS_(d1, d3); CAS_(d1, d2);
        unsigned res2x = 0u, res2y = 0u;
#pragma unroll
        for (int r = 0; r < 16; ++r) {
            unsigned mx, my; row_umax16_x2(c0, d0, mx, my);
            const bool popx = (c0 == mx), popy = (d0 == my);
            c0 = popx ? c1 : c0; c1 = popx ? c2 : c1; c2 = popx ? c3 : c2; c3 = popx ? 0u : c3;
            d0 = popy ? d1 : d0; d1 = popy ? d2 : d1; d2 = popy ? d3 : d2; d3 = popy ? 0u : d3;
            res2x = (l15 == r) ? mx : res2x; res2y = (l15 == r) ? my : res2y;
        }
#define TK_FIN(RES2_, S1_, S2_, TH_) do { const unsigned code = 255u - ((RES2_) & 0xFFu); \
            const unsigned ka = (unsigned)__shfl((int)S1_, rbase + (int)(code >> 4 & 15u)), kb = (unsigned)__shfl((int)S2_, rbase + (int)(code & 15u)); \
            const float ts = hkey2f(ka) + hkey2f(kb); \
            const int e = (int)((127u - (ka & 0x7Fu)) * 128u + (127u - (kb & 0x7Fu))); \
            const float sve = SV[e], sue = SU[e];                                \
            const float tmax = __builtin_bit_cast(float, (unsigned)__shfl((int)__builtin_bit_cast(unsigned, ts), rbase)); \
            const float ex = __expf(ts - tmax); \
            const float sum = row_fsum16(ex); \
            const int th = (TH_) + row; \
            const size_t o = (size_t)(th >> 3) * NEXP_SEL + (th & 7) * 16 + l15; \
            IDX[o] = e; GATE[o] = ex / sum * sve; GSU[o] = sue; } while (0)
        TK_FIN(res2x, S1x, S2x, thb); TK_FIN(res2y, S1y, S2y, thb + 4);
#undef TK_FIN
    } }
}

constexpr int PG_TOK = 16;
constexpr int PG_IDX = 0, PG_HID = 4096, PG_SA = PG_HID + 8192, PG_TB = PG_SA + 64, PG_WB = PG_TB + 4096;
static_assert(PG_WB % 16 == 0 && PG_TB % 16 == 0 && NWAVES * PG_WB <= RING_BYTES, "gather LDS map");
typedef int pgv4i __attribute__((ext_vector_type(4))); typedef int pgv8i __attribute__((ext_vector_type(8)));
__device__ __forceinline__ pgv8i pg_cat8(const l2 a, const l2 b) { const pgv4i x = __builtin_bit_cast(pgv4i, a), y = __builtin_bit_cast(pgv4i, b); return __builtin_shufflevector(x, y, 0, 1, 2, 3, 4, 5, 6, 7); }
__device__ __forceinline__ pgv8i pg_lo8(const l2 a) { const pgv4i x = __builtin_bit_cast(pgv4i, a); return (pgv8i){x[0], x[1], x[2], x[3], 0, 0, 0, 0}; }
__device__ __forceinline__ void peer_sliced(Frame& F) {
    const unsigned char* U8T = F.ws + WS_U8; const unsigned char* V8T = F.ws + WS_V8; unsigned char* X4 = F.ws + WS_X4;
    const float* SSQ = (const float*)(F.ws + WS_CTL) + CW_SSQ;
    const int* IDX = (const int*)(F.ws + WS_IDX); const float* GATE = (const float*)(F.ws + WS_GATE); const float* GSU = (const float*)(F.ws + WS_GSU); const float* gf = F.in[17];
    bf16* PO = (bf16*)(F.ws + WS_PO); const bf16* HB = (const bf16*)(F.ws + WS_HN2);
    const int gw = F.vcu * NWAVES + F.wave, NGW = F.G * NWAVES, lane = F.lane, m = lane & 15, g = lane >> 4;
    const int row8 = lane >> 3, piece = lane & 7;
    LAS unsigned char* wb = F.lds + F.wave * PG_WB;
    LAS unsigned short* idxs = (LAS unsigned short*)(wb + PG_IDX);
    LAS float* hid = (LAS float*)(wb + PG_HID);
    LAS float* sqp = hid + 64 + lane;
    LAS float* sai = (LAS float*)(wb + PG_SA);
    LAS unsigned char* tb = wb + PG_TB;
    const int p8 = m & 7; const unsigned bsh = 8u * (unsigned)(p8 & 3); const bool bhi = (p8 >> 2) != 0;
    constexpr size_t SLICE = (size_t)16384 * 128;
    const int usw = 16 * (piece ^ ((row8 >> 1) & 3));
    const int urd0 = m * 128 + 16 * ((2 * g) ^ ((m >> 1) & 7)), urd1 = m * 128 + 16 * ((2 * g + 1) ^ ((m >> 1) & 7));
    for (int blk = gw; blk < NTOK / PG_TOK; blk += NGW) {
        const int t0 = blk * PG_TOK;
#pragma unroll
        for (int k = 0; k < 32; ++k) { const int id = lane + 64 * k;
            idxs[16 * (lane & 7) + (lane >> 3) + 128 * (k >> 1) + 8 * (k & 1)] = (unsigned short)IDX[(size_t)t0 * NEXP_SEL + id]; }
#pragma unroll
        for (int k = 0; k < 8; ++k) *(LAS f32x4*)(hid + 4 * (lane + 64 * k)) = (f32x4){0.f, 0.f, 0.f, 0.f};
        LDS_WAIT(); asm volatile("" ::: "memory");
        float xdq = 1.f;
        { f32x4 g2v[4];
#pragma unroll
          for (int q = 0; q < 4; ++q) g2v[q] = *((const GAS f32x4*)F.in[12] + 4 * lane + q);
#pragma unroll
          for (int i0 = 0; i0 < PG_TOK; i0 += 8) { v4u xr[8][2];
#pragma unroll
            for (int i = 0; i < 8; ++i) { const GAS v4u* hp_ = (const GAS v4u*)(HB + (size_t)(t0 + i0 + i) * DM) + 2 * lane; xr[i][0] = hp_[0]; xr[i][1] = hp_[1]; }
#pragma unroll
            for (int i = 0; i < 8; ++i) { const unsigned w_[8] = {xr[i][0].x, xr[i][0].y, xr[i][0].z, xr[i][0].w, xr[i][1].x, xr[i][1].y, xr[i][1].z, xr[i][1].w}; float f_[16]; float am = 0.f;
#pragma unroll
              for (int q = 0; q < 8; ++q) { f_[2 * q] = bflo(w_[q]) * g2v[q >> 1][2 * (q & 1)]; f_[2 * q + 1] = bfhi(w_[q]) * g2v[q >> 1][2 * (q & 1) + 1]; am = fmaxf(am, fmaxf(fabsf(f_[2 * q]), fabsf(f_[2 * q + 1]))); }
#pragma unroll
              for (int o = 1; o < 64; o <<= 1) am = fmaxf(am, __shfl_xor(am, o));
              const float qs = am > 0.f ? 6.f / am : 1.f; unsigned r0 = 0u, r1 = 0u;
              r0 = __builtin_amdgcn_cvt_scalef32_pk_fp4_f32(r0, f_[0] * qs, f_[1] * qs, 1.0f, 0); r0 = __builtin_amdgcn_cvt_scalef32_pk_fp4_f32(r0, f_[2] * qs, f_[3] * qs, 1.0f, 1);
              r0 = __builtin_amdgcn_cvt_scalef32_pk_fp4_f32(r0, f_[4] * qs, f_[5] * qs, 1.0f, 2); r0 = __builtin_amdgcn_cvt_scalef32_pk_fp4_f32(r0, f_[6] * qs, f_[7] * qs, 1.0f, 3);
              r1 = __builtin_amdgcn_cvt_scalef32_pk_fp4_f32(r1, f_[8] * qs, f_[9] * qs, 1.0f, 0); r1 = __builtin_amdgcn_cvt_scalef32_pk_fp4_f32(r1, f_[10] * qs, f_[11] * qs, 1.0f, 1);
              r1 = __builtin_amdgcn_cvt_scalef32_pk_fp4_f32(r1, f_[12] * qs, f_[13] * qs, 1.0f, 2); r1 = __builtin_amdgcn_cvt_scalef32_pk_fp4_f32(r1, f_[14] * qs, f_[15] * qs, 1.0f, 3);
              *(GAS v2u*)(X4 + (size_t)(t0 + i0 + i) * 512 + 8 * lane) = (v2u){r0, r1};
              xdq = lane == i0 + i ? (am > 0.f ? am * (1.f / 6.f) : 1.f) : xdq; } }
        }
        VM_WAIT();
        v4u ab[2][16]; l2 xs[2][2];
#define PGU_ISSUE_AT(UP_, XP_, i_, buf_) do { _Pragma("unroll") for (int k = 0; k < 16; ++k) { const unsigned e = idxs[(i_) * 128 + 16 * row8 + k]; \
                ab[buf_][k] = *(const GAS v4u*)((UP_) + (size_t)(e * 128u + (unsigned)(usw ^ ((k & 1) ? 64 : 0)))); } \
                _Pragma("unroll") for (int q = 0; q < 2; ++q) xs[buf_][q] = *(const GAS l2*)((XP_) + (size_t)(unsigned)(32 * g + (i_) * 512 + 16 * q)); } while (0)
        PGU_ISSUE_AT(U8T, X4 + (size_t)t0 * 512, 0, 0);
        for (int p = 0; p < 4; ++p) {
            const unsigned char* Up = U8T + (size_t)p * SLICE;
            const unsigned char* Xp = X4 + (size_t)t0 * 512 + 128 * p;
#define PGU_WR(i_, cur_, rb_, S_) do { _Pragma("unroll") for (int q4 = 0; q4 < 4; ++q4) *(LAS v4u*)(tb + 1024 * q4 + 16 * lane) = ab[cur_][4 * (rb_) + q4]; \
                S_##0 = *(const LAS l2*)(tb + urd0); S_##1 = *(const LAS l2*)(tb + urd1); S_##2 = *(const LAS l2*)(tb + 2048 + urd0); S_##3 = *(const LAS l2*)(tb + 2048 + urd1); \
                S_##c0 = *(const LAS f32x4*)(hid + (i_) * 128 + 32 * (rb_) + 4 * g); S_##c1 = *(const LAS f32x4*)(hid + (i_) * 128 + 32 * (rb_) + 16 + 4 * g); } while (0)
#define PGU_MF(i_, cur_, rb_, S_) do { f32x4 acc0 = S_##c0, acc1 = S_##c1; \
                const pgv8i x0_ = pg_lo8(xs[cur_][0]), x1_ = pg_lo8(xs[cur_][1]); \
                acc0 = __builtin_amdgcn_mfma_scale_f32_16x16x128_f8f6f4(pg_lo8(S_##0), x0_, acc0, 4, 4, 0, 0x7f7f7f7f, 0, 0x7f7f7f7f); acc1 = __builtin_amdgcn_mfma_scale_f32_16x16x128_f8f6f4(pg_lo8(S_##2), x0_, acc1, 4, 4, 0, 0x7f7f7f7f, 0, 0x7f7f7f7f); \
                acc0 = __builtin_amdgcn_mfma_scale_f32_16x16x128_f8f6f4(pg_lo8(S_##1), x1_, acc0, 4, 4, 0, 0x7f7f7f7f, 0, 0x7f7f7f7f); acc1 = __builtin_amdgcn_mfma_scale_f32_16x16x128_f8f6f4(pg_lo8(S_##3), x1_, acc1, 4, 4, 0, 0x7f7f7f7f, 0, 0x7f7f7f7f); \
                LAS float* hp_ = hid + (i_) * 128 + 32 * (rb_) + 4 * g; \
                asm volatile("s_nop 7\n\ts_mov_b32 exec_lo, 0x10001\n\ts_mov_b32 exec_hi, 0x10001\n\t" \
                             "ds_write_b128 %0, %1\n\tds_write_b128 %0, %2 offset:64\n\t" \
                             "s_mov_b64 exec, -1" \
                             :: "v"(hp_), "v"(acc0), "v"(acc1) : "memory"); } while (0)
#define PGU_BODY(i_, cur_, nxt_) do { { const bool wr_ = (i_) + 1 == PG_TOK; const int nx_ = wr_ ? 0 : (i_) + 1; const unsigned char* un_ = wr_ ? Up + SLICE : Up; const unsigned char* xn_ = wr_ ? Xp + 128 : Xp; PGU_ISSUE_AT(un_, xn_, nx_, nxt_); } SCHED_FENCE(); \
                l2 fa0, fa1, fa2, fa3, fb0, fb1, fb2, fb3; f32x4 fac0, fac1, fbc0, fbc1; \
                PGU_WR(i_, cur_, 0, fa); PGU_WR(i_, cur_, 1, fb); SCHED_FENCE(); \
                PGU_MF(i_, cur_, 0, fa); SCHED_FENCE(); PGU_WR(i_, cur_, 2, fa); SCHED_FENCE(); \
                PGU_MF(i_, cur_, 1, fb); SCHED_FENCE(); PGU_WR(i_, cur_, 3, fb); SCHED_FENCE(); \
                PGU_MF(i_, cur_, 2, fa); SCHED_FENCE(); PGU_MF(i_, cur_, 3, fb); SCHED_FENCE(); } while (0)
            for (int i2 = 0; i2 < PG_TOK; i2 += 2) { PGU_BODY(i2, 0, 1); PGU_BODY(i2 + 1, 1, 0); }
#undef PGU_BODY
#undef PGU_WR
#undef PGU_MF
            LDS_WAIT(); asm volatile("" ::: "memory");
        }
        { f32x2_t suv[16], gvv[16], hv[16];
          float sxl = SSQ[t0 + (lane & 15)]; sxl = xdq / sqrtf(sxl * (1.f / DM) + EPS);
#pragma unroll
          for (int i = 0; i < PG_TOK; ++i) { suv[i] = *(const GAS f32x2_t*)(GSU + (size_t)(t0 + i) * NEXP_SEL + 2 * lane); gvv[i] = *(const GAS f32x2_t*)(GATE + (size_t)(t0 + i) * NEXP_SEL + 2 * lane); }
#pragma unroll
          for (int i = 0; i < PG_TOK; ++i) hv[i] = *(const LAS f32x2_t*)(hid + i * 128 + 2 * lane);
          float w0[16], w1[16], am[16];
#pragma unroll
          for (int i = 0; i < PG_TOK; ++i) { const float sx = __builtin_bit_cast(float, __builtin_amdgcn_readlane(__builtin_bit_cast(int, sxl), i));
              w0[i] = gelu_as(hv[i].x * suv[i].x * sx) * gvv[i].x; w1[i] = gelu_as(hv[i].y * suv[i].y * sx) * gvv[i].y; am[i] = fmaxf(fabsf(w0[i]), fabsf(w1[i])); }
#pragma unroll
          for (int o = 1; o < 64; o <<= 1)
#pragma unroll
              for (int i = 0; i < PG_TOK; ++i) am[i] = fmaxf(am[i], __shfl_xor(am[i], o));
          LDS_WAIT(); asm volatile("" ::: "memory");
#pragma unroll
          for (int i = 0; i < PG_TOK; ++i) { const float sa = am[i] > 0.f ? 224.f / am[i] : 1.f;
              const int pk = __builtin_amdgcn_cvt_pk_fp8_f32(w0[i] * sa, w1[i] * sa, 0, false);
              LAS unsigned char* wq = (LAS unsigned char*)(hid + i * 128) + 32 * (lane & 3) + (lane >> 2);
              wq[0] = (unsigned char)pk; wq[16] = (unsigned char)(pk >> 8);
              if (lane == 0) sai[i] = am[i] > 0.f ? am[i] * (1.f / 224.f) : 1.f; }
        }
        LDS_WAIT(); asm volatile("" ::: "memory");
        v4u va[2][16];
#define PGV_ISSUE_AT(VP_, i_, buf_) do { _Pragma("unroll") for (int k = 0; k < 16; ++k) { const unsigned e = idxs[(i_) * 128 + 16 * row8 + k]; va[buf_][k] = *(const GAS v4u*)((VP_) + (size_t)(e * 128u + 16u * (unsigned)piece)); } } while (0)
        PGV_ISSUE_AT(V8T, 0, 0);
        for (int p = 0; p < 8; ++p) {
            const unsigned char* Vp = V8T + (size_t)p * SLICE;
#define PGV_BODY(i_, cur_, nxt_) do { { const bool wr_ = (i_) + 1 == PG_TOK; const int nx_ = wr_ ? 0 : (i_) + 1; const unsigned char* vn_ = wr_ ? Vp + SLICE : Vp; PGV_ISSUE_AT(vn_, nx_, nxt_); } \
                const v4u w4_ = *(const LAS v4u*)((LAS unsigned char*)(hid + (i_) * 128) + 16 * row8); \
                const unsigned ww[4] = {w4_.x, w4_.y, w4_.z, w4_.w}; \
                SCHED_FENCE(); f32x4 cl = (f32x4){0.f, 0.f, 0.f, 0.f}, chh = (f32x4){0.f, 0.f, 0.f, 0.f}; \
                _Pragma("unroll") for (int k = 0; k < 16; ++k) { \
                    const unsigned a8 = ((ww[k >> 2] >> (8 * (k & 3))) & 0xffu) << bsh; const long bop = (long)(bhi ? ((unsigned long long)a8 << 32) : (unsigned long long)a8); \
                    const long alo = (long)(((unsigned long long)va[cur_][k].y << 32) | (unsigned long long)va[cur_][k].x), ahi = (long)(((unsigned long long)va[cur_][k].w << 32) | (unsigned long long)va[cur_][k].z); \
                    cl = __builtin_amdgcn_mfma_f32_16x16x32_fp8_fp8(alo, bop, cl, 0, 0, 0); chh = __builtin_amdgcn_mfma_f32_16x16x32_fp8_fp8(ahi, bop, chh, 0, 0, 0); } \
                SCHED_FENCE(); \
                _Pragma("unroll") for (int i4 = 0; i4 < 4; ++i4) { \
                    cl[i4] += __shfl(cl[i4], (lane + 40) & 63); chh[i4] += __shfl(chh[i4], (lane + 40) & 63); } \
                { const float isa = sai[i_]; LAS unsigned short* ob = (LAS unsigned short*)(tb) + 64 * g + m;         \
                  if (m < 8 && g < 2) { _Pragma("unroll") for (int i4 = 0; i4 < 4; ++i4) { ob[16 * i4] = (unsigned short)f2bf(cl[i4] * isa); ob[16 * i4 + 8] = (unsigned short)f2bf(chh[i4] * isa); } } \
                  const v4u ov = *(const LAS v4u*)(tb + 16 * (lane & 15)); \
                  if (lane < 16) *(GAS v4u*)(PO + (size_t)(t0 + (i_)) * DM + 128 * p + 8 * lane) = ov; } } while (0)
            for (int i2 = 0; i2 < PG_TOK; i2 += 2) { PGV_BODY(i2, 0, 1); PGV_BODY(i2 + 1, 1, 0); }
#undef PGV_BODY
        }
        LDS_WAIT(); asm volatile("" ::: "memory");
        VM_WAIT();
#undef PGU_ISSUE_AT
#undef PGV_ISSUE_AT
        { f32x4 ggv[4];
#pragma unroll
          for (int j = 0; j < 4; ++j) ggv[j] = *((const GAS f32x4*)gf + lane + 64 * j);
          v2u paX[4], pbX[4], haX[4], hbX[4], paY[4], pbY[4], haY[4], hbY[4];
#define PGF_LOAD(S_, i_) do { const GAS v2u* prA = (const GAS v2u*)(PO + (size_t)(t0 + (i_)) * DM) + lane; const GAS v2u* prB = prA + DM / 4; \
              const GAS v2u* hbA = (const GAS v2u*)(HB + (size_t)(t0 + (i_)) * DM) + lane; const GAS v2u* hbB = hbA + DM / 4; \
              _Pragma("unroll") for (int j = 0; j < 4; ++j) { pa##S_[j] = prA[64 * j]; ha##S_[j] = hbA[64 * j]; pb##S_[j] = prB[64 * j]; hb##S_[j] = hbB[64 * j]; } } while (0)
#define PGF_BODY(S_, i_) do { GAS f32x4* hrA = (GAS f32x4*)(F.out + (size_t)(t0 + (i_)) * DM) + lane; GAS f32x4* hrB = hrA + DM / 4; \
              f32x4 ya[4], yb[4]; float sa = 0.f, sb = 0.f; \
              _Pragma("unroll") for (int j = 0; j < 4; ++j) { \
                  ya[j] = (f32x4){bflo(ha##S_[j].x), bfhi(ha##S_[j].x), bflo(ha##S_[j].y), bfhi(ha##S_[j].y)} + (f32x4){bflo(pa##S_[j].x), bfhi(pa##S_[j].x), bflo(pa##S_[j].y), bfhi(pa##S_[j].y)}; \
                  yb[j] = (f32x4){bflo(hb##S_[j].x), bfhi(hb##S_[j].x), bflo(hb##S_[j].y), bfhi(hb##S_[j].y)} + (f32x4){bflo(pb##S_[j].x), bfhi(pb##S_[j].x), bflo(pb##S_[j].y), bfhi(pb##S_[j].y)}; \
                  sa += (ya[j].x * ya[j].x + ya[j].y * ya[j].y) + (ya[j].z * ya[j].z + ya[j].w * ya[j].w); sb += (yb[j].x * yb[j].x + yb[j].y * yb[j].y) + (yb[j].z * yb[j].z + yb[j].w * yb[j].w); } \
              _Pragma("unroll") for (int o = 1; o < 64; o <<= 1) { sa += __shfl_xor(sa, o); sb += __shfl_xor(sb, o); } \
              const float ra = 1.f / sqrtf(sa * (1.f / DM) + EPS), rb = 1.f / sqrtf(sb * (1.f / DM) + EPS); \
              _Pragma("unroll") for (int j = 0; j < 4; ++j) { hrA[64 * j] = ya[j] * ra * ggv[j]; hrB[64 * j] = yb[j] * rb * ggv[j]; } } while (0)
          PGF_LOAD(X, 0);
          for (int i = 0; i < PG_TOK; i += 4) { PGF_LOAD(Y, i + 2); PGF_BODY(X, i); PGF_LOAD(X, (i + 4) & (PG_TOK - 1)); PGF_BODY(Y, i + 2); }
#undef PGF_LOAD
#undef PGF_BODY
        }
        LDS_WAIT(); asm volatile("" ::: "memory");
    }
}

struct Args { const float* in[18]; float* out; unsigned char* ws; int ph_lo, ph_hi; };
__global__ void __launch_bounds__(NWAVES * 64, 2) hymba_fwd(Args args) {
    extern __shared__ __attribute__((aligned(16))) unsigned char lds[];
    Frame F;
    F.lds = (LAS unsigned char*)lds;
    F.MISC = (volatile LAS unsigned*)(F.lds + MISC_OFF);
    F.tid = threadIdx.x; F.lane = F.tid & 63; F.wave = __builtin_amdgcn_readfirstlane(F.tid >> 6);
    F.G = gridDim.x; { const int bx = blockIdx.x; F.vcu = (F.G % 8 == 0) ? (bx % 8) * (F.G / 8) + bx / 8 : bx; }
#pragma unroll
    for (int i = 0; i < 18; ++i) F.in[i] = args.in[i];
    F.out = args.out; F.ws = args.ws;
    for (int u = F.tid; u < (LDS_BYTES - LDSCTL_OFF) / 4; u += NWAVES * 64) ((LAS unsigned*)(F.lds + LDSCTL_OFF))[u] = 0u;
    __syncthreads();
    const int lo = args.ph_lo, hi = args.ph_hi;
    const bool multi = (hi - lo) > 1;
    XcdBarrier bar; bar.bar = (unsigned*)(F.ws + WS_CTL) + CW_BAR; bar.x = 0; bar.st = nullptr;
    if (multi) bar = xcd_barrier_post((unsigned*)(F.ws + WS_CTL) + CW_BAR, F.MISC + 8);
#define IN(k) (lo <= (k) && (k) < hi)
#define SEAM(k) do { if (IN(k) && IN((k) + 1)) xcd_barrier(bar); } while (0)

    if (IN(0)) { p0_prologue(F); } SEAM(0);
    if (IN(1)) {
        pg8::Gemm g{(const pg8::bf16_t*)(F.ws + WS_HN), (const pg8::bf16_t*)(F.ws + WS_WIN), NTOK, INW, DM}; pg8::StaticOrder S; S.init(NTOK, INW, F.G, (int)blockIdx.x);
        pg8::EpiProj E{(pg8::bf16_t*)(F.ws + WS_PROJ), INW, 2, QSCALE};
        pg8::gemm_phase<pg8::EpiProj, pg8::StaticOrder, PG8_ALIGN, PG8_SP2>(F.lds + RING_OFF, g, S, E);
    } SEAM(1);
    if (IN(2)) { hgrn_mfma(F); }
    if (IN(3)) { quant_drain(F); attn_mfma(F, 0); }
    if (IN(3) && IN(4)) xcd_barrier(bar);
    if (IN(4)) {
        pg8::Gemm g{(const pg8::bf16_t*)(F.ws + WS_HN), (const pg8::bf16_t*)(F.ws + WS_WOUT), NTOK, DM, DM}; pg8::StaticOrder S; S.init(NTOK, DM, F.G, (int)blockIdx.x);
        pg8::EpiMix E{DM, F.in[0], (pg8::bf16_t*)(F.ws + WS_HN2), (float*)(F.ws + WS_CTL) + CW_SSQ};
        pg8::gemm_phase<pg8::EpiMix, pg8::StaticOrder, PG8_ALIGN, PG8_SP2>(F.lds + RING_OFF, g, S, E);
    }
    if (IN(4) && IN(6)) xcd_barrier(bar);
    if (IN(6)) {
        pg8::Gemm g{(const pg8::bf16_t*)(F.ws + WS_HN2), (const pg8::bf16_t*)(F.ws + WS_W2), NTOK, 2048, DM}; pg8::StaticOrder S; S.init(NTOK, 2048, F.G, (int)blockIdx.x);
        pg8::EpiScaleRow E{(_Float16*)(F.ws + WS_SC), 2048, (const float*)(F.ws + WS_CTL) + CW_SSQ, 1.f / DM, EPS};
        pg8::gemm_phase<pg8::EpiScaleRow, pg8::StaticOrder, PG8_ALIGN, PG8_SP2>(F.lds + RING_OFF, g, S, E);
    } SEAM(6);
    if (IN(7)) { topk_v2(F); }
    if (IN(7) && IN(8)) { VM_WAIT(); }
    if (IN(8)) { peer_sliced(F); }
#undef IN
#undef SEAM
}

extern "C" void kernel_launch(void* const* d_in, const int* in_sizes, int n_in, void* d_out, int out_size, void* d_ws, size_t ws_size, hipStream_t stream) {
    static int grid = 0;
    if (grid == 0) {
        if (n_in != 18 || in_sizes[0] != NTOK * DM || out_size != NTOK * DM || ws_size < WS_END) { fprintf(stderr, "kernel_launch: unexpected shapes (n_in %d, in0 %d, out %d, ws %zu); nothing launched\n", n_in, n_in > 0 ? in_sizes[0] : -1, out_size, ws_size); grid = -1; return; }
        int dev = 0, cus = 0, per_cu = 0;
        if (hipGetDevice(&dev) != hipSuccess || hipDeviceGetAttribute(&cus, hipDeviceAttributeMultiprocessorCount, dev) != hipSuccess) { grid = -1; return; }
        if (hipFuncSetAttribute((const void*)hymba_fwd, hipFuncAttributeMaxDynamicSharedMemorySize, LDS_BYTES) != hipSuccess) { fprintf(stderr, "kernel_launch: hipFuncSetAttribute failed\n"); grid = -1; return; }
        if (hipOccupancyMaxActiveBlocksPerMultiprocessor(&per_cu, (const void*)hymba_fwd, NWAVES * 64, LDS_BYTES) != hipSuccess || per_cu < 1)
            fprintf(stderr, "kernel_launch: note: occupancy query reports %d workgroups per CU\n", per_cu);
        (void)hipGetLastError();
        grid = cus;
    }
    if (grid < 0) return;
    if (hipMemsetAsync((char*)d_ws + WS_CTL, 0, CTL_ZERO_BYTES, stream) != hipSuccess) return;
    Args a{};
    for (int i = 0; i < 18; ++i) a.in[i] = (const float*)d_in[i];
    a.out = (float*)d_out; a.ws = (unsigned char*)d_ws; a.ph_lo = 0; a.ph_hi = 9;
    hipLaunchKernelGGL(hymba_fwd, dim3(grid), dim3(NWAVES * 64), LDS_BYTES, stream, a);
}
```

```cpp
#include <hip/hip_runtime.h>
#include <cstdio>
#include <cstdint>
#include <cmath>
namespace pg8 {
#define PG8_LAS __attribute__((address_space(3)))
typedef unsigned short bf16_t;
typedef short bf16x8 __attribute__((ext_vector_type(8)));
typedef float f32x4 __attribute__((ext_vector_type(4)));
typedef unsigned u32x4 __attribute__((ext_vector_type(4)));
constexpr int BM = 256, BK = 64, HALF = 128, HTB = HALF * BK * 2  , STAGE_BYTES = 8 * HTB, NXCD = 8, WGM = 8;

__host__ __device__ __forceinline__ int lds_byte(int r, int c) { const int st = (r >> 4) * 2 + (c >> 5), rr = r & 15, cc = c & 31, ob = rr * 64 + cc * 2; return st * 1024 + (ob ^ (((ob >> 9) & 1) << 5)); }
__host__ __device__ __forceinline__ void stage_rc(int b, int& R, int& C) { const int st = b / 1024, sb = b % 1024, swz = sb ^ (((sb >> 9) & 1) << 5); R = (st >> 1) * 16 + swz / 64; C = (st & 1) * 32 + (swz % 64) / 2; }
__host__ __device__ __forceinline__ int perm32(int rho) { const int n = rho >> 4, i = rho & 15; return 8 * (i >> 2) + 4 * n + (i & 3); }

struct Unit { int pm, pn; };
struct Gemm { const bf16_t* A; const bf16_t* Bt; int M, N, K; };

struct StaticOrder {
    int nM, nN, nwg, G, c;
    __host__ __device__ void init(int M, int N, int G_, int c_) { nM = M / BM; nN = N / BM; nwg = nM * nN; G = G_; c = c_; }
    __host__ __device__ bool next(int i, Unit& u) const {
        const long L = (long)i * G + c; if (L >= nwg) return false;
        int wgid = (int)L; { const int q = nwg / NXCD, r = nwg % NXCD, xcd = wgid % NXCD, off = wgid / NXCD; wgid = (xcd < r ? xcd * (q + 1) : r * (q + 1) + (xcd - r) * q) + off; }
        const int nig = WGM * nN, gid = wgid / nig, fm = gid * WGM, gsz = (nM - fm) < WGM ? (nM - fm) : WGM;
        u.pm = fm + ((wgid % nig) % gsz); u.pn = (wgid % nig) / gsz; return true;
    }
    __device__ __forceinline__ void a_ready(const Unit&) const {}
    __device__ __forceinline__ void done(const Unit&) const {}
};
__device__ __forceinline__ unsigned cvt_pk_bf16(float lo, float hi) { unsigned r; asm volatile("v_cvt_pk_bf16_f32 %0, %1, %2" : "=v"(r) : "v"(lo), "v"(hi)); return r; }
typedef float f32x2 __attribute__((ext_vector_type(2)));
__device__ __forceinline__ f32x2 gelu_pk(f32x2 v) {
    const f32x2 av = __builtin_elementwise_abs(v), d = av * 0.2316418882f + 1.0f;
    f32x2 t; t.x = __builtin_amdgcn_rcpf(d.x); t.y = __builtin_amdgcn_rcpf(d.y);
    f32x2 q = t * 0.5307027145f + (-0.7265760135f); q = q * t + 0.7107068705f; q = q * t + (-0.142248368f); q = q * t + 0.127414796f; q = q * t;
    const f32x2 s = (v * v) * (-0.72134752044f);
    f32x2 e; e.x = __builtin_amdgcn_exp2f(s.x); e.y = __builtin_amdgcn_exp2f(s.y);
    const f32x2 m = v * (q * e), r = v - m;
    f32x2 o; o.x = v.x < 0.f ? m.x : r.x; o.y = v.y < 0.f ? m.y : r.y; return o;
}
struct EpiProj {
    static constexpr bool PERM = true, AFTER_DRAIN = false;
    bf16_t* O; int ldc; int qtiles; float qscale;
    __device__ __forceinline__ void operator()(const f32x4 (&acc)[2][2][4][2], const Unit& u, int wr, int wc, int fr, int fq) const {
        const int row0 = u.pm * BM + wr * 64 + fr, col0 = u.pn * BM + wc * 32 + 8 * fq;
        const float sc = (u.pn < qtiles) ? qscale : 1.f;
#pragma unroll
        for (int ai = 0; ai < 2; ++ai)
#pragma unroll
            for (int m = 0; m < 4; ++m) { bf16_t* rowp = O + (size_t)(row0 + ai * HALF + m * 16) * ldc + col0;
#pragma unroll
                for (int bj = 0; bj < 2; ++bj) { const f32x4 v0 = acc[ai][bj][m][0] * sc, v1 = acc[ai][bj][m][1] * sc;
                    u32x4 w; w.x = cvt_pk_bf16(v0[0], v0[1]); w.y = cvt_pk_bf16(v0[2], v0[3]); w.z = cvt_pk_bf16(v1[0], v1[1]); w.w = cvt_pk_bf16(v1[2], v1[3]);
                    *(u32x4*)(rowp + bj * HALF) = w; } }
    }
};
struct EpiF32Res {
    static constexpr bool PERM = false, AFTER_DRAIN = false;
    float* C; int ldc; const float* res;
    __device__ __forceinline__ void operator()(const f32x4 (&acc)[2][2][4][2], const Unit& u, int wr, int wc, int fr, int fq) const {
        const int row0 = u.pm * BM + wr * 64 + fr, col0 = u.pn * BM + wc * 32 + 4 * fq;
#pragma unroll
        for (int ai = 0; ai < 2; ++ai)
#pragma unroll
            for (int m = 0; m < 4; ++m) { const size_t off = (size_t)(row0 + ai * HALF + m * 16) * ldc + col0;
#pragma unroll
                for (int bj = 0; bj < 2; ++bj)
#pragma unroll
                    for (int n = 0; n < 2; ++n) { f32x4 o = acc[ai][bj][m][n]; if (res) o = o + *(const f32x4*)(res + off + bj * HALF + n * 16);
                        *(f32x4*)(C + off + bj * HALF + n * 16) = o; } }
    }
};

struct EpiMix {
    static constexpr bool PERM = true, AFTER_DRAIN = false;
    int ldc; const float* res; bf16_t* HB; float* ssq;
    __device__ __forceinline__ void operator()(const f32x4 (&acc)[2][2][4][2], const Unit& u, int wr, int wc, int fr, int fq) const {
        const int row0 = u.pm * BM + wr * 64 + fr, col0 = u.pn * BM + wc * 32 + 8 * fq;
#pragma unroll
        for (int ai = 0; ai < 2; ++ai)
#pragma unroll
            for (int m = 0; m < 4; ++m) { const int row = row0 + ai * HALF + m * 16; const size_t off = (size_t)row * ldc + col0; float sq = 0.f;
#pragma unroll
                for (int bj = 0; bj < 2; ++bj) {
                    const f32x4 h0 = acc[ai][bj][m][0] + *(const f32x4*)(res + off + bj * HALF), h1 = acc[ai][bj][m][1] + *(const f32x4*)(res + off + bj * HALF + 4);
                    sq += (h0[0] * h0[0] + h0[1] * h0[1]) + (h0[2] * h0[2] + h0[3] * h0[3]) + (h1[0] * h1[0] + h1[1] * h1[1]) + (h1[2] * h1[2] + h1[3] * h1[3]);
                    u32x4 w; w.x = cvt_pk_bf16(h0[0], h0[1]); w.y = cvt_pk_bf16(h0[2], h0[3]); w.z = cvt_pk_bf16(h1[0], h1[1]); w.w = cvt_pk_bf16(h1[2], h1[3]);
                    *(u32x4*)(HB + off + bj * HALF) = w; }
                sq += __shfl_xor(sq, 16); sq += __shfl_xor(sq, 32);
                if (fq == 0) atomicAdd(ssq + row, sq); }
    }
};
struct EpiScaleRow {
    static constexpr bool PERM = true, AFTER_DRAIN = false;
    _Float16* C; int ldc; const float* ssq; float invk, eps;
    __device__ __forceinline__ void operator()(const f32x4 (&acc)[2][2][4][2], const Unit& u, int wr, int wc, int fr, int fq) const {
        typedef _Float16 h2 __attribute__((ext_vector_type(2)));
        const int row0 = u.pm * BM + wr * 64 + fr, col0 = u.pn * BM + wc * 32 + 8 * fq;
#pragma unroll
        for (int ai = 0; ai < 2; ++ai)
#pragma unroll
            for (int m = 0; m < 4; ++m) { const int row = row0 + ai * HALF + m * 16; const size_t off = (size_t)row * ldc + col0; const float rs = 1.f / sqrtf(ssq[row] * invk + eps);
#pragma unroll
                for (int bj = 0; bj < 2; ++bj) { const f32x4 v0 = acc[ai][bj][m][0] * rs, v1 = acc[ai][bj][m][1] * rs;
                    const h2 p0 = {(_Float16)v0[0], (_Float16)v0[1]}, p1 = {(_Float16)v0[2], (_Float16)v0[3]}, p2 = {(_Float16)v1[0], (_Float16)v1[1]}, p3 = {(_Float16)v1[2], (_Float16)v1[3]};
                    u32x4 w; w.x = __builtin_bit_cast(unsigned, p0); w.y = __builtin_bit_cast(unsigned, p1); w.z = __builtin_bit_cast(unsigned, p2); w.w = __builtin_bit_cast(unsigned, p3);
                    *(u32x4*)(C + off + bj * HALF) = w; } }
    }
};
template <class Epi, class Sched, bool ALIGN_EPI = false, bool SP2 = false>
__device__ __forceinline__ void gemm_phase(PG8_LAS unsigned char* lds, const Gemm g, const Sched& S, const Epi& E) {
    const int tid = threadIdx.x, wid = __builtin_amdgcn_readfirstlane(tid >> 6), lane = tid & 63, wr = wid >> 2, wc = wid & 3, fr = lane & 15, fq = lane >> 4;
    const int K = g.K, nt = K / BK;
    unsigned voffA[2], voffB[2];
#pragma unroll
    for (int i = 0; i < 2; ++i) { int R, C; stage_rc(tid * 16 + i * 8192, R, C); const int Rb = Epi::PERM ? ((R & ~31) + perm32(R & 31)) : R;
        voffA[i] = (unsigned)(R * K + C) * 2u; voffB[i] = (unsigned)(Rb * K + C) * 2u; }
    const size_t kstep = (size_t)(BK * 2);
    const size_t hstep = (size_t)HALF * K * 2;
    const size_t tstep = 2 * hstep;
    const unsigned ldsw = (unsigned)wid * 1024u;
    const int aoff = lds_byte(wr * 64 + fr, fq * 8), boff = lds_byte(wc * 32 + fr, fq * 8);
#define PG8_SA(b, h) (((b) * 2 + (h)) * HTB)
#define PG8_SB(b, h) ((4 + (b) * 2 + (h)) * HTB)
#define PG8_STAGE(bufoff, gbase, voff) do { _Pragma("unroll") for (int _i = 0; _i < 2; ++_i) \
        __builtin_amdgcn_global_load_lds((const unsigned*)((const char*)(gbase) + (voff)[_i]), (PG8_LAS unsigned*)(lds + (bufoff) + ldsw + _i * 8192), 16, 0, 0); } while (0)
#define PG8_LDA(dst, b, h) do { _Pragma("unroll") for (int m = 0; m < 4; ++m) _Pragma("unroll") for (int k = 0; k < 2; ++k) dst[m][k] = *(const PG8_LAS bf16x8*)(lds + PG8_SA(b, h) + aoff + m * 2048 + k * 1024); } while (0)
#define PG8_LDB(dst, b, h) do { _Pragma("unroll") for (int n = 0; n < 2; ++n) _Pragma("unroll") for (int k = 0; k < 2; ++k) dst[n][k] = *(const PG8_LAS bf16x8*)(lds + PG8_SB(b, h) + boff + n * 2048 + k * 1024); } while (0)
#define PG8_MMA(ai, bj, At, Bt) do { __builtin_amdgcn_s_setprio(1); _Pragma("unroll") for (int m = 0; m < 4; ++m) _Pragma("unroll") for (int n = 0; n < 2; ++n) _Pragma("unroll") for (int k = 0; k < 2; ++k) \
        acc[ai][bj][m][n] = __builtin_amdgcn_mfma_f32_16x16x32_bf16(Bt[n][k], At[m][k], acc[ai][bj][m][n], 0, 0, 0); __builtin_amdgcn_s_setprio(0); } while (0)
#define PG8_WAIT_V(n) asm volatile("s_waitcnt vmcnt(" #n ")" ::: "memory")
#define PG8_WAIT_L(n) asm volatile("s_waitcnt lgkmcnt(" #n ")" ::: "memory")
#define PG8_BAR __builtin_amdgcn_s_barrier()
#define PG8_SCHED __builtin_amdgcn_sched_barrier(0)
    Unit cur, nxt; int ui = 0;
    if (!S.next(0, cur)) return;
    f32x4 acc[2][2][4][2];
#pragma unroll
    for (int a = 0; a < 2; ++a)
#pragma unroll
        for (int b = 0; b < 2; ++b)
#pragma unroll
            for (int m = 0; m < 4; ++m)
#pragma unroll
                for (int n = 0; n < 2; ++n) acc[a][b][m][n] = (f32x4){0.f, 0.f, 0.f, 0.f};
    bf16x8 At[4][2], B0[2][2], B1[2][2];
    const char* cA = (const char*)g.A + (size_t)cur.pm * tstep; const char* cB = (const char*)g.Bt + (size_t)cur.pn * tstep;
    S.a_ready(cur);
    if constexpr (SP2) {
        PG8_STAGE(PG8_SB(0, 0), cB, voffB); PG8_STAGE(PG8_SB(0, 1), cB + hstep, voffB); PG8_STAGE(PG8_SA(0, 0), cA, voffA); PG8_STAGE(PG8_SA(0, 1), cA + hstep, voffA);
        if (wr == 1) PG8_BAR;
        PG8_WAIT_V(2); PG8_BAR;
        PG8_STAGE(PG8_SB(1, 0), cB + kstep, voffB); PG8_STAGE(PG8_SA(1, 0), cA + kstep, voffA); PG8_STAGE(PG8_SB(1, 1), cB + hstep + kstep, voffB);
        PG8_WAIT_V(6); PG8_BAR;
    } else {
        PG8_STAGE(PG8_SB(0, 0), cB, voffB); PG8_STAGE(PG8_SA(0, 0), cA, voffA); PG8_STAGE(PG8_SB(0, 1), cB + hstep, voffB); PG8_STAGE(PG8_SA(0, 1), cA + hstep, voffA);
        if (wr == 1) PG8_BAR;
        PG8_WAIT_V(4); PG8_BAR;
        PG8_STAGE(PG8_SB(1, 0), cB + kstep, voffB); PG8_STAGE(PG8_SA(1, 0), cA + kstep, voffA); PG8_STAGE(PG8_SB(1, 1), cB + hstep + kstep, voffB);
        PG8_WAIT_V(6); PG8_BAR;
    }
    for (;;) {
        const bool has_next = S.next(ui + 1, nxt);
        const char* nA = has_next ? (const char*)g.A + (size_t)nxt.pm * tstep : cA; const char* nB = has_next ? (const char*)g.Bt + (size_t)nxt.pn * tstep : cB;
        for (int t = 0; t < nt; t += 2) {
            const bool last = (t == nt - 2);
            const char* a1 = cA + (size_t)(t + 1) * kstep;
            const char* a2 = last ? nA : cA + (size_t)(t + 2) * kstep; const char* b2 = last ? nB : cB + (size_t)(t + 2) * kstep;
            const char* a3 = a2 + kstep; const char* b3 = b2 + kstep;
            if (last && has_next) S.a_ready(nxt);
            if constexpr (SP2) {
            PG8_LDB(B0, 0, 0); PG8_LDB(B1, 0, 1); PG8_SCHED; PG8_LDA(At, 0, 0); PG8_STAGE(PG8_SA(1, 1), a1 + hstep, voffA);
            PG8_WAIT_V(8); PG8_WAIT_L(0); PG8_BAR; PG8_MMA(0, 0, At, B0); PG8_MMA(0, 1, At, B1); PG8_BAR; PG8_SCHED;
            PG8_LDA(At, 0, 1); PG8_STAGE(PG8_SB(0, 0), b2, voffB); PG8_STAGE(PG8_SB(0, 1), b2 + hstep, voffB); PG8_STAGE(PG8_SA(0, 0), a2, voffA);
            PG8_WAIT_V(8); PG8_WAIT_L(0); PG8_BAR; PG8_MMA(1, 0, At, B0); PG8_MMA(1, 1, At, B1); PG8_BAR; PG8_SCHED;
            PG8_LDB(B0, 1, 0); PG8_LDB(B1, 1, 1); PG8_SCHED; PG8_LDA(At, 1, 0); PG8_STAGE(PG8_SA(0, 1), a2 + hstep, voffA);
            PG8_WAIT_V(8); PG8_WAIT_L(0); PG8_BAR; PG8_MMA(0, 0, At, B0); PG8_MMA(0, 1, At, B1); PG8_BAR; PG8_SCHED;
            PG8_LDA(At, 1, 1); PG8_STAGE(PG8_SB(1, 0), b3, voffB); PG8_STAGE(PG8_SB(1, 1), b3 + hstep, voffB); PG8_STAGE(PG8_SA(1, 0), a3, voffA);
            PG8_WAIT_V(8); PG8_WAIT_L(0); PG8_BAR; PG8_MMA(1, 0, At, B0); PG8_MMA(1, 1, At, B1); PG8_BAR; PG8_SCHED;
            } else {
            PG8_LDB(B0, 0, 0); PG8_SCHED; PG8_LDA(At, 0, 0); PG8_STAGE(PG8_SA(1, 1), a1 + hstep, voffA);
            PG8_WAIT_L(8); PG8_BAR; PG8_WAIT_L(0); PG8_MMA(0, 0, At, B0); PG8_BAR; PG8_SCHED;
            PG8_LDB(B1, 0, 1); PG8_STAGE(PG8_SB(0, 0), b2, voffB);
            PG8_BAR; PG8_WAIT_L(0); PG8_MMA(0, 1, At, B1); PG8_BAR;
            PG8_LDA(At, 0, 1); PG8_STAGE(PG8_SA(0, 0), a2, voffA);
            PG8_BAR; PG8_WAIT_L(0); PG8_MMA(1, 0, At, B0); PG8_BAR; PG8_SCHED;
            PG8_STAGE(PG8_SB(0, 1), b2 + hstep, voffB);
            PG8_WAIT_V(6); PG8_BAR; PG8_MMA(1, 1, At, B1); PG8_BAR;
            PG8_LDB(B0, 1, 0); PG8_SCHED; PG8_LDA(At, 1, 0); PG8_STAGE(PG8_SA(0, 1), a2 + hstep, voffA);
            PG8_WAIT_L(8); PG8_BAR; PG8_WAIT_L(0); PG8_MMA(0, 0, At, B0); PG8_BAR; PG8_SCHED;
            PG8_LDB(B1, 1, 1); PG8_STAGE(PG8_SB(1, 0), b3, voffB);
            PG8_BAR; PG8_WAIT_L(0); PG8_MMA(0, 1, At, B1); PG8_BAR;
            PG8_LDA(At, 1, 1); PG8_STAGE(PG8_SA(1, 0), a3, voffA);
            PG8_BAR; PG8_WAIT_L(0); PG8_MMA(1, 0, At, B0); PG8_BAR; PG8_SCHED;
            PG8_STAGE(PG8_SB(1, 1), b3 + hstep, voffB);
            PG8_WAIT_V(6); PG8_BAR; PG8_MMA(1, 1, At, B1); PG8_BAR;
            }
        }
        if constexpr (ALIGN_EPI) { if (wr == 0) PG8_BAR; }
        if constexpr (!Epi::AFTER_DRAIN) { E(acc, cur, wr, wc, fr, fq); S.done(cur); }
        if (!has_next) break;
#pragma unroll
        for (int a = 0; a < 2; ++a)
#pragma unroll
            for (int b = 0; b < 2; ++b)
#pragma unroll
                for (int m = 0; m < 4; ++m)
#pragma unroll
                    for (int n = 0; n < 2; ++n) acc[a][b][m][n] = (f32x4){0.f, 0.f, 0.f, 0.f};
        cur = nxt; cA = nA; cB = nB; ++ui;
        if constexpr (ALIGN_EPI) { if (wr == 1) PG8_BAR; }
    }
    PG8_WAIT_V(0);
    if constexpr (!ALIGN_EPI) { if (wr == 0) PG8_BAR; }
    PG8_BAR;
    if constexpr (Epi::AFTER_DRAIN) { E.fused(acc, cur, wr, wc, fr, fq, lds, wid, lane); S.done(cur); }
#undef PG8_SA
#undef PG8_SB
#undef PG8_STAGE
#undef PG8_LDA
#undef PG8_LDB
#undef PG8_MMA
#undef PG8_WAIT_V
#undef PG8_WAIT_L
#undef PG8_BAR
#undef PG8_SCHED
}
}
#ifndef PG8_SP2
#define PG8_SP2 true
#endif
#ifndef PG8_ALIGN
#define PG8_ALIGN true
#endif

constexpr int NWAVES = 8;
constexpr int NTOK = 32768, DM = 1024, SEQ = 2048, NBATCH = 16, INW = 3584;
constexpr int C_DQ = 0, C_DK = 512, C_DV = 1024, C_HQ = 1536, C_HF = 2048, C_HI = 2560, C_HG = 3072;
constexpr float EPS = 1e-6f;
constexpr float QSCALE = 0.125f * 1.4426950408889634f;
constexpr float LAM_INIT = 0.2f;
constexpr int NEXP_SEL = 128;

constexpr size_t MiB = 1u << 20;
constexpr size_t WS_CTL = 0, CTL_ZERO_BYTES = 1 * MiB;
constexpr size_t WS_SMALL = 1 * MiB;
constexpr size_t WS_WIN = 2 * MiB;
constexpr size_t WS_WOUT = 10 * MiB;
constexpr size_t WS_W2 = 12 * MiB;
constexpr size_t WS_U8 = 17 * MiB;
constexpr size_t WS_V8 = 33 * MiB;
constexpr size_t WS_SU = 49 * MiB;
constexpr size_t WS_SV = 49 * MiB + 512 * 1024;
constexpr size_t WS_X8 = 50 * MiB;
constexpr size_t WS_SX = 116 * MiB;
constexpr size_t WS_GSU = 120 * MiB;
constexpr size_t WS_HN = 84 * MiB;
constexpr size_t WS_PROJ = 148 * MiB;
constexpr size_t WS_HN2 = 148 * MiB;
constexpr size_t WS_SC = 212 * MiB;
constexpr size_t WS_PO = 352 * MiB;
constexpr size_t WS_X4 = 420 * MiB;
constexpr size_t WS_IDX = 468 * MiB;
constexpr size_t WS_GATE = 484 * MiB;
constexpr size_t WS_END = 500 * MiB;
constexpr int SM_LB = 0, SM_LAM = 512, SM_BIAS = 1024;
constexpr int CW_BAR = 4096;
constexpr int CW_ATTQ = 8192;
constexpr int CW_SSQ = 131072;

constexpr int RING_OFF = 0, RING_BYTES = 139264;
constexpr int LDSCTL_OFF = RING_BYTES, MISC_OFF = LDSCTL_OFF + 320;
constexpr int LDS_BYTES = 147456;

#define GAS __attribute__((address_space(1)))
#define LAS __attribute__((address_space(3)))
typedef unsigned short bf16;
typedef unsigned v4u __attribute__((ext_vector_type(4)));
typedef unsigned v2u __attribute__((ext_vector_type(2)));
typedef float f32x4 __attribute__((ext_vector_type(4)));
typedef short bf16x8 __attribute__((ext_vector_type(8)));
typedef GAS unsigned gu32;
typedef long l2 __attribute__((ext_vector_type(2)));
typedef int v4i __attribute__((ext_vector_type(4)));
#define RLX_AGENT __ATOMIC_RELAXED, __HIP_MEMORY_SCOPE_AGENT
#define LDS_WAIT() asm volatile("s_waitcnt lgkmcnt(0)" ::: "memory")
#define VM_WAIT() asm volatile("s_waitcnt vmcnt(0)" ::: "memory")
__device__ __forceinline__ unsigned f2bf(float f) { unsigned u = __builtin_bit_cast(unsigned, f); return (u + 0x7fffu + ((u >> 16) & 1u)) >> 16; }
__device__ __forceinline__ unsigned pk2(float lo, float hi) { return f2bf(lo) | (f2bf(hi) << 16); }
__device__ __forceinline__ float bflo(unsigned w) { return __builtin_bit_cast(float, w << 16); }
__device__ __forceinline__ float bfhi(unsigned w) { return __builtin_bit_cast(float, w & 0xffff0000u); }

#define XB_TMO      128
#define XB_XCNT(j)  (256  + 64 * (j))
#define XB_XSUB(j)  (1280 + 64 * (j))
#define XB_XGEN(j)  (2304 + 64 * (j))
#define XB_TOP      3328
#define XB_TOPGEN   3392
#define XCD_BAR_WORDS 3456
#define XB_SPIN_CAP (1u << 18)
__device__ __forceinline__ unsigned xb_ld(unsigned* p)              { return __hip_atomic_load(p, __ATOMIC_RELAXED, __HIP_MEMORY_SCOPE_AGENT); }
__device__ __forceinline__ unsigned xb_add(unsigned* p, unsigned v) { return __hip_atomic_fetch_add(p, v, __ATOMIC_RELAXED, __HIP_MEMORY_SCOPE_AGENT); }
__device__ __forceinline__ unsigned xb_xcc_id() { return (unsigned)__builtin_amdgcn_s_getreg((3 << 11) | 20) & 0xFu; }
#define XB_SPIN(cond, bar) do { unsigned _sp = 0; while (cond) { __builtin_amdgcn_s_sleep(1); \
    if ((++_sp & 255u) == 0u) { if (xb_ld(&(bar)[XB_TMO])) break; if (_sp > XB_SPIN_CAP) { atomicAdd(&(bar)[XB_TMO], 1u); break; } } } } while (0)
struct XcdBarrier { unsigned* bar; unsigned x; volatile LAS unsigned* st; };
__device__ __forceinline__ XcdBarrier xcd_barrier_post(unsigned* bar, volatile LAS unsigned* st) {
    XcdBarrier b; b.bar = bar; b.x = xb_xcc_id(); b.st = st;
    if (threadIdx.x == 0) (void)xb_add(&bar[XB_XCNT(b.x)], 1u);
    return b;
}
__device__ __forceinline__ void xcd_barrier_complete(unsigned* bar, unsigned x, unsigned& nloc, unsigned& nx) {
    const unsigned G = gridDim.x * gridDim.y * gridDim.z;
    unsigned sum, cnt, mine, sp = 0u;
    for (;;) {
        sum = 0u; cnt = 0u; mine = 0u;
#pragma unroll
        for (unsigned j = 0; j < 16; ++j) { const unsigned c = xb_ld(&bar[XB_XCNT(j)]); sum += c; cnt += (c > 0u) ? 1u : 0u; mine = (j == x) ? c : mine; }
        if (sum == G) break;
        __builtin_amdgcn_s_sleep(1);
        if ((++sp & 255u) == 0u) { if (xb_ld(&bar[XB_TMO])) break; if (sp > XB_SPIN_CAP) { atomicAdd(&bar[XB_TMO], 1u); break; } }
    }
    nloc = mine > 0u ? mine : 1u; nx = cnt > 0u ? cnt : 1u;
}
__device__ __forceinline__ void xcd_barrier(const XcdBarrier& b) {
    asm volatile("s_waitcnt vmcnt(0)" ::: "memory");
    __syncthreads();
    if (threadIdx.x == 0) {
        unsigned* bar = b.bar;
        __builtin_amdgcn_s_waitcnt(0);
        unsigned nloc = b.st[0], nx = b.st[1];
        if (nloc == 0u) { xcd_barrier_complete(bar, b.x, nloc, nx); b.st[0] = nloc; b.st[1] = nx; }
        const unsigned old = xb_add(&bar[XB_XSUB(b.x)], 1u);
        const unsigned gen = old / nloc;
        if (old + 1u == (gen + 1u) * nloc) {
            __builtin_amdgcn_fence(__ATOMIC_RELEASE, "agent");
            asm volatile("s_waitcnt vmcnt(0)" ::: "memory");
            const unsigned og = xb_add(&bar[XB_TOP], 1u);
            const unsigned tg = og / nx;
            if (og + 1u == (tg + 1u) * nx) xb_add(&bar[XB_TOPGEN], 1u);
            else XB_SPIN(xb_ld(&bar[XB_TOPGEN]) == tg, bar);
            __builtin_amdgcn_fence(__ATOMIC_ACQUIRE, "agent");
            xb_add(&bar[XB_XGEN(b.x)], 1u);
            asm volatile("s_waitcnt vmcnt(0)" ::: "memory");
        } else {
            XB_SPIN(xb_ld(&bar[XB_XGEN(b.x)]) == gen, bar);
            __builtin_amdgcn_fence(__ATOMIC_ACQUIRE, "agent");
            asm volatile("s_waitcnt vmcnt(0)" ::: "memory");
        }
    }
    __syncthreads();
}

#define SCHED_FENCE() __builtin_amdgcn_sched_barrier(0)
__device__ __forceinline__ float gelu_as(float v) {
    const float av = fabsf(v), t = __builtin_amdgcn_rcpf(av * 0.2316418882f + 1.0f);
    float q = t * 0.5307027145f + (-0.7265760135f); q = q * t + 0.7107068705f; q = q * t + (-0.142248368f); q = q * t + 0.127414796f; q = q * t;
    const float e = __builtin_amdgcn_exp2f((v * v) * (-0.72134752044f));
    const float mm = v * (q * e);
    return v < 0.f ? mm : v - mm;
}
struct Frame {
    LAS unsigned char* lds;
    volatile LAS unsigned* MISC;
    int tid, lane, wave, vcu, G;
    const float* in[18]; float* out; unsigned char* ws;
};
__device__ __forceinline__ float wave_sum(float v) {
#pragma unroll
    for (int o = 1; o < 64; o <<= 1) v += __shfl_xor(v, o);
    return v;
}
__device__ __forceinline__ float sigmoidf_(float x) { return 1.f / (1.f + __expf(-x)); }

__device__ __forceinline__ void p0_transpose_item(const float* W, int K, int N, bf16* WT, int row_off, LAS float* scr, int item, int lane) {
    const int nblk = N / 32, kb = item / nblk, nb = item % nblk, k0 = 64 * kb, n0 = 32 * nb;
#pragma unroll 8
    for (int i = 0; i < 32; ++i) { const int kk = 2 * i + (lane >> 5); scr[kk * 33 + (lane & 31)] = W[(size_t)(k0 + kk) * N + n0 + (lane & 31)]; }
    LDS_WAIT(); asm volatile("" ::: "memory");
    const int c = lane & 7;
#pragma unroll
    for (int j = 0; j < 4; ++j) { const int n = (lane >> 3) + 8 * j; const LAS float* s = scr + (8 * c) * 33 + n;
        v4u o; o.x = pk2(s[0 * 33], s[1 * 33]); o.y = pk2(s[2 * 33], s[3 * 33]); o.z = pk2(s[4 * 33], s[5 * 33]); o.w = pk2(s[6 * 33], s[7 * 33]);
        *(GAS v4u*)(WT + (size_t)(row_off + n0 + n) * K + k0 + 8 * c) = o; }
    LDS_WAIT(); asm volatile("" ::: "memory");
}

__device__ __forceinline__ void quant_vals_fp8(const f32x4 (&v)[4], unsigned char* dst, float* dq, int lane, size_t slice_stride) {
    float mx = 0.f;
#pragma unroll
    for (int j = 0; j < 4; ++j) mx = fmaxf(mx, fmaxf(fmaxf(fabsf(v[j].x), fabsf(v[j].y)), fmaxf(fabsf(v[j].z), fabsf(v[j].w))));
#pragma unroll
    for (int o = 1; o < 64; o <<= 1) mx = fmaxf(mx, __shfl_xor(mx, o));
    const float qs = mx > 0.f ? 224.f / mx : 1.f;
#pragma unroll
    for (int j = 0; j < 4; ++j) { int p = __builtin_amdgcn_cvt_pk_fp8_f32(v[j].x * qs, v[j].y * qs, 0, false); p = __builtin_amdgcn_cvt_pk_fp8_f32(v[j].z * qs, v[j].w * qs, p, true);
        const int d = 4 * lane + 256 * j; *(GAS unsigned*)(dst + (slice_stride ? (size_t)(d >> 7) * slice_stride + (d & 127) : (size_t)d)) = (unsigned)p; }
    if (lane == 0) *dq = mx > 0.f ? mx * (1.f / 224.f) : 1.f;
}
__device__ __forceinline__ void quant_row_fp4(const float* src, unsigned char* dst, float* dq, int lane, size_t slice_stride) {
    const GAS f32x4* xr = (const GAS f32x4*)src + lane; f32x4 v[4];
#pragma unroll
    for (int j = 0; j < 4; ++j) v[j] = xr[64 * j];
    float mx = 0.f;
#pragma unroll
    for (int j = 0; j < 4; ++j) mx = fmaxf(mx, fmaxf(fmaxf(fabsf(v[j].x), fabsf(v[j].y)), fmaxf(fabsf(v[j].z), fabsf(v[j].w))));
#pragma unroll
    for (int o = 1; o < 64; o <<= 1) mx = fmaxf(mx, __shfl_xor(mx, o));
    const float qs = mx > 0.f ? 6.f / mx : 1.f;
#pragma unroll
    for (int j = 0; j < 4; ++j) { unsigned r = 0u;
        r = __builtin_amdgcn_cvt_scalef32_pk_fp4_f32(r, v[j].x * qs, v[j].y * qs, 1.0f, 0); r = __builtin_amdgcn_cvt_scalef32_pk_fp4_f32(r, v[j].z * qs, v[j].w * qs, 1.0f, 1);
        *(GAS unsigned short*)(dst + (size_t)j * slice_stride + 2 * lane) = (unsigned short)r; }
    if (lane == 0) *dq = mx > 0.f ? mx * (1.f / 6.f) : 1.f;
}
__device__ __forceinline__ void quant_row_fp8(const float* src, unsigned char* dst, float* dq, int lane, size_t slice_stride) {
    const GAS f32x4* xr = (const GAS f32x4*)src + lane; f32x4 v[4];
#pragma unroll
    for (int j = 0; j < 4; ++j) v[j] = xr[64 * j];
    quant_vals_fp8(v, dst, dq, lane, slice_stride);
}
__device__ __forceinline__ void p0_prologue(Frame& F) {
    LAS float* scr = (LAS float*)(F.lds + RING_OFF + F.wave * 16384);
    const int gw = F.vcu * NWAVES + F.wave, NGW = F.G * NWAVES;
    bf16* WinT = (bf16*)(F.ws + WS_WIN); bf16* WoutT = (bf16*)(F.ws + WS_WOUT); bf16* W2T = (bf16*)(F.ws + WS_W2);
    float* small = (float*)(F.ws + WS_SMALL);
    if (blockIdx.x == 0) {
        const int t = F.tid;
        { const float l0 = F.in[9][t], l1 = F.in[9][512 + t]; small[SM_LB + t] = 1.f / (1.f + expf(l1 - l0)); }
        { const int h = t >> 7, n = t & 127; int bk;
          if (n < 16) bk = n; else { bk = 16 + (int)(logf((float)n * (1.f / 16.f)) / logf(8.f) * 16.f); bk = bk > 31 ? 31 : bk; }
          small[SM_BIAS + t] = F.in[8][bk * 4 + h] * 1.4426950408889634f; }
        if (F.wave == 0) {
            const float a = wave_sum(F.in[3][F.lane] * F.in[4][F.lane]), b = wave_sum(F.in[5][F.lane] * F.in[6][F.lane]);
            if (F.lane == 0) small[SM_LAM] = expf(a) - expf(b) + LAM_INIT;
        }
    }
    constexpr int I_IN = (DM / 64) * (INW / 32), I_OUT = (DM / 64) * (DM / 32);
    for (int it = gw; it < I_IN + I_OUT; it += NGW) {
        if (it < I_IN) p0_transpose_item(F.in[2], DM, INW, WinT, 0, scr, it, F.lane);
        else p0_transpose_item(F.in[11], DM, DM, WoutT, 0, scr, it - I_IN, F.lane);
    }
    for (int u = F.vcu; u < 256; u += F.G) {
        const int hc = u >> 4, kb = u & 15, k = kb * 64 + F.lane;
        const GAS f32x4* wrow = (const GAS f32x4*)(F.in[13] + (size_t)k * 2048 + hc * 128);
        float a[16];
#pragma unroll
        for (int nn = 0; nn < 16; ++nn) a[nn] = 0.f;
        const float* kr = F.in[14] + ((size_t)hc * 128 + F.wave * 16) * 128;
        for (int i = 0; i < 32; ++i) {
            const f32x4 w = wrow[i];
#pragma unroll
            for (int nn = 0; nn < 16; ++nn) { const float* kk = kr + nn * 128 + 4 * i; a[nn] += (kk[0] * w.x + kk[1] * w.y) + (kk[2] * w.z + kk[3] * w.w); }
        }
        const float g2k = F.in[12][k];
#pragma unroll
        for (int nn = 0; nn < 16; ++nn) W2T[((size_t)hc * 128 + F.wave * 16 + nn) * DM + k] = (bf16)f2bf(a[nn] * g2k);
    }
    bf16* HN = (bf16*)(F.ws + WS_HN);
    for (int m = gw; m < NTOK; m += 2 * NGW) {
        const int m2 = m + NGW;
        const GAS f32x4* xa = (const GAS f32x4*)(F.in[0] + (size_t)m * DM) + F.lane; const GAS f32x4* xb = (const GAS f32x4*)(F.in[0] + (size_t)(m2 < NTOK ? m2 : m) * DM) + F.lane;
        const GAS f32x4* gr = (const GAS f32x4*)F.in[1] + F.lane;
        f32x4 va[4], vb[4]; float sa = 0.f, sb = 0.f;
#pragma unroll
        for (int j = 0; j < 4; ++j) { va[j] = xa[64 * j]; vb[j] = xb[64 * j]; }
#pragma unroll
        for (int j = 0; j < 4; ++j) { sa += (va[j].x * va[j].x + va[j].y * va[j].y) + (va[j].z * va[j].z + va[j].w * va[j].w); sb += (vb[j].x * vb[j].x + vb[j].y * vb[j].y) + (vb[j].z * vb[j].z + vb[j].w * vb[j].w); }
#pragma unroll
        for (int o = 1; o < 64; o <<= 1) { sa += __shfl_xor(sa, o); sb += __shfl_xor(sb, o); }
        const float ra = 1.f / sqrtf(sa * (1.f / DM) + EPS), rb = 1.f / sqrtf(sb * (1.f / DM) + EPS);
        GAS unsigned long long* oa = (GAS unsigned long long*)(HN + (size_t)m * DM) + F.lane; GAS unsigned long long* ob = (GAS unsigned long long*)(HN + (size_t)m2 * DM) + F.lane;
#pragma unroll
        for (int j = 0; j < 4; ++j) { const f32x4 gg = gr[64 * j];
            oa[64 * j] = (unsigned long long)pk2(va[j].x * ra * gg.x, va[j].y * ra * gg.y) | ((unsigned long long)pk2(va[j].z * ra * gg.z, va[j].w * ra * gg.w) << 32);
            if (m2 < NTOK) ob[64 * j] = (unsigned long long)pk2(vb[j].x * rb * gg.x, vb[j].y * rb * gg.y) | ((unsigned long long)pk2(vb[j].z * rb * gg.z, vb[j].w * rb * gg.w) << 32); }
    }
}


constexpr int QCHUNKS = 2 * 16384 / 64;
__device__ __forceinline__ void quant_chunk(Frame& F, int c) {
    unsigned char* U8 = F.ws + WS_U8; unsigned char* V8 = F.ws + WS_V8; float* SU = (float*)(F.ws + WS_SU); float* SV = (float*)(F.ws + WS_SV);
#pragma unroll 1
    for (int k = 0; k < 8; ++k) { const int rr = 64 * c + 8 * F.wave + k;
        if (rr < 16384) quant_row_fp4(F.in[15] + (size_t)rr * DM, U8 + (size_t)rr * 128, SU + rr, F.lane, (size_t)16384 * 128);
        else { const int e = rr - 16384; quant_row_fp8(F.in[16] + (size_t)e * DM, V8 + (size_t)e * 128, SV + e, F.lane, (size_t)16384 * 128); } }
}

__device__ __forceinline__ void quant_drain(Frame& F) {
    unsigned* qctr = (unsigned*)(F.ws + WS_CTL) + CW_ATTQ + 128;
    if (F.tid == 0) F.MISC[13] = __hip_atomic_fetch_add(qctr, 1u, __ATOMIC_RELAXED, __HIP_MEMORY_SCOPE_AGENT);
    for (int it = 0;; ++it) {
        __syncthreads();
        const int qc = (int)F.MISC[13 + (it & 1)];
        if (qc >= QCHUNKS) break;
        unsigned nx = 0u;
        if (F.tid == 0) nx = __hip_atomic_fetch_add(qctr, 1u, __ATOMIC_RELAXED, __HIP_MEMORY_SCOPE_AGENT);
        quant_chunk(F, qc);
        if (F.tid == 0) F.MISC[13 + ((it + 1) & 1)] = nx;
    }
}

typedef float f32x16 __attribute__((ext_vector_type(16)));
typedef short s16x4 __attribute__((ext_vector_type(4)));
typedef short v4i16_t __attribute__((ext_vector_type(4)));
typedef float f32x2_t __attribute__((ext_vector_type(2))); typedef __bf16 bf16x2_t __attribute__((ext_vector_type(2)));
__device__ __forceinline__ unsigned cvtpk_bf16(float lo, float hi) { f32x2_t v = {lo, hi}; bf16x2_t b = __builtin_convertvector(v, bf16x2_t); return __builtin_bit_cast(unsigned, b); }
__device__ __forceinline__ float xhalf_max(float v) { return fmaxf(v, __shfl_xor(v, 32)); }
__device__ __forceinline__ float xhalf_sum(float v) { return v + __shfl_xor(v, 32); }
__device__ __forceinline__ float max3f_(float a, float b, float c) { float r; asm("v_max3_f32 %0, %1, %2, %3" : "=v"(r) : "v"(a), "v"(b), "v"(c)); return r; }
constexpr int AT_KP = 144, AT_VP = 320, AT_K1 = 64 * AT_KP, AT_KS = 2 * AT_K1, AT_V0 = 2 * AT_KS, AT_VS = 64 * AT_VP;
constexpr int AT_XO = 0, AT_YB = 65536, AT_YP = 272, AT_Q = 100864, AT_TAB = AT_Q + 8 * 4096;
static_assert(AT_TAB + 320 * 4 <= RING_BYTES && AT_YB + 4 * 32 * AT_YP <= AT_Q && AT_V0 + 3 * AT_VS <= AT_Q, "attention LDS map");
#define AT_MFMA(a, b, c) __builtin_amdgcn_mfma_f32_32x32x16_bf16(a, b, c, 0, 0, 0)
#define AT_SGB(mask, n) __builtin_amdgcn_sched_group_barrier(mask, n, 0)
__device__ __forceinline__ void attn_mfma(Frame& F, int qslot) {
    const bf16* PROJ = (const bf16*)(F.ws + WS_PROJ); bf16* MIXED = (bf16*)(F.ws + WS_HN);
    const float* small = (const float*)(F.ws + WS_SMALL);
    LAS unsigned char* lds = F.lds;
    LAS float* TAB = (LAS float*)(lds + AT_TAB);
    const int tid = F.tid, lane = F.lane, wave = F.wave, map = wave >> 2, qt = wave & 3, r32 = lane & 31, hi = lane >> 5;
    const int koff = map * AT_K1 + r32 * AT_KP + hi * 16;
    const int voff = AT_V0 + (4 * hi + ((lane & 15) >> 2)) * AT_VP + (16 * ((lane >> 4) & 1) + 4 * (lane & 3)) * 2;
    unsigned* qctr = (unsigned*)(F.ws + WS_CTL) + CW_ATTQ + 64 * qslot;
    if (tid == 0) F.MISC[12] = __hip_atomic_fetch_add(qctr, 1u, __ATOMIC_RELAXED, __HIP_MEMORY_SCOPE_AGENT);
    for (;;) {
        __syncthreads();
        const int L = (int)F.MISC[12];
        if (L >= 1024) break;
        unsigned nxtu = 0u;
        if (tid == 0) nxtu = __hip_atomic_fetch_add(qctr, 1u, __ATOMIC_RELAXED, __HIP_MEMORY_SCOPE_AGENT);
        const int qb = 15 - (L >> 6), bh = L & 63;
        const int b = bh >> 2, h = bh & 3, q0 = qb * 128; const size_t tok0 = (size_t)b * SEQ;
        const int NT = (q0 + 128) / 64;
        int tidu = F.tid; asm volatile("" : "+v"(tidu));
        if (tidu < 320) { const int n = tidu - 96; TAB[tidu] = n < 0 ? -INFINITY : small[SM_BIAS + h * 128 + (n > 127 ? 127 : n)]; }
        bf16x8 qf0, qf1, qf2, qf3;
        { const bf16* qrow = PROJ + (tok0 + q0 + 32 * qt + r32) * INW + C_DQ + h * 128 + map * 64 + 8 * hi;
          qf0 = *(const GAS bf16x8*)(qrow); qf1 = *(const GAS bf16x8*)(qrow + 16); qf2 = *(const GAS bf16x8*)(qrow + 32); qf3 = *(const GAS bf16x8*)(qrow + 48); }
        const unsigned char* projb = (const unsigned char*)PROJ;
        const unsigned ksrc = (unsigned)(((tok0 + (tidu >> 4)) * INW + C_DK + h * 128 + (tidu & 15) * 8) * 2), vsrc = ksrc + (C_DV - C_DK) * 2;
        const int kdst = ((tidu & 15) >> 3) * AT_K1 + (tidu >> 4) * AT_KP + (tidu & 7) * 16, vdst = AT_V0 + (tidu >> 4) * AT_VP + (tidu & 15) * 16;
#define AT_GLD(src, row) (*(const GAS v4u*)(projb + (size_t)((src) + (unsigned)((row) * (INW * 2)))))
        v4u kr[2], vr[2];
#pragma unroll
        for (int i = 0; i < 2; ++i) { kr[i] = AT_GLD(ksrc, 32 * i); vr[i] = AT_GLD(vsrc, 32 * i); }
#pragma unroll
        for (int i = 0; i < 2; ++i) { *(LAS v4u*)(lds + kdst + 32 * i * AT_KP) = kr[i]; *(LAS v4u*)(lds + vdst + 32 * i * AT_VP) = vr[i]; }
#pragma unroll
        for (int i = 0; i < 2; ++i) { kr[i] = AT_GLD(ksrc, 64 + 32 * i); vr[i] = AT_GLD(vsrc, 64 + 32 * i); }
        __syncthreads();
        const float bfar = TAB[96 + 127];
        f32x16 o[4];
#pragma unroll
        for (int mt = 0; mt < 4; ++mt) o[mt] = (f32x16){0.f,0.f,0.f,0.f,0.f,0.f,0.f,0.f,0.f,0.f,0.f,0.f,0.f,0.f,0.f,0.f};
        float mrun = -INFINITY, lsum = 0.f, alpha = 1.f, cexp = 0.f; bool resc = false;
        const int qlo = q0 + 32 * qt, qpos = qlo + r32;
        const int NTW = NT - 1 + (qt >> 1);
        f32x16 pA0, pA1, pB0, pB1;
        int vs_prev = 0, vs_cur = 0, vs_next = AT_VS;
#define AT_ROT() do { vs_prev = vs_cur; vs_cur = vs_next; vs_next = (vs_next == 2 * AT_VS) ? 0 : vs_next + AT_VS; } while (0)
#define AT_Z16 (f32x16){0.f,0.f,0.f,0.f,0.f,0.f,0.f,0.f,0.f,0.f,0.f,0.f,0.f,0.f,0.f,0.f}
#define AT_SBAR() __builtin_amdgcn_sched_barrier(0)
#define AT_PIN(x) asm volatile("" : "+v"(x))
        bf16x8 kAa, kAb, kBa, kBb; s16x4 f0l, f0h, f1l, f1h;
#define AT_KRD2(S, KB, s4) do { k##S##a = *(const LAS bf16x8*)(lds + (KB) + koff + 32 * (s4)); k##S##b = *(const LAS bf16x8*)(lds + (KB) + koff + 32 * AT_KP + 32 * (s4)); } while (0)
#define AT_VRD(Fn, g) do { LAS unsigned char* vp_ = vb_ + (32 * ((g) >> 3) + 16 * (((g) >> 2) & 1)) * AT_VP + 64 * ((g) & 3); \
            Fn##l = __builtin_bit_cast(s16x4, __builtin_amdgcn_ds_read_tr16_b64_v4i16((LAS v4i16_t*)vp_)); Fn##h = __builtin_bit_cast(s16x4, __builtin_amdgcn_ds_read_tr16_b64_v4i16((LAS v4i16_t*)(vp_ + 8 * AT_VP))); } while (0)
#define AT_VFR(Fn) (bf16x8){Fn##l[0], Fn##l[1], Fn##l[2], Fn##l[3], Fn##h[0], Fn##h[1], Fn##h[2], Fn##h[3]}
#define AT_GAPA(MF, RD, FILL, P, g, PK) do { MF; RD; \
            if (FILL) { const float e0_ = P[4 * ((g) & 3)], e1_ = P[4 * ((g) & 3) + 1], e2_ = P[4 * ((g) & 3) + 2], e3_ = P[4 * ((g) & 3) + 3]; \
                sacc_ += e0_; sacc_ += e1_; sacc_ += e2_; sacc_ += e3_; \
                PK[2 * (g)] = __builtin_bit_cast(float, cvtpk_bf16(e0_, e1_)); PK[2 * (g) + 1] = __builtin_bit_cast(float, cvtpk_bf16(e2_, e3_)); AT_PIN(PK); AT_PIN(sacc_); } \
            AT_SBAR(); } while (0)
#define AT_PHASE_A(C0, C1, P0, P1, KB, FILL) do { float sacc_ = 0.f; \
            AT_SBAR(); AT_KRD2(A, KB, 0); AT_SBAR(); \
            AT_GAPA(C0 = AT_MFMA(kAa, qf0, AT_Z16), AT_KRD2(B, KB, 1), FILL, P0, 0, P0); \
            AT_GAPA(C1 = AT_MFMA(kAb, qf0, AT_Z16), (void)0,           FILL, P0, 1, P0); \
            AT_GAPA(C0 = AT_MFMA(kBa, qf1, C0),     AT_KRD2(A, KB, 2), FILL, P0, 2, P0); \
            AT_GAPA(C1 = AT_MFMA(kBb, qf1, C1),     (void)0,           FILL, P0, 3, P0); \
            AT_GAPA(C0 = AT_MFMA(kAa, qf2, C0),     AT_KRD2(B, KB, 3), FILL, P1, 4, P0); \
            AT_GAPA(C1 = AT_MFMA(kAb, qf2, C1),     (void)0,           FILL, P1, 5, P0); \
            AT_GAPA(C0 = AT_MFMA(kBa, qf3, C0),     (void)0,           FILL, P1, 6, P0); \
            AT_GAPA(C1 = AT_MFMA(kBb, qf3, C1),     (void)0,           FILL, P1, 7, P0); \
            lsum += sacc_; } while (0)
#define AT_MID(C0, C1, t) do { float tm, cadd; \
            if (qlo - (64 * (t) + 63) < 127) { \
                const LAS float* rp = TAB + (qpos - 64 * (t) - 4 * hi + 96 - 59); tm = -INFINITY; \
                _Pragma("unroll") for (int r = 0; r < 16; ++r) { const int off = (r & 3) + 8 * (r >> 2); C0[r] += rp[59 - off]; C1[r] += rp[27 - off]; tm = max3f_(tm, C0[r], C1[r]); } \
                cadd = 0.f; \
            } else { \
                tm = max3f_(C0[0], C1[0], C0[1]); \
                _Pragma("unroll") for (int r = 1; r < 15; ++r) tm = max3f_(tm, C1[r], C0[r + 1]); \
                tm = fmaxf(tm, C1[15]); tm += bfar; cadd = bfar; } \
            tm = xhalf_max(tm); resc = false; \
            if (__any(tm > mrun + 8.f)) { const float mnew = fmaxf(mrun, tm); alpha = __builtin_amdgcn_exp2f(mrun - mnew); lsum *= alpha; mrun = mnew; resc = true; } \
            cexp = cadd - mrun; } while (0)
#define AT_EXP(C0, C1) do { _Pragma("unroll") for (int r = 0; r < 16; ++r) { C0[r] = __builtin_amdgcn_exp2f(C0[r] + cexp); C1[r] = __builtin_amdgcn_exp2f(C1[r] + cexp); } } while (0)
#define AT_GAPB(Fn, g, PK, C, DOEXP) do { o[(g) & 3] = AT_MFMA(AT_VFR(Fn), __builtin_bit_cast(bf16x8, (f32x4){PK[4 * ((g) >> 2)], PK[4 * ((g) >> 2) + 1], PK[4 * ((g) >> 2) + 2], PK[4 * ((g) >> 2) + 3]}), o[(g) & 3]); \
            if ((g) + 2 < 16) AT_VRD(Fn, (g) + 2); \
            if (DOEXP) { C[2 * ((g) & 7)] = __builtin_amdgcn_exp2f(C[2 * ((g) & 7)] + cexp); C[2 * ((g) & 7) + 1] = __builtin_amdgcn_exp2f(C[2 * ((g) & 7) + 1] + cexp); AT_PIN(C); } \
            AT_SBAR(); } while (0)
#define AT_PHASE_B(C0, C1, PK, VB, DOEXP) do { LAS unsigned char* vb_ = lds + (VB) + voff; \
            AT_SBAR(); AT_VRD(f0, 0); AT_VRD(f1, 1); AT_SBAR(); \
            AT_GAPB(f0, 0, PK, C0, DOEXP);  AT_GAPB(f1, 1, PK, C0, DOEXP);  AT_GAPB(f0, 2, PK, C0, DOEXP);  AT_GAPB(f1, 3, PK, C0, DOEXP); \
            AT_GAPB(f0, 4, PK, C0, DOEXP);  AT_GAPB(f1, 5, PK, C0, DOEXP);  AT_GAPB(f0, 6, PK, C0, DOEXP);  AT_GAPB(f1, 7, PK, C0, DOEXP); \
            AT_GAPB(f0, 8, PK, C1, DOEXP);  AT_GAPB(f1, 9, PK, C1, DOEXP);  AT_GAPB(f0, 10, PK, C1, DOEXP); AT_GAPB(f1, 11, PK, C1, DOEXP); \
            AT_GAPB(f0, 12, PK, C1, DOEXP); AT_GAPB(f1, 13, PK, C1, DOEXP); AT_GAPB(f0, 14, PK, C1, DOEXP); AT_GAPB(f1, 15, PK, C1, DOEXP); } while (0)
#define AT_RESC() do { if (resc) { _Pragma("unroll") for (int mt = 0; mt < 4; ++mt) o[mt] = o[mt] * alpha; } } while (0)
#define AT_STAGE(t) do { if ((t) + 1 < NT) { \
                _Pragma("unroll") for (int i = 0; i < 2; ++i) { *(LAS v4u*)(lds + (((t) + 1) & 1) * AT_KS + kdst + 32 * i * AT_KP) = kr[i]; *(LAS v4u*)(lds + vs_next + vdst + 32 * i * AT_VP) = vr[i]; } \
                if ((t) + 2 < NT) { _Pragma("unroll") for (int i = 0; i < 2; ++i) { kr[i] = AT_GLD(ksrc, 64 * ((t) + 2) + 32 * i); vr[i] = AT_GLD(vsrc, 64 * ((t) + 2) + 32 * i); } } } \
            __syncthreads(); AT_ROT(); } while (0)
#define AT_STEP(C0, C1, P0, P1, t) do { \
            AT_PHASE_A(C0, C1, P0, P1, ((t) & 1) * AT_KS, 1); \
            AT_MID(C0, C1, t); \
            AT_PHASE_B(C0, C1, P0, vs_prev, 1); \
            AT_RESC(); } while (0)
#define AT_PACK(P0, P1) do { float ps_ = 0.f; \
            _Pragma("unroll") for (int r = 0; r < 16; ++r) ps_ += P0[r] + P1[r]; \
            lsum += ps_; \
            _Pragma("unroll") for (int w = 0; w < 8; ++w) { const float lo_ = P0[2 * w], hi_ = P0[2 * w + 1]; P0[w] = __builtin_bit_cast(float, cvtpk_bf16(lo_, hi_)); } \
            _Pragma("unroll") for (int w = 0; w < 8; ++w) P0[8 + w] = __builtin_bit_cast(float, cvtpk_bf16(P1[2 * w], P1[2 * w + 1])); } while (0)
        AT_PHASE_A(pA0, pA1, pA0, pA1, 0, 0); AT_MID(pA0, pA1, 0); AT_EXP(pA0, pA1); AT_RESC();
        AT_STAGE(0);
        if (tid == 0) F.MISC[12] = nxtu;
        int t = 1;
        for (; t + 1 < NT; t += 2) {
            AT_STEP(pB0, pB1, pA0, pA1, t);     AT_STAGE(t);
            AT_STEP(pA0, pA1, pB0, pB1, t + 1); AT_STAGE(t + 1);
        }
        if (NTW == NT) {
            AT_STEP(pB0, pB1, pA0, pA1, t); AT_ROT();
            AT_PACK(pB0, pB1); AT_PHASE_B(pB0, pB1, pB0, vs_prev, 0);
        } else {
            AT_PACK(pA0, pA1); AT_PHASE_B(pA0, pA1, pA0, vs_prev, 0);
        }
        __syncthreads();
        { int lane_e = F.lane; asm volatile("" : "+v"(lane_e));
        const int lane = lane_e, r32 = lane & 31, hi = lane >> 5;
        const float inv = 1.f / xhalf_sum(lsum);
        LAS float* XO = (LAS float*)(lds + AT_XO) + qt * 4096 + r32;
        if (map == 1) {
            const float sc = inv * small[SM_LAM];
#pragma unroll
            for (int mt = 0; mt < 4; ++mt)
#pragma unroll
                for (int r = 0; r < 16; ++r) XO[(32 * mt + (r & 3) + 8 * (r >> 2) + 4 * hi) * 32] = o[mt][r] * sc;
        }
        __syncthreads();
        if (map == 0) {
            float ss = 0.f;
#pragma unroll
            for (int mt = 0; mt < 4; ++mt)
#pragma unroll
                for (int r = 0; r < 16; ++r) { const float a = o[mt][r] * inv - XO[(32 * mt + (r & 3) + 8 * (r >> 2) + 4 * hi) * 32]; o[mt][r] = a; ss += a * a; }
            ss = xhalf_sum(ss);
            const float rr = (1.f - LAM_INIT) / sqrtf(ss * (1.f / 128.f) + EPS);
            LAS unsigned char* yb = lds + AT_YB + qt * (32 * AT_YP);
#pragma unroll
            for (int mt = 0; mt < 4; ++mt)
#pragma unroll
                for (int r4 = 0; r4 < 4; ++r4) { const int dv = 32 * mt + 8 * r4 + 4 * hi; const f32x4 gg = *(const GAS f32x4*)(F.in[7] + dv);
                    v2u w; w.x = cvtpk_bf16(o[mt][4 * r4] * rr * gg.x, o[mt][4 * r4 + 1] * rr * gg.y); w.y = cvtpk_bf16(o[mt][4 * r4 + 2] * rr * gg.z, o[mt][4 * r4 + 3] * rr * gg.w);
                    *(LAS v2u*)(yb + r32 * AT_YP + dv * 2) = w; }
            LDS_WAIT(); asm volatile("" ::: "memory");
            bf16* obase = MIXED + (tok0 + q0 + 32 * qt) * DM + h * 128;
#pragma unroll
            for (int i = 0; i < 8; ++i) { const int id = lane + 64 * i, row = id >> 4, cch = id & 15;
                const v4u w = *(const LAS v4u*)(yb + row * AT_YP + cch * 16); *(GAS v4u*)(obase + (size_t)row * DM + cch * 8) = w; }
        } }
#undef AT_ROT
#undef AT_GLD
#undef AT_KRD2
#undef AT_VRD
#undef AT_VFR
#undef AT_GAPA
#undef AT_GAPB
#undef AT_PHASE_A
#undef AT_PHASE_B
#undef AT_PACK
#undef AT_MID
#undef AT_EXP
#undef AT_RESC
#undef AT_STAGE
#undef AT_STEP
    }
}

constexpr int HG_P = 288, HG_VP = 320, HG_GP = 272, HG_OP = 136;
constexpr int HG_QD = 0, HG_KI = 32 * HG_P, HG_V = 2 * 32 * HG_P, HG_CD = HG_V + 32 * HG_VP, HG_G = HG_CD + 512, HG_BUF = HG_G + 32 * HG_GP;
constexpr int HG_O = 2 * HG_BUF;
static_assert(HG_O + 32 * HG_OP * 4 <= RING_BYTES, "hgrn LDS map");
__device__ __forceinline__ bf16x8 pack8(const f32x16& x, int s) {
    v4u p; p.x = cvtpk_bf16(x[8 * s], x[8 * s + 1]); p.y = cvtpk_bf16(x[8 * s + 2], x[8 * s + 3]); p.z = cvtpk_bf16(x[8 * s + 4], x[8 * s + 5]); p.w = cvtpk_bf16(x[8 * s + 6], x[8 * s + 7]);
    return __builtin_bit_cast(bf16x8, p);
}
__device__ __forceinline__ bf16x8 tr_pair(LAS unsigned char* p0, LAS unsigned char* p1) {
    const s16x4 lo = __builtin_bit_cast(s16x4, __builtin_amdgcn_ds_read_tr16_b64_v4i16((LAS v4i16_t*)p0));
    const s16x4 hi4 = __builtin_bit_cast(s16x4, __builtin_amdgcn_ds_read_tr16_b64_v4i16((LAS v4i16_t*)p1));
    return (bf16x8){lo[0], lo[1], lo[2], lo[3], hi4[0], hi4[1], hi4[2], hi4[3]};
}
#define DPPF_(x, ctrl) __builtin_bit_cast(float, __builtin_amdgcn_update_dpp(0, __builtin_bit_cast(int, (x)), (ctrl), 0xf, 0xf, true))
__device__ __forceinline__ void hg_prep8(LAS unsigned char* bufp, const v4u rq, const v4u rf, const f32x4 lbA, const f32x4 lbB, int pc, int dk8, int lane) {
    const float lbv[8] = {lbA.x, lbA.y, lbA.z, lbA.w, lbB.x, lbB.y, lbB.z, lbB.w};
    float bb[8], fv[8];
    const unsigned fw[4] = {rf.x, rf.y, rf.z, rf.w}, qw[4] = {rq.x, rq.y, rq.z, rq.w};
#pragma unroll
    for (int i = 0; i < 8; ++i) { const float x = (i & 1) ? bfhi(fw[i >> 1]) : bflo(fw[i >> 1]); const float f = lbv[i] + (1.f - lbv[i]) * __builtin_amdgcn_rcpf(1.f + __expf(-x)); fv[i] = f; bb[i] = f; }
#define HG_SCAN_STEP(ctrl) asm volatile("s_nop 1\n\tv_mul_f32_dpp %0, %0, %0 " ctrl "\n\tv_mul_f32_dpp %1, %1, %1 " ctrl "\n\tv_mul_f32_dpp %2, %2, %2 " ctrl "\n\tv_mul_f32_dpp %3, %3, %3 " ctrl "\n\t" \
        "v_mul_f32_dpp %4, %4, %4 " ctrl "\n\tv_mul_f32_dpp %5, %5, %5 " ctrl "\n\tv_mul_f32_dpp %6, %6, %6 " ctrl "\n\tv_mul_f32_dpp %7, %7, %7 " ctrl \
        : "+v"(bb[0]), "+v"(bb[1]), "+v"(bb[2]), "+v"(bb[3]), "+v"(bb[4]), "+v"(bb[5]), "+v"(bb[6]), "+v"(bb[7]))
    HG_SCAN_STEP("row_shr:1 row_mask:0xf bank_mask:0xf");
    HG_SCAN_STEP("row_shr:2 row_mask:0xf bank_mask:0xf");
    HG_SCAN_STEP("row_shr:4 row_mask:0xf bank_mask:0xf");
    HG_SCAN_STEP("row_shr:8 row_mask:0xf bank_mask:0xf");
    HG_SCAN_STEP("row_bcast:15 row_mask:0xa bank_mask:0xf");
#undef HG_SCAN_STEP
    float qd[8], ki[8];
#pragma unroll
    for (int i = 0; i < 8; ++i) { const float e = bb[i], ei = __builtin_amdgcn_rcpf(bb[i]);
        const float xq = (i & 1) ? bfhi(qw[i >> 1]) : bflo(qw[i >> 1]); const float q = xq * __builtin_amdgcn_rcpf(1.f + __expf(-xq)); const float k = 1.f - fv[i];
        qd[i] = q * e; ki[i] = k * ei; }
    *(LAS v4u*)(bufp + HG_QD + pc * HG_P + dk8 * 2) = (v4u){cvtpk_bf16(qd[0], qd[1]), cvtpk_bf16(qd[2], qd[3]), cvtpk_bf16(qd[4], qd[5]), cvtpk_bf16(qd[6], qd[7])};
    *(LAS v4u*)(bufp + HG_KI + pc * HG_P + dk8 * 2) = (v4u){cvtpk_bf16(ki[0], ki[1]), cvtpk_bf16(ki[2], ki[3]), cvtpk_bf16(ki[4], ki[5]), cvtpk_bf16(ki[6], ki[7])};
    if (pc == 31) { *(LAS f32x4*)(bufp + HG_CD + dk8 * 4) = (f32x4){bb[0], bb[1], bb[2], bb[3]}; *(LAS f32x4*)(bufp + HG_CD + dk8 * 4 + 16) = (f32x4){bb[4], bb[5], bb[6], bb[7]}; }
}
__device__ __forceinline__ void hgrn_mfma(Frame& F) {
    const bf16* PROJ = (const bf16*)(F.ws + WS_PROJ); bf16* MIXED = (bf16*)(F.ws + WS_HN);
    const float* small = (const float*)(F.ws + WS_SMALL);
    LAS unsigned char* lds = F.lds;
    const int tid = F.tid, lane = F.lane, wave = F.wave, r32 = lane & 31, hh = lane >> 5;
    for (int u = F.vcu; u < 64; u += F.G) {
        const int b = u >> 2, h = u & 3; const size_t tok0 = (size_t)b * SEQ;
        __syncthreads();
        if (wave >= 4) {
            const int pt = tid - 256, pc = lane & 31, dkA = 16 * (wave - 4) + 8 * hh;
            const int vcA = pt >> 4, vseg = pt & 15;
            const f32x4 lb0 = *(const GAS f32x4*)(small + SM_LB + h * 128 + dkA), lb1 = *(const GAS f32x4*)(small + SM_LB + h * 128 + dkA + 4);
            const f32x4 lb2 = *(const GAS f32x4*)(small + SM_LB + h * 128 + dkA + 64), lb3 = *(const GAS f32x4*)(small + SM_LB + h * 128 + dkA + 68);
            v4u q0A, f0A, v0A, g0A, q1A, f1A, v1A, g1A, q0B, f0B, v0B, g0B, q1B, f1B, v1B, g1B, q0C, f0C, v0C, g0C, q1C, f1C, v1C, g1C, q0D, f0D, v0D, g0D, q1D, f1D, v1D, g1D;
#define HP_LOAD(S, chn) do { const bf16* p_ = PROJ + (tok0 + 32 * (chn) + pc) * INW + h * 128 + dkA; const bf16* v_ = PROJ + (tok0 + 32 * (chn) + vcA) * INW + h * 128 + vseg * 8; \
            asm volatile("global_load_dwordx4 %0, %1, off" : "=v"(q0##S) : "v"(p_ + C_HQ) : "memory"); \
            asm volatile("global_load_dwordx4 %0, %1, off" : "=v"(f0##S) : "v"(p_ + C_HF) : "memory"); \
            asm volatile("global_load_dwordx4 %0, %1, off" : "=v"(v0##S) : "v"(v_ + C_HI) : "memory"); \
            asm volatile("global_load_dwordx4 %0, %1, off" : "=v"(g0##S) : "v"(v_ + C_HG) : "memory"); \
            asm volatile("global_load_dwordx4 %0, %1, off" : "=v"(q1##S) : "v"(p_ + C_HQ + 64) : "memory"); \
            asm volatile("global_load_dwordx4 %0, %1, off" : "=v"(f1##S) : "v"(p_ + C_HF + 64) : "memory"); \
            asm volatile("global_load_dwordx4 %0, %1, off" : "=v"(v1##S) : "v"(v_ + (size_t)16 * INW + C_HI) : "memory"); \
            asm volatile("global_load_dwordx4 %0, %1, off" : "=v"(g1##S) : "v"(v_ + (size_t)16 * INW + C_HG) : "memory"); } while (0)
#define HP_WAIT(S) asm volatile("s_waitcnt vmcnt(24)" : "+v"(q0##S), "+v"(f0##S), "+v"(v0##S), "+v"(g0##S), "+v"(q1##S), "+v"(f1##S), "+v"(v1##S), "+v"(g1##S) :: "memory")
#define HP_PASS0(S, bufp) do { hg_prep8(bufp, q0##S, f0##S, lb0, lb1, pc, dkA, lane); \
            *(LAS v4u*)((bufp) + HG_V + vcA * HG_VP + vseg * 16) = v0##S; *(LAS v4u*)((bufp) + HG_V + (vcA + 16) * HG_VP + vseg * 16) = v1##S; \
            *(LAS v4u*)((bufp) + HG_G + vcA * HG_GP + vseg * 16) = g0##S; *(LAS v4u*)((bufp) + HG_G + (vcA + 16) * HG_GP + vseg * 16) = g1##S; } while (0)
#define HP_PASS1(S, bufp) hg_prep8(bufp, q1##S, f1##S, lb2, lb3, pc, dkA + 64, lane)
#define HP_CL(c) ((c) < SEQ / 32 ? (c) : SEQ / 32 - 1)
            HP_LOAD(A, 0); HP_LOAD(B, 1); HP_LOAD(C, 2); HP_LOAD(D, 3);
            HP_WAIT(A); HP_PASS0(A, lds); HP_PASS1(A, lds);
            HP_LOAD(A, 4);
            for (int ch4 = 0; ch4 < SEQ / 32; ch4 += 4) {
                __syncthreads();
                HP_WAIT(B); HP_PASS0(B, lds + HG_BUF);
                __syncthreads();
                HP_PASS1(B, lds + HG_BUF); HP_LOAD(B, HP_CL(ch4 + 5));
                __syncthreads();
                HP_WAIT(C); HP_PASS0(C, lds);
                __syncthreads();
                HP_PASS1(C, lds); HP_LOAD(C, HP_CL(ch4 + 6));
                __syncthreads();
                HP_WAIT(D); HP_PASS0(D, lds + HG_BUF);
                __syncthreads();
                HP_PASS1(D, lds + HG_BUF); HP_LOAD(D, HP_CL(ch4 + 7));
                __syncthreads();
                HP_WAIT(A); HP_PASS0(A, lds);
                __syncthreads();
                HP_PASS1(A, lds); HP_LOAD(A, HP_CL(ch4 + 8));
            }
            asm volatile("s_waitcnt vmcnt(0)" : "+v"(q0A), "+v"(f0A), "+v"(v0A), "+v"(g0A), "+v"(q1A), "+v"(f1A), "+v"(v1A), "+v"(g1A), "+v"(q0B), "+v"(f0B), "+v"(v0B), "+v"(g0B), "+v"(q1B), "+v"(f1B), "+v"(v1B), "+v"(g1B) :: "memory");
            asm volatile("" : "+v"(q0C), "+v"(f0C), "+v"(v0C), "+v"(g0C), "+v"(q1C), "+v"(f1C), "+v"(v1C), "+v"(g1C), "+v"(q0D), "+v"(f0D), "+v"(v0D), "+v"(g0D), "+v"(q1D), "+v"(f1D), "+v"(v1D), "+v"(g1D) :: "memory");
#undef HP_CL
#undef HP_LOAD
#undef HP_WAIT
#undef HP_PASS0
#undef HP_PASS1
        } else {
            const int dvt = wave;
            const int kdoff = (((lane & 15) >> 2)) * HG_P + (16 * ((lane >> 4) & 1) + 4 * (lane & 3)) * 2;
            const int troff = (((lane & 15) >> 2)) * HG_VP + (32 * dvt + 16 * ((lane >> 4) & 1) + 4 * (lane & 3)) * 2;
            const int vc = tid >> 3, sg = tid & 7;
            const f32x4 ga0 = *(const GAS f32x4*)(F.in[10] + 8 * sg), ga1 = *(const GAS f32x4*)(F.in[10] + 8 * sg + 4);
            const f32x4 gb0 = *(const GAS f32x4*)(F.in[10] + 64 + 8 * sg), gb1 = *(const GAS f32x4*)(F.in[10] + 64 + 8 * sg + 4);
            f32x16 S0, S1, S2, S3;
#pragma unroll
            for (int r = 0; r < 16; ++r) { S0[r] = 0.f; S1[r] = 0.f; S2[r] = 0.f; S3[r] = 0.f; }
            for (int ch = 0; ch < SEQ / 32; ++ch) {
                LAS unsigned char* bufp = lds + (ch & 1) * HG_BUF;
                __syncthreads();
                f32x16 o, X;
#pragma unroll
                for (int r = 0; r < 16; ++r) { o[r] = 0.f; X[r] = 0.f; }
                bf16x8 qaf[8], kif[8], qdf[8];
                __builtin_amdgcn_sched_barrier(0);
#pragma unroll
                for (int i = 0; i < 8; ++i) { LAS unsigned char* qa = bufp + HG_QD + r32 * HG_P + (16 * i + 4 * hh) * 2;
                    const v2u a0 = *(const LAS v2u*)qa, a1 = *(const LAS v2u*)(qa + 16); qaf[i] = __builtin_bit_cast(bf16x8, (v4u){a0.x, a0.y, a1.x, a1.y}); }
#pragma unroll
                for (int s8 = 0; s8 < 4; ++s8) { kif[s8] = *(const LAS bf16x8*)(bufp + HG_KI + r32 * HG_P + (16 * s8 + 8 * hh) * 2); qdf[s8] = *(const LAS bf16x8*)(bufp + HG_QD + r32 * HG_P + (16 * s8 + 8 * hh) * 2); }
                __builtin_amdgcn_sched_barrier(0);
#pragma unroll
                for (int i = 0; i < 8; ++i)
                    o = __builtin_amdgcn_mfma_f32_32x32x16_bf16(qaf[i], pack8((i >> 1) == 0 ? S0 : (i >> 1) == 1 ? S1 : (i >> 1) == 2 ? S2 : S3, i & 1), o, 0, 0, 0);
#pragma unroll
                for (int s8 = 4; s8 < 8; ++s8) { kif[s8] = *(const LAS bf16x8*)(bufp + HG_KI + r32 * HG_P + (16 * s8 + 8 * hh) * 2); qdf[s8] = *(const LAS bf16x8*)(bufp + HG_QD + r32 * HG_P + (16 * s8 + 8 * hh) * 2); }
                bf16x8 vx0, vx1;
                { LAS unsigned char* vp = bufp + HG_V + troff + (4 * hh) * HG_VP; vx0 = tr_pair(vp, vp + 8 * HG_VP); vx1 = tr_pair(vp + 16 * HG_VP, vp + 24 * HG_VP); }
                __builtin_amdgcn_sched_barrier(0);
#pragma unroll
                for (int s8 = 0; s8 < 8; ++s8) X = __builtin_amdgcn_mfma_f32_32x32x16_bf16(kif[s8], qdf[s8], X, 0, 0, 0);
                __builtin_amdgcn_sched_barrier(0);
#pragma unroll
                for (int r = 0; r < 16; ++r) { const int cp = (r & 3) + 8 * (r >> 2) + 4 * hh; X[r] = cp > r32 ? 0.f : X[r]; }
                o = __builtin_amdgcn_mfma_f32_32x32x16_bf16(pack8(X, 0), vx0, o, 0, 0, 0);
                o = __builtin_amdgcn_mfma_f32_32x32x16_bf16(pack8(X, 1), vx1, o, 0, 0, 0);
                { LAS float* ob = (LAS float*)(lds + HG_O) + 32 * dvt + r32;
#pragma unroll
                  for (int r = 0; r < 16; ++r) ob[((r & 3) + 8 * (r >> 2) + 4 * hh) * HG_OP] = o[r]; }
                __syncthreads();
                { bf16x8 kaf[8], vbf[2];
                  __builtin_amdgcn_sched_barrier(0);
#pragma unroll
                  for (int s2 = 0; s2 < 2; ++s2) { LAS unsigned char* vp = bufp + HG_V + troff + (16 * s2 + 8 * hh) * HG_VP; vbf[s2] = tr_pair(vp, vp + 4 * HG_VP); }
#pragma unroll
                  for (int i = 0; i < 8; ++i) { LAS unsigned char* kp = bufp + HG_KI + kdoff + (16 * (i & 1) + 8 * hh) * HG_P + 32 * (i >> 1) * 2;
                      kaf[i] = tr_pair(kp, kp + 4 * HG_P); }
                  __builtin_amdgcn_sched_barrier(0);
#pragma unroll
                  for (int i = 0; i < 8; ++i) {
                      if ((i >> 1) == 0)      S0 = __builtin_amdgcn_mfma_f32_32x32x16_bf16(kaf[i], vbf[i & 1], S0, 0, 0, 0);
                      else if ((i >> 1) == 1) S1 = __builtin_amdgcn_mfma_f32_32x32x16_bf16(kaf[i], vbf[i & 1], S1, 0, 0, 0);
                      else if ((i >> 1) == 2) S2 = __builtin_amdgcn_mfma_f32_32x32x16_bf16(kaf[i], vbf[i & 1], S2, 0, 0, 0);
                      else                    S3 = __builtin_amdgcn_mfma_f32_32x32x16_bf16(kaf[i], vbf[i & 1], S3, 0, 0, 0);
                  }
                  __builtin_amdgcn_sched_barrier(0); }
#pragma unroll
                for (int kk = 0; kk < 4; ++kk) {
                    const LAS float* cdp = (const LAS float*)(bufp + HG_CD) + 32 * kk + 4 * hh;
#pragma unroll
                    for (int r4 = 0; r4 < 4; ++r4) { const f32x4 c4 = *(const LAS f32x4*)(cdp + 8 * r4);
                        if (kk == 0)      { S0[4 * r4] *= c4.x; S0[4 * r4 + 1] *= c4.y; S0[4 * r4 + 2] *= c4.z; S0[4 * r4 + 3] *= c4.w; }
                        else if (kk == 1) { S1[4 * r4] *= c4.x; S1[4 * r4 + 1] *= c4.y; S1[4 * r4 + 2] *= c4.z; S1[4 * r4 + 3] *= c4.w; }
                        else if (kk == 2) { S2[4 * r4] *= c4.x; S2[4 * r4 + 1] *= c4.y; S2[4 * r4 + 2] *= c4.z; S2[4 * r4 + 3] *= c4.w; }
                        else              { S3[4 * r4] *= c4.x; S3[4 * r4 + 1] *= c4.y; S3[4 * r4 + 2] *= c4.z; S3[4 * r4 + 3] *= c4.w; } }
                }
                { const LAS float* op = (const LAS float*)(lds + HG_O) + vc * HG_OP + 8 * sg;
                  const f32x4 x0 = *(const LAS f32x4*)op, x1 = *(const LAS f32x4*)(op + 4), x2 = *(const LAS f32x4*)(op + 64), x3 = *(const LAS f32x4*)(op + 68);
                  const v4u gwa = *(const LAS v4u*)(bufp + HG_G + vc * HG_GP + sg * 16), gwb = *(const LAS v4u*)(bufp + HG_G + vc * HG_GP + (sg + 8) * 16);
                  float ss = ((x0.x * x0.x + x0.y * x0.y) + (x0.z * x0.z + x0.w * x0.w)) + ((x1.x * x1.x + x1.y * x1.y) + (x1.z * x1.z + x1.w * x1.w))
                           + ((x2.x * x2.x + x2.y * x2.y) + (x2.z * x2.z + x2.w * x2.w)) + ((x3.x * x3.x + x3.y * x3.y) + (x3.z * x3.z + x3.w * x3.w));
                  ss += DPPF_(ss, 0xB1); ss += DPPF_(ss, 0x4E); ss += DPPF_(ss, 0x141);
                  const float rr = __builtin_amdgcn_rsqf(ss * (1.f / 128.f) + EPS);
                  const size_t tok = tok0 + 32 * ch + vc;
                  const unsigned gwa_[4] = {gwa.x, gwa.y, gwa.z, gwa.w}, gwb_[4] = {gwb.x, gwb.y, gwb.z, gwb.w};
                  const float ova[8] = {x0.x, x0.y, x0.z, x0.w, x1.x, x1.y, x1.z, x1.w}, ovb[8] = {x2.x, x2.y, x2.z, x2.w, x3.x, x3.y, x3.z, x3.w};
                  const float gga[8] = {ga0.x, ga0.y, ga0.z, ga0.w, ga1.x, ga1.y, ga1.z, ga1.w}, ggb[8] = {gb0.x, gb0.y, gb0.z, gb0.w, gb1.x, gb1.y, gb1.z, gb1.w};
                  unsigned wa[4], wb[4];
#pragma unroll
                  for (int j = 0; j < 4; ++j) { const float a0 = bflo(gwa_[j]), a1 = bfhi(gwa_[j]), b0 = bflo(gwb_[j]), b1 = bfhi(gwb_[j]);
                      wa[j] = cvtpk_bf16(ova[2 * j] * rr * gga[2 * j] * (a0 * __builtin_amdgcn_rcpf(1.f + __expf(-a0))), ova[2 * j + 1] * rr * gga[2 * j + 1] * (a1 * __builtin_amdgcn_rcpf(1.f + __expf(-a1))));
                      wb[j] = cvtpk_bf16(ovb[2 * j] * rr * ggb[2 * j] * (b0 * __builtin_amdgcn_rcpf(1.f + __expf(-b0))), ovb[2 * j + 1] * rr * ggb[2 * j + 1] * (b1 * __builtin_amdgcn_rcpf(1.f + __expf(-b1)))); }
                  bf16* dst = MIXED + tok * DM + 512 + h * 128 + 8 * sg;
                  *(GAS v4u*)dst = (v4u){wa[0], wa[1], wa[2], wa[3]}; *(GAS v4u*)(dst + 64) = (v4u){wb[0], wb[1], wb[2], wb[3]}; }
            }
        }
    }
}
template <int N> __device__ __forceinline__ unsigned row_ror(unsigned x) { return (unsigned)__builtin_amdgcn_update_dpp((int)x, (int)x, 0x120 + N, 0xf, 0xf, false); }
__device__ __forceinline__ unsigned umax_(unsigned a, unsigned b) { return a > b ? a : b; }
__device__ __forceinline__ unsigned umin_(unsigned a, unsigned b) { return a < b ? a : b; }
__device__ __forceinline__ unsigned row_umax16(unsigned x) {
    unsigned y;
    asm volatile("s_nop 1\n\tv_max_u32_dpp %0, %1, %1 row_ror:1 row_mask:0xf bank_mask:0xf\n\t"
                 "s_nop 1\n\tv_max_u32_dpp %0, %0, %0 row_ror:2 row_mask:0xf bank_mask:0xf\n\t"
                 "s_nop 1\n\tv_max_u32_dpp %0, %0, %0 row_ror:4 row_mask:0xf bank_mask:0xf\n\t"
                 "s_nop 1\n\tv_max_u32_dpp %0, %0, %0 row_ror:8 row_mask:0xf bank_mask:0xf"
                 : "=&v"(y) : "v"(x));
    return y;
}
__device__ __forceinline__ float row_fsum16(float v) {
    v += __builtin_bit_cast(float, row_ror<1>(__builtin_bit_cast(unsigned, v))); v += __builtin_bit_cast(float, row_ror<2>(__builtin_bit_cast(unsigned, v)));
    v += __builtin_bit_cast(float, row_ror<4>(__builtin_bit_cast(unsigned, v))); v += __builtin_bit_cast(float, row_ror<8>(__builtin_bit_cast(unsigned, v))); return v; }
__device__ __forceinline__ unsigned h2key(unsigned x) { return (x & 0x80000000u) ? (~x & 0xffff0000u) : (x | 0x80000000u); }
__device__ __forceinline__ float hkey2f(unsigned k) { const unsigned hb = ((k & 0x80000000u) ? (k & 0x7fff0000u) : (~k & 0xffff0000u)) >> 16; return (float)__builtin_bit_cast(_Float16, (unsigned short)hb); }
__device__ __forceinline__ unsigned f2key(float f) { const unsigned u = __builtin_bit_cast(unsigned, f); return (u & 0x80000000u) ? ~u : (u | 0x80000000u); }
__device__ __forceinline__ float key2f(unsigned k) { const unsigned u = (k & 0x80000000u) ? (k & 0x7fffffffu) : ~k; return __builtin_bit_cast(float, u); }
__device__ __forceinline__ unsigned pair_code(int s) {
    if (s < 16) return (unsigned)s;
    if (s < 24) return 16u + (unsigned)(s - 16);
    if (s < 29) return 32u + (unsigned)(s - 24);
    if (s < 33) return 48u + (unsigned)(s - 29);
    if (s < 36) return 64u + (unsigned)(s - 33);
    if (s < 42) return 80u + 16u * (unsigned)((s - 36) >> 1) + (unsigned)((s - 36) & 1);
    if (s < 50) return 128u + 16u * (unsigned)(s - 42);
    return 0xFFu;
}
#define CAS_(a, b) do { const unsigned hi_ = umax_(a, b), lo_ = umin_(a, b); a = hi_; b = lo_; } while (0)
__device__ __forceinline__ void row_umax16_x2(unsigned xa, unsigned xb, unsigned& ya, unsigned& yb) {
    asm volatile("s_nop 1\n\tv_max_u32_dpp %0, %2, %2 row_ror:1 row_mask:0xf bank_mask:0xf\n\tv_max_u32_dpp %1, %3, %3 row_ror:1 row_mask:0xf bank_mask:0xf\n\t"
                 "s_nop 0\n\tv_max_u32_dpp %0, %0, %0 row_ror:2 row_mask:0xf bank_mask:0xf\n\tv_max_u32_dpp %1, %1, %1 row_ror:2 row_mask:0xf bank_mask:0xf\n\t"
                 "s_nop 0\n\tv_max_u32_dpp %0, %0, %0 row_ror:4 row_mask:0xf bank_mask:0xf\n\tv_max_u32_dpp %1, %1, %1 row_ror:4 row_mask:0xf bank_mask:0xf\n\t"
                 "s_nop 0\n\tv_max_u32_dpp %0, %0, %0 row_ror:8 row_mask:0xf bank_mask:0xf\n\tv_max_u32_dpp %1, %1, %1 row_ror:8 row_mask:0xf bank_mask:0xf"
                 : "=&v"(ya), "=&v"(yb) : "v"(xa), "v"(xb));
}
__device__ __forceinline__ void row_umax16_x4(unsigned xa, unsigned xb, unsigned xc, unsigned xd, unsigned& ya, unsigned& yb, unsigned& yc, unsigned& yd) {
    asm volatile("s_nop 1\n\tv_max_u32_dpp %0, %4, %4 row_ror:1 row_mask:0xf bank_mask:0xf\n\tv_max_u32_dpp %1, %5, %5 row_ror:1 row_mask:0xf bank_mask:0xf\n\t"
                 "v_max_u32_dpp %2, %6, %6 row_ror:1 row_mask:0xf bank_mask:0xf\n\tv_max_u32_dpp %3, %7, %7 row_ror:1 row_mask:0xf bank_mask:0xf\n\t"
                 "v_max_u32_dpp %0, %0, %0 row_ror:2 row_mask:0xf bank_mask:0xf\n\tv_max_u32_dpp %1, %1, %1 row_ror:2 row_mask:0xf bank_mask:0xf\n\t"
                 "v_max_u32_dpp %2, %2, %2 row_ror:2 row_mask:0xf bank_mask:0xf\n\tv_max_u32_dpp %3, %3, %3 row_ror:2 row_mask:0xf bank_mask:0xf\n\t"
                 "v_max_u32_dpp %0, %0, %0 row_ror:4 row_mask:0xf bank_mask:0xf\n\tv_max_u32_dpp %1, %1, %1 row_ror:4 row_mask:0xf bank_mask:0xf\n\t"
                 "v_max_u32_dpp %2, %2, %2 row_ror:4 row_mask:0xf bank_mask:0xf\n\tv_max_u32_dpp %3, %3, %3 row_ror:4 row_mask:0xf bank_mask:0xf\n\t"
                 "v_max_u32_dpp %0, %0, %0 row_ror:8 row_mask:0xf bank_mask:0xf\n\tv_max_u32_dpp %1, %1, %1 row_ror:8 row_mask:0xf bank_mask:0xf\n\t"
                 "v_max_u32_dpp %2, %2, %2 row_ror:8 row_mask:0xf bank_mask:0xf\n\tv_max_u32_dpp %3, %3, %3 row_ror:8 row_mask:0xf bank_mask:0xf"
                 : "=&v"(ya), "=&v"(yb), "=&v"(yc), "=&v"(yd) : "v"(xa), "v"(xb), "v"(xc), "v"(xd));
}
#define TK_LOAD(th_) (*(const GAS v4u*)(SC + (size_t)((th_) >> 3) * 2048 + ((th_) & 7) * 256 + c * 128 + l15 * 8))
#define TK_LOADSORT(P, sv_) \
    unsigned P##0, P##1, P##2, P##3, P##4, P##5, P##6, P##7; \
    { const v4u sv = (sv_); const unsigned nb = 127u - 8u * (unsigned)l15; \
      P##0 = h2key(sv.x << 16) | nb; P##1 = h2key(sv.x & 0xffff0000u) | (nb - 1u); P##2 = h2key(sv.y << 16) | (nb - 2u); P##3 = h2key(sv.y & 0xffff0000u) | (nb - 3u); \
      P##4 = h2key(sv.z << 16) | (nb - 4u); P##5 = h2key(sv.z & 0xffff0000u) | (nb - 5u); P##6 = h2key(sv.w << 16) | (nb - 6u); P##7 = h2key(sv.w & 0xffff0000u) | (nb - 7u); \
      CAS_(P##0, P##1); CAS_(P##2, P##3); CAS_(P##4, P##5); CAS_(P##6, P##7); CAS_(P##0, P##2); CAS_(P##1, P##3); CAS_(P##4, P##6); CAS_(P##5, P##7); CAS_(P##1, P##2); CAS_(P##5, P##6); CAS_(P##0, P##4); CAS_(P##3, P##7); \
      CAS_(P##1, P##5); CAS_(P##2, P##6); CAS_(P##1, P##4); CAS_(P##3, P##6); CAS_(P##2, P##4); CAS_(P##3, P##5); CAS_(P##3, P##4); }
#define TK_POP(P, m_) do { const bool pop_ = (P##0 == (m_)); P##0 = pop_ ? P##1 : P##0; P##1 = pop_ ? P##2 : P##1; P##2 = pop_ ? P##3 : P##2; P##3 = pop_ ? P##4 : P##3; \
      P##4 = pop_ ? P##5 : P##4; P##5 = pop_ ? P##6 : P##5; P##6 = pop_ ? P##7 : P##6; P##7 = pop_ ? 0u : P##7; } while (0)
__device__ __forceinline__ void topk_stage1x2(const v4u svA, const v4u svB, int l15, unsigned& resA, unsigned& resB) {
    TK_LOADSORT(ka, svA) TK_LOADSORT(kb, svB)
    unsigned ra = 0u, rb = 0u;
#pragma unroll
    for (int r = 0; r < 16; ++r) {
        unsigned ma, mb; row_umax16_x2(ka0, kb0, ma, mb);
        TK_POP(ka, ma); TK_POP(kb, mb);
        ra = (l15 == r) ? ma : ra; rb = (l15 == r) ? mb : rb;
    }
    resA = ra; resB = rb;
}
__device__ __forceinline__ void topk_stage1x4(const v4u svA, const v4u svB, const v4u svC, const v4u svD, int l15, unsigned& resA, unsigned& resB, unsigned& resC, unsigned& resD) {
    TK_LOADSORT(ka, svA) TK_LOADSORT(kb, svB) TK_LOADSORT(kc, svC) TK_LOADSORT(kd, svD)
    unsigned ra = 0u, rb = 0u, rc = 0u, rd = 0u;
#pragma unroll
    for (int r = 0; r < 16; ++r) {
        unsigned ma, mb, mc, md; row_umax16_x4(ka0, kb0, kc0, kd0, ma, mb, mc, md);
        TK_POP(ka, ma); TK_POP(kb, mb); TK_POP(kc, mc); TK_POP(kd, md);
        ra = (l15 == r) ? ma : ra; rb = (l15 == r) ? mb : rb; rc = (l15 == r) ? mc : rc; rd = (l15 == r) ? md : rd;
    }
    resA = ra; resB = rb; resC = rc; resD = rd;
}
__device__ __forceinline__ void topk_v2(Frame& F) {
    const unsigned short* SC = (const unsigned short*)(F.ws + WS_SC); int* IDX = (int*)(F.ws + WS_IDX); float* GATE = (float*)(F.ws + WS_GATE); float* GSU = (float*)(F.ws + WS_GSU);
    const float* SU = (const float*)(F.ws + WS_SU); const float* SV = (const float*)(F.ws + WS_SV);
    const int gw = F.vcu * NWAVES + F.wave, NGW = F.G * NWAVES, lane = F.lane, l15 = lane & 15, row = lane >> 4, c = row & 1, rbase = lane & 48;
    const unsigned pc0 = pair_code(l15), pc1 = pair_code(l15 + 16), pc2 = pair_code(l15 + 32), pc3 = pair_code(l15 + 48);
    const int src1 = l15 + 32 * (row & 1), src2 = src1 + 16;
    for (int it0 = gw * 32; it0 < NTOK * 2; it0 += NGW * 32) {
    v4u svA = TK_LOAD(4 * it0 + (row >> 1)), svB = TK_LOAD(4 * it0 + 2 + (row >> 1)), svC = TK_LOAD(4 * it0 + 4 + (row >> 1)), svD = TK_LOAD(4 * it0 + 6 + (row >> 1));
    for (int it = it0; it < it0 + 32; it += 2) {
        const int thb = 4 * it; const int thn = 4 * (it + 2 < it0 + 32 ? it + 2 : it);
        const v4u nvA = TK_LOAD(thn + (row >> 1)), nvB = TK_LOAD(thn + 2 + (row >> 1)), nvC = TK_LOAD(thn + 4 + (row >> 1)), nvD = TK_LOAD(thn + 6 + (row >> 1));
        unsigned resA, resB, resC, resD; topk_stage1x4(svA, svB, svC, svD, l15, resA, resB, resC, resD); svA = nvA; svB = nvB; svC = nvC; svD = nvD;
#define TK_S12(RA_, RB_, S1_, S2_) const unsigned S1_##a = (unsigned)__shfl((int)RA_, src1), S2_##a = (unsigned)__shfl((int)RA_, src2), S1_##b = (unsigned)__shfl((int)RB_, src1), S2_##b = (unsigned)__shfl((int)RB_, src2); \
        const unsigned S1_ = row < 2 ? S1_##a : S1_##b, S2_ = row < 2 ? S2_##a : S2_##b
        TK_S12(resA, resB, S1x, S2x); TK_S12(resC, resD, S1y, S2y);
#undef TK_S12
        unsigned c0, c1, c2, c3, d0, d1, d2, d3;
#define TK_CAND(CK, PC, S1_, S2_) do { const unsigned ka_ = (unsigned)__shfl((int)S1_, rbase + (int)((PC) >> 4 & 15u)), kb_ = (unsigned)__shfl((int)S2_, rbase + (int)((PC) & 15u)); \
            const float sm_ = hkey2f(ka_) + hkey2f(kb_); CK = (PC) == 0xFFu ? 0u : ((f2key(sm_) & ~0xFFu) | (255u - (PC))); } while (0)
        TK_CAND(c0, pc0, S1x, S2x); TK_CAND(c1, pc1, S1x, S2x); TK_CAND(c2, pc2, S1x, S2x); TK_CAND(c3, pc3, S1x, S2x);
        TK_CAND(d0, pc0, S1y, S2y); TK_CAND(d1, pc1, S1y, S2y); TK_CAND(d2, pc2, S1y, S2y); TK_CAND(d3, pc3, S1y, S2y);
#undef TK_CAND
        CAS_(c0, c1); CAS_(c2, c3); CAS_(c0, c2); CAS_(c1, c3); CAS_(c1, c2);
        CAS_(d0, d1); CAS_(d2, d3); CAS_(d0, d2); CAS_(d1, d3); CAS_(d1, d2);
        unsigned res2x = 0u, res2y = 0u;
#pragma unroll
        for (int r = 0; r < 16; ++r) {
            unsigned mx, my; row_umax16_x2(c0, d0, mx, my);
            const bool popx = (c0 == mx), popy = (d0 == my);
            c0 = popx ? c1 : c0; c1 = popx ? c2 : c1; c2 = popx ? c3 : c2; c3 = popx ? 0u : c3;
            d0 = popy ? d1 : d0; d1 = popy ? d2 : d1; d2 = popy ? d3 : d2; d3 = popy ? 0u : d3;
            res2x = (l15 == r) ? mx : res2x; res2y = (l15 == r) ? my : res2y;
        }
#define TK_FIN(RES2_, S1_, S2_, TH_) do { const unsigned code = 255u - ((RES2_) & 0xFFu); \
            const unsigned ka = (unsigned)__shfl((int)S1_, rbase + (int)(code >> 4 & 15u)), kb = (unsigned)__shfl((int)S2_, rbase + (int)(code & 15u)); \
            const float ts = hkey2f(ka) + hkey2f(kb); \
            const int e = (int)((127u - (ka & 0x7Fu)) * 128u + (127u - (kb & 0x7Fu))); \
            const float sve = SV[e], sue = SU[e];                                \
            const float tmax = __builtin_bit_cast(float, (unsigned)__shfl((int)__builtin_bit_cast(unsigned, ts), rbase)); \
            const float ex = __expf(ts - tmax); \
            const float sum = row_fsum16(ex); \
            const int th = (TH_) + row; \
            const size_t o = (size_t)(th >> 3) * NEXP_SEL + (th & 7) * 16 + l15; \
            IDX[o] = e; GATE[o] = ex / sum * sve; GSU[o] = sue; } while (0)
        TK_FIN(res2x, S1x, S2x, thb); TK_FIN(res2y, S1y, S2y, thb + 4);
#undef TK_FIN
    } }
}

constexpr int PG_TOK = 16;
constexpr int PG_IDX = 0, PG_HID = 4096, PG_SA = PG_HID + 8192, PG_TB = PG_SA + 64, PG_WB = PG_TB + 4096;
static_assert(PG_WB % 16 == 0 && PG_TB % 16 == 0 && NWAVES * PG_WB <= RING_BYTES, "gather LDS map");
typedef int pgv4i __attribute__((ext_vector_type(4))); typedef int pgv8i __attribute__((ext_vector_type(8)));
__device__ __forceinline__ pgv8i pg_cat8(const l2 a, const l2 b) { const pgv4i x = __builtin_bit_cast(pgv4i, a), y = __builtin_bit_cast(pgv4i, b); return __builtin_shufflevector(x, y, 0, 1, 2, 3, 4, 5, 6, 7); }
__device__ __forceinline__ pgv8i pg_lo8(const l2 a) { const pgv4i x = __builtin_bit_cast(pgv4i, a); return (pgv8i){x[0], x[1], x[2], x[3], 0, 0, 0, 0}; }
__device__ __forceinline__ f32x4 f8x4(unsigned p) { const auto lo = __builtin_amdgcn_cvt_pk_f32_fp8((int)p, false); const auto hi = __builtin_amdgcn_cvt_pk_f32_fp8((int)p, true); return (f32x4){lo[0], lo[1], hi[0], hi[1]}; }
__device__ __forceinline__ void peer_sliced(Frame& F) {
    const unsigned char* U8T = F.ws + WS_U8; const unsigned char* V8T = F.ws + WS_V8; unsigned char* X4 = F.ws + WS_X4;
    const float* SSQ = (const float*)(F.ws + WS_CTL) + CW_SSQ;
    const int* IDX = (const int*)(F.ws + WS_IDX); const float* GATE = (const float*)(F.ws + WS_GATE); const float* GSU = (const float*)(F.ws + WS_GSU); const float* gf = F.in[17];
    unsigned char* PO = F.ws + WS_PO; const bf16* HB = (const bf16*)(F.ws + WS_HN2);
    const int gw = F.vcu * NWAVES + F.wave, NGW = F.G * NWAVES, lane = F.lane, m = lane & 15, g = lane >> 4;
    const int row8 = lane >> 3, piece = lane & 7;
    LAS unsigned char* wb = F.lds + F.wave * PG_WB;
    LAS unsigned short* idxs = (LAS unsigned short*)(wb + PG_IDX);
    LAS float* hid = (LAS float*)(wb + PG_HID);
    LAS float* sqp = hid + 64 + lane;
    LAS float* sai = (LAS float*)(wb + PG_SA);
    LAS unsigned char* tb = wb + PG_TB;
    const int p8 = m & 7; const unsigned bsh = 8u * (unsigned)(p8 & 3); const bool bhi = (p8 >> 2) != 0;
    constexpr size_t SLICE = (size_t)16384 * 128;
    const int usw = 16 * (piece ^ ((row8 >> 1) & 3));
    const int urd0 = m * 128 + 16 * ((2 * g) ^ ((m >> 1) & 7)), urd1 = m * 128 + 16 * ((2 * g + 1) ^ ((m >> 1) & 7));
    for (int blk = gw; blk < NTOK / PG_TOK; blk += NGW) {
        const int t0 = blk * PG_TOK;
#pragma unroll
        for (int k = 0; k < 32; ++k) { const int id = lane + 64 * k;
            idxs[16 * (lane & 7) + (lane >> 3) + 128 * (k >> 1) + 8 * (k & 1)] = (unsigned short)IDX[(size_t)t0 * NEXP_SEL + id]; }
#pragma unroll
        for (int k = 0; k < 8; ++k) *(LAS f32x4*)(hid + 4 * (lane + 64 * k)) = (f32x4){0.f, 0.f, 0.f, 0.f};
        LDS_WAIT(); asm volatile("" ::: "memory");
        float xdq = 1.f;
        { f32x4 g2v[4];
#pragma unroll
          for (int q = 0; q < 4; ++q) g2v[q] = *((const GAS f32x4*)F.in[12] + 4 * lane + q);
#pragma unroll
          for (int i0 = 0; i0 < PG_TOK; i0 += 8) { v4u xr[8][2];
#pragma unroll
            for (int i = 0; i < 8; ++i) { const GAS v4u* hp_ = (const GAS v4u*)(HB + (size_t)(t0 + i0 + i) * DM) + 2 * lane; xr[i][0] = hp_[0]; xr[i][1] = hp_[1]; }
#pragma unroll
            for (int i = 0; i < 8; ++i) { const unsigned w_[8] = {xr[i][0].x, xr[i][0].y, xr[i][0].z, xr[i][0].w, xr[i][1].x, xr[i][1].y, xr[i][1].z, xr[i][1].w}; float f_[16]; float am = 0.f;
#pragma unroll
              for (int q = 0; q < 8; ++q) { f_[2 * q] = bflo(w_[q]) * g2v[q >> 1][2 * (q & 1)]; f_[2 * q + 1] = bfhi(w_[q]) * g2v[q >> 1][2 * (q & 1) + 1]; am = fmaxf(am, fmaxf(fabsf(f_[2 * q]), fabsf(f_[2 * q + 1]))); }
#pragma unroll
              for (int o = 1; o < 64; o <<= 1) am = fmaxf(am, __shfl_xor(am, o));
              const float qs = am > 0.f ? 6.f / am : 1.f; unsigned r0 = 0u, r1 = 0u;
              r0 = __builtin_amdgcn_cvt_scalef32_pk_fp4_f32(r0, f_[0] * qs, f_[1] * qs, 1.0f, 0); r0 = __builtin_amdgcn_cvt_scalef32_pk_fp4_f32(r0, f_[2] * qs, f_[3] * qs, 1.0f, 1);
              r0 = __builtin_amdgcn_cvt_scalef32_pk_fp4_f32(r0, f_[4] * qs, f_[5] * qs, 1.0f, 2); r0 = __builtin_amdgcn_cvt_scalef32_pk_fp4_f32(r0, f_[6] * qs, f_[7] * qs, 1.0f, 3);
              r1 = __builtin_amdgcn_cvt_scalef32_pk_fp4_f32(r1, f_[8] * qs, f_[9] * qs, 1.0f, 0); r1 = __builtin_amdgcn_cvt_scalef32_pk_fp4_f32(r1, f_[10] * qs, f_[11] * qs, 1.0f, 1);
              r1 = __builtin_amdgcn_cvt_scalef32_pk_fp4_f32(r1, f_[12] * qs, f_[13] * qs, 1.0f, 2); r1 = __builtin_amdgcn_cvt_scalef32_pk_fp4_f32(r1, f_[14] * qs, f_[15] * qs, 1.0f, 3);
              *(GAS v2u*)(X4 + (size_t)(t0 + i0 + i) * 512 + 8 * lane) = (v2u){r0, r1};
              xdq = lane == i0 + i ? (am > 0.f ? am * (1.f / 6.f) : 1.f) : xdq; } }
        }
        VM_WAIT();
        v4u ab[2][16]; l2 xs[2][2];
#define PGU_ISSUE_AT(UP_, XP_, i_, buf_) do { _Pragma("unroll") for (int k = 0; k < 16; ++k) { const unsigned e = idxs[(i_) * 128 + 16 * row8 + k]; \
                ab[buf_][k] = *(const GAS v4u*)((UP_) + (size_t)(e * 128u + (unsigned)(usw ^ ((k & 1) ? 64 : 0)))); } \
                _Pragma("unroll") for (int q = 0; q < 2; ++q) xs[buf_][q] = *(const GAS l2*)((XP_) + (size_t)(unsigned)(32 * g + (i_) * 512 + 16 * q)); } while (0)
        PGU_ISSUE_AT(U8T, X4 + (size_t)t0 * 512, 0, 0);
        for (int p = 0; p < 4; ++p) {
            const unsigned char* Up = U8T + (size_t)p * SLICE;
            const unsigned char* Xp = X4 + (size_t)t0 * 512 + 128 * p;
#define PGU_WR(i_, cur_, rb_, S_) do { _Pragma("unroll") for (int q4 = 0; q4 < 4; ++q4) *(LAS v4u*)(tb + 1024 * q4 + 16 * lane) = ab[cur_][4 * (rb_) + q4]; \
                S_##0 = *(const LAS l2*)(tb + urd0); S_##1 = *(const LAS l2*)(tb + urd1); S_##2 = *(const LAS l2*)(tb + 2048 + urd0); S_##3 = *(const LAS l2*)(tb + 2048 + urd1); \
                S_##c0 = *(const LAS f32x4*)(hid + (i_) * 128 + 32 * (rb_) + 4 * g); S_##c1 = *(const LAS f32x4*)(hid + (i_) * 128 + 32 * (rb_) + 16 + 4 * g); } while (0)
#define PGU_MF(i_, cur_, rb_, S_) do { f32x4 acc0 = S_##c0, acc1 = S_##c1; \
                const pgv8i x0_ = pg_lo8(xs[cur_][0]), x1_ = pg_lo8(xs[cur_][1]); \
                acc0 = __builtin_amdgcn_mfma_scale_f32_16x16x128_f8f6f4(pg_lo8(S_##0), x0_, acc0, 4, 4, 0, 0x7f7f7f7f, 0, 0x7f7f7f7f); acc1 = __builtin_amdgcn_mfma_scale_f32_16x16x128_f8f6f4(pg_lo8(S_##2), x0_, acc1, 4, 4, 0, 0x7f7f7f7f, 0, 0x7f7f7f7f); \
                acc0 = __builtin_amdgcn_mfma_scale_f32_16x16x128_f8f6f4(pg_lo8(S_##1), x1_, acc0, 4, 4, 0, 0x7f7f7f7f, 0, 0x7f7f7f7f); acc1 = __builtin_amdgcn_mfma_scale_f32_16x16x128_f8f6f4(pg_lo8(S_##3), x1_, acc1, 4, 4, 0, 0x7f7f7f7f, 0, 0x7f7f7f7f); \
                LAS float* hp_ = hid + (i_) * 128 + 32 * (rb_) + 4 * g; \
                asm volatile("s_nop 7\n\ts_mov_b32 exec_lo, 0x10001\n\ts_mov_b32 exec_hi, 0x10001\n\t" \
                             "ds_write_b128 %0, %1\n\tds_write_b128 %0, %2 offset:64\n\t" \
                             "s_mov_b64 exec, -1" \
                             :: "v"(hp_), "v"(acc0), "v"(acc1) : "memory"); } while (0)
#define PGU_BODY(i_, cur_, nxt_) do { { const bool wr_ = (i_) + 1 == PG_TOK; const int nx_ = wr_ ? 0 : (i_) + 1; const unsigned char* un_ = wr_ ? Up + SLICE : Up; const unsigned char* xn_ = wr_ ? Xp + 128 : Xp; PGU_ISSUE_AT(un_, xn_, nx_, nxt_); } SCHED_FENCE(); \
                l2 fa0, fa1, fa2, fa3, fb0, fb1, fb2, fb3; f32x4 fac0, fac1, fbc0, fbc1; \
                PGU_WR(i_, cur_, 0, fa); PGU_WR(i_, cur_, 1, fb); SCHED_FENCE(); \
                PGU_MF(i_, cur_, 0, fa); SCHED_FENCE(); PGU_WR(i_, cur_, 2, fa); SCHED_FENCE(); \
                PGU_MF(i_, cur_, 1, fb); SCHED_FENCE(); PGU_WR(i_, cur_, 3, fb); SCHED_FENCE(); \
                PGU_MF(i_, cur_, 2, fa); SCHED_FENCE(); PGU_MF(i_, cur_, 3, fb); SCHED_FENCE(); } while (0)
            for (int i2 = 0; i2 < PG_TOK; i2 += 2) { PGU_BODY(i2, 0, 1); PGU_BODY(i2 + 1, 1, 0); }
#undef PGU_BODY
#undef PGU_WR
#undef PGU_MF
            LDS_WAIT(); asm volatile("" ::: "memory");
        }
        { f32x2_t suv[16], gvv[16], hv[16];
          float sxl = SSQ[t0 + (lane & 15)]; sxl = xdq / sqrtf(sxl * (1.f / DM) + EPS);
#pragma unroll
          for (int i = 0; i < PG_TOK; ++i) { suv[i] = *(const GAS f32x2_t*)(GSU + (size_t)(t0 + i) * NEXP_SEL + 2 * lane); gvv[i] = *(const GAS f32x2_t*)(GATE + (size_t)(t0 + i) * NEXP_SEL + 2 * lane); }
#pragma unroll
          for (int i = 0; i < PG_TOK; ++i) hv[i] = *(const LAS f32x2_t*)(hid + i * 128 + 2 * lane);
          float w0[16], w1[16], am[16];
#pragma unroll
          for (int i = 0; i < PG_TOK; ++i) { const float sx = __builtin_bit_cast(float, __builtin_amdgcn_readlane(__builtin_bit_cast(int, sxl), i));
              w0[i] = gelu_as(hv[i].x * suv[i].x * sx) * gvv[i].x; w1[i] = gelu_as(hv[i].y * suv[i].y * sx) * gvv[i].y; am[i] = fmaxf(fabsf(w0[i]), fabsf(w1[i])); }
#pragma unroll
          for (int o = 1; o < 64; o <<= 1)
#pragma unroll
              for (int i = 0; i < PG_TOK; ++i) am[i] = fmaxf(am[i], __shfl_xor(am[i], o));
          LDS_WAIT(); asm volatile("" ::: "memory");
#pragma unroll
          for (int i = 0; i < PG_TOK; ++i) { const float sa = am[i] > 0.f ? 224.f / am[i] : 1.f;
              const int pk = __builtin_amdgcn_cvt_pk_fp8_f32(w0[i] * sa, w1[i] * sa, 0, false);
              LAS unsigned char* wq = (LAS unsigned char*)(hid + i * 128) + 32 * (lane & 3) + (lane >> 2);
              wq[0] = (unsigned char)pk; wq[16] = (unsigned char)(pk >> 8);
              if (lane == 0) sai[i] = am[i] > 0.f ? am[i] * (1.f / 224.f) : 1.f; }
        }
        LDS_WAIT(); asm volatile("" ::: "memory");
        v4u va[2][16];
#define PGV_ISSUE_AT(VP_, i_, buf_) do { _Pragma("unroll") for (int k = 0; k < 16; ++k) { const unsigned e = idxs[(i_) * 128 + 16 * row8 + k]; va[buf_][k] = *(const GAS v4u*)((VP_) + (size_t)(e * 128u + 16u * (unsigned)piece)); } } while (0)
        PGV_ISSUE_AT(V8T, 0, 0);
        for (int p = 0; p < 8; ++p) {
            const unsigned char* Vp = V8T + (size_t)p * SLICE;
#define PGV_BODY(i_, cur_, nxt_) do { { const bool wr_ = (i_) + 1 == PG_TOK; const int nx_ = wr_ ? 0 : (i_) + 1; const unsigned char* vn_ = wr_ ? Vp + SLICE : Vp; PGV_ISSUE_AT(vn_, nx_, nxt_); } \
                const v4u w4_ = *(const LAS v4u*)((LAS unsigned char*)(hid + (i_) * 128) + 16 * row8); \
                const unsigned ww[4] = {w4_.x, w4_.y, w4_.z, w4_.w}; \
                SCHED_FENCE(); f32x4 cl = (f32x4){0.f, 0.f, 0.f, 0.f}, chh = (f32x4){0.f, 0.f, 0.f, 0.f}; \
                _Pragma("unroll") for (int k = 0; k < 16; ++k) { \
                    const unsigned a8 = ((ww[k >> 2] >> (8 * (k & 3))) & 0xffu) << bsh; const long bop = (long)(bhi ? ((unsigned long long)a8 << 32) : (unsigned long long)a8); \
                    const long alo = (long)(((unsigned long long)va[cur_][k].y << 32) | (unsigned long long)va[cur_][k].x), ahi = (long)(((unsigned long long)va[cur_][k].w << 32) | (unsigned long long)va[cur_][k].z); \
                    cl = __builtin_amdgcn_mfma_f32_16x16x32_fp8_fp8(alo, bop, cl, 0, 0, 0); chh = __builtin_amdgcn_mfma_f32_16x16x32_fp8_fp8(ahi, bop, chh, 0, 0, 0); } \
                SCHED_FENCE(); \
                _Pragma("unroll") for (int i4 = 0; i4 < 4; ++i4) { \
                    cl[i4] += __shfl(cl[i4], (lane + 40) & 63); chh[i4] += __shfl(chh[i4], (lane + 40) & 63); } \
                { const float isa = sai[i_]; LAS unsigned char* ob = (LAS unsigned char*)(tb) + 64 * g + m;         \
                  if (m < 8 && g < 2) { _Pragma("unroll") for (int i4 = 0; i4 < 4; ++i4) { const int pk_ = __builtin_amdgcn_cvt_pk_fp8_f32(cl[i4] * isa, chh[i4] * isa, 0, false); ob[16 * i4] = (unsigned char)pk_; ob[16 * i4 + 8] = (unsigned char)(pk_ >> 8); } } \
                  const v2u ov = *(const LAS v2u*)(tb + 8 * (lane & 15)); \
                  if (lane < 16) *(GAS v2u*)(PO + (size_t)(t0 + (i_)) * DM + 128 * p + 8 * lane) = ov; } } while (0)
            for (int i2 = 0; i2 < PG_TOK; i2 += 2) { PGV_BODY(i2, 0, 1); PGV_BODY(i2 + 1, 1, 0); }
#undef PGV_BODY
        }
        LDS_WAIT(); asm volatile("" ::: "memory");
        VM_WAIT();
#undef PGU_ISSUE_AT
#undef PGV_ISSUE_AT
        { f32x4 ggv[4];
#pragma unroll
          for (int j = 0; j < 4; ++j) ggv[j] = *((const GAS f32x4*)gf + lane + 64 * j);
          unsigned paX[4], pbX[4], paY[4], pbY[4]; v2u haX[4], hbX[4], haY[4], hbY[4];
#define PGF_LOAD(S_, i_) do { const GAS unsigned* prA = (const GAS unsigned*)(PO + (size_t)(t0 + (i_)) * DM) + lane; const GAS unsigned* prB = prA + DM / 4; \
              const GAS v2u* hbA = (const GAS v2u*)(HB + (size_t)(t0 + (i_)) * DM) + lane; const GAS v2u* hbB = hbA + DM / 4; \
              _Pragma("unroll") for (int j = 0; j < 4; ++j) { pa##S_[j] = prA[64 * j]; ha##S_[j] = hbA[64 * j]; pb##S_[j] = prB[64 * j]; hb##S_[j] = hbB[64 * j]; } } while (0)
#define PGF_BODY(S_, i_) do { GAS f32x4* hrA = (GAS f32x4*)(F.out + (size_t)(t0 + (i_)) * DM) + lane; GAS f32x4* hrB = hrA + DM / 4; \
              f32x4 ya[4], yb[4]; float sa = 0.f, sb = 0.f; \
              _Pragma("unroll") for (int j = 0; j < 4; ++j) { \
                  ya[j] = (f32x4){bflo(ha##S_[j].x), bfhi(ha##S_[j].x), bflo(ha##S_[j].y), bfhi(ha##S_[j].y)} + f8x4(pa##S_[j]); \
                  yb[j] = (f32x4){bflo(hb##S_[j].x), bfhi(hb##S_[j].x), bflo(hb##S_[j].y), bfhi(hb##S_[j].y)} + f8x4(pb##S_[j]); \
                  sa += (ya[j].x * ya[j].x + ya[j].y * ya[j].y) + (ya[j].z * ya[j].z + ya[j].w * ya[j].w); sb += (yb[j].x * yb[j].x + yb[j].y * yb[j].y) + (yb[j].z * yb[j].z + yb[j].w * yb[j].w); } \
              _Pragma("unroll") for (int o = 1; o < 64; o <<= 1) { sa += __shfl_xor(sa, o); sb += __shfl_xor(sb, o); } \
              const float ra = 1.f / sqrtf(sa * (1.f / DM) + EPS), rb = 1.f / sqrtf(sb * (1.f / DM) + EPS); \
              _Pragma("unroll") for (int j = 0; j < 4; ++j) { hrA[64 * j] = ya[j] * ra * ggv[j]; hrB[64 * j] = yb[j] * rb * ggv[j]; } } while (0)
          PGF_LOAD(X, 0);
          for (int i = 0; i < PG_TOK; i += 4) { PGF_LOAD(Y, i + 2); PGF_BODY(X, i); PGF_LOAD(X, (i + 4) & (PG_TOK - 1)); PGF_BODY(Y, i + 2); }
#undef PGF_LOAD
#undef PGF_BODY
        }
        LDS_WAIT(); asm volatile("" ::: "memory");
    }
}

struct Args { const float* in[18]; float* out; unsigned char* ws; int ph_lo, ph_hi; };
__global__ void __launch_bounds__(NWAVES * 64, 2) hymba_fwd(Args args) {
    extern __shared__ __attribute__((aligned(16))) unsigned char lds[];
    Frame F;
    F.lds = (LAS unsigned char*)lds;
    F.MISC = (volatile LAS unsigned*)(F.lds + MISC_OFF);
    F.tid = threadIdx.x; F.lane = F.tid & 63; F.wave = __builtin_amdgcn_readfirstlane(F.tid >> 6);
    F.G = gridDim.x; { const int bx = blockIdx.x; F.vcu = (F.G % 8 == 0) ? (bx % 8) * (F.G / 8) + bx / 8 : bx; }
#pragma unroll
    for (int i = 0; i < 18; ++i) F.in[i] = args.in[i];
    F.out = args.out; F.ws = args.ws;
    for (int u = F.tid; u < (LDS_BYTES - LDSCTL_OFF) / 4; u += NWAVES * 64) ((LAS unsigned*)(F.lds + LDSCTL_OFF))[u] = 0u;
    __syncthreads();
    const int lo = args.ph_lo, hi = args.ph_hi;
    const bool multi = (hi - lo) > 1;
    XcdBarrier bar; bar.bar = (unsigned*)(F.ws + WS_CTL) + CW_BAR; bar.x = 0; bar.st = nullptr;
    if (multi) bar = xcd_barrier_post((unsigned*)(F.ws + WS_CTL) + CW_BAR, F.MISC + 8);
#define IN(k) (lo <= (k) && (k) < hi)
#define SEAM(k) do { if (IN(k) && IN((k) + 1)) xcd_barrier(bar); } while (0)

    if (IN(0)) { p0_prologue(F); } SEAM(0);
    if (IN(1)) {
        pg8::Gemm g{(const pg8::bf16_t*)(F.ws + WS_HN), (const pg8::bf16_t*)(F.ws + WS_WIN), NTOK, INW, DM}; pg8::StaticOrder S; S.init(NTOK, INW, F.G, (int)blockIdx.x);
        pg8::EpiProj E{(pg8::bf16_t*)(F.ws + WS_PROJ), INW, 2, QSCALE};
        pg8::gemm_phase<pg8::EpiProj, pg8::StaticOrder, PG8_ALIGN, PG8_SP2>(F.lds + RING_OFF, g, S, E);
    } SEAM(1);
    if (IN(2)) { hgrn_mfma(F); }
    if (IN(3)) { quant_drain(F); attn_mfma(F, 0); }
    if (IN(3) && IN(4)) xcd_barrier(bar);
    if (IN(4)) {
        pg8::Gemm g{(const pg8::bf16_t*)(F.ws + WS_HN), (const pg8::bf16_t*)(F.ws + WS_WOUT), NTOK, DM, DM}; pg8::StaticOrder S; S.init(NTOK, DM, F.G, (int)blockIdx.x);
        pg8::EpiMix E{DM, F.in[0], (pg8::bf16_t*)(F.ws + WS_HN2), (float*)(F.ws + WS_CTL) + CW_SSQ};
        pg8::gemm_phase<pg8::EpiMix, pg8::StaticOrder, PG8_ALIGN, PG8_SP2>(F.lds + RING_OFF, g, S, E);
    }
    if (IN(4) && IN(6)) xcd_barrier(bar);
    if (IN(6)) {
        pg8::Gemm g{(const pg8::bf16_t*)(F.ws + WS_HN2), (const pg8::bf16_t*)(F.ws + WS_W2), NTOK, 2048, DM}; pg8::StaticOrder S; S.init(NTOK, 2048, F.G, (int)blockIdx.x);
        pg8::EpiScaleRow E{(_Float16*)(F.ws + WS_SC), 2048, (const float*)(F.ws + WS_CTL) + CW_SSQ, 1.f / DM, EPS};
        pg8::gemm_phase<pg8::EpiScaleRow, pg8::StaticOrder, PG8_ALIGN, PG8_SP2>(F.lds + RING_OFF, g, S, E);
    } SEAM(6);
    if (IN(7)) { topk_v2(F); }
    if (IN(7) && IN(8)) { VM_WAIT(); }
    if (IN(8)) { peer_sliced(F); }
#undef IN
#undef SEAM
}

extern "C" void kernel_launch(void* const* d_in, const int* in_sizes, int n_in, void* d_out, int out_size, void* d_ws, size_t ws_size, hipStream_t stream) {
    static int grid = 0;
    if (grid == 0) {
        if (n_in != 18 || in_sizes[0] != NTOK * DM || out_size != NTOK * DM || ws_size < WS_END) { fprintf(stderr, "kernel_launch: unexpected shapes (n_in %d, in0 %d, out %d, ws %zu); nothing launched\n", n_in, n_in > 0 ? in_sizes[0] : -1, out_size, ws_size); grid = -1; return; }
        int dev = 0, cus = 0, per_cu = 0;
        if (hipGetDevice(&dev) != hipSuccess || hipDeviceGetAttribute(&cus, hipDeviceAttributeMultiprocessorCount, dev) != hipSuccess) { grid = -1; return; }
        if (hipFuncSetAttribute((const void*)hymba_fwd, hipFuncAttributeMaxDynamicSharedMemorySize, LDS_BYTES) != hipSuccess) { fprintf(stderr, "kernel_launch: hipFuncSetAttribute failed\n"); grid = -1; return; }
        if (hipOccupancyMaxActiveBlocksPerMultiprocessor(&per_cu, (const void*)hymba_fwd, NWAVES * 64, LDS_BYTES) != hipSuccess || per_cu < 1)
            fprintf(stderr, "kernel_launch: note: occupancy query reports %d workgroups per CU\n", per_cu);
        (void)hipGetLastError();
        grid = cus;
    }
    if (grid < 0) return;
    if (hipMemsetAsync((char*)d_ws + WS_CTL, 0, CTL_ZERO_BYTES, stream) != hipSuccess) return;
    Args a{};
    for (int i = 0; i < 18; ++i) a.in[i] = (const float*)d_in[i];
    a.out = (float*)d_out; a.ws = (unsigned char*)d_ws; a.ph_lo = 0; a.ph_hi = 9;
    hipLaunchKernelGGL(hymba_fwd, dim3(grid), dim3(NWAVES * 64), LDS_BYTES, stream, a);
}
```

```cpp
#include <hip/hip_runtime.h>
#include <cstdio>
#include <cstdint>
#include <cmath>
namespace pg8 {
#define PG8_LAS __attribute__((address_space(3)))
typedef unsigned short bf16_t;
typedef short bf16x8 __attribute__((ext_vector_type(8)));
typedef float f32x4 __attribute__((ext_vector_type(4)));
typedef unsigned u32x4 __attribute__((ext_vector_type(4)));
constexpr int BM = 256, BK = 64, HALF = 128, HTB = HALF * BK * 2  , STAGE_BYTES = 8 * HTB, NXCD = 8, WGM = 8;

__host__ __device__ __forceinline__ int lds_byte(int r, int c) { const int st = (r >> 4) * 2 + (c >> 5), rr = r & 15, cc = c & 31, ob = rr * 64 + cc * 2; return st * 1024 + (ob ^ (((ob >> 9) & 1) << 5)); }
__host__ __device__ __forceinline__ void stage_rc(int b, int& R, int& C) { const int st = b / 1024, sb = b % 1024, swz = sb ^ (((sb >> 9) & 1) << 5); R = (st >> 1) * 16 + swz / 64; C = (st & 1) * 32 + (swz % 64) / 2; }
__host__ __device__ __forceinline__ int perm32(int rho) { const int n = rho >> 4, i = rho & 15; return 8 * (i >> 2) + 4 * n + (i & 3); }

struct Unit { int pm, pn; };
struct Gemm { const bf16_t* A; const bf16_t* Bt; int M, N, K; };

struct StaticOrder {
    int nM, nN, nwg, G, c;
    __host__ __device__ void init(int M, int N, int G_, int c_) { nM = M / BM; nN = N / BM; nwg = nM * nN; G = G_; c = c_; }
    __host__ __device__ bool next(int i, Unit& u) const {
        const long L = (long)i * G + c; if (L >= nwg) return false;
        int wgid = (int)L; { const int q = nwg / NXCD, r = nwg % NXCD, xcd = wgid % NXCD, off = wgid / NXCD; wgid = (xcd < r ? xcd * (q + 1) : r * (q + 1) + (xcd - r) * q) + off; }
        const int nig = WGM * nN, gid = wgid / nig, fm = gid * WGM, gsz = (nM - fm) < WGM ? (nM - fm) : WGM;
        u.pm = fm + ((wgid % nig) % gsz); u.pn = (wgid % nig) / gsz; return true;
    }
    __device__ __forceinline__ void a_ready(const Unit&) const {}
    __device__ __forceinline__ void done(const Unit&) const {}
};
__device__ __forceinline__ unsigned cvt_pk_bf16(float lo, float hi) { unsigned r; asm volatile("v_cvt_pk_bf16_f32 %0, %1, %2" : "=v"(r) : "v"(lo), "v"(hi)); return r; }
typedef float f32x2 __attribute__((ext_vector_type(2)));
__device__ __forceinline__ f32x2 gelu_pk(f32x2 v) {
    const f32x2 av = __builtin_elementwise_abs(v), d = av * 0.2316418882f + 1.0f;
    f32x2 t; t.x = __builtin_amdgcn_rcpf(d.x); t.y = __builtin_amdgcn_rcpf(d.y);
    f32x2 q = t * 0.5307027145f + (-0.7265760135f); q = q * t + 0.7107068705f; q = q * t + (-0.142248368f); q = q * t + 0.127414796f; q = q * t;
    const f32x2 s = (v * v) * (-0.72134752044f);
    f32x2 e; e.x = __builtin_amdgcn_exp2f(s.x); e.y = __builtin_amdgcn_exp2f(s.y);
    const f32x2 m = v * (q * e), r = v - m;
    f32x2 o; o.x = v.x < 0.f ? m.x : r.x; o.y = v.y < 0.f ? m.y : r.y; return o;
}
struct EpiProj {
    static constexpr bool PERM = true, AFTER_DRAIN = false;
    bf16_t* O; int ldc; int qtiles; float qscale;
    __device__ __forceinline__ void operator()(const f32x4 (&acc)[2][2][4][2], const Unit& u, int wr, int wc, int fr, int fq) const {
        const int row0 = u.pm * BM + wr * 64 + fr, col0 = u.pn * BM + wc * 32 + 8 * fq;
        const float sc = (u.pn < qtiles) ? qscale : 1.f;
#pragma unroll
        for (int ai = 0; ai < 2; ++ai)
#pragma unroll
            for (int m = 0; m < 4; ++m) { bf16_t* rowp = O + (size_t)(row0 + ai * HALF + m * 16) * ldc + col0;
#pragma unroll
                for (int bj = 0; bj < 2; ++bj) { const f32x4 v0 = acc[ai][bj][m][0] * sc, v1 = acc[ai][bj][m][1] * sc;
                    u32x4 w; w.x = cvt_pk_bf16(v0[0], v0[1]); w.y = cvt_pk_bf16(v0[2], v0[3]); w.z = cvt_pk_bf16(v1[0], v1[1]); w.w = cvt_pk_bf16(v1[2], v1[3]);
                    *(u32x4*)(rowp + bj * HALF) = w; } }
    }
};
struct EpiF32Res {
    static constexpr bool PERM = false, AFTER_DRAIN = false;
    float* C; int ldc; const float* res;
    __device__ __forceinline__ void operator()(const f32x4 (&acc)[2][2][4][2], const Unit& u, int wr, int wc, int fr, int fq) const {
        const int row0 = u.pm * BM + wr * 64 + fr, col0 = u.pn * BM + wc * 32 + 4 * fq;
#pragma unroll
        for (int ai = 0; ai < 2; ++ai)
#pragma unroll
            for (int m = 0; m < 4; ++m) { const size_t off = (size_t)(row0 + ai * HALF + m * 16) * ldc + col0;
#pragma unroll
                for (int bj = 0; bj < 2; ++bj)
#pragma unroll
                    for (int n = 0; n < 2; ++n) { f32x4 o = acc[ai][bj][m][n]; if (res) o = o + *(const f32x4*)(res + off + bj * HALF + n * 16);
                        *(f32x4*)(C + off + bj * HALF + n * 16) = o; } }
    }
};

struct EpiMix {
    static constexpr bool PERM = true, AFTER_DRAIN = false;
    int ldc; const float* res; bf16_t* HB; float* ssq;
    __device__ __forceinline__ void operator()(const f32x4 (&acc)[2][2][4][2], const Unit& u, int wr, int wc, int fr, int fq) const {
        const int row0 = u.pm * BM + wr * 64 + fr, col0 = u.pn * BM + wc * 32 + 8 * fq;
#pragma unroll
        for (int ai = 0; ai < 2; ++ai) {
            f32x4 r[4][2][2];
#pragma unroll
            for (int m = 0; m < 4; ++m) { const size_t off = (size_t)(row0 + ai * HALF + m * 16) * ldc + col0;
#pragma unroll
                for (int bj = 0; bj < 2; ++bj) { r[m][bj][0] = *(const f32x4*)(res + off + bj * HALF); r[m][bj][1] = *(const f32x4*)(res + off + bj * HALF + 4); } }
#pragma unroll
            for (int m = 0; m < 4; ++m) { const int row = row0 + ai * HALF + m * 16; const size_t off = (size_t)row * ldc + col0; float sq = 0.f;
#pragma unroll
                for (int bj = 0; bj < 2; ++bj) {
                    const f32x4 h0 = acc[ai][bj][m][0] + r[m][bj][0], h1 = acc[ai][bj][m][1] + r[m][bj][1];
                    sq += (h0[0] * h0[0] + h0[1] * h0[1]) + (h0[2] * h0[2] + h0[3] * h0[3]) + (h1[0] * h1[0] + h1[1] * h1[1]) + (h1[2] * h1[2] + h1[3] * h1[3]);
                    u32x4 w; w.x = cvt_pk_bf16(h0[0], h0[1]); w.y = cvt_pk_bf16(h0[2], h0[3]); w.z = cvt_pk_bf16(h1[0], h1[1]); w.w = cvt_pk_bf16(h1[2], h1[3]);
                    *(u32x4*)(HB + off + bj * HALF) = w; }
                sq += __shfl_xor(sq, 16); sq += __shfl_xor(sq, 32);
                if (fq == 0) atomicAdd(ssq + row, sq); }
        }
    }
};
struct EpiScaleRow {
    static constexpr bool PERM = true, AFTER_DRAIN = false;
    _Float16* C; int ldc; const float* ssq; float invk, eps;
    __device__ __forceinline__ void operator()(const f32x4 (&acc)[2][2][4][2], const Unit& u, int wr, int wc, int fr, int fq) const {
        typedef _Float16 h2 __attribute__((ext_vector_type(2)));
        const int row0 = u.pm * BM + wr * 64 + fr, col0 = u.pn * BM + wc * 32 + 8 * fq;
        float sv[2][4];
#pragma unroll
        for (int ai = 0; ai < 2; ++ai)
#pragma unroll
            for (int m = 0; m < 4; ++m) sv[ai][m] = ssq[row0 + ai * HALF + m * 16];
#pragma unroll
        for (int ai = 0; ai < 2; ++ai)
#pragma unroll
            for (int m = 0; m < 4; ++m) { const int row = row0 + ai * HALF + m * 16; const size_t off = (size_t)row * ldc + col0; const float rs = 1.f / sqrtf(sv[ai][m] * invk + eps);
#pragma unroll
                for (int bj = 0; bj < 2; ++bj) { const f32x4 v0 = acc[ai][bj][m][0] * rs, v1 = acc[ai][bj][m][1] * rs;
                    const h2 p0 = {(_Float16)v0[0], (_Float16)v0[1]}, p1 = {(_Float16)v0[2], (_Float16)v0[3]}, p2 = {(_Float16)v1[0], (_Float16)v1[1]}, p3 = {(_Float16)v1[2], (_Float16)v1[3]};
                    u32x4 w; w.x = __builtin_bit_cast(unsigned, p0); w.y = __builtin_bit_cast(unsigned, p1); w.z = __builtin_bit_cast(unsigned, p2); w.w = __builtin_bit_cast(unsigned, p3);
                    *(u32x4*)(C + off + bj * HALF) = w; } }
    }
};
template <class Epi, class Sched, bool ALIGN_EPI = false, bool SP2 = false>
__device__ __forceinline__ void gemm_phase(PG8_LAS unsigned char* lds, const Gemm g, const Sched& S, const Epi& E) {
    const int tid = threadIdx.x, wid = __builtin_amdgcn_readfirstlane(tid >> 6), lane = tid & 63, wr = wid >> 2, wc = wid & 3, fr = lane & 15, fq = lane >> 4;
    const int K = g.K, nt = K / BK;
    unsigned voffA[2], voffB[2];
#pragma unroll
    for (int i = 0; i < 2; ++i) { int R, C; stage_rc(tid * 16 + i * 8192, R, C); const int Rb = Epi::PERM ? ((R & ~31) + perm32(R & 31)) : R;
        voffA[i] = (unsigned)(R * K + C) * 2u; voffB[i] = (unsigned)(Rb * K + C) * 2u; }
    const size_t kstep = (size_t)(BK * 2);
    const size_t hstep = (size_t)HALF * K * 2;
    const size_t tstep = 2 * hstep;
    const unsigned ldsw = (unsigned)wid * 1024u;
    const int aoff = lds_byte(wr * 64 + fr, fq * 8), boff = lds_byte(wc * 32 + fr, fq * 8);
#define PG8_SA(b, h) (((b) * 2 + (h)) * HTB)
#define PG8_SB(b, h) ((4 + (b) * 2 + (h)) * HTB)
#define PG8_STAGE(bufoff, gbase, voff) do { _Pragma("unroll") for (int _i = 0; _i < 2; ++_i) \
        __builtin_amdgcn_global_load_lds((const unsigned*)((const char*)(gbase) + (voff)[_i]), (PG8_LAS unsigned*)(lds + (bufoff) + ldsw + _i * 8192), 16, 0, 0); } while (0)
#define PG8_LDA(dst, b, h) do { _Pragma("unroll") for (int m = 0; m < 4; ++m) _Pragma("unroll") for (int k = 0; k < 2; ++k) dst[m][k] = *(const PG8_LAS bf16x8*)(lds + PG8_SA(b, h) + aoff + m * 2048 + k * 1024); } while (0)
#define PG8_LDB(dst, b, h) do { _Pragma("unroll") for (int n = 0; n < 2; ++n) _Pragma("unroll") for (int k = 0; k < 2; ++k) dst[n][k] = *(const PG8_LAS bf16x8*)(lds + PG8_SB(b, h) + boff + n * 2048 + k * 1024); } while (0)
#define PG8_MMA(ai, bj, At, Bt) do { __builtin_amdgcn_s_setprio(1); _Pragma("unroll") for (int m = 0; m < 4; ++m) _Pragma("unroll") for (int n = 0; n < 2; ++n) _Pragma("unroll") for (int k = 0; k < 2; ++k) \
        acc[ai][bj][m][n] = __builtin_amdgcn_mfma_f32_16x16x32_bf16(Bt[n][k], At[m][k], acc[ai][bj][m][n], 0, 0, 0); __builtin_amdgcn_s_setprio(0); } while (0)
#define PG8_WAIT_V(n) asm volatile("s_waitcnt vmcnt(" #n ")" ::: "memory")
#define PG8_WAIT_L(n) asm volatile("s_waitcnt lgkmcnt(" #n ")" ::: "memory")
#define PG8_BAR __builtin_amdgcn_s_barrier()
#define PG8_SCHED __builtin_amdgcn_sched_barrier(0)
    Unit cur, nxt; int ui = 0;
    if (!S.next(0, cur)) return;
    f32x4 acc[2][2][4][2];
#pragma unroll
    for (int a = 0; a < 2; ++a)
#pragma unroll
        for (int b = 0; b < 2; ++b)
#pragma unroll
            for (int m = 0; m < 4; ++m)
#pragma unroll
                for (int n = 0; n < 2; ++n) acc[a][b][m][n] = (f32x4){0.f, 0.f, 0.f, 0.f};
    bf16x8 At[4][2], B0[2][2], B1[2][2];
    const char* cA = (const char*)g.A + (size_t)cur.pm * tstep; const char* cB = (const char*)g.Bt + (size_t)cur.pn * tstep;
    S.a_ready(cur);
    if constexpr (SP2) {
        PG8_STAGE(PG8_SB(0, 0), cB, voffB); PG8_STAGE(PG8_SB(0, 1), cB + hstep, voffB); PG8_STAGE(PG8_SA(0, 0), cA, voffA); PG8_STAGE(PG8_SA(0, 1), cA + hstep, voffA);
        if (wr == 1) PG8_BAR;
        PG8_WAIT_V(2); PG8_BAR;
        PG8_STAGE(PG8_SB(1, 0), cB + kstep, voffB); PG8_STAGE(PG8_SA(1, 0), cA + kstep, voffA); PG8_STAGE(PG8_SB(1, 1), cB + hstep + kstep, voffB);
        PG8_WAIT_V(6); PG8_BAR;
    } else {
        PG8_STAGE(PG8_SB(0, 0), cB, voffB); PG8_STAGE(PG8_SA(0, 0), cA, voffA); PG8_STAGE(PG8_SB(0, 1), cB + hstep, voffB); PG8_STAGE(PG8_SA(0, 1), cA + hstep, voffA);
        if (wr == 1) PG8_BAR;
        PG8_WAIT_V(4); PG8_BAR;
        PG8_STAGE(PG8_SB(1, 0), cB + kstep, voffB); PG8_STAGE(PG8_SA(1, 0), cA + kstep, voffA); PG8_STAGE(PG8_SB(1, 1), cB + hstep + kstep, voffB);
        PG8_WAIT_V(6); PG8_BAR;
    }
    for (;;) {
        const bool has_next = S.next(ui + 1, nxt);
        const char* nA = has_next ? (const char*)g.A + (size_t)nxt.pm * tstep : cA; const char* nB = has_next ? (const char*)g.Bt + (size_t)nxt.pn * tstep : cB;
        for (int t = 0; t < nt; t += 2) {
            const bool last = (t == nt - 2);
            const char* a1 = cA + (size_t)(t + 1) * kstep;
            const char* a2 = last ? nA : cA + (size_t)(t + 2) * kstep; const char* b2 = last ? nB : cB + (size_t)(t + 2) * kstep;
            const char* a3 = a2 + kstep; const char* b3 = b2 + kstep;
            if (last && has_next) S.a_ready(nxt);
            if constexpr (SP2) {
            PG8_LDB(B0, 0, 0); PG8_LDB(B1, 0, 1); PG8_SCHED; PG8_LDA(At, 0, 0); PG8_STAGE(PG8_SA(1, 1), a1 + hstep, voffA);
            PG8_WAIT_V(8); PG8_WAIT_L(0); PG8_BAR; PG8_MMA(0, 0, At, B0); PG8_MMA(0, 1, At, B1); PG8_BAR; PG8_SCHED;
            PG8_LDA(At, 0, 1); PG8_STAGE(PG8_SB(0, 0), b2, voffB); PG8_STAGE(PG8_SB(0, 1), b2 + hstep, voffB); PG8_STAGE(PG8_SA(0, 0), a2, voffA);
            PG8_WAIT_V(8); PG8_WAIT_L(0); PG8_BAR; PG8_MMA(1, 0, At, B0); PG8_MMA(1, 1, At, B1); PG8_BAR; PG8_SCHED;
            PG8_LDB(B0, 1, 0); PG8_LDB(B1, 1, 1); PG8_SCHED; PG8_LDA(At, 1, 0); PG8_STAGE(PG8_SA(0, 1), a2 + hstep, voffA);
            PG8_WAIT_V(8); PG8_WAIT_L(0); PG8_BAR; PG8_MMA(0, 0, At, B0); PG8_MMA(0, 1, At, B1); PG8_BAR; PG8_SCHED;
            PG8_LDA(At, 1, 1); PG8_STAGE(PG8_SB(1, 0), b3, voffB); PG8_STAGE(PG8_SB(1, 1), b3 + hstep, voffB); PG8_STAGE(PG8_SA(1, 0), a3, voffA);
            PG8_WAIT_V(8); PG8_WAIT_L(0); PG8_BAR; PG8_MMA(1, 0, At, B0); PG8_MMA(1, 1, At, B1); PG8_BAR; PG8_SCHED;
            } else {
            PG8_LDB(B0, 0, 0); PG8_SCHED; PG8_LDA(At, 0, 0); PG8_STAGE(PG8_SA(1, 1), a1 + hstep, voffA);
            PG8_WAIT_L(8); PG8_BAR; PG8_WAIT_L(0); PG8_MMA(0, 0, At, B0); PG8_BAR; PG8_SCHED;
            PG8_LDB(B1, 0, 1); PG8_STAGE(PG8_SB(0, 0), b2, voffB);
            PG8_BAR; PG8_WAIT_L(0); PG8_MMA(0, 1, At, B1); PG8_BAR;
            PG8_LDA(At, 0, 1); PG8_STAGE(PG8_SA(0, 0), a2, voffA);
            PG8_BAR; PG8_WAIT_L(0); PG8_MMA(1, 0, At, B0); PG8_BAR; PG8_SCHED;
            PG8_STAGE(PG8_SB(0, 1), b2 + hstep, voffB);
            PG8_WAIT_V(6); PG8_BAR; PG8_MMA(1, 1, At, B1); PG8_BAR;
            PG8_LDB(B0, 1, 0); PG8_SCHED; PG8_LDA(At, 1, 0); PG8_STAGE(PG8_SA(0, 1), a2 + hstep, voffA);
            PG8_WAIT_L(8); PG8_BAR; PG8_WAIT_L(0); PG8_MMA(0, 0, At, B0); PG8_BAR; PG8_SCHED;
            PG8_LDB(B1, 1, 1); PG8_STAGE(PG8_SB(1, 0), b3, voffB);
            PG8_BAR; PG8_WAIT_L(0); PG8_MMA(0, 1, At, B1); PG8_BAR;
            PG8_LDA(At, 1, 1); PG8_STAGE(PG8_SA(1, 0), a3, voffA);
            PG8_BAR; PG8_WAIT_L(0); PG8_MMA(1, 0, At, B0); PG8_BAR; PG8_SCHED;
            PG8_STAGE(PG8_SB(1, 1), b3 + hstep, voffB);
            PG8_WAIT_V(6); PG8_BAR; PG8_MMA(1, 1, At, B1); PG8_BAR;
            }
        }
        if constexpr (ALIGN_EPI) { if (wr == 0) PG8_BAR; }
        if constexpr (!Epi::AFTER_DRAIN) { E(acc, cur, wr, wc, fr, fq); S.done(cur); }
        if (!has_next) break;
#pragma unroll
        for (int a = 0; a < 2; ++a)
#pragma unroll
            for (int b = 0; b < 2; ++b)
#pragma unroll
                for (int m = 0; m < 4; ++m)
#pragma unroll
                    for (int n = 0; n < 2; ++n) acc[a][b][m][n] = (f32x4){0.f, 0.f, 0.f, 0.f};
        cur = nxt; cA = nA; cB = nB; ++ui;
        if constexpr (ALIGN_EPI) { if (wr == 1) PG8_BAR; }
    }
    PG8_WAIT_V(0);
    if constexpr (!ALIGN_EPI) { if (wr == 0) PG8_BAR; }
    PG8_BAR;
    if constexpr (Epi::AFTER_DRAIN) { E.fused(acc, cur, wr, wc, fr, fq, lds, wid, lane); S.done(cur); }
#undef PG8_SA
#undef PG8_SB
#undef PG8_STAGE
#undef PG8_LDA
#undef PG8_LDB
#undef PG8_MMA
#undef PG8_WAIT_V
#undef PG8_WAIT_L
#undef PG8_BAR
#undef PG8_SCHED
}
}
#ifndef PG8_SP2
#define PG8_SP2 true
#endif
#ifndef PG8_ALIGN
#define PG8_ALIGN true
#endif

constexpr int NWAVES = 8;
constexpr int NTOK = 32768, DM = 1024, SEQ = 2048, NBATCH = 16, INW = 3584;
constexpr int C_DQ = 0, C_DK = 512, C_DV = 1024, C_HQ = 1536, C_HF = 2048, C_HI = 2560, C_HG = 3072;
constexpr float EPS = 1e-6f;
constexpr float QSCALE = 0.125f * 1.4426950408889634f;
constexpr float LAM_INIT = 0.2f;
constexpr int NEXP_SEL = 128;

constexpr size_t MiB = 1u << 20;
constexpr size_t WS_CTL = 0, CTL_ZERO_BYTES = 1 * MiB;
constexpr size_t WS_SMALL = 1 * MiB;
constexpr size_t WS_WIN = 2 * MiB;
constexpr size_t WS_WOUT = 10 * MiB;
constexpr size_t WS_W2 = 12 * MiB;
constexpr size_t WS_U8 = 17 * MiB;
constexpr size_t WS_V8 = 33 * MiB;
constexpr size_t WS_SU = 49 * MiB;
constexpr size_t WS_SV = 49 * MiB + 512 * 1024;
constexpr size_t WS_X8 = 50 * MiB;
constexpr size_t WS_SX = 116 * MiB;
constexpr size_t WS_GSU = 120 * MiB;
constexpr size_t WS_HN = 84 * MiB;
constexpr size_t WS_PROJ = 148 * MiB;
constexpr size_t WS_HN2 = 148 * MiB;
constexpr size_t WS_SC = 212 * MiB;
constexpr size_t WS_PO = 352 * MiB;
constexpr size_t WS_X4 = 420 * MiB;
constexpr size_t WS_IDX = 468 * MiB;
constexpr size_t WS_GATE = 484 * MiB;
constexpr size_t WS_END = 500 * MiB;
constexpr int SM_LB = 0, SM_LAM = 512, SM_BIAS = 1024;
constexpr int CW_BAR = 4096;
constexpr int CW_ATTQ = 8192;
constexpr int CW_SSQ = 131072;

constexpr int RING_OFF = 0, RING_BYTES = 139264;
constexpr int LDSCTL_OFF = RING_BYTES, MISC_OFF = LDSCTL_OFF + 320;
constexpr int LDS_BYTES = 147456;

#define GAS __attribute__((address_space(1)))
#define LAS __attribute__((address_space(3)))
typedef unsigned short bf16;
typedef unsigned v4u __attribute__((ext_vector_type(4)));
typedef unsigned v2u __attribute__((ext_vector_type(2)));
typedef float f32x4 __attribute__((ext_vector_type(4)));
typedef short bf16x8 __attribute__((ext_vector_type(8)));
typedef GAS unsigned gu32;
typedef long l2 __attribute__((ext_vector_type(2)));
typedef int v4i __attribute__((ext_vector_type(4)));
#define RLX_AGENT __ATOMIC_RELAXED, __HIP_MEMORY_SCOPE_AGENT
#define LDS_WAIT() asm volatile("s_waitcnt lgkmcnt(0)" ::: "memory")
#define VM_WAIT() asm volatile("s_waitcnt vmcnt(0)" ::: "memory")
__device__ __forceinline__ unsigned f2bf(float f) { unsigned u = __builtin_bit_cast(unsigned, f); return (u + 0x7fffu + ((u >> 16) & 1u)) >> 16; }
__device__ __forceinline__ unsigned pk2(float lo, float hi) { return f2bf(lo) | (f2bf(hi) << 16); }
__device__ __forceinline__ float bflo(unsigned w) { return __builtin_bit_cast(float, w << 16); }
__device__ __forceinline__ float bfhi(unsigned w) { return __builtin_bit_cast(float, w & 0xffff0000u); }

#define XB_TMO      128
#define XB_XCNT(j)  (256  + 64 * (j))
#define XB_XSUB(j)  (1280 + 64 * (j))
#define XB_XGEN(j)  (2304 + 64 * (j))
#define XB_TOP      3328
#define XB_TOPGEN   3392
#define XCD_BAR_WORDS 3456
#define XB_SPIN_CAP (1u << 18)
__device__ __forceinline__ unsigned xb_ld(unsigned* p)              { return __hip_atomic_load(p, __ATOMIC_RELAXED, __HIP_MEMORY_SCOPE_AGENT); }
__device__ __forceinline__ unsigned xb_add(unsigned* p, unsigned v) { return __hip_atomic_fetch_add(p, v, __ATOMIC_RELAXED, __HIP_MEMORY_SCOPE_AGENT); }
__device__ __forceinline__ unsigned xb_xcc_id() { return (unsigned)__builtin_amdgcn_s_getreg((3 << 11) | 20) & 0xFu; }
#define XB_SPIN(cond, bar) do { unsigned _sp = 0; while (cond) { __builtin_amdgcn_s_sleep(1); \
    if ((++_sp & 255u) == 0u) { if (xb_ld(&(bar)[XB_TMO])) break; if (_sp > XB_SPIN_CAP) { atomicAdd(&(bar)[XB_TMO], 1u); break; } } } } while (0)
struct XcdBarrier { unsigned* bar; unsigned x; volatile LAS unsigned* st; };
__device__ __forceinline__ XcdBarrier xcd_barrier_post(unsigned* bar, volatile LAS unsigned* st) {
    XcdBarrier b; b.bar = bar; b.x = xb_xcc_id(); b.st = st;
    if (threadIdx.x == 0) (void)xb_add(&bar[XB_XCNT(b.x)], 1u);
    return b;
}
__device__ __forceinline__ void xcd_barrier_complete(unsigned* bar, unsigned x, unsigned& nloc, unsigned& nx) {
    const unsigned G = gridDim.x * gridDim.y * gridDim.z;
    unsigned sum, cnt, mine, sp = 0u;
    for (;;) {
        sum = 0u; cnt = 0u; mine = 0u;
#pragma unroll
        for (unsigned j = 0; j < 16; ++j) { const unsigned c = xb_ld(&bar[XB_XCNT(j)]); sum += c; cnt += (c > 0u) ? 1u : 0u; mine = (j == x) ? c : mine; }
        if (sum == G) break;
        __builtin_amdgcn_s_sleep(1);
        if ((++sp & 255u) == 0u) { if (xb_ld(&bar[XB_TMO])) break; if (sp > XB_SPIN_CAP) { atomicAdd(&bar[XB_TMO], 1u); break; } }
    }
    nloc = mine > 0u ? mine : 1u; nx = cnt > 0u ? cnt : 1u;
}
__device__ __forceinline__ void xcd_barrier(const XcdBarrier& b) {
    asm volatile("s_waitcnt vmcnt(0)" ::: "memory");
    __syncthreads();
    if (threadIdx.x == 0) {
        unsigned* bar = b.bar;
        __builtin_amdgcn_s_waitcnt(0);
        unsigned nloc = b.st[0], nx = b.st[1];
        if (nloc == 0u) { xcd_barrier_complete(bar, b.x, nloc, nx); b.st[0] = nloc; b.st[1] = nx; }
        const unsigned old = xb_add(&bar[XB_XSUB(b.x)], 1u);
        const unsigned gen = old / nloc;
        if (old + 1u == (gen + 1u) * nloc) {
            __builtin_amdgcn_fence(__ATOMIC_RELEASE, "agent");
            asm volatile("s_waitcnt vmcnt(0)" ::: "memory");
            const unsigned og = xb_add(&bar[XB_TOP], 1u);
            const unsigned tg = og / nx;
            if (og + 1u == (tg + 1u) * nx) xb_add(&bar[XB_TOPGEN], 1u);
            else XB_SPIN(xb_ld(&bar[XB_TOPGEN]) == tg, bar);
            __builtin_amdgcn_fence(__ATOMIC_ACQUIRE, "agent");
            xb_add(&bar[XB_XGEN(b.x)], 1u);
            asm volatile("s_waitcnt vmcnt(0)" ::: "memory");
        } else {
            XB_SPIN(xb_ld(&bar[XB_XGEN(b.x)]) == gen, bar);
            __builtin_amdgcn_fence(__ATOMIC_ACQUIRE, "agent");
            asm volatile("s_waitcnt vmcnt(0)" ::: "memory");
        }
    }
    __syncthreads();
}

#define SCHED_FENCE() __builtin_amdgcn_sched_barrier(0)
__device__ __forceinline__ float gelu_as(float v) {
    const float av = fabsf(v), t = __builtin_amdgcn_rcpf(av * 0.2316418882f + 1.0f);
    float q = t * 0.5307027145f + (-0.7265760135f); q = q * t + 0.7107068705f; q = q * t + (-0.142248368f); q = q * t + 0.127414796f; q = q * t;
    const float e = __builtin_amdgcn_exp2f((v * v) * (-0.72134752044f));
    const float mm = v * (q * e);
    return v < 0.f ? mm : v - mm;
}
struct Frame {
    LAS unsigned char* lds;
    volatile LAS unsigned* MISC;
    int tid, lane, wave, vcu, G;
    const float* in[18]; float* out; unsigned char* ws;
};
__device__ __forceinline__ float wave_sum(float v) {
#pragma unroll
    for (int o = 1; o < 64; o <<= 1) v += __shfl_xor(v, o);
    return v;
}
__device__ __forceinline__ float sigmoidf_(float x) { return 1.f / (1.f + __expf(-x)); }

__device__ __forceinline__ void p0_transpose_item(const float* W, int K, int N, bf16* WT, int row_off, LAS float* scr, int item, int lane) {
    const int nblk = N / 32, kb = item / nblk, nb = item % nblk, k0 = 64 * kb, n0 = 32 * nb;
#pragma unroll 8
    for (int i = 0; i < 32; ++i) { const int kk = 2 * i + (lane >> 5); scr[kk * 33 + (lane & 31)] = W[(size_t)(k0 + kk) * N + n0 + (lane & 31)]; }
    LDS_WAIT(); asm volatile("" ::: "memory");
    const int c = lane & 7;
#pragma unroll
    for (int j = 0; j < 4; ++j) { const int n = (lane >> 3) + 8 * j; const LAS float* s = scr + (8 * c) * 33 + n;
        v4u o; o.x = pk2(s[0 * 33], s[1 * 33]); o.y = pk2(s[2 * 33], s[3 * 33]); o.z = pk2(s[4 * 33], s[5 * 33]); o.w = pk2(s[6 * 33], s[7 * 33]);
        *(GAS v4u*)(WT + (size_t)(row_off + n0 + n) * K + k0 + 8 * c) = o; }
    LDS_WAIT(); asm volatile("" ::: "memory");
}

__device__ __forceinline__ void quant_vals_fp8(const f32x4 (&v)[4], unsigned char* dst, float* dq, int lane, size_t slice_stride) {
    float mx = 0.f;
#pragma unroll
    for (int j = 0; j < 4; ++j) mx = fmaxf(mx, fmaxf(fmaxf(fabsf(v[j].x), fabsf(v[j].y)), fmaxf(fabsf(v[j].z), fabsf(v[j].w))));
#pragma unroll
    for (int o = 1; o < 64; o <<= 1) mx = fmaxf(mx, __shfl_xor(mx, o));
    const float qs = mx > 0.f ? 224.f / mx : 1.f;
#pragma unroll
    for (int j = 0; j < 4; ++j) { int p = __builtin_amdgcn_cvt_pk_fp8_f32(v[j].x * qs, v[j].y * qs, 0, false); p = __builtin_amdgcn_cvt_pk_fp8_f32(v[j].z * qs, v[j].w * qs, p, true);
        const int d = 4 * lane + 256 * j; *(GAS unsigned*)(dst + (slice_stride ? (size_t)(d >> 7) * slice_stride + (d & 127) : (size_t)d)) = (unsigned)p; }
    if (lane == 0) *dq = mx > 0.f ? mx * (1.f / 224.f) : 1.f;
}
__device__ __forceinline__ void quant_row_fp4(const float* src, unsigned char* dst, float* dq, int lane, size_t slice_stride) {
    const GAS f32x4* xr = (const GAS f32x4*)src + lane; f32x4 v[4];
#pragma unroll
    for (int j = 0; j < 4; ++j) v[j] = xr[64 * j];
    float mx = 0.f;
#pragma unroll
    for (int j = 0; j < 4; ++j) mx = fmaxf(mx, fmaxf(fmaxf(fabsf(v[j].x), fabsf(v[j].y)), fmaxf(fabsf(v[j].z), fabsf(v[j].w))));
#pragma unroll
    for (int o = 1; o < 64; o <<= 1) mx = fmaxf(mx, __shfl_xor(mx, o));
    const float qs = mx > 0.f ? 6.f / mx : 1.f;
#pragma unroll
    for (int j = 0; j < 4; ++j) { unsigned r = 0u;
        r = __builtin_amdgcn_cvt_scalef32_pk_fp4_f32(r, v[j].x * qs, v[j].y * qs, 1.0f, 0); r = __builtin_amdgcn_cvt_scalef32_pk_fp4_f32(r, v[j].z * qs, v[j].w * qs, 1.0f, 1);
        *(GAS unsigned short*)(dst + (size_t)j * slice_stride + 2 * lane) = (unsigned short)r; }
    if (lane == 0) *dq = mx > 0.f ? mx * (1.f / 6.f) : 1.f;
}
__device__ __forceinline__ void quant_row_fp8(const float* src, unsigned char* dst, float* dq, int lane, size_t slice_stride) {
    const GAS f32x4* xr = (const GAS f32x4*)src + lane; f32x4 v[4];
#pragma unroll
    for (int j = 0; j < 4; ++j) v[j] = xr[64 * j];
    quant_vals_fp8(v, dst, dq, lane, slice_stride);
}
__device__ __forceinline__ void p0_prologue(Frame& F) {
    LAS float* scr = (LAS float*)(F.lds + RING_OFF + F.wave * 16384);
    const int gw = F.vcu * NWAVES + F.wave, NGW = F.G * NWAVES;
    bf16* WinT = (bf16*)(F.ws + WS_WIN); bf16* WoutT = (bf16*)(F.ws + WS_WOUT); bf16* W2T = (bf16*)(F.ws + WS_W2);
    float* small = (float*)(F.ws + WS_SMALL);
    if (blockIdx.x == 0) {
        const int t = F.tid;
        { const float l0 = F.in[9][t], l1 = F.in[9][512 + t]; small[SM_LB + t] = 1.f / (1.f + expf(l1 - l0)); }
        { const int h = t >> 7, n = t & 127; int bk;
          if (n < 16) bk = n; else { bk = 16 + (int)(logf((float)n * (1.f / 16.f)) / logf(8.f) * 16.f); bk = bk > 31 ? 31 : bk; }
          small[SM_BIAS + t] = F.in[8][bk * 4 + h] * 1.4426950408889634f; }
        if (F.wave == 0) {
            const float a = wave_sum(F.in[3][F.lane] * F.in[4][F.lane]), b = wave_sum(F.in[5][F.lane] * F.in[6][F.lane]);
            if (F.lane == 0) small[SM_LAM] = expf(a) - expf(b) + LAM_INIT;
        }
    }
    constexpr int I_IN = (DM / 64) * (INW / 32), I_OUT = (DM / 64) * (DM / 32);
    for (int it = gw; it < I_IN + I_OUT; it += NGW) {
        if (it < I_IN) p0_transpose_item(F.in[2], DM, INW, WinT, 0, scr, it, F.lane);
        else p0_transpose_item(F.in[11], DM, DM, WoutT, 0, scr, it - I_IN, F.lane);
    }
    for (int u = F.vcu; u < 256; u += F.G) {
        const int hc = u >> 4, kb = u & 15, k = kb * 64 + F.lane;
        const GAS f32x4* wrow = (const GAS f32x4*)(F.in[13] + (size_t)k * 2048 + hc * 128);
        float a[16];
#pragma unroll
        for (int nn = 0; nn < 16; ++nn) a[nn] = 0.f;
        const float* kr = F.in[14] + ((size_t)hc * 128 + F.wave * 16) * 128;
        for (int i = 0; i < 32; ++i) {
            const f32x4 w = wrow[i];
#pragma unroll
            for (int nn = 0; nn < 16; ++nn) { const float* kk = kr + nn * 128 + 4 * i; a[nn] += (kk[0] * w.x + kk[1] * w.y) + (kk[2] * w.z + kk[3] * w.w); }
        }
        const float g2k = F.in[12][k];
#pragma unroll
        for (int nn = 0; nn < 16; ++nn) W2T[((size_t)hc * 128 + F.wave * 16 + nn) * DM + k] = (bf16)f2bf(a[nn] * g2k);
    }
    bf16* HN = (bf16*)(F.ws + WS_HN);
    for (int m = gw; m < NTOK; m += 2 * NGW) {
        const int m2 = m + NGW;
        const GAS f32x4* xa = (const GAS f32x4*)(F.in[0] + (size_t)m * DM) + F.lane; const GAS f32x4* xb = (const GAS f32x4*)(F.in[0] + (size_t)(m2 < NTOK ? m2 : m) * DM) + F.lane;
        const GAS f32x4* gr = (const GAS f32x4*)F.in[1] + F.lane;
        f32x4 va[4], vb[4]; float sa = 0.f, sb = 0.f;
#pragma unroll
        for (int j = 0; j < 4; ++j) { va[j] = xa[64 * j]; vb[j] = xb[64 * j]; }
#pragma unroll
        for (int j = 0; j < 4; ++j) { sa += (va[j].x * va[j].x + va[j].y * va[j].y) + (va[j].z * va[j].z + va[j].w * va[j].w); sb += (vb[j].x * vb[j].x + vb[j].y * vb[j].y) + (vb[j].z * vb[j].z + vb[j].w * vb[j].w); }
#pragma unroll
        for (int o = 1; o < 64; o <<= 1) { sa += __shfl_xor(sa, o); sb += __shfl_xor(sb, o); }
        const float ra = 1.f / sqrtf(sa * (1.f / DM) + EPS), rb = 1.f / sqrtf(sb * (1.f / DM) + EPS);
        GAS unsigned long long* oa = (GAS unsigned long long*)(HN + (size_t)m * DM) + F.lane; GAS unsigned long long* ob = (GAS unsigned long long*)(HN + (size_t)m2 * DM) + F.lane;
#pragma unroll
        for (int j = 0; j < 4; ++j) { const f32x4 gg = gr[64 * j];
            oa[64 * j] = (unsigned long long)pk2(va[j].x * ra * gg.x, va[j].y * ra * gg.y) | ((unsigned long long)pk2(va[j].z * ra * gg.z, va[j].w * ra * gg.w) << 32);
            if (m2 < NTOK) ob[64 * j] = (unsigned long long)pk2(vb[j].x * rb * gg.x, vb[j].y * rb * gg.y) | ((unsigned long long)pk2(vb[j].z * rb * gg.z, vb[j].w * rb * gg.w) << 32); }
    }
}


constexpr int QCHUNKS = 2 * 16384 / 64;
__device__ __forceinline__ void quant_chunk(Frame& F, int c) {
    unsigned char* U8 = F.ws + WS_U8; unsigned char* V8 = F.ws + WS_V8; float* SU = (float*)(F.ws + WS_SU); float* SV = (float*)(F.ws + WS_SV);
#pragma unroll 1
    for (int k = 0; k < 8; ++k) { const int rr = 64 * c + 8 * F.wave + k;
        if (rr < 16384) quant_row_fp4(F.in[15] + (size_t)rr * DM, U8 + (size_t)rr * 128, SU + rr, F.lane, (size_t)16384 * 128);
        else { const int e = rr - 16384; quant_row_fp8(F.in[16] + (size_t)e * DM, V8 + (size_t)e * 128, SV + e, F.lane, (size_t)16384 * 128); } }
}

__device__ __forceinline__ void quant_drain(Frame& F) {
    unsigned* qctr = (unsigned*)(F.ws + WS_CTL) + CW_ATTQ + 128;
    if (F.tid == 0) F.MISC[13] = __hip_atomic_fetch_add(qctr, 1u, __ATOMIC_RELAXED, __HIP_MEMORY_SCOPE_AGENT);
    for (int it = 0;; ++it) {
        __syncthreads();
        const int qc = (int)F.MISC[13 + (it & 1)];
        if (qc >= QCHUNKS) break;
        unsigned nx = 0u;
        if (F.tid == 0) nx = __hip_atomic_fetch_add(qctr, 1u, __ATOMIC_RELAXED, __HIP_MEMORY_SCOPE_AGENT);
        quant_chunk(F, qc);
        if (F.tid == 0) F.MISC[13 + ((it + 1) & 1)] = nx;
    }
}

typedef float f32x16 __attribute__((ext_vector_type(16)));
typedef short s16x4 __attribute__((ext_vector_type(4)));
typedef short v4i16_t __attribute__((ext_vector_type(4)));
typedef float f32x2_t __attribute__((ext_vector_type(2))); typedef __bf16 bf16x2_t __attribute__((ext_vector_type(2)));
__device__ __forceinline__ unsigned cvtpk_bf16(float lo, float hi) { f32x2_t v = {lo, hi}; bf16x2_t b = __builtin_convertvector(v, bf16x2_t); return __builtin_bit_cast(unsigned, b); }
__device__ __forceinline__ float xhalf_max(float v) { return fmaxf(v, __shfl_xor(v, 32)); }
__device__ __forceinline__ float xhalf_sum(float v) { return v + __shfl_xor(v, 32); }
__device__ __forceinline__ float max3f_(float a, float b, float c) { float r; asm("v_max3_f32 %0, %1, %2, %3" : "=v"(r) : "v"(a), "v"(b), "v"(c)); return r; }
constexpr int AT_KP = 144, AT_VP = 320, AT_K1 = 64 * AT_KP, AT_KS = 2 * AT_K1, AT_V0 = 2 * AT_KS, AT_VS = 64 * AT_VP;
constexpr int AT_XO = 0, AT_YB = 65536, AT_YP = 272, AT_Q = 100864, AT_TAB = AT_Q + 8 * 4096;
static_assert(AT_TAB + 320 * 4 <= RING_BYTES && AT_YB + 4 * 32 * AT_YP <= AT_Q && AT_V0 + 3 * AT_VS <= AT_Q, "attention LDS map");
#define AT_MFMA(a, b, c) __builtin_amdgcn_mfma_f32_32x32x16_bf16(a, b, c, 0, 0, 0)
#define AT_SGB(mask, n) __builtin_amdgcn_sched_group_barrier(mask, n, 0)
__device__ __forceinline__ void attn_mfma(Frame& F, int qslot) {
    const bf16* PROJ = (const bf16*)(F.ws + WS_PROJ); bf16* MIXED = (bf16*)(F.ws + WS_HN);
    const float* small = (const float*)(F.ws + WS_SMALL);
    LAS unsigned char* lds = F.lds;
    LAS float* TAB = (LAS float*)(lds + AT_TAB);
    const int tid = F.tid, lane = F.lane, wave = F.wave, map = wave >> 2, qt = wave & 3, r32 = lane & 31, hi = lane >> 5;
    const int koff = map * AT_K1 + r32 * AT_KP + hi * 16;
    const int voff = AT_V0 + (4 * hi + ((lane & 15) >> 2)) * AT_VP + (16 * ((lane >> 4) & 1) + 4 * (lane & 3)) * 2;
    unsigned* qctr = (unsigned*)(F.ws + WS_CTL) + CW_ATTQ + 64 * qslot;
    if (tid == 0) F.MISC[12] = __hip_atomic_fetch_add(qctr, 1u, __ATOMIC_RELAXED, __HIP_MEMORY_SCOPE_AGENT);
    for (;;) {
        __syncthreads();
        const int L = (int)F.MISC[12];
        if (L >= 1024) break;
        unsigned nxtu = 0u;
        if (tid == 0) nxtu = __hip_atomic_fetch_add(qctr, 1u, __ATOMIC_RELAXED, __HIP_MEMORY_SCOPE_AGENT);
        const int qb = 15 - (L >> 6), bh = L & 63;
        const int b = bh >> 2, h = bh & 3, q0 = qb * 128; const size_t tok0 = (size_t)b * SEQ;
        const int NT = (q0 + 128) / 64;
        int tidu = F.tid; asm volatile("" : "+v"(tidu));
        if (tidu < 320) { const int n = tidu - 96; TAB[tidu] = n < 0 ? -INFINITY : small[SM_BIAS + h * 128 + (n > 127 ? 127 : n)]; }
        bf16x8 qf0, qf1, qf2, qf3;
        { const bf16* qrow = PROJ + (tok0 + q0 + 32 * qt + r32) * INW + C_DQ + h * 128 + map * 64 + 8 * hi;
          qf0 = *(const GAS bf16x8*)(qrow); qf1 = *(const GAS bf16x8*)(qrow + 16); qf2 = *(const GAS bf16x8*)(qrow + 32); qf3 = *(const GAS bf16x8*)(qrow + 48); }
        const unsigned char* projb = (const unsigned char*)PROJ;
        const unsigned ksrc = (unsigned)(((tok0 + (tidu >> 4)) * INW + C_DK + h * 128 + (tidu & 15) * 8) * 2), vsrc = ksrc + (C_DV - C_DK) * 2;
        const int kdst = ((tidu & 15) >> 3) * AT_K1 + (tidu >> 4) * AT_KP + (tidu & 7) * 16, vdst = AT_V0 + (tidu >> 4) * AT_VP + (tidu & 15) * 16;
#define AT_GLD(src, row) (*(const GAS v4u*)(projb + (size_t)((src) + (unsigned)((row) * (INW * 2)))))
        v4u kr[2], vr[2];
#pragma unroll
        for (int i = 0; i < 2; ++i) { kr[i] = AT_GLD(ksrc, 32 * i); vr[i] = AT_GLD(vsrc, 32 * i); }
#pragma unroll
        for (int i = 0; i < 2; ++i) { *(LAS v4u*)(lds + kdst + 32 * i * AT_KP) = kr[i]; *(LAS v4u*)(lds + vdst + 32 * i * AT_VP) = vr[i]; }
#pragma unroll
        for (int i = 0; i < 2; ++i) { kr[i] = AT_GLD(ksrc, 64 + 32 * i); vr[i] = AT_GLD(vsrc, 64 + 32 * i); }
        __syncthreads();
        const float bfar = TAB[96 + 127];
        f32x16 o[4];
#pragma unroll
        for (int mt = 0; mt < 4; ++mt) o[mt] = (f32x16){0.f,0.f,0.f,0.f,0.f,0.f,0.f,0.f,0.f,0.f,0.f,0.f,0.f,0.f,0.f,0.f};
        float mrun = -INFINITY, lsum = 0.f, alpha = 1.f, cexp = 0.f; bool resc = false;
        const int qlo = q0 + 32 * qt, qpos = qlo + r32;
        const int NTW = NT - 1 + (qt >> 1);
        f32x16 pA0, pA1, pB0, pB1;
        int vs_prev = 0, vs_cur = 0, vs_next = AT_VS;
#define AT_ROT() do { vs_prev = vs_cur; vs_cur = vs_next; vs_next = (vs_next == 2 * AT_VS) ? 0 : vs_next + AT_VS; } while (0)
#define AT_Z16 (f32x16){0.f,0.f,0.f,0.f,0.f,0.f,0.f,0.f,0.f,0.f,0.f,0.f,0.f,0.f,0.f,0.f}
#define AT_SBAR() __builtin_amdgcn_sched_barrier(0)
#define AT_PIN(x) asm volatile("" : "+v"(x))
        bf16x8 kAa, kAb, kBa, kBb; s16x4 f0l, f0h, f1l, f1h;
#define AT_KRD2(S, KB, s4) do { k##S##a = *(const LAS bf16x8*)(lds + (KB) + koff + 32 * (s4)); k##S##b = *(const LAS bf16x8*)(lds + (KB) + koff + 32 * AT_KP + 32 * (s4)); } while (0)
#define AT_VRD(Fn, g) do { LAS unsigned char* vp_ = vb_ + (32 * ((g) >> 3) + 16 * (((g) >> 2) & 1)) * AT_VP + 64 * ((g) & 3); \
            Fn##l = __builtin_bit_cast(s16x4, __builtin_amdgcn_ds_read_tr16_b64_v4i16((LAS v4i16_t*)vp_)); Fn##h = __builtin_bit_cast(s16x4, __builtin_amdgcn_ds_read_tr16_b64_v4i16((LAS v4i16_t*)(vp_ + 8 * AT_VP))); } while (0)
#define AT_VFR(Fn) (bf16x8){Fn##l[0], Fn##l[1], Fn##l[2], Fn##l[3], Fn##h[0], Fn##h[1], Fn##h[2], Fn##h[3]}
#define AT_GAPA(MF, RD, FILL, P, g, PK) do { MF; RD; \
            if (FILL) { const float e0_ = P[4 * ((g) & 3)], e1_ = P[4 * ((g) & 3) + 1], e2_ = P[4 * ((g) & 3) + 2], e3_ = P[4 * ((g) & 3) + 3]; \
                sacc_ += e0_; sacc_ += e1_; sacc_ += e2_; sacc_ += e3_; \
                PK[2 * (g)] = __builtin_bit_cast(float, cvtpk_bf16(e0_, e1_)); PK[2 * (g) + 1] = __builtin_bit_cast(float, cvtpk_bf16(e2_, e3_)); AT_PIN(PK); AT_PIN(sacc_); } \
            AT_SBAR(); } while (0)
#define AT_PHASE_A(C0, C1, P0, P1, KB, FILL) do { float sacc_ = 0.f; \
            AT_SBAR(); AT_KRD2(A, KB, 0); AT_SBAR(); \
            AT_GAPA(C0 = AT_MFMA(kAa, qf0, AT_Z16), AT_KRD2(B, KB, 1), FILL, P0, 0, P0); \
            AT_GAPA(C1 = AT_MFMA(kAb, qf0, AT_Z16), (void)0,           FILL, P0, 1, P0); \
            AT_GAPA(C0 = AT_MFMA(kBa, qf1, C0),     AT_KRD2(A, KB, 2), FILL, P0, 2, P0); \
            AT_GAPA(C1 = AT_MFMA(kBb, qf1, C1),     (void)0,           FILL, P0, 3, P0); \
            AT_GAPA(C0 = AT_MFMA(kAa, qf2, C0),     AT_KRD2(B, KB, 3), FILL, P1, 4, P0); \
            AT_GAPA(C1 = AT_MFMA(kAb, qf2, C1),     (void)0,           FILL, P1, 5, P0); \
            AT_GAPA(C0 = AT_MFMA(kBa, qf3, C0),     (void)0,           FILL, P1, 6, P0); \
            AT_GAPA(C1 = AT_MFMA(kBb, qf3, C1),     (void)0,           FILL, P1, 7, P0); \
            lsum += sacc_; } while (0)
#define AT_MID(C0, C1, t) do { float tm, cadd; \
            if (qlo - (64 * (t) + 63) < 127) { \
                const LAS float* rp = TAB + (qpos - 64 * (t) - 4 * hi + 96 - 59); tm = -INFINITY; \
                _Pragma("unroll") for (int r = 0; r < 16; ++r) { const int off = (r & 3) + 8 * (r >> 2); C0[r] += rp[59 - off]; C1[r] += rp[27 - off]; tm = max3f_(tm, C0[r], C1[r]); } \
                cadd = 0.f; \
            } else { \
                tm = max3f_(C0[0], C1[0], C0[1]); \
                _Pragma("unroll") for (int r = 1; r < 15; ++r) tm = max3f_(tm, C1[r], C0[r + 1]); \
                tm = fmaxf(tm, C1[15]); tm += bfar; cadd = bfar; } \
            tm = xhalf_max(tm); resc = false; \
            if (__any(tm > mrun + 8.f)) { const float mnew = fmaxf(mrun, tm); alpha = __builtin_amdgcn_exp2f(mrun - mnew); lsum *= alpha; mrun = mnew; resc = true; } \
            cexp = cadd - mrun; } while (0)
#define AT_EXP(C0, C1) do { _Pragma("unroll") for (int r = 0; r < 16; ++r) { C0[r] = __builtin_amdgcn_exp2f(C0[r] + cexp); C1[r] = __builtin_amdgcn_exp2f(C1[r] + cexp); } } while (0)
#define AT_GAPB(Fn, g, PK, C, DOEXP) do { o[(g) & 3] = AT_MFMA(AT_VFR(Fn), __builtin_bit_cast(bf16x8, (f32x4){PK[4 * ((g) >> 2)], PK[4 * ((g) >> 2) + 1], PK[4 * ((g) >> 2) + 2], PK[4 * ((g) >> 2) + 3]}), o[(g) & 3]); \
            if ((g) + 2 < 16) AT_VRD(Fn, (g) + 2); \
            if (DOEXP) { C[2 * ((g) & 7)] = __builtin_amdgcn_exp2f(C[2 * ((g) & 7)] + cexp); C[2 * ((g) & 7) + 1] = __builtin_amdgcn_exp2f(C[2 * ((g) & 7) + 1] + cexp); AT_PIN(C); } \
            AT_SBAR(); } while (0)
#define AT_PHASE_B(C0, C1, PK, VB, DOEXP) do { LAS unsigned char* vb_ = lds + (VB) + voff; \
            AT_SBAR(); AT_VRD(f0, 0); AT_VRD(f1, 1); AT_SBAR(); \
            AT_GAPB(f0, 0, PK, C0, DOEXP);  AT_GAPB(f1, 1, PK, C0, DOEXP);  AT_GAPB(f0, 2, PK, C0, DOEXP);  AT_GAPB(f1, 3, PK, C0, DOEXP); \
            AT_GAPB(f0, 4, PK, C0, DOEXP);  AT_GAPB(f1, 5, PK, C0, DOEXP);  AT_GAPB(f0, 6, PK, C0, DOEXP);  AT_GAPB(f1, 7, PK, C0, DOEXP); \
            AT_GAPB(f0, 8, PK, C1, DOEXP);  AT_GAPB(f1, 9, PK, C1, DOEXP);  AT_GAPB(f0, 10, PK, C1, DOEXP); AT_GAPB(f1, 11, PK, C1, DOEXP); \
            AT_GAPB(f0, 12, PK, C1, DOEXP); AT_GAPB(f1, 13, PK, C1, DOEXP); AT_GAPB(f0, 14, PK, C1, DOEXP); AT_GAPB(f1, 15, PK, C1, DOEXP); } while (0)
#define AT_RESC() do { if (resc) { _Pragma("unroll") for (int mt = 0; mt < 4; ++mt) o[mt] = o[mt] * alpha; } } while (0)
#define AT_STAGE(t) do { if ((t) + 1 < NT) { \
                _Pragma("unroll") for (int i = 0; i < 2; ++i) { *(LAS v4u*)(lds + (((t) + 1) & 1) * AT_KS + kdst + 32 * i * AT_KP) = kr[i]; *(LAS v4u*)(lds + vs_next + vdst + 32 * i * AT_VP) = vr[i]; } \
                if ((t) + 2 < NT) { _Pragma("unroll") for (int i = 0; i < 2; ++i) { kr[i] = AT_GLD(ksrc, 64 * ((t) + 2) + 32 * i); vr[i] = AT_GLD(vsrc, 64 * ((t) + 2) + 32 * i); } } } \
            __syncthreads(); AT_ROT(); } while (0)
#define AT_STEP(C0, C1, P0, P1, t) do { \
            AT_PHASE_A(C0, C1, P0, P1, ((t) & 1) * AT_KS, 1); \
            AT_MID(C0, C1, t); \
            AT_PHASE_B(C0, C1, P0, vs_prev, 1); \
            AT_RESC(); } while (0)
#define AT_PACK(P0, P1) do { float ps_ = 0.f; \
            _Pragma("unroll") for (int r = 0; r < 16; ++r) ps_ += P0[r] + P1[r]; \
            lsum += ps_; \
            _Pragma("unroll") for (int w = 0; w < 8; ++w) { const float lo_ = P0[2 * w], hi_ = P0[2 * w + 1]; P0[w] = __builtin_bit_cast(float, cvtpk_bf16(lo_, hi_)); } \
            _Pragma("unroll") for (int w = 0; w < 8; ++w) P0[8 + w] = __builtin_bit_cast(float, cvtpk_bf16(P1[2 * w], P1[2 * w + 1])); } while (0)
        AT_PHASE_A(pA0, pA1, pA0, pA1, 0, 0); AT_MID(pA0, pA1, 0); AT_EXP(pA0, pA1); AT_RESC();
        AT_STAGE(0);
        if (tid == 0) F.MISC[12] = nxtu;
        int t = 1;
        for (; t + 1 < NT; t += 2) {
            AT_STEP(pB0, pB1, pA0, pA1, t);     AT_STAGE(t);
            AT_STEP(pA0, pA1, pB0, pB1, t + 1); AT_STAGE(t + 1);
        }
        if (NTW == NT) {
            AT_STEP(pB0, pB1, pA0, pA1, t); AT_ROT();
            AT_PACK(pB0, pB1); AT_PHASE_B(pB0, pB1, pB0, vs_prev, 0);
        } else {
            AT_PACK(pA0, pA1); AT_PHASE_B(pA0, pA1, pA0, vs_prev, 0);
        }
        __syncthreads();
        { int lane_e = F.lane; asm volatile("" : "+v"(lane_e));
        const int lane = lane_e, r32 = lane & 31, hi = lane >> 5;
        const float inv = 1.f / xhalf_sum(lsum);
        LAS float* XO = (LAS float*)(lds + AT_XO) + qt * 4096 + r32;
        if (map == 1) {
            const float sc = inv * small[SM_LAM];
#pragma unroll
            for (int mt = 0; mt < 4; ++mt)
#pragma unroll
                for (int r = 0; r < 16; ++r) XO[(32 * mt + (r & 3) + 8 * (r >> 2) + 4 * hi) * 32] = o[mt][r] * sc;
        }
        __syncthreads();
        if (map == 0) {
            float ss = 0.f;
#pragma unroll
            for (int mt = 0; mt < 4; ++mt)
#pragma unroll
                for (int r = 0; r < 16; ++r) { const float a = o[mt][r] * inv - XO[(32 * mt + (r & 3) + 8 * (r >> 2) + 4 * hi) * 32]; o[mt][r] = a; ss += a * a; }
            ss = xhalf_sum(ss);
            const float rr = (1.f - LAM_INIT) / sqrtf(ss * (1.f / 128.f) + EPS);
            LAS unsigned char* yb = lds + AT_YB + qt * (32 * AT_YP);
#pragma unroll
            for (int mt = 0; mt < 4; ++mt)
#pragma unroll
                for (int r4 = 0; r4 < 4; ++r4) { const int dv = 32 * mt + 8 * r4 + 4 * hi; const f32x4 gg = *(const GAS f32x4*)(F.in[7] + dv);
                    v2u w; w.x = cvtpk_bf16(o[mt][4 * r4] * rr * gg.x, o[mt][4 * r4 + 1] * rr * gg.y); w.y = cvtpk_bf16(o[mt][4 * r4 + 2] * rr * gg.z, o[mt][4 * r4 + 3] * rr * gg.w);
                    *(LAS v2u*)(yb + r32 * AT_YP + dv * 2) = w; }
            LDS_WAIT(); asm volatile("" ::: "memory");
            bf16* obase = MIXED + (tok0 + q0 + 32 * qt) * DM + h * 128;
#pragma unroll
            for (int i = 0; i < 8; ++i) { const int id = lane + 64 * i, row = id >> 4, cch = id & 15;
                const v4u w = *(const LAS v4u*)(yb + row * AT_YP + cch * 16); *(GAS v4u*)(obase + (size_t)row * DM + cch * 8) = w; }
        } }
#undef AT_ROT
#undef AT_GLD
#undef AT_KRD2
#undef AT_VRD
#undef AT_VFR
#undef AT_GAPA
#undef AT_GAPB
#undef AT_PHASE_A
#undef AT_PHASE_B
#undef AT_PACK
#undef AT_MID
#undef AT_EXP
#undef AT_RESC
#undef AT_STAGE
#undef AT_STEP
    }
}

constexpr int HG_P = 288, HG_VP = 320, HG_GP = 272, HG_OP = 136;
constexpr int HG_QD = 0, HG_KI = 32 * HG_P, HG_V = 2 * 32 * HG_P, HG_CD = HG_V + 32 * HG_VP, HG_G = HG_CD + 512, HG_BUF = HG_G + 32 * HG_GP;
constexpr int HG_O = 2 * HG_BUF;
static_assert(HG_O + 32 * HG_OP * 4 <= RING_BYTES, "hgrn LDS map");
__device__ __forceinline__ bf16x8 pack8(const f32x16& x, int s) {
    v4u p; p.x = cvtpk_bf16(x[8 * s], x[8 * s + 1]); p.y = cvtpk_bf16(x[8 * s + 2], x[8 * s + 3]); p.z = cvtpk_bf16(x[8 * s + 4], x[8 * s + 5]); p.w = cvtpk_bf16(x[8 * s + 6], x[8 * s + 7]);
    return __builtin_bit_cast(bf16x8, p);
}
__device__ __forceinline__ bf16x8 tr_pair(LAS unsigned char* p0, LAS unsigned char* p1) {
    const s16x4 lo = __builtin_bit_cast(s16x4, __builtin_amdgcn_ds_read_tr16_b64_v4i16((LAS v4i16_t*)p0));
    const s16x4 hi4 = __builtin_bit_cast(s16x4, __builtin_amdgcn_ds_read_tr16_b64_v4i16((LAS v4i16_t*)p1));
    return (bf16x8){lo[0], lo[1], lo[2], lo[3], hi4[0], hi4[1], hi4[2], hi4[3]};
}
#define DPPF_(x, ctrl) __builtin_bit_cast(float, __builtin_amdgcn_update_dpp(0, __builtin_bit_cast(int, (x)), (ctrl), 0xf, 0xf, true))
__device__ __forceinline__ void hg_prep8(LAS unsigned char* bufp, const v4u rq, const v4u rf, const f32x4 lbA, const f32x4 lbB, int pc, int dk8, int lane) {
    const float lbv[8] = {lbA.x, lbA.y, lbA.z, lbA.w, lbB.x, lbB.y, lbB.z, lbB.w};
    float bb[8], fv[8];
    const unsigned fw[4] = {rf.x, rf.y, rf.z, rf.w}, qw[4] = {rq.x, rq.y, rq.z, rq.w};
#pragma unroll
    for (int i = 0; i < 8; ++i) { const float x = (i & 1) ? bfhi(fw[i >> 1]) : bflo(fw[i >> 1]); const float f = lbv[i] + (1.f - lbv[i]) * __builtin_amdgcn_rcpf(1.f + __expf(-x)); fv[i] = f; bb[i] = f; }
#define HG_SCAN_STEP(ctrl) asm volatile("s_nop 1\n\tv_mul_f32_dpp %0, %0, %0 " ctrl "\n\tv_mul_f32_dpp %1, %1, %1 " ctrl "\n\tv_mul_f32_dpp %2, %2, %2 " ctrl "\n\tv_mul_f32_dpp %3, %3, %3 " ctrl "\n\t" \
        "v_mul_f32_dpp %4, %4, %4 " ctrl "\n\tv_mul_f32_dpp %5, %5, %5 " ctrl "\n\tv_mul_f32_dpp %6, %6, %6 " ctrl "\n\tv_mul_f32_dpp %7, %7, %7 " ctrl \
        : "+v"(bb[0]), "+v"(bb[1]), "+v"(bb[2]), "+v"(bb[3]), "+v"(bb[4]), "+v"(bb[5]), "+v"(bb[6]), "+v"(bb[7]))
    HG_SCAN_STEP("row_shr:1 row_mask:0xf bank_mask:0xf");
    HG_SCAN_STEP("row_shr:2 row_mask:0xf bank_mask:0xf");
    HG_SCAN_STEP("row_shr:4 row_mask:0xf bank_mask:0xf");
    HG_SCAN_STEP("row_shr:8 row_mask:0xf bank_mask:0xf");
    HG_SCAN_STEP("row_bcast:15 row_mask:0xa bank_mask:0xf");
#undef HG_SCAN_STEP
    float qd[8], ki[8];
#pragma unroll
    for (int i = 0; i < 8; ++i) { const float e = bb[i], ei = __builtin_amdgcn_rcpf(bb[i]);
        const float xq = (i & 1) ? bfhi(qw[i >> 1]) : bflo(qw[i >> 1]); const float q = xq * __builtin_amdgcn_rcpf(1.f + __expf(-xq)); const float k = 1.f - fv[i];
        qd[i] = q * e; ki[i] = k * ei; }
    *(LAS v4u*)(bufp + HG_QD + pc * HG_P + dk8 * 2) = (v4u){cvtpk_bf16(qd[0], qd[1]), cvtpk_bf16(qd[2], qd[3]), cvtpk_bf16(qd[4], qd[5]), cvtpk_bf16(qd[6], qd[7])};
    *(LAS v4u*)(bufp + HG_KI + pc * HG_P + dk8 * 2) = (v4u){cvtpk_bf16(ki[0], ki[1]), cvtpk_bf16(ki[2], ki[3]), cvtpk_bf16(ki[4], ki[5]), cvtpk_bf16(ki[6], ki[7])};
    if (pc == 31) { *(LAS f32x4*)(bufp + HG_CD + dk8 * 4) = (f32x4){bb[0], bb[1], bb[2], bb[3]}; *(LAS f32x4*)(bufp + HG_CD + dk8 * 4 + 16) = (f32x4){bb[4], bb[5], bb[6], bb[7]}; }
}
__device__ __forceinline__ void hgrn_mfma(Frame& F) {
    const bf16* PROJ = (const bf16*)(F.ws + WS_PROJ); bf16* MIXED = (bf16*)(F.ws + WS_HN);
    const float* small = (const float*)(F.ws + WS_SMALL);
    LAS unsigned char* lds = F.lds;
    const int tid = F.tid, lane = F.lane, wave = F.wave, r32 = lane & 31, hh = lane >> 5;
    for (int u = F.vcu; u < 64; u += F.G) {
        const int b = u >> 2, h = u & 3; const size_t tok0 = (size_t)b * SEQ;
        __syncthreads();
        if (wave >= 4) {
            const int pt = tid - 256, pc = lane & 31, dkA = 16 * (wave - 4) + 8 * hh;
            const int vcA = pt >> 4, vseg = pt & 15;
            const f32x4 lb0 = *(const GAS f32x4*)(small + SM_LB + h * 128 + dkA), lb1 = *(const GAS f32x4*)(small + SM_LB + h * 128 + dkA + 4);
            const f32x4 lb2 = *(const GAS f32x4*)(small + SM_LB + h * 128 + dkA + 64), lb3 = *(const GAS f32x4*)(small + SM_LB + h * 128 + dkA + 68);
            v4u q0A, f0A, v0A, g0A, q1A, f1A, v1A, g1A, q0B, f0B, v0B, g0B, q1B, f1B, v1B, g1B, q0C, f0C, v0C, g0C, q1C, f1C, v1C, g1C, q0D, f0D, v0D, g0D, q1D, f1D, v1D, g1D;
#define HP_LOAD(S, chn) do { const bf16* p_ = PROJ + (tok0 + 32 * (chn) + pc) * INW + h * 128 + dkA; const bf16* v_ = PROJ + (tok0 + 32 * (chn) + vcA) * INW + h * 128 + vseg * 8; \
            asm volatile("global_load_dwordx4 %0, %1, off" : "=v"(q0##S) : "v"(p_ + C_HQ) : "memory"); \
            asm volatile("global_load_dwordx4 %0, %1, off" : "=v"(f0##S) : "v"(p_ + C_HF) : "memory"); \
            asm volatile("global_load_dwordx4 %0, %1, off" : "=v"(v0##S) : "v"(v_ + C_HI) : "memory"); \
            asm volatile("global_load_dwordx4 %0, %1, off" : "=v"(g0##S) : "v"(v_ + C_HG) : "memory"); \
            asm volatile("global_load_dwordx4 %0, %1, off" : "=v"(q1##S) : "v"(p_ + C_HQ + 64) : "memory"); \
            asm volatile("global_load_dwordx4 %0, %1, off" : "=v"(f1##S) : "v"(p_ + C_HF + 64) : "memory"); \
            asm volatile("global_load_dwordx4 %0, %1, off" : "=v"(v1##S) : "v"(v_ + (size_t)16 * INW + C_HI) : "memory"); \
            asm volatile("global_load_dwordx4 %0, %1, off" : "=v"(g1##S) : "v"(v_ + (size_t)16 * INW + C_HG) : "memory"); } while (0)
#define HP_WAIT(S) asm volatile("s_waitcnt vmcnt(24)" : "+v"(q0##S), "+v"(f0##S), "+v"(v0##S), "+v"(g0##S), "+v"(q1##S), "+v"(f1##S), "+v"(v1##S), "+v"(g1##S) :: "memory")
#define HP_PASS0(S, bufp) do { hg_prep8(bufp, q0##S, f0##S, lb0, lb1, pc, dkA, lane); \
            *(LAS v4u*)((bufp) + HG_V + vcA * HG_VP + vseg * 16) = v0##S; *(LAS v4u*)((bufp) + HG_V + (vcA + 16) * HG_VP + vseg * 16) = v1##S; \
            *(LAS v4u*)((bufp) + HG_G + vcA * HG_GP + vseg * 16) = g0##S; *(LAS v4u*)((bufp) + HG_G + (vcA + 16) * HG_GP + vseg * 16) = g1##S; } while (0)
#define HP_PASS1(S, bufp) hg_prep8(bufp, q1##S, f1##S, lb2, lb3, pc, dkA + 64, lane)
#define HP_CL(c) ((c) < SEQ / 32 ? (c) : SEQ / 32 - 1)
            HP_LOAD(A, 0); HP_LOAD(B, 1); HP_LOAD(C, 2); HP_LOAD(D, 3);
            HP_WAIT(A); HP_PASS0(A, lds); HP_PASS1(A, lds);
            HP_LOAD(A, 4);
            for (int ch4 = 0; ch4 < SEQ / 32; ch4 += 4) {
                __syncthreads();
                HP_WAIT(B); HP_PASS0(B, lds + HG_BUF);
                __syncthreads();
                HP_PASS1(B, lds + HG_BUF); HP_LOAD(B, HP_CL(ch4 + 5));
                __syncthreads();
                HP_WAIT(C); HP_PASS0(C, lds);
                __syncthreads();
                HP_PASS1(C, lds); HP_LOAD(C, HP_CL(ch4 + 6));
                __syncthreads();
                HP_WAIT(D); HP_PASS0(D, lds + HG_BUF);
                __syncthreads();
                HP_PASS1(D, lds + HG_BUF); HP_LOAD(D, HP_CL(ch4 + 7));
                __syncthreads();
                HP_WAIT(A); HP_PASS0(A, lds);
                __syncthreads();
                HP_PASS1(A, lds); HP_LOAD(A, HP_CL(ch4 + 8));
            }
            asm volatile("s_waitcnt vmcnt(0)" : "+v"(q0A), "+v"(f0A), "+v"(v0A), "+v"(g0A), "+v"(q1A), "+v"(f1A), "+v"(v1A), "+v"(g1A), "+v"(q0B), "+v"(f0B), "+v"(v0B), "+v"(g0B), "+v"(q1B), "+v"(f1B), "+v"(v1B), "+v"(g1B) :: "memory");
            asm volatile("" : "+v"(q0C), "+v"(f0C), "+v"(v0C), "+v"(g0C), "+v"(q1C), "+v"(f1C), "+v"(v1C), "+v"(g1C), "+v"(q0D), "+v"(f0D), "+v"(v0D), "+v"(g0D), "+v"(q1D), "+v"(f1D), "+v"(v1D), "+v"(g1D) :: "memory");
#undef HP_CL
#undef HP_LOAD
#undef HP_WAIT
#undef HP_PASS0
#undef HP_PASS1
        } else {
            const int dvt = wave;
            const int kdoff = (((lane & 15) >> 2)) * HG_P + (16 * ((lane >> 4) & 1) + 4 * (lane & 3)) * 2;
            const int troff = (((lane & 15) >> 2)) * HG_VP + (32 * dvt + 16 * ((lane >> 4) & 1) + 4 * (lane & 3)) * 2;
            const int vc = tid >> 3, sg = tid & 7;
            const f32x4 ga0 = *(const GAS f32x4*)(F.in[10] + 8 * sg), ga1 = *(const GAS f32x4*)(F.in[10] + 8 * sg + 4);
            const f32x4 gb0 = *(const GAS f32x4*)(F.in[10] + 64 + 8 * sg), gb1 = *(const GAS f32x4*)(F.in[10] + 64 + 8 * sg + 4);
            f32x16 S0, S1, S2, S3;
#pragma unroll
            for (int r = 0; r < 16; ++r) { S0[r] = 0.f; S1[r] = 0.f; S2[r] = 0.f; S3[r] = 0.f; }
            for (int ch = 0; ch < SEQ / 32; ++ch) {
                LAS unsigned char* bufp = lds + (ch & 1) * HG_BUF;
                __syncthreads();
                f32x16 o, X;
#pragma unroll
                for (int r = 0; r < 16; ++r) { o[r] = 0.f; X[r] = 0.f; }
                bf16x8 qaf[8], kif[8], qdf[8];
                __builtin_amdgcn_sched_barrier(0);
#pragma unroll
                for (int i = 0; i < 8; ++i) { LAS unsigned char* qa = bufp + HG_QD + r32 * HG_P + (16 * i + 4 * hh) * 2;
                    const v2u a0 = *(const LAS v2u*)qa, a1 = *(const LAS v2u*)(qa + 16); qaf[i] = __builtin_bit_cast(bf16x8, (v4u){a0.x, a0.y, a1.x, a1.y}); }
#pragma unroll
                for (int s8 = 0; s8 < 4; ++s8) { kif[s8] = *(const LAS bf16x8*)(bufp + HG_KI + r32 * HG_P + (16 * s8 + 8 * hh) * 2); qdf[s8] = *(const LAS bf16x8*)(bufp + HG_QD + r32 * HG_P + (16 * s8 + 8 * hh) * 2); }
                __builtin_amdgcn_sched_barrier(0);
#pragma unroll
                for (int i = 0; i < 8; ++i)
                    o = __builtin_amdgcn_mfma_f32_32x32x16_bf16(qaf[i], pack8((i >> 1) == 0 ? S0 : (i >> 1) == 1 ? S1 : (i >> 1) == 2 ? S2 : S3, i & 1), o, 0, 0, 0);
#pragma unroll
                for (int s8 = 4; s8 < 8; ++s8) { kif[s8] = *(const LAS bf16x8*)(bufp + HG_KI + r32 * HG_P + (16 * s8 + 8 * hh) * 2); qdf[s8] = *(const LAS bf16x8*)(bufp + HG_QD + r32 * HG_P + (16 * s8 + 8 * hh) * 2); }
                bf16x8 vx0, vx1;
                { LAS unsigned char* vp = bufp + HG_V + troff + (4 * hh) * HG_VP; vx0 = tr_pair(vp, vp + 8 * HG_VP); vx1 = tr_pair(vp + 16 * HG_VP, vp + 24 * HG_VP); }
                __builtin_amdgcn_sched_barrier(0);
#pragma unroll
                for (int s8 = 0; s8 < 8; ++s8) X = __builtin_amdgcn_mfma_f32_32x32x16_bf16(kif[s8], qdf[s8], X, 0, 0, 0);
                __builtin_amdgcn_sched_barrier(0);
#pragma unroll
                for (int r = 0; r < 16; ++r) { const int cp = (r & 3) + 8 * (r >> 2) + 4 * hh; X[r] = cp > r32 ? 0.f : X[r]; }
                o = __builtin_amdgcn_mfma_f32_32x32x16_bf16(pack8(X, 0), vx0, o, 0, 0, 0);
                o = __builtin_amdgcn_mfma_f32_32x32x16_bf16(pack8(X, 1), vx1, o, 0, 0, 0);
                { LAS float* ob = (LAS float*)(lds + HG_O) + 32 * dvt + r32;
#pragma unroll
                  for (int r = 0; r < 16; ++r) ob[((r & 3) + 8 * (r >> 2) + 4 * hh) * HG_OP] = o[r]; }
                __syncthreads();
                { bf16x8 kaf[8], vbf[2];
                  __builtin_amdgcn_sched_barrier(0);
#pragma unroll
                  for (int s2 = 0; s2 < 2; ++s2) { LAS unsigned char* vp = bufp + HG_V + troff + (16 * s2 + 8 * hh) * HG_VP; vbf[s2] = tr_pair(vp, vp + 4 * HG_VP); }
#pragma unroll
                  for (int i = 0; i < 8; ++i) { LAS unsigned char* kp = bufp + HG_KI + kdoff + (16 * (i & 1) + 8 * hh) * HG_P + 32 * (i >> 1) * 2;
                      kaf[i] = tr_pair(kp, kp + 4 * HG_P); }
                  __builtin_amdgcn_sched_barrier(0);
#pragma unroll
                  for (int i = 0; i < 8; ++i) {
                      if ((i >> 1) == 0)      S0 = __builtin_amdgcn_mfma_f32_32x32x16_bf16(kaf[i], vbf[i & 1], S0, 0, 0, 0);
                      else if ((i >> 1) == 1) S1 = __builtin_amdgcn_mfma_f32_32x32x16_bf16(kaf[i], vbf[i & 1], S1, 0, 0, 0);
                      else if ((i >> 1) == 2) S2 = __builtin_amdgcn_mfma_f32_32x32x16_bf16(kaf[i], vbf[i & 1], S2, 0, 0, 0);
                      else                    S3 = __builtin_amdgcn_mfma_f32_32x32x16_bf16(kaf[i], vbf[i & 1], S3, 0, 0, 0);
                  }
                  __builtin_amdgcn_sched_barrier(0); }
#pragma unroll
                for (int kk = 0; kk < 4; ++kk) {
                    const LAS float* cdp = (const LAS float*)(bufp + HG_CD) + 32 * kk + 4 * hh;
#pragma unroll
                    for (int r4 = 0; r4 < 4; ++r4) { const f32x4 c4 = *(const LAS f32x4*)(cdp + 8 * r4);
                        if (kk == 0)      { S0[4 * r4] *= c4.x; S0[4 * r4 + 1] *= c4.y; S0[4 * r4 + 2] *= c4.z; S0[4 * r4 + 3] *= c4.w; }
                        else if (kk == 1) { S1[4 * r4] *= c4.x; S1[4 * r4 + 1] *= c4.y; S1[4 * r4 + 2] *= c4.z; S1[4 * r4 + 3] *= c4.w; }
                        else if (kk == 2) { S2[4 * r4] *= c4.x; S2[4 * r4 + 1] *= c4.y; S2[4 * r4 + 2] *= c4.z; S2[4 * r4 + 3] *= c4.w; }
                        else              { S3[4 * r4] *= c4.x; S3[4 * r4 + 1] *= c4.y; S3[4 * r4 + 2] *= c4.z; S3[4 * r4 + 3] *= c4.w; } }
                }
                { const LAS float* op = (const LAS float*)(lds + HG_O) + vc * HG_OP + 8 * sg;
                  const f32x4 x0 = *(const LAS f32x4*)op, x1 = *(const LAS f32x4*)(op + 4), x2 = *(const LAS f32x4*)(op + 64), x3 = *(const LAS f32x4*)(op + 68);
                  const v4u gwa = *(const LAS v4u*)(bufp + HG_G + vc * HG_GP + sg * 16), gwb = *(const LAS v4u*)(bufp + HG_G + vc * HG_GP + (sg + 8) * 16);
                  float ss = ((x0.x * x0.x + x0.y * x0.y) + (x0.z * x0.z + x0.w * x0.w)) + ((x1.x * x1.x + x1.y * x1.y) + (x1.z * x1.z + x1.w * x1.w))
                           + ((x2.x * x2.x + x2.y * x2.y) + (x2.z * x2.z + x2.w * x2.w)) + ((x3.x * x3.x + x3.y * x3.y) + (x3.z * x3.z + x3.w * x3.w));
                  ss += DPPF_(ss, 0xB1); ss += DPPF_(ss, 0x4E); ss += DPPF_(ss, 0x141);
                  const float rr = __builtin_amdgcn_rsqf(ss * (1.f / 128.f) + EPS);
                  const size_t tok = tok0 + 32 * ch + vc;
                  const unsigned gwa_[4] = {gwa.x, gwa.y, gwa.z, gwa.w}, gwb_[4] = {gwb.x, gwb.y, gwb.z, gwb.w};
                  const float ova[8] = {x0.x, x0.y, x0.z, x0.w, x1.x, x1.y, x1.z, x1.w}, ovb[8] = {x2.x, x2.y, x2.z, x2.w, x3.x, x3.y, x3.z, x3.w};
                  const float gga[8] = {ga0.x, ga0.y, ga0.z, ga0.w, ga1.x, ga1.y, ga1.z, ga1.w}, ggb[8] = {gb0.x, gb0.y, gb0.z, gb0.w, gb1.x, gb1.y, gb1.z, gb1.w};
                  unsigned wa[4], wb[4];
#pragma unroll
                  for (int j = 0; j < 4; ++j) { const float a0 = bflo(gwa_[j]), a1 = bfhi(gwa_[j]), b0 = bflo(gwb_[j]), b1 = bfhi(gwb_[j]);
                      wa[j] = cvtpk_bf16(ova[2 * j] * rr * gga[2 * j] * (a0 * __builtin_amdgcn_rcpf(1.f + __expf(-a0))), ova[2 * j + 1] * rr * gga[2 * j + 1] * (a1 * __builtin_amdgcn_rcpf(1.f + __expf(-a1))));
                      wb[j] = cvtpk_bf16(ovb[2 * j] * rr * ggb[2 * j] * (b0 * __builtin_amdgcn_rcpf(1.f + __expf(-b0))), ovb[2 * j + 1] * rr * ggb[2 * j + 1] * (b1 * __builtin_amdgcn_rcpf(1.f + __expf(-b1)))); }
                  bf16* dst = MIXED + tok * DM + 512 + h * 128 + 8 * sg;
                  *(GAS v4u*)dst = (v4u){wa[0], wa[1], wa[2], wa[3]}; *(GAS v4u*)(dst + 64) = (v4u){wb[0], wb[1], wb[2], wb[3]}; }
            }
        }
    }
}
template <int N> __device__ __forceinline__ unsigned row_ror(unsigned x) { return (unsigned)__builtin_amdgcn_update_dpp((int)x, (int)x, 0x120 + N, 0xf, 0xf, false); }
__device__ __forceinline__ unsigned umax_(unsigned a, unsigned b) { return a > b ? a : b; }
__device__ __forceinline__ unsigned umin_(unsigned a, unsigned b) { return a < b ? a : b; }
__device__ __forceinline__ unsigned row_umax16(unsigned x) {
    unsigned y;
    asm volatile("s_nop 1\n\tv_max_u32_dpp %0, %1, %1 row_ror:1 row_mask:0xf bank_mask:0xf\n\t"
                 "s_nop 1\n\tv_max_u32_dpp %0, %0, %0 row_ror:2 row_mask:0xf bank_mask:0xf\n\t"
                 "s_nop 1\n\tv_max_u32_dpp %0, %0, %0 row_ror:4 row_mask:0xf bank_mask:0xf\n\t"
                 "s_nop 1\n\tv_max_u32_dpp %0, %0, %0 row_ror:8 row_mask:0xf bank_mask:0xf"
                 : "=&v"(y) : "v"(x));
    return y;
}
__device__ __forceinline__ float row_fsum16(float v) {
    v += __builtin_bit_cast(float, row_ror<1>(__builtin_bit_cast(unsigned, v))); v += __builtin_bit_cast(float, row_ror<2>(__builtin_bit_cast(unsigned, v)));
    v += __builtin_bit_cast(float, row_ror<4>(__builtin_bit_cast(unsigned, v))); v += __builtin_bit_cast(float, row_ror<8>(__builtin_bit_cast(unsigned, v))); return v; }
__device__ __forceinline__ unsigned h2key(unsigned x) { return (x & 0x80000000u) ? (~x & 0xffff0000u) : (x | 0x80000000u); }
__device__ __forceinline__ float hkey2f(unsigned k) { const unsigned hb = ((k & 0x80000000u) ? (k & 0x7fff0000u) : (~k & 0xffff0000u)) >> 16; return (float)__builtin_bit_cast(_Float16, (unsigned short)hb); }
__device__ __forceinline__ unsigned f2key(float f) { const unsigned u = __builtin_bit_cast(unsigned, f); return (u & 0x80000000u) ? ~u : (u | 0x80000000u); }
__device__ __forceinline__ float key2f(unsigned k) { const unsigned u = (k & 0x80000000u) ? (k & 0x7fffffffu) : ~k; return __builtin_bit_cast(float, u); }
__device__ __forceinline__ unsigned pair_code(int s) {
    if (s < 16) return (unsigned)s;
    if (s < 24) return 16u + (unsigned)(s - 16);
    if (s < 29) return 32u + (unsigned)(s - 24);
    if (s < 33) return 48u + (unsigned)(s - 29);
    if (s < 36) return 64u + (unsigned)(s - 33);
    if (s < 42) return 80u + 16u * (unsigned)((s - 36) >> 1) + (unsigned)((s - 36) & 1);
    if (s < 50) return 128u + 16u * (unsigned)(s - 42);
    return 0xFFu;
}
#define CAS_(a, b) do { const unsigned hi_ = umax_(a, b), lo_ = umin_(a, b); a = hi_; b = lo_; } while (0)
__device__ __forceinline__ void row_umax16_x2(unsigned xa, unsigned xb, unsigned& ya, unsigned& yb) {
    asm volatile("s_nop 1\n\tv_max_u32_dpp %0, %2, %2 row_ror:1 row_mask:0xf bank_mask:0xf\n\tv_max_u32_dpp %1, %3, %3 row_ror:1 row_mask:0xf bank_mask:0xf\n\t"
                 "s_nop 0\n\tv_max_u32_dpp %0, %0, %0 row_ror:2 row_mask:0xf bank_mask:0xf\n\tv_max_u32_dpp %1, %1, %1 row_ror:2 row_mask:0xf bank_mask:0xf\n\t"
                 "s_nop 0\n\tv_max_u32_dpp %0, %0, %0 row_ror:4 row_mask:0xf bank_mask:0xf\n\tv_max_u32_dpp %1, %1, %1 row_ror:4 row_mask:0xf bank_mask:0xf\n\t"
                 "s_nop 0\n\tv_max_u32_dpp %0, %0, %0 row_ror:8 row_mask:0xf bank_mask:0xf\n\tv_max_u32_dpp %1, %1, %1 row_ror:8 row_mask:0xf bank_mask:0xf"
                 : "=&v"(ya), "=&v"(yb) : "v"(xa), "v"(xb));
}
__device__ __forceinline__ void row_umax16_x4(unsigned xa, unsigned xb, unsigned xc, unsigned xd, unsigned& ya, unsigned& yb, unsigned& yc, unsigned& yd) {
    asm volatile("s_nop 1\n\tv_max_u32_dpp %0, %4, %4 row_ror:1 row_mask:0xf bank_mask:0xf\n\tv_max_u32_dpp %1, %5, %5 row_ror:1 row_mask:0xf bank_mask:0xf\n\t"
                 "v_max_u32_dpp %2, %6, %6 row_ror:1 row_mask:0xf bank_mask:0xf\n\tv_max_u32_dpp %3, %7, %7 row_ror:1 row_mask:0xf bank_mask:0xf\n\t"
                 "v_max_u32_dpp %0, %0, %0 row_ror:2 row_mask:0xf bank_mask:0xf\n\tv_max_u32_dpp %1, %1, %1 row_ror:2 row_mask:0xf bank_mask:0xf\n\t"
                 "v_max_u32_dpp %2, %2, %2 row_ror:2 row_mask:0xf bank_mask:0xf\n\tv_max_u32_dpp %3, %3, %3 row_ror:2 row_mask:0xf bank_mask:0xf\n\t"
                 "v_max_u32_dpp %0, %0, %0 row_ror:4 row_mask:0xf bank_mask:0xf\n\tv_max_u32_dpp %1, %1, %1 row_ror:4 row_mask:0xf bank_mask:0xf\n\t"
                 "v_max_u32_dpp %2, %2, %2 row_ror:4 row_mask:0xf bank_mask:0xf\n\tv_max_u32_dpp %3, %3, %3 row_ror:4 row_mask:0xf bank_mask:0xf\n\t"
                 "v_max_u32_dpp %0, %0, %0 row_ror:8 row_mask:0xf bank_mask:0xf\n\tv_max_u32_dpp %1, %1, %1 row_ror:8 row_mask:0xf bank_mask:0xf\n\t"
                 "v_max_u32_dpp %2, %2, %2 row_ror:8 row_mask:0xf bank_mask:0xf\n\tv_max_u32_dpp %3, %3, %3 row_ror:8 row_mask:0xf bank_mask:0xf"
                 : "=&v"(ya), "=&v"(yb), "=&v"(yc), "=&v"(yd) : "v"(xa), "v"(xb), "v"(xc), "v"(xd));
}
#define TK_LOAD(th_) (*(const GAS v4u*)(SC + (size_t)((th_) >> 3) * 2048 + ((th_) & 7) * 256 + c * 128 + l15 * 8))
#define TK_LOADSORT(P, sv_) \
    unsigned P##0, P##1, P##2, P##3, P##4, P##5, P##6, P##7; \
    { const v4u sv = (sv_); const unsigned nb = 127u - 8u * (unsigned)l15; \
      P##0 = h2key(sv.x << 16) | nb; P##1 = h2key(sv.x & 0xffff0000u) | (nb - 1u); P##2 = h2key(sv.y << 16) | (nb - 2u); P##3 = h2key(sv.y & 0xffff0000u) | (nb - 3u); \
      P##4 = h2key(sv.z << 16) | (nb - 4u); P##5 = h2key(sv.z & 0xffff0000u) | (nb - 5u); P##6 = h2key(sv.w << 16) | (nb - 6u); P##7 = h2key(sv.w & 0xffff0000u) | (nb - 7u); \
      CAS_(P##0, P##1); CAS_(P##2, P##3); CAS_(P##4, P##5); CAS_(P##6, P##7); CAS_(P##0, P##2); CAS_(P##1, P##3); CAS_(P##4, P##6); CAS_(P##5, P##7); CAS_(P##1, P##2); CAS_(P##5, P##6); CAS_(P##0, P##4); CAS_(P##3, P##7); \
      CAS_(P##1, P##5); CAS_(P##2, P##6); CAS_(P##1, P##4); CAS_(P##3, P##6); CAS_(P##2, P##4); CAS_(P##3, P##5); CAS_(P##3, P##4); }
#define TK_POP(P, m_) do { const bool pop_ = (P##0 == (m_)); P##0 = pop_ ? P##1 : P##0; P##1 = pop_ ? P##2 : P##1; P##2 = pop_ ? P##3 : P##2; P##3 = pop_ ? P##4 : P##3; \
      P##4 = pop_ ? P##5 : P##4; P##5 = pop_ ? P##6 : P##5; P##6 = pop_ ? P##7 : P##6; P##7 = pop_ ? 0u : P##7; } while (0)
__device__ __forceinline__ void topk_stage1x2(const v4u svA, const v4u svB, int l15, unsigned& resA, unsigned& resB) {
    TK_LOADSORT(ka, svA) TK_LOADSORT(kb, svB)
    unsigned ra = 0u, rb = 0u;
#pragma unroll
    for (int r = 0; r < 16; ++r) {
        unsigned ma, mb; row_umax16_x2(ka0, kb0, ma, mb);
        TK_POP(ka, ma); TK_POP(kb, mb);
        ra = (l15 == r) ? ma : ra; rb = (l15 == r) ? mb : rb;
    }
    resA = ra; resB = rb;
}
__device__ __forceinline__ void topk_stage1x4(const v4u svA, const v4u svB, const v4u svC, const v4u svD, int l15, unsigned& resA, unsigned& resB, unsigned& resC, unsigned& resD) {
    TK_LOADSORT(ka, svA) TK_LOADSORT(kb, svB) TK_LOADSORT(kc, svC) TK_LOADSORT(kd, svD)
    unsigned ra = 0u, rb = 0u, rc = 0u, rd = 0u;
#pragma unroll
    for (int r = 0; r < 16; ++r) {
        unsigned ma, mb, mc, md; row_umax16_x4(ka0, kb0, kc0, kd0, ma, mb, mc, md);
        TK_POP(ka, ma); TK_POP(kb, mb); TK_POP(kc, mc); TK_POP(kd, md);
        ra = (l15 == r) ? ma : ra; rb = (l15 == r) ? mb : rb; rc = (l15 == r) ? mc : rc; rd = (l15 == r) ? md : rd;
    }
    resA = ra; resB = rb; resC = rc; resD = rd;
}
__device__ __forceinline__ void topk_v2(Frame& F) {
    const unsigned short* SC = (const unsigned short*)(F.ws + WS_SC); int* IDX = (int*)(F.ws + WS_IDX); float* GATE = (float*)(F.ws + WS_GATE); float* GSU = (float*)(F.ws + WS_GSU);
    const float* SU = (const float*)(F.ws + WS_SU); const float* SV = (const float*)(F.ws + WS_SV);
    const int gw = F.vcu * NWAVES + F.wave, NGW = F.G * NWAVES, lane = F.lane, l15 = lane & 15, row = lane >> 4, c = row & 1, rbase = lane & 48;
    const unsigned pc0 = pair_code(l15), pc1 = pair_code(l15 + 16), pc2 = pair_code(l15 + 32), pc3 = pair_code(l15 + 48);
    const int src1 = l15 + 32 * (row & 1), src2 = src1 + 16;
    for (int it0 = gw * 32; it0 < NTOK * 2; it0 += NGW * 32) {
    v4u svA = TK_LOAD(4 * it0 + (row >> 1)), svB = TK_LOAD(4 * it0 + 2 + (row >> 1)), svC = TK_LOAD(4 * it0 + 4 + (row >> 1)), svD = TK_LOAD(4 * it0 + 6 + (row >> 1));
    for (int it = it0; it < it0 + 32; it += 2) {
        const int thb = 4 * it; const int thn = 4 * (it + 2 < it0 + 32 ? it + 2 : it);
        const v4u nvA = TK_LOAD(thn + (row >> 1)), nvB = TK_LOAD(thn + 2 + (row >> 1)), nvC = TK_LOAD(thn + 4 + (row >> 1)), nvD = TK_LOAD(thn + 6 + (row >> 1));
        unsigned resA, resB, resC, resD; topk_stage1x4(svA, svB, svC, svD, l15, resA, resB, resC, resD); svA = nvA; svB = nvB; svC = nvC; svD = nvD;
#define TK_S12(RA_, RB_, S1_, S2_) const unsigned S1_##a = (unsigned)__shfl((int)RA_, src1), S2_##a = (unsigned)__shfl((int)RA_, src2), S1_##b = (unsigned)__shfl((int)RB_, src1), S2_##b = (unsigned)__shfl((int)RB_, src2); \
        const unsigned S1_ = row < 2 ? S1_##a : S1_##b, S2_ = row < 2 ? S2_##a : S2_##b
        TK_S12(resA, resB, S1x, S2x); TK_S12(resC, resD, S1y, S2y);
#undef TK_S12
        unsigned c0, c1, c2, c3, d0, d1, d2, d3;
#define TK_CAND(CK, PC, S1_, S2_) do { const unsigned ka_ = (unsigned)__shfl((int)S1_, rbase + (int)((PC) >> 4 & 15u)), kb_ = (unsigned)__shfl((int)S2_, rbase + (int)((PC) & 15u)); \
            const float sm_ = hkey2f(ka_) + hkey2f(kb_); CK = (PC) == 0xFFu ? 0u : ((f2key(sm_) & ~0xFFu) | (255u - (PC))); } while (0)
        TK_CAND(c0, pc0, S1x, S2x); TK_CAND(c1, pc1, S1x, S2x); TK_CAND(c2, pc2, S1x, S2x); TK_CAND(c3, pc3, S1x, S2x);
        TK_CAND(d0, pc0, S1y, S2y); TK_CAND(d1, pc1, S1y, S2y); TK_CAND(d2, pc2, S1y, S2y); TK_CAND(d3, pc3, S1y, S2y);
#undef TK_CAND
        CAS_(c0, c1); CAS_(c2, c3); CAS_(c0, c2); CAS_(c1, c3); CAS_(c1, c2);
        CAS_(d0, d1); CAS_(d2, d3); CAS_(d0, d2); CAS_(d1, d3); CAS_(d1, d2);
        unsigned res2x = 0u, res2y = 0u;
#pragma unroll
        for (int r = 0; r < 16; ++r) {
            unsigned mx, my; row_umax16_x2(c0, d0, mx, my);
            const bool popx = (c0 == mx), popy = (d0 == my);
            c0 = popx ? c1 : c0; c1 = popx ? c2 : c1; c2 = popx ? c3 : c2; c3 = popx ? 0u : c3;
            d0 = popy ? d1 : d0; d1 = popy ? d2 : d1; d2 = popy ? d3 : d2; d3 = popy ? 0u : d3;
            res2x = (l15 == r) ? mx : res2x; res2y = (l15 == r) ? my : res2y;
        }
#define TK_FIN(RES2_, S1_, S2_, TH_) do { const unsigned code = 255u - ((RES2_) & 0xFFu); \
            const unsigned ka = (unsigned)__shfl((int)S1_, rbase + (int)(code >> 4 & 15u)), kb = (unsigned)__shfl((int)S2_, rbase + (int)(code & 15u)); \
            const float ts = hkey2f(ka) + hkey2f(kb); \
            const int e = (int)((127u - (ka & 0x7Fu)) * 128u + (127u - (kb & 0x7Fu))); \
            const float sve = SV[e], sue = SU[e];                                \
            const float tmax = __builtin_bit_cast(float, (unsigned)__shfl((int)__builtin_bit_cast(unsigned, ts), rbase)); \
            const float ex = __expf(ts - tmax); \
            const float sum = row_fsum16(ex); \
            const int th = (TH_) + row; \
            const size_t o = (size_t)(th >> 3) * NEXP_SEL + (th & 7) * 16 + l15; \
            IDX[o] = e; GATE[o] = ex / sum * sve; GSU[o] = sue; } while (0)
        TK_FIN(res2x, S1x, S2x, thb); TK_FIN(res2y, S1y, S2y, thb + 4);
#undef TK_FIN
    } }
}

constexpr int PG_TOK = 16;
constexpr int PG_IDX = 0, PG_HID = 4096, PG_SA = PG_HID + 8192, PG_TB = PG_SA + 64, PG_WB = PG_TB + 4096;
static_assert(PG_WB % 16 == 0 && PG_TB % 16 == 0 && NWAVES * PG_WB <= RING_BYTES, "gather LDS map");
typedef int pgv4i __attribute__((ext_vector_type(4))); typedef int pgv8i __attribute__((ext_vector_type(8)));
__device__ __forceinline__ pgv8i pg_cat8(const l2 a, const l2 b) { const pgv4i x = __builtin_bit_cast(pgv4i, a), y = __builtin_bit_cast(pgv4i, b); return __builtin_shufflevector(x, y, 0, 1, 2, 3, 4, 5, 6, 7); }
__device__ __forceinline__ pgv8i pg_lo8(const l2 a) { const pgv4i x = __builtin_bit_cast(pgv4i, a); return (pgv8i){x[0], x[1], x[2], x[3], 0, 0, 0, 0}; }
__device__ __forceinline__ f32x4 f8x4(unsigned p) { const auto lo = __builtin_amdgcn_cvt_pk_f32_fp8((int)p, false); const auto hi = __builtin_amdgcn_cvt_pk_f32_fp8((int)p, true); return (f32x4){lo[0], lo[1], hi[0], hi[1]}; }
__device__ __forceinline__ void peer_sliced(Frame& F) {
    const unsigned char* U8T = F.ws + WS_U8; const unsigned char* V8T = F.ws + WS_V8; unsigned char* X4 = F.ws + WS_X4;
    const float* SSQ = (const float*)(F.ws + WS_CTL) + CW_SSQ;
    const int* IDX = (const int*)(F.ws + WS_IDX); const float* GATE = (const float*)(F.ws + WS_GATE); const float* GSU = (const float*)(F.ws + WS_GSU); const float* gf = F.in[17];
    unsigned char* PO = F.ws + WS_PO; const bf16* HB = (const bf16*)(F.ws + WS_HN2);
    const int gw = F.vcu * NWAVES + F.wave, NGW = F.G * NWAVES, lane = F.lane, m = lane & 15, g = lane >> 4;
    const int row8 = lane >> 3, piece = lane & 7;
    LAS unsigned char* wb = F.lds + F.wave * PG_WB;
    LAS unsigned short* idxs = (LAS unsigned short*)(wb + PG_IDX);
    LAS float* hid = (LAS float*)(wb + PG_HID);
    LAS float* sqp = hid + 64 + lane;
    LAS float* sai = (LAS float*)(wb + PG_SA);
    LAS unsigned char* tb = wb + PG_TB;
    const int p8 = m & 7; const unsigned bsh = 8u * (unsigned)(p8 & 3); const bool bhi = (p8 >> 2) != 0;
    constexpr size_t SLICE = (size_t)16384 * 128;
    const int usw = 16 * (piece ^ ((row8 >> 1) & 3));
    const int urd0 = m * 128 + 16 * ((2 * g) ^ ((m >> 1) & 7)), urd1 = m * 128 + 16 * ((2 * g + 1) ^ ((m >> 1) & 7));
    for (int blk = gw; blk < NTOK / PG_TOK; blk += NGW) {
        const int t0 = blk * PG_TOK;
#pragma unroll
        for (int k = 0; k < 32; ++k) { const int id = lane + 64 * k;
            idxs[16 * (lane & 7) + (lane >> 3) + 128 * (k >> 1) + 8 * (k & 1)] = (unsigned short)IDX[(size_t)t0 * NEXP_SEL + id]; }
#pragma unroll
        for (int k = 0; k < 8; ++k) *(LAS f32x4*)(hid + 4 * (lane + 64 * k)) = (f32x4){0.f, 0.f, 0.f, 0.f};
        LDS_WAIT(); asm volatile("" ::: "memory");
        float xdq = 1.f;
        { f32x4 g2v[4];
#pragma unroll
          for (int q = 0; q < 4; ++q) g2v[q] = *((const GAS f32x4*)F.in[12] + 4 * lane + q);
#pragma unroll
          for (int i0 = 0; i0 < PG_TOK; i0 += 8) { v4u xr[8][2];
#pragma unroll
            for (int i = 0; i < 8; ++i) { const GAS v4u* hp_ = (const GAS v4u*)(HB + (size_t)(t0 + i0 + i) * DM) + 2 * lane; xr[i][0] = hp_[0]; xr[i][1] = hp_[1]; }
#pragma unroll
            for (int i = 0; i < 8; ++i) { const unsigned w_[8] = {xr[i][0].x, xr[i][0].y, xr[i][0].z, xr[i][0].w, xr[i][1].x, xr[i][1].y, xr[i][1].z, xr[i][1].w}; float f_[16]; float am = 0.f;
#pragma unroll
              for (int q = 0; q < 8; ++q) { f_[2 * q] = bflo(w_[q]) * g2v[q >> 1][2 * (q & 1)]; f_[2 * q + 1] = bfhi(w_[q]) * g2v[q >> 1][2 * (q & 1) + 1]; am = fmaxf(am, fmaxf(fabsf(f_[2 * q]), fabsf(f_[2 * q + 1]))); }
#pragma unroll
              for (int o = 1; o < 64; o <<= 1) am = fmaxf(am, __shfl_xor(am, o));
              const float qs = am > 0.f ? 6.f / am : 1.f; unsigned r0 = 0u, r1 = 0u;
              r0 = __builtin_amdgcn_cvt_scalef32_pk_fp4_f32(r0, f_[0] * qs, f_[1] * qs, 1.0f, 0); r0 = __builtin_amdgcn_cvt_scalef32_pk_fp4_f32(r0, f_[2] * qs, f_[3] * qs, 1.0f, 1);
              r0 = __builtin_amdgcn_cvt_scalef32_pk_fp4_f32(r0, f_[4] * qs, f_[5] * qs, 1.0f, 2); r0 = __builtin_amdgcn_cvt_scalef32_pk_fp4_f32(r0, f_[6] * qs, f_[7] * qs, 1.0f, 3);
              r1 = __builtin_amdgcn_cvt_scalef32_pk_fp4_f32(r1, f_[8] * qs, f_[9] * qs, 1.0f, 0); r1 = __builtin_amdgcn_cvt_scalef32_pk_fp4_f32(r1, f_[10] * qs, f_[11] * qs, 1.0f, 1);
              r1 = __builtin_amdgcn_cvt_scalef32_pk_fp4_f32(r1, f_[12] * qs, f_[13] * qs, 1.0f, 2); r1 = __builtin_amdgcn_cvt_scalef32_pk_fp4_f32(r1, f_[14] * qs, f_[15] * qs, 1.0f, 3);
              *(GAS v2u*)(X4 + (size_t)(t0 + i0 + i) * 512 + 8 * lane) = (v2u){r0, r1};
              xdq = lane == i0 + i ? (am > 0.f ? am * (1.f / 6.f) : 1.f) : xdq; } }
        }
        VM_WAIT();
        v4u ab[2][16]; l2 xs[2][2];
#define PGU_ISSUE_AT(UP_, XP_, i_, buf_) do { _Pragma("unroll") for (int k = 0; k < 16; ++k) { const unsigned e = idxs[(i_) * 128 + 16 * row8 + k]; \
                ab[buf_][k] = *(const GAS v4u*)((UP_) + (size_t)(e * 128u + (unsigned)(usw ^ ((k & 1) ? 64 : 0)))); } \
                _Pragma("unroll") for (int q = 0; q < 2; ++q) xs[buf_][q] = *(const GAS l2*)((XP_) + (size_t)(unsigned)(32 * g + (i_) * 512 + 16 * q)); } while (0)
        PGU_ISSUE_AT(U8T, X4 + (size_t)t0 * 512, 0, 0);
        for (int p = 0; p < 4; ++p) {
            const unsigned char* Up = U8T + (size_t)p * SLICE;
            const unsigned char* Xp = X4 + (size_t)t0 * 512 + 128 * p;
#define PGU_WR(i_, cur_, rb_, S_) do { _Pragma("unroll") for (int q4 = 0; q4 < 4; ++q4) *(LAS v4u*)(tb + 1024 * q4 + 16 * lane) = ab[cur_][4 * (rb_) + q4]; \
                S_##0 = *(const LAS l2*)(tb + urd0); S_##1 = *(const LAS l2*)(tb + urd1); S_##2 = *(const LAS l2*)(tb + 2048 + urd0); S_##3 = *(const LAS l2*)(tb + 2048 + urd1); \
                S_##c0 = *(const LAS f32x4*)(hid + (i_) * 128 + 32 * (rb_) + 4 * g); S_##c1 = *(const LAS f32x4*)(hid + (i_) * 128 + 32 * (rb_) + 16 + 4 * g); } while (0)
#define PGU_MF(i_, cur_, rb_, S_) do { f32x4 acc0 = S_##c0, acc1 = S_##c1; \
                const pgv8i x0_ = pg_lo8(xs[cur_][0]), x1_ = pg_lo8(xs[cur_][1]); \
                acc0 = __builtin_amdgcn_mfma_scale_f32_16x16x128_f8f6f4(pg_lo8(S_##0), x0_, acc0, 4, 4, 0, 0x7f7f7f7f, 0, 0x7f7f7f7f); acc1 = __builtin_amdgcn_mfma_scale_f32_16x16x128_f8f6f4(pg_lo8(S_##2), x0_, acc1, 4, 4, 0, 0x7f7f7f7f, 0, 0x7f7f7f7f); \
                acc0 = __builtin_amdgcn_mfma_scale_f32_16x16x128_f8f6f4(pg_lo8(S_##1), x1_, acc0, 4, 4, 0, 0x7f7f7f7f, 0, 0x7f7f7f7f); acc1 = __builtin_amdgcn_mfma_scale_f32_16x16x128_f8f6f4(pg_lo8(S_##3), x1_, acc1, 4, 4, 0, 0x7f7f7f7f, 0, 0x7f7f7f7f); \
                LAS float* hp_ = hid + (i_) * 128 + 32 * (rb_) + 4 * g; \
                asm volatile("s_nop 7\n\ts_mov_b32 exec_lo, 0x10001\n\ts_mov_b32 exec_hi, 0x10001\n\t" \
                             "ds_write_b128 %0, %1\n\tds_write_b128 %0, %2 offset:64\n\t" \
                             "s_mov_b64 exec, -1" \
                             :: "v"(hp_), "v"(acc0), "v"(acc1) : "memory"); } while (0)
#define PGU_BODY(i_, cur_, nxt_) do { { const bool wr_ = (i_) + 1 == PG_TOK; const int nx_ = wr_ ? 0 : (i_) + 1; const unsigned char* un_ = wr_ ? Up + SLICE : Up; const unsigned char* xn_ = wr_ ? Xp + 128 : Xp; PGU_ISSUE_AT(un_, xn_, nx_, nxt_); } SCHED_FENCE(); \
                l2 fa0, fa1, fa2, fa3, fb0, fb1, fb2, fb3; f32x4 fac0, fac1, fbc0, fbc1; \
                PGU_WR(i_, cur_, 0, fa); PGU_WR(i_, cur_, 1, fb); SCHED_FENCE(); \
                PGU_MF(i_, cur_, 0, fa); SCHED_FENCE(); PGU_WR(i_, cur_, 2, fa); SCHED_FENCE(); \
                PGU_MF(i_, cur_, 1, fb); SCHED_FENCE(); PGU_WR(i_, cur_, 3, fb); SCHED_FENCE(); \
                PGU_MF(i_, cur_, 2, fa); SCHED_FENCE(); PGU_MF(i_, cur_, 3, fb); SCHED_FENCE(); } while (0)
            for (int i2 = 0; i2 < PG_TOK; i2 += 2) { PGU_BODY(i2, 0, 1); PGU_BODY(i2 + 1, 1, 0); }
#undef PGU_BODY
#undef PGU_WR
#undef PGU_MF
            LDS_WAIT(); asm volatile("" ::: "memory");
        }
        { f32x2_t suv[16], gvv[16], hv[16];
          float sxl = SSQ[t0 + (lane & 15)]; sxl = xdq / sqrtf(sxl * (1.f / DM) + EPS);
#pragma unroll
          for (int i = 0; i < PG_TOK; ++i) { suv[i] = *(const GAS f32x2_t*)(GSU + (size_t)(t0 + i) * NEXP_SEL + 2 * lane); gvv[i] = *(const GAS f32x2_t*)(GATE + (size_t)(t0 + i) * NEXP_SEL + 2 * lane); }
#pragma unroll
          for (int i = 0; i < PG_TOK; ++i) hv[i] = *(const LAS f32x2_t*)(hid + i * 128 + 2 * lane);
          float w0[16], w1[16], am[16];
#pragma unroll
          for (int i = 0; i < PG_TOK; ++i) { const float sx = __builtin_bit_cast(float, __builtin_amdgcn_readlane(__builtin_bit_cast(int, sxl), i));
              w0[i] = gelu_as(hv[i].x * suv[i].x * sx) * gvv[i].x; w1[i] = gelu_as(hv[i].y * suv[i].y * sx) * gvv[i].y; am[i] = fmaxf(fabsf(w0[i]), fabsf(w1[i])); }
#pragma unroll
          for (int o = 1; o < 64; o <<= 1)
#pragma unroll
              for (int i = 0; i < PG_TOK; ++i) am[i] = fmaxf(am[i], __shfl_xor(am[i], o));
          LDS_WAIT(); asm volatile("" ::: "memory");
#pragma unroll
          for (int i = 0; i < PG_TOK; ++i) { const float sa = am[i] > 0.f ? 224.f / am[i] : 1.f;
              const int pk = __builtin_amdgcn_cvt_pk_fp8_f32(w0[i] * sa, w1[i] * sa, 0, false);
              LAS unsigned char* wq = (LAS unsigned char*)(hid + i * 128) + 32 * (lane & 3) + (lane >> 2);
              wq[0] = (unsigned char)pk; wq[16] = (unsigned char)(pk >> 8);
              if (lane == 0) sai[i] = am[i] > 0.f ? am[i] * (1.f / 224.f) : 1.f; }
        }
        LDS_WAIT(); asm volatile("" ::: "memory");
        v4u va[2][16];
#define PGV_ISSUE_AT(VP_, i_, buf_) do { _Pragma("unroll") for (int k = 0; k < 16; ++k) { const unsigned e = idxs[(i_) * 128 + 16 * row8 + k]; va[buf_][k] = *(const GAS v4u*)((VP_) + (size_t)(e * 128u + 16u * (unsigned)piece)); } } while (0)
        PGV_ISSUE_AT(V8T, 0, 0);
        for (int p = 0; p < 8; ++p) {
            const unsigned char* Vp = V8T + (size_t)p * SLICE;
#define PGV_BODY(i_, cur_, nxt_) do { { const bool wr_ = (i_) + 1 == PG_TOK; const int nx_ = wr_ ? 0 : (i_) + 1; const unsigned char* vn_ = wr_ ? Vp + SLICE : Vp; PGV_ISSUE_AT(vn_, nx_, nxt_); } \
                const v4u w4_ = *(const LAS v4u*)((LAS unsigned char*)(hid + (i_) * 128) + 16 * row8); \
                const unsigned ww[4] = {w4_.x, w4_.y, w4_.z, w4_.w}; \
                SCHED_FENCE(); f32x4 cl = (f32x4){0.f, 0.f, 0.f, 0.f}, chh = (f32x4){0.f, 0.f, 0.f, 0.f}; \
                _Pragma("unroll") for (int k = 0; k < 16; ++k) { \
                    const unsigned a8 = ((ww[k >> 2] >> (8 * (k & 3))) & 0xffu) << bsh; const long bop = (long)(bhi ? ((unsigned long long)a8 << 32) : (unsigned long long)a8); \
                    const long alo = (long)(((unsigned long long)va[cur_][k].y << 32) | (unsigned long long)va[cur_][k].x), ahi = (long)(((unsigned long long)va[cur_][k].w << 32) | (unsigned long long)va[cur_][k].z); \
                    cl = __builtin_amdgcn_mfma_f32_16x16x32_fp8_fp8(alo, bop, cl, 0, 0, 0); chh = __builtin_amdgcn_mfma_f32_16x16x32_fp8_fp8(ahi, bop, chh, 0, 0, 0); } \
                SCHED_FENCE(); \
                _Pragma("unroll") for (int i4 = 0; i4 < 4; ++i4) { \
                    cl[i4] += __shfl(cl[i4], (lane + 40) & 63); chh[i4] += __shfl(chh[i4], (lane + 40) & 63); } \
                { const float isa = sai[i_]; LAS unsigned char* ob = (LAS unsigned char*)(tb) + 64 * g + m;         \
                  if (m < 8 && g < 2) { _Pragma("unroll") for (int i4 = 0; i4 < 4; ++i4) { const int pk_ = __builtin_amdgcn_cvt_pk_fp8_f32(cl[i4] * isa, chh[i4] * isa, 0, false); ob[16 * i4] = (unsigned char)pk_; ob[16 * i4 + 8] = (unsigned char)(pk_ >> 8); } } \
                  const v2u ov = *(const LAS v2u*)(tb + 8 * (lane & 15)); \
                  if (lane < 16) *(GAS v2u*)(PO + (size_t)(t0 + (i_)) * DM + 128 * p + 8 * lane) = ov; } } while (0)
            for (int i2 = 0; i2 < PG_TOK; i2 += 2) { PGV_BODY(i2, 0, 1); PGV_BODY(i2 + 1, 1, 0); }
#undef PGV_BODY
        }
        LDS_WAIT(); asm volatile("" ::: "memory");
        VM_WAIT();
#undef PGU_ISSUE_AT
#undef PGV_ISSUE_AT
        { f32x4 ggv[4];
#pragma unroll
          for (int j = 0; j < 4; ++j) ggv[j] = *((const GAS f32x4*)gf + lane + 64 * j);
          unsigned paX[4], pbX[4], paY[4], pbY[4]; v2u haX[4], hbX[4], haY[4], hbY[4];
#define PGF_LOAD(S_, i_) do { const GAS unsigned* prA = (const GAS unsigned*)(PO + (size_t)(t0 + (i_)) * DM) + lane; const GAS unsigned* prB = prA + DM / 4; \
              const GAS v2u* hbA = (const GAS v2u*)(HB + (size_t)(t0 + (i_)) * DM) + lane; const GAS v2u* hbB = hbA + DM / 4; \
              _Pragma("unroll") for (int j = 0; j < 4; ++j) { pa##S_[j] = prA[64 * j]; ha##S_[j] = hbA[64 * j]; pb##S_[j] = prB[64 * j]; hb##S_[j] = hbB[64 * j]; } } while (0)
#define PGF_BODY(S_, i_) do { GAS f32x4* hrA = (GAS f32x4*)(F.out + (size_t)(t0 + (i_)) * DM) + lane; GAS f32x4* hrB = hrA + DM / 4; \
              f32x4 ya[4], yb[4]; float sa = 0.f, sb = 0.f; \
              _Pragma("unroll") for (int j = 0; j < 4; ++j) { \
                  ya[j] = (f32x4){bflo(ha##S_[j].x), bfhi(ha##S_[j].x), bflo(ha##S_[j].y), bfhi(ha##S_[j].y)} + f8x4(pa##S_[j]); \
                  yb[j] = (f32x4){bflo(hb##S_[j].x), bfhi(hb##S_[j].x), bflo(hb##S_[j].y), bfhi(hb##S_[j].y)} + f8x4(pb##S_[j]); \
                  sa += (ya[j].x * ya[j].x + ya[j].y * ya[j].y) + (ya[j].z * ya[j].z + ya[j].w * ya[j].w); sb += (yb[j].x * yb[j].x + yb[j].y * yb[j].y) + (yb[j].z * yb[j].z + yb[j].w * yb[j].w); } \
              _Pragma("unroll") for (int o = 1; o < 64; o <<= 1) { sa += __shfl_xor(sa, o); sb += __shfl_xor(sb, o); } \
              const float ra = 1.f / sqrtf(sa * (1.f / DM) + EPS), rb = 1.f / sqrtf(sb * (1.f / DM) + EPS); \
              _Pragma("unroll") for (int j = 0; j < 4; ++j) { hrA[64 * j] = ya[j] * ra * ggv[j]; hrB[64 * j] = yb[j] * rb * ggv[j]; } } while (0)
          PGF_LOAD(X, 0);
          for (int i = 0; i < PG_TOK; i += 4) { PGF_LOAD(Y, i + 2); PGF_BODY(X, i); PGF_LOAD(X, (i + 4) & (PG_TOK - 1)); PGF_BODY(Y, i + 2); }
#undef PGF_LOAD
#undef PGF_BODY
        }
        LDS_WAIT(); asm volatile("" ::: "memory");
    }
}

struct Args { const float* in[18]; float* out; unsigned char* ws; int ph_lo, ph_hi; };
__global__ void __launch_bounds__(NWAVES * 64, 2) hymba_fwd(Args args) {
    extern __shared__ __attribute__((aligned(16))) unsigned char lds[];
    Frame F;
    F.lds = (LAS unsigned char*)lds;
    F.MISC = (volatile LAS unsigned*)(F.lds + MISC_OFF);
    F.tid = threadIdx.x; F.lane = F.tid & 63; F.wave = __builtin_amdgcn_readfirstlane(F.tid >> 6);
    F.G = gridDim.x; { const int bx = blockIdx.x; F.vcu = (F.G % 8 == 0) ? (bx % 8) * (F.G / 8) + bx / 8 : bx; }
#pragma unroll
    for (int i = 0; i < 18; ++i) F.in[i] = args.in[i];
    F.out = args.out; F.ws = args.ws;
    for (int u = F.tid; u < (LDS_BYTES - LDSCTL_OFF) / 4; u += NWAVES * 64) ((LAS unsigned*)(F.lds + LDSCTL_OFF))[u] = 0u;
    __syncthreads();
    const int lo = args.ph_lo, hi = args.ph_hi;
    const bool multi = (hi - lo) > 1;
    XcdBarrier bar; bar.bar = (unsigned*)(F.ws + WS_CTL) + CW_BAR; bar.x = 0; bar.st = nullptr;
    if (multi) bar = xcd_barrier_post((unsigned*)(F.ws + WS_CTL) + CW_BAR, F.MISC + 8);
#define IN(k) (lo <= (k) && (k) < hi)
#define SEAM(k) do { if (IN(k) && IN((k) + 1)) xcd_barrier(bar); } while (0)

    if (IN(0)) { p0_prologue(F); } SEAM(0);
    if (IN(1)) {
        pg8::Gemm g{(const pg8::bf16_t*)(F.ws + WS_HN), (const pg8::bf16_t*)(F.ws + WS_WIN), NTOK, INW, DM}; pg8::StaticOrder S; S.init(NTOK, INW, F.G, (int)blockIdx.x);
        pg8::EpiProj E{(pg8::bf16_t*)(F.ws + WS_PROJ), INW, 2, QSCALE};
        pg8::gemm_phase<pg8::EpiProj, pg8::StaticOrder, PG8_ALIGN, PG8_SP2>(F.lds + RING_OFF, g, S, E);
    } SEAM(1);
    if (IN(2)) { hgrn_mfma(F); }
    if (IN(3)) { quant_drain(F); attn_mfma(F, 0); }
    if (IN(3) && IN(4)) xcd_barrier(bar);
    if (IN(4)) {
        pg8::Gemm g{(const pg8::bf16_t*)(F.ws + WS_HN), (const pg8::bf16_t*)(F.ws + WS_WOUT), NTOK, DM, DM}; pg8::StaticOrder S; S.init(NTOK, DM, F.G, (int)blockIdx.x);
        pg8::EpiMix E{DM, F.in[0], (pg8::bf16_t*)(F.ws + WS_HN2), (float*)(F.ws + WS_CTL) + CW_SSQ};
        pg8::gemm_phase<pg8::EpiMix, pg8::StaticOrder, PG8_ALIGN, PG8_SP2>(F.lds + RING_OFF, g, S, E);
    }
    if (IN(4) && IN(6)) xcd_barrier(bar);
    if (IN(6)) {
        pg8::Gemm g{(const pg8::bf16_t*)(F.ws + WS_HN2), (const pg8::bf16_t*)(F.ws + WS_W2), NTOK, 2048, DM}; pg8::StaticOrder S; S.init(NTOK, 2048, F.G, (int)blockIdx.x);
        pg8::EpiScaleRow E{(_Float16*)(F.ws + WS_SC), 2048, (const float*)(F.ws + WS_CTL) + CW_SSQ, 1.f / DM, EPS};
        pg8::gemm_phase<pg8::EpiScaleRow, pg8::StaticOrder, PG8_ALIGN, PG8_SP2>(F.lds + RING_OFF, g, S, E);
    } SEAM(6);
    if (IN(7)) { topk_v2(F); }
    if (IN(7) && IN(8)) { VM_WAIT(); }
    if (IN(8)) { peer_sliced(F); }
#undef IN
#undef SEAM
}

extern "C" void kernel_launch(void* const* d_in, const int* in_sizes, int n_in, void* d_out, int out_size, void* d_ws, size_t ws_size, hipStream_t stream) {
    static int grid = 0;
    if (grid == 0) {
        if (n_in != 18 || in_sizes[0] != NTOK * DM || out_size != NTOK * DM || ws_size < WS_END) { fprintf(stderr, "kernel_launch: unexpected shapes (n_in %d, in0 %d, out %d, ws %zu); nothing launched\n", n_in, n_in > 0 ? in_sizes[0] : -1, out_size, ws_size); grid = -1; return; }
        int dev = 0, cus = 0, per_cu = 0;
        if (hipGetDevice(&dev) != hipSuccess || hipDeviceGetAttribute(&cus, hipDeviceAttributeMultiprocessorCount, dev) != hipSuccess) { grid = -1; return; }
        if (hipFuncSetAttribute((const void*)hymba_fwd, hipFuncAttributeMaxDynamicSharedMemorySize, LDS_BYTES) != hipSuccess) { fprintf(stderr, "kernel_launch: hipFuncSetAttribute failed\n"); grid = -1; return; }
        if (hipOccupancyMaxActiveBlocksPerMultiprocessor(&per_cu, (const void*)hymba_fwd, NWAVES * 64, LDS_BYTES) != hipSuccess || per_cu < 1)
            fprintf(stderr, "kernel_launch: note: occupancy query reports %d workgroups per CU\n", per_cu);
        (void)hipGetLastError();
        grid = cus;
    }
    if (grid < 0) return;
    if (hipMemsetAsync((char*)d_ws + WS_CTL, 0, CTL_ZERO_BYTES, stream) != hipSuccess) return;
    Args a{};
    for (int i = 0; i < 18; ++i) a.in[i] = (const float*)d_in[i];
    a.out = (float*)d_out; a.ws = (unsigned char*)d_ws; a.ph_lo = 0; a.ph_hi = 9;
    hipLaunchKernelGGL(hymba_fwd, dim3(grid), dim3(NWAVES * 64), LDS_BYTES, stream, a);
}
```
